# Optimizing an MI355X kernel written in HIP

```python
import jax, jax.numpy as jnp
from jax import lax
import numpy as np

D_MODEL = 1024
BATCH = 4
SEQ = 8192
DEPTH = 1

GMLP_GROUPS = 4
GMLP_GROUP_DIM = 128
GMLP_WIDTH = GMLP_GROUPS * GMLP_GROUP_DIM
CHUNK = 128
N_HEADS = 8
Q_RANK = 256
KV_RANK = 128
HEAD_V = 64
ATTN_WIDTH = N_HEADS * HEAD_V
IDX_HEADS = 4
IDX_DIM = 64
TOPK_MAX = 256
Q_BLOCK = 128
N_EXPERTS = 32
TOP_K = 4
D_EXPERT = 1024
SWIGLU_LIMIT = 7.0
SWIGLU_ALPHA = 1.702
MOE_BLOCK = 128
EPS = 1e-6

OFF_UV = 0
OFF_CQ = OFF_UV + 2 * GMLP_WIDTH
OFF_CKV = OFF_CQ + Q_RANK
OFF_KIDX = OFF_CKV + KV_RANK
OFF_WIDX = OFF_KIDX + IDX_DIM
OFF_GATE = OFF_WIDX + IDX_HEADS
IN_WIDTH = OFF_GATE + 2 * D_MODEL

kernel_name = "hybrid_gmlp_dsa_moe_block"


def rms_norm(x, g):
    xf = x.astype(jnp.float32)
    y = xf * lax.rsqrt(jnp.mean(xf * xf, axis=-1, keepdims=True) + EPS)
    return (y * g.astype(jnp.float32)).astype(x.dtype)


def gmlp_mixer(uv, v_g, w_s, b_s):
    B, S, _ = uv.shape
    z = jax.nn.gelu(uv)
    u, v = z[..., :GMLP_WIDTH], z[..., GMLP_WIDTH:]
    v = v.reshape(B, S // CHUNK, CHUNK, GMLP_GROUPS, GMLP_GROUP_DIM)
    v = rms_norm(v, v_g)
    causal = jnp.tril(jnp.ones((CHUNK, CHUNK), dtype=bool))
    w = jnp.where(causal[None], w_s, jnp.zeros_like(w_s)).astype(v.dtype)
    sv = jnp.einsum('gts,bcsgd->bctgd', w, v) + b_s.T[None, None, :, :, None].astype(v.dtype)
    return u * sv.reshape(B, S, GMLP_WIDTH)


def dsa_mixer(q, kv, q_idx, k_idx, w_idx, w_uv):
    B, S, H, C = q.shape
    nb = S // Q_BLOCK
    k_top = min(TOPK_MAX, S // 4)
    scale = C ** -0.5
    k_idx_f = k_idx.astype(jnp.float32)
    key_pos = jnp.arange(S)

    def to_blocks(a):
        return jnp.moveaxis(a.reshape((B, nb, Q_BLOCK) + a.shape[2:]), 1, 0)

    def attn_block(args):
        blk, qb, qib, wb = args
        t = blk * Q_BLOCK + jnp.arange(Q_BLOCK)
        logits = jnp.einsum('bqhd,bsd->bqhs', qib.astype(jnp.float32), k_idx_f) * (IDX_DIM ** -0.5)
        score = jnp.einsum('bqhs,bqh->bqs', jax.nn.relu(logits), wb.astype(jnp.float32))
        causal = key_pos[None, :] <= t[:, None]
        score = jnp.where(causal[None], score, -jnp.inf)
        _, idx = lax.top_k(score, k_top)
        valid = idx <= t[None, :, None]
        kv_sel = jax.vmap(lambda kv_b, i_b: kv_b[i_b])(kv, idx).astype(jnp.float32)
        s = jnp.einsum('bqhc,bqkc->bhqk', qb.astype(jnp.float32), kv_sel) * scale
        s = jnp.where(valid[:, None], s, -jnp.inf)
        p = jax.nn.softmax(s, axis=-1)
        o = jnp.einsum('bhqk,bqkc->bqhc', p, kv_sel)
        return o.astype(q.dtype)

    o = lax.map(attn_block, (jnp.arange(nb), to_blocks(q), to_blocks(q_idx), to_blocks(w_idx)))
    o = jnp.moveaxis(o, 0, 1).reshape(B, S, H, C)
    o = jnp.einsum('bshc,hcv->bshv', o, w_uv)
    return o.reshape(B, S, ATTN_WIDTH)


def moe(xn, w_router, b_router, w_exp1, b_exp1, w_exp2, b_exp2):
    B, S, D = xn.shape
    T = B * S
    xt = xn.reshape(T, D)
    logits = (xt @ w_router + b_router).astype(jnp.float32)
    top_val, top_idx = lax.top_k(logits, TOP_K)
    gates = jax.nn.softmax(top_val, axis=-1)
    P = T * TOP_K
    flat_e = top_idx.reshape(P)
    flat_tok = jnp.repeat(jnp.arange(T, dtype=jnp.int32), TOP_K)
    flat_g = gates.reshape(P)
    order = jnp.argsort(flat_e, stable=True)
    se = flat_e[order]
    counts = jnp.bincount(flat_e, length=N_EXPERTS)
    padded = (counts + MOE_BLOCK - 1) // MOE_BLOCK * MOE_BLOCK
    pad_end = jnp.cumsum(padded)
    pad_start = pad_end - padded
    grp_start = jnp.cumsum(counts) - counts
    dest = pad_start[se] + (jnp.arange(P) - grp_start[se])
    n_blocks = -(-P // MOE_BLOCK) + N_EXPERTS
    n_rows = n_blocks * MOE_BLOCK
    row_tok = jnp.full((n_rows,), T, dtype=jnp.int32).at[dest].set(flat_tok[order])
    row_gate = jnp.zeros((n_rows,), jnp.float32).at[dest].set(flat_g[order])
    blk_start = jnp.arange(n_blocks) * MOE_BLOCK
    blk_e = jnp.minimum(jnp.searchsorted(pad_end, blk_start, side='right'), N_EXPERTS - 1)
    x_pad = jnp.concatenate([xt, jnp.zeros((1, D), xt.dtype)], axis=0)

    def expert_block(args):
        tok, g, e = args
        xb = x_pad[tok]
        hb = xb @ w_exp1[e] + b_exp1[e]
        hg = jnp.minimum(hb[:, :D_EXPERT], SWIGLU_LIMIT)
        hu = jnp.clip(hb[:, D_EXPERT:], -SWIGLU_LIMIT, SWIGLU_LIMIT)
        act = (hu + 1.0) * (hg * jax.nn.sigmoid(SWIGLU_ALPHA * hg))
        y = act @ w_exp2[e] + b_exp2[e]
        return y * g[:, None].astype(y.dtype)

    ys = lax.map(expert_block, (row_tok.reshape(n_blocks, MOE_BLOCK),
                                row_gate.reshape(n_blocks, MOE_BLOCK), blk_e))
    out = jax.ops.segment_sum(ys.reshape(n_rows, D), row_tok, num_segments=T + 1)[:T]
    return out.reshape(B, S, D)


def setup_inputs(seed: int = 0) -> dict:
    key = jax.random.key(seed)
    ks = jax.random.split(key, 24)
    f32 = jnp.float32

    def nrm(k, shape, fan_in):
        return jax.random.normal(k, shape, f32) * (fan_in ** -0.5)

    def gain(k, n):
        return 1.0 + 0.1 * jax.random.normal(k, (n,), f32)

    return {
        "x": jax.random.normal(ks[0], (BATCH, SEQ, D_MODEL), f32),
        "norm1_g": gain(ks[1], D_MODEL),
        "w_in": nrm(ks[2], (D_MODEL, IN_WIDTH), D_MODEL),
        "q_lat_g": gain(ks[3], Q_RANK),
        "w_uq": nrm(ks[4], (Q_RANK, N_HEADS, KV_RANK), Q_RANK),
        "q_norm_g": gain(ks[5], KV_RANK),
        "kv_norm_g": gain(ks[6], KV_RANK),
        "w_uv": nrm(ks[7], (N_HEADS, KV_RANK, HEAD_V), KV_RANK),
        "w_q_idx": nrm(ks[8], (Q_RANK, IDX_HEADS, IDX_DIM), Q_RANK),
        "k_idx_g": gain(ks[9], IDX_DIM),
        "gmlp_v_g": gain(ks[10], GMLP_GROUP_DIM),
        "w_spatial": nrm(ks[11], (GMLP_GROUPS, CHUNK, CHUNK), CHUNK),
        "b_spatial": 1.0 + 0.1 * jax.random.normal(ks[12], (GMLP_GROUPS, CHUNK), f32),
        "w_proj_a": nrm(ks[13], (GMLP_WIDTH, D_MODEL), GMLP_WIDTH),
        "w_proj_b": nrm(ks[14], (ATTN_WIDTH, D_MODEL), ATTN_WIDTH),
        "w_out": nrm(ks[15], (D_MODEL, D_MODEL), D_MODEL),
        "norm2_g": gain(ks[16], D_MODEL),
        "w_router": nrm(ks[17], (D_MODEL, N_EXPERTS), D_MODEL),
        "b_router": 0.01 * jax.random.normal(ks[18], (N_EXPERTS,), f32),
        "w_exp1": nrm(ks[19], (N_EXPERTS, D_MODEL, 2 * D_EXPERT), D_MODEL),
        "b_exp1": 0.01 * jax.random.normal(ks[20], (N_EXPERTS, 2 * D_EXPERT), f32),
        "w_exp2": nrm(ks[21], (N_EXPERTS, D_EXPERT, D_MODEL), D_EXPERT),
        "b_exp2": 0.01 * jax.random.normal(ks[22], (N_EXPERTS, D_MODEL), f32),
    }


def reference(x, norm1_g, w_in, q_lat_g, w_uq, q_norm_g, kv_norm_g, w_uv, w_q_idx, k_idx_g,
              gmlp_v_g, w_spatial, b_spatial, w_proj_a, w_proj_b, w_out, norm2_g,
              w_router, b_router, w_exp1, b_exp1, w_exp2, b_exp2):
    for _ in range(DEPTH):
        xn = rms_norm(x, norm1_g)
        h = xn @ w_in
        y_a = gmlp_mixer(h[..., OFF_UV:OFF_CQ], gmlp_v_g, w_spatial, b_spatial)
        c_q = rms_norm(h[..., OFF_CQ:OFF_CKV], q_lat_g)
        q = rms_norm(jnp.einsum('bsr,rhc->bshc', c_q, w_uq), q_norm_g)
        kv = rms_norm(h[..., OFF_CKV:OFF_KIDX], kv_norm_g)
        q_idx = jnp.einsum('bsr,rhd->bshd', c_q, w_q_idx)
        k_idx = rms_norm(h[..., OFF_KIDX:OFF_WIDX], k_idx_g)
        w_idx = h[..., OFF_WIDX:OFF_GATE] * (IDX_HEADS ** -0.5)
        y_b = dsa_mixer(q, kv, q_idx, k_idx, w_idx, w_uv)
        g_a = jax.nn.sigmoid(h[..., OFF_GATE:OFF_GATE + D_MODEL])
        g_b = jax.nn.sigmoid(h[..., OFF_GATE + D_MODEL:IN_WIDTH])
        merged = g_a * (y_a @ w_proj_a) + g_b * (y_b @ w_proj_b)
        x = x + merged @ w_out
        x = x + moe(rms_norm(x, norm2_g), w_router, b_router, w_exp1, b_exp1, w_exp2, b_exp2)
    return x
```

```cpp
#include <hip/hip_runtime.h>
#include <hip/hip_cooperative_groups.h>
#include <cstdio>
#include <cstdint>
namespace cg = cooperative_groups;

#define LAS __attribute__((address_space(3)))
#define DI __device__ __forceinline__
typedef unsigned short u16;
typedef short bf16x8 __attribute__((ext_vector_type(8)));
typedef short s16x4 __attribute__((ext_vector_type(4)));
typedef float f32x4 __attribute__((ext_vector_type(4)));
typedef float f32x2 __attribute__((ext_vector_type(2)));
typedef unsigned u32x4 __attribute__((ext_vector_type(4)));
typedef unsigned u32x2 __attribute__((ext_vector_type(2)));
typedef __bf16 bf2_t __attribute__((ext_vector_type(2)));

constexpr int NT = 512;
constexpr int LDS_BYTES = 155648;
constexpr int Dm = 1024, Bsz = 4, S = 8192, T = Bsz * S;
constexpr int NIN = 3584;
constexpr int NE = 32, ECAP = 32768, PPAD = 131072 + NE * 256;
constexpr float EPS = 1e-6f;

constexpr size_t MiB = 1024 * 1024;
constexpr size_t WS_CTL = 0;
constexpr size_t WS_WIN = 64 * 1024;
constexpr size_t WS_WQ = WS_WIN + (size_t)NIN * 1024 * 2;
constexpr size_t WS_WSP = WS_WQ + 1280 * 256 * 2;
constexpr size_t WS_WCAT = WS_WSP + 4 * 128 * 128 * 2;
constexpr size_t WS_WOUT = WS_WCAT + 1024 * 1536 * 2;
constexpr size_t WS_WR = WS_WOUT + 1024 * 1024 * 2;
constexpr size_t WS_WE1 = WS_WR + 32 * 1024 * 4;
constexpr size_t WS_WE2 = WS_WE1 + (size_t)32 * 2048 * 1024 * 2;
constexpr size_t WS_RS1 = WS_WE2 + (size_t)32 * 1024 * 1024 * 2;
constexpr size_t WS_SSQ = WS_RS1 + (size_t)T * 4;
constexpr size_t WS_WI = WS_SSQ + (size_t)T * 32 * 4;
constexpr size_t WS_ROUTE = WS_WI + (size_t)T * 4 * 4;
constexpr size_t WS_LTOK = WS_ROUTE + (size_t)T * 4 * 4;
constexpr size_t WS_LGATE = WS_LTOK + (size_t)NE * ECAP * 4;
constexpr size_t WS_XN2 = WS_LGATE + (size_t)NE * ECAP * 4;
constexpr size_t WS_R0 = WS_XN2 + (size_t)T * 1024 * 2;
constexpr size_t WS_XB = WS_R0;
constexpr size_t WS_H = WS_XB + (size_t)T * 1024 * 2;
constexpr size_t WS_Q = WS_H + (size_t)T * NIN * 2;
constexpr size_t WS_QI = WS_Q + (size_t)T * 1024 * 2;
constexpr size_t WS_KVN = WS_QI + (size_t)T * 256 * 2;
constexpr size_t WS_KIN = WS_KVN + (size_t)T * 128 * 2;
constexpr size_t WS_YO = WS_KIN + (size_t)T * 64 * 2;
constexpr size_t WS_TMP = WS_YO + (size_t)T * 1536 * 2;
constexpr size_t WS_MRG = WS_TMP + (size_t)T * 1024 * 2;
constexpr size_t WS_R0END = WS_MRG + (size_t)T * 1024 * 2;
constexpr size_t WS_ACT = WS_XB;
constexpr size_t WS_YB = WS_Q;
static_assert(WS_ACT + (size_t)PPAD * 1024 * 2 <= WS_Q, "ACT overlaps YB");
static_assert(WS_YB + (size_t)PPAD * 1024 * 2 <= WS_R0END, "YB too large");
constexpr size_t WS_END = WS_R0END;

struct Args { const float* in[23]; float* out; unsigned char* ws; unsigned mask; unsigned pad; };
enum { I_X = 0, I_N1G, I_WIN, I_QLG, I_WUQ, I_QNG, I_KVG, I_WUV, I_WQI, I_KIG, I_VG, I_WSP, I_BSP, I_WPA, I_WPB, I_WOUT, I_N2G, I_WR, I_BR, I_WE1, I_BE1, I_WE2, I_BE2 };

DI unsigned pk2(float a, float b) { f32x2 v = {a, b}; bf2_t r = __builtin_convertvector(v, bf2_t); return __builtin_bit_cast(unsigned, r); }
DI float bflo(unsigned u) { return __uint_as_float(u << 16); }
DI float bfhi(unsigned u) { return __uint_as_float(u & 0xffff0000u); }
DI u16 f2bf(float f) { return (u16)(pk2(f, 0.f) & 0xffffu); }
DI float bf2f(u16 h) { return __uint_as_float(((unsigned)h) << 16); }
DI float sigmoidf_(float x) { return __builtin_amdgcn_rcpf(1.0f + __expf(-x)); }
DI float gelu_tanh(float x) { const float u = 1.5957691216057308f * (x + 0.044715f * x * x * x); return x * sigmoidf_(u); }
DI int otid() { int t = threadIdx.x; asm volatile("" : "+v"(t)); return t; }
DI void wave_lds_sync() { asm volatile("s_waitcnt lgkmcnt(0)" ::: "memory"); }

namespace g8 {
constexpr int BM = 256, BK = 64, HALF = 128, HTB = HALF * BK * 2, STAGE_BYTES = 8 * HTB, NXCD = 8, WGM = 8;
DI int lds_byte(int r, int c) { const int st = (r >> 4) * 2 + (c >> 5), rr = r & 15, cc = c & 31, ob = rr * 64 + cc * 2; return st * 1024 + (ob ^ (((ob >> 9) & 1) << 5)); }
DI void stage_rc(int b, int& R, int& C) { const int st = b / 1024, sb = b % 1024, swz = sb ^ (((sb >> 9) & 1) << 5); R = (st >> 1) * 16 + swz / 64; C = (st & 1) * 32 + (swz % 64) / 2; }

struct UnitD { const char* Bp; int pm, pn, e, rb; };

DI bool static_tile(int i, int G, int c, int nM, int nN, int& pm, int& pn) {
    const int nwg = nM * nN; const long L = (long)i * G + c; if (L >= nwg) return false;
    int wgid = (int)L; { const int q = nwg / NXCD, r = nwg % NXCD, xcd = wgid % NXCD, off = wgid / NXCD; wgid = (xcd < r ? xcd * (q + 1) : r * (q + 1) + (xcd - r) * q) + off; }
    const int nig = WGM * nN, gid = wgid / nig, fm = gid * WGM, gsz = (nM - fm) < WGM ? (nM - fm) : WGM;
    pm = fm + ((wgid % nig) % gsz); pn = (wgid % nig) / gsz; return true;
}

struct PlainSched {
    const char* Abase; const char* Bbase; int lda, ldb, K, nM, nN, G, c;
    DI bool next(int i, UnitD& u) const { int pm, pn; if (!static_tile(i, G, c, nM, nN, pm, pn)) return false; u.pm = pm; u.pn = pn; u.e = 0; u.rb = 0; u.Bp = Bbase + (size_t)pn * BM * ldb * 2; return true; }
    DI void a_offs(const UnitD& u, int R0, int C0, unsigned (&o)[2][2]) const {
#pragma unroll
        for (int h = 0; h < 2; ++h)
#pragma unroll
            for (int i = 0; i < 2; ++i) o[h][i] = (unsigned)(((size_t)(u.pm * BM + h * HALF + R0 + 64 * i) * lda + C0) * 2);
    }
};

template <class Epi, class Sched>
DI void gemm_phase(LAS unsigned char* lds, const Sched& S, const Epi& E) {
    const int tid = otid(), wid = __builtin_amdgcn_readfirstlane(tid >> 6), lane = tid & 63, wr = wid >> 2, wc = wid & 3, fr = lane & 15, fq = lane >> 4;
    const int nt = S.K / BK;
    int R0, C0; stage_rc(tid * 16, R0, C0);
    unsigned voffB[2];
#pragma unroll
    for (int i = 0; i < 2; ++i) voffB[i] = (unsigned)(((R0 + 64 * i) * S.ldb + C0) * 2);
    const size_t hstepB = (size_t)HALF * S.ldb * 2;
    const unsigned ldsw = (unsigned)wid * 1024u;
    const int aoff = lds_byte(wr * 64 + fr, fq * 8), boff = lds_byte(wc * 32 + fr, fq * 8);
    const char* Ab = S.Abase;
#define G8_SA(b, h) (((b) * 2 + (h)) * HTB)
#define G8_SB(b, h) ((4 + (b) * 2 + (h)) * HTB)
#define G8_STAGE_A(bufoff, offs, kb) do { _Pragma("unroll") for (int _i = 0; _i < 2; ++_i) \
        __builtin_amdgcn_global_load_lds((const unsigned*)(Ab + (size_t)(offs)[_i] + (size_t)(kb)), (LAS unsigned*)(lds + (bufoff) + ldsw + _i * 8192), 16, 0, 0); } while (0)
#define G8_STAGE_B(bufoff, gbase, kb) do { _Pragma("unroll") for (int _i = 0; _i < 2; ++_i) \
        __builtin_amdgcn_global_load_lds((const unsigned*)((gbase) + voffB[_i] + (size_t)(kb)), (LAS unsigned*)(lds + (bufoff) + ldsw + _i * 8192), 16, 0, 0); } while (0)
#define G8_LDA(dst, b, h) do { _Pragma("unroll") for (int m = 0; m < 4; ++m) _Pragma("unroll") for (int k = 0; k < 2; ++k) dst[m][k] = *(const LAS bf16x8*)(lds + G8_SA(b, h) + aoff + m * 2048 + k * 1024); } while (0)
#define G8_LDB(dst, b, h) do { _Pragma("unroll") for (int n = 0; n < 2; ++n) _Pragma("unroll") for (int k = 0; k < 2; ++k) dst[n][k] = *(const LAS bf16x8*)(lds + G8_SB(b, h) + boff + n * 2048 + k * 1024); } while (0)
#define G8_MMA(ai, bj, At, Bt) do { __builtin_amdgcn_s_setprio(1); _Pragma("unroll") for (int m = 0; m < 4; ++m) _Pragma("unroll") for (int n = 0; n < 2; ++n) _Pragma("unroll") for (int k = 0; k < 2; ++k) \
        acc[ai][bj][m][n] = __builtin_amdgcn_mfma_f32_16x16x32_bf16(Bt[n][k], At[m][k], acc[ai][bj][m][n], 0, 0, 0); __builtin_amdgcn_s_setprio(0); } while (0)
#define G8_WAIT_V(n) asm volatile("s_waitcnt vmcnt(" #n ")" ::: "memory")
#define G8_WAIT_L(n) asm volatile("s_waitcnt lgkmcnt(" #n ")" ::: "memory")
#define G8_BAR __builtin_amdgcn_s_barrier()
#define G8_SCHED __builtin_amdgcn_sched_barrier(0)
    UnitD cur, nxt; int ui = 0;
    if (!S.next(0, cur)) return;
    f32x4 acc[2][2][4][2];
#pragma unroll
    for (int a = 0; a < 2; ++a)
#pragma unroll
        for (int b = 0; b < 2; ++b)
#pragma unroll
            for (int m = 0; m < 4; ++m)
#pragma unroll
                for (int n = 0; n < 2; ++n) acc[a][b][m][n] = (f32x4){0.f, 0.f, 0.f, 0.f};
    bf16x8 At[4][2], B0[2][2], B1[2][2];
    unsigned cA[2][2];
    S.a_offs(cur, R0, C0, cA);
    const char* cB = cur.Bp;
    G8_STAGE_B(G8_SB(0, 0), cB, 0); G8_STAGE_A(G8_SA(0, 0), cA[0], 0); G8_STAGE_B(G8_SB(0, 1), cB + hstepB, 0); G8_STAGE_A(G8_SA(0, 1), cA[1], 0);
    if (wr == 1) G8_BAR;
    G8_WAIT_V(4); G8_BAR;
    G8_STAGE_B(G8_SB(1, 0), cB, 128); G8_STAGE_A(G8_SA(1, 0), cA[0], 128); G8_STAGE_B(G8_SB(1, 1), cB + hstepB, 128);
    G8_WAIT_V(6); G8_BAR;
    for (;;) {
        const bool has_next = S.next(ui + 1, nxt);
        const char* nB = has_next ? nxt.Bp : cB;
        for (int t = 0; t < nt; t += 2) {
            const bool last = (t == nt - 2);
            const unsigned k1 = (unsigned)(t + 1) * 128u;
            const unsigned k2 = last ? 0u : (unsigned)(t + 2) * 128u, k3 = k2 + 128u;
            unsigned c1[2] = {cA[1][0], cA[1][1]};
            if (last && has_next) S.a_offs(nxt, R0, C0, cA);
            const char* b2 = last ? nB : cB;
            G8_LDB(B0, 0, 0); G8_SCHED; G8_LDA(At, 0, 0); G8_STAGE_A(G8_SA(1, 1), c1, k1);
            G8_WAIT_L(8); G8_BAR; G8_WAIT_L(0); G8_MMA(0, 0, At, B0); G8_BAR; G8_SCHED;
            G8_LDB(B1, 0, 1); G8_STAGE_B(G8_SB(0, 0), b2, k2);
            G8_BAR; G8_WAIT_L(0); G8_MMA(0, 1, At, B1); G8_BAR;
            G8_LDA(At, 0, 1); G8_STAGE_A(G8_SA(0, 0), cA[0], k2);
            G8_BAR; G8_WAIT_L(0); G8_MMA(1, 0, At, B0); G8_BAR; G8_SCHED;
            G8_STAGE_B(G8_SB(0, 1), b2 + hstepB, k2);
            G8_WAIT_V(6); G8_BAR; G8_MMA(1, 1, At, B1); G8_BAR;
            G8_LDB(B0, 1, 0); G8_SCHED; G8_LDA(At, 1, 0); G8_STAGE_A(G8_SA(0, 1), cA[1], k2);
            G8_WAIT_L(8); G8_BAR; G8_WAIT_L(0); G8_MMA(0, 0, At, B0); G8_BAR; G8_SCHED;
            G8_LDB(B1, 1, 1); G8_STAGE_B(G8_SB(1, 0), b2, k3);
            G8_BAR; G8_WAIT_L(0); G8_MMA(0, 1, At, B1); G8_BAR;
            G8_LDA(At, 1, 1); G8_STAGE_A(G8_SA(1, 0), cA[0], k3);
            G8_BAR; G8_WAIT_L(0); G8_MMA(1, 0, At, B0); G8_BAR; G8_SCHED;
            G8_STAGE_B(G8_SB(1, 1), b2 + hstepB, k3);
            G8_WAIT_V(6); G8_BAR; G8_MMA(1, 1, At, B1); G8_BAR;
        }
        E(acc, cur, wr, wc, fr, fq);
        if (!has_next) break;
#pragma unroll
        for (int a = 0; a < 2; ++a)
#pragma unroll
            for (int b = 0; b < 2; ++b)
#pragma unroll
                for (int m = 0; m < 4; ++m)
#pragma unroll
                    for (int n = 0; n < 2; ++n) acc[a][b][m][n] = (f32x4){0.f, 0.f, 0.f, 0.f};
        cur = nxt; cB = nB; ++ui;
    }
    G8_WAIT_V(0);
    if (wr == 0) G8_BAR;
    G8_BAR;
#undef G8_SA
#undef G8_SB
#undef G8_STAGE_A
#undef G8_STAGE_B
#undef G8_LDA
#undef G8_LDB
#undef G8_MMA
#undef G8_WAIT_V
#undef G8_WAIT_L
#undef G8_BAR
#undef G8_SCHED
}
}
using g8::UnitD;
typedef f32x4 Acc[2][2][4][2];

struct EpiIn {
    u16* H; const float* rs1; float* SSQ; float* WI;
    DI void operator()(const Acc& acc, const UnitD& u, int wr, int wc, int fr, int fq) const {
        const int pn = u.pn;
#pragma unroll
        for (int ai = 0; ai < 2; ++ai)
#pragma unroll
            for (int m = 0; m < 4; ++m) {
                const int row = u.pm * 256 + ai * 128 + wr * 64 + m * 16 + fr;
                const float rs = rs1[row];
#pragma unroll
                for (int bj = 0; bj < 2; ++bj) {
                    float ssq = 0.f;
#pragma unroll
                    for (int n = 0; n < 2; ++n) {
                        const int col = pn * 256 + bj * 128 + wc * 32 + n * 16 + 4 * fq;
                        f32x4 v = acc[ai][bj][m][n] * rs;
                        if (pn < 4) { v[0] = gelu_tanh(v[0]); v[1] = gelu_tanh(v[1]); v[2] = gelu_tanh(v[2]); v[3] = gelu_tanh(v[3]); }
                        else if (pn >= 6) { v[0] = sigmoidf_(v[0]); v[1] = sigmoidf_(v[1]); v[2] = sigmoidf_(v[2]); v[3] = sigmoidf_(v[3]); }
                        ssq += (v[0] * v[0] + v[1] * v[1]) + (v[2] * v[2] + v[3] * v[3]);
                        u32x2 w; w.x = pk2(v[0], v[1]); w.y = pk2(v[2], v[3]);
                        *(u32x2*)(H + (size_t)row * NIN + col) = w;
                        if (pn == 5 && bj == 1 && wc == 2 && n == 0 && fq == 0) *(f32x4*)(WI + (size_t)row * 4) = v * 0.5f;
                    }
                    if (pn >= 2 && pn <= 5) {
                        ssq += __shfl_xor(ssq, 16); ssq += __shfl_xor(ssq, 32);
                        if (fq == 0) SSQ[(size_t)row * 32 + (pn - 2) * 8 + bj * 4 + wc] = ssq;
                    }
                }
            }
    }
};
struct EpiQ {
    u16* Q; u16* QI; const float* SSQ;
    DI void operator()(const Acc& acc, const UnitD& u, int wr, int wc, int fr, int fq) const {
#pragma unroll
        for (int ai = 0; ai < 2; ++ai)
#pragma unroll
            for (int m = 0; m < 4; ++m) {
                const int row = u.pm * 256 + ai * 128 + wr * 64 + m * 16 + fr;
                const f32x4 s0 = *(const f32x4*)(SSQ + (size_t)row * 32 + 16), s1 = *(const f32x4*)(SSQ + (size_t)row * 32 + 20);
                const float ss = ((s0[0] + s0[1]) + (s0[2] + s0[3])) + ((s1[0] + s1[1]) + (s1[2] + s1[3]));
                const float rs = __builtin_amdgcn_rsqf(ss * (1.0f / 256.0f) + EPS);
#pragma unroll
                for (int bj = 0; bj < 2; ++bj)
#pragma unroll
                    for (int n = 0; n < 2; ++n) {
                        const int col = u.pn * 256 + bj * 128 + wc * 32 + n * 16 + 4 * fq;
                        const f32x4 v = acc[ai][bj][m][n] * rs;
                        u32x2 w; w.x = pk2(v[0], v[1]); w.y = pk2(v[2], v[3]);
                        if (col < 1024) *(u32x2*)(Q + (size_t)row * 1024 + col) = w; else *(u32x2*)(QI + (size_t)row * 256 + (col - 1024)) = w;
                    }
            }
    }
};
template <int SECOND> struct EpiMrg {
    u16* OUT; const u16* TMP; const u16* H;
    DI void operator()(const Acc& acc, const UnitD& u, int wr, int wc, int fr, int fq) const {
#pragma unroll
        for (int ai = 0; ai < 2; ++ai)
#pragma unroll
            for (int m = 0; m < 4; ++m) {
                const int row = u.pm * 256 + ai * 128 + wr * 64 + m * 16 + fr;
#pragma unroll
                for (int bj = 0; bj < 2; ++bj)
#pragma unroll
                    for (int n = 0; n < 2; ++n) {
                        const int col = u.pn * 256 + bj * 128 + wc * 32 + n * 16 + 4 * fq;
                        const u32x2 g = *(const u32x2*)(H + (size_t)row * NIN + 1536 + SECOND * 1024 + col);
                        f32x4 v = acc[ai][bj][m][n];
                        v[0] *= bflo(g.x); v[1] *= bfhi(g.x); v[2] *= bflo(g.y); v[3] *= bfhi(g.y);
                        if (SECOND) { const u32x2 t = *(const u32x2*)(TMP + (size_t)row * 1024 + col); v[0] += bflo(t.x); v[1] += bfhi(t.x); v[2] += bflo(t.y); v[3] += bfhi(t.y); }
                        u32x2 w; w.x = pk2(v[0], v[1]); w.y = pk2(v[2], v[3]);
                        *(u32x2*)(OUT + (size_t)row * 1024 + col) = w;
                    }
            }
    }
};
struct EpiOut {
    float* out; const float* x;
    DI void operator()(const Acc& acc, const UnitD& u, int wr, int wc, int fr, int fq) const {
#pragma unroll
        for (int ai = 0; ai < 2; ++ai)
#pragma unroll
            for (int m = 0; m < 4; ++m) {
                const int row = u.pm * 256 + ai * 128 + wr * 64 + m * 16 + fr;
#pragma unroll
                for (int bj = 0; bj < 2; ++bj)
#pragma unroll
                    for (int n = 0; n < 2; ++n) {
                        const size_t o = (size_t)row * 1024 + u.pn * 256 + bj * 128 + wc * 32 + n * 16 + 4 * fq;
                        *(f32x4*)(out + o) = *(const f32x4*)(x + o) + acc[ai][bj][m][n];
                    }
            }
    }
};

constexpr int MOE_TAB = g8::STAGE_BYTES;
DI void moe_table(LAS unsigned char* lds, const unsigned* CNT) {
    LAS int* tab = (LAS int*)(lds + MOE_TAB);
    __syncthreads();
    if (threadIdx.x == 0) { int acc = 0; for (int e = 0; e < NE; ++e) { const int c = (int)__hip_atomic_load(CNT + e, __ATOMIC_RELAXED, __HIP_MEMORY_SCOPE_AGENT); tab[e] = acc; tab[33 + e] = c; acc += (c + 255) >> 8; } tab[32] = acc; }
    __syncthreads();
}
template <int NPN, bool GATHER> struct MoeSched {
    const char* Abase; const char* Wbase; const int* LTOK; LAS const int* tab; int lda, ldb, K, G, c; size_t wstride;
    DI bool next(int i, UnitD& u) const {
        const long L = (long)i * G + c; const int R = tab[32];
        if (L >= (long)R * NPN) return false;
        const int rbg = (int)(L / NPN), pn = (int)(L % NPN);
        int e = 0;
        for (int j = 1; j < NE; ++j) e += (tab[j] <= rbg) ? 1 : 0;
        e = __builtin_amdgcn_readfirstlane(e);
        u.pm = rbg; u.pn = pn; u.e = e; u.rb = rbg - tab[e];
        u.Bp = Wbase + (size_t)e * wstride + (size_t)pn * 256 * ldb * 2;
        return true;
    }
    DI void a_offs(const UnitD& u, int R0, int C0, unsigned (&o)[2][2]) const {
        const int cnt = tab[33 + u.e];
#pragma unroll
        for (int h = 0; h < 2; ++h)
#pragma unroll
            for (int i = 0; i < 2; ++i) {
                const int r = h * 128 + R0 + 64 * i;
                if (GATHER) { const int slot = u.rb * 256 + r; const int tok = slot < cnt ? LTOK[(size_t)u.e * ECAP + slot] : 0; o[h][i] = (unsigned)(((size_t)tok * lda + C0) * 2); }
                else o[h][i] = (unsigned)(((size_t)(u.pm * 256 + r) * lda + C0) * 2);
            }
    }
};
struct EpiMoe1 {
    u16* ACT; const float* b1;
    DI void operator()(const Acc& acc, const UnitD& u, int wr, int wc, int fr, int fq) const {
        const float* be = b1 + (size_t)u.e * 2048;
#pragma unroll
        for (int n = 0; n < 2; ++n) {
            const int hc = u.pn * 128 + wc * 32 + n * 16 + 4 * fq;
            const f32x4 bg = *(const f32x4*)(be + hc), bu = *(const f32x4*)(be + 1024 + hc);
#pragma unroll
            for (int ai = 0; ai < 2; ++ai)
#pragma unroll
                for (int m = 0; m < 4; ++m) {
                    const int row = u.pm * 256 + ai * 128 + wr * 64 + m * 16 + fr;
                    const f32x4 g = acc[ai][0][m][n] + bg, up = acc[ai][1][m][n] + bu;
                    float a[4];
#pragma unroll
                    for (int j = 0; j < 4; ++j) { const float hg = fminf(g[j], 7.0f), hu = fminf(fmaxf(up[j], -7.0f), 7.0f); a[j] = (hu + 1.0f) * (hg * sigmoidf_(1.702f * hg)); }
                    u32x2 w; w.x = pk2(a[0], a[1]); w.y = pk2(a[2], a[3]);
                    *(u32x2*)(ACT + (size_t)row * 1024 + hc) = w;
                }
        }
    }
};
struct EpiMoe2 {
    u16* YB; const float* b2; const float* LGATE; LAS const int* tab;
    DI void operator()(const Acc& acc, const UnitD& u, int wr, int wc, int fr, int fq) const {
        const float* be = b2 + (size_t)u.e * 1024; const int cnt = tab[33 + u.e];
#pragma unroll
        for (int ai = 0; ai < 2; ++ai)
#pragma unroll
            for (int m = 0; m < 4; ++m) {
                const int r = ai * 128 + wr * 64 + m * 16 + fr, slot = u.rb * 256 + r;
                const float gate = slot < cnt ? LGATE[(size_t)u.e * ECAP + slot] : 0.f;
#pragma unroll
                for (int bj = 0; bj < 2; ++bj)
#pragma unroll
                    for (int n = 0; n < 2; ++n) {
                        const int col = u.pn * 256 + bj * 128 + wc * 32 + n * 16 + 4 * fq;
                        const f32x4 v = (acc[ai][bj][m][n] + *(const f32x4*)(be + col)) * gate;
                        u32x2 w; w.x = pk2(v[0], v[1]); w.y = pk2(v[2], v[3]);
                        *(u32x2*)(YB + (size_t)(u.pm * 256 + r) * 1024 + col) = w;
                    }
            }
    }
};

template <class F> DI void tr_tile(LAS unsigned char* lds, const float* src, int ld_src, int Nsz, int k0, int n0, const float* sk, float mul, u16* dst, int ld_dst, F rowmap) {
    LAS float* t = (LAS float*)lds;
    const int tid = otid();
    __syncthreads();
#pragma unroll
    for (int it = 0; it < 2; ++it) {
        const int k = (tid >> 4) + 32 * it, n = 4 * (tid & 15);
        f32x4 v = {0.f, 0.f, 0.f, 0.f};
        if (n0 + n < Nsz) v = *(const f32x4*)(src + (size_t)(k0 + k) * ld_src + n0 + n);
        const float s = (sk ? sk[k0 + k] : 1.0f) * mul;
        t[k * 65 + n] = v[0] * s; t[k * 65 + n + 1] = v[1] * s; t[k * 65 + n + 2] = v[2] * s; t[k * 65 + n + 3] = v[3] * s;
    }
    __syncthreads();
    const int n = tid >> 3, kc = (tid & 7) * 8;
    if (n0 + n < Nsz) {
        u32x4 w;
        w.x = pk2(t[(kc + 0) * 65 + n], t[(kc + 1) * 65 + n]); w.y = pk2(t[(kc + 2) * 65 + n], t[(kc + 3) * 65 + n]);
        w.z = pk2(t[(kc + 4) * 65 + n], t[(kc + 5) * 65 + n]); w.w = pk2(t[(kc + 6) * 65 + n], t[(kc + 7) * 65 + n]);
        *(u32x4*)(dst + (size_t)rowmap(n0 + n) * ld_dst + k0 + kc) = w;
    }
}
struct MapId { DI int operator()(int n) const { return n; } };
struct MapIn { DI int operator()(int n) const { return n < 1476 ? n : n + 60; } };
struct MapE1 { DI int operator()(int n) const { const int hi = n >= 1024 ? 1 : 0, q = n - hi * 1024; return (q >> 7) * 256 + hi * 128 + (q & 127); } };

DI void phase0(const Args& a, LAS unsigned char* lds) {
    unsigned char* ws = a.ws;
    const int tid = otid();
    const size_t gtid = (size_t)blockIdx.x * NT + tid, gstride = (size_t)gridDim.x * NT;
    for (size_t i = gtid; i < 16384; i += gstride) ((unsigned*)(ws + WS_CTL))[i] = 0u;
    for (size_t i = gtid; i < 60 * 1024 / 2; i += gstride) ((unsigned*)(ws + WS_WIN + (size_t)1476 * 1024 * 2))[i] = 0u;
    for (size_t i = gtid; i < 32 * 1024; i += gstride) { const int e = (int)(i >> 10), k = (int)(i & 1023); ((float*)(ws + WS_WR))[i] = a.in[I_WR][k * 32 + e] * a.in[I_N2G][k]; }
    for (size_t i = gtid; i < 4 * 128 * 128; i += gstride) { const int tt = (int)((i >> 7) & 127), ss = (int)(i & 127); ((u16*)(ws + WS_WSP))[i] = f2bf(ss <= tt ? a.in[I_WSP][i] : 0.f); }
    {
        const int wid = tid >> 6, lane = tid & 63;
        for (int row = blockIdx.x * 8 + wid; row < T; row += gridDim.x * 8) {
            const float* xr = a.in[I_X] + (size_t)row * 1024; u16* xb = (u16*)(ws + WS_XB) + (size_t)row * 1024;
            float ss = 0.f;
#pragma unroll
            for (int i = 0; i < 4; ++i) {
                const f32x4 v = *(const f32x4*)(xr + i * 256 + lane * 4);
                ss += (v[0] * v[0] + v[1] * v[1]) + (v[2] * v[2] + v[3] * v[3]);
                u32x2 w; w.x = pk2(v[0], v[1]); w.y = pk2(v[2], v[3]);
                *(u32x2*)(xb + i * 256 + lane * 4) = w;
            }
#pragma unroll
            for (int o = 32; o >= 1; o >>= 1) ss += __shfl_xor(ss, o);
            if (lane == 0) ((float*)(ws + WS_RS1))[row] = __builtin_amdgcn_rsqf(ss * (1.0f / 1024.0f) + EPS);
        }
    }
    constexpr int U_IN = 16 * 56, U_UQ = 4 * 16, U_QI = 4 * 4, U_PA = 8 * 16, U_OUT = 16 * 16, U_E1 = 32 * 16 * 32, U_E2 = 32 * 16 * 16, U_CB = 64;
    constexpr int U_TOT = U_IN + U_UQ + U_QI + U_PA + U_OUT + U_E1 + U_E2 + U_CB;
    for (int u = blockIdx.x; u < U_TOT; u += gridDim.x) {
        int v = u;
        if (v < U_IN) { tr_tile(lds, a.in[I_WIN], 3524, 3524, (v & 15) * 64, (v >> 4) * 64, a.in[I_N1G], 1.0f, (u16*)(ws + WS_WIN), 1024, MapIn()); continue; }
        v -= U_IN;
        if (v < U_UQ) { tr_tile(lds, a.in[I_WUQ], 1024, 1024, (v & 3) * 64, (v >> 2) * 64, a.in[I_QLG], 1.0f, (u16*)(ws + WS_WQ), 256, MapId()); continue; }
        v -= U_UQ;
        if (v < U_QI) { tr_tile(lds, a.in[I_WQI], 256, 256, (v & 3) * 64, (v >> 2) * 64, a.in[I_QLG], 0.125f, (u16*)(ws + WS_WQ) + 1024 * 256, 256, MapId()); continue; }
        v -= U_QI;
        if (v < U_PA) { tr_tile(lds, a.in[I_WPA], 1024, 1024, (v & 7) * 64, (v >> 3) * 64, nullptr, 1.0f, (u16*)(ws + WS_WCAT), 1536, MapId()); continue; }
        v -= U_PA;
        if (v < U_OUT) { tr_tile(lds, a.in[I_WOUT], 1024, 1024, (v & 15) * 64, (v >> 4) * 64, nullptr, 1.0f, (u16*)(ws + WS_WOUT), 1024, MapId()); continue; }
        v -= U_OUT;
        if (v < U_E1) { const int e = v >> 9, w = v & 511; tr_tile(lds, a.in[I_WE1] + (size_t)e * 1024 * 2048, 2048, 2048, (w & 15) * 64, (w >> 4) * 64, a.in[I_N2G], 1.0f, (u16*)(ws + WS_WE1) + (size_t)e * 2048 * 1024, 1024, MapE1()); continue; }
        v -= U_E1;
        if (v < U_E2) { const int e = v >> 8, w = v & 255; tr_tile(lds, a.in[I_WE2] + (size_t)e * 1024 * 1024, 1024, 1024, (w & 15) * 64, (w >> 4) * 64, nullptr, 1.0f, (u16*)(ws + WS_WE2) + (size_t)e * 1024 * 1024, 1024, MapId()); continue; }
        v -= U_E2;
        {
            const int h = v >> 3, c0 = (v & 7) * 16;
            LAS float* t = (LAS float*)lds;
            __syncthreads();
            for (int i = tid; i < 1024; i += NT) t[i] = a.in[I_WUV][(size_t)h * 128 * 64 + (size_t)c0 * 64 + i];
            __syncthreads();
            for (int nn = tid; nn < 1024; nn += NT) {
                float accv[16];
#pragma unroll
                for (int i = 0; i < 16; ++i) accv[i] = 0.f;
                for (int vv = 0; vv < 64; ++vv) {
                    const float pb = a.in[I_WPB][(size_t)(h * 64 + vv) * 1024 + nn];
#pragma unroll
                    for (int i = 0; i < 16; ++i) accv[i] += t[i * 64 + vv] * pb;
                }
                u32x4 w0, w1;
                w0.x = pk2(accv[0], accv[1]); w0.y = pk2(accv[2], accv[3]); w0.z = pk2(accv[4], accv[5]); w0.w = pk2(accv[6], accv[7]);
                w1.x = pk2(accv[8], accv[9]); w1.y = pk2(accv[10], accv[11]); w1.z = pk2(accv[12], accv[13]); w1.w = pk2(accv[14], accv[15]);
                u16* d = (u16*)(ws + WS_WCAT) + (size_t)nn * 1536 + 512 + h * 128 + c0;
                *(u32x4*)d = w0; *(u32x4*)(d + 8) = w1;
            }
        }
    }
}

DI void gmlp_unit(const Args& a, LAS unsigned char* lds, int u) {
    unsigned char* ws = a.ws;
    const int tid = otid(), wid = tid >> 6, lane = tid & 63, fr = lane & 15, fq = lane >> 4;
    const int g = u & 3, row0 = (u >> 2) * 128;
    const u16* H = (const u16*)(ws + WS_H);
    LAS u16* img = (LAS u16*)lds;
    __syncthreads();
    {
        const int s = tid & 127, cset = tid >> 7;
        const f32x4 sq = *(const f32x4*)((const float*)(ws + WS_SSQ) + (size_t)(row0 + s) * 32 + g * 4);
        const float rs = __builtin_amdgcn_rsqf(((sq[0] + sq[1]) + (sq[2] + sq[3])) * (1.0f / 128.0f) + EPS);
#pragma unroll
        for (int it = 0; it < 4; ++it) {
            const int c = cset + 4 * it;
            const u32x4 raw = *(const u32x4*)(H + (size_t)(row0 + s) * NIN + 512 + g * 128 + 8 * c);
            const float* vg = a.in[I_VG] + 8 * c;
            float f[8] = {bflo(raw.x), bfhi(raw.x), bflo(raw.y), bfhi(raw.y), bflo(raw.z), bfhi(raw.z), bflo(raw.w), bfhi(raw.w)};
#pragma unroll
            for (int i = 0; i < 8; ++i) img[(8 * c + i) * 136 + s] = f2bf(f[i] * rs * vg[i]);
        }
    }
    __syncthreads();
    const u16* W = (const u16*)(ws + WS_WSP) + (size_t)g * 128 * 128 + (size_t)(16 * wid + fr) * 128;
    f32x4 acc[8];
#pragma unroll
    for (int i = 0; i < 8; ++i) acc[i] = (f32x4){0.f, 0.f, 0.f, 0.f};
    const int nks = (16 * wid + 15) / 32 + 1;
    for (int ks = 0; ks < nks; ++ks) {
        const bf16x8 bw = *(const bf16x8*)(W + ks * 32 + 8 * fq);
#pragma unroll
        for (int i = 0; i < 8; ++i) {
            const bf16x8 av = *(const LAS bf16x8*)(img + (16 * i + fr) * 136 + ks * 32 + 8 * fq);
            acc[i] = __builtin_amdgcn_mfma_f32_16x16x32_bf16(av, bw, acc[i], 0, 0, 0);
        }
    }
    const int t = 16 * wid + fr;
    const float bias = a.in[I_BSP][g * 128 + t];
    u16* YO = (u16*)(ws + WS_YO);
#pragma unroll
    for (int i = 0; i < 8; ++i) {
        const int d = 16 * i + 4 * fq;
        const u32x2 uu = *(const u32x2*)(H + (size_t)(row0 + t) * NIN + g * 128 + d);
        const float y0 = bflo(uu.x) * (acc[i][0] + bias), y1 = bfhi(uu.x) * (acc[i][1] + bias), y2 = bflo(uu.y) * (acc[i][2] + bias), y3 = bfhi(uu.y) * (acc[i][3] + bias);
        u32x2 w; w.x = pk2(y0, y1); w.y = pk2(y2, y3);
        *(u32x2*)(YO + (size_t)(row0 + t) * 1536 + g * 128 + d) = w;
    }
}

DI void kvnorm(const Args& a) {
    unsigned char* ws = a.ws;
    const u16* H = (const u16*)(ws + WS_H); const float* SSQ = (const float*)(ws + WS_SSQ);
    const size_t gtid = (size_t)blockIdx.x * NT + otid(), gstride = (size_t)gridDim.x * NT;
    for (size_t idx = gtid; idx < (size_t)T * 24; idx += gstride) {
        const int row = (int)(idx / 24), c = (int)(idx % 24);
        const u16* src; u16* dst; const float* gain; float rs;
        if (c < 16) {
            const f32x4 sq = *(const f32x4*)(SSQ + (size_t)row * 32 + 24);
            rs = __builtin_amdgcn_rsqf(((sq[0] + sq[1]) + (sq[2] + sq[3])) * (1.0f / 128.0f) + EPS);
            src = H + (size_t)row * NIN + 1280 + 8 * c; dst = (u16*)(ws + WS_KVN) + (size_t)row * 128 + 8 * c; gain = a.in[I_KVG] + 8 * c;
        } else {
            const int cc = c - 16;
            rs = __builtin_amdgcn_rsqf((SSQ[(size_t)row * 32 + 28] + SSQ[(size_t)row * 32 + 29]) * (1.0f / 64.0f) + EPS);
            src = H + (size_t)row * NIN + 1408 + 8 * cc; dst = (u16*)(ws + WS_KIN) + (size_t)row * 64 + 8 * cc; gain = a.in[I_KIG] + 8 * cc;
        }
        const u32x4 raw = *(const u32x4*)src;
        u32x4 w;
        w.x = pk2(bflo(raw.x) * rs * gain[0], bfhi(raw.x) * rs * gain[1]); w.y = pk2(bflo(raw.y) * rs * gain[2], bfhi(raw.y) * rs * gain[3]);
        w.z = pk2(bflo(raw.z) * rs * gain[4], bfhi(raw.z) * rs * gain[5]); w.w = pk2(bflo(raw.w) * rs * gain[6], bfhi(raw.w) * rs * gain[7]);
        *(u32x4*)dst = w;
    }
}

constexpr int P3_ROWS = 0, P3_HIST = 131072, P3_LIST = 147456;
DI unsigned f2key(float f) { const unsigned u = __float_as_uint(f); return (u & 0x80000000u) ? ~u : (u | 0x80000000u); }

DI void select_top(LAS const float* row, LAS unsigned* hist, LAS unsigned* list, int N, int lane) {
    unsigned pmask = 0u, pval = 0u; int need = 256;
#pragma unroll 1
    for (int level = 0; level < 3; ++level) {
        const int shift = level == 0 ? 21 : (level == 1 ? 10 : 0);
        const unsigned dmask = level == 2 ? 1023u : 2047u;
#pragma unroll
        for (int i = 0; i < 4; ++i) *(LAS u32x4*)(hist + lane * 16 + i * 4) = (u32x4){0u, 0u, 0u, 0u};
        wave_lds_sync();
        for (int p = lane; p < N; p += 64) {
            const unsigned key = f2key(row[p]);
            if ((key & pmask) == pval) { const unsigned d = (key >> shift) & dmask; __hip_atomic_fetch_add(hist + (d >> 1), 1u << ((d & 1u) * 16u), __ATOMIC_RELAXED, __HIP_MEMORY_SCOPE_WORKGROUP); }
        }
        wave_lds_sync();
        unsigned w[16]; int sl = 0;
#pragma unroll
        for (int i = 0; i < 4; ++i) { const u32x4 v = *(LAS const u32x4*)(hist + lane * 16 + i * 4); w[4 * i] = v.x; w[4 * i + 1] = v.y; w[4 * i + 2] = v.z; w[4 * i + 3] = v.w; }
#pragma unroll
        for (int i = 0; i < 16; ++i) sl += (int)(w[i] & 0xffffu) + (int)(w[i] >> 16);
        int suf = sl;
#pragma unroll
        for (int o = 1; o < 64; o <<= 1) { const int tv = __shfl_down(suf, o); if (lane + o < 64) suf += tv; }
        const unsigned long long bal = __ballot(suf >= need);
        const int L = 63 - __builtin_clzll(bal);
        int cum = suf - sl, dsel = 0, above = 0; bool found = false;
#pragma unroll
        for (int i = 15; i >= 0; --i) {
            const int chi = (int)(w[i] >> 16), clo = (int)(w[i] & 0xffffu);
            if (!found && cum + chi >= need) { found = true; dsel = lane * 32 + 2 * i + 1; above = cum; } cum += found ? 0 : chi;
            if (!found && cum + clo >= need) { found = true; dsel = lane * 32 + 2 * i; above = cum; } cum += found ? 0 : clo;
        }
        const int d = __shfl(dsel, L), ab = __shfl(above, L);
        need -= ab; pval |= ((unsigned)d) << shift; pmask |= dmask << shift;
    }
    int pos = 0, ties = 0;
    const unsigned long long lt = (1ull << lane) - 1ull;
    for (int p0 = 0; p0 < N; p0 += 64) {
        const int p = p0 + lane; const bool valid = p < N;
        const unsigned key = valid ? f2key(row[p]) : 0u;
        const bool gt = valid && key > pval, eq = valid && key == pval;
        const unsigned long long em = __ballot(eq);
        const bool take = gt || (eq && (ties + __builtin_popcountll(em & lt)) < need);
        const unsigned long long tm = __ballot(take);
        if (take) list[pos + __builtin_popcountll(tm & lt)] = (unsigned)p;
        pos += __builtin_popcountll(tm); ties += __builtin_popcountll(em);
    }
}

DI void dsa_phase(const Args& a, LAS unsigned char* lds) {
    unsigned char* ws = a.ws;
    const int tid = otid(), wid = __builtin_amdgcn_readfirstlane(tid >> 6), lane = tid & 63, fr = lane & 15, fq = lane >> 4;
    const u16* QI = (const u16*)(ws + WS_QI); const u16* KIN = (const u16*)(ws + WS_KIN); const u16* KVN = (const u16*)(ws + WS_KVN);
    const u16* Q = (const u16*)(ws + WS_Q); const float* WI = (const float*)(ws + WS_WI); u16* YO = (u16*)(ws + WS_YO);
    LAS float* rows = (LAS float*)(lds + P3_ROWS);
    for (int gi = blockIdx.x; gi < T / 4; gi += gridDim.x) {
        const int b = gi & 3, t0 = S - 4 - 4 * (gi >> 2);
        const size_t brow = (size_t)b * S;
        const int ntile = (t0 + 4 + 15) >> 4;
        __syncthreads();
        {
            bf16x8 qa[2];
#pragma unroll
            for (int ks = 0; ks < 2; ++ks) qa[ks] = *(const bf16x8*)(QI + (brow + t0 + (fr >> 2)) * 256 + (fr & 3) * 64 + ks * 32 + 8 * fq);
            const f32x4 wi = *(const f32x4*)(WI + (brow + t0 + fq) * 4);
            for (int jt = wid; jt < ntile; jt += 8) {
                const u16* kp = KIN + (brow + jt * 16 + fr) * 64 + 8 * fq;
                const bf16x8 k0 = *(const bf16x8*)kp, k1 = *(const bf16x8*)(kp + 32);
                f32x4 d = {0.f, 0.f, 0.f, 0.f};
                d = __builtin_amdgcn_mfma_f32_16x16x32_bf16(qa[0], k0, d, 0, 0, 0);
                d = __builtin_amdgcn_mfma_f32_16x16x32_bf16(qa[1], k1, d, 0, 0, 0);
                const float sc = ((fmaxf(d[0], 0.f) * wi[0] + fmaxf(d[1], 0.f) * wi[1]) + fmaxf(d[2], 0.f) * wi[2]) + fmaxf(d[3], 0.f) * wi[3];
                rows[fq * 8192 + jt * 16 + fr] = sc;
            }
        }
        __syncthreads();
        if (wid < 4) {
            const int q = wid, t = t0 + q, N = t + 1;
            LAS float* row = rows + q * 8192;
            LAS unsigned* hist = (LAS unsigned*)(lds + P3_HIST + q * 4096);
            LAS unsigned* list = (LAS unsigned*)(lds + P3_LIST + q * 1024);
            int cnt;
            if (N <= 256) { for (int p = lane; p < 256; p += 64) list[p] = p < N ? (unsigned)p : 0u; cnt = N; }
            else { select_top(row, hist, list, N, lane); cnt = 256; }
            wave_lds_sync();
            bf16x8 qf[4];
            {
                const int head = fr & 7;
                const u16* qrow = Q + (brow + t) * 1024 + head * 128;
                float f[4][8]; float ss = 0.f;
#pragma unroll
                for (int ks = 0; ks < 4; ++ks) {
                    const u32x4 raw = *(const u32x4*)(qrow + ks * 32 + 8 * fq);
                    f[ks][0] = bflo(raw.x); f[ks][1] = bfhi(raw.x); f[ks][2] = bflo(raw.y); f[ks][3] = bfhi(raw.y); f[ks][4] = bflo(raw.z); f[ks][5] = bfhi(raw.z); f[ks][6] = bflo(raw.w); f[ks][7] = bfhi(raw.w);
#pragma unroll
                    for (int j = 0; j < 8; ++j) ss += f[ks][j] * f[ks][j];
                }
                ss += __shfl_xor(ss, 16); ss += __shfl_xor(ss, 32);
                const float rq = __builtin_amdgcn_rsqf(ss * (1.0f / 128.0f) + EPS) * 0.08838834764831845f;
#pragma unroll
                for (int ks = 0; ks < 4; ++ks) {
                    const float* qg = a.in[I_QNG] + ks * 32 + 8 * fq;
                    u32x4 w;
                    w.x = pk2(f[ks][0] * rq * qg[0], f[ks][1] * rq * qg[1]); w.y = pk2(f[ks][2] * rq * qg[2], f[ks][3] * rq * qg[3]);
                    w.z = pk2(f[ks][4] * rq * qg[4], f[ks][5] * rq * qg[5]); w.w = pk2(f[ks][6] * rq * qg[6], f[ks][7] * rq * qg[7]);
                    qf[ks] = __builtin_bit_cast(bf16x8, w);
                }
            }
            f32x4 sc[16];
#pragma unroll
            for (int jt = 0; jt < 16; ++jt) {
                const unsigned key = list[jt * 16 + fr];
                const u16* kv = KVN + (brow + key) * 128 + 8 * fq;
                f32x4 d = {0.f, 0.f, 0.f, 0.f};
#pragma unroll
                for (int ks = 0; ks < 4; ++ks) { const bf16x8 av = *(const bf16x8*)(kv + ks * 32); d = __builtin_amdgcn_mfma_f32_16x16x32_bf16(av, qf[ks], d, 0, 0, 0); }
                sc[jt] = d;
            }
            float mx = -3.0e38f;
#pragma unroll
            for (int jt = 0; jt < 16; ++jt)
#pragma unroll
                for (int r = 0; r < 4; ++r) { if (jt * 16 + 4 * fq + r >= cnt) sc[jt][r] = -3.0e38f; mx = fmaxf(mx, sc[jt][r]); }
            mx = fmaxf(mx, __shfl_xor(mx, 16)); mx = fmaxf(mx, __shfl_xor(mx, 32));
            float lsum = 0.f;
#pragma unroll
            for (int jt = 0; jt < 16; ++jt)
#pragma unroll
                for (int r = 0; r < 4; ++r) { const float p = __expf(sc[jt][r] - mx); sc[jt][r] = p; lsum += p; }
            lsum += __shfl_xor(lsum, 16); lsum += __shfl_xor(lsum, 32);
            LAS unsigned char* img = (LAS unsigned char*)row;
            f32x4 oacc[8];
#pragma unroll
            for (int i = 0; i < 8; ++i) oacc[i] = (f32x4){0.f, 0.f, 0.f, 0.f};
#pragma unroll
            for (int pp = 0; pp < 8; ++pp) {
#pragma unroll
                for (int it = 0; it < 8; ++it) {
                    const int piece = it * 64 + lane, slot = piece >> 4, ch = piece & 15;
                    const unsigned key = list[pp * 32 + slot];
                    const u32x4 v = *(const u32x4*)(KVN + (brow + key) * 128 + 8 * ch);
                    *(LAS u32x4*)(img + slot * 288 + ch * 16) = v;
                }
                wave_lds_sync();
                u32x4 pw; pw.x = pk2(sc[2 * pp][0], sc[2 * pp][1]); pw.y = pk2(sc[2 * pp][2], sc[2 * pp][3]); pw.z = pk2(sc[2 * pp + 1][0], sc[2 * pp + 1][1]); pw.w = pk2(sc[2 * pp + 1][2], sc[2 * pp + 1][3]);
                const bf16x8 pb = __builtin_bit_cast(bf16x8, pw);
#pragma unroll
                for (int cb = 0; cb < 8; ++cb) {
                    const s16x4 r0 = __builtin_amdgcn_ds_read_tr16_b64_v4i16((LAS s16x4*)(img + (4 * fq + (fr >> 2)) * 288 + (cb * 16 + 4 * (fr & 3)) * 2));
                    const s16x4 r1 = __builtin_amdgcn_ds_read_tr16_b64_v4i16((LAS s16x4*)(img + (16 + 4 * fq + (fr >> 2)) * 288 + (cb * 16 + 4 * (fr & 3)) * 2));
                    const bf16x8 av = {r0[0], r0[1], r0[2], r0[3], r1[0], r1[1], r1[2], r1[3]};
                    oacc[cb] = __builtin_amdgcn_mfma_f32_16x16x32_bf16(av, pb, oacc[cb], 0, 0, 0);
                }
                wave_lds_sync();
            }
            const float inv = __builtin_amdgcn_rcpf(lsum);
            if (fr < 8) {
                u16* orow = YO + (brow + t) * 1536 + 512 + fr * 128 + 4 * fq;
#pragma unroll
                for (int cb = 0; cb < 8; ++cb) { u32x2 w; w.x = pk2(oacc[cb][0] * inv, oacc[cb][1] * inv); w.y = pk2(oacc[cb][2] * inv, oacc[cb][3] * inv); *(u32x2*)(orow + cb * 16) = w; }
            }
        }
    }
}

constexpr int P6_WT = 0, P6_LCNT = 131072, P6_BASE = 131072 + 128, P6_RI = 131072 + 256;
DI void router_phase(const Args& a, LAS unsigned char* lds) {
    unsigned char* ws = a.ws;
    const int tid = otid(), wid = tid >> 6, lane = tid & 63;
    LAS float* WT = (LAS float*)(lds + P6_WT); LAS int* lcnt = (LAS int*)(lds + P6_LCNT); LAS int* lbase = (LAS int*)(lds + P6_BASE); LAS int* RI = (LAS int*)(lds + P6_RI);
    const float* WR = (const float*)(ws + WS_WR);
    unsigned* CNT = (unsigned*)(ws + WS_CTL);
    __syncthreads();
    for (int i = tid; i < 32 * 1024 / 4; i += NT) *(LAS f32x4*)(WT + 4 * i) = *(const f32x4*)(WR + 4 * i);
    for (int rg = blockIdx.x; rg < T / 128; rg += gridDim.x) {
        if (tid < 32) lcnt[tid] = 0;
        __syncthreads();
        for (int it = 0; it < 16; ++it) {
            const int rl = wid + 8 * it, row = rg * 128 + rl;
            const float* xr = a.out + (size_t)row * 1024;
            f32x4 xv[4]; float ss = 0.f;
#pragma unroll
            for (int i = 0; i < 4; ++i) { xv[i] = *(const f32x4*)(xr + i * 256 + lane * 4); ss += (xv[i][0] * xv[i][0] + xv[i][1] * xv[i][1]) + (xv[i][2] * xv[i][2] + xv[i][3] * xv[i][3]); }
#pragma unroll
            for (int o = 32; o >= 1; o >>= 1) ss += __shfl_xor(ss, o);
            const float rs = __builtin_amdgcn_rsqf(ss * (1.0f / 1024.0f) + EPS);
            u16* xn = (u16*)(ws + WS_XN2) + (size_t)row * 1024;
#pragma unroll
            for (int i = 0; i < 4; ++i) { u32x2 w; w.x = pk2(xv[i][0] * rs, xv[i][1] * rs); w.y = pk2(xv[i][2] * rs, xv[i][3] * rs); *(u32x2*)(xn + i * 256 + lane * 4) = w; }
            float acc[32];
#pragma unroll
            for (int e = 0; e < 32; ++e) {
                float s = 0.f;
#pragma unroll
                for (int i = 0; i < 4; ++i) { const f32x4 w = *(LAS const f32x4*)(WT + e * 1024 + i * 256 + lane * 4); s += (xv[i][0] * w[0] + xv[i][1] * w[1]) + (xv[i][2] * w[2] + xv[i][3] * w[3]); }
                acc[e] = s;
            }
            float v16[16], v8[8], v4[4], v2[2], v1;
            { const bool hi = (lane & 32) != 0;
#pragma unroll
              for (int e = 0; e < 16; ++e) { const float keep = hi ? acc[e + 16] : acc[e], send = hi ? acc[e] : acc[e + 16]; v16[e] = keep + __shfl_xor(send, 32); } }
            { const bool hi = (lane & 16) != 0;
#pragma unroll
              for (int e = 0; e < 8; ++e) { const float keep = hi ? v16[e + 8] : v16[e], send = hi ? v16[e] : v16[e + 8]; v8[e] = keep + __shfl_xor(send, 16); } }
            { const bool hi = (lane & 8) != 0;
#pragma unroll
              for (int e = 0; e < 4; ++e) { const float keep = hi ? v8[e + 4] : v8[e], send = hi ? v8[e] : v8[e + 4]; v4[e] = keep + __shfl_xor(send, 8); } }
            { const bool hi = (lane & 4) != 0;
#pragma unroll
              for (int e = 0; e < 2; ++e) { const float keep = hi ? v4[e + 2] : v4[e], send = hi ? v4[e] : v4[e + 2]; v2[e] = keep + __shfl_xor(send, 4); } }
            { const bool hi = (lane & 2) != 0; const float keep = hi ? v2[1] : v2[0], send = hi ? v2[0] : v2[1]; v1 = keep + __shfl_xor(send, 2); }
            v1 += __shfl_xor(v1, 1);
            const int myexp = lane >> 1;
            float logit = v1 * rs + a.in[I_BR][myexp];
            float tv[4]; int ti[4];
#pragma unroll
            for (int k = 0; k < 4; ++k) {
                float bv = logit; int bi = myexp;
#pragma unroll
                for (int o = 32; o >= 1; o >>= 1) { const float ov = __shfl_xor(bv, o); const int oi = __shfl_xor(bi, o); if (ov > bv || (ov == bv && oi < bi)) { bv = ov; bi = oi; } }
                tv[k] = bv; ti[k] = bi;
                if (myexp == bi) logit = -3.0e38f;
            }
            const float e1 = __expf(tv[1] - tv[0]), e2 = __expf(tv[2] - tv[0]), e3 = __expf(tv[3] - tv[0]);
            const float inv = 1.0f / (1.0f + e1 + e2 + e3);
            if (lane < 4) {
                const int e = lane == 0 ? ti[0] : (lane == 1 ? ti[1] : (lane == 2 ? ti[2] : ti[3]));
                const float gt = (lane == 0 ? 1.0f : (lane == 1 ? e1 : (lane == 2 ? e2 : e3))) * inv;
                const int ls = __hip_atomic_fetch_add(lcnt + e, 1, __ATOMIC_RELAXED, __HIP_MEMORY_SCOPE_WORKGROUP);
                RI[(rl * 4 + lane) * 3 + 0] = e; RI[(rl * 4 + lane) * 3 + 1] = ls; RI[(rl * 4 + lane) * 3 + 2] = __float_as_int(gt);
            }
        }
        __syncthreads();
        if (tid < 32) lbase[tid] = (int)__hip_atomic_fetch_add(CNT + tid, (unsigned)lcnt[tid], __ATOMIC_RELAXED, __HIP_MEMORY_SCOPE_AGENT);
        __syncthreads();
        {
            const int rl = tid >> 2, k = tid & 3, row = rg * 128 + rl;
            const int e = RI[tid * 3 + 0], slot = lbase[e] + RI[tid * 3 + 1]; const float gt = __int_as_float(RI[tid * 3 + 2]);
            ((int*)(ws + WS_LTOK))[(size_t)e * ECAP + slot] = row;
            ((float*)(ws + WS_LGATE))[(size_t)e * ECAP + slot] = gt;
            ((unsigned*)(ws + WS_ROUTE))[(size_t)row * 4 + k] = ((unsigned)e << 16) | (unsigned)slot;
        }
        __syncthreads();
    }
}

DI void combine_phase(const Args& a, LAS unsigned char* lds) {
    unsigned char* ws = a.ws;
    LAS const int* tab = (LAS const int*)(lds + MOE_TAB);
    const int tid = otid(), wid = tid >> 6, lane = tid & 63;
    const u16* YB = (const u16*)(ws + WS_YB); const unsigned* ROUTE = (const unsigned*)(ws + WS_ROUTE);
    for (int row = blockIdx.x * 8 + wid; row < T; row += gridDim.x * 8) {
        size_t pos[4];
#pragma unroll
        for (int k = 0; k < 4; ++k) { const unsigned r = ROUTE[(size_t)row * 4 + k]; const int e = (int)(r >> 16), slot = (int)(r & 0xffffu); pos[k] = (size_t)tab[e] * 256 + slot; }
        float* orow = a.out + (size_t)row * 1024;
#pragma unroll
        for (int i = 0; i < 4; ++i) {
            f32x4 v = *(const f32x4*)(orow + i * 256 + lane * 4);
#pragma unroll
            for (int k = 0; k < 4; ++k) { const u32x2 y = *(const u32x2*)(YB + pos[k] * 1024 + i * 256 + lane * 4); v[0] += bflo(y.x); v[1] += bfhi(y.x); v[2] += bflo(y.y); v[3] += bfhi(y.y); }
            *(f32x4*)(orow + i * 256 + lane * 4) = v;
        }
    }
}

__global__ void __launch_bounds__(NT, 2) fwd(Args a) {
    extern __shared__ __attribute__((aligned(16))) unsigned char lds_raw[];
    LAS unsigned char* lds = (LAS unsigned char*)lds_raw;
    cg::grid_group grid = cg::this_grid();
    unsigned char* ws = a.ws;
    const int G = gridDim.x, c = blockIdx.x;

    phase0(a, lds);
    grid.sync();
    {
        g8::PlainSched s; s.Abase = (const char*)(ws + WS_XB); s.Bbase = (const char*)(ws + WS_WIN); s.lda = 1024; s.ldb = 1024; s.K = 1024; s.nM = T / 256; s.nN = NIN / 256; s.G = G; s.c = c;
        EpiIn e; e.H = (u16*)(ws + WS_H); e.rs1 = (const float*)(ws + WS_RS1); e.SSQ = (float*)(ws + WS_SSQ); e.WI = (float*)(ws + WS_WI);
        g8::gemm_phase(lds, s, e);
    }
    grid.sync();
    {
        g8::PlainSched s; s.Abase = (const char*)(ws + WS_H) + 1024 * 2; s.Bbase = (const char*)(ws + WS_WQ); s.lda = NIN; s.ldb = 256; s.K = 256; s.nM = T / 256; s.nN = 5; s.G = G; s.c = c;
        EpiQ e; e.Q = (u16*)(ws + WS_Q); e.QI = (u16*)(ws + WS_QI); e.SSQ = (const float*)(ws + WS_SSQ);
        g8::gemm_phase(lds, s, e);
        for (int u = c; u < 1024; u += G) gmlp_unit(a, lds, u);
        kvnorm(a);
    }
    grid.sync();
    dsa_phase(a, lds);
    grid.sync();
    {
        g8::PlainSched s; s.Abase = (const char*)(ws + WS_YO); s.Bbase = (const char*)(ws + WS_WCAT); s.lda = 1536; s.ldb = 1536; s.K = 512; s.nM = T / 256; s.nN = 4; s.G = G; s.c = c;
        EpiMrg<0> e0; e0.OUT = (u16*)(ws + WS_TMP); e0.TMP = nullptr; e0.H = (const u16*)(ws + WS_H);
        g8::gemm_phase(lds, s, e0);
        s.Abase = (const char*)(ws + WS_YO) + 512 * 2; s.Bbase = (const char*)(ws + WS_WCAT) + 512 * 2; s.K = 1024;
        EpiMrg<1> e1; e1.OUT = (u16*)(ws + WS_MRG); e1.TMP = (const u16*)(ws + WS_TMP); e1.H = (const u16*)(ws + WS_H);
        g8::gemm_phase(lds, s, e1);
    }
    grid.sync();
    {
        g8::PlainSched s; s.Abase = (const char*)(ws + WS_MRG); s.Bbase = (const char*)(ws + WS_WOUT); s.lda = 1024; s.ldb = 1024; s.K = 1024; s.nM = T / 256; s.nN = 4; s.G = G; s.c = c;
        EpiOut e; e.out = a.out; e.x = a.in[I_X];
        g8::gemm_phase(lds, s, e);
    }
    grid.sync();
    router_phase(a, lds);
    grid.sync();
    moe_table(lds, (const unsigned*)(ws + WS_CTL));
    {
        MoeSched<8, true> s; s.Abase = (const char*)(ws + WS_XN2); s.Wbase = (const char*)(ws + WS_WE1); s.LTOK = (const int*)(ws + WS_LTOK); s.tab = (LAS const int*)(lds + MOE_TAB);
        s.lda = 1024; s.ldb = 1024; s.K = 1024; s.G = G; s.c = c; s.wstride = (size_t)2048 * 1024 * 2;
        EpiMoe1 e; e.ACT = (u16*)(ws + WS_ACT); e.b1 = a.in[I_BE1];
        g8::gemm_phase(lds, s, e);
    }
    grid.sync();
    {
        MoeSched<4, false> s; s.Abase = (const char*)(ws + WS_ACT); s.Wbase = (const char*)(ws + WS_WE2); s.LTOK = nullptr; s.tab = (LAS const int*)(lds + MOE_TAB);
        s.lda = 1024; s.ldb = 1024; s.K = 1024; s.G = G; s.c = c; s.wstride = (size_t)1024 * 1024 * 2;
        EpiMoe2 e; e.YB = (u16*)(ws + WS_YB); e.b2 = a.in[I_BE2]; e.LGATE = (const float*)(ws + WS_LGATE); e.tab = (LAS const int*)(lds + MOE_TAB);
        g8::gemm_phase(lds, s, e);
    }
    grid.sync();
    combine_phase(a, lds);
}

extern "C" void kernel_launch(void* const* d_in, const int* in_sizes, int n_in, void* d_out, int out_size, void* d_ws, size_t ws_size, hipStream_t stream) {
    static int grid = 0;
    if (grid == 0) {
        int dev = 0, cus = 0, per_cu = 0;
        if (n_in != 23 || out_size != T * Dm || ws_size < WS_END) { fprintf(stderr, "kernel_launch: unexpected problem (n_in %d, out %d, ws %zu < %zu)\n", n_in, out_size, ws_size, (size_t)WS_END); grid = -1; return; }
        if (hipGetDevice(&dev) != hipSuccess || hipDeviceGetAttribute(&cus, hipDeviceAttributeMultiprocessorCount, dev) != hipSuccess) { grid = -1; return; }
        if (hipFuncSetAttribute((const void*)fwd, hipFuncAttributeMaxDynamicSharedMemorySize, LDS_BYTES) != hipSuccess) { fprintf(stderr, "hipFuncSetAttribute failed\n"); grid = -1; return; }
        if (hipOccupancyMaxActiveBlocksPerMultiprocessor(&per_cu, (const void*)fwd, NT, LDS_BYTES) != hipSuccess || per_cu < 1) { fprintf(stderr, "occupancy query failed (%d)\n", per_cu); grid = -1; return; }
        grid = cus;
        fprintf(stderr, "kernel_launch: cus %d per_cu %d grid %d ws %zu need %zu\n", cus, per_cu, grid, ws_size, (size_t)WS_END);
    }
    if (grid < 0) return;
    Args a{};
    for (int i = 0; i < 23; ++i) a.in[i] = (const float*)d_in[i];
    a.out = (float*)d_out; a.ws = (unsigned char*)d_ws; a.mask = 0xffffffffu; a.pad = 0u;
    void* args[] = {&a};
    hipError_t e = hipLaunchCooperativeKernel((const void*)fwd, dim3(grid), dim3(NT), args, LDS_BYTES, stream);
    if (e != hipSuccess) fprintf(stderr, "cooperative launch failed: %s (grid %d)\n", hipGetErrorString(e), grid);
}
```

```cpp
#include <hip/hip_runtime.h>
#include <hip/hip_cooperative_groups.h>
#include <cstdio>
#include <cstdint>
namespace cg = cooperative_groups;

#define LAS __attribute__((address_space(3)))
#define DI __device__ __forceinline__
typedef unsigned short u16;
typedef short bf16x8 __attribute__((ext_vector_type(8)));
typedef short s16x4 __attribute__((ext_vector_type(4)));
typedef float f32x4 __attribute__((ext_vector_type(4)));
typedef float f32x2 __attribute__((ext_vector_type(2)));
typedef unsigned u32x4 __attribute__((ext_vector_type(4)));
typedef unsigned u32x2 __attribute__((ext_vector_type(2)));
typedef __bf16 bf2_t __attribute__((ext_vector_type(2)));

constexpr int NT = 512;
constexpr int LDS_BYTES = 155648;
constexpr int Dm = 1024, Bsz = 4, S = 8192, T = Bsz * S;
constexpr int NIN = 3584;
constexpr int NE = 32, ECAP = 32768, PPAD = 131072 + NE * 256;
constexpr float EPS = 1e-6f;

constexpr size_t MiB = 1024 * 1024;
constexpr size_t WS_CTL = 0;
constexpr size_t WS_WIN = 64 * 1024;
constexpr size_t WS_WQ = WS_WIN + (size_t)NIN * 1024 * 2;
constexpr size_t WS_WSP = WS_WQ + 1280 * 256 * 2;
constexpr size_t WS_WCAT = WS_WSP + 4 * 128 * 128 * 2;
constexpr size_t WS_WOUT = WS_WCAT + 1024 * 1536 * 2;
constexpr size_t WS_WR = WS_WOUT + 1024 * 1024 * 2;
constexpr size_t WS_WE1 = WS_WR + 32 * 1024 * 4;
constexpr size_t WS_WE2 = WS_WE1 + (size_t)32 * 2048 * 1024 * 2;
constexpr size_t WS_RS1 = WS_WE2 + (size_t)32 * 1024 * 1024 * 2;
constexpr size_t WS_SSQ = WS_RS1 + (size_t)T * 4;
constexpr size_t WS_WI = WS_SSQ + (size_t)T * 32 * 4;
constexpr size_t WS_ROUTE = WS_WI + (size_t)T * 4 * 4;
constexpr size_t WS_LTOK = WS_ROUTE + (size_t)T * 4 * 4;
constexpr size_t WS_LGATE = WS_LTOK + (size_t)NE * ECAP * 4;
constexpr size_t WS_XN2 = WS_LGATE + (size_t)NE * ECAP * 4;
constexpr size_t WS_R0 = WS_XN2 + (size_t)T * 1024 * 2;
constexpr size_t WS_XB = WS_R0;
constexpr size_t WS_H = WS_XB + (size_t)T * 1024 * 2;
constexpr size_t WS_Q = WS_H + (size_t)T * NIN * 2;
constexpr size_t WS_QI = WS_Q + (size_t)T * 1024 * 2;
constexpr size_t WS_KVN = WS_QI + (size_t)T * 256 * 2;
constexpr size_t WS_KIN = WS_KVN + (size_t)T * 128 * 2;
constexpr size_t WS_YO = WS_KIN + (size_t)T * 64 * 2;
constexpr size_t WS_TMP = WS_YO + (size_t)T * 1536 * 2;
constexpr size_t WS_MRG = WS_TMP + (size_t)T * 1024 * 2;
constexpr size_t WS_R0END = WS_MRG + (size_t)T * 1024 * 2;
constexpr size_t WS_ACT = WS_XB;
constexpr size_t WS_YB = WS_Q;
static_assert(WS_ACT + (size_t)PPAD * 1024 * 2 <= WS_Q, "ACT overlaps YB");
static_assert(WS_YB + (size_t)PPAD * 1024 * 2 <= WS_R0END, "YB too large");
constexpr size_t WS_END = WS_R0END;

struct Args { const float* in[23]; float* out; unsigned char* ws; unsigned mask; unsigned pad; };
enum { I_X = 0, I_N1G, I_WIN, I_QLG, I_WUQ, I_QNG, I_KVG, I_WUV, I_WQI, I_KIG, I_VG, I_WSP, I_BSP, I_WPA, I_WPB, I_WOUT, I_N2G, I_WR, I_BR, I_WE1, I_BE1, I_WE2, I_BE2 };

DI unsigned pk2(float a, float b) { f32x2 v = {a, b}; bf2_t r = __builtin_convertvector(v, bf2_t); return __builtin_bit_cast(unsigned, r); }
DI float bflo(unsigned u) { return __uint_as_float(u << 16); }
DI float bfhi(unsigned u) { return __uint_as_float(u & 0xffff0000u); }
DI u16 f2bf(float f) { return (u16)(pk2(f, 0.f) & 0xffffu); }
DI float bf2f(u16 h) { return __uint_as_float(((unsigned)h) << 16); }
DI float sigmoidf_(float x) { return __builtin_amdgcn_rcpf(1.0f + __expf(-x)); }
DI float gelu_tanh(float x) { const float u = 1.5957691216057308f * (x + 0.044715f * x * x * x); return x * sigmoidf_(u); }
DI int otid() { int t = threadIdx.x; asm volatile("" : "+v"(t)); return t; }
DI void wave_lds_sync() { asm volatile("s_waitcnt lgkmcnt(0)" ::: "memory"); }

namespace g8 {
constexpr int BM = 256, BK = 64, HALF = 128, HTB = HALF * BK * 2, STAGE_BYTES = 8 * HTB, NXCD = 8, WGM = 8;
DI int lds_byte(int r, int c) { const int st = (r >> 4) * 2 + (c >> 5), rr = r & 15, cc = c & 31, ob = rr * 64 + cc * 2; return st * 1024 + (ob ^ (((ob >> 9) & 1) << 5)); }
DI void stage_rc(int b, int& R, int& C) { const int st = b / 1024, sb = b % 1024, swz = sb ^ (((sb >> 9) & 1) << 5); R = (st >> 1) * 16 + swz / 64; C = (st & 1) * 32 + (swz % 64) / 2; }

struct UnitD { const char* Bp; int pm, pn, e, rb; };

DI bool static_tile(int i, int G, int c, int nM, int nN, int& pm, int& pn) {
    const int nwg = nM * nN; const long L = (long)i * G + c; if (L >= nwg) return false;
    int wgid = (int)L; { const int q = nwg / NXCD, r = nwg % NXCD, xcd = wgid % NXCD, off = wgid / NXCD; wgid = (xcd < r ? xcd * (q + 1) : r * (q + 1) + (xcd - r) * q) + off; }
    const int nig = WGM * nN, gid = wgid / nig, fm = gid * WGM, gsz = (nM - fm) < WGM ? (nM - fm) : WGM;
    pm = fm + ((wgid % nig) % gsz); pn = (wgid % nig) / gsz; return true;
}

struct PlainSched {
    const char* Abase; const char* Bbase; int lda, ldb, K, nM, nN, G, c;
    DI bool next(int i, UnitD& u) const { int pm, pn; if (!static_tile(i, G, c, nM, nN, pm, pn)) return false; u.pm = pm; u.pn = pn; u.e = 0; u.rb = 0; u.Bp = Bbase + (size_t)pn * BM * ldb * 2; return true; }
    DI void a_offs(const UnitD& u, int R0, int C0, unsigned (&o)[2][2]) const {
#pragma unroll
        for (int h = 0; h < 2; ++h)
#pragma unroll
            for (int i = 0; i < 2; ++i) o[h][i] = (unsigned)(((size_t)(u.pm * BM + h * HALF + R0 + 64 * i) * lda + C0) * 2);
    }
};

template <class Epi, class Sched>
DI void gemm_phase(LAS unsigned char* lds, const Sched& S, const Epi& E) {
    const int tid = otid(), wid = __builtin_amdgcn_readfirstlane(tid >> 6), lane = tid & 63, wr = wid >> 2, wc = wid & 3, fr = lane & 15, fq = lane >> 4;
    const int nt = S.K / BK;
    int R0, C0; stage_rc(tid * 16, R0, C0);
    unsigned voffB[2];
#pragma unroll
    for (int i = 0; i < 2; ++i) voffB[i] = (unsigned)(((R0 + 64 * i) * S.ldb + C0) * 2);
    const size_t hstepB = (size_t)HALF * S.ldb * 2;
    const unsigned ldsw = (unsigned)wid * 1024u;
    const int aoff = lds_byte(wr * 64 + fr, fq * 8), boff = lds_byte(wc * 32 + fr, fq * 8);
    const char* Ab = S.Abase;
#define G8_SA(b, h) (((b) * 2 + (h)) * HTB)
#define G8_SB(b, h) ((4 + (b) * 2 + (h)) * HTB)
#define G8_STAGE_A(bufoff, offs, kb) do { _Pragma("unroll") for (int _i = 0; _i < 2; ++_i) \
        __builtin_amdgcn_global_load_lds((const unsigned*)(Ab + (size_t)(offs)[_i] + (size_t)(kb)), (LAS unsigned*)(lds + (bufoff) + ldsw + _i * 8192), 16, 0, 0); } while (0)
#define G8_STAGE_B(bufoff, gbase, kb) do { _Pragma("unroll") for (int _i = 0; _i < 2; ++_i) \
        __builtin_amdgcn_global_load_lds((const unsigned*)((gbase) + voffB[_i] + (size_t)(kb)), (LAS unsigned*)(lds + (bufoff) + ldsw + _i * 8192), 16, 0, 0); } while (0)
#define G8_LDA(dst, b, h) do { _Pragma("unroll") for (int m = 0; m < 4; ++m) _Pragma("unroll") for (int k = 0; k < 2; ++k) dst[m][k] = *(const LAS bf16x8*)(lds + G8_SA(b, h) + aoff + m * 2048 + k * 1024); } while (0)
#define G8_LDB(dst, b, h) do { _Pragma("unroll") for (int n = 0; n < 2; ++n) _Pragma("unroll") for (int k = 0; k < 2; ++k) dst[n][k] = *(const LAS bf16x8*)(lds + G8_SB(b, h) + boff + n * 2048 + k * 1024); } while (0)
#define G8_MMA(ai, bj, At, Bt) do { __builtin_amdgcn_s_setprio(1); _Pragma("unroll") for (int m = 0; m < 4; ++m) _Pragma("unroll") for (int n = 0; n < 2; ++n) _Pragma("unroll") for (int k = 0; k < 2; ++k) \
        acc[ai][bj][m][n] = __builtin_amdgcn_mfma_f32_16x16x32_bf16(Bt[n][k], At[m][k], acc[ai][bj][m][n], 0, 0, 0); __builtin_amdgcn_s_setprio(0); } while (0)
#define G8_WAIT_V(n) asm volatile("s_waitcnt vmcnt(" #n ")" ::: "memory")
#define G8_WAIT_L(n) asm volatile("s_waitcnt lgkmcnt(" #n ")" ::: "memory")
#define G8_BAR __builtin_amdgcn_s_barrier()
#define G8_SCHED __builtin_amdgcn_sched_barrier(0)
    UnitD cur, nxt; int ui = 0;
    if (!S.next(0, cur)) return;
    f32x4 acc[2][2][4][2];
#pragma unroll
    for (int a = 0; a < 2; ++a)
#pragma unroll
        for (int b = 0; b < 2; ++b)
#pragma unroll
            for (int m = 0; m < 4; ++m)
#pragma unroll
                for (int n = 0; n < 2; ++n) acc[a][b][m][n] = (f32x4){0.f, 0.f, 0.f, 0.f};
    bf16x8 At[4][2], B0[2][2], B1[2][2];
    unsigned cA[2][2];
    S.a_offs(cur, R0, C0, cA);
    const char* cB = cur.Bp;
    G8_STAGE_B(G8_SB(0, 0), cB, 0); G8_STAGE_A(G8_SA(0, 0), cA[0], 0); G8_STAGE_B(G8_SB(0, 1), cB + hstepB, 0); G8_STAGE_A(G8_SA(0, 1), cA[1], 0);
    if (wr == 1) G8_BAR;
    G8_WAIT_V(4); G8_BAR;
    G8_STAGE_B(G8_SB(1, 0), cB, 128); G8_STAGE_A(G8_SA(1, 0), cA[0], 128); G8_STAGE_B(G8_SB(1, 1), cB + hstepB, 128);
    G8_WAIT_V(6); G8_BAR;
    for (;;) {
        const bool has_next = S.next(ui + 1, nxt);
        const char* nB = has_next ? nxt.Bp : cB;
        for (int t = 0; t < nt; t += 2) {
            const bool last = (t == nt - 2);
            const unsigned k1 = (unsigned)(t + 1) * 128u;
            const unsigned k2 = last ? 0u : (unsigned)(t + 2) * 128u, k3 = k2 + 128u;
            unsigned c1[2] = {cA[1][0], cA[1][1]};
            if (last && has_next) S.a_offs(nxt, R0, C0, cA);
            const char* b2 = last ? nB : cB;
            G8_LDB(B0, 0, 0); G8_SCHED; G8_LDA(At, 0, 0); G8_STAGE_A(G8_SA(1, 1), c1, k1);
            G8_WAIT_L(8); G8_BAR; G8_WAIT_L(0); G8_MMA(0, 0, At, B0); G8_BAR; G8_SCHED;
            G8_LDB(B1, 0, 1); G8_STAGE_B(G8_SB(0, 0), b2, k2);
            G8_BAR; G8_WAIT_L(0); G8_MMA(0, 1, At, B1); G8_BAR;
            G8_LDA(At, 0, 1); G8_STAGE_A(G8_SA(0, 0), cA[0], k2);
            G8_BAR; G8_WAIT_L(0); G8_MMA(1, 0, At, B0); G8_BAR; G8_SCHED;
            G8_STAGE_B(G8_SB(0, 1), b2 + hstepB, k2);
            G8_WAIT_V(6); G8_BAR; G8_MMA(1, 1, At, B1); G8_BAR;
            G8_LDB(B0, 1, 0); G8_SCHED; G8_LDA(At, 1, 0); G8_STAGE_A(G8_SA(0, 1), cA[1], k2);
            G8_WAIT_L(8); G8_BAR; G8_WAIT_L(0); G8_MMA(0, 0, At, B0); G8_BAR; G8_SCHED;
            G8_LDB(B1, 1, 1); G8_STAGE_B(G8_SB(1, 0), b2, k3);
            G8_BAR; G8_WAIT_L(0); G8_MMA(0, 1, At, B1); G8_BAR;
            G8_LDA(At, 1, 1); G8_STAGE_A(G8_SA(1, 0), cA[0], k3);
            G8_BAR; G8_WAIT_L(0); G8_MMA(1, 0, At, B0); G8_BAR; G8_SCHED;
            G8_STAGE_B(G8_SB(1, 1), b2 + hstepB, k3);
            G8_WAIT_V(6); G8_BAR; G8_MMA(1, 1, At, B1); G8_BAR;
        }
        E(acc, cur, wr, wc, fr, fq);
        if (!has_next) break;
#pragma unroll
        for (int a = 0; a < 2; ++a)
#pragma unroll
            for (int b = 0; b < 2; ++b)
#pragma unroll
                for (int m = 0; m < 4; ++m)
#pragma unroll
                    for (int n = 0; n < 2; ++n) acc[a][b][m][n] = (f32x4){0.f, 0.f, 0.f, 0.f};
        cur = nxt; cB = nB; ++ui;
    }
    G8_WAIT_V(0);
    if (wr == 0) G8_BAR;
    G8_BAR;
#undef G8_SA
#undef G8_SB
#undef G8_STAGE_A
#undef G8_STAGE_B
#undef G8_LDA
#undef G8_LDB
#undef G8_MMA
#undef G8_WAIT_V
#undef G8_WAIT_L
#undef G8_BAR
#undef G8_SCHED
}
}
using g8::UnitD;
typedef f32x4 Acc[2][2][4][2];

struct EpiIn {
    u16* H; const float* rs1; float* SSQ; float* WI;
    DI void operator()(const Acc& acc, const UnitD& u, int wr, int wc, int fr, int fq) const {
        const int pn = u.pn;
#pragma unroll
        for (int ai = 0; ai < 2; ++ai)
#pragma unroll
            for (int m = 0; m < 4; ++m) {
                const int row = u.pm * 256 + ai * 128 + wr * 64 + m * 16 + fr;
                const float rs = rs1[row];
#pragma unroll
                for (int bj = 0; bj < 2; ++bj) {
                    float ssq = 0.f;
#pragma unroll
                    for (int n = 0; n < 2; ++n) {
                        const int col = pn * 256 + bj * 128 + wc * 32 + n * 16 + 4 * fq;
                        f32x4 v = acc[ai][bj][m][n] * rs;
                        if (pn < 4) { v[0] = gelu_tanh(v[0]); v[1] = gelu_tanh(v[1]); v[2] = gelu_tanh(v[2]); v[3] = gelu_tanh(v[3]); }
                        else if (pn >= 6) { v[0] = sigmoidf_(v[0]); v[1] = sigmoidf_(v[1]); v[2] = sigmoidf_(v[2]); v[3] = sigmoidf_(v[3]); }
                        ssq += (v[0] * v[0] + v[1] * v[1]) + (v[2] * v[2] + v[3] * v[3]);
                        u32x2 w; w.x = pk2(v[0], v[1]); w.y = pk2(v[2], v[3]);
                        *(u32x2*)(H + (size_t)row * NIN + col) = w;
                        if (pn == 5 && bj == 1 && wc == 2 && n == 0 && fq == 0) *(f32x4*)(WI + (size_t)row * 4) = v * 0.5f;
                    }
                    if (pn >= 2 && pn <= 5) {
                        ssq += __shfl_xor(ssq, 16); ssq += __shfl_xor(ssq, 32);
                        if (fq == 0) SSQ[(size_t)row * 32 + (pn - 2) * 8 + bj * 4 + wc] = ssq;
                    }
                }
            }
    }
};
struct EpiQ {
    u16* Q; u16* QI; const float* SSQ;
    DI void operator()(const Acc& acc, const UnitD& u, int wr, int wc, int fr, int fq) const {
#pragma unroll
        for (int ai = 0; ai < 2; ++ai)
#pragma unroll
            for (int m = 0; m < 4; ++m) {
                const int row = u.pm * 256 + ai * 128 + wr * 64 + m * 16 + fr;
                const f32x4 s0 = *(const f32x4*)(SSQ + (size_t)row * 32 + 16), s1 = *(const f32x4*)(SSQ + (size_t)row * 32 + 20);
                const float ss = ((s0[0] + s0[1]) + (s0[2] + s0[3])) + ((s1[0] + s1[1]) + (s1[2] + s1[3]));
                const float rs = __builtin_amdgcn_rsqf(ss * (1.0f / 256.0f) + EPS);
#pragma unroll
                for (int bj = 0; bj < 2; ++bj)
#pragma unroll
                    for (int n = 0; n < 2; ++n) {
                        const int col = u.pn * 256 + bj * 128 + wc * 32 + n * 16 + 4 * fq;
                        const f32x4 v = acc[ai][bj][m][n] * rs;
                        u32x2 w; w.x = pk2(v[0], v[1]); w.y = pk2(v[2], v[3]);
                        if (col < 1024) *(u32x2*)(Q + (size_t)row * 1024 + col) = w; else *(u32x2*)(QI + (size_t)row * 256 + (col - 1024)) = w;
                    }
            }
    }
};
template <int SECOND> struct EpiMrg {
    u16* OUT; const u16* TMP; const u16* H;
    DI void operator()(const Acc& acc, const UnitD& u, int wr, int wc, int fr, int fq) const {
#pragma unroll
        for (int ai = 0; ai < 2; ++ai)
#pragma unroll
            for (int m = 0; m < 4; ++m) {
                const int row = u.pm * 256 + ai * 128 + wr * 64 + m * 16 + fr;
#pragma unroll
                for (int bj = 0; bj < 2; ++bj)
#pragma unroll
                    for (int n = 0; n < 2; ++n) {
                        const int col = u.pn * 256 + bj * 128 + wc * 32 + n * 16 + 4 * fq;
                        const u32x2 g = *(const u32x2*)(H + (size_t)row * NIN + 1536 + SECOND * 1024 + col);
                        f32x4 v = acc[ai][bj][m][n];
                        v[0] *= bflo(g.x); v[1] *= bfhi(g.x); v[2] *= bflo(g.y); v[3] *= bfhi(g.y);
                        if (SECOND) { const u32x2 t = *(const u32x2*)(TMP + (size_t)row * 1024 + col); v[0] += bflo(t.x); v[1] += bfhi(t.x); v[2] += bflo(t.y); v[3] += bfhi(t.y); }
                        u32x2 w; w.x = pk2(v[0], v[1]); w.y = pk2(v[2], v[3]);
                        *(u32x2*)(OUT + (size_t)row * 1024 + col) = w;
                    }
            }
    }
};
struct EpiOut {
    float* out; const float* x;
    DI void operator()(const Acc& acc, const UnitD& u, int wr, int wc, int fr, int fq) const {
#pragma unroll
        for (int ai = 0; ai < 2; ++ai)
#pragma unroll
            for (int m = 0; m < 4; ++m) {
                const int row = u.pm * 256 + ai * 128 + wr * 64 + m * 16 + fr;
#pragma unroll
                for (int bj = 0; bj < 2; ++bj)
#pragma unroll
                    for (int n = 0; n < 2; ++n) {
                        const size_t o = (size_t)row * 1024 + u.pn * 256 + bj * 128 + wc * 32 + n * 16 + 4 * fq;
                        *(f32x4*)(out + o) = *(const f32x4*)(x + o) + acc[ai][bj][m][n];
                    }
            }
    }
};

constexpr int MOE_TAB = g8::STAGE_BYTES;
DI void moe_table(LAS unsigned char* lds, const unsigned* CNT) {
    LAS int* tab = (LAS int*)(lds + MOE_TAB);
    __syncthreads();
    if (threadIdx.x == 0) { int acc = 0; for (int e = 0; e < NE; ++e) { const int c = (int)__hip_atomic_load(CNT + e, __ATOMIC_RELAXED, __HIP_MEMORY_SCOPE_AGENT); tab[e] = acc; tab[33 + e] = c; acc += (c + 255) >> 8; } tab[32] = acc; }
    __syncthreads();
}
template <int NPN, bool GATHER> struct MoeSched {
    const char* Abase; const char* Wbase; const int* LTOK; LAS const int* tab; int lda, ldb, K, G, c; size_t wstride;
    DI bool next(int i, UnitD& u) const {
        const long L = (long)i * G + c; const int R = tab[32];
        if (L >= (long)R * NPN) return false;
        const int rbg = (int)(L / NPN), pn = (int)(L % NPN);
        int e = 0;
        for (int j = 1; j < NE; ++j) e += (tab[j] <= rbg) ? 1 : 0;
        e = __builtin_amdgcn_readfirstlane(e);
        u.pm = rbg; u.pn = pn; u.e = e; u.rb = rbg - tab[e];
        u.Bp = Wbase + (size_t)e * wstride + (size_t)pn * 256 * ldb * 2;
        return true;
    }
    DI void a_offs(const UnitD& u, int R0, int C0, unsigned (&o)[2][2]) const {
        const int cnt = tab[33 + u.e];
#pragma unroll
        for (int h = 0; h < 2; ++h)
#pragma unroll
            for (int i = 0; i < 2; ++i) {
                const int r = h * 128 + R0 + 64 * i;
                if (GATHER) { const int slot = u.rb * 256 + r; const int tok = slot < cnt ? LTOK[(size_t)u.e * ECAP + slot] : 0; o[h][i] = (unsigned)(((size_t)tok * lda + C0) * 2); }
                else o[h][i] = (unsigned)(((size_t)(u.pm * 256 + r) * lda + C0) * 2);
            }
    }
};
struct EpiMoe1 {
    u16* ACT; const float* b1;
    DI void operator()(const Acc& acc, const UnitD& u, int wr, int wc, int fr, int fq) const {
        const float* be = b1 + (size_t)u.e * 2048;
#pragma unroll
        for (int n = 0; n < 2; ++n) {
            const int hc = u.pn * 128 + wc * 32 + n * 16 + 4 * fq;
            const f32x4 bg = *(const f32x4*)(be + hc), bu = *(const f32x4*)(be + 1024 + hc);
#pragma unroll
            for (int ai = 0; ai < 2; ++ai)
#pragma unroll
                for (int m = 0; m < 4; ++m) {
                    const int row = u.pm * 256 + ai * 128 + wr * 64 + m * 16 + fr;
                    const f32x4 g = acc[ai][0][m][n] + bg, up = acc[ai][1][m][n] + bu;
                    float a[4];
#pragma unroll
                    for (int j = 0; j < 4; ++j) { const float hg = fminf(g[j], 7.0f), hu = fminf(fmaxf(up[j], -7.0f), 7.0f); a[j] = (hu + 1.0f) * (hg * sigmoidf_(1.702f * hg)); }
                    u32x2 w; w.x = pk2(a[0], a[1]); w.y = pk2(a[2], a[3]);
                    *(u32x2*)(ACT + (size_t)row * 1024 + hc) = w;
                }
        }
    }
};
struct EpiMoe2 {
    u16* YB; const float* b2; const float* LGATE; LAS const int* tab;
    DI void operator()(const Acc& acc, const UnitD& u, int wr, int wc, int fr, int fq) const {
        const float* be = b2 + (size_t)u.e * 1024; const int cnt = tab[33 + u.e];
#pragma unroll
        for (int ai = 0; ai < 2; ++ai)
#pragma unroll
            for (int m = 0; m < 4; ++m) {
                const int r = ai * 128 + wr * 64 + m * 16 + fr, slot = u.rb * 256 + r;
                const float gate = slot < cnt ? LGATE[(size_t)u.e * ECAP + slot] : 0.f;
#pragma unroll
                for (int bj = 0; bj < 2; ++bj)
#pragma unroll
                    for (int n = 0; n < 2; ++n) {
                        const int col = u.pn * 256 + bj * 128 + wc * 32 + n * 16 + 4 * fq;
                        const f32x4 v = (acc[ai][bj][m][n] + *(const f32x4*)(be + col)) * gate;
                        u32x2 w; w.x = pk2(v[0], v[1]); w.y = pk2(v[2], v[3]);
                        *(u32x2*)(YB + (size_t)(u.pm * 256 + r) * 1024 + col) = w;
                    }
            }
    }
};

template <class F> DI void tr_tile(LAS unsigned char* lds, const float* src, int ld_src, int Nsz, int k0, int n0, const float* sk, float mul, u16* dst, int ld_dst, F rowmap) {
    LAS float* t = (LAS float*)lds;
    const int tid = otid();
    __syncthreads();
#pragma unroll
    for (int it = 0; it < 2; ++it) {
        const int k = (tid >> 4) + 32 * it, n = 4 * (tid & 15);
        f32x4 v = {0.f, 0.f, 0.f, 0.f};
        if (n0 + n < Nsz) v = *(const f32x4*)(src + (size_t)(k0 + k) * ld_src + n0 + n);
        const float s = (sk ? sk[k0 + k] : 1.0f) * mul;
        t[k * 65 + n] = v[0] * s; t[k * 65 + n + 1] = v[1] * s; t[k * 65 + n + 2] = v[2] * s; t[k * 65 + n + 3] = v[3] * s;
    }
    __syncthreads();
    const int n = tid >> 3, kc = (tid & 7) * 8;
    if (n0 + n < Nsz) {
        u32x4 w;
        w.x = pk2(t[(kc + 0) * 65 + n], t[(kc + 1) * 65 + n]); w.y = pk2(t[(kc + 2) * 65 + n], t[(kc + 3) * 65 + n]);
        w.z = pk2(t[(kc + 4) * 65 + n], t[(kc + 5) * 65 + n]); w.w = pk2(t[(kc + 6) * 65 + n], t[(kc + 7) * 65 + n]);
        *(u32x4*)(dst + (size_t)rowmap(n0 + n) * ld_dst + k0 + kc) = w;
    }
}
struct MapId { DI int operator()(int n) const { return n; } };
struct MapIn { DI int operator()(int n) const { return n < 1476 ? n : n + 60; } };
struct MapE1 { DI int operator()(int n) const { const int hi = n >= 1024 ? 1 : 0, q = n - hi * 1024; return (q >> 7) * 256 + hi * 128 + (q & 127); } };

DI void phase0(const Args& a, LAS unsigned char* lds) {
    unsigned char* ws = a.ws;
    const int tid = otid();
    const size_t gtid = (size_t)blockIdx.x * NT + tid, gstride = (size_t)gridDim.x * NT;
    for (size_t i = gtid; i < 16384; i += gstride) ((unsigned*)(ws + WS_CTL))[i] = 0u;
    for (size_t i = gtid; i < 60 * 1024 / 2; i += gstride) ((unsigned*)(ws + WS_WIN + (size_t)1476 * 1024 * 2))[i] = 0u;
    for (size_t i = gtid; i < 32 * 1024; i += gstride) { const int e = (int)(i >> 10), k = (int)(i & 1023); ((float*)(ws + WS_WR))[i] = a.in[I_WR][k * 32 + e] * a.in[I_N2G][k]; }
    for (size_t i = gtid; i < 4 * 128 * 128; i += gstride) { const int tt = (int)((i >> 7) & 127), ss = (int)(i & 127); ((u16*)(ws + WS_WSP))[i] = f2bf(ss <= tt ? a.in[I_WSP][i] : 0.f); }
    {
        const int wid = tid >> 6, lane = tid & 63;
        for (int row = blockIdx.x * 8 + wid; row < T; row += gridDim.x * 8) {
            const float* xr = a.in[I_X] + (size_t)row * 1024; u16* xb = (u16*)(ws + WS_XB) + (size_t)row * 1024;
            float ss = 0.f;
#pragma unroll
            for (int i = 0; i < 4; ++i) {
                const f32x4 v = *(const f32x4*)(xr + i * 256 + lane * 4);
                ss += (v[0] * v[0] + v[1] * v[1]) + (v[2] * v[2] + v[3] * v[3]);
                u32x2 w; w.x = pk2(v[0], v[1]); w.y = pk2(v[2], v[3]);
                *(u32x2*)(xb + i * 256 + lane * 4) = w;
            }
#pragma unroll
            for (int o = 32; o >= 1; o >>= 1) ss += __shfl_xor(ss, o);
            if (lane == 0) ((float*)(ws + WS_RS1))[row] = __builtin_amdgcn_rsqf(ss * (1.0f / 1024.0f) + EPS);
        }
    }
    constexpr int U_IN = 16 * 56, U_UQ = 4 * 16, U_QI = 4 * 4, U_PA = 8 * 16, U_OUT = 16 * 16, U_E1 = 32 * 16 * 32, U_E2 = 32 * 16 * 16, U_CB = 64;
    constexpr int U_TOT = U_IN + U_UQ + U_QI + U_PA + U_OUT + U_E1 + U_E2 + U_CB;
    for (int u = blockIdx.x; u < U_TOT; u += gridDim.x) {
        int v = u;
        if (v < U_IN) { tr_tile(lds, a.in[I_WIN], 3524, 3524, (v & 15) * 64, (v >> 4) * 64, a.in[I_N1G], 1.0f, (u16*)(ws + WS_WIN), 1024, MapIn()); continue; }
        v -= U_IN;
        if (v < U_UQ) { tr_tile(lds, a.in[I_WUQ], 1024, 1024, (v & 3) * 64, (v >> 2) * 64, a.in[I_QLG], 1.0f, (u16*)(ws + WS_WQ), 256, MapId()); continue; }
        v -= U_UQ;
        if (v < U_QI) { tr_tile(lds, a.in[I_WQI], 256, 256, (v & 3) * 64, (v >> 2) * 64, a.in[I_QLG], 0.125f, (u16*)(ws + WS_WQ) + 1024 * 256, 256, MapId()); continue; }
        v -= U_QI;
        if (v < U_PA) { tr_tile(lds, a.in[I_WPA], 1024, 1024, (v & 7) * 64, (v >> 3) * 64, nullptr, 1.0f, (u16*)(ws + WS_WCAT), 1536, MapId()); continue; }
        v -= U_PA;
        if (v < U_OUT) { tr_tile(lds, a.in[I_WOUT], 1024, 1024, (v & 15) * 64, (v >> 4) * 64, nullptr, 1.0f, (u16*)(ws + WS_WOUT), 1024, MapId()); continue; }
        v -= U_OUT;
        if (v < U_E1) { const int e = v >> 9, w = v & 511; tr_tile(lds, a.in[I_WE1] + (size_t)e * 1024 * 2048, 2048, 2048, (w & 15) * 64, (w >> 4) * 64, a.in[I_N2G], 1.0f, (u16*)(ws + WS_WE1) + (size_t)e * 2048 * 1024, 1024, MapE1()); continue; }
        v -= U_E1;
        if (v < U_E2) { const int e = v >> 8, w = v & 255; tr_tile(lds, a.in[I_WE2] + (size_t)e * 1024 * 1024, 1024, 1024, (w & 15) * 64, (w >> 4) * 64, nullptr, 1.0f, (u16*)(ws + WS_WE2) + (size_t)e * 1024 * 1024, 1024, MapId()); continue; }
        v -= U_E2;
        {
            const int h = v >> 3, c0 = (v & 7) * 16;
            LAS float* t = (LAS float*)lds;
            __syncthreads();
            for (int i = tid; i < 1024; i += NT) t[i] = a.in[I_WUV][(size_t)h * 128 * 64 + (size_t)c0 * 64 + i];
            __syncthreads();
            for (int nn = tid; nn < 1024; nn += NT) {
                float accv[16];
#pragma unroll
                for (int i = 0; i < 16; ++i) accv[i] = 0.f;
                for (int vv = 0; vv < 64; ++vv) {
                    const float pb = a.in[I_WPB][(size_t)(h * 64 + vv) * 1024 + nn];
#pragma unroll
                    for (int i = 0; i < 16; ++i) accv[i] += t[i * 64 + vv] * pb;
                }
                u32x4 w0, w1;
                w0.x = pk2(accv[0], accv[1]); w0.y = pk2(accv[2], accv[3]); w0.z = pk2(accv[4], accv[5]); w0.w = pk2(accv[6], accv[7]);
                w1.x = pk2(accv[8], accv[9]); w1.y = pk2(accv[10], accv[11]); w1.z = pk2(accv[12], accv[13]); w1.w = pk2(accv[14], accv[15]);
                u16* d = (u16*)(ws + WS_WCAT) + (size_t)nn * 1536 + 512 + h * 128 + c0;
                *(u32x4*)d = w0; *(u32x4*)(d + 8) = w1;
            }
        }
    }
}

DI void gmlp_unit(const Args& a, LAS unsigned char* lds, int u) {
    unsigned char* ws = a.ws;
    const int tid = otid(), wid = tid >> 6, lane = tid & 63, fr = lane & 15, fq = lane >> 4;
    const int g = u & 3, row0 = (u >> 2) * 128;
    const u16* H = (const u16*)(ws + WS_H);
    LAS u16* img = (LAS u16*)lds;
    __syncthreads();
    {
        const int s = tid & 127, cset = tid >> 7;
        const f32x4 sq = *(const f32x4*)((const float*)(ws + WS_SSQ) + (size_t)(row0 + s) * 32 + g * 4);
        const float rs = __builtin_amdgcn_rsqf(((sq[0] + sq[1]) + (sq[2] + sq[3])) * (1.0f / 128.0f) + EPS);
#pragma unroll
        for (int it = 0; it < 4; ++it) {
            const int c = cset + 4 * it;
            const u32x4 raw = *(const u32x4*)(H + (size_t)(row0 + s) * NIN + 512 + g * 128 + 8 * c);
            const float* vg = a.in[I_VG] + 8 * c;
            float f[8] = {bflo(raw.x), bfhi(raw.x), bflo(raw.y), bfhi(raw.y), bflo(raw.z), bfhi(raw.z), bflo(raw.w), bfhi(raw.w)};
#pragma unroll
            for (int i = 0; i < 8; ++i) img[(8 * c + i) * 136 + s] = f2bf(f[i] * rs * vg[i]);
        }
    }
    __syncthreads();
    const u16* W = (const u16*)(ws + WS_WSP) + (size_t)g * 128 * 128 + (size_t)(16 * wid + fr) * 128;
    f32x4 acc[8];
#pragma unroll
    for (int i = 0; i < 8; ++i) acc[i] = (f32x4){0.f, 0.f, 0.f, 0.f};
    const int nks = (16 * wid + 15) / 32 + 1;
    for (int ks = 0; ks < nks; ++ks) {
        const bf16x8 bw = *(const bf16x8*)(W + ks * 32 + 8 * fq);
#pragma unroll
        for (int i = 0; i < 8; ++i) {
            const bf16x8 av = *(const LAS bf16x8*)(img + (16 * i + fr) * 136 + ks * 32 + 8 * fq);
            acc[i] = __builtin_amdgcn_mfma_f32_16x16x32_bf16(av, bw, acc[i], 0, 0, 0);
        }
    }
    const int t = 16 * wid + fr;
    const float bias = a.in[I_BSP][g * 128 + t];
    u16* YO = (u16*)(ws + WS_YO);
#pragma unroll
    for (int i = 0; i < 8; ++i) {
        const int d = 16 * i + 4 * fq;
        const u32x2 uu = *(const u32x2*)(H + (size_t)(row0 + t) * NIN + g * 128 + d);
        const float y0 = bflo(uu.x) * (acc[i][0] + bias), y1 = bfhi(uu.x) * (acc[i][1] + bias), y2 = bflo(uu.y) * (acc[i][2] + bias), y3 = bfhi(uu.y) * (acc[i][3] + bias);
        u32x2 w; w.x = pk2(y0, y1); w.y = pk2(y2, y3);
        *(u32x2*)(YO + (size_t)(row0 + t) * 1536 + g * 128 + d) = w;
    }
}

DI void kvnorm(const Args& a) {
    unsigned char* ws = a.ws;
    const u16* H = (const u16*)(ws + WS_H); const float* SSQ = (const float*)(ws + WS_SSQ);
    const size_t gtid = (size_t)blockIdx.x * NT + otid(), gstride = (size_t)gridDim.x * NT;
    for (size_t idx = gtid; idx < (size_t)T * 24; idx += gstride) {
        const int row = (int)(idx / 24), c = (int)(idx % 24);
        const u16* src; u16* dst; const float* gain; float rs;
        if (c < 16) {
            const f32x4 sq = *(const f32x4*)(SSQ + (size_t)row * 32 + 24);
            rs = __builtin_amdgcn_rsqf(((sq[0] + sq[1]) + (sq[2] + sq[3])) * (1.0f / 128.0f) + EPS);
            src = H + (size_t)row * NIN + 1280 + 8 * c; dst = (u16*)(ws + WS_KVN) + (size_t)row * 128 + 8 * c; gain = a.in[I_KVG] + 8 * c;
        } else {
            const int cc = c - 16;
            rs = __builtin_amdgcn_rsqf((SSQ[(size_t)row * 32 + 28] + SSQ[(size_t)row * 32 + 29]) * (1.0f / 64.0f) + EPS);
            src = H + (size_t)row * NIN + 1408 + 8 * cc; dst = (u16*)(ws + WS_KIN) + (size_t)row * 64 + 8 * cc; gain = a.in[I_KIG] + 8 * cc;
        }
        const u32x4 raw = *(const u32x4*)src;
        u32x4 w;
        w.x = pk2(bflo(raw.x) * rs * gain[0], bfhi(raw.x) * rs * gain[1]); w.y = pk2(bflo(raw.y) * rs * gain[2], bfhi(raw.y) * rs * gain[3]);
        w.z = pk2(bflo(raw.z) * rs * gain[4], bfhi(raw.z) * rs * gain[5]); w.w = pk2(bflo(raw.w) * rs * gain[6], bfhi(raw.w) * rs * gain[7]);
        *(u32x4*)dst = w;
    }
}

constexpr int P3_ROWS = 0, P3_HIST = 131072, P3_LIST = 147456;
DI unsigned f2key(float f) { const unsigned u = __float_as_uint(f); return (u & 0x80000000u) ? ~u : (u | 0x80000000u); }
DI int wave_incl_scan(int v, int lane) {
#pragma unroll
    for (int o = 1; o < 64; o <<= 1) { const int t = __shfl_up(v, o); if (lane >= o) v += t; }
    return v;
}
DI int wave_suffix_scan(int v, int lane) {
#pragma unroll
    for (int o = 1; o < 64; o <<= 1) { const int t = __shfl_down(v, o); if (lane + o < 64) v += t; }
    return v;
}
DI void select_top16(LAS const u16* row, LAS unsigned* hist, LAS u16* list, int N, int lane) {
    int need = 256;
    *(LAS u32x4*)(hist + lane * 8) = (u32x4){0u, 0u, 0u, 0u}; *(LAS u32x4*)(hist + lane * 8 + 4) = (u32x4){0u, 0u, 0u, 0u};
    wave_lds_sync();
    for (int p0 = 0; p0 < N; p0 += 512) {
        const int base = p0 + lane * 8;
        const u32x4 kk = *(LAS const u32x4*)(row + base);
        const unsigned kw[4] = {kk.x, kk.y, kk.z, kk.w};
#pragma unroll
        for (int j = 0; j < 8; ++j) {
            const unsigned key = (kw[j >> 1] >> (16 * (j & 1))) & 0xffffu;
            if (base + j < N) { const unsigned d = key >> 6; __hip_atomic_fetch_add(hist + (d >> 1), 1u << ((d & 1u) * 16u), __ATOMIC_RELAXED, __HIP_MEMORY_SCOPE_WORKGROUP); }
        }
    }
    wave_lds_sync();
    unsigned d1;
    {
        unsigned w[8]; int sl = 0;
        { const u32x4 v0 = *(LAS const u32x4*)(hist + lane * 8), v1 = *(LAS const u32x4*)(hist + lane * 8 + 4); w[0] = v0.x; w[1] = v0.y; w[2] = v0.z; w[3] = v0.w; w[4] = v1.x; w[5] = v1.y; w[6] = v1.z; w[7] = v1.w; }
#pragma unroll
        for (int i = 0; i < 8; ++i) sl += (int)(w[i] & 0xffffu) + (int)(w[i] >> 16);
        const int suf = wave_suffix_scan(sl, lane);
        const unsigned long long bal = __ballot(suf >= need);
        const int L = 63 - __builtin_clzll(bal);
        int cum = suf - sl, dsel = 0, above = 0; bool found = false;
#pragma unroll
        for (int i = 7; i >= 0; --i) {
            const int chi = (int)(w[i] >> 16), clo = (int)(w[i] & 0xffffu);
            if (!found && cum + chi >= need) { found = true; dsel = lane * 16 + 2 * i + 1; above = cum; } cum += found ? 0 : chi;
            if (!found && cum + clo >= need) { found = true; dsel = lane * 16 + 2 * i; above = cum; } cum += found ? 0 : clo;
        }
        d1 = (unsigned)__shfl(dsel, L); need -= __shfl(above, L);
    }
    wave_lds_sync();
    hist[lane] = 0u;
    wave_lds_sync();
    for (int p0 = 0; p0 < N; p0 += 512) {
        const int base = p0 + lane * 8;
        const u32x4 kk = *(LAS const u32x4*)(row + base);
        const unsigned kw[4] = {kk.x, kk.y, kk.z, kk.w};
#pragma unroll
        for (int j = 0; j < 8; ++j) {
            const unsigned key = (kw[j >> 1] >> (16 * (j & 1))) & 0xffffu;
            if (base + j < N && (key >> 6) == d1) __hip_atomic_fetch_add(hist + (key & 63u), 1u, __ATOMIC_RELAXED, __HIP_MEMORY_SCOPE_WORKGROUP);
        }
    }
    wave_lds_sync();
    unsigned T16;
    {
        const int cme = (int)hist[lane];
        const int suf = wave_suffix_scan(cme, lane);
        const unsigned long long bal = __ballot(suf >= need);
        const int L = 63 - __builtin_clzll(bal);
        need -= __shfl(suf - cme, L);
        T16 = (d1 << 6) | (unsigned)L;
    }
    int pos = 0, ties = 0;
    for (int p0 = 0; p0 < N; p0 += 512) {
        const int base = p0 + lane * 8;
        const u32x4 kk = *(LAS const u32x4*)(row + base);
        const unsigned kw[4] = {kk.x, kk.y, kk.z, kk.w};
        unsigned gtm = 0u, eqm = 0u;
#pragma unroll
        for (int j = 0; j < 8; ++j) {
            const unsigned key = (kw[j >> 1] >> (16 * (j & 1))) & 0xffffu;
            const bool valid = base + j < N;
            gtm |= (valid && key > T16) ? (1u << j) : 0u; eqm |= (valid && key == T16) ? (1u << j) : 0u;
        }
        const int ne = __builtin_popcount(eqm);
        const int einc = wave_incl_scan(ne, lane);
        int erank = ties + einc - ne;
        unsigned takem = gtm;
#pragma unroll
        for (int j = 0; j < 8; ++j) if (eqm & (1u << j)) { if (erank < need) takem |= 1u << j; ++erank; }
        const int nk = __builtin_popcount(takem);
        const int kinc = wave_incl_scan(nk, lane);
        int wp = pos + kinc - nk;
#pragma unroll
        for (int j = 0; j < 8; ++j) if (takem & (1u << j)) { list[wp] = (u16)(base + j); ++wp; }
        pos += __shfl(kinc, 63); ties += __shfl(einc, 63);
    }
}

DI void dsa_phase(const Args& a, LAS unsigned char* lds) {
    unsigned char* ws = a.ws;
    const int tid = otid(), wid = __builtin_amdgcn_readfirstlane(tid >> 6), lane = tid & 63, fr = lane & 15, fq = lane >> 4;
    const u16* QI = (const u16*)(ws + WS_QI); const u16* KIN = (const u16*)(ws + WS_KIN); const u16* KVN = (const u16*)(ws + WS_KVN);
    const u16* Q = (const u16*)(ws + WS_Q); const float* WI = (const float*)(ws + WS_WI); u16* YO = (u16*)(ws + WS_YO);
    LAS u16* rows = (LAS u16*)(lds + P3_ROWS);
    for (int gi = blockIdx.x; gi < T / 8; gi += gridDim.x) {
        const int b = gi & 3, t0 = S - 8 - 8 * (gi >> 2);
        const size_t brow = (size_t)b * S;
        const int ntile = (t0 + 8 + 15) >> 4;
        __syncthreads();
        {
            bf16x8 qa[2][2]; f32x4 wi[2];
#pragma unroll
            for (int rg = 0; rg < 2; ++rg) {
#pragma unroll
                for (int ks = 0; ks < 2; ++ks) qa[rg][ks] = *(const bf16x8*)(QI + (brow + t0 + 4 * rg + (fr >> 2)) * 256 + (fr & 3) * 64 + ks * 32 + 8 * fq);
                wi[rg] = *(const f32x4*)(WI + (brow + t0 + 4 * rg + fq) * 4);
            }
            for (int jt0 = wid; jt0 < ntile; jt0 += 32) {
                bf16x8 kf[4][2];
#pragma unroll
                for (int u = 0; u < 4; ++u) {
                    const int jt = (jt0 + 8 * u) < ntile ? (jt0 + 8 * u) : (ntile - 1);
                    const u16* kp = KIN + (brow + jt * 16 + fr) * 64 + 8 * fq;
                    kf[u][0] = *(const bf16x8*)kp; kf[u][1] = *(const bf16x8*)(kp + 32);
                }
#pragma unroll
                for (int u = 0; u < 4; ++u) {
                    const int jt = jt0 + 8 * u;
                    if (jt < ntile) {
#pragma unroll
                        for (int rg = 0; rg < 2; ++rg) {
                            f32x4 d = {0.f, 0.f, 0.f, 0.f};
                            d = __builtin_amdgcn_mfma_f32_16x16x32_bf16(qa[rg][0], kf[u][0], d, 0, 0, 0);
                            d = __builtin_amdgcn_mfma_f32_16x16x32_bf16(qa[rg][1], kf[u][1], d, 0, 0, 0);
                            const float sc = ((fmaxf(d[0], 0.f) * wi[rg][0] + fmaxf(d[1], 0.f) * wi[rg][1]) + fmaxf(d[2], 0.f) * wi[rg][2]) + fmaxf(d[3], 0.f) * wi[rg][3];
                            rows[(4 * rg + fq) * 8192 + jt * 16 + fr] = (u16)(f2key(sc) >> 16);
                        }
                    }
                }
            }
        }
        __syncthreads();
        {
            const int q = wid, t = t0 + q, N = t + 1;
            LAS u16* row = rows + q * 8192;
            LAS unsigned* hist = (LAS unsigned*)(lds + P3_HIST + q * 2048);
            LAS u16* list = (LAS u16*)(lds + P3_LIST + q * 512);
            int cnt;
            if (N <= 256) { for (int p = lane; p < 256; p += 64) list[p] = p < N ? (u16)p : (u16)0; cnt = N; }
            else { select_top16(row, hist, list, N, lane); cnt = 256; }
            wave_lds_sync();
            bf16x8 qf[4];
            {
                const int head = fr & 7;
                const u16* qrow = Q + (brow + t) * 1024 + head * 128;
                float f[4][8]; float ss = 0.f;
#pragma unroll
                for (int ks = 0; ks < 4; ++ks) {
                    const u32x4 raw = *(const u32x4*)(qrow + ks * 32 + 8 * fq);
                    f[ks][0] = bflo(raw.x); f[ks][1] = bfhi(raw.x); f[ks][2] = bflo(raw.y); f[ks][3] = bfhi(raw.y); f[ks][4] = bflo(raw.z); f[ks][5] = bfhi(raw.z); f[ks][6] = bflo(raw.w); f[ks][7] = bfhi(raw.w);
#pragma unroll
                    for (int j = 0; j < 8; ++j) ss += f[ks][j] * f[ks][j];
                }
                ss += __shfl_xor(ss, 16); ss += __shfl_xor(ss, 32);
                const float rq = __builtin_amdgcn_rsqf(ss * (1.0f / 128.0f) + EPS) * 0.08838834764831845f;
#pragma unroll
                for (int ks = 0; ks < 4; ++ks) {
                    const float* qg = a.in[I_QNG] + ks * 32 + 8 * fq;
                    u32x4 w;
                    w.x = pk2(f[ks][0] * rq * qg[0], f[ks][1] * rq * qg[1]); w.y = pk2(f[ks][2] * rq * qg[2], f[ks][3] * rq * qg[3]);
                    w.z = pk2(f[ks][4] * rq * qg[4], f[ks][5] * rq * qg[5]); w.w = pk2(f[ks][6] * rq * qg[6], f[ks][7] * rq * qg[7]);
                    qf[ks] = __builtin_bit_cast(bf16x8, w);
                }
            }
            LAS unsigned char* img = (LAS unsigned char*)row;
            const int nsteps = (cnt + 31) >> 5;
            u32x4 pf[8];
#pragma unroll
            for (int it = 0; it < 8; ++it) { const int piece = it * 64 + lane; const unsigned key = list[piece >> 4]; pf[it] = *(const u32x4*)(KVN + (brow + key) * 128 + 8 * (piece & 15)); }
            f32x4 oacc[8];
#pragma unroll
            for (int i = 0; i < 8; ++i) oacc[i] = (f32x4){0.f, 0.f, 0.f, 0.f};
            float mrun = -3.0e38f, lpart = 0.f;
#pragma unroll 1
            for (int pp = 0; pp < nsteps; ++pp) {
#pragma unroll
                for (int it = 0; it < 8; ++it) { const int piece = it * 64 + lane; *(LAS u32x4*)(img + (piece >> 4) * 288 + (piece & 15) * 16) = pf[it]; }
                if (pp + 1 < nsteps) {
#pragma unroll
                    for (int it = 0; it < 8; ++it) { const int piece = it * 64 + lane; const unsigned key = list[(pp + 1) * 32 + (piece >> 4)]; pf[it] = *(const u32x4*)(KVN + (brow + key) * 128 + 8 * (piece & 15)); }
                }
                wave_lds_sync();
                f32x4 sa = {0.f, 0.f, 0.f, 0.f}, sb = {0.f, 0.f, 0.f, 0.f};
#pragma unroll
                for (int ks = 0; ks < 4; ++ks) {
                    const bf16x8 a0 = *(LAS const bf16x8*)(img + fr * 288 + (ks * 32 + 8 * fq) * 2), a1 = *(LAS const bf16x8*)(img + (16 + fr) * 288 + (ks * 32 + 8 * fq) * 2);
                    sa = __builtin_amdgcn_mfma_f32_16x16x32_bf16(a0, qf[ks], sa, 0, 0, 0); sb = __builtin_amdgcn_mfma_f32_16x16x32_bf16(a1, qf[ks], sb, 0, 0, 0);
                }
                const int pb0 = pp * 32 + 4 * fq;
#pragma unroll
                for (int r = 0; r < 4; ++r) { if (pb0 + r >= cnt) sa[r] = -3.0e38f; if (pb0 + 16 + r >= cnt) sb[r] = -3.0e38f; }
                float mx = fmaxf(fmaxf(fmaxf(sa[0], sa[1]), fmaxf(sa[2], sa[3])), fmaxf(fmaxf(sb[0], sb[1]), fmaxf(sb[2], sb[3])));
                mx = fmaxf(mx, __shfl_xor(mx, 16)); mx = fmaxf(mx, __shfl_xor(mx, 32));
                const float mnew = fmaxf(mrun, mx), alpha = __expf(mrun - mnew);
                mrun = mnew;
                float ps = 0.f;
#pragma unroll
                for (int r = 0; r < 4; ++r) { sa[r] = __expf(sa[r] - mnew); sb[r] = __expf(sb[r] - mnew); ps += sa[r] + sb[r]; }
                lpart = lpart * alpha + ps;
#pragma unroll
                for (int cb = 0; cb < 8; ++cb) oacc[cb] *= alpha;
                u32x4 pw; pw.x = pk2(sa[0], sa[1]); pw.y = pk2(sa[2], sa[3]); pw.z = pk2(sb[0], sb[1]); pw.w = pk2(sb[2], sb[3]);
                const bf16x8 pb = __builtin_bit_cast(bf16x8, pw);
#pragma unroll
                for (int cb = 0; cb < 8; ++cb) {
                    const s16x4 r0 = __builtin_amdgcn_ds_read_tr16_b64_v4i16((LAS s16x4*)(img + (4 * fq + (fr >> 2)) * 288 + (cb * 16 + 4 * (fr & 3)) * 2));
                    const s16x4 r1 = __builtin_amdgcn_ds_read_tr16_b64_v4i16((LAS s16x4*)(img + (16 + 4 * fq + (fr >> 2)) * 288 + (cb * 16 + 4 * (fr & 3)) * 2));
                    const bf16x8 av = {r0[0], r0[1], r0[2], r0[3], r1[0], r1[1], r1[2], r1[3]};
                    oacc[cb] = __builtin_amdgcn_mfma_f32_16x16x32_bf16(av, pb, oacc[cb], 0, 0, 0);
                }
                wave_lds_sync();
            }
            float lsum = lpart; lsum += __shfl_xor(lsum, 16); lsum += __shfl_xor(lsum, 32);
            const float inv = __builtin_amdgcn_rcpf(lsum);
            if (fr < 8) {
                u16* orow = YO + (brow + t) * 1536 + 512 + fr * 128 + 4 * fq;
#pragma unroll
                for (int cb = 0; cb < 8; ++cb) { u32x2 w; w.x = pk2(oacc[cb][0] * inv, oacc[cb][1] * inv); w.y = pk2(oacc[cb][2] * inv, oacc[cb][3] * inv); *(u32x2*)(orow + cb * 16) = w; }
            }
        }
    }
}

constexpr int P6_WT = 0, P6_LCNT = 131072, P6_BASE = 131072 + 128, P6_RI = 131072 + 256;
DI void router_phase(const Args& a, LAS unsigned char* lds) {
    unsigned char* ws = a.ws;
    const int tid = otid(), wid = tid >> 6, lane = tid & 63;
    LAS float* WT = (LAS float*)(lds + P6_WT); LAS int* lcnt = (LAS int*)(lds + P6_LCNT); LAS int* lbase = (LAS int*)(lds + P6_BASE); LAS int* RI = (LAS int*)(lds + P6_RI);
    const float* WR = (const float*)(ws + WS_WR);
    unsigned* CNT = (unsigned*)(ws + WS_CTL);
    __syncthreads();
    for (int i = tid; i < 32 * 1024 / 4; i += NT) *(LAS f32x4*)(WT + 4 * i) = *(const f32x4*)(WR + 4 * i);
    for (int rg = blockIdx.x; rg < T / 128; rg += gridDim.x) {
        if (tid < 32) lcnt[tid] = 0;
        __syncthreads();
        for (int it = 0; it < 16; ++it) {
            const int rl = wid + 8 * it, row = rg * 128 + rl;
            const float* xr = a.out + (size_t)row * 1024;
            f32x4 xv[4]; float ss = 0.f;
#pragma unroll
            for (int i = 0; i < 4; ++i) { xv[i] = *(const f32x4*)(xr + i * 256 + lane * 4); ss += (xv[i][0] * xv[i][0] + xv[i][1] * xv[i][1]) + (xv[i][2] * xv[i][2] + xv[i][3] * xv[i][3]); }
#pragma unroll
            for (int o = 32; o >= 1; o >>= 1) ss += __shfl_xor(ss, o);
            const float rs = __builtin_amdgcn_rsqf(ss * (1.0f / 1024.0f) + EPS);
            u16* xn = (u16*)(ws + WS_XN2) + (size_t)row * 1024;
#pragma unroll
            for (int i = 0; i < 4; ++i) { u32x2 w; w.x = pk2(xv[i][0] * rs, xv[i][1] * rs); w.y = pk2(xv[i][2] * rs, xv[i][3] * rs); *(u32x2*)(xn + i * 256 + lane * 4) = w; }
            float acc[32];
#pragma unroll
            for (int e = 0; e < 32; ++e) {
                float s = 0.f;
#pragma unroll
                for (int i = 0; i < 4; ++i) { const f32x4 w = *(LAS const f32x4*)(WT + e * 1024 + i * 256 + lane * 4); s += (xv[i][0] * w[0] + xv[i][1] * w[1]) + (xv[i][2] * w[2] + xv[i][3] * w[3]); }
                acc[e] = s;
            }
            float v16[16], v8[8], v4[4], v2[2], v1;
            { const bool hi = (lane & 32) != 0;
#pragma unroll
              for (int e = 0; e < 16; ++e) { const float keep = hi ? acc[e + 16] : acc[e], send = hi ? acc[e] : acc[e + 16]; v16[e] = keep + __shfl_xor(send, 32); } }
            { const bool hi = (lane & 16) != 0;
#pragma unroll
              for (int e = 0; e < 8; ++e) { const float keep = hi ? v16[e + 8] : v16[e], send = hi ? v16[e] : v16[e + 8]; v8[e] = keep + __shfl_xor(send, 16); } }
            { const bool hi = (lane & 8) != 0;
#pragma unroll
              for (int e = 0; e < 4; ++e) { const float keep = hi ? v8[e + 4] : v8[e], send = hi ? v8[e] : v8[e + 4]; v4[e] = keep + __shfl_xor(send, 8); } }
            { const bool hi = (lane & 4) != 0;
#pragma unroll
              for (int e = 0; e < 2; ++e) { const float keep = hi ? v4[e + 2] : v4[e], send = hi ? v4[e] : v4[e + 2]; v2[e] = keep + __shfl_xor(send, 4); } }
            { const bool hi = (lane & 2) != 0; const float keep = hi ? v2[1] : v2[0], send = hi ? v2[0] : v2[1]; v1 = keep + __shfl_xor(send, 2); }
            v1 += __shfl_xor(v1, 1);
            const int myexp = lane >> 1;
            float logit = v1 * rs + a.in[I_BR][myexp];
            float tv[4]; int ti[4];
#pragma unroll
            for (int k = 0; k < 4; ++k) {
                float bv = logit; int bi = myexp;
#pragma unroll
                for (int o = 32; o >= 1; o >>= 1) { const float ov = __shfl_xor(bv, o); const int oi = __shfl_xor(bi, o); if (ov > bv || (ov == bv && oi < bi)) { bv = ov; bi = oi; } }
                tv[k] = bv; ti[k] = bi;
                if (myexp == bi) logit = -3.0e38f;
            }
            const float e1 = __expf(tv[1] - tv[0]), e2 = __expf(tv[2] - tv[0]), e3 = __expf(tv[3] - tv[0]);
            const float inv = 1.0f / (1.0f + e1 + e2 + e3);
            if (lane < 4) {
                const int e = lane == 0 ? ti[0] : (lane == 1 ? ti[1] : (lane == 2 ? ti[2] : ti[3]));
                const float gt = (lane == 0 ? 1.0f : (lane == 1 ? e1 : (lane == 2 ? e2 : e3))) * inv;
                const int ls = __hip_atomic_fetch_add(lcnt + e, 1, __ATOMIC_RELAXED, __HIP_MEMORY_SCOPE_WORKGROUP);
                RI[(rl * 4 + lane) * 3 + 0] = e; RI[(rl * 4 + lane) * 3 + 1] = ls; RI[(rl * 4 + lane) * 3 + 2] = __float_as_int(gt);
            }
        }
        __syncthreads();
        if (tid < 32) lbase[tid] = (int)__hip_atomic_fetch_add(CNT + tid, (unsigned)lcnt[tid], __ATOMIC_RELAXED, __HIP_MEMORY_SCOPE_AGENT);
        __syncthreads();
        {
            const int rl = tid >> 2, k = tid & 3, row = rg * 128 + rl;
            const int e = RI[tid * 3 + 0], slot = lbase[e] + RI[tid * 3 + 1]; const float gt = __int_as_float(RI[tid * 3 + 2]);
            ((int*)(ws + WS_LTOK))[(size_t)e * ECAP + slot] = row;
            ((float*)(ws + WS_LGATE))[(size_t)e * ECAP + slot] = gt;
            ((unsigned*)(ws + WS_ROUTE))[(size_t)row * 4 + k] = ((unsigned)e << 16) | (unsigned)slot;
        }
        __syncthreads();
    }
}

DI void combine_phase(const Args& a, LAS unsigned char* lds) {
    unsigned char* ws = a.ws;
    LAS const int* tab = (LAS const int*)(lds + MOE_TAB);
    const int tid = otid(), wid = tid >> 6, lane = tid & 63;
    const u16* YB = (const u16*)(ws + WS_YB); const unsigned* ROUTE = (const unsigned*)(ws + WS_ROUTE);
    for (int row = blockIdx.x * 8 + wid; row < T; row += gridDim.x * 8) {
        size_t pos[4];
#pragma unroll
        for (int k = 0; k < 4; ++k) { const unsigned r = ROUTE[(size_t)row * 4 + k]; const int e = (int)(r >> 16), slot = (int)(r & 0xffffu); pos[k] = (size_t)tab[e] * 256 + slot; }
        float* orow = a.out + (size_t)row * 1024;
#pragma unroll
        for (int i = 0; i < 4; ++i) {
            f32x4 v = *(const f32x4*)(orow + i * 256 + lane * 4);
#pragma unroll
            for (int k = 0; k < 4; ++k) { const u32x2 y = *(const u32x2*)(YB + pos[k] * 1024 + i * 256 + lane * 4); v[0] += bflo(y.x); v[1] += bfhi(y.x); v[2] += bflo(y.y); v[3] += bfhi(y.y); }
            *(f32x4*)(orow + i * 256 + lane * 4) = v;
        }
    }
}

__global__ void __launch_bounds__(NT, 2) fwd(Args a) {
    extern __shared__ __attribute__((aligned(16))) unsigned char lds_raw[];
    LAS unsigned char* lds = (LAS unsigned char*)lds_raw;
    cg::grid_group grid = cg::this_grid();
    unsigned char* ws = a.ws;
    const int G = gridDim.x, c = blockIdx.x;

    phase0(a, lds);
    grid.sync();
    {
        g8::PlainSched s; s.Abase = (const char*)(ws + WS_XB); s.Bbase = (const char*)(ws + WS_WIN); s.lda = 1024; s.ldb = 1024; s.K = 1024; s.nM = T / 256; s.nN = NIN / 256; s.G = G; s.c = c;
        EpiIn e; e.H = (u16*)(ws + WS_H); e.rs1 = (const float*)(ws + WS_RS1); e.SSQ = (float*)(ws + WS_SSQ); e.WI = (float*)(ws + WS_WI);
        g8::gemm_phase(lds, s, e);
    }
    grid.sync();
    {
        g8::PlainSched s; s.Abase = (const char*)(ws + WS_H) + 1024 * 2; s.Bbase = (const char*)(ws + WS_WQ); s.lda = NIN; s.ldb = 256; s.K = 256; s.nM = T / 256; s.nN = 5; s.G = G; s.c = c;
        EpiQ e; e.Q = (u16*)(ws + WS_Q); e.QI = (u16*)(ws + WS_QI); e.SSQ = (const float*)(ws + WS_SSQ);
        g8::gemm_phase(lds, s, e);
        for (int u = c; u < 1024; u += G) gmlp_unit(a, lds, u);
        kvnorm(a);
    }
    grid.sync();
    dsa_phase(a, lds);
    grid.sync();
    {
        g8::PlainSched s; s.Abase = (const char*)(ws + WS_YO); s.Bbase = (const char*)(ws + WS_WCAT); s.lda = 1536; s.ldb = 1536; s.K = 512; s.nM = T / 256; s.nN = 4; s.G = G; s.c = c;
        EpiMrg<0> e0; e0.OUT = (u16*)(ws + WS_TMP); e0.TMP = nullptr; e0.H = (const u16*)(ws + WS_H);
        g8::gemm_phase(lds, s, e0);
        s.Abase = (const char*)(ws + WS_YO) + 512 * 2; s.Bbase = (const char*)(ws + WS_WCAT) + 512 * 2; s.K = 1024;
        EpiMrg<1> e1; e1.OUT = (u16*)(ws + WS_MRG); e1.TMP = (const u16*)(ws + WS_TMP); e1.H = (const u16*)(ws + WS_H);
        g8::gemm_phase(lds, s, e1);
    }
    grid.sync();
    {
        g8::PlainSched s; s.Abase = (const char*)(ws + WS_MRG); s.Bbase = (const char*)(ws + WS_WOUT); s.lda = 1024; s.ldb = 1024; s.K = 1024; s.nM = T / 256; s.nN = 4; s.G = G; s.c = c;
        EpiOut e; e.out = a.out; e.x = a.in[I_X];
        g8::gemm_phase(lds, s, e);
    }
    grid.sync();
    router_phase(a, lds);
    grid.sync();
    moe_table(lds, (const unsigned*)(ws + WS_CTL));
    {
        MoeSched<8, true> s; s.Abase = (const char*)(ws + WS_XN2); s.Wbase = (const char*)(ws + WS_WE1); s.LTOK = (const int*)(ws + WS_LTOK); s.tab = (LAS const int*)(lds + MOE_TAB);
        s.lda = 1024; s.ldb = 1024; s.K = 1024; s.G = G; s.c = c; s.wstride = (size_t)2048 * 1024 * 2;
        EpiMoe1 e; e.ACT = (u16*)(ws + WS_ACT); e.b1 = a.in[I_BE1];
        g8::gemm_phase(lds, s, e);
    }
    grid.sync();
    {
        MoeSched<4, false> s; s.Abase = (const char*)(ws + WS_ACT); s.Wbase = (const char*)(ws + WS_WE2); s.LTOK = nullptr; s.tab = (LAS const int*)(lds + MOE_TAB);
        s.lda = 1024; s.ldb = 1024; s.K = 1024; s.G = G; s.c = c; s.wstride = (size_t)1024 * 1024 * 2;
        EpiMoe2 e; e.YB = (u16*)(ws + WS_YB); e.b2 = a.in[I_BE2]; e.LGATE = (const float*)(ws + WS_LGATE); e.tab = (LAS const int*)(lds + MOE_TAB);
        g8::gemm_phase(lds, s, e);
    }
    grid.sync();
    combine_phase(a, lds);
}

extern "C" void kernel_launch(void* const* d_in, const int* in_sizes, int n_in, void* d_out, int out_size, void* d_ws, size_t ws_size, hipStream_t stream) {
    static int grid = 0;
    if (grid == 0) {
        int dev = 0, cus = 0, per_cu = 0;
        if (n_in != 23 || out_size != T * Dm || ws_size < WS_END) { fprintf(stderr, "kernel_launch: unexpected problem (n_in %d, out %d, ws %zu < %zu)\n", n_in, out_size, ws_size, (size_t)WS_END); grid = -1; return; }
        if (hipGetDevice(&dev) != hipSuccess || hipDeviceGetAttribute(&cus, hipDeviceAttributeMultiprocessorCount, dev) != hipSuccess) { grid = -1; return; }
        if (hipFuncSetAttribute((const void*)fwd, hipFuncAttributeMaxDynamicSharedMemorySize, LDS_BYTES) != hipSuccess) { fprintf(stderr, "hipFuncSetAttribute failed\n"); grid = -1; return; }
        if (hipOccupancyMaxActiveBlocksPerMultiprocessor(&per_cu, (const void*)fwd, NT, LDS_BYTES) != hipSuccess || per_cu < 1) { fprintf(stderr, "occupancy query failed (%d)\n", per_cu); grid = -1; return; }
        grid = cus;
        fprintf(stderr, "kernel_launch: cus %d per_cu %d grid %d ws %zu need %zu\n", cus, per_cu, grid, ws_size, (size_t)WS_END);
    }
    if (grid < 0) return;
    Args a{};
    for (int i = 0; i < 23; ++i) a.in[i] = (const float*)d_in[i];
    a.out = (float*)d_out; a.ws = (unsigned char*)d_ws; a.mask = 0xffffffffu; a.pad = 0u;
    void* args[] = {&a};
    hipError_t e = hipLaunchCooperativeKernel((const void*)fwd, dim3(grid), dim3(NT), args, LDS_BYTES, stream);
    if (e != hipSuccess) fprintf(stderr, "cooperative launch failed: %s (grid %d)\n", hipGetErrorString(e), grid);
}
```

```cpp
#include <hip/hip_runtime.h>
#include <hip/hip_cooperative_groups.h>
#include <cstdio>
#include <cstdint>
namespace cg = cooperative_groups;

#define LAS __attribute__((address_space(3)))
#define DI __device__ __forceinline__
typedef unsigned short u16;
typedef short bf16x8 __attribute__((ext_vector_type(8)));
typedef short s16x4 __attribute__((ext_vector_type(4)));
typedef float f32x4 __attribute__((ext_vector_type(4)));
typedef float f32x2 __attribute__((ext_vector_type(2)));
typedef unsigned u32x4 __attribute__((ext_vector_type(4)));
typedef unsigned u32x2 __attribute__((ext_vector_type(2)));
typedef __bf16 bf2_t __attribute__((ext_vector_type(2)));

constexpr int NT = 512;
constexpr int LDS_BYTES = 155648;
constexpr int Dm = 1024, Bsz = 4, S = 8192, T = Bsz * S;
constexpr int NIN = 3584;
constexpr int NE = 32, ECAP = 32768, PPAD = 131072 + NE * 256;
constexpr float EPS = 1e-6f;

constexpr size_t MiB = 1024 * 1024;
constexpr size_t WS_CTL = 0;
constexpr size_t WS_WIN = 64 * 1024;
constexpr size_t WS_WQ = WS_WIN + (size_t)NIN * 1024 * 2;
constexpr size_t WS_WSP = WS_WQ + 1280 * 256 * 2;
constexpr size_t WS_WCAT = WS_WSP + 4 * 128 * 128 * 2;
constexpr size_t WS_WOUT = WS_WCAT + 1024 * 1536 * 2;
constexpr size_t WS_WR = WS_WOUT + 1024 * 1024 * 2;
constexpr size_t WS_WE1 = WS_WR + 32 * 1024 * 4;
constexpr size_t WS_WE2 = WS_WE1 + (size_t)32 * 2048 * 1024 * 2;
constexpr size_t WS_RS1 = WS_WE2 + (size_t)32 * 1024 * 1024 * 2;
constexpr size_t WS_SSQ = WS_RS1 + (size_t)T * 4;
constexpr size_t WS_WI = WS_SSQ + (size_t)T * 32 * 4;
constexpr size_t WS_ROUTE = WS_WI + (size_t)T * 4 * 4;
constexpr size_t WS_LTOK = WS_ROUTE + (size_t)T * 4 * 4;
constexpr size_t WS_LGATE = WS_LTOK + (size_t)NE * ECAP * 4;
constexpr size_t WS_XN2 = WS_LGATE + (size_t)NE * ECAP * 4;
constexpr size_t WS_R0 = WS_XN2 + (size_t)T * 1024 * 2;
constexpr size_t WS_XB = WS_R0;
constexpr size_t WS_H = WS_XB + (size_t)T * 1024 * 2;
constexpr size_t WS_Q = WS_H + (size_t)T * NIN * 2;
constexpr size_t WS_QI = WS_Q + (size_t)T * 1024 * 2;
constexpr size_t WS_KVN = WS_QI + (size_t)T * 256 * 2;
constexpr size_t WS_KIN = WS_KVN + (size_t)T * 128 * 2;
constexpr size_t WS_YO = WS_KIN + (size_t)T * 64 * 2;
constexpr size_t WS_TMP = WS_YO + (size_t)T * 1536 * 2;
constexpr size_t WS_MRG = WS_TMP + (size_t)T * 1024 * 2;
constexpr size_t WS_R0END = WS_MRG + (size_t)T * 1024 * 2;
constexpr size_t WS_ACT = WS_XB;
constexpr size_t WS_YB = WS_Q;
static_assert(WS_ACT + (size_t)PPAD * 1024 * 2 <= WS_Q, "ACT overlaps YB");
static_assert(WS_YB + (size_t)PPAD * 1024 * 2 <= WS_R0END, "YB too large");
constexpr size_t WS_END = WS_R0END;

struct Args { const float* in[23]; float* out; unsigned char* ws; unsigned mask; unsigned pad; };
enum { I_X = 0, I_N1G, I_WIN, I_QLG, I_WUQ, I_QNG, I_KVG, I_WUV, I_WQI, I_KIG, I_VG, I_WSP, I_BSP, I_WPA, I_WPB, I_WOUT, I_N2G, I_WR, I_BR, I_WE1, I_BE1, I_WE2, I_BE2 };

DI unsigned pk2(float a, float b) { f32x2 v = {a, b}; bf2_t r = __builtin_convertvector(v, bf2_t); return __builtin_bit_cast(unsigned, r); }
DI float bflo(unsigned u) { return __uint_as_float(u << 16); }
DI float bfhi(unsigned u) { return __uint_as_float(u & 0xffff0000u); }
DI u16 f2bf(float f) { return (u16)(pk2(f, 0.f) & 0xffffu); }
DI float bf2f(u16 h) { return __uint_as_float(((unsigned)h) << 16); }
DI float sigmoidf_(float x) { return __builtin_amdgcn_rcpf(1.0f + __expf(-x)); }
DI float gelu_tanh(float x) { const float u = 1.5957691216057308f * (x + 0.044715f * x * x * x); return x * sigmoidf_(u); }
DI int otid() { int t = threadIdx.x; asm volatile("" : "+v"(t)); return t; }
DI void wave_lds_sync() { asm volatile("s_waitcnt lgkmcnt(0)" ::: "memory"); }

namespace g8 {
constexpr int BM = 256, BK = 64, HALF = 128, HTB = HALF * BK * 2, STAGE_BYTES = 8 * HTB, NXCD = 8, WGM = 8;
DI int lds_byte(int r, int c) { const int st = (r >> 4) * 2 + (c >> 5), rr = r & 15, cc = c & 31, ob = rr * 64 + cc * 2; return st * 1024 + (ob ^ (((ob >> 9) & 1) << 5)); }
DI void stage_rc(int b, int& R, int& C) { const int st = b / 1024, sb = b % 1024, swz = sb ^ (((sb >> 9) & 1) << 5); R = (st >> 1) * 16 + swz / 64; C = (st & 1) * 32 + (swz % 64) / 2; }

struct UnitD { const char* Bp; int pm, pn, e, rb; };

DI bool static_tile(int i, int G, int c, int nM, int nN, int& pm, int& pn) {
    const int nwg = nM * nN; const long L = (long)i * G + c; if (L >= nwg) return false;
    int wgid = (int)L; { const int q = nwg / NXCD, r = nwg % NXCD, xcd = wgid % NXCD, off = wgid / NXCD; wgid = (xcd < r ? xcd * (q + 1) : r * (q + 1) + (xcd - r) * q) + off; }
    const int nig = WGM * nN, gid = wgid / nig, fm = gid * WGM, gsz = (nM - fm) < WGM ? (nM - fm) : WGM;
    pm = fm + ((wgid % nig) % gsz); pn = (wgid % nig) / gsz; return true;
}

struct PlainSched {
    const char* Abase; const char* Bbase; int lda, ldb, K, nM, nN, G, c;
    DI bool next(int i, UnitD& u) const { int pm, pn; if (!static_tile(i, G, c, nM, nN, pm, pn)) return false; u.pm = pm; u.pn = pn; u.e = 0; u.rb = 0; u.Bp = Bbase + (size_t)pn * BM * ldb * 2; return true; }
    DI void a_offs(const UnitD& u, int R0, int C0, unsigned (&o)[2][2]) const {
#pragma unroll
        for (int h = 0; h < 2; ++h)
#pragma unroll
            for (int i = 0; i < 2; ++i) o[h][i] = (unsigned)(((size_t)(u.pm * BM + h * HALF + R0 + 64 * i) * lda + C0) * 2);
    }
};

template <class Epi, class Sched>
DI void gemm_phase(LAS unsigned char* lds, const Sched& S, const Epi& E) {
    const int tid = otid(), wid = __builtin_amdgcn_readfirstlane(tid >> 6), lane = tid & 63, wr = wid >> 2, wc = wid & 3, fr = lane & 15, fq = lane >> 4;
    const int nt = S.K / BK;
    int R0, C0; stage_rc(tid * 16, R0, C0);
    unsigned voffB[2];
#pragma unroll
    for (int i = 0; i < 2; ++i) voffB[i] = (unsigned)(((R0 + 64 * i) * S.ldb + C0) * 2);
    const size_t hstepB = (size_t)HALF * S.ldb * 2;
    const unsigned ldsw = (unsigned)wid * 1024u;
    const int aoff = lds_byte(wr * 64 + fr, fq * 8), boff = lds_byte(wc * 32 + fr, fq * 8);
    const char* Ab = S.Abase;
#define G8_SA(b, h) (((b) * 2 + (h)) * HTB)
#define G8_SB(b, h) ((4 + (b) * 2 + (h)) * HTB)
#define G8_STAGE_A(bufoff, offs, kb) do { _Pragma("unroll") for (int _i = 0; _i < 2; ++_i) \
        __builtin_amdgcn_global_load_lds((const unsigned*)(Ab + (size_t)(offs)[_i] + (size_t)(kb)), (LAS unsigned*)(lds + (bufoff) + ldsw + _i * 8192), 16, 0, 0); } while (0)
#define G8_STAGE_B(bufoff, gbase, kb) do { _Pragma("unroll") for (int _i = 0; _i < 2; ++_i) \
        __builtin_amdgcn_global_load_lds((const unsigned*)((gbase) + voffB[_i] + (size_t)(kb)), (LAS unsigned*)(lds + (bufoff) + ldsw + _i * 8192), 16, 0, 0); } while (0)
#define G8_LDA(dst, b, h) do { _Pragma("unroll") for (int m = 0; m < 4; ++m) _Pragma("unroll") for (int k = 0; k < 2; ++k) dst[m][k] = *(const LAS bf16x8*)(lds + G8_SA(b, h) + aoff + m * 2048 + k * 1024); } while (0)
#define G8_LDB(dst, b, h) do { _Pragma("unroll") for (int n = 0; n < 2; ++n) _Pragma("unroll") for (int k = 0; k < 2; ++k) dst[n][k] = *(const LAS bf16x8*)(lds + G8_SB(b, h) + boff + n * 2048 + k * 1024); } while (0)
#define G8_MMA(ai, bj, At, Bt) do { __builtin_amdgcn_s_setprio(1); _Pragma("unroll") for (int m = 0; m < 4; ++m) _Pragma("unroll") for (int n = 0; n < 2; ++n) _Pragma("unroll") for (int k = 0; k < 2; ++k) \
        acc[ai][bj][m][n] = __builtin_amdgcn_mfma_f32_16x16x32_bf16(Bt[n][k], At[m][k], acc[ai][bj][m][n], 0, 0, 0); __builtin_amdgcn_s_setprio(0); } while (0)
#define G8_WAIT_V(n) asm volatile("s_waitcnt vmcnt(" #n ")" ::: "memory")
#define G8_WAIT_L(n) asm volatile("s_waitcnt lgkmcnt(" #n ")" ::: "memory")
#define G8_BAR __builtin_amdgcn_s_barrier()
#define G8_SCHED __builtin_amdgcn_sched_barrier(0)
    UnitD cur, nxt; int ui = 0;
    if (!S.next(0, cur)) return;
    f32x4 acc[2][2][4][2];
#pragma unroll
    for (int a = 0; a < 2; ++a)
#pragma unroll
        for (int b = 0; b < 2; ++b)
#pragma unroll
            for (int m = 0; m < 4; ++m)
#pragma unroll
                for (int n = 0; n < 2; ++n) acc[a][b][m][n] = (f32x4){0.f, 0.f, 0.f, 0.f};
    bf16x8 At[4][2], B0[2][2], B1[2][2];
    unsigned cA[2][2];
    S.a_offs(cur, R0, C0, cA);
    const char* cB = cur.Bp;
    G8_STAGE_B(G8_SB(0, 0), cB, 0); G8_STAGE_A(G8_SA(0, 0), cA[0], 0); G8_STAGE_B(G8_SB(0, 1), cB + hstepB, 0); G8_STAGE_A(G8_SA(0, 1), cA[1], 0);
    if (wr == 1) G8_BAR;
    G8_WAIT_V(4); G8_BAR;
    G8_STAGE_B(G8_SB(1, 0), cB, 128); G8_STAGE_A(G8_SA(1, 0), cA[0], 128); G8_STAGE_B(G8_SB(1, 1), cB + hstepB, 128);
    G8_WAIT_V(6); G8_BAR;
    for (;;) {
        const bool has_next = S.next(ui + 1, nxt);
        const char* nB = has_next ? nxt.Bp : cB;
        for (int t = 0; t < nt; t += 2) {
            const bool last = (t == nt - 2);
            const unsigned k1 = (unsigned)(t + 1) * 128u;
            const unsigned k2 = last ? 0u : (unsigned)(t + 2) * 128u, k3 = k2 + 128u;
            unsigned c1[2] = {cA[1][0], cA[1][1]};
            if (last && has_next) S.a_offs(nxt, R0, C0, cA);
            const char* b2 = last ? nB : cB;
            G8_LDB(B0, 0, 0); G8_SCHED; G8_LDA(At, 0, 0); G8_STAGE_A(G8_SA(1, 1), c1, k1);
            G8_WAIT_L(8); G8_BAR; G8_WAIT_L(0); G8_MMA(0, 0, At, B0); G8_BAR; G8_SCHED;
            G8_LDB(B1, 0, 1); G8_STAGE_B(G8_SB(0, 0), b2, k2);
            G8_BAR; G8_WAIT_L(0); G8_MMA(0, 1, At, B1); G8_BAR;
            G8_LDA(At, 0, 1); G8_STAGE_A(G8_SA(0, 0), cA[0], k2);
            G8_BAR; G8_WAIT_L(0); G8_MMA(1, 0, At, B0); G8_BAR; G8_SCHED;
            G8_STAGE_B(G8_SB(0, 1), b2 + hstepB, k2);
            G8_WAIT_V(6); G8_BAR; G8_MMA(1, 1, At, B1); G8_BAR;
            G8_LDB(B0, 1, 0); G8_SCHED; G8_LDA(At, 1, 0); G8_STAGE_A(G8_SA(0, 1), cA[1], k2);
            G8_WAIT_L(8); G8_BAR; G8_WAIT_L(0); G8_MMA(0, 0, At, B0); G8_BAR; G8_SCHED;
            G8_LDB(B1, 1, 1); G8_STAGE_B(G8_SB(1, 0), b2, k3);
            G8_BAR; G8_WAIT_L(0); G8_MMA(0, 1, At, B1); G8_BAR;
            G8_LDA(At, 1, 1); G8_STAGE_A(G8_SA(1, 0), cA[0], k3);
            G8_BAR; G8_WAIT_L(0); G8_MMA(1, 0, At, B0); G8_BAR; G8_SCHED;
            G8_STAGE_B(G8_SB(1, 1), b2 + hstepB, k3);
            G8_WAIT_V(6); G8_BAR; G8_MMA(1, 1, At, B1); G8_BAR;
        }
        E(acc, cur, wr, wc, fr, fq);
        if (!has_next) break;
#pragma unroll
        for (int a = 0; a < 2; ++a)
#pragma unroll
            for (int b = 0; b < 2; ++b)
#pragma unroll
                for (int m = 0; m < 4; ++m)
#pragma unroll
                    for (int n = 0; n < 2; ++n) acc[a][b][m][n] = (f32x4){0.f, 0.f, 0.f, 0.f};
        cur = nxt; cB = nB; ++ui;
    }
    G8_WAIT_V(0);
    if (wr == 0) G8_BAR;
    G8_BAR;
#undef G8_SA
#undef G8_SB
#undef G8_STAGE_A
#undef G8_STAGE_B
#undef G8_LDA
#undef G8_LDB
#undef G8_MMA
#undef G8_WAIT_V
#undef G8_WAIT_L
#undef G8_BAR
#undef G8_SCHED
}
}
using g8::UnitD;
typedef f32x4 Acc[2][2][4][2];

struct EpiIn {
    u16* H; const float* rs1; float* SSQ; float* WI;
    DI void operator()(const Acc& acc, const UnitD& u, int wr, int wc, int fr, int fq) const {
        const int pn = u.pn;
#pragma unroll
        for (int ai = 0; ai < 2; ++ai)
#pragma unroll
            for (int m = 0; m < 4; ++m) {
                const int row = u.pm * 256 + ai * 128 + wr * 64 + m * 16 + fr;
                const float rs = rs1[row];
#pragma unroll
                for (int bj = 0; bj < 2; ++bj) {
                    float ssq = 0.f;
#pragma unroll
                    for (int n = 0; n < 2; ++n) {
                        const int col = pn * 256 + bj * 128 + wc * 32 + n * 16 + 4 * fq;
                        f32x4 v = acc[ai][bj][m][n] * rs;
                        if (pn < 4) { v[0] = gelu_tanh(v[0]); v[1] = gelu_tanh(v[1]); v[2] = gelu_tanh(v[2]); v[3] = gelu_tanh(v[3]); }
                        else if (pn >= 6) { v[0] = sigmoidf_(v[0]); v[1] = sigmoidf_(v[1]); v[2] = sigmoidf_(v[2]); v[3] = sigmoidf_(v[3]); }
                        ssq += (v[0] * v[0] + v[1] * v[1]) + (v[2] * v[2] + v[3] * v[3]);
                        u32x2 w; w.x = pk2(v[0], v[1]); w.y = pk2(v[2], v[3]);
                        *(u32x2*)(H + (size_t)row * NIN + col) = w;
                        if (pn == 5 && bj == 1 && wc == 2 && n == 0 && fq == 0) *(f32x4*)(WI + (size_t)row * 4) = v * 0.5f;
                    }
                    if (pn >= 2 && pn <= 5) {
                        ssq += __shfl_xor(ssq, 16); ssq += __shfl_xor(ssq, 32);
                        if (fq == 0) SSQ[(size_t)row * 32 + (pn - 2) * 8 + bj * 4 + wc] = ssq;
                    }
                }
            }
    }
};
struct EpiQ {
    u16* Q; u16* QI; const float* SSQ;
    DI void operator()(const Acc& acc, const UnitD& u, int wr, int wc, int fr, int fq) const {
#pragma unroll
        for (int ai = 0; ai < 2; ++ai)
#pragma unroll
            for (int m = 0; m < 4; ++m) {
                const int row = u.pm * 256 + ai * 128 + wr * 64 + m * 16 + fr;
                const f32x4 s0 = *(const f32x4*)(SSQ + (size_t)row * 32 + 16), s1 = *(const f32x4*)(SSQ + (size_t)row * 32 + 20);
                const float ss = ((s0[0] + s0[1]) + (s0[2] + s0[3])) + ((s1[0] + s1[1]) + (s1[2] + s1[3]));
                const float rs = __builtin_amdgcn_rsqf(ss * (1.0f / 256.0f) + EPS);
#pragma unroll
                for (int bj = 0; bj < 2; ++bj)
#pragma unroll
                    for (int n = 0; n < 2; ++n) {
                        const int col = u.pn * 256 + bj * 128 + wc * 32 + n * 16 + 4 * fq;
                        const f32x4 v = acc[ai][bj][m][n] * rs;
                        u32x2 w; w.x = pk2(v[0], v[1]); w.y = pk2(v[2], v[3]);
                        if (col < 1024) *(u32x2*)(Q + (size_t)row * 1024 + col) = w; else *(u32x2*)(QI + (size_t)row * 256 + (col - 1024)) = w;
                    }
            }
    }
};
template <int SECOND> struct EpiMrg {
    u16* OUT; const u16* TMP; const u16* H;
    DI void operator()(const Acc& acc, const UnitD& u, int wr, int wc, int fr, int fq) const {
#pragma unroll
        for (int ai = 0; ai < 2; ++ai)
#pragma unroll
            for (int m = 0; m < 4; ++m) {
                const int row = u.pm * 256 + ai * 128 + wr * 64 + m * 16 + fr;
#pragma unroll
                for (int bj = 0; bj < 2; ++bj)
#pragma unroll
                    for (int n = 0; n < 2; ++n) {
                        const int col = u.pn * 256 + bj * 128 + wc * 32 + n * 16 + 4 * fq;
                        const u32x2 g = *(const u32x2*)(H + (size_t)row * NIN + 1536 + SECOND * 1024 + col);
                        f32x4 v = acc[ai][bj][m][n];
                        v[0] *= bflo(g.x); v[1] *= bfhi(g.x); v[2] *= bflo(g.y); v[3] *= bfhi(g.y);
                        if (SECOND) { const u32x2 t = *(const u32x2*)(TMP + (size_t)row * 1024 + col); v[0] += bflo(t.x); v[1] += bfhi(t.x); v[2] += bflo(t.y); v[3] += bfhi(t.y); }
                        u32x2 w; w.x = pk2(v[0], v[1]); w.y = pk2(v[2], v[3]);
                        *(u32x2*)(OUT + (size_t)row * 1024 + col) = w;
                    }
            }
    }
};
struct EpiOut {
    float* out; const float* x;
    DI void operator()(const Acc& acc, const UnitD& u, int wr, int wc, int fr, int fq) const {
#pragma unroll
        for (int ai = 0; ai < 2; ++ai)
#pragma unroll
            for (int m = 0; m < 4; ++m) {
                const int row = u.pm * 256 + ai * 128 + wr * 64 + m * 16 + fr;
#pragma unroll
                for (int bj = 0; bj < 2; ++bj)
#pragma unroll
                    for (int n = 0; n < 2; ++n) {
                        const size_t o = (size_t)row * 1024 + u.pn * 256 + bj * 128 + wc * 32 + n * 16 + 4 * fq;
                        *(f32x4*)(out + o) = *(const f32x4*)(x + o) + acc[ai][bj][m][n];
                    }
            }
    }
};

constexpr int MOE_TAB = g8::STAGE_BYTES;
DI void moe_table(LAS unsigned char* lds, const unsigned* CNT) {
    LAS int* tab = (LAS int*)(lds + MOE_TAB);
    __syncthreads();
    if (threadIdx.x == 0) { int acc = 0; for (int e = 0; e < NE; ++e) { const int c = (int)__hip_atomic_load(CNT + e, __ATOMIC_RELAXED, __HIP_MEMORY_SCOPE_AGENT); tab[e] = acc; tab[33 + e] = c; acc += (c + 255) >> 8; } tab[32] = acc; }
    __syncthreads();
}
template <int NPN, bool GATHER> struct MoeSched {
    const char* Abase; const char* Wbase; const int* LTOK; LAS const int* tab; int lda, ldb, K, G, c; size_t wstride;
    DI bool next(int i, UnitD& u) const {
        const long L = (long)i * G + c; const int R = tab[32];
        if (L >= (long)R * NPN) return false;
        const int rbg = (int)(L / NPN), pn = (int)(L % NPN);
        int e = 0;
        for (int j = 1; j < NE; ++j) e += (tab[j] <= rbg) ? 1 : 0;
        e = __builtin_amdgcn_readfirstlane(e);
        u.pm = rbg; u.pn = pn; u.e = e; u.rb = rbg - tab[e];
        u.Bp = Wbase + (size_t)e * wstride + (size_t)pn * 256 * ldb * 2;
        return true;
    }
    DI void a_offs(const UnitD& u, int R0, int C0, unsigned (&o)[2][2]) const {
        const int cnt = tab[33 + u.e];
#pragma unroll
        for (int h = 0; h < 2; ++h)
#pragma unroll
            for (int i = 0; i < 2; ++i) {
                const int r = h * 128 + R0 + 64 * i;
                if (GATHER) { const int slot = u.rb * 256 + r; const int tok = slot < cnt ? LTOK[(size_t)u.e * ECAP + slot] : 0; o[h][i] = (unsigned)(((size_t)tok * lda + C0) * 2); }
                else o[h][i] = (unsigned)(((size_t)(u.pm * 256 + r) * lda + C0) * 2);
            }
    }
};
struct EpiMoe1 {
    u16* ACT; const float* b1;
    DI void operator()(const Acc& acc, const UnitD& u, int wr, int wc, int fr, int fq) const {
        const float* be = b1 + (size_t)u.e * 2048;
#pragma unroll
        for (int n = 0; n < 2; ++n) {
            const int hc = u.pn * 128 + wc * 32 + n * 16 + 4 * fq;
            const f32x4 bg = *(const f32x4*)(be + hc), bu = *(const f32x4*)(be + 1024 + hc);
#pragma unroll
            for (int ai = 0; ai < 2; ++ai)
#pragma unroll
                for (int m = 0; m < 4; ++m) {
                    const int row = u.pm * 256 + ai * 128 + wr * 64 + m * 16 + fr;
                    const f32x4 g = acc[ai][0][m][n] + bg, up = acc[ai][1][m][n] + bu;
                    float a[4];
#pragma unroll
                    for (int j = 0; j < 4; ++j) { const float hg = fminf(g[j], 7.0f), hu = fminf(fmaxf(up[j], -7.0f), 7.0f); a[j] = (hu + 1.0f) * (hg * sigmoidf_(1.702f * hg)); }
                    u32x2 w; w.x = pk2(a[0], a[1]); w.y = pk2(a[2], a[3]);
                    *(u32x2*)(ACT + (size_t)row * 1024 + hc) = w;
                }
        }
    }
};
struct EpiMoe2 {
    u16* YB; const float* b2; const float* LGATE; LAS const int* tab;
    DI void operator()(const Acc& acc, const UnitD& u, int wr, int wc, int fr, int fq) const {
        const float* be = b2 + (size_t)u.e * 1024; const int cnt = tab[33 + u.e];
#pragma unroll
        for (int ai = 0; ai < 2; ++ai)
#pragma unroll
            for (int m = 0; m < 4; ++m) {
                const int r = ai * 128 + wr * 64 + m * 16 + fr, slot = u.rb * 256 + r;
                const float gate = slot < cnt ? LGATE[(size_t)u.e * ECAP + slot] : 0.f;
#pragma unroll
                for (int bj = 0; bj < 2; ++bj)
#pragma unroll
                    for (int n = 0; n < 2; ++n) {
                        const int col = u.pn * 256 + bj * 128 + wc * 32 + n * 16 + 4 * fq;
                        const f32x4 v = (acc[ai][bj][m][n] + *(const f32x4*)(be + col)) * gate;
                        u32x2 w; w.x = pk2(v[0], v[1]); w.y = pk2(v[2], v[3]);
                        *(u32x2*)(YB + (size_t)(u.pm * 256 + r) * 1024 + col) = w;
                    }
            }
    }
};

template <class F> DI void tr_tile(LAS unsigned char* lds, const float* src, int ld_src, int Nsz, int k0, int n0, const float* sk, float mul, u16* dst, int ld_dst, F rowmap) {
    LAS float* t = (LAS float*)lds;
    const int tid = otid();
    __syncthreads();
#pragma unroll
    for (int it = 0; it < 2; ++it) {
        const int k = (tid >> 4) + 32 * it, n = 4 * (tid & 15);
        f32x4 v = {0.f, 0.f, 0.f, 0.f};
        if (n0 + n < Nsz) v = *(const f32x4*)(src + (size_t)(k0 + k) * ld_src + n0 + n);
        const float s = (sk ? sk[k0 + k] : 1.0f) * mul;
        t[k * 65 + n] = v[0] * s; t[k * 65 + n + 1] = v[1] * s; t[k * 65 + n + 2] = v[2] * s; t[k * 65 + n + 3] = v[3] * s;
    }
    __syncthreads();
    const int n = tid >> 3, kc = (tid & 7) * 8;
    if (n0 + n < Nsz) {
        u32x4 w;
        w.x = pk2(t[(kc + 0) * 65 + n], t[(kc + 1) * 65 + n]); w.y = pk2(t[(kc + 2) * 65 + n], t[(kc + 3) * 65 + n]);
        w.z = pk2(t[(kc + 4) * 65 + n], t[(kc + 5) * 65 + n]); w.w = pk2(t[(kc + 6) * 65 + n], t[(kc + 7) * 65 + n]);
        *(u32x4*)(dst + (size_t)rowmap(n0 + n) * ld_dst + k0 + kc) = w;
    }
}
struct MapId { DI int operator()(int n) const { return n; } };
struct MapIn { DI int operator()(int n) const { return n < 1476 ? n : n + 60; } };
struct MapE1 { DI int operator()(int n) const { const int hi = n >= 1024 ? 1 : 0, q = n - hi * 1024; return (q >> 7) * 256 + hi * 128 + (q & 127); } };

DI void phase0(const Args& a, LAS unsigned char* lds) {
    unsigned char* ws = a.ws;
    const int tid = otid();
    const size_t gtid = (size_t)blockIdx.x * NT + tid, gstride = (size_t)gridDim.x * NT;
    for (size_t i = gtid; i < 16384; i += gstride) ((unsigned*)(ws + WS_CTL))[i] = 0u;
    for (size_t i = gtid; i < 60 * 1024 / 2; i += gstride) ((unsigned*)(ws + WS_WIN + (size_t)1476 * 1024 * 2))[i] = 0u;
    for (size_t i = gtid; i < 32 * 1024; i += gstride) { const int e = (int)(i >> 10), k = (int)(i & 1023); ((float*)(ws + WS_WR))[i] = a.in[I_WR][k * 32 + e] * a.in[I_N2G][k]; }
    for (size_t i = gtid; i < 4 * 128 * 128; i += gstride) { const int tt = (int)((i >> 7) & 127), ss = (int)(i & 127); ((u16*)(ws + WS_WSP))[i] = f2bf(ss <= tt ? a.in[I_WSP][i] : 0.f); }
    {
        const int wid = tid >> 6, lane = tid & 63;
        for (int row = blockIdx.x * 8 + wid; row < T; row += gridDim.x * 8) {
            const float* xr = a.in[I_X] + (size_t)row * 1024; u16* xb = (u16*)(ws + WS_XB) + (size_t)row * 1024;
            float ss = 0.f;
#pragma unroll
            for (int i = 0; i < 4; ++i) {
                const f32x4 v = *(const f32x4*)(xr + i * 256 + lane * 4);
                ss += (v[0] * v[0] + v[1] * v[1]) + (v[2] * v[2] + v[3] * v[3]);
                u32x2 w; w.x = pk2(v[0], v[1]); w.y = pk2(v[2], v[3]);
                *(u32x2*)(xb + i * 256 + lane * 4) = w;
            }
#pragma unroll
            for (int o = 32; o >= 1; o >>= 1) ss += __shfl_xor(ss, o);
            if (lane == 0) ((float*)(ws + WS_RS1))[row] = __builtin_amdgcn_rsqf(ss * (1.0f / 1024.0f) + EPS);
        }
    }
    constexpr int U_IN = 16 * 56, U_UQ = 4 * 16, U_QI = 4 * 4, U_PA = 8 * 16, U_OUT = 16 * 16, U_E1 = 32 * 16 * 32, U_E2 = 32 * 16 * 16, U_CB = 64;
    constexpr int U_TOT = U_IN + U_UQ + U_QI + U_PA + U_OUT + U_E1 + U_E2 + U_CB;
    for (int u = blockIdx.x; u < U_TOT; u += gridDim.x) {
        int v = u;
        if (v < U_IN) { tr_tile(lds, a.in[I_WIN], 3524, 3524, (v & 15) * 64, (v >> 4) * 64, a.in[I_N1G], 1.0f, (u16*)(ws + WS_WIN), 1024, MapIn()); continue; }
        v -= U_IN;
        if (v < U_UQ) { tr_tile(lds, a.in[I_WUQ], 1024, 1024, (v & 3) * 64, (v >> 2) * 64, a.in[I_QLG], 1.0f, (u16*)(ws + WS_WQ), 256, MapId()); continue; }
        v -= U_UQ;
        if (v < U_QI) { tr_tile(lds, a.in[I_WQI], 256, 256, (v & 3) * 64, (v >> 2) * 64, a.in[I_QLG], 0.125f, (u16*)(ws + WS_WQ) + 1024 * 256, 256, MapId()); continue; }
        v -= U_QI;
        if (v < U_PA) { tr_tile(lds, a.in[I_WPA], 1024, 1024, (v & 7) * 64, (v >> 3) * 64, nullptr, 1.0f, (u16*)(ws + WS_WCAT), 1536, MapId()); continue; }
        v -= U_PA;
        if (v < U_OUT) { tr_tile(lds, a.in[I_WOUT], 1024, 1024, (v & 15) * 64, (v >> 4) * 64, nullptr, 1.0f, (u16*)(ws + WS_WOUT), 1024, MapId()); continue; }
        v -= U_OUT;
        if (v < U_E1) { const int e = v >> 9, w = v & 511; tr_tile(lds, a.in[I_WE1] + (size_t)e * 1024 * 2048, 2048, 2048, (w & 15) * 64, (w >> 4) * 64, a.in[I_N2G], 1.0f, (u16*)(ws + WS_WE1) + (size_t)e * 2048 * 1024, 1024, MapE1()); continue; }
        v -= U_E1;
        if (v < U_E2) { const int e = v >> 8, w = v & 255; tr_tile(lds, a.in[I_WE2] + (size_t)e * 1024 * 1024, 1024, 1024, (w & 15) * 64, (w >> 4) * 64, nullptr, 1.0f, (u16*)(ws + WS_WE2) + (size_t)e * 1024 * 1024, 1024, MapId()); continue; }
        v -= U_E2;
        {
            const int h = v >> 3, c0 = (v & 7) * 16;
            LAS float* t = (LAS float*)lds;
            __syncthreads();
            for (int i = tid; i < 1024; i += NT) t[i] = a.in[I_WUV][(size_t)h * 128 * 64 + (size_t)c0 * 64 + i];
            __syncthreads();
            for (int nn = tid; nn < 1024; nn += NT) {
                float accv[16];
#pragma unroll
                for (int i = 0; i < 16; ++i) accv[i] = 0.f;
                for (int vv = 0; vv < 64; ++vv) {
                    const float pb = a.in[I_WPB][(size_t)(h * 64 + vv) * 1024 + nn];
#pragma unroll
                    for (int i = 0; i < 16; ++i) accv[i] += t[i * 64 + vv] * pb;
                }
                u32x4 w0, w1;
                w0.x = pk2(accv[0], accv[1]); w0.y = pk2(accv[2], accv[3]); w0.z = pk2(accv[4], accv[5]); w0.w = pk2(accv[6], accv[7]);
                w1.x = pk2(accv[8], accv[9]); w1.y = pk2(accv[10], accv[11]); w1.z = pk2(accv[12], accv[13]); w1.w = pk2(accv[14], accv[15]);
                u16* d = (u16*)(ws + WS_WCAT) + (size_t)nn * 1536 + 512 + h * 128 + c0;
                *(u32x4*)d = w0; *(u32x4*)(d + 8) = w1;
            }
        }
    }
}

DI void gmlp_unit(const Args& a, LAS unsigned char* lds, int u) {
    unsigned char* ws = a.ws;
    const int tid = otid(), wid = tid >> 6, lane = tid & 63, fr = lane & 15, fq = lane >> 4;
    const int g = u & 3, row0 = (u >> 2) * 128;
    const u16* H = (const u16*)(ws + WS_H);
    LAS u16* img = (LAS u16*)lds;
    __syncthreads();
    {
        const int s = tid & 127, cset = tid >> 7;
        const f32x4 sq = *(const f32x4*)((const float*)(ws + WS_SSQ) + (size_t)(row0 + s) * 32 + g * 4);
        const float rs = __builtin_amdgcn_rsqf(((sq[0] + sq[1]) + (sq[2] + sq[3])) * (1.0f / 128.0f) + EPS);
#pragma unroll
        for (int it = 0; it < 4; ++it) {
            const int c = cset + 4 * it;
            const u32x4 raw = *(const u32x4*)(H + (size_t)(row0 + s) * NIN + 512 + g * 128 + 8 * c);
            const float* vg = a.in[I_VG] + 8 * c;
            float f[8] = {bflo(raw.x), bfhi(raw.x), bflo(raw.y), bfhi(raw.y), bflo(raw.z), bfhi(raw.z), bflo(raw.w), bfhi(raw.w)};
#pragma unroll
            for (int i = 0; i < 8; ++i) img[(8 * c + i) * 136 + s] = f2bf(f[i] * rs * vg[i]);
        }
    }
    __syncthreads();
    const u16* W = (const u16*)(ws + WS_WSP) + (size_t)g * 128 * 128 + (size_t)(16 * wid + fr) * 128;
    f32x4 acc[8];
#pragma unroll
    for (int i = 0; i < 8; ++i) acc[i] = (f32x4){0.f, 0.f, 0.f, 0.f};
    const int nks = (16 * wid + 15) / 32 + 1;
    for (int ks = 0; ks < nks; ++ks) {
        const bf16x8 bw = *(const bf16x8*)(W + ks * 32 + 8 * fq);
#pragma unroll
        for (int i = 0; i < 8; ++i) {
            const bf16x8 av = *(const LAS bf16x8*)(img + (16 * i + fr) * 136 + ks * 32 + 8 * fq);
            acc[i] = __builtin_amdgcn_mfma_f32_16x16x32_bf16(av, bw, acc[i], 0, 0, 0);
        }
    }
    const int t = 16 * wid + fr;
    const float bias = a.in[I_BSP][g * 128 + t];
    u16* YO = (u16*)(ws + WS_YO);
#pragma unroll
    for (int i = 0; i < 8; ++i) {
        const int d = 16 * i + 4 * fq;
        const u32x2 uu = *(const u32x2*)(H + (size_t)(row0 + t) * NIN + g * 128 + d);
        const float y0 = bflo(uu.x) * (acc[i][0] + bias), y1 = bfhi(uu.x) * (acc[i][1] + bias), y2 = bflo(uu.y) * (acc[i][2] + bias), y3 = bfhi(uu.y) * (acc[i][3] + bias);
        u32x2 w; w.x = pk2(y0, y1); w.y = pk2(y2, y3);
        *(u32x2*)(YO + (size_t)(row0 + t) * 1536 + g * 128 + d) = w;
    }
}

DI void kvnorm(const Args& a) {
    unsigned char* ws = a.ws;
    const u16* H = (const u16*)(ws + WS_H); const float* SSQ = (const float*)(ws + WS_SSQ);
    const size_t gtid = (size_t)blockIdx.x * NT + otid(), gstride = (size_t)gridDim.x * NT;
    for (size_t idx = gtid; idx < (size_t)T * 24; idx += gstride) {
        const int row = (int)(idx / 24), c = (int)(idx % 24);
        const u16* src; u16* dst; const float* gain; float rs;
        if (c < 16) {
            const f32x4 sq = *(const f32x4*)(SSQ + (size_t)row * 32 + 24);
            rs = __builtin_amdgcn_rsqf(((sq[0] + sq[1]) + (sq[2] + sq[3])) * (1.0f / 128.0f) + EPS);
            src = H + (size_t)row * NIN + 1280 + 8 * c; dst = (u16*)(ws + WS_KVN) + (size_t)row * 128 + 8 * c; gain = a.in[I_KVG] + 8 * c;
        } else {
            const int cc = c - 16;
            rs = __builtin_amdgcn_rsqf((SSQ[(size_t)row * 32 + 28] + SSQ[(size_t)row * 32 + 29]) * (1.0f / 64.0f) + EPS);
            src = H + (size_t)row * NIN + 1408 + 8 * cc; dst = (u16*)(ws + WS_KIN) + (size_t)row * 64 + 8 * cc; gain = a.in[I_KIG] + 8 * cc;
        }
        const u32x4 raw = *(const u32x4*)src;
        u32x4 w;
        w.x = pk2(bflo(raw.x) * rs * gain[0], bfhi(raw.x) * rs * gain[1]); w.y = pk2(bflo(raw.y) * rs * gain[2], bfhi(raw.y) * rs * gain[3]);
        w.z = pk2(bflo(raw.z) * rs * gain[4], bfhi(raw.z) * rs * gain[5]); w.w = pk2(bflo(raw.w) * rs * gain[6], bfhi(raw.w) * rs * gain[7]);
        *(u32x4*)dst = w;
    }
}

constexpr int P3_ROWS = 0, P3_HIST = 131072, P3_LIST = 147456;
DI unsigned f2key(float f) { const unsigned u = __float_as_uint(f); return (u & 0x80000000u) ? ~u : (u | 0x80000000u); }
DI int wave_incl_scan(int v, int lane) {
#pragma unroll
    for (int o = 1; o < 64; o <<= 1) { const int t = __shfl_up(v, o); if (lane >= o) v += t; }
    return v;
}
DI int wave_suffix_scan(int v, int lane) {
#pragma unroll
    for (int o = 1; o < 64; o <<= 1) { const int t = __shfl_down(v, o); if (lane + o < 64) v += t; }
    return v;
}
DI unsigned pk_gt(unsigned kw, unsigned xw, unsigned one) {
    unsigned d, m;
    asm("v_pk_sub_u16 %0, %1, %2 clamp" : "=v"(d) : "v"(kw), "v"(xw));
    asm("v_pk_min_u16 %0, %1, %2" : "=v"(m) : "v"(d), "v"(one));
    return m;
}
DI unsigned pk_subs(unsigned kw, unsigned xw) { unsigned d; asm("v_pk_sub_u16 %0, %1, %2 clamp" : "=v"(d) : "v"(kw), "v"(xw)); return d; }
DI unsigned pk_min1(unsigned d, unsigned one) { unsigned m; asm("v_pk_min_u16 %0, %1, %2" : "=v"(m) : "v"(d), "v"(one)); return m; }
DI unsigned pk_add(unsigned a, unsigned b) { unsigned r; asm("v_pk_add_u16 %0, %1, %2" : "=v"(r) : "v"(a), "v"(b)); return r; }
DI int wave_sum(int v) {
    v += __builtin_amdgcn_update_dpp(0, v, 0xB1, 0xf, 0xf, false);
    v += __builtin_amdgcn_update_dpp(0, v, 0x4E, 0xf, 0xf, false);
    v += __builtin_amdgcn_update_dpp(0, v, 0x141, 0xf, 0xf, false);
    v += __builtin_amdgcn_update_dpp(0, v, 0x140, 0xf, 0xf, false);
    return __builtin_amdgcn_readlane(v, 0) + __builtin_amdgcn_readlane(v, 16) + __builtin_amdgcn_readlane(v, 32) + __builtin_amdgcn_readlane(v, 48);
}
DI int rowaddr(int p) { return (p & ~511) | ((p & 63) << 3) | ((p >> 6) & 7); }
typedef unsigned short us2_t __attribute__((ext_vector_type(2)));
DI unsigned dot2acc(unsigned flags, unsigned wts, unsigned acc) { return __builtin_amdgcn_udot2(__builtin_bit_cast(us2_t, flags), __builtin_bit_cast(us2_t, wts), acc, false); }
DI void select_top16(LAS u16* row, LAS u16* list, int N, int lane) {
    const int Nup = (N + 511) & ~511, niter = Nup >> 9;
    for (int p = N + lane; p < Nup; p += 64) row[rowaddr(p)] = (u16)0;
    wave_lds_sync();
    u32x4 kr[16];
#pragma unroll
    for (int i = 0; i < 16; ++i) { kr[i] = (u32x4){0u, 0u, 0u, 0u}; if (i < niter) kr[i] = *(LAS const u32x4*)(row + i * 512 + lane * 8); }
    const unsigned one = 0x00010001u;
    auto count_gt = [&](unsigned x) -> int {
        const unsigned xw = x | (x << 16);
        unsigned acc = 0u, acc1 = 0u, acc2 = 0u, acc3 = 0u;
#pragma unroll
        for (int c = 0; c < 4; ++c) {
            if (4 * c < niter) {
                unsigned d[16];
#pragma unroll
                for (int i = 0; i < 4; ++i) { d[4 * i] = pk_subs(kr[4 * c + i].x, xw); d[4 * i + 1] = pk_subs(kr[4 * c + i].y, xw); d[4 * i + 2] = pk_subs(kr[4 * c + i].z, xw); d[4 * i + 3] = pk_subs(kr[4 * c + i].w, xw); }
#pragma unroll
                for (int i = 0; i < 16; ++i) d[i] = pk_min1(d[i], one);
#pragma unroll
                for (int i = 0; i < 16; i += 4) { acc = dot2acc(d[i], one, acc); acc1 = dot2acc(d[i + 1], one, acc1); acc2 = dot2acc(d[i + 2], one, acc2); acc3 = dot2acc(d[i + 3], one, acc3); }
            }
        }
        return wave_sum((int)((acc + acc1) + (acc2 + acc3)));
    };
    unsigned T = 0u; int cge = Nup;
#pragma unroll 1
    for (int bit = 15; bit >= 0; --bit) {
        const unsigned cand = T | (1u << bit);
        const int cnt = count_gt(cand - 1u);
        if (cnt >= 256) { T = cand; cge = cnt; }
    }
    auto build = [&](unsigned x, unsigned (&M)[4]) {
        const unsigned xw = x | (x << 16);
#pragma unroll
        for (int c = 0; c < 4; ++c) {
            M[c] = 0u;
            if (4 * c < niter) {
#pragma unroll
                for (int i = 4 * c; i < 4 * c + 4; ++i) {
                    unsigned byte = dot2acc(pk_gt(kr[i].x, xw, one), 0x00020001u, 0u);
                    byte = dot2acc(pk_gt(kr[i].y, xw, one), 0x00080004u, byte);
                    byte = dot2acc(pk_gt(kr[i].z, xw, one), 0x00200010u, byte);
                    byte = dot2acc(pk_gt(kr[i].w, xw, one), 0x00800040u, byte);
                    M[c] |= byte << (8 * (i & 3));
                }
            }
        }
    };
    unsigned M[4];
    build(T - 1u, M);
    if (cge != 256) {
        unsigned G[4]; build(T, G);
        unsigned E[4];
#pragma unroll
        for (int c = 0; c < 4; ++c) E[c] = M[c] & ~G[c];
        const int need = 256 - (cge - wave_sum((int)(__builtin_popcount(E[0]) + __builtin_popcount(E[1]) + __builtin_popcount(E[2]) + __builtin_popcount(E[3]))));
        auto below = [&](int B, int c) -> unsigned { const int nb = B - 32 * c; return nb <= 0 ? 0u : (nb >= 32 ? 0xffffffffu : ((1u << nb) - 1u)); };
        auto ties_below = [&](int B) -> int {
            return wave_sum((int)(__builtin_popcount(E[0] & below(B, 0)) + __builtin_popcount(E[1] & below(B, 1)) + __builtin_popcount(E[2] & below(B, 2)) + __builtin_popcount(E[3] & below(B, 3))));
        };
        int lo = 0, hi = 127;
#pragma unroll 1
        while (lo < hi) { const int mid = (lo + hi) >> 1; if (ties_below(mid + 1) >= need) hi = mid; else lo = mid + 1; }
        const int Bs = lo, r = need - ties_below(Bs);
        const unsigned ew = Bs < 32 ? E[0] : (Bs < 64 ? E[1] : (Bs < 96 ? E[2] : E[3]));
        const bool tb = ((ew >> (Bs & 31)) & 1u) != 0u;
        const unsigned long long em = __ballot(tb);
        const bool take_row = tb && __builtin_popcountll(em & ((1ull << lane) - 1ull)) < r;
#pragma unroll
        for (int c = 0; c < 4; ++c) {
            unsigned tk = E[c] & below(Bs, c);
            if ((Bs >> 5) == c && take_row) tk |= 1u << (Bs & 31);
            M[c] = G[c] | tk;
        }
    }
    const int kl = __builtin_popcount(M[0]) + __builtin_popcount(M[1]) + __builtin_popcount(M[2]) + __builtin_popcount(M[3]);
    int wp = wave_incl_scan(kl, lane) - kl;
#pragma unroll
    for (int c = 0; c < 4; ++c) {
        unsigned m = M[c];
        while (m) { const int b = __builtin_ctz(m); list[wp] = (u16)((32 * c + b) * 64 + lane); ++wp; m &= m - 1u; }
    }
}

DI void dsa_phase(const Args& a, LAS unsigned char* lds) {
    unsigned char* ws = a.ws;
    const int tid = otid(), wid = __builtin_amdgcn_readfirstlane(tid >> 6), lane = tid & 63, fr = lane & 15, fq = lane >> 4;
    const u16* QI = (const u16*)(ws + WS_QI); const u16* KIN = (const u16*)(ws + WS_KIN); const u16* KVN = (const u16*)(ws + WS_KVN);
    const u16* Q = (const u16*)(ws + WS_Q); const float* WI = (const float*)(ws + WS_WI); u16* YO = (u16*)(ws + WS_YO);
    LAS u16* rows = (LAS u16*)(lds + P3_ROWS);
    for (int gi = blockIdx.x; gi < T / 8; gi += gridDim.x) {
        const int b = gi & 3, t0 = S - 8 - 8 * (gi >> 2);
        const size_t brow = (size_t)b * S;
        const int ntile = (t0 + 8 + 15) >> 4;
        __syncthreads();
        {
            bf16x8 qa[2][2]; f32x4 wi[2];
#pragma unroll
            for (int rg = 0; rg < 2; ++rg) {
#pragma unroll
                for (int ks = 0; ks < 2; ++ks) qa[rg][ks] = *(const bf16x8*)(QI + (brow + t0 + 4 * rg + (fr >> 2)) * 256 + (fr & 3) * 64 + ks * 32 + 8 * fq);
                wi[rg] = *(const f32x4*)(WI + (brow + t0 + 4 * rg + fq) * 4);
            }
            auto ldk = [&](bf16x8 (&kf)[4][2], int jt0) {
#pragma unroll
                for (int u = 0; u < 4; ++u) {
                    const int jt = (jt0 + 8 * u) < ntile ? (jt0 + 8 * u) : (ntile - 1);
                    const u16* kp = KIN + (brow + jt * 16 + fr) * 64 + 8 * fq;
                    kf[u][0] = *(const bf16x8*)kp; kf[u][1] = *(const bf16x8*)(kp + 32);
                }
            };
            auto cmpk = [&](const bf16x8 (&kf)[4][2], int jt0) {
#pragma unroll
                for (int u = 0; u < 4; ++u) {
                    const int jt = jt0 + 8 * u;
                    if (jt < ntile) {
#pragma unroll
                        for (int rg = 0; rg < 2; ++rg) {
                            f32x4 d = {0.f, 0.f, 0.f, 0.f};
                            d = __builtin_amdgcn_mfma_f32_16x16x32_bf16(qa[rg][0], kf[u][0], d, 0, 0, 0);
                            d = __builtin_amdgcn_mfma_f32_16x16x32_bf16(qa[rg][1], kf[u][1], d, 0, 0, 0);
                            const float sc = ((fmaxf(d[0], 0.f) * wi[rg][0] + fmaxf(d[1], 0.f) * wi[rg][1]) + fmaxf(d[2], 0.f) * wi[rg][2]) + fmaxf(d[3], 0.f) * wi[rg][3];
                            rows[(4 * rg + fq) * 8192 + rowaddr(jt * 16 + fr)] = (u16)(f2key(sc) >> 16);
                        }
                    }
                }
            };
            bf16x8 kA[4][2], kB[4][2];
            if (wid < ntile) ldk(kA, wid);
            for (int jt0 = wid; jt0 < ntile; jt0 += 64) {
                const bool hasB = jt0 + 32 < ntile;
                if (hasB) ldk(kB, jt0 + 32);
                cmpk(kA, jt0);
                if (hasB) { if (jt0 + 64 < ntile) ldk(kA, jt0 + 64); cmpk(kB, jt0 + 32); }
            }
        }
        __syncthreads();
        {
            const int q = wid, t = t0 + q, N = t + 1;
            LAS u16* row = rows + q * 8192;
            LAS u16* list = (LAS u16*)(lds + P3_LIST + q * 512);
            int cnt;
            if (N <= 256) { for (int p = lane; p < 256; p += 64) list[p] = p < N ? (u16)p : (u16)0; cnt = N; }
            else { select_top16(row, list, N, lane); cnt = 256; }
            wave_lds_sync();
            bf16x8 qf[4];
            {
                const int head = fr & 7;
                const u16* qrow = Q + (brow + t) * 1024 + head * 128;
                float f[4][8]; float ss = 0.f;
#pragma unroll
                for (int ks = 0; ks < 4; ++ks) {
                    const u32x4 raw = *(const u32x4*)(qrow + ks * 32 + 8 * fq);
                    f[ks][0] = bflo(raw.x); f[ks][1] = bfhi(raw.x); f[ks][2] = bflo(raw.y); f[ks][3] = bfhi(raw.y); f[ks][4] = bflo(raw.z); f[ks][5] = bfhi(raw.z); f[ks][6] = bflo(raw.w); f[ks][7] = bfhi(raw.w);
#pragma unroll
                    for (int j = 0; j < 8; ++j) ss += f[ks][j] * f[ks][j];
                }
                ss += __shfl_xor(ss, 16); ss += __shfl_xor(ss, 32);
                const float rq = __builtin_amdgcn_rsqf(ss * (1.0f / 128.0f) + EPS) * 0.08838834764831845f;
#pragma unroll
                for (int ks = 0; ks < 4; ++ks) {
                    const float* qg = a.in[I_QNG] + ks * 32 + 8 * fq;
                    u32x4 w;
                    w.x = pk2(f[ks][0] * rq * qg[0], f[ks][1] * rq * qg[1]); w.y = pk2(f[ks][2] * rq * qg[2], f[ks][3] * rq * qg[3]);
                    w.z = pk2(f[ks][4] * rq * qg[4], f[ks][5] * rq * qg[5]); w.w = pk2(f[ks][6] * rq * qg[6], f[ks][7] * rq * qg[7]);
                    qf[ks] = __builtin_bit_cast(bf16x8, w);
                }
            }
            LAS unsigned char* img = (LAS unsigned char*)row;
            const int nsteps = (cnt + 31) >> 5;
            f32x4 oacc[8];
#pragma unroll
            for (int i = 0; i < 8; ++i) oacc[i] = (f32x4){0.f, 0.f, 0.f, 0.f};
            float mrun = -3.0e38f, lpart = 0.f;
            auto issue = [&](u32x4 (&pf)[8], int pp) {
#pragma unroll
                for (int it = 0; it < 8; ++it) { const int piece = it * 64 + lane; const unsigned key = list[pp * 32 + (piece >> 4)]; pf[it] = *(const u32x4*)(KVN + (brow + key) * 128 + 8 * (piece & 15)); }
            };
            auto step = [&](u32x4 (&pf)[8], int pp) {
#pragma unroll
                for (int it = 0; it < 8; ++it) { const int piece = it * 64 + lane; *(LAS u32x4*)(img + (piece >> 4) * 288 + (piece & 15) * 16) = pf[it]; }
                if (pp + 1 < nsteps) issue(pf, pp + 1);
                wave_lds_sync();
                __builtin_amdgcn_sched_barrier(0);
                f32x4 sa = {0.f, 0.f, 0.f, 0.f}, sb = {0.f, 0.f, 0.f, 0.f};
#pragma unroll
                for (int ks = 0; ks < 4; ++ks) {
                    const bf16x8 a0 = *(LAS const bf16x8*)(img + fr * 288 + (ks * 32 + 8 * fq) * 2), a1 = *(LAS const bf16x8*)(img + (16 + fr) * 288 + (ks * 32 + 8 * fq) * 2);
                    sa = __builtin_amdgcn_mfma_f32_16x16x32_bf16(a0, qf[ks], sa, 0, 0, 0); sb = __builtin_amdgcn_mfma_f32_16x16x32_bf16(a1, qf[ks], sb, 0, 0, 0);
                }
                const int pb0 = pp * 32 + 4 * fq;
#pragma unroll
                for (int r = 0; r < 4; ++r) { if (pb0 + r >= cnt) sa[r] = -3.0e38f; if (pb0 + 16 + r >= cnt) sb[r] = -3.0e38f; }
                float mx = fmaxf(fmaxf(fmaxf(sa[0], sa[1]), fmaxf(sa[2], sa[3])), fmaxf(fmaxf(sb[0], sb[1]), fmaxf(sb[2], sb[3])));
                mx = fmaxf(mx, __shfl_xor(mx, 16)); mx = fmaxf(mx, __shfl_xor(mx, 32));
                const float mnew = fmaxf(mrun, mx), alpha = __expf(mrun - mnew);
                mrun = mnew;
                float ps = 0.f;
#pragma unroll
                for (int r = 0; r < 4; ++r) { sa[r] = __expf(sa[r] - mnew); sb[r] = __expf(sb[r] - mnew); ps += sa[r] + sb[r]; }
                lpart = lpart * alpha + ps;
#pragma unroll
                for (int cb = 0; cb < 8; ++cb) oacc[cb] *= alpha;
                u32x4 pw; pw.x = pk2(sa[0], sa[1]); pw.y = pk2(sa[2], sa[3]); pw.z = pk2(sb[0], sb[1]); pw.w = pk2(sb[2], sb[3]);
                const bf16x8 pb = __builtin_bit_cast(bf16x8, pw);
#pragma unroll
                for (int cb = 0; cb < 8; ++cb) {
                    const s16x4 r0 = __builtin_amdgcn_ds_read_tr16_b64_v4i16((LAS s16x4*)(img + (4 * fq + (fr >> 2)) * 288 + (cb * 16 + 4 * (fr & 3)) * 2));
                    const s16x4 r1 = __builtin_amdgcn_ds_read_tr16_b64_v4i16((LAS s16x4*)(img + (16 + 4 * fq + (fr >> 2)) * 288 + (cb * 16 + 4 * (fr & 3)) * 2));
                    const bf16x8 av = {r0[0], r0[1], r0[2], r0[3], r1[0], r1[1], r1[2], r1[3]};
                    oacc[cb] = __builtin_amdgcn_mfma_f32_16x16x32_bf16(av, pb, oacc[cb], 0, 0, 0);
                    if (cb == 3) __builtin_amdgcn_sched_barrier(0);
                }
                wave_lds_sync();
            };
            u32x4 pf0[8];
            issue(pf0, 0);
#pragma unroll 1
            for (int pp = 0; pp < nsteps; ++pp) step(pf0, pp);
            float lsum = lpart; lsum += __shfl_xor(lsum, 16); lsum += __shfl_xor(lsum, 32);
            const float inv = __builtin_amdgcn_rcpf(lsum);
            if (fr < 8) {
                u16* orow = YO + (brow + t) * 1536 + 512 + fr * 128 + 4 * fq;
#pragma unroll
                for (int cb = 0; cb < 8; ++cb) { u32x2 w; w.x = pk2(oacc[cb][0] * inv, oacc[cb][1] * inv); w.y = pk2(oacc[cb][2] * inv, oacc[cb][3] * inv); *(u32x2*)(orow + cb * 16) = w; }
            }
        }
    }
}

constexpr int P6_WT = 0, P6_LCNT = 131072, P6_BASE = 131072 + 128, P6_RI = 131072 + 256;
DI void router_phase(const Args& a, LAS unsigned char* lds) {
    unsigned char* ws = a.ws;
    const int tid = otid(), wid = tid >> 6, lane = tid & 63;
    LAS float* WT = (LAS float*)(lds + P6_WT); LAS int* lcnt = (LAS int*)(lds + P6_LCNT); LAS int* lbase = (LAS int*)(lds + P6_BASE); LAS int* RI = (LAS int*)(lds + P6_RI);
    const float* WR = (const float*)(ws + WS_WR);
    unsigned* CNT = (unsigned*)(ws + WS_CTL);
    __syncthreads();
    for (int i = tid; i < 32 * 1024 / 4; i += NT) *(LAS f32x4*)(WT + 4 * i) = *(const f32x4*)(WR + 4 * i);
    for (int rg = blockIdx.x; rg < T / 128; rg += gridDim.x) {
        if (tid < 32) lcnt[tid] = 0;
        __syncthreads();
        for (int it = 0; it < 16; ++it) {
            const int rl = wid + 8 * it, row = rg * 128 + rl;
            const float* xr = a.out + (size_t)row * 1024;
            f32x4 xv[4]; float ss = 0.f;
#pragma unroll
            for (int i = 0; i < 4; ++i) { xv[i] = *(const f32x4*)(xr + i * 256 + lane * 4); ss += (xv[i][0] * xv[i][0] + xv[i][1] * xv[i][1]) + (xv[i][2] * xv[i][2] + xv[i][3] * xv[i][3]); }
#pragma unroll
            for (int o = 32; o >= 1; o >>= 1) ss += __shfl_xor(ss, o);
            const float rs = __builtin_amdgcn_rsqf(ss * (1.0f / 1024.0f) + EPS);
            u16* xn = (u16*)(ws + WS_XN2) + (size_t)row * 1024;
#pragma unroll
            for (int i = 0; i < 4; ++i) { u32x2 w; w.x = pk2(xv[i][0] * rs, xv[i][1] * rs); w.y = pk2(xv[i][2] * rs, xv[i][3] * rs); *(u32x2*)(xn + i * 256 + lane * 4) = w; }
            float acc[32];
#pragma unroll
            for (int e = 0; e < 32; ++e) {
                float s = 0.f;
#pragma unroll
                for (int i = 0; i < 4; ++i) { const f32x4 w = *(LAS const f32x4*)(WT + e * 1024 + i * 256 + lane * 4); s += (xv[i][0] * w[0] + xv[i][1] * w[1]) + (xv[i][2] * w[2] + xv[i][3] * w[3]); }
                acc[e] = s;
            }
            float v16[16], v8[8], v4[4], v2[2], v1;
            { const bool hi = (lane & 32) != 0;
#pragma unroll
              for (int e = 0; e < 16; ++e) { const float keep = hi ? acc[e + 16] : acc[e], send = hi ? acc[e] : acc[e + 16]; v16[e] = keep + __shfl_xor(send, 32); } }
            { const bool hi = (lane & 16) != 0;
#pragma unroll
              for (int e = 0; e < 8; ++e) { const float keep = hi ? v16[e + 8] : v16[e], send = hi ? v16[e] : v16[e + 8]; v8[e] = keep + __shfl_xor(send, 16); } }
            { const bool hi = (lane & 8) != 0;
#pragma unroll
              for (int e = 0; e < 4; ++e) { const float keep = hi ? v8[e + 4] : v8[e], send = hi ? v8[e] : v8[e + 4]; v4[e] = keep + __shfl_xor(send, 8); } }
            { const bool hi = (lane & 4) != 0;
#pragma unroll
              for (int e = 0; e < 2; ++e) { const float keep = hi ? v4[e + 2] : v4[e], send = hi ? v4[e] : v4[e + 2]; v2[e] = keep + __shfl_xor(send, 4); } }
            { const bool hi = (lane & 2) != 0; const float keep = hi ? v2[1] : v2[0], send = hi ? v2[0] : v2[1]; v1 = keep + __shfl_xor(send, 2); }
            v1 += __shfl_xor(v1, 1);
            const int myexp = lane >> 1;
            float logit = v1 * rs + a.in[I_BR][myexp];
            float tv[4]; int ti[4];
#pragma unroll
            for (int k = 0; k < 4; ++k) {
                float bv = logit; int bi = myexp;
#pragma unroll
                for (int o = 32; o >= 1; o >>= 1) { const float ov = __shfl_xor(bv, o); const int oi = __shfl_xor(bi, o); if (ov > bv || (ov == bv && oi < bi)) { bv = ov; bi = oi; } }
                tv[k] = bv; ti[k] = bi;
                if (myexp == bi) logit = -3.0e38f;
            }
            const float e1 = __expf(tv[1] - tv[0]), e2 = __expf(tv[2] - tv[0]), e3 = __expf(tv[3] - tv[0]);
            const float inv = 1.0f / (1.0f + e1 + e2 + e3);
            if (lane < 4) {
                const int e = lane == 0 ? ti[0] : (lane == 1 ? ti[1] : (lane == 2 ? ti[2] : ti[3]));
                const float gt = (lane == 0 ? 1.0f : (lane == 1 ? e1 : (lane == 2 ? e2 : e3))) * inv;
                const int ls = __hip_atomic_fetch_add(lcnt + e, 1, __ATOMIC_RELAXED, __HIP_MEMORY_SCOPE_WORKGROUP);
                RI[(rl * 4 + lane) * 3 + 0] = e; RI[(rl * 4 + lane) * 3 + 1] = ls; RI[(rl * 4 + lane) * 3 + 2] = __float_as_int(gt);
            }
        }
        __syncthreads();
        if (tid < 32) lbase[tid] = (int)__hip_atomic_fetch_add(CNT + tid, (unsigned)lcnt[tid], __ATOMIC_RELAXED, __HIP_MEMORY_SCOPE_AGENT);
        __syncthreads();
        {
            const int rl = tid >> 2, k = tid & 3, row = rg * 128 + rl;
            const int e = RI[tid * 3 + 0], slot = lbase[e] + RI[tid * 3 + 1]; const float gt = __int_as_float(RI[tid * 3 + 2]);
            ((int*)(ws + WS_LTOK))[(size_t)e * ECAP + slot] = row;
            ((float*)(ws + WS_LGATE))[(size_t)e * ECAP + slot] = gt;
            ((unsigned*)(ws + WS_ROUTE))[(size_t)row * 4 + k] = ((unsigned)e << 16) | (unsigned)slot;
        }
        __syncthreads();
    }
}

DI void combine_phase(const Args& a, LAS unsigned char* lds) {
    unsigned char* ws = a.ws;
    LAS const int* tab = (LAS const int*)(lds + MOE_TAB);
    const int tid = otid(), wid = tid >> 6, lane = tid & 63;
    const u16* YB = (const u16*)(ws + WS_YB); const unsigned* ROUTE = (const unsigned*)(ws + WS_ROUTE);
    for (int row = blockIdx.x * 8 + wid; row < T; row += gridDim.x * 8) {
        size_t pos[4];
#pragma unroll
        for (int k = 0; k < 4; ++k) { const unsigned r = ROUTE[(size_t)row * 4 + k]; const int e = (int)(r >> 16), slot = (int)(r & 0xffffu); pos[k] = (size_t)tab[e] * 256 + slot; }
        float* orow = a.out + (size_t)row * 1024;
#pragma unroll
        for (int i = 0; i < 4; ++i) {
            f32x4 v = *(const f32x4*)(orow + i * 256 + lane * 4);
#pragma unroll
            for (int k = 0; k < 4; ++k) { const u32x2 y = *(const u32x2*)(YB + pos[k] * 1024 + i * 256 + lane * 4); v[0] += bflo(y.x); v[1] += bfhi(y.x); v[2] += bflo(y.y); v[3] += bfhi(y.y); }
            *(f32x4*)(orow + i * 256 + lane * 4) = v;
        }
    }
}

__global__ void __launch_bounds__(NT, 2) fwd(Args a) {
    extern __shared__ __attribute__((aligned(16))) unsigned char lds_raw[];
    LAS unsigned char* lds = (LAS unsigned char*)lds_raw;
    cg::grid_group grid = cg::this_grid();
    unsigned char* ws = a.ws;
    const int G = gridDim.x, c = blockIdx.x;

    phase0(a, lds);
    grid.sync();
    {
        g8::PlainSched s; s.Abase = (const char*)(ws + WS_XB); s.Bbase = (const char*)(ws + WS_WIN); s.lda = 1024; s.ldb = 1024; s.K = 1024; s.nM = T / 256; s.nN = NIN / 256; s.G = G; s.c = c;
        EpiIn e; e.H = (u16*)(ws + WS_H); e.rs1 = (const float*)(ws + WS_RS1); e.SSQ = (float*)(ws + WS_SSQ); e.WI = (float*)(ws + WS_WI);
        g8::gemm_phase(lds, s, e);
    }
    grid.sync();
    {
        g8::PlainSched s; s.Abase = (const char*)(ws + WS_H) + 1024 * 2; s.Bbase = (const char*)(ws + WS_WQ); s.lda = NIN; s.ldb = 256; s.K = 256; s.nM = T / 256; s.nN = 5; s.G = G; s.c = c;
        EpiQ e; e.Q = (u16*)(ws + WS_Q); e.QI = (u16*)(ws + WS_QI); e.SSQ = (const float*)(ws + WS_SSQ);
        g8::gemm_phase(lds, s, e);
        for (int u = c; u < 1024; u += G) gmlp_unit(a, lds, u);
        kvnorm(a);
    }
    grid.sync();
    dsa_phase(a, lds);
    grid.sync();
    {
        g8::PlainSched s; s.Abase = (const char*)(ws + WS_YO); s.Bbase = (const char*)(ws + WS_WCAT); s.lda = 1536; s.ldb = 1536; s.K = 512; s.nM = T / 256; s.nN = 4; s.G = G; s.c = c;
        EpiMrg<0> e0; e0.OUT = (u16*)(ws + WS_TMP); e0.TMP = nullptr; e0.H = (const u16*)(ws + WS_H);
        g8::gemm_phase(lds, s, e0);
        s.Abase = (const char*)(ws + WS_YO) + 512 * 2; s.Bbase = (const char*)(ws + WS_WCAT) + 512 * 2; s.K = 1024;
        EpiMrg<1> e1; e1.OUT = (u16*)(ws + WS_MRG); e1.TMP = (const u16*)(ws + WS_TMP); e1.H = (const u16*)(ws + WS_H);
        g8::gemm_phase(lds, s, e1);
    }
    grid.sync();
    {
        g8::PlainSched s; s.Abase = (const char*)(ws + WS_MRG); s.Bbase = (const char*)(ws + WS_WOUT); s.lda = 1024; s.ldb = 1024; s.K = 1024; s.nM = T / 256; s.nN = 4; s.G = G; s.c = c;
        EpiOut e; e.out = a.out; e.x = a.in[I_X];
        g8::gemm_phase(lds, s, e);
    }
    grid.sync();
    router_phase(a, lds);
    grid.sync();
    moe_table(lds, (const unsigned*)(ws + WS_CTL));
    {
        MoeSched<8, true> s; s.Abase = (const char*)(ws + WS_XN2); s.Wbase = (const char*)(ws + WS_WE1); s.LTOK = (const int*)(ws + WS_LTOK); s.tab = (LAS const int*)(lds + MOE_TAB);
        s.lda = 1024; s.ldb = 1024; s.K = 1024; s.G = G; s.c = c; s.wstride = (size_t)2048 * 1024 * 2;
        EpiMoe1 e; e.ACT = (u16*)(ws + WS_ACT); e.b1 = a.in[I_BE1];
        g8::gemm_phase(lds, s, e);
    }
    grid.sync();
    {
        MoeSched<4, false> s; s.Abase = (const char*)(ws + WS_ACT); s.Wbase = (const char*)(ws + WS_WE2); s.LTOK = nullptr; s.tab = (LAS const int*)(lds + MOE_TAB);
        s.lda = 1024; s.ldb = 1024; s.K = 1024; s.G = G; s.c = c; s.wstride = (size_t)1024 * 1024 * 2;
        EpiMoe2 e; e.YB = (u16*)(ws + WS_YB); e.b2 = a.in[I_BE2]; e.LGATE = (const float*)(ws + WS_LGATE); e.tab = (LAS const int*)(lds + MOE_TAB);
        g8::gemm_phase(lds, s, e);
    }
    grid.sync();
    combine_phase(a, lds);
}

extern "C" void kernel_launch(void* const* d_in, const int* in_sizes, int n_in, void* d_out, int out_size, void* d_ws, size_t ws_size, hipStream_t stream) {
    static int grid = 0;
    if (grid == 0) {
        int dev = 0, cus = 0, per_cu = 0;
        if (n_in != 23 || out_size != T * Dm || ws_size < WS_END) { fprintf(stderr, "kernel_launch: unexpected problem (n_in %d, out %d, ws %zu < %zu)\n", n_in, out_size, ws_size, (size_t)WS_END); grid = -1; return; }
        if (hipGetDevice(&dev) != hipSuccess || hipDeviceGetAttribute(&cus, hipDeviceAttributeMultiprocessorCount, dev) != hipSuccess) { grid = -1; return; }
        if (hipFuncSetAttribute((const void*)fwd, hipFuncAttributeMaxDynamicSharedMemorySize, LDS_BYTES) != hipSuccess) { fprintf(stderr, "hipFuncSetAttribute failed\n"); grid = -1; return; }
        if (hipOccupancyMaxActiveBlocksPerMultiprocessor(&per_cu, (const void*)fwd, NT, LDS_BYTES) != hipSuccess || per_cu < 1) { fprintf(stderr, "occupancy query failed (%d)\n", per_cu); grid = -1; return; }
        grid = cus;
        fprintf(stderr, "kernel_launch: cus %d per_cu %d grid %d ws %zu need %zu\n", cus, per_cu, grid, ws_size, (size_t)WS_END);
    }
    if (grid < 0) return;
    Args a{};
    for (int i = 0; i < 23; ++i) a.in[i] = (const float*)d_in[i];
    a.out = (float*)d_out; a.ws = (unsigned char*)d_ws; a.mask = 0xffffffffu; a.pad = 0u;
    void* args[] = {&a};
    hipError_t e = hipLaunchCooperativeKernel((const void*)fwd, dim3(grid), dim3(NT), args, LDS_BYTES, stream);
    if (e != hipSuccess) fprintf(stderr, "cooperative launch failed: %s (grid %d)\n", hipGetErrorString(e), grid);
}
```

```cpp
#include <hip/hip_runtime.h>
#include <hip/hip_cooperative_groups.h>
#include <cstdio>
#include <cstdint>
namespace cg = cooperative_groups;

#define LAS __attribute__((address_space(3)))
#define DI __device__ __forceinline__
typedef unsigned short u16;
typedef short bf16x8 __attribute__((ext_vector_type(8)));
typedef short s16x4 __attribute__((ext_vector_type(4)));
typedef float f32x4 __attribute__((ext_vector_type(4)));
typedef float f32x2 __attribute__((ext_vector_type(2)));
typedef unsigned u32x4 __attribute__((ext_vector_type(4)));
typedef unsigned u32x2 __attribute__((ext_vector_type(2)));
typedef __bf16 bf2_t __attribute__((ext_vector_type(2)));

constexpr int NT = 512;
constexpr int LDS_BYTES = 155648;
constexpr int Dm = 1024, Bsz = 4, S = 8192, T = Bsz * S;
constexpr int NIN = 3584;
constexpr int NE = 32, ECAP = 32768, PPAD = 131072 + NE * 256;
constexpr float EPS = 1e-6f;

constexpr size_t MiB = 1024 * 1024;
constexpr size_t WS_CTL = 0;
constexpr size_t WS_BAR = 16384;
constexpr int LDS_BARST = LDS_BYTES - 16;
constexpr size_t WS_WIN = 64 * 1024;
constexpr size_t WS_WQ = WS_WIN + (size_t)NIN * 1024 * 2;
constexpr size_t WS_WSP = WS_WQ + 1280 * 256 * 2;
constexpr size_t WS_WCAT = WS_WSP + 4 * 128 * 128 * 2;
constexpr size_t WS_WOUT = WS_WCAT + 1024 * 1536 * 2;
constexpr size_t WS_WR = WS_WOUT + 1024 * 1024 * 2;
constexpr size_t WS_WE1 = WS_WR + 32 * 1024 * 4;
constexpr size_t WS_WE2 = WS_WE1 + (size_t)32 * 2048 * 1024 * 2;
constexpr size_t WS_RS1 = WS_WE2 + (size_t)32 * 1024 * 1024 * 2;
constexpr size_t WS_SSQ = WS_RS1 + (size_t)T * 4;
constexpr size_t WS_WI = WS_SSQ + (size_t)T * 32 * 4;
constexpr size_t WS_ROUTE = WS_WI + (size_t)T * 4 * 4;
constexpr size_t WS_LTOK = WS_ROUTE + (size_t)T * 4 * 4;
constexpr size_t WS_LGATE = WS_LTOK + (size_t)NE * ECAP * 4;
constexpr size_t WS_XN2 = WS_LGATE + (size_t)NE * ECAP * 4;
constexpr size_t WS_R0 = WS_XN2 + (size_t)T * 1024 * 2;
constexpr size_t WS_XB = WS_R0;
constexpr size_t WS_H = WS_XB + (size_t)T * 1024 * 2;
constexpr size_t WS_Q = WS_H + (size_t)T * NIN * 2;
constexpr size_t WS_QI = WS_Q + (size_t)T * 1024 * 2;
constexpr size_t WS_KVN = WS_QI + (size_t)T * 256 * 2;
constexpr size_t WS_KIN = WS_KVN + (size_t)T * 128 * 2;
constexpr size_t WS_YO = WS_KIN + (size_t)T * 64 * 2;
constexpr size_t WS_TMP = WS_YO + (size_t)T * 1536 * 2;
constexpr size_t WS_MRG = WS_TMP + (size_t)T * 1024 * 2;
constexpr size_t WS_R0END = WS_MRG + (size_t)T * 1024 * 2;
constexpr size_t WS_ACT = WS_XB;
constexpr size_t WS_YB = WS_Q;
static_assert(WS_ACT + (size_t)PPAD * 1024 * 2 <= WS_Q, "ACT overlaps YB");
static_assert(WS_YB + (size_t)PPAD * 1024 * 2 <= WS_R0END, "YB too large");
constexpr size_t WS_END = WS_R0END;

struct Args { const float* in[23]; float* out; unsigned char* ws; unsigned mask; unsigned pad; };
enum { I_X = 0, I_N1G, I_WIN, I_QLG, I_WUQ, I_QNG, I_KVG, I_WUV, I_WQI, I_KIG, I_VG, I_WSP, I_BSP, I_WPA, I_WPB, I_WOUT, I_N2G, I_WR, I_BR, I_WE1, I_BE1, I_WE2, I_BE2 };

DI unsigned pk2(float a, float b) { f32x2 v = {a, b}; bf2_t r = __builtin_convertvector(v, bf2_t); return __builtin_bit_cast(unsigned, r); }
DI float bflo(unsigned u) { return __uint_as_float(u << 16); }
DI float bfhi(unsigned u) { return __uint_as_float(u & 0xffff0000u); }
DI u16 f2bf(float f) { return (u16)(pk2(f, 0.f) & 0xffffu); }
DI float bf2f(u16 h) { return __uint_as_float(((unsigned)h) << 16); }
DI float sigmoidf_(float x) { return __builtin_amdgcn_rcpf(1.0f + __expf(-x)); }
DI float gelu_tanh(float x) { const float u = 1.5957691216057308f * (x + 0.044715f * x * x * x); return x * sigmoidf_(u); }
DI int otid() { int t = threadIdx.x; asm volatile("" : "+v"(t)); return t; }
DI void wave_lds_sync() { asm volatile("s_waitcnt lgkmcnt(0)" ::: "memory"); }

namespace g8 {
constexpr int BM = 256, BK = 64, HALF = 128, HTB = HALF * BK * 2, STAGE_BYTES = 8 * HTB, NXCD = 8, WGM = 8;
DI int lds_byte(int r, int c) { const int st = (r >> 4) * 2 + (c >> 5), rr = r & 15, cc = c & 31, ob = rr * 64 + cc * 2; return st * 1024 + (ob ^ (((ob >> 9) & 1) << 5)); }
DI void stage_rc(int b, int& R, int& C) { const int st = b / 1024, sb = b % 1024, swz = sb ^ (((sb >> 9) & 1) << 5); R = (st >> 1) * 16 + swz / 64; C = (st & 1) * 32 + (swz % 64) / 2; }

struct UnitD { const char* Bp; int pm, pn, e, rb; };

DI bool static_tile(int i, int G, int c, int nM, int nN, int& pm, int& pn) {
    const int nwg = nM * nN; const long L = (long)i * G + c; if (L >= nwg) return false;
    int wgid = (int)L; { const int q = nwg / NXCD, r = nwg % NXCD, xcd = wgid % NXCD, off = wgid / NXCD; wgid = (xcd < r ? xcd * (q + 1) : r * (q + 1) + (xcd - r) * q) + off; }
    const int nig = WGM * nN, gid = wgid / nig, fm = gid * WGM, gsz = (nM - fm) < WGM ? (nM - fm) : WGM;
    pm = fm + ((wgid % nig) % gsz); pn = (wgid % nig) / gsz; return true;
}

struct PlainSched {
    const char* Abase; const char* Bbase; int lda, ldb, K, nM, nN, G, c;
    DI bool next(int i, UnitD& u) const { int pm, pn; if (!static_tile(i, G, c, nM, nN, pm, pn)) return false; u.pm = pm; u.pn = pn; u.e = 0; u.rb = 0; u.Bp = Bbase + (size_t)pn * BM * ldb * 2; return true; }
    DI void a_offs(const UnitD& u, int R0, int C0, unsigned (&o)[2][2]) const {
#pragma unroll
        for (int h = 0; h < 2; ++h)
#pragma unroll
            for (int i = 0; i < 2; ++i) o[h][i] = (unsigned)(((size_t)(u.pm * BM + h * HALF + R0 + 64 * i) * lda + C0) * 2);
    }
};

template <class Epi, class Sched>
DI void gemm_phase(LAS unsigned char* lds, const Sched& S, const Epi& E) {
    const int tid = otid(), wid = __builtin_amdgcn_readfirstlane(tid >> 6), lane = tid & 63, wr = wid >> 2, wc = wid & 3, fr = lane & 15, fq = lane >> 4;
    const int nt = S.K / BK;
    int R0, C0; stage_rc(tid * 16, R0, C0);
    unsigned voffB[2];
#pragma unroll
    for (int i = 0; i < 2; ++i) voffB[i] = (unsigned)(((R0 + 64 * i) * S.ldb + C0) * 2);
    const size_t hstepB = (size_t)HALF * S.ldb * 2;
    const unsigned ldsw = (unsigned)wid * 1024u;
    const int aoff = lds_byte(wr * 64 + fr, fq * 8), boff = lds_byte(wc * 32 + fr, fq * 8);
    const char* Ab = S.Abase;
#define G8_SA(b, h) (((b) * 2 + (h)) * HTB)
#define G8_SB(b, h) ((4 + (b) * 2 + (h)) * HTB)
#define G8_STAGE_A(bufoff, offs, kb) do { _Pragma("unroll") for (int _i = 0; _i < 2; ++_i) \
        __builtin_amdgcn_global_load_lds((const unsigned*)(Ab + (size_t)(offs)[_i] + (size_t)(kb)), (LAS unsigned*)(lds + (bufoff) + ldsw + _i * 8192), 16, 0, 0); } while (0)
#define G8_STAGE_B(bufoff, gbase, kb) do { _Pragma("unroll") for (int _i = 0; _i < 2; ++_i) \
        __builtin_amdgcn_global_load_lds((const unsigned*)((gbase) + voffB[_i] + (size_t)(kb)), (LAS unsigned*)(lds + (bufoff) + ldsw + _i * 8192), 16, 0, 0); } while (0)
#define G8_LDA(dst, b, h) do { _Pragma("unroll") for (int m = 0; m < 4; ++m) _Pragma("unroll") for (int k = 0; k < 2; ++k) dst[m][k] = *(const LAS bf16x8*)(lds + G8_SA(b, h) + aoff + m * 2048 + k * 1024); } while (0)
#define G8_LDB(dst, b, h) do { _Pragma("unroll") for (int n = 0; n < 2; ++n) _Pragma("unroll") for (int k = 0; k < 2; ++k) dst[n][k] = *(const LAS bf16x8*)(lds + G8_SB(b, h) + boff + n * 2048 + k * 1024); } while (0)
#define G8_MMA(ai, bj, At, Bt) do { __builtin_amdgcn_s_setprio(1); _Pragma("unroll") for (int m = 0; m < 4; ++m) _Pragma("unroll") for (int n = 0; n < 2; ++n) _Pragma("unroll") for (int k = 0; k < 2; ++k) \
        acc[ai][bj][m][n] = __builtin_amdgcn_mfma_f32_16x16x32_bf16(Bt[n][k], At[m][k], acc[ai][bj][m][n], 0, 0, 0); __builtin_amdgcn_s_setprio(0); } while (0)
#define G8_WAIT_V(n) asm volatile("s_waitcnt vmcnt(" #n ")" ::: "memory")
#define G8_WAIT_L(n) asm volatile("s_waitcnt lgkmcnt(" #n ")" ::: "memory")
#define G8_BAR __builtin_amdgcn_s_barrier()
#define G8_SCHED __builtin_amdgcn_sched_barrier(0)
    UnitD cur, nxt; int ui = 0;
    if (!S.next(0, cur)) return;
    f32x4 acc[2][2][4][2];
#pragma unroll
    for (int a = 0; a < 2; ++a)
#pragma unroll
        for (int b = 0; b < 2; ++b)
#pragma unroll
            for (int m = 0; m < 4; ++m)
#pragma unroll
                for (int n = 0; n < 2; ++n) acc[a][b][m][n] = (f32x4){0.f, 0.f, 0.f, 0.f};
    bf16x8 At[4][2], B0[2][2], B1[2][2];
    unsigned cA[2][2];
    S.a_offs(cur, R0, C0, cA);
    const char* cB = cur.Bp;
    G8_STAGE_B(G8_SB(0, 0), cB, 0); G8_STAGE_A(G8_SA(0, 0), cA[0], 0); G8_STAGE_B(G8_SB(0, 1), cB + hstepB, 0); G8_STAGE_A(G8_SA(0, 1), cA[1], 0);
    if (wr == 1) G8_BAR;
    G8_WAIT_V(4); G8_BAR;
    G8_STAGE_B(G8_SB(1, 0), cB, 128); G8_STAGE_A(G8_SA(1, 0), cA[0], 128); G8_STAGE_B(G8_SB(1, 1), cB + hstepB, 128);
    G8_WAIT_V(6); G8_BAR;
    for (;;) {
        const bool has_next = S.next(ui + 1, nxt);
        const char* nB = has_next ? nxt.Bp : cB;
        for (int t = 0; t < nt; t += 2) {
            const bool last = (t == nt - 2);
            const unsigned k1 = (unsigned)(t + 1) * 128u;
            const unsigned k2 = last ? 0u : (unsigned)(t + 2) * 128u, k3 = k2 + 128u;
            unsigned c1[2] = {cA[1][0], cA[1][1]};
            if (last && has_next) S.a_offs(nxt, R0, C0, cA);
            const char* b2 = last ? nB : cB;
            G8_LDB(B0, 0, 0); G8_SCHED; G8_LDA(At, 0, 0); G8_STAGE_A(G8_SA(1, 1), c1, k1);
            G8_WAIT_L(8); G8_BAR; G8_WAIT_L(0); G8_MMA(0, 0, At, B0); G8_BAR; G8_SCHED;
            G8_LDB(B1, 0, 1); G8_STAGE_B(G8_SB(0, 0), b2, k2);
            G8_BAR; G8_WAIT_L(0); G8_MMA(0, 1, At, B1); G8_BAR;
            G8_LDA(At, 0, 1); G8_STAGE_A(G8_SA(0, 0), cA[0], k2);
            G8_BAR; G8_WAIT_L(0); G8_MMA(1, 0, At, B0); G8_BAR; G8_SCHED;
            G8_STAGE_B(G8_SB(0, 1), b2 + hstepB, k2);
            G8_WAIT_V(6); G8_BAR; G8_MMA(1, 1, At, B1); G8_BAR;
            G8_LDB(B0, 1, 0); G8_SCHED; G8_LDA(At, 1, 0); G8_STAGE_A(G8_SA(0, 1), cA[1], k2);
            G8_WAIT_L(8); G8_BAR; G8_WAIT_L(0); G8_MMA(0, 0, At, B0); G8_BAR; G8_SCHED;
            G8_LDB(B1, 1, 1); G8_STAGE_B(G8_SB(1, 0), b2, k3);
            G8_BAR; G8_WAIT_L(0); G8_MMA(0, 1, At, B1); G8_BAR;
            G8_LDA(At, 1, 1); G8_STAGE_A(G8_SA(1, 0), cA[0], k3);
            G8_BAR; G8_WAIT_L(0); G8_MMA(1, 0, At, B0); G8_BAR; G8_SCHED;
            G8_STAGE_B(G8_SB(1, 1), b2 + hstepB, k3);
            G8_WAIT_V(6); G8_BAR; G8_MMA(1, 1, At, B1); G8_BAR;
        }
        E(acc, cur, wr, wc, fr, fq);
        if (!has_next) break;
#pragma unroll
        for (int a = 0; a < 2; ++a)
#pragma unroll
            for (int b = 0; b < 2; ++b)
#pragma unroll
                for (int m = 0; m < 4; ++m)
#pragma unroll
                    for (int n = 0; n < 2; ++n) acc[a][b][m][n] = (f32x4){0.f, 0.f, 0.f, 0.f};
        cur = nxt; cB = nB; ++ui;
    }
    G8_WAIT_V(0);
    if (wr == 0) G8_BAR;
    G8_BAR;
#undef G8_SA
#undef G8_SB
#undef G8_STAGE_A
#undef G8_STAGE_B
#undef G8_LDA
#undef G8_LDB
#undef G8_MMA
#undef G8_WAIT_V
#undef G8_WAIT_L
#undef G8_BAR
#undef G8_SCHED
}
}
using g8::UnitD;
typedef f32x4 Acc[2][2][4][2];

struct EpiIn {
    u16* H; const float* rs1; float* SSQ; float* WI;
    DI void operator()(const Acc& acc, const UnitD& u, int wr, int wc, int fr, int fq) const {
        const int pn = u.pn;
#pragma unroll
        for (int ai = 0; ai < 2; ++ai)
#pragma unroll
            for (int m = 0; m < 4; ++m) {
                const int row = u.pm * 256 + ai * 128 + wr * 64 + m * 16 + fr;
                const float rs = rs1[row];
#pragma unroll
                for (int bj = 0; bj < 2; ++bj) {
                    float ssq = 0.f;
#pragma unroll
                    for (int n = 0; n < 2; ++n) {
                        const int col = pn * 256 + bj * 128 + wc * 32 + n * 16 + 4 * fq;
                        f32x4 v = acc[ai][bj][m][n] * rs;
                        if (pn < 4) { v[0] = gelu_tanh(v[0]); v[1] = gelu_tanh(v[1]); v[2] = gelu_tanh(v[2]); v[3] = gelu_tanh(v[3]); }
                        else if (pn >= 6) { v[0] = sigmoidf_(v[0]); v[1] = sigmoidf_(v[1]); v[2] = sigmoidf_(v[2]); v[3] = sigmoidf_(v[3]); }
                        ssq += (v[0] * v[0] + v[1] * v[1]) + (v[2] * v[2] + v[3] * v[3]);
                        u32x2 w; w.x = pk2(v[0], v[1]); w.y = pk2(v[2], v[3]);
                        *(u32x2*)(H + (size_t)row * NIN + col) = w;
                        if (pn == 5 && bj == 1 && wc == 2 && n == 0 && fq == 0) *(f32x4*)(WI + (size_t)row * 4) = v * 0.5f;
                    }
                    if (pn >= 2 && pn <= 5) {
                        ssq += __shfl_xor(ssq, 16); ssq += __shfl_xor(ssq, 32);
                        if (fq == 0) SSQ[(size_t)row * 32 + (pn - 2) * 8 + bj * 4 + wc] = ssq;
                    }
                }
            }
    }
};
struct EpiQ {
    u16* Q; u16* QI; const float* SSQ;
    DI void operator()(const Acc& acc, const UnitD& u, int wr, int wc, int fr, int fq) const {
#pragma unroll
        for (int ai = 0; ai < 2; ++ai)
#pragma unroll
            for (int m = 0; m < 4; ++m) {
                const int row = u.pm * 256 + ai * 128 + wr * 64 + m * 16 + fr;
                const f32x4 s0 = *(const f32x4*)(SSQ + (size_t)row * 32 + 16), s1 = *(const f32x4*)(SSQ + (size_t)row * 32 + 20);
                const float ss = ((s0[0] + s0[1]) + (s0[2] + s0[3])) + ((s1[0] + s1[1]) + (s1[2] + s1[3]));
                const float rs = __builtin_amdgcn_rsqf(ss * (1.0f / 256.0f) + EPS);
#pragma unroll
                for (int bj = 0; bj < 2; ++bj)
#pragma unroll
                    for (int n = 0; n < 2; ++n) {
                        const int col = u.pn * 256 + bj * 128 + wc * 32 + n * 16 + 4 * fq;
                        const f32x4 v = acc[ai][bj][m][n] * rs;
                        u32x2 w; w.x = pk2(v[0], v[1]); w.y = pk2(v[2], v[3]);
                        if (col < 1024) *(u32x2*)(Q + (size_t)row * 1024 + col) = w; else *(u32x2*)(QI + (size_t)row * 256 + (col - 1024)) = w;
                    }
            }
    }
};
template <int SECOND> struct EpiMrg {
    u16* OUT; const u16* TMP; const u16* H;
    DI void operator()(const Acc& acc, const UnitD& u, int wr, int wc, int fr, int fq) const {
#pragma unroll
        for (int ai = 0; ai < 2; ++ai)
#pragma unroll
            for (int m = 0; m < 4; ++m) {
                const int row = u.pm * 256 + ai * 128 + wr * 64 + m * 16 + fr;
#pragma unroll
                for (int bj = 0; bj < 2; ++bj)
#pragma unroll
                    for (int n = 0; n < 2; ++n) {
                        const int col = u.pn * 256 + bj * 128 + wc * 32 + n * 16 + 4 * fq;
                        const u32x2 g = *(const u32x2*)(H + (size_t)row * NIN + 1536 + SECOND * 1024 + col);
                        f32x4 v = acc[ai][bj][m][n];
                        v[0] *= bflo(g.x); v[1] *= bfhi(g.x); v[2] *= bflo(g.y); v[3] *= bfhi(g.y);
                        if (SECOND) { const u32x2 t = *(const u32x2*)(TMP + (size_t)row * 1024 + col); v[0] += bflo(t.x); v[1] += bfhi(t.x); v[2] += bflo(t.y); v[3] += bfhi(t.y); }
                        u32x2 w; w.x = pk2(v[0], v[1]); w.y = pk2(v[2], v[3]);
                        *(u32x2*)(OUT + (size_t)row * 1024 + col) = w;
                    }
            }
    }
};
struct EpiOut {
    float* out; const float* x;
    DI void operator()(const Acc& acc, const UnitD& u, int wr, int wc, int fr, int fq) const {
#pragma unroll
        for (int ai = 0; ai < 2; ++ai)
#pragma unroll
            for (int m = 0; m < 4; ++m) {
                const int row = u.pm * 256 + ai * 128 + wr * 64 + m * 16 + fr;
#pragma unroll
                for (int bj = 0; bj < 2; ++bj)
#pragma unroll
                    for (int n = 0; n < 2; ++n) {
                        const size_t o = (size_t)row * 1024 + u.pn * 256 + bj * 128 + wc * 32 + n * 16 + 4 * fq;
                        *(f32x4*)(out + o) = *(const f32x4*)(x + o) + acc[ai][bj][m][n];
                    }
            }
    }
};

constexpr int MOE_TAB = g8::STAGE_BYTES;
DI void moe_table(LAS unsigned char* lds, const unsigned* CNT) {
    LAS int* tab = (LAS int*)(lds + MOE_TAB);
    __syncthreads();
    if (threadIdx.x == 0) { int acc = 0; for (int e = 0; e < NE; ++e) { const int c = (int)__hip_atomic_load(CNT + e, __ATOMIC_RELAXED, __HIP_MEMORY_SCOPE_AGENT); tab[e] = acc; tab[33 + e] = c; acc += (c + 255) >> 8; } tab[32] = acc; }
    __syncthreads();
}
template <int NPN, bool GATHER> struct MoeSched {
    const char* Abase; const char* Wbase; const int* LTOK; LAS const int* tab; int lda, ldb, K, G, c; size_t wstride;
    DI bool next(int i, UnitD& u) const {
        const long L = (long)i * G + c; const int R = tab[32];
        if (L >= (long)R * NPN) return false;
        const int rbg = (int)(L / NPN), pn = (int)(L % NPN);
        int e = 0;
        for (int j = 1; j < NE; ++j) e += (tab[j] <= rbg) ? 1 : 0;
        e = __builtin_amdgcn_readfirstlane(e);
        u.pm = rbg; u.pn = pn; u.e = e; u.rb = rbg - tab[e];
        u.Bp = Wbase + (size_t)e * wstride + (size_t)pn * 256 * ldb * 2;
        return true;
    }
    DI void a_offs(const UnitD& u, int R0, int C0, unsigned (&o)[2][2]) const {
        const int cnt = tab[33 + u.e];
#pragma unroll
        for (int h = 0; h < 2; ++h)
#pragma unroll
            for (int i = 0; i < 2; ++i) {
                const int r = h * 128 + R0 + 64 * i;
                if (GATHER) { const int slot = u.rb * 256 + r; const int tok = slot < cnt ? LTOK[(size_t)u.e * ECAP + slot] : 0; o[h][i] = (unsigned)(((size_t)tok * lda + C0) * 2); }
                else o[h][i] = (unsigned)(((size_t)(u.pm * 256 + r) * lda + C0) * 2);
            }
    }
};
struct EpiMoe1 {
    u16* ACT; const float* b1;
    DI void operator()(const Acc& acc, const UnitD& u, int wr, int wc, int fr, int fq) const {
        const float* be = b1 + (size_t)u.e * 2048;
#pragma unroll
        for (int n = 0; n < 2; ++n) {
            const int hc = u.pn * 128 + wc * 32 + n * 16 + 4 * fq;
            const f32x4 bg = *(const f32x4*)(be + hc), bu = *(const f32x4*)(be + 1024 + hc);
#pragma unroll
            for (int ai = 0; ai < 2; ++ai)
#pragma unroll
                for (int m = 0; m < 4; ++m) {
                    const int row = u.pm * 256 + ai * 128 + wr * 64 + m * 16 + fr;
                    const f32x4 g = acc[ai][0][m][n] + bg, up = acc[ai][1][m][n] + bu;
                    float a[4];
#pragma unroll
                    for (int j = 0; j < 4; ++j) { const float hg = fminf(g[j], 7.0f), hu = fminf(fmaxf(up[j], -7.0f), 7.0f); a[j] = (hu + 1.0f) * (hg * sigmoidf_(1.702f * hg)); }
                    u32x2 w; w.x = pk2(a[0], a[1]); w.y = pk2(a[2], a[3]);
                    *(u32x2*)(ACT + (size_t)row * 1024 + hc) = w;
                }
        }
    }
};
struct EpiMoe2 {
    u16* YB; const float* b2; const float* LGATE; LAS const int* tab;
    DI void operator()(const Acc& acc, const UnitD& u, int wr, int wc, int fr, int fq) const {
        const float* be = b2 + (size_t)u.e * 1024; const int cnt = tab[33 + u.e];
#pragma unroll
        for (int ai = 0; ai < 2; ++ai)
#pragma unroll
            for (int m = 0; m < 4; ++m) {
                const int r = ai * 128 + wr * 64 + m * 16 + fr, slot = u.rb * 256 + r;
                const float gate = slot < cnt ? LGATE[(size_t)u.e * ECAP + slot] : 0.f;
#pragma unroll
                for (int bj = 0; bj < 2; ++bj)
#pragma unroll
                    for (int n = 0; n < 2; ++n) {
                        const int col = u.pn * 256 + bj * 128 + wc * 32 + n * 16 + 4 * fq;
                        const f32x4 v = (acc[ai][bj][m][n] + *(const f32x4*)(be + col)) * gate;
                        u32x2 w; w.x = pk2(v[0], v[1]); w.y = pk2(v[2], v[3]);
                        *(u32x2*)(YB + (size_t)(u.pm * 256 + r) * 1024 + col) = w;
                    }
            }
    }
};

template <class F> DI void tr_tile(LAS unsigned char* lds, const float* src, int ld_src, int Nsz, int k0, int n0, const float* sk, float mul, u16* dst, int ld_dst, F rowmap) {
    LAS float* t = (LAS float*)lds;
    const int tid = otid();
    __syncthreads();
#pragma unroll
    for (int it = 0; it < 2; ++it) {
        const int k = (tid >> 4) + 32 * it, n = 4 * (tid & 15);
        f32x4 v = {0.f, 0.f, 0.f, 0.f};
        if (n0 + n < Nsz) v = *(const f32x4*)(src + (size_t)(k0 + k) * ld_src + n0 + n);
        const float s = (sk ? sk[k0 + k] : 1.0f) * mul;
        t[k * 65 + n] = v[0] * s; t[k * 65 + n + 1] = v[1] * s; t[k * 65 + n + 2] = v[2] * s; t[k * 65 + n + 3] = v[3] * s;
    }
    __syncthreads();
    const int n = tid >> 3, kc = (tid & 7) * 8;
    if (n0 + n < Nsz) {
        u32x4 w;
        w.x = pk2(t[(kc + 0) * 65 + n], t[(kc + 1) * 65 + n]); w.y = pk2(t[(kc + 2) * 65 + n], t[(kc + 3) * 65 + n]);
        w.z = pk2(t[(kc + 4) * 65 + n], t[(kc + 5) * 65 + n]); w.w = pk2(t[(kc + 6) * 65 + n], t[(kc + 7) * 65 + n]);
        *(u32x4*)(dst + (size_t)rowmap(n0 + n) * ld_dst + k0 + kc) = w;
    }
}
struct MapId { DI int operator()(int n) const { return n; } };
struct MapIn { DI int operator()(int n) const { return n < 1476 ? n : n + 60; } };
struct MapE1 { DI int operator()(int n) const { const int hi = n >= 1024 ? 1 : 0, q = n - hi * 1024; return (q >> 7) * 256 + hi * 128 + (q & 127); } };

DI void phase0(const Args& a, LAS unsigned char* lds) {
    unsigned char* ws = a.ws;
    const int tid = otid();
    const size_t gtid = (size_t)blockIdx.x * NT + tid, gstride = (size_t)gridDim.x * NT;
    for (size_t i = gtid; i < 60 * 1024 / 2; i += gstride) ((unsigned*)(ws + WS_WIN + (size_t)1476 * 1024 * 2))[i] = 0u;
    for (size_t i = gtid; i < 32 * 1024; i += gstride) { const int e = (int)(i >> 10), k = (int)(i & 1023); ((float*)(ws + WS_WR))[i] = a.in[I_WR][k * 32 + e] * a.in[I_N2G][k]; }
    for (size_t i = gtid; i < 4 * 128 * 128; i += gstride) { const int tt = (int)((i >> 7) & 127), ss = (int)(i & 127); ((u16*)(ws + WS_WSP))[i] = f2bf(ss <= tt ? a.in[I_WSP][i] : 0.f); }
    {
        const int wid = tid >> 6, lane = tid & 63;
        for (int row = blockIdx.x * 8 + wid; row < T; row += gridDim.x * 8) {
            const float* xr = a.in[I_X] + (size_t)row * 1024; u16* xb = (u16*)(ws + WS_XB) + (size_t)row * 1024;
            float ss = 0.f;
#pragma unroll
            for (int i = 0; i < 4; ++i) {
                const f32x4 v = *(const f32x4*)(xr + i * 256 + lane * 4);
                ss += (v[0] * v[0] + v[1] * v[1]) + (v[2] * v[2] + v[3] * v[3]);
                u32x2 w; w.x = pk2(v[0], v[1]); w.y = pk2(v[2], v[3]);
                *(u32x2*)(xb + i * 256 + lane * 4) = w;
            }
#pragma unroll
            for (int o = 32; o >= 1; o >>= 1) ss += __shfl_xor(ss, o);
            if (lane == 0) ((float*)(ws + WS_RS1))[row] = __builtin_amdgcn_rsqf(ss * (1.0f / 1024.0f) + EPS);
        }
    }
    constexpr int U_IN = 16 * 56, U_UQ = 4 * 16, U_QI = 4 * 4, U_PA = 8 * 16, U_OUT = 16 * 16, U_E1 = 32 * 16 * 32, U_E2 = 32 * 16 * 16, U_CB = 64;
    constexpr int U_TOT = U_IN + U_UQ + U_QI + U_PA + U_OUT + U_E1 + U_E2 + U_CB;
    for (int u = blockIdx.x; u < U_TOT; u += gridDim.x) {
        int v = u;
        if (v < U_IN) { tr_tile(lds, a.in[I_WIN], 3524, 3524, (v & 15) * 64, (v >> 4) * 64, a.in[I_N1G], 1.0f, (u16*)(ws + WS_WIN), 1024, MapIn()); continue; }
        v -= U_IN;
        if (v < U_UQ) { tr_tile(lds, a.in[I_WUQ], 1024, 1024, (v & 3) * 64, (v >> 2) * 64, a.in[I_QLG], 1.0f, (u16*)(ws + WS_WQ), 256, MapId()); continue; }
        v -= U_UQ;
        if (v < U_QI) { tr_tile(lds, a.in[I_WQI], 256, 256, (v & 3) * 64, (v >> 2) * 64, a.in[I_QLG], 0.125f, (u16*)(ws + WS_WQ) + 1024 * 256, 256, MapId()); continue; }
        v -= U_QI;
        if (v < U_PA) { tr_tile(lds, a.in[I_WPA], 1024, 1024, (v & 7) * 64, (v >> 3) * 64, nullptr, 1.0f, (u16*)(ws + WS_WCAT), 1536, MapId()); continue; }
        v -= U_PA;
        if (v < U_OUT) { tr_tile(lds, a.in[I_WOUT], 1024, 1024, (v & 15) * 64, (v >> 4) * 64, nullptr, 1.0f, (u16*)(ws + WS_WOUT), 1024, MapId()); continue; }
        v -= U_OUT;
        if (v < U_E1) { const int e = v >> 9, w = v & 511; tr_tile(lds, a.in[I_WE1] + (size_t)e * 1024 * 2048, 2048, 2048, (w & 15) * 64, (w >> 4) * 64, a.in[I_N2G], 1.0f, (u16*)(ws + WS_WE1) + (size_t)e * 2048 * 1024, 1024, MapE1()); continue; }
        v -= U_E1;
        if (v < U_E2) { const int e = v >> 8, w = v & 255; tr_tile(lds, a.in[I_WE2] + (size_t)e * 1024 * 1024, 1024, 1024, (w & 15) * 64, (w >> 4) * 64, nullptr, 1.0f, (u16*)(ws + WS_WE2) + (size_t)e * 1024 * 1024, 1024, MapId()); continue; }
        v -= U_E2;
        {
            const int h = v >> 3, c0 = (v & 7) * 16;
            LAS float* t = (LAS float*)lds;
            __syncthreads();
            for (int i = tid; i < 1024; i += NT) t[i] = a.in[I_WUV][(size_t)h * 128 * 64 + (size_t)c0 * 64 + i];
            __syncthreads();
            for (int nn = tid; nn < 1024; nn += NT) {
                float accv[16];
#pragma unroll
                for (int i = 0; i < 16; ++i) accv[i] = 0.f;
                for (int vv = 0; vv < 64; ++vv) {
                    const float pb = a.in[I_WPB][(size_t)(h * 64 + vv) * 1024 + nn];
#pragma unroll
                    for (int i = 0; i < 16; ++i) accv[i] += t[i * 64 + vv] * pb;
                }
                u32x4 w0, w1;
                w0.x = pk2(accv[0], accv[1]); w0.y = pk2(accv[2], accv[3]); w0.z = pk2(accv[4], accv[5]); w0.w = pk2(accv[6], accv[7]);
                w1.x = pk2(accv[8], accv[9]); w1.y = pk2(accv[10], accv[11]); w1.z = pk2(accv[12], accv[13]); w1.w = pk2(accv[14], accv[15]);
                u16* d = (u16*)(ws + WS_WCAT) + (size_t)nn * 1536 + 512 + h * 128 + c0;
                *(u32x4*)d = w0; *(u32x4*)(d + 8) = w1;
            }
        }
    }
}

DI void gmlp_unit(const Args& a, LAS unsigned char* lds, int u) {
    unsigned char* ws = a.ws;
    const int tid = otid(), wid = tid >> 6, lane = tid & 63, fr = lane & 15, fq = lane >> 4;
    const int g = u & 3, row0 = (u >> 2) * 128;
    const u16* H = (const u16*)(ws + WS_H);
    LAS u16* img = (LAS u16*)lds;
    __syncthreads();
    {
        const int s = tid & 127, cset = tid >> 7;
        const f32x4 sq = *(const f32x4*)((const float*)(ws + WS_SSQ) + (size_t)(row0 + s) * 32 + g * 4);
        const float rs = __builtin_amdgcn_rsqf(((sq[0] + sq[1]) + (sq[2] + sq[3])) * (1.0f / 128.0f) + EPS);
#pragma unroll
        for (int it = 0; it < 4; ++it) {
            const int c = cset + 4 * it;
            const u32x4 raw = *(const u32x4*)(H + (size_t)(row0 + s) * NIN + 512 + g * 128 + 8 * c);
            const float* vg = a.in[I_VG] + 8 * c;
            float f[8] = {bflo(raw.x), bfhi(raw.x), bflo(raw.y), bfhi(raw.y), bflo(raw.z), bfhi(raw.z), bflo(raw.w), bfhi(raw.w)};
#pragma unroll
            for (int i = 0; i < 8; ++i) img[(8 * c + i) * 136 + s] = f2bf(f[i] * rs * vg[i]);
        }
    }
    __syncthreads();
    const u16* W = (const u16*)(ws + WS_WSP) + (size_t)g * 128 * 128 + (size_t)(16 * wid + fr) * 128;
    f32x4 acc[8];
#pragma unroll
    for (int i = 0; i < 8; ++i) acc[i] = (f32x4){0.f, 0.f, 0.f, 0.f};
    const int nks = (16 * wid + 15) / 32 + 1;
    for (int ks = 0; ks < nks; ++ks) {
        const bf16x8 bw = *(const bf16x8*)(W + ks * 32 + 8 * fq);
#pragma unroll
        for (int i = 0; i < 8; ++i) {
            const bf16x8 av = *(const LAS bf16x8*)(img + (16 * i + fr) * 136 + ks * 32 + 8 * fq);
            acc[i] = __builtin_amdgcn_mfma_f32_16x16x32_bf16(av, bw, acc[i], 0, 0, 0);
        }
    }
    const int t = 16 * wid + fr;
    const float bias = a.in[I_BSP][g * 128 + t];
    u16* YO = (u16*)(ws + WS_YO);
#pragma unroll
    for (int i = 0; i < 8; ++i) {
        const int d = 16 * i + 4 * fq;
        const u32x2 uu = *(const u32x2*)(H + (size_t)(row0 + t) * NIN + g * 128 + d);
        const float y0 = bflo(uu.x) * (acc[i][0] + bias), y1 = bfhi(uu.x) * (acc[i][1] + bias), y2 = bflo(uu.y) * (acc[i][2] + bias), y3 = bfhi(uu.y) * (acc[i][3] + bias);
        u32x2 w; w.x = pk2(y0, y1); w.y = pk2(y2, y3);
        *(u32x2*)(YO + (size_t)(row0 + t) * 1536 + g * 128 + d) = w;
    }
}

DI void kvnorm(const Args& a) {
    unsigned char* ws = a.ws;
    const u16* H = (const u16*)(ws + WS_H); const float* SSQ = (const float*)(ws + WS_SSQ);
    const size_t gtid = (size_t)blockIdx.x * NT + otid(), gstride = (size_t)gridDim.x * NT;
    for (size_t idx = gtid; idx < (size_t)T * 24; idx += gstride) {
        const int row = (int)(idx / 24), c = (int)(idx % 24);
        const u16* src; u16* dst; const float* gain; float rs;
        if (c < 16) {
            const f32x4 sq = *(const f32x4*)(SSQ + (size_t)row * 32 + 24);
            rs = __builtin_amdgcn_rsqf(((sq[0] + sq[1]) + (sq[2] + sq[3])) * (1.0f / 128.0f) + EPS);
            src = H + (size_t)row * NIN + 1280 + 8 * c; dst = (u16*)(ws + WS_KVN) + (size_t)row * 128 + 8 * c; gain = a.in[I_KVG] + 8 * c;
        } else {
            const int cc = c - 16;
            rs = __builtin_amdgcn_rsqf((SSQ[(size_t)row * 32 + 28] + SSQ[(size_t)row * 32 + 29]) * (1.0f / 64.0f) + EPS);
            src = H + (size_t)row * NIN + 1408 + 8 * cc; dst = (u16*)(ws + WS_KIN) + (size_t)row * 64 + 8 * cc; gain = a.in[I_KIG] + 8 * cc;
        }
        const u32x4 raw = *(const u32x4*)src;
        u32x4 w;
        w.x = pk2(bflo(raw.x) * rs * gain[0], bfhi(raw.x) * rs * gain[1]); w.y = pk2(bflo(raw.y) * rs * gain[2], bfhi(raw.y) * rs * gain[3]);
        w.z = pk2(bflo(raw.z) * rs * gain[4], bfhi(raw.z) * rs * gain[5]); w.w = pk2(bflo(raw.w) * rs * gain[6], bfhi(raw.w) * rs * gain[7]);
        *(u32x4*)dst = w;
    }
}

constexpr int P3_ROWS = 0, P3_HIST = 131072, P3_LIST = 147456;
DI unsigned f2key(float f) { const unsigned u = __float_as_uint(f); return (u & 0x80000000u) ? ~u : (u | 0x80000000u); }
DI int wave_incl_scan(int v, int lane) {
#pragma unroll
    for (int o = 1; o < 64; o <<= 1) { const int t = __shfl_up(v, o); if (lane >= o) v += t; }
    return v;
}
DI int wave_suffix_scan(int v, int lane) {
#pragma unroll
    for (int o = 1; o < 64; o <<= 1) { const int t = __shfl_down(v, o); if (lane + o < 64) v += t; }
    return v;
}
DI unsigned pk_gt(unsigned kw, unsigned xw, unsigned one) {
    unsigned d, m;
    asm("v_pk_sub_u16 %0, %1, %2 clamp" : "=v"(d) : "v"(kw), "v"(xw));
    asm("v_pk_min_u16 %0, %1, %2" : "=v"(m) : "v"(d), "v"(one));
    return m;
}
DI unsigned pk_subs(unsigned kw, unsigned xw) { unsigned d; asm("v_pk_sub_u16 %0, %1, %2 clamp" : "=v"(d) : "v"(kw), "v"(xw)); return d; }
DI unsigned pk_min1(unsigned d, unsigned one) { unsigned m; asm("v_pk_min_u16 %0, %1, %2" : "=v"(m) : "v"(d), "v"(one)); return m; }
DI unsigned pk_add(unsigned a, unsigned b) { unsigned r; asm("v_pk_add_u16 %0, %1, %2" : "=v"(r) : "v"(a), "v"(b)); return r; }
DI int wave_sum(int v) {
    v += __builtin_amdgcn_update_dpp(0, v, 0xB1, 0xf, 0xf, false);
    v += __builtin_amdgcn_update_dpp(0, v, 0x4E, 0xf, 0xf, false);
    v += __builtin_amdgcn_update_dpp(0, v, 0x141, 0xf, 0xf, false);
    v += __builtin_amdgcn_update_dpp(0, v, 0x140, 0xf, 0xf, false);
    return __builtin_amdgcn_readlane(v, 0) + __builtin_amdgcn_readlane(v, 16) + __builtin_amdgcn_readlane(v, 32) + __builtin_amdgcn_readlane(v, 48);
}
DI int rowaddr(int p) { return (p & ~511) | ((p & 63) << 3) | ((p >> 6) & 7); }
typedef unsigned short us2_t __attribute__((ext_vector_type(2)));
DI unsigned dot2acc(unsigned flags, unsigned wts, unsigned acc) { return __builtin_amdgcn_udot2(__builtin_bit_cast(us2_t, flags), __builtin_bit_cast(us2_t, wts), acc, false); }
DI void select_top16(LAS u16* row, LAS u16* list, int N, int lane) {
    const int Nup = (N + 511) & ~511, niter = Nup >> 9;
    for (int p = N + lane; p < Nup; p += 64) row[rowaddr(p)] = (u16)0;
    wave_lds_sync();
    u32x4 kr[16];
#pragma unroll
    for (int i = 0; i < 16; ++i) { kr[i] = (u32x4){0u, 0u, 0u, 0u}; if (i < niter) kr[i] = *(LAS const u32x4*)(row + i * 512 + lane * 8); }
    const unsigned one = 0x00010001u;
    auto count_gt = [&](unsigned x) -> int {
        const unsigned xw = x | (x << 16);
        unsigned acc = 0u, acc1 = 0u, acc2 = 0u, acc3 = 0u;
#pragma unroll
        for (int c = 0; c < 4; ++c) {
            if (4 * c < niter) {
                unsigned d[16];
#pragma unroll
                for (int i = 0; i < 4; ++i) { d[4 * i] = pk_subs(kr[4 * c + i].x, xw); d[4 * i + 1] = pk_subs(kr[4 * c + i].y, xw); d[4 * i + 2] = pk_subs(kr[4 * c + i].z, xw); d[4 * i + 3] = pk_subs(kr[4 * c + i].w, xw); }
#pragma unroll
                for (int i = 0; i < 16; ++i) d[i] = pk_min1(d[i], one);
#pragma unroll
                for (int i = 0; i < 16; i += 4) { acc = dot2acc(d[i], one, acc); acc1 = dot2acc(d[i + 1], one, acc1); acc2 = dot2acc(d[i + 2], one, acc2); acc3 = dot2acc(d[i + 3], one, acc3); }
            }
        }
        return wave_sum((int)((acc + acc1) + (acc2 + acc3)));
    };
    unsigned T = 0u; int cge = Nup;
#pragma unroll 1
    for (int bit = 15; bit >= 0; --bit) {
        const unsigned cand = T | (1u << bit);
        const int cnt = count_gt(cand - 1u);
        if (cnt >= 256) { T = cand; cge = cnt; }
    }
    auto build = [&](unsigned x, unsigned (&M)[4]) {
        const unsigned xw = x | (x << 16);
#pragma unroll
        for (int c = 0; c < 4; ++c) {
            M[c] = 0u;
            if (4 * c < niter) {
#pragma unroll
                for (int i = 4 * c; i < 4 * c + 4; ++i) {
                    unsigned byte = dot2acc(pk_gt(kr[i].x, xw, one), 0x00020001u, 0u);
                    byte = dot2acc(pk_gt(kr[i].y, xw, one), 0x00080004u, byte);
                    byte = dot2acc(pk_gt(kr[i].z, xw, one), 0x00200010u, byte);
                    byte = dot2acc(pk_gt(kr[i].w, xw, one), 0x00800040u, byte);
                    M[c] |= byte << (8 * (i & 3));
                }
            }
        }
    };
    unsigned M[4];
    build(T - 1u, M);
    if (cge != 256) {
        unsigned G[4]; build(T, G);
        unsigned E[4];
#pragma unroll
        for (int c = 0; c < 4; ++c) E[c] = M[c] & ~G[c];
        const int need = 256 - (cge - wave_sum((int)(__builtin_popcount(E[0]) + __builtin_popcount(E[1]) + __builtin_popcount(E[2]) + __builtin_popcount(E[3]))));
        auto below = [&](int B, int c) -> unsigned { const int nb = B - 32 * c; return nb <= 0 ? 0u : (nb >= 32 ? 0xffffffffu : ((1u << nb) - 1u)); };
        auto ties_below = [&](int B) -> int {
            return wave_sum((int)(__builtin_popcount(E[0] & below(B, 0)) + __builtin_popcount(E[1] & below(B, 1)) + __builtin_popcount(E[2] & below(B, 2)) + __builtin_popcount(E[3] & below(B, 3))));
        };
        int lo = 0, hi = 127;
#pragma unroll 1
        while (lo < hi) { const int mid = (lo + hi) >> 1; if (ties_below(mid + 1) >= need) hi = mid; else lo = mid + 1; }
        const int Bs = lo, r = need - ties_below(Bs);
        const unsigned ew = Bs < 32 ? E[0] : (Bs < 64 ? E[1] : (Bs < 96 ? E[2] : E[3]));
        const bool tb = ((ew >> (Bs & 31)) & 1u) != 0u;
        const unsigned long long em = __ballot(tb);
        const bool take_row = tb && __builtin_popcountll(em & ((1ull << lane) - 1ull)) < r;
#pragma unroll
        for (int c = 0; c < 4; ++c) {
            unsigned tk = E[c] & below(Bs, c);
            if ((Bs >> 5) == c && take_row) tk |= 1u << (Bs & 31);
            M[c] = G[c] | tk;
        }
    }
    const int kl = __builtin_popcount(M[0]) + __builtin_popcount(M[1]) + __builtin_popcount(M[2]) + __builtin_popcount(M[3]);
    int wp = wave_incl_scan(kl, lane) - kl;
#pragma unroll
    for (int c = 0; c < 4; ++c) {
        unsigned m = M[c];
        while (m) { const int b = __builtin_ctz(m); list[wp] = (u16)((32 * c + b) * 64 + lane); ++wp; m &= m - 1u; }
    }
}

DI void dsa_phase(const Args& a, LAS unsigned char* lds) {
    unsigned char* ws = a.ws;
    const int tid = otid(), wid = __builtin_amdgcn_readfirstlane(tid >> 6), lane = tid & 63, fr = lane & 15, fq = lane >> 4;
    const u16* QI = (const u16*)(ws + WS_QI); const u16* KIN = (const u16*)(ws + WS_KIN); const u16* KVN = (const u16*)(ws + WS_KVN);
    const u16* Q = (const u16*)(ws + WS_Q); const float* WI = (const float*)(ws + WS_WI); u16* YO = (u16*)(ws + WS_YO);
    LAS u16* rows = (LAS u16*)(lds + P3_ROWS);
    for (int gi = blockIdx.x; gi < T / 8; gi += gridDim.x) {
        const int b = gi & 3, t0 = S - 8 - 8 * (gi >> 2);
        const size_t brow = (size_t)b * S;
        const int ntile = (t0 + 8 + 15) >> 4;
        __syncthreads();
        {
            bf16x8 qa[2][2]; f32x4 wi[2];
#pragma unroll
            for (int rg = 0; rg < 2; ++rg) {
#pragma unroll
                for (int ks = 0; ks < 2; ++ks) qa[rg][ks] = *(const bf16x8*)(QI + (brow + t0 + 4 * rg + (fr >> 2)) * 256 + (fr & 3) * 64 + ks * 32 + 8 * fq);
                wi[rg] = *(const f32x4*)(WI + (brow + t0 + 4 * rg + fq) * 4);
            }
            auto ldk = [&](bf16x8 (&kf)[4][2], int jt0) {
#pragma unroll
                for (int u = 0; u < 4; ++u) {
                    const int jt = (jt0 + 8 * u) < ntile ? (jt0 + 8 * u) : (ntile - 1);
                    const u16* kp = KIN + (brow + jt * 16 + fr) * 64 + 8 * fq;
                    kf[u][0] = *(const bf16x8*)kp; kf[u][1] = *(const bf16x8*)(kp + 32);
                }
            };
            auto cmpk = [&](const bf16x8 (&kf)[4][2], int jt0) {
#pragma unroll
                for (int u = 0; u < 4; ++u) {
                    const int jt = jt0 + 8 * u;
                    if (jt < ntile) {
#pragma unroll
                        for (int rg = 0; rg < 2; ++rg) {
                            f32x4 d = {0.f, 0.f, 0.f, 0.f};
                            d = __builtin_amdgcn_mfma_f32_16x16x32_bf16(qa[rg][0], kf[u][0], d, 0, 0, 0);
                            d = __builtin_amdgcn_mfma_f32_16x16x32_bf16(qa[rg][1], kf[u][1], d, 0, 0, 0);
                            const float sc = ((fmaxf(d[0], 0.f) * wi[rg][0] + fmaxf(d[1], 0.f) * wi[rg][1]) + fmaxf(d[2], 0.f) * wi[rg][2]) + fmaxf(d[3], 0.f) * wi[rg][3];
                            rows[(4 * rg + fq) * 8192 + rowaddr(jt * 16 + fr)] = (u16)(f2key(sc) >> 16);
                        }
                    }
                }
            };
            bf16x8 kA[4][2], kB[4][2];
            if (wid < ntile) ldk(kA, wid);
            for (int jt0 = wid; jt0 < ntile; jt0 += 64) {
                const bool hasB = jt0 + 32 < ntile;
                if (hasB) ldk(kB, jt0 + 32);
                cmpk(kA, jt0);
                if (hasB) { if (jt0 + 64 < ntile) ldk(kA, jt0 + 64); cmpk(kB, jt0 + 32); }
            }
        }
        __syncthreads();
        {
            const int q = wid, t = t0 + q, N = t + 1;
            LAS u16* row = rows + q * 8192;
            LAS u16* list = (LAS u16*)(lds + P3_LIST + q * 512);
            int cnt;
            if (N <= 256) { for (int p = lane; p < 256; p += 64) list[p] = p < N ? (u16)p : (u16)0; cnt = N; }
            else { select_top16(row, list, N, lane); cnt = 256; }
            wave_lds_sync();
            bf16x8 qf[4];
            {
                const int head = fr & 7;
                const u16* qrow = Q + (brow + t) * 1024 + head * 128;
                float f[4][8]; float ss = 0.f;
#pragma unroll
                for (int ks = 0; ks < 4; ++ks) {
                    const u32x4 raw = *(const u32x4*)(qrow + ks * 32 + 8 * fq);
                    f[ks][0] = bflo(raw.x); f[ks][1] = bfhi(raw.x); f[ks][2] = bflo(raw.y); f[ks][3] = bfhi(raw.y); f[ks][4] = bflo(raw.z); f[ks][5] = bfhi(raw.z); f[ks][6] = bflo(raw.w); f[ks][7] = bfhi(raw.w);
#pragma unroll
                    for (int j = 0; j < 8; ++j) ss += f[ks][j] * f[ks][j];
                }
                ss += __shfl_xor(ss, 16); ss += __shfl_xor(ss, 32);
                const float rq = __builtin_amdgcn_rsqf(ss * (1.0f / 128.0f) + EPS) * 0.08838834764831845f;
#pragma unroll
                for (int ks = 0; ks < 4; ++ks) {
                    const float* qg = a.in[I_QNG] + ks * 32 + 8 * fq;
                    u32x4 w;
                    w.x = pk2(f[ks][0] * rq * qg[0], f[ks][1] * rq * qg[1]); w.y = pk2(f[ks][2] * rq * qg[2], f[ks][3] * rq * qg[3]);
                    w.z = pk2(f[ks][4] * rq * qg[4], f[ks][5] * rq * qg[5]); w.w = pk2(f[ks][6] * rq * qg[6], f[ks][7] * rq * qg[7]);
                    qf[ks] = __builtin_bit_cast(bf16x8, w);
                }
            }
            LAS unsigned char* img = (LAS unsigned char*)row;
            const int nsteps = (cnt + 31) >> 5;
            f32x4 oacc[8];
#pragma unroll
            for (int i = 0; i < 8; ++i) oacc[i] = (f32x4){0.f, 0.f, 0.f, 0.f};
            float mrun = -3.0e38f, lpart = 0.f;
            auto issue = [&](u32x4 (&pf)[8], int pp) {
#pragma unroll
                for (int it = 0; it < 8; ++it) { const int piece = it * 64 + lane; const unsigned key = list[pp * 32 + (piece >> 4)]; pf[it] = *(const u32x4*)(KVN + (brow + key) * 128 + 8 * (piece & 15)); }
            };
            auto step = [&](u32x4 (&pf)[8], int pp) {
#pragma unroll
                for (int it = 0; it < 8; ++it) { const int piece = it * 64 + lane; *(LAS u32x4*)(img + (piece >> 4) * 288 + (piece & 15) * 16) = pf[it]; }
                if (pp + 1 < nsteps) issue(pf, pp + 1);
                wave_lds_sync();
                __builtin_amdgcn_sched_barrier(0);
                f32x4 sa = {0.f, 0.f, 0.f, 0.f}, sb = {0.f, 0.f, 0.f, 0.f};
#pragma unroll
                for (int ks = 0; ks < 4; ++ks) {
                    const bf16x8 a0 = *(LAS const bf16x8*)(img + fr * 288 + (ks * 32 + 8 * fq) * 2), a1 = *(LAS const bf16x8*)(img + (16 + fr) * 288 + (ks * 32 + 8 * fq) * 2);
                    sa = __builtin_amdgcn_mfma_f32_16x16x32_bf16(a0, qf[ks], sa, 0, 0, 0); sb = __builtin_amdgcn_mfma_f32_16x16x32_bf16(a1, qf[ks], sb, 0, 0, 0);
                }
                const int pb0 = pp * 32 + 4 * fq;
#pragma unroll
                for (int r = 0; r < 4; ++r) { if (pb0 + r >= cnt) sa[r] = -3.0e38f; if (pb0 + 16 + r >= cnt) sb[r] = -3.0e38f; }
                float mx = fmaxf(fmaxf(fmaxf(sa[0], sa[1]), fmaxf(sa[2], sa[3])), fmaxf(fmaxf(sb[0], sb[1]), fmaxf(sb[2], sb[3])));
                mx = fmaxf(mx, __shfl_xor(mx, 16)); mx = fmaxf(mx, __shfl_xor(mx, 32));
                const float mnew = fmaxf(mrun, mx), alpha = __expf(mrun - mnew);
                mrun = mnew;
                float ps = 0.f;
#pragma unroll
                for (int r = 0; r < 4; ++r) { sa[r] = __expf(sa[r] - mnew); sb[r] = __expf(sb[r] - mnew); ps += sa[r] + sb[r]; }
                lpart = lpart * alpha + ps;
#pragma unroll
                for (int cb = 0; cb < 8; ++cb) oacc[cb] *= alpha;
                u32x4 pw; pw.x = pk2(sa[0], sa[1]); pw.y = pk2(sa[2], sa[3]); pw.z = pk2(sb[0], sb[1]); pw.w = pk2(sb[2], sb[3]);
                const bf16x8 pb = __builtin_bit_cast(bf16x8, pw);
#pragma unroll
                for (int cb = 0; cb < 8; ++cb) {
                    const s16x4 r0 = __builtin_amdgcn_ds_read_tr16_b64_v4i16((LAS s16x4*)(img + (4 * fq + (fr >> 2)) * 288 + (cb * 16 + 4 * (fr & 3)) * 2));
                    const s16x4 r1 = __builtin_amdgcn_ds_read_tr16_b64_v4i16((LAS s16x4*)(img + (16 + 4 * fq + (fr >> 2)) * 288 + (cb * 16 + 4 * (fr & 3)) * 2));
                    const bf16x8 av = {r0[0], r0[1], r0[2], r0[3], r1[0], r1[1], r1[2], r1[3]};
                    oacc[cb] = __builtin_amdgcn_mfma_f32_16x16x32_bf16(av, pb, oacc[cb], 0, 0, 0);
                    if (cb == 3) __builtin_amdgcn_sched_barrier(0);
                }
                wave_lds_sync();
            };
            u32x4 pf0[8];
            issue(pf0, 0);
#pragma unroll 1
            for (int pp = 0; pp < nsteps; ++pp) step(pf0, pp);
            float lsum = lpart; lsum += __shfl_xor(lsum, 16); lsum += __shfl_xor(lsum, 32);
            const float inv = __builtin_amdgcn_rcpf(lsum);
            if (fr < 8) {
                u16* orow = YO + (brow + t) * 1536 + 512 + fr * 128 + 4 * fq;
#pragma unroll
                for (int cb = 0; cb < 8; ++cb) { u32x2 w; w.x = pk2(oacc[cb][0] * inv, oacc[cb][1] * inv); w.y = pk2(oacc[cb][2] * inv, oacc[cb][3] * inv); *(u32x2*)(orow + cb * 16) = w; }
            }
        }
    }
}

constexpr int P6_WT = 0, P6_LCNT = 131072, P6_BASE = 131072 + 128, P6_RI = 131072 + 256;
DI void router_phase(const Args& a, LAS unsigned char* lds) {
    unsigned char* ws = a.ws;
    const int tid = otid(), wid = tid >> 6, lane = tid & 63;
    LAS float* WT = (LAS float*)(lds + P6_WT); LAS int* lcnt = (LAS int*)(lds + P6_LCNT); LAS int* lbase = (LAS int*)(lds + P6_BASE); LAS int* RI = (LAS int*)(lds + P6_RI);
    const float* WR = (const float*)(ws + WS_WR);
    unsigned* CNT = (unsigned*)(ws + WS_CTL);
    __syncthreads();
    for (int i = tid; i < 32 * 1024 / 4; i += NT) *(LAS f32x4*)(WT + 4 * i) = *(const f32x4*)(WR + 4 * i);
    for (int rg = blockIdx.x; rg < T / 128; rg += gridDim.x) {
        if (tid < 32) lcnt[tid] = 0;
        __syncthreads();
        for (int it = 0; it < 16; ++it) {
            const int rl = wid + 8 * it, row = rg * 128 + rl;
            const float* xr = a.out + (size_t)row * 1024;
            f32x4 xv[4]; float ss = 0.f;
#pragma unroll
            for (int i = 0; i < 4; ++i) { xv[i] = *(const f32x4*)(xr + i * 256 + lane * 4); ss += (xv[i][0] * xv[i][0] + xv[i][1] * xv[i][1]) + (xv[i][2] * xv[i][2] + xv[i][3] * xv[i][3]); }
#pragma unroll
            for (int o = 32; o >= 1; o >>= 1) ss += __shfl_xor(ss, o);
            const float rs = __builtin_amdgcn_rsqf(ss * (1.0f / 1024.0f) + EPS);
            u16* xn = (u16*)(ws + WS_XN2) + (size_t)row * 1024;
#pragma unroll
            for (int i = 0; i < 4; ++i) { u32x2 w; w.x = pk2(xv[i][0] * rs, xv[i][1] * rs); w.y = pk2(xv[i][2] * rs, xv[i][3] * rs); *(u32x2*)(xn + i * 256 + lane * 4) = w; }
            float acc[32];
#pragma unroll
            for (int e = 0; e < 32; ++e) {
                float s = 0.f;
#pragma unroll
                for (int i = 0; i < 4; ++i) { const f32x4 w = *(LAS const f32x4*)(WT + e * 1024 + i * 256 + lane * 4); s += (xv[i][0] * w[0] + xv[i][1] * w[1]) + (xv[i][2] * w[2] + xv[i][3] * w[3]); }
                acc[e] = s;
            }
            float v16[16], v8[8], v4[4], v2[2], v1;
            { const bool hi = (lane & 32) != 0;
#pragma unroll
              for (int e = 0; e < 16; ++e) { const float keep = hi ? acc[e + 16] : acc[e], send = hi ? acc[e] : acc[e + 16]; v16[e] = keep + __shfl_xor(send, 32); } }
            { const bool hi = (lane & 16) != 0;
#pragma unroll
              for (int e = 0; e < 8; ++e) { const float keep = hi ? v16[e + 8] : v16[e], send = hi ? v16[e] : v16[e + 8]; v8[e] = keep + __shfl_xor(send, 16); } }
            { const bool hi = (lane & 8) != 0;
#pragma unroll
              for (int e = 0; e < 4; ++e) { const float keep = hi ? v8[e + 4] : v8[e], send = hi ? v8[e] : v8[e + 4]; v4[e] = keep + __shfl_xor(send, 8); } }
            { const bool hi = (lane & 4) != 0;
#pragma unroll
              for (int e = 0; e < 2; ++e) { const float keep = hi ? v4[e + 2] : v4[e], send = hi ? v4[e] : v4[e + 2]; v2[e] = keep + __shfl_xor(send, 4); } }
            { const bool hi = (lane & 2) != 0; const float keep = hi ? v2[1] : v2[0], send = hi ? v2[0] : v2[1]; v1 = keep + __shfl_xor(send, 2); }
            v1 += __shfl_xor(v1, 1);
            const int myexp = lane >> 1;
            float logit = v1 * rs + a.in[I_BR][myexp];
            float tv[4]; int ti[4];
#pragma unroll
            for (int k = 0; k < 4; ++k) {
                float bv = logit; int bi = myexp;
#pragma unroll
                for (int o = 32; o >= 1; o >>= 1) { const float ov = __shfl_xor(bv, o); const int oi = __shfl_xor(bi, o); if (ov > bv || (ov == bv && oi < bi)) { bv = ov; bi = oi; } }
                tv[k] = bv; ti[k] = bi;
                if (myexp == bi) logit = -3.0e38f;
            }
            const float e1 = __expf(tv[1] - tv[0]), e2 = __expf(tv[2] - tv[0]), e3 = __expf(tv[3] - tv[0]);
            const float inv = 1.0f / (1.0f + e1 + e2 + e3);
            if (lane < 4) {
                const int e = lane == 0 ? ti[0] : (lane == 1 ? ti[1] : (lane == 2 ? ti[2] : ti[3]));
                const float gt = (lane == 0 ? 1.0f : (lane == 1 ? e1 : (lane == 2 ? e2 : e3))) * inv;
                const int ls = __hip_atomic_fetch_add(lcnt + e, 1, __ATOMIC_RELAXED, __HIP_MEMORY_SCOPE_WORKGROUP);
                RI[(rl * 4 + lane) * 3 + 0] = e; RI[(rl * 4 + lane) * 3 + 1] = ls; RI[(rl * 4 + lane) * 3 + 2] = __float_as_int(gt);
            }
        }
        __syncthreads();
        if (tid < 32) lbase[tid] = (int)__hip_atomic_fetch_add(CNT + tid, (unsigned)lcnt[tid], __ATOMIC_RELAXED, __HIP_MEMORY_SCOPE_AGENT);
        __syncthreads();
        {
            const int rl = tid >> 2, k = tid & 3, row = rg * 128 + rl;
            const int e = RI[tid * 3 + 0], slot = lbase[e] + RI[tid * 3 + 1]; const float gt = __int_as_float(RI[tid * 3 + 2]);
            ((int*)(ws + WS_LTOK))[(size_t)e * ECAP + slot] = row;
            ((float*)(ws + WS_LGATE))[(size_t)e * ECAP + slot] = gt;
            ((unsigned*)(ws + WS_ROUTE))[(size_t)row * 4 + k] = ((unsigned)e << 16) | (unsigned)slot;
        }
        __syncthreads();
    }
}

DI void combine_phase(const Args& a, LAS unsigned char* lds) {
    unsigned char* ws = a.ws;
    LAS const int* tab = (LAS const int*)(lds + MOE_TAB);
    const int tid = otid(), wid = tid >> 6, lane = tid & 63;
    const u16* YB = (const u16*)(ws + WS_YB); const unsigned* ROUTE = (const unsigned*)(ws + WS_ROUTE);
    for (int row = blockIdx.x * 8 + wid; row < T; row += gridDim.x * 8) {
        size_t pos[4];
#pragma unroll
        for (int k = 0; k < 4; ++k) { const unsigned r = ROUTE[(size_t)row * 4 + k]; const int e = (int)(r >> 16), slot = (int)(r & 0xffffu); pos[k] = (size_t)tab[e] * 256 + slot; }
        float* orow = a.out + (size_t)row * 1024;
#pragma unroll
        for (int i = 0; i < 4; ++i) {
            f32x4 v = *(const f32x4*)(orow + i * 256 + lane * 4);
#pragma unroll
            for (int k = 0; k < 4; ++k) { const u32x2 y = *(const u32x2*)(YB + pos[k] * 1024 + i * 256 + lane * 4); v[0] += bflo(y.x); v[1] += bfhi(y.x); v[2] += bflo(y.y); v[3] += bfhi(y.y); }
            *(f32x4*)(orow + i * 256 + lane * 4) = v;
        }
    }
}

#define XB_TMO      128
#define XB_XCNT(j)  (256  + 64 * (j))
#define XB_XSUB(j)  (1280 + 64 * (j))
#define XB_XGEN(j)  (2304 + 64 * (j))
#define XB_TOP      3328
#define XB_TOPGEN   3392
#define XCD_BAR_WORDS 3456
#define XB_SPIN_CAP (1u << 18)

__device__ __forceinline__ unsigned xb_ld(unsigned* p)              { return __hip_atomic_load(p, __ATOMIC_RELAXED, __HIP_MEMORY_SCOPE_AGENT); }
__device__ __forceinline__ unsigned xb_add(unsigned* p, unsigned v) { return __hip_atomic_fetch_add(p, v, __ATOMIC_RELAXED, __HIP_MEMORY_SCOPE_AGENT); }
__device__ __forceinline__ unsigned xb_xcc_id() { return (unsigned)__builtin_amdgcn_s_getreg((3 << 11) | 20) & 0xFu; }
#define XB_SPIN(cond, bar) do { unsigned _sp = 0; while (cond) { __builtin_amdgcn_s_sleep(1); \
    if ((++_sp & 255u) == 0u) { if (xb_ld(&(bar)[XB_TMO])) break; if (_sp > XB_SPIN_CAP) { atomicAdd(&(bar)[XB_TMO], 1u); break; } } } } while (0)

struct XcdBarrier {
    unsigned* bar; unsigned x;
    volatile LAS unsigned* st;
};

__device__ __forceinline__ XcdBarrier xcd_barrier_post(unsigned* bar, volatile LAS unsigned* st) {
    XcdBarrier b; b.bar = bar; b.x = xb_xcc_id(); b.st = st;
    if (threadIdx.x == 0) (void)xb_add(&bar[XB_XCNT(b.x)], 1u);
    return b;
}
__device__ __forceinline__ void xcd_barrier_complete(unsigned* bar, unsigned x, unsigned& nloc, unsigned& nx) {
    const unsigned G = gridDim.x * gridDim.y * gridDim.z;
    unsigned sum, cnt, mine, sp = 0u;
    for (;;) {
        sum = 0u; cnt = 0u; mine = 0u;
#pragma unroll
        for (unsigned j = 0; j < 16; ++j) { const unsigned c = xb_ld(&bar[XB_XCNT(j)]); sum += c; cnt += (c > 0u) ? 1u : 0u; mine = (j == x) ? c : mine; }
        if (sum == G) break;
        __builtin_amdgcn_s_sleep(1);
        if ((++sp & 255u) == 0u) { if (xb_ld(&bar[XB_TMO])) break; if (sp > XB_SPIN_CAP) { atomicAdd(&bar[XB_TMO], 1u); break; } }
    }
    nloc = mine > 0u ? mine : 1u; nx = cnt > 0u ? cnt : 1u;
}

__device__ __forceinline__ void xcd_barrier(const XcdBarrier& b) {
    asm volatile("s_waitcnt vmcnt(0)" ::: "memory");
    __syncthreads();
    if (threadIdx.x == 0) {
        unsigned* bar = b.bar;
        __builtin_amdgcn_s_waitcnt(0);
        unsigned nloc = b.st[0], nx = b.st[1];
        if (nloc == 0u) { xcd_barrier_complete(bar, b.x, nloc, nx); b.st[0] = nloc; b.st[1] = nx; }
        const unsigned old = xb_add(&bar[XB_XSUB(b.x)], 1u);
        const unsigned gen = old / nloc;
        if (old + 1u == (gen + 1u) * nloc) {
            __builtin_amdgcn_fence(__ATOMIC_RELEASE, "agent");
            asm volatile("s_waitcnt vmcnt(0)" ::: "memory");
            const unsigned og = xb_add(&bar[XB_TOP], 1u);
            const unsigned tg = og / nx;
            if (og + 1u == (tg + 1u) * nx) xb_add(&bar[XB_TOPGEN], 1u);
            else XB_SPIN(xb_ld(&bar[XB_TOPGEN]) == tg, bar);
            __builtin_amdgcn_fence(__ATOMIC_ACQUIRE, "agent");
            xb_add(&bar[XB_XGEN(b.x)], 1u);
            asm volatile("s_waitcnt vmcnt(0)" ::: "memory");
        } else {
            XB_SPIN(xb_ld(&bar[XB_XGEN(b.x)]) == gen, bar);
            __builtin_amdgcn_fence(__ATOMIC_ACQUIRE, "agent");
            asm volatile("s_waitcnt vmcnt(0)" ::: "memory");
        }
    }
    __syncthreads();
}

__global__ void __launch_bounds__(NT, 2) fwd(Args a) {
    extern __shared__ __attribute__((aligned(16))) unsigned char lds_raw[];
    LAS unsigned char* lds = (LAS unsigned char*)lds_raw;
    cg::grid_group grid = cg::this_grid();
    unsigned char* ws = a.ws;
    const int G = gridDim.x, c = blockIdx.x;
    if (threadIdx.x < 2) ((volatile LAS unsigned*)(lds + LDS_BARST))[threadIdx.x] = 0u;
    __syncthreads();
    const XcdBarrier xbar = xcd_barrier_post((unsigned*)(ws + WS_BAR), (volatile LAS unsigned*)(lds + LDS_BARST));

    phase0(a, lds);
    grid.sync();
    {
        g8::PlainSched s; s.Abase = (const char*)(ws + WS_XB); s.Bbase = (const char*)(ws + WS_WIN); s.lda = 1024; s.ldb = 1024; s.K = 1024; s.nM = T / 256; s.nN = NIN / 256; s.G = G; s.c = c;
        EpiIn e; e.H = (u16*)(ws + WS_H); e.rs1 = (const float*)(ws + WS_RS1); e.SSQ = (float*)(ws + WS_SSQ); e.WI = (float*)(ws + WS_WI);
        g8::gemm_phase(lds, s, e);
    }
    xcd_barrier(xbar);
    {
        g8::PlainSched s; s.Abase = (const char*)(ws + WS_H) + 1024 * 2; s.Bbase = (const char*)(ws + WS_WQ); s.lda = NIN; s.ldb = 256; s.K = 256; s.nM = T / 256; s.nN = 5; s.G = G; s.c = c;
        EpiQ e; e.Q = (u16*)(ws + WS_Q); e.QI = (u16*)(ws + WS_QI); e.SSQ = (const float*)(ws + WS_SSQ);
        g8::gemm_phase(lds, s, e);
        for (int u = c; u < 1024; u += G) gmlp_unit(a, lds, u);
        kvnorm(a);
    }
    xcd_barrier(xbar);
    dsa_phase(a, lds);
    xcd_barrier(xbar);
    {
        g8::PlainSched s; s.Abase = (const char*)(ws + WS_YO); s.Bbase = (const char*)(ws + WS_WCAT); s.lda = 1536; s.ldb = 1536; s.K = 512; s.nM = T / 256; s.nN = 4; s.G = G; s.c = c;
        EpiMrg<0> e0; e0.OUT = (u16*)(ws + WS_TMP); e0.TMP = nullptr; e0.H = (const u16*)(ws + WS_H);
        g8::gemm_phase(lds, s, e0);
        s.Abase = (const char*)(ws + WS_YO) + 512 * 2; s.Bbase = (const char*)(ws + WS_WCAT) + 512 * 2; s.K = 1024;
        EpiMrg<1> e1; e1.OUT = (u16*)(ws + WS_MRG); e1.TMP = (const u16*)(ws + WS_TMP); e1.H = (const u16*)(ws + WS_H);
        g8::gemm_phase(lds, s, e1);
    }
    xcd_barrier(xbar);
    {
        g8::PlainSched s; s.Abase = (const char*)(ws + WS_MRG); s.Bbase = (const char*)(ws + WS_WOUT); s.lda = 1024; s.ldb = 1024; s.K = 1024; s.nM = T / 256; s.nN = 4; s.G = G; s.c = c;
        EpiOut e; e.out = a.out; e.x = a.in[I_X];
        g8::gemm_phase(lds, s, e);
    }
    xcd_barrier(xbar);
    router_phase(a, lds);
    xcd_barrier(xbar);
    moe_table(lds, (const unsigned*)(ws + WS_CTL));
    {
        MoeSched<8, true> s; s.Abase = (const char*)(ws + WS_XN2); s.Wbase = (const char*)(ws + WS_WE1); s.LTOK = (const int*)(ws + WS_LTOK); s.tab = (LAS const int*)(lds + MOE_TAB);
        s.lda = 1024; s.ldb = 1024; s.K = 1024; s.G = G; s.c = c; s.wstride = (size_t)2048 * 1024 * 2;
        EpiMoe1 e; e.ACT = (u16*)(ws + WS_ACT); e.b1 = a.in[I_BE1];
        g8::gemm_phase(lds, s, e);
    }
    xcd_barrier(xbar);
    {
        MoeSched<4, false> s; s.Abase = (const char*)(ws + WS_ACT); s.Wbase = (const char*)(ws + WS_WE2); s.LTOK = nullptr; s.tab = (LAS const int*)(lds + MOE_TAB);
        s.lda = 1024; s.ldb = 1024; s.K = 1024; s.G = G; s.c = c; s.wstride = (size_t)1024 * 1024 * 2;
        EpiMoe2 e; e.YB = (u16*)(ws + WS_YB); e.b2 = a.in[I_BE2]; e.LGATE = (const float*)(ws + WS_LGATE); e.tab = (LAS const int*)(lds + MOE_TAB);
        g8::gemm_phase(lds, s, e);
    }
    xcd_barrier(xbar);
    combine_phase(a, lds);
}

extern "C" void kernel_launch(void* const* d_in, const int* in_sizes, int n_in, void* d_out, int out_size, void* d_ws, size_t ws_size, hipStream_t stream) {
    static int grid = 0;
    if (grid == 0) {
        int dev = 0, cus = 0, per_cu = 0;
        if (n_in != 23 || out_size != T * Dm || ws_size < WS_END) { fprintf(stderr, "kernel_launch: unexpected problem (n_in %d, out %d, ws %zu < %zu)\n", n_in, out_size, ws_size, (size_t)WS_END); grid = -1; return; }
        if (hipGetDevice(&dev) != hipSuccess || hipDeviceGetAttribute(&cus, hipDeviceAttributeMultiprocessorCount, dev) != hipSuccess) { grid = -1; return; }
        if (hipFuncSetAttribute((const void*)fwd, hipFuncAttributeMaxDynamicSharedMemorySize, LDS_BYTES) != hipSuccess) { fprintf(stderr, "hipFuncSetAttribute failed\n"); grid = -1; return; }
        if (hipOccupancyMaxActiveBlocksPerMultiprocessor(&per_cu, (const void*)fwd, NT, LDS_BYTES) != hipSuccess || per_cu < 1) { fprintf(stderr, "occupancy query failed (%d)\n", per_cu); grid = -1; return; }
        grid = cus;
        fprintf(stderr, "kernel_launch: cus %d per_cu %d grid %d ws %zu need %zu\n", cus, per_cu, grid, ws_size, (size_t)WS_END);
    }
    if (grid < 0) return;
    Args a{};
    for (int i = 0; i < 23; ++i) a.in[i] = (const float*)d_in[i];
    a.out = (float*)d_out; a.ws = (unsigned char*)d_ws; a.mask = 0xffffffffu; a.pad = 0u;
    if (hipMemsetAsync((char*)d_ws + WS_CTL, 0, 65536, stream) != hipSuccess) { fprintf(stderr, "memset failed\n"); return; }
    void* args[] = {&a};
    hipError_t e = hipLaunchCooperativeKernel((const void*)fwd, dim3(grid), dim3(NT), args, LDS_BYTES, stream);
    if (e != hipSuccess) fprintf(stderr, "cooperative launch failed: %s (grid %d)\n", hipGetErrorString(e), grid);
}
```

```cpp
#include <hip/hip_runtime.h>
#include <hip/hip_cooperative_groups.h>
#include <cstdio>
#include <cstdint>
namespace cg = cooperative_groups;

#define LAS __attribute__((address_space(3)))
#define DI __device__ __forceinline__
typedef unsigned short u16;
typedef short bf16x8 __attribute__((ext_vector_type(8)));
typedef short s16x4 __attribute__((ext_vector_type(4)));
typedef float f32x4 __attribute__((ext_vector_type(4)));
typedef float f32x2 __attribute__((ext_vector_type(2)));
typedef unsigned u32x4 __attribute__((ext_vector_type(4)));
typedef unsigned u32x2 __attribute__((ext_vector_type(2)));
typedef __bf16 bf2_t __attribute__((ext_vector_type(2)));

constexpr int NT = 512;
constexpr int LDS_BYTES = 155648;
constexpr int Dm = 1024, Bsz = 4, S = 8192, T = Bsz * S;
constexpr int NIN = 3584;
constexpr int NE = 32, ECAP = 32768, PPAD = 131072 + NE * 256;
constexpr float EPS = 1e-6f;

constexpr size_t MiB = 1024 * 1024;
constexpr size_t WS_CTL = 0;
constexpr size_t WS_BAR = 16384;
constexpr int LDS_BARST = LDS_BYTES - 16;
constexpr size_t WS_WIN = 64 * 1024;
constexpr size_t WS_WQ = WS_WIN + (size_t)NIN * 1024 * 2;
constexpr size_t WS_WSP = WS_WQ + 1280 * 256 * 2;
constexpr size_t WS_WCAT = WS_WSP + 4 * 128 * 128 * 2;
constexpr size_t WS_WOUT = WS_WCAT + 1024 * 1536 * 2;
constexpr size_t WS_WR = WS_WOUT + 1024 * 1024 * 2;
constexpr size_t WS_WE1 = WS_WR + 32 * 1024 * 4;
constexpr size_t WS_WE2 = WS_WE1 + (size_t)32 * 2048 * 1024 * 2;
constexpr size_t WS_RS1 = WS_WE2 + (size_t)32 * 1024 * 1024 * 2;
constexpr size_t WS_SSQ = WS_RS1 + (size_t)T * 4;
constexpr size_t WS_WI = WS_SSQ + (size_t)T * 32 * 4;
constexpr size_t WS_ROUTE = WS_WI + (size_t)T * 4 * 4;
constexpr size_t WS_LTOK = WS_ROUTE + (size_t)T * 4 * 4;
constexpr size_t WS_LGATE = WS_LTOK + (size_t)NE * ECAP * 4;
constexpr size_t WS_LRS = WS_LGATE + (size_t)NE * ECAP * 4;
constexpr size_t WS_XN2 = WS_LRS + (size_t)NE * ECAP * 4;
constexpr size_t WS_R0 = WS_XN2 + (size_t)T * 1024 * 2;
constexpr size_t WS_XB = WS_R0;
constexpr size_t WS_H = WS_XB + (size_t)T * 1024 * 2;
constexpr size_t WS_Q = WS_H + (size_t)T * NIN * 2;
constexpr size_t WS_QI = WS_Q + (size_t)T * 1024 * 2;
constexpr size_t WS_KVN = WS_QI + (size_t)T * 256 * 2;
constexpr size_t WS_KIN = WS_KVN + (size_t)T * 128 * 2;
constexpr size_t WS_YO = WS_KIN + (size_t)T * 64 * 2;
constexpr size_t WS_TMP = WS_YO + (size_t)T * 1536 * 2;
constexpr size_t WS_MRG = WS_TMP + (size_t)T * 1024 * 2;
constexpr size_t WS_R0END = WS_MRG + (size_t)T * 1024 * 2;
constexpr size_t WS_ACT = WS_XB;
constexpr size_t WS_YB = WS_Q;
static_assert(WS_ACT + (size_t)PPAD * 1024 * 2 <= WS_Q, "ACT overlaps YB");
static_assert(WS_YB + (size_t)PPAD * 1024 * 2 <= WS_R0END, "YB too large");
constexpr size_t WS_END = WS_R0END;

struct Args { const float* in[23]; float* out; unsigned char* ws; unsigned mask; unsigned pad; };
enum { I_X = 0, I_N1G, I_WIN, I_QLG, I_WUQ, I_QNG, I_KVG, I_WUV, I_WQI, I_KIG, I_VG, I_WSP, I_BSP, I_WPA, I_WPB, I_WOUT, I_N2G, I_WR, I_BR, I_WE1, I_BE1, I_WE2, I_BE2 };

DI unsigned pk2(float a, float b) { f32x2 v = {a, b}; bf2_t r = __builtin_convertvector(v, bf2_t); return __builtin_bit_cast(unsigned, r); }
DI float bflo(unsigned u) { return __uint_as_float(u << 16); }
DI float bfhi(unsigned u) { return __uint_as_float(u & 0xffff0000u); }
DI u16 f2bf(float f) { return (u16)(pk2(f, 0.f) & 0xffffu); }
DI float bf2f(u16 h) { return __uint_as_float(((unsigned)h) << 16); }
DI float sigmoidf_(float x) { return __builtin_amdgcn_rcpf(1.0f + __expf(-x)); }
DI float gelu_tanh(float x) { const float u = 1.5957691216057308f * (x + 0.044715f * x * x * x); return x * sigmoidf_(u); }
DI int otid() { int t = threadIdx.x; asm volatile("" : "+v"(t)); return t; }
DI void wave_lds_sync() { asm volatile("s_waitcnt lgkmcnt(0)" ::: "memory"); }

namespace g8 {
constexpr int BM = 256, BK = 64, HALF = 128, HTB = HALF * BK * 2, STAGE_BYTES = 8 * HTB, NXCD = 8, WGM = 8;
DI int lds_byte(int r, int c) { const int st = (r >> 4) * 2 + (c >> 5), rr = r & 15, cc = c & 31, ob = rr * 64 + cc * 2; return st * 1024 + (ob ^ (((ob >> 9) & 1) << 5)); }
DI void stage_rc(int b, int& R, int& C) { const int st = b / 1024, sb = b % 1024, swz = sb ^ (((sb >> 9) & 1) << 5); R = (st >> 1) * 16 + swz / 64; C = (st & 1) * 32 + (swz % 64) / 2; }

struct UnitD { const char* Bp; int pm, pn, e, rb; };

DI bool static_tile(int i, int G, int c, int nM, int nN, int& pm, int& pn) {
    const int nwg = nM * nN; const long L = (long)i * G + c; if (L >= nwg) return false;
    int wgid = (int)L; { const int q = nwg / NXCD, r = nwg % NXCD, xcd = wgid % NXCD, off = wgid / NXCD; wgid = (xcd < r ? xcd * (q + 1) : r * (q + 1) + (xcd - r) * q) + off; }
    const int nig = WGM * nN, gid = wgid / nig, fm = gid * WGM, gsz = (nM - fm) < WGM ? (nM - fm) : WGM;
    pm = fm + ((wgid % nig) % gsz); pn = (wgid % nig) / gsz; return true;
}

struct PlainSched {
    const char* Abase; const char* Bbase; int lda, ldb, K, nM, nN, G, c;
    DI bool next(int i, UnitD& u) const { int pm, pn; if (!static_tile(i, G, c, nM, nN, pm, pn)) return false; u.pm = pm; u.pn = pn; u.e = 0; u.rb = 0; u.Bp = Bbase + (size_t)pn * BM * ldb * 2; return true; }
    DI void a_offs(const UnitD& u, int R0, int C0, unsigned (&o)[2][2]) const {
#pragma unroll
        for (int h = 0; h < 2; ++h)
#pragma unroll
            for (int i = 0; i < 2; ++i) o[h][i] = (unsigned)(((size_t)(u.pm * BM + h * HALF + R0 + 64 * i) * lda + C0) * 2);
    }
};

template <class Epi, class Sched>
DI void gemm_phase(LAS unsigned char* lds, const Sched& S, const Epi& E) {
    const int tid = otid(), wid = __builtin_amdgcn_readfirstlane(tid >> 6), lane = tid & 63, wr = wid >> 2, wc = wid & 3, fr = lane & 15, fq = lane >> 4;
    const int nt = S.K / BK;
    int R0, C0; stage_rc(tid * 16, R0, C0);
    unsigned voffB[2];
#pragma unroll
    for (int i = 0; i < 2; ++i) voffB[i] = (unsigned)(((R0 + 64 * i) * S.ldb + C0) * 2);
    const size_t hstepB = (size_t)HALF * S.ldb * 2;
    const unsigned ldsw = (unsigned)wid * 1024u;
    const int aoff = lds_byte(wr * 64 + fr, fq * 8), boff = lds_byte(wc * 32 + fr, fq * 8);
    const char* Ab = S.Abase;
#define G8_SA(b, h) (((b) * 2 + (h)) * HTB)
#define G8_SB(b, h) ((4 + (b) * 2 + (h)) * HTB)
#define G8_STAGE_A(bufoff, offs, kb) do { _Pragma("unroll") for (int _i = 0; _i < 2; ++_i) \
        __builtin_amdgcn_global_load_lds((const unsigned*)(Ab + (size_t)(offs)[_i] + (size_t)(kb)), (LAS unsigned*)(lds + (bufoff) + ldsw + _i * 8192), 16, 0, 0); } while (0)
#define G8_STAGE_B(bufoff, gbase, kb) do { _Pragma("unroll") for (int _i = 0; _i < 2; ++_i) \
        __builtin_amdgcn_global_load_lds((const unsigned*)((gbase) + voffB[_i] + (size_t)(kb)), (LAS unsigned*)(lds + (bufoff) + ldsw + _i * 8192), 16, 0, 0); } while (0)
#define G8_LDA(dst, b, h) do { _Pragma("unroll") for (int m = 0; m < 4; ++m) _Pragma("unroll") for (int k = 0; k < 2; ++k) dst[m][k] = *(const LAS bf16x8*)(lds + G8_SA(b, h) + aoff + m * 2048 + k * 1024); } while (0)
#define G8_LDB(dst, b, h) do { _Pragma("unroll") for (int n = 0; n < 2; ++n) _Pragma("unroll") for (int k = 0; k < 2; ++k) dst[n][k] = *(const LAS bf16x8*)(lds + G8_SB(b, h) + boff + n * 2048 + k * 1024); } while (0)
#define G8_MMA(ai, bj, At, Bt) do { __builtin_amdgcn_s_setprio(1); _Pragma("unroll") for (int m = 0; m < 4; ++m) _Pragma("unroll") for (int n = 0; n < 2; ++n) _Pragma("unroll") for (int k = 0; k < 2; ++k) \
        acc[ai][bj][m][n] = __builtin_amdgcn_mfma_f32_16x16x32_bf16(Bt[n][k], At[m][k], acc[ai][bj][m][n], 0, 0, 0); __builtin_amdgcn_s_setprio(0); } while (0)
#define G8_WAIT_V(n) asm volatile("s_waitcnt vmcnt(" #n ")" ::: "memory")
#define G8_WAIT_L(n) asm volatile("s_waitcnt lgkmcnt(" #n ")" ::: "memory")
#define G8_BAR __builtin_amdgcn_s_barrier()
#define G8_SCHED __builtin_amdgcn_sched_barrier(0)
    UnitD cur, nxt; int ui = 0;
    if (!S.next(0, cur)) return;
    f32x4 acc[2][2][4][2];
#pragma unroll
    for (int a = 0; a < 2; ++a)
#pragma unroll
        for (int b = 0; b < 2; ++b)
#pragma unroll
            for (int m = 0; m < 4; ++m)
#pragma unroll
                for (int n = 0; n < 2; ++n) acc[a][b][m][n] = (f32x4){0.f, 0.f, 0.f, 0.f};
    bf16x8 At[4][2], B0[2][2], B1[2][2];
    unsigned cA[2][2];
    S.a_offs(cur, R0, C0, cA);
    const char* cB = cur.Bp;
    G8_STAGE_B(G8_SB(0, 0), cB, 0); G8_STAGE_A(G8_SA(0, 0), cA[0], 0); G8_STAGE_B(G8_SB(0, 1), cB + hstepB, 0); G8_STAGE_A(G8_SA(0, 1), cA[1], 0);
    if (wr == 1) G8_BAR;
    G8_WAIT_V(4); G8_BAR;
    G8_STAGE_B(G8_SB(1, 0), cB, 128); G8_STAGE_A(G8_SA(1, 0), cA[0], 128); G8_STAGE_B(G8_SB(1, 1), cB + hstepB, 128);
    G8_WAIT_V(6); G8_BAR;
    for (;;) {
        const bool has_next = S.next(ui + 1, nxt);
        const char* nB = has_next ? nxt.Bp : cB;
        for (int t = 0; t < nt; t += 2) {
            const bool last = (t == nt - 2);
            const unsigned k1 = (unsigned)(t + 1) * 128u;
            const unsigned k2 = last ? 0u : (unsigned)(t + 2) * 128u, k3 = k2 + 128u;
            unsigned c1[2] = {cA[1][0], cA[1][1]};
            if (last && has_next) S.a_offs(nxt, R0, C0, cA);
            const char* b2 = last ? nB : cB;
            G8_LDB(B0, 0, 0); G8_SCHED; G8_LDA(At, 0, 0); G8_STAGE_A(G8_SA(1, 1), c1, k1);
            G8_WAIT_L(8); G8_BAR; G8_WAIT_L(0); G8_MMA(0, 0, At, B0); G8_BAR; G8_SCHED;
            G8_LDB(B1, 0, 1); G8_STAGE_B(G8_SB(0, 0), b2, k2);
            G8_BAR; G8_WAIT_L(0); G8_MMA(0, 1, At, B1); G8_BAR;
            G8_LDA(At, 0, 1); G8_STAGE_A(G8_SA(0, 0), cA[0], k2);
            G8_BAR; G8_WAIT_L(0); G8_MMA(1, 0, At, B0); G8_BAR; G8_SCHED;
            G8_STAGE_B(G8_SB(0, 1), b2 + hstepB, k2);
            G8_WAIT_V(6); G8_BAR; G8_MMA(1, 1, At, B1); G8_BAR;
            G8_LDB(B0, 1, 0); G8_SCHED; G8_LDA(At, 1, 0); G8_STAGE_A(G8_SA(0, 1), cA[1], k2);
            G8_WAIT_L(8); G8_BAR; G8_WAIT_L(0); G8_MMA(0, 0, At, B0); G8_BAR; G8_SCHED;
            G8_LDB(B1, 1, 1); G8_STAGE_B(G8_SB(1, 0), b2, k3);
            G8_BAR; G8_WAIT_L(0); G8_MMA(0, 1, At, B1); G8_BAR;
            G8_LDA(At, 1, 1); G8_STAGE_A(G8_SA(1, 0), cA[0], k3);
            G8_BAR; G8_WAIT_L(0); G8_MMA(1, 0, At, B0); G8_BAR; G8_SCHED;
            G8_STAGE_B(G8_SB(1, 1), b2 + hstepB, k3);
            G8_WAIT_V(6); G8_BAR; G8_MMA(1, 1, At, B1); G8_BAR;
        }
        E(acc, cur, wr, wc, fr, fq);
        if (!has_next) break;
#pragma unroll
        for (int a = 0; a < 2; ++a)
#pragma unroll
            for (int b = 0; b < 2; ++b)
#pragma unroll
                for (int m = 0; m < 4; ++m)
#pragma unroll
                    for (int n = 0; n < 2; ++n) acc[a][b][m][n] = (f32x4){0.f, 0.f, 0.f, 0.f};
        cur = nxt; cB = nB; ++ui;
    }
    G8_WAIT_V(0);
    if (wr == 0) G8_BAR;
    G8_BAR;
#undef G8_SA
#undef G8_SB
#undef G8_STAGE_A
#undef G8_STAGE_B
#undef G8_LDA
#undef G8_LDB
#undef G8_MMA
#undef G8_WAIT_V
#undef G8_WAIT_L
#undef G8_BAR
#undef G8_SCHED
}
}
using g8::UnitD;
typedef f32x4 Acc[2][2][4][2];

struct EpiIn {
    u16* H; const float* rs1; float* SSQ; float* WI;
    DI void operator()(const Acc& acc, const UnitD& u, int wr, int wc, int fr, int fq) const {
        const int pn = u.pn;
#pragma unroll
        for (int ai = 0; ai < 2; ++ai)
#pragma unroll
            for (int m = 0; m < 4; ++m) {
                const int row = u.pm * 256 + ai * 128 + wr * 64 + m * 16 + fr;
                const float rs = rs1[row];
#pragma unroll
                for (int bj = 0; bj < 2; ++bj) {
                    float ssq = 0.f;
#pragma unroll
                    for (int n = 0; n < 2; ++n) {
                        const int col = pn * 256 + bj * 128 + wc * 32 + n * 16 + 4 * fq;
                        f32x4 v = acc[ai][bj][m][n] * rs;
                        if (pn < 4) { v[0] = gelu_tanh(v[0]); v[1] = gelu_tanh(v[1]); v[2] = gelu_tanh(v[2]); v[3] = gelu_tanh(v[3]); }
                        else if (pn >= 6) { v[0] = sigmoidf_(v[0]); v[1] = sigmoidf_(v[1]); v[2] = sigmoidf_(v[2]); v[3] = sigmoidf_(v[3]); }
                        ssq += (v[0] * v[0] + v[1] * v[1]) + (v[2] * v[2] + v[3] * v[3]);
                        u32x2 w; w.x = pk2(v[0], v[1]); w.y = pk2(v[2], v[3]);
                        *(u32x2*)(H + (size_t)row * NIN + col) = w;
                        if (pn == 5 && bj == 1 && wc == 2 && n == 0 && fq == 0) *(f32x4*)(WI + (size_t)row * 4) = v * 0.5f;
                    }
                    if (pn >= 2 && pn <= 5) {
                        ssq += __shfl_xor(ssq, 16); ssq += __shfl_xor(ssq, 32);
                        if (fq == 0) SSQ[(size_t)row * 32 + (pn - 2) * 8 + bj * 4 + wc] = ssq;
                    }
                }
            }
    }
};
struct EpiQ {
    u16* Q; u16* QI; const float* SSQ;
    DI void operator()(const Acc& acc, const UnitD& u, int wr, int wc, int fr, int fq) const {
#pragma unroll
        for (int ai = 0; ai < 2; ++ai)
#pragma unroll
            for (int m = 0; m < 4; ++m) {
                const int row = u.pm * 256 + ai * 128 + wr * 64 + m * 16 + fr;
                const f32x4 s0 = *(const f32x4*)(SSQ + (size_t)row * 32 + 16), s1 = *(const f32x4*)(SSQ + (size_t)row * 32 + 20);
                const float ss = ((s0[0] + s0[1]) + (s0[2] + s0[3])) + ((s1[0] + s1[1]) + (s1[2] + s1[3]));
                const float rs = __builtin_amdgcn_rsqf(ss * (1.0f / 256.0f) + EPS);
#pragma unroll
                for (int bj = 0; bj < 2; ++bj)
#pragma unroll
                    for (int n = 0; n < 2; ++n) {
                        const int col = u.pn * 256 + bj * 128 + wc * 32 + n * 16 + 4 * fq;
                        const f32x4 v = acc[ai][bj][m][n] * rs;
                        u32x2 w; w.x = pk2(v[0], v[1]); w.y = pk2(v[2], v[3]);
                        if (col < 1024) *(u32x2*)(Q + (size_t)row * 1024 + col) = w; else *(u32x2*)(QI + (size_t)row * 256 + (col - 1024)) = w;
                    }
            }
    }
};
template <int SECOND> struct EpiMrg {
    u16* OUT; const u16* TMP; const u16* H;
    DI void operator()(const Acc& acc, const UnitD& u, int wr, int wc, int fr, int fq) const {
#pragma unroll
        for (int ai = 0; ai < 2; ++ai)
#pragma unroll
            for (int m = 0; m < 4; ++m) {
                const int row = u.pm * 256 + ai * 128 + wr * 64 + m * 16 + fr;
#pragma unroll
                for (int bj = 0; bj < 2; ++bj)
#pragma unroll
                    for (int n = 0; n < 2; ++n) {
                        const int col = u.pn * 256 + bj * 128 + wc * 32 + n * 16 + 4 * fq;
                        const u32x2 g = *(const u32x2*)(H + (size_t)row * NIN + 1536 + SECOND * 1024 + col);
                        f32x4 v = acc[ai][bj][m][n];
                        v[0] *= bflo(g.x); v[1] *= bfhi(g.x); v[2] *= bflo(g.y); v[3] *= bfhi(g.y);
                        if (SECOND) { const u32x2 t = *(const u32x2*)(TMP + (size_t)row * 1024 + col); v[0] += bflo(t.x); v[1] += bfhi(t.x); v[2] += bflo(t.y); v[3] += bfhi(t.y); }
                        u32x2 w; w.x = pk2(v[0], v[1]); w.y = pk2(v[2], v[3]);
                        *(u32x2*)(OUT + (size_t)row * 1024 + col) = w;
                    }
            }
    }
};
struct EpiOut {
    float* out; const float* x; u16* XN;
    DI void operator()(const Acc& acc, const UnitD& u, int wr, int wc, int fr, int fq) const {
#pragma unroll
        for (int ai = 0; ai < 2; ++ai)
#pragma unroll
            for (int m = 0; m < 4; ++m) {
                const int row = u.pm * 256 + ai * 128 + wr * 64 + m * 16 + fr;
#pragma unroll
                for (int bj = 0; bj < 2; ++bj)
#pragma unroll
                    for (int n = 0; n < 2; ++n) {
                        const size_t o = (size_t)row * 1024 + u.pn * 256 + bj * 128 + wc * 32 + n * 16 + 4 * fq;
                        const f32x4 v = *(const f32x4*)(x + o) + acc[ai][bj][m][n];
                        *(f32x4*)(out + o) = v;
                        u32x2 w; w.x = pk2(v[0], v[1]); w.y = pk2(v[2], v[3]); *(u32x2*)(XN + o) = w;
                    }
            }
    }
};

constexpr int MOE_TAB = g8::STAGE_BYTES;
DI void moe_table(LAS unsigned char* lds, const unsigned* CNT) {
    LAS int* tab = (LAS int*)(lds + MOE_TAB);
    __syncthreads();
    if (threadIdx.x == 0) { int acc = 0; for (int e = 0; e < NE; ++e) { const int c = (int)__hip_atomic_load(CNT + e, __ATOMIC_RELAXED, __HIP_MEMORY_SCOPE_AGENT); tab[e] = acc; tab[33 + e] = c; acc += (c + 255) >> 8; } tab[32] = acc; }
    __syncthreads();
}
template <int NPN, bool GATHER> struct MoeSched {
    const char* Abase; const char* Wbase; const int* LTOK; LAS const int* tab; int lda, ldb, K, G, c; size_t wstride;
    DI bool next(int i, UnitD& u) const {
        const long L = (long)i * G + c; const int R = tab[32];
        if (L >= (long)R * NPN) return false;
        const int rbg = (int)(L / NPN), pn = (int)(L % NPN);
        int e = 0;
        for (int j = 1; j < NE; ++j) e += (tab[j] <= rbg) ? 1 : 0;
        e = __builtin_amdgcn_readfirstlane(e);
        u.pm = rbg; u.pn = pn; u.e = e; u.rb = rbg - tab[e];
        u.Bp = Wbase + (size_t)e * wstride + (size_t)pn * 256 * ldb * 2;
        return true;
    }
    DI void a_offs(const UnitD& u, int R0, int C0, unsigned (&o)[2][2]) const {
        const int cnt = tab[33 + u.e];
#pragma unroll
        for (int h = 0; h < 2; ++h)
#pragma unroll
            for (int i = 0; i < 2; ++i) {
                const int r = h * 128 + R0 + 64 * i;
                if (GATHER) { const int slot = u.rb * 256 + r; const int tok = slot < cnt ? LTOK[(size_t)u.e * ECAP + slot] : 0; o[h][i] = (unsigned)(((size_t)tok * lda + C0) * 2); }
                else o[h][i] = (unsigned)(((size_t)(u.pm * 256 + r) * lda + C0) * 2);
            }
    }
};
struct EpiMoe1 {
    u16* ACT; const float* b1; const float* LRS; LAS const int* tab;
    DI void operator()(const Acc& acc, const UnitD& u, int wr, int wc, int fr, int fq) const {
        const float* be = b1 + (size_t)u.e * 2048; const int cnt = tab[33 + u.e];
        float rsv[2][4];
#pragma unroll
        for (int ai = 0; ai < 2; ++ai)
#pragma unroll
            for (int m = 0; m < 4; ++m) { const int slot = u.rb * 256 + ai * 128 + wr * 64 + m * 16 + fr; rsv[ai][m] = slot < cnt ? LRS[(size_t)u.e * ECAP + slot] : 0.f; }
#pragma unroll
        for (int n = 0; n < 2; ++n) {
            const int hc = u.pn * 128 + wc * 32 + n * 16 + 4 * fq;
            const f32x4 bg = *(const f32x4*)(be + hc), bu = *(const f32x4*)(be + 1024 + hc);
#pragma unroll
            for (int ai = 0; ai < 2; ++ai)
#pragma unroll
                for (int m = 0; m < 4; ++m) {
                    const int row = u.pm * 256 + ai * 128 + wr * 64 + m * 16 + fr;
                    const f32x4 g = acc[ai][0][m][n] * rsv[ai][m] + bg, up = acc[ai][1][m][n] * rsv[ai][m] + bu;
                    float a[4];
#pragma unroll
                    for (int j = 0; j < 4; ++j) { const float hg = fminf(g[j], 7.0f), hu = fminf(fmaxf(up[j], -7.0f), 7.0f); a[j] = (hu + 1.0f) * (hg * sigmoidf_(1.702f * hg)); }
                    u32x2 w; w.x = pk2(a[0], a[1]); w.y = pk2(a[2], a[3]);
                    *(u32x2*)(ACT + (size_t)row * 1024 + hc) = w;
                }
        }
    }
};
struct EpiMoe2 {
    u16* YB; const float* b2; const float* LGATE; LAS const int* tab;
    DI void operator()(const Acc& acc, const UnitD& u, int wr, int wc, int fr, int fq) const {
        const float* be = b2 + (size_t)u.e * 1024; const int cnt = tab[33 + u.e];
#pragma unroll
        for (int ai = 0; ai < 2; ++ai)
#pragma unroll
            for (int m = 0; m < 4; ++m) {
                const int r = ai * 128 + wr * 64 + m * 16 + fr, slot = u.rb * 256 + r;
                const float gate = slot < cnt ? LGATE[(size_t)u.e * ECAP + slot] : 0.f;
#pragma unroll
                for (int bj = 0; bj < 2; ++bj)
#pragma unroll
                    for (int n = 0; n < 2; ++n) {
                        const int col = u.pn * 256 + bj * 128 + wc * 32 + n * 16 + 4 * fq;
                        const f32x4 v = (acc[ai][bj][m][n] + *(const f32x4*)(be + col)) * gate;
                        u32x2 w; w.x = pk2(v[0], v[1]); w.y = pk2(v[2], v[3]);
                        *(u32x2*)(YB + (size_t)(u.pm * 256 + r) * 1024 + col) = w;
                    }
            }
    }
};

template <class F> DI void tr_tile(LAS unsigned char* lds, const float* src, int ld_src, int Nsz, int k0, int n0, const float* sk, float mul, u16* dst, int ld_dst, F rowmap) {
    LAS float* t = (LAS float*)lds;
    const int tid = otid();
    __syncthreads();
#pragma unroll
    for (int it = 0; it < 2; ++it) {
        const int k = (tid >> 4) + 32 * it, n = 4 * (tid & 15);
        f32x4 v = {0.f, 0.f, 0.f, 0.f};
        if (n0 + n < Nsz) v = *(const f32x4*)(src + (size_t)(k0 + k) * ld_src + n0 + n);
        const float s = (sk ? sk[k0 + k] : 1.0f) * mul;
        t[k * 65 + n] = v[0] * s; t[k * 65 + n + 1] = v[1] * s; t[k * 65 + n + 2] = v[2] * s; t[k * 65 + n + 3] = v[3] * s;
    }
    __syncthreads();
    const int n = tid >> 3, kc = (tid & 7) * 8;
    if (n0 + n < Nsz) {
        u32x4 w;
        w.x = pk2(t[(kc + 0) * 65 + n], t[(kc + 1) * 65 + n]); w.y = pk2(t[(kc + 2) * 65 + n], t[(kc + 3) * 65 + n]);
        w.z = pk2(t[(kc + 4) * 65 + n], t[(kc + 5) * 65 + n]); w.w = pk2(t[(kc + 6) * 65 + n], t[(kc + 7) * 65 + n]);
        *(u32x4*)(dst + (size_t)rowmap(n0 + n) * ld_dst + k0 + kc) = w;
    }
}
struct MapId { DI int operator()(int n) const { return n; } };
struct MapIn { DI int operator()(int n) const { return n < 1476 ? n : n + 60; } };
struct MapE1 { DI int operator()(int n) const { const int hi = n >= 1024 ? 1 : 0, q = n - hi * 1024; return (q >> 7) * 256 + hi * 128 + (q & 127); } };

DI void phase0(const Args& a, LAS unsigned char* lds) {
    unsigned char* ws = a.ws;
    const int tid = otid();
    const size_t gtid = (size_t)blockIdx.x * NT + tid, gstride = (size_t)gridDim.x * NT;
    for (size_t i = gtid; i < 60 * 1024 / 2; i += gstride) ((unsigned*)(ws + WS_WIN + (size_t)1476 * 1024 * 2))[i] = 0u;
    for (size_t i = gtid; i < 32 * 1024; i += gstride) { const int e = (int)(i >> 10), k = (int)(i & 1023); const float w = a.in[I_WR][k * 32 + e] * a.in[I_N2G][k]; const u16 h = f2bf(w); ((u16*)(ws + WS_WR))[i] = h; ((u16*)(ws + WS_WR))[32 * 1024 + i] = f2bf(w - bf2f(h)); }
    for (size_t i = gtid; i < 4 * 128 * 128; i += gstride) { const int tt = (int)((i >> 7) & 127), ss = (int)(i & 127); ((u16*)(ws + WS_WSP))[i] = f2bf(ss <= tt ? a.in[I_WSP][i] : 0.f); }
    {
        const int wid = tid >> 6, lane = tid & 63;
        for (int row = blockIdx.x * 8 + wid; row < T; row += gridDim.x * 8) {
            const float* xr = a.in[I_X] + (size_t)row * 1024; u16* xb = (u16*)(ws + WS_XB) + (size_t)row * 1024;
            float ss = 0.f;
#pragma unroll
            for (int i = 0; i < 4; ++i) {
                const f32x4 v = *(const f32x4*)(xr + i * 256 + lane * 4);
                ss += (v[0] * v[0] + v[1] * v[1]) + (v[2] * v[2] + v[3] * v[3]);
                u32x2 w; w.x = pk2(v[0], v[1]); w.y = pk2(v[2], v[3]);
                *(u32x2*)(xb + i * 256 + lane * 4) = w;
            }
#pragma unroll
            for (int o = 32; o >= 1; o >>= 1) ss += __shfl_xor(ss, o);
            if (lane == 0) ((float*)(ws + WS_RS1))[row] = __builtin_amdgcn_rsqf(ss * (1.0f / 1024.0f) + EPS);
        }
    }
    constexpr int U_IN = 16 * 56, U_UQ = 4 * 16, U_QI = 4 * 4, U_PA = 8 * 16, U_OUT = 16 * 16, U_E1 = 32 * 16 * 32, U_E2 = 32 * 16 * 16, U_CB = 64;
    constexpr int U_TOT = U_IN + U_UQ + U_QI + U_PA + U_OUT + U_E1 + U_E2 + U_CB;
    for (int u = blockIdx.x; u < U_TOT; u += gridDim.x) {
        int v = u;
        if (v < U_IN) { tr_tile(lds, a.in[I_WIN], 3524, 3524, (v & 15) * 64, (v >> 4) * 64, a.in[I_N1G], 1.0f, (u16*)(ws + WS_WIN), 1024, MapIn()); continue; }
        v -= U_IN;
        if (v < U_UQ) { tr_tile(lds, a.in[I_WUQ], 1024, 1024, (v & 3) * 64, (v >> 2) * 64, a.in[I_QLG], 1.0f, (u16*)(ws + WS_WQ), 256, MapId()); continue; }
        v -= U_UQ;
        if (v < U_QI) { tr_tile(lds, a.in[I_WQI], 256, 256, (v & 3) * 64, (v >> 2) * 64, a.in[I_QLG], 0.125f, (u16*)(ws + WS_WQ) + 1024 * 256, 256, MapId()); continue; }
        v -= U_QI;
        if (v < U_PA) { tr_tile(lds, a.in[I_WPA], 1024, 1024, (v & 7) * 64, (v >> 3) * 64, nullptr, 1.0f, (u16*)(ws + WS_WCAT), 1536, MapId()); continue; }
        v -= U_PA;
        if (v < U_OUT) { tr_tile(lds, a.in[I_WOUT], 1024, 1024, (v & 15) * 64, (v >> 4) * 64, nullptr, 1.0f, (u16*)(ws + WS_WOUT), 1024, MapId()); continue; }
        v -= U_OUT;
        if (v < U_E1) { const int e = v >> 9, w = v & 511; tr_tile(lds, a.in[I_WE1] + (size_t)e * 1024 * 2048, 2048, 2048, (w & 15) * 64, (w >> 4) * 64, a.in[I_N2G], 1.0f, (u16*)(ws + WS_WE1) + (size_t)e * 2048 * 1024, 1024, MapE1()); continue; }
        v -= U_E1;
        if (v < U_E2) { const int e = v >> 8, w = v & 255; tr_tile(lds, a.in[I_WE2] + (size_t)e * 1024 * 1024, 1024, 1024, (w & 15) * 64, (w >> 4) * 64, nullptr, 1.0f, (u16*)(ws + WS_WE2) + (size_t)e * 1024 * 1024, 1024, MapId()); continue; }
        v -= U_E2;
        {
            const int h = v >> 3, c0 = (v & 7) * 16;
            LAS float* t = (LAS float*)lds;
            __syncthreads();
            for (int i = tid; i < 1024; i += NT) t[i] = a.in[I_WUV][(size_t)h * 128 * 64 + (size_t)c0 * 64 + i];
            __syncthreads();
            for (int nn = tid; nn < 1024; nn += NT) {
                float accv[16];
#pragma unroll
                for (int i = 0; i < 16; ++i) accv[i] = 0.f;
                for (int vv = 0; vv < 64; ++vv) {
                    const float pb = a.in[I_WPB][(size_t)(h * 64 + vv) * 1024 + nn];
#pragma unroll
                    for (int i = 0; i < 16; ++i) accv[i] += t[i * 64 + vv] * pb;
                }
                u32x4 w0, w1;
                w0.x = pk2(accv[0], accv[1]); w0.y = pk2(accv[2], accv[3]); w0.z = pk2(accv[4], accv[5]); w0.w = pk2(accv[6], accv[7]);
                w1.x = pk2(accv[8], accv[9]); w1.y = pk2(accv[10], accv[11]); w1.z = pk2(accv[12], accv[13]); w1.w = pk2(accv[14], accv[15]);
                u16* d = (u16*)(ws + WS_WCAT) + (size_t)nn * 1536 + 512 + h * 128 + c0;
                *(u32x4*)d = w0; *(u32x4*)(d + 8) = w1;
            }
        }
    }
}

DI void gmlp_unit(const Args& a, LAS unsigned char* lds, int u) {
    unsigned char* ws = a.ws;
    const int tid = otid(), wid = tid >> 6, lane = tid & 63, fr = lane & 15, fq = lane >> 4;
    const int g = u & 3, row0 = (u >> 2) * 128;
    const u16* H = (const u16*)(ws + WS_H);
    LAS u16* img = (LAS u16*)lds;
    __syncthreads();
    {
        const int s = tid & 127, cset = tid >> 7;
        const f32x4 sq = *(const f32x4*)((const float*)(ws + WS_SSQ) + (size_t)(row0 + s) * 32 + g * 4);
        const float rs = __builtin_amdgcn_rsqf(((sq[0] + sq[1]) + (sq[2] + sq[3])) * (1.0f / 128.0f) + EPS);
#pragma unroll
        for (int it = 0; it < 4; ++it) {
            const int c = cset + 4 * it;
            const u32x4 raw = *(const u32x4*)(H + (size_t)(row0 + s) * NIN + 512 + g * 128 + 8 * c);
            const float* vg = a.in[I_VG] + 8 * c;
            float f[8] = {bflo(raw.x), bfhi(raw.x), bflo(raw.y), bfhi(raw.y), bflo(raw.z), bfhi(raw.z), bflo(raw.w), bfhi(raw.w)};
#pragma unroll
            for (int i = 0; i < 8; ++i) img[(8 * c + i) * 136 + s] = f2bf(f[i] * rs * vg[i]);
        }
    }
    __syncthreads();
    const u16* W = (const u16*)(ws + WS_WSP) + (size_t)g * 128 * 128 + (size_t)(16 * wid + fr) * 128;
    f32x4 acc[8];
#pragma unroll
    for (int i = 0; i < 8; ++i) acc[i] = (f32x4){0.f, 0.f, 0.f, 0.f};
    const int nks = (16 * wid + 15) / 32 + 1;
    for (int ks = 0; ks < nks; ++ks) {
        const bf16x8 bw = *(const bf16x8*)(W + ks * 32 + 8 * fq);
#pragma unroll
        for (int i = 0; i < 8; ++i) {
            const bf16x8 av = *(const LAS bf16x8*)(img + (16 * i + fr) * 136 + ks * 32 + 8 * fq);
            acc[i] = __builtin_amdgcn_mfma_f32_16x16x32_bf16(av, bw, acc[i], 0, 0, 0);
        }
    }
    const int t = 16 * wid + fr;
    const float bias = a.in[I_BSP][g * 128 + t];
    u16* YO = (u16*)(ws + WS_YO);
#pragma unroll
    for (int i = 0; i < 8; ++i) {
        const int d = 16 * i + 4 * fq;
        const u32x2 uu = *(const u32x2*)(H + (size_t)(row0 + t) * NIN + g * 128 + d);
        const float y0 = bflo(uu.x) * (acc[i][0] + bias), y1 = bfhi(uu.x) * (acc[i][1] + bias), y2 = bflo(uu.y) * (acc[i][2] + bias), y3 = bfhi(uu.y) * (acc[i][3] + bias);
        u32x2 w; w.x = pk2(y0, y1); w.y = pk2(y2, y3);
        *(u32x2*)(YO + (size_t)(row0 + t) * 1536 + g * 128 + d) = w;
    }
}

DI void kvnorm(const Args& a) {
    unsigned char* ws = a.ws;
    const u16* H = (const u16*)(ws + WS_H); const float* SSQ = (const float*)(ws + WS_SSQ);
    const size_t gtid = (size_t)blockIdx.x * NT + otid(), gstride = (size_t)gridDim.x * NT;
    for (size_t idx = gtid; idx < (size_t)T * 24; idx += gstride) {
        const int row = (int)(idx / 24), c = (int)(idx % 24);
        const u16* src; u16* dst; const float* gain; float rs;
        if (c < 16) {
            const f32x4 sq = *(const f32x4*)(SSQ + (size_t)row * 32 + 24);
            rs = __builtin_amdgcn_rsqf(((sq[0] + sq[1]) + (sq[2] + sq[3])) * (1.0f / 128.0f) + EPS);
            src = H + (size_t)row * NIN + 1280 + 8 * c; dst = (u16*)(ws + WS_KVN) + (size_t)row * 128 + 8 * c; gain = a.in[I_KVG] + 8 * c;
        } else {
            const int cc = c - 16;
            rs = __builtin_amdgcn_rsqf((SSQ[(size_t)row * 32 + 28] + SSQ[(size_t)row * 32 + 29]) * (1.0f / 64.0f) + EPS);
            src = H + (size_t)row * NIN + 1408 + 8 * cc; dst = (u16*)(ws + WS_KIN) + (size_t)row * 64 + 8 * cc; gain = a.in[I_KIG] + 8 * cc;
        }
        const u32x4 raw = *(const u32x4*)src;
        u32x4 w;
        w.x = pk2(bflo(raw.x) * rs * gain[0], bfhi(raw.x) * rs * gain[1]); w.y = pk2(bflo(raw.y) * rs * gain[2], bfhi(raw.y) * rs * gain[3]);
        w.z = pk2(bflo(raw.z) * rs * gain[4], bfhi(raw.z) * rs * gain[5]); w.w = pk2(bflo(raw.w) * rs * gain[6], bfhi(raw.w) * rs * gain[7]);
        *(u32x4*)dst = w;
    }
}

constexpr int P3_ROWS = 0, P3_HIST = 131072, P3_LIST = 147456;
DI unsigned f2key(float f) { const unsigned u = __float_as_uint(f); return (u & 0x80000000u) ? ~u : (u | 0x80000000u); }
DI int wave_incl_scan(int v, int lane) {
#pragma unroll
    for (int o = 1; o < 64; o <<= 1) { const int t = __shfl_up(v, o); if (lane >= o) v += t; }
    return v;
}
DI int wave_suffix_scan(int v, int lane) {
#pragma unroll
    for (int o = 1; o < 64; o <<= 1) { const int t = __shfl_down(v, o); if (lane + o < 64) v += t; }
    return v;
}
DI unsigned pk_gt(unsigned kw, unsigned xw, unsigned one) {
    unsigned d, m;
    asm("v_pk_sub_u16 %0, %1, %2 clamp" : "=v"(d) : "v"(kw), "v"(xw));
    asm("v_pk_min_u16 %0, %1, %2" : "=v"(m) : "v"(d), "v"(one));
    return m;
}
DI unsigned pk_subs(unsigned kw, unsigned xw) { unsigned d; asm("v_pk_sub_u16 %0, %1, %2 clamp" : "=v"(d) : "v"(kw), "v"(xw)); return d; }
DI unsigned pk_min1(unsigned d, unsigned one) { unsigned m; asm("v_pk_min_u16 %0, %1, %2" : "=v"(m) : "v"(d), "v"(one)); return m; }
DI unsigned pk_add(unsigned a, unsigned b) { unsigned r; asm("v_pk_add_u16 %0, %1, %2" : "=v"(r) : "v"(a), "v"(b)); return r; }
DI int wave_sum(int v) {
    v += __builtin_amdgcn_update_dpp(0, v, 0xB1, 0xf, 0xf, false);
    v += __builtin_amdgcn_update_dpp(0, v, 0x4E, 0xf, 0xf, false);
    v += __builtin_amdgcn_update_dpp(0, v, 0x141, 0xf, 0xf, false);
    v += __builtin_amdgcn_update_dpp(0, v, 0x140, 0xf, 0xf, false);
    return __builtin_amdgcn_readlane(v, 0) + __builtin_amdgcn_readlane(v, 16) + __builtin_amdgcn_readlane(v, 32) + __builtin_amdgcn_readlane(v, 48);
}
DI int rowaddr(int p) { return (p & ~511) | ((p & 63) << 3) | ((p >> 6) & 7); }
typedef unsigned short us2_t __attribute__((ext_vector_type(2)));
DI unsigned dot2acc(unsigned flags, unsigned wts, unsigned acc) { return __builtin_amdgcn_udot2(__builtin_bit_cast(us2_t, flags), __builtin_bit_cast(us2_t, wts), acc, false); }
DI void select_top16(LAS u16* row, LAS u16* list, int N, int lane) {
    const int Nup = (N + 511) & ~511, niter = Nup >> 9;
    for (int p = N + lane; p < Nup; p += 64) row[rowaddr(p)] = (u16)0;
    wave_lds_sync();
    u32x4 kr[16];
#pragma unroll
    for (int i = 0; i < 16; ++i) { kr[i] = (u32x4){0u, 0u, 0u, 0u}; if (i < niter) kr[i] = *(LAS const u32x4*)(row + i * 512 + lane * 8); }
    const unsigned one = 0x00010001u;
    auto count_gt = [&](unsigned x) -> int {
        const unsigned xw = x | (x << 16);
        unsigned acc = 0u, acc1 = 0u, acc2 = 0u, acc3 = 0u;
#pragma unroll
        for (int c = 0; c < 4; ++c) {
            if (4 * c < niter) {
                unsigned d[16];
#pragma unroll
                for (int i = 0; i < 4; ++i) { d[4 * i] = pk_subs(kr[4 * c + i].x, xw); d[4 * i + 1] = pk_subs(kr[4 * c + i].y, xw); d[4 * i + 2] = pk_subs(kr[4 * c + i].z, xw); d[4 * i + 3] = pk_subs(kr[4 * c + i].w, xw); }
#pragma unroll
                for (int i = 0; i < 16; ++i) d[i] = pk_min1(d[i], one);
#pragma unroll
                for (int i = 0; i < 16; i += 4) { acc = dot2acc(d[i], one, acc); acc1 = dot2acc(d[i + 1], one, acc1); acc2 = dot2acc(d[i + 2], one, acc2); acc3 = dot2acc(d[i + 3], one, acc3); }
            }
        }
        return wave_sum((int)((acc + acc1) + (acc2 + acc3)));
    };
    unsigned T = 0u; int cge = Nup;
#pragma unroll 1
    for (int bit = 15; bit >= 0; --bit) {
        const unsigned cand = T | (1u << bit);
        const int cnt = count_gt(cand - 1u);
        if (cnt >= 256) { T = cand; cge = cnt; }
    }
    auto build = [&](unsigned x, unsigned (&M)[4]) {
        const unsigned xw = x | (x << 16);
#pragma unroll
        for (int c = 0; c < 4; ++c) {
            M[c] = 0u;
            if (4 * c < niter) {
#pragma unroll
                for (int i = 4 * c; i < 4 * c + 4; ++i) {
                    unsigned byte = dot2acc(pk_gt(kr[i].x, xw, one), 0x00020001u, 0u);
                    byte = dot2acc(pk_gt(kr[i].y, xw, one), 0x00080004u, byte);
                    byte = dot2acc(pk_gt(kr[i].z, xw, one), 0x00200010u, byte);
                    byte = dot2acc(pk_gt(kr[i].w, xw, one), 0x00800040u, byte);
                    M[c] |= byte << (8 * (i & 3));
                }
            }
        }
    };
    unsigned M[4];
    build(T - 1u, M);
    if (cge != 256) {
        unsigned G[4]; build(T, G);
        unsigned E[4];
#pragma unroll
        for (int c = 0; c < 4; ++c) E[c] = M[c] & ~G[c];
        const int need = 256 - (cge - wave_sum((int)(__builtin_popcount(E[0]) + __builtin_popcount(E[1]) + __builtin_popcount(E[2]) + __builtin_popcount(E[3]))));
        auto below = [&](int B, int c) -> unsigned { const int nb = B - 32 * c; return nb <= 0 ? 0u : (nb >= 32 ? 0xffffffffu : ((1u << nb) - 1u)); };
        auto ties_below = [&](int B) -> int {
            return wave_sum((int)(__builtin_popcount(E[0] & below(B, 0)) + __builtin_popcount(E[1] & below(B, 1)) + __builtin_popcount(E[2] & below(B, 2)) + __builtin_popcount(E[3] & below(B, 3))));
        };
        int lo = 0, hi = 127;
#pragma unroll 1
        while (lo < hi) { const int mid = (lo + hi) >> 1; if (ties_below(mid + 1) >= need) hi = mid; else lo = mid + 1; }
        const int Bs = lo, r = need - ties_below(Bs);
        const unsigned ew = Bs < 32 ? E[0] : (Bs < 64 ? E[1] : (Bs < 96 ? E[2] : E[3]));
        const bool tb = ((ew >> (Bs & 31)) & 1u) != 0u;
        const unsigned long long em = __ballot(tb);
        const bool take_row = tb && __builtin_popcountll(em & ((1ull << lane) - 1ull)) < r;
#pragma unroll
        for (int c = 0; c < 4; ++c) {
            unsigned tk = E[c] & below(Bs, c);
            if ((Bs >> 5) == c && take_row) tk |= 1u << (Bs & 31);
            M[c] = G[c] | tk;
        }
    }
    const int kl = __builtin_popcount(M[0]) + __builtin_popcount(M[1]) + __builtin_popcount(M[2]) + __builtin_popcount(M[3]);
    int wp = wave_incl_scan(kl, lane) - kl;
#pragma unroll
    for (int c = 0; c < 4; ++c) {
        unsigned m = M[c];
        while (m) { const int b = __builtin_ctz(m); list[wp] = (u16)((32 * c + b) * 64 + lane); ++wp; m &= m - 1u; }
    }
}

DI void dsa_phase(const Args& a, LAS unsigned char* lds) {
    unsigned char* ws = a.ws;
    const int tid = otid(), wid = __builtin_amdgcn_readfirstlane(tid >> 6), lane = tid & 63, fr = lane & 15, fq = lane >> 4;
    const u16* QI = (const u16*)(ws + WS_QI); const u16* KIN = (const u16*)(ws + WS_KIN); const u16* KVN = (const u16*)(ws + WS_KVN);
    const u16* Q = (const u16*)(ws + WS_Q); const float* WI = (const float*)(ws + WS_WI); u16* YO = (u16*)(ws + WS_YO);
    LAS u16* rows = (LAS u16*)(lds + P3_ROWS);
    for (int gi = blockIdx.x; gi < T / 8; gi += gridDim.x) {
        const int b = gi & 3, t0 = S - 8 - 8 * (gi >> 2);
        const size_t brow = (size_t)b * S;
        const int ntile = (t0 + 8 + 15) >> 4;
        __syncthreads();
        {
            bf16x8 qa[2][2]; f32x4 wi[2];
#pragma unroll
            for (int rg = 0; rg < 2; ++rg) {
#pragma unroll
                for (int ks = 0; ks < 2; ++ks) qa[rg][ks] = *(const bf16x8*)(QI + (brow + t0 + 4 * rg + (fr >> 2)) * 256 + (fr & 3) * 64 + ks * 32 + 8 * fq);
                wi[rg] = *(const f32x4*)(WI + (brow + t0 + 4 * rg + fq) * 4);
            }
            auto ldk = [&](bf16x8 (&kf)[4][2], int jt0) {
#pragma unroll
                for (int u = 0; u < 4; ++u) {
                    const int jt = (jt0 + 8 * u) < ntile ? (jt0 + 8 * u) : (ntile - 1);
                    const u16* kp = KIN + (brow + jt * 16 + fr) * 64 + 8 * fq;
                    kf[u][0] = *(const bf16x8*)kp; kf[u][1] = *(const bf16x8*)(kp + 32);
                }
            };
            auto cmpk = [&](const bf16x8 (&kf)[4][2], int jt0) {
#pragma unroll
                for (int u = 0; u < 4; ++u) {
                    const int jt = jt0 + 8 * u;
                    if (jt < ntile) {
#pragma unroll
                        for (int rg = 0; rg < 2; ++rg) {
                            f32x4 d = {0.f, 0.f, 0.f, 0.f};
                            d = __builtin_amdgcn_mfma_f32_16x16x32_bf16(qa[rg][0], kf[u][0], d, 0, 0, 0);
                            d = __builtin_amdgcn_mfma_f32_16x16x32_bf16(qa[rg][1], kf[u][1], d, 0, 0, 0);
                            const float sc = ((fmaxf(d[0], 0.f) * wi[rg][0] + fmaxf(d[1], 0.f) * wi[rg][1]) + fmaxf(d[2], 0.f) * wi[rg][2]) + fmaxf(d[3], 0.f) * wi[rg][3];
                            rows[(4 * rg + fq) * 8192 + rowaddr(jt * 16 + fr)] = (u16)(f2key(sc) >> 16);
                        }
                    }
                }
            };
            bf16x8 kA[4][2], kB[4][2];
            if (wid < ntile) ldk(kA, wid);
            for (int jt0 = wid; jt0 < ntile; jt0 += 64) {
                const bool hasB = jt0 + 32 < ntile;
                if (hasB) ldk(kB, jt0 + 32);
                cmpk(kA, jt0);
                if (hasB) { if (jt0 + 64 < ntile) ldk(kA, jt0 + 64); cmpk(kB, jt0 + 32); }
            }
        }
        __syncthreads();
        {
            const int q = wid, t = t0 + q, N = t + 1;
            LAS u16* row = rows + q * 8192;
            LAS u16* list = (LAS u16*)(lds + P3_LIST + q * 512);
            int cnt;
            if (N <= 256) { for (int p = lane; p < 256; p += 64) list[p] = p < N ? (u16)p : (u16)0; cnt = N; }
            else { select_top16(row, list, N, lane); cnt = 256; }
            wave_lds_sync();
            bf16x8 qf[4];
            {
                const int head = fr & 7;
                const u16* qrow = Q + (brow + t) * 1024 + head * 128;
                float f[4][8]; float ss = 0.f;
#pragma unroll
                for (int ks = 0; ks < 4; ++ks) {
                    const u32x4 raw = *(const u32x4*)(qrow + ks * 32 + 8 * fq);
                    f[ks][0] = bflo(raw.x); f[ks][1] = bfhi(raw.x); f[ks][2] = bflo(raw.y); f[ks][3] = bfhi(raw.y); f[ks][4] = bflo(raw.z); f[ks][5] = bfhi(raw.z); f[ks][6] = bflo(raw.w); f[ks][7] = bfhi(raw.w);
#pragma unroll
                    for (int j = 0; j < 8; ++j) ss += f[ks][j] * f[ks][j];
                }
                ss += __shfl_xor(ss, 16); ss += __shfl_xor(ss, 32);
                const float rq = __builtin_amdgcn_rsqf(ss * (1.0f / 128.0f) + EPS) * 0.08838834764831845f;
#pragma unroll
                for (int ks = 0; ks < 4; ++ks) {
                    const float* qg = a.in[I_QNG] + ks * 32 + 8 * fq;
                    u32x4 w;
                    w.x = pk2(f[ks][0] * rq * qg[0], f[ks][1] * rq * qg[1]); w.y = pk2(f[ks][2] * rq * qg[2], f[ks][3] * rq * qg[3]);
                    w.z = pk2(f[ks][4] * rq * qg[4], f[ks][5] * rq * qg[5]); w.w = pk2(f[ks][6] * rq * qg[6], f[ks][7] * rq * qg[7]);
                    qf[ks] = __builtin_bit_cast(bf16x8, w);
                }
            }
            LAS unsigned char* img = (LAS unsigned char*)row;
            const int nsteps = (cnt + 31) >> 5;
            f32x4 oacc[8];
#pragma unroll
            for (int i = 0; i < 8; ++i) oacc[i] = (f32x4){0.f, 0.f, 0.f, 0.f};
            float mrun = -3.0e38f, lpart = 0.f;
            auto issue = [&](u32x4 (&pf)[8], int pp) {
#pragma unroll
                for (int it = 0; it < 8; ++it) { const int piece = it * 64 + lane; const unsigned key = list[pp * 32 + (piece >> 4)]; pf[it] = *(const u32x4*)(KVN + (brow + key) * 128 + 8 * (piece & 15)); }
            };
            auto step = [&](u32x4 (&pf)[8], int pp) {
#pragma unroll
                for (int it = 0; it < 8; ++it) { const int piece = it * 64 + lane; *(LAS u32x4*)(img + (piece >> 4) * 288 + (piece & 15) * 16) = pf[it]; }
                if (pp + 1 < nsteps) issue(pf, pp + 1);
                wave_lds_sync();
                __builtin_amdgcn_sched_barrier(0);
                f32x4 sa = {0.f, 0.f, 0.f, 0.f}, sb = {0.f, 0.f, 0.f, 0.f};
#pragma unroll
                for (int ks = 0; ks < 4; ++ks) {
                    const bf16x8 a0 = *(LAS const bf16x8*)(img + fr * 288 + (ks * 32 + 8 * fq) * 2), a1 = *(LAS const bf16x8*)(img + (16 + fr) * 288 + (ks * 32 + 8 * fq) * 2);
                    sa = __builtin_amdgcn_mfma_f32_16x16x32_bf16(a0, qf[ks], sa, 0, 0, 0); sb = __builtin_amdgcn_mfma_f32_16x16x32_bf16(a1, qf[ks], sb, 0, 0, 0);
                }
                const int pb0 = pp * 32 + 4 * fq;
#pragma unroll
                for (int r = 0; r < 4; ++r) { if (pb0 + r >= cnt) sa[r] = -3.0e38f; if (pb0 + 16 + r >= cnt) sb[r] = -3.0e38f; }
                float mx = fmaxf(fmaxf(fmaxf(sa[0], sa[1]), fmaxf(sa[2], sa[3])), fmaxf(fmaxf(sb[0], sb[1]), fmaxf(sb[2], sb[3])));
                mx = fmaxf(mx, __shfl_xor(mx, 16)); mx = fmaxf(mx, __shfl_xor(mx, 32));
                const float mnew = fmaxf(mrun, mx), alpha = __expf(mrun - mnew);
                mrun = mnew;
                float ps = 0.f;
#pragma unroll
                for (int r = 0; r < 4; ++r) { sa[r] = __expf(sa[r] - mnew); sb[r] = __expf(sb[r] - mnew); ps += sa[r] + sb[r]; }
                lpart = lpart * alpha + ps;
#pragma unroll
                for (int cb = 0; cb < 8; ++cb) oacc[cb] *= alpha;
                u32x4 pw; pw.x = pk2(sa[0], sa[1]); pw.y = pk2(sa[2], sa[3]); pw.z = pk2(sb[0], sb[1]); pw.w = pk2(sb[2], sb[3]);
                const bf16x8 pb = __builtin_bit_cast(bf16x8, pw);
#pragma unroll
                for (int cb = 0; cb < 8; ++cb) {
                    const s16x4 r0 = __builtin_amdgcn_ds_read_tr16_b64_v4i16((LAS s16x4*)(img + (4 * fq + (fr >> 2)) * 288 + (cb * 16 + 4 * (fr & 3)) * 2));
                    const s16x4 r1 = __builtin_amdgcn_ds_read_tr16_b64_v4i16((LAS s16x4*)(img + (16 + 4 * fq + (fr >> 2)) * 288 + (cb * 16 + 4 * (fr & 3)) * 2));
                    const bf16x8 av = {r0[0], r0[1], r0[2], r0[3], r1[0], r1[1], r1[2], r1[3]};
                    oacc[cb] = __builtin_amdgcn_mfma_f32_16x16x32_bf16(av, pb, oacc[cb], 0, 0, 0);
                    if (cb == 3) __builtin_amdgcn_sched_barrier(0);
                }
                wave_lds_sync();
            };
            u32x4 pf0[8];
            issue(pf0, 0);
#pragma unroll 1
            for (int pp = 0; pp < nsteps; ++pp) step(pf0, pp);
            float lsum = lpart; lsum += __shfl_xor(lsum, 16); lsum += __shfl_xor(lsum, 32);
            const float inv = __builtin_amdgcn_rcpf(lsum);
            if (fr < 8) {
                u16* orow = YO + (brow + t) * 1536 + 512 + fr * 128 + 4 * fq;
#pragma unroll
                for (int cb = 0; cb < 8; ++cb) { u32x2 w; w.x = pk2(oacc[cb][0] * inv, oacc[cb][1] * inv); w.y = pk2(oacc[cb][2] * inv, oacc[cb][3] * inv); *(u32x2*)(orow + cb * 16) = w; }
            }
        }
    }
}

constexpr int P6_LCNT = 0, P6_BASE = 128, P6_RSB = 256, P6_RI = 1024;
DI unsigned dpp_max_u32(unsigned v) {
    v = max(v, (unsigned)__builtin_amdgcn_update_dpp(0, (int)v, 0xB1, 0xf, 0xf, false));
    v = max(v, (unsigned)__builtin_amdgcn_update_dpp(0, (int)v, 0x4E, 0xf, 0xf, false));
    v = max(v, (unsigned)__builtin_amdgcn_update_dpp(0, (int)v, 0x141, 0xf, 0xf, false));
    v = max(v, (unsigned)__builtin_amdgcn_update_dpp(0, (int)v, 0x140, 0xf, 0xf, false));
    return v;
}
DI float key2f(unsigned k) { return __uint_as_float((k & 0x80000000u) ? (k & 0x7fffffffu) : ~k); }
DI void router_phase(const Args& a, LAS unsigned char* lds) {
    unsigned char* ws = a.ws;
    const int tid = otid(), wid = tid >> 6, lane = tid & 63, fr = lane & 15, fq = lane >> 4;
    LAS int* lcnt = (LAS int*)(lds + P6_LCNT); LAS int* lbase = (LAS int*)(lds + P6_BASE); LAS float* rsb = (LAS float*)(lds + P6_RSB); LAS int* RI = (LAS int*)(lds + P6_RI);
    const u16* WRH = (const u16*)(ws + WS_WR); const u16* WRL = WRH + 32 * 1024;
    unsigned* CNT = (unsigned*)(ws + WS_CTL);
    for (int rg = blockIdx.x; rg < T / 128; rg += gridDim.x) {
        __syncthreads();
        if (tid < 32) lcnt[tid] = 0;
        __syncthreads();
        {
            const int row = rg * 128 + wid * 16 + fr;
            const float* xr = a.out + (size_t)row * 1024 + 8 * fq;
            f32x4 acc[2] = {{0.f, 0.f, 0.f, 0.f}, {0.f, 0.f, 0.f, 0.f}};
            float ss = 0.f;
#pragma unroll 4
            for (int ks = 0; ks < 32; ++ks) {
                const f32x4 x0 = *(const f32x4*)(xr + ks * 32), x1 = *(const f32x4*)(xr + ks * 32 + 4);
                ss += ((x0[0] * x0[0] + x0[1] * x0[1]) + (x0[2] * x0[2] + x0[3] * x0[3])) + ((x1[0] * x1[0] + x1[1] * x1[1]) + (x1[2] * x1[2] + x1[3] * x1[3]));
                u32x4 hw; hw.x = pk2(x0[0], x0[1]); hw.y = pk2(x0[2], x0[3]); hw.z = pk2(x1[0], x1[1]); hw.w = pk2(x1[2], x1[3]);
                u32x4 lw; lw.x = pk2(x0[0] - bflo(hw.x), x0[1] - bfhi(hw.x)); lw.y = pk2(x0[2] - bflo(hw.y), x0[3] - bfhi(hw.y)); lw.z = pk2(x1[0] - bflo(hw.z), x1[1] - bfhi(hw.z)); lw.w = pk2(x1[2] - bflo(hw.w), x1[3] - bfhi(hw.w));
                const bf16x8 xh = __builtin_bit_cast(bf16x8, hw), xl = __builtin_bit_cast(bf16x8, lw);
#pragma unroll
                for (int nt = 0; nt < 2; ++nt) {
                    const bf16x8 wh = *(const bf16x8*)(WRH + (size_t)(nt * 16 + fr) * 1024 + ks * 32 + 8 * fq), wl = *(const bf16x8*)(WRL + (size_t)(nt * 16 + fr) * 1024 + ks * 32 + 8 * fq);
                    acc[nt] = __builtin_amdgcn_mfma_f32_16x16x32_bf16(xh, wh, acc[nt], 0, 0, 0);
                    acc[nt] = __builtin_amdgcn_mfma_f32_16x16x32_bf16(xl, wh, acc[nt], 0, 0, 0);
                    acc[nt] = __builtin_amdgcn_mfma_f32_16x16x32_bf16(xh, wl, acc[nt], 0, 0, 0);
                }
            }
            ss += __shfl_xor(ss, 16); ss += __shfl_xor(ss, 32);
            if (fq == 0) rsb[wid * 16 + fr] = __builtin_amdgcn_rsqf(ss * (1.0f / 1024.0f) + EPS);
            wave_lds_sync();
            const float b0 = a.in[I_BR][fr], b1 = a.in[I_BR][16 + fr];
#pragma unroll
            for (int r = 0; r < 4; ++r) {
                const float rs = rsb[wid * 16 + 4 * fq + r];
                unsigned k0 = (f2key(acc[0][r] * rs + b0) & ~31u) | (unsigned)(31 - fr), k1 = (f2key(acc[1][r] * rs + b1) & ~31u) | (unsigned)(15 - fr);
                unsigned sel[4];
#pragma unroll
                for (int k = 0; k < 4; ++k) {
                    const unsigned best = dpp_max_u32(k0 > k1 ? k0 : k1);
                    sel[k] = best;
                    if (k0 == best) k0 = 0u;
                    if (k1 == best) k1 = 0u;
                }
                const float v0 = key2f(sel[0] & ~31u), e1 = __expf(key2f(sel[1] & ~31u) - v0), e2 = __expf(key2f(sel[2] & ~31u) - v0), e3 = __expf(key2f(sel[3] & ~31u) - v0);
                const float inv = 1.0f / (1.0f + e1 + e2 + e3);
                if (fr < 4) {
                    const unsigned sk = fr == 0 ? sel[0] : (fr == 1 ? sel[1] : (fr == 2 ? sel[2] : sel[3]));
                    const int e = 31 - (int)(sk & 31u);
                    const float gt = (fr == 0 ? 1.0f : (fr == 1 ? e1 : (fr == 2 ? e2 : e3))) * inv;
                    const int ls = __hip_atomic_fetch_add(lcnt + e, 1, __ATOMIC_RELAXED, __HIP_MEMORY_SCOPE_WORKGROUP);
                    const int ri = ((wid * 16 + 4 * fq + r) * 4 + fr) * 4;
                    RI[ri + 0] = e; RI[ri + 1] = ls; RI[ri + 2] = __float_as_int(gt); RI[ri + 3] = __float_as_int(rs);
                }
            }
        }
        __syncthreads();
        if (tid < 32) lbase[tid] = (int)__hip_atomic_fetch_add(CNT + tid, (unsigned)lcnt[tid], __ATOMIC_RELAXED, __HIP_MEMORY_SCOPE_AGENT);
        __syncthreads();
        {
            const int rl = tid >> 2, k = tid & 3, row = rg * 128 + rl;
            const int e = RI[tid * 4 + 0], slot = lbase[e] + RI[tid * 4 + 1];
            ((int*)(ws + WS_LTOK))[(size_t)e * ECAP + slot] = row;
            ((float*)(ws + WS_LGATE))[(size_t)e * ECAP + slot] = __int_as_float(RI[tid * 4 + 2]);
            ((float*)(ws + WS_LRS))[(size_t)e * ECAP + slot] = __int_as_float(RI[tid * 4 + 3]);
            ((unsigned*)(ws + WS_ROUTE))[(size_t)row * 4 + k] = ((unsigned)e << 16) | (unsigned)slot;
        }
    }
}

DI void combine_phase(const Args& a, LAS unsigned char* lds) {
    unsigned char* ws = a.ws;
    LAS const int* tab = (LAS const int*)(lds + MOE_TAB);
    const int tid = otid(), wid = tid >> 6, lane = tid & 63;
    const u16* YB = (const u16*)(ws + WS_YB); const unsigned* ROUTE = (const unsigned*)(ws + WS_ROUTE);
    for (int row = blockIdx.x * 8 + wid; row < T; row += gridDim.x * 8) {
        size_t pos[4];
#pragma unroll
        for (int k = 0; k < 4; ++k) { const unsigned r = ROUTE[(size_t)row * 4 + k]; const int e = (int)(r >> 16), slot = (int)(r & 0xffffu); pos[k] = (size_t)tab[e] * 256 + slot; }
        float* orow = a.out + (size_t)row * 1024;
#pragma unroll
        for (int i = 0; i < 4; ++i) {
            f32x4 v = *(const f32x4*)(orow + i * 256 + lane * 4);
#pragma unroll
            for (int k = 0; k < 4; ++k) { const u32x2 y = *(const u32x2*)(YB + pos[k] * 1024 + i * 256 + lane * 4); v[0] += bflo(y.x); v[1] += bfhi(y.x); v[2] += bflo(y.y); v[3] += bfhi(y.y); }
            *(f32x4*)(orow + i * 256 + lane * 4) = v;
        }
    }
}

#define XB_TMO      128
#define XB_XCNT(j)  (256  + 64 * (j))
#define XB_XSUB(j)  (1280 + 64 * (j))
#define XB_XGEN(j)  (2304 + 64 * (j))
#define XB_TOP      3328
#define XB_TOPGEN   3392
#define XCD_BAR_WORDS 3456
#define XB_SPIN_CAP (1u << 18)

__device__ __forceinline__ unsigned xb_ld(unsigned* p)              { return __hip_atomic_load(p, __ATOMIC_RELAXED, __HIP_MEMORY_SCOPE_AGENT); }
__device__ __forceinline__ unsigned xb_add(unsigned* p, unsigned v) { return __hip_atomic_fetch_add(p, v, __ATOMIC_RELAXED, __HIP_MEMORY_SCOPE_AGENT); }
__device__ __forceinline__ unsigned xb_xcc_id() { return (unsigned)__builtin_amdgcn_s_getreg((3 << 11) | 20) & 0xFu; }
#define XB_SPIN(cond, bar) do { unsigned _sp = 0; while (cond) { __builtin_amdgcn_s_sleep(1); \
    if ((++_sp & 255u) == 0u) { if (xb_ld(&(bar)[XB_TMO])) break; if (_sp > XB_SPIN_CAP) { atomicAdd(&(bar)[XB_TMO], 1u); break; } } } } while (0)

struct XcdBarrier {
    unsigned* bar; unsigned x;
    volatile LAS unsigned* st;
};

__device__ __forceinline__ XcdBarrier xcd_barrier_post(unsigned* bar, volatile LAS unsigned* st) {
    XcdBarrier b; b.bar = bar; b.x = xb_xcc_id(); b.st = st;
    if (threadIdx.x == 0) (void)xb_add(&bar[XB_XCNT(b.x)], 1u);
    return b;
}
__device__ __forceinline__ void xcd_barrier_complete(unsigned* bar, unsigned x, unsigned& nloc, unsigned& nx) {
    const unsigned G = gridDim.x * gridDim.y * gridDim.z;
    unsigned sum, cnt, mine, sp = 0u;
    for (;;) {
        sum = 0u; cnt = 0u; mine = 0u;
#pragma unroll
        for (unsigned j = 0; j < 16; ++j) { const unsigned c = xb_ld(&bar[XB_XCNT(j)]); sum += c; cnt += (c > 0u) ? 1u : 0u; mine = (j == x) ? c : mine; }
        if (sum == G) break;
        __builtin_amdgcn_s_sleep(1);
        if ((++sp & 255u) == 0u) { if (xb_ld(&bar[XB_TMO])) break; if (sp > XB_SPIN_CAP) { atomicAdd(&bar[XB_TMO], 1u); break; } }
    }
    nloc = mine > 0u ? mine : 1u; nx = cnt > 0u ? cnt : 1u;
}

__device__ __forceinline__ void xcd_barrier(const XcdBarrier& b) {
    asm volatile("s_waitcnt vmcnt(0)" ::: "memory");
    __syncthreads();
    if (threadIdx.x == 0) {
        unsigned* bar = b.bar;
        __builtin_amdgcn_s_waitcnt(0);
        unsigned nloc = b.st[0], nx = b.st[1];
        if (nloc == 0u) { xcd_barrier_complete(bar, b.x, nloc, nx); b.st[0] = nloc; b.st[1] = nx; }
        const unsigned old = xb_add(&bar[XB_XSUB(b.x)], 1u);
        const unsigned gen = old / nloc;
        if (old + 1u == (gen + 1u) * nloc) {
            __builtin_amdgcn_fence(__ATOMIC_RELEASE, "agent");
            asm volatile("s_waitcnt vmcnt(0)" ::: "memory");
            const unsigned og = xb_add(&bar[XB_TOP], 1u);
            const unsigned tg = og / nx;
            if (og + 1u == (tg + 1u) * nx) xb_add(&bar[XB_TOPGEN], 1u);
            else XB_SPIN(xb_ld(&bar[XB_TOPGEN]) == tg, bar);
            __builtin_amdgcn_fence(__ATOMIC_ACQUIRE, "agent");
            xb_add(&bar[XB_XGEN(b.x)], 1u);
            asm volatile("s_waitcnt vmcnt(0)" ::: "memory");
        } else {
            XB_SPIN(xb_ld(&bar[XB_XGEN(b.x)]) == gen, bar);
            __builtin_amdgcn_fence(__ATOMIC_ACQUIRE, "agent");
            asm volatile("s_waitcnt vmcnt(0)" ::: "memory");
        }
    }
    __syncthreads();
}

__global__ void __launch_bounds__(NT, 2) fwd(Args a) {
    extern __shared__ __attribute__((aligned(16))) unsigned char lds_raw[];
    LAS unsigned char* lds = (LAS unsigned char*)lds_raw;
    cg::grid_group grid = cg::this_grid();
    unsigned char* ws = a.ws;
    const int G = gridDim.x, c = blockIdx.x;
    if (threadIdx.x < 2) ((volatile LAS unsigned*)(lds + LDS_BARST))[threadIdx.x] = 0u;
    __syncthreads();
    const XcdBarrier xbar = xcd_barrier_post((unsigned*)(ws + WS_BAR), (volatile LAS unsigned*)(lds + LDS_BARST));

    phase0(a, lds);
    grid.sync();
    {
        g8::PlainSched s; s.Abase = (const char*)(ws + WS_XB); s.Bbase = (const char*)(ws + WS_WIN); s.lda = 1024; s.ldb = 1024; s.K = 1024; s.nM = T / 256; s.nN = NIN / 256; s.G = G; s.c = c;
        EpiIn e; e.H = (u16*)(ws + WS_H); e.rs1 = (const float*)(ws + WS_RS1); e.SSQ = (float*)(ws + WS_SSQ); e.WI = (float*)(ws + WS_WI);
        g8::gemm_phase(lds, s, e);
    }
    xcd_barrier(xbar);
    {
        g8::PlainSched s; s.Abase = (const char*)(ws + WS_H) + 1024 * 2; s.Bbase = (const char*)(ws + WS_WQ); s.lda = NIN; s.ldb = 256; s.K = 256; s.nM = T / 256; s.nN = 5; s.G = G; s.c = c;
        EpiQ e; e.Q = (u16*)(ws + WS_Q); e.QI = (u16*)(ws + WS_QI); e.SSQ = (const float*)(ws + WS_SSQ);
        g8::gemm_phase(lds, s, e);
        for (int u = c; u < 1024; u += G) gmlp_unit(a, lds, u);
        kvnorm(a);
    }
    xcd_barrier(xbar);
    dsa_phase(a, lds);
    xcd_barrier(xbar);
    {
        g8::PlainSched s; s.Abase = (const char*)(ws + WS_YO); s.Bbase = (const char*)(ws + WS_WCAT); s.lda = 1536; s.ldb = 1536; s.K = 512; s.nM = T / 256; s.nN = 4; s.G = G; s.c = c;
        EpiMrg<0> e0; e0.OUT = (u16*)(ws + WS_TMP); e0.TMP = nullptr; e0.H = (const u16*)(ws + WS_H);
        g8::gemm_phase(lds, s, e0);
        s.Abase = (const char*)(ws + WS_YO) + 512 * 2; s.Bbase = (const char*)(ws + WS_WCAT) + 512 * 2; s.K = 1024;
        EpiMrg<1> e1; e1.OUT = (u16*)(ws + WS_MRG); e1.TMP = (const u16*)(ws + WS_TMP); e1.H = (const u16*)(ws + WS_H);
        g8::gemm_phase(lds, s, e1);
    }
    xcd_barrier(xbar);
    {
        g8::PlainSched s; s.Abase = (const char*)(ws + WS_MRG); s.Bbase = (const char*)(ws + WS_WOUT); s.lda = 1024; s.ldb = 1024; s.K = 1024; s.nM = T / 256; s.nN = 4; s.G = G; s.c = c;
        EpiOut e; e.out = a.out; e.x = a.in[I_X]; e.XN = (u16*)(ws + WS_XN2);
        g8::gemm_phase(lds, s, e);
    }
    xcd_barrier(xbar);
    router_phase(a, lds);
    xcd_barrier(xbar);
    moe_table(lds, (const unsigned*)(ws + WS_CTL));
    {
        MoeSched<8, true> s; s.Abase = (const char*)(ws + WS_XN2); s.Wbase = (const char*)(ws + WS_WE1); s.LTOK = (const int*)(ws + WS_LTOK); s.tab = (LAS const int*)(lds + MOE_TAB);
        s.lda = 1024; s.ldb = 1024; s.K = 1024; s.G = G; s.c = c; s.wstride = (size_t)2048 * 1024 * 2;
        EpiMoe1 e; e.ACT = (u16*)(ws + WS_ACT); e.b1 = a.in[I_BE1]; e.LRS = (const float*)(ws + WS_LRS); e.tab = (LAS const int*)(lds + MOE_TAB);
        g8::gemm_phase(lds, s, e);
    }
    xcd_barrier(xbar);
    {
        MoeSched<4, false> s; s.Abase = (const char*)(ws + WS_ACT); s.Wbase = (const char*)(ws + WS_WE2); s.LTOK = nullptr; s.tab = (LAS const int*)(lds + MOE_TAB);
        s.lda = 1024; s.ldb = 1024; s.K = 1024; s.G = G; s.c = c; s.wstride = (size_t)1024 * 1024 * 2;
        EpiMoe2 e; e.YB = (u16*)(ws + WS_YB); e.b2 = a.in[I_BE2]; e.LGATE = (const float*)(ws + WS_LGATE); e.tab = (LAS const int*)(lds + MOE_TAB);
        g8::gemm_phase(lds, s, e);
    }
    xcd_barrier(xbar);
    combine_phase(a, lds);
}

extern "C" void kernel_launch(void* const* d_in, const int* in_sizes, int n_in, void* d_out, int out_size, void* d_ws, size_t ws_size, hipStream_t stream) {
    static int grid = 0;
    if (grid == 0) {
        int dev = 0, cus = 0, per_cu = 0;
        if (n_in != 23 || out_size != T * Dm || ws_size < WS_END) { fprintf(stderr, "kernel_launch: unexpected problem (n_in %d, out %d, ws %zu < %zu)\n", n_in, out_size, ws_size, (size_t)WS_END); grid = -1; return; }
        if (hipGetDevice(&dev) != hipSuccess || hipDeviceGetAttribute(&cus, hipDeviceAttributeMultiprocessorCount, dev) != hipSuccess) { grid = -1; return; }
        if (hipFuncSetAttribute((const void*)fwd, hipFuncAttributeMaxDynamicSharedMemorySize, LDS_BYTES) != hipSuccess) { fprintf(stderr, "hipFuncSetAttribute failed\n"); grid = -1; return; }
        if (hipOccupancyMaxActiveBlocksPerMultiprocessor(&per_cu, (const void*)fwd, NT, LDS_BYTES) != hipSuccess || per_cu < 1) { fprintf(stderr, "occupancy query failed (%d)\n", per_cu); grid = -1; return; }
        grid = cus;
        fprintf(stderr, "kernel_launch: cus %d per_cu %d grid %d ws %zu need %zu\n", cus, per_cu, grid, ws_size, (size_t)WS_END);
    }
    if (grid < 0) return;
    Args a{};
    for (int i = 0; i < 23; ++i) a.in[i] = (const float*)d_in[i];
    a.out = (float*)d_out; a.ws = (unsigned char*)d_ws; a.mask = 0xffffffffu; a.pad = 0u;
    if (hipMemsetAsync((char*)d_ws + WS_CTL, 0, 65536, stream) != hipSuccess) { fprintf(stderr, "memset failed\n"); return; }
    void* args[] = {&a};
    hipError_t e = hipLaunchCooperativeKernel((const void*)fwd, dim3(grid), dim3(NT), args, LDS_BYTES, stream);
    if (e != hipSuccess) fprintf(stderr, "cooperative launch failed: %s (grid %d)\n", hipGetErrorString(e), grid);
}
```

```cpp
#include <hip/hip_runtime.h>
#include <hip/hip_cooperative_groups.h>
#include <cstdio>
#include <cstdint>
namespace cg = cooperative_groups;

#define LAS __attribute__((address_space(3)))
#define DI __device__ __forceinline__
typedef unsigned short u16;
typedef short bf16x8 __attribute__((ext_vector_type(8)));
typedef short s16x4 __attribute__((ext_vector_type(4)));
typedef float f32x4 __attribute__((ext_vector_type(4)));
typedef float f32x2 __attribute__((ext_vector_type(2)));
typedef unsigned u32x4 __attribute__((ext_vector_type(4)));
typedef unsigned u32x2 __attribute__((ext_vector_type(2)));
typedef __bf16 bf2_t __attribute__((ext_vector_type(2)));
typedef int v8i_t __attribute__((ext_vector_type(8)));

constexpr int NT = 512;
constexpr int LDS_BYTES = 155648;
constexpr int Dm = 1024, Bsz = 4, S = 8192, T = Bsz * S;
constexpr int NIN = 3584;
constexpr int NE = 32, ECAP = 32768, PPAD = 131072 + NE * 256;
constexpr float EPS = 1e-6f;

constexpr size_t MiB = 1024 * 1024;
constexpr size_t WS_CTL = 0;
constexpr size_t WS_BAR = 16384;
constexpr int LDS_BARST = LDS_BYTES - 16;
constexpr size_t WS_WIN = 64 * 1024;
constexpr size_t WS_WQ = WS_WIN + (size_t)NIN * 1024 * 2;
constexpr size_t WS_WSP = WS_WQ + 1280 * 256 * 2;
constexpr size_t WS_WCAT = WS_WSP + 4 * 128 * 128 * 2;
constexpr size_t WS_WOUT = WS_WCAT + 1024 * 1536 * 2;
constexpr size_t WS_WR = WS_WOUT + 1024 * 1024 * 2;
constexpr size_t WS_WE1 = WS_WR + 32 * 1024 * 4;
constexpr size_t WS_WE2 = WS_WE1 + (size_t)32 * 2048 * 1024 * 2;
constexpr size_t WS_RS1 = WS_WE2 + (size_t)32 * 1024 * 1024 * 2;
constexpr size_t WS_SSQ = WS_RS1 + (size_t)T * 4;
constexpr size_t WS_WI = WS_SSQ + (size_t)T * 32 * 4;
constexpr size_t WS_ROUTE = WS_WI + (size_t)T * 4 * 4;
constexpr size_t WS_LTOK = WS_ROUTE + (size_t)T * 4 * 4;
constexpr size_t WS_LGATE = WS_LTOK + (size_t)NE * ECAP * 4;
constexpr size_t WS_LRS = WS_LGATE + (size_t)NE * ECAP * 4;
constexpr size_t WS_XN2 = WS_LRS + (size_t)NE * ECAP * 4;
constexpr size_t WS_R0 = WS_XN2 + (size_t)T * 1024 * 2;
constexpr size_t WS_XB = WS_R0;
constexpr size_t WS_H = WS_XB + (size_t)T * 1024 * 2;
constexpr size_t WS_Q = WS_H + (size_t)T * NIN * 2;
constexpr size_t WS_QI = WS_Q + (size_t)T * 1024 * 2;
constexpr size_t WS_KVN = WS_QI + (size_t)T * 256 * 2;
constexpr size_t WS_KIN = WS_KVN + (size_t)T * 128 * 2;
constexpr size_t WS_YO = WS_KIN + (size_t)T * 64 * 2;
constexpr size_t WS_TMP = WS_YO + (size_t)T * 1536 * 2;
constexpr size_t WS_MRG = WS_TMP + (size_t)T * 1024 * 2;
constexpr size_t WS_R0END = WS_MRG + (size_t)T * 1024 * 2;
constexpr size_t WS_ACT = WS_XB;
constexpr size_t WS_YB = WS_Q;
static_assert(WS_ACT + (size_t)PPAD * 1024 * 2 <= WS_Q, "ACT overlaps YB");
static_assert(WS_YB + (size_t)PPAD * 1024 * 2 <= WS_R0END, "YB too large");
constexpr size_t WS_END = WS_R0END;

struct Args { const float* in[23]; float* out; unsigned char* ws; unsigned mask; unsigned pad; };
enum { I_X = 0, I_N1G, I_WIN, I_QLG, I_WUQ, I_QNG, I_KVG, I_WUV, I_WQI, I_KIG, I_VG, I_WSP, I_BSP, I_WPA, I_WPB, I_WOUT, I_N2G, I_WR, I_BR, I_WE1, I_BE1, I_WE2, I_BE2 };

DI unsigned pk2(float a, float b) { f32x2 v = {a, b}; bf2_t r = __builtin_convertvector(v, bf2_t); return __builtin_bit_cast(unsigned, r); }
DI unsigned pk4_fp8(float a, float b, float c, float d) { unsigned w = 0u; w = (unsigned)__builtin_amdgcn_cvt_pk_fp8_f32(a, b, (int)w, false); w = (unsigned)__builtin_amdgcn_cvt_pk_fp8_f32(c, d, (int)w, true); return w; }
DI float bflo(unsigned u) { return __uint_as_float(u << 16); }
DI float bfhi(unsigned u) { return __uint_as_float(u & 0xffff0000u); }
DI u16 f2bf(float f) { return (u16)(pk2(f, 0.f) & 0xffffu); }
DI float bf2f(u16 h) { return __uint_as_float(((unsigned)h) << 16); }
DI float sigmoidf_(float x) { return __builtin_amdgcn_rcpf(1.0f + __expf(-x)); }
DI float gelu_tanh(float x) { const float u = 1.5957691216057308f * (x + 0.044715f * x * x * x); return x * sigmoidf_(u); }
DI int otid() { int t = threadIdx.x; asm volatile("" : "+v"(t)); return t; }
DI void wave_lds_sync() { asm volatile("s_waitcnt lgkmcnt(0)" ::: "memory"); }

namespace g8 {
constexpr int BM = 256, BK = 64, HALF = 128, HTB = HALF * BK * 2, STAGE_BYTES = 8 * HTB, NXCD = 8, WGM = 8;
DI int lds_byte(int r, int c) { const int st = (r >> 4) * 2 + (c >> 5), rr = r & 15, cc = c & 31, ob = rr * 64 + cc * 2; return st * 1024 + (ob ^ (((ob >> 9) & 1) << 5)); }
DI void stage_rc(int b, int& R, int& C) { const int st = b / 1024, sb = b % 1024, swz = sb ^ (((sb >> 9) & 1) << 5); R = (st >> 1) * 16 + swz / 64; C = (st & 1) * 32 + (swz % 64) / 2; }

struct UnitD { const char* Bp; int pm, pn, e, rb; };

DI bool static_tile(int i, int G, int c, int nM, int nN, int& pm, int& pn) {
    const int nwg = nM * nN; const long L = (long)i * G + c; if (L >= nwg) return false;
    int wgid = (int)L; { const int q = nwg / NXCD, r = nwg % NXCD, xcd = wgid % NXCD, off = wgid / NXCD; wgid = (xcd < r ? xcd * (q + 1) : r * (q + 1) + (xcd - r) * q) + off; }
    const int nig = WGM * nN, gid = wgid / nig, fm = gid * WGM, gsz = (nM - fm) < WGM ? (nM - fm) : WGM;
    pm = fm + ((wgid % nig) % gsz); pn = (wgid % nig) / gsz; return true;
}

struct PlainSched {
    const char* Abase; const char* Bbase; int lda, ldb, K, nM, nN, G, c; static constexpr int esz = 2;
    DI bool next(int i, UnitD& u) const { int pm, pn; if (!static_tile(i, G, c, nM, nN, pm, pn)) return false; u.pm = pm; u.pn = pn; u.e = 0; u.rb = 0; u.Bp = Bbase + (size_t)pn * BM * ldb * 2; return true; }
    DI void a_offs(const UnitD& u, int R0, int C0, unsigned (&o)[2][2]) const {
#pragma unroll
        for (int h = 0; h < 2; ++h)
#pragma unroll
            for (int i = 0; i < 2; ++i) o[h][i] = (unsigned)(((size_t)(u.pm * BM + h * HALF + R0 + 64 * i) * lda + C0) * 2);
    }
};

template <bool FP8 = false, class Epi, class Sched>
DI void gemm_phase(LAS unsigned char* lds, const Sched& S, const Epi& E) {
    const int tid = otid(), wid = __builtin_amdgcn_readfirstlane(tid >> 6), lane = tid & 63, wr = wid >> 2, wc = wid & 3, fr = lane & 15, fq = lane >> 4;
    const int nt = S.K * Sched::esz / 128;
    int R0, C0; stage_rc(tid * 16, R0, C0);
    unsigned voffB[2];
#pragma unroll
    for (int i = 0; i < 2; ++i) voffB[i] = (unsigned)((R0 + 64 * i) * S.ldb * Sched::esz + C0 * 2);
    const size_t hstepB = (size_t)HALF * S.ldb * Sched::esz;
    const unsigned ldsw = (unsigned)wid * 1024u;
    const int aoff = FP8 ? lds_byte(wr * 64 + fr, fq * 16) : lds_byte(wr * 64 + fr, fq * 8), boff = FP8 ? lds_byte(wc * 32 + fr, fq * 16) : lds_byte(wc * 32 + fr, fq * 8);
    const unsigned mxscale = 0x7f7f7f7fu;
    const int kst = FP8 ? 16 : 1024;
    const char* Ab = S.Abase;
#define G8_SA(b, h) (((b) * 2 + (h)) * HTB)
#define G8_SB(b, h) ((4 + (b) * 2 + (h)) * HTB)
#define G8_STAGE_A(bufoff, offs, kb) do { _Pragma("unroll") for (int _i = 0; _i < 2; ++_i) \
        __builtin_amdgcn_global_load_lds((const unsigned*)(Ab + (size_t)(offs)[_i] + (size_t)(kb)), (LAS unsigned*)(lds + (bufoff) + ldsw + _i * 8192), 16, 0, 0); } while (0)
#define G8_STAGE_B(bufoff, gbase, kb) do { _Pragma("unroll") for (int _i = 0; _i < 2; ++_i) \
        __builtin_amdgcn_global_load_lds((const unsigned*)((gbase) + voffB[_i] + (size_t)(kb)), (LAS unsigned*)(lds + (bufoff) + ldsw + _i * 8192), 16, 0, 0); } while (0)
#define G8_LDA(dst, b, h) do { _Pragma("unroll") for (int m = 0; m < 4; ++m) { const i32x4_t _p = *(const LAS i32x4_t*)(lds + G8_SA(b, h) + aoff + m * 2048), _q = *(const LAS i32x4_t*)(lds + G8_SA(b, h) + aoff + m * 2048 + kst); dst[m] = __builtin_shufflevector(_p, _q, 0, 1, 2, 3, 4, 5, 6, 7); } } while (0)
#define G8_LDB(dst, b, h) do { _Pragma("unroll") for (int n = 0; n < 2; ++n) { const i32x4_t _p = *(const LAS i32x4_t*)(lds + G8_SB(b, h) + boff + n * 2048), _q = *(const LAS i32x4_t*)(lds + G8_SB(b, h) + boff + n * 2048 + kst); dst[n] = __builtin_shufflevector(_p, _q, 0, 1, 2, 3, 4, 5, 6, 7); } } while (0)
#define G8_MMA(ai, bj, At, Bt) do { __builtin_amdgcn_s_setprio(1); _Pragma("unroll") for (int m = 0; m < 4; ++m) _Pragma("unroll") for (int n = 0; n < 2; ++n) { \
        if constexpr (FP8) asm volatile("v_mfma_scale_f32_16x16x128_f8f6f4 %0, %1, %2, %0, %3, %3 op_sel_hi:[0,0,0]" : "+v"(acc[ai][bj][m][n]) : "v"(Bt[n]), "v"(At[m]), "v"(mxscale)); \
        else { acc[ai][bj][m][n] = __builtin_amdgcn_mfma_f32_16x16x32_bf16(__builtin_bit_cast(bf16x8, __builtin_shufflevector(Bt[n], Bt[n], 0, 1, 2, 3)), __builtin_bit_cast(bf16x8, __builtin_shufflevector(At[m], At[m], 0, 1, 2, 3)), acc[ai][bj][m][n], 0, 0, 0); \
               acc[ai][bj][m][n] = __builtin_amdgcn_mfma_f32_16x16x32_bf16(__builtin_bit_cast(bf16x8, __builtin_shufflevector(Bt[n], Bt[n], 4, 5, 6, 7)), __builtin_bit_cast(bf16x8, __builtin_shufflevector(At[m], At[m], 4, 5, 6, 7)), acc[ai][bj][m][n], 0, 0, 0); } } \
        __builtin_amdgcn_s_setprio(0); } while (0)
#define G8_WAIT_V(n) asm volatile("s_waitcnt vmcnt(" #n ")" ::: "memory")
#define G8_WAIT_L(n) asm volatile("s_waitcnt lgkmcnt(" #n ")" ::: "memory")
#define G8_BAR __builtin_amdgcn_s_barrier()
#define G8_SCHED __builtin_amdgcn_sched_barrier(0)
    UnitD cur, nxt; int ui = 0;
    if (!S.next(0, cur)) return;
    f32x4 acc[2][2][4][2];
#pragma unroll
    for (int a = 0; a < 2; ++a)
#pragma unroll
        for (int b = 0; b < 2; ++b)
#pragma unroll
            for (int m = 0; m < 4; ++m)
#pragma unroll
                for (int n = 0; n < 2; ++n) acc[a][b][m][n] = (f32x4){0.f, 0.f, 0.f, 0.f};
    typedef int i32x4_t __attribute__((ext_vector_type(4)));
    v8i_t At[4], B0[2], B1[2];
    unsigned cA[2][2];
    S.a_offs(cur, R0, C0, cA);
    const char* cB = cur.Bp;
    G8_STAGE_B(G8_SB(0, 0), cB, 0); G8_STAGE_A(G8_SA(0, 0), cA[0], 0); G8_STAGE_B(G8_SB(0, 1), cB + hstepB, 0); G8_STAGE_A(G8_SA(0, 1), cA[1], 0);
    if (wr == 1) G8_BAR;
    G8_WAIT_V(4); G8_BAR;
    G8_STAGE_B(G8_SB(1, 0), cB, 128); G8_STAGE_A(G8_SA(1, 0), cA[0], 128); G8_STAGE_B(G8_SB(1, 1), cB + hstepB, 128);
    G8_WAIT_V(6); G8_BAR;
    for (;;) {
        const bool has_next = S.next(ui + 1, nxt);
        const char* nB = has_next ? nxt.Bp : cB;
        for (int t = 0; t < nt; t += 2) {
            const bool last = (t == nt - 2);
            const unsigned k1 = (unsigned)(t + 1) * 128u;
            const unsigned k2 = last ? 0u : (unsigned)(t + 2) * 128u, k3 = k2 + 128u;
            unsigned c1[2] = {cA[1][0], cA[1][1]};
            if (last && has_next) S.a_offs(nxt, R0, C0, cA);
            const char* b2 = last ? nB : cB;
            G8_LDB(B0, 0, 0); G8_SCHED; G8_LDA(At, 0, 0); G8_STAGE_A(G8_SA(1, 1), c1, k1);
            G8_WAIT_L(8); G8_BAR; G8_WAIT_L(0); G8_MMA(0, 0, At, B0); G8_BAR; G8_SCHED;
            G8_LDB(B1, 0, 1); G8_STAGE_B(G8_SB(0, 0), b2, k2);
            G8_BAR; G8_WAIT_L(0); G8_MMA(0, 1, At, B1); G8_BAR;
            G8_LDA(At, 0, 1); G8_STAGE_A(G8_SA(0, 0), cA[0], k2);
            G8_BAR; G8_WAIT_L(0); G8_MMA(1, 0, At, B0); G8_BAR; G8_SCHED;
            G8_STAGE_B(G8_SB(0, 1), b2 + hstepB, k2);
            G8_WAIT_V(6); G8_BAR; G8_MMA(1, 1, At, B1); G8_BAR;
            G8_LDB(B0, 1, 0); G8_SCHED; G8_LDA(At, 1, 0); G8_STAGE_A(G8_SA(0, 1), cA[1], k2);
            G8_WAIT_L(8); G8_BAR; G8_WAIT_L(0); G8_MMA(0, 0, At, B0); G8_BAR; G8_SCHED;
            G8_LDB(B1, 1, 1); G8_STAGE_B(G8_SB(1, 0), b2, k3);
            G8_BAR; G8_WAIT_L(0); G8_MMA(0, 1, At, B1); G8_BAR;
            G8_LDA(At, 1, 1); G8_STAGE_A(G8_SA(1, 0), cA[0], k3);
            G8_BAR; G8_WAIT_L(0); G8_MMA(1, 0, At, B0); G8_BAR; G8_SCHED;
            G8_STAGE_B(G8_SB(1, 1), b2 + hstepB, k3);
            G8_WAIT_V(6); G8_BAR; G8_MMA(1, 1, At, B1); G8_BAR;
        }
        if constexpr (FP8) asm volatile("s_nop 15\n\ts_nop 15" ::: "memory");
        E(acc, cur, wr, wc, fr, fq);
        if (!has_next) break;
#pragma unroll
        for (int a = 0; a < 2; ++a)
#pragma unroll
            for (int b = 0; b < 2; ++b)
#pragma unroll
                for (int m = 0; m < 4; ++m)
#pragma unroll
                    for (int n = 0; n < 2; ++n) acc[a][b][m][n] = (f32x4){0.f, 0.f, 0.f, 0.f};
        cur = nxt; cB = nB; ++ui;
    }
    G8_WAIT_V(0);
    if (wr == 0) G8_BAR;
    G8_BAR;
#undef G8_SA
#undef G8_SB
#undef G8_STAGE_A
#undef G8_STAGE_B
#undef G8_LDA
#undef G8_LDB
#undef G8_MMA
#undef G8_WAIT_V
#undef G8_WAIT_L
#undef G8_BAR
#undef G8_SCHED
}
}
using g8::UnitD;
typedef f32x4 Acc[2][2][4][2];

struct EpiIn {
    u16* H; const float* rs1; float* SSQ; float* WI;
    DI void operator()(const Acc& acc, const UnitD& u, int wr, int wc, int fr, int fq) const {
        const int pn = u.pn;
#pragma unroll
        for (int ai = 0; ai < 2; ++ai)
#pragma unroll
            for (int m = 0; m < 4; ++m) {
                const int row = u.pm * 256 + ai * 128 + wr * 64 + m * 16 + fr;
                const float rs = rs1[row];
#pragma unroll
                for (int bj = 0; bj < 2; ++bj) {
                    float ssq = 0.f;
#pragma unroll
                    for (int n = 0; n < 2; ++n) {
                        const int col = pn * 256 + bj * 128 + wc * 32 + n * 16 + 4 * fq;
                        f32x4 v = acc[ai][bj][m][n] * rs;
                        if (pn < 4) { v[0] = gelu_tanh(v[0]); v[1] = gelu_tanh(v[1]); v[2] = gelu_tanh(v[2]); v[3] = gelu_tanh(v[3]); }
                        else if (pn >= 6) { v[0] = sigmoidf_(v[0]); v[1] = sigmoidf_(v[1]); v[2] = sigmoidf_(v[2]); v[3] = sigmoidf_(v[3]); }
                        ssq += (v[0] * v[0] + v[1] * v[1]) + (v[2] * v[2] + v[3] * v[3]);
                        u32x2 w; w.x = pk2(v[0], v[1]); w.y = pk2(v[2], v[3]);
                        *(u32x2*)(H + (size_t)row * NIN + col) = w;
                        if (pn == 5 && bj == 1 && wc == 2 && n == 0 && fq == 0) *(f32x4*)(WI + (size_t)row * 4) = v * 0.5f;
                    }
                    if (pn >= 2 && pn <= 5) {
                        ssq += __shfl_xor(ssq, 16); ssq += __shfl_xor(ssq, 32);
                        if (fq == 0) SSQ[(size_t)row * 32 + (pn - 2) * 8 + bj * 4 + wc] = ssq;
                    }
                }
            }
    }
};
struct EpiQ {
    u16* Q; u16* QI; const float* SSQ;
    DI void operator()(const Acc& acc, const UnitD& u, int wr, int wc, int fr, int fq) const {
#pragma unroll
        for (int ai = 0; ai < 2; ++ai)
#pragma unroll
            for (int m = 0; m < 4; ++m) {
                const int row = u.pm * 256 + ai * 128 + wr * 64 + m * 16 + fr;
                const f32x4 s0 = *(const f32x4*)(SSQ + (size_t)row * 32 + 16), s1 = *(const f32x4*)(SSQ + (size_t)row * 32 + 20);
                const float ss = ((s0[0] + s0[1]) + (s0[2] + s0[3])) + ((s1[0] + s1[1]) + (s1[2] + s1[3]));
                const float rs = __builtin_amdgcn_rsqf(ss * (1.0f / 256.0f) + EPS);
#pragma unroll
                for (int bj = 0; bj < 2; ++bj)
#pragma unroll
                    for (int n = 0; n < 2; ++n) {
                        const int col = u.pn * 256 + bj * 128 + wc * 32 + n * 16 + 4 * fq;
                        const f32x4 v = acc[ai][bj][m][n] * rs;
                        u32x2 w; w.x = pk2(v[0], v[1]); w.y = pk2(v[2], v[3]);
                        if (col < 1024) *(u32x2*)(Q + (size_t)row * 1024 + col) = w; else *(u32x2*)(QI + (size_t)row * 256 + (col - 1024)) = w;
                    }
            }
    }
};
template <int SECOND> struct EpiMrg {
    u16* OUT; const u16* TMP; const u16* H;
    DI void operator()(const Acc& acc, const UnitD& u, int wr, int wc, int fr, int fq) const {
#pragma unroll
        for (int ai = 0; ai < 2; ++ai)
#pragma unroll
            for (int m = 0; m < 4; ++m) {
                const int row = u.pm * 256 + ai * 128 + wr * 64 + m * 16 + fr;
#pragma unroll
                for (int bj = 0; bj < 2; ++bj)
#pragma unroll
                    for (int n = 0; n < 2; ++n) {
                        const int col = u.pn * 256 + bj * 128 + wc * 32 + n * 16 + 4 * fq;
                        const u32x2 g = *(const u32x2*)(H + (size_t)row * NIN + 1536 + SECOND * 1024 + col);
                        f32x4 v = acc[ai][bj][m][n];
                        v[0] *= bflo(g.x); v[1] *= bfhi(g.x); v[2] *= bflo(g.y); v[3] *= bfhi(g.y);
                        if (SECOND) { const u32x2 t = *(const u32x2*)(TMP + (size_t)row * 1024 + col); v[0] += bflo(t.x); v[1] += bfhi(t.x); v[2] += bflo(t.y); v[3] += bfhi(t.y); }
                        u32x2 w; w.x = pk2(v[0], v[1]); w.y = pk2(v[2], v[3]);
                        *(u32x2*)(OUT + (size_t)row * 1024 + col) = w;
                    }
            }
    }
};
struct EpiOut {
    float* out; const float* x; unsigned char* XN;
    DI void operator()(const Acc& acc, const UnitD& u, int wr, int wc, int fr, int fq) const {
#pragma unroll
        for (int ai = 0; ai < 2; ++ai)
#pragma unroll
            for (int m = 0; m < 4; ++m) {
                const int row = u.pm * 256 + ai * 128 + wr * 64 + m * 16 + fr;
#pragma unroll
                for (int bj = 0; bj < 2; ++bj)
#pragma unroll
                    for (int n = 0; n < 2; ++n) {
                        const size_t o = (size_t)row * 1024 + u.pn * 256 + bj * 128 + wc * 32 + n * 16 + 4 * fq;
                        const f32x4 v = *(const f32x4*)(x + o) + acc[ai][bj][m][n];
                        *(f32x4*)(out + o) = v;
                        *(unsigned*)(XN + o) = pk4_fp8(v[0], v[1], v[2], v[3]);
                    }
            }
    }
};

constexpr int MOE_TAB = g8::STAGE_BYTES;
DI void moe_table(LAS unsigned char* lds, const unsigned* CNT) {
    LAS int* tab = (LAS int*)(lds + MOE_TAB);
    __syncthreads();
    if (threadIdx.x == 0) { int acc = 0; for (int e = 0; e < NE; ++e) { const int c = (int)__hip_atomic_load(CNT + e, __ATOMIC_RELAXED, __HIP_MEMORY_SCOPE_AGENT); tab[e] = acc; tab[33 + e] = c; acc += (c + 255) >> 8; } tab[32] = acc; }
    __syncthreads();
}
template <int NPN, bool GATHER> struct MoeSched {
    const char* Abase; const char* Wbase; const int* LTOK; LAS const int* tab; int lda, ldb, K, G, c; size_t wstride; static constexpr int esz = 1;
    DI bool next(int i, UnitD& u) const {
        const long L = (long)i * G + c; const int R = tab[32];
        if (L >= (long)R * NPN) return false;
        const int rbg = (int)(L / NPN), pn = (int)(L % NPN);
        int e = 0;
        for (int j = 1; j < NE; ++j) e += (tab[j] <= rbg) ? 1 : 0;
        e = __builtin_amdgcn_readfirstlane(e);
        u.pm = rbg; u.pn = pn; u.e = e; u.rb = rbg - tab[e];
        u.Bp = Wbase + (size_t)e * wstride + (size_t)pn * 256 * ldb * esz;
        return true;
    }
    DI void a_offs(const UnitD& u, int R0, int C0, unsigned (&o)[2][2]) const {
        const int cnt = tab[33 + u.e];
#pragma unroll
        for (int h = 0; h < 2; ++h)
#pragma unroll
            for (int i = 0; i < 2; ++i) {
                const int r = h * 128 + R0 + 64 * i;
                if (GATHER) { const int slot = u.rb * 256 + r; const int tok = slot < cnt ? LTOK[(size_t)u.e * ECAP + slot] : 0; o[h][i] = (unsigned)((size_t)tok * lda * esz + C0 * 2); }
                else o[h][i] = (unsigned)((size_t)(u.pm * 256 + r) * lda * esz + C0 * 2);
            }
    }
};
struct EpiMoe1 {
    unsigned char* ACT; const float* b1; const float* LRS; LAS const int* tab;
    DI void operator()(const Acc& acc, const UnitD& u, int wr, int wc, int fr, int fq) const {
        const float* be = b1 + (size_t)u.e * 2048; const int cnt = tab[33 + u.e];
        float rsv[2][4];
#pragma unroll
        for (int ai = 0; ai < 2; ++ai)
#pragma unroll
            for (int m = 0; m < 4; ++m) { const int slot = u.rb * 256 + ai * 128 + wr * 64 + m * 16 + fr; rsv[ai][m] = slot < cnt ? LRS[(size_t)u.e * ECAP + slot] : 0.f; }
#pragma unroll
        for (int n = 0; n < 2; ++n) {
            const int hc = u.pn * 128 + wc * 32 + n * 16 + 4 * fq;
            const f32x4 bg = *(const f32x4*)(be + hc), bu = *(const f32x4*)(be + 1024 + hc);
#pragma unroll
            for (int ai = 0; ai < 2; ++ai)
#pragma unroll
                for (int m = 0; m < 4; ++m) {
                    const int row = u.pm * 256 + ai * 128 + wr * 64 + m * 16 + fr;
                    const f32x4 g = acc[ai][0][m][n] * (rsv[ai][m] * 0.015625f) + bg, up = acc[ai][1][m][n] * (rsv[ai][m] * 0.015625f) + bu;
                    float a[4];
#pragma unroll
                    for (int j = 0; j < 4; ++j) { const float hg = fminf(g[j], 7.0f), hu = fminf(fmaxf(up[j], -7.0f), 7.0f); a[j] = (hu + 1.0f) * (hg * sigmoidf_(1.702f * hg)); }
                    *(unsigned*)(ACT + (size_t)row * 1024 + hc) = pk4_fp8(a[0], a[1], a[2], a[3]);
                }
        }
    }
};
struct EpiMoe2 {
    u16* YB; const float* b2; const float* LGATE; LAS const int* tab;
    DI void operator()(const Acc& acc, const UnitD& u, int wr, int wc, int fr, int fq) const {
        const float* be = b2 + (size_t)u.e * 1024; const int cnt = tab[33 + u.e];
#pragma unroll
        for (int ai = 0; ai < 2; ++ai)
#pragma unroll
            for (int m = 0; m < 4; ++m) {
                const int r = ai * 128 + wr * 64 + m * 16 + fr, slot = u.rb * 256 + r;
                const float gate = slot < cnt ? LGATE[(size_t)u.e * ECAP + slot] : 0.f;
#pragma unroll
                for (int bj = 0; bj < 2; ++bj)
#pragma unroll
                    for (int n = 0; n < 2; ++n) {
                        const int col = u.pn * 256 + bj * 128 + wc * 32 + n * 16 + 4 * fq;
                        const f32x4 v = (acc[ai][bj][m][n] * 0.015625f + *(const f32x4*)(be + col)) * gate;
                        u32x2 w; w.x = pk2(v[0], v[1]); w.y = pk2(v[2], v[3]);
                        *(u32x2*)(YB + (size_t)(u.pm * 256 + r) * 1024 + col) = w;
                    }
            }
    }
};

template <bool FP8 = false, class F> DI void tr_tile(LAS unsigned char* lds, const float* src, int ld_src, int Nsz, int k0, int n0, const float* sk, float mul, u16* dst, int ld_dst, F rowmap) {
    LAS float* t = (LAS float*)lds;
    const int tid = otid();
    __syncthreads();
#pragma unroll
    for (int it = 0; it < 2; ++it) {
        const int k = (tid >> 4) + 32 * it, n = 4 * (tid & 15);
        f32x4 v = {0.f, 0.f, 0.f, 0.f};
        if (n0 + n < Nsz) v = *(const f32x4*)(src + (size_t)(k0 + k) * ld_src + n0 + n);
        const float s = (sk ? sk[k0 + k] : 1.0f) * mul;
        t[k * 65 + n] = v[0] * s; t[k * 65 + n + 1] = v[1] * s; t[k * 65 + n + 2] = v[2] * s; t[k * 65 + n + 3] = v[3] * s;
    }
    __syncthreads();
    const int n = tid >> 3, kc = (tid & 7) * 8;
    if (FP8) {
        if (n0 + n < Nsz) {
            u32x2 w;
            w.x = pk4_fp8(t[(kc + 0) * 65 + n], t[(kc + 1) * 65 + n], t[(kc + 2) * 65 + n], t[(kc + 3) * 65 + n]);
            w.y = pk4_fp8(t[(kc + 4) * 65 + n], t[(kc + 5) * 65 + n], t[(kc + 6) * 65 + n], t[(kc + 7) * 65 + n]);
            *(u32x2*)((unsigned char*)dst + (size_t)rowmap(n0 + n) * ld_dst + k0 + kc) = w;
        }
    } else if (n0 + n < Nsz) {
        u32x4 w;
        w.x = pk2(t[(kc + 0) * 65 + n], t[(kc + 1) * 65 + n]); w.y = pk2(t[(kc + 2) * 65 + n], t[(kc + 3) * 65 + n]);
        w.z = pk2(t[(kc + 4) * 65 + n], t[(kc + 5) * 65 + n]); w.w = pk2(t[(kc + 6) * 65 + n], t[(kc + 7) * 65 + n]);
        *(u32x4*)(dst + (size_t)rowmap(n0 + n) * ld_dst + k0 + kc) = w;
    }
}
struct MapId { DI int operator()(int n) const { return n; } };
struct MapIn { DI int operator()(int n) const { return n < 1476 ? n : n + 60; } };
struct MapE1 { DI int operator()(int n) const { const int hi = n >= 1024 ? 1 : 0, q = n - hi * 1024; return (q >> 7) * 256 + hi * 128 + (q & 127); } };

DI void phase0(const Args& a, LAS unsigned char* lds) {
    unsigned char* ws = a.ws;
    const int tid = otid();
    const size_t gtid = (size_t)blockIdx.x * NT + tid, gstride = (size_t)gridDim.x * NT;
    for (size_t i = gtid; i < 60 * 1024 / 2; i += gstride) ((unsigned*)(ws + WS_WIN + (size_t)1476 * 1024 * 2))[i] = 0u;
    for (size_t i = gtid; i < 32 * 1024; i += gstride) { const int e = (int)(i >> 10), k = (int)(i & 1023); const float w = a.in[I_WR][k * 32 + e] * a.in[I_N2G][k]; const u16 h = f2bf(w); ((u16*)(ws + WS_WR))[i] = h; ((u16*)(ws + WS_WR))[32 * 1024 + i] = f2bf(w - bf2f(h)); }
    for (size_t i = gtid; i < 4 * 128 * 128; i += gstride) { const int tt = (int)((i >> 7) & 127), ss = (int)(i & 127); ((u16*)(ws + WS_WSP))[i] = f2bf(ss <= tt ? a.in[I_WSP][i] : 0.f); }
    {
        const int wid = tid >> 6, lane = tid & 63;
        for (int row = blockIdx.x * 8 + wid; row < T; row += gridDim.x * 8) {
            const float* xr = a.in[I_X] + (size_t)row * 1024; u16* xb = (u16*)(ws + WS_XB) + (size_t)row * 1024;
            float ss = 0.f;
#pragma unroll
            for (int i = 0; i < 4; ++i) {
                const f32x4 v = *(const f32x4*)(xr + i * 256 + lane * 4);
                ss += (v[0] * v[0] + v[1] * v[1]) + (v[2] * v[2] + v[3] * v[3]);
                u32x2 w; w.x = pk2(v[0], v[1]); w.y = pk2(v[2], v[3]);
                *(u32x2*)(xb + i * 256 + lane * 4) = w;
            }
#pragma unroll
            for (int o = 32; o >= 1; o >>= 1) ss += __shfl_xor(ss, o);
            if (lane == 0) ((float*)(ws + WS_RS1))[row] = __builtin_amdgcn_rsqf(ss * (1.0f / 1024.0f) + EPS);
        }
    }
    constexpr int U_IN = 16 * 56, U_UQ = 4 * 16, U_QI = 4 * 4, U_PA = 8 * 16, U_OUT = 16 * 16, U_E1 = 32 * 16 * 32, U_E2 = 32 * 16 * 16, U_CB = 64;
    constexpr int U_TOT = U_IN + U_UQ + U_QI + U_PA + U_OUT + U_E1 + U_E2 + U_CB;
    for (int u = blockIdx.x; u < U_TOT; u += gridDim.x) {
        int v = u;
        if (v < U_IN) { tr_tile(lds, a.in[I_WIN], 3524, 3524, (v & 15) * 64, (v >> 4) * 64, a.in[I_N1G], 1.0f, (u16*)(ws + WS_WIN), 1024, MapIn()); continue; }
        v -= U_IN;
        if (v < U_UQ) { tr_tile(lds, a.in[I_WUQ], 1024, 1024, (v & 3) * 64, (v >> 2) * 64, a.in[I_QLG], 1.0f, (u16*)(ws + WS_WQ), 256, MapId()); continue; }
        v -= U_UQ;
        if (v < U_QI) { tr_tile(lds, a.in[I_WQI], 256, 256, (v & 3) * 64, (v >> 2) * 64, a.in[I_QLG], 0.125f, (u16*)(ws + WS_WQ) + 1024 * 256, 256, MapId()); continue; }
        v -= U_QI;
        if (v < U_PA) { tr_tile(lds, a.in[I_WPA], 1024, 1024, (v & 7) * 64, (v >> 3) * 64, nullptr, 1.0f, (u16*)(ws + WS_WCAT), 1536, MapId()); continue; }
        v -= U_PA;
        if (v < U_OUT) { tr_tile(lds, a.in[I_WOUT], 1024, 1024, (v & 15) * 64, (v >> 4) * 64, nullptr, 1.0f, (u16*)(ws + WS_WOUT), 1024, MapId()); continue; }
        v -= U_OUT;
        if (v < U_E1) { const int e = v >> 9, w = v & 511; tr_tile<true>(lds, a.in[I_WE1] + (size_t)e * 1024 * 2048, 2048, 2048, (w & 15) * 64, (w >> 4) * 64, a.in[I_N2G], 64.0f, (u16*)(ws + WS_WE1 + (size_t)e * 2048 * 1024), 1024, MapE1()); continue; }
        v -= U_E1;
        if (v < U_E2) { const int e = v >> 8, w = v & 255; tr_tile<true>(lds, a.in[I_WE2] + (size_t)e * 1024 * 1024, 1024, 1024, (w & 15) * 64, (w >> 4) * 64, nullptr, 64.0f, (u16*)(ws + WS_WE2 + (size_t)e * 1024 * 1024), 1024, MapId()); continue; }
        v -= U_E2;
        {
            const int h = v >> 3, c0 = (v & 7) * 16;
            LAS float* t = (LAS float*)lds;
            __syncthreads();
            for (int i = tid; i < 1024; i += NT) t[i] = a.in[I_WUV][(size_t)h * 128 * 64 + (size_t)c0 * 64 + i];
            __syncthreads();
            for (int nn = tid; nn < 1024; nn += NT) {
                float accv[16];
#pragma unroll
                for (int i = 0; i < 16; ++i) accv[i] = 0.f;
                for (int vv = 0; vv < 64; ++vv) {
                    const float pb = a.in[I_WPB][(size_t)(h * 64 + vv) * 1024 + nn];
#pragma unroll
                    for (int i = 0; i < 16; ++i) accv[i] += t[i * 64 + vv] * pb;
                }
                u32x4 w0, w1;
                w0.x = pk2(accv[0], accv[1]); w0.y = pk2(accv[2], accv[3]); w0.z = pk2(accv[4], accv[5]); w0.w = pk2(accv[6], accv[7]);
                w1.x = pk2(accv[8], accv[9]); w1.y = pk2(accv[10], accv[11]); w1.z = pk2(accv[12], accv[13]); w1.w = pk2(accv[14], accv[15]);
                u16* d = (u16*)(ws + WS_WCAT) + (size_t)nn * 1536 + 512 + h * 128 + c0;
                *(u32x4*)d = w0; *(u32x4*)(d + 8) = w1;
            }
        }
    }
}

DI void gmlp_unit(const Args& a, LAS unsigned char* lds, int u) {
    unsigned char* ws = a.ws;
    const int tid = otid(), wid = tid >> 6, lane = tid & 63, fr = lane & 15, fq = lane >> 4;
    const int g = u & 3, row0 = (u >> 2) * 128;
    const u16* H = (const u16*)(ws + WS_H);
    LAS u16* img = (LAS u16*)lds;
    __syncthreads();
    {
        const int s = tid & 127, cset = tid >> 7;
        const f32x4 sq = *(const f32x4*)((const float*)(ws + WS_SSQ) + (size_t)(row0 + s) * 32 + g * 4);
        const float rs = __builtin_amdgcn_rsqf(((sq[0] + sq[1]) + (sq[2] + sq[3])) * (1.0f / 128.0f) + EPS);
#pragma unroll
        for (int it = 0; it < 4; ++it) {
            const int c = cset + 4 * it;
            const u32x4 raw = *(const u32x4*)(H + (size_t)(row0 + s) * NIN + 512 + g * 128 + 8 * c);
            const float* vg = a.in[I_VG] + 8 * c;
            float f[8] = {bflo(raw.x), bfhi(raw.x), bflo(raw.y), bfhi(raw.y), bflo(raw.z), bfhi(raw.z), bflo(raw.w), bfhi(raw.w)};
#pragma unroll
            for (int i = 0; i < 8; ++i) img[(8 * c + i) * 136 + s] = f2bf(f[i] * rs * vg[i]);
        }
    }
    __syncthreads();
    const u16* W = (const u16*)(ws + WS_WSP) + (size_t)g * 128 * 128 + (size_t)(16 * wid + fr) * 128;
    f32x4 acc[8];
#pragma unroll
    for (int i = 0; i < 8; ++i) acc[i] = (f32x4){0.f, 0.f, 0.f, 0.f};
    const int nks = (16 * wid + 15) / 32 + 1;
    for (int ks = 0; ks < nks; ++ks) {
        const bf16x8 bw = *(const bf16x8*)(W + ks * 32 + 8 * fq);
#pragma unroll
        for (int i = 0; i < 8; ++i) {
            const bf16x8 av = *(const LAS bf16x8*)(img + (16 * i + fr) * 136 + ks * 32 + 8 * fq);
            acc[i] = __builtin_amdgcn_mfma_f32_16x16x32_bf16(av, bw, acc[i], 0, 0, 0);
        }
    }
    const int t = 16 * wid + fr;
    const float bias = a.in[I_BSP][g * 128 + t];
    u16* YO = (u16*)(ws + WS_YO);
#pragma unroll
    for (int i = 0; i < 8; ++i) {
        const int d = 16 * i + 4 * fq;
        const u32x2 uu = *(const u32x2*)(H + (size_t)(row0 + t) * NIN + g * 128 + d);
        const float y0 = bflo(uu.x) * (acc[i][0] + bias), y1 = bfhi(uu.x) * (acc[i][1] + bias), y2 = bflo(uu.y) * (acc[i][2] + bias), y3 = bfhi(uu.y) * (acc[i][3] + bias);
        u32x2 w; w.x = pk2(y0, y1); w.y = pk2(y2, y3);
        *(u32x2*)(YO + (size_t)(row0 + t) * 1536 + g * 128 + d) = w;
    }
}

DI void kvnorm(const Args& a) {
    unsigned char* ws = a.ws;
    const u16* H = (const u16*)(ws + WS_H); const float* SSQ = (const float*)(ws + WS_SSQ);
    const size_t gtid = (size_t)blockIdx.x * NT + otid(), gstride = (size_t)gridDim.x * NT;
    for (size_t idx = gtid; idx < (size_t)T * 24; idx += gstride) {
        const int row = (int)(idx / 24), c = (int)(idx % 24);
        const u16* src; u16* dst; const float* gain; float rs;
        if (c < 16) {
            const f32x4 sq = *(const f32x4*)(SSQ + (size_t)row * 32 + 24);
            rs = __builtin_amdgcn_rsqf(((sq[0] + sq[1]) + (sq[2] + sq[3])) * (1.0f / 128.0f) + EPS);
            src = H + (size_t)row * NIN + 1280 + 8 * c; dst = (u16*)(ws + WS_KVN) + (size_t)row * 128 + 8 * c; gain = a.in[I_KVG] + 8 * c;
        } else {
            const int cc = c - 16;
            rs = __builtin_amdgcn_rsqf((SSQ[(size_t)row * 32 + 28] + SSQ[(size_t)row * 32 + 29]) * (1.0f / 64.0f) + EPS);
            src = H + (size_t)row * NIN + 1408 + 8 * cc; dst = (u16*)(ws + WS_KIN) + (size_t)row * 64 + 8 * cc; gain = a.in[I_KIG] + 8 * cc;
        }
        const u32x4 raw = *(const u32x4*)src;
        u32x4 w;
        w.x = pk2(bflo(raw.x) * rs * gain[0], bfhi(raw.x) * rs * gain[1]); w.y = pk2(bflo(raw.y) * rs * gain[2], bfhi(raw.y) * rs * gain[3]);
        w.z = pk2(bflo(raw.z) * rs * gain[4], bfhi(raw.z) * rs * gain[5]); w.w = pk2(bflo(raw.w) * rs * gain[6], bfhi(raw.w) * rs * gain[7]);
        *(u32x4*)dst = w;
    }
}

constexpr int P3_ROWS = 0, P3_HIST = 131072, P3_LIST = 147456;
DI unsigned f2key(float f) { const unsigned u = __float_as_uint(f); return (u & 0x80000000u) ? ~u : (u | 0x80000000u); }
DI int wave_incl_scan(int v, int lane) {
#pragma unroll
    for (int o = 1; o < 64; o <<= 1) { const int t = __shfl_up(v, o); if (lane >= o) v += t; }
    return v;
}
DI int wave_suffix_scan(int v, int lane) {
#pragma unroll
    for (int o = 1; o < 64; o <<= 1) { const int t = __shfl_down(v, o); if (lane + o < 64) v += t; }
    return v;
}
DI unsigned pk_gt(unsigned kw, unsigned xw, unsigned one) {
    unsigned d, m;
    asm("v_pk_sub_u16 %0, %1, %2 clamp" : "=v"(d) : "v"(kw), "v"(xw));
    asm("v_pk_min_u16 %0, %1, %2" : "=v"(m) : "v"(d), "v"(one));
    return m;
}
DI unsigned pk_subs(unsigned kw, unsigned xw) { unsigned d; asm("v_pk_sub_u16 %0, %1, %2 clamp" : "=v"(d) : "v"(kw), "v"(xw)); return d; }
DI unsigned pk_min1(unsigned d, unsigned one) { unsigned m; asm("v_pk_min_u16 %0, %1, %2" : "=v"(m) : "v"(d), "v"(one)); return m; }
DI unsigned pk_add(unsigned a, unsigned b) { unsigned r; asm("v_pk_add_u16 %0, %1, %2" : "=v"(r) : "v"(a), "v"(b)); return r; }
DI int wave_sum(int v) {
    v += __builtin_amdgcn_update_dpp(0, v, 0xB1, 0xf, 0xf, false);
    v += __builtin_amdgcn_update_dpp(0, v, 0x4E, 0xf, 0xf, false);
    v += __builtin_amdgcn_update_dpp(0, v, 0x141, 0xf, 0xf, false);
    v += __builtin_amdgcn_update_dpp(0, v, 0x140, 0xf, 0xf, false);
    return __builtin_amdgcn_readlane(v, 0) + __builtin_amdgcn_readlane(v, 16) + __builtin_amdgcn_readlane(v, 32) + __builtin_amdgcn_readlane(v, 48);
}
DI int rowaddr(int p) { return (p & ~511) | ((p & 63) << 3) | ((p >> 6) & 7); }
typedef unsigned short us2_t __attribute__((ext_vector_type(2)));
DI unsigned dot2acc(unsigned flags, unsigned wts, unsigned acc) { return __builtin_amdgcn_udot2(__builtin_bit_cast(us2_t, flags), __builtin_bit_cast(us2_t, wts), acc, false); }
DI void select_top16(LAS u16* row, LAS u16* list, int N, int lane) {
    const int Nup = (N + 511) & ~511, niter = Nup >> 9;
    for (int p = N + lane; p < Nup; p += 64) row[rowaddr(p)] = (u16)0;
    wave_lds_sync();
    u32x4 kr[16];
#pragma unroll
    for (int i = 0; i < 16; ++i) { kr[i] = (u32x4){0u, 0u, 0u, 0u}; if (i < niter) kr[i] = *(LAS const u32x4*)(row + i * 512 + lane * 8); }
    const unsigned one = 0x00010001u;
    auto count_gt = [&](unsigned x) -> int {
        const unsigned xw = x | (x << 16);
        unsigned acc = 0u, acc1 = 0u, acc2 = 0u, acc3 = 0u;
#pragma unroll
        for (int c = 0; c < 4; ++c) {
            if (4 * c < niter) {
                unsigned d[16];
#pragma unroll
                for (int i = 0; i < 4; ++i) { d[4 * i] = pk_subs(kr[4 * c + i].x, xw); d[4 * i + 1] = pk_subs(kr[4 * c + i].y, xw); d[4 * i + 2] = pk_subs(kr[4 * c + i].z, xw); d[4 * i + 3] = pk_subs(kr[4 * c + i].w, xw); }
#pragma unroll
                for (int i = 0; i < 16; ++i) d[i] = pk_min1(d[i], one);
#pragma unroll
                for (int i = 0; i < 16; i += 4) { acc = dot2acc(d[i], one, acc); acc1 = dot2acc(d[i + 1], one, acc1); acc2 = dot2acc(d[i + 2], one, acc2); acc3 = dot2acc(d[i + 3], one, acc3); }
            }
        }
        return wave_sum((int)((acc + acc1) + (acc2 + acc3)));
    };
    unsigned T = 0u; int cge = Nup;
#pragma unroll 1
    for (int bit = 15; bit >= 0; --bit) {
        const unsigned cand = T | (1u << bit);
        const int cnt = count_gt(cand - 1u);
        if (cnt >= 256) { T = cand; cge = cnt; }
    }
    auto build = [&](unsigned x, unsigned (&M)[4]) {
        const unsigned xw = x | (x << 16);
#pragma unroll
        for (int c = 0; c < 4; ++c) {
            M[c] = 0u;
            if (4 * c < niter) {
#pragma unroll
                for (int i = 4 * c; i < 4 * c + 4; ++i) {
                    unsigned byte = dot2acc(pk_gt(kr[i].x, xw, one), 0x00020001u, 0u);
                    byte = dot2acc(pk_gt(kr[i].y, xw, one), 0x00080004u, byte);
                    byte = dot2acc(pk_gt(kr[i].z, xw, one), 0x00200010u, byte);
                    byte = dot2acc(pk_gt(kr[i].w, xw, one), 0x00800040u, byte);
                    M[c] |= byte << (8 * (i & 3));
                }
            }
        }
    };
    unsigned M[4];
    build(T - 1u, M);
    if (cge != 256) {
        unsigned G[4]; build(T, G);
        unsigned E[4];
#pragma unroll
        for (int c = 0; c < 4; ++c) E[c] = M[c] & ~G[c];
        const int need = 256 - (cge - wave_sum((int)(__builtin_popcount(E[0]) + __builtin_popcount(E[1]) + __builtin_popcount(E[2]) + __builtin_popcount(E[3]))));
        auto below = [&](int B, int c) -> unsigned { const int nb = B - 32 * c; return nb <= 0 ? 0u : (nb >= 32 ? 0xffffffffu : ((1u << nb) - 1u)); };
        auto ties_below = [&](int B) -> int {
            return wave_sum((int)(__builtin_popcount(E[0] & below(B, 0)) + __builtin_popcount(E[1] & below(B, 1)) + __builtin_popcount(E[2] & below(B, 2)) + __builtin_popcount(E[3] & below(B, 3))));
        };
        int lo = 0, hi = 127;
#pragma unroll 1
        while (lo < hi) { const int mid = (lo + hi) >> 1; if (ties_below(mid + 1) >= need) hi = mid; else lo = mid + 1; }
        const int Bs = lo, r = need - ties_below(Bs);
        const unsigned ew = Bs < 32 ? E[0] : (Bs < 64 ? E[1] : (Bs < 96 ? E[2] : E[3]));
        const bool tb = ((ew >> (Bs & 31)) & 1u) != 0u;
        const unsigned long long em = __ballot(tb);
        const bool take_row = tb && __builtin_popcountll(em & ((1ull << lane) - 1ull)) < r;
#pragma unroll
        for (int c = 0; c < 4; ++c) {
            unsigned tk = E[c] & below(Bs, c);
            if ((Bs >> 5) == c && take_row) tk |= 1u << (Bs & 31);
            M[c] = G[c] | tk;
        }
    }
    const int kl = __builtin_popcount(M[0]) + __builtin_popcount(M[1]) + __builtin_popcount(M[2]) + __builtin_popcount(M[3]);
    int wp = wave_incl_scan(kl, lane) - kl;
#pragma unroll
    for (int c = 0; c < 4; ++c) {
        unsigned m = M[c];
        while (m) { const int b = __builtin_ctz(m); list[wp] = (u16)((32 * c + b) * 64 + lane); ++wp; m &= m - 1u; }
    }
}

DI void dsa_phase(const Args& a, LAS unsigned char* lds) {
    unsigned char* ws = a.ws;
    const int tid = otid(), wid = __builtin_amdgcn_readfirstlane(tid >> 6), lane = tid & 63, fr = lane & 15, fq = lane >> 4;
    const u16* QI = (const u16*)(ws + WS_QI); const u16* KIN = (const u16*)(ws + WS_KIN); const u16* KVN = (const u16*)(ws + WS_KVN);
    const u16* Q = (const u16*)(ws + WS_Q); const float* WI = (const float*)(ws + WS_WI); u16* YO = (u16*)(ws + WS_YO);
    LAS u16* rows = (LAS u16*)(lds + P3_ROWS);
    for (int gi = blockIdx.x; gi < T / 8; gi += gridDim.x) {
        const int b = gi & 3, t0 = S - 8 - 8 * (gi >> 2);
        const size_t brow = (size_t)b * S;
        const int ntile = (t0 + 8 + 15) >> 4;
        __syncthreads();
        {
            bf16x8 qa[2][2]; f32x4 wi[2];
#pragma unroll
            for (int rg = 0; rg < 2; ++rg) {
#pragma unroll
                for (int ks = 0; ks < 2; ++ks) qa[rg][ks] = *(const bf16x8*)(QI + (brow + t0 + 4 * rg + (fr >> 2)) * 256 + (fr & 3) * 64 + ks * 32 + 8 * fq);
                wi[rg] = *(const f32x4*)(WI + (brow + t0 + 4 * rg + fq) * 4);
            }
            auto ldk = [&](bf16x8 (&kf)[4][2], int jt0) {
#pragma unroll
                for (int u = 0; u < 4; ++u) {
                    const int jt = (jt0 + 8 * u) < ntile ? (jt0 + 8 * u) : (ntile - 1);
                    const u16* kp = KIN + (brow + jt * 16 + fr) * 64 + 8 * fq;
                    kf[u][0] = *(const bf16x8*)kp; kf[u][1] = *(const bf16x8*)(kp + 32);
                }
            };
            auto cmpk = [&](const bf16x8 (&kf)[4][2], int jt0) {
#pragma unroll
                for (int u = 0; u < 4; ++u) {
                    const int jt = jt0 + 8 * u;
                    if (jt < ntile) {
#pragma unroll
                        for (int rg = 0; rg < 2; ++rg) {
                            f32x4 d = {0.f, 0.f, 0.f, 0.f};
                            d = __builtin_amdgcn_mfma_f32_16x16x32_bf16(qa[rg][0], kf[u][0], d, 0, 0, 0);
                            d = __builtin_amdgcn_mfma_f32_16x16x32_bf16(qa[rg][1], kf[u][1], d, 0, 0, 0);
                            const float sc = ((fmaxf(d[0], 0.f) * wi[rg][0] + fmaxf(d[1], 0.f) * wi[rg][1]) + fmaxf(d[2], 0.f) * wi[rg][2]) + fmaxf(d[3], 0.f) * wi[rg][3];
                            rows[(4 * rg + fq) * 8192 + rowaddr(jt * 16 + fr)] = (u16)(f2key(sc) >> 16);
                        }
                    }
                }
            };
            bf16x8 kA[4][2], kB[4][2];
            if (wid < ntile) ldk(kA, wid);
            for (int jt0 = wid; jt0 < ntile; jt0 += 64) {
                const bool hasB = jt0 + 32 < ntile;
                if (hasB) ldk(kB, jt0 + 32);
                cmpk(kA, jt0);
                if (hasB) { if (jt0 + 64 < ntile) ldk(kA, jt0 + 64); cmpk(kB, jt0 + 32); }
            }
        }
        __syncthreads();
        {
            const int q = wid, t = t0 + q, N = t + 1;
            LAS u16* row = rows + q * 8192;
            LAS u16* list = (LAS u16*)(lds + P3_LIST + q * 512);
            int cnt;
            if (N <= 256) { for (int p = lane; p < 256; p += 64) list[p] = p < N ? (u16)p : (u16)0; cnt = N; }
            else { select_top16(row, list, N, lane); cnt = 256; }
            wave_lds_sync();
            bf16x8 qf[4];
            {
                const int head = fr & 7;
                const u16* qrow = Q + (brow + t) * 1024 + head * 128;
                float f[4][8]; float ss = 0.f;
#pragma unroll
                for (int ks = 0; ks < 4; ++ks) {
                    const u32x4 raw = *(const u32x4*)(qrow + ks * 32 + 8 * fq);
                    f[ks][0] = bflo(raw.x); f[ks][1] = bfhi(raw.x); f[ks][2] = bflo(raw.y); f[ks][3] = bfhi(raw.y); f[ks][4] = bflo(raw.z); f[ks][5] = bfhi(raw.z); f[ks][6] = bflo(raw.w); f[ks][7] = bfhi(raw.w);
#pragma unroll
                    for (int j = 0; j < 8; ++j) ss += f[ks][j] * f[ks][j];
                }
                ss += __shfl_xor(ss, 16); ss += __shfl_xor(ss, 32);
                const float rq = __builtin_amdgcn_rsqf(ss * (1.0f / 128.0f) + EPS) * 0.08838834764831845f;
#pragma unroll
                for (int ks = 0; ks < 4; ++ks) {
                    const float* qg = a.in[I_QNG] + ks * 32 + 8 * fq;
                    u32x4 w;
                    w.x = pk2(f[ks][0] * rq * qg[0], f[ks][1] * rq * qg[1]); w.y = pk2(f[ks][2] * rq * qg[2], f[ks][3] * rq * qg[3]);
                    w.z = pk2(f[ks][4] * rq * qg[4], f[ks][5] * rq * qg[5]); w.w = pk2(f[ks][6] * rq * qg[6], f[ks][7] * rq * qg[7]);
                    qf[ks] = __builtin_bit_cast(bf16x8, w);
                }
            }
            LAS unsigned char* img = (LAS unsigned char*)row;
            const int nsteps = (cnt + 31) >> 5;
            f32x4 oacc[8];
#pragma unroll
            for (int i = 0; i < 8; ++i) oacc[i] = (f32x4){0.f, 0.f, 0.f, 0.f};
            float mrun = -3.0e38f, lpart = 0.f;
            auto issue = [&](u32x4 (&pf)[8], int pp) {
#pragma unroll
                for (int it = 0; it < 8; ++it) { const int piece = it * 64 + lane; const unsigned key = list[pp * 32 + (piece >> 4)]; pf[it] = *(const u32x4*)(KVN + (brow + key) * 128 + 8 * (piece & 15)); }
            };
            auto step = [&](u32x4 (&pf)[8], int pp) {
#pragma unroll
                for (int it = 0; it < 8; ++it) { const int piece = it * 64 + lane; *(LAS u32x4*)(img + (piece >> 4) * 288 + (piece & 15) * 16) = pf[it]; }
                if (pp + 1 < nsteps) issue(pf, pp + 1);
                wave_lds_sync();
                __builtin_amdgcn_sched_barrier(0);
                f32x4 sa = {0.f, 0.f, 0.f, 0.f}, sb = {0.f, 0.f, 0.f, 0.f};
#pragma unroll
                for (int ks = 0; ks < 4; ++ks) {
                    const bf16x8 a0 = *(LAS const bf16x8*)(img + fr * 288 + (ks * 32 + 8 * fq) * 2), a1 = *(LAS const bf16x8*)(img + (16 + fr) * 288 + (ks * 32 + 8 * fq) * 2);
                    sa = __builtin_amdgcn_mfma_f32_16x16x32_bf16(a0, qf[ks], sa, 0, 0, 0); sb = __builtin_amdgcn_mfma_f32_16x16x32_bf16(a1, qf[ks], sb, 0, 0, 0);
                }
                const int pb0 = pp * 32 + 4 * fq;
#pragma unroll
                for (int r = 0; r < 4; ++r) { if (pb0 + r >= cnt) sa[r] = -3.0e38f; if (pb0 + 16 + r >= cnt) sb[r] = -3.0e38f; }
                float mx = fmaxf(fmaxf(fmaxf(sa[0], sa[1]), fmaxf(sa[2], sa[3])), fmaxf(fmaxf(sb[0], sb[1]), fmaxf(sb[2], sb[3])));
                mx = fmaxf(mx, __shfl_xor(mx, 16)); mx = fmaxf(mx, __shfl_xor(mx, 32));
                const float mnew = fmaxf(mrun, mx), alpha = __expf(mrun - mnew);
                mrun = mnew;
                float ps = 0.f;
#pragma unroll
                for (int r = 0; r < 4; ++r) { sa[r] = __expf(sa[r] - mnew); sb[r] = __expf(sb[r] - mnew); ps += sa[r] + sb[r]; }
                lpart = lpart * alpha + ps;
#pragma unroll
                for (int cb = 0; cb < 8; ++cb) oacc[cb] *= alpha;
                u32x4 pw; pw.x = pk2(sa[0], sa[1]); pw.y = pk2(sa[2], sa[3]); pw.z = pk2(sb[0], sb[1]); pw.w = pk2(sb[2], sb[3]);
                const bf16x8 pb = __builtin_bit_cast(bf16x8, pw);
#pragma unroll
                for (int cb = 0; cb < 8; ++cb) {
                    const s16x4 r0 = __builtin_amdgcn_ds_read_tr16_b64_v4i16((LAS s16x4*)(img + (4 * fq + (fr >> 2)) * 288 + (cb * 16 + 4 * (fr & 3)) * 2));
                    const s16x4 r1 = __builtin_amdgcn_ds_read_tr16_b64_v4i16((LAS s16x4*)(img + (16 + 4 * fq + (fr >> 2)) * 288 + (cb * 16 + 4 * (fr & 3)) * 2));
                    const bf16x8 av = {r0[0], r0[1], r0[2], r0[3], r1[0], r1[1], r1[2], r1[3]};
                    oacc[cb] = __builtin_amdgcn_mfma_f32_16x16x32_bf16(av, pb, oacc[cb], 0, 0, 0);
                    if (cb == 3) __builtin_amdgcn_sched_barrier(0);
                }
                wave_lds_sync();
            };
            u32x4 pf0[8];
            issue(pf0, 0);
#pragma unroll 1
            for (int pp = 0; pp < nsteps; ++pp) step(pf0, pp);
            float lsum = lpart; lsum += __shfl_xor(lsum, 16); lsum += __shfl_xor(lsum, 32);
            const float inv = __builtin_amdgcn_rcpf(lsum);
            if (fr < 8) {
                u16* orow = YO + (brow + t) * 1536 + 512 + fr * 128 + 4 * fq;
#pragma unroll
                for (int cb = 0; cb < 8; ++cb) { u32x2 w; w.x = pk2(oacc[cb][0] * inv, oacc[cb][1] * inv); w.y = pk2(oacc[cb][2] * inv, oacc[cb][3] * inv); *(u32x2*)(orow + cb * 16) = w; }
            }
        }
    }
}

constexpr int P6_LCNT = 0, P6_BASE = 128, P6_RSB = 256, P6_RI = 1024;
DI unsigned dpp_max_u32(unsigned v) {
    v = max(v, (unsigned)__builtin_amdgcn_update_dpp(0, (int)v, 0xB1, 0xf, 0xf, false));
    v = max(v, (unsigned)__builtin_amdgcn_update_dpp(0, (int)v, 0x4E, 0xf, 0xf, false));
    v = max(v, (unsigned)__builtin_amdgcn_update_dpp(0, (int)v, 0x141, 0xf, 0xf, false));
    v = max(v, (unsigned)__builtin_amdgcn_update_dpp(0, (int)v, 0x140, 0xf, 0xf, false));
    return v;
}
DI float key2f(unsigned k) { return __uint_as_float((k & 0x80000000u) ? (k & 0x7fffffffu) : ~k); }
DI void router_phase(const Args& a, LAS unsigned char* lds) {
    unsigned char* ws = a.ws;
    const int tid = otid(), wid = tid >> 6, lane = tid & 63, fr = lane & 15, fq = lane >> 4;
    LAS int* lcnt = (LAS int*)(lds + P6_LCNT); LAS int* lbase = (LAS int*)(lds + P6_BASE); LAS float* rsb = (LAS float*)(lds + P6_RSB); LAS int* RI = (LAS int*)(lds + P6_RI);
    const u16* WRH = (const u16*)(ws + WS_WR); const u16* WRL = WRH + 32 * 1024;
    unsigned* CNT = (unsigned*)(ws + WS_CTL);
    for (int rg = blockIdx.x; rg < T / 128; rg += gridDim.x) {
        __syncthreads();
        if (tid < 32) lcnt[tid] = 0;
        __syncthreads();
        {
            const int row = rg * 128 + wid * 16 + fr;
            const float* xr = a.out + (size_t)row * 1024 + 8 * fq;
            f32x4 acc[2] = {{0.f, 0.f, 0.f, 0.f}, {0.f, 0.f, 0.f, 0.f}};
            float ss = 0.f;
#pragma unroll 4
            for (int ks = 0; ks < 32; ++ks) {
                const f32x4 x0 = *(const f32x4*)(xr + ks * 32), x1 = *(const f32x4*)(xr + ks * 32 + 4);
                ss += ((x0[0] * x0[0] + x0[1] * x0[1]) + (x0[2] * x0[2] + x0[3] * x0[3])) + ((x1[0] * x1[0] + x1[1] * x1[1]) + (x1[2] * x1[2] + x1[3] * x1[3]));
                u32x4 hw; hw.x = pk2(x0[0], x0[1]); hw.y = pk2(x0[2], x0[3]); hw.z = pk2(x1[0], x1[1]); hw.w = pk2(x1[2], x1[3]);
                u32x4 lw; lw.x = pk2(x0[0] - bflo(hw.x), x0[1] - bfhi(hw.x)); lw.y = pk2(x0[2] - bflo(hw.y), x0[3] - bfhi(hw.y)); lw.z = pk2(x1[0] - bflo(hw.z), x1[1] - bfhi(hw.z)); lw.w = pk2(x1[2] - bflo(hw.w), x1[3] - bfhi(hw.w));
                const bf16x8 xh = __builtin_bit_cast(bf16x8, hw), xl = __builtin_bit_cast(bf16x8, lw);
#pragma unroll
                for (int nt = 0; nt < 2; ++nt) {
                    const bf16x8 wh = *(const bf16x8*)(WRH + (size_t)(nt * 16 + fr) * 1024 + ks * 32 + 8 * fq), wl = *(const bf16x8*)(WRL + (size_t)(nt * 16 + fr) * 1024 + ks * 32 + 8 * fq);
                    acc[nt] = __builtin_amdgcn_mfma_f32_16x16x32_bf16(xh, wh, acc[nt], 0, 0, 0);
                    acc[nt] = __builtin_amdgcn_mfma_f32_16x16x32_bf16(xl, wh, acc[nt], 0, 0, 0);
                    acc[nt] = __builtin_amdgcn_mfma_f32_16x16x32_bf16(xh, wl, acc[nt], 0, 0, 0);
                }
            }
            ss += __shfl_xor(ss, 16); ss += __shfl_xor(ss, 32);
            if (fq == 0) rsb[wid * 16 + fr] = __builtin_amdgcn_rsqf(ss * (1.0f / 1024.0f) + EPS);
            wave_lds_sync();
            const float b0 = a.in[I_BR][fr], b1 = a.in[I_BR][16 + fr];
#pragma unroll
            for (int r = 0; r < 4; ++r) {
                const float rs = rsb[wid * 16 + 4 * fq + r];
                unsigned k0 = (f2key(acc[0][r] * rs + b0) & ~31u) | (unsigned)(31 - fr), k1 = (f2key(acc[1][r] * rs + b1) & ~31u) | (unsigned)(15 - fr);
                unsigned sel[4];
#pragma unroll
                for (int k = 0; k < 4; ++k) {
                    const unsigned best = dpp_max_u32(k0 > k1 ? k0 : k1);
                    sel[k] = best;
                    if (k0 == best) k0 = 0u;
                    if (k1 == best) k1 = 0u;
                }
                const float v0 = key2f(sel[0] & ~31u), e1 = __expf(key2f(sel[1] & ~31u) - v0), e2 = __expf(key2f(sel[2] & ~31u) - v0), e3 = __expf(key2f(sel[3] & ~31u) - v0);
                const float inv = 1.0f / (1.0f + e1 + e2 + e3);
                if (fr < 4) {
                    const unsigned sk = fr == 0 ? sel[0] : (fr == 1 ? sel[1] : (fr == 2 ? sel[2] : sel[3]));
                    const int e = 31 - (int)(sk & 31u);
                    const float gt = (fr == 0 ? 1.0f : (fr == 1 ? e1 : (fr == 2 ? e2 : e3))) * inv;
                    const int ls = __hip_atomic_fetch_add(lcnt + e, 1, __ATOMIC_RELAXED, __HIP_MEMORY_SCOPE_WORKGROUP);
                    const int ri = ((wid * 16 + 4 * fq + r) * 4 + fr) * 4;
                    RI[ri + 0] = e; RI[ri + 1] = ls; RI[ri + 2] = __float_as_int(gt); RI[ri + 3] = __float_as_int(rs);
                }
            }
        }
        __syncthreads();
        if (tid < 32) lbase[tid] = (int)__hip_atomic_fetch_add(CNT + tid, (unsigned)lcnt[tid], __ATOMIC_RELAXED, __HIP_MEMORY_SCOPE_AGENT);
        __syncthreads();
        {
            const int rl = tid >> 2, k = tid & 3, row = rg * 128 + rl;
            const int e = RI[tid * 4 + 0], slot = lbase[e] + RI[tid * 4 + 1];
            ((int*)(ws + WS_LTOK))[(size_t)e * ECAP + slot] = row;
            ((float*)(ws + WS_LGATE))[(size_t)e * ECAP + slot] = __int_as_float(RI[tid * 4 + 2]);
            ((float*)(ws + WS_LRS))[(size_t)e * ECAP + slot] = __int_as_float(RI[tid * 4 + 3]);
            ((unsigned*)(ws + WS_ROUTE))[(size_t)row * 4 + k] = ((unsigned)e << 16) | (unsigned)slot;
        }
    }
}

DI void combine_phase(const Args& a, LAS unsigned char* lds) {
    unsigned char* ws = a.ws;
    LAS const int* tab = (LAS const int*)(lds + MOE_TAB);
    const int tid = otid(), wid = tid >> 6, lane = tid & 63;
    const u16* YB = (const u16*)(ws + WS_YB); const unsigned* ROUTE = (const unsigned*)(ws + WS_ROUTE);
    for (int row = blockIdx.x * 8 + wid; row < T; row += gridDim.x * 8) {
        size_t pos[4];
#pragma unroll
        for (int k = 0; k < 4; ++k) { const unsigned r = ROUTE[(size_t)row * 4 + k]; const int e = (int)(r >> 16), slot = (int)(r & 0xffffu); pos[k] = (size_t)tab[e] * 256 + slot; }
        float* orow = a.out + (size_t)row * 1024;
#pragma unroll
        for (int i = 0; i < 4; ++i) {
            f32x4 v = *(const f32x4*)(orow + i * 256 + lane * 4);
#pragma unroll
            for (int k = 0; k < 4; ++k) { const u32x2 y = *(const u32x2*)(YB + pos[k] * 1024 + i * 256 + lane * 4); v[0] += bflo(y.x); v[1] += bfhi(y.x); v[2] += bflo(y.y); v[3] += bfhi(y.y); }
            *(f32x4*)(orow + i * 256 + lane * 4) = v;
        }
    }
}

#define XB_TMO      128
#define XB_XCNT(j)  (256  + 64 * (j))
#define XB_XSUB(j)  (1280 + 64 * (j))
#define XB_XGEN(j)  (2304 + 64 * (j))
#define XB_TOP      3328
#define XB_TOPGEN   3392
#define XCD_BAR_WORDS 3456
#define XB_SPIN_CAP (1u << 18)

__device__ __forceinline__ unsigned xb_ld(unsigned* p)              { return __hip_atomic_load(p, __ATOMIC_RELAXED, __HIP_MEMORY_SCOPE_AGENT); }
__device__ __forceinline__ unsigned xb_add(unsigned* p, unsigned v) { return __hip_atomic_fetch_add(p, v, __ATOMIC_RELAXED, __HIP_MEMORY_SCOPE_AGENT); }
__device__ __forceinline__ unsigned xb_xcc_id() { return (unsigned)__builtin_amdgcn_s_getreg((3 << 11) | 20) & 0xFu; }
#define XB_SPIN(cond, bar) do { unsigned _sp = 0; while (cond) { __builtin_amdgcn_s_sleep(1); \
    if ((++_sp & 255u) == 0u) { if (xb_ld(&(bar)[XB_TMO])) break; if (_sp > XB_SPIN_CAP) { atomicAdd(&(bar)[XB_TMO], 1u); break; } } } } while (0)

struct XcdBarrier {
    unsigned* bar; unsigned x;
    volatile LAS unsigned* st;
};

__device__ __forceinline__ XcdBarrier xcd_barrier_post(unsigned* bar, volatile LAS unsigned* st) {
    XcdBarrier b; b.bar = bar; b.x = xb_xcc_id(); b.st = st;
    if (threadIdx.x == 0) (void)xb_add(&bar[XB_XCNT(b.x)], 1u);
    return b;
}
__device__ __forceinline__ void xcd_barrier_complete(unsigned* bar, unsigned x, unsigned& nloc, unsigned& nx) {
    const unsigned G = gridDim.x * gridDim.y * gridDim.z;
    unsigned sum, cnt, mine, sp = 0u;
    for (;;) {
        sum = 0u; cnt = 0u; mine = 0u;
#pragma unroll
        for (unsigned j = 0; j < 16; ++j) { const unsigned c = xb_ld(&bar[XB_XCNT(j)]); sum += c; cnt += (c > 0u) ? 1u : 0u; mine = (j == x) ? c : mine; }
        if (sum == G) break;
        __builtin_amdgcn_s_sleep(1);
        if ((++sp & 255u) == 0u) { if (xb_ld(&bar[XB_TMO])) break; if (sp > XB_SPIN_CAP) { atomicAdd(&bar[XB_TMO], 1u); break; } }
    }
    nloc = mine > 0u ? mine : 1u; nx = cnt > 0u ? cnt : 1u;
}

__device__ __forceinline__ void xcd_barrier(const XcdBarrier& b) {
    asm volatile("s_waitcnt vmcnt(0)" ::: "memory");
    __syncthreads();
    if (threadIdx.x == 0) {
        unsigned* bar = b.bar;
        __builtin_amdgcn_s_waitcnt(0);
        unsigned nloc = b.st[0], nx = b.st[1];
        if (nloc == 0u) { xcd_barrier_complete(bar, b.x, nloc, nx); b.st[0] = nloc; b.st[1] = nx; }
        const unsigned old = xb_add(&bar[XB_XSUB(b.x)], 1u);
        const unsigned gen = old / nloc;
        if (old + 1u == (gen + 1u) * nloc) {
            __builtin_amdgcn_fence(__ATOMIC_RELEASE, "agent");
            asm volatile("s_waitcnt vmcnt(0)" ::: "memory");
            const unsigned og = xb_add(&bar[XB_TOP], 1u);
            const unsigned tg = og / nx;
            if (og + 1u == (tg + 1u) * nx) xb_add(&bar[XB_TOPGEN], 1u);
            else XB_SPIN(xb_ld(&bar[XB_TOPGEN]) == tg, bar);
            __builtin_amdgcn_fence(__ATOMIC_ACQUIRE, "agent");
            xb_add(&bar[XB_XGEN(b.x)], 1u);
            asm volatile("s_waitcnt vmcnt(0)" ::: "memory");
        } else {
            XB_SPIN(xb_ld(&bar[XB_XGEN(b.x)]) == gen, bar);
            __builtin_amdgcn_fence(__ATOMIC_ACQUIRE, "agent");
            asm volatile("s_waitcnt vmcnt(0)" ::: "memory");
        }
    }
    __syncthreads();
}

__global__ void __launch_bounds__(NT, 2) fwd(Args a) {
    extern __shared__ __attribute__((aligned(16))) unsigned char lds_raw[];
    LAS unsigned char* lds = (LAS unsigned char*)lds_raw;
    cg::grid_group grid = cg::this_grid();
    unsigned char* ws = a.ws;
    const int G = gridDim.x, c = blockIdx.x;
    if (threadIdx.x < 2) ((volatile LAS unsigned*)(lds + LDS_BARST))[threadIdx.x] = 0u;
    __syncthreads();
    const XcdBarrier xbar = xcd_barrier_post((unsigned*)(ws + WS_BAR), (volatile LAS unsigned*)(lds + LDS_BARST));

    phase0(a, lds);
    grid.sync();
    {
        g8::PlainSched s; s.Abase = (const char*)(ws + WS_XB); s.Bbase = (const char*)(ws + WS_WIN); s.lda = 1024; s.ldb = 1024; s.K = 1024; s.nM = T / 256; s.nN = NIN / 256; s.G = G; s.c = c;
        EpiIn e; e.H = (u16*)(ws + WS_H); e.rs1 = (const float*)(ws + WS_RS1); e.SSQ = (float*)(ws + WS_SSQ); e.WI = (float*)(ws + WS_WI);
        g8::gemm_phase(lds, s, e);
    }
    xcd_barrier(xbar);
    {
        g8::PlainSched s; s.Abase = (const char*)(ws + WS_H) + 1024 * 2; s.Bbase = (const char*)(ws + WS_WQ); s.lda = NIN; s.ldb = 256; s.K = 256; s.nM = T / 256; s.nN = 5; s.G = G; s.c = c;
        EpiQ e; e.Q = (u16*)(ws + WS_Q); e.QI = (u16*)(ws + WS_QI); e.SSQ = (const float*)(ws + WS_SSQ);
        g8::gemm_phase(lds, s, e);
        for (int u = c; u < 1024; u += G) gmlp_unit(a, lds, u);
        kvnorm(a);
    }
    xcd_barrier(xbar);
    dsa_phase(a, lds);
    xcd_barrier(xbar);
    {
        g8::PlainSched s; s.Abase = (const char*)(ws + WS_YO); s.Bbase = (const char*)(ws + WS_WCAT); s.lda = 1536; s.ldb = 1536; s.K = 512; s.nM = T / 256; s.nN = 4; s.G = G; s.c = c;
        EpiMrg<0> e0; e0.OUT = (u16*)(ws + WS_TMP); e0.TMP = nullptr; e0.H = (const u16*)(ws + WS_H);
        g8::gemm_phase(lds, s, e0);
        s.Abase = (const char*)(ws + WS_YO) + 512 * 2; s.Bbase = (const char*)(ws + WS_WCAT) + 512 * 2; s.K = 1024;
        EpiMrg<1> e1; e1.OUT = (u16*)(ws + WS_MRG); e1.TMP = (const u16*)(ws + WS_TMP); e1.H = (const u16*)(ws + WS_H);
        g8::gemm_phase(lds, s, e1);
    }
    xcd_barrier(xbar);
    {
        g8::PlainSched s; s.Abase = (const char*)(ws + WS_MRG); s.Bbase = (const char*)(ws + WS_WOUT); s.lda = 1024; s.ldb = 1024; s.K = 1024; s.nM = T / 256; s.nN = 4; s.G = G; s.c = c;
        EpiOut e; e.out = a.out; e.x = a.in[I_X]; e.XN = (unsigned char*)(ws + WS_XN2);
        g8::gemm_phase(lds, s, e);
    }
    xcd_barrier(xbar);
    router_phase(a, lds);
    xcd_barrier(xbar);
    moe_table(lds, (const unsigned*)(ws + WS_CTL));
    {
        MoeSched<8, true> s; s.Abase = (const char*)(ws + WS_XN2); s.Wbase = (const char*)(ws + WS_WE1); s.LTOK = (const int*)(ws + WS_LTOK); s.tab = (LAS const int*)(lds + MOE_TAB);
        s.lda = 1024; s.ldb = 1024; s.K = 1024; s.G = G; s.c = c; s.wstride = (size_t)2048 * 1024;
        EpiMoe1 e; e.ACT = (unsigned char*)(ws + WS_ACT); e.b1 = a.in[I_BE1]; e.LRS = (const float*)(ws + WS_LRS); e.tab = (LAS const int*)(lds + MOE_TAB);
        g8::gemm_phase<true>(lds, s, e);
    }
    xcd_barrier(xbar);
    {
        MoeSched<4, false> s; s.Abase = (const char*)(ws + WS_ACT); s.Wbase = (const char*)(ws + WS_WE2); s.LTOK = nullptr; s.tab = (LAS const int*)(lds + MOE_TAB);
        s.lda = 1024; s.ldb = 1024; s.K = 1024; s.G = G; s.c = c; s.wstride = (size_t)1024 * 1024;
        EpiMoe2 e; e.YB = (u16*)(ws + WS_YB); e.b2 = a.in[I_BE2]; e.LGATE = (const float*)(ws + WS_LGATE); e.tab = (LAS const int*)(lds + MOE_TAB);
        g8::gemm_phase<true>(lds, s, e);
    }
    xcd_barrier(xbar);
    combine_phase(a, lds);
}

extern "C" void kernel_launch(void* const* d_in, const int* in_sizes, int n_in, void* d_out, int out_size, void* d_ws, size_t ws_size, hipStream_t stream) {
    static int grid = 0;
    if (grid == 0) {
        int dev = 0, cus = 0, per_cu = 0;
        if (n_in != 23 || out_size != T * Dm || ws_size < WS_END) { fprintf(stderr, "kernel_launch: unexpected problem (n_in %d, out %d, ws %zu < %zu)\n", n_in, out_size, ws_size, (size_t)WS_END); grid = -1; return; }
        if (hipGetDevice(&dev) != hipSuccess || hipDeviceGetAttribute(&cus, hipDeviceAttributeMultiprocessorCount, dev) != hipSuccess) { grid = -1; return; }
        if (hipFuncSetAttribute((const void*)fwd, hipFuncAttributeMaxDynamicSharedMemorySize, LDS_BYTES) != hipSuccess) { fprintf(stderr, "hipFuncSetAttribute failed\n"); grid = -1; return; }
        if (hipOccupancyMaxActiveBlocksPerMultiprocessor(&per_cu, (const void*)fwd, NT, LDS_BYTES) != hipSuccess || per_cu < 1) { fprintf(stderr, "occupancy query failed (%d)\n", per_cu); grid = -1; return; }
        grid = cus;
        fprintf(stderr, "kernel_launch: cus %d per_cu %d grid %d ws %zu need %zu\n", cus, per_cu, grid, ws_size, (size_t)WS_END);
    }
    if (grid < 0) return;
    Args a{};
    for (int i = 0; i < 23; ++i) a.in[i] = (const float*)d_in[i];
    a.out = (float*)d_out; a.ws = (unsigned char*)d_ws; a.mask = 0xffffffffu; a.pad = 0u;
    if (hipMemsetAsync((char*)d_ws + WS_CTL, 0, 65536, stream) != hipSuccess) { fprintf(stderr, "memset failed\n"); return; }
    void* args[] = {&a};
    hipError_t e = hipLaunchCooperativeKernel((const void*)fwd, dim3(grid), dim3(NT), args, LDS_BYTES, stream);
    if (e != hipSuccess) fprintf(stderr, "cooperative launch failed: %s (grid %d)\n", hipGetErrorString(e), grid);
}
```

```cpp
#include <hip/hip_runtime.h>
#include <hip/hip_cooperative_groups.h>
#include <cstdio>
#include <cstdint>
namespace cg = cooperative_groups;

#define LAS __attribute__((address_space(3)))
#define DI __device__ __forceinline__
typedef unsigned short u16;
typedef short bf16x8 __attribute__((ext_vector_type(8)));
typedef short s16x4 __attribute__((ext_vector_type(4)));
typedef float f32x4 __attribute__((ext_vector_type(4)));
typedef float f32x2 __attribute__((ext_vector_type(2)));
typedef unsigned u32x4 __attribute__((ext_vector_type(4)));
typedef unsigned u32x2 __attribute__((ext_vector_type(2)));
typedef __bf16 bf2_t __attribute__((ext_vector_type(2)));
typedef int v8i_t __attribute__((ext_vector_type(8)));

constexpr int NT = 512;
constexpr int LDS_BYTES = 155648;
constexpr int Dm = 1024, Bsz = 4, S = 8192, T = Bsz * S;
constexpr int NIN = 3584;
constexpr int NE = 32, ECAP = 32768, PPAD = 131072 + NE * 256;
constexpr float EPS = 1e-6f;

constexpr size_t MiB = 1024 * 1024;
constexpr size_t WS_CTL = 0;
constexpr size_t WS_BAR = 16384;
constexpr int LDS_BARST = LDS_BYTES - 16;
constexpr size_t WS_WIN = 64 * 1024;
constexpr size_t WS_WQ = WS_WIN + (size_t)NIN * 1024 * 2;
constexpr size_t WS_WSP = WS_WQ + 1280 * 256 * 2;
constexpr size_t WS_WCAT = WS_WSP + 4 * 128 * 128 * 2;
constexpr size_t WS_WOUT = WS_WCAT + 1024 * 1536 * 2;
constexpr size_t WS_WR = WS_WOUT + 1024 * 1024 * 2;
constexpr size_t WS_WE1 = WS_WR + 32 * 1024 * 4;
constexpr size_t WS_WE2 = WS_WE1 + (size_t)32 * 2048 * 1024 * 2;
constexpr size_t WS_RS1 = WS_WE2 + (size_t)32 * 1024 * 1024 * 2;
constexpr size_t WS_SSQ = WS_RS1 + (size_t)T * 4;
constexpr size_t WS_WI = WS_SSQ + (size_t)T * 32 * 4;
constexpr size_t WS_ROUTE = WS_WI + (size_t)T * 4 * 4;
constexpr size_t WS_LTOK = WS_ROUTE + (size_t)T * 4 * 4;
constexpr size_t WS_LGATE = WS_LTOK + (size_t)NE * ECAP * 4;
constexpr size_t WS_LRS = WS_LGATE + (size_t)NE * ECAP * 4;
constexpr size_t WS_XN2 = WS_LRS + (size_t)NE * ECAP * 4;
constexpr size_t WS_R0 = WS_XN2 + (size_t)T * 1024 * 2;
constexpr size_t WS_XB = WS_R0;
constexpr size_t WS_H = WS_XB + (size_t)T * 1024 * 2;
constexpr size_t WS_Q = WS_H + (size_t)T * NIN * 2;
constexpr size_t WS_QI = WS_Q + (size_t)T * 1024 * 2;
constexpr size_t WS_KVN = WS_QI + (size_t)T * 256 * 2;
constexpr size_t WS_KIN = WS_KVN + (size_t)T * 128 * 2;
constexpr size_t WS_YO = WS_KIN + (size_t)T * 64 * 2;
constexpr size_t WS_TMP = WS_YO + (size_t)T * 1536 * 2;
constexpr size_t WS_MRG = WS_TMP + (size_t)T * 1024 * 2;
constexpr size_t WS_R0END = WS_MRG + (size_t)T * 1024 * 2;
constexpr size_t WS_ACT = WS_XB;
constexpr size_t WS_YB = WS_Q;
static_assert(WS_ACT + (size_t)PPAD * 1024 * 2 <= WS_Q, "ACT overlaps YB");
static_assert(WS_YB + (size_t)PPAD * 1024 * 2 <= WS_R0END, "YB too large");
constexpr size_t WS_END = WS_R0END;

struct Args { const float* in[23]; float* out; unsigned char* ws; unsigned mask; unsigned pad; };
enum { I_X = 0, I_N1G, I_WIN, I_QLG, I_WUQ, I_QNG, I_KVG, I_WUV, I_WQI, I_KIG, I_VG, I_WSP, I_BSP, I_WPA, I_WPB, I_WOUT, I_N2G, I_WR, I_BR, I_WE1, I_BE1, I_WE2, I_BE2 };

DI unsigned pk2(float a, float b) { f32x2 v = {a, b}; bf2_t r = __builtin_convertvector(v, bf2_t); return __builtin_bit_cast(unsigned, r); }
DI unsigned pk4_fp8(float a, float b, float c, float d) { unsigned w = 0u; w = (unsigned)__builtin_amdgcn_cvt_pk_fp8_f32(a, b, (int)w, false); w = (unsigned)__builtin_amdgcn_cvt_pk_fp8_f32(c, d, (int)w, true); return w; }
DI unsigned pk4_i8(float a, float b, float c, float d) {
    const int ia = (int)__builtin_rintf(fminf(fmaxf(a * 32.0f, -127.0f), 127.0f)), ib = (int)__builtin_rintf(fminf(fmaxf(b * 32.0f, -127.0f), 127.0f));
    const int ic = (int)__builtin_rintf(fminf(fmaxf(c * 32.0f, -127.0f), 127.0f)), id = (int)__builtin_rintf(fminf(fmaxf(d * 32.0f, -127.0f), 127.0f));
    return (unsigned)(ia & 0xff) | ((unsigned)(ib & 0xff) << 8) | ((unsigned)(ic & 0xff) << 16) | ((unsigned)(id & 0xff) << 24);
}
DI float bflo(unsigned u) { return __uint_as_float(u << 16); }
DI float bfhi(unsigned u) { return __uint_as_float(u & 0xffff0000u); }
DI u16 f2bf(float f) { return (u16)(pk2(f, 0.f) & 0xffffu); }
DI float bf2f(u16 h) { return __uint_as_float(((unsigned)h) << 16); }
DI float sigmoidf_(float x) { return __builtin_amdgcn_rcpf(1.0f + __expf(-x)); }
DI float gelu_tanh(float x) { const float u = 1.5957691216057308f * (x + 0.044715f * x * x * x); return x * sigmoidf_(u); }
DI int otid() { int t = threadIdx.x; asm volatile("" : "+v"(t)); return t; }
DI void wave_lds_sync() { asm volatile("s_waitcnt lgkmcnt(0)" ::: "memory"); }

namespace g8 {
constexpr int BM = 256, BK = 64, HALF = 128, HTB = HALF * BK * 2, STAGE_BYTES = 8 * HTB, NXCD = 8, WGM = 8;
DI int lds_byte(int r, int c) { const int st = (r >> 4) * 2 + (c >> 5), rr = r & 15, cc = c & 31, ob = rr * 64 + cc * 2; return st * 1024 + (ob ^ (((ob >> 9) & 1) << 5)); }
DI void stage_rc(int b, int& R, int& C) { const int st = b / 1024, sb = b % 1024, swz = sb ^ (((sb >> 9) & 1) << 5); R = (st >> 1) * 16 + swz / 64; C = (st & 1) * 32 + (swz % 64) / 2; }

struct UnitD { const char* Bp; int pm, pn, e, rb; };

DI bool static_tile(int i, int G, int c, int nM, int nN, int& pm, int& pn) {
    const int nwg = nM * nN; const long L = (long)i * G + c; if (L >= nwg) return false;
    int wgid = (int)L; { const int q = nwg / NXCD, r = nwg % NXCD, xcd = wgid % NXCD, off = wgid / NXCD; wgid = (xcd < r ? xcd * (q + 1) : r * (q + 1) + (xcd - r) * q) + off; }
    const int nig = WGM * nN, gid = wgid / nig, fm = gid * WGM, gsz = (nM - fm) < WGM ? (nM - fm) : WGM;
    pm = fm + ((wgid % nig) % gsz); pn = (wgid % nig) / gsz; return true;
}

struct PlainSched {
    const char* Abase; const char* Bbase; int lda, ldb, K, nM, nN, G, c; static constexpr int esz = 2;
    DI bool next(int i, UnitD& u) const { int pm, pn; if (!static_tile(i, G, c, nM, nN, pm, pn)) return false; u.pm = pm; u.pn = pn; u.e = 0; u.rb = 0; u.Bp = Bbase + (size_t)pn * BM * ldb * 2; return true; }
    DI void a_offs(const UnitD& u, int R0, int C0, unsigned (&o)[2][2]) const {
#pragma unroll
        for (int h = 0; h < 2; ++h)
#pragma unroll
            for (int i = 0; i < 2; ++i) o[h][i] = (unsigned)(((size_t)(u.pm * BM + h * HALF + R0 + 64 * i) * lda + C0) * 2);
    }
};

template <bool FP8 = false, class Epi, class Sched>
DI void gemm_phase(LAS unsigned char* lds, const Sched& S, const Epi& E) {
    const int tid = otid(), wid = __builtin_amdgcn_readfirstlane(tid >> 6), lane = tid & 63, wr = wid >> 2, wc = wid & 3, fr = lane & 15, fq = lane >> 4;
    const int nt = S.K * Sched::esz / 128;
    int R0, C0; stage_rc(tid * 16, R0, C0);
    unsigned voffB[2];
#pragma unroll
    for (int i = 0; i < 2; ++i) voffB[i] = (unsigned)((R0 + 64 * i) * S.ldb * Sched::esz + C0 * 2);
    const size_t hstepB = (size_t)HALF * S.ldb * Sched::esz;
    const unsigned ldsw = (unsigned)wid * 1024u;
    const int aoff = FP8 ? lds_byte(wr * 64 + fr, fq * 16) : lds_byte(wr * 64 + fr, fq * 8), boff = FP8 ? lds_byte(wc * 32 + fr, fq * 16) : lds_byte(wc * 32 + fr, fq * 8);
    const unsigned mxscale = 0x7f7f7f7fu;
    const int kst = FP8 ? 16 : 1024;
    const char* Ab = S.Abase;
#define G8_SA(b, h) (((b) * 2 + (h)) * HTB)
#define G8_SB(b, h) ((4 + (b) * 2 + (h)) * HTB)
#define G8_STAGE_A(bufoff, offs, kb) do { _Pragma("unroll") for (int _i = 0; _i < 2; ++_i) \
        __builtin_amdgcn_global_load_lds((const unsigned*)(Ab + (size_t)(offs)[_i] + (size_t)(kb)), (LAS unsigned*)(lds + (bufoff) + ldsw + _i * 8192), 16, 0, 0); } while (0)
#define G8_STAGE_B(bufoff, gbase, kb) do { _Pragma("unroll") for (int _i = 0; _i < 2; ++_i) \
        __builtin_amdgcn_global_load_lds((const unsigned*)((gbase) + voffB[_i] + (size_t)(kb)), (LAS unsigned*)(lds + (bufoff) + ldsw + _i * 8192), 16, 0, 0); } while (0)
#define G8_LDA(dst, b, h) do { _Pragma("unroll") for (int m = 0; m < 4; ++m) { const i32x4_t _p = *(const LAS i32x4_t*)(lds + G8_SA(b, h) + aoff + m * 2048), _q = *(const LAS i32x4_t*)(lds + G8_SA(b, h) + aoff + m * 2048 + kst); dst[m] = __builtin_shufflevector(_p, _q, 0, 1, 2, 3, 4, 5, 6, 7); } } while (0)
#define G8_LDB(dst, b, h) do { _Pragma("unroll") for (int n = 0; n < 2; ++n) { const i32x4_t _p = *(const LAS i32x4_t*)(lds + G8_SB(b, h) + boff + n * 2048), _q = *(const LAS i32x4_t*)(lds + G8_SB(b, h) + boff + n * 2048 + kst); dst[n] = __builtin_shufflevector(_p, _q, 0, 1, 2, 3, 4, 5, 6, 7); } } while (0)
#define G8_MMA(ai, bj, At, Bt) do { __builtin_amdgcn_s_setprio(1); _Pragma("unroll") for (int m = 0; m < 4; ++m) _Pragma("unroll") for (int n = 0; n < 2; ++n) { \
        if constexpr (FP8) asm volatile("v_mfma_scale_f32_16x16x128_f8f6f4 %0, %1, %2, %0, %3, %3 op_sel_hi:[0,0,0]" : "+v"(acc[ai][bj][m][n]) : "v"(Bt[n]), "v"(At[m]), "v"(mxscale)); \
        else { acc[ai][bj][m][n] = __builtin_amdgcn_mfma_f32_16x16x32_bf16(__builtin_bit_cast(bf16x8, __builtin_shufflevector(Bt[n], Bt[n], 0, 1, 2, 3)), __builtin_bit_cast(bf16x8, __builtin_shufflevector(At[m], At[m], 0, 1, 2, 3)), acc[ai][bj][m][n], 0, 0, 0); \
               acc[ai][bj][m][n] = __builtin_amdgcn_mfma_f32_16x16x32_bf16(__builtin_bit_cast(bf16x8, __builtin_shufflevector(Bt[n], Bt[n], 4, 5, 6, 7)), __builtin_bit_cast(bf16x8, __builtin_shufflevector(At[m], At[m], 4, 5, 6, 7)), acc[ai][bj][m][n], 0, 0, 0); } } \
        __builtin_amdgcn_s_setprio(0); } while (0)
#define G8_WAIT_V(n) asm volatile("s_waitcnt vmcnt(" #n ")" ::: "memory")
#define G8_WAIT_L(n) asm volatile("s_waitcnt lgkmcnt(" #n ")" ::: "memory")
#define G8_BAR __builtin_amdgcn_s_barrier()
#define G8_SCHED __builtin_amdgcn_sched_barrier(0)
    UnitD cur, nxt; int ui = 0;
    if (!S.next(0, cur)) return;
    f32x4 acc[2][2][4][2];
#pragma unroll
    for (int a = 0; a < 2; ++a)
#pragma unroll
        for (int b = 0; b < 2; ++b)
#pragma unroll
            for (int m = 0; m < 4; ++m)
#pragma unroll
                for (int n = 0; n < 2; ++n) acc[a][b][m][n] = (f32x4){0.f, 0.f, 0.f, 0.f};
    typedef int i32x4_t __attribute__((ext_vector_type(4)));
    v8i_t At[4], B0[2], B1[2];
    unsigned cA[2][2];
    S.a_offs(cur, R0, C0, cA);
    const char* cB = cur.Bp;
    G8_STAGE_B(G8_SB(0, 0), cB, 0); G8_STAGE_A(G8_SA(0, 0), cA[0], 0); G8_STAGE_B(G8_SB(0, 1), cB + hstepB, 0); G8_STAGE_A(G8_SA(0, 1), cA[1], 0);
    if (wr == 1) G8_BAR;
    G8_WAIT_V(4); G8_BAR;
    G8_STAGE_B(G8_SB(1, 0), cB, 128); G8_STAGE_A(G8_SA(1, 0), cA[0], 128); G8_STAGE_B(G8_SB(1, 1), cB + hstepB, 128);
    G8_WAIT_V(6); G8_BAR;
    for (;;) {
        const bool has_next = S.next(ui + 1, nxt);
        const char* nB = has_next ? nxt.Bp : cB;
        for (int t = 0; t < nt; t += 2) {
            const bool last = (t == nt - 2);
            const unsigned k1 = (unsigned)(t + 1) * 128u;
            const unsigned k2 = last ? 0u : (unsigned)(t + 2) * 128u, k3 = k2 + 128u;
            unsigned c1[2] = {cA[1][0], cA[1][1]};
            if (last && has_next) S.a_offs(nxt, R0, C0, cA);
            const char* b2 = last ? nB : cB;
            G8_LDB(B0, 0, 0); G8_SCHED; G8_LDA(At, 0, 0); G8_STAGE_A(G8_SA(1, 1), c1, k1);
            G8_WAIT_L(8); G8_BAR; G8_WAIT_L(0); G8_MMA(0, 0, At, B0); G8_BAR; G8_SCHED;
            G8_LDB(B1, 0, 1); G8_STAGE_B(G8_SB(0, 0), b2, k2);
            G8_BAR; G8_WAIT_L(0); G8_MMA(0, 1, At, B1); G8_BAR;
            G8_LDA(At, 0, 1); G8_STAGE_A(G8_SA(0, 0), cA[0], k2);
            G8_BAR; G8_WAIT_L(0); G8_MMA(1, 0, At, B0); G8_BAR; G8_SCHED;
            G8_STAGE_B(G8_SB(0, 1), b2 + hstepB, k2);
            G8_WAIT_V(6); G8_BAR; G8_MMA(1, 1, At, B1); G8_BAR;
            G8_LDB(B0, 1, 0); G8_SCHED; G8_LDA(At, 1, 0); G8_STAGE_A(G8_SA(0, 1), cA[1], k2);
            G8_WAIT_L(8); G8_BAR; G8_WAIT_L(0); G8_MMA(0, 0, At, B0); G8_BAR; G8_SCHED;
            G8_LDB(B1, 1, 1); G8_STAGE_B(G8_SB(1, 0), b2, k3);
            G8_BAR; G8_WAIT_L(0); G8_MMA(0, 1, At, B1); G8_BAR;
            G8_LDA(At, 1, 1); G8_STAGE_A(G8_SA(1, 0), cA[0], k3);
            G8_BAR; G8_WAIT_L(0); G8_MMA(1, 0, At, B0); G8_BAR; G8_SCHED;
            G8_STAGE_B(G8_SB(1, 1), b2 + hstepB, k3);
            G8_WAIT_V(6); G8_BAR; G8_MMA(1, 1, At, B1); G8_BAR;
        }
        if constexpr (FP8) asm volatile("s_nop 15\n\ts_nop 15" ::: "memory");
        E(acc, cur, wr, wc, fr, fq);
        if (!has_next) break;
#pragma unroll
        for (int a = 0; a < 2; ++a)
#pragma unroll
            for (int b = 0; b < 2; ++b)
#pragma unroll
                for (int m = 0; m < 4; ++m)
#pragma unroll
                    for (int n = 0; n < 2; ++n) acc[a][b][m][n] = (f32x4){0.f, 0.f, 0.f, 0.f};
        cur = nxt; cB = nB; ++ui;
    }
    G8_WAIT_V(0);
    if (wr == 0) G8_BAR;
    G8_BAR;
#undef G8_SA
#undef G8_SB
#undef G8_STAGE_A
#undef G8_STAGE_B
#undef G8_LDA
#undef G8_LDB
#undef G8_MMA
#undef G8_WAIT_V
#undef G8_WAIT_L
#undef G8_BAR
#undef G8_SCHED
}
}
using g8::UnitD;
typedef f32x4 Acc[2][2][4][2];

struct EpiIn {
    u16* H; const float* rs1; float* SSQ; float* WI;
    DI void operator()(const Acc& acc, const UnitD& u, int wr, int wc, int fr, int fq) const {
        const int pn = u.pn;
#pragma unroll
        for (int ai = 0; ai < 2; ++ai)
#pragma unroll
            for (int m = 0; m < 4; ++m) {
                const int row = u.pm * 256 + ai * 128 + wr * 64 + m * 16 + fr;
                const float rs = rs1[row];
#pragma unroll
                for (int bj = 0; bj < 2; ++bj) {
                    float ssq = 0.f;
#pragma unroll
                    for (int n = 0; n < 2; ++n) {
                        const int col = pn * 256 + bj * 128 + wc * 32 + n * 16 + 4 * fq;
                        f32x4 v = acc[ai][bj][m][n] * rs;
                        if (pn < 4) { v[0] = gelu_tanh(v[0]); v[1] = gelu_tanh(v[1]); v[2] = gelu_tanh(v[2]); v[3] = gelu_tanh(v[3]); }
                        else if (pn >= 6) { v[0] = sigmoidf_(v[0]); v[1] = sigmoidf_(v[1]); v[2] = sigmoidf_(v[2]); v[3] = sigmoidf_(v[3]); }
                        ssq += (v[0] * v[0] + v[1] * v[1]) + (v[2] * v[2] + v[3] * v[3]);
                        u32x2 w; w.x = pk2(v[0], v[1]); w.y = pk2(v[2], v[3]);
                        *(u32x2*)(H + (size_t)row * NIN + col) = w;
                        if (pn == 5 && bj == 1 && wc == 2 && n == 0 && fq == 0) *(f32x4*)(WI + (size_t)row * 4) = v * 0.5f;
                    }
                    if (pn >= 2 && pn <= 5) {
                        ssq += __shfl_xor(ssq, 16); ssq += __shfl_xor(ssq, 32);
                        if (fq == 0) SSQ[(size_t)row * 32 + (pn - 2) * 8 + bj * 4 + wc] = ssq;
                    }
                }
            }
    }
};
struct EpiQ {
    u16* Q; u16* QI; const float* SSQ;
    DI void operator()(const Acc& acc, const UnitD& u, int wr, int wc, int fr, int fq) const {
#pragma unroll
        for (int ai = 0; ai < 2; ++ai)
#pragma unroll
            for (int m = 0; m < 4; ++m) {
                const int row = u.pm * 256 + ai * 128 + wr * 64 + m * 16 + fr;
                const f32x4 s0 = *(const f32x4*)(SSQ + (size_t)row * 32 + 16), s1 = *(const f32x4*)(SSQ + (size_t)row * 32 + 20);
                const float ss = ((s0[0] + s0[1]) + (s0[2] + s0[3])) + ((s1[0] + s1[1]) + (s1[2] + s1[3]));
                const float rs = __builtin_amdgcn_rsqf(ss * (1.0f / 256.0f) + EPS);
#pragma unroll
                for (int bj = 0; bj < 2; ++bj)
#pragma unroll
                    for (int n = 0; n < 2; ++n) {
                        const int col = u.pn * 256 + bj * 128 + wc * 32 + n * 16 + 4 * fq;
                        const f32x4 v = acc[ai][bj][m][n] * rs;
                        u32x2 w; w.x = pk2(v[0], v[1]); w.y = pk2(v[2], v[3]);
                        if (col < 1024) *(u32x2*)(Q + (size_t)row * 1024 + col) = w; else *(unsigned*)((unsigned char*)QI + (size_t)row * 256 + (col - 1024)) = pk4_i8(v[0], v[1], v[2], v[3]);
                    }
            }
    }
};
template <int SECOND> struct EpiMrg {
    u16* OUT; const u16* TMP; const u16* H;
    DI void operator()(const Acc& acc, const UnitD& u, int wr, int wc, int fr, int fq) const {
#pragma unroll
        for (int ai = 0; ai < 2; ++ai)
#pragma unroll
            for (int m = 0; m < 4; ++m) {
                const int row = u.pm * 256 + ai * 128 + wr * 64 + m * 16 + fr;
#pragma unroll
                for (int bj = 0; bj < 2; ++bj)
#pragma unroll
                    for (int n = 0; n < 2; ++n) {
                        const int col = u.pn * 256 + bj * 128 + wc * 32 + n * 16 + 4 * fq;
                        const u32x2 g = *(const u32x2*)(H + (size_t)row * NIN + 1536 + SECOND * 1024 + col);
                        f32x4 v = acc[ai][bj][m][n];
                        v[0] *= bflo(g.x); v[1] *= bfhi(g.x); v[2] *= bflo(g.y); v[3] *= bfhi(g.y);
                        if (SECOND) { const u32x2 t = *(const u32x2*)(TMP + (size_t)row * 1024 + col); v[0] += bflo(t.x); v[1] += bfhi(t.x); v[2] += bflo(t.y); v[3] += bfhi(t.y); }
                        u32x2 w; w.x = pk2(v[0], v[1]); w.y = pk2(v[2], v[3]);
                        *(u32x2*)(OUT + (size_t)row * 1024 + col) = w;
                    }
            }
    }
};
struct EpiOut {
    float* out; const float* x; unsigned char* XN;
    DI void operator()(const Acc& acc, const UnitD& u, int wr, int wc, int fr, int fq) const {
#pragma unroll
        for (int ai = 0; ai < 2; ++ai)
#pragma unroll
            for (int m = 0; m < 4; ++m) {
                const int row = u.pm * 256 + ai * 128 + wr * 64 + m * 16 + fr;
#pragma unroll
                for (int bj = 0; bj < 2; ++bj)
#pragma unroll
                    for (int n = 0; n < 2; ++n) {
                        const size_t o = (size_t)row * 1024 + u.pn * 256 + bj * 128 + wc * 32 + n * 16 + 4 * fq;
                        const f32x4 v = *(const f32x4*)(x + o) + acc[ai][bj][m][n];
                        *(f32x4*)(out + o) = v;
                        *(unsigned*)(XN + o) = pk4_fp8(v[0], v[1], v[2], v[3]);
                    }
            }
    }
};

constexpr int MOE_TAB = g8::STAGE_BYTES;
DI void moe_table(LAS unsigned char* lds, const unsigned* CNT) {
    LAS int* tab = (LAS int*)(lds + MOE_TAB);
    __syncthreads();
    if (threadIdx.x == 0) { int acc = 0; for (int e = 0; e < NE; ++e) { const int c = (int)__hip_atomic_load(CNT + e, __ATOMIC_RELAXED, __HIP_MEMORY_SCOPE_AGENT); tab[e] = acc; tab[33 + e] = c; acc += (c + 255) >> 8; } tab[32] = acc; }
    __syncthreads();
}
template <int NPN, bool GATHER> struct MoeSched {
    const char* Abase; const char* Wbase; const int* LTOK; LAS const int* tab; int lda, ldb, K, G, c; size_t wstride; static constexpr int esz = 1;
    DI bool next(int i, UnitD& u) const {
        const long L = (long)i * G + c; const int R = tab[32];
        if (L >= (long)R * NPN) return false;
        const int rbg = (int)(L / NPN), pn = (int)(L % NPN);
        int e = 0;
        for (int j = 1; j < NE; ++j) e += (tab[j] <= rbg) ? 1 : 0;
        e = __builtin_amdgcn_readfirstlane(e);
        u.pm = rbg; u.pn = pn; u.e = e; u.rb = rbg - tab[e];
        u.Bp = Wbase + (size_t)e * wstride + (size_t)pn * 256 * ldb * esz;
        return true;
    }
    DI void a_offs(const UnitD& u, int R0, int C0, unsigned (&o)[2][2]) const {
        const int cnt = tab[33 + u.e];
#pragma unroll
        for (int h = 0; h < 2; ++h)
#pragma unroll
            for (int i = 0; i < 2; ++i) {
                const int r = h * 128 + R0 + 64 * i;
                if (GATHER) { const int slot = u.rb * 256 + r; const int tok = slot < cnt ? LTOK[(size_t)u.e * ECAP + slot] : 0; o[h][i] = (unsigned)((size_t)tok * lda * esz + C0 * 2); }
                else o[h][i] = (unsigned)((size_t)(u.pm * 256 + r) * lda * esz + C0 * 2);
            }
    }
};
struct EpiMoe1 {
    unsigned char* ACT; const float* b1; const float* LRS; LAS const int* tab;
    DI void operator()(const Acc& acc, const UnitD& u, int wr, int wc, int fr, int fq) const {
        const float* be = b1 + (size_t)u.e * 2048; const int cnt = tab[33 + u.e];
        float rsv[2][4];
#pragma unroll
        for (int ai = 0; ai < 2; ++ai)
#pragma unroll
            for (int m = 0; m < 4; ++m) { const int slot = u.rb * 256 + ai * 128 + wr * 64 + m * 16 + fr; rsv[ai][m] = slot < cnt ? LRS[(size_t)u.e * ECAP + slot] : 0.f; }
#pragma unroll
        for (int n = 0; n < 2; ++n) {
            const int hc = u.pn * 128 + wc * 32 + n * 16 + 4 * fq;
            const f32x4 bg = *(const f32x4*)(be + hc), bu = *(const f32x4*)(be + 1024 + hc);
#pragma unroll
            for (int ai = 0; ai < 2; ++ai)
#pragma unroll
                for (int m = 0; m < 4; ++m) {
                    const int row = u.pm * 256 + ai * 128 + wr * 64 + m * 16 + fr;
                    const f32x4 g = acc[ai][0][m][n] * (rsv[ai][m] * 0.015625f) + bg, up = acc[ai][1][m][n] * (rsv[ai][m] * 0.015625f) + bu;
                    float a[4];
#pragma unroll
                    for (int j = 0; j < 4; ++j) { const float hg = fminf(g[j], 7.0f), hu = fminf(fmaxf(up[j], -7.0f), 7.0f); a[j] = (hu + 1.0f) * (hg * sigmoidf_(1.702f * hg)); }
                    *(unsigned*)(ACT + (size_t)row * 1024 + hc) = pk4_fp8(a[0], a[1], a[2], a[3]);
                }
        }
    }
};
struct EpiMoe2 {
    u16* YB; const float* b2; const float* LGATE; LAS const int* tab;
    DI void operator()(const Acc& acc, const UnitD& u, int wr, int wc, int fr, int fq) const {
        const float* be = b2 + (size_t)u.e * 1024; const int cnt = tab[33 + u.e];
#pragma unroll
        for (int ai = 0; ai < 2; ++ai)
#pragma unroll
            for (int m = 0; m < 4; ++m) {
                const int r = ai * 128 + wr * 64 + m * 16 + fr, slot = u.rb * 256 + r;
                const float gate = slot < cnt ? LGATE[(size_t)u.e * ECAP + slot] : 0.f;
#pragma unroll
                for (int bj = 0; bj < 2; ++bj)
#pragma unroll
                    for (int n = 0; n < 2; ++n) {
                        const int col = u.pn * 256 + bj * 128 + wc * 32 + n * 16 + 4 * fq;
                        const f32x4 v = (acc[ai][bj][m][n] * 0.015625f + *(const f32x4*)(be + col)) * gate;
                        u32x2 w; w.x = pk2(v[0], v[1]); w.y = pk2(v[2], v[3]);
                        *(u32x2*)(YB + (size_t)(u.pm * 256 + r) * 1024 + col) = w;
                    }
            }
    }
};

template <bool FP8 = false, class F> DI void tr_tile(LAS unsigned char* lds, const float* src, int ld_src, int Nsz, int k0, int n0, const float* sk, float mul, u16* dst, int ld_dst, F rowmap) {
    LAS float* t = (LAS float*)lds;
    const int tid = otid();
    __syncthreads();
#pragma unroll
    for (int it = 0; it < 2; ++it) {
        const int k = (tid >> 4) + 32 * it, n = 4 * (tid & 15);
        f32x4 v = {0.f, 0.f, 0.f, 0.f};
        if (n0 + n < Nsz) v = *(const f32x4*)(src + (size_t)(k0 + k) * ld_src + n0 + n);
        const float s = (sk ? sk[k0 + k] : 1.0f) * mul;
        t[k * 65 + n] = v[0] * s; t[k * 65 + n + 1] = v[1] * s; t[k * 65 + n + 2] = v[2] * s; t[k * 65 + n + 3] = v[3] * s;
    }
    __syncthreads();
    const int n = tid >> 3, kc = (tid & 7) * 8;
    if (FP8) {
        if (n0 + n < Nsz) {
            u32x2 w;
            w.x = pk4_fp8(t[(kc + 0) * 65 + n], t[(kc + 1) * 65 + n], t[(kc + 2) * 65 + n], t[(kc + 3) * 65 + n]);
            w.y = pk4_fp8(t[(kc + 4) * 65 + n], t[(kc + 5) * 65 + n], t[(kc + 6) * 65 + n], t[(kc + 7) * 65 + n]);
            *(u32x2*)((unsigned char*)dst + (size_t)rowmap(n0 + n) * ld_dst + k0 + kc) = w;
        }
    } else if (n0 + n < Nsz) {
        u32x4 w;
        w.x = pk2(t[(kc + 0) * 65 + n], t[(kc + 1) * 65 + n]); w.y = pk2(t[(kc + 2) * 65 + n], t[(kc + 3) * 65 + n]);
        w.z = pk2(t[(kc + 4) * 65 + n], t[(kc + 5) * 65 + n]); w.w = pk2(t[(kc + 6) * 65 + n], t[(kc + 7) * 65 + n]);
        *(u32x4*)(dst + (size_t)rowmap(n0 + n) * ld_dst + k0 + kc) = w;
    }
}
struct MapId { DI int operator()(int n) const { return n; } };
struct MapIn { DI int operator()(int n) const { return n < 1476 ? n : n + 60; } };
struct MapE1 { DI int operator()(int n) const { const int hi = n >= 1024 ? 1 : 0, q = n - hi * 1024; return (q >> 7) * 256 + hi * 128 + (q & 127); } };

DI void phase0(const Args& a, LAS unsigned char* lds) {
    unsigned char* ws = a.ws;
    const int tid = otid();
    const size_t gtid = (size_t)blockIdx.x * NT + tid, gstride = (size_t)gridDim.x * NT;
    for (size_t i = gtid; i < 60 * 1024 / 2; i += gstride) ((unsigned*)(ws + WS_WIN + (size_t)1476 * 1024 * 2))[i] = 0u;
    for (size_t i = gtid; i < 32 * 1024; i += gstride) { const int e = (int)(i >> 10), k = (int)(i & 1023); const float w = a.in[I_WR][k * 32 + e] * a.in[I_N2G][k]; const u16 h = f2bf(w); ((u16*)(ws + WS_WR))[i] = h; ((u16*)(ws + WS_WR))[32 * 1024 + i] = f2bf(w - bf2f(h)); }
    for (size_t i = gtid; i < 4 * 128 * 128; i += gstride) { const int tt = (int)((i >> 7) & 127), ss = (int)(i & 127); ((u16*)(ws + WS_WSP))[i] = f2bf(ss <= tt ? a.in[I_WSP][i] : 0.f); }
    {
        const int wid = tid >> 6, lane = tid & 63;
        for (int row = blockIdx.x * 8 + wid; row < T; row += gridDim.x * 8) {
            const float* xr = a.in[I_X] + (size_t)row * 1024; u16* xb = (u16*)(ws + WS_XB) + (size_t)row * 1024;
            float ss = 0.f;
#pragma unroll
            for (int i = 0; i < 4; ++i) {
                const f32x4 v = *(const f32x4*)(xr + i * 256 + lane * 4);
                ss += (v[0] * v[0] + v[1] * v[1]) + (v[2] * v[2] + v[3] * v[3]);
                u32x2 w; w.x = pk2(v[0], v[1]); w.y = pk2(v[2], v[3]);
                *(u32x2*)(xb + i * 256 + lane * 4) = w;
            }
#pragma unroll
            for (int o = 32; o >= 1; o >>= 1) ss += __shfl_xor(ss, o);
            if (lane == 0) ((float*)(ws + WS_RS1))[row] = __builtin_amdgcn_rsqf(ss * (1.0f / 1024.0f) + EPS);
        }
    }
    constexpr int U_IN = 16 * 56, U_UQ = 4 * 16, U_QI = 4 * 4, U_PA = 8 * 16, U_OUT = 16 * 16, U_E1 = 32 * 16 * 32, U_E2 = 32 * 16 * 16, U_CB = 64;
    constexpr int U_TOT = U_IN + U_UQ + U_QI + U_PA + U_OUT + U_E1 + U_E2 + U_CB;
    for (int u = blockIdx.x; u < U_TOT; u += gridDim.x) {
        int v = u;
        if (v < U_IN) { tr_tile(lds, a.in[I_WIN], 3524, 3524, (v & 15) * 64, (v >> 4) * 64, a.in[I_N1G], 1.0f, (u16*)(ws + WS_WIN), 1024, MapIn()); continue; }
        v -= U_IN;
        if (v < U_UQ) { tr_tile(lds, a.in[I_WUQ], 1024, 1024, (v & 3) * 64, (v >> 2) * 64, a.in[I_QLG], 1.0f, (u16*)(ws + WS_WQ), 256, MapId()); continue; }
        v -= U_UQ;
        if (v < U_QI) { tr_tile(lds, a.in[I_WQI], 256, 256, (v & 3) * 64, (v >> 2) * 64, a.in[I_QLG], 1.0f, (u16*)(ws + WS_WQ) + 1024 * 256, 256, MapId()); continue; }
        v -= U_QI;
        if (v < U_PA) { tr_tile(lds, a.in[I_WPA], 1024, 1024, (v & 7) * 64, (v >> 3) * 64, nullptr, 1.0f, (u16*)(ws + WS_WCAT), 1536, MapId()); continue; }
        v -= U_PA;
        if (v < U_OUT) { tr_tile(lds, a.in[I_WOUT], 1024, 1024, (v & 15) * 64, (v >> 4) * 64, nullptr, 1.0f, (u16*)(ws + WS_WOUT), 1024, MapId()); continue; }
        v -= U_OUT;
        if (v < U_E1) { const int e = v >> 9, w = v & 511; tr_tile<true>(lds, a.in[I_WE1] + (size_t)e * 1024 * 2048, 2048, 2048, (w & 15) * 64, (w >> 4) * 64, a.in[I_N2G], 64.0f, (u16*)(ws + WS_WE1 + (size_t)e * 2048 * 1024), 1024, MapE1()); continue; }
        v -= U_E1;
        if (v < U_E2) { const int e = v >> 8, w = v & 255; tr_tile<true>(lds, a.in[I_WE2] + (size_t)e * 1024 * 1024, 1024, 1024, (w & 15) * 64, (w >> 4) * 64, nullptr, 64.0f, (u16*)(ws + WS_WE2 + (size_t)e * 1024 * 1024), 1024, MapId()); continue; }
        v -= U_E2;
        {
            const int h = v >> 3, c0 = (v & 7) * 16;
            LAS float* t = (LAS float*)lds;
            __syncthreads();
            for (int i = tid; i < 1024; i += NT) t[i] = a.in[I_WUV][(size_t)h * 128 * 64 + (size_t)c0 * 64 + i];
            __syncthreads();
            for (int nn = tid; nn < 1024; nn += NT) {
                float accv[16];
#pragma unroll
                for (int i = 0; i < 16; ++i) accv[i] = 0.f;
                for (int vv = 0; vv < 64; ++vv) {
                    const float pb = a.in[I_WPB][(size_t)(h * 64 + vv) * 1024 + nn];
#pragma unroll
                    for (int i = 0; i < 16; ++i) accv[i] += t[i * 64 + vv] * pb;
                }
                u32x4 w0, w1;
                w0.x = pk2(accv[0], accv[1]); w0.y = pk2(accv[2], accv[3]); w0.z = pk2(accv[4], accv[5]); w0.w = pk2(accv[6], accv[7]);
                w1.x = pk2(accv[8], accv[9]); w1.y = pk2(accv[10], accv[11]); w1.z = pk2(accv[12], accv[13]); w1.w = pk2(accv[14], accv[15]);
                u16* d = (u16*)(ws + WS_WCAT) + (size_t)nn * 1536 + 512 + h * 128 + c0;
                *(u32x4*)d = w0; *(u32x4*)(d + 8) = w1;
            }
        }
    }
}

DI void gmlp_unit(const Args& a, LAS unsigned char* lds, int u) {
    unsigned char* ws = a.ws;
    const int tid = otid(), wid = tid >> 6, lane = tid & 63, fr = lane & 15, fq = lane >> 4;
    const int g = u & 3, row0 = (u >> 2) * 128;
    const u16* H = (const u16*)(ws + WS_H);
    LAS u16* img = (LAS u16*)lds;
    __syncthreads();
    {
        const int s = tid & 127, cset = tid >> 7;
        const f32x4 sq = *(const f32x4*)((const float*)(ws + WS_SSQ) + (size_t)(row0 + s) * 32 + g * 4);
        const float rs = __builtin_amdgcn_rsqf(((sq[0] + sq[1]) + (sq[2] + sq[3])) * (1.0f / 128.0f) + EPS);
#pragma unroll
        for (int it = 0; it < 4; ++it) {
            const int c = cset + 4 * it;
            const u32x4 raw = *(const u32x4*)(H + (size_t)(row0 + s) * NIN + 512 + g * 128 + 8 * c);
            const float* vg = a.in[I_VG] + 8 * c;
            float f[8] = {bflo(raw.x), bfhi(raw.x), bflo(raw.y), bfhi(raw.y), bflo(raw.z), bfhi(raw.z), bflo(raw.w), bfhi(raw.w)};
#pragma unroll
            for (int i = 0; i < 8; ++i) img[(8 * c + i) * 136 + s] = f2bf(f[i] * rs * vg[i]);
        }
    }
    __syncthreads();
    const u16* W = (const u16*)(ws + WS_WSP) + (size_t)g * 128 * 128 + (size_t)(16 * wid + fr) * 128;
    f32x4 acc[8];
#pragma unroll
    for (int i = 0; i < 8; ++i) acc[i] = (f32x4){0.f, 0.f, 0.f, 0.f};
    const int nks = (16 * wid + 15) / 32 + 1;
    for (int ks = 0; ks < nks; ++ks) {
        const bf16x8 bw = *(const bf16x8*)(W + ks * 32 + 8 * fq);
#pragma unroll
        for (int i = 0; i < 8; ++i) {
            const bf16x8 av = *(const LAS bf16x8*)(img + (16 * i + fr) * 136 + ks * 32 + 8 * fq);
            acc[i] = __builtin_amdgcn_mfma_f32_16x16x32_bf16(av, bw, acc[i], 0, 0, 0);
        }
    }
    const int t = 16 * wid + fr;
    const float bias = a.in[I_BSP][g * 128 + t];
    u16* YO = (u16*)(ws + WS_YO);
#pragma unroll
    for (int i = 0; i < 8; ++i) {
        const int d = 16 * i + 4 * fq;
        const u32x2 uu = *(const u32x2*)(H + (size_t)(row0 + t) * NIN + g * 128 + d);
        const float y0 = bflo(uu.x) * (acc[i][0] + bias), y1 = bfhi(uu.x) * (acc[i][1] + bias), y2 = bflo(uu.y) * (acc[i][2] + bias), y3 = bfhi(uu.y) * (acc[i][3] + bias);
        u32x2 w; w.x = pk2(y0, y1); w.y = pk2(y2, y3);
        *(u32x2*)(YO + (size_t)(row0 + t) * 1536 + g * 128 + d) = w;
    }
}

DI void kvnorm(const Args& a) {
    unsigned char* ws = a.ws;
    const u16* H = (const u16*)(ws + WS_H); const float* SSQ = (const float*)(ws + WS_SSQ);
    const size_t gtid = (size_t)blockIdx.x * NT + otid(), gstride = (size_t)gridDim.x * NT;
    for (size_t idx = gtid; idx < (size_t)T * 24; idx += gstride) {
        const int row = (int)(idx / 24), c = (int)(idx % 24);
        const u16* src; u16* dst; const float* gain; float rs;
        if (c < 16) {
            const f32x4 sq = *(const f32x4*)(SSQ + (size_t)row * 32 + 24);
            rs = __builtin_amdgcn_rsqf(((sq[0] + sq[1]) + (sq[2] + sq[3])) * (1.0f / 128.0f) + EPS);
            src = H + (size_t)row * NIN + 1280 + 8 * c; dst = (u16*)(ws + WS_KVN) + (size_t)row * 128 + 8 * c; gain = a.in[I_KVG] + 8 * c;
        } else {
            const int cc = c - 16;
            rs = __builtin_amdgcn_rsqf((SSQ[(size_t)row * 32 + 28] + SSQ[(size_t)row * 32 + 29]) * (1.0f / 64.0f) + EPS);
            src = H + (size_t)row * NIN + 1408 + 8 * cc; dst = nullptr; gain = a.in[I_KIG] + 8 * cc;
            const u32x4 raw = *(const u32x4*)src;
            u32x2 w8;
            w8.x = pk4_i8(bflo(raw.x) * rs * gain[0], bfhi(raw.x) * rs * gain[1], bflo(raw.y) * rs * gain[2], bfhi(raw.y) * rs * gain[3]);
            w8.y = pk4_i8(bflo(raw.z) * rs * gain[4], bfhi(raw.z) * rs * gain[5], bflo(raw.w) * rs * gain[6], bfhi(raw.w) * rs * gain[7]);
            *(u32x2*)(ws + WS_KIN + (size_t)row * 64 + 8 * cc) = w8;
            continue;
        }
        const u32x4 raw = *(const u32x4*)src;
        u32x4 w;
        w.x = pk2(bflo(raw.x) * rs * gain[0], bfhi(raw.x) * rs * gain[1]); w.y = pk2(bflo(raw.y) * rs * gain[2], bfhi(raw.y) * rs * gain[3]);
        w.z = pk2(bflo(raw.z) * rs * gain[4], bfhi(raw.z) * rs * gain[5]); w.w = pk2(bflo(raw.w) * rs * gain[6], bfhi(raw.w) * rs * gain[7]);
        *(u32x4*)dst = w;
    }
}

constexpr int P3_ROWS = 0, P3_HIST = 131072, P3_LIST = 147456;
DI unsigned f2key(float f) { const unsigned u = __float_as_uint(f); return (u & 0x80000000u) ? ~u : (u | 0x80000000u); }
DI int wave_incl_scan(int v, int lane) {
#pragma unroll
    for (int o = 1; o < 64; o <<= 1) { const int t = __shfl_up(v, o); if (lane >= o) v += t; }
    return v;
}
DI int wave_suffix_scan(int v, int lane) {
#pragma unroll
    for (int o = 1; o < 64; o <<= 1) { const int t = __shfl_down(v, o); if (lane + o < 64) v += t; }
    return v;
}
DI unsigned pk_gt(unsigned kw, unsigned xw, unsigned one) {
    unsigned d, m;
    asm("v_pk_sub_u16 %0, %1, %2 clamp" : "=v"(d) : "v"(kw), "v"(xw));
    asm("v_pk_min_u16 %0, %1, %2" : "=v"(m) : "v"(d), "v"(one));
    return m;
}
DI unsigned pk_subs(unsigned kw, unsigned xw) { unsigned d; asm("v_pk_sub_u16 %0, %1, %2 clamp" : "=v"(d) : "v"(kw), "v"(xw)); return d; }
DI unsigned pk_min1(unsigned d, unsigned one) { unsigned m; asm("v_pk_min_u16 %0, %1, %2" : "=v"(m) : "v"(d), "v"(one)); return m; }
DI unsigned pk_add(unsigned a, unsigned b) { unsigned r; asm("v_pk_add_u16 %0, %1, %2" : "=v"(r) : "v"(a), "v"(b)); return r; }
DI int wave_sum(int v) {
    v += __builtin_amdgcn_update_dpp(0, v, 0xB1, 0xf, 0xf, false);
    v += __builtin_amdgcn_update_dpp(0, v, 0x4E, 0xf, 0xf, false);
    v += __builtin_amdgcn_update_dpp(0, v, 0x141, 0xf, 0xf, false);
    v += __builtin_amdgcn_update_dpp(0, v, 0x140, 0xf, 0xf, false);
    return __builtin_amdgcn_readlane(v, 0) + __builtin_amdgcn_readlane(v, 16) + __builtin_amdgcn_readlane(v, 32) + __builtin_amdgcn_readlane(v, 48);
}
DI int rowaddr(int p) { return (p & ~511) | ((p & 63) << 3) | ((p >> 6) & 7); }
typedef unsigned short us2_t __attribute__((ext_vector_type(2)));
DI unsigned dot2acc(unsigned flags, unsigned wts, unsigned acc) { return __builtin_amdgcn_udot2(__builtin_bit_cast(us2_t, flags), __builtin_bit_cast(us2_t, wts), acc, false); }
DI void select_top16(LAS u16* row, LAS u16* list, int N, int lane) {
    const int Nup = (N + 511) & ~511, niter = Nup >> 9;
    for (int p = N + lane; p < Nup; p += 64) row[rowaddr(p)] = (u16)0;
    wave_lds_sync();
    u32x4 kr[16];
#pragma unroll
    for (int i = 0; i < 16; ++i) { kr[i] = (u32x4){0u, 0u, 0u, 0u}; if (i < niter) kr[i] = *(LAS const u32x4*)(row + i * 512 + lane * 8); }
    const unsigned one = 0x00010001u;
    auto count_gt = [&](unsigned x) -> int {
        const unsigned xw = x | (x << 16);
        unsigned acc = 0u, acc1 = 0u, acc2 = 0u, acc3 = 0u;
#pragma unroll
        for (int c = 0; c < 4; ++c) {
            if (4 * c < niter) {
                unsigned d[16];
#pragma unroll
                for (int i = 0; i < 4; ++i) { d[4 * i] = pk_subs(kr[4 * c + i].x, xw); d[4 * i + 1] = pk_subs(kr[4 * c + i].y, xw); d[4 * i + 2] = pk_subs(kr[4 * c + i].z, xw); d[4 * i + 3] = pk_subs(kr[4 * c + i].w, xw); }
#pragma unroll
                for (int i = 0; i < 16; ++i) d[i] = pk_min1(d[i], one);
#pragma unroll
                for (int i = 0; i < 16; i += 4) { acc = dot2acc(d[i], one, acc); acc1 = dot2acc(d[i + 1], one, acc1); acc2 = dot2acc(d[i + 2], one, acc2); acc3 = dot2acc(d[i + 3], one, acc3); }
            }
        }
        return wave_sum((int)((acc + acc1) + (acc2 + acc3)));
    };
    unsigned T = 0u; int cge = Nup;
#pragma unroll 1
    for (int bit = 15; bit >= 0; --bit) {
        const unsigned cand = T | (1u << bit);
        const int cnt = count_gt(cand - 1u);
        if (cnt >= 256) { T = cand; cge = cnt; }
    }
    auto build = [&](unsigned x, unsigned (&M)[4]) {
        const unsigned xw = x | (x << 16);
#pragma unroll
        for (int c = 0; c < 4; ++c) {
            M[c] = 0u;
            if (4 * c < niter) {
#pragma unroll
                for (int i = 4 * c; i < 4 * c + 4; ++i) {
                    unsigned byte = dot2acc(pk_gt(kr[i].x, xw, one), 0x00020001u, 0u);
                    byte = dot2acc(pk_gt(kr[i].y, xw, one), 0x00080004u, byte);
                    byte = dot2acc(pk_gt(kr[i].z, xw, one), 0x00200010u, byte);
                    byte = dot2acc(pk_gt(kr[i].w, xw, one), 0x00800040u, byte);
                    M[c] |= byte << (8 * (i & 3));
                }
            }
        }
    };
    unsigned M[4];
    build(T - 1u, M);
    if (cge != 256) {
        unsigned G[4]; build(T, G);
        unsigned E[4];
#pragma unroll
        for (int c = 0; c < 4; ++c) E[c] = M[c] & ~G[c];
        const int need = 256 - (cge - wave_sum((int)(__builtin_popcount(E[0]) + __builtin_popcount(E[1]) + __builtin_popcount(E[2]) + __builtin_popcount(E[3]))));
        auto below = [&](int B, int c) -> unsigned { const int nb = B - 32 * c; return nb <= 0 ? 0u : (nb >= 32 ? 0xffffffffu : ((1u << nb) - 1u)); };
        auto ties_below = [&](int B) -> int {
            return wave_sum((int)(__builtin_popcount(E[0] & below(B, 0)) + __builtin_popcount(E[1] & below(B, 1)) + __builtin_popcount(E[2] & below(B, 2)) + __builtin_popcount(E[3] & below(B, 3))));
        };
        int lo = 0, hi = 127;
#pragma unroll 1
        while (lo < hi) { const int mid = (lo + hi) >> 1; if (ties_below(mid + 1) >= need) hi = mid; else lo = mid + 1; }
        const int Bs = lo, r = need - ties_below(Bs);
        const unsigned ew = Bs < 32 ? E[0] : (Bs < 64 ? E[1] : (Bs < 96 ? E[2] : E[3]));
        const bool tb = ((ew >> (Bs & 31)) & 1u) != 0u;
        const unsigned long long em = __ballot(tb);
        const bool take_row = tb && __builtin_popcountll(em & ((1ull << lane) - 1ull)) < r;
#pragma unroll
        for (int c = 0; c < 4; ++c) {
            unsigned tk = E[c] & below(Bs, c);
            if ((Bs >> 5) == c && take_row) tk |= 1u << (Bs & 31);
            M[c] = G[c] | tk;
        }
    }
    const int kl = __builtin_popcount(M[0]) + __builtin_popcount(M[1]) + __builtin_popcount(M[2]) + __builtin_popcount(M[3]);
    int wp = wave_incl_scan(kl, lane) - kl;
#pragma unroll
    for (int c = 0; c < 4; ++c) {
        unsigned m = M[c];
        while (m) { const int b = __builtin_ctz(m); list[wp] = (u16)((32 * c + b) * 64 + lane); ++wp; m &= m - 1u; }
    }
}

DI void dsa_phase(const Args& a, LAS unsigned char* lds) {
    unsigned char* ws = a.ws;
    const int tid = otid(), wid = __builtin_amdgcn_readfirstlane(tid >> 6), lane = tid & 63, fr = lane & 15, fq = lane >> 4;
    const unsigned char* QI = (const unsigned char*)(ws + WS_QI); const unsigned char* KIN = (const unsigned char*)(ws + WS_KIN); const u16* KVN = (const u16*)(ws + WS_KVN);
    const u16* Q = (const u16*)(ws + WS_Q); const float* WI = (const float*)(ws + WS_WI); u16* YO = (u16*)(ws + WS_YO);
    LAS u16* rows = (LAS u16*)(lds + P3_ROWS);
    for (int gi = blockIdx.x; gi < T / 8; gi += gridDim.x) {
        const int b = gi & 3, t0 = S - 8 - 8 * (gi >> 2);
        const size_t brow = (size_t)b * S;
        const int ntile = (t0 + 8 + 15) >> 4;
        __syncthreads();
        {
            typedef int i32x4_t __attribute__((ext_vector_type(4)));
            i32x4_t qa[2]; f32x4 wi[2];
#pragma unroll
            for (int rg = 0; rg < 2; ++rg) {
                qa[rg] = *(const i32x4_t*)(QI + (brow + t0 + 4 * rg + (fr >> 2)) * 256 + (fr & 3) * 64 + 16 * fq);
                wi[rg] = *(const f32x4*)(WI + (brow + t0 + 4 * rg + fq) * 4);
            }
            auto ldk = [&](i32x4_t (&kf)[4], int jt0) {
#pragma unroll
                for (int u = 0; u < 4; ++u) {
                    const int jt = (jt0 + 8 * u) < ntile ? (jt0 + 8 * u) : (ntile - 1);
                    kf[u] = *(const i32x4_t*)(KIN + (brow + jt * 16 + fr) * 64 + 16 * fq);
                }
            };
            auto cmpk = [&](const i32x4_t (&kf)[4], int jt0) {
#pragma unroll
                for (int u = 0; u < 4; ++u) {
                    const int jt = jt0 + 8 * u;
                    if (jt < ntile) {
#pragma unroll
                        for (int rg = 0; rg < 2; ++rg) {
                            i32x4_t d = {0, 0, 0, 0};
                            d = __builtin_amdgcn_mfma_i32_16x16x64_i8(qa[rg], kf[u], d, 0, 0, 0);
                            const float sc = (((float)max(d[0], 0) * wi[rg][0] + (float)max(d[1], 0) * wi[rg][1]) + (float)max(d[2], 0) * wi[rg][2]) + (float)max(d[3], 0) * wi[rg][3];
                            rows[(4 * rg + fq) * 8192 + rowaddr(jt * 16 + fr)] = (u16)(f2key(sc) >> 16);
                        }
                    }
                }
            };
            i32x4_t kA[4], kB[4];
            if (wid < ntile) ldk(kA, wid);
            for (int jt0 = wid; jt0 < ntile; jt0 += 64) {
                const bool hasB = jt0 + 32 < ntile;
                if (hasB) ldk(kB, jt0 + 32);
                cmpk(kA, jt0);
                if (hasB) { if (jt0 + 64 < ntile) ldk(kA, jt0 + 64); cmpk(kB, jt0 + 32); }
            }
        }
        __syncthreads();
        {
            const int q = wid, t = t0 + q, N = t + 1;
            LAS u16* row = rows + q * 8192;
            LAS u16* list = (LAS u16*)(lds + P3_LIST + q * 512);
            int cnt;
            if (N <= 256) { for (int p = lane; p < 256; p += 64) list[p] = p < N ? (u16)p : (u16)0; cnt = N; }
            else { select_top16(row, list, N, lane); cnt = 256; }
            wave_lds_sync();
            bf16x8 qf[4];
            {
                const int head = fr & 7;
                const u16* qrow = Q + (brow + t) * 1024 + head * 128;
                float f[4][8]; float ss = 0.f;
#pragma unroll
                for (int ks = 0; ks < 4; ++ks) {
                    const u32x4 raw = *(const u32x4*)(qrow + ks * 32 + 8 * fq);
                    f[ks][0] = bflo(raw.x); f[ks][1] = bfhi(raw.x); f[ks][2] = bflo(raw.y); f[ks][3] = bfhi(raw.y); f[ks][4] = bflo(raw.z); f[ks][5] = bfhi(raw.z); f[ks][6] = bflo(raw.w); f[ks][7] = bfhi(raw.w);
#pragma unroll
                    for (int j = 0; j < 8; ++j) ss += f[ks][j] * f[ks][j];
                }
                ss += __shfl_xor(ss, 16); ss += __shfl_xor(ss, 32);
                const float rq = __builtin_amdgcn_rsqf(ss * (1.0f / 128.0f) + EPS) * 0.08838834764831845f;
#pragma unroll
                for (int ks = 0; ks < 4; ++ks) {
                    const float* qg = a.in[I_QNG] + ks * 32 + 8 * fq;
                    u32x4 w;
                    w.x = pk2(f[ks][0] * rq * qg[0], f[ks][1] * rq * qg[1]); w.y = pk2(f[ks][2] * rq * qg[2], f[ks][3] * rq * qg[3]);
                    w.z = pk2(f[ks][4] * rq * qg[4], f[ks][5] * rq * qg[5]); w.w = pk2(f[ks][6] * rq * qg[6], f[ks][7] * rq * qg[7]);
                    qf[ks] = __builtin_bit_cast(bf16x8, w);
                }
            }
            LAS unsigned char* img = (LAS unsigned char*)row;
            const int nsteps = (cnt + 31) >> 5;
            f32x4 oacc[8];
#pragma unroll
            for (int i = 0; i < 8; ++i) oacc[i] = (f32x4){0.f, 0.f, 0.f, 0.f};
            float mrun = -3.0e38f, lpart = 0.f;
            auto issue = [&](u32x4 (&pf)[8], int pp) {
#pragma unroll
                for (int it = 0; it < 8; ++it) { const int piece = it * 64 + lane; const unsigned key = list[pp * 32 + (piece >> 4)]; pf[it] = *(const u32x4*)(KVN + (brow + key) * 128 + 8 * (piece & 15)); }
            };
            auto step = [&](u32x4 (&pf)[8], int pp) {
#pragma unroll
                for (int it = 0; it < 8; ++it) { const int piece = it * 64 + lane; *(LAS u32x4*)(img + (piece >> 4) * 288 + (piece & 15) * 16) = pf[it]; }
                if (pp + 1 < nsteps) issue(pf, pp + 1);
                wave_lds_sync();
                __builtin_amdgcn_sched_barrier(0);
                f32x4 sa = {0.f, 0.f, 0.f, 0.f}, sb = {0.f, 0.f, 0.f, 0.f};
#pragma unroll
                for (int ks = 0; ks < 4; ++ks) {
                    const bf16x8 a0 = *(LAS const bf16x8*)(img + fr * 288 + (ks * 32 + 8 * fq) * 2), a1 = *(LAS const bf16x8*)(img + (16 + fr) * 288 + (ks * 32 + 8 * fq) * 2);
                    sa = __builtin_amdgcn_mfma_f32_16x16x32_bf16(a0, qf[ks], sa, 0, 0, 0); sb = __builtin_amdgcn_mfma_f32_16x16x32_bf16(a1, qf[ks], sb, 0, 0, 0);
                }
                const int pb0 = pp * 32 + 4 * fq;
#pragma unroll
                for (int r = 0; r < 4; ++r) { if (pb0 + r >= cnt) sa[r] = -3.0e38f; if (pb0 + 16 + r >= cnt) sb[r] = -3.0e38f; }
                float mx = fmaxf(fmaxf(fmaxf(sa[0], sa[1]), fmaxf(sa[2], sa[3])), fmaxf(fmaxf(sb[0], sb[1]), fmaxf(sb[2], sb[3])));
                mx = fmaxf(mx, __shfl_xor(mx, 16)); mx = fmaxf(mx, __shfl_xor(mx, 32));
                const float mnew = fmaxf(mrun, mx), alpha = __expf(mrun - mnew);
                mrun = mnew;
                float ps = 0.f;
#pragma unroll
                for (int r = 0; r < 4; ++r) { sa[r] = __expf(sa[r] - mnew); sb[r] = __expf(sb[r] - mnew); ps += sa[r] + sb[r]; }
                lpart = lpart * alpha + ps;
#pragma unroll
                for (int cb = 0; cb < 8; ++cb) oacc[cb] *= alpha;
                u32x4 pw; pw.x = pk2(sa[0], sa[1]); pw.y = pk2(sa[2], sa[3]); pw.z = pk2(sb[0], sb[1]); pw.w = pk2(sb[2], sb[3]);
                const bf16x8 pb = __builtin_bit_cast(bf16x8, pw);
#pragma unroll
                for (int cb = 0; cb < 8; ++cb) {
                    const s16x4 r0 = __builtin_amdgcn_ds_read_tr16_b64_v4i16((LAS s16x4*)(img + (4 * fq + (fr >> 2)) * 288 + (cb * 16 + 4 * (fr & 3)) * 2));
                    const s16x4 r1 = __builtin_amdgcn_ds_read_tr16_b64_v4i16((LAS s16x4*)(img + (16 + 4 * fq + (fr >> 2)) * 288 + (cb * 16 + 4 * (fr & 3)) * 2));
                    const bf16x8 av = {r0[0], r0[1], r0[2], r0[3], r1[0], r1[1], r1[2], r1[3]};
                    oacc[cb] = __builtin_amdgcn_mfma_f32_16x16x32_bf16(av, pb, oacc[cb], 0, 0, 0);
                    if (cb == 3) __builtin_amdgcn_sched_barrier(0);
                }
                wave_lds_sync();
            };
            u32x4 pf0[8];
            issue(pf0, 0);
#pragma unroll 1
            for (int pp = 0; pp < nsteps; ++pp) step(pf0, pp);
            float lsum = lpart; lsum += __shfl_xor(lsum, 16); lsum += __shfl_xor(lsum, 32);
            const float inv = __builtin_amdgcn_rcpf(lsum);
            if (fr < 8) {
                u16* orow = YO + (brow + t) * 1536 + 512 + fr * 128 + 4 * fq;
#pragma unroll
                for (int cb = 0; cb < 8; ++cb) { u32x2 w; w.x = pk2(oacc[cb][0] * inv, oacc[cb][1] * inv); w.y = pk2(oacc[cb][2] * inv, oacc[cb][3] * inv); *(u32x2*)(orow + cb * 16) = w; }
            }
        }
    }
}

constexpr int P6_LCNT = 0, P6_BASE = 128, P6_RSB = 256, P6_RI = 1024;
DI unsigned dpp_max_u32(unsigned v) {
    v = max(v, (unsigned)__builtin_amdgcn_update_dpp(0, (int)v, 0xB1, 0xf, 0xf, false));
    v = max(v, (unsigned)__builtin_amdgcn_update_dpp(0, (int)v, 0x4E, 0xf, 0xf, false));
    v = max(v, (unsigned)__builtin_amdgcn_update_dpp(0, (int)v, 0x141, 0xf, 0xf, false));
    v = max(v, (unsigned)__builtin_amdgcn_update_dpp(0, (int)v, 0x140, 0xf, 0xf, false));
    return v;
}
DI float key2f(unsigned k) { return __uint_as_float((k & 0x80000000u) ? (k & 0x7fffffffu) : ~k); }
DI void router_phase(const Args& a, LAS unsigned char* lds) {
    unsigned char* ws = a.ws;
    const int tid = otid(), wid = tid >> 6, lane = tid & 63, fr = lane & 15, fq = lane >> 4;
    LAS int* lcnt = (LAS int*)(lds + P6_LCNT); LAS int* lbase = (LAS int*)(lds + P6_BASE); LAS float* rsb = (LAS float*)(lds + P6_RSB); LAS int* RI = (LAS int*)(lds + P6_RI);
    const u16* WRH = (const u16*)(ws + WS_WR); const u16* WRL = WRH + 32 * 1024;
    unsigned* CNT = (unsigned*)(ws + WS_CTL);
    for (int rg = blockIdx.x; rg < T / 128; rg += gridDim.x) {
        __syncthreads();
        if (tid < 32) lcnt[tid] = 0;
        __syncthreads();
        {
            const int row = rg * 128 + wid * 16 + fr;
            const float* xr = a.out + (size_t)row * 1024 + 8 * fq;
            f32x4 acc[2] = {{0.f, 0.f, 0.f, 0.f}, {0.f, 0.f, 0.f, 0.f}};
            float ss = 0.f;
#pragma unroll 4
            for (int ks = 0; ks < 32; ++ks) {
                const f32x4 x0 = *(const f32x4*)(xr + ks * 32), x1 = *(const f32x4*)(xr + ks * 32 + 4);
                ss += ((x0[0] * x0[0] + x0[1] * x0[1]) + (x0[2] * x0[2] + x0[3] * x0[3])) + ((x1[0] * x1[0] + x1[1] * x1[1]) + (x1[2] * x1[2] + x1[3] * x1[3]));
                u32x4 hw; hw.x = pk2(x0[0], x0[1]); hw.y = pk2(x0[2], x0[3]); hw.z = pk2(x1[0], x1[1]); hw.w = pk2(x1[2], x1[3]);
                u32x4 lw; lw.x = pk2(x0[0] - bflo(hw.x), x0[1] - bfhi(hw.x)); lw.y = pk2(x0[2] - bflo(hw.y), x0[3] - bfhi(hw.y)); lw.z = pk2(x1[0] - bflo(hw.z), x1[1] - bfhi(hw.z)); lw.w = pk2(x1[2] - bflo(hw.w), x1[3] - bfhi(hw.w));
                const bf16x8 xh = __builtin_bit_cast(bf16x8, hw), xl = __builtin_bit_cast(bf16x8, lw);
#pragma unroll
                for (int nt = 0; nt < 2; ++nt) {
                    const bf16x8 wh = *(const bf16x8*)(WRH + (size_t)(nt * 16 + fr) * 1024 + ks * 32 + 8 * fq), wl = *(const bf16x8*)(WRL + (size_t)(nt * 16 + fr) * 1024 + ks * 32 + 8 * fq);
                    acc[nt] = __builtin_amdgcn_mfma_f32_16x16x32_bf16(xh, wh, acc[nt], 0, 0, 0);
                    acc[nt] = __builtin_amdgcn_mfma_f32_16x16x32_bf16(xl, wh, acc[nt], 0, 0, 0);
                    acc[nt] = __builtin_amdgcn_mfma_f32_16x16x32_bf16(xh, wl, acc[nt], 0, 0, 0);
                }
            }
            ss += __shfl_xor(ss, 16); ss += __shfl_xor(ss, 32);
            if (fq == 0) rsb[wid * 16 + fr] = __builtin_amdgcn_rsqf(ss * (1.0f / 1024.0f) + EPS);
            wave_lds_sync();
            const float b0 = a.in[I_BR][fr], b1 = a.in[I_BR][16 + fr];
#pragma unroll
            for (int r = 0; r < 4; ++r) {
                const float rs = rsb[wid * 16 + 4 * fq + r];
                unsigned k0 = (f2key(acc[0][r] * rs + b0) & ~31u) | (unsigned)(31 - fr), k1 = (f2key(acc[1][r] * rs + b1) & ~31u) | (unsigned)(15 - fr);
                unsigned sel[4];
#pragma unroll
                for (int k = 0; k < 4; ++k) {
                    const unsigned best = dpp_max_u32(k0 > k1 ? k0 : k1);
                    sel[k] = best;
                    if (k0 == best) k0 = 0u;
                    if (k1 == best) k1 = 0u;
                }
                const float v0 = key2f(sel[0] & ~31u), e1 = __expf(key2f(sel[1] & ~31u) - v0), e2 = __expf(key2f(sel[2] & ~31u) - v0), e3 = __expf(key2f(sel[3] & ~31u) - v0);
                const float inv = 1.0f / (1.0f + e1 + e2 + e3);
                if (fr < 4) {
                    const unsigned sk = fr == 0 ? sel[0] : (fr == 1 ? sel[1] : (fr == 2 ? sel[2] : sel[3]));
                    const int e = 31 - (int)(sk & 31u);
                    const float gt = (fr == 0 ? 1.0f : (fr == 1 ? e1 : (fr == 2 ? e2 : e3))) * inv;
                    const int ls = __hip_atomic_fetch_add(lcnt + e, 1, __ATOMIC_RELAXED, __HIP_MEMORY_SCOPE_WORKGROUP);
                    const int ri = ((wid * 16 + 4 * fq + r) * 4 + fr) * 4;
                    RI[ri + 0] = e; RI[ri + 1] = ls; RI[ri + 2] = __float_as_int(gt); RI[ri + 3] = __float_as_int(rs);
                }
            }
        }
        __syncthreads();
        if (tid < 32) lbase[tid] = (int)__hip_atomic_fetch_add(CNT + tid, (unsigned)lcnt[tid], __ATOMIC_RELAXED, __HIP_MEMORY_SCOPE_AGENT);
        __syncthreads();
        {
            const int rl = tid >> 2, k = tid & 3, row = rg * 128 + rl;
            const int e = RI[tid * 4 + 0], slot = lbase[e] + RI[tid * 4 + 1];
            ((int*)(ws + WS_LTOK))[(size_t)e * ECAP + slot] = row;
            ((float*)(ws + WS_LGATE))[(size_t)e * ECAP + slot] = __int_as_float(RI[tid * 4 + 2]);
            ((float*)(ws + WS_LRS))[(size_t)e * ECAP + slot] = __int_as_float(RI[tid * 4 + 3]);
            ((unsigned*)(ws + WS_ROUTE))[(size_t)row * 4 + k] = ((unsigned)e << 16) | (unsigned)slot;
        }
    }
}

DI void combine_phase(const Args& a, LAS unsigned char* lds) {
    unsigned char* ws = a.ws;
    LAS const int* tab = (LAS const int*)(lds + MOE_TAB);
    const int tid = otid(), wid = tid >> 6, lane = tid & 63;
    const u16* YB = (const u16*)(ws + WS_YB); const unsigned* ROUTE = (const unsigned*)(ws + WS_ROUTE);
    for (int row = blockIdx.x * 8 + wid; row < T; row += gridDim.x * 8) {
        size_t pos[4];
#pragma unroll
        for (int k = 0; k < 4; ++k) { const unsigned r = ROUTE[(size_t)row * 4 + k]; const int e = (int)(r >> 16), slot = (int)(r & 0xffffu); pos[k] = (size_t)tab[e] * 256 + slot; }
        float* orow = a.out + (size_t)row * 1024;
#pragma unroll
        for (int i = 0; i < 4; ++i) {
            f32x4 v = *(const f32x4*)(orow + i * 256 + lane * 4);
#pragma unroll
            for (int k = 0; k < 4; ++k) { const u32x2 y = *(const u32x2*)(YB + pos[k] * 1024 + i * 256 + lane * 4); v[0] += bflo(y.x); v[1] += bfhi(y.x); v[2] += bflo(y.y); v[3] += bfhi(y.y); }
            *(f32x4*)(orow + i * 256 + lane * 4) = v;
        }
    }
}

#define XB_TMO      128
#define XB_XCNT(j)  (256  + 64 * (j))
#define XB_XSUB(j)  (1280 + 64 * (j))
#define XB_XGEN(j)  (2304 + 64 * (j))
#define XB_TOP      3328
#define XB_TOPGEN   3392
#define XCD_BAR_WORDS 3456
#define XB_SPIN_CAP (1u << 18)

__device__ __forceinline__ unsigned xb_ld(unsigned* p)              { return __hip_atomic_load(p, __ATOMIC_RELAXED, __HIP_MEMORY_SCOPE_AGENT); }
__device__ __forceinline__ unsigned xb_add(unsigned* p, unsigned v) { return __hip_atomic_fetch_add(p, v, __ATOMIC_RELAXED, __HIP_MEMORY_SCOPE_AGENT); }
__device__ __forceinline__ unsigned xb_xcc_id() { return (unsigned)__builtin_amdgcn_s_getreg((3 << 11) | 20) & 0xFu; }
#define XB_SPIN(cond, bar) do { unsigned _sp = 0; while (cond) { __builtin_amdgcn_s_sleep(1); \
    if ((++_sp & 255u) == 0u) { if (xb_ld(&(bar)[XB_TMO])) break; if (_sp > XB_SPIN_CAP) { atomicAdd(&(bar)[XB_TMO], 1u); break; } } } } while (0)

struct XcdBarrier {
    unsigned* bar; unsigned x;
    volatile LAS unsigned* st;
};

__device__ __forceinline__ XcdBarrier xcd_barrier_post(unsigned* bar, volatile LAS unsigned* st) {
    XcdBarrier b; b.bar = bar; b.x = xb_xcc_id(); b.st = st;
    if (threadIdx.x == 0) (void)xb_add(&bar[XB_XCNT(b.x)], 1u);
    return b;
}
__device__ __forceinline__ void xcd_barrier_complete(unsigned* bar, unsigned x, unsigned& nloc, unsigned& nx) {
    const unsigned G = gridDim.x * gridDim.y * gridDim.z;
    unsigned sum, cnt, mine, sp = 0u;
    for (;;) {
        sum = 0u; cnt = 0u; mine = 0u;
#pragma unroll
        for (unsigned j = 0; j < 16; ++j) { const unsigned c = xb_ld(&bar[XB_XCNT(j)]); sum += c; cnt += (c > 0u) ? 1u : 0u; mine = (j == x) ? c : mine; }
        if (sum == G) break;
        __builtin_amdgcn_s_sleep(1);
        if ((++sp & 255u) == 0u) { if (xb_ld(&bar[XB_TMO])) break; if (sp > XB_SPIN_CAP) { atomicAdd(&bar[XB_TMO], 1u); break; } }
    }
    nloc = mine > 0u ? mine : 1u; nx = cnt > 0u ? cnt : 1u;
}

__device__ __forceinline__ void xcd_barrier(const XcdBarrier& b) {
    asm volatile("s_waitcnt vmcnt(0)" ::: "memory");
    __syncthreads();
    if (threadIdx.x == 0) {
        unsigned* bar = b.bar;
        __builtin_amdgcn_s_waitcnt(0);
        unsigned nloc = b.st[0], nx = b.st[1];
        if (nloc == 0u) { xcd_barrier_complete(bar, b.x, nloc, nx); b.st[0] = nloc; b.st[1] = nx; }
        const unsigned old = xb_add(&bar[XB_XSUB(b.x)], 1u);
        const unsigned gen = old / nloc;
        if (old + 1u == (gen + 1u) * nloc) {
            __builtin_amdgcn_fence(__ATOMIC_RELEASE, "agent");
            asm volatile("s_waitcnt vmcnt(0)" ::: "memory");
            const unsigned og = xb_add(&bar[XB_TOP], 1u);
            const unsigned tg = og / nx;
            if (og + 1u == (tg + 1u) * nx) xb_add(&bar[XB_TOPGEN], 1u);
            else XB_SPIN(xb_ld(&bar[XB_TOPGEN]) == tg, bar);
            __builtin_amdgcn_fence(__ATOMIC_ACQUIRE, "agent");
            xb_add(&bar[XB_XGEN(b.x)], 1u);
            asm volatile("s_waitcnt vmcnt(0)" ::: "memory");
        } else {
            XB_SPIN(xb_ld(&bar[XB_XGEN(b.x)]) == gen, bar);
            __builtin_amdgcn_fence(__ATOMIC_ACQUIRE, "agent");
            asm volatile("s_waitcnt vmcnt(0)" ::: "memory");
        }
    }
    __syncthreads();
}

__global__ void __launch_bounds__(NT, 2) fwd(Args a) {
    extern __shared__ __attribute__((aligned(16))) unsigned char lds_raw[];
    LAS unsigned char* lds = (LAS unsigned char*)lds_raw;
    cg::grid_group grid = cg::this_grid();
    unsigned char* ws = a.ws;
    const int G = gridDim.x, c = blockIdx.x;
    if (threadIdx.x < 2) ((volatile LAS unsigned*)(lds + LDS_BARST))[threadIdx.x] = 0u;
    __syncthreads();
    const XcdBarrier xbar = xcd_barrier_post((unsigned*)(ws + WS_BAR), (volatile LAS unsigned*)(lds + LDS_BARST));

    phase0(a, lds);
    grid.sync();
    {
        g8::PlainSched s; s.Abase = (const char*)(ws + WS_XB); s.Bbase = (const char*)(ws + WS_WIN); s.lda = 1024; s.ldb = 1024; s.K = 1024; s.nM = T / 256; s.nN = NIN / 256; s.G = G; s.c = c;
        EpiIn e; e.H = (u16*)(ws + WS_H); e.rs1 = (const float*)(ws + WS_RS1); e.SSQ = (float*)(ws + WS_SSQ); e.WI = (float*)(ws + WS_WI);
        g8::gemm_phase(lds, s, e);
    }
    xcd_barrier(xbar);
    {
        g8::PlainSched s; s.Abase = (const char*)(ws + WS_H) + 1024 * 2; s.Bbase = (const char*)(ws + WS_WQ); s.lda = NIN; s.ldb = 256; s.K = 256; s.nM = T / 256; s.nN = 5; s.G = G; s.c = c;
        EpiQ e; e.Q = (u16*)(ws + WS_Q); e.QI = (u16*)(ws + WS_QI); e.SSQ = (const float*)(ws + WS_SSQ);
        g8::gemm_phase(lds, s, e);
        for (int u = c; u < 1024; u += G) gmlp_unit(a, lds, u);
        kvnorm(a);
    }
    xcd_barrier(xbar);
    dsa_phase(a, lds);
    xcd_barrier(xbar);
    {
        g8::PlainSched s; s.Abase = (const char*)(ws + WS_YO); s.Bbase = (const char*)(ws + WS_WCAT); s.lda = 1536; s.ldb = 1536; s.K = 512; s.nM = T / 256; s.nN = 4; s.G = G; s.c = c;
        EpiMrg<0> e0; e0.OUT = (u16*)(ws + WS_TMP); e0.TMP = nullptr; e0.H = (const u16*)(ws + WS_H);
        g8::gemm_phase(lds, s, e0);
        s.Abase = (const char*)(ws + WS_YO) + 512 * 2; s.Bbase = (const char*)(ws + WS_WCAT) + 512 * 2; s.K = 1024;
        EpiMrg<1> e1; e1.OUT = (u16*)(ws + WS_MRG); e1.TMP = (const u16*)(ws + WS_TMP); e1.H = (const u16*)(ws + WS_H);
        g8::gemm_phase(lds, s, e1);
    }
    xcd_barrier(xbar);
    {
        g8::PlainSched s; s.Abase = (const char*)(ws + WS_MRG); s.Bbase = (const char*)(ws + WS_WOUT); s.lda = 1024; s.ldb = 1024; s.K = 1024; s.nM = T / 256; s.nN = 4; s.G = G; s.c = c;
        EpiOut e; e.out = a.out; e.x = a.in[I_X]; e.XN = (unsigned char*)(ws + WS_XN2);
        g8::gemm_phase(lds, s, e);
    }
    xcd_barrier(xbar);
    router_phase(a, lds);
    xcd_barrier(xbar);
    moe_table(lds, (const unsigned*)(ws + WS_CTL));
    {
        MoeSched<8, true> s; s.Abase = (const char*)(ws + WS_XN2); s.Wbase = (const char*)(ws + WS_WE1); s.LTOK = (const int*)(ws + WS_LTOK); s.tab = (LAS const int*)(lds + MOE_TAB);
        s.lda = 1024; s.ldb = 1024; s.K = 1024; s.G = G; s.c = c; s.wstride = (size_t)2048 * 1024;
        EpiMoe1 e; e.ACT = (unsigned char*)(ws + WS_ACT); e.b1 = a.in[I_BE1]; e.LRS = (const float*)(ws + WS_LRS); e.tab = (LAS const int*)(lds + MOE_TAB);
        g8::gemm_phase<true>(lds, s, e);
    }
    xcd_barrier(xbar);
    {
        MoeSched<4, false> s; s.Abase = (const char*)(ws + WS_ACT); s.Wbase = (const char*)(ws + WS_WE2); s.LTOK = nullptr; s.tab = (LAS const int*)(lds + MOE_TAB);
        s.lda = 1024; s.ldb = 1024; s.K = 1024; s.G = G; s.c = c; s.wstride = (size_t)1024 * 1024;
        EpiMoe2 e; e.YB = (u16*)(ws + WS_YB); e.b2 = a.in[I_BE2]; e.LGATE = (const float*)(ws + WS_LGATE); e.tab = (LAS const int*)(lds + MOE_TAB);
        g8::gemm_phase<true>(lds, s, e);
    }
    xcd_barrier(xbar);
    combine_phase(a, lds);
}

extern "C" void kernel_launch(void* const* d_in, const int* in_sizes, int n_in, void* d_out, int out_size, void* d_ws, size_t ws_size, hipStream_t stream) {
    static int grid = 0;
    if (grid == 0) {
        int dev = 0, cus = 0, per_cu = 0;
        if (n_in != 23 || out_size != T * Dm || ws_size < WS_END) { fprintf(stderr, "kernel_launch: unexpected problem (n_in %d, out %d, ws %zu < %zu)\n", n_in, out_size, ws_size, (size_t)WS_END); grid = -1; return; }
        if (hipGetDevice(&dev) != hipSuccess || hipDeviceGetAttribute(&cus, hipDeviceAttributeMultiprocessorCount, dev) != hipSuccess) { grid = -1; return; }
        if (hipFuncSetAttribute((const void*)fwd, hipFuncAttributeMaxDynamicSharedMemorySize, LDS_BYTES) != hipSuccess) { fprintf(stderr, "hipFuncSetAttribute failed\n"); grid = -1; return; }
        if (hipOccupancyMaxActiveBlocksPerMultiprocessor(&per_cu, (const void*)fwd, NT, LDS_BYTES) != hipSuccess || per_cu < 1) { fprintf(stderr, "occupancy query failed (%d)\n", per_cu); grid = -1; return; }
        grid = cus;
        fprintf(stderr, "kernel_launch: cus %d per_cu %d grid %d ws %zu need %zu\n", cus, per_cu, grid, ws_size, (size_t)WS_END);
    }
    if (grid < 0) return;
    Args a{};
    for (int i = 0; i < 23; ++i) a.in[i] = (const float*)d_in[i];
    a.out = (float*)d_out; a.ws = (unsigned char*)d_ws; a.mask = 0xffffffffu; a.pad = 0u;
    if (hipMemsetAsync((char*)d_ws + WS_CTL, 0, 65536, stream) != hipSuccess) { fprintf(stderr, "memset failed\n"); return; }
    void* args[] = {&a};
    hipError_t e = hipLaunchCooperativeKernel((const void*)fwd, dim3(grid), dim3(NT), args, LDS_BYTES, stream);
    if (e != hipSuccess) fprintf(stderr, "cooperative launch failed: %s (grid %d)\n", hipGetErrorString(e), grid);
}
```

```cpp
#include <hip/hip_runtime.h>
#include <hip/hip_cooperative_groups.h>
#include <cstdio>
#include <cstdint>
namespace cg = cooperative_groups;

#define LAS __attribute__((address_space(3)))
#define DI __device__ __forceinline__
typedef unsigned short u16;
typedef short bf16x8 __attribute__((ext_vector_type(8)));
typedef short s16x4 __attribute__((ext_vector_type(4)));
typedef float f32x4 __attribute__((ext_vector_type(4)));
typedef float f32x2 __attribute__((ext_vector_type(2)));
typedef unsigned u32x4 __attribute__((ext_vector_type(4)));
typedef unsigned u32x2 __attribute__((ext_vector_type(2)));
typedef __bf16 bf2_t __attribute__((ext_vector_type(2)));
typedef int v8i_t __attribute__((ext_vector_type(8)));

constexpr int NT = 512;
constexpr int LDS_BYTES = 155648;
constexpr int Dm = 1024, Bsz = 4, S = 8192, T = Bsz * S;
constexpr int NIN = 3584;
constexpr int NE = 32, ECAP = 32768, PPAD = 131072 + NE * 256;
constexpr float EPS = 1e-6f;

constexpr size_t MiB = 1024 * 1024;
constexpr size_t WS_CTL = 0;
constexpr size_t WS_BAR = 16384;
constexpr int LDS_BARST = LDS_BYTES - 16;
constexpr size_t WS_WIN = 64 * 1024;
constexpr size_t WS_WQ = WS_WIN + (size_t)NIN * 1024 * 2;
constexpr size_t WS_WSP = WS_WQ + 1280 * 256 * 2;
constexpr size_t WS_WCAT = WS_WSP + 4 * 128 * 128 * 2;
constexpr size_t WS_WOUT = WS_WCAT + 1024 * 1536 * 2;
constexpr size_t WS_WR = WS_WOUT + 1024 * 1024 * 2;
constexpr size_t WS_WE1 = WS_WR + 32 * 1024 * 4;
constexpr size_t WS_WE2 = WS_WE1 + (size_t)32 * 2048 * 1024 * 2;
constexpr size_t WS_RS1 = WS_WE2 + (size_t)32 * 1024 * 1024 * 2;
constexpr size_t WS_SSQ = WS_RS1 + (size_t)T * 4;
constexpr size_t WS_WI = WS_SSQ + (size_t)T * 32 * 4;
constexpr size_t WS_ROUTE = WS_WI + (size_t)T * 4 * 4;
constexpr size_t WS_LTOK = WS_ROUTE + (size_t)T * 4 * 4;
constexpr size_t WS_LGATE = WS_LTOK + (size_t)NE * ECAP * 4;
constexpr size_t WS_LRS = WS_LGATE + (size_t)NE * ECAP * 4;
constexpr size_t WS_XN2 = WS_LRS + (size_t)NE * ECAP * 4;
constexpr size_t WS_R0 = WS_XN2 + (size_t)T * 1024 * 2;
constexpr size_t WS_XB = WS_R0;
constexpr size_t WS_H = WS_XB + (size_t)T * 1024 * 2;
constexpr size_t WS_Q = WS_H + (size_t)T * NIN * 2;
constexpr size_t WS_QI = WS_Q + (size_t)T * 1024 * 2;
constexpr size_t WS_KVN = WS_QI + (size_t)T * 256 * 2;
constexpr size_t WS_KIN = WS_KVN + (size_t)T * 128 * 2;
constexpr size_t WS_YO = WS_KIN + (size_t)T * 64 * 2;
constexpr size_t WS_TMP = WS_YO + (size_t)T * 1536 * 2;
constexpr size_t WS_MRG = WS_TMP + (size_t)T * 1024 * 2;
constexpr size_t WS_R0END = WS_MRG + (size_t)T * 1024 * 2;
constexpr size_t WS_ACT = WS_XB;
constexpr size_t WS_YB = WS_Q;
static_assert(WS_ACT + (size_t)PPAD * 1024 * 2 <= WS_Q, "ACT overlaps YB");
static_assert(WS_YB + (size_t)PPAD * 1024 * 2 <= WS_R0END, "YB too large");
constexpr size_t WS_END = WS_R0END;

struct Args { const float* in[23]; float* out; unsigned char* ws; unsigned mask; unsigned pad; };
enum { I_X = 0, I_N1G, I_WIN, I_QLG, I_WUQ, I_QNG, I_KVG, I_WUV, I_WQI, I_KIG, I_VG, I_WSP, I_BSP, I_WPA, I_WPB, I_WOUT, I_N2G, I_WR, I_BR, I_WE1, I_BE1, I_WE2, I_BE2 };

DI unsigned pk2(float a, float b) { f32x2 v = {a, b}; bf2_t r = __builtin_convertvector(v, bf2_t); return __builtin_bit_cast(unsigned, r); }
DI unsigned pk4_fp8(float a, float b, float c, float d) { unsigned w = 0u; w = (unsigned)__builtin_amdgcn_cvt_pk_fp8_f32(a, b, (int)w, false); w = (unsigned)__builtin_amdgcn_cvt_pk_fp8_f32(c, d, (int)w, true); return w; }
DI unsigned pk4_i8(float a, float b, float c, float d) {
    const int ia = (int)__builtin_rintf(fminf(fmaxf(a * 32.0f, -127.0f), 127.0f)), ib = (int)__builtin_rintf(fminf(fmaxf(b * 32.0f, -127.0f), 127.0f));
    const int ic = (int)__builtin_rintf(fminf(fmaxf(c * 32.0f, -127.0f), 127.0f)), id = (int)__builtin_rintf(fminf(fmaxf(d * 32.0f, -127.0f), 127.0f));
    return (unsigned)(ia & 0xff) | ((unsigned)(ib & 0xff) << 8) | ((unsigned)(ic & 0xff) << 16) | ((unsigned)(id & 0xff) << 24);
}
DI float bflo(unsigned u) { return __uint_as_float(u << 16); }
DI float bfhi(unsigned u) { return __uint_as_float(u & 0xffff0000u); }
DI u16 f2bf(float f) { return (u16)(pk2(f, 0.f) & 0xffffu); }
DI float bf2f(u16 h) { return __uint_as_float(((unsigned)h) << 16); }
DI float sigmoidf_(float x) { return __builtin_amdgcn_rcpf(1.0f + __expf(-x)); }
DI float gelu_tanh(float x) { const float u = 1.5957691216057308f * (x + 0.044715f * x * x * x); return x * sigmoidf_(u); }
DI float fast_sigmoid(float x) { return __builtin_amdgcn_rcpf(1.0f + __builtin_amdgcn_exp2f(x * -1.4426950408889634f)); }
DI float fast_gelu(float x) { const float p = __builtin_fmaf(x * x, -0.10294324f, -2.3022082f); return x * __builtin_amdgcn_rcpf(1.0f + __builtin_amdgcn_exp2f(x * p)); }
DI int otid() { int t = threadIdx.x; asm volatile("" : "+v"(t)); return t; }
DI void wave_lds_sync() { asm volatile("s_waitcnt lgkmcnt(0)" ::: "memory"); }

namespace g8 {
constexpr int BM = 256, BK = 64, HALF = 128, HTB = HALF * BK * 2, STAGE_BYTES = 8 * HTB, NXCD = 8, WGM = 8;
DI int lds_byte(int r, int c) { const int st = (r >> 4) * 2 + (c >> 5), rr = r & 15, cc = c & 31, ob = rr * 64 + cc * 2; return st * 1024 + (ob ^ (((ob >> 9) & 1) << 5)); }
DI int perm32(int rho) { const int n = rho >> 4, i = rho & 15; return 8 * (i >> 2) + 4 * n + (i & 3); }
DI void stage_rc(int b, int& R, int& C) { const int st = b / 1024, sb = b % 1024, swz = sb ^ (((sb >> 9) & 1) << 5); R = (st >> 1) * 16 + swz / 64; C = (st & 1) * 32 + (swz % 64) / 2; }

struct UnitD { const char* Bp; int pm, pn, e, rb; };

DI bool static_tile(int i, int G, int c, int nM, int nN, int& pm, int& pn) {
    const int nwg = nM * nN; const long L = (long)i * G + c; if (L >= nwg) return false;
    int wgid = (int)L; { const int q = nwg / NXCD, r = nwg % NXCD, xcd = wgid % NXCD, off = wgid / NXCD; wgid = (xcd < r ? xcd * (q + 1) : r * (q + 1) + (xcd - r) * q) + off; }
    const int nig = WGM * nN, gid = wgid / nig, fm = gid * WGM, gsz = (nM - fm) < WGM ? (nM - fm) : WGM;
    pm = fm + ((wgid % nig) % gsz); pn = (wgid % nig) / gsz; return true;
}

struct PlainSched {
    const char* Abase; const char* Bbase; int lda, ldb, K, nM, nN, G, c; static constexpr int esz = 2;
    DI bool next(int i, UnitD& u) const { int pm, pn; if (!static_tile(i, G, c, nM, nN, pm, pn)) return false; u.pm = pm; u.pn = pn; u.e = 0; u.rb = 0; u.Bp = Bbase + (size_t)pn * BM * ldb * 2; return true; }
    DI void a_offs(const UnitD& u, int R0, int C0, unsigned (&o)[2][2]) const {
#pragma unroll
        for (int h = 0; h < 2; ++h)
#pragma unroll
            for (int i = 0; i < 2; ++i) o[h][i] = (unsigned)(((size_t)(u.pm * BM + h * HALF + R0 + 64 * i) * lda + C0) * 2);
    }
};

template <bool FP8 = false, class Epi, class Sched>
DI void gemm_phase(LAS unsigned char* lds, const Sched& S, const Epi& E) {
    const int tid = otid(), wid = __builtin_amdgcn_readfirstlane(tid >> 6), lane = tid & 63, wr = wid >> 2, wc = wid & 3, fr = lane & 15, fq = lane >> 4;
    const int nt = S.K * Sched::esz / 128;
    int R0, C0; stage_rc(tid * 16, R0, C0);
    unsigned voffB[2];
#pragma unroll
    for (int i = 0; i < 2; ++i) { const int Rr = R0 + 64 * i, Rb = Epi::PERM ? ((Rr & ~31) + perm32(Rr & 31)) : Rr; voffB[i] = (unsigned)(Rb * S.ldb * Sched::esz + C0 * 2); }
    const size_t hstepB = (size_t)HALF * S.ldb * Sched::esz;
    const unsigned ldsw = (unsigned)wid * 1024u;
    const int aoff = FP8 ? lds_byte(wr * 64 + fr, fq * 16) : lds_byte(wr * 64 + fr, fq * 8), boff = FP8 ? lds_byte(wc * 32 + fr, fq * 16) : lds_byte(wc * 32 + fr, fq * 8);
    const unsigned mxscale = 0x7f7f7f7fu;
    const int kst = FP8 ? 16 : 1024;
    const char* Ab = S.Abase;
#define G8_SA(b, h) (((b) * 2 + (h)) * HTB)
#define G8_SB(b, h) ((4 + (b) * 2 + (h)) * HTB)
#define G8_STAGE_A(bufoff, offs, kb) do { _Pragma("unroll") for (int _i = 0; _i < 2; ++_i) \
        __builtin_amdgcn_global_load_lds((const unsigned*)(Ab + (size_t)(offs)[_i] + (size_t)(kb)), (LAS unsigned*)(lds + (bufoff) + ldsw + _i * 8192), 16, 0, 0); } while (0)
#define G8_STAGE_B(bufoff, gbase, kb) do { _Pragma("unroll") for (int _i = 0; _i < 2; ++_i) \
        __builtin_amdgcn_global_load_lds((const unsigned*)((gbase) + voffB[_i] + (size_t)(kb)), (LAS unsigned*)(lds + (bufoff) + ldsw + _i * 8192), 16, 0, 0); } while (0)
#define G8_LDA(dst, b, h) do { _Pragma("unroll") for (int m = 0; m < 4; ++m) { const i32x4_t _p = *(const LAS i32x4_t*)(lds + G8_SA(b, h) + aoff + m * 2048), _q = *(const LAS i32x4_t*)(lds + G8_SA(b, h) + aoff + m * 2048 + kst); dst[m] = __builtin_shufflevector(_p, _q, 0, 1, 2, 3, 4, 5, 6, 7); } } while (0)
#define G8_LDB(dst, b, h) do { _Pragma("unroll") for (int n = 0; n < 2; ++n) { const i32x4_t _p = *(const LAS i32x4_t*)(lds + G8_SB(b, h) + boff + n * 2048), _q = *(const LAS i32x4_t*)(lds + G8_SB(b, h) + boff + n * 2048 + kst); dst[n] = __builtin_shufflevector(_p, _q, 0, 1, 2, 3, 4, 5, 6, 7); } } while (0)
#define G8_MMA(ai, bj, At, Bt) do { __builtin_amdgcn_s_setprio(1); _Pragma("unroll") for (int m = 0; m < 4; ++m) _Pragma("unroll") for (int n = 0; n < 2; ++n) { \
        if constexpr (FP8) asm volatile("v_mfma_scale_f32_16x16x128_f8f6f4 %0, %1, %2, %0, %3, %3 op_sel_hi:[0,0,0]" : "+v"(acc[ai][bj][m][n]) : "v"(Bt[n]), "v"(At[m]), "v"(mxscale)); \
        else { acc[ai][bj][m][n] = __builtin_amdgcn_mfma_f32_16x16x32_bf16(__builtin_bit_cast(bf16x8, __builtin_shufflevector(Bt[n], Bt[n], 0, 1, 2, 3)), __builtin_bit_cast(bf16x8, __builtin_shufflevector(At[m], At[m], 0, 1, 2, 3)), acc[ai][bj][m][n], 0, 0, 0); \
               acc[ai][bj][m][n] = __builtin_amdgcn_mfma_f32_16x16x32_bf16(__builtin_bit_cast(bf16x8, __builtin_shufflevector(Bt[n], Bt[n], 4, 5, 6, 7)), __builtin_bit_cast(bf16x8, __builtin_shufflevector(At[m], At[m], 4, 5, 6, 7)), acc[ai][bj][m][n], 0, 0, 0); } } \
        __builtin_amdgcn_s_setprio(0); } while (0)
#define G8_WAIT_V(n) asm volatile("s_waitcnt vmcnt(" #n ")" ::: "memory")
#define G8_WAIT_L(n) asm volatile("s_waitcnt lgkmcnt(" #n ")" ::: "memory")
#define G8_BAR __builtin_amdgcn_s_barrier()
#define G8_SCHED __builtin_amdgcn_sched_barrier(0)
    UnitD cur, nxt; int ui = 0;
    if (!S.next(0, cur)) return;
    f32x4 acc[2][2][4][2];
#pragma unroll
    for (int a = 0; a < 2; ++a)
#pragma unroll
        for (int b = 0; b < 2; ++b)
#pragma unroll
            for (int m = 0; m < 4; ++m)
#pragma unroll
                for (int n = 0; n < 2; ++n) acc[a][b][m][n] = (f32x4){0.f, 0.f, 0.f, 0.f};
    typedef int i32x4_t __attribute__((ext_vector_type(4)));
    v8i_t At[4], B0[2], B1[2];
    unsigned cA[2][2];
    S.a_offs(cur, R0, C0, cA);
    const char* cB = cur.Bp;
    G8_STAGE_B(G8_SB(0, 0), cB, 0); G8_STAGE_A(G8_SA(0, 0), cA[0], 0); G8_STAGE_B(G8_SB(0, 1), cB + hstepB, 0); G8_STAGE_A(G8_SA(0, 1), cA[1], 0);
    if (wr == 1) G8_BAR;
    G8_WAIT_V(4); G8_BAR;
    G8_STAGE_B(G8_SB(1, 0), cB, 128); G8_STAGE_A(G8_SA(1, 0), cA[0], 128); G8_STAGE_B(G8_SB(1, 1), cB + hstepB, 128);
    G8_WAIT_V(6); G8_BAR;
    for (;;) {
        const bool has_next = S.next(ui + 1, nxt);
        const char* nB = has_next ? nxt.Bp : cB;
        for (int t = 0; t < nt; t += 2) {
            const bool last = (t == nt - 2);
            const unsigned k1 = (unsigned)(t + 1) * 128u;
            const unsigned k2 = last ? 0u : (unsigned)(t + 2) * 128u, k3 = k2 + 128u;
            unsigned c1[2] = {cA[1][0], cA[1][1]};
            if (last && has_next) S.a_offs(nxt, R0, C0, cA);
            const char* b2 = last ? nB : cB;
            G8_LDB(B0, 0, 0); G8_SCHED; G8_LDA(At, 0, 0); G8_STAGE_A(G8_SA(1, 1), c1, k1);
            G8_WAIT_L(8); G8_BAR; G8_WAIT_L(0); G8_MMA(0, 0, At, B0); G8_BAR; G8_SCHED;
            G8_LDB(B1, 0, 1); G8_STAGE_B(G8_SB(0, 0), b2, k2);
            G8_BAR; G8_WAIT_L(0); G8_MMA(0, 1, At, B1); G8_BAR;
            G8_LDA(At, 0, 1); G8_STAGE_A(G8_SA(0, 0), cA[0], k2);
            G8_BAR; G8_WAIT_L(0); G8_MMA(1, 0, At, B0); G8_BAR; G8_SCHED;
            G8_STAGE_B(G8_SB(0, 1), b2 + hstepB, k2);
            G8_WAIT_V(6); G8_BAR; G8_MMA(1, 1, At, B1); G8_BAR;
            G8_LDB(B0, 1, 0); G8_SCHED; G8_LDA(At, 1, 0); G8_STAGE_A(G8_SA(0, 1), cA[1], k2);
            G8_WAIT_L(8); G8_BAR; G8_WAIT_L(0); G8_MMA(0, 0, At, B0); G8_BAR; G8_SCHED;
            G8_LDB(B1, 1, 1); G8_STAGE_B(G8_SB(1, 0), b2, k3);
            G8_BAR; G8_WAIT_L(0); G8_MMA(0, 1, At, B1); G8_BAR;
            G8_LDA(At, 1, 1); G8_STAGE_A(G8_SA(1, 0), cA[0], k3);
            G8_BAR; G8_WAIT_L(0); G8_MMA(1, 0, At, B0); G8_BAR; G8_SCHED;
            G8_STAGE_B(G8_SB(1, 1), b2 + hstepB, k3);
            G8_WAIT_V(6); G8_BAR; G8_MMA(1, 1, At, B1); G8_BAR;
        }
        if constexpr (FP8) asm volatile("s_nop 15\n\ts_nop 15" ::: "memory");
        E(acc, cur, wr, wc, fr, fq);
        if (!has_next) break;
#pragma unroll
        for (int a = 0; a < 2; ++a)
#pragma unroll
            for (int b = 0; b < 2; ++b)
#pragma unroll
                for (int m = 0; m < 4; ++m)
#pragma unroll
                    for (int n = 0; n < 2; ++n) acc[a][b][m][n] = (f32x4){0.f, 0.f, 0.f, 0.f};
        cur = nxt; cB = nB; ++ui;
    }
    G8_WAIT_V(0);
    if (wr == 0) G8_BAR;
    G8_BAR;
#undef G8_SA
#undef G8_SB
#undef G8_STAGE_A
#undef G8_STAGE_B
#undef G8_LDA
#undef G8_LDB
#undef G8_MMA
#undef G8_WAIT_V
#undef G8_WAIT_L
#undef G8_BAR
#undef G8_SCHED
}
}
using g8::UnitD;
typedef f32x4 Acc[2][2][4][2];

struct EpiIn {
    static constexpr bool PERM = true;
    u16* H; const float* rs1; float* SSQ; float* WI;
    template <int ACT, bool DOSSQ> DI void run(const Acc& acc, const UnitD& u, int wr, int wc, int fr, int fq) const {
        const int pn = u.pn;
#pragma unroll
        for (int ai = 0; ai < 2; ++ai)
#pragma unroll
            for (int m = 0; m < 4; ++m) {
                const int row = u.pm * 256 + ai * 128 + wr * 64 + m * 16 + fr;
                const float rs = rs1[row];
#pragma unroll
                for (int bj = 0; bj < 2; ++bj) {
                    f32x4 v0 = acc[ai][bj][m][0] * rs, v1 = acc[ai][bj][m][1] * rs;
                    if (ACT == 1) {
#pragma unroll
                        for (int j = 0; j < 4; ++j) { v0[j] = fast_gelu(v0[j]); v1[j] = fast_gelu(v1[j]); }
                    } else if (ACT == 2) {
#pragma unroll
                        for (int j = 0; j < 4; ++j) { v0[j] = fast_sigmoid(v0[j]); v1[j] = fast_sigmoid(v1[j]); }
                    }
                    u32x4 w; w.x = pk2(v0[0], v0[1]); w.y = pk2(v0[2], v0[3]); w.z = pk2(v1[0], v1[1]); w.w = pk2(v1[2], v1[3]);
                    *(u32x4*)(H + (size_t)row * NIN + pn * 256 + bj * 128 + wc * 32 + 8 * fq) = w;
                    if (DOSSQ) {
                        float ssq = ((v0[0] * v0[0] + v0[1] * v0[1]) + (v0[2] * v0[2] + v0[3] * v0[3])) + ((v1[0] * v1[0] + v1[1] * v1[1]) + (v1[2] * v1[2] + v1[3] * v1[3]));
                        ssq += __shfl_xor(ssq, 16); ssq += __shfl_xor(ssq, 32);
                        if (fq == 0) SSQ[(size_t)row * 32 + (pn - 2) * 8 + bj * 4 + wc] = ssq;
                        if (pn == 5 && bj == 1 && wc == 2 && fq == 0) *(f32x4*)(WI + (size_t)row * 4) = v0 * 0.5f;
                    }
                }
            }
    }
    DI void operator()(const Acc& acc, const UnitD& u, int wr, int wc, int fr, int fq) const {
        const int pn = u.pn;
        if (pn < 2) run<1, false>(acc, u, wr, wc, fr, fq);
        else if (pn < 4) run<1, true>(acc, u, wr, wc, fr, fq);
        else if (pn < 6) run<0, true>(acc, u, wr, wc, fr, fq);
        else run<2, false>(acc, u, wr, wc, fr, fq);
    }
};
struct EpiQ {
    static constexpr bool PERM = true;
    u16* Q; u16* QI; const float* SSQ;
    DI void operator()(const Acc& acc, const UnitD& u, int wr, int wc, int fr, int fq) const {
#pragma unroll
        for (int ai = 0; ai < 2; ++ai)
#pragma unroll
            for (int m = 0; m < 4; ++m) {
                const int row = u.pm * 256 + ai * 128 + wr * 64 + m * 16 + fr;
                const f32x4 s0 = *(const f32x4*)(SSQ + (size_t)row * 32 + 16), s1 = *(const f32x4*)(SSQ + (size_t)row * 32 + 20);
                const float ss = ((s0[0] + s0[1]) + (s0[2] + s0[3])) + ((s1[0] + s1[1]) + (s1[2] + s1[3]));
                const float rs = __builtin_amdgcn_rsqf(ss * (1.0f / 256.0f) + EPS);
#pragma unroll
                for (int bj = 0; bj < 2; ++bj) {
                    const int col = u.pn * 256 + bj * 128 + wc * 32 + 8 * fq;
                    const f32x4 v0 = acc[ai][bj][m][0] * rs, v1 = acc[ai][bj][m][1] * rs;
                    if (col < 1024) { u32x4 w; w.x = pk2(v0[0], v0[1]); w.y = pk2(v0[2], v0[3]); w.z = pk2(v1[0], v1[1]); w.w = pk2(v1[2], v1[3]); *(u32x4*)(Q + (size_t)row * 1024 + col) = w; }
                    else { u32x2 w; w.x = pk4_i8(v0[0], v0[1], v0[2], v0[3]); w.y = pk4_i8(v1[0], v1[1], v1[2], v1[3]); *(u32x2*)((unsigned char*)QI + (size_t)row * 256 + (col - 1024)) = w; }
                }
            }
    }
};
template <int SECOND> struct EpiMrg {
    static constexpr bool PERM = true;
    u16* OUT; const u16* TMP; const u16* H;
    DI void operator()(const Acc& acc, const UnitD& u, int wr, int wc, int fr, int fq) const {
#pragma unroll
        for (int ai = 0; ai < 2; ++ai)
#pragma unroll
            for (int m = 0; m < 4; ++m) {
                const int row = u.pm * 256 + ai * 128 + wr * 64 + m * 16 + fr;
#pragma unroll
                for (int bj = 0; bj < 2; ++bj) {
                    const int col = u.pn * 256 + bj * 128 + wc * 32 + 8 * fq;
                    const u32x4 g = *(const u32x4*)(H + (size_t)row * NIN + 1536 + SECOND * 1024 + col);
                    f32x4 v0 = acc[ai][bj][m][0], v1 = acc[ai][bj][m][1];
                    v0[0] *= bflo(g.x); v0[1] *= bfhi(g.x); v0[2] *= bflo(g.y); v0[3] *= bfhi(g.y); v1[0] *= bflo(g.z); v1[1] *= bfhi(g.z); v1[2] *= bflo(g.w); v1[3] *= bfhi(g.w);
                    if (SECOND) { const u32x4 t = *(const u32x4*)(TMP + (size_t)row * 1024 + col);
                        v0[0] += bflo(t.x); v0[1] += bfhi(t.x); v0[2] += bflo(t.y); v0[3] += bfhi(t.y); v1[0] += bflo(t.z); v1[1] += bfhi(t.z); v1[2] += bflo(t.w); v1[3] += bfhi(t.w); }
                    u32x4 w; w.x = pk2(v0[0], v0[1]); w.y = pk2(v0[2], v0[3]); w.z = pk2(v1[0], v1[1]); w.w = pk2(v1[2], v1[3]);
                    *(u32x4*)(OUT + (size_t)row * 1024 + col) = w;
                }
            }
    }
};
struct EpiOut {
    static constexpr bool PERM = false;
    float* out; const float* x;
    DI void operator()(const Acc& acc, const UnitD& u, int wr, int wc, int fr, int fq) const {
#pragma unroll
        for (int ai = 0; ai < 2; ++ai)
#pragma unroll
            for (int m = 0; m < 4; ++m) {
                const int row = u.pm * 256 + ai * 128 + wr * 64 + m * 16 + fr;
#pragma unroll
                for (int bj = 0; bj < 2; ++bj)
#pragma unroll
                    for (int n = 0; n < 2; ++n) {
                        const size_t o = (size_t)row * 1024 + u.pn * 256 + bj * 128 + wc * 32 + n * 16 + 4 * fq;
                        *(f32x4*)(out + o) = *(const f32x4*)(x + o) + acc[ai][bj][m][n];
                    }
            }
    }
};

constexpr int MOE_TAB = g8::STAGE_BYTES;
DI void moe_table(LAS unsigned char* lds, const unsigned* CNT) {
    LAS int* tab = (LAS int*)(lds + MOE_TAB);
    __syncthreads();
    if (threadIdx.x == 0) { int acc = 0; for (int e = 0; e < NE; ++e) { const int c = (int)__hip_atomic_load(CNT + e, __ATOMIC_RELAXED, __HIP_MEMORY_SCOPE_AGENT); tab[e] = acc; tab[33 + e] = c; acc += (c + 255) >> 8; } tab[32] = acc; }
    __syncthreads();
}
template <int NPN, bool GATHER> struct MoeSched {
    const char* Abase; const char* Wbase; const int* LTOK; LAS const int* tab; int lda, ldb, K, G, c; size_t wstride; static constexpr int esz = 1;
    DI bool next(int i, UnitD& u) const {
        const long L = (long)i * G + c; const int R = tab[32];
        if (L >= (long)R * NPN) return false;
        const int rbg = (int)(L / NPN), pn = (int)(L % NPN);
        int e = 0;
        for (int j = 1; j < NE; ++j) e += (tab[j] <= rbg) ? 1 : 0;
        e = __builtin_amdgcn_readfirstlane(e);
        u.pm = rbg; u.pn = pn; u.e = e; u.rb = rbg - tab[e];
        u.Bp = Wbase + (size_t)e * wstride + (size_t)pn * 256 * ldb * esz;
        return true;
    }
    DI void a_offs(const UnitD& u, int R0, int C0, unsigned (&o)[2][2]) const {
        const int cnt = tab[33 + u.e];
#pragma unroll
        for (int h = 0; h < 2; ++h)
#pragma unroll
            for (int i = 0; i < 2; ++i) {
                const int r = h * 128 + R0 + 64 * i;
                if (GATHER) { const int slot = u.rb * 256 + r; const int tok = slot < cnt ? LTOK[(size_t)u.e * ECAP + slot] : 0; o[h][i] = (unsigned)((size_t)tok * lda * esz + C0 * 2); }
                else o[h][i] = (unsigned)((size_t)(u.pm * 256 + r) * lda * esz + C0 * 2);
            }
    }
};
struct EpiMoe1 {
    static constexpr bool PERM = true;
    unsigned char* ACT; const float* b1;
    DI void operator()(const Acc& acc, const UnitD& u, int wr, int wc, int fr, int fq) const {
        const float* be = b1 + (size_t)u.e * 2048;
        const int hc = u.pn * 128 + wc * 32 + 8 * fq;
        const f32x4 bg0 = *(const f32x4*)(be + hc), bg1 = *(const f32x4*)(be + hc + 4), bu0 = *(const f32x4*)(be + 1024 + hc), bu1 = *(const f32x4*)(be + 1024 + hc + 4);
#pragma unroll
        for (int ai = 0; ai < 2; ++ai)
#pragma unroll
            for (int m = 0; m < 4; ++m) {
                const int row = u.pm * 256 + ai * 128 + wr * 64 + m * 16 + fr;
                float av[8];
#pragma unroll
                for (int n = 0; n < 2; ++n) {
                    const f32x4 g = acc[ai][0][m][n] * 0.015625f + (n ? bg1 : bg0), up = acc[ai][1][m][n] * 0.015625f + (n ? bu1 : bu0);
#pragma unroll
                    for (int j = 0; j < 4; ++j) {
                        const float hg = fminf(g[j], 7.0f), hu = __builtin_amdgcn_fmed3f(up[j], -7.0f, 7.0f);
                        av[4 * n + j] = (hu + 1.0f) * (hg * __builtin_amdgcn_rcpf(1.0f + __builtin_amdgcn_exp2f(hg * -2.4554669595930157f)));
                    }
                }
                u32x2 w; w.x = pk4_fp8(av[0], av[1], av[2], av[3]); w.y = pk4_fp8(av[4], av[5], av[6], av[7]);
                *(u32x2*)(ACT + (size_t)row * 1024 + hc) = w;
            }
    }
};
struct EpiMoe2 {
    static constexpr bool PERM = true;
    u16* YB; const float* b2; const float* LGATE; LAS const int* tab;
    DI void operator()(const Acc& acc, const UnitD& u, int wr, int wc, int fr, int fq) const {
        const float* be = b2 + (size_t)u.e * 1024; const int cnt = tab[33 + u.e];
#pragma unroll
        for (int ai = 0; ai < 2; ++ai)
#pragma unroll
            for (int m = 0; m < 4; ++m) {
                const int r = ai * 128 + wr * 64 + m * 16 + fr, slot = u.rb * 256 + r;
                const float gate = slot < cnt ? LGATE[(size_t)u.e * ECAP + slot] : 0.f;
#pragma unroll
                for (int bj = 0; bj < 2; ++bj) {
                    const int col = u.pn * 256 + bj * 128 + wc * 32 + 8 * fq;
                    const f32x4 v0 = (acc[ai][bj][m][0] * 0.015625f + *(const f32x4*)(be + col)) * gate, v1 = (acc[ai][bj][m][1] * 0.015625f + *(const f32x4*)(be + col + 4)) * gate;
                    u32x4 w; w.x = pk2(v0[0], v0[1]); w.y = pk2(v0[2], v0[3]); w.z = pk2(v1[0], v1[1]); w.w = pk2(v1[2], v1[3]);
                    *(u32x4*)(YB + (size_t)(u.pm * 256 + r) * 1024 + col) = w;
                }
            }
    }
};

template <bool FP8 = false, class F> DI void tr_tile(LAS unsigned char* lds, const float* src, int ld_src, int Nsz, int k0, int n0, const float* sk, float mul, u16* dst, int ld_dst, F rowmap) {
    LAS float* t = (LAS float*)lds;
    const int tid = otid();
    __syncthreads();
#pragma unroll
    for (int it = 0; it < 2; ++it) {
        const int k = (tid >> 4) + 32 * it, n = 4 * (tid & 15);
        f32x4 v = {0.f, 0.f, 0.f, 0.f};
        if (n0 + n < Nsz) v = *(const f32x4*)(src + (size_t)(k0 + k) * ld_src + n0 + n);
        const float s = (sk ? sk[k0 + k] : 1.0f) * mul;
        t[k * 65 + n] = v[0] * s; t[k * 65 + n + 1] = v[1] * s; t[k * 65 + n + 2] = v[2] * s; t[k * 65 + n + 3] = v[3] * s;
    }
    __syncthreads();
    const int n = tid >> 3, kc = (tid & 7) * 8;
    if (FP8) {
        if (n0 + n < Nsz) {
            u32x2 w;
            w.x = pk4_fp8(t[(kc + 0) * 65 + n], t[(kc + 1) * 65 + n], t[(kc + 2) * 65 + n], t[(kc + 3) * 65 + n]);
            w.y = pk4_fp8(t[(kc + 4) * 65 + n], t[(kc + 5) * 65 + n], t[(kc + 6) * 65 + n], t[(kc + 7) * 65 + n]);
            *(u32x2*)((unsigned char*)dst + (size_t)rowmap(n0 + n) * ld_dst + k0 + kc) = w;
        }
    } else if (n0 + n < Nsz) {
        u32x4 w;
        w.x = pk2(t[(kc + 0) * 65 + n], t[(kc + 1) * 65 + n]); w.y = pk2(t[(kc + 2) * 65 + n], t[(kc + 3) * 65 + n]);
        w.z = pk2(t[(kc + 4) * 65 + n], t[(kc + 5) * 65 + n]); w.w = pk2(t[(kc + 6) * 65 + n], t[(kc + 7) * 65 + n]);
        *(u32x4*)(dst + (size_t)rowmap(n0 + n) * ld_dst + k0 + kc) = w;
    }
}
struct MapId { DI int operator()(int n) const { return n; } };
struct MapIn { DI int operator()(int n) const { return n < 1476 ? n : n + 60; } };
struct MapE1 { DI int operator()(int n) const { const int hi = n >= 1024 ? 1 : 0, q = n - hi * 1024; return (q >> 7) * 256 + hi * 128 + (q & 127); } };

DI void phase0(const Args& a, LAS unsigned char* lds) {
    unsigned char* ws = a.ws;
    const int tid = otid();
    const size_t gtid = (size_t)blockIdx.x * NT + tid, gstride = (size_t)gridDim.x * NT;
    for (size_t i = gtid; i < 60 * 1024 / 2; i += gstride) ((unsigned*)(ws + WS_WIN + (size_t)1476 * 1024 * 2))[i] = 0u;
    for (size_t i = gtid; i < 32 * 1024; i += gstride) { const int e = (int)(i >> 10), k = (int)(i & 1023); const float w = a.in[I_WR][k * 32 + e] * a.in[I_N2G][k]; const u16 h = f2bf(w); ((u16*)(ws + WS_WR))[i] = h; ((u16*)(ws + WS_WR))[32 * 1024 + i] = f2bf(w - bf2f(h)); }
    for (size_t i = gtid; i < 4 * 128 * 128; i += gstride) { const int tt = (int)((i >> 7) & 127), ss = (int)(i & 127); ((u16*)(ws + WS_WSP))[i] = f2bf(ss <= tt ? a.in[I_WSP][i] : 0.f); }
    {
        const int wid = tid >> 6, lane = tid & 63;
        for (int row = blockIdx.x * 8 + wid; row < T; row += gridDim.x * 8) {
            const float* xr = a.in[I_X] + (size_t)row * 1024; u16* xb = (u16*)(ws + WS_XB) + (size_t)row * 1024;
            float ss = 0.f;
#pragma unroll
            for (int i = 0; i < 4; ++i) {
                const f32x4 v = *(const f32x4*)(xr + i * 256 + lane * 4);
                ss += (v[0] * v[0] + v[1] * v[1]) + (v[2] * v[2] + v[3] * v[3]);
                u32x2 w; w.x = pk2(v[0], v[1]); w.y = pk2(v[2], v[3]);
                *(u32x2*)(xb + i * 256 + lane * 4) = w;
            }
#pragma unroll
            for (int o = 32; o >= 1; o >>= 1) ss += __shfl_xor(ss, o);
            if (lane == 0) ((float*)(ws + WS_RS1))[row] = __builtin_amdgcn_rsqf(ss * (1.0f / 1024.0f) + EPS);
        }
    }
    constexpr int U_IN = 16 * 56, U_UQ = 4 * 16, U_QI = 4 * 4, U_PA = 8 * 16, U_OUT = 16 * 16, U_E1 = 32 * 16 * 32, U_E2 = 32 * 16 * 16, U_CB = 64;
    constexpr int U_TOT = U_IN + U_UQ + U_QI + U_PA + U_OUT + U_E1 + U_E2 + U_CB;
    for (int u = blockIdx.x; u < U_TOT; u += gridDim.x) {
        int v = u;
        if (v < U_IN) { tr_tile(lds, a.in[I_WIN], 3524, 3524, (v & 15) * 64, (v >> 4) * 64, a.in[I_N1G], 1.0f, (u16*)(ws + WS_WIN), 1024, MapIn()); continue; }
        v -= U_IN;
        if (v < U_UQ) { tr_tile(lds, a.in[I_WUQ], 1024, 1024, (v & 3) * 64, (v >> 2) * 64, a.in[I_QLG], 1.0f, (u16*)(ws + WS_WQ), 256, MapId()); continue; }
        v -= U_UQ;
        if (v < U_QI) { tr_tile(lds, a.in[I_WQI], 256, 256, (v & 3) * 64, (v >> 2) * 64, a.in[I_QLG], 1.0f, (u16*)(ws + WS_WQ) + 1024 * 256, 256, MapId()); continue; }
        v -= U_QI;
        if (v < U_PA) { tr_tile(lds, a.in[I_WPA], 1024, 1024, (v & 7) * 64, (v >> 3) * 64, nullptr, 1.0f, (u16*)(ws + WS_WCAT), 1536, MapId()); continue; }
        v -= U_PA;
        if (v < U_OUT) { tr_tile(lds, a.in[I_WOUT], 1024, 1024, (v & 15) * 64, (v >> 4) * 64, nullptr, 1.0f, (u16*)(ws + WS_WOUT), 1024, MapId()); continue; }
        v -= U_OUT;
        if (v < U_E1) { const int e = v >> 9, w = v & 511; tr_tile<true>(lds, a.in[I_WE1] + (size_t)e * 1024 * 2048, 2048, 2048, (w & 15) * 64, (w >> 4) * 64, a.in[I_N2G], 64.0f, (u16*)(ws + WS_WE1 + (size_t)e * 2048 * 1024), 1024, MapE1()); continue; }
        v -= U_E1;
        if (v < U_E2) { const int e = v >> 8, w = v & 255; tr_tile<true>(lds, a.in[I_WE2] + (size_t)e * 1024 * 1024, 1024, 1024, (w & 15) * 64, (w >> 4) * 64, nullptr, 64.0f, (u16*)(ws + WS_WE2 + (size_t)e * 1024 * 1024), 1024, MapId()); continue; }
        v -= U_E2;
        {
            const int h = v >> 3, c0 = (v & 7) * 16;
            LAS float* t = (LAS float*)lds;
            __syncthreads();
            for (int i = tid; i < 1024; i += NT) t[i] = a.in[I_WUV][(size_t)h * 128 * 64 + (size_t)c0 * 64 + i];
            __syncthreads();
            for (int nn = tid; nn < 1024; nn += NT) {
                float accv[16];
#pragma unroll
                for (int i = 0; i < 16; ++i) accv[i] = 0.f;
                for (int vv = 0; vv < 64; ++vv) {
                    const float pb = a.in[I_WPB][(size_t)(h * 64 + vv) * 1024 + nn];
#pragma unroll
                    for (int i = 0; i < 16; ++i) accv[i] += t[i * 64 + vv] * pb;
                }
                u32x4 w0, w1;
                w0.x = pk2(accv[0], accv[1]); w0.y = pk2(accv[2], accv[3]); w0.z = pk2(accv[4], accv[5]); w0.w = pk2(accv[6], accv[7]);
                w1.x = pk2(accv[8], accv[9]); w1.y = pk2(accv[10], accv[11]); w1.z = pk2(accv[12], accv[13]); w1.w = pk2(accv[14], accv[15]);
                u16* d = (u16*)(ws + WS_WCAT) + (size_t)nn * 1536 + 512 + h * 128 + c0;
                *(u32x4*)d = w0; *(u32x4*)(d + 8) = w1;
            }
        }
    }
}

DI void gmlp_unit(const Args& a, LAS unsigned char* lds, int u) {
    unsigned char* ws = a.ws;
    const int tid = otid(), wid = tid >> 6, lane = tid & 63, fr = lane & 15, fq = lane >> 4;
    const int g = u & 3, row0 = (u >> 2) * 128;
    const u16* H = (const u16*)(ws + WS_H);
    LAS u16* img = (LAS u16*)lds;
    __syncthreads();
    {
        const int s = tid & 127, cset = tid >> 7;
        const f32x4 sq = *(const f32x4*)((const float*)(ws + WS_SSQ) + (size_t)(row0 + s) * 32 + g * 4);
        const float rs = __builtin_amdgcn_rsqf(((sq[0] + sq[1]) + (sq[2] + sq[3])) * (1.0f / 128.0f) + EPS);
#pragma unroll
        for (int it = 0; it < 4; ++it) {
            const int c = cset + 4 * it;
            const u32x4 raw = *(const u32x4*)(H + (size_t)(row0 + s) * NIN + 512 + g * 128 + 8 * c);
            const float* vg = a.in[I_VG] + 8 * c;
            float f[8] = {bflo(raw.x), bfhi(raw.x), bflo(raw.y), bfhi(raw.y), bflo(raw.z), bfhi(raw.z), bflo(raw.w), bfhi(raw.w)};
#pragma unroll
            for (int i = 0; i < 8; ++i) img[(8 * c + i) * 136 + s] = f2bf(f[i] * rs * vg[i]);
        }
    }
    __syncthreads();
    const u16* W = (const u16*)(ws + WS_WSP) + (size_t)g * 128 * 128 + (size_t)(16 * wid + fr) * 128;
    f32x4 acc[8];
#pragma unroll
    for (int i = 0; i < 8; ++i) acc[i] = (f32x4){0.f, 0.f, 0.f, 0.f};
    const int nks = (16 * wid + 15) / 32 + 1;
    for (int ks = 0; ks < nks; ++ks) {
        const bf16x8 bw = *(const bf16x8*)(W + ks * 32 + 8 * fq);
#pragma unroll
        for (int i = 0; i < 8; ++i) {
            const bf16x8 av = *(const LAS bf16x8*)(img + (16 * i + fr) * 136 + ks * 32 + 8 * fq);
            acc[i] = __builtin_amdgcn_mfma_f32_16x16x32_bf16(av, bw, acc[i], 0, 0, 0);
        }
    }
    const int t = 16 * wid + fr;
    const float bias = a.in[I_BSP][g * 128 + t];
    u16* YO = (u16*)(ws + WS_YO);
#pragma unroll
    for (int i = 0; i < 8; ++i) {
        const int d = 16 * i + 4 * fq;
        const u32x2 uu = *(const u32x2*)(H + (size_t)(row0 + t) * NIN + g * 128 + d);
        const float y0 = bflo(uu.x) * (acc[i][0] + bias), y1 = bfhi(uu.x) * (acc[i][1] + bias), y2 = bflo(uu.y) * (acc[i][2] + bias), y3 = bfhi(uu.y) * (acc[i][3] + bias);
        u32x2 w; w.x = pk2(y0, y1); w.y = pk2(y2, y3);
        *(u32x2*)(YO + (size_t)(row0 + t) * 1536 + g * 128 + d) = w;
    }
}

DI void kvnorm(const Args& a) {
    unsigned char* ws = a.ws;
    const u16* H = (const u16*)(ws + WS_H); const float* SSQ = (const float*)(ws + WS_SSQ);
    const size_t gtid = (size_t)blockIdx.x * NT + otid(), gstride = (size_t)gridDim.x * NT;
    for (size_t idx = gtid; idx < (size_t)T * 24; idx += gstride) {
        const int row = (int)(idx / 24), c = (int)(idx % 24);
        const u16* src; u16* dst; const float* gain; float rs;
        if (c < 16) {
            const f32x4 sq = *(const f32x4*)(SSQ + (size_t)row * 32 + 24);
            rs = __builtin_amdgcn_rsqf(((sq[0] + sq[1]) + (sq[2] + sq[3])) * (1.0f / 128.0f) + EPS);
            src = H + (size_t)row * NIN + 1280 + 8 * c; dst = (u16*)(ws + WS_KVN) + (size_t)row * 128 + 8 * c; gain = a.in[I_KVG] + 8 * c;
        } else {
            const int cc = c - 16;
            rs = __builtin_amdgcn_rsqf((SSQ[(size_t)row * 32 + 28] + SSQ[(size_t)row * 32 + 29]) * (1.0f / 64.0f) + EPS);
            src = H + (size_t)row * NIN + 1408 + 8 * cc; dst = nullptr; gain = a.in[I_KIG] + 8 * cc;
            const u32x4 raw = *(const u32x4*)src;
            u32x2 w8;
            w8.x = pk4_i8(bflo(raw.x) * rs * gain[0], bfhi(raw.x) * rs * gain[1], bflo(raw.y) * rs * gain[2], bfhi(raw.y) * rs * gain[3]);
            w8.y = pk4_i8(bflo(raw.z) * rs * gain[4], bfhi(raw.z) * rs * gain[5], bflo(raw.w) * rs * gain[6], bfhi(raw.w) * rs * gain[7]);
            *(u32x2*)(ws + WS_KIN + (size_t)row * 64 + 8 * cc) = w8;
            continue;
        }
        const u32x4 raw = *(const u32x4*)src;
        u32x4 w;
        w.x = pk2(bflo(raw.x) * rs * gain[0], bfhi(raw.x) * rs * gain[1]); w.y = pk2(bflo(raw.y) * rs * gain[2], bfhi(raw.y) * rs * gain[3]);
        w.z = pk2(bflo(raw.z) * rs * gain[4], bfhi(raw.z) * rs * gain[5]); w.w = pk2(bflo(raw.w) * rs * gain[6], bfhi(raw.w) * rs * gain[7]);
        *(u32x4*)dst = w;
    }
}

constexpr int P3_ROWS = 0, P3_HIST = 131072, P3_LIST = 147456;
DI unsigned f2key(float f) { const unsigned u = __float_as_uint(f); return (u & 0x80000000u) ? ~u : (u | 0x80000000u); }
DI int wave_incl_scan(int v, int lane) {
#pragma unroll
    for (int o = 1; o < 64; o <<= 1) { const int t = __shfl_up(v, o); if (lane >= o) v += t; }
    return v;
}
DI int wave_suffix_scan(int v, int lane) {
#pragma unroll
    for (int o = 1; o < 64; o <<= 1) { const int t = __shfl_down(v, o); if (lane + o < 64) v += t; }
    return v;
}
DI unsigned pk_gt(unsigned kw, unsigned xw, unsigned one) {
    unsigned d, m;
    asm("v_pk_sub_u16 %0, %1, %2 clamp" : "=v"(d) : "v"(kw), "v"(xw));
    asm("v_pk_min_u16 %0, %1, %2" : "=v"(m) : "v"(d), "v"(one));
    return m;
}
DI unsigned pk_subs(unsigned kw, unsigned xw) { unsigned d; asm("v_pk_sub_u16 %0, %1, %2 clamp" : "=v"(d) : "v"(kw), "v"(xw)); return d; }
DI unsigned pk_min1(unsigned d, unsigned one) { unsigned m; asm("v_pk_min_u16 %0, %1, %2" : "=v"(m) : "v"(d), "v"(one)); return m; }
DI unsigned pk_add(unsigned a, unsigned b) { unsigned r; asm("v_pk_add_u16 %0, %1, %2" : "=v"(r) : "v"(a), "v"(b)); return r; }
DI int wave_sum(int v) {
    v += __builtin_amdgcn_update_dpp(0, v, 0xB1, 0xf, 0xf, false);
    v += __builtin_amdgcn_update_dpp(0, v, 0x4E, 0xf, 0xf, false);
    v += __builtin_amdgcn_update_dpp(0, v, 0x141, 0xf, 0xf, false);
    v += __builtin_amdgcn_update_dpp(0, v, 0x140, 0xf, 0xf, false);
    return __builtin_amdgcn_readlane(v, 0) + __builtin_amdgcn_readlane(v, 16) + __builtin_amdgcn_readlane(v, 32) + __builtin_amdgcn_readlane(v, 48);
}
DI int rowaddr(int p) { return (p & ~511) | ((p & 63) << 3) | ((p >> 6) & 7); }
typedef unsigned short us2_t __attribute__((ext_vector_type(2)));
DI unsigned dot2acc(unsigned flags, unsigned wts, unsigned acc) { return __builtin_amdgcn_udot2(__builtin_bit_cast(us2_t, flags), __builtin_bit_cast(us2_t, wts), acc, false); }
DI void select_top16(LAS u16* row, LAS u16* list, int N, int lane) {
    const int Nup = (N + 511) & ~511, niter = Nup >> 9;
    for (int p = N + lane; p < Nup; p += 64) row[rowaddr(p)] = (u16)0;
    wave_lds_sync();
    u32x4 kr[16];
#pragma unroll
    for (int i = 0; i < 16; ++i) { kr[i] = (u32x4){0u, 0u, 0u, 0u}; if (i < niter) kr[i] = *(LAS const u32x4*)(row + i * 512 + lane * 8); }
    const unsigned one = 0x00010001u;
    auto count_gt = [&](unsigned x) -> int {
        const unsigned xw = x | (x << 16);
        unsigned acc = 0u, acc1 = 0u, acc2 = 0u, acc3 = 0u;
#pragma unroll
        for (int c = 0; c < 4; ++c) {
            if (4 * c < niter) {
                unsigned d[16];
#pragma unroll
                for (int i = 0; i < 4; ++i) { d[4 * i] = pk_subs(kr[4 * c + i].x, xw); d[4 * i + 1] = pk_subs(kr[4 * c + i].y, xw); d[4 * i + 2] = pk_subs(kr[4 * c + i].z, xw); d[4 * i + 3] = pk_subs(kr[4 * c + i].w, xw); }
#pragma unroll
                for (int i = 0; i < 16; ++i) d[i] = pk_min1(d[i], one);
#pragma unroll
                for (int i = 0; i < 16; i += 4) { acc = dot2acc(d[i], one, acc); acc1 = dot2acc(d[i + 1], one, acc1); acc2 = dot2acc(d[i + 2], one, acc2); acc3 = dot2acc(d[i + 3], one, acc3); }
            }
        }
        return wave_sum((int)((acc + acc1) + (acc2 + acc3)));
    };
    unsigned T = 0u; int cge = Nup;
#pragma unroll 1
    for (int bit = 15; bit >= 0; --bit) {
        const unsigned cand = T | (1u << bit);
        const int cnt = count_gt(cand - 1u);
        if (cnt >= 256) { T = cand; cge = cnt; }
    }
    auto build = [&](unsigned x, unsigned (&M)[4]) {
        const unsigned xw = x | (x << 16);
#pragma unroll
        for (int c = 0; c < 4; ++c) {
            M[c] = 0u;
            if (4 * c < niter) {
#pragma unroll
                for (int i = 4 * c; i < 4 * c + 4; ++i) {
                    unsigned byte = dot2acc(pk_gt(kr[i].x, xw, one), 0x00020001u, 0u);
                    byte = dot2acc(pk_gt(kr[i].y, xw, one), 0x00080004u, byte);
                    byte = dot2acc(pk_gt(kr[i].z, xw, one), 0x00200010u, byte);
                    byte = dot2acc(pk_gt(kr[i].w, xw, one), 0x00800040u, byte);
                    M[c] |= byte << (8 * (i & 3));
                }
            }
        }
    };
    unsigned M[4];
    build(T - 1u, M);
    if (cge != 256) {
        unsigned G[4]; build(T, G);
        unsigned E[4];
#pragma unroll
        for (int c = 0; c < 4; ++c) E[c] = M[c] & ~G[c];
        const int need = 256 - (cge - wave_sum((int)(__builtin_popcount(E[0]) + __builtin_popcount(E[1]) + __builtin_popcount(E[2]) + __builtin_popcount(E[3]))));
        auto below = [&](int B, int c) -> unsigned { const int nb = B - 32 * c; return nb <= 0 ? 0u : (nb >= 32 ? 0xffffffffu : ((1u << nb) - 1u)); };
        auto ties_below = [&](int B) -> int {
            return wave_sum((int)(__builtin_popcount(E[0] & below(B, 0)) + __builtin_popcount(E[1] & below(B, 1)) + __builtin_popcount(E[2] & below(B, 2)) + __builtin_popcount(E[3] & below(B, 3))));
        };
        int lo = 0, hi = 127;
#pragma unroll 1
        while (lo < hi) { const int mid = (lo + hi) >> 1; if (ties_below(mid + 1) >= need) hi = mid; else lo = mid + 1; }
        const int Bs = lo, r = need - ties_below(Bs);
        const unsigned ew = Bs < 32 ? E[0] : (Bs < 64 ? E[1] : (Bs < 96 ? E[2] : E[3]));
        const bool tb = ((ew >> (Bs & 31)) & 1u) != 0u;
        const unsigned long long em = __ballot(tb);
        const bool take_row = tb && __builtin_popcountll(em & ((1ull << lane) - 1ull)) < r;
#pragma unroll
        for (int c = 0; c < 4; ++c) {
            unsigned tk = E[c] & below(Bs, c);
            if ((Bs >> 5) == c && take_row) tk |= 1u << (Bs & 31);
            M[c] = G[c] | tk;
        }
    }
    const int kl = __builtin_popcount(M[0]) + __builtin_popcount(M[1]) + __builtin_popcount(M[2]) + __builtin_popcount(M[3]);
    int wp = wave_incl_scan(kl, lane) - kl;
#pragma unroll
    for (int c = 0; c < 4; ++c) {
        unsigned m = M[c];
        while (m) { const int b = __builtin_ctz(m); list[wp] = (u16)((32 * c + b) * 64 + lane); ++wp; m &= m - 1u; }
    }
}

DI void dsa_phase(const Args& a, LAS unsigned char* lds) {
    unsigned char* ws = a.ws;
    const int tid = otid(), wid = __builtin_amdgcn_readfirstlane(tid >> 6), lane = tid & 63, fr = lane & 15, fq = lane >> 4;
    const unsigned char* QI = (const unsigned char*)(ws + WS_QI); const unsigned char* KIN = (const unsigned char*)(ws + WS_KIN); const u16* KVN = (const u16*)(ws + WS_KVN);
    const u16* Q = (const u16*)(ws + WS_Q); const float* WI = (const float*)(ws + WS_WI); u16* YO = (u16*)(ws + WS_YO);
    LAS u16* rows = (LAS u16*)(lds + P3_ROWS);
    for (int gi = blockIdx.x; gi < T / 8; gi += gridDim.x) {
        const int b = gi & 3, t0 = S - 8 - 8 * (gi >> 2);
        const size_t brow = (size_t)b * S;
        const int ntile = (t0 + 8 + 15) >> 4;
        __syncthreads();
        {
            typedef int i32x4_t __attribute__((ext_vector_type(4)));
            i32x4_t qa[2]; f32x4 wi[2];
#pragma unroll
            for (int rg = 0; rg < 2; ++rg) {
                qa[rg] = *(const i32x4_t*)(QI + (brow + t0 + 4 * rg + (fr >> 2)) * 256 + (fr & 3) * 64 + 16 * fq);
                wi[rg] = *(const f32x4*)(WI + (brow + t0 + 4 * rg + fq) * 4);
            }
            auto ldk = [&](i32x4_t (&kf)[4], int jt0) {
#pragma unroll
                for (int u = 0; u < 4; ++u) {
                    const int jt = (jt0 + 8 * u) < ntile ? (jt0 + 8 * u) : (ntile - 1);
                    kf[u] = *(const i32x4_t*)(KIN + (brow + jt * 16 + fr) * 64 + 16 * fq);
                }
            };
            auto cmpk = [&](const i32x4_t (&kf)[4], int jt0) {
#pragma unroll
                for (int u = 0; u < 4; ++u) {
                    const int jt = jt0 + 8 * u;
                    if (jt < ntile) {
#pragma unroll
                        for (int rg = 0; rg < 2; ++rg) {
                            i32x4_t d = {0, 0, 0, 0};
                            d = __builtin_amdgcn_mfma_i32_16x16x64_i8(qa[rg], kf[u], d, 0, 0, 0);
                            const float sc = (((float)max(d[0], 0) * wi[rg][0] + (float)max(d[1], 0) * wi[rg][1]) + (float)max(d[2], 0) * wi[rg][2]) + (float)max(d[3], 0) * wi[rg][3];
                            rows[(4 * rg + fq) * 8192 + rowaddr(jt * 16 + fr)] = (u16)(f2key(sc) >> 16);
                        }
                    }
                }
            };
            i32x4_t kA[4], kB[4];
            if (wid < ntile) ldk(kA, wid);
            for (int jt0 = wid; jt0 < ntile; jt0 += 64) {
                const bool hasB = jt0 + 32 < ntile;
                if (hasB) ldk(kB, jt0 + 32);
                cmpk(kA, jt0);
                if (hasB) { if (jt0 + 64 < ntile) ldk(kA, jt0 + 64); cmpk(kB, jt0 + 32); }
            }
        }
        __syncthreads();
        {
            const int q = wid, t = t0 + q, N = t + 1;
            LAS u16* row = rows + q * 8192;
            LAS u16* list = (LAS u16*)(lds + P3_LIST + q * 512);
            int cnt;
            if (N <= 256) { for (int p = lane; p < 256; p += 64) list[p] = p < N ? (u16)p : (u16)0; cnt = N; }
            else { select_top16(row, list, N, lane); cnt = 256; }
            wave_lds_sync();
            bf16x8 qf[4];
            {
                const int head = fr & 7;
                const u16* qrow = Q + (brow + t) * 1024 + head * 128;
                float f[4][8]; float ss = 0.f;
#pragma unroll
                for (int ks = 0; ks < 4; ++ks) {
                    const u32x4 raw = *(const u32x4*)(qrow + ks * 32 + 8 * fq);
                    f[ks][0] = bflo(raw.x); f[ks][1] = bfhi(raw.x); f[ks][2] = bflo(raw.y); f[ks][3] = bfhi(raw.y); f[ks][4] = bflo(raw.z); f[ks][5] = bfhi(raw.z); f[ks][6] = bflo(raw.w); f[ks][7] = bfhi(raw.w);
#pragma unroll
                    for (int j = 0; j < 8; ++j) ss += f[ks][j] * f[ks][j];
                }
                ss += __shfl_xor(ss, 16); ss += __shfl_xor(ss, 32);
                const float rq = __builtin_amdgcn_rsqf(ss * (1.0f / 128.0f) + EPS) * 0.08838834764831845f;
#pragma unroll
                for (int ks = 0; ks < 4; ++ks) {
                    const float* qg = a.in[I_QNG] + ks * 32 + 8 * fq;
                    u32x4 w;
                    w.x = pk2(f[ks][0] * rq * qg[0], f[ks][1] * rq * qg[1]); w.y = pk2(f[ks][2] * rq * qg[2], f[ks][3] * rq * qg[3]);
                    w.z = pk2(f[ks][4] * rq * qg[4], f[ks][5] * rq * qg[5]); w.w = pk2(f[ks][6] * rq * qg[6], f[ks][7] * rq * qg[7]);
                    qf[ks] = __builtin_bit_cast(bf16x8, w);
                }
            }
            LAS unsigned char* img = (LAS unsigned char*)row;
            const int nsteps = (cnt + 31) >> 5;
            f32x4 oacc[8];
#pragma unroll
            for (int i = 0; i < 8; ++i) oacc[i] = (f32x4){0.f, 0.f, 0.f, 0.f};
            float mrun = -3.0e38f, lpart = 0.f;
            auto issue = [&](u32x4 (&pf)[8], int pp) {
#pragma unroll
                for (int it = 0; it < 8; ++it) { const int piece = it * 64 + lane; const unsigned key = list[pp * 32 + (piece >> 4)]; pf[it] = *(const u32x4*)(KVN + (brow + key) * 128 + 8 * (piece & 15)); }
            };
            auto step = [&](u32x4 (&pf)[8], int pp) {
#pragma unroll
                for (int it = 0; it < 8; ++it) { const int piece = it * 64 + lane; *(LAS u32x4*)(img + (piece >> 4) * 288 + (piece & 15) * 16) = pf[it]; }
                if (pp + 1 < nsteps) issue(pf, pp + 1);
                wave_lds_sync();
                __builtin_amdgcn_sched_barrier(0);
                f32x4 sa = {0.f, 0.f, 0.f, 0.f}, sb = {0.f, 0.f, 0.f, 0.f};
#pragma unroll
                for (int ks = 0; ks < 4; ++ks) {
                    const bf16x8 a0 = *(LAS const bf16x8*)(img + fr * 288 + (ks * 32 + 8 * fq) * 2), a1 = *(LAS const bf16x8*)(img + (16 + fr) * 288 + (ks * 32 + 8 * fq) * 2);
                    sa = __builtin_amdgcn_mfma_f32_16x16x32_bf16(a0, qf[ks], sa, 0, 0, 0); sb = __builtin_amdgcn_mfma_f32_16x16x32_bf16(a1, qf[ks], sb, 0, 0, 0);
                }
                const int pb0 = pp * 32 + 4 * fq;
#pragma unroll
                for (int r = 0; r < 4; ++r) { if (pb0 + r >= cnt) sa[r] = -3.0e38f; if (pb0 + 16 + r >= cnt) sb[r] = -3.0e38f; }
                float mx = fmaxf(fmaxf(fmaxf(sa[0], sa[1]), fmaxf(sa[2], sa[3])), fmaxf(fmaxf(sb[0], sb[1]), fmaxf(sb[2], sb[3])));
                mx = fmaxf(mx, __shfl_xor(mx, 16)); mx = fmaxf(mx, __shfl_xor(mx, 32));
                const float mnew = fmaxf(mrun, mx), alpha = __expf(mrun - mnew);
                mrun = mnew;
                float ps = 0.f;
#pragma unroll
                for (int r = 0; r < 4; ++r) { sa[r] = __expf(sa[r] - mnew); sb[r] = __expf(sb[r] - mnew); ps += sa[r] + sb[r]; }
                lpart = lpart * alpha + ps;
#pragma unroll
                for (int cb = 0; cb < 8; ++cb) oacc[cb] *= alpha;
                u32x4 pw; pw.x = pk2(sa[0], sa[1]); pw.y = pk2(sa[2], sa[3]); pw.z = pk2(sb[0], sb[1]); pw.w = pk2(sb[2], sb[3]);
                const bf16x8 pb = __builtin_bit_cast(bf16x8, pw);
#pragma unroll
                for (int cb = 0; cb < 8; ++cb) {
                    const s16x4 r0 = __builtin_amdgcn_ds_read_tr16_b64_v4i16((LAS s16x4*)(img + (4 * fq + (fr >> 2)) * 288 + (cb * 16 + 4 * (fr & 3)) * 2));
                    const s16x4 r1 = __builtin_amdgcn_ds_read_tr16_b64_v4i16((LAS s16x4*)(img + (16 + 4 * fq + (fr >> 2)) * 288 + (cb * 16 + 4 * (fr & 3)) * 2));
                    const bf16x8 av = {r0[0], r0[1], r0[2], r0[3], r1[0], r1[1], r1[2], r1[3]};
                    oacc[cb] = __builtin_amdgcn_mfma_f32_16x16x32_bf16(av, pb, oacc[cb], 0, 0, 0);
                    if (cb == 3) __builtin_amdgcn_sched_barrier(0);
                }
                wave_lds_sync();
            };
            u32x4 pf0[8];
            issue(pf0, 0);
#pragma unroll 1
            for (int pp = 0; pp < nsteps; ++pp) step(pf0, pp);
            float lsum = lpart; lsum += __shfl_xor(lsum, 16); lsum += __shfl_xor(lsum, 32);
            const float inv = __builtin_amdgcn_rcpf(lsum);
            if (fr < 8) {
                u16* orow = YO + (brow + t) * 1536 + 512 + fr * 128 + 4 * fq;
#pragma unroll
                for (int cb = 0; cb < 8; ++cb) { u32x2 w; w.x = pk2(oacc[cb][0] * inv, oacc[cb][1] * inv); w.y = pk2(oacc[cb][2] * inv, oacc[cb][3] * inv); *(u32x2*)(orow + cb * 16) = w; }
            }
        }
    }
}

constexpr int P6_LCNT = 0, P6_BASE = 128, P6_RSB = 256, P6_RI = 1024;
DI unsigned dpp_max_u32(unsigned v) {
    v = max(v, (unsigned)__builtin_amdgcn_update_dpp(0, (int)v, 0xB1, 0xf, 0xf, false));
    v = max(v, (unsigned)__builtin_amdgcn_update_dpp(0, (int)v, 0x4E, 0xf, 0xf, false));
    v = max(v, (unsigned)__builtin_amdgcn_update_dpp(0, (int)v, 0x141, 0xf, 0xf, false));
    v = max(v, (unsigned)__builtin_amdgcn_update_dpp(0, (int)v, 0x140, 0xf, 0xf, false));
    return v;
}
DI float key2f(unsigned k) { return __uint_as_float((k & 0x80000000u) ? (k & 0x7fffffffu) : ~k); }
DI void router_phase(const Args& a, LAS unsigned char* lds) {
    unsigned char* ws = a.ws;
    const int tid = otid(), wid = tid >> 6, lane = tid & 63, fr = lane & 15, fq = lane >> 4;
    LAS int* lcnt = (LAS int*)(lds + P6_LCNT); LAS int* lbase = (LAS int*)(lds + P6_BASE); LAS float* rsb = (LAS float*)(lds + P6_RSB); LAS int* RI = (LAS int*)(lds + P6_RI);
    const u16* WRH = (const u16*)(ws + WS_WR); const u16* WRL = WRH + 32 * 1024;
    unsigned* CNT = (unsigned*)(ws + WS_CTL);
    for (int rg = blockIdx.x; rg < T / 128; rg += gridDim.x) {
        __syncthreads();
        if (tid < 32) lcnt[tid] = 0;
        __syncthreads();
        {
            const int row = rg * 128 + wid * 16 + fr;
            const float* xr = a.out + (size_t)row * 1024 + 8 * fq;
            f32x4 acc[2] = {{0.f, 0.f, 0.f, 0.f}, {0.f, 0.f, 0.f, 0.f}};
            float ss = 0.f;
#pragma unroll 4
            for (int ks = 0; ks < 32; ++ks) {
                const f32x4 x0 = *(const f32x4*)(xr + ks * 32), x1 = *(const f32x4*)(xr + ks * 32 + 4);
                ss += ((x0[0] * x0[0] + x0[1] * x0[1]) + (x0[2] * x0[2] + x0[3] * x0[3])) + ((x1[0] * x1[0] + x1[1] * x1[1]) + (x1[2] * x1[2] + x1[3] * x1[3]));
                u32x4 hw; hw.x = pk2(x0[0], x0[1]); hw.y = pk2(x0[2], x0[3]); hw.z = pk2(x1[0], x1[1]); hw.w = pk2(x1[2], x1[3]);
                u32x4 lw; lw.x = pk2(x0[0] - bflo(hw.x), x0[1] - bfhi(hw.x)); lw.y = pk2(x0[2] - bflo(hw.y), x0[3] - bfhi(hw.y)); lw.z = pk2(x1[0] - bflo(hw.z), x1[1] - bfhi(hw.z)); lw.w = pk2(x1[2] - bflo(hw.w), x1[3] - bfhi(hw.w));
                const bf16x8 xh = __builtin_bit_cast(bf16x8, hw), xl = __builtin_bit_cast(bf16x8, lw);
#pragma unroll
                for (int nt = 0; nt < 2; ++nt) {
                    const bf16x8 wh = *(const bf16x8*)(WRH + (size_t)(nt * 16 + fr) * 1024 + ks * 32 + 8 * fq), wl = *(const bf16x8*)(WRL + (size_t)(nt * 16 + fr) * 1024 + ks * 32 + 8 * fq);
                    acc[nt] = __builtin_amdgcn_mfma_f32_16x16x32_bf16(xh, wh, acc[nt], 0, 0, 0);
                    acc[nt] = __builtin_amdgcn_mfma_f32_16x16x32_bf16(xl, wh, acc[nt], 0, 0, 0);
                    acc[nt] = __builtin_amdgcn_mfma_f32_16x16x32_bf16(xh, wl, acc[nt], 0, 0, 0);
                }
            }
            ss += __shfl_xor(ss, 16); ss += __shfl_xor(ss, 32);
            const float rsrow = __builtin_amdgcn_rsqf(ss * (1.0f / 1024.0f) + EPS);
            if (fq == 0) rsb[wid * 16 + fr] = rsrow;
            {
                unsigned char* xn = ws + WS_XN2 + (size_t)row * 1024 + 8 * fq;
#pragma unroll 4
                for (int ks = 0; ks < 32; ++ks) {
                    const f32x4 x0 = *(const f32x4*)(xr + ks * 32), x1 = *(const f32x4*)(xr + ks * 32 + 4);
                    u32x2 w; w.x = pk4_fp8(x0[0] * rsrow, x0[1] * rsrow, x0[2] * rsrow, x0[3] * rsrow); w.y = pk4_fp8(x1[0] * rsrow, x1[1] * rsrow, x1[2] * rsrow, x1[3] * rsrow);
                    *(u32x2*)(xn + ks * 32) = w;
                }
            }
            wave_lds_sync();
            const float b0 = a.in[I_BR][fr], b1 = a.in[I_BR][16 + fr];
#pragma unroll
            for (int r = 0; r < 4; ++r) {
                const float rs = rsb[wid * 16 + 4 * fq + r];
                unsigned k0 = (f2key(acc[0][r] * rs + b0) & ~31u) | (unsigned)(31 - fr), k1 = (f2key(acc[1][r] * rs + b1) & ~31u) | (unsigned)(15 - fr);
                unsigned sel[4];
#pragma unroll
                for (int k = 0; k < 4; ++k) {
                    const unsigned best = dpp_max_u32(k0 > k1 ? k0 : k1);
                    sel[k] = best;
                    if (k0 == best) k0 = 0u;
                    if (k1 == best) k1 = 0u;
                }
                const float v0 = key2f(sel[0] & ~31u), e1 = __expf(key2f(sel[1] & ~31u) - v0), e2 = __expf(key2f(sel[2] & ~31u) - v0), e3 = __expf(key2f(sel[3] & ~31u) - v0);
                const float inv = 1.0f / (1.0f + e1 + e2 + e3);
                if (fr < 4) {
                    const unsigned sk = fr == 0 ? sel[0] : (fr == 1 ? sel[1] : (fr == 2 ? sel[2] : sel[3]));
                    const int e = 31 - (int)(sk & 31u);
                    const float gt = (fr == 0 ? 1.0f : (fr == 1 ? e1 : (fr == 2 ? e2 : e3))) * inv;
                    const int ls = __hip_atomic_fetch_add(lcnt + e, 1, __ATOMIC_RELAXED, __HIP_MEMORY_SCOPE_WORKGROUP);
                    const int ri = ((wid * 16 + 4 * fq + r) * 4 + fr) * 4;
                    RI[ri + 0] = e; RI[ri + 1] = ls; RI[ri + 2] = __float_as_int(gt);
                }
            }
        }
        __syncthreads();
        if (tid < 32) lbase[tid] = (int)__hip_atomic_fetch_add(CNT + tid, (unsigned)lcnt[tid], __ATOMIC_RELAXED, __HIP_MEMORY_SCOPE_AGENT);
        __syncthreads();
        {
            const int rl = tid >> 2, k = tid & 3, row = rg * 128 + rl;
            const int e = RI[tid * 4 + 0], slot = lbase[e] + RI[tid * 4 + 1];
            ((int*)(ws + WS_LTOK))[(size_t)e * ECAP + slot] = row;
            ((float*)(ws + WS_LGATE))[(size_t)e * ECAP + slot] = __int_as_float(RI[tid * 4 + 2]);
            ((unsigned*)(ws + WS_ROUTE))[(size_t)row * 4 + k] = ((unsigned)e << 16) | (unsigned)slot;
        }
    }
}

DI void combine_phase(const Args& a, LAS unsigned char* lds) {
    unsigned char* ws = a.ws;
    LAS const int* tab = (LAS const int*)(lds + MOE_TAB);
    const int tid = otid(), wid = tid >> 6, lane = tid & 63;
    const u16* YB = (const u16*)(ws + WS_YB); const unsigned* ROUTE = (const unsigned*)(ws + WS_ROUTE);
    for (int row = blockIdx.x * 8 + wid; row < T; row += gridDim.x * 8) {
        size_t pos[4];
#pragma unroll
        for (int k = 0; k < 4; ++k) { const unsigned r = ROUTE[(size_t)row * 4 + k]; const int e = (int)(r >> 16), slot = (int)(r & 0xffffu); pos[k] = (size_t)tab[e] * 256 + slot; }
        float* orow = a.out + (size_t)row * 1024;
#pragma unroll
        for (int i = 0; i < 4; ++i) {
            f32x4 v = *(const f32x4*)(orow + i * 256 + lane * 4);
#pragma unroll
            for (int k = 0; k < 4; ++k) { const u32x2 y = *(const u32x2*)(YB + pos[k] * 1024 + i * 256 + lane * 4); v[0] += bflo(y.x); v[1] += bfhi(y.x); v[2] += bflo(y.y); v[3] += bfhi(y.y); }
            *(f32x4*)(orow + i * 256 + lane * 4) = v;
        }
    }
}

#define XB_TMO      128
#define XB_XCNT(j)  (256  + 64 * (j))
#define XB_XSUB(j)  (1280 + 64 * (j))
#define XB_XGEN(j)  (2304 + 64 * (j))
#define XB_TOP      3328
#define XB_TOPGEN   3392
#define XCD_BAR_WORDS 3456
#define XB_SPIN_CAP (1u << 18)

__device__ __forceinline__ unsigned xb_ld(unsigned* p)              { return __hip_atomic_load(p, __ATOMIC_RELAXED, __HIP_MEMORY_SCOPE_AGENT); }
__device__ __forceinline__ unsigned xb_add(unsigned* p, unsigned v) { return __hip_atomic_fetch_add(p, v, __ATOMIC_RELAXED, __HIP_MEMORY_SCOPE_AGENT); }
__device__ __forceinline__ unsigned xb_xcc_id() { return (unsigned)__builtin_amdgcn_s_getreg((3 << 11) | 20) & 0xFu; }
#define XB_SPIN(cond, bar) do { unsigned _sp = 0; while (cond) { __builtin_amdgcn_s_sleep(1); \
    if ((++_sp & 255u) == 0u) { if (xb_ld(&(bar)[XB_TMO])) break; if (_sp > XB_SPIN_CAP) { atomicAdd(&(bar)[XB_TMO], 1u); break; } } } } while (0)

struct XcdBarrier {
    unsigned* bar; unsigned x;
    volatile LAS unsigned* st;
};

__device__ __forceinline__ XcdBarrier xcd_barrier_post(unsigned* bar, volatile LAS unsigned* st) {
    XcdBarrier b; b.bar = bar; b.x = xb_xcc_id(); b.st = st;
    if (threadIdx.x == 0) (void)xb_add(&bar[XB_XCNT(b.x)], 1u);
    return b;
}
__device__ __forceinline__ void xcd_barrier_complete(unsigned* bar, unsigned x, unsigned& nloc, unsigned& nx) {
    const unsigned G = gridDim.x * gridDim.y * gridDim.z;
    unsigned sum, cnt, mine, sp = 0u;
    for (;;) {
        sum = 0u; cnt = 0u; mine = 0u;
#pragma unroll
        for (unsigned j = 0; j < 16; ++j) { const unsigned c = xb_ld(&bar[XB_XCNT(j)]); sum += c; cnt += (c > 0u) ? 1u : 0u; mine = (j == x) ? c : mine; }
        if (sum == G) break;
        __builtin_amdgcn_s_sleep(1);
        if ((++sp & 255u) == 0u) { if (xb_ld(&bar[XB_TMO])) break; if (sp > XB_SPIN_CAP) { atomicAdd(&bar[XB_TMO], 1u); break; } }
    }
    nloc = mine > 0u ? mine : 1u; nx = cnt > 0u ? cnt : 1u;
}

__device__ __forceinline__ void xcd_barrier(const XcdBarrier& b) {
    asm volatile("s_waitcnt vmcnt(0)" ::: "memory");
    __syncthreads();
    if (threadIdx.x == 0) {
        unsigned* bar = b.bar;
        __builtin_amdgcn_s_waitcnt(0);
        unsigned nloc = b.st[0], nx = b.st[1];
        if (nloc == 0u) { xcd_barrier_complete(bar, b.x, nloc, nx); b.st[0] = nloc; b.st[1] = nx; }
        const unsigned old = xb_add(&bar[XB_XSUB(b.x)], 1u);
        const unsigned gen = old / nloc;
        if (old + 1u == (gen + 1u) * nloc) {
            __builtin_amdgcn_fence(__ATOMIC_RELEASE, "agent");
            asm volatile("s_waitcnt vmcnt(0)" ::: "memory");
            const unsigned og = xb_add(&bar[XB_TOP], 1u);
            const unsigned tg = og / nx;
            if (og + 1u == (tg + 1u) * nx) xb_add(&bar[XB_TOPGEN], 1u);
            else XB_SPIN(xb_ld(&bar[XB_TOPGEN]) == tg, bar);
            __builtin_amdgcn_fence(__ATOMIC_ACQUIRE, "agent");
            xb_add(&bar[XB_XGEN(b.x)], 1u);
            asm volatile("s_waitcnt vmcnt(0)" ::: "memory");
        } else {
            XB_SPIN(xb_ld(&bar[XB_XGEN(b.x)]) == gen, bar);
            __builtin_amdgcn_fence(__ATOMIC_ACQUIRE, "agent");
            asm volatile("s_waitcnt vmcnt(0)" ::: "memory");
        }
    }
    __syncthreads();
}

__global__ void __launch_bounds__(NT, 2) fwd(Args a) {
    extern __shared__ __attribute__((aligned(16))) unsigned char lds_raw[];
    LAS unsigned char* lds = (LAS unsigned char*)lds_raw;
    cg::grid_group grid = cg::this_grid();
    unsigned char* ws = a.ws;
    const int G = gridDim.x, c = blockIdx.x;
    if (threadIdx.x < 2) ((volatile LAS unsigned*)(lds + LDS_BARST))[threadIdx.x] = 0u;
    __syncthreads();
    const XcdBarrier xbar = xcd_barrier_post((unsigned*)(ws + WS_BAR), (volatile LAS unsigned*)(lds + LDS_BARST));

    phase0(a, lds);
    grid.sync();
    {
        g8::PlainSched s; s.Abase = (const char*)(ws + WS_XB); s.Bbase = (const char*)(ws + WS_WIN); s.lda = 1024; s.ldb = 1024; s.K = 1024; s.nM = T / 256; s.nN = NIN / 256; s.G = G; s.c = c;
        EpiIn e; e.H = (u16*)(ws + WS_H); e.rs1 = (const float*)(ws + WS_RS1); e.SSQ = (float*)(ws + WS_SSQ); e.WI = (float*)(ws + WS_WI);
        g8::gemm_phase(lds, s, e);
    }
    xcd_barrier(xbar);
    {
        g8::PlainSched s; s.Abase = (const char*)(ws + WS_H) + 1024 * 2; s.Bbase = (const char*)(ws + WS_WQ); s.lda = NIN; s.ldb = 256; s.K = 256; s.nM = T / 256; s.nN = 5; s.G = G; s.c = c;
        EpiQ e; e.Q = (u16*)(ws + WS_Q); e.QI = (u16*)(ws + WS_QI); e.SSQ = (const float*)(ws + WS_SSQ);
        g8::gemm_phase(lds, s, e);
        for (int u = c; u < 1024; u += G) gmlp_unit(a, lds, u);
        kvnorm(a);
    }
    xcd_barrier(xbar);
    dsa_phase(a, lds);
    xcd_barrier(xbar);
    {
        g8::PlainSched s; s.Abase = (const char*)(ws + WS_YO); s.Bbase = (const char*)(ws + WS_WCAT); s.lda = 1536; s.ldb = 1536; s.K = 512; s.nM = T / 256; s.nN = 4; s.G = G; s.c = c;
        EpiMrg<0> e0; e0.OUT = (u16*)(ws + WS_TMP); e0.TMP = nullptr; e0.H = (const u16*)(ws + WS_H);
        g8::gemm_phase(lds, s, e0);
        s.Abase = (const char*)(ws + WS_YO) + 512 * 2; s.Bbase = (const char*)(ws + WS_WCAT) + 512 * 2; s.K = 1024;
        EpiMrg<1> e1; e1.OUT = (u16*)(ws + WS_MRG); e1.TMP = (const u16*)(ws + WS_TMP); e1.H = (const u16*)(ws + WS_H);
        g8::gemm_phase(lds, s, e1);
    }
    xcd_barrier(xbar);
    {
        g8::PlainSched s; s.Abase = (const char*)(ws + WS_MRG); s.Bbase = (const char*)(ws + WS_WOUT); s.lda = 1024; s.ldb = 1024; s.K = 1024; s.nM = T / 256; s.nN = 4; s.G = G; s.c = c;
        EpiOut e; e.out = a.out; e.x = a.in[I_X];
        g8::gemm_phase(lds, s, e);
    }
    xcd_barrier(xbar);
    router_phase(a, lds);
    xcd_barrier(xbar);
    moe_table(lds, (const unsigned*)(ws + WS_CTL));
    {
        MoeSched<8, true> s; s.Abase = (const char*)(ws + WS_XN2); s.Wbase = (const char*)(ws + WS_WE1); s.LTOK = (const int*)(ws + WS_LTOK); s.tab = (LAS const int*)(lds + MOE_TAB);
        s.lda = 1024; s.ldb = 1024; s.K = 1024; s.G = G; s.c = c; s.wstride = (size_t)2048 * 1024;
        EpiMoe1 e; e.ACT = (unsigned char*)(ws + WS_ACT); e.b1 = a.in[I_BE1];
        g8::gemm_phase<true>(lds, s, e);
    }
    xcd_barrier(xbar);
    {
        MoeSched<4, false> s; s.Abase = (const char*)(ws + WS_ACT); s.Wbase = (const char*)(ws + WS_WE2); s.LTOK = nullptr; s.tab = (LAS const int*)(lds + MOE_TAB);
        s.lda = 1024; s.ldb = 1024; s.K = 1024; s.G = G; s.c = c; s.wstride = (size_t)1024 * 1024;
        EpiMoe2 e; e.YB = (u16*)(ws + WS_YB); e.b2 = a.in[I_BE2]; e.LGATE = (const float*)(ws + WS_LGATE); e.tab = (LAS const int*)(lds + MOE_TAB);
        g8::gemm_phase<true>(lds, s, e);
    }
    xcd_barrier(xbar);
    combine_phase(a, lds);
}

extern "C" void kernel_launch(void* const* d_in, const int* in_sizes, int n_in, void* d_out, int out_size, void* d_ws, size_t ws_size, hipStream_t stream) {
    static int grid = 0;
    if (grid == 0) {
        int dev = 0, cus = 0, per_cu = 0;
        if (n_in != 23 || out_size != T * Dm || ws_size < WS_END) { fprintf(stderr, "kernel_launch: unexpected problem (n_in %d, out %d, ws %zu < %zu)\n", n_in, out_size, ws_size, (size_t)WS_END); grid = -1; return; }
        if (hipGetDevice(&dev) != hipSuccess || hipDeviceGetAttribute(&cus, hipDeviceAttributeMultiprocessorCount, dev) != hipSuccess) { grid = -1; return; }
        if (hipFuncSetAttribute((const void*)fwd, hipFuncAttributeMaxDynamicSharedMemorySize, LDS_BYTES) != hipSuccess) { fprintf(stderr, "hipFuncSetAttribute failed\n"); grid = -1; return; }
        if (hipOccupancyMaxActiveBlocksPerMultiprocessor(&per_cu, (const void*)fwd, NT, LDS_BYTES) != hipSuccess || per_cu < 1) { fprintf(stderr, "occupancy query failed (%d)\n", per_cu); grid = -1; return; }
        grid = cus;
        fprintf(stderr, "kernel_launch: cus %d per_cu %d grid %d ws %zu need %zu\n", cus, per_cu, grid, ws_size, (size_t)WS_END);
    }
    if (grid < 0) return;
    Args a{};
    for (int i = 0; i < 23; ++i) a.in[i] = (const float*)d_in[i];
    a.out = (float*)d_out; a.ws = (unsigned char*)d_ws; a.mask = 0xffffffffu; a.pad = 0u;
    if (hipMemsetAsync((char*)d_ws + WS_CTL, 0, 65536, stream) != hipSuccess) { fprintf(stderr, "memset failed\n"); return; }
    void* args[] = {&a};
    hipError_t e = hipLaunchCooperativeKernel((const void*)fwd, dim3(grid), dim3(NT), args, LDS_BYTES, stream);
    if (e != hipSuccess) fprintf(stderr, "cooperative launch failed: %s (grid %d)\n", hipGetErrorString(e), grid);
}
```

```cpp
#include <hip/hip_runtime.h>
#include <hip/hip_cooperative_groups.h>
#include <cstdio>
#include <cstdint>
namespace cg = cooperative_groups;

#define LAS __attribute__((address_space(3)))
#define DI __device__ __forceinline__
typedef unsigned short u16;
typedef short bf16x8 __attribute__((ext_vector_type(8)));
typedef short s16x4 __attribute__((ext_vector_type(4)));
typedef float f32x4 __attribute__((ext_vector_type(4)));
typedef float f32x2 __attribute__((ext_vector_type(2)));
typedef unsigned u32x4 __attribute__((ext_vector_type(4)));
typedef unsigned u32x2 __attribute__((ext_vector_type(2)));
typedef __bf16 bf2_t __attribute__((ext_vector_type(2)));
typedef int v8i_t __attribute__((ext_vector_type(8)));

constexpr int NT = 512;
constexpr int LDS_BYTES = 155648;
constexpr int Dm = 1024, Bsz = 4, S = 8192, T = Bsz * S;
constexpr int NIN = 3584;
constexpr int NE = 32, ECAP = 32768, PPAD = 131072 + NE * 256;
constexpr float EPS = 1e-6f;

constexpr size_t MiB = 1024 * 1024;
constexpr size_t WS_CTL = 0;
constexpr size_t WS_BAR = 16384;
constexpr int LDS_BARST = LDS_BYTES - 16;
constexpr size_t WS_WIN = 64 * 1024;
constexpr size_t WS_WQ = WS_WIN + (size_t)NIN * 1024 * 2;
constexpr size_t WS_WSP = WS_WQ + 1280 * 256 * 2;
constexpr size_t WS_WCAT = WS_WSP + 4 * 128 * 128 * 2;
constexpr size_t WS_WOUT = WS_WCAT + 1024 * 1536 * 2;
constexpr size_t WS_WR = WS_WOUT + 1024 * 1024 * 2;
constexpr size_t WS_WE1 = WS_WR + 32 * 1024 * 4;
constexpr size_t WS_WE2 = WS_WE1 + (size_t)32 * 2048 * 1024 * 2;
constexpr size_t WS_RS1 = WS_WE2 + (size_t)32 * 1024 * 1024 * 2;
constexpr size_t WS_SSQ = WS_RS1 + (size_t)T * 4;
constexpr size_t WS_WI = WS_SSQ + (size_t)T * 32 * 4;
constexpr size_t WS_ROUTE = WS_WI + (size_t)T * 4 * 4;
constexpr size_t WS_LTOK = WS_ROUTE + (size_t)T * 4 * 4;
constexpr size_t WS_LGATE = WS_LTOK + (size_t)NE * ECAP * 4;
constexpr size_t WS_LRS = WS_LGATE + (size_t)NE * ECAP * 4;
constexpr size_t WS_XN2 = WS_LRS + (size_t)NE * ECAP * 4;
constexpr size_t WS_R0 = WS_XN2 + (size_t)T * 1024 * 2;
constexpr size_t WS_XB = WS_R0;
constexpr size_t WS_H = WS_XB + (size_t)T * 1024 * 2;
constexpr size_t WS_Q = WS_H + (size_t)T * NIN * 2;
constexpr size_t WS_QI = WS_Q + (size_t)T * 1024 * 2;
constexpr size_t WS_KVN = WS_QI + (size_t)T * 256 * 2;
constexpr size_t WS_KIN = WS_KVN + (size_t)T * 128 * 2;
constexpr size_t WS_YO = WS_KIN + (size_t)T * 64 * 2;
constexpr size_t WS_TMP = WS_YO + (size_t)T * 1536 * 2;
constexpr size_t WS_MRG = WS_TMP + (size_t)T * 1024 * 2;
constexpr size_t WS_R0END = WS_MRG + (size_t)T * 1024 * 2;
constexpr size_t WS_ACT = WS_XB;
constexpr size_t WS_YB = WS_Q;
static_assert(WS_ACT + (size_t)PPAD * 1024 * 2 <= WS_Q, "ACT overlaps YB");
static_assert(WS_YB + (size_t)PPAD * 1024 * 2 <= WS_R0END, "YB too large");
constexpr size_t WS_END = WS_R0END;

struct Args { const float* in[23]; float* out; unsigned char* ws; unsigned mask; unsigned pad; };
enum { I_X = 0, I_N1G, I_WIN, I_QLG, I_WUQ, I_QNG, I_KVG, I_WUV, I_WQI, I_KIG, I_VG, I_WSP, I_BSP, I_WPA, I_WPB, I_WOUT, I_N2G, I_WR, I_BR, I_WE1, I_BE1, I_WE2, I_BE2 };

DI unsigned pk2(float a, float b) { f32x2 v = {a, b}; bf2_t r = __builtin_convertvector(v, bf2_t); return __builtin_bit_cast(unsigned, r); }
DI unsigned pk4_fp8(float a, float b, float c, float d) { unsigned w = 0u; w = (unsigned)__builtin_amdgcn_cvt_pk_fp8_f32(a, b, (int)w, false); w = (unsigned)__builtin_amdgcn_cvt_pk_fp8_f32(c, d, (int)w, true); return w; }
DI unsigned pk4_i8(float a, float b, float c, float d) {
    const int ia = (int)__builtin_rintf(fminf(fmaxf(a * 32.0f, -127.0f), 127.0f)), ib = (int)__builtin_rintf(fminf(fmaxf(b * 32.0f, -127.0f), 127.0f));
    const int ic = (int)__builtin_rintf(fminf(fmaxf(c * 32.0f, -127.0f), 127.0f)), id = (int)__builtin_rintf(fminf(fmaxf(d * 32.0f, -127.0f), 127.0f));
    return (unsigned)(ia & 0xff) | ((unsigned)(ib & 0xff) << 8) | ((unsigned)(ic & 0xff) << 16) | ((unsigned)(id & 0xff) << 24);
}
DI float bflo(unsigned u) { return __uint_as_float(u << 16); }
DI float bfhi(unsigned u) { return __uint_as_float(u & 0xffff0000u); }
DI u16 f2bf(float f) { return (u16)(pk2(f, 0.f) & 0xffffu); }
DI float bf2f(u16 h) { return __uint_as_float(((unsigned)h) << 16); }
DI float sigmoidf_(float x) { return __builtin_amdgcn_rcpf(1.0f + __expf(-x)); }
DI float gelu_tanh(float x) { const float u = 1.5957691216057308f * (x + 0.044715f * x * x * x); return x * sigmoidf_(u); }
DI float fast_sigmoid(float x) { return __builtin_amdgcn_rcpf(1.0f + __builtin_amdgcn_exp2f(x * -1.4426950408889634f)); }
DI float fast_gelu(float x) { const float p = __builtin_fmaf(x * x, -0.10294324f, -2.3022082f); return x * __builtin_amdgcn_rcpf(1.0f + __builtin_amdgcn_exp2f(x * p)); }
DI int otid() { int t = threadIdx.x; asm volatile("" : "+v"(t)); return t; }
DI void wave_lds_sync() { asm volatile("s_waitcnt lgkmcnt(0)" ::: "memory"); }

namespace g8 {
constexpr int BM = 256, BK = 64, HALF = 128, HTB = HALF * BK * 2, STAGE_BYTES = 8 * HTB, NXCD = 8, WGM = 8;
DI int lds_byte(int r, int c) { const int st = (r >> 4) * 2 + (c >> 5), rr = r & 15, cc = c & 31, ob = rr * 64 + cc * 2; return st * 1024 + (ob ^ (((ob >> 9) & 1) << 5)); }
DI int perm32(int rho) { const int n = rho >> 4, i = rho & 15; return 8 * (i >> 2) + 4 * n + (i & 3); }
DI void stage_rc(int b, int& R, int& C) { const int st = b / 1024, sb = b % 1024, swz = sb ^ (((sb >> 9) & 1) << 5); R = (st >> 1) * 16 + swz / 64; C = (st & 1) * 32 + (swz % 64) / 2; }

struct UnitD { const char* Bp; int pm, pn, e, rb; };

DI bool static_tile(int i, int G, int c, int nM, int nN, int& pm, int& pn) {
    const int nwg = nM * nN; const long L = (long)i * G + c; if (L >= nwg) return false;
    int wgid = (int)L; { const int q = nwg / NXCD, r = nwg % NXCD, xcd = wgid % NXCD, off = wgid / NXCD; wgid = (xcd < r ? xcd * (q + 1) : r * (q + 1) + (xcd - r) * q) + off; }
    const int nig = WGM * nN, gid = wgid / nig, fm = gid * WGM, gsz = (nM - fm) < WGM ? (nM - fm) : WGM;
    pm = fm + ((wgid % nig) % gsz); pn = (wgid % nig) / gsz; return true;
}

struct PlainSched {
    const char* Abase; const char* Bbase; int lda, ldb, K, nM, nN, G, c; static constexpr int esz = 2;
    DI bool next(int i, UnitD& u) const { int pm, pn; if (!static_tile(i, G, c, nM, nN, pm, pn)) return false; u.pm = pm; u.pn = pn; u.e = 0; u.rb = 0; u.Bp = Bbase + (size_t)pn * BM * ldb * 2; return true; }
    DI void a_offs(const UnitD& u, int R0, int C0, unsigned (&o)[2][2]) const {
#pragma unroll
        for (int h = 0; h < 2; ++h)
#pragma unroll
            for (int i = 0; i < 2; ++i) o[h][i] = (unsigned)(((size_t)(u.pm * BM + h * HALF + R0 + 64 * i) * lda + C0) * 2);
    }
};

template <bool FP8 = false, class Epi, class Sched>
DI void gemm_phase(LAS unsigned char* lds, const Sched& S, const Epi& E) {
    const int tid = otid(), wid = __builtin_amdgcn_readfirstlane(tid >> 6), lane = tid & 63, wr = wid >> 2, wc = wid & 3, fr = lane & 15, fq = lane >> 4;
    const int nt = S.K * Sched::esz / 128;
    int R0, C0; stage_rc(tid * 16, R0, C0);
    unsigned voffB[2];
#pragma unroll
    for (int i = 0; i < 2; ++i) { const int Rr = R0 + 64 * i, Rb = Epi::PERM ? ((Rr & ~31) + perm32(Rr & 31)) : Rr; voffB[i] = (unsigned)(Rb * S.ldb * Sched::esz + C0 * 2); }
    const size_t hstepB = (size_t)HALF * S.ldb * Sched::esz;
    const unsigned ldsw = (unsigned)wid * 1024u;
    const int aoff = FP8 ? lds_byte(wr * 64 + fr, fq * 16) : lds_byte(wr * 64 + fr, fq * 8), boff = FP8 ? lds_byte(wc * 32 + fr, fq * 16) : lds_byte(wc * 32 + fr, fq * 8);
    const unsigned mxscale = 0x7f7f7f7fu;
    const int kst = FP8 ? 16 : 1024;
    const char* Ab = S.Abase;
#define G8_SA(b, h) (((b) * 2 + (h)) * HTB)
#define G8_SB(b, h) ((4 + (b) * 2 + (h)) * HTB)
#define G8_STAGE_A(bufoff, offs, kb) do { _Pragma("unroll") for (int _i = 0; _i < 2; ++_i) \
        __builtin_amdgcn_global_load_lds((const unsigned*)(Ab + (size_t)(offs)[_i] + (size_t)(kb)), (LAS unsigned*)(lds + (bufoff) + ldsw + _i * 8192), 16, 0, 0); } while (0)
#define G8_STAGE_B(bufoff, gbase, kb) do { _Pragma("unroll") for (int _i = 0; _i < 2; ++_i) \
        __builtin_amdgcn_global_load_lds((const unsigned*)((gbase) + voffB[_i] + (size_t)(kb)), (LAS unsigned*)(lds + (bufoff) + ldsw + _i * 8192), 16, 0, 0); } while (0)
#define G8_LDA(dst, b, h) do { _Pragma("unroll") for (int m = 0; m < 4; ++m) { const i32x4_t _p = *(const LAS i32x4_t*)(lds + G8_SA(b, h) + aoff + m * 2048), _q = *(const LAS i32x4_t*)(lds + G8_SA(b, h) + aoff + m * 2048 + kst); dst[m] = __builtin_shufflevector(_p, _q, 0, 1, 2, 3, 4, 5, 6, 7); } } while (0)
#define G8_LDB(dst, b, h) do { _Pragma("unroll") for (int n = 0; n < 2; ++n) { const i32x4_t _p = *(const LAS i32x4_t*)(lds + G8_SB(b, h) + boff + n * 2048), _q = *(const LAS i32x4_t*)(lds + G8_SB(b, h) + boff + n * 2048 + kst); dst[n] = __builtin_shufflevector(_p, _q, 0, 1, 2, 3, 4, 5, 6, 7); } } while (0)
#define G8_MMA(ai, bj, At, Bt) do { __builtin_amdgcn_s_setprio(1); _Pragma("unroll") for (int m = 0; m < 4; ++m) _Pragma("unroll") for (int n = 0; n < 2; ++n) { \
        if constexpr (FP8) asm volatile("v_mfma_scale_f32_16x16x128_f8f6f4 %0, %1, %2, %0, %3, %3 op_sel_hi:[0,0,0]" : "+v"(acc[ai][bj][m][n]) : "v"(Bt[n]), "v"(At[m]), "v"(mxscale)); \
        else { acc[ai][bj][m][n] = __builtin_amdgcn_mfma_f32_16x16x32_bf16(__builtin_bit_cast(bf16x8, __builtin_shufflevector(Bt[n], Bt[n], 0, 1, 2, 3)), __builtin_bit_cast(bf16x8, __builtin_shufflevector(At[m], At[m], 0, 1, 2, 3)), acc[ai][bj][m][n], 0, 0, 0); \
               acc[ai][bj][m][n] = __builtin_amdgcn_mfma_f32_16x16x32_bf16(__builtin_bit_cast(bf16x8, __builtin_shufflevector(Bt[n], Bt[n], 4, 5, 6, 7)), __builtin_bit_cast(bf16x8, __builtin_shufflevector(At[m], At[m], 4, 5, 6, 7)), acc[ai][bj][m][n], 0, 0, 0); } } \
        __builtin_amdgcn_s_setprio(0); } while (0)
#define G8_WAIT_V(n) asm volatile("s_waitcnt vmcnt(" #n ")" ::: "memory")
#define G8_WAIT_L(n) asm volatile("s_waitcnt lgkmcnt(" #n ")" ::: "memory")
#define G8_BAR __builtin_amdgcn_s_barrier()
#define G8_SCHED __builtin_amdgcn_sched_barrier(0)
    UnitD cur, nxt; int ui = 0;
    if (!S.next(0, cur)) return;
    f32x4 acc[2][2][4][2];
#pragma unroll
    for (int a = 0; a < 2; ++a)
#pragma unroll
        for (int b = 0; b < 2; ++b)
#pragma unroll
            for (int m = 0; m < 4; ++m)
#pragma unroll
                for (int n = 0; n < 2; ++n) acc[a][b][m][n] = (f32x4){0.f, 0.f, 0.f, 0.f};
    typedef int i32x4_t __attribute__((ext_vector_type(4)));
    v8i_t At[4], B0[2], B1[2];
    unsigned cA[2][2];
    S.a_offs(cur, R0, C0, cA);
    const char* cB = cur.Bp;
    G8_STAGE_B(G8_SB(0, 0), cB, 0); G8_STAGE_A(G8_SA(0, 0), cA[0], 0); G8_STAGE_B(G8_SB(0, 1), cB + hstepB, 0); G8_STAGE_A(G8_SA(0, 1), cA[1], 0);
    if (wr == 1) G8_BAR;
    G8_WAIT_V(4); G8_BAR;
    G8_STAGE_B(G8_SB(1, 0), cB, 128); G8_STAGE_A(G8_SA(1, 0), cA[0], 128); G8_STAGE_B(G8_SB(1, 1), cB + hstepB, 128);
    G8_WAIT_V(6); G8_BAR;
    for (;;) {
        const bool has_next = S.next(ui + 1, nxt);
        const char* nB = has_next ? nxt.Bp : cB;
        for (int t = 0; t < nt; t += 2) {
            const bool last = (t == nt - 2);
            const unsigned k1 = (unsigned)(t + 1) * 128u;
            const unsigned k2 = last ? 0u : (unsigned)(t + 2) * 128u, k3 = k2 + 128u;
            unsigned c1[2] = {cA[1][0], cA[1][1]};
            if (last && has_next) S.a_offs(nxt, R0, C0, cA);
            const char* b2 = last ? nB : cB;
            G8_LDB(B0, 0, 0); G8_SCHED; G8_LDA(At, 0, 0); G8_STAGE_A(G8_SA(1, 1), c1, k1);
            G8_WAIT_L(8); G8_BAR; G8_WAIT_L(0); G8_MMA(0, 0, At, B0); G8_BAR; G8_SCHED;
            G8_LDB(B1, 0, 1); G8_STAGE_B(G8_SB(0, 0), b2, k2);
            G8_BAR; G8_WAIT_L(0); G8_MMA(0, 1, At, B1); G8_BAR;
            G8_LDA(At, 0, 1); G8_STAGE_A(G8_SA(0, 0), cA[0], k2);
            G8_BAR; G8_WAIT_L(0); G8_MMA(1, 0, At, B0); G8_BAR; G8_SCHED;
            G8_STAGE_B(G8_SB(0, 1), b2 + hstepB, k2);
            G8_WAIT_V(6); G8_BAR; G8_MMA(1, 1, At, B1); G8_BAR;
            G8_LDB(B0, 1, 0); G8_SCHED; G8_LDA(At, 1, 0); G8_STAGE_A(G8_SA(0, 1), cA[1], k2);
            G8_WAIT_L(8); G8_BAR; G8_WAIT_L(0); G8_MMA(0, 0, At, B0); G8_BAR; G8_SCHED;
            G8_LDB(B1, 1, 1); G8_STAGE_B(G8_SB(1, 0), b2, k3);
            G8_BAR; G8_WAIT_L(0); G8_MMA(0, 1, At, B1); G8_BAR;
            G8_LDA(At, 1, 1); G8_STAGE_A(G8_SA(1, 0), cA[0], k3);
            G8_BAR; G8_WAIT_L(0); G8_MMA(1, 0, At, B0); G8_BAR; G8_SCHED;
            G8_STAGE_B(G8_SB(1, 1), b2 + hstepB, k3);
            G8_WAIT_V(6); G8_BAR; G8_MMA(1, 1, At, B1); G8_BAR;
        }
        if constexpr (FP8) asm volatile("s_nop 15\n\ts_nop 15" ::: "memory");
        E(acc, cur, wr, wc, fr, fq);
        if (!has_next) break;
#pragma unroll
        for (int a = 0; a < 2; ++a)
#pragma unroll
            for (int b = 0; b < 2; ++b)
#pragma unroll
                for (int m = 0; m < 4; ++m)
#pragma unroll
                    for (int n = 0; n < 2; ++n) acc[a][b][m][n] = (f32x4){0.f, 0.f, 0.f, 0.f};
        cur = nxt; cB = nB; ++ui;
    }
    G8_WAIT_V(0);
    if (wr == 0) G8_BAR;
    G8_BAR;
#undef G8_SA
#undef G8_SB
#undef G8_STAGE_A
#undef G8_STAGE_B
#undef G8_LDA
#undef G8_LDB
#undef G8_MMA
#undef G8_WAIT_V
#undef G8_WAIT_L
#undef G8_BAR
#undef G8_SCHED
}
}
using g8::UnitD;
typedef f32x4 Acc[2][2][4][2];

struct EpiIn {
    static constexpr bool PERM = true;
    u16* H; const float* rs1; float* SSQ; float* WI;
    template <int ACT, bool DOSSQ> DI void run(const Acc& acc, const UnitD& u, int wr, int wc, int fr, int fq) const {
        const int pn = u.pn;
        float rsv[2][4];
#pragma unroll
        for (int ai = 0; ai < 2; ++ai)
#pragma unroll
            for (int m = 0; m < 4; ++m) rsv[ai][m] = rs1[u.pm * 256 + ai * 128 + wr * 64 + m * 16 + fr];
        __builtin_amdgcn_sched_barrier(0);
#pragma unroll
        for (int ai = 0; ai < 2; ++ai)
#pragma unroll
            for (int m = 0; m < 4; ++m) {
                const int row = u.pm * 256 + ai * 128 + wr * 64 + m * 16 + fr;
                const float rs = rsv[ai][m];
#pragma unroll
                for (int bj = 0; bj < 2; ++bj) {
                    f32x4 v0 = acc[ai][bj][m][0] * rs, v1 = acc[ai][bj][m][1] * rs;
                    if (ACT == 1) {
#pragma unroll
                        for (int j = 0; j < 4; ++j) { v0[j] = fast_gelu(v0[j]); v1[j] = fast_gelu(v1[j]); }
                    } else if (ACT == 2) {
#pragma unroll
                        for (int j = 0; j < 4; ++j) { v0[j] = fast_sigmoid(v0[j]); v1[j] = fast_sigmoid(v1[j]); }
                    }
                    u32x4 w; w.x = pk2(v0[0], v0[1]); w.y = pk2(v0[2], v0[3]); w.z = pk2(v1[0], v1[1]); w.w = pk2(v1[2], v1[3]);
                    *(u32x4*)(H + (size_t)row * NIN + pn * 256 + bj * 128 + wc * 32 + 8 * fq) = w;
                    if (DOSSQ) {
                        float ssq = ((v0[0] * v0[0] + v0[1] * v0[1]) + (v0[2] * v0[2] + v0[3] * v0[3])) + ((v1[0] * v1[0] + v1[1] * v1[1]) + (v1[2] * v1[2] + v1[3] * v1[3]));
                        ssq += __shfl_xor(ssq, 16); ssq += __shfl_xor(ssq, 32);
                        if (fq == 0) SSQ[(size_t)row * 32 + (pn - 2) * 8 + bj * 4 + wc] = ssq;
                        if (pn == 5 && bj == 1 && wc == 2 && fq == 0) *(f32x4*)(WI + (size_t)row * 4) = v0 * 0.5f;
                    }
                }
            }
    }
    DI void operator()(const Acc& acc, const UnitD& u, int wr, int wc, int fr, int fq) const {
        const int pn = u.pn;
        if (pn < 2) run<1, false>(acc, u, wr, wc, fr, fq);
        else if (pn < 4) run<1, true>(acc, u, wr, wc, fr, fq);
        else if (pn < 6) run<0, true>(acc, u, wr, wc, fr, fq);
        else run<2, false>(acc, u, wr, wc, fr, fq);
    }
};
struct EpiQ {
    static constexpr bool PERM = true;
    u16* Q; u16* QI; const float* SSQ;
    DI void operator()(const Acc& acc, const UnitD& u, int wr, int wc, int fr, int fq) const {
        f32x4 sq[2][4][2];
#pragma unroll
        for (int ai = 0; ai < 2; ++ai)
#pragma unroll
            for (int m = 0; m < 4; ++m) { const int row = u.pm * 256 + ai * 128 + wr * 64 + m * 16 + fr; sq[ai][m][0] = *(const f32x4*)(SSQ + (size_t)row * 32 + 16); sq[ai][m][1] = *(const f32x4*)(SSQ + (size_t)row * 32 + 20); }
        __builtin_amdgcn_sched_barrier(0);
#pragma unroll
        for (int ai = 0; ai < 2; ++ai)
#pragma unroll
            for (int m = 0; m < 4; ++m) {
                const int row = u.pm * 256 + ai * 128 + wr * 64 + m * 16 + fr;
                const f32x4 s0 = sq[ai][m][0], s1 = sq[ai][m][1];
                const float ss = ((s0[0] + s0[1]) + (s0[2] + s0[3])) + ((s1[0] + s1[1]) + (s1[2] + s1[3]));
                const float rs = __builtin_amdgcn_rsqf(ss * (1.0f / 256.0f) + EPS);
#pragma unroll
                for (int bj = 0; bj < 2; ++bj) {
                    const int col = u.pn * 256 + bj * 128 + wc * 32 + 8 * fq;
                    const f32x4 v0 = acc[ai][bj][m][0] * rs, v1 = acc[ai][bj][m][1] * rs;
                    if (col < 1024) { u32x4 w; w.x = pk2(v0[0], v0[1]); w.y = pk2(v0[2], v0[3]); w.z = pk2(v1[0], v1[1]); w.w = pk2(v1[2], v1[3]); *(u32x4*)(Q + (size_t)row * 1024 + col) = w; }
                    else { u32x2 w; w.x = pk4_i8(v0[0], v0[1], v0[2], v0[3]); w.y = pk4_i8(v1[0], v1[1], v1[2], v1[3]); *(u32x2*)((unsigned char*)QI + (size_t)row * 256 + (col - 1024)) = w; }
                }
            }
    }
};
template <int SECOND> struct EpiMrg {
    static constexpr bool PERM = true;
    u16* OUT; const u16* TMP; const u16* H;
    DI void operator()(const Acc& acc, const UnitD& u, int wr, int wc, int fr, int fq) const {
#pragma unroll
        for (int ai = 0; ai < 2; ++ai) {
            u32x4 g[4][2], tp[4][2];
#pragma unroll
            for (int m = 0; m < 4; ++m)
#pragma unroll
                for (int bj = 0; bj < 2; ++bj) {
                    const int row = u.pm * 256 + ai * 128 + wr * 64 + m * 16 + fr, col = u.pn * 256 + bj * 128 + wc * 32 + 8 * fq;
                    g[m][bj] = *(const u32x4*)(H + (size_t)row * NIN + 1536 + SECOND * 1024 + col);
                    if (SECOND) tp[m][bj] = *(const u32x4*)(TMP + (size_t)row * 1024 + col);
                }
            __builtin_amdgcn_sched_barrier(0);
#pragma unroll
            for (int m = 0; m < 4; ++m)
#pragma unroll
                for (int bj = 0; bj < 2; ++bj) {
                    const int row = u.pm * 256 + ai * 128 + wr * 64 + m * 16 + fr, col = u.pn * 256 + bj * 128 + wc * 32 + 8 * fq;
                    const u32x4 gg = g[m][bj];
                    f32x4 v0 = acc[ai][bj][m][0], v1 = acc[ai][bj][m][1];
                    v0[0] *= bflo(gg.x); v0[1] *= bfhi(gg.x); v0[2] *= bflo(gg.y); v0[3] *= bfhi(gg.y); v1[0] *= bflo(gg.z); v1[1] *= bfhi(gg.z); v1[2] *= bflo(gg.w); v1[3] *= bfhi(gg.w);
                    if (SECOND) { const u32x4 t = tp[m][bj];
                        v0[0] += bflo(t.x); v0[1] += bfhi(t.x); v0[2] += bflo(t.y); v0[3] += bfhi(t.y); v1[0] += bflo(t.z); v1[1] += bfhi(t.z); v1[2] += bflo(t.w); v1[3] += bfhi(t.w); }
                    u32x4 w; w.x = pk2(v0[0], v0[1]); w.y = pk2(v0[2], v0[3]); w.z = pk2(v1[0], v1[1]); w.w = pk2(v1[2], v1[3]);
                    *(u32x4*)(OUT + (size_t)row * 1024 + col) = w;
                }
            __builtin_amdgcn_sched_barrier(0);
        }
    }
};
struct EpiOut {
    static constexpr bool PERM = false;
    float* out; const float* x;
    DI void operator()(const Acc& acc, const UnitD& u, int wr, int wc, int fr, int fq) const {
#pragma unroll
        for (int ai = 0; ai < 2; ++ai) {
            f32x4 xv[4][2][2];
#pragma unroll
            for (int m = 0; m < 4; ++m)
#pragma unroll
                for (int bj = 0; bj < 2; ++bj)
#pragma unroll
                    for (int n = 0; n < 2; ++n)
                        xv[m][bj][n] = *(const f32x4*)(x + (size_t)(u.pm * 256 + ai * 128 + wr * 64 + m * 16 + fr) * 1024 + u.pn * 256 + bj * 128 + wc * 32 + n * 16 + 4 * fq);
            __builtin_amdgcn_sched_barrier(0);
#pragma unroll
            for (int m = 0; m < 4; ++m)
#pragma unroll
                for (int bj = 0; bj < 2; ++bj)
#pragma unroll
                    for (int n = 0; n < 2; ++n)
                        *(f32x4*)(out + (size_t)(u.pm * 256 + ai * 128 + wr * 64 + m * 16 + fr) * 1024 + u.pn * 256 + bj * 128 + wc * 32 + n * 16 + 4 * fq) = xv[m][bj][n] + acc[ai][bj][m][n];
            __builtin_amdgcn_sched_barrier(0);
        }
    }
};

constexpr int MOE_TAB = g8::STAGE_BYTES;
DI void moe_table(LAS unsigned char* lds, const unsigned* CNT) {
    LAS int* tab = (LAS int*)(lds + MOE_TAB);
    __syncthreads();
    if (threadIdx.x == 0) { int acc = 0; for (int e = 0; e < NE; ++e) { const int c = (int)__hip_atomic_load(CNT + e, __ATOMIC_RELAXED, __HIP_MEMORY_SCOPE_AGENT); tab[e] = acc; tab[33 + e] = c; acc += (c + 255) >> 8; } tab[32] = acc; }
    __syncthreads();
}
template <int NPN, bool GATHER> struct MoeSched {
    const char* Abase; const char* Wbase; const int* LTOK; LAS const int* tab; int lda, ldb, K, G, c; size_t wstride; static constexpr int esz = 1;
    DI bool next(int i, UnitD& u) const {
        const long L = (long)i * G + c; const int R = tab[32];
        if (L >= (long)R * NPN) return false;
        const int rbg = (int)(L / NPN), pn = (int)(L % NPN);
        int e = 0;
        for (int j = 1; j < NE; ++j) e += (tab[j] <= rbg) ? 1 : 0;
        e = __builtin_amdgcn_readfirstlane(e);
        u.pm = rbg; u.pn = pn; u.e = e; u.rb = rbg - tab[e];
        u.Bp = Wbase + (size_t)e * wstride + (size_t)pn * 256 * ldb * esz;
        return true;
    }
    DI void a_offs(const UnitD& u, int R0, int C0, unsigned (&o)[2][2]) const {
        const int cnt = tab[33 + u.e];
#pragma unroll
        for (int h = 0; h < 2; ++h)
#pragma unroll
            for (int i = 0; i < 2; ++i) {
                const int r = h * 128 + R0 + 64 * i;
                if (GATHER) { const int slot = u.rb * 256 + r; const int tok = slot < cnt ? LTOK[(size_t)u.e * ECAP + slot] : 0; o[h][i] = (unsigned)((size_t)tok * lda * esz + C0 * 2); }
                else o[h][i] = (unsigned)((size_t)(u.pm * 256 + r) * lda * esz + C0 * 2);
            }
    }
};
struct EpiMoe1 {
    static constexpr bool PERM = true;
    unsigned char* ACT; const float* b1;
    DI void operator()(const Acc& acc, const UnitD& u, int wr, int wc, int fr, int fq) const {
        const float* be = b1 + (size_t)u.e * 2048;
        const int hc = u.pn * 128 + wc * 32 + 8 * fq;
        const f32x4 bg0 = *(const f32x4*)(be + hc), bg1 = *(const f32x4*)(be + hc + 4), bu0 = *(const f32x4*)(be + 1024 + hc), bu1 = *(const f32x4*)(be + 1024 + hc + 4);
        __builtin_amdgcn_sched_barrier(0);
#pragma unroll
        for (int ai = 0; ai < 2; ++ai)
#pragma unroll
            for (int m = 0; m < 4; ++m) {
                const int row = u.pm * 256 + ai * 128 + wr * 64 + m * 16 + fr;
                float av[8];
#pragma unroll
                for (int n = 0; n < 2; ++n) {
                    const f32x4 g = acc[ai][0][m][n] * 0.015625f + (n ? bg1 : bg0), up = acc[ai][1][m][n] * 0.015625f + (n ? bu1 : bu0);
#pragma unroll
                    for (int j = 0; j < 4; ++j) {
                        const float hg = fminf(g[j], 7.0f), hu = __builtin_amdgcn_fmed3f(up[j], -7.0f, 7.0f);
                        av[4 * n + j] = (hu + 1.0f) * (hg * __builtin_amdgcn_rcpf(1.0f + __builtin_amdgcn_exp2f(hg * -2.4554669595930157f)));
                    }
                }
                u32x2 w; w.x = pk4_fp8(av[0], av[1], av[2], av[3]); w.y = pk4_fp8(av[4], av[5], av[6], av[7]);
                *(u32x2*)(ACT + (size_t)row * 1024 + hc) = w;
            }
    }
};
struct EpiMoe2 {
    static constexpr bool PERM = true;
    u16* YB; const float* b2; const float* LGATE; LAS const int* tab;
    DI void operator()(const Acc& acc, const UnitD& u, int wr, int wc, int fr, int fq) const {
        const float* be = b2 + (size_t)u.e * 1024; const int cnt = tab[33 + u.e];
        float gate[2][4]; f32x4 bias[2][2];
#pragma unroll
        for (int ai = 0; ai < 2; ++ai)
#pragma unroll
            for (int m = 0; m < 4; ++m) { const int slot = u.rb * 256 + ai * 128 + wr * 64 + m * 16 + fr; gate[ai][m] = slot < cnt ? LGATE[(size_t)u.e * ECAP + slot] : 0.f; }
#pragma unroll
        for (int bj = 0; bj < 2; ++bj) { const int col = u.pn * 256 + bj * 128 + wc * 32 + 8 * fq; bias[bj][0] = *(const f32x4*)(be + col); bias[bj][1] = *(const f32x4*)(be + col + 4); }
        __builtin_amdgcn_sched_barrier(0);
#pragma unroll
        for (int ai = 0; ai < 2; ++ai)
#pragma unroll
            for (int m = 0; m < 4; ++m) {
                const int r = ai * 128 + wr * 64 + m * 16 + fr;
                const float gt = gate[ai][m];
#pragma unroll
                for (int bj = 0; bj < 2; ++bj) {
                    const int col = u.pn * 256 + bj * 128 + wc * 32 + 8 * fq;
                    const f32x4 v0 = (acc[ai][bj][m][0] * 0.015625f + bias[bj][0]) * gt, v1 = (acc[ai][bj][m][1] * 0.015625f + bias[bj][1]) * gt;
                    u32x4 w; w.x = pk2(v0[0], v0[1]); w.y = pk2(v0[2], v0[3]); w.z = pk2(v1[0], v1[1]); w.w = pk2(v1[2], v1[3]);
                    *(u32x4*)(YB + (size_t)(u.pm * 256 + r) * 1024 + col) = w;
                }
            }
    }
};

template <bool FP8 = false, class F> DI void tr_tile(LAS unsigned char* lds, const float* src, int ld_src, int Nsz, int k0, int n0, const float* sk, float mul, u16* dst, int ld_dst, F rowmap) {
    LAS float* t = (LAS float*)lds;
    const int tid = otid();
    __syncthreads();
#pragma unroll
    for (int it = 0; it < 2; ++it) {
        const int k = (tid >> 4) + 32 * it, n = 4 * (tid & 15);
        f32x4 v = {0.f, 0.f, 0.f, 0.f};
        if (n0 + n < Nsz) v = *(const f32x4*)(src + (size_t)(k0 + k) * ld_src + n0 + n);
        const float s = (sk ? sk[k0 + k] : 1.0f) * mul;
        t[k * 65 + n] = v[0] * s; t[k * 65 + n + 1] = v[1] * s; t[k * 65 + n + 2] = v[2] * s; t[k * 65 + n + 3] = v[3] * s;
    }
    __syncthreads();
    const int n = tid >> 3, kc = (tid & 7) * 8;
    if (FP8) {
        if (n0 + n < Nsz) {
            u32x2 w;
            w.x = pk4_fp8(t[(kc + 0) * 65 + n], t[(kc + 1) * 65 + n], t[(kc + 2) * 65 + n], t[(kc + 3) * 65 + n]);
            w.y = pk4_fp8(t[(kc + 4) * 65 + n], t[(kc + 5) * 65 + n], t[(kc + 6) * 65 + n], t[(kc + 7) * 65 + n]);
            *(u32x2*)((unsigned char*)dst + (size_t)rowmap(n0 + n) * ld_dst + k0 + kc) = w;
        }
    } else if (n0 + n < Nsz) {
        u32x4 w;
        w.x = pk2(t[(kc + 0) * 65 + n], t[(kc + 1) * 65 + n]); w.y = pk2(t[(kc + 2) * 65 + n], t[(kc + 3) * 65 + n]);
        w.z = pk2(t[(kc + 4) * 65 + n], t[(kc + 5) * 65 + n]); w.w = pk2(t[(kc + 6) * 65 + n], t[(kc + 7) * 65 + n]);
        *(u32x4*)(dst + (size_t)rowmap(n0 + n) * ld_dst + k0 + kc) = w;
    }
}
struct MapId { DI int operator()(int n) const { return n; } };
struct MapIn { DI int operator()(int n) const { return n < 1476 ? n : n + 60; } };
struct MapE1 { DI int operator()(int n) const { const int hi = n >= 1024 ? 1 : 0, q = n - hi * 1024; return (q >> 7) * 256 + hi * 128 + (q & 127); } };

DI void phase0(const Args& a, LAS unsigned char* lds) {
    unsigned char* ws = a.ws;
    const int tid = otid();
    const size_t gtid = (size_t)blockIdx.x * NT + tid, gstride = (size_t)gridDim.x * NT;
    for (size_t i = gtid; i < 60 * 1024 / 2; i += gstride) ((unsigned*)(ws + WS_WIN + (size_t)1476 * 1024 * 2))[i] = 0u;
    for (size_t i = gtid; i < 32 * 1024; i += gstride) { const int e = (int)(i >> 10), k = (int)(i & 1023); const float w = a.in[I_WR][k * 32 + e] * a.in[I_N2G][k]; const u16 h = f2bf(w); ((u16*)(ws + WS_WR))[i] = h; ((u16*)(ws + WS_WR))[32 * 1024 + i] = f2bf(w - bf2f(h)); }
    for (size_t i = gtid; i < 4 * 128 * 128; i += gstride) { const int tt = (int)((i >> 7) & 127), ss = (int)(i & 127); ((u16*)(ws + WS_WSP))[i] = f2bf(ss <= tt ? a.in[I_WSP][i] : 0.f); }
    {
        const int wid = tid >> 6, lane = tid & 63;
        for (int row = blockIdx.x * 8 + wid; row < T; row += gridDim.x * 8) {
            const float* xr = a.in[I_X] + (size_t)row * 1024; u16* xb = (u16*)(ws + WS_XB) + (size_t)row * 1024;
            float ss = 0.f;
#pragma unroll
            for (int i = 0; i < 4; ++i) {
                const f32x4 v = *(const f32x4*)(xr + i * 256 + lane * 4);
                ss += (v[0] * v[0] + v[1] * v[1]) + (v[2] * v[2] + v[3] * v[3]);
                u32x2 w; w.x = pk2(v[0], v[1]); w.y = pk2(v[2], v[3]);
                *(u32x2*)(xb + i * 256 + lane * 4) = w;
            }
#pragma unroll
            for (int o = 32; o >= 1; o >>= 1) ss += __shfl_xor(ss, o);
            if (lane == 0) ((float*)(ws + WS_RS1))[row] = __builtin_amdgcn_rsqf(ss * (1.0f / 1024.0f) + EPS);
        }
    }
    constexpr int U_IN = 16 * 56, U_UQ = 4 * 16, U_QI = 4 * 4, U_PA = 8 * 16, U_OUT = 16 * 16, U_E1 = 32 * 16 * 32, U_E2 = 32 * 16 * 16, U_CB = 64;
    constexpr int U_TOT = U_IN + U_UQ + U_QI + U_PA + U_OUT + U_E1 + U_E2 + U_CB;
    for (int u = blockIdx.x; u < U_TOT; u += gridDim.x) {
        int v = u;
        if (v < U_IN) { tr_tile(lds, a.in[I_WIN], 3524, 3524, (v & 15) * 64, (v >> 4) * 64, a.in[I_N1G], 1.0f, (u16*)(ws + WS_WIN), 1024, MapIn()); continue; }
        v -= U_IN;
        if (v < U_UQ) { tr_tile(lds, a.in[I_WUQ], 1024, 1024, (v & 3) * 64, (v >> 2) * 64, a.in[I_QLG], 1.0f, (u16*)(ws + WS_WQ), 256, MapId()); continue; }
        v -= U_UQ;
        if (v < U_QI) { tr_tile(lds, a.in[I_WQI], 256, 256, (v & 3) * 64, (v >> 2) * 64, a.in[I_QLG], 1.0f, (u16*)(ws + WS_WQ) + 1024 * 256, 256, MapId()); continue; }
        v -= U_QI;
        if (v < U_PA) { tr_tile(lds, a.in[I_WPA], 1024, 1024, (v & 7) * 64, (v >> 3) * 64, nullptr, 1.0f, (u16*)(ws + WS_WCAT), 1536, MapId()); continue; }
        v -= U_PA;
        if (v < U_OUT) { tr_tile(lds, a.in[I_WOUT], 1024, 1024, (v & 15) * 64, (v >> 4) * 64, nullptr, 1.0f, (u16*)(ws + WS_WOUT), 1024, MapId()); continue; }
        v -= U_OUT;
        if (v < U_E1) { const int e = v >> 9, w = v & 511; tr_tile<true>(lds, a.in[I_WE1] + (size_t)e * 1024 * 2048, 2048, 2048, (w & 15) * 64, (w >> 4) * 64, a.in[I_N2G], 64.0f, (u16*)(ws + WS_WE1 + (size_t)e * 2048 * 1024), 1024, MapE1()); continue; }
        v -= U_E1;
        if (v < U_E2) { const int e = v >> 8, w = v & 255; tr_tile<true>(lds, a.in[I_WE2] + (size_t)e * 1024 * 1024, 1024, 1024, (w & 15) * 64, (w >> 4) * 64, nullptr, 64.0f, (u16*)(ws + WS_WE2 + (size_t)e * 1024 * 1024), 1024, MapId()); continue; }
        v -= U_E2;
        {
            const int h = v >> 3, c0 = (v & 7) * 16;
            LAS float* t = (LAS float*)lds;
            __syncthreads();
            for (int i = tid; i < 1024; i += NT) t[i] = a.in[I_WUV][(size_t)h * 128 * 64 + (size_t)c0 * 64 + i];
            __syncthreads();
            for (int nn = tid; nn < 1024; nn += NT) {
                float accv[16];
#pragma unroll
                for (int i = 0; i < 16; ++i) accv[i] = 0.f;
                for (int vv = 0; vv < 64; ++vv) {
                    const float pb = a.in[I_WPB][(size_t)(h * 64 + vv) * 1024 + nn];
#pragma unroll
                    for (int i = 0; i < 16; ++i) accv[i] += t[i * 64 + vv] * pb;
                }
                u32x4 w0, w1;
                w0.x = pk2(accv[0], accv[1]); w0.y = pk2(accv[2], accv[3]); w0.z = pk2(accv[4], accv[5]); w0.w = pk2(accv[6], accv[7]);
                w1.x = pk2(accv[8], accv[9]); w1.y = pk2(accv[10], accv[11]); w1.z = pk2(accv[12], accv[13]); w1.w = pk2(accv[14], accv[15]);
                u16* d = (u16*)(ws + WS_WCAT) + (size_t)nn * 1536 + 512 + h * 128 + c0;
                *(u32x4*)d = w0; *(u32x4*)(d + 8) = w1;
            }
        }
    }
}

DI void gmlp_unit(const Args& a, LAS unsigned char* lds, int u) {
    unsigned char* ws = a.ws;
    const int tid = otid(), wid = tid >> 6, lane = tid & 63, fr = lane & 15, fq = lane >> 4;
    const int g = u & 3, row0 = (u >> 2) * 128;
    const u16* H = (const u16*)(ws + WS_H);
    LAS u16* img = (LAS u16*)lds;
    __syncthreads();
    {
        const int s = tid & 127, cset = tid >> 7;
        const f32x4 sq = *(const f32x4*)((const float*)(ws + WS_SSQ) + (size_t)(row0 + s) * 32 + g * 4);
        const float rs = __builtin_amdgcn_rsqf(((sq[0] + sq[1]) + (sq[2] + sq[3])) * (1.0f / 128.0f) + EPS);
#pragma unroll
        for (int it = 0; it < 4; ++it) {
            const int c = cset + 4 * it;
            const u32x4 raw = *(const u32x4*)(H + (size_t)(row0 + s) * NIN + 512 + g * 128 + 8 * c);
            const float* vg = a.in[I_VG] + 8 * c;
            float f[8] = {bflo(raw.x), bfhi(raw.x), bflo(raw.y), bfhi(raw.y), bflo(raw.z), bfhi(raw.z), bflo(raw.w), bfhi(raw.w)};
#pragma unroll
            for (int i = 0; i < 8; ++i) img[(8 * c + i) * 136 + s] = f2bf(f[i] * rs * vg[i]);
        }
    }
    __syncthreads();
    const u16* W = (const u16*)(ws + WS_WSP) + (size_t)g * 128 * 128 + (size_t)(16 * wid + fr) * 128;
    f32x4 acc[8];
#pragma unroll
    for (int i = 0; i < 8; ++i) acc[i] = (f32x4){0.f, 0.f, 0.f, 0.f};
    const int nks = (16 * wid + 15) / 32 + 1;
    for (int ks = 0; ks < nks; ++ks) {
        const bf16x8 bw = *(const bf16x8*)(W + ks * 32 + 8 * fq);
#pragma unroll
        for (int i = 0; i < 8; ++i) {
            const bf16x8 av = *(const LAS bf16x8*)(img + (16 * i + fr) * 136 + ks * 32 + 8 * fq);
            acc[i] = __builtin_amdgcn_mfma_f32_16x16x32_bf16(av, bw, acc[i], 0, 0, 0);
        }
    }
    const int t = 16 * wid + fr;
    const float bias = a.in[I_BSP][g * 128 + t];
    u16* YO = (u16*)(ws + WS_YO);
#pragma unroll
    for (int i = 0; i < 8; ++i) {
        const int d = 16 * i + 4 * fq;
        const u32x2 uu = *(const u32x2*)(H + (size_t)(row0 + t) * NIN + g * 128 + d);
        const float y0 = bflo(uu.x) * (acc[i][0] + bias), y1 = bfhi(uu.x) * (acc[i][1] + bias), y2 = bflo(uu.y) * (acc[i][2] + bias), y3 = bfhi(uu.y) * (acc[i][3] + bias);
        u32x2 w; w.x = pk2(y0, y1); w.y = pk2(y2, y3);
        *(u32x2*)(YO + (size_t)(row0 + t) * 1536 + g * 128 + d) = w;
    }
}

DI void kvnorm(const Args& a) {
    unsigned char* ws = a.ws;
    const u16* H = (const u16*)(ws + WS_H); const float* SSQ = (const float*)(ws + WS_SSQ);
    const size_t gtid = (size_t)blockIdx.x * NT + otid(), gstride = (size_t)gridDim.x * NT;
    for (size_t idx = gtid; idx < (size_t)T * 24; idx += gstride) {
        const int row = (int)(idx / 24), c = (int)(idx % 24);
        const u16* src; u16* dst; const float* gain; float rs;
        if (c < 16) {
            const f32x4 sq = *(const f32x4*)(SSQ + (size_t)row * 32 + 24);
            rs = __builtin_amdgcn_rsqf(((sq[0] + sq[1]) + (sq[2] + sq[3])) * (1.0f / 128.0f) + EPS);
            src = H + (size_t)row * NIN + 1280 + 8 * c; dst = (u16*)(ws + WS_KVN) + (size_t)row * 128 + 8 * c; gain = a.in[I_KVG] + 8 * c;
        } else {
            const int cc = c - 16;
            rs = __builtin_amdgcn_rsqf((SSQ[(size_t)row * 32 + 28] + SSQ[(size_t)row * 32 + 29]) * (1.0f / 64.0f) + EPS);
            src = H + (size_t)row * NIN + 1408 + 8 * cc; dst = nullptr; gain = a.in[I_KIG] + 8 * cc;
            const u32x4 raw = *(const u32x4*)src;
            u32x2 w8;
            w8.x = pk4_i8(bflo(raw.x) * rs * gain[0], bfhi(raw.x) * rs * gain[1], bflo(raw.y) * rs * gain[2], bfhi(raw.y) * rs * gain[3]);
            w8.y = pk4_i8(bflo(raw.z) * rs * gain[4], bfhi(raw.z) * rs * gain[5], bflo(raw.w) * rs * gain[6], bfhi(raw.w) * rs * gain[7]);
            *(u32x2*)(ws + WS_KIN + (size_t)row * 64 + 8 * cc) = w8;
            continue;
        }
        const u32x4 raw = *(const u32x4*)src;
        u32x4 w;
        w.x = pk2(bflo(raw.x) * rs * gain[0], bfhi(raw.x) * rs * gain[1]); w.y = pk2(bflo(raw.y) * rs * gain[2], bfhi(raw.y) * rs * gain[3]);
        w.z = pk2(bflo(raw.z) * rs * gain[4], bfhi(raw.z) * rs * gain[5]); w.w = pk2(bflo(raw.w) * rs * gain[6], bfhi(raw.w) * rs * gain[7]);
        *(u32x4*)dst = w;
    }
}

constexpr int P3_ROWS = 0, P3_HIST = 131072, P3_LIST = 147456;
DI unsigned f2key(float f) { const unsigned u = __float_as_uint(f); return (u & 0x80000000u) ? ~u : (u | 0x80000000u); }
DI int wave_incl_scan(int v, int lane) {
#pragma unroll
    for (int o = 1; o < 64; o <<= 1) { const int t = __shfl_up(v, o); if (lane >= o) v += t; }
    return v;
}
DI int wave_suffix_scan(int v, int lane) {
#pragma unroll
    for (int o = 1; o < 64; o <<= 1) { const int t = __shfl_down(v, o); if (lane + o < 64) v += t; }
    return v;
}
DI unsigned pk_gt(unsigned kw, unsigned xw, unsigned one) {
    unsigned d, m;
    asm("v_pk_sub_u16 %0, %1, %2 clamp" : "=v"(d) : "v"(kw), "v"(xw));
    asm("v_pk_min_u16 %0, %1, %2" : "=v"(m) : "v"(d), "v"(one));
    return m;
}
DI unsigned pk_subs(unsigned kw, unsigned xw) { unsigned d; asm("v_pk_sub_u16 %0, %1, %2 clamp" : "=v"(d) : "v"(kw), "v"(xw)); return d; }
DI unsigned pk_min1(unsigned d, unsigned one) { unsigned m; asm("v_pk_min_u16 %0, %1, %2" : "=v"(m) : "v"(d), "v"(one)); return m; }
DI unsigned pk_add(unsigned a, unsigned b) { unsigned r; asm("v_pk_add_u16 %0, %1, %2" : "=v"(r) : "v"(a), "v"(b)); return r; }
DI int wave_sum(int v) {
    v += __builtin_amdgcn_update_dpp(0, v, 0xB1, 0xf, 0xf, false);
    v += __builtin_amdgcn_update_dpp(0, v, 0x4E, 0xf, 0xf, false);
    v += __builtin_amdgcn_update_dpp(0, v, 0x141, 0xf, 0xf, false);
    v += __builtin_amdgcn_update_dpp(0, v, 0x140, 0xf, 0xf, false);
    return __builtin_amdgcn_readlane(v, 0) + __builtin_amdgcn_readlane(v, 16) + __builtin_amdgcn_readlane(v, 32) + __builtin_amdgcn_readlane(v, 48);
}
DI int rowaddr(int p) { return (p & ~511) | ((p & 63) << 3) | ((p >> 6) & 7); }
typedef unsigned short us2_t __attribute__((ext_vector_type(2)));
DI unsigned dot2acc(unsigned flags, unsigned wts, unsigned acc) { return __builtin_amdgcn_udot2(__builtin_bit_cast(us2_t, flags), __builtin_bit_cast(us2_t, wts), acc, false); }
DI void select_top16(LAS u16* row, LAS u16* list, int N, int lane) {
    const int Nup = (N + 511) & ~511, niter = Nup >> 9;
    for (int p = N + lane; p < Nup; p += 64) row[rowaddr(p)] = (u16)0;
    wave_lds_sync();
    u32x4 kr[16];
#pragma unroll
    for (int i = 0; i < 16; ++i) { kr[i] = (u32x4){0u, 0u, 0u, 0u}; if (i < niter) kr[i] = *(LAS const u32x4*)(row + i * 512 + lane * 8); }
    const unsigned one = 0x00010001u;
    auto count_gt = [&](unsigned x) -> int {
        const unsigned xw = x | (x << 16);
        unsigned acc = 0u, acc1 = 0u, acc2 = 0u, acc3 = 0u;
#pragma unroll
        for (int c = 0; c < 4; ++c) {
            if (4 * c < niter) {
                unsigned d[16];
#pragma unroll
                for (int i = 0; i < 4; ++i) { d[4 * i] = pk_subs(kr[4 * c + i].x, xw); d[4 * i + 1] = pk_subs(kr[4 * c + i].y, xw); d[4 * i + 2] = pk_subs(kr[4 * c + i].z, xw); d[4 * i + 3] = pk_subs(kr[4 * c + i].w, xw); }
#pragma unroll
                for (int i = 0; i < 16; ++i) d[i] = pk_min1(d[i], one);
#pragma unroll
                for (int i = 0; i < 16; i += 4) { acc = dot2acc(d[i], one, acc); acc1 = dot2acc(d[i + 1], one, acc1); acc2 = dot2acc(d[i + 2], one, acc2); acc3 = dot2acc(d[i + 3], one, acc3); }
            }
        }
        return wave_sum((int)((acc + acc1) + (acc2 + acc3)));
    };
    unsigned T = 0u; int cge = Nup;
#pragma unroll 1
    for (int bit = 15; bit >= 0; --bit) {
        const unsigned cand = T | (1u << bit);
        const int cnt = count_gt(cand - 1u);
        if (cnt >= 256) { T = cand; cge = cnt; }
    }
    auto build = [&](unsigned x, unsigned (&M)[4]) {
        const unsigned xw = x | (x << 16);
#pragma unroll
        for (int c = 0; c < 4; ++c) {
            M[c] = 0u;
            if (4 * c < niter) {
#pragma unroll
                for (int i = 4 * c; i < 4 * c + 4; ++i) {
                    unsigned byte = dot2acc(pk_gt(kr[i].x, xw, one), 0x00020001u, 0u);
                    byte = dot2acc(pk_gt(kr[i].y, xw, one), 0x00080004u, byte);
                    byte = dot2acc(pk_gt(kr[i].z, xw, one), 0x00200010u, byte);
                    byte = dot2acc(pk_gt(kr[i].w, xw, one), 0x00800040u, byte);
                    M[c] |= byte << (8 * (i & 3));
                }
            }
        }
    };
    unsigned M[4];
    build(T - 1u, M);
    if (cge != 256) {
        unsigned G[4]; build(T, G);
        unsigned E[4];
#pragma unroll
        for (int c = 0; c < 4; ++c) E[c] = M[c] & ~G[c];
        const int need = 256 - (cge - wave_sum((int)(__builtin_popcount(E[0]) + __builtin_popcount(E[1]) + __builtin_popcount(E[2]) + __builtin_popcount(E[3]))));
        auto below = [&](int B, int c) -> unsigned { const int nb = B - 32 * c; return nb <= 0 ? 0u : (nb >= 32 ? 0xffffffffu : ((1u << nb) - 1u)); };
        auto ties_below = [&](int B) -> int {
            return wave_sum((int)(__builtin_popcount(E[0] & below(B, 0)) + __builtin_popcount(E[1] & below(B, 1)) + __builtin_popcount(E[2] & below(B, 2)) + __builtin_popcount(E[3] & below(B, 3))));
        };
        int lo = 0, hi = 127;
#pragma unroll 1
        while (lo < hi) { const int mid = (lo + hi) >> 1; if (ties_below(mid + 1) >= need) hi = mid; else lo = mid + 1; }
        const int Bs = lo, r = need - ties_below(Bs);
        const unsigned ew = Bs < 32 ? E[0] : (Bs < 64 ? E[1] : (Bs < 96 ? E[2] : E[3]));
        const bool tb = ((ew >> (Bs & 31)) & 1u) != 0u;
        const unsigned long long em = __ballot(tb);
        const bool take_row = tb && __builtin_popcountll(em & ((1ull << lane) - 1ull)) < r;
#pragma unroll
        for (int c = 0; c < 4; ++c) {
            unsigned tk = E[c] & below(Bs, c);
            if ((Bs >> 5) == c && take_row) tk |= 1u << (Bs & 31);
            M[c] = G[c] | tk;
        }
    }
    const int kl = __builtin_popcount(M[0]) + __builtin_popcount(M[1]) + __builtin_popcount(M[2]) + __builtin_popcount(M[3]);
    int wp = wave_incl_scan(kl, lane) - kl;
#pragma unroll
    for (int c = 0; c < 4; ++c) {
        unsigned m = M[c];
        while (m) { const int b = __builtin_ctz(m); list[wp] = (u16)((32 * c + b) * 64 + lane); ++wp; m &= m - 1u; }
    }
}

DI void dsa_phase(const Args& a, LAS unsigned char* lds) {
    unsigned char* ws = a.ws;
    const int tid = otid(), wid = __builtin_amdgcn_readfirstlane(tid >> 6), lane = tid & 63, fr = lane & 15, fq = lane >> 4;
    const unsigned char* QI = (const unsigned char*)(ws + WS_QI); const unsigned char* KIN = (const unsigned char*)(ws + WS_KIN); const u16* KVN = (const u16*)(ws + WS_KVN);
    const u16* Q = (const u16*)(ws + WS_Q); const float* WI = (const float*)(ws + WS_WI); u16* YO = (u16*)(ws + WS_YO);
    LAS u16* rows = (LAS u16*)(lds + P3_ROWS);
    for (int gi = blockIdx.x; gi < T / 8; gi += gridDim.x) {
        const int b = gi & 3, t0 = S - 8 - 8 * (gi >> 2);
        const size_t brow = (size_t)b * S;
        const int ntile = (t0 + 8 + 15) >> 4;
        __syncthreads();
        {
            typedef int i32x4_t __attribute__((ext_vector_type(4)));
            i32x4_t qa[2]; f32x4 wi[2];
#pragma unroll
            for (int rg = 0; rg < 2; ++rg) {
                qa[rg] = *(const i32x4_t*)(QI + (brow + t0 + 4 * rg + (fr >> 2)) * 256 + (fr & 3) * 64 + 16 * fq);
                wi[rg] = *(const f32x4*)(WI + (brow + t0 + 4 * rg + fq) * 4);
            }
            auto ldk = [&](i32x4_t (&kf)[4], int jt0) {
#pragma unroll
                for (int u = 0; u < 4; ++u) {
                    const int jt = (jt0 + 8 * u) < ntile ? (jt0 + 8 * u) : (ntile - 1);
                    kf[u] = *(const i32x4_t*)(KIN + (brow + jt * 16 + fr) * 64 + 16 * fq);
                }
            };
            auto cmpk = [&](const i32x4_t (&kf)[4], int jt0) {
#pragma unroll
                for (int u = 0; u < 4; ++u) {
                    const int jt = jt0 + 8 * u;
                    if (jt < ntile) {
#pragma unroll
                        for (int rg = 0; rg < 2; ++rg) {
                            i32x4_t d = {0, 0, 0, 0};
                            d = __builtin_amdgcn_mfma_i32_16x16x64_i8(qa[rg], kf[u], d, 0, 0, 0);
                            const float sc = (((float)max(d[0], 0) * wi[rg][0] + (float)max(d[1], 0) * wi[rg][1]) + (float)max(d[2], 0) * wi[rg][2]) + (float)max(d[3], 0) * wi[rg][3];
                            rows[(4 * rg + fq) * 8192 + rowaddr(jt * 16 + fr)] = (u16)(f2key(sc) >> 16);
                        }
                    }
                }
            };
            i32x4_t kA[4], kB[4];
            if (wid < ntile) ldk(kA, wid);
            for (int jt0 = wid; jt0 < ntile; jt0 += 64) {
                const bool hasB = jt0 + 32 < ntile;
                if (hasB) ldk(kB, jt0 + 32);
                cmpk(kA, jt0);
                if (hasB) { if (jt0 + 64 < ntile) ldk(kA, jt0 + 64); cmpk(kB, jt0 + 32); }
            }
        }
        __syncthreads();
        {
            const int q = wid, t = t0 + q, N = t + 1;
            LAS u16* row = rows + q * 8192;
            LAS u16* list = (LAS u16*)(lds + P3_LIST + q * 512);
            int cnt;
            if (N <= 256) { for (int p = lane; p < 256; p += 64) list[p] = p < N ? (u16)p : (u16)0; cnt = N; }
            else { select_top16(row, list, N, lane); cnt = 256; }
            wave_lds_sync();
            bf16x8 qf[4];
            {
                const int head = fr & 7;
                const u16* qrow = Q + (brow + t) * 1024 + head * 128;
                float f[4][8]; float ss = 0.f;
#pragma unroll
                for (int ks = 0; ks < 4; ++ks) {
                    const u32x4 raw = *(const u32x4*)(qrow + ks * 32 + 8 * fq);
                    f[ks][0] = bflo(raw.x); f[ks][1] = bfhi(raw.x); f[ks][2] = bflo(raw.y); f[ks][3] = bfhi(raw.y); f[ks][4] = bflo(raw.z); f[ks][5] = bfhi(raw.z); f[ks][6] = bflo(raw.w); f[ks][7] = bfhi(raw.w);
#pragma unroll
                    for (int j = 0; j < 8; ++j) ss += f[ks][j] * f[ks][j];
                }
                ss += __shfl_xor(ss, 16); ss += __shfl_xor(ss, 32);
                const float rq = __builtin_amdgcn_rsqf(ss * (1.0f / 128.0f) + EPS) * (0.08838834764831845f * 1.4426950408889634f);
#pragma unroll
                for (int ks = 0; ks < 4; ++ks) {
                    const float* qg = a.in[I_QNG] + ks * 32 + 8 * fq;
                    u32x4 w;
                    w.x = pk2(f[ks][0] * rq * qg[0], f[ks][1] * rq * qg[1]); w.y = pk2(f[ks][2] * rq * qg[2], f[ks][3] * rq * qg[3]);
                    w.z = pk2(f[ks][4] * rq * qg[4], f[ks][5] * rq * qg[5]); w.w = pk2(f[ks][6] * rq * qg[6], f[ks][7] * rq * qg[7]);
                    qf[ks] = __builtin_bit_cast(bf16x8, w);
                }
            }
            LAS unsigned char* img = (LAS unsigned char*)row;
            const int nsteps = (cnt + 31) >> 5;
            f32x4 oacc[8];
#pragma unroll
            for (int i = 0; i < 8; ++i) oacc[i] = (f32x4){0.f, 0.f, 0.f, 0.f};
            float mrun = -3.0e38f, lpart = 0.f;
            auto issue = [&](u32x4 (&pf)[8], int pp) {
#pragma unroll
                for (int it = 0; it < 8; ++it) { const int piece = it * 64 + lane; const unsigned key = list[pp * 32 + (piece >> 4)]; pf[it] = *(const u32x4*)(KVN + (brow + key) * 128 + 8 * (piece & 15)); }
            };
            auto step = [&](u32x4 (&pf)[8], int pp) {
#pragma unroll
                for (int it = 0; it < 8; ++it) { const int piece = it * 64 + lane; *(LAS u32x4*)(img + (piece >> 4) * 288 + (piece & 15) * 16) = pf[it]; }
                if (pp + 1 < nsteps) issue(pf, pp + 1);
                wave_lds_sync();
                __builtin_amdgcn_sched_barrier(0);
                f32x4 sa = {0.f, 0.f, 0.f, 0.f}, sb = {0.f, 0.f, 0.f, 0.f};
#pragma unroll
                for (int ks = 0; ks < 4; ++ks) {
                    const bf16x8 a0 = *(LAS const bf16x8*)(img + fr * 288 + (ks * 32 + 8 * fq) * 2), a1 = *(LAS const bf16x8*)(img + (16 + fr) * 288 + (ks * 32 + 8 * fq) * 2);
                    sa = __builtin_amdgcn_mfma_f32_16x16x32_bf16(a0, qf[ks], sa, 0, 0, 0); sb = __builtin_amdgcn_mfma_f32_16x16x32_bf16(a1, qf[ks], sb, 0, 0, 0);
                }
                if (pp * 32 + 32 > cnt) {
                    const int pb0 = pp * 32 + 4 * fq;
#pragma unroll
                    for (int r = 0; r < 4; ++r) { if (pb0 + r >= cnt) sa[r] = -3.0e38f; if (pb0 + 16 + r >= cnt) sb[r] = -3.0e38f; }
                }
                float mx = fmaxf(fmaxf(fmaxf(sa[0], sa[1]), fmaxf(sa[2], sa[3])), fmaxf(fmaxf(sb[0], sb[1]), fmaxf(sb[2], sb[3])));
                mx = fmaxf(mx, __shfl_xor(mx, 16)); mx = fmaxf(mx, __shfl_xor(mx, 32));
                if (__ballot(mx > mrun) != 0ull) {
                    const float mnew = fmaxf(mrun, mx), alpha = __builtin_amdgcn_exp2f(mrun - mnew);
                    mrun = mnew; lpart *= alpha;
#pragma unroll
                    for (int cb = 0; cb < 8; ++cb) oacc[cb] *= alpha;
                }
                float ps = 0.f;
#pragma unroll
                for (int r = 0; r < 4; ++r) { sa[r] = __builtin_amdgcn_exp2f(sa[r] - mrun); sb[r] = __builtin_amdgcn_exp2f(sb[r] - mrun); ps += sa[r] + sb[r]; }
                lpart += ps;
                u32x4 pw; pw.x = pk2(sa[0], sa[1]); pw.y = pk2(sa[2], sa[3]); pw.z = pk2(sb[0], sb[1]); pw.w = pk2(sb[2], sb[3]);
                const bf16x8 pb = __builtin_bit_cast(bf16x8, pw);
#pragma unroll
                for (int cb = 0; cb < 8; ++cb) {
                    const s16x4 r0 = __builtin_amdgcn_ds_read_tr16_b64_v4i16((LAS s16x4*)(img + (4 * fq + (fr >> 2)) * 288 + (cb * 16 + 4 * (fr & 3)) * 2));
                    const s16x4 r1 = __builtin_amdgcn_ds_read_tr16_b64_v4i16((LAS s16x4*)(img + (16 + 4 * fq + (fr >> 2)) * 288 + (cb * 16 + 4 * (fr & 3)) * 2));
                    const bf16x8 av = {r0[0], r0[1], r0[2], r0[3], r1[0], r1[1], r1[2], r1[3]};
                    oacc[cb] = __builtin_amdgcn_mfma_f32_16x16x32_bf16(av, pb, oacc[cb], 0, 0, 0);
                    if (cb == 3) __builtin_amdgcn_sched_barrier(0);
                }
                wave_lds_sync();
            };
            u32x4 pf0[8];
            issue(pf0, 0);
#pragma unroll 1
            for (int pp = 0; pp < nsteps; ++pp) step(pf0, pp);
            float lsum = lpart; lsum += __shfl_xor(lsum, 16); lsum += __shfl_xor(lsum, 32);
            const float inv = __builtin_amdgcn_rcpf(lsum);
            if (fr < 8) {
                u16* orow = YO + (brow + t) * 1536 + 512 + fr * 128 + 4 * fq;
#pragma unroll
                for (int cb = 0; cb < 8; ++cb) { u32x2 w; w.x = pk2(oacc[cb][0] * inv, oacc[cb][1] * inv); w.y = pk2(oacc[cb][2] * inv, oacc[cb][3] * inv); *(u32x2*)(orow + cb * 16) = w; }
            }
        }
    }
}

constexpr int P6_LCNT = 0, P6_BASE = 128, P6_RSB = 256, P6_RI = 1024;
DI unsigned dpp_max_u32(unsigned v) {
    v = max(v, (unsigned)__builtin_amdgcn_update_dpp(0, (int)v, 0xB1, 0xf, 0xf, false));
    v = max(v, (unsigned)__builtin_amdgcn_update_dpp(0, (int)v, 0x4E, 0xf, 0xf, false));
    v = max(v, (unsigned)__builtin_amdgcn_update_dpp(0, (int)v, 0x141, 0xf, 0xf, false));
    v = max(v, (unsigned)__builtin_amdgcn_update_dpp(0, (int)v, 0x140, 0xf, 0xf, false));
    return v;
}
DI float key2f(unsigned k) { return __uint_as_float((k & 0x80000000u) ? (k & 0x7fffffffu) : ~k); }
DI void router_phase(const Args& a, LAS unsigned char* lds) {
    unsigned char* ws = a.ws;
    const int tid = otid(), wid = tid >> 6, lane = tid & 63, fr = lane & 15, fq = lane >> 4;
    LAS int* lcnt = (LAS int*)(lds + P6_LCNT); LAS int* lbase = (LAS int*)(lds + P6_BASE); LAS float* rsb = (LAS float*)(lds + P6_RSB); LAS int* RI = (LAS int*)(lds + P6_RI);
    const u16* WRH = (const u16*)(ws + WS_WR); const u16* WRL = WRH + 32 * 1024;
    unsigned* CNT = (unsigned*)(ws + WS_CTL);
    for (int rg = blockIdx.x; rg < T / 128; rg += gridDim.x) {
        __syncthreads();
        if (tid < 32) lcnt[tid] = 0;
        __syncthreads();
        {
            const int row = rg * 128 + wid * 16 + fr;
            const float* xr = a.out + (size_t)row * 1024 + 8 * fq;
            f32x4 acc[2] = {{0.f, 0.f, 0.f, 0.f}, {0.f, 0.f, 0.f, 0.f}};
            float ss = 0.f;
#pragma unroll 4
            for (int ks = 0; ks < 32; ++ks) {
                const f32x4 x0 = *(const f32x4*)(xr + ks * 32), x1 = *(const f32x4*)(xr + ks * 32 + 4);
                ss += ((x0[0] * x0[0] + x0[1] * x0[1]) + (x0[2] * x0[2] + x0[3] * x0[3])) + ((x1[0] * x1[0] + x1[1] * x1[1]) + (x1[2] * x1[2] + x1[3] * x1[3]));
                u32x4 hw; hw.x = pk2(x0[0], x0[1]); hw.y = pk2(x0[2], x0[3]); hw.z = pk2(x1[0], x1[1]); hw.w = pk2(x1[2], x1[3]);
                u32x4 lw; lw.x = pk2(x0[0] - bflo(hw.x), x0[1] - bfhi(hw.x)); lw.y = pk2(x0[2] - bflo(hw.y), x0[3] - bfhi(hw.y)); lw.z = pk2(x1[0] - bflo(hw.z), x1[1] - bfhi(hw.z)); lw.w = pk2(x1[2] - bflo(hw.w), x1[3] - bfhi(hw.w));
                const bf16x8 xh = __builtin_bit_cast(bf16x8, hw), xl = __builtin_bit_cast(bf16x8, lw);
#pragma unroll
                for (int nt = 0; nt < 2; ++nt) {
                    const bf16x8 wh = *(const bf16x8*)(WRH + (size_t)(nt * 16 + fr) * 1024 + ks * 32 + 8 * fq), wl = *(const bf16x8*)(WRL + (size_t)(nt * 16 + fr) * 1024 + ks * 32 + 8 * fq);
                    acc[nt] = __builtin_amdgcn_mfma_f32_16x16x32_bf16(xh, wh, acc[nt], 0, 0, 0);
                    acc[nt] = __builtin_amdgcn_mfma_f32_16x16x32_bf16(xl, wh, acc[nt], 0, 0, 0);
                    acc[nt] = __builtin_amdgcn_mfma_f32_16x16x32_bf16(xh, wl, acc[nt], 0, 0, 0);
                }
            }
            ss += __shfl_xor(ss, 16); ss += __shfl_xor(ss, 32);
            const float rsrow = __builtin_amdgcn_rsqf(ss * (1.0f / 1024.0f) + EPS);
            if (fq == 0) rsb[wid * 16 + fr] = rsrow;
            {
                unsigned char* xn = ws + WS_XN2 + (size_t)row * 1024 + 8 * fq;
#pragma unroll 4
                for (int ks = 0; ks < 32; ++ks) {
                    const f32x4 x0 = *(const f32x4*)(xr + ks * 32), x1 = *(const f32x4*)(xr + ks * 32 + 4);
                    u32x2 w; w.x = pk4_fp8(x0[0] * rsrow, x0[1] * rsrow, x0[2] * rsrow, x0[3] * rsrow); w.y = pk4_fp8(x1[0] * rsrow, x1[1] * rsrow, x1[2] * rsrow, x1[3] * rsrow);
                    *(u32x2*)(xn + ks * 32) = w;
                }
            }
            wave_lds_sync();
            const float b0 = a.in[I_BR][fr], b1 = a.in[I_BR][16 + fr];
#pragma unroll
            for (int r = 0; r < 4; ++r) {
                const float rs = rsb[wid * 16 + 4 * fq + r];
                unsigned k0 = (f2key(acc[0][r] * rs + b0) & ~31u) | (unsigned)(31 - fr), k1 = (f2key(acc[1][r] * rs + b1) & ~31u) | (unsigned)(15 - fr);
                unsigned sel[4];
#pragma unroll
                for (int k = 0; k < 4; ++k) {
                    const unsigned best = dpp_max_u32(k0 > k1 ? k0 : k1);
                    sel[k] = best;
                    if (k0 == best) k0 = 0u;
                    if (k1 == best) k1 = 0u;
                }
                const float v0 = key2f(sel[0] & ~31u), e1 = __expf(key2f(sel[1] & ~31u) - v0), e2 = __expf(key2f(sel[2] & ~31u) - v0), e3 = __expf(key2f(sel[3] & ~31u) - v0);
                const float inv = 1.0f / (1.0f + e1 + e2 + e3);
                if (fr < 4) {
                    const unsigned sk = fr == 0 ? sel[0] : (fr == 1 ? sel[1] : (fr == 2 ? sel[2] : sel[3]));
                    const int e = 31 - (int)(sk & 31u);
                    const float gt = (fr == 0 ? 1.0f : (fr == 1 ? e1 : (fr == 2 ? e2 : e3))) * inv;
                    const int ls = __hip_atomic_fetch_add(lcnt + e, 1, __ATOMIC_RELAXED, __HIP_MEMORY_SCOPE_WORKGROUP);
                    const int ri = ((wid * 16 + 4 * fq + r) * 4 + fr) * 4;
                    RI[ri + 0] = e; RI[ri + 1] = ls; RI[ri + 2] = __float_as_int(gt);
                }
            }
        }
        __syncthreads();
        if (tid < 32) lbase[tid] = (int)__hip_atomic_fetch_add(CNT + tid, (unsigned)lcnt[tid], __ATOMIC_RELAXED, __HIP_MEMORY_SCOPE_AGENT);
        __syncthreads();
        {
            const int rl = tid >> 2, k = tid & 3, row = rg * 128 + rl;
            const int e = RI[tid * 4 + 0], slot = lbase[e] + RI[tid * 4 + 1];
            ((int*)(ws + WS_LTOK))[(size_t)e * ECAP + slot] = row;
            ((float*)(ws + WS_LGATE))[(size_t)e * ECAP + slot] = __int_as_float(RI[tid * 4 + 2]);
            ((unsigned*)(ws + WS_ROUTE))[(size_t)row * 4 + k] = ((unsigned)e << 16) | (unsigned)slot;
        }
    }
}

DI void combine_phase(const Args& a, LAS unsigned char* lds) {
    unsigned char* ws = a.ws;
    LAS const int* tab = (LAS const int*)(lds + MOE_TAB);
    const int tid = otid(), wid = tid >> 6, lane = tid & 63;
    const u16* YB = (const u16*)(ws + WS_YB); const unsigned* ROUTE = (const unsigned*)(ws + WS_ROUTE);
    for (int row = blockIdx.x * 8 + wid; row < T; row += gridDim.x * 8) {
        size_t pos[4];
#pragma unroll
        for (int k = 0; k < 4; ++k) { const unsigned r = ROUTE[(size_t)row * 4 + k]; const int e = (int)(r >> 16), slot = (int)(r & 0xffffu); pos[k] = (size_t)tab[e] * 256 + slot; }
        float* orow = a.out + (size_t)row * 1024;
#pragma unroll
        for (int i = 0; i < 4; ++i) {
            f32x4 v = *(const f32x4*)(orow + i * 256 + lane * 4);
#pragma unroll
            for (int k = 0; k < 4; ++k) { const u32x2 y = *(const u32x2*)(YB + pos[k] * 1024 + i * 256 + lane * 4); v[0] += bflo(y.x); v[1] += bfhi(y.x); v[2] += bflo(y.y); v[3] += bfhi(y.y); }
            *(f32x4*)(orow + i * 256 + lane * 4) = v;
        }
    }
}

#define XB_TMO      128
#define XB_XCNT(j)  (256  + 64 * (j))
#define XB_XSUB(j)  (1280 + 64 * (j))
#define XB_XGEN(j)  (2304 + 64 * (j))
#define XB_TOP      3328
#define XB_TOPGEN   3392
#define XCD_BAR_WORDS 3456
#define XB_SPIN_CAP (1u << 18)

__device__ __forceinline__ unsigned xb_ld(unsigned* p)              { return __hip_atomic_load(p, __ATOMIC_RELAXED, __HIP_MEMORY_SCOPE_AGENT); }
__device__ __forceinline__ unsigned xb_add(unsigned* p, unsigned v) { return __hip_atomic_fetch_add(p, v, __ATOMIC_RELAXED, __HIP_MEMORY_SCOPE_AGENT); }
__device__ __forceinline__ unsigned xb_xcc_id() { return (unsigned)__builtin_amdgcn_s_getreg((3 << 11) | 20) & 0xFu; }
#define XB_SPIN(cond, bar) do { unsigned _sp = 0; while (cond) { __builtin_amdgcn_s_sleep(1); \
    if ((++_sp & 255u) == 0u) { if (xb_ld(&(bar)[XB_TMO])) break; if (_sp > XB_SPIN_CAP) { atomicAdd(&(bar)[XB_TMO], 1u); break; } } } } while (0)

struct XcdBarrier {
    unsigned* bar; unsigned x;
    volatile LAS unsigned* st;
};

__device__ __forceinline__ XcdBarrier xcd_barrier_post(unsigned* bar, volatile LAS unsigned* st) {
    XcdBarrier b; b.bar = bar; b.x = xb_xcc_id(); b.st = st;
    if (threadIdx.x == 0) (void)xb_add(&bar[XB_XCNT(b.x)], 1u);
    return b;
}
__device__ __forceinline__ void xcd_barrier_complete(unsigned* bar, unsigned x, unsigned& nloc, unsigned& nx) {
    const unsigned G = gridDim.x * gridDim.y * gridDim.z;
    unsigned sum, cnt, mine, sp = 0u;
    for (;;) {
        sum = 0u; cnt = 0u; mine = 0u;
#pragma unroll
        for (unsigned j = 0; j < 16; ++j) { const unsigned c = xb_ld(&bar[XB_XCNT(j)]); sum += c; cnt += (c > 0u) ? 1u : 0u; mine = (j == x) ? c : mine; }
        if (sum == G) break;
        __builtin_amdgcn_s_sleep(1);
        if ((++sp & 255u) == 0u) { if (xb_ld(&bar[XB_TMO])) break; if (sp > XB_SPIN_CAP) { atomicAdd(&bar[XB_TMO], 1u); break; } }
    }
    nloc = mine > 0u ? mine : 1u; nx = cnt > 0u ? cnt : 1u;
}

__device__ __forceinline__ void xcd_barrier(const XcdBarrier& b) {
    asm volatile("s_waitcnt vmcnt(0)" ::: "memory");
    __syncthreads();
    if (threadIdx.x == 0) {
        unsigned* bar = b.bar;
        __builtin_amdgcn_s_waitcnt(0);
        unsigned nloc = b.st[0], nx = b.st[1];
        if (nloc == 0u) { xcd_barrier_complete(bar, b.x, nloc, nx); b.st[0] = nloc; b.st[1] = nx; }
        const unsigned old = xb_add(&bar[XB_XSUB(b.x)], 1u);
        const unsigned gen = old / nloc;
        if (old + 1u == (gen + 1u) * nloc) {
            __builtin_amdgcn_fence(__ATOMIC_RELEASE, "agent");
            asm volatile("s_waitcnt vmcnt(0)" ::: "memory");
            const unsigned og = xb_add(&bar[XB_TOP], 1u);
            const unsigned tg = og / nx;
            if (og + 1u == (tg + 1u) * nx) xb_add(&bar[XB_TOPGEN], 1u);
            else XB_SPIN(xb_ld(&bar[XB_TOPGEN]) == tg, bar);
            __builtin_amdgcn_fence(__ATOMIC_ACQUIRE, "agent");
            xb_add(&bar[XB_XGEN(b.x)], 1u);
            asm volatile("s_waitcnt vmcnt(0)" ::: "memory");
        } else {
            XB_SPIN(xb_ld(&bar[XB_XGEN(b.x)]) == gen, bar);
            __builtin_amdgcn_fence(__ATOMIC_ACQUIRE, "agent");
            asm volatile("s_waitcnt vmcnt(0)" ::: "memory");
        }
    }
    __syncthreads();
}

__global__ void __launch_bounds__(NT, 2) fwd(Args a) {
    extern __shared__ __attribute__((aligned(16))) unsigned char lds_raw[];
    LAS unsigned char* lds = (LAS unsigned char*)lds_raw;
    cg::grid_group grid = cg::this_grid();
    unsigned char* ws = a.ws;
    const int G = gridDim.x, c = blockIdx.x;
    if (threadIdx.x < 2) ((volatile LAS unsigned*)(lds + LDS_BARST))[threadIdx.x] = 0u;
    __syncthreads();
    const XcdBarrier xbar = xcd_barrier_post((unsigned*)(ws + WS_BAR), (volatile LAS unsigned*)(lds + LDS_BARST));

    phase0(a, lds);
    grid.sync();
    {
        g8::PlainSched s; s.Abase = (const char*)(ws + WS_XB); s.Bbase = (const char*)(ws + WS_WIN); s.lda = 1024; s.ldb = 1024; s.K = 1024; s.nM = T / 256; s.nN = NIN / 256; s.G = G; s.c = c;
        EpiIn e; e.H = (u16*)(ws + WS_H); e.rs1 = (const float*)(ws + WS_RS1); e.SSQ = (float*)(ws + WS_SSQ); e.WI = (float*)(ws + WS_WI);
        g8::gemm_phase(lds, s, e);
    }
    xcd_barrier(xbar);
    {
        g8::PlainSched s; s.Abase = (const char*)(ws + WS_H) + 1024 * 2; s.Bbase = (const char*)(ws + WS_WQ); s.lda = NIN; s.ldb = 256; s.K = 256; s.nM = T / 256; s.nN = 5; s.G = G; s.c = c;
        EpiQ e; e.Q = (u16*)(ws + WS_Q); e.QI = (u16*)(ws + WS_QI); e.SSQ = (const float*)(ws + WS_SSQ);
        g8::gemm_phase(lds, s, e);
        for (int u = c; u < 1024; u += G) gmlp_unit(a, lds, u);
        kvnorm(a);
    }
    xcd_barrier(xbar);
    dsa_phase(a, lds);
    xcd_barrier(xbar);
    {
        g8::PlainSched s; s.Abase = (const char*)(ws + WS_YO); s.Bbase = (const char*)(ws + WS_WCAT); s.lda = 1536; s.ldb = 1536; s.K = 512; s.nM = T / 256; s.nN = 4; s.G = G; s.c = c;
        EpiMrg<0> e0; e0.OUT = (u16*)(ws + WS_TMP); e0.TMP = nullptr; e0.H = (const u16*)(ws + WS_H);
        g8::gemm_phase(lds, s, e0);
        s.Abase = (const char*)(ws + WS_YO) + 512 * 2; s.Bbase = (const char*)(ws + WS_WCAT) + 512 * 2; s.K = 1024;
        EpiMrg<1> e1; e1.OUT = (u16*)(ws + WS_MRG); e1.TMP = (const u16*)(ws + WS_TMP); e1.H = (const u16*)(ws + WS_H);
        g8::gemm_phase(lds, s, e1);
    }
    xcd_barrier(xbar);
    {
        g8::PlainSched s; s.Abase = (const char*)(ws + WS_MRG); s.Bbase = (const char*)(ws + WS_WOUT); s.lda = 1024; s.ldb = 1024; s.K = 1024; s.nM = T / 256; s.nN = 4; s.G = G; s.c = c;
        EpiOut e; e.out = a.out; e.x = a.in[I_X];
        g8::gemm_phase(lds, s, e);
    }
    xcd_barrier(xbar);
    router_phase(a, lds);
    xcd_barrier(xbar);
    moe_table(lds, (const unsigned*)(ws + WS_CTL));
    {
        MoeSched<8, true> s; s.Abase = (const char*)(ws + WS_XN2); s.Wbase = (const char*)(ws + WS_WE1); s.LTOK = (const int*)(ws + WS_LTOK); s.tab = (LAS const int*)(lds + MOE_TAB);
        s.lda = 1024; s.ldb = 1024; s.K = 1024; s.G = G; s.c = c; s.wstride = (size_t)2048 * 1024;
        EpiMoe1 e; e.ACT = (unsigned char*)(ws + WS_ACT); e.b1 = a.in[I_BE1];
        g8::gemm_phase<true>(lds, s, e);
    }
    xcd_barrier(xbar);
    {
        MoeSched<4, false> s; s.Abase = (const char*)(ws + WS_ACT); s.Wbase = (const char*)(ws + WS_WE2); s.LTOK = nullptr; s.tab = (LAS const int*)(lds + MOE_TAB);
        s.lda = 1024; s.ldb = 1024; s.K = 1024; s.G = G; s.c = c; s.wstride = (size_t)1024 * 1024;
        EpiMoe2 e; e.YB = (u16*)(ws + WS_YB); e.b2 = a.in[I_BE2]; e.LGATE = (const float*)(ws + WS_LGATE); e.tab = (LAS const int*)(lds + MOE_TAB);
        g8::gemm_phase<true>(lds, s, e);
    }
    xcd_barrier(xbar);
    combine_phase(a, lds);
}

extern "C" void kernel_launch(void* const* d_in, const int* in_sizes, int n_in, void* d_out, int out_size, void* d_ws, size_t ws_size, hipStream_t stream) {
    static int grid = 0;
    if (grid == 0) {
        int dev = 0, cus = 0, per_cu = 0;
        if (n_in != 23 || out_size != T * Dm || ws_size < WS_END) { fprintf(stderr, "kernel_launch: unexpected problem (n_in %d, out %d, ws %zu < %zu)\n", n_in, out_size, ws_size, (size_t)WS_END); grid = -1; return; }
        if (hipGetDevice(&dev) != hipSuccess || hipDeviceGetAttribute(&cus, hipDeviceAttributeMultiprocessorCount, dev) != hipSuccess) { grid = -1; return; }
        if (hipFuncSetAttribute((const void*)fwd, hipFuncAttributeMaxDynamicSharedMemorySize, LDS_BYTES) != hipSuccess) { fprintf(stderr, "hipFuncSetAttribute failed\n"); grid = -1; return; }
        if (hipOccupancyMaxActiveBlocksPerMultiprocessor(&per_cu, (const void*)fwd, NT, LDS_BYTES) != hipSuccess || per_cu < 1) { fprintf(stderr, "occupancy query failed (%d)\n", per_cu); grid = -1; return; }
        grid = cus;
        fprintf(stderr, "kernel_launch: cus %d per_cu %d grid %d ws %zu need %zu\n", cus, per_cu, grid, ws_size, (size_t)WS_END);
    }
    if (grid < 0) return;
    Args a{};
    for (int i = 0; i < 23; ++i) a.in[i] = (const float*)d_in[i];
    a.out = (float*)d_out; a.ws = (unsigned char*)d_ws; a.mask = 0xffffffffu; a.pad = 0u;
    if (hipMemsetAsync((char*)d_ws + WS_CTL, 0, 65536, stream) != hipSuccess) { fprintf(stderr, "memset failed\n"); return; }
    void* args[] = {&a};
    hipError_t e = hipLaunchCooperativeKernel((const void*)fwd, dim3(grid), dim3(NT), args, LDS_BYTES, stream);
    if (e != hipSuccess) fprintf(stderr, "cooperative launch failed: %s (grid %d)\n", hipGetErrorString(e), grid);
}
```

```cpp
#include <hip/hip_runtime.h>
#include <hip/hip_cooperative_groups.h>
#include <cstdio>
#include <cstdint>
namespace cg = cooperative_groups;

#define LAS __attribute__((address_space(3)))
#define DI __device__ __forceinline__
typedef unsigned short u16;
typedef short bf16x8 __attribute__((ext_vector_type(8)));
typedef short s16x4 __attribute__((ext_vector_type(4)));
typedef float f32x4 __attribute__((ext_vector_type(4)));
typedef float f32x2 __attribute__((ext_vector_type(2)));
typedef unsigned u32x4 __attribute__((ext_vector_type(4)));
typedef unsigned u32x2 __attribute__((ext_vector_type(2)));
typedef __bf16 bf2_t __attribute__((ext_vector_type(2)));
typedef int v8i_t __attribute__((ext_vector_type(8)));

constexpr int NT = 512;
constexpr int LDS_BYTES = 155648;
constexpr int Dm = 1024, Bsz = 4, S = 8192, T = Bsz * S;
constexpr int NIN = 3584;
constexpr int NE = 32, ECAP = 32768, PPAD = 131072 + NE * 256;
constexpr float EPS = 1e-6f;

constexpr size_t MiB = 1024 * 1024;
constexpr size_t WS_CTL = 0;
constexpr size_t WS_BAR = 16384;
constexpr int LDS_BARST = LDS_BYTES - 16;
constexpr size_t WS_WIN = 64 * 1024;
constexpr size_t WS_WQ = WS_WIN + (size_t)NIN * 1024 * 2;
constexpr size_t WS_WSP = WS_WQ + 1280 * 256 * 2;
constexpr size_t WS_WCAT = WS_WSP + 4 * 128 * 128 * 2;
constexpr size_t WS_WOUT = WS_WCAT + 1024 * 1536 * 2;
constexpr size_t WS_WR = WS_WOUT + 1024 * 1024 * 2;
constexpr size_t WS_WE1 = WS_WR + 32 * 1024 * 4;
constexpr size_t WS_WE2 = WS_WE1 + (size_t)32 * 2048 * 1024 * 2;
constexpr size_t WS_RS1 = WS_WE2 + (size_t)32 * 1024 * 1024 * 2;
constexpr size_t WS_SSQ = WS_RS1 + (size_t)T * 4;
constexpr size_t WS_WI = WS_SSQ + (size_t)T * 32 * 4;
constexpr size_t WS_ROUTE = WS_WI + (size_t)T * 4 * 4;
constexpr size_t WS_LTOK = WS_ROUTE + (size_t)T * 4 * 4;
constexpr size_t WS_LGATE = WS_LTOK + (size_t)NE * ECAP * 4;
constexpr size_t WS_LRS = WS_LGATE + (size_t)NE * ECAP * 4;
constexpr size_t WS_XN2 = WS_LRS + (size_t)NE * ECAP * 4;
constexpr size_t WS_R0 = WS_XN2 + (size_t)T * 1024 * 2;
constexpr size_t WS_XB = WS_R0;
constexpr size_t WS_H = WS_XB + (size_t)T * 1024 * 2;
constexpr size_t WS_Q = WS_H + (size_t)T * NIN * 2;
constexpr size_t WS_QI = WS_Q + (size_t)T * 1024 * 2;
constexpr size_t WS_KVN = WS_QI + (size_t)T * 256 * 2;
constexpr size_t WS_KIN = WS_KVN + (size_t)T * 128 * 2;
constexpr size_t WS_YO = WS_KIN + (size_t)T * 64 * 2;
constexpr size_t WS_TMP = WS_YO + (size_t)T * 1536 * 2;
constexpr size_t WS_MRG = WS_TMP + (size_t)T * 1024 * 2;
constexpr size_t WS_R0END = WS_MRG + (size_t)T * 1024 * 2;
constexpr size_t WS_ACT = WS_XB;
constexpr size_t WS_YB = WS_Q;
static_assert(WS_ACT + (size_t)PPAD * 1024 * 2 <= WS_Q, "ACT overlaps YB");
static_assert(WS_YB + (size_t)PPAD * 1024 * 2 <= WS_R0END, "YB too large");
constexpr size_t WS_END = WS_R0END;

struct Args { const float* in[23]; float* out; unsigned char* ws; unsigned mask; unsigned pad; };
enum { I_X = 0, I_N1G, I_WIN, I_QLG, I_WUQ, I_QNG, I_KVG, I_WUV, I_WQI, I_KIG, I_VG, I_WSP, I_BSP, I_WPA, I_WPB, I_WOUT, I_N2G, I_WR, I_BR, I_WE1, I_BE1, I_WE2, I_BE2 };

DI unsigned pk2(float a, float b) { f32x2 v = {a, b}; bf2_t r = __builtin_convertvector(v, bf2_t); return __builtin_bit_cast(unsigned, r); }
DI unsigned pk4_fp8(float a, float b, float c, float d) { unsigned w = 0u; w = (unsigned)__builtin_amdgcn_cvt_pk_fp8_f32(a, b, (int)w, false); w = (unsigned)__builtin_amdgcn_cvt_pk_fp8_f32(c, d, (int)w, true); return w; }
DI unsigned pk4_i8(float a, float b, float c, float d) {
    const int ia = (int)__builtin_rintf(fminf(fmaxf(a * 32.0f, -127.0f), 127.0f)), ib = (int)__builtin_rintf(fminf(fmaxf(b * 32.0f, -127.0f), 127.0f));
    const int ic = (int)__builtin_rintf(fminf(fmaxf(c * 32.0f, -127.0f), 127.0f)), id = (int)__builtin_rintf(fminf(fmaxf(d * 32.0f, -127.0f), 127.0f));
    return (unsigned)(ia & 0xff) | ((unsigned)(ib & 0xff) << 8) | ((unsigned)(ic & 0xff) << 16) | ((unsigned)(id & 0xff) << 24);
}
DI float bflo(unsigned u) { return __uint_as_float(u << 16); }
DI float bfhi(unsigned u) { return __uint_as_float(u & 0xffff0000u); }
DI u16 f2bf(float f) { return (u16)(pk2(f, 0.f) & 0xffffu); }
DI float bf2f(u16 h) { return __uint_as_float(((unsigned)h) << 16); }
DI float sigmoidf_(float x) { return __builtin_amdgcn_rcpf(1.0f + __expf(-x)); }
DI float gelu_tanh(float x) { const float u = 1.5957691216057308f * (x + 0.044715f * x * x * x); return x * sigmoidf_(u); }
DI float fast_sigmoid(float x) { return __builtin_amdgcn_rcpf(1.0f + __builtin_amdgcn_exp2f(x * -1.4426950408889634f)); }
DI float fast_gelu(float x) { const float p = __builtin_fmaf(x * x, -0.10294324f, -2.3022082f); return x * __builtin_amdgcn_rcpf(1.0f + __builtin_amdgcn_exp2f(x * p)); }
DI int otid() { int t = threadIdx.x; asm volatile("" : "+v"(t)); return t; }
DI void wave_lds_sync() { asm volatile("s_waitcnt lgkmcnt(0)" ::: "memory"); }

namespace g8 {
constexpr int BM = 256, BK = 64, HALF = 128, HTB = HALF * BK * 2, STAGE_BYTES = 8 * HTB, NXCD = 8, WGM = 8;
DI int lds_byte(int r, int c) { const int st = (r >> 4) * 2 + (c >> 5), rr = r & 15, cc = c & 31, ob = rr * 64 + cc * 2; return st * 1024 + (ob ^ (((ob >> 9) & 1) << 5)); }
DI int perm32(int rho) { const int n = rho >> 4, i = rho & 15; return 8 * (i >> 2) + 4 * n + (i & 3); }
DI void stage_rc(int b, int& R, int& C) { const int st = b / 1024, sb = b % 1024, swz = sb ^ (((sb >> 9) & 1) << 5); R = (st >> 1) * 16 + swz / 64; C = (st & 1) * 32 + (swz % 64) / 2; }

struct UnitD { const char* Bp; int pm, pn, e, rb; };

DI bool static_tile(int i, int G, int c, int nM, int nN, int& pm, int& pn) {
    const int nwg = nM * nN; const long L = (long)i * G + c; if (L >= nwg) return false;
    int wgid = (int)L; { const int q = nwg / NXCD, r = nwg % NXCD, xcd = wgid % NXCD, off = wgid / NXCD; wgid = (xcd < r ? xcd * (q + 1) : r * (q + 1) + (xcd - r) * q) + off; }
    const int nig = WGM * nN, gid = wgid / nig, fm = gid * WGM, gsz = (nM - fm) < WGM ? (nM - fm) : WGM;
    pm = fm + ((wgid % nig) % gsz); pn = (wgid % nig) / gsz; return true;
}

struct PlainSched {
    const char* Abase; const char* Bbase; int lda, ldb, K, nM, nN, G, c; static constexpr int esz = 2;
    DI bool next(int i, UnitD& u) const { int pm, pn; if (!static_tile(i, G, c, nM, nN, pm, pn)) return false; u.pm = pm; u.pn = pn; u.e = 0; u.rb = 0; u.Bp = Bbase + (size_t)pn * BM * ldb * 2; return true; }
    DI void a_offs(const UnitD& u, int R0, int C0, unsigned (&o)[2][2]) const {
#pragma unroll
        for (int h = 0; h < 2; ++h)
#pragma unroll
            for (int i = 0; i < 2; ++i) o[h][i] = (unsigned)(((size_t)(u.pm * BM + h * HALF + R0 + 64 * i) * lda + C0) * 2);
    }
};

template <bool FP8 = false, class Epi, class Sched>
DI void gemm_phase(LAS unsigned char* lds, const Sched& S, const Epi& E) {
    const int tid = otid(), wid = __builtin_amdgcn_readfirstlane(tid >> 6), lane = tid & 63, wr = wid >> 2, wc = wid & 3, fr = lane & 15, fq = lane >> 4;
    const int nt = S.K * Sched::esz / 128;
    int R0, C0; stage_rc(tid * 16, R0, C0);
    unsigned voffB[2];
#pragma unroll
    for (int i = 0; i < 2; ++i) { const int Rr = R0 + 64 * i, Rb = Epi::PERM ? ((Rr & ~31) + perm32(Rr & 31)) : Rr; voffB[i] = (unsigned)(Rb * S.ldb * Sched::esz + C0 * 2); }
    const size_t hstepB = (size_t)HALF * S.ldb * Sched::esz;
    const unsigned ldsw = (unsigned)wid * 1024u;
    const int aoff = FP8 ? lds_byte(wr * 64 + fr, fq * 16) : lds_byte(wr * 64 + fr, fq * 8), boff = FP8 ? lds_byte(wc * 32 + fr, fq * 16) : lds_byte(wc * 32 + fr, fq * 8);
    const unsigned mxscale = 0x7f7f7f7fu;
    const int kst = FP8 ? 16 : 1024;
    const char* Ab = S.Abase;
#define G8_SA(b, h) (((b) * 2 + (h)) * HTB)
#define G8_SB(b, h) ((4 + (b) * 2 + (h)) * HTB)
#define G8_STAGE_A(bufoff, offs, kb) do { _Pragma("unroll") for (int _i = 0; _i < 2; ++_i) \
        __builtin_amdgcn_global_load_lds((const unsigned*)(Ab + (size_t)(offs)[_i] + (size_t)(kb)), (LAS unsigned*)(lds + (bufoff) + ldsw + _i * 8192), 16, 0, 0); } while (0)
#define G8_STAGE_B(bufoff, gbase, kb) do { _Pragma("unroll") for (int _i = 0; _i < 2; ++_i) \
        __builtin_amdgcn_global_load_lds((const unsigned*)((gbase) + voffB[_i] + (size_t)(kb)), (LAS unsigned*)(lds + (bufoff) + ldsw + _i * 8192), 16, 0, 0); } while (0)
#define G8_LDA(dst, b, h) do { _Pragma("unroll") for (int m = 0; m < 4; ++m) { const i32x4_t _p = *(const LAS i32x4_t*)(lds + G8_SA(b, h) + aoff + m * 2048), _q = *(const LAS i32x4_t*)(lds + G8_SA(b, h) + aoff + m * 2048 + kst); dst[m] = __builtin_shufflevector(_p, _q, 0, 1, 2, 3, 4, 5, 6, 7); } } while (0)
#define G8_LDB(dst, b, h) do { _Pragma("unroll") for (int n = 0; n < 2; ++n) { const i32x4_t _p = *(const LAS i32x4_t*)(lds + G8_SB(b, h) + boff + n * 2048), _q = *(const LAS i32x4_t*)(lds + G8_SB(b, h) + boff + n * 2048 + kst); dst[n] = __builtin_shufflevector(_p, _q, 0, 1, 2, 3, 4, 5, 6, 7); } } while (0)
#define G8_MMA(ai, bj, At, Bt) do { __builtin_amdgcn_s_setprio(1); _Pragma("unroll") for (int m = 0; m < 4; ++m) _Pragma("unroll") for (int n = 0; n < 2; ++n) { \
        if constexpr (FP8) asm volatile("v_mfma_scale_f32_16x16x128_f8f6f4 %0, %1, %2, %0, %3, %3 op_sel_hi:[0,0,0]" : "+v"(acc[ai][bj][m][n]) : "v"(Bt[n]), "v"(At[m]), "v"(mxscale)); \
        else { acc[ai][bj][m][n] = __builtin_amdgcn_mfma_f32_16x16x32_bf16(__builtin_bit_cast(bf16x8, __builtin_shufflevector(Bt[n], Bt[n], 0, 1, 2, 3)), __builtin_bit_cast(bf16x8, __builtin_shufflevector(At[m], At[m], 0, 1, 2, 3)), acc[ai][bj][m][n], 0, 0, 0); \
               acc[ai][bj][m][n] = __builtin_amdgcn_mfma_f32_16x16x32_bf16(__builtin_bit_cast(bf16x8, __builtin_shufflevector(Bt[n], Bt[n], 4, 5, 6, 7)), __builtin_bit_cast(bf16x8, __builtin_shufflevector(At[m], At[m], 4, 5, 6, 7)), acc[ai][bj][m][n], 0, 0, 0); } } \
        __builtin_amdgcn_s_setprio(0); } while (0)
#define G8_WAIT_V(n) asm volatile("s_waitcnt vmcnt(" #n ")" ::: "memory")
#define G8_WAIT_L(n) asm volatile("s_waitcnt lgkmcnt(" #n ")" ::: "memory")
#define G8_BAR __builtin_amdgcn_s_barrier()
#define G8_SCHED __builtin_amdgcn_sched_barrier(0)
    UnitD cur, nxt; int ui = 0;
    if (!S.next(0, cur)) return;
    f32x4 acc[2][2][4][2];
#pragma unroll
    for (int a = 0; a < 2; ++a)
#pragma unroll
        for (int b = 0; b < 2; ++b)
#pragma unroll
            for (int m = 0; m < 4; ++m)
#pragma unroll
                for (int n = 0; n < 2; ++n) acc[a][b][m][n] = (f32x4){0.f, 0.f, 0.f, 0.f};
    typedef int i32x4_t __attribute__((ext_vector_type(4)));
    v8i_t At[4], B0[2], B1[2];
    unsigned cA[2][2];
    S.a_offs(cur, R0, C0, cA);
    const char* cB = cur.Bp;
    G8_STAGE_B(G8_SB(0, 0), cB, 0); G8_STAGE_A(G8_SA(0, 0), cA[0], 0); G8_STAGE_B(G8_SB(0, 1), cB + hstepB, 0); G8_STAGE_A(G8_SA(0, 1), cA[1], 0);
    if (wr == 1) G8_BAR;
    G8_WAIT_V(4); G8_BAR;
    G8_STAGE_B(G8_SB(1, 0), cB, 128); G8_STAGE_A(G8_SA(1, 0), cA[0], 128); G8_STAGE_B(G8_SB(1, 1), cB + hstepB, 128);
    G8_WAIT_V(6); G8_BAR;
    for (;;) {
        const bool has_next = S.next(ui + 1, nxt);
        const char* nB = has_next ? nxt.Bp : cB;
        for (int t = 0; t < nt; t += 2) {
            const bool last = (t == nt - 2);
            const unsigned k1 = (unsigned)(t + 1) * 128u;
            const unsigned k2 = last ? 0u : (unsigned)(t + 2) * 128u, k3 = k2 + 128u;
            unsigned c1[2] = {cA[1][0], cA[1][1]};
            if (last && has_next) S.a_offs(nxt, R0, C0, cA);
            const char* b2 = last ? nB : cB;
            G8_LDB(B0, 0, 0); G8_SCHED; G8_LDA(At, 0, 0); G8_STAGE_A(G8_SA(1, 1), c1, k1);
            G8_WAIT_L(8); G8_BAR; G8_WAIT_L(0); G8_MMA(0, 0, At, B0); G8_BAR; G8_SCHED;
            G8_LDB(B1, 0, 1); G8_STAGE_B(G8_SB(0, 0), b2, k2);
            G8_BAR; G8_WAIT_L(0); G8_MMA(0, 1, At, B1); G8_BAR;
            G8_LDA(At, 0, 1); G8_STAGE_A(G8_SA(0, 0), cA[0], k2);
            G8_BAR; G8_WAIT_L(0); G8_MMA(1, 0, At, B0); G8_BAR; G8_SCHED;
            G8_STAGE_B(G8_SB(0, 1), b2 + hstepB, k2);
            G8_WAIT_V(6); G8_BAR; G8_MMA(1, 1, At, B1); G8_BAR;
            G8_LDB(B0, 1, 0); G8_SCHED; G8_LDA(At, 1, 0); G8_STAGE_A(G8_SA(0, 1), cA[1], k2);
            G8_WAIT_L(8); G8_BAR; G8_WAIT_L(0); G8_MMA(0, 0, At, B0); G8_BAR; G8_SCHED;
            G8_LDB(B1, 1, 1); G8_STAGE_B(G8_SB(1, 0), b2, k3);
            G8_BAR; G8_WAIT_L(0); G8_MMA(0, 1, At, B1); G8_BAR;
            G8_LDA(At, 1, 1); G8_STAGE_A(G8_SA(1, 0), cA[0], k3);
            G8_BAR; G8_WAIT_L(0); G8_MMA(1, 0, At, B0); G8_BAR; G8_SCHED;
            G8_STAGE_B(G8_SB(1, 1), b2 + hstepB, k3);
            G8_WAIT_V(6); G8_BAR; G8_MMA(1, 1, At, B1); G8_BAR;
        }
        if constexpr (FP8) asm volatile("s_nop 15\n\ts_nop 15" ::: "memory");
        E(acc, cur, wr, wc, fr, fq);
        if (!has_next) break;
#pragma unroll
        for (int a = 0; a < 2; ++a)
#pragma unroll
            for (int b = 0; b < 2; ++b)
#pragma unroll
                for (int m = 0; m < 4; ++m)
#pragma unroll
                    for (int n = 0; n < 2; ++n) acc[a][b][m][n] = (f32x4){0.f, 0.f, 0.f, 0.f};
        cur = nxt; cB = nB; ++ui;
    }
    G8_WAIT_V(0);
    if (wr == 0) G8_BAR;
    G8_BAR;
#undef G8_SA
#undef G8_SB
#undef G8_STAGE_A
#undef G8_STAGE_B
#undef G8_LDA
#undef G8_LDB
#undef G8_MMA
#undef G8_WAIT_V
#undef G8_WAIT_L
#undef G8_BAR
#undef G8_SCHED
}
}
using g8::UnitD;
typedef f32x4 Acc[2][2][4][2];

struct EpiIn {
    static constexpr bool PERM = true;
    u16* H; const float* rs1; float* SSQ; float* WI;
    template <int ACT, bool DOSSQ> DI void run(const Acc& acc, const UnitD& u, int wr, int wc, int fr, int fq) const {
        const int pn = u.pn;
        float rsv[2][4];
#pragma unroll
        for (int ai = 0; ai < 2; ++ai)
#pragma unroll
            for (int m = 0; m < 4; ++m) rsv[ai][m] = rs1[u.pm * 256 + ai * 128 + wr * 64 + m * 16 + fr];
        __builtin_amdgcn_sched_barrier(0);
#pragma unroll
        for (int ai = 0; ai < 2; ++ai)
#pragma unroll
            for (int m = 0; m < 4; ++m) {
                const int row = u.pm * 256 + ai * 128 + wr * 64 + m * 16 + fr;
                const float rs = rsv[ai][m];
#pragma unroll
                for (int bj = 0; bj < 2; ++bj) {
                    f32x4 v0 = acc[ai][bj][m][0] * rs, v1 = acc[ai][bj][m][1] * rs;
                    if (ACT == 1) {
#pragma unroll
                        for (int j = 0; j < 4; ++j) { v0[j] = fast_gelu(v0[j]); v1[j] = fast_gelu(v1[j]); }
                    } else if (ACT == 2) {
#pragma unroll
                        for (int j = 0; j < 4; ++j) { v0[j] = fast_sigmoid(v0[j]); v1[j] = fast_sigmoid(v1[j]); }
                    }
                    u32x4 w; w.x = pk2(v0[0], v0[1]); w.y = pk2(v0[2], v0[3]); w.z = pk2(v1[0], v1[1]); w.w = pk2(v1[2], v1[3]);
                    *(u32x4*)(H + (size_t)row * NIN + pn * 256 + bj * 128 + wc * 32 + 8 * fq) = w;
                    if (DOSSQ) {
                        float ssq = ((v0[0] * v0[0] + v0[1] * v0[1]) + (v0[2] * v0[2] + v0[3] * v0[3])) + ((v1[0] * v1[0] + v1[1] * v1[1]) + (v1[2] * v1[2] + v1[3] * v1[3]));
                        ssq += __shfl_xor(ssq, 16); ssq += __shfl_xor(ssq, 32);
                        if (fq == 0) SSQ[(size_t)row * 32 + (pn - 2) * 8 + bj * 4 + wc] = ssq;
                        if (pn == 5 && bj == 1 && wc == 2 && fq == 0) *(f32x4*)(WI + (size_t)row * 4) = v0 * 0.5f;
                    }
                }
            }
    }
    DI void operator()(const Acc& acc, const UnitD& u, int wr, int wc, int fr, int fq) const {
        const int pn = u.pn;
        if (pn < 2) run<1, false>(acc, u, wr, wc, fr, fq);
        else if (pn < 4) run<1, true>(acc, u, wr, wc, fr, fq);
        else if (pn < 6) run<0, true>(acc, u, wr, wc, fr, fq);
        else run<2, false>(acc, u, wr, wc, fr, fq);
    }
};
struct EpiQ {
    static constexpr bool PERM = true;
    u16* Q; u16* QI; const float* SSQ;
    DI void operator()(const Acc& acc, const UnitD& u, int wr, int wc, int fr, int fq) const {
        f32x4 sq[2][4][2];
#pragma unroll
        for (int ai = 0; ai < 2; ++ai)
#pragma unroll
            for (int m = 0; m < 4; ++m) { const int row = u.pm * 256 + ai * 128 + wr * 64 + m * 16 + fr; sq[ai][m][0] = *(const f32x4*)(SSQ + (size_t)row * 32 + 16); sq[ai][m][1] = *(const f32x4*)(SSQ + (size_t)row * 32 + 20); }
        __builtin_amdgcn_sched_barrier(0);
#pragma unroll
        for (int ai = 0; ai < 2; ++ai)
#pragma unroll
            for (int m = 0; m < 4; ++m) {
                const int row = u.pm * 256 + ai * 128 + wr * 64 + m * 16 + fr;
                const f32x4 s0 = sq[ai][m][0], s1 = sq[ai][m][1];
                const float ss = ((s0[0] + s0[1]) + (s0[2] + s0[3])) + ((s1[0] + s1[1]) + (s1[2] + s1[3]));
                const float rs = __builtin_amdgcn_rsqf(ss * (1.0f / 256.0f) + EPS);
#pragma unroll
                for (int bj = 0; bj < 2; ++bj) {
                    const int col = u.pn * 256 + bj * 128 + wc * 32 + 8 * fq;
                    const f32x4 v0 = acc[ai][bj][m][0] * rs, v1 = acc[ai][bj][m][1] * rs;
                    if (col < 1024) { u32x4 w; w.x = pk2(v0[0], v0[1]); w.y = pk2(v0[2], v0[3]); w.z = pk2(v1[0], v1[1]); w.w = pk2(v1[2], v1[3]); *(u32x4*)(Q + (size_t)row * 1024 + col) = w; }
                    else { u32x2 w; w.x = pk4_i8(v0[0], v0[1], v0[2], v0[3]); w.y = pk4_i8(v1[0], v1[1], v1[2], v1[3]); *(u32x2*)((unsigned char*)QI + (size_t)row * 256 + (col - 1024)) = w; }
                }
            }
    }
};
template <int SECOND> struct EpiMrg {
    static constexpr bool PERM = true;
    u16* OUT; const u16* TMP; const u16* H;
    DI void operator()(const Acc& acc, const UnitD& u, int wr, int wc, int fr, int fq) const {
#pragma unroll
        for (int ai = 0; ai < 2; ++ai) {
            u32x4 g[4][2], tp[4][2];
#pragma unroll
            for (int m = 0; m < 4; ++m)
#pragma unroll
                for (int bj = 0; bj < 2; ++bj) {
                    const int row = u.pm * 256 + ai * 128 + wr * 64 + m * 16 + fr, col = u.pn * 256 + bj * 128 + wc * 32 + 8 * fq;
                    g[m][bj] = *(const u32x4*)(H + (size_t)row * NIN + 1536 + SECOND * 1024 + col);
                    if (SECOND) tp[m][bj] = *(const u32x4*)(TMP + (size_t)row * 1024 + col);
                }
            __builtin_amdgcn_sched_barrier(0);
#pragma unroll
            for (int m = 0; m < 4; ++m)
#pragma unroll
                for (int bj = 0; bj < 2; ++bj) {
                    const int row = u.pm * 256 + ai * 128 + wr * 64 + m * 16 + fr, col = u.pn * 256 + bj * 128 + wc * 32 + 8 * fq;
                    const u32x4 gg = g[m][bj];
                    f32x4 v0 = acc[ai][bj][m][0], v1 = acc[ai][bj][m][1];
                    v0[0] *= bflo(gg.x); v0[1] *= bfhi(gg.x); v0[2] *= bflo(gg.y); v0[3] *= bfhi(gg.y); v1[0] *= bflo(gg.z); v1[1] *= bfhi(gg.z); v1[2] *= bflo(gg.w); v1[3] *= bfhi(gg.w);
                    if (SECOND) { const u32x4 t = tp[m][bj];
                        v0[0] += bflo(t.x); v0[1] += bfhi(t.x); v0[2] += bflo(t.y); v0[3] += bfhi(t.y); v1[0] += bflo(t.z); v1[1] += bfhi(t.z); v1[2] += bflo(t.w); v1[3] += bfhi(t.w); }
                    u32x4 w; w.x = pk2(v0[0], v0[1]); w.y = pk2(v0[2], v0[3]); w.z = pk2(v1[0], v1[1]); w.w = pk2(v1[2], v1[3]);
                    *(u32x4*)(OUT + (size_t)row * 1024 + col) = w;
                }
            __builtin_amdgcn_sched_barrier(0);
        }
    }
};
struct EpiOut {
    static constexpr bool PERM = false;
    float* out; const float* x;
    DI void operator()(const Acc& acc, const UnitD& u, int wr, int wc, int fr, int fq) const {
#pragma unroll
        for (int ai = 0; ai < 2; ++ai) {
            f32x4 xv[4][2][2];
#pragma unroll
            for (int m = 0; m < 4; ++m)
#pragma unroll
                for (int bj = 0; bj < 2; ++bj)
#pragma unroll
                    for (int n = 0; n < 2; ++n)
                        xv[m][bj][n] = *(const f32x4*)(x + (size_t)(u.pm * 256 + ai * 128 + wr * 64 + m * 16 + fr) * 1024 + u.pn * 256 + bj * 128 + wc * 32 + n * 16 + 4 * fq);
            __builtin_amdgcn_sched_barrier(0);
#pragma unroll
            for (int m = 0; m < 4; ++m)
#pragma unroll
                for (int bj = 0; bj < 2; ++bj)
#pragma unroll
                    for (int n = 0; n < 2; ++n)
                        *(f32x4*)(out + (size_t)(u.pm * 256 + ai * 128 + wr * 64 + m * 16 + fr) * 1024 + u.pn * 256 + bj * 128 + wc * 32 + n * 16 + 4 * fq) = xv[m][bj][n] + acc[ai][bj][m][n];
            __builtin_amdgcn_sched_barrier(0);
        }
    }
};

constexpr int MOE_TAB = g8::STAGE_BYTES;
DI void moe_table(LAS unsigned char* lds, const unsigned* CNT) {
    LAS int* tab = (LAS int*)(lds + MOE_TAB);
    __syncthreads();
    if (threadIdx.x == 0) { int acc = 0; for (int e = 0; e < NE; ++e) { const int c = (int)__hip_atomic_load(CNT + e, __ATOMIC_RELAXED, __HIP_MEMORY_SCOPE_AGENT); tab[e] = acc; tab[33 + e] = c; acc += (c + 255) >> 8; } tab[32] = acc; }
    __syncthreads();
}
template <int NPN, bool GATHER> struct MoeSched {
    const char* Abase; const char* Wbase; const int* LTOK; LAS const int* tab; int lda, ldb, K, G, c; size_t wstride; static constexpr int esz = 1;
    DI bool next(int i, UnitD& u) const {
        const long L = (long)i * G + c; const int R = tab[32];
        if (L >= (long)R * NPN) return false;
        const int rbg = (int)(L / NPN), pn = (int)(L % NPN);
        int e = 0;
        for (int j = 1; j < NE; ++j) e += (tab[j] <= rbg) ? 1 : 0;
        e = __builtin_amdgcn_readfirstlane(e);
        u.pm = rbg; u.pn = pn; u.e = e; u.rb = rbg - tab[e];
        u.Bp = Wbase + (size_t)e * wstride + (size_t)pn * 256 * ldb * esz;
        return true;
    }
    DI void a_offs(const UnitD& u, int R0, int C0, unsigned (&o)[2][2]) const {
        const int cnt = tab[33 + u.e];
#pragma unroll
        for (int h = 0; h < 2; ++h)
#pragma unroll
            for (int i = 0; i < 2; ++i) {
                const int r = h * 128 + R0 + 64 * i;
                if (GATHER) { const int slot = u.rb * 256 + r; const int tok = slot < cnt ? LTOK[(size_t)u.e * ECAP + slot] : 0; o[h][i] = (unsigned)((size_t)tok * lda * esz + C0 * 2); }
                else o[h][i] = (unsigned)((size_t)(u.pm * 256 + r) * lda * esz + C0 * 2);
            }
    }
};
struct EpiMoe1 {
    static constexpr bool PERM = true;
    unsigned char* ACT; const float* b1;
    DI void operator()(const Acc& acc, const UnitD& u, int wr, int wc, int fr, int fq) const {
        const float* be = b1 + (size_t)u.e * 2048;
        const int hc = u.pn * 128 + wc * 32 + 8 * fq;
        const f32x4 bg0 = *(const f32x4*)(be + hc), bg1 = *(const f32x4*)(be + hc + 4), bu0 = *(const f32x4*)(be + 1024 + hc), bu1 = *(const f32x4*)(be + 1024 + hc + 4);
        __builtin_amdgcn_sched_barrier(0);
#pragma unroll
        for (int ai = 0; ai < 2; ++ai)
#pragma unroll
            for (int m = 0; m < 4; ++m) {
                const int row = u.pm * 256 + ai * 128 + wr * 64 + m * 16 + fr;
                float av[8];
#pragma unroll
                for (int n = 0; n < 2; ++n) {
                    const f32x4 g = acc[ai][0][m][n] * 0.015625f + (n ? bg1 : bg0), up = acc[ai][1][m][n] * 0.015625f + (n ? bu1 : bu0);
#pragma unroll
                    for (int j = 0; j < 4; ++j) {
                        const float hg = fminf(g[j], 7.0f), hu = __builtin_amdgcn_fmed3f(up[j], -7.0f, 7.0f);
                        av[4 * n + j] = (hu + 1.0f) * (hg * __builtin_amdgcn_rcpf(1.0f + __builtin_amdgcn_exp2f(hg * -2.4554669595930157f)));
                    }
                }
                u32x2 w; w.x = pk4_fp8(av[0], av[1], av[2], av[3]); w.y = pk4_fp8(av[4], av[5], av[6], av[7]);
                *(u32x2*)(ACT + (size_t)row * 1024 + hc) = w;
            }
    }
};
struct EpiMoe2 {
    static constexpr bool PERM = true;
    u16* YB; const float* b2; const float* LGATE; LAS const int* tab;
    DI void operator()(const Acc& acc, const UnitD& u, int wr, int wc, int fr, int fq) const {
        const float* be = b2 + (size_t)u.e * 1024; const int cnt = tab[33 + u.e];
        float gate[2][4]; f32x4 bias[2][2];
#pragma unroll
        for (int ai = 0; ai < 2; ++ai)
#pragma unroll
            for (int m = 0; m < 4; ++m) { const int slot = u.rb * 256 + ai * 128 + wr * 64 + m * 16 + fr; gate[ai][m] = slot < cnt ? LGATE[(size_t)u.e * ECAP + slot] : 0.f; }
#pragma unroll
        for (int bj = 0; bj < 2; ++bj) { const int col = u.pn * 256 + bj * 128 + wc * 32 + 8 * fq; bias[bj][0] = *(const f32x4*)(be + col); bias[bj][1] = *(const f32x4*)(be + col + 4); }
        __builtin_amdgcn_sched_barrier(0);
#pragma unroll
        for (int ai = 0; ai < 2; ++ai)
#pragma unroll
            for (int m = 0; m < 4; ++m) {
                const int r = ai * 128 + wr * 64 + m * 16 + fr;
                const float gt = gate[ai][m];
#pragma unroll
                for (int bj = 0; bj < 2; ++bj) {
                    const int col = u.pn * 256 + bj * 128 + wc * 32 + 8 * fq;
                    const f32x4 v0 = (acc[ai][bj][m][0] * 0.015625f + bias[bj][0]) * gt, v1 = (acc[ai][bj][m][1] * 0.015625f + bias[bj][1]) * gt;
                    u32x4 w; w.x = pk2(v0[0], v0[1]); w.y = pk2(v0[2], v0[3]); w.z = pk2(v1[0], v1[1]); w.w = pk2(v1[2], v1[3]);
                    *(u32x4*)(YB + (size_t)(u.pm * 256 + r) * 1024 + col) = w;
                }
            }
    }
};

template <bool FP8 = false, class F> DI void tr_tile(LAS unsigned char* lds, const float* src, int ld_src, int Nsz, int k0, int n0, const float* sk, float mul, u16* dst, int ld_dst, F rowmap) {
    LAS float* t = (LAS float*)lds;
    const int tid = otid();
    __syncthreads();
#pragma unroll
    for (int it = 0; it < 2; ++it) {
        const int k = (tid >> 4) + 32 * it, n = 4 * (tid & 15);
        f32x4 v = {0.f, 0.f, 0.f, 0.f};
        if (n0 + n < Nsz) v = *(const f32x4*)(src + (size_t)(k0 + k) * ld_src + n0 + n);
        const float s = (sk ? sk[k0 + k] : 1.0f) * mul;
        t[k * 65 + n] = v[0] * s; t[k * 65 + n + 1] = v[1] * s; t[k * 65 + n + 2] = v[2] * s; t[k * 65 + n + 3] = v[3] * s;
    }
    __syncthreads();
    const int n = tid >> 3, kc = (tid & 7) * 8;
    if (FP8) {
        if (n0 + n < Nsz) {
            u32x2 w;
            w.x = pk4_fp8(t[(kc + 0) * 65 + n], t[(kc + 1) * 65 + n], t[(kc + 2) * 65 + n], t[(kc + 3) * 65 + n]);
            w.y = pk4_fp8(t[(kc + 4) * 65 + n], t[(kc + 5) * 65 + n], t[(kc + 6) * 65 + n], t[(kc + 7) * 65 + n]);
            *(u32x2*)((unsigned char*)dst + (size_t)rowmap(n0 + n) * ld_dst + k0 + kc) = w;
        }
    } else if (n0 + n < Nsz) {
        u32x4 w;
        w.x = pk2(t[(kc + 0) * 65 + n], t[(kc + 1) * 65 + n]); w.y = pk2(t[(kc + 2) * 65 + n], t[(kc + 3) * 65 + n]);
        w.z = pk2(t[(kc + 4) * 65 + n], t[(kc + 5) * 65 + n]); w.w = pk2(t[(kc + 6) * 65 + n], t[(kc + 7) * 65 + n]);
        *(u32x4*)(dst + (size_t)rowmap(n0 + n) * ld_dst + k0 + kc) = w;
    }
}
struct MapId { DI int operator()(int n) const { return n; } };
struct MapIn { DI int operator()(int n) const { return n < 1476 ? n : n + 60; } };
struct MapE1 { DI int operator()(int n) const { const int hi = n >= 1024 ? 1 : 0, q = n - hi * 1024; return (q >> 7) * 256 + hi * 128 + (q & 127); } };

DI void phase0(const Args& a, LAS unsigned char* lds) {
    unsigned char* ws = a.ws;
    const int tid = otid();
    const size_t gtid = (size_t)blockIdx.x * NT + tid, gstride = (size_t)gridDim.x * NT;
    for (size_t i = gtid; i < 60 * 1024 / 2; i += gstride) ((unsigned*)(ws + WS_WIN + (size_t)1476 * 1024 * 2))[i] = 0u;
    for (size_t i = gtid; i < 32 * 1024; i += gstride) { const int e = (int)(i >> 10), k = (int)(i & 1023); const float w = a.in[I_WR][k * 32 + e] * a.in[I_N2G][k]; const u16 h = f2bf(w); ((u16*)(ws + WS_WR))[i] = h; ((u16*)(ws + WS_WR))[32 * 1024 + i] = f2bf(w - bf2f(h)); }
    for (size_t i = gtid; i < 4 * 128 * 128; i += gstride) { const int tt = (int)((i >> 7) & 127), ss = (int)(i & 127); ((u16*)(ws + WS_WSP))[i] = f2bf(ss <= tt ? a.in[I_WSP][i] : 0.f); }
    {
        const int wid = tid >> 6, lane = tid & 63;
        for (int row = blockIdx.x * 8 + wid; row < T; row += gridDim.x * 8) {
            const float* xr = a.in[I_X] + (size_t)row * 1024; u16* xb = (u16*)(ws + WS_XB) + (size_t)row * 1024;
            float ss = 0.f;
#pragma unroll
            for (int i = 0; i < 4; ++i) {
                const f32x4 v = *(const f32x4*)(xr + i * 256 + lane * 4);
                ss += (v[0] * v[0] + v[1] * v[1]) + (v[2] * v[2] + v[3] * v[3]);
                u32x2 w; w.x = pk2(v[0], v[1]); w.y = pk2(v[2], v[3]);
                *(u32x2*)(xb + i * 256 + lane * 4) = w;
            }
#pragma unroll
            for (int o = 32; o >= 1; o >>= 1) ss += __shfl_xor(ss, o);
            if (lane == 0) ((float*)(ws + WS_RS1))[row] = __builtin_amdgcn_rsqf(ss * (1.0f / 1024.0f) + EPS);
        }
    }
    constexpr int U_IN = 16 * 56, U_UQ = 4 * 16, U_QI = 4 * 4, U_PA = 8 * 16, U_OUT = 16 * 16, U_E1 = 32 * 16 * 32, U_E2 = 32 * 16 * 16, U_CB = 64;
    constexpr int U_TOT = U_IN + U_UQ + U_QI + U_PA + U_OUT + U_E1 + U_E2 + U_CB;
    for (int u = blockIdx.x; u < U_TOT; u += gridDim.x) {
        int v = u;
        if (v < U_IN) { tr_tile(lds, a.in[I_WIN], 3524, 3524, (v & 15) * 64, (v >> 4) * 64, a.in[I_N1G], 1.0f, (u16*)(ws + WS_WIN), 1024, MapIn()); continue; }
        v -= U_IN;
        if (v < U_UQ) { tr_tile(lds, a.in[I_WUQ], 1024, 1024, (v & 3) * 64, (v >> 2) * 64, a.in[I_QLG], 1.0f, (u16*)(ws + WS_WQ), 256, MapId()); continue; }
        v -= U_UQ;
        if (v < U_QI) { tr_tile(lds, a.in[I_WQI], 256, 256, (v & 3) * 64, (v >> 2) * 64, a.in[I_QLG], 1.0f, (u16*)(ws + WS_WQ) + 1024 * 256, 256, MapId()); continue; }
        v -= U_QI;
        if (v < U_PA) { tr_tile(lds, a.in[I_WPA], 1024, 1024, (v & 7) * 64, (v >> 3) * 64, nullptr, 1.0f, (u16*)(ws + WS_WCAT), 1536, MapId()); continue; }
        v -= U_PA;
        if (v < U_OUT) { tr_tile(lds, a.in[I_WOUT], 1024, 1024, (v & 15) * 64, (v >> 4) * 64, nullptr, 1.0f, (u16*)(ws + WS_WOUT), 1024, MapId()); continue; }
        v -= U_OUT;
        if (v < U_E1) { const int e = v >> 9, w = v & 511; tr_tile<true>(lds, a.in[I_WE1] + (size_t)e * 1024 * 2048, 2048, 2048, (w & 15) * 64, (w >> 4) * 64, a.in[I_N2G], 64.0f, (u16*)(ws + WS_WE1 + (size_t)e * 2048 * 1024), 1024, MapE1()); continue; }
        v -= U_E1;
        if (v < U_E2) { const int e = v >> 8, w = v & 255; tr_tile<true>(lds, a.in[I_WE2] + (size_t)e * 1024 * 1024, 1024, 1024, (w & 15) * 64, (w >> 4) * 64, nullptr, 64.0f, (u16*)(ws + WS_WE2 + (size_t)e * 1024 * 1024), 1024, MapId()); continue; }
        v -= U_E2;
        {
            const int h = v >> 3, c0 = (v & 7) * 16;
            LAS float* t = (LAS float*)lds;
            __syncthreads();
            for (int i = tid; i < 1024; i += NT) t[i] = a.in[I_WUV][(size_t)h * 128 * 64 + (size_t)c0 * 64 + i];
            __syncthreads();
            for (int nn = tid; nn < 1024; nn += NT) {
                float accv[16];
#pragma unroll
                for (int i = 0; i < 16; ++i) accv[i] = 0.f;
                for (int vv = 0; vv < 64; ++vv) {
                    const float pb = a.in[I_WPB][(size_t)(h * 64 + vv) * 1024 + nn];
#pragma unroll
                    for (int i = 0; i < 16; ++i) accv[i] += t[i * 64 + vv] * pb;
                }
                u32x4 w0, w1;
                w0.x = pk2(accv[0], accv[1]); w0.y = pk2(accv[2], accv[3]); w0.z = pk2(accv[4], accv[5]); w0.w = pk2(accv[6], accv[7]);
                w1.x = pk2(accv[8], accv[9]); w1.y = pk2(accv[10], accv[11]); w1.z = pk2(accv[12], accv[13]); w1.w = pk2(accv[14], accv[15]);
                u16* d = (u16*)(ws + WS_WCAT) + (size_t)nn * 1536 + 512 + h * 128 + c0;
                *(u32x4*)d = w0; *(u32x4*)(d + 8) = w1;
            }
        }
    }
}

DI void gmlp_unit(const Args& a, LAS unsigned char* lds, int u) {
    unsigned char* ws = a.ws;
    const int tid = otid(), wid = tid >> 6, lane = tid & 63, fr = lane & 15, fq = lane >> 4;
    const int g = u & 3, row0 = (u >> 2) * 128;
    const u16* H = (const u16*)(ws + WS_H);
    LAS u16* img = (LAS u16*)lds;
    __syncthreads();
    {
        const int s = tid & 127, cset = tid >> 7;
        const f32x4 sq = *(const f32x4*)((const float*)(ws + WS_SSQ) + (size_t)(row0 + s) * 32 + g * 4);
        const float rs = __builtin_amdgcn_rsqf(((sq[0] + sq[1]) + (sq[2] + sq[3])) * (1.0f / 128.0f) + EPS);
#pragma unroll
        for (int it = 0; it < 4; ++it) {
            const int c = cset + 4 * it;
            const u32x4 raw = *(const u32x4*)(H + (size_t)(row0 + s) * NIN + 512 + g * 128 + 8 * c);
            const float* vg = a.in[I_VG] + 8 * c;
            float f[8] = {bflo(raw.x), bfhi(raw.x), bflo(raw.y), bfhi(raw.y), bflo(raw.z), bfhi(raw.z), bflo(raw.w), bfhi(raw.w)};
#pragma unroll
            for (int i = 0; i < 8; ++i) img[(8 * c + i) * 136 + s] = f2bf(f[i] * rs * vg[i]);
        }
    }
    __syncthreads();
    const u16* W = (const u16*)(ws + WS_WSP) + (size_t)g * 128 * 128 + (size_t)(16 * wid + fr) * 128;
    f32x4 acc[8];
#pragma unroll
    for (int i = 0; i < 8; ++i) acc[i] = (f32x4){0.f, 0.f, 0.f, 0.f};
    const int nks = (16 * wid + 15) / 32 + 1;
    for (int ks = 0; ks < nks; ++ks) {
        const bf16x8 bw = *(const bf16x8*)(W + ks * 32 + 8 * fq);
#pragma unroll
        for (int i = 0; i < 8; ++i) {
            const bf16x8 av = *(const LAS bf16x8*)(img + (16 * i + fr) * 136 + ks * 32 + 8 * fq);
            acc[i] = __builtin_amdgcn_mfma_f32_16x16x32_bf16(av, bw, acc[i], 0, 0, 0);
        }
    }
    const int t = 16 * wid + fr;
    const float bias = a.in[I_BSP][g * 128 + t];
    u16* YO = (u16*)(ws + WS_YO);
#pragma unroll
    for (int i = 0; i < 8; ++i) {
        const int d = 16 * i + 4 * fq;
        const u32x2 uu = *(const u32x2*)(H + (size_t)(row0 + t) * NIN + g * 128 + d);
        const float y0 = bflo(uu.x) * (acc[i][0] + bias), y1 = bfhi(uu.x) * (acc[i][1] + bias), y2 = bflo(uu.y) * (acc[i][2] + bias), y3 = bfhi(uu.y) * (acc[i][3] + bias);
        u32x2 w; w.x = pk2(y0, y1); w.y = pk2(y2, y3);
        *(u32x2*)(YO + (size_t)(row0 + t) * 1536 + g * 128 + d) = w;
    }
}

DI void kvnorm(const Args& a) {
    unsigned char* ws = a.ws;
    const u16* H = (const u16*)(ws + WS_H); const float* SSQ = (const float*)(ws + WS_SSQ);
    const size_t gtid = (size_t)blockIdx.x * NT + otid(), gstride = (size_t)gridDim.x * NT;
    for (size_t idx = gtid; idx < (size_t)T * 24; idx += gstride) {
        const int row = (int)(idx / 24), c = (int)(idx % 24);
        const u16* src; u16* dst; const float* gain; float rs;
        if (c < 16) {
            const f32x4 sq = *(const f32x4*)(SSQ + (size_t)row * 32 + 24);
            rs = __builtin_amdgcn_rsqf(((sq[0] + sq[1]) + (sq[2] + sq[3])) * (1.0f / 128.0f) + EPS);
            src = H + (size_t)row * NIN + 1280 + 8 * c; dst = (u16*)(ws + WS_KVN) + (size_t)row * 128 + 8 * c; gain = a.in[I_KVG] + 8 * c;
        } else {
            const int cc = c - 16;
            rs = __builtin_amdgcn_rsqf((SSQ[(size_t)row * 32 + 28] + SSQ[(size_t)row * 32 + 29]) * (1.0f / 64.0f) + EPS);
            src = H + (size_t)row * NIN + 1408 + 8 * cc; dst = nullptr; gain = a.in[I_KIG] + 8 * cc;
            const u32x4 raw = *(const u32x4*)src;
            u32x2 w8;
            w8.x = pk4_i8(bflo(raw.x) * rs * gain[0], bfhi(raw.x) * rs * gain[1], bflo(raw.y) * rs * gain[2], bfhi(raw.y) * rs * gain[3]);
            w8.y = pk4_i8(bflo(raw.z) * rs * gain[4], bfhi(raw.z) * rs * gain[5], bflo(raw.w) * rs * gain[6], bfhi(raw.w) * rs * gain[7]);
            *(u32x2*)(ws + WS_KIN + (size_t)row * 64 + 8 * cc) = w8;
            continue;
        }
        const u32x4 raw = *(const u32x4*)src;
        u32x4 w;
        w.x = pk2(bflo(raw.x) * rs * gain[0], bfhi(raw.x) * rs * gain[1]); w.y = pk2(bflo(raw.y) * rs * gain[2], bfhi(raw.y) * rs * gain[3]);
        w.z = pk2(bflo(raw.z) * rs * gain[4], bfhi(raw.z) * rs * gain[5]); w.w = pk2(bflo(raw.w) * rs * gain[6], bfhi(raw.w) * rs * gain[7]);
        *(u32x4*)dst = w;
    }
}

constexpr int P3_ROWS = 0, P3_HIST = 131072, P3_LIST = 147456;
DI unsigned f2key(float f) { const unsigned u = __float_as_uint(f); return (u & 0x80000000u) ? ~u : (u | 0x80000000u); }
DI int wave_incl_scan(int v, int lane) {
#pragma unroll
    for (int o = 1; o < 64; o <<= 1) { const int t = __shfl_up(v, o); if (lane >= o) v += t; }
    return v;
}
DI int wave_suffix_scan(int v, int lane) {
#pragma unroll
    for (int o = 1; o < 64; o <<= 1) { const int t = __shfl_down(v, o); if (lane + o < 64) v += t; }
    return v;
}
DI unsigned pk_gt(unsigned kw, unsigned xw, unsigned one) {
    unsigned d, m;
    asm("v_pk_sub_u16 %0, %1, %2 clamp" : "=v"(d) : "v"(kw), "v"(xw));
    asm("v_pk_min_u16 %0, %1, %2" : "=v"(m) : "v"(d), "v"(one));
    return m;
}
DI unsigned pk_subs(unsigned kw, unsigned xw) { unsigned d; asm("v_pk_sub_u16 %0, %1, %2 clamp" : "=v"(d) : "v"(kw), "v"(xw)); return d; }
DI unsigned pk_min1(unsigned d, unsigned one) { unsigned m; asm("v_pk_min_u16 %0, %1, %2" : "=v"(m) : "v"(d), "v"(one)); return m; }
DI unsigned pk_add(unsigned a, unsigned b) { unsigned r; asm("v_pk_add_u16 %0, %1, %2" : "=v"(r) : "v"(a), "v"(b)); return r; }
DI int wave_sum(int v) {
    v += __builtin_amdgcn_update_dpp(0, v, 0xB1, 0xf, 0xf, false);
    v += __builtin_amdgcn_update_dpp(0, v, 0x4E, 0xf, 0xf, false);
    v += __builtin_amdgcn_update_dpp(0, v, 0x141, 0xf, 0xf, false);
    v += __builtin_amdgcn_update_dpp(0, v, 0x140, 0xf, 0xf, false);
    return __builtin_amdgcn_readlane(v, 0) + __builtin_amdgcn_readlane(v, 16) + __builtin_amdgcn_readlane(v, 32) + __builtin_amdgcn_readlane(v, 48);
}
DI int rowaddr(int p) { return (p & ~511) | ((p & 63) << 3) | ((p >> 6) & 7); }
typedef unsigned short us2_t __attribute__((ext_vector_type(2)));
DI unsigned dot2acc(unsigned flags, unsigned wts, unsigned acc) { return __builtin_amdgcn_udot2(__builtin_bit_cast(us2_t, flags), __builtin_bit_cast(us2_t, wts), acc, false); }
DI void select_top16(LAS u16* row, LAS u16* list, int N, int lane) {
    const int Nup = (N + 511) & ~511, niter = Nup >> 9;
    for (int p = N + lane; p < Nup; p += 64) row[rowaddr(p)] = (u16)0;
    wave_lds_sync();
    u32x4 kr[16];
#pragma unroll
    for (int i = 0; i < 16; ++i) { kr[i] = (u32x4){0u, 0u, 0u, 0u}; if (i < niter) kr[i] = *(LAS const u32x4*)(row + i * 512 + lane * 8); }
    const unsigned one = 0x00010001u;
    auto count_gt = [&](unsigned x) -> int {
        const unsigned xw = x | (x << 16);
        unsigned acc = 0u, acc1 = 0u, acc2 = 0u, acc3 = 0u;
#pragma unroll
        for (int c = 0; c < 4; ++c) {
            if (4 * c < niter) {
                unsigned d[16];
#pragma unroll
                for (int i = 0; i < 4; ++i) { d[4 * i] = pk_subs(kr[4 * c + i].x, xw); d[4 * i + 1] = pk_subs(kr[4 * c + i].y, xw); d[4 * i + 2] = pk_subs(kr[4 * c + i].z, xw); d[4 * i + 3] = pk_subs(kr[4 * c + i].w, xw); }
#pragma unroll
                for (int i = 0; i < 16; ++i) d[i] = pk_min1(d[i], one);
#pragma unroll
                for (int i = 0; i < 16; i += 4) { acc = dot2acc(d[i], one, acc); acc1 = dot2acc(d[i + 1], one, acc1); acc2 = dot2acc(d[i + 2], one, acc2); acc3 = dot2acc(d[i + 3], one, acc3); }
            }
        }
        return wave_sum((int)((acc + acc1) + (acc2 + acc3)));
    };
    unsigned T = 0u; int cge = Nup;
#pragma unroll 1
    for (int bit = 15; bit >= 0; --bit) {
        const unsigned cand = T | (1u << bit);
        const int cnt = count_gt(cand - 1u);
        if (cnt >= 256) { T = cand; cge = cnt; }
    }
    auto build = [&](unsigned x, unsigned (&M)[4]) {
        const unsigned xw = x | (x << 16);
#pragma unroll
        for (int c = 0; c < 4; ++c) {
            M[c] = 0u;
            if (4 * c < niter) {
#pragma unroll
                for (int i = 4 * c; i < 4 * c + 4; ++i) {
                    unsigned byte = dot2acc(pk_gt(kr[i].x, xw, one), 0x00020001u, 0u);
                    byte = dot2acc(pk_gt(kr[i].y, xw, one), 0x00080004u, byte);
                    byte = dot2acc(pk_gt(kr[i].z, xw, one), 0x00200010u, byte);
                    byte = dot2acc(pk_gt(kr[i].w, xw, one), 0x00800040u, byte);
                    M[c] |= byte << (8 * (i & 3));
                }
            }
        }
    };
    unsigned M[4];
    build(T - 1u, M);
    if (cge != 256) {
        unsigned G[4]; build(T, G);
        unsigned E[4];
#pragma unroll
        for (int c = 0; c < 4; ++c) E[c] = M[c] & ~G[c];
        const int need = 256 - (cge - wave_sum((int)(__builtin_popcount(E[0]) + __builtin_popcount(E[1]) + __builtin_popcount(E[2]) + __builtin_popcount(E[3]))));
        auto below = [&](int B, int c) -> unsigned { const int nb = B - 32 * c; return nb <= 0 ? 0u : (nb >= 32 ? 0xffffffffu : ((1u << nb) - 1u)); };
        auto ties_below = [&](int B) -> int {
            return wave_sum((int)(__builtin_popcount(E[0] & below(B, 0)) + __builtin_popcount(E[1] & below(B, 1)) + __builtin_popcount(E[2] & below(B, 2)) + __builtin_popcount(E[3] & below(B, 3))));
        };
        int lo = 0, hi = 127;
#pragma unroll 1
        while (lo < hi) { const int mid = (lo + hi) >> 1; if (ties_below(mid + 1) >= need) hi = mid; else lo = mid + 1; }
        const int Bs = lo, r = need - ties_below(Bs);
        const unsigned ew = Bs < 32 ? E[0] : (Bs < 64 ? E[1] : (Bs < 96 ? E[2] : E[3]));
        const bool tb = ((ew >> (Bs & 31)) & 1u) != 0u;
        const unsigned long long em = __ballot(tb);
        const bool take_row = tb && __builtin_popcountll(em & ((1ull << lane) - 1ull)) < r;
#pragma unroll
        for (int c = 0; c < 4; ++c) {
            unsigned tk = E[c] & below(Bs, c);
            if ((Bs >> 5) == c && take_row) tk |= 1u << (Bs & 31);
            M[c] = G[c] | tk;
        }
    }
    const int kl = __builtin_popcount(M[0]) + __builtin_popcount(M[1]) + __builtin_popcount(M[2]) + __builtin_popcount(M[3]);
    int wp = wave_incl_scan(kl, lane) - kl;
#pragma unroll
    for (int c = 0; c < 4; ++c) {
        unsigned m = M[c];
        while (m) { const int b = __builtin_ctz(m); list[wp] = (u16)((32 * c + b) * 64 + lane); ++wp; m &= m - 1u; }
    }
}

DI void dsa_phase(const Args& a, LAS unsigned char* lds) {
    unsigned char* ws = a.ws;
    const int tid = otid(), wid = __builtin_amdgcn_readfirstlane(tid >> 6), lane = tid & 63, fr = lane & 15, fq = lane >> 4;
    const unsigned char* QI = (const unsigned char*)(ws + WS_QI); const unsigned char* KIN = (const unsigned char*)(ws + WS_KIN); const u16* KVN = (const u16*)(ws + WS_KVN);
    const u16* Q = (const u16*)(ws + WS_Q); const float* WI = (const float*)(ws + WS_WI); u16* YO = (u16*)(ws + WS_YO);
    LAS u16* rows = (LAS u16*)(lds + P3_ROWS);
    for (int gi = blockIdx.x; gi < T / 8; gi += gridDim.x) {
        const int b = gi & 3, t0 = S - 8 - 8 * (gi >> 2);
        const size_t brow = (size_t)b * S;
        const int ntile = (t0 + 8 + 15) >> 4;
        __syncthreads();
        {
            typedef int i32x4_t __attribute__((ext_vector_type(4)));
            i32x4_t qa[2]; f32x4 wi[2];
#pragma unroll
            for (int rg = 0; rg < 2; ++rg) {
                qa[rg] = *(const i32x4_t*)(QI + (brow + t0 + 4 * rg + (fr >> 2)) * 256 + (fr & 3) * 64 + 16 * fq);
                wi[rg] = *(const f32x4*)(WI + (brow + t0 + 4 * rg + fq) * 4);
            }
            auto ldk = [&](i32x4_t (&kf)[4], int jt0) {
#pragma unroll
                for (int u = 0; u < 4; ++u) {
                    const int jt = (jt0 + 8 * u) < ntile ? (jt0 + 8 * u) : (ntile - 1);
                    kf[u] = *(const i32x4_t*)(KIN + (brow + jt * 16 + fr) * 64 + 16 * fq);
                }
            };
            auto cmpk = [&](const i32x4_t (&kf)[4], int jt0) {
#pragma unroll
                for (int u = 0; u < 4; ++u) {
                    const int jt = jt0 + 8 * u;
                    if (jt < ntile) {
#pragma unroll
                        for (int rg = 0; rg < 2; ++rg) {
                            i32x4_t d = {0, 0, 0, 0};
                            d = __builtin_amdgcn_mfma_i32_16x16x64_i8(qa[rg], kf[u], d, 0, 0, 0);
                            const float sc = (((float)max(d[0], 0) * wi[rg][0] + (float)max(d[1], 0) * wi[rg][1]) + (float)max(d[2], 0) * wi[rg][2]) + (float)max(d[3], 0) * wi[rg][3];
                            rows[(4 * rg + fq) * 8192 + rowaddr(jt * 16 + fr)] = (u16)(f2key(sc) >> 16);
                        }
                    }
                }
            };
            i32x4_t kA[4], kB[4];
            if (wid < ntile) ldk(kA, wid);
            for (int jt0 = wid; jt0 < ntile; jt0 += 64) {
                const bool hasB = jt0 + 32 < ntile;
                if (hasB) ldk(kB, jt0 + 32);
                cmpk(kA, jt0);
                if (hasB) { if (jt0 + 64 < ntile) ldk(kA, jt0 + 64); cmpk(kB, jt0 + 32); }
            }
        }
        __syncthreads();
        {
            const int q = wid, t = t0 + q, N = t + 1;
            LAS u16* row = rows + q * 8192;
            LAS u16* list = (LAS u16*)(lds + P3_LIST + q * 512);
            int cnt;
            if (N <= 256) { for (int p = lane; p < 256; p += 64) list[p] = p < N ? (u16)p : (u16)0; cnt = N; }
            else { select_top16(row, list, N, lane); cnt = 256; }
            wave_lds_sync();
            bf16x8 qf[4];
            {
                const int head = fr & 7;
                const u16* qrow = Q + (brow + t) * 1024 + head * 128;
                float f[4][8]; float ss = 0.f;
#pragma unroll
                for (int ks = 0; ks < 4; ++ks) {
                    const u32x4 raw = *(const u32x4*)(qrow + ks * 32 + 8 * fq);
                    f[ks][0] = bflo(raw.x); f[ks][1] = bfhi(raw.x); f[ks][2] = bflo(raw.y); f[ks][3] = bfhi(raw.y); f[ks][4] = bflo(raw.z); f[ks][5] = bfhi(raw.z); f[ks][6] = bflo(raw.w); f[ks][7] = bfhi(raw.w);
#pragma unroll
                    for (int j = 0; j < 8; ++j) ss += f[ks][j] * f[ks][j];
                }
                ss += __shfl_xor(ss, 16); ss += __shfl_xor(ss, 32);
                const float rq = __builtin_amdgcn_rsqf(ss * (1.0f / 128.0f) + EPS) * (0.08838834764831845f * 1.4426950408889634f);
#pragma unroll
                for (int ks = 0; ks < 4; ++ks) {
                    const float* qg = a.in[I_QNG] + ks * 32 + 8 * fq;
                    u32x4 w;
                    w.x = pk2(f[ks][0] * rq * qg[0], f[ks][1] * rq * qg[1]); w.y = pk2(f[ks][2] * rq * qg[2], f[ks][3] * rq * qg[3]);
                    w.z = pk2(f[ks][4] * rq * qg[4], f[ks][5] * rq * qg[5]); w.w = pk2(f[ks][6] * rq * qg[6], f[ks][7] * rq * qg[7]);
                    qf[ks] = __builtin_bit_cast(bf16x8, w);
                }
            }
            LAS unsigned char* img = (LAS unsigned char*)row;
            const int nsteps = (cnt + 31) >> 5;
            f32x4 oacc[8];
#pragma unroll
            for (int i = 0; i < 8; ++i) oacc[i] = (f32x4){0.f, 0.f, 0.f, 0.f};
            float mrun = -3.0e38f, lpart = 0.f;
            auto issue = [&](u32x4 (&pf)[8], int pp) {
#pragma unroll
                for (int it = 0; it < 8; ++it) { const int piece = it * 64 + lane; const unsigned key = list[pp * 32 + (piece >> 4)]; pf[it] = *(const u32x4*)(KVN + (brow + key) * 128 + 8 * (piece & 15)); }
            };
            auto step = [&](u32x4 (&pf)[8], int pp) {
#pragma unroll
                for (int it = 0; it < 8; ++it) { const int piece = it * 64 + lane; *(LAS u32x4*)(img + (piece >> 4) * 288 + (piece & 15) * 16) = pf[it]; }
                if (pp + 1 < nsteps) issue(pf, pp + 1);
                wave_lds_sync();
                __builtin_amdgcn_sched_barrier(0);
                f32x4 sa = {0.f, 0.f, 0.f, 0.f}, sb = {0.f, 0.f, 0.f, 0.f};
#pragma unroll
                for (int ks = 0; ks < 4; ++ks) {
                    const bf16x8 a0 = *(LAS const bf16x8*)(img + fr * 288 + (ks * 32 + 8 * fq) * 2), a1 = *(LAS const bf16x8*)(img + (16 + fr) * 288 + (ks * 32 + 8 * fq) * 2);
                    sa = __builtin_amdgcn_mfma_f32_16x16x32_bf16(a0, qf[ks], sa, 0, 0, 0); sb = __builtin_amdgcn_mfma_f32_16x16x32_bf16(a1, qf[ks], sb, 0, 0, 0);
                }
                if (pp * 32 + 32 > cnt) {
                    const int pb0 = pp * 32 + 4 * fq;
#pragma unroll
                    for (int r = 0; r < 4; ++r) { if (pb0 + r >= cnt) sa[r] = -3.0e38f; if (pb0 + 16 + r >= cnt) sb[r] = -3.0e38f; }
                }
                float mx = fmaxf(fmaxf(fmaxf(sa[0], sa[1]), fmaxf(sa[2], sa[3])), fmaxf(fmaxf(sb[0], sb[1]), fmaxf(sb[2], sb[3])));
                mx = fmaxf(mx, __shfl_xor(mx, 16)); mx = fmaxf(mx, __shfl_xor(mx, 32));
                if (__ballot(mx > mrun) != 0ull) {
                    const float mnew = fmaxf(mrun, mx), alpha = __builtin_amdgcn_exp2f(mrun - mnew);
                    mrun = mnew; lpart *= alpha;
#pragma unroll
                    for (int cb = 0; cb < 8; ++cb) oacc[cb] *= alpha;
                }
                float ps = 0.f;
#pragma unroll
                for (int r = 0; r < 4; ++r) { sa[r] = __builtin_amdgcn_exp2f(sa[r] - mrun); sb[r] = __builtin_amdgcn_exp2f(sb[r] - mrun); ps += sa[r] + sb[r]; }
                lpart += ps;
                u32x4 pw; pw.x = pk2(sa[0], sa[1]); pw.y = pk2(sa[2], sa[3]); pw.z = pk2(sb[0], sb[1]); pw.w = pk2(sb[2], sb[3]);
                const bf16x8 pb = __builtin_bit_cast(bf16x8, pw);
#pragma unroll
                for (int cb = 0; cb < 8; ++cb) {
                    const s16x4 r0 = __builtin_amdgcn_ds_read_tr16_b64_v4i16((LAS s16x4*)(img + (4 * fq + (fr >> 2)) * 288 + (cb * 16 + 4 * (fr & 3)) * 2));
                    const s16x4 r1 = __builtin_amdgcn_ds_read_tr16_b64_v4i16((LAS s16x4*)(img + (16 + 4 * fq + (fr >> 2)) * 288 + (cb * 16 + 4 * (fr & 3)) * 2));
                    const bf16x8 av = {r0[0], r0[1], r0[2], r0[3], r1[0], r1[1], r1[2], r1[3]};
                    oacc[cb] = __builtin_amdgcn_mfma_f32_16x16x32_bf16(av, pb, oacc[cb], 0, 0, 0);
                    if (cb == 3) __builtin_amdgcn_sched_barrier(0);
                }
                wave_lds_sync();
            };
            u32x4 pf0[8];
            issue(pf0, 0);
#pragma unroll 1
            for (int pp = 0; pp < nsteps; ++pp) step(pf0, pp);
            float lsum = lpart; lsum += __shfl_xor(lsum, 16); lsum += __shfl_xor(lsum, 32);
            const float inv = __builtin_amdgcn_rcpf(lsum);
            if (fr < 8) {
                u16* orow = YO + (brow + t) * 1536 + 512 + fr * 128 + 4 * fq;
#pragma unroll
                for (int cb = 0; cb < 8; ++cb) { u32x2 w; w.x = pk2(oacc[cb][0] * inv, oacc[cb][1] * inv); w.y = pk2(oacc[cb][2] * inv, oacc[cb][3] * inv); *(u32x2*)(orow + cb * 16) = w; }
            }
        }
    }
}

constexpr int P6_LCNT = 0, P6_BASE = 128, P6_RSB = 256, P6_RI = 1024;
DI unsigned dpp_max_u32(unsigned v) {
    v = max(v, (unsigned)__builtin_amdgcn_update_dpp(0, (int)v, 0xB1, 0xf, 0xf, false));
    v = max(v, (unsigned)__builtin_amdgcn_update_dpp(0, (int)v, 0x4E, 0xf, 0xf, false));
    v = max(v, (unsigned)__builtin_amdgcn_update_dpp(0, (int)v, 0x141, 0xf, 0xf, false));
    v = max(v, (unsigned)__builtin_amdgcn_update_dpp(0, (int)v, 0x140, 0xf, 0xf, false));
    return v;
}
DI float key2f(unsigned k) { return __uint_as_float((k & 0x80000000u) ? (k & 0x7fffffffu) : ~k); }
DI void router_phase(const Args& a, LAS unsigned char* lds) {
    unsigned char* ws = a.ws;
    const int tid = otid(), wid = tid >> 6, lane = tid & 63, fr = lane & 15, fq = lane >> 4;
    LAS int* lcnt = (LAS int*)(lds + P6_LCNT); LAS int* lbase = (LAS int*)(lds + P6_BASE); LAS float* rsb = (LAS float*)(lds + P6_RSB); LAS int* RI = (LAS int*)(lds + P6_RI);
    const u16* WRH = (const u16*)(ws + WS_WR); const u16* WRL = WRH + 32 * 1024;
    unsigned* CNT = (unsigned*)(ws + WS_CTL);
    for (int rg = blockIdx.x; rg < T / 128; rg += gridDim.x) {
        __syncthreads();
        if (tid < 32) lcnt[tid] = 0;
        __syncthreads();
        {
            const int row = rg * 128 + wid * 16 + fr;
            const float* xr = a.out + (size_t)row * 1024 + 8 * fq;
            f32x4 acc[2] = {{0.f, 0.f, 0.f, 0.f}, {0.f, 0.f, 0.f, 0.f}};
            float ss = 0.f;
#pragma unroll 4
            for (int ks = 0; ks < 32; ++ks) {
                const f32x4 x0 = *(const f32x4*)(xr + ks * 32), x1 = *(const f32x4*)(xr + ks * 32 + 4);
                ss += ((x0[0] * x0[0] + x0[1] * x0[1]) + (x0[2] * x0[2] + x0[3] * x0[3])) + ((x1[0] * x1[0] + x1[1] * x1[1]) + (x1[2] * x1[2] + x1[3] * x1[3]));
                u32x4 hw; hw.x = pk2(x0[0], x0[1]); hw.y = pk2(x0[2], x0[3]); hw.z = pk2(x1[0], x1[1]); hw.w = pk2(x1[2], x1[3]);
                u32x4 lw; lw.x = pk2(x0[0] - bflo(hw.x), x0[1] - bfhi(hw.x)); lw.y = pk2(x0[2] - bflo(hw.y), x0[3] - bfhi(hw.y)); lw.z = pk2(x1[0] - bflo(hw.z), x1[1] - bfhi(hw.z)); lw.w = pk2(x1[2] - bflo(hw.w), x1[3] - bfhi(hw.w));
                const bf16x8 xh = __builtin_bit_cast(bf16x8, hw), xl = __builtin_bit_cast(bf16x8, lw);
#pragma unroll
                for (int nt = 0; nt < 2; ++nt) {
                    const bf16x8 wh = *(const bf16x8*)(WRH + (size_t)(nt * 16 + fr) * 1024 + ks * 32 + 8 * fq), wl = *(const bf16x8*)(WRL + (size_t)(nt * 16 + fr) * 1024 + ks * 32 + 8 * fq);
                    acc[nt] = __builtin_amdgcn_mfma_f32_16x16x32_bf16(xh, wh, acc[nt], 0, 0, 0);
                    acc[nt] = __builtin_amdgcn_mfma_f32_16x16x32_bf16(xl, wh, acc[nt], 0, 0, 0);
                    acc[nt] = __builtin_amdgcn_mfma_f32_16x16x32_bf16(xh, wl, acc[nt], 0, 0, 0);
                }
            }
            ss += __shfl_xor(ss, 16); ss += __shfl_xor(ss, 32);
            const float rsrow = __builtin_amdgcn_rsqf(ss * (1.0f / 1024.0f) + EPS);
            if (fq == 0) rsb[wid * 16 + fr] = rsrow;
            {
                unsigned char* xn = ws + WS_XN2 + (size_t)row * 1024 + 8 * fq;
#pragma unroll 4
                for (int ks = 0; ks < 32; ++ks) {
                    const f32x4 x0 = *(const f32x4*)(xr + ks * 32), x1 = *(const f32x4*)(xr + ks * 32 + 4);
                    u32x2 w; w.x = pk4_fp8(x0[0] * rsrow, x0[1] * rsrow, x0[2] * rsrow, x0[3] * rsrow); w.y = pk4_fp8(x1[0] * rsrow, x1[1] * rsrow, x1[2] * rsrow, x1[3] * rsrow);
                    *(u32x2*)(xn + ks * 32) = w;
                }
            }
            wave_lds_sync();
            const float b0 = a.in[I_BR][fr], b1 = a.in[I_BR][16 + fr];
#pragma unroll
            for (int r = 0; r < 4; ++r) {
                const float rs = rsb[wid * 16 + 4 * fq + r];
                unsigned k0 = (f2key(acc[0][r] * rs + b0) & ~31u) | (unsigned)(31 - fr), k1 = (f2key(acc[1][r] * rs + b1) & ~31u) | (unsigned)(15 - fr);
                unsigned sel[4];
#pragma unroll
                for (int k = 0; k < 4; ++k) {
                    const unsigned best = dpp_max_u32(k0 > k1 ? k0 : k1);
                    sel[k] = best;
                    if (k0 == best) k0 = 0u;
                    if (k1 == best) k1 = 0u;
                }
                const float v0 = key2f(sel[0] & ~31u), e1 = __expf(key2f(sel[1] & ~31u) - v0), e2 = __expf(key2f(sel[2] & ~31u) - v0), e3 = __expf(key2f(sel[3] & ~31u) - v0);
                const float inv = 1.0f / (1.0f + e1 + e2 + e3);
                if (fr < 4) {
                    const unsigned sk = fr == 0 ? sel[0] : (fr == 1 ? sel[1] : (fr == 2 ? sel[2] : sel[3]));
                    const int e = 31 - (int)(sk & 31u);
                    const float gt = (fr == 0 ? 1.0f : (fr == 1 ? e1 : (fr == 2 ? e2 : e3))) * inv;
                    const int ls = __hip_atomic_fetch_add(lcnt + e, 1, __ATOMIC_RELAXED, __HIP_MEMORY_SCOPE_WORKGROUP);
                    const int ri = ((wid * 16 + 4 * fq + r) * 4 + fr) * 4;
                    RI[ri + 0] = e; RI[ri + 1] = ls; RI[ri + 2] = __float_as_int(gt);
                }
            }
        }
        __syncthreads();
        if (tid < 32) lbase[tid] = (int)__hip_atomic_fetch_add(CNT + tid, (unsigned)lcnt[tid], __ATOMIC_RELAXED, __HIP_MEMORY_SCOPE_AGENT);
        __syncthreads();
        {
            const int rl = tid >> 2, k = tid & 3, row = rg * 128 + rl;
            const int e = RI[tid * 4 + 0], slot = lbase[e] + RI[tid * 4 + 1];
            ((int*)(ws + WS_LTOK))[(size_t)e * ECAP + slot] = row;
            ((float*)(ws + WS_LGATE))[(size_t)e * ECAP + slot] = __int_as_float(RI[tid * 4 + 2]);
            ((unsigned*)(ws + WS_ROUTE))[(size_t)row * 4 + k] = ((unsigned)e << 16) | (unsigned)slot;
        }
    }
}

DI void combine_phase(const Args& a, LAS unsigned char* lds) {
    unsigned char* ws = a.ws;
    LAS const int* tab = (LAS const int*)(lds + MOE_TAB);
    const int tid = otid(), wid = tid >> 6, lane = tid & 63;
    const u16* YB = (const u16*)(ws + WS_YB); const unsigned* ROUTE = (const unsigned*)(ws + WS_ROUTE);
    for (int row = blockIdx.x * 8 + wid; row < T; row += gridDim.x * 8) {
        size_t pos[4];
#pragma unroll
        for (int k = 0; k < 4; ++k) { const unsigned r = ROUTE[(size_t)row * 4 + k]; const int e = (int)(r >> 16), slot = (int)(r & 0xffffu); pos[k] = (size_t)tab[e] * 256 + slot; }
        float* orow = a.out + (size_t)row * 1024;
#pragma unroll
        for (int i = 0; i < 4; ++i) {
            f32x4 v = *(const f32x4*)(orow + i * 256 + lane * 4);
#pragma unroll
            for (int k = 0; k < 4; ++k) { const u32x2 y = *(const u32x2*)(YB + pos[k] * 1024 + i * 256 + lane * 4); v[0] += bflo(y.x); v[1] += bfhi(y.x); v[2] += bflo(y.y); v[3] += bfhi(y.y); }
            *(f32x4*)(orow + i * 256 + lane * 4) = v;
        }
    }
}

#define XB_TMO      128
#define XB_XCNT(j)  (256  + 64 * (j))
#define XB_XSUB(j)  (1280 + 64 * (j))
#define XB_XGEN(j)  (2304 + 64 * (j))
#define XB_TOP      3328
#define XB_TOPGEN   3392
#define XCD_BAR_WORDS 3456
#define XB_SPIN_CAP (1u << 18)

__device__ __forceinline__ unsigned xb_ld(unsigned* p)              { return __hip_atomic_load(p, __ATOMIC_RELAXED, __HIP_MEMORY_SCOPE_AGENT); }
__device__ __forceinline__ unsigned xb_add(unsigned* p, unsigned v) { return __hip_atomic_fetch_add(p, v, __ATOMIC_RELAXED, __HIP_MEMORY_SCOPE_AGENT); }
__device__ __forceinline__ unsigned xb_xcc_id() { return (unsigned)__builtin_amdgcn_s_getreg((3 << 11) | 20) & 0xFu; }
#define XB_SPIN(cond, bar) do { unsigned _sp = 0; while (cond) { __builtin_amdgcn_s_sleep(1); \
    if ((++_sp & 255u) == 0u) { if (xb_ld(&(bar)[XB_TMO])) break; if (_sp > XB_SPIN_CAP) { atomicAdd(&(bar)[XB_TMO], 1u); break; } } } } while (0)

struct XcdBarrier {
    unsigned* bar; unsigned x;
    volatile LAS unsigned* st;
};

__device__ __forceinline__ XcdBarrier xcd_barrier_post(unsigned* bar, volatile LAS unsigned* st) {
    XcdBarrier b; b.bar = bar; b.x = xb_xcc_id(); b.st = st;
    if (threadIdx.x == 0) (void)xb_add(&bar[XB_XCNT(b.x)], 1u);
    return b;
}
__device__ __forceinline__ void xcd_barrier_complete(unsigned* bar, unsigned x, unsigned& nloc, unsigned& nx) {
    const unsigned G = gridDim.x * gridDim.y * gridDim.z;
    unsigned sum, cnt, mine, sp = 0u;
    for (;;) {
        sum = 0u; cnt = 0u; mine = 0u;
#pragma unroll
        for (unsigned j = 0; j < 16; ++j) { const unsigned c = xb_ld(&bar[XB_XCNT(j)]); sum += c; cnt += (c > 0u) ? 1u : 0u; mine = (j == x) ? c : mine; }
        if (sum == G) break;
        __builtin_amdgcn_s_sleep(1);
        if ((++sp & 255u) == 0u) { if (xb_ld(&bar[XB_TMO])) break; if (sp > XB_SPIN_CAP) { atomicAdd(&bar[XB_TMO], 1u); break; } }
    }
    nloc = mine > 0u ? mine : 1u; nx = cnt > 0u ? cnt : 1u;
}

__device__ __forceinline__ void xcd_barrier(const XcdBarrier& b) {
    asm volatile("s_waitcnt vmcnt(0)" ::: "memory");
    __syncthreads();
    if (threadIdx.x == 0) {
        unsigned* bar = b.bar;
        __builtin_amdgcn_s_waitcnt(0);
        unsigned nloc = b.st[0], nx = b.st[1];
        if (nloc == 0u) { xcd_barrier_complete(bar, b.x, nloc, nx); b.st[0] = nloc; b.st[1] = nx; }
        const unsigned old = xb_add(&bar[XB_XSUB(b.x)], 1u);
        const unsigned gen = old / nloc;
        if (old + 1u == (gen + 1u) * nloc) {
            __builtin_amdgcn_fence(__ATOMIC_RELEASE, "agent");
            asm volatile("s_waitcnt vmcnt(0)" ::: "memory");
            const unsigned og = xb_add(&bar[XB_TOP], 1u);
            const unsigned tg = og / nx;
            if (og + 1u == (tg + 1u) * nx) xb_add(&bar[XB_TOPGEN], 1u);
            else XB_SPIN(xb_ld(&bar[XB_TOPGEN]) == tg, bar);
            __builtin_amdgcn_fence(__ATOMIC_ACQUIRE, "agent");
            xb_add(&bar[XB_XGEN(b.x)], 1u);
            asm volatile("s_waitcnt vmcnt(0)" ::: "memory");
        } else {
            XB_SPIN(xb_ld(&bar[XB_XGEN(b.x)]) == gen, bar);
            __builtin_amdgcn_fence(__ATOMIC_ACQUIRE, "agent");
            asm volatile("s_waitcnt vmcnt(0)" ::: "memory");
        }
    }
    __syncthreads();
}

__global__ void __launch_bounds__(NT, 2) fwd(Args a) {
    extern __shared__ __attribute__((aligned(16))) unsigned char lds_raw[];
    LAS unsigned char* lds = (LAS unsigned char*)lds_raw;
    cg::grid_group grid = cg::this_grid();
    unsigned char* ws = a.ws;
    const int G = gridDim.x, c = blockIdx.x;
    if (threadIdx.x < 2) ((volatile LAS unsigned*)(lds + LDS_BARST))[threadIdx.x] = 0u;
    __syncthreads();
    const XcdBarrier xbar = xcd_barrier_post((unsigned*)(ws + WS_BAR), (volatile LAS unsigned*)(lds + LDS_BARST));

    phase0(a, lds);
    xcd_barrier(xbar);
    {
        g8::PlainSched s; s.Abase = (const char*)(ws + WS_XB); s.Bbase = (const char*)(ws + WS_WIN); s.lda = 1024; s.ldb = 1024; s.K = 1024; s.nM = T / 256; s.nN = NIN / 256; s.G = G; s.c = c;
        EpiIn e; e.H = (u16*)(ws + WS_H); e.rs1 = (const float*)(ws + WS_RS1); e.SSQ = (float*)(ws + WS_SSQ); e.WI = (float*)(ws + WS_WI);
        g8::gemm_phase(lds, s, e);
    }
    xcd_barrier(xbar);
    {
        g8::PlainSched s; s.Abase = (const char*)(ws + WS_H) + 1024 * 2; s.Bbase = (const char*)(ws + WS_WQ); s.lda = NIN; s.ldb = 256; s.K = 256; s.nM = T / 256; s.nN = 5; s.G = G; s.c = c;
        EpiQ e; e.Q = (u16*)(ws + WS_Q); e.QI = (u16*)(ws + WS_QI); e.SSQ = (const float*)(ws + WS_SSQ);
        g8::gemm_phase(lds, s, e);
        for (int u = c; u < 1024; u += G) gmlp_unit(a, lds, u);
        kvnorm(a);
    }
    xcd_barrier(xbar);
    dsa_phase(a, lds);
    xcd_barrier(xbar);
    {
        g8::PlainSched s; s.Abase = (const char*)(ws + WS_YO); s.Bbase = (const char*)(ws + WS_WCAT); s.lda = 1536; s.ldb = 1536; s.K = 512; s.nM = T / 256; s.nN = 4; s.G = G; s.c = c;
        EpiMrg<0> e0; e0.OUT = (u16*)(ws + WS_TMP); e0.TMP = nullptr; e0.H = (const u16*)(ws + WS_H);
        g8::gemm_phase(lds, s, e0);
        s.Abase = (const char*)(ws + WS_YO) + 512 * 2; s.Bbase = (const char*)(ws + WS_WCAT) + 512 * 2; s.K = 1024;
        EpiMrg<1> e1; e1.OUT = (u16*)(ws + WS_MRG); e1.TMP = (const u16*)(ws + WS_TMP); e1.H = (const u16*)(ws + WS_H);
        g8::gemm_phase(lds, s, e1);
    }
    xcd_barrier(xbar);
    {
        g8::PlainSched s; s.Abase = (const char*)(ws + WS_MRG); s.Bbase = (const char*)(ws + WS_WOUT); s.lda = 1024; s.ldb = 1024; s.K = 1024; s.nM = T / 256; s.nN = 4; s.G = G; s.c = c;
        EpiOut e; e.out = a.out; e.x = a.in[I_X];
        g8::gemm_phase(lds, s, e);
    }
    xcd_barrier(xbar);
    router_phase(a, lds);
    xcd_barrier(xbar);
    moe_table(lds, (const unsigned*)(ws + WS_CTL));
    {
        MoeSched<8, true> s; s.Abase = (const char*)(ws + WS_XN2); s.Wbase = (const char*)(ws + WS_WE1); s.LTOK = (const int*)(ws + WS_LTOK); s.tab = (LAS const int*)(lds + MOE_TAB);
        s.lda = 1024; s.ldb = 1024; s.K = 1024; s.G = G; s.c = c; s.wstride = (size_t)2048 * 1024;
        EpiMoe1 e; e.ACT = (unsigned char*)(ws + WS_ACT); e.b1 = a.in[I_BE1];
        g8::gemm_phase<true>(lds, s, e);
    }
    xcd_barrier(xbar);
    {
        MoeSched<4, false> s; s.Abase = (const char*)(ws + WS_ACT); s.Wbase = (const char*)(ws + WS_WE2); s.LTOK = nullptr; s.tab = (LAS const int*)(lds + MOE_TAB);
        s.lda = 1024; s.ldb = 1024; s.K = 1024; s.G = G; s.c = c; s.wstride = (size_t)1024 * 1024;
        EpiMoe2 e; e.YB = (u16*)(ws + WS_YB); e.b2 = a.in[I_BE2]; e.LGATE = (const float*)(ws + WS_LGATE); e.tab = (LAS const int*)(lds + MOE_TAB);
        g8::gemm_phase<true>(lds, s, e);
    }
    xcd_barrier(xbar);
    combine_phase(a, lds);
    if (a.mask == 0u) grid.sync();
}

extern "C" void kernel_launch(void* const* d_in, const int* in_sizes, int n_in, void* d_out, int out_size, void* d_ws, size_t ws_size, hipStream_t stream) {
    static int grid = 0;
    if (grid == 0) {
        int dev = 0, cus = 0, per_cu = 0;
        if (n_in != 23 || out_size != T * Dm || ws_size < WS_END) { fprintf(stderr, "kernel_launch: unexpected problem (n_in %d, out %d, ws %zu < %zu)\n", n_in, out_size, ws_size, (size_t)WS_END); grid = -1; return; }
        if (hipGetDevice(&dev) != hipSuccess || hipDeviceGetAttribute(&cus, hipDeviceAttributeMultiprocessorCount, dev) != hipSuccess) { grid = -1; return; }
        if (hipFuncSetAttribute((const void*)fwd, hipFuncAttributeMaxDynamicSharedMemorySize, LDS_BYTES) != hipSuccess) { fprintf(stderr, "hipFuncSetAttribute failed\n"); grid = -1; return; }
        if (hipOccupancyMaxActiveBlocksPerMultiprocessor(&per_cu, (const void*)fwd, NT, LDS_BYTES) != hipSuccess || per_cu < 1) { fprintf(stderr, "occupancy query failed (%d)\n", per_cu); grid = -1; return; }
        grid = cus;
        fprintf(stderr, "kernel_launch: cus %d per_cu %d grid %d ws %zu need %zu\n", cus, per_cu, grid, ws_size, (size_t)WS_END);
    }
    if (grid < 0) return;
    Args a{};
    for (int i = 0; i < 23; ++i) a.in[i] = (const float*)d_in[i];
    a.out = (float*)d_out; a.ws = (unsigned char*)d_ws; a.mask = 0xffffffffu; a.pad = 0u;
    if (hipMemsetAsync((char*)d_ws + WS_CTL, 0, 65536, stream) != hipSuccess) { fprintf(stderr, "memset failed\n"); return; }
    void* args[] = {&a};
    hipError_t e = hipLaunchCooperativeKernel((const void*)fwd, dim3(grid), dim3(NT), args, LDS_BYTES, stream);
    if (e != hipSuccess) fprintf(stderr, "cooperative launch failed: %s (grid %d)\n", hipGetErrorString(e), grid);
}
```

```cpp
#include <hip/hip_runtime.h>
#include <hip/hip_cooperative_groups.h>
#include <cstdio>
#include <cstdint>
namespace cg = cooperative_groups;

#define LAS __attribute__((address_space(3)))
#define DI __device__ __forceinline__
typedef unsigned short u16;
typedef short bf16x8 __attribute__((ext_vector_type(8)));
typedef short s16x4 __attribute__((ext_vector_type(4)));
typedef float f32x4 __attribute__((ext_vector_type(4)));
typedef float f32x2 __attribute__((ext_vector_type(2)));
typedef unsigned u32x4 __attribute__((ext_vector_type(4)));
typedef unsigned u32x2 __attribute__((ext_vector_type(2)));
typedef __bf16 bf2_t __attribute__((ext_vector_type(2)));
typedef int v8i_t __attribute__((ext_vector_type(8)));

constexpr int NT = 512;
constexpr int LDS_BYTES = 155648;
constexpr int Dm = 1024, Bsz = 4, S = 8192, T = Bsz * S;
constexpr int NIN = 3584;
constexpr int NE = 32, ECAP = 32768, PPAD = 131072 + NE * 256;
constexpr float EPS = 1e-6f;

constexpr size_t MiB = 1024 * 1024;
constexpr size_t WS_CTL = 0;
constexpr size_t WS_BAR = 16384;
constexpr int LDS_BARST = LDS_BYTES - 16;
constexpr size_t WS_WIN = 64 * 1024;
constexpr size_t WS_WQ = WS_WIN + (size_t)NIN * 1024 * 2;
constexpr size_t WS_WSP = WS_WQ + 1280 * 256 * 2;
constexpr size_t WS_WCAT = WS_WSP + 4 * 128 * 128 * 2;
constexpr size_t WS_WOUT = WS_WCAT + 1024 * 1536 * 2;
constexpr size_t WS_WR = WS_WOUT + 1024 * 1024 * 2;
constexpr size_t WS_WE1 = WS_WR + 32 * 1024 * 4;
constexpr size_t WS_WE2 = WS_WE1 + (size_t)32 * 2048 * 1024 * 2;
constexpr size_t WS_RS1 = WS_WE2 + (size_t)32 * 1024 * 1024 * 2;
constexpr size_t WS_SSQ = WS_RS1 + (size_t)T * 4;
constexpr size_t WS_WI = WS_SSQ + (size_t)T * 32 * 4;
constexpr size_t WS_ROUTE = WS_WI + (size_t)T * 4 * 4;
constexpr size_t WS_LTOK = WS_ROUTE + (size_t)T * 4 * 4;
constexpr size_t WS_LGATE = WS_LTOK + (size_t)NE * ECAP * 4;
constexpr size_t WS_LRS = WS_LGATE + (size_t)NE * ECAP * 4;
constexpr size_t WS_XN2 = WS_LRS + (size_t)NE * ECAP * 4;
constexpr size_t WS_R0 = WS_XN2 + (size_t)T * 1024 * 2;
constexpr size_t WS_XB = WS_R0;
constexpr size_t WS_H = WS_XB + (size_t)T * 1024 * 2;
constexpr size_t WS_Q = WS_H + (size_t)T * NIN * 2;
constexpr size_t WS_QI = WS_Q + (size_t)T * 1024 * 2;
constexpr size_t WS_KVN = WS_QI + (size_t)T * 256 * 2;
constexpr size_t WS_KIN = WS_KVN + (size_t)T * 128 * 2;
constexpr size_t WS_YO = WS_KIN + (size_t)T * 64 * 2;
constexpr size_t WS_TMP = WS_YO + (size_t)T * 1536 * 2;
constexpr size_t WS_MRG = WS_TMP + (size_t)T * 1024 * 2;
constexpr size_t WS_R0END = WS_MRG + (size_t)T * 1024 * 2;
constexpr size_t WS_ACT = WS_XB;
constexpr size_t WS_YB = WS_Q;
static_assert(WS_ACT + (size_t)PPAD * 1024 * 2 <= WS_Q, "ACT overlaps YB");
static_assert(WS_YB + (size_t)PPAD * 1024 * 2 <= WS_R0END, "YB too large");
constexpr size_t WS_END = WS_R0END;

struct Args { const float* in[23]; float* out; unsigned char* ws; unsigned mask; unsigned pad; };
enum { I_X = 0, I_N1G, I_WIN, I_QLG, I_WUQ, I_QNG, I_KVG, I_WUV, I_WQI, I_KIG, I_VG, I_WSP, I_BSP, I_WPA, I_WPB, I_WOUT, I_N2G, I_WR, I_BR, I_WE1, I_BE1, I_WE2, I_BE2 };

DI unsigned pk2(float a, float b) { f32x2 v = {a, b}; bf2_t r = __builtin_convertvector(v, bf2_t); return __builtin_bit_cast(unsigned, r); }
DI unsigned pk4_fp8(float a, float b, float c, float d) { unsigned w = 0u; w = (unsigned)__builtin_amdgcn_cvt_pk_fp8_f32(a, b, (int)w, false); w = (unsigned)__builtin_amdgcn_cvt_pk_fp8_f32(c, d, (int)w, true); return w; }
DI unsigned pk4_i8(float a, float b, float c, float d) {
    const int ia = (int)__builtin_rintf(fminf(fmaxf(a * 32.0f, -127.0f), 127.0f)), ib = (int)__builtin_rintf(fminf(fmaxf(b * 32.0f, -127.0f), 127.0f));
    const int ic = (int)__builtin_rintf(fminf(fmaxf(c * 32.0f, -127.0f), 127.0f)), id = (int)__builtin_rintf(fminf(fmaxf(d * 32.0f, -127.0f), 127.0f));
    return (unsigned)(ia & 0xff) | ((unsigned)(ib & 0xff) << 8) | ((unsigned)(ic & 0xff) << 16) | ((unsigned)(id & 0xff) << 24);
}
DI float bflo(unsigned u) { return __uint_as_float(u << 16); }
DI float bfhi(unsigned u) { return __uint_as_float(u & 0xffff0000u); }
DI u16 f2bf(float f) { return (u16)(pk2(f, 0.f) & 0xffffu); }
DI float bf2f(u16 h) { return __uint_as_float(((unsigned)h) << 16); }
DI float sigmoidf_(float x) { return __builtin_amdgcn_rcpf(1.0f + __expf(-x)); }
DI float gelu_tanh(float x) { const float u = 1.5957691216057308f * (x + 0.044715f * x * x * x); return x * sigmoidf_(u); }
DI float fast_sigmoid(float x) { return __builtin_amdgcn_rcpf(1.0f + __builtin_amdgcn_exp2f(x * -1.4426950408889634f)); }
DI float fast_gelu(float x) { const float p = __builtin_fmaf(x * x, -0.10294324f, -2.3022082f); return x * __builtin_amdgcn_rcpf(1.0f + __builtin_amdgcn_exp2f(x * p)); }
DI int otid() { int t = threadIdx.x; asm volatile("" : "+v"(t)); return t; }
DI void wave_lds_sync() { asm volatile("s_waitcnt lgkmcnt(0)" ::: "memory"); }

namespace g8 {
constexpr int BM = 256, BK = 64, HALF = 128, HTB = HALF * BK * 2, STAGE_BYTES = 8 * HTB, NXCD = 8, WGM = 8;
DI int lds_byte(int r, int c) { const int st = (r >> 4) * 2 + (c >> 5), rr = r & 15, cc = c & 31, ob = rr * 64 + cc * 2; return st * 1024 + (ob ^ (((ob >> 9) & 1) << 5)); }
DI int perm32(int rho) { const int n = rho >> 4, i = rho & 15; return 8 * (i >> 2) + 4 * n + (i & 3); }
DI void stage_rc(int b, int& R, int& C) { const int st = b / 1024, sb = b % 1024, swz = sb ^ (((sb >> 9) & 1) << 5); R = (st >> 1) * 16 + swz / 64; C = (st & 1) * 32 + (swz % 64) / 2; }

struct UnitD { const char* Bp; int pm, pn, e, rb; };

DI bool static_tile(int i, int G, int c, int nM, int nN, int& pm, int& pn) {
    const int nwg = nM * nN; const long L = (long)i * G + c; if (L >= nwg) return false;
    int wgid = (int)L; { const int q = nwg / NXCD, r = nwg % NXCD, xcd = wgid % NXCD, off = wgid / NXCD; wgid = (xcd < r ? xcd * (q + 1) : r * (q + 1) + (xcd - r) * q) + off; }
    const int nig = WGM * nN, gid = wgid / nig, fm = gid * WGM, gsz = (nM - fm) < WGM ? (nM - fm) : WGM;
    pm = fm + ((wgid % nig) % gsz); pn = (wgid % nig) / gsz; return true;
}

struct PlainSched {
    const char* Abase; const char* Bbase; int lda, ldb, K, nM, nN, G, c; static constexpr int esz = 2;
    DI bool next(int i, UnitD& u) const { int pm, pn; if (!static_tile(i, G, c, nM, nN, pm, pn)) return false; u.pm = pm; u.pn = pn; u.e = 0; u.rb = 0; u.Bp = Bbase + (size_t)pn * BM * ldb * 2; return true; }
    DI void a_offs(const UnitD& u, int R0, int C0, unsigned (&o)[2][2]) const {
#pragma unroll
        for (int h = 0; h < 2; ++h)
#pragma unroll
            for (int i = 0; i < 2; ++i) o[h][i] = (unsigned)(((size_t)(u.pm * BM + h * HALF + R0 + 64 * i) * lda + C0) * 2);
    }
};

template <bool FP8 = false, class Epi, class Sched>
DI void gemm_phase(LAS unsigned char* lds, const Sched& S, const Epi& E) {
    const int tid = otid(), wid = __builtin_amdgcn_readfirstlane(tid >> 6), lane = tid & 63, wr = wid >> 2, wc = wid & 3, fr = lane & 15, fq = lane >> 4;
    const int nt = S.K * Sched::esz / 128;
    int R0, C0; stage_rc(tid * 16, R0, C0);
    unsigned voffB[2];
#pragma unroll
    for (int i = 0; i < 2; ++i) { const int Rr = R0 + 64 * i, Rb = Epi::PERM ? ((Rr & ~31) + perm32(Rr & 31)) : Rr; voffB[i] = (unsigned)(Rb * S.ldb * Sched::esz + C0 * 2); }
    const size_t hstepB = (size_t)HALF * S.ldb * Sched::esz;
    const unsigned ldsw = (unsigned)wid * 1024u;
    const int aoff = FP8 ? lds_byte(wr * 64 + fr, fq * 16) : lds_byte(wr * 64 + fr, fq * 8), boff = FP8 ? lds_byte(wc * 32 + fr, fq * 16) : lds_byte(wc * 32 + fr, fq * 8);
    const unsigned mxscale = 0x7f7f7f7fu;
    const int kst = FP8 ? 16 : 1024;
    const char* Ab = S.Abase;
#define G8_SA(b, h) (((b) * 2 + (h)) * HTB)
#define G8_SB(b, h) ((4 + (b) * 2 + (h)) * HTB)
#define G8_STAGE_A(bufoff, offs, kb) do { _Pragma("unroll") for (int _i = 0; _i < 2; ++_i) \
        __builtin_amdgcn_global_load_lds((const unsigned*)(Ab + (size_t)(offs)[_i] + (size_t)(kb)), (LAS unsigned*)(lds + (bufoff) + ldsw + _i * 8192), 16, 0, 0); } while (0)
#define G8_STAGE_B(bufoff, gbase, kb) do { _Pragma("unroll") for (int _i = 0; _i < 2; ++_i) \
        __builtin_amdgcn_global_load_lds((const unsigned*)((gbase) + voffB[_i] + (size_t)(kb)), (LAS unsigned*)(lds + (bufoff) + ldsw + _i * 8192), 16, 0, 0); } while (0)
#define G8_LDA(dst, b, h) do { _Pragma("unroll") for (int m = 0; m < 4; ++m) { const i32x4_t _p = *(const LAS i32x4_t*)(lds + G8_SA(b, h) + aoff + m * 2048), _q = *(const LAS i32x4_t*)(lds + G8_SA(b, h) + aoff + m * 2048 + kst); dst[m] = __builtin_shufflevector(_p, _q, 0, 1, 2, 3, 4, 5, 6, 7); } } while (0)
#define G8_LDB(dst, b, h) do { _Pragma("unroll") for (int n = 0; n < 2; ++n) { const i32x4_t _p = *(const LAS i32x4_t*)(lds + G8_SB(b, h) + boff + n * 2048), _q = *(const LAS i32x4_t*)(lds + G8_SB(b, h) + boff + n * 2048 + kst); dst[n] = __builtin_shufflevector(_p, _q, 0, 1, 2, 3, 4, 5, 6, 7); } } while (0)
#define G8_MMA(ai, bj, At, Bt) do { __builtin_amdgcn_s_setprio(1); _Pragma("unroll") for (int m = 0; m < 4; ++m) _Pragma("unroll") for (int n = 0; n < 2; ++n) { \
        if constexpr (FP8) asm volatile("v_mfma_scale_f32_16x16x128_f8f6f4 %0, %1, %2, %0, %3, %3 op_sel_hi:[0,0,0]" : "+v"(acc[ai][bj][m][n]) : "v"(Bt[n]), "v"(At[m]), "v"(mxscale)); \
        else { acc[ai][bj][m][n] = __builtin_amdgcn_mfma_f32_16x16x32_bf16(__builtin_bit_cast(bf16x8, __builtin_shufflevector(Bt[n], Bt[n], 0, 1, 2, 3)), __builtin_bit_cast(bf16x8, __builtin_shufflevector(At[m], At[m], 0, 1, 2, 3)), acc[ai][bj][m][n], 0, 0, 0); \
               acc[ai][bj][m][n] = __builtin_amdgcn_mfma_f32_16x16x32_bf16(__builtin_bit_cast(bf16x8, __builtin_shufflevector(Bt[n], Bt[n], 4, 5, 6, 7)), __builtin_bit_cast(bf16x8, __builtin_shufflevector(At[m], At[m], 4, 5, 6, 7)), acc[ai][bj][m][n], 0, 0, 0); } } \
        __builtin_amdgcn_s_setprio(0); } while (0)
#define G8_WAIT_V(n) asm volatile("s_waitcnt vmcnt(" #n ")" ::: "memory")
#define G8_WAIT_L(n) asm volatile("s_waitcnt lgkmcnt(" #n ")" ::: "memory")
#define G8_BAR __builtin_amdgcn_s_barrier()
#define G8_SCHED __builtin_amdgcn_sched_barrier(0)
    UnitD cur, nxt; int ui = 0;
    if (!S.next(0, cur)) return;
    f32x4 acc[2][2][4][2];
#pragma unroll
    for (int a = 0; a < 2; ++a)
#pragma unroll
        for (int b = 0; b < 2; ++b)
#pragma unroll
            for (int m = 0; m < 4; ++m)
#pragma unroll
                for (int n = 0; n < 2; ++n) acc[a][b][m][n] = (f32x4){0.f, 0.f, 0.f, 0.f};
    typedef int i32x4_t __attribute__((ext_vector_type(4)));
    v8i_t At[4], B0[2], B1[2];
    unsigned cA[2][2];
    S.a_offs(cur, R0, C0, cA);
    const char* cB = cur.Bp;
    G8_STAGE_B(G8_SB(0, 0), cB, 0); G8_STAGE_A(G8_SA(0, 0), cA[0], 0); G8_STAGE_B(G8_SB(0, 1), cB + hstepB, 0); G8_STAGE_A(G8_SA(0, 1), cA[1], 0);
    if (wr == 1) G8_BAR;
    G8_WAIT_V(4); G8_BAR;
    G8_STAGE_B(G8_SB(1, 0), cB, 128); G8_STAGE_A(G8_SA(1, 0), cA[0], 128); G8_STAGE_B(G8_SB(1, 1), cB + hstepB, 128);
    G8_WAIT_V(6); G8_BAR;
    for (;;) {
        const bool has_next = S.next(ui + 1, nxt);
        const char* nB = has_next ? nxt.Bp : cB;
        for (int t = 0; t < nt; t += 2) {
            const bool last = (t == nt - 2);
            const unsigned k1 = (unsigned)(t + 1) * 128u;
            const unsigned k2 = last ? 0u : (unsigned)(t + 2) * 128u, k3 = k2 + 128u;
            unsigned c1[2] = {cA[1][0], cA[1][1]};
            if (last && has_next) S.a_offs(nxt, R0, C0, cA);
            const char* b2 = last ? nB : cB;
            G8_LDB(B0, 0, 0); G8_SCHED; G8_LDA(At, 0, 0); G8_STAGE_A(G8_SA(1, 1), c1, k1);
            G8_WAIT_L(8); G8_BAR; G8_WAIT_L(0); G8_MMA(0, 0, At, B0); G8_BAR; G8_SCHED;
            G8_LDB(B1, 0, 1); G8_STAGE_B(G8_SB(0, 0), b2, k2);
            G8_BAR; G8_WAIT_L(0); G8_MMA(0, 1, At, B1); G8_BAR;
            G8_LDA(At, 0, 1); G8_STAGE_A(G8_SA(0, 0), cA[0], k2);
            G8_BAR; G8_WAIT_L(0); G8_MMA(1, 0, At, B0); G8_BAR; G8_SCHED;
            G8_STAGE_B(G8_SB(0, 1), b2 + hstepB, k2);
            G8_WAIT_V(6); G8_BAR; G8_MMA(1, 1, At, B1); G8_BAR;
            G8_LDB(B0, 1, 0); G8_SCHED; G8_LDA(At, 1, 0); G8_STAGE_A(G8_SA(0, 1), cA[1], k2);
            G8_WAIT_L(8); G8_BAR; G8_WAIT_L(0); G8_MMA(0, 0, At, B0); G8_BAR; G8_SCHED;
            G8_LDB(B1, 1, 1); G8_STAGE_B(G8_SB(1, 0), b2, k3);
            G8_BAR; G8_WAIT_L(0); G8_MMA(0, 1, At, B1); G8_BAR;
            G8_LDA(At, 1, 1); G8_STAGE_A(G8_SA(1, 0), cA[0], k3);
            G8_BAR; G8_WAIT_L(0); G8_MMA(1, 0, At, B0); G8_BAR; G8_SCHED;
            G8_STAGE_B(G8_SB(1, 1), b2 + hstepB, k3);
            G8_WAIT_V(6); G8_BAR; G8_MMA(1, 1, At, B1); G8_BAR;
        }
        if constexpr (FP8) asm volatile("s_nop 15\n\ts_nop 15" ::: "memory");
        E(acc, cur, wr, wc, fr, fq);
        if (!has_next) break;
#pragma unroll
        for (int a = 0; a < 2; ++a)
#pragma unroll
            for (int b = 0; b < 2; ++b)
#pragma unroll
                for (int m = 0; m < 4; ++m)
#pragma unroll
                    for (int n = 0; n < 2; ++n) acc[a][b][m][n] = (f32x4){0.f, 0.f, 0.f, 0.f};
        cur = nxt; cB = nB; ++ui;
    }
    G8_WAIT_V(0);
    if (wr == 0) G8_BAR;
    G8_BAR;
#undef G8_SA
#undef G8_SB
#undef G8_STAGE_A
#undef G8_STAGE_B
#undef G8_LDA
#undef G8_LDB
#undef G8_MMA
#undef G8_WAIT_V
#undef G8_WAIT_L
#undef G8_BAR
#undef G8_SCHED
}
}
using g8::UnitD;
typedef f32x4 Acc[2][2][4][2];

struct EpiIn {
    static constexpr bool PERM = true;
    u16* H; const float* rs1; float* SSQ; float* WI;
    template <int ACT, bool DOSSQ> DI void run(const Acc& acc, const UnitD& u, int wr, int wc, int fr, int fq) const {
        const int pn = u.pn;
        float rsv[2][4];
#pragma unroll
        for (int ai = 0; ai < 2; ++ai)
#pragma unroll
            for (int m = 0; m < 4; ++m) rsv[ai][m] = rs1[u.pm * 256 + ai * 128 + wr * 64 + m * 16 + fr];
        __builtin_amdgcn_sched_barrier(0);
#pragma unroll
        for (int ai = 0; ai < 2; ++ai)
#pragma unroll
            for (int m = 0; m < 4; ++m) {
                const int row = u.pm * 256 + ai * 128 + wr * 64 + m * 16 + fr;
                const float rs = rsv[ai][m];
#pragma unroll
                for (int bj = 0; bj < 2; ++bj) {
                    f32x4 v0 = acc[ai][bj][m][0] * rs, v1 = acc[ai][bj][m][1] * rs;
                    if (ACT == 1) {
#pragma unroll
                        for (int j = 0; j < 4; ++j) { v0[j] = fast_gelu(v0[j]); v1[j] = fast_gelu(v1[j]); }
                    } else if (ACT == 2) {
#pragma unroll
                        for (int j = 0; j < 4; ++j) { v0[j] = fast_sigmoid(v0[j]); v1[j] = fast_sigmoid(v1[j]); }
                    }
                    u32x4 w; w.x = pk2(v0[0], v0[1]); w.y = pk2(v0[2], v0[3]); w.z = pk2(v1[0], v1[1]); w.w = pk2(v1[2], v1[3]);
                    *(u32x4*)(H + (size_t)row * NIN + pn * 256 + bj * 128 + wc * 32 + 8 * fq) = w;
                    if (DOSSQ) {
                        float ssq = ((v0[0] * v0[0] + v0[1] * v0[1]) + (v0[2] * v0[2] + v0[3] * v0[3])) + ((v1[0] * v1[0] + v1[1] * v1[1]) + (v1[2] * v1[2] + v1[3] * v1[3]));
                        ssq += __shfl_xor(ssq, 16); ssq += __shfl_xor(ssq, 32);
                        if (fq == 0) SSQ[(size_t)row * 32 + (pn - 2) * 8 + bj * 4 + wc] = ssq;
                        if (pn == 5 && bj == 1 && wc == 2 && fq == 0) *(f32x4*)(WI + (size_t)row * 4) = v0 * 0.5f;
                    }
                }
            }
    }
    DI void operator()(const Acc& acc, const UnitD& u, int wr, int wc, int fr, int fq) const {
        const int pn = u.pn;
        if (pn < 2) run<1, false>(acc, u, wr, wc, fr, fq);
        else if (pn < 4) run<1, true>(acc, u, wr, wc, fr, fq);
        else if (pn < 6) run<0, true>(acc, u, wr, wc, fr, fq);
        else run<2, false>(acc, u, wr, wc, fr, fq);
    }
};
struct EpiQ {
    static constexpr bool PERM = true;
    u16* Q; u16* QI; const float* SSQ;
    DI void operator()(const Acc& acc, const UnitD& u, int wr, int wc, int fr, int fq) const {
        f32x4 sq[2][4][2];
#pragma unroll
        for (int ai = 0; ai < 2; ++ai)
#pragma unroll
            for (int m = 0; m < 4; ++m) { const int row = u.pm * 256 + ai * 128 + wr * 64 + m * 16 + fr; sq[ai][m][0] = *(const f32x4*)(SSQ + (size_t)row * 32 + 16); sq[ai][m][1] = *(const f32x4*)(SSQ + (size_t)row * 32 + 20); }
        __builtin_amdgcn_sched_barrier(0);
#pragma unroll
        for (int ai = 0; ai < 2; ++ai)
#pragma unroll
            for (int m = 0; m < 4; ++m) {
                const int row = u.pm * 256 + ai * 128 + wr * 64 + m * 16 + fr;
                const f32x4 s0 = sq[ai][m][0], s1 = sq[ai][m][1];
                const float ss = ((s0[0] + s0[1]) + (s0[2] + s0[3])) + ((s1[0] + s1[1]) + (s1[2] + s1[3]));
                const float rs = __builtin_amdgcn_rsqf(ss * (1.0f / 256.0f) + EPS);
#pragma unroll
                for (int bj = 0; bj < 2; ++bj) {
                    const int col = u.pn * 256 + bj * 128 + wc * 32 + 8 * fq;
                    const f32x4 v0 = acc[ai][bj][m][0] * rs, v1 = acc[ai][bj][m][1] * rs;
                    if (col < 1024) { u32x4 w; w.x = pk2(v0[0], v0[1]); w.y = pk2(v0[2], v0[3]); w.z = pk2(v1[0], v1[1]); w.w = pk2(v1[2], v1[3]); *(u32x4*)(Q + (size_t)row * 1024 + col) = w; }
                    else { u32x2 w; w.x = pk4_i8(v0[0], v0[1], v0[2], v0[3]); w.y = pk4_i8(v1[0], v1[1], v1[2], v1[3]); *(u32x2*)((unsigned char*)QI + (size_t)row * 256 + (col - 1024)) = w; }
                }
            }
    }
};
template <int SECOND> struct EpiMrg {
    static constexpr bool PERM = true;
    u16* OUT; const u16* TMP; const u16* H;
    DI void operator()(const Acc& acc, const UnitD& u, int wr, int wc, int fr, int fq) const {
#pragma unroll
        for (int ai = 0; ai < 2; ++ai) {
            u32x4 g[4][2], tp[4][2];
#pragma unroll
            for (int m = 0; m < 4; ++m)
#pragma unroll
                for (int bj = 0; bj < 2; ++bj) {
                    const int row = u.pm * 256 + ai * 128 + wr * 64 + m * 16 + fr, col = u.pn * 256 + bj * 128 + wc * 32 + 8 * fq;
                    g[m][bj] = *(const u32x4*)(H + (size_t)row * NIN + 1536 + SECOND * 1024 + col);
                    if (SECOND) tp[m][bj] = *(const u32x4*)(TMP + (size_t)row * 1024 + col);
                }
            __builtin_amdgcn_sched_barrier(0);
#pragma unroll
            for (int m = 0; m < 4; ++m)
#pragma unroll
                for (int bj = 0; bj < 2; ++bj) {
                    const int row = u.pm * 256 + ai * 128 + wr * 64 + m * 16 + fr, col = u.pn * 256 + bj * 128 + wc * 32 + 8 * fq;
                    const u32x4 gg = g[m][bj];
                    f32x4 v0 = acc[ai][bj][m][0], v1 = acc[ai][bj][m][1];
                    v0[0] *= bflo(gg.x); v0[1] *= bfhi(gg.x); v0[2] *= bflo(gg.y); v0[3] *= bfhi(gg.y); v1[0] *= bflo(gg.z); v1[1] *= bfhi(gg.z); v1[2] *= bflo(gg.w); v1[3] *= bfhi(gg.w);
                    if (SECOND) { const u32x4 t = tp[m][bj];
                        v0[0] += bflo(t.x); v0[1] += bfhi(t.x); v0[2] += bflo(t.y); v0[3] += bfhi(t.y); v1[0] += bflo(t.z); v1[1] += bfhi(t.z); v1[2] += bflo(t.w); v1[3] += bfhi(t.w); }
                    u32x4 w; w.x = pk2(v0[0], v0[1]); w.y = pk2(v0[2], v0[3]); w.z = pk2(v1[0], v1[1]); w.w = pk2(v1[2], v1[3]);
                    *(u32x4*)(OUT + (size_t)row * 1024 + col) = w;
                }
            __builtin_amdgcn_sched_barrier(0);
        }
    }
};
struct EpiOut {
    static constexpr bool PERM = false;
    float* out; const float* x;
    DI void operator()(const Acc& acc, const UnitD& u, int wr, int wc, int fr, int fq) const {
#pragma unroll
        for (int ai = 0; ai < 2; ++ai) {
            f32x4 xv[4][2][2];
#pragma unroll
            for (int m = 0; m < 4; ++m)
#pragma unroll
                for (int bj = 0; bj < 2; ++bj)
#pragma unroll
                    for (int n = 0; n < 2; ++n)
                        xv[m][bj][n] = *(const f32x4*)(x + (size_t)(u.pm * 256 + ai * 128 + wr * 64 + m * 16 + fr) * 1024 + u.pn * 256 + bj * 128 + wc * 32 + n * 16 + 4 * fq);
            __builtin_amdgcn_sched_barrier(0);
#pragma unroll
            for (int m = 0; m < 4; ++m)
#pragma unroll
                for (int bj = 0; bj < 2; ++bj)
#pragma unroll
                    for (int n = 0; n < 2; ++n)
                        *(f32x4*)(out + (size_t)(u.pm * 256 + ai * 128 + wr * 64 + m * 16 + fr) * 1024 + u.pn * 256 + bj * 128 + wc * 32 + n * 16 + 4 * fq) = xv[m][bj][n] + acc[ai][bj][m][n];
            __builtin_amdgcn_sched_barrier(0);
        }
    }
};

constexpr int MOE_TAB = g8::STAGE_BYTES;
DI void moe_table(LAS unsigned char* lds, const unsigned* CNT) {
    LAS int* tab = (LAS int*)(lds + MOE_TAB);
    __syncthreads();
    if (threadIdx.x == 0) { int acc = 0; for (int e = 0; e < NE; ++e) { const int c = (int)__hip_atomic_load(CNT + e, __ATOMIC_RELAXED, __HIP_MEMORY_SCOPE_AGENT); tab[e] = acc; tab[33 + e] = c; acc += (c + 255) >> 8; } tab[32] = acc; }
    __syncthreads();
}
template <int NPN, bool GATHER> struct MoeSched {
    const char* Abase; const char* Wbase; const int* LTOK; LAS const int* tab; int lda, ldb, K, G, c; size_t wstride; static constexpr int esz = 1;
    DI bool next(int i, UnitD& u) const {
        const long L = (long)i * G + c; const int R = tab[32];
        if (L >= (long)R * NPN) return false;
        const int rbg = (int)(L / NPN), pn = (int)(L % NPN);
        int e = 0;
        for (int j = 1; j < NE; ++j) e += (tab[j] <= rbg) ? 1 : 0;
        e = __builtin_amdgcn_readfirstlane(e);
        u.pm = rbg; u.pn = pn; u.e = e; u.rb = rbg - tab[e];
        u.Bp = Wbase + (size_t)e * wstride + (size_t)pn * 256 * ldb * esz;
        return true;
    }
    DI void a_offs(const UnitD& u, int R0, int C0, unsigned (&o)[2][2]) const {
        const int cnt = tab[33 + u.e];
#pragma unroll
        for (int h = 0; h < 2; ++h)
#pragma unroll
            for (int i = 0; i < 2; ++i) {
                const int r = h * 128 + R0 + 64 * i;
                if (GATHER) { const int slot = u.rb * 256 + r; const int tok = slot < cnt ? LTOK[(size_t)u.e * ECAP + slot] : 0; o[h][i] = (unsigned)((size_t)tok * lda * esz + C0 * 2); }
                else o[h][i] = (unsigned)((size_t)(u.pm * 256 + r) * lda * esz + C0 * 2);
            }
    }
};
struct EpiMoe1 {
    static constexpr bool PERM = true;
    unsigned char* ACT; const float* b1;
    DI void operator()(const Acc& acc, const UnitD& u, int wr, int wc, int fr, int fq) const {
        const float* be = b1 + (size_t)u.e * 2048;
        const int hc = u.pn * 128 + wc * 32 + 8 * fq;
        const f32x4 bg0 = *(const f32x4*)(be + hc), bg1 = *(const f32x4*)(be + hc + 4), bu0 = *(const f32x4*)(be + 1024 + hc), bu1 = *(const f32x4*)(be + 1024 + hc + 4);
        __builtin_amdgcn_sched_barrier(0);
#pragma unroll
        for (int ai = 0; ai < 2; ++ai)
#pragma unroll
            for (int m = 0; m < 4; ++m) {
                const int row = u.pm * 256 + ai * 128 + wr * 64 + m * 16 + fr;
                float av[8];
#pragma unroll
                for (int n = 0; n < 2; ++n) {
                    const f32x4 g = acc[ai][0][m][n] * 0.015625f + (n ? bg1 : bg0), up = acc[ai][1][m][n] * 0.015625f + (n ? bu1 : bu0);
#pragma unroll
                    for (int j = 0; j < 4; ++j) {
                        const float hg = fminf(g[j], 7.0f), hu = __builtin_amdgcn_fmed3f(up[j], -7.0f, 7.0f);
                        av[4 * n + j] = (hu + 1.0f) * (hg * __builtin_amdgcn_rcpf(1.0f + __builtin_amdgcn_exp2f(hg * -2.4554669595930157f)));
                    }
                }
                u32x2 w; w.x = pk4_fp8(av[0], av[1], av[2], av[3]); w.y = pk4_fp8(av[4], av[5], av[6], av[7]);
                *(u32x2*)(ACT + (size_t)row * 1024 + hc) = w;
            }
    }
};
struct EpiMoe2 {
    static constexpr bool PERM = true;
    u16* YB; const float* b2; const float* LGATE; LAS const int* tab;
    DI void operator()(const Acc& acc, const UnitD& u, int wr, int wc, int fr, int fq) const {
        const float* be = b2 + (size_t)u.e * 1024; const int cnt = tab[33 + u.e];
        float gate[2][4]; f32x4 bias[2][2];
#pragma unroll
        for (int ai = 0; ai < 2; ++ai)
#pragma unroll
            for (int m = 0; m < 4; ++m) { const int slot = u.rb * 256 + ai * 128 + wr * 64 + m * 16 + fr; gate[ai][m] = slot < cnt ? LGATE[(size_t)u.e * ECAP + slot] : 0.f; }
#pragma unroll
        for (int bj = 0; bj < 2; ++bj) { const int col = u.pn * 256 + bj * 128 + wc * 32 + 8 * fq; bias[bj][0] = *(const f32x4*)(be + col); bias[bj][1] = *(const f32x4*)(be + col + 4); }
        __builtin_amdgcn_sched_barrier(0);
#pragma unroll
        for (int ai = 0; ai < 2; ++ai)
#pragma unroll
            for (int m = 0; m < 4; ++m) {
                const int r = ai * 128 + wr * 64 + m * 16 + fr;
                const float gt = gate[ai][m];
#pragma unroll
                for (int bj = 0; bj < 2; ++bj) {
                    const int col = u.pn * 256 + bj * 128 + wc * 32 + 8 * fq;
                    const f32x4 v0 = (acc[ai][bj][m][0] * 0.015625f + bias[bj][0]) * gt, v1 = (acc[ai][bj][m][1] * 0.015625f + bias[bj][1]) * gt;
                    u32x4 w; w.x = pk2(v0[0], v0[1]); w.y = pk2(v0[2], v0[3]); w.z = pk2(v1[0], v1[1]); w.w = pk2(v1[2], v1[3]);
                    *(u32x4*)(YB + (size_t)(u.pm * 256 + r) * 1024 + col) = w;
                }
            }
    }
};

template <bool FP8 = false, class F> DI void tr_tile(LAS unsigned char* lds, const float* src, int ld_src, int Nsz, int k0, int n0, const float* sk, float mul, u16* dst, int ld_dst, F rowmap) {
    LAS float* t = (LAS float*)lds;
    const int tid = otid();
    __syncthreads();
#pragma unroll
    for (int it = 0; it < 2; ++it) {
        const int k = (tid >> 4) + 32 * it, n = 4 * (tid & 15);
        f32x4 v = {0.f, 0.f, 0.f, 0.f};
        if (n0 + n < Nsz) v = *(const f32x4*)(src + (size_t)(k0 + k) * ld_src + n0 + n);
        const float s = (sk ? sk[k0 + k] : 1.0f) * mul;
        t[k * 65 + n] = v[0] * s; t[k * 65 + n + 1] = v[1] * s; t[k * 65 + n + 2] = v[2] * s; t[k * 65 + n + 3] = v[3] * s;
    }
    __syncthreads();
    const int n = tid >> 3, kc = (tid & 7) * 8;
    if (FP8) {
        if (n0 + n < Nsz) {
            u32x2 w;
            w.x = pk4_fp8(t[(kc + 0) * 65 + n], t[(kc + 1) * 65 + n], t[(kc + 2) * 65 + n], t[(kc + 3) * 65 + n]);
            w.y = pk4_fp8(t[(kc + 4) * 65 + n], t[(kc + 5) * 65 + n], t[(kc + 6) * 65 + n], t[(kc + 7) * 65 + n]);
            *(u32x2*)((unsigned char*)dst + (size_t)rowmap(n0 + n) * ld_dst + k0 + kc) = w;
        }
    } else if (n0 + n < Nsz) {
        u32x4 w;
        w.x = pk2(t[(kc + 0) * 65 + n], t[(kc + 1) * 65 + n]); w.y = pk2(t[(kc + 2) * 65 + n], t[(kc + 3) * 65 + n]);
        w.z = pk2(t[(kc + 4) * 65 + n], t[(kc + 5) * 65 + n]); w.w = pk2(t[(kc + 6) * 65 + n], t[(kc + 7) * 65 + n]);
        *(u32x4*)(dst + (size_t)rowmap(n0 + n) * ld_dst + k0 + kc) = w;
    }
}
struct MapId { DI int operator()(int n) const { return n; } };
struct MapIn { DI int operator()(int n) const { return n < 1476 ? n : n + 60; } };
struct MapE1 { DI int operator()(int n) const { const int hi = n >= 1024 ? 1 : 0, q = n - hi * 1024; return (q >> 7) * 256 + hi * 128 + (q & 127); } };

DI void phase0(const Args& a, LAS unsigned char* lds) {
    unsigned char* ws = a.ws;
    const int tid = otid();
    const size_t gtid = (size_t)blockIdx.x * NT + tid, gstride = (size_t)gridDim.x * NT;
    for (size_t i = gtid; i < 60 * 1024 / 2; i += gstride) ((unsigned*)(ws + WS_WIN + (size_t)1476 * 1024 * 2))[i] = 0u;
    for (size_t i = gtid; i < 32 * 1024; i += gstride) { const int e = (int)(i >> 10), k = (int)(i & 1023); const float w = a.in[I_WR][k * 32 + e] * a.in[I_N2G][k]; const u16 h = f2bf(w); ((u16*)(ws + WS_WR))[i] = h; ((u16*)(ws + WS_WR))[32 * 1024 + i] = f2bf(w - bf2f(h)); }
    for (size_t i = gtid; i < 4 * 128 * 128; i += gstride) { const int tt = (int)((i >> 7) & 127), ss = (int)(i & 127); ((u16*)(ws + WS_WSP))[i] = f2bf(ss <= tt ? a.in[I_WSP][i] : 0.f); }
    {
        const int wid = tid >> 6, lane = tid & 63;
        for (int row = blockIdx.x * 8 + wid; row < T; row += gridDim.x * 8) {
            const float* xr = a.in[I_X] + (size_t)row * 1024; u16* xb = (u16*)(ws + WS_XB) + (size_t)row * 1024;
            float ss = 0.f;
#pragma unroll
            for (int i = 0; i < 4; ++i) {
                const f32x4 v = *(const f32x4*)(xr + i * 256 + lane * 4);
                ss += (v[0] * v[0] + v[1] * v[1]) + (v[2] * v[2] + v[3] * v[3]);
                u32x2 w; w.x = pk2(v[0], v[1]); w.y = pk2(v[2], v[3]);
                *(u32x2*)(xb + i * 256 + lane * 4) = w;
            }
#pragma unroll
            for (int o = 32; o >= 1; o >>= 1) ss += __shfl_xor(ss, o);
            if (lane == 0) ((float*)(ws + WS_RS1))[row] = __builtin_amdgcn_rsqf(ss * (1.0f / 1024.0f) + EPS);
        }
    }
    constexpr int U_IN = 16 * 56, U_UQ = 4 * 16, U_QI = 4 * 4, U_PA = 8 * 16, U_OUT = 16 * 16, U_E1 = 32 * 16 * 32, U_E2 = 32 * 16 * 16, U_CB = 64;
    constexpr int U_TOT = U_IN + U_UQ + U_QI + U_PA + U_OUT + U_E1 + U_E2 + U_CB;
    for (int u = blockIdx.x; u < U_TOT; u += gridDim.x) {
        int v = u;
        if (v < U_IN) { tr_tile(lds, a.in[I_WIN], 3524, 3524, (v & 15) * 64, (v >> 4) * 64, a.in[I_N1G], 1.0f, (u16*)(ws + WS_WIN), 1024, MapIn()); continue; }
        v -= U_IN;
        if (v < U_UQ) { tr_tile(lds, a.in[I_WUQ], 1024, 1024, (v & 3) * 64, (v >> 2) * 64, a.in[I_QLG], 1.0f, (u16*)(ws + WS_WQ), 256, MapId()); continue; }
        v -= U_UQ;
        if (v < U_QI) { tr_tile(lds, a.in[I_WQI], 256, 256, (v & 3) * 64, (v >> 2) * 64, a.in[I_QLG], 1.0f, (u16*)(ws + WS_WQ) + 1024 * 256, 256, MapId()); continue; }
        v -= U_QI;
        if (v < U_PA) { tr_tile(lds, a.in[I_WPA], 1024, 1024, (v & 7) * 64, (v >> 3) * 64, nullptr, 1.0f, (u16*)(ws + WS_WCAT), 1536, MapId()); continue; }
        v -= U_PA;
        if (v < U_OUT) { tr_tile(lds, a.in[I_WOUT], 1024, 1024, (v & 15) * 64, (v >> 4) * 64, nullptr, 1.0f, (u16*)(ws + WS_WOUT), 1024, MapId()); continue; }
        v -= U_OUT;
        if (v < U_E1) { const int e = v >> 9, w = v & 511; tr_tile<true>(lds, a.in[I_WE1] + (size_t)e * 1024 * 2048, 2048, 2048, (w & 15) * 64, (w >> 4) * 64, a.in[I_N2G], 64.0f, (u16*)(ws + WS_WE1 + (size_t)e * 2048 * 1024), 1024, MapE1()); continue; }
        v -= U_E1;
        if (v < U_E2) { const int e = v >> 8, w = v & 255; tr_tile<true>(lds, a.in[I_WE2] + (size_t)e * 1024 * 1024, 1024, 1024, (w & 15) * 64, (w >> 4) * 64, nullptr, 64.0f, (u16*)(ws + WS_WE2 + (size_t)e * 1024 * 1024), 1024, MapId()); continue; }
        v -= U_E2;
        {
            const int h = v >> 3, c0 = (v & 7) * 16;
            LAS float* t = (LAS float*)lds;
            __syncthreads();
            for (int i = tid; i < 1024; i += NT) t[i] = a.in[I_WUV][(size_t)h * 128 * 64 + (size_t)c0 * 64 + i];
            __syncthreads();
            for (int nn = tid; nn < 1024; nn += NT) {
                float accv[16];
#pragma unroll
                for (int i = 0; i < 16; ++i) accv[i] = 0.f;
                for (int vv = 0; vv < 64; ++vv) {
                    const float pb = a.in[I_WPB][(size_t)(h * 64 + vv) * 1024 + nn];
#pragma unroll
                    for (int i = 0; i < 16; ++i) accv[i] += t[i * 64 + vv] * pb;
                }
                u32x4 w0, w1;
                w0.x = pk2(accv[0], accv[1]); w0.y = pk2(accv[2], accv[3]); w0.z = pk2(accv[4], accv[5]); w0.w = pk2(accv[6], accv[7]);
                w1.x = pk2(accv[8], accv[9]); w1.y = pk2(accv[10], accv[11]); w1.z = pk2(accv[12], accv[13]); w1.w = pk2(accv[14], accv[15]);
                u16* d = (u16*)(ws + WS_WCAT) + (size_t)nn * 1536 + 512 + h * 128 + c0;
                *(u32x4*)d = w0; *(u32x4*)(d + 8) = w1;
            }
        }
    }
}

DI void gmlp_unit(const Args& a, LAS unsigned char* lds, int u) {
    unsigned char* ws = a.ws;
    const int tid = otid(), wid = tid >> 6, lane = tid & 63, fr = lane & 15, fq = lane >> 4;
    const int g = u & 3, row0 = (u >> 2) * 128;
    const u16* H = (const u16*)(ws + WS_H);
    LAS u16* img = (LAS u16*)lds;
    __syncthreads();
    {
        const int s = tid & 127, cset = tid >> 7;
        const f32x4 sq = *(const f32x4*)((const float*)(ws + WS_SSQ) + (size_t)(row0 + s) * 32 + g * 4);
        const float rs = __builtin_amdgcn_rsqf(((sq[0] + sq[1]) + (sq[2] + sq[3])) * (1.0f / 128.0f) + EPS);
#pragma unroll
        for (int it = 0; it < 4; ++it) {
            const int c = cset + 4 * it;
            const u32x4 raw = *(const u32x4*)(H + (size_t)(row0 + s) * NIN + 512 + g * 128 + 8 * c);
            const float* vg = a.in[I_VG] + 8 * c;
            float f[8] = {bflo(raw.x), bfhi(raw.x), bflo(raw.y), bfhi(raw.y), bflo(raw.z), bfhi(raw.z), bflo(raw.w), bfhi(raw.w)};
#pragma unroll
            for (int i = 0; i < 8; ++i) img[(8 * c + i) * 136 + s] = f2bf(f[i] * rs * vg[i]);
        }
    }
    __syncthreads();
    const u16* W = (const u16*)(ws + WS_WSP) + (size_t)g * 128 * 128 + (size_t)(16 * wid + fr) * 128;
    f32x4 acc[8];
#pragma unroll
    for (int i = 0; i < 8; ++i) acc[i] = (f32x4){0.f, 0.f, 0.f, 0.f};
    const int nks = (16 * wid + 15) / 32 + 1;
    for (int ks = 0; ks < nks; ++ks) {
        const bf16x8 bw = *(const bf16x8*)(W + ks * 32 + 8 * fq);
#pragma unroll
        for (int i = 0; i < 8; ++i) {
            const bf16x8 av = *(const LAS bf16x8*)(img + (16 * i + fr) * 136 + ks * 32 + 8 * fq);
            acc[i] = __builtin_amdgcn_mfma_f32_16x16x32_bf16(av, bw, acc[i], 0, 0, 0);
        }
    }
    const int t = 16 * wid + fr;
    const float bias = a.in[I_BSP][g * 128 + t];
    u16* YO = (u16*)(ws + WS_YO);
#pragma unroll
    for (int i = 0; i < 8; ++i) {
        const int d = 16 * i + 4 * fq;
        const u32x2 uu = *(const u32x2*)(H + (size_t)(row0 + t) * NIN + g * 128 + d);
        const float y0 = bflo(uu.x) * (acc[i][0] + bias), y1 = bfhi(uu.x) * (acc[i][1] + bias), y2 = bflo(uu.y) * (acc[i][2] + bias), y3 = bfhi(uu.y) * (acc[i][3] + bias);
        u32x2 w; w.x = pk2(y0, y1); w.y = pk2(y2, y3);
        *(u32x2*)(YO + (size_t)(row0 + t) * 1536 + g * 128 + d) = w;
    }
}

DI void kvnorm(const Args& a) {
    unsigned char* ws = a.ws;
    const u16* H = (const u16*)(ws + WS_H); const float* SSQ = (const float*)(ws + WS_SSQ);
    const size_t gtid = (size_t)blockIdx.x * NT + otid(), gstride = (size_t)gridDim.x * NT;
    for (size_t idx = gtid; idx < (size_t)T * 24; idx += gstride) {
        const int row = (int)(idx / 24), c = (int)(idx % 24);
        const u16* src; u16* dst; const float* gain; float rs;
        if (c < 16) {
            const f32x4 sq = *(const f32x4*)(SSQ + (size_t)row * 32 + 24);
            rs = __builtin_amdgcn_rsqf(((sq[0] + sq[1]) + (sq[2] + sq[3])) * (1.0f / 128.0f) + EPS);
            src = H + (size_t)row * NIN + 1280 + 8 * c; dst = (u16*)(ws + WS_KVN) + (size_t)row * 128 + 8 * c; gain = a.in[I_KVG] + 8 * c;
        } else {
            const int cc = c - 16;
            rs = __builtin_amdgcn_rsqf((SSQ[(size_t)row * 32 + 28] + SSQ[(size_t)row * 32 + 29]) * (1.0f / 64.0f) + EPS);
            src = H + (size_t)row * NIN + 1408 + 8 * cc; dst = nullptr; gain = a.in[I_KIG] + 8 * cc;
            const u32x4 raw = *(const u32x4*)src;
            u32x2 w8;
            w8.x = pk4_i8(bflo(raw.x) * rs * gain[0], bfhi(raw.x) * rs * gain[1], bflo(raw.y) * rs * gain[2], bfhi(raw.y) * rs * gain[3]);
            w8.y = pk4_i8(bflo(raw.z) * rs * gain[4], bfhi(raw.z) * rs * gain[5], bflo(raw.w) * rs * gain[6], bfhi(raw.w) * rs * gain[7]);
            *(u32x2*)(ws + WS_KIN + (size_t)row * 64 + 8 * cc) = w8;
            continue;
        }
        const u32x4 raw = *(const u32x4*)src;
        u32x4 w;
        w.x = pk2(bflo(raw.x) * rs * gain[0], bfhi(raw.x) * rs * gain[1]); w.y = pk2(bflo(raw.y) * rs * gain[2], bfhi(raw.y) * rs * gain[3]);
        w.z = pk2(bflo(raw.z) * rs * gain[4], bfhi(raw.z) * rs * gain[5]); w.w = pk2(bflo(raw.w) * rs * gain[6], bfhi(raw.w) * rs * gain[7]);
        *(u32x4*)dst = w;
    }
}

constexpr int P3_ROWS = 0, P3_HIST = 131072, P3_LIST = 147456;
DI unsigned f2key(float f) { const unsigned u = __float_as_uint(f); return (u & 0x80000000u) ? ~u : (u | 0x80000000u); }
DI int wave_incl_scan(int v, int lane) {
#pragma unroll
    for (int o = 1; o < 64; o <<= 1) { const int t = __shfl_up(v, o); if (lane >= o) v += t; }
    return v;
}
DI int wave_suffix_scan(int v, int lane) {
#pragma unroll
    for (int o = 1; o < 64; o <<= 1) { const int t = __shfl_down(v, o); if (lane + o < 64) v += t; }
    return v;
}
DI unsigned pk_gt(unsigned kw, unsigned xw, unsigned one) {
    unsigned d, m;
    asm("v_pk_sub_u16 %0, %1, %2 clamp" : "=v"(d) : "v"(kw), "v"(xw));
    asm("v_pk_min_u16 %0, %1, %2" : "=v"(m) : "v"(d), "v"(one));
    return m;
}
DI unsigned pk_subs(unsigned kw, unsigned xw) { unsigned d; asm("v_pk_sub_u16 %0, %1, %2 clamp" : "=v"(d) : "v"(kw), "v"(xw)); return d; }
DI unsigned pk_min1(unsigned d, unsigned one) { unsigned m; asm("v_pk_min_u16 %0, %1, %2" : "=v"(m) : "v"(d), "v"(one)); return m; }
DI unsigned pk_add(unsigned a, unsigned b) { unsigned r; asm("v_pk_add_u16 %0, %1, %2" : "=v"(r) : "v"(a), "v"(b)); return r; }
DI int wave_sum(int v) {
    v += __builtin_amdgcn_update_dpp(0, v, 0xB1, 0xf, 0xf, false);
    v += __builtin_amdgcn_update_dpp(0, v, 0x4E, 0xf, 0xf, false);
    v += __builtin_amdgcn_update_dpp(0, v, 0x141, 0xf, 0xf, false);
    v += __builtin_amdgcn_update_dpp(0, v, 0x140, 0xf, 0xf, false);
    return __builtin_amdgcn_readlane(v, 0) + __builtin_amdgcn_readlane(v, 16) + __builtin_amdgcn_readlane(v, 32) + __builtin_amdgcn_readlane(v, 48);
}
DI int rowaddr(int p) { return (p & ~511) | ((p & 63) << 3) | ((p >> 6) & 7); }
typedef unsigned short us2_t __attribute__((ext_vector_type(2)));
DI unsigned dot2acc(unsigned flags, unsigned wts, unsigned acc) { return __builtin_amdgcn_udot2(__builtin_bit_cast(us2_t, flags), __builtin_bit_cast(us2_t, wts), acc, false); }
DI void keys_load(LAS u16* row, int N, int lane, u32x4 (&kr)[16]) {
    const int Nup = (N + 511) & ~511, niter = Nup >> 9;
    for (int p = N + lane; p < Nup; p += 64) row[rowaddr(p)] = (u16)0;
    wave_lds_sync();
#pragma unroll
    for (int i = 0; i < 16; ++i) { kr[i] = (u32x4){0u, 0u, 0u, 0u}; if (i < niter) kr[i] = *(LAS const u32x4*)(row + i * 512 + lane * 8); }
    wave_lds_sync();
}
DI void keys_select(const u32x4 (&kr)[16], LAS u16* list, int N, int lane) {
    const int Nup = (N + 511) & ~511, niter = Nup >> 9;
    const unsigned one = 0x00010001u;
    auto count_gt = [&](unsigned x) -> int {
        const unsigned xw = x | (x << 16);
        unsigned acc = 0u, acc1 = 0u, acc2 = 0u, acc3 = 0u;
#pragma unroll
        for (int c = 0; c < 4; ++c) {
            if (4 * c < niter) {
#pragma unroll
                for (int h = 0; h < 2; ++h) {
                    unsigned d[8];
#pragma unroll
                    for (int i = 0; i < 2; ++i) { const u32x4 kk = kr[4 * c + 2 * h + i]; d[4 * i] = pk_subs(kk.x, xw); d[4 * i + 1] = pk_subs(kk.y, xw); d[4 * i + 2] = pk_subs(kk.z, xw); d[4 * i + 3] = pk_subs(kk.w, xw); }
#pragma unroll
                    for (int i = 0; i < 8; ++i) d[i] = pk_min1(d[i], one);
#pragma unroll
                    for (int i = 0; i < 8; i += 4) { acc = dot2acc(d[i], one, acc); acc1 = dot2acc(d[i + 1], one, acc1); acc2 = dot2acc(d[i + 2], one, acc2); acc3 = dot2acc(d[i + 3], one, acc3); }
                }
            }
        }
        return wave_sum((int)((acc + acc1) + (acc2 + acc3)));
    };
    unsigned T = 0u; int cge = Nup;
#pragma unroll 1
    for (int bit = 15; bit >= 0; --bit) {
        const unsigned cand = T | (1u << bit);
        const int cnt = count_gt(cand - 1u);
        if (cnt >= 256) { T = cand; cge = cnt; }
    }
    auto build = [&](unsigned x, unsigned (&M)[4]) {
        const unsigned xw = x | (x << 16);
#pragma unroll
        for (int c = 0; c < 4; ++c) {
            M[c] = 0u;
            if (4 * c < niter) {
#pragma unroll
                for (int i = 4 * c; i < 4 * c + 4; ++i) {
                    unsigned byte = dot2acc(pk_gt(kr[i].x, xw, one), 0x00020001u, 0u);
                    byte = dot2acc(pk_gt(kr[i].y, xw, one), 0x00080004u, byte);
                    byte = dot2acc(pk_gt(kr[i].z, xw, one), 0x00200010u, byte);
                    byte = dot2acc(pk_gt(kr[i].w, xw, one), 0x00800040u, byte);
                    M[c] |= byte << (8 * (i & 3));
                }
            }
        }
    };
    unsigned M[4];
    build(T - 1u, M);
    if (cge != 256) {
        unsigned G[4]; build(T, G);
        unsigned E[4];
#pragma unroll
        for (int c = 0; c < 4; ++c) E[c] = M[c] & ~G[c];
        const int need = 256 - (cge - wave_sum((int)(__builtin_popcount(E[0]) + __builtin_popcount(E[1]) + __builtin_popcount(E[2]) + __builtin_popcount(E[3]))));
        auto below = [&](int B, int c) -> unsigned { const int nb = B - 32 * c; return nb <= 0 ? 0u : (nb >= 32 ? 0xffffffffu : ((1u << nb) - 1u)); };
        auto ties_below = [&](int B) -> int {
            return wave_sum((int)(__builtin_popcount(E[0] & below(B, 0)) + __builtin_popcount(E[1] & below(B, 1)) + __builtin_popcount(E[2] & below(B, 2)) + __builtin_popcount(E[3] & below(B, 3))));
        };
        int lo = 0, hi = 127;
#pragma unroll 1
        while (lo < hi) { const int mid = (lo + hi) >> 1; if (ties_below(mid + 1) >= need) hi = mid; else lo = mid + 1; }
        const int Bs = lo, r = need - ties_below(Bs);
        const unsigned ew = Bs < 32 ? E[0] : (Bs < 64 ? E[1] : (Bs < 96 ? E[2] : E[3]));
        const bool tb = ((ew >> (Bs & 31)) & 1u) != 0u;
        const unsigned long long em = __ballot(tb);
        const bool take_row = tb && __builtin_popcountll(em & ((1ull << lane) - 1ull)) < r;
#pragma unroll
        for (int c = 0; c < 4; ++c) {
            unsigned tk = E[c] & below(Bs, c);
            if ((Bs >> 5) == c && take_row) tk |= 1u << (Bs & 31);
            M[c] = G[c] | tk;
        }
    }
    const int kl = __builtin_popcount(M[0]) + __builtin_popcount(M[1]) + __builtin_popcount(M[2]) + __builtin_popcount(M[3]);
    int wp = wave_incl_scan(kl, lane) - kl;
#pragma unroll
    for (int c = 0; c < 4; ++c) {
        unsigned m = M[c];
        while (m) { const int b = __builtin_ctz(m); list[wp] = (u16)((32 * c + b) * 64 + lane); ++wp; m &= m - 1u; }
    }
}

DI void attend(const Args& a, size_t brow, int t, int cnt, LAS const u16* list, LAS unsigned char* img, int lane, int fr, int fq) {
    const u16* Q = (const u16*)(a.ws + WS_Q); const u16* KVN = (const u16*)(a.ws + WS_KVN); u16* YO = (u16*)(a.ws + WS_YO);
    bf16x8 qf[4];
    {
        const int head = fr & 7;
        const u16* qrow = Q + (brow + t) * 1024 + head * 128;
        float f[4][8]; float ss = 0.f;
#pragma unroll
        for (int ks = 0; ks < 4; ++ks) {
            const u32x4 raw = *(const u32x4*)(qrow + ks * 32 + 8 * fq);
            f[ks][0] = bflo(raw.x); f[ks][1] = bfhi(raw.x); f[ks][2] = bflo(raw.y); f[ks][3] = bfhi(raw.y); f[ks][4] = bflo(raw.z); f[ks][5] = bfhi(raw.z); f[ks][6] = bflo(raw.w); f[ks][7] = bfhi(raw.w);
#pragma unroll
            for (int j = 0; j < 8; ++j) ss += f[ks][j] * f[ks][j];
        }
        ss += __shfl_xor(ss, 16); ss += __shfl_xor(ss, 32);
        const float rq = __builtin_amdgcn_rsqf(ss * (1.0f / 128.0f) + EPS) * (0.08838834764831845f * 1.4426950408889634f);
#pragma unroll
        for (int ks = 0; ks < 4; ++ks) {
            const float* qg = a.in[I_QNG] + ks * 32 + 8 * fq;
            u32x4 w;
            w.x = pk2(f[ks][0] * rq * qg[0], f[ks][1] * rq * qg[1]); w.y = pk2(f[ks][2] * rq * qg[2], f[ks][3] * rq * qg[3]);
            w.z = pk2(f[ks][4] * rq * qg[4], f[ks][5] * rq * qg[5]); w.w = pk2(f[ks][6] * rq * qg[6], f[ks][7] * rq * qg[7]);
            qf[ks] = __builtin_bit_cast(bf16x8, w);
        }
    }
    const int nsteps = (cnt + 31) >> 5;
    f32x4 oacc[8];
#pragma unroll
    for (int i = 0; i < 8; ++i) oacc[i] = (f32x4){0.f, 0.f, 0.f, 0.f};
    float mrun = -3.0e38f, lpart = 0.f;
    auto issue = [&](u32x4 (&pf)[8], int pp) {
#pragma unroll
        for (int it = 0; it < 8; ++it) { const int piece = it * 64 + lane; const unsigned key = list[pp * 32 + (piece >> 4)]; pf[it] = *(const u32x4*)(KVN + (brow + key) * 128 + 8 * (piece & 15)); }
    };
    auto step = [&](u32x4 (&pf)[8], int pp) {
#pragma unroll
        for (int it = 0; it < 8; ++it) { const int piece = it * 64 + lane; *(LAS u32x4*)(img + (piece >> 4) * 288 + (piece & 15) * 16) = pf[it]; }
        if (pp + 1 < nsteps) issue(pf, pp + 1);
        wave_lds_sync();
        __builtin_amdgcn_sched_barrier(0);
        f32x4 sa = {0.f, 0.f, 0.f, 0.f}, sb = {0.f, 0.f, 0.f, 0.f};
#pragma unroll
        for (int ks = 0; ks < 4; ++ks) {
            const bf16x8 a0 = *(LAS const bf16x8*)(img + fr * 288 + (ks * 32 + 8 * fq) * 2), a1 = *(LAS const bf16x8*)(img + (16 + fr) * 288 + (ks * 32 + 8 * fq) * 2);
            sa = __builtin_amdgcn_mfma_f32_16x16x32_bf16(a0, qf[ks], sa, 0, 0, 0); sb = __builtin_amdgcn_mfma_f32_16x16x32_bf16(a1, qf[ks], sb, 0, 0, 0);
            if (ks == 1) __builtin_amdgcn_sched_barrier(0);
        }
        if (pp * 32 + 32 > cnt) {
            const int pb0 = pp * 32 + 4 * fq;
#pragma unroll
            for (int r = 0; r < 4; ++r) { if (pb0 + r >= cnt) sa[r] = -3.0e38f; if (pb0 + 16 + r >= cnt) sb[r] = -3.0e38f; }
        }
        float mx = fmaxf(fmaxf(fmaxf(sa[0], sa[1]), fmaxf(sa[2], sa[3])), fmaxf(fmaxf(sb[0], sb[1]), fmaxf(sb[2], sb[3])));
        mx = fmaxf(mx, __shfl_xor(mx, 16)); mx = fmaxf(mx, __shfl_xor(mx, 32));
        if (__ballot(mx > mrun) != 0ull) {
            const float mnew = fmaxf(mrun, mx), alpha = __builtin_amdgcn_exp2f(mrun - mnew);
            mrun = mnew; lpart *= alpha;
#pragma unroll
            for (int cb = 0; cb < 8; ++cb) oacc[cb] *= alpha;
        }
        float ps = 0.f;
#pragma unroll
        for (int r = 0; r < 4; ++r) { sa[r] = __builtin_amdgcn_exp2f(sa[r] - mrun); sb[r] = __builtin_amdgcn_exp2f(sb[r] - mrun); ps += sa[r] + sb[r]; }
        lpart += ps;
        u32x4 pw; pw.x = pk2(sa[0], sa[1]); pw.y = pk2(sa[2], sa[3]); pw.z = pk2(sb[0], sb[1]); pw.w = pk2(sb[2], sb[3]);
        const bf16x8 pb = __builtin_bit_cast(bf16x8, pw);
#pragma unroll
        for (int cb = 0; cb < 8; ++cb) {
            const s16x4 r0 = __builtin_amdgcn_ds_read_tr16_b64_v4i16((LAS s16x4*)(img + (4 * fq + (fr >> 2)) * 288 + (cb * 16 + 4 * (fr & 3)) * 2));
            const s16x4 r1 = __builtin_amdgcn_ds_read_tr16_b64_v4i16((LAS s16x4*)(img + (16 + 4 * fq + (fr >> 2)) * 288 + (cb * 16 + 4 * (fr & 3)) * 2));
            const bf16x8 av = {r0[0], r0[1], r0[2], r0[3], r1[0], r1[1], r1[2], r1[3]};
            oacc[cb] = __builtin_amdgcn_mfma_f32_16x16x32_bf16(av, pb, oacc[cb], 0, 0, 0);
            if (cb == 3) __builtin_amdgcn_sched_barrier(0);
        }
        wave_lds_sync();
    };
    u32x4 pf0[8];
    issue(pf0, 0);
#pragma unroll 1
    for (int pp = 0; pp < nsteps; ++pp) step(pf0, pp);
    float lsum = lpart; lsum += __shfl_xor(lsum, 16); lsum += __shfl_xor(lsum, 32);
    const float inv = __builtin_amdgcn_rcpf(lsum);
    if (fr < 8) {
        u16* orow = YO + (brow + t) * 1536 + 512 + fr * 128 + 4 * fq;
#pragma unroll
        for (int cb = 0; cb < 8; ++cb) { u32x2 w; w.x = pk2(oacc[cb][0] * inv, oacc[cb][1] * inv); w.y = pk2(oacc[cb][2] * inv, oacc[cb][3] * inv); *(u32x2*)(orow + cb * 16) = w; }
    }
}

DI void dsa_phase(const Args& a, LAS unsigned char* lds) {
    unsigned char* ws = a.ws;
    const int wid = __builtin_amdgcn_readfirstlane(otid() >> 6);
    LAS u16* rows = (LAS u16*)(lds + P3_ROWS);
    bool bprev = false; size_t pbrow = 0; int pt0 = 0, bbuf = 0;
    for (int gi = blockIdx.x; gi < T / 8; gi += gridDim.x) {
        const int lane = otid() & 63, fr = lane & 15, fq = lane >> 4;
        const int b = gi & 3, t0 = S - 8 - 8 * (gi >> 2);
        const size_t brow = (size_t)b * S;
        const int ntile = (t0 + 8 + 15) >> 4;
        __syncthreads();
        {
            const unsigned char* QI = (const unsigned char*)(ws + WS_QI); const unsigned char* KIN = (const unsigned char*)(ws + WS_KIN); const float* WI = (const float*)(ws + WS_WI);
            typedef int i32x4_t __attribute__((ext_vector_type(4)));
            i32x4_t qa[2]; f32x4 wi[2];
#pragma unroll
            for (int rg = 0; rg < 2; ++rg) {
                qa[rg] = *(const i32x4_t*)(QI + (brow + t0 + 4 * rg + (fr >> 2)) * 256 + (fr & 3) * 64 + 16 * fq);
                wi[rg] = *(const f32x4*)(WI + (brow + t0 + 4 * rg + fq) * 4);
            }
            auto ldk = [&](i32x4_t (&kf)[4], int jt0) {
#pragma unroll
                for (int u = 0; u < 4; ++u) {
                    const int jt = (jt0 + 8 * u) < ntile ? (jt0 + 8 * u) : (ntile - 1);
                    kf[u] = *(const i32x4_t*)(KIN + (brow + jt * 16 + fr) * 64 + 16 * fq);
                }
            };
            auto cmpk = [&](const i32x4_t (&kf)[4], int jt0) {
#pragma unroll
                for (int u = 0; u < 4; ++u) {
                    const int jt = jt0 + 8 * u;
                    if (jt < ntile) {
#pragma unroll
                        for (int rg = 0; rg < 2; ++rg) {
                            i32x4_t d = {0, 0, 0, 0};
                            d = __builtin_amdgcn_mfma_i32_16x16x64_i8(qa[rg], kf[u], d, 0, 0, 0);
                            const float sc = (((float)max(d[0], 0) * wi[rg][0] + (float)max(d[1], 0) * wi[rg][1]) + (float)max(d[2], 0) * wi[rg][2]) + (float)max(d[3], 0) * wi[rg][3];
                            rows[(4 * rg + fq) * 8192 + rowaddr(jt * 16 + fr)] = (u16)(f2key(sc) >> 16);
                        }
                    }
                }
            };
            i32x4_t kA[4], kB[4];
            if (wid < ntile) ldk(kA, wid);
            for (int jt0 = wid; jt0 < ntile; jt0 += 64) {
                const bool hasB = jt0 + 32 < ntile;
                if (hasB) ldk(kB, jt0 + 32);
                cmpk(kA, jt0);
                if (hasB) { if (jt0 + 64 < ntile) ldk(kA, jt0 + 64); cmpk(kB, jt0 + 32); }
            }
        }
        __syncthreads();
        if (wid < 4) {
            u32x4 kr[16];
            const int N0 = t0 + wid + 1, N1 = N0 + 4;
            if (N0 > 256) keys_load(rows + wid * 8192, N0, lane, kr);
            __syncthreads();
            LAS u16* l0 = (LAS u16*)(lds + (bbuf ? P3_HIST : P3_LIST) + wid * 512);
            LAS u16* l1 = l0 + 4 * 256;
            if (N0 > 256) keys_select(kr, l0, N0, lane); else { for (int p = lane; p < 256; p += 64) l0[p] = p < N0 ? (u16)p : (u16)0; }
            if (N1 > 256) { keys_load(rows + (wid + 4) * 8192, N1, lane, kr); keys_select(kr, l1, N1, lane); } else { for (int p = lane; p < 256; p += 64) l1[p] = p < N1 ? (u16)p : (u16)0; }
        } else {
            __syncthreads();
            if (bprev) {
                LAS const u16* lp = (LAS const u16*)(lds + (bbuf ? P3_LIST : P3_HIST));
                LAS unsigned char* img = (LAS unsigned char*)(rows + (wid - 4) * 8192);
                { const int q = wid - 4, t = pt0 + q; attend(a, pbrow, t, t + 1 < 256 ? t + 1 : 256, lp + q * 256, img, lane, fr, fq); }
                { const int q = wid, t = pt0 + q; attend(a, pbrow, t, t + 1 < 256 ? t + 1 : 256, lp + q * 256, img, lane, fr, fq); }
            }
        }
        bprev = true; pbrow = brow; pt0 = t0; bbuf ^= 1;
    }
    __syncthreads();
    if (bprev) {
        const int lane = otid() & 63, fr = lane & 15, fq = lane >> 4;
        LAS const u16* lp = (LAS const u16*)(lds + (bbuf ? P3_LIST : P3_HIST));
        const int q = wid, t = pt0 + q;
        attend(a, pbrow, t, t + 1 < 256 ? t + 1 : 256, lp + q * 256, (LAS unsigned char*)(rows + wid * 8192), lane, fr, fq);
    }
}

constexpr int P6_LCNT = 0, P6_BASE = 128, P6_RSB = 256, P6_RI = 1024;
DI unsigned dpp_max_u32(unsigned v) {
    v = max(v, (unsigned)__builtin_amdgcn_update_dpp(0, (int)v, 0xB1, 0xf, 0xf, false));
    v = max(v, (unsigned)__builtin_amdgcn_update_dpp(0, (int)v, 0x4E, 0xf, 0xf, false));
    v = max(v, (unsigned)__builtin_amdgcn_update_dpp(0, (int)v, 0x141, 0xf, 0xf, false));
    v = max(v, (unsigned)__builtin_amdgcn_update_dpp(0, (int)v, 0x140, 0xf, 0xf, false));
    return v;
}
DI float key2f(unsigned k) { return __uint_as_float((k & 0x80000000u) ? (k & 0x7fffffffu) : ~k); }
DI void router_phase(const Args& a, LAS unsigned char* lds) {
    unsigned char* ws = a.ws;
    const int tid = otid(), wid = tid >> 6, lane = tid & 63, fr = lane & 15, fq = lane >> 4;
    LAS int* lcnt = (LAS int*)(lds + P6_LCNT); LAS int* lbase = (LAS int*)(lds + P6_BASE); LAS float* rsb = (LAS float*)(lds + P6_RSB); LAS int* RI = (LAS int*)(lds + P6_RI);
    const u16* WRH = (const u16*)(ws + WS_WR); const u16* WRL = WRH + 32 * 1024;
    unsigned* CNT = (unsigned*)(ws + WS_CTL);
    for (int rg = blockIdx.x; rg < T / 128; rg += gridDim.x) {
        __syncthreads();
        if (tid < 32) lcnt[tid] = 0;
        __syncthreads();
        {
            const int row = rg * 128 + wid * 16 + fr;
            const float* xr = a.out + (size_t)row * 1024 + 8 * fq;
            f32x4 acc[2] = {{0.f, 0.f, 0.f, 0.f}, {0.f, 0.f, 0.f, 0.f}};
            float ss = 0.f;
#pragma unroll 4
            for (int ks = 0; ks < 32; ++ks) {
                const f32x4 x0 = *(const f32x4*)(xr + ks * 32), x1 = *(const f32x4*)(xr + ks * 32 + 4);
                ss += ((x0[0] * x0[0] + x0[1] * x0[1]) + (x0[2] * x0[2] + x0[3] * x0[3])) + ((x1[0] * x1[0] + x1[1] * x1[1]) + (x1[2] * x1[2] + x1[3] * x1[3]));
                u32x4 hw; hw.x = pk2(x0[0], x0[1]); hw.y = pk2(x0[2], x0[3]); hw.z = pk2(x1[0], x1[1]); hw.w = pk2(x1[2], x1[3]);
                u32x4 lw; lw.x = pk2(x0[0] - bflo(hw.x), x0[1] - bfhi(hw.x)); lw.y = pk2(x0[2] - bflo(hw.y), x0[3] - bfhi(hw.y)); lw.z = pk2(x1[0] - bflo(hw.z), x1[1] - bfhi(hw.z)); lw.w = pk2(x1[2] - bflo(hw.w), x1[3] - bfhi(hw.w));
                const bf16x8 xh = __builtin_bit_cast(bf16x8, hw), xl = __builtin_bit_cast(bf16x8, lw);
#pragma unroll
                for (int nt = 0; nt < 2; ++nt) {
                    const bf16x8 wh = *(const bf16x8*)(WRH + (size_t)(nt * 16 + fr) * 1024 + ks * 32 + 8 * fq), wl = *(const bf16x8*)(WRL + (size_t)(nt * 16 + fr) * 1024 + ks * 32 + 8 * fq);
                    acc[nt] = __builtin_amdgcn_mfma_f32_16x16x32_bf16(xh, wh, acc[nt], 0, 0, 0);
                    acc[nt] = __builtin_amdgcn_mfma_f32_16x16x32_bf16(xl, wh, acc[nt], 0, 0, 0);
                    acc[nt] = __builtin_amdgcn_mfma_f32_16x16x32_bf16(xh, wl, acc[nt], 0, 0, 0);
                }
            }
            ss += __shfl_xor(ss, 16); ss += __shfl_xor(ss, 32);
            const float rsrow = __builtin_amdgcn_rsqf(ss * (1.0f / 1024.0f) + EPS);
            if (fq == 0) rsb[wid * 16 + fr] = rsrow;
            {
                unsigned char* xn = ws + WS_XN2 + (size_t)row * 1024 + 8 * fq;
#pragma unroll 4
                for (int ks = 0; ks < 32; ++ks) {
                    const f32x4 x0 = *(const f32x4*)(xr + ks * 32), x1 = *(const f32x4*)(xr + ks * 32 + 4);
                    u32x2 w; w.x = pk4_fp8(x0[0] * rsrow, x0[1] * rsrow, x0[2] * rsrow, x0[3] * rsrow); w.y = pk4_fp8(x1[0] * rsrow, x1[1] * rsrow, x1[2] * rsrow, x1[3] * rsrow);
                    *(u32x2*)(xn + ks * 32) = w;
                }
            }
            wave_lds_sync();
            const float b0 = a.in[I_BR][fr], b1 = a.in[I_BR][16 + fr];
#pragma unroll
            for (int r = 0; r < 4; ++r) {
                const float rs = rsb[wid * 16 + 4 * fq + r];
                unsigned k0 = (f2key(acc[0][r] * rs + b0) & ~31u) | (unsigned)(31 - fr), k1 = (f2key(acc[1][r] * rs + b1) & ~31u) | (unsigned)(15 - fr);
                unsigned sel[4];
#pragma unroll
                for (int k = 0; k < 4; ++k) {
                    const unsigned best = dpp_max_u32(k0 > k1 ? k0 : k1);
                    sel[k] = best;
                    if (k0 == best) k0 = 0u;
                    if (k1 == best) k1 = 0u;
                }
                const float v0 = key2f(sel[0] & ~31u), e1 = __expf(key2f(sel[1] & ~31u) - v0), e2 = __expf(key2f(sel[2] & ~31u) - v0), e3 = __expf(key2f(sel[3] & ~31u) - v0);
                const float inv = 1.0f / (1.0f + e1 + e2 + e3);
                if (fr < 4) {
                    const unsigned sk = fr == 0 ? sel[0] : (fr == 1 ? sel[1] : (fr == 2 ? sel[2] : sel[3]));
                    const int e = 31 - (int)(sk & 31u);
                    const float gt = (fr == 0 ? 1.0f : (fr == 1 ? e1 : (fr == 2 ? e2 : e3))) * inv;
                    const int ls = __hip_atomic_fetch_add(lcnt + e, 1, __ATOMIC_RELAXED, __HIP_MEMORY_SCOPE_WORKGROUP);
                    const int ri = ((wid * 16 + 4 * fq + r) * 4 + fr) * 4;
                    RI[ri + 0] = e; RI[ri + 1] = ls; RI[ri + 2] = __float_as_int(gt);
                }
            }
        }
        __syncthreads();
        if (tid < 32) lbase[tid] = (int)__hip_atomic_fetch_add(CNT + tid, (unsigned)lcnt[tid], __ATOMIC_RELAXED, __HIP_MEMORY_SCOPE_AGENT);
        __syncthreads();
        {
            const int rl = tid >> 2, k = tid & 3, row = rg * 128 + rl;
            const int e = RI[tid * 4 + 0], slot = lbase[e] + RI[tid * 4 + 1];
            ((int*)(ws + WS_LTOK))[(size_t)e * ECAP + slot] = row;
            ((float*)(ws + WS_LGATE))[(size_t)e * ECAP + slot] = __int_as_float(RI[tid * 4 + 2]);
            ((unsigned*)(ws + WS_ROUTE))[(size_t)row * 4 + k] = ((unsigned)e << 16) | (unsigned)slot;
        }
    }
}

DI void combine_phase(const Args& a, LAS unsigned char* lds) {
    unsigned char* ws = a.ws;
    LAS const int* tab = (LAS const int*)(lds + MOE_TAB);
    const int tid = otid(), wid = tid >> 6, lane = tid & 63;
    const u16* YB = (const u16*)(ws + WS_YB); const unsigned* ROUTE = (const unsigned*)(ws + WS_ROUTE);
    for (int row = blockIdx.x * 8 + wid; row < T; row += gridDim.x * 8) {
        size_t pos[4];
#pragma unroll
        for (int k = 0; k < 4; ++k) { const unsigned r = ROUTE[(size_t)row * 4 + k]; const int e = (int)(r >> 16), slot = (int)(r & 0xffffu); pos[k] = (size_t)tab[e] * 256 + slot; }
        float* orow = a.out + (size_t)row * 1024;
#pragma unroll
        for (int i = 0; i < 4; ++i) {
            f32x4 v = *(const f32x4*)(orow + i * 256 + lane * 4);
#pragma unroll
            for (int k = 0; k < 4; ++k) { const u32x2 y = *(const u32x2*)(YB + pos[k] * 1024 + i * 256 + lane * 4); v[0] += bflo(y.x); v[1] += bfhi(y.x); v[2] += bflo(y.y); v[3] += bfhi(y.y); }
            *(f32x4*)(orow + i * 256 + lane * 4) = v;
        }
    }
}

#define XB_TMO      128
#define XB_XCNT(j)  (256  + 64 * (j))
#define XB_XSUB(j)  (1280 + 64 * (j))
#define XB_XGEN(j)  (2304 + 64 * (j))
#define XB_TOP      3328
#define XB_TOPGEN   3392
#define XCD_BAR_WORDS 3456
#define XB_SPIN_CAP (1u << 18)

__device__ __forceinline__ unsigned xb_ld(unsigned* p)              { return __hip_atomic_load(p, __ATOMIC_RELAXED, __HIP_MEMORY_SCOPE_AGENT); }
__device__ __forceinline__ unsigned xb_add(unsigned* p, unsigned v) { return __hip_atomic_fetch_add(p, v, __ATOMIC_RELAXED, __HIP_MEMORY_SCOPE_AGENT); }
__device__ __forceinline__ unsigned xb_xcc_id() { return (unsigned)__builtin_amdgcn_s_getreg((3 << 11) | 20) & 0xFu; }
#define XB_SPIN(cond, bar) do { unsigned _sp = 0; while (cond) { __builtin_amdgcn_s_sleep(1); \
    if ((++_sp & 255u) == 0u) { if (xb_ld(&(bar)[XB_TMO])) break; if (_sp > XB_SPIN_CAP) { atomicAdd(&(bar)[XB_TMO], 1u); break; } } } } while (0)

struct XcdBarrier {
    unsigned* bar; unsigned x;
    volatile LAS unsigned* st;
};

__device__ __forceinline__ XcdBarrier xcd_barrier_post(unsigned* bar, volatile LAS unsigned* st) {
    XcdBarrier b; b.bar = bar; b.x = xb_xcc_id(); b.st = st;
    if (threadIdx.x == 0) (void)xb_add(&bar[XB_XCNT(b.x)], 1u);
    return b;
}
__device__ __forceinline__ void xcd_barrier_complete(unsigned* bar, unsigned x, unsigned& nloc, unsigned& nx) {
    const unsigned G = gridDim.x * gridDim.y * gridDim.z;
    unsigned sum, cnt, mine, sp = 0u;
    for (;;) {
        sum = 0u; cnt = 0u; mine = 0u;
#pragma unroll
        for (unsigned j = 0; j < 16; ++j) { const unsigned c = xb_ld(&bar[XB_XCNT(j)]); sum += c; cnt += (c > 0u) ? 1u : 0u; mine = (j == x) ? c : mine; }
        if (sum == G) break;
        __builtin_amdgcn_s_sleep(1);
        if ((++sp & 255u) == 0u) { if (xb_ld(&bar[XB_TMO])) break; if (sp > XB_SPIN_CAP) { atomicAdd(&bar[XB_TMO], 1u); break; } }
    }
    nloc = mine > 0u ? mine : 1u; nx = cnt > 0u ? cnt : 1u;
}

__device__ __forceinline__ void xcd_barrier(const XcdBarrier& b) {
    asm volatile("s_waitcnt vmcnt(0)" ::: "memory");
    __syncthreads();
    if (threadIdx.x == 0) {
        unsigned* bar = b.bar;
        __builtin_amdgcn_s_waitcnt(0);
        unsigned nloc = b.st[0], nx = b.st[1];
        if (nloc == 0u) { xcd_barrier_complete(bar, b.x, nloc, nx); b.st[0] = nloc; b.st[1] = nx; }
        const unsigned old = xb_add(&bar[XB_XSUB(b.x)], 1u);
        const unsigned gen = old / nloc;
        if (old + 1u == (gen + 1u) * nloc) {
            __builtin_amdgcn_fence(__ATOMIC_RELEASE, "agent");
            asm volatile("s_waitcnt vmcnt(0)" ::: "memory");
            const unsigned og = xb_add(&bar[XB_TOP], 1u);
            const unsigned tg = og / nx;
            if (og + 1u == (tg + 1u) * nx) xb_add(&bar[XB_TOPGEN], 1u);
            else XB_SPIN(xb_ld(&bar[XB_TOPGEN]) == tg, bar);
            __builtin_amdgcn_fence(__ATOMIC_ACQUIRE, "agent");
            xb_add(&bar[XB_XGEN(b.x)], 1u);
            asm volatile("s_waitcnt vmcnt(0)" ::: "memory");
        } else {
            XB_SPIN(xb_ld(&bar[XB_XGEN(b.x)]) == gen, bar);
            __builtin_amdgcn_fence(__ATOMIC_ACQUIRE, "agent");
            asm volatile("s_waitcnt vmcnt(0)" ::: "memory");
        }
    }
    __syncthreads();
}

__global__ void __launch_bounds__(NT, 2) fwd(Args a) {
    extern __shared__ __attribute__((aligned(16))) unsigned char lds_raw[];
    LAS unsigned char* lds = (LAS unsigned char*)lds_raw;
    cg::grid_group grid = cg::this_grid();
    unsigned char* ws = a.ws;
    const int G = gridDim.x, c = blockIdx.x;
    if (threadIdx.x < 2) ((volatile LAS unsigned*)(lds + LDS_BARST))[threadIdx.x] = 0u;
    __syncthreads();
    const XcdBarrier xbar = xcd_barrier_post((unsigned*)(ws + WS_BAR), (volatile LAS unsigned*)(lds + LDS_BARST));

    phase0(a, lds);
    xcd_barrier(xbar);
    {
        g8::PlainSched s; s.Abase = (const char*)(ws + WS_XB); s.Bbase = (const char*)(ws + WS_WIN); s.lda = 1024; s.ldb = 1024; s.K = 1024; s.nM = T / 256; s.nN = NIN / 256; s.G = G; s.c = c;
        EpiIn e; e.H = (u16*)(ws + WS_H); e.rs1 = (const float*)(ws + WS_RS1); e.SSQ = (float*)(ws + WS_SSQ); e.WI = (float*)(ws + WS_WI);
        g8::gemm_phase(lds, s, e);
    }
    xcd_barrier(xbar);
    {
        g8::PlainSched s; s.Abase = (const char*)(ws + WS_H) + 1024 * 2; s.Bbase = (const char*)(ws + WS_WQ); s.lda = NIN; s.ldb = 256; s.K = 256; s.nM = T / 256; s.nN = 5; s.G = G; s.c = c;
        EpiQ e; e.Q = (u16*)(ws + WS_Q); e.QI = (u16*)(ws + WS_QI); e.SSQ = (const float*)(ws + WS_SSQ);
        g8::gemm_phase(lds, s, e);
        for (int u = c; u < 1024; u += G) gmlp_unit(a, lds, u);
        kvnorm(a);
    }
    xcd_barrier(xbar);
    dsa_phase(a, lds);
    xcd_barrier(xbar);
    {
        g8::PlainSched s; s.Abase = (const char*)(ws + WS_YO); s.Bbase = (const char*)(ws + WS_WCAT); s.lda = 1536; s.ldb = 1536; s.K = 512; s.nM = T / 256; s.nN = 4; s.G = G; s.c = c;
        EpiMrg<0> e0; e0.OUT = (u16*)(ws + WS_TMP); e0.TMP = nullptr; e0.H = (const u16*)(ws + WS_H);
        g8::gemm_phase(lds, s, e0);
        s.Abase = (const char*)(ws + WS_YO) + 512 * 2; s.Bbase = (const char*)(ws + WS_WCAT) + 512 * 2; s.K = 1024;
        EpiMrg<1> e1; e1.OUT = (u16*)(ws + WS_MRG); e1.TMP = (const u16*)(ws + WS_TMP); e1.H = (const u16*)(ws + WS_H);
        g8::gemm_phase(lds, s, e1);
    }
    xcd_barrier(xbar);
    {
        g8::PlainSched s; s.Abase = (const char*)(ws + WS_MRG); s.Bbase = (const char*)(ws + WS_WOUT); s.lda = 1024; s.ldb = 1024; s.K = 1024; s.nM = T / 256; s.nN = 4; s.G = G; s.c = c;
        EpiOut e; e.out = a.out; e.x = a.in[I_X];
        g8::gemm_phase(lds, s, e);
    }
    xcd_barrier(xbar);
    router_phase(a, lds);
    xcd_barrier(xbar);
    moe_table(lds, (const unsigned*)(ws + WS_CTL));
    {
        MoeSched<8, true> s; s.Abase = (const char*)(ws + WS_XN2); s.Wbase = (const char*)(ws + WS_WE1); s.LTOK = (const int*)(ws + WS_LTOK); s.tab = (LAS const int*)(lds + MOE_TAB);
        s.lda = 1024; s.ldb = 1024; s.K = 1024; s.G = G; s.c = c; s.wstride = (size_t)2048 * 1024;
        EpiMoe1 e; e.ACT = (unsigned char*)(ws + WS_ACT); e.b1 = a.in[I_BE1];
        g8::gemm_phase<true>(lds, s, e);
    }
    xcd_barrier(xbar);
    {
        MoeSched<4, false> s; s.Abase = (const char*)(ws + WS_ACT); s.Wbase = (const char*)(ws + WS_WE2); s.LTOK = nullptr; s.tab = (LAS const int*)(lds + MOE_TAB);
        s.lda = 1024; s.ldb = 1024; s.K = 1024; s.G = G; s.c = c; s.wstride = (size_t)1024 * 1024;
        EpiMoe2 e; e.YB = (u16*)(ws + WS_YB); e.b2 = a.in[I_BE2]; e.LGATE = (const float*)(ws + WS_LGATE); e.tab = (LAS const int*)(lds + MOE_TAB);
        g8::gemm_phase<true>(lds, s, e);
    }
    xcd_barrier(xbar);
    combine_phase(a, lds);
    if (a.mask == 0u) grid.sync();
}

extern "C" void kernel_launch(void* const* d_in, const int* in_sizes, int n_in, void* d_out, int out_size, void* d_ws, size_t ws_size, hipStream_t stream) {
    static int grid = 0;
    if (grid == 0) {
        int dev = 0, cus = 0, per_cu = 0;
        if (n_in != 23 || out_size != T * Dm || ws_size < WS_END) { fprintf(stderr, "kernel_launch: unexpected problem (n_in %d, out %d, ws %zu < %zu)\n", n_in, out_size, ws_size, (size_t)WS_END); grid = -1; return; }
        if (hipGetDevice(&dev) != hipSuccess || hipDeviceGetAttribute(&cus, hipDeviceAttributeMultiprocessorCount, dev) != hipSuccess) { grid = -1; return; }
        if (hipFuncSetAttribute((const void*)fwd, hipFuncAttributeMaxDynamicSharedMemorySize, LDS_BYTES) != hipSuccess) { fprintf(stderr, "hipFuncSetAttribute failed\n"); grid = -1; return; }
        if (hipOccupancyMaxActiveBlocksPerMultiprocessor(&per_cu, (const void*)fwd, NT, LDS_BYTES) != hipSuccess || per_cu < 1) { fprintf(stderr, "occupancy query failed (%d)\n", per_cu); grid = -1; return; }
        grid = cus;
        fprintf(stderr, "kernel_launch: cus %d per_cu %d grid %d ws %zu need %zu\n", cus, per_cu, grid, ws_size, (size_t)WS_END);
    }
    if (grid < 0) return;
    Args a{};
    for (int i = 0; i < 23; ++i) a.in[i] = (const float*)d_in[i];
    a.out = (float*)d_out; a.ws = (unsigned char*)d_ws; a.mask = 0xffffffffu; a.pad = 0u;
    if (hipMemsetAsync((char*)d_ws + WS_CTL, 0, 65536, stream) != hipSuccess) { fprintf(stderr, "memset failed\n"); return; }
    void* args[] = {&a};
    hipError_t e = hipLaunchCooperativeKernel((const void*)fwd, dim3(grid), dim3(NT), args, LDS_BYTES, stream);
    if (e != hipSuccess) fprintf(stderr, "cooperative launch failed: %s (grid %d)\n", hipGetErrorString(e), grid);
}
```

```cpp
#include <hip/hip_runtime.h>
#include <hip/hip_cooperative_groups.h>
#include <cstdio>
#include <cstdint>
namespace cg = cooperative_groups;

#define LAS __attribute__((address_space(3)))
#define DI __device__ __forceinline__
typedef unsigned short u16;
typedef short bf16x8 __attribute__((ext_vector_type(8)));
typedef short s16x4 __attribute__((ext_vector_type(4)));
typedef float f32x4 __attribute__((ext_vector_type(4)));
typedef float f32x2 __attribute__((ext_vector_type(2)));
typedef unsigned u32x4 __attribute__((ext_vector_type(4)));
typedef unsigned u32x2 __attribute__((ext_vector_type(2)));
typedef __bf16 bf2_t __attribute__((ext_vector_type(2)));
typedef int v8i_t __attribute__((ext_vector_type(8)));

constexpr int NT = 512;
constexpr int LDS_BYTES = 155648;
constexpr int Dm = 1024, Bsz = 4, S = 8192, T = Bsz * S;
constexpr int NIN = 3584;
constexpr int NE = 32, ECAP = 32768, PPAD = 131072 + NE * 256;
constexpr float EPS = 1e-6f;

constexpr size_t MiB = 1024 * 1024;
constexpr size_t WS_CTL = 0;
constexpr size_t WS_BAR = 16384;
constexpr int LDS_BARST = LDS_BYTES - 16;
constexpr size_t WS_WIN = 64 * 1024;
constexpr size_t WS_WQ = WS_WIN + (size_t)NIN * 1024 * 2;
constexpr size_t WS_WSP = WS_WQ + 1280 * 256 * 2;
constexpr size_t WS_WCAT = WS_WSP + 4 * 128 * 128 * 2;
constexpr size_t WS_WOUT = WS_WCAT + 1024 * 1536 * 2;
constexpr size_t WS_WR = WS_WOUT + 1024 * 1024 * 2;
constexpr size_t WS_WE1 = WS_WR + 32 * 1024 * 4;
constexpr size_t WS_WE2 = WS_WE1 + (size_t)32 * 2048 * 1024 * 2;
constexpr size_t WS_RS1 = WS_WE2 + (size_t)32 * 1024 * 1024 * 2;
constexpr size_t WS_SSQ = WS_RS1 + (size_t)T * 4;
constexpr size_t WS_WI = WS_SSQ + (size_t)T * 32 * 4;
constexpr size_t WS_ROUTE = WS_WI + (size_t)T * 4 * 4;
constexpr size_t WS_LTOK = WS_ROUTE + (size_t)T * 4 * 4;
constexpr size_t WS_LGATE = WS_LTOK + (size_t)NE * ECAP * 4;
constexpr size_t WS_LRS = WS_LGATE + (size_t)NE * ECAP * 4;
constexpr size_t WS_XN2 = WS_LRS + (size_t)NE * ECAP * 4;
constexpr size_t WS_R0 = WS_XN2 + (size_t)T * 1024 * 2;
constexpr size_t WS_XB = WS_R0;
constexpr size_t WS_H = WS_XB + (size_t)T * 1024 * 2;
constexpr size_t WS_Q = WS_H + (size_t)T * NIN * 2;
constexpr size_t WS_QI = WS_Q + (size_t)T * 1024 * 2;
constexpr size_t WS_KVN = WS_QI + (size_t)T * 256 * 2;
constexpr size_t WS_KIN = WS_KVN + (size_t)T * 128 * 2;
constexpr size_t WS_YO = WS_KIN + (size_t)T * 64 * 2;
constexpr size_t WS_TMP = WS_YO + (size_t)T * 1536 * 2;
constexpr size_t WS_MRG = WS_TMP + (size_t)T * 1024 * 2;
constexpr size_t WS_R0END = WS_MRG + (size_t)T * 1024 * 2;
constexpr size_t WS_ACT = WS_XB;
constexpr size_t WS_YB = WS_Q;
static_assert(WS_ACT + (size_t)PPAD * 1024 * 2 <= WS_Q, "ACT overlaps YB");
static_assert(WS_YB + (size_t)PPAD * 1024 * 2 <= WS_R0END, "YB too large");
constexpr size_t WS_END = WS_R0END;

struct Args { const float* in[23]; float* out; unsigned char* ws; unsigned mask; unsigned pad; };
enum { I_X = 0, I_N1G, I_WIN, I_QLG, I_WUQ, I_QNG, I_KVG, I_WUV, I_WQI, I_KIG, I_VG, I_WSP, I_BSP, I_WPA, I_WPB, I_WOUT, I_N2G, I_WR, I_BR, I_WE1, I_BE1, I_WE2, I_BE2 };

DI unsigned pk2(float a, float b) { f32x2 v = {a, b}; bf2_t r = __builtin_convertvector(v, bf2_t); return __builtin_bit_cast(unsigned, r); }
DI unsigned pk4_fp8(float a, float b, float c, float d) { unsigned w = 0u; w = (unsigned)__builtin_amdgcn_cvt_pk_fp8_f32(a, b, (int)w, false); w = (unsigned)__builtin_amdgcn_cvt_pk_fp8_f32(c, d, (int)w, true); return w; }
DI unsigned pk4_i8(float a, float b, float c, float d) {
    const int ia = (int)__builtin_rintf(fminf(fmaxf(a * 32.0f, -127.0f), 127.0f)), ib = (int)__builtin_rintf(fminf(fmaxf(b * 32.0f, -127.0f), 127.0f));
    const int ic = (int)__builtin_rintf(fminf(fmaxf(c * 32.0f, -127.0f), 127.0f)), id = (int)__builtin_rintf(fminf(fmaxf(d * 32.0f, -127.0f), 127.0f));
    return (unsigned)(ia & 0xff) | ((unsigned)(ib & 0xff) << 8) | ((unsigned)(ic & 0xff) << 16) | ((unsigned)(id & 0xff) << 24);
}
DI float bflo(unsigned u) { return __uint_as_float(u << 16); }
DI float bfhi(unsigned u) { return __uint_as_float(u & 0xffff0000u); }
DI u16 f2bf(float f) { return (u16)(pk2(f, 0.f) & 0xffffu); }
DI float bf2f(u16 h) { return __uint_as_float(((unsigned)h) << 16); }
DI float sigmoidf_(float x) { return __builtin_amdgcn_rcpf(1.0f + __expf(-x)); }
DI float gelu_tanh(float x) { const float u = 1.5957691216057308f * (x + 0.044715f * x * x * x); return x * sigmoidf_(u); }
DI float fast_sigmoid(float x) { return __builtin_amdgcn_rcpf(1.0f + __builtin_amdgcn_exp2f(x * -1.4426950408889634f)); }
DI float fast_gelu(float x) { const float p = __builtin_fmaf(x * x, -0.10294324f, -2.3022082f); return x * __builtin_amdgcn_rcpf(1.0f + __builtin_amdgcn_exp2f(x * p)); }
DI int otid() { int t = threadIdx.x; asm volatile("" : "+v"(t)); return t; }
DI void wave_lds_sync() { asm volatile("s_waitcnt lgkmcnt(0)" ::: "memory"); }

namespace g8 {
constexpr int BM = 256, BK = 64, HALF = 128, HTB = HALF * BK * 2, STAGE_BYTES = 8 * HTB, NXCD = 8, WGM = 8;
DI int lds_byte(int r, int c) { const int st = (r >> 4) * 2 + (c >> 5), rr = r & 15, cc = c & 31, ob = rr * 64 + cc * 2; return st * 1024 + (ob ^ (((ob >> 9) & 1) << 5)); }
DI int perm32(int rho) { const int n = rho >> 4, i = rho & 15; return 8 * (i >> 2) + 4 * n + (i & 3); }
DI void stage_rc(int b, int& R, int& C) { const int st = b / 1024, sb = b % 1024, swz = sb ^ (((sb >> 9) & 1) << 5); R = (st >> 1) * 16 + swz / 64; C = (st & 1) * 32 + (swz % 64) / 2; }

struct UnitD { const char* Bp; int pm, pn, e, rb; };

DI bool static_tile(int i, int G, int c, int nM, int nN, int& pm, int& pn) {
    const int nwg = nM * nN; const long L = (long)i * G + c; if (L >= nwg) return false;
    int wgid = (int)L; { const int q = nwg / NXCD, r = nwg % NXCD, xcd = wgid % NXCD, off = wgid / NXCD; wgid = (xcd < r ? xcd * (q + 1) : r * (q + 1) + (xcd - r) * q) + off; }
    const int nig = WGM * nN, gid = wgid / nig, fm = gid * WGM, gsz = (nM - fm) < WGM ? (nM - fm) : WGM;
    pm = fm + ((wgid % nig) % gsz); pn = (wgid % nig) / gsz; return true;
}

struct PlainSched {
    const char* Abase; const char* Bbase; int lda, ldb, K, nM, nN, G, c; static constexpr int esz = 2;
    DI bool next(int i, UnitD& u) const { int pm, pn; if (!static_tile(i, G, c, nM, nN, pm, pn)) return false; u.pm = pm; u.pn = pn; u.e = 0; u.rb = 0; u.Bp = Bbase + (size_t)pn * BM * ldb * 2; return true; }
    DI void a_offs(const UnitD& u, int R0, int C0, unsigned (&o)[2][2]) const {
#pragma unroll
        for (int h = 0; h < 2; ++h)
#pragma unroll
            for (int i = 0; i < 2; ++i) o[h][i] = (unsigned)(((size_t)(u.pm * BM + h * HALF + R0 + 64 * i) * lda + C0) * 2);
    }
};

template <bool FP8 = false, class Epi, class Sched>
DI void gemm_phase(LAS unsigned char* lds, const Sched& S, const Epi& E) {
    const int tid = otid(), wid = __builtin_amdgcn_readfirstlane(tid >> 6), lane = tid & 63, wr = wid >> 2, wc = wid & 3, fr = lane & 15, fq = lane >> 4;
    const int nt = S.K * Sched::esz / 128;
    int R0, C0; stage_rc(tid * 16, R0, C0);
    unsigned voffB[2];
#pragma unroll
    for (int i = 0; i < 2; ++i) { const int Rr = R0 + 64 * i, Rb = Epi::PERM ? ((Rr & ~31) + perm32(Rr & 31)) : Rr; voffB[i] = (unsigned)(Rb * S.ldb * Sched::esz + C0 * 2); }
    const size_t hstepB = (size_t)HALF * S.ldb * Sched::esz;
    const unsigned ldsw = (unsigned)wid * 1024u;
    const int aoff = FP8 ? lds_byte(wr * 64 + fr, fq * 16) : lds_byte(wr * 64 + fr, fq * 8), boff = FP8 ? lds_byte(wc * 32 + fr, fq * 16) : lds_byte(wc * 32 + fr, fq * 8);
    const unsigned mxscale = 0x7f7f7f7fu;
    const int kst = FP8 ? 16 : 1024;
    const char* Ab = S.Abase;
#define G8_SA(b, h) (((b) * 2 + (h)) * HTB)
#define G8_SB(b, h) ((4 + (b) * 2 + (h)) * HTB)
#define G8_STAGE_A(bufoff, offs, kb) do { _Pragma("unroll") for (int _i = 0; _i < 2; ++_i) \
        __builtin_amdgcn_global_load_lds((const unsigned*)(Ab + (size_t)(offs)[_i] + (size_t)(kb)), (LAS unsigned*)(lds + (bufoff) + ldsw + _i * 8192), 16, 0, 0); } while (0)
#define G8_STAGE_B(bufoff, gbase, kb) do { _Pragma("unroll") for (int _i = 0; _i < 2; ++_i) \
        __builtin_amdgcn_global_load_lds((const unsigned*)((gbase) + voffB[_i] + (size_t)(kb)), (LAS unsigned*)(lds + (bufoff) + ldsw + _i * 8192), 16, 0, 0); } while (0)
#define G8_LDA(dst, b, h) do { _Pragma("unroll") for (int m = 0; m < 4; ++m) { const i32x4_t _p = *(const LAS i32x4_t*)(lds + G8_SA(b, h) + aoff + m * 2048), _q = *(const LAS i32x4_t*)(lds + G8_SA(b, h) + aoff + m * 2048 + kst); dst[m] = __builtin_shufflevector(_p, _q, 0, 1, 2, 3, 4, 5, 6, 7); } } while (0)
#define G8_LDB(dst, b, h) do { _Pragma("unroll") for (int n = 0; n < 2; ++n) { const i32x4_t _p = *(const LAS i32x4_t*)(lds + G8_SB(b, h) + boff + n * 2048), _q = *(const LAS i32x4_t*)(lds + G8_SB(b, h) + boff + n * 2048 + kst); dst[n] = __builtin_shufflevector(_p, _q, 0, 1, 2, 3, 4, 5, 6, 7); } } while (0)
#define G8_MMA(ai, bj, At, Bt) do { __builtin_amdgcn_s_setprio(1); _Pragma("unroll") for (int m = 0; m < 4; ++m) _Pragma("unroll") for (int n = 0; n < 2; ++n) { \
        if constexpr (FP8) asm volatile("v_mfma_scale_f32_16x16x128_f8f6f4 %0, %1, %2, %0, %3, %3 op_sel_hi:[0,0,0]" : "+v"(acc[ai][bj][m][n]) : "v"(Bt[n]), "v"(At[m]), "v"(mxscale)); \
        else { acc[ai][bj][m][n] = __builtin_amdgcn_mfma_f32_16x16x32_bf16(__builtin_bit_cast(bf16x8, __builtin_shufflevector(Bt[n], Bt[n], 0, 1, 2, 3)), __builtin_bit_cast(bf16x8, __builtin_shufflevector(At[m], At[m], 0, 1, 2, 3)), acc[ai][bj][m][n], 0, 0, 0); \
               acc[ai][bj][m][n] = __builtin_amdgcn_mfma_f32_16x16x32_bf16(__builtin_bit_cast(bf16x8, __builtin_shufflevector(Bt[n], Bt[n], 4, 5, 6, 7)), __builtin_bit_cast(bf16x8, __builtin_shufflevector(At[m], At[m], 4, 5, 6, 7)), acc[ai][bj][m][n], 0, 0, 0); } } \
        __builtin_amdgcn_s_setprio(0); } while (0)
#define G8_WAIT_V(n) asm volatile("s_waitcnt vmcnt(" #n ")" ::: "memory")
#define G8_WAIT_L(n) asm volatile("s_waitcnt lgkmcnt(" #n ")" ::: "memory")
#define G8_BAR __builtin_amdgcn_s_barrier()
#define G8_SCHED __builtin_amdgcn_sched_barrier(0)
    UnitD cur, nxt; int ui = 0;
    if (!S.next(0, cur)) return;
    f32x4 acc[2][2][4][2];
#pragma unroll
    for (int a = 0; a < 2; ++a)
#pragma unroll
        for (int b = 0; b < 2; ++b)
#pragma unroll
            for (int m = 0; m < 4; ++m)
#pragma unroll
                for (int n = 0; n < 2; ++n) acc[a][b][m][n] = (f32x4){0.f, 0.f, 0.f, 0.f};
    typedef int i32x4_t __attribute__((ext_vector_type(4)));
    v8i_t At[4], B0[2], B1[2];
    unsigned cA[2][2];
    S.a_offs(cur, R0, C0, cA);
    const char* cB = cur.Bp;
    G8_STAGE_B(G8_SB(0, 0), cB, 0); G8_STAGE_A(G8_SA(0, 0), cA[0], 0); G8_STAGE_B(G8_SB(0, 1), cB + hstepB, 0); G8_STAGE_A(G8_SA(0, 1), cA[1], 0);
    if (wr == 1) G8_BAR;
    G8_WAIT_V(4); G8_BAR;
    G8_STAGE_B(G8_SB(1, 0), cB, 128); G8_STAGE_A(G8_SA(1, 0), cA[0], 128); G8_STAGE_B(G8_SB(1, 1), cB + hstepB, 128);
    G8_WAIT_V(6); G8_BAR;
    for (;;) {
        const bool has_next = S.next(ui + 1, nxt);
        const char* nB = has_next ? nxt.Bp : cB;
        for (int t = 0; t < nt; t += 2) {
            const bool last = (t == nt - 2);
            const unsigned k1 = (unsigned)(t + 1) * 128u;
            const unsigned k2 = last ? 0u : (unsigned)(t + 2) * 128u, k3 = k2 + 128u;
            unsigned c1[2] = {cA[1][0], cA[1][1]};
            if (last && has_next) S.a_offs(nxt, R0, C0, cA);
            const char* b2 = last ? nB : cB;
            G8_LDB(B0, 0, 0); G8_SCHED; G8_LDA(At, 0, 0); G8_STAGE_A(G8_SA(1, 1), c1, k1);
            G8_WAIT_L(8); G8_BAR; G8_WAIT_L(0); G8_MMA(0, 0, At, B0); G8_BAR; G8_SCHED;
            G8_LDB(B1, 0, 1); G8_STAGE_B(G8_SB(0, 0), b2, k2);
            G8_BAR; G8_WAIT_L(0); G8_MMA(0, 1, At, B1); G8_BAR;
            G8_LDA(At, 0, 1); G8_STAGE_A(G8_SA(0, 0), cA[0], k2);
            G8_BAR; G8_WAIT_L(0); G8_MMA(1, 0, At, B0); G8_BAR; G8_SCHED;
            G8_STAGE_B(G8_SB(0, 1), b2 + hstepB, k2);
            G8_WAIT_V(6); G8_BAR; G8_MMA(1, 1, At, B1); G8_BAR;
            G8_LDB(B0, 1, 0); G8_SCHED; G8_LDA(At, 1, 0); G8_STAGE_A(G8_SA(0, 1), cA[1], k2);
            G8_WAIT_L(8); G8_BAR; G8_WAIT_L(0); G8_MMA(0, 0, At, B0); G8_BAR; G8_SCHED;
            G8_LDB(B1, 1, 1); G8_STAGE_B(G8_SB(1, 0), b2, k3);
            G8_BAR; G8_WAIT_L(0); G8_MMA(0, 1, At, B1); G8_BAR;
            G8_LDA(At, 1, 1); G8_STAGE_A(G8_SA(1, 0), cA[0], k3);
            G8_BAR; G8_WAIT_L(0); G8_MMA(1, 0, At, B0); G8_BAR; G8_SCHED;
            G8_STAGE_B(G8_SB(1, 1), b2 + hstepB, k3);
            G8_WAIT_V(6); G8_BAR; G8_MMA(1, 1, At, B1); G8_BAR;
        }
        if constexpr (FP8) asm volatile("s_nop 15\n\ts_nop 15" ::: "memory");
        E(acc, cur, wr, wc, fr, fq);
        if (!has_next) break;
#pragma unroll
        for (int a = 0; a < 2; ++a)
#pragma unroll
            for (int b = 0; b < 2; ++b)
#pragma unroll
                for (int m = 0; m < 4; ++m)
#pragma unroll
                    for (int n = 0; n < 2; ++n) acc[a][b][m][n] = (f32x4){0.f, 0.f, 0.f, 0.f};
        cur = nxt; cB = nB; ++ui;
    }
    G8_WAIT_V(0);
    if (wr == 0) G8_BAR;
    G8_BAR;
#undef G8_SA
#undef G8_SB
#undef G8_STAGE_A
#undef G8_STAGE_B
#undef G8_LDA
#undef G8_LDB
#undef G8_MMA
#undef G8_WAIT_V
#undef G8_WAIT_L
#undef G8_BAR
#undef G8_SCHED
}
}
using g8::UnitD;
typedef f32x4 Acc[2][2][4][2];

struct EpiIn {
    static constexpr bool PERM = true;
    u16* H; const float* rs1; float* SSQ; float* WI;
    template <int ACT, bool DOSSQ> DI void run(const Acc& acc, const UnitD& u, int wr, int wc, int fr, int fq) const {
        const int pn = u.pn;
        float rsv[2][4];
#pragma unroll
        for (int ai = 0; ai < 2; ++ai)
#pragma unroll
            for (int m = 0; m < 4; ++m) rsv[ai][m] = rs1[u.pm * 256 + ai * 128 + wr * 64 + m * 16 + fr];
        __builtin_amdgcn_sched_barrier(0);
#pragma unroll
        for (int ai = 0; ai < 2; ++ai)
#pragma unroll
            for (int m = 0; m < 4; ++m) {
                const int row = u.pm * 256 + ai * 128 + wr * 64 + m * 16 + fr;
                const float rs = rsv[ai][m];
#pragma unroll
                for (int bj = 0; bj < 2; ++bj) {
                    f32x4 v0 = acc[ai][bj][m][0] * rs, v1 = acc[ai][bj][m][1] * rs;
                    if (ACT == 1) {
#pragma unroll
                        for (int j = 0; j < 4; ++j) { v0[j] = fast_gelu(v0[j]); v1[j] = fast_gelu(v1[j]); }
                    } else if (ACT == 2) {
#pragma unroll
                        for (int j = 0; j < 4; ++j) { v0[j] = fast_sigmoid(v0[j]); v1[j] = fast_sigmoid(v1[j]); }
                    }
                    u32x4 w; w.x = pk2(v0[0], v0[1]); w.y = pk2(v0[2], v0[3]); w.z = pk2(v1[0], v1[1]); w.w = pk2(v1[2], v1[3]);
                    *(u32x4*)(H + (size_t)row * NIN + pn * 256 + bj * 128 + wc * 32 + 8 * fq) = w;
                    if (DOSSQ) {
                        float ssq = ((v0[0] * v0[0] + v0[1] * v0[1]) + (v0[2] * v0[2] + v0[3] * v0[3])) + ((v1[0] * v1[0] + v1[1] * v1[1]) + (v1[2] * v1[2] + v1[3] * v1[3]));
                        ssq += __shfl_xor(ssq, 16); ssq += __shfl_xor(ssq, 32);
                        if (fq == 0) SSQ[(size_t)row * 32 + (pn - 2) * 8 + bj * 4 + wc] = ssq;
                        if (pn == 5 && bj == 1 && wc == 2 && fq == 0) *(f32x4*)(WI + (size_t)row * 4) = v0 * 0.5f;
                    }
                }
            }
    }
    DI void operator()(const Acc& acc, const UnitD& u, int wr, int wc, int fr, int fq) const {
        const int pn = u.pn;
        if (pn < 2) run<1, false>(acc, u, wr, wc, fr, fq);
        else if (pn < 4) run<1, true>(acc, u, wr, wc, fr, fq);
        else if (pn < 6) run<0, true>(acc, u, wr, wc, fr, fq);
        else run<2, false>(acc, u, wr, wc, fr, fq);
    }
};
struct EpiQ {
    static constexpr bool PERM = true;
    u16* Q; u16* QI; const float* SSQ;
    DI void operator()(const Acc& acc, const UnitD& u, int wr, int wc, int fr, int fq) const {
        f32x4 sq[2][4][2];
#pragma unroll
        for (int ai = 0; ai < 2; ++ai)
#pragma unroll
            for (int m = 0; m < 4; ++m) { const int row = u.pm * 256 + ai * 128 + wr * 64 + m * 16 + fr; sq[ai][m][0] = *(const f32x4*)(SSQ + (size_t)row * 32 + 16); sq[ai][m][1] = *(const f32x4*)(SSQ + (size_t)row * 32 + 20); }
        __builtin_amdgcn_sched_barrier(0);
#pragma unroll
        for (int ai = 0; ai < 2; ++ai)
#pragma unroll
            for (int m = 0; m < 4; ++m) {
                const int row = u.pm * 256 + ai * 128 + wr * 64 + m * 16 + fr;
                const f32x4 s0 = sq[ai][m][0], s1 = sq[ai][m][1];
                const float ss = ((s0[0] + s0[1]) + (s0[2] + s0[3])) + ((s1[0] + s1[1]) + (s1[2] + s1[3]));
                const float rs = __builtin_amdgcn_rsqf(ss * (1.0f / 256.0f) + EPS);
#pragma unroll
                for (int bj = 0; bj < 2; ++bj) {
                    const int col = u.pn * 256 + bj * 128 + wc * 32 + 8 * fq;
                    const f32x4 v0 = acc[ai][bj][m][0] * rs, v1 = acc[ai][bj][m][1] * rs;
                    if (col < 1024) { u32x4 w; w.x = pk2(v0[0], v0[1]); w.y = pk2(v0[2], v0[3]); w.z = pk2(v1[0], v1[1]); w.w = pk2(v1[2], v1[3]); *(u32x4*)(Q + (size_t)row * 1024 + col) = w; }
                    else { u32x2 w; w.x = pk4_i8(v0[0], v0[1], v0[2], v0[3]); w.y = pk4_i8(v1[0], v1[1], v1[2], v1[3]); *(u32x2*)((unsigned char*)QI + (size_t)row * 256 + (col - 1024)) = w; }
                }
            }
    }
};
template <int SECOND> struct EpiMrg {
    static constexpr bool PERM = true;
    u16* OUT; const u16* TMP; const u16* H;
    DI void operator()(const Acc& acc, const UnitD& u, int wr, int wc, int fr, int fq) const {
#pragma unroll
        for (int ai = 0; ai < 2; ++ai) {
            u32x4 g[4][2], tp[4][2];
#pragma unroll
            for (int m = 0; m < 4; ++m)
#pragma unroll
                for (int bj = 0; bj < 2; ++bj) {
                    const int row = u.pm * 256 + ai * 128 + wr * 64 + m * 16 + fr, col = u.pn * 256 + bj * 128 + wc * 32 + 8 * fq;
                    g[m][bj] = *(const u32x4*)(H + (size_t)row * NIN + 1536 + SECOND * 1024 + col);
                    if (SECOND) tp[m][bj] = *(const u32x4*)(TMP + (size_t)row * 1024 + col);
                }
            __builtin_amdgcn_sched_barrier(0);
#pragma unroll
            for (int m = 0; m < 4; ++m)
#pragma unroll
                for (int bj = 0; bj < 2; ++bj) {
                    const int row = u.pm * 256 + ai * 128 + wr * 64 + m * 16 + fr, col = u.pn * 256 + bj * 128 + wc * 32 + 8 * fq;
                    const u32x4 gg = g[m][bj];
                    f32x4 v0 = acc[ai][bj][m][0], v1 = acc[ai][bj][m][1];
                    v0[0] *= bflo(gg.x); v0[1] *= bfhi(gg.x); v0[2] *= bflo(gg.y); v0[3] *= bfhi(gg.y); v1[0] *= bflo(gg.z); v1[1] *= bfhi(gg.z); v1[2] *= bflo(gg.w); v1[3] *= bfhi(gg.w);
                    if (SECOND) { const u32x4 t = tp[m][bj];
                        v0[0] += bflo(t.x); v0[1] += bfhi(t.x); v0[2] += bflo(t.y); v0[3] += bfhi(t.y); v1[0] += bflo(t.z); v1[1] += bfhi(t.z); v1[2] += bflo(t.w); v1[3] += bfhi(t.w); }
                    u32x4 w; w.x = pk2(v0[0], v0[1]); w.y = pk2(v0[2], v0[3]); w.z = pk2(v1[0], v1[1]); w.w = pk2(v1[2], v1[3]);
                    *(u32x4*)(OUT + (size_t)row * 1024 + col) = w;
                }
            __builtin_amdgcn_sched_barrier(0);
        }
    }
};
struct EpiOut {
    static constexpr bool PERM = false;
    float* out; const float* x;
    DI void operator()(const Acc& acc, const UnitD& u, int wr, int wc, int fr, int fq) const {
#pragma unroll
        for (int ai = 0; ai < 2; ++ai) {
            f32x4 xv[4][2][2];
#pragma unroll
            for (int m = 0; m < 4; ++m)
#pragma unroll
                for (int bj = 0; bj < 2; ++bj)
#pragma unroll
                    for (int n = 0; n < 2; ++n)
                        xv[m][bj][n] = *(const f32x4*)(x + (size_t)(u.pm * 256 + ai * 128 + wr * 64 + m * 16 + fr) * 1024 + u.pn * 256 + bj * 128 + wc * 32 + n * 16 + 4 * fq);
            __builtin_amdgcn_sched_barrier(0);
#pragma unroll
            for (int m = 0; m < 4; ++m)
#pragma unroll
                for (int bj = 0; bj < 2; ++bj)
#pragma unroll
                    for (int n = 0; n < 2; ++n)
                        *(f32x4*)(out + (size_t)(u.pm * 256 + ai * 128 + wr * 64 + m * 16 + fr) * 1024 + u.pn * 256 + bj * 128 + wc * 32 + n * 16 + 4 * fq) = xv[m][bj][n] + acc[ai][bj][m][n];
            __builtin_amdgcn_sched_barrier(0);
        }
    }
};

constexpr int MOE_TAB = g8::STAGE_BYTES;
DI void moe_table(LAS unsigned char* lds, const unsigned* CNT) {
    LAS int* tab = (LAS int*)(lds + MOE_TAB);
    __syncthreads();
    if (threadIdx.x == 0) { int acc = 0; for (int e = 0; e < NE; ++e) { const int c = (int)__hip_atomic_load(CNT + e, __ATOMIC_RELAXED, __HIP_MEMORY_SCOPE_AGENT); tab[e] = acc; tab[33 + e] = c; acc += (c + 255) >> 8; } tab[32] = acc; }
    __syncthreads();
}
template <int NPN, bool GATHER> struct MoeSched {
    const char* Abase; const char* Wbase; const int* LTOK; LAS const int* tab; int lda, ldb, K, G, c; size_t wstride; static constexpr int esz = 1;
    DI bool next(int i, UnitD& u) const {
        const long L = (long)i * G + c; const int R = tab[32];
        if (L >= (long)R * NPN) return false;
        const int rbg = (int)(L / NPN), pn = (int)(L % NPN);
        int e = 0;
        for (int j = 1; j < NE; ++j) e += (tab[j] <= rbg) ? 1 : 0;
        e = __builtin_amdgcn_readfirstlane(e);
        u.pm = rbg; u.pn = pn; u.e = e; u.rb = rbg - tab[e];
        u.Bp = Wbase + (size_t)e * wstride + (size_t)pn * 256 * ldb * esz;
        return true;
    }
    DI void a_offs(const UnitD& u, int R0, int C0, unsigned (&o)[2][2]) const {
        const int cnt = tab[33 + u.e];
#pragma unroll
        for (int h = 0; h < 2; ++h)
#pragma unroll
            for (int i = 0; i < 2; ++i) {
                const int r = h * 128 + R0 + 64 * i;
                if (GATHER) { const int slot = u.rb * 256 + r; const int tok = slot < cnt ? LTOK[(size_t)u.e * ECAP + slot] : 0; o[h][i] = (unsigned)((size_t)tok * lda * esz + C0 * 2); }
                else o[h][i] = (unsigned)((size_t)(u.pm * 256 + r) * lda * esz + C0 * 2);
            }
    }
};
struct EpiMoe1 {
    static constexpr bool PERM = true;
    unsigned char* ACT; const float* b1;
    DI void operator()(const Acc& acc, const UnitD& u, int wr, int wc, int fr, int fq) const {
        const float* be = b1 + (size_t)u.e * 2048;
        const int hc = u.pn * 128 + wc * 32 + 8 * fq;
        const f32x4 bg0 = *(const f32x4*)(be + hc), bg1 = *(const f32x4*)(be + hc + 4), bu0 = *(const f32x4*)(be + 1024 + hc), bu1 = *(const f32x4*)(be + 1024 + hc + 4);
        __builtin_amdgcn_sched_barrier(0);
#pragma unroll
        for (int ai = 0; ai < 2; ++ai)
#pragma unroll
            for (int m = 0; m < 4; ++m) {
                const int row = u.pm * 256 + ai * 128 + wr * 64 + m * 16 + fr;
                float av[8];
#pragma unroll
                for (int n = 0; n < 2; ++n) {
                    const f32x4 g = acc[ai][0][m][n] * 0.015625f + (n ? bg1 : bg0), up = acc[ai][1][m][n] * 0.015625f + (n ? bu1 : bu0);
#pragma unroll
                    for (int j = 0; j < 4; ++j) {
                        const float hg = fminf(g[j], 7.0f), hu = __builtin_amdgcn_fmed3f(up[j], -7.0f, 7.0f);
                        av[4 * n + j] = (hu + 1.0f) * (hg * __builtin_amdgcn_rcpf(1.0f + __builtin_amdgcn_exp2f(hg * -2.4554669595930157f)));
                    }
                }
                u32x2 w; w.x = pk4_fp8(av[0], av[1], av[2], av[3]); w.y = pk4_fp8(av[4], av[5], av[6], av[7]);
                *(u32x2*)(ACT + (size_t)row * 1024 + hc) = w;
            }
    }
};
struct EpiMoe2 {
    static constexpr bool PERM = true;
    u16* YB; const float* b2; const float* LGATE; LAS const int* tab;
    DI void operator()(const Acc& acc, const UnitD& u, int wr, int wc, int fr, int fq) const {
        const float* be = b2 + (size_t)u.e * 1024; const int cnt = tab[33 + u.e];
        float gate[2][4]; f32x4 bias[2][2];
#pragma unroll
        for (int ai = 0; ai < 2; ++ai)
#pragma unroll
            for (int m = 0; m < 4; ++m) { const int slot = u.rb * 256 + ai * 128 + wr * 64 + m * 16 + fr; gate[ai][m] = slot < cnt ? LGATE[(size_t)u.e * ECAP + slot] : 0.f; }
#pragma unroll
        for (int bj = 0; bj < 2; ++bj) { const int col = u.pn * 256 + bj * 128 + wc * 32 + 8 * fq; bias[bj][0] = *(const f32x4*)(be + col); bias[bj][1] = *(const f32x4*)(be + col + 4); }
        __builtin_amdgcn_sched_barrier(0);
#pragma unroll
        for (int ai = 0; ai < 2; ++ai)
#pragma unroll
            for (int m = 0; m < 4; ++m) {
                const int r = ai * 128 + wr * 64 + m * 16 + fr;
                const float gt = gate[ai][m];
#pragma unroll
                for (int bj = 0; bj < 2; ++bj) {
                    const int col = u.pn * 256 + bj * 128 + wc * 32 + 8 * fq;
                    const f32x4 v0 = (acc[ai][bj][m][0] * 0.015625f + bias[bj][0]) * gt, v1 = (acc[ai][bj][m][1] * 0.015625f + bias[bj][1]) * gt;
                    u32x4 w; w.x = pk2(v0[0], v0[1]); w.y = pk2(v0[2], v0[3]); w.z = pk2(v1[0], v1[1]); w.w = pk2(v1[2], v1[3]);
                    *(u32x4*)(YB + (size_t)(u.pm * 256 + r) * 1024 + col) = w;
                }
            }
    }
};

template <bool FP8 = false, class F> DI void tr_tile(LAS unsigned char* lds, const float* src, int ld_src, int Nsz, int k0, int n0, const float* sk, float mul, u16* dst, int ld_dst, F rowmap) {
    LAS float* t = (LAS float*)lds;
    const int tid = otid();
    __syncthreads();
#pragma unroll
    for (int it = 0; it < 2; ++it) {
        const int k = (tid >> 4) + 32 * it, n = 4 * (tid & 15);
        f32x4 v = {0.f, 0.f, 0.f, 0.f};
        if (n0 + n < Nsz) v = *(const f32x4*)(src + (size_t)(k0 + k) * ld_src + n0 + n);
        const float s = (sk ? sk[k0 + k] : 1.0f) * mul;
        t[k * 65 + n] = v[0] * s; t[k * 65 + n + 1] = v[1] * s; t[k * 65 + n + 2] = v[2] * s; t[k * 65 + n + 3] = v[3] * s;
    }
    __syncthreads();
    const int n = tid >> 3, kc = (tid & 7) * 8;
    if (FP8) {
        if (n0 + n < Nsz) {
            u32x2 w;
            w.x = pk4_fp8(t[(kc + 0) * 65 + n], t[(kc + 1) * 65 + n], t[(kc + 2) * 65 + n], t[(kc + 3) * 65 + n]);
            w.y = pk4_fp8(t[(kc + 4) * 65 + n], t[(kc + 5) * 65 + n], t[(kc + 6) * 65 + n], t[(kc + 7) * 65 + n]);
            *(u32x2*)((unsigned char*)dst + (size_t)rowmap(n0 + n) * ld_dst + k0 + kc) = w;
        }
    } else if (n0 + n < Nsz) {
        u32x4 w;
        w.x = pk2(t[(kc + 0) * 65 + n], t[(kc + 1) * 65 + n]); w.y = pk2(t[(kc + 2) * 65 + n], t[(kc + 3) * 65 + n]);
        w.z = pk2(t[(kc + 4) * 65 + n], t[(kc + 5) * 65 + n]); w.w = pk2(t[(kc + 6) * 65 + n], t[(kc + 7) * 65 + n]);
        *(u32x4*)(dst + (size_t)rowmap(n0 + n) * ld_dst + k0 + kc) = w;
    }
}
struct MapId { DI int operator()(int n) const { return n; } };
struct MapIn { DI int operator()(int n) const { return n < 1476 ? n : n + 60; } };
struct MapE1 { DI int operator()(int n) const { const int hi = n >= 1024 ? 1 : 0, q = n - hi * 1024; return (q >> 7) * 256 + hi * 128 + (q & 127); } };

DI void phase0(const Args& a, LAS unsigned char* lds) {
    unsigned char* ws = a.ws;
    const int tid = otid();
    const size_t gtid = (size_t)blockIdx.x * NT + tid, gstride = (size_t)gridDim.x * NT;
    for (size_t i = gtid; i < 60 * 1024 / 2; i += gstride) ((unsigned*)(ws + WS_WIN + (size_t)1476 * 1024 * 2))[i] = 0u;
    for (size_t i = gtid; i < 32 * 1024; i += gstride) { const int e = (int)(i >> 10), k = (int)(i & 1023); const float w = a.in[I_WR][k * 32 + e] * a.in[I_N2G][k]; const u16 h = f2bf(w); ((u16*)(ws + WS_WR))[i] = h; ((u16*)(ws + WS_WR))[32 * 1024 + i] = f2bf(w - bf2f(h)); }
    for (size_t i = gtid; i < 4 * 128 * 128; i += gstride) { const int tt = (int)((i >> 7) & 127), ss = (int)(i & 127); ((u16*)(ws + WS_WSP))[i] = f2bf(ss <= tt ? a.in[I_WSP][i] : 0.f); }
    {
        const int wid = tid >> 6, lane = tid & 63;
        for (int row = blockIdx.x * 8 + wid; row < T; row += gridDim.x * 8) {
            const float* xr = a.in[I_X] + (size_t)row * 1024; u16* xb = (u16*)(ws + WS_XB) + (size_t)row * 1024;
            float ss = 0.f;
#pragma unroll
            for (int i = 0; i < 4; ++i) {
                const f32x4 v = *(const f32x4*)(xr + i * 256 + lane * 4);
                ss += (v[0] * v[0] + v[1] * v[1]) + (v[2] * v[2] + v[3] * v[3]);
                u32x2 w; w.x = pk2(v[0], v[1]); w.y = pk2(v[2], v[3]);
                *(u32x2*)(xb + i * 256 + lane * 4) = w;
            }
#pragma unroll
            for (int o = 32; o >= 1; o >>= 1) ss += __shfl_xor(ss, o);
            if (lane == 0) ((float*)(ws + WS_RS1))[row] = __builtin_amdgcn_rsqf(ss * (1.0f / 1024.0f) + EPS);
        }
    }
    constexpr int U_IN = 16 * 56, U_UQ = 4 * 16, U_QI = 4 * 4, U_PA = 8 * 16, U_OUT = 16 * 16, U_E1 = 32 * 16 * 32, U_E2 = 32 * 16 * 16, U_CB = 64;
    constexpr int U_TOT = U_IN + U_UQ + U_QI + U_PA + U_OUT + U_E1 + U_E2 + U_CB;
    for (int u = blockIdx.x; u < U_TOT; u += gridDim.x) {
        int v = u;
        if (v < U_IN) { tr_tile(lds, a.in[I_WIN], 3524, 3524, (v & 15) * 64, (v >> 4) * 64, a.in[I_N1G], 1.0f, (u16*)(ws + WS_WIN), 1024, MapIn()); continue; }
        v -= U_IN;
        if (v < U_UQ) { tr_tile(lds, a.in[I_WUQ], 1024, 1024, (v & 3) * 64, (v >> 2) * 64, a.in[I_QLG], 1.0f, (u16*)(ws + WS_WQ), 256, MapId()); continue; }
        v -= U_UQ;
        if (v < U_QI) { tr_tile(lds, a.in[I_WQI], 256, 256, (v & 3) * 64, (v >> 2) * 64, a.in[I_QLG], 1.0f, (u16*)(ws + WS_WQ) + 1024 * 256, 256, MapId()); continue; }
        v -= U_QI;
        if (v < U_PA) { tr_tile(lds, a.in[I_WPA], 1024, 1024, (v & 7) * 64, (v >> 3) * 64, nullptr, 1.0f, (u16*)(ws + WS_WCAT), 1536, MapId()); continue; }
        v -= U_PA;
        if (v < U_OUT) { tr_tile(lds, a.in[I_WOUT], 1024, 1024, (v & 15) * 64, (v >> 4) * 64, nullptr, 1.0f, (u16*)(ws + WS_WOUT), 1024, MapId()); continue; }
        v -= U_OUT;
        if (v < U_E1) { const int e = v >> 9, w = v & 511; tr_tile<true>(lds, a.in[I_WE1] + (size_t)e * 1024 * 2048, 2048, 2048, (w & 15) * 64, (w >> 4) * 64, a.in[I_N2G], 64.0f, (u16*)(ws + WS_WE1 + (size_t)e * 2048 * 1024), 1024, MapE1()); continue; }
        v -= U_E1;
        if (v < U_E2) { const int e = v >> 8, w = v & 255; tr_tile<true>(lds, a.in[I_WE2] + (size_t)e * 1024 * 1024, 1024, 1024, (w & 15) * 64, (w >> 4) * 64, nullptr, 64.0f, (u16*)(ws + WS_WE2 + (size_t)e * 1024 * 1024), 1024, MapId()); continue; }
        v -= U_E2;
        {
            const int h = v >> 3, c0 = (v & 7) * 16;
            LAS float* t = (LAS float*)lds;
            __syncthreads();
            for (int i = tid; i < 1024; i += NT) t[i] = a.in[I_WUV][(size_t)h * 128 * 64 + (size_t)c0 * 64 + i];
            __syncthreads();
            for (int nn = tid; nn < 1024; nn += NT) {
                float accv[16];
#pragma unroll
                for (int i = 0; i < 16; ++i) accv[i] = 0.f;
                for (int vv = 0; vv < 64; ++vv) {
                    const float pb = a.in[I_WPB][(size_t)(h * 64 + vv) * 1024 + nn];
#pragma unroll
                    for (int i = 0; i < 16; ++i) accv[i] += t[i * 64 + vv] * pb;
                }
                u32x4 w0, w1;
                w0.x = pk2(accv[0], accv[1]); w0.y = pk2(accv[2], accv[3]); w0.z = pk2(accv[4], accv[5]); w0.w = pk2(accv[6], accv[7]);
                w1.x = pk2(accv[8], accv[9]); w1.y = pk2(accv[10], accv[11]); w1.z = pk2(accv[12], accv[13]); w1.w = pk2(accv[14], accv[15]);
                u16* d = (u16*)(ws + WS_WCAT) + (size_t)nn * 1536 + 512 + h * 128 + c0;
                *(u32x4*)d = w0; *(u32x4*)(d + 8) = w1;
            }
        }
    }
}

DI void gmlp_unit(const Args& a, LAS unsigned char* lds, int u) {
    unsigned char* ws = a.ws;
    const int tid = otid(), wid = tid >> 6, lane = tid & 63, fr = lane & 15, fq = lane >> 4;
    const int g = u & 3, row0 = (u >> 2) * 128;
    const u16* H = (const u16*)(ws + WS_H);
    LAS u16* img = (LAS u16*)lds;
    __syncthreads();
    {
        const int s = tid & 127, cset = tid >> 7;
        const f32x4 sq = *(const f32x4*)((const float*)(ws + WS_SSQ) + (size_t)(row0 + s) * 32 + g * 4);
        const float rs = __builtin_amdgcn_rsqf(((sq[0] + sq[1]) + (sq[2] + sq[3])) * (1.0f / 128.0f) + EPS);
#pragma unroll
        for (int it = 0; it < 4; ++it) {
            const int c = cset + 4 * it;
            const u32x4 raw = *(const u32x4*)(H + (size_t)(row0 + s) * NIN + 512 + g * 128 + 8 * c);
            const float* vg = a.in[I_VG] + 8 * c;
            float f[8] = {bflo(raw.x), bfhi(raw.x), bflo(raw.y), bfhi(raw.y), bflo(raw.z), bfhi(raw.z), bflo(raw.w), bfhi(raw.w)};
#pragma unroll
            for (int i = 0; i < 8; ++i) img[(8 * c + i) * 136 + s] = f2bf(f[i] * rs * vg[i]);
        }
    }
    __syncthreads();
    const u16* W = (const u16*)(ws + WS_WSP) + (size_t)g * 128 * 128 + (size_t)(16 * wid + fr) * 128;
    f32x4 acc[8];
#pragma unroll
    for (int i = 0; i < 8; ++i) acc[i] = (f32x4){0.f, 0.f, 0.f, 0.f};
    const int nks = (16 * wid + 15) / 32 + 1;
    for (int ks = 0; ks < nks; ++ks) {
        const bf16x8 bw = *(const bf16x8*)(W + ks * 32 + 8 * fq);
#pragma unroll
        for (int i = 0; i < 8; ++i) {
            const bf16x8 av = *(const LAS bf16x8*)(img + (16 * i + fr) * 136 + ks * 32 + 8 * fq);
            acc[i] = __builtin_amdgcn_mfma_f32_16x16x32_bf16(av, bw, acc[i], 0, 0, 0);
        }
    }
    const int t = 16 * wid + fr;
    const float bias = a.in[I_BSP][g * 128 + t];
    u16* YO = (u16*)(ws + WS_YO);
#pragma unroll
    for (int i = 0; i < 8; ++i) {
        const int d = 16 * i + 4 * fq;
        const u32x2 uu = *(const u32x2*)(H + (size_t)(row0 + t) * NIN + g * 128 + d);
        const float y0 = bflo(uu.x) * (acc[i][0] + bias), y1 = bfhi(uu.x) * (acc[i][1] + bias), y2 = bflo(uu.y) * (acc[i][2] + bias), y3 = bfhi(uu.y) * (acc[i][3] + bias);
        u32x2 w; w.x = pk2(y0, y1); w.y = pk2(y2, y3);
        *(u32x2*)(YO + (size_t)(row0 + t) * 1536 + g * 128 + d) = w;
    }
}

DI void kvnorm(const Args& a) {
    unsigned char* ws = a.ws;
    const u16* H = (const u16*)(ws + WS_H); const float* SSQ = (const float*)(ws + WS_SSQ);
    const size_t gtid = (size_t)blockIdx.x * NT + otid(), gstride = (size_t)gridDim.x * NT;
    for (size_t idx = gtid; idx < (size_t)T * 24; idx += gstride) {
        const int row = (int)(idx / 24), c = (int)(idx % 24);
        const u16* src; u16* dst; const float* gain; float rs;
        if (c < 16) {
            const f32x4 sq = *(const f32x4*)(SSQ + (size_t)row * 32 + 24);
            rs = __builtin_amdgcn_rsqf(((sq[0] + sq[1]) + (sq[2] + sq[3])) * (1.0f / 128.0f) + EPS);
            src = H + (size_t)row * NIN + 1280 + 8 * c; dst = (u16*)(ws + WS_KVN) + (size_t)row * 128 + 8 * c; gain = a.in[I_KVG] + 8 * c;
        } else {
            const int cc = c - 16;
            rs = __builtin_amdgcn_rsqf((SSQ[(size_t)row * 32 + 28] + SSQ[(size_t)row * 32 + 29]) * (1.0f / 64.0f) + EPS);
            src = H + (size_t)row * NIN + 1408 + 8 * cc; dst = nullptr; gain = a.in[I_KIG] + 8 * cc;
            const u32x4 raw = *(const u32x4*)src;
            u32x2 w8;
            w8.x = pk4_i8(bflo(raw.x) * rs * gain[0], bfhi(raw.x) * rs * gain[1], bflo(raw.y) * rs * gain[2], bfhi(raw.y) * rs * gain[3]);
            w8.y = pk4_i8(bflo(raw.z) * rs * gain[4], bfhi(raw.z) * rs * gain[5], bflo(raw.w) * rs * gain[6], bfhi(raw.w) * rs * gain[7]);
            *(u32x2*)(ws + WS_KIN + (size_t)row * 64 + 8 * cc) = w8;
            continue;
        }
        const u32x4 raw = *(const u32x4*)src;
        u32x4 w;
        w.x = pk2(bflo(raw.x) * rs * gain[0], bfhi(raw.x) * rs * gain[1]); w.y = pk2(bflo(raw.y) * rs * gain[2], bfhi(raw.y) * rs * gain[3]);
        w.z = pk2(bflo(raw.z) * rs * gain[4], bfhi(raw.z) * rs * gain[5]); w.w = pk2(bflo(raw.w) * rs * gain[6], bfhi(raw.w) * rs * gain[7]);
        *(u32x4*)dst = w;
    }
}

constexpr int P3_ROWS = 0, P3_HIST = 131072, P3_LIST = 147456;
DI unsigned f2key(float f) { const unsigned u = __float_as_uint(f); return (u & 0x80000000u) ? ~u : (u | 0x80000000u); }
DI int wave_incl_scan(int v, int lane) {
#pragma unroll
    for (int o = 1; o < 64; o <<= 1) { const int t = __shfl_up(v, o); if (lane >= o) v += t; }
    return v;
}
DI int wave_suffix_scan(int v, int lane) {
#pragma unroll
    for (int o = 1; o < 64; o <<= 1) { const int t = __shfl_down(v, o); if (lane + o < 64) v += t; }
    return v;
}
DI unsigned pk_gt(unsigned kw, unsigned xw, unsigned one) {
    unsigned d, m;
    asm("v_pk_sub_u16 %0, %1, %2 clamp" : "=v"(d) : "v"(kw), "v"(xw));
    asm("v_pk_min_u16 %0, %1, %2" : "=v"(m) : "v"(d), "v"(one));
    return m;
}
DI unsigned pk_subs(unsigned kw, unsigned xw) { unsigned d; asm("v_pk_sub_u16 %0, %1, %2 clamp" : "=v"(d) : "v"(kw), "v"(xw)); return d; }
DI unsigned pk_min1(unsigned d, unsigned one) { unsigned m; asm("v_pk_min_u16 %0, %1, %2" : "=v"(m) : "v"(d), "v"(one)); return m; }
DI unsigned pk_max(unsigned a, unsigned b) { unsigned r; asm("v_pk_max_u16 %0, %1, %2" : "=v"(r) : "v"(a), "v"(b)); return r; }
DI unsigned pk_add(unsigned a, unsigned b) { unsigned r; asm("v_pk_add_u16 %0, %1, %2" : "=v"(r) : "v"(a), "v"(b)); return r; }
DI int wave_sum(int v) {
    v += __builtin_amdgcn_update_dpp(0, v, 0xB1, 0xf, 0xf, false);
    v += __builtin_amdgcn_update_dpp(0, v, 0x4E, 0xf, 0xf, false);
    v += __builtin_amdgcn_update_dpp(0, v, 0x141, 0xf, 0xf, false);
    v += __builtin_amdgcn_update_dpp(0, v, 0x140, 0xf, 0xf, false);
    return __builtin_amdgcn_readlane(v, 0) + __builtin_amdgcn_readlane(v, 16) + __builtin_amdgcn_readlane(v, 32) + __builtin_amdgcn_readlane(v, 48);
}
DI int rowaddr(int p) { return (p & ~511) | ((p & 63) << 3) | ((p >> 6) & 7); }
typedef unsigned short us2_t __attribute__((ext_vector_type(2)));
DI unsigned dot2acc(unsigned flags, unsigned wts, unsigned acc) { return __builtin_amdgcn_udot2(__builtin_bit_cast(us2_t, flags), __builtin_bit_cast(us2_t, wts), acc, false); }
DI void keys_load(LAS u16* row, int N, int lane, u32x4 (&kr)[16]) {
    const int Nup = (N + 511) & ~511, niter = Nup >> 9;
    for (int p = N + lane; p < Nup; p += 64) row[rowaddr(p)] = (u16)0;
    wave_lds_sync();
#pragma unroll
    for (int i = 0; i < 16; ++i) { kr[i] = (u32x4){0u, 0u, 0u, 0u}; if (i < niter) kr[i] = *(LAS const u32x4*)(row + i * 512 + lane * 8); }
    wave_lds_sync();
}
DI void keys_select(const u32x4 (&kr)[16], LAS u16* list, int N, int lane) {
    const int Nup = (N + 511) & ~511, niter = Nup >> 9;
    const unsigned one = 0x00010001u;
    auto count_gt = [&](unsigned x) -> int {
        const unsigned xw = x | (x << 16);
        unsigned acc = 0u, acc1 = 0u, acc2 = 0u, acc3 = 0u;
#pragma unroll
        for (int c = 0; c < 4; ++c) {
            if (4 * c < niter) {
#pragma unroll
                for (int h = 0; h < 2; ++h) {
                    unsigned d[8];
#pragma unroll
                    for (int i = 0; i < 2; ++i) { const u32x4 kk = kr[4 * c + 2 * h + i]; d[4 * i] = pk_subs(kk.x, xw); d[4 * i + 1] = pk_subs(kk.y, xw); d[4 * i + 2] = pk_subs(kk.z, xw); d[4 * i + 3] = pk_subs(kk.w, xw); }
#pragma unroll
                    for (int i = 0; i < 8; ++i) d[i] = pk_min1(d[i], one);
#pragma unroll
                    for (int i = 0; i < 8; i += 4) { acc = dot2acc(d[i], one, acc); acc1 = dot2acc(d[i + 1], one, acc1); acc2 = dot2acc(d[i + 2], one, acc2); acc3 = dot2acc(d[i + 3], one, acc3); }
                }
            }
        }
        return wave_sum((int)((acc + acc1) + (acc2 + acc3)));
    };
    unsigned T = 0u; int cge = Nup, topbit = 15;
    {
        unsigned mx = 0u;
#pragma unroll
        for (int c = 0; c < 4; ++c) {
            if (4 * c < niter) {
#pragma unroll
                for (int i = 4 * c; i < 4 * c + 4; ++i) { mx = pk_max(mx, kr[i].x); mx = pk_max(mx, kr[i].y); mx = pk_max(mx, kr[i].z); mx = pk_max(mx, kr[i].w); }
            }
        }
        unsigned m1 = max(mx & 0xffffu, mx >> 16);
        m1 = max(m1, (unsigned)__builtin_amdgcn_update_dpp(0, (int)m1, 0xB1, 0xf, 0xf, false)); m1 = max(m1, (unsigned)__builtin_amdgcn_update_dpp(0, (int)m1, 0x4E, 0xf, 0xf, false));
        m1 = max(m1, (unsigned)__builtin_amdgcn_update_dpp(0, (int)m1, 0x141, 0xf, 0xf, false)); m1 = max(m1, (unsigned)__builtin_amdgcn_update_dpp(0, (int)m1, 0x140, 0xf, 0xf, false));
        const unsigned kmax = max(max((unsigned)__builtin_amdgcn_readlane((int)m1, 0), (unsigned)__builtin_amdgcn_readlane((int)m1, 16)), max((unsigned)__builtin_amdgcn_readlane((int)m1, 32), (unsigned)__builtin_amdgcn_readlane((int)m1, 48)));
        if (kmax > 1024u) {
            const unsigned lo = kmax - 1023u;
            const int clo = count_gt(lo - 1u);
            if (clo >= 256) { T = lo; cge = clo; topbit = 9; }
        }
    }
#pragma unroll 1
    for (int bit = topbit; bit >= 0; --bit) {
        const unsigned cand = topbit == 15 ? (T | (1u << bit)) : (T + (1u << bit));
        if (cand > 0xffffu) continue;
        const int cnt = count_gt(cand - 1u);
        if (cnt >= 256) { T = cand; cge = cnt; }
    }
    auto build = [&](unsigned x, unsigned (&M)[4]) {
        const unsigned xw = x | (x << 16);
#pragma unroll
        for (int c = 0; c < 4; ++c) {
            M[c] = 0u;
            if (4 * c < niter) {
#pragma unroll
                for (int i = 4 * c; i < 4 * c + 4; ++i) {
                    unsigned byte = dot2acc(pk_gt(kr[i].x, xw, one), 0x00020001u, 0u);
                    byte = dot2acc(pk_gt(kr[i].y, xw, one), 0x00080004u, byte);
                    byte = dot2acc(pk_gt(kr[i].z, xw, one), 0x00200010u, byte);
                    byte = dot2acc(pk_gt(kr[i].w, xw, one), 0x00800040u, byte);
                    M[c] |= byte << (8 * (i & 3));
                }
            }
        }
    };
    unsigned M[4];
    build(T - 1u, M);
    if (cge != 256) {
        unsigned G[4]; build(T, G);
        unsigned E[4];
#pragma unroll
        for (int c = 0; c < 4; ++c) E[c] = M[c] & ~G[c];
        const int need = 256 - (cge - wave_sum((int)(__builtin_popcount(E[0]) + __builtin_popcount(E[1]) + __builtin_popcount(E[2]) + __builtin_popcount(E[3]))));
        auto below = [&](int B, int c) -> unsigned { const int nb = B - 32 * c; return nb <= 0 ? 0u : (nb >= 32 ? 0xffffffffu : ((1u << nb) - 1u)); };
        auto ties_below = [&](int B) -> int {
            return wave_sum((int)(__builtin_popcount(E[0] & below(B, 0)) + __builtin_popcount(E[1] & below(B, 1)) + __builtin_popcount(E[2] & below(B, 2)) + __builtin_popcount(E[3] & below(B, 3))));
        };
        int lo = 0, hi = 127;
#pragma unroll 1
        while (lo < hi) { const int mid = (lo + hi) >> 1; if (ties_below(mid + 1) >= need) hi = mid; else lo = mid + 1; }
        const int Bs = lo, r = need - ties_below(Bs);
        const unsigned ew = Bs < 32 ? E[0] : (Bs < 64 ? E[1] : (Bs < 96 ? E[2] : E[3]));
        const bool tb = ((ew >> (Bs & 31)) & 1u) != 0u;
        const unsigned long long em = __ballot(tb);
        const bool take_row = tb && __builtin_popcountll(em & ((1ull << lane) - 1ull)) < r;
#pragma unroll
        for (int c = 0; c < 4; ++c) {
            unsigned tk = E[c] & below(Bs, c);
            if ((Bs >> 5) == c && take_row) tk |= 1u << (Bs & 31);
            M[c] = G[c] | tk;
        }
    }
    const int kl = __builtin_popcount(M[0]) + __builtin_popcount(M[1]) + __builtin_popcount(M[2]) + __builtin_popcount(M[3]);
    int wp = wave_incl_scan(kl, lane) - kl;
#pragma unroll
    for (int c = 0; c < 4; ++c) {
        unsigned m = M[c];
        while (m) { const int b = __builtin_ctz(m); list[wp] = (u16)((32 * c + b) * 64 + lane); ++wp; m &= m - 1u; }
    }
}

DI void attend(const Args& a, size_t brow, int t, int cnt, LAS const u16* list, LAS unsigned char* img, int lane, int fr, int fq) {
    const u16* Q = (const u16*)(a.ws + WS_Q); const u16* KVN = (const u16*)(a.ws + WS_KVN); u16* YO = (u16*)(a.ws + WS_YO);
    bf16x8 qf[4];
    {
        const int head = fr & 7;
        const u16* qrow = Q + (brow + t) * 1024 + head * 128;
        float f[4][8]; float ss = 0.f;
#pragma unroll
        for (int ks = 0; ks < 4; ++ks) {
            const u32x4 raw = *(const u32x4*)(qrow + ks * 32 + 8 * fq);
            f[ks][0] = bflo(raw.x); f[ks][1] = bfhi(raw.x); f[ks][2] = bflo(raw.y); f[ks][3] = bfhi(raw.y); f[ks][4] = bflo(raw.z); f[ks][5] = bfhi(raw.z); f[ks][6] = bflo(raw.w); f[ks][7] = bfhi(raw.w);
#pragma unroll
            for (int j = 0; j < 8; ++j) ss += f[ks][j] * f[ks][j];
        }
        ss += __shfl_xor(ss, 16); ss += __shfl_xor(ss, 32);
        const float rq = __builtin_amdgcn_rsqf(ss * (1.0f / 128.0f) + EPS) * (0.08838834764831845f * 1.4426950408889634f);
#pragma unroll
        for (int ks = 0; ks < 4; ++ks) {
            const float* qg = a.in[I_QNG] + ks * 32 + 8 * fq;
            u32x4 w;
            w.x = pk2(f[ks][0] * rq * qg[0], f[ks][1] * rq * qg[1]); w.y = pk2(f[ks][2] * rq * qg[2], f[ks][3] * rq * qg[3]);
            w.z = pk2(f[ks][4] * rq * qg[4], f[ks][5] * rq * qg[5]); w.w = pk2(f[ks][6] * rq * qg[6], f[ks][7] * rq * qg[7]);
            qf[ks] = __builtin_bit_cast(bf16x8, w);
        }
    }
    const int nsteps = (cnt + 31) >> 5;
    f32x4 oacc[8];
#pragma unroll
    for (int i = 0; i < 8; ++i) oacc[i] = (f32x4){0.f, 0.f, 0.f, 0.f};
    float mrun = -3.0e38f, lpart = 0.f;
    const char* kvb = (const char*)(KVN + brow * 128);
    auto issue = [&](u32x4 (&pf)[8], int pp) {
#pragma unroll
        for (int it = 0; it < 8; ++it) { const int piece = it * 64 + lane; const unsigned key = list[pp * 32 + (piece >> 4)]; pf[it] = *(const u32x4*)(kvb + (key * 256u + 16u * (unsigned)(piece & 15))); }
    };
    auto step = [&](u32x4 (&pf)[8], int pp) {
#pragma unroll
        for (int it = 0; it < 8; ++it) { const int piece = it * 64 + lane; *(LAS u32x4*)(img + (piece >> 4) * 288 + (piece & 15) * 16) = pf[it]; }
        if (pp + 2 < nsteps) issue(pf, pp + 2);
        wave_lds_sync();
        __builtin_amdgcn_sched_barrier(0);
        f32x4 sa = {0.f, 0.f, 0.f, 0.f}, sb = {0.f, 0.f, 0.f, 0.f};
#pragma unroll
        for (int ks = 0; ks < 4; ++ks) {
            const bf16x8 a0 = *(LAS const bf16x8*)(img + fr * 288 + (ks * 32 + 8 * fq) * 2), a1 = *(LAS const bf16x8*)(img + (16 + fr) * 288 + (ks * 32 + 8 * fq) * 2);
            sa = __builtin_amdgcn_mfma_f32_16x16x32_bf16(a0, qf[ks], sa, 0, 0, 0); sb = __builtin_amdgcn_mfma_f32_16x16x32_bf16(a1, qf[ks], sb, 0, 0, 0);
            if (ks == 1) __builtin_amdgcn_sched_barrier(0);
        }
        if (pp * 32 + 32 > cnt) {
            const int pb0 = pp * 32 + 4 * fq;
#pragma unroll
            for (int r = 0; r < 4; ++r) { if (pb0 + r >= cnt) sa[r] = -3.0e38f; if (pb0 + 16 + r >= cnt) sb[r] = -3.0e38f; }
        }
        float mx = fmaxf(fmaxf(fmaxf(sa[0], sa[1]), fmaxf(sa[2], sa[3])), fmaxf(fmaxf(sb[0], sb[1]), fmaxf(sb[2], sb[3])));
        mx = fmaxf(mx, __shfl_xor(mx, 16)); mx = fmaxf(mx, __shfl_xor(mx, 32));
        if (__ballot(mx > mrun) != 0ull) {
            const float mnew = fmaxf(mrun, mx), alpha = __builtin_amdgcn_exp2f(mrun - mnew);
            mrun = mnew; lpart *= alpha;
#pragma unroll
            for (int cb = 0; cb < 8; ++cb) oacc[cb] *= alpha;
        }
        float ps = 0.f;
#pragma unroll
        for (int r = 0; r < 4; ++r) { sa[r] = __builtin_amdgcn_exp2f(sa[r] - mrun); sb[r] = __builtin_amdgcn_exp2f(sb[r] - mrun); ps += sa[r] + sb[r]; }
        lpart += ps;
        u32x4 pw; pw.x = pk2(sa[0], sa[1]); pw.y = pk2(sa[2], sa[3]); pw.z = pk2(sb[0], sb[1]); pw.w = pk2(sb[2], sb[3]);
        const bf16x8 pb = __builtin_bit_cast(bf16x8, pw);
#pragma unroll
        for (int cb = 0; cb < 8; ++cb) {
            const s16x4 r0 = __builtin_amdgcn_ds_read_tr16_b64_v4i16((LAS s16x4*)(img + (4 * fq + (fr >> 2)) * 288 + (cb * 16 + 4 * (fr & 3)) * 2));
            const s16x4 r1 = __builtin_amdgcn_ds_read_tr16_b64_v4i16((LAS s16x4*)(img + (16 + 4 * fq + (fr >> 2)) * 288 + (cb * 16 + 4 * (fr & 3)) * 2));
            const bf16x8 av = {r0[0], r0[1], r0[2], r0[3], r1[0], r1[1], r1[2], r1[3]};
            oacc[cb] = __builtin_amdgcn_mfma_f32_16x16x32_bf16(av, pb, oacc[cb], 0, 0, 0);
            if (cb == 3) __builtin_amdgcn_sched_barrier(0);
        }
        wave_lds_sync();
    };
    u32x4 pf0[8], pf1[8];
    issue(pf0, 0);
    if (nsteps > 1) issue(pf1, 1);
#pragma unroll 1
    for (int pp = 0; pp < nsteps; pp += 2) {
        step(pf0, pp);
        if (pp + 1 < nsteps) step(pf1, pp + 1);
    }
    float lsum = lpart; lsum += __shfl_xor(lsum, 16); lsum += __shfl_xor(lsum, 32);
    const float inv = __builtin_amdgcn_rcpf(lsum);
    if (fr < 8) {
        u16* orow = YO + (brow + t) * 1536 + 512 + fr * 128 + 4 * fq;
#pragma unroll
        for (int cb = 0; cb < 8; ++cb) { u32x2 w; w.x = pk2(oacc[cb][0] * inv, oacc[cb][1] * inv); w.y = pk2(oacc[cb][2] * inv, oacc[cb][3] * inv); *(u32x2*)(orow + cb * 16) = w; }
    }
}

DI void dsa_phase(const Args& a, LAS unsigned char* lds) {
    unsigned char* ws = a.ws;
    const int wid = __builtin_amdgcn_readfirstlane(otid() >> 6);
    LAS u16* rows = (LAS u16*)(lds + P3_ROWS);
    bool bprev = false; size_t pbrow = 0; int pt0 = 0, bbuf = 0;
    for (int gi = blockIdx.x; gi < T / 8; gi += gridDim.x) {
        const int lane = otid() & 63, fr = lane & 15, fq = lane >> 4;
        const int b = gi & 3, t0 = S - 8 - 8 * (gi >> 2);
        const size_t brow = (size_t)b * S;
        const int ntile = (t0 + 8 + 15) >> 4;
        __syncthreads();
        {
            const unsigned char* QI = (const unsigned char*)(ws + WS_QI); const unsigned char* KIN = (const unsigned char*)(ws + WS_KIN); const float* WI = (const float*)(ws + WS_WI);
            typedef int i32x4_t __attribute__((ext_vector_type(4)));
            i32x4_t qa[2]; f32x4 wi[2];
#pragma unroll
            for (int rg = 0; rg < 2; ++rg) {
                qa[rg] = *(const i32x4_t*)(QI + (brow + t0 + 4 * rg + (fr >> 2)) * 256 + (fr & 3) * 64 + 16 * fq);
                wi[rg] = *(const f32x4*)(WI + (brow + t0 + 4 * rg + fq) * 4);
            }
            auto ldk = [&](i32x4_t (&kf)[4], int jt0) {
#pragma unroll
                for (int u = 0; u < 4; ++u) {
                    const int jt = (jt0 + 8 * u) < ntile ? (jt0 + 8 * u) : (ntile - 1);
                    kf[u] = *(const i32x4_t*)(KIN + (brow + jt * 16 + fr) * 64 + 16 * fq);
                }
            };
            auto cmpk = [&](const i32x4_t (&kf)[4], int jt0) {
#pragma unroll
                for (int u = 0; u < 4; ++u) {
                    const int jt = jt0 + 8 * u;
                    if (jt < ntile) {
#pragma unroll
                        for (int rg = 0; rg < 2; ++rg) {
                            i32x4_t d = {0, 0, 0, 0};
                            d = __builtin_amdgcn_mfma_i32_16x16x64_i8(qa[rg], kf[u], d, 0, 0, 0);
                            const float sc = (((float)max(d[0], 0) * wi[rg][0] + (float)max(d[1], 0) * wi[rg][1]) + (float)max(d[2], 0) * wi[rg][2]) + (float)max(d[3], 0) * wi[rg][3];
                            rows[(4 * rg + fq) * 8192 + rowaddr(jt * 16 + fr)] = (u16)(f2key(sc) >> 16);
                        }
                    }
                }
            };
            i32x4_t kA[4], kB[4];
            if (wid < ntile) ldk(kA, wid);
            for (int jt0 = wid; jt0 < ntile; jt0 += 64) {
                const bool hasB = jt0 + 32 < ntile;
                if (hasB) ldk(kB, jt0 + 32);
                cmpk(kA, jt0);
                if (hasB) { if (jt0 + 64 < ntile) ldk(kA, jt0 + 64); cmpk(kB, jt0 + 32); }
            }
        }
        __syncthreads();
        if (wid < 4) {
            u32x4 kr[16];
            const int N0 = t0 + wid + 1, N1 = N0 + 4;
            if (N0 > 256) keys_load(rows + wid * 8192, N0, lane, kr);
            __syncthreads();
            LAS u16* l0 = (LAS u16*)(lds + (bbuf ? P3_HIST : P3_LIST) + wid * 512);
            LAS u16* l1 = l0 + 4 * 256;
            if (N0 > 256) keys_select(kr, l0, N0, lane); else { for (int p = lane; p < 256; p += 64) l0[p] = p < N0 ? (u16)p : (u16)0; }
            if (N1 > 256) { keys_load(rows + (wid + 4) * 8192, N1, lane, kr); keys_select(kr, l1, N1, lane); } else { for (int p = lane; p < 256; p += 64) l1[p] = p < N1 ? (u16)p : (u16)0; }
        } else {
            __syncthreads();
            if (bprev) {
                LAS const u16* lp = (LAS const u16*)(lds + (bbuf ? P3_LIST : P3_HIST));
                LAS unsigned char* img = (LAS unsigned char*)(rows + (wid - 4) * 8192);
                { const int q = wid - 4, t = pt0 + q; attend(a, pbrow, t, t + 1 < 256 ? t + 1 : 256, lp + q * 256, img, lane, fr, fq); }
                { const int q = wid, t = pt0 + q; attend(a, pbrow, t, t + 1 < 256 ? t + 1 : 256, lp + q * 256, img, lane, fr, fq); }
            }
        }
        bprev = true; pbrow = brow; pt0 = t0; bbuf ^= 1;
    }
    __syncthreads();
    if (bprev) {
        const int lane = otid() & 63, fr = lane & 15, fq = lane >> 4;
        LAS const u16* lp = (LAS const u16*)(lds + (bbuf ? P3_LIST : P3_HIST));
        const int q = wid, t = pt0 + q;
        attend(a, pbrow, t, t + 1 < 256 ? t + 1 : 256, lp + q * 256, (LAS unsigned char*)(rows + wid * 8192), lane, fr, fq);
    }
}

constexpr int P6_LCNT = 0, P6_BASE = 128, P6_RSB = 256, P6_RI = 1024;
DI unsigned dpp_max_u32(unsigned v) {
    v = max(v, (unsigned)__builtin_amdgcn_update_dpp(0, (int)v, 0xB1, 0xf, 0xf, false));
    v = max(v, (unsigned)__builtin_amdgcn_update_dpp(0, (int)v, 0x4E, 0xf, 0xf, false));
    v = max(v, (unsigned)__builtin_amdgcn_update_dpp(0, (int)v, 0x141, 0xf, 0xf, false));
    v = max(v, (unsigned)__builtin_amdgcn_update_dpp(0, (int)v, 0x140, 0xf, 0xf, false));
    return v;
}
DI float key2f(unsigned k) { return __uint_as_float((k & 0x80000000u) ? (k & 0x7fffffffu) : ~k); }
DI void router_phase(const Args& a, LAS unsigned char* lds) {
    unsigned char* ws = a.ws;
    const int tid = otid(), wid = tid >> 6, lane = tid & 63, fr = lane & 15, fq = lane >> 4;
    LAS int* lcnt = (LAS int*)(lds + P6_LCNT); LAS int* lbase = (LAS int*)(lds + P6_BASE); LAS float* rsb = (LAS float*)(lds + P6_RSB); LAS int* RI = (LAS int*)(lds + P6_RI);
    const u16* WRH = (const u16*)(ws + WS_WR); const u16* WRL = WRH + 32 * 1024;
    unsigned* CNT = (unsigned*)(ws + WS_CTL);
    for (int rg = blockIdx.x; rg < T / 128; rg += gridDim.x) {
        __syncthreads();
        if (tid < 32) lcnt[tid] = 0;
        __syncthreads();
        {
            const int row = rg * 128 + wid * 16 + fr;
            const float* xr = a.out + (size_t)row * 1024 + 8 * fq;
            f32x4 acc[2] = {{0.f, 0.f, 0.f, 0.f}, {0.f, 0.f, 0.f, 0.f}};
            float ss = 0.f;
#pragma unroll 4
            for (int ks = 0; ks < 32; ++ks) {
                const f32x4 x0 = *(const f32x4*)(xr + ks * 32), x1 = *(const f32x4*)(xr + ks * 32 + 4);
                ss += ((x0[0] * x0[0] + x0[1] * x0[1]) + (x0[2] * x0[2] + x0[3] * x0[3])) + ((x1[0] * x1[0] + x1[1] * x1[1]) + (x1[2] * x1[2] + x1[3] * x1[3]));
                u32x4 hw; hw.x = pk2(x0[0], x0[1]); hw.y = pk2(x0[2], x0[3]); hw.z = pk2(x1[0], x1[1]); hw.w = pk2(x1[2], x1[3]);
                u32x4 lw; lw.x = pk2(x0[0] - bflo(hw.x), x0[1] - bfhi(hw.x)); lw.y = pk2(x0[2] - bflo(hw.y), x0[3] - bfhi(hw.y)); lw.z = pk2(x1[0] - bflo(hw.z), x1[1] - bfhi(hw.z)); lw.w = pk2(x1[2] - bflo(hw.w), x1[3] - bfhi(hw.w));
                const bf16x8 xh = __builtin_bit_cast(bf16x8, hw), xl = __builtin_bit_cast(bf16x8, lw);
#pragma unroll
                for (int nt = 0; nt < 2; ++nt) {
                    const bf16x8 wh = *(const bf16x8*)(WRH + (size_t)(nt * 16 + fr) * 1024 + ks * 32 + 8 * fq), wl = *(const bf16x8*)(WRL + (size_t)(nt * 16 + fr) * 1024 + ks * 32 + 8 * fq);
                    acc[nt] = __builtin_amdgcn_mfma_f32_16x16x32_bf16(xh, wh, acc[nt], 0, 0, 0);
                    acc[nt] = __builtin_amdgcn_mfma_f32_16x16x32_bf16(xl, wh, acc[nt], 0, 0, 0);
                    acc[nt] = __builtin_amdgcn_mfma_f32_16x16x32_bf16(xh, wl, acc[nt], 0, 0, 0);
                }
            }
            ss += __shfl_xor(ss, 16); ss += __shfl_xor(ss, 32);
            const float rsrow = __builtin_amdgcn_rsqf(ss * (1.0f / 1024.0f) + EPS);
            if (fq == 0) rsb[wid * 16 + fr] = rsrow;
            {
                unsigned char* xn = ws + WS_XN2 + (size_t)row * 1024 + 8 * fq;
#pragma unroll 4
                for (int ks = 0; ks < 32; ++ks) {
                    const f32x4 x0 = *(const f32x4*)(xr + ks * 32), x1 = *(const f32x4*)(xr + ks * 32 + 4);
                    u32x2 w; w.x = pk4_fp8(x0[0] * rsrow, x0[1] * rsrow, x0[2] * rsrow, x0[3] * rsrow); w.y = pk4_fp8(x1[0] * rsrow, x1[1] * rsrow, x1[2] * rsrow, x1[3] * rsrow);
                    *(u32x2*)(xn + ks * 32) = w;
                }
            }
            wave_lds_sync();
            const float b0 = a.in[I_BR][fr], b1 = a.in[I_BR][16 + fr];
#pragma unroll
            for (int r = 0; r < 4; ++r) {
                const float rs = rsb[wid * 16 + 4 * fq + r];
                unsigned k0 = (f2key(acc[0][r] * rs + b0) & ~31u) | (unsigned)(31 - fr), k1 = (f2key(acc[1][r] * rs + b1) & ~31u) | (unsigned)(15 - fr);
                unsigned sel[4];
#pragma unroll
                for (int k = 0; k < 4; ++k) {
                    const unsigned best = dpp_max_u32(k0 > k1 ? k0 : k1);
                    sel[k] = best;
                    if (k0 == best) k0 = 0u;
                    if (k1 == best) k1 = 0u;
                }
                const float v0 = key2f(sel[0] & ~31u), e1 = __expf(key2f(sel[1] & ~31u) - v0), e2 = __expf(key2f(sel[2] & ~31u) - v0), e3 = __expf(key2f(sel[3] & ~31u) - v0);
                const float inv = 1.0f / (1.0f + e1 + e2 + e3);
                if (fr < 4) {
                    const unsigned sk = fr == 0 ? sel[0] : (fr == 1 ? sel[1] : (fr == 2 ? sel[2] : sel[3]));
                    const int e = 31 - (int)(sk & 31u);
                    const float gt = (fr == 0 ? 1.0f : (fr == 1 ? e1 : (fr == 2 ? e2 : e3))) * inv;
                    const int ls = __hip_atomic_fetch_add(lcnt + e, 1, __ATOMIC_RELAXED, __HIP_MEMORY_SCOPE_WORKGROUP);
                    const int ri = ((wid * 16 + 4 * fq + r) * 4 + fr) * 4;
                    RI[ri + 0] = e; RI[ri + 1] = ls; RI[ri + 2] = __float_as_int(gt);
                }
            }
        }
        __syncthreads();
        if (tid < 32) lbase[tid] = (int)__hip_atomic_fetch_add(CNT + tid, (unsigned)lcnt[tid], __ATOMIC_RELAXED, __HIP_MEMORY_SCOPE_AGENT);
        __syncthreads();
        {
            const int rl = tid >> 2, k = tid & 3, row = rg * 128 + rl;
            const int e = RI[tid * 4 + 0], slot = lbase[e] + RI[tid * 4 + 1];
            ((int*)(ws + WS_LTOK))[(size_t)e * ECAP + slot] = row;
            ((float*)(ws + WS_LGATE))[(size_t)e * ECAP + slot] = __int_as_float(RI[tid * 4 + 2]);
            ((unsigned*)(ws + WS_ROUTE))[(size_t)row * 4 + k] = ((unsigned)e << 16) | (unsigned)slot;
        }
    }
}

DI void combine_phase(const Args& a, LAS unsigned char* lds) {
    unsigned char* ws = a.ws;
    LAS const int* tab = (LAS const int*)(lds + MOE_TAB);
    const int tid = otid(), wid = tid >> 6, lane = tid & 63;
    const u16* YB = (const u16*)(ws + WS_YB); const unsigned* ROUTE = (const unsigned*)(ws + WS_ROUTE);
    for (int row = blockIdx.x * 8 + wid; row < T; row += gridDim.x * 8) {
        size_t pos[4];
#pragma unroll
        for (int k = 0; k < 4; ++k) { const unsigned r = ROUTE[(size_t)row * 4 + k]; const int e = (int)(r >> 16), slot = (int)(r & 0xffffu); pos[k] = (size_t)tab[e] * 256 + slot; }
        float* orow = a.out + (size_t)row * 1024;
#pragma unroll
        for (int i = 0; i < 4; ++i) {
            f32x4 v = *(const f32x4*)(orow + i * 256 + lane * 4);
#pragma unroll
            for (int k = 0; k < 4; ++k) { const u32x2 y = *(const u32x2*)(YB + pos[k] * 1024 + i * 256 + lane * 4); v[0] += bflo(y.x); v[1] += bfhi(y.x); v[2] += bflo(y.y); v[3] += bfhi(y.y); }
            *(f32x4*)(orow + i * 256 + lane * 4) = v;
        }
    }
}

#define XB_TMO      128
#define XB_XCNT(j)  (256  + 64 * (j))
#define XB_XSUB(j)  (1280 + 64 * (j))
#define XB_XGEN(j)  (2304 + 64 * (j))
#define XB_TOP      3328
#define XB_TOPGEN   3392
#define XCD_BAR_WORDS 3456
#define XB_SPIN_CAP (1u << 18)

__device__ __forceinline__ unsigned xb_ld(unsigned* p)              { return __hip_atomic_load(p, __ATOMIC_RELAXED, __HIP_MEMORY_SCOPE_AGENT); }
__device__ __forceinline__ unsigned xb_add(unsigned* p, unsigned v) { return __hip_atomic_fetch_add(p, v, __ATOMIC_RELAXED, __HIP_MEMORY_SCOPE_AGENT); }
__device__ __forceinline__ unsigned xb_xcc_id() { return (unsigned)__builtin_amdgcn_s_getreg((3 << 11) | 20) & 0xFu; }
#define XB_SPIN(cond, bar) do { unsigned _sp = 0; while (cond) { __builtin_amdgcn_s_sleep(1); \
    if ((++_sp & 255u) == 0u) { if (xb_ld(&(bar)[XB_TMO])) break; if (_sp > XB_SPIN_CAP) { atomicAdd(&(bar)[XB_TMO], 1u); break; } } } } while (0)

struct XcdBarrier {
    unsigned* bar; unsigned x;
    volatile LAS unsigned* st;
};

__device__ __forceinline__ XcdBarrier xcd_barrier_post(unsigned* bar, volatile LAS unsigned* st) {
    XcdBarrier b; b.bar = bar; b.x = xb_xcc_id(); b.st = st;
    if (threadIdx.x == 0) (void)xb_add(&bar[XB_XCNT(b.x)], 1u);
    return b;
}
__device__ __forceinline__ void xcd_barrier_complete(unsigned* bar, unsigned x, unsigned& nloc, unsigned& nx) {
    const unsigned G = gridDim.x * gridDim.y * gridDim.z;
    unsigned sum, cnt, mine, sp = 0u;
    for (;;) {
        sum = 0u; cnt = 0u; mine = 0u;
#pragma unroll
        for (unsigned j = 0; j < 16; ++j) { const unsigned c = xb_ld(&bar[XB_XCNT(j)]); sum += c; cnt += (c > 0u) ? 1u : 0u; mine = (j == x) ? c : mine; }
        if (sum == G) break;
        __builtin_amdgcn_s_sleep(1);
        if ((++sp & 255u) == 0u) { if (xb_ld(&bar[XB_TMO])) break; if (sp > XB_SPIN_CAP) { atomicAdd(&bar[XB_TMO], 1u); break; } }
    }
    nloc = mine > 0u ? mine : 1u; nx = cnt > 0u ? cnt : 1u;
}

__device__ __forceinline__ void xcd_barrier(const XcdBarrier& b) {
    asm volatile("s_waitcnt vmcnt(0)" ::: "memory");
    __syncthreads();
    if (threadIdx.x == 0) {
        unsigned* bar = b.bar;
        __builtin_amdgcn_s_waitcnt(0);
        unsigned nloc = b.st[0], nx = b.st[1];
        if (nloc == 0u) { xcd_barrier_complete(bar, b.x, nloc, nx); b.st[0] = nloc; b.st[1] = nx; }
        const unsigned old = xb_add(&bar[XB_XSUB(b.x)], 1u);
        const unsigned gen = old / nloc;
        if (old + 1u == (gen + 1u) * nloc) {
            __builtin_amdgcn_fence(__ATOMIC_RELEASE, "agent");
            asm volatile("s_waitcnt vmcnt(0)" ::: "memory");
            const unsigned og = xb_add(&bar[XB_TOP], 1u);
            const unsigned tg = og / nx;
            if (og + 1u == (tg + 1u) * nx) xb_add(&bar[XB_TOPGEN], 1u);
            else XB_SPIN(xb_ld(&bar[XB_TOPGEN]) == tg, bar);
            __builtin_amdgcn_fence(__ATOMIC_ACQUIRE, "agent");
            xb_add(&bar[XB_XGEN(b.x)], 1u);
            asm volatile("s_waitcnt vmcnt(0)" ::: "memory");
        } else {
            XB_SPIN(xb_ld(&bar[XB_XGEN(b.x)]) == gen, bar);
            __builtin_amdgcn_fence(__ATOMIC_ACQUIRE, "agent");
            asm volatile("s_waitcnt vmcnt(0)" ::: "memory");
        }
    }
    __syncthreads();
}

__global__ void __launch_bounds__(NT, 2) fwd(Args a) {
    extern __shared__ __attribute__((aligned(16))) unsigned char lds_raw[];
    LAS unsigned char* lds = (LAS unsigned char*)lds_raw;
    cg::grid_group grid = cg::this_grid();
    unsigned char* ws = a.ws;
    const int G = gridDim.x, c = blockIdx.x;
    if (threadIdx.x < 2) ((volatile LAS unsigned*)(lds + LDS_BARST))[threadIdx.x] = 0u;
    __syncthreads();
    const XcdBarrier xbar = xcd_barrier_post((unsigned*)(ws + WS_BAR), (volatile LAS unsigned*)(lds + LDS_BARST));

    phase0(a, lds);
    xcd_barrier(xbar);
    {
        g8::PlainSched s; s.Abase = (const char*)(ws + WS_XB); s.Bbase = (const char*)(ws + WS_WIN); s.lda = 1024; s.ldb = 1024; s.K = 1024; s.nM = T / 256; s.nN = NIN / 256; s.G = G; s.c = c;
        EpiIn e; e.H = (u16*)(ws + WS_H); e.rs1 = (const float*)(ws + WS_RS1); e.SSQ = (float*)(ws + WS_SSQ); e.WI = (float*)(ws + WS_WI);
        g8::gemm_phase(lds, s, e);
    }
    xcd_barrier(xbar);
    {
        g8::PlainSched s; s.Abase = (const char*)(ws + WS_H) + 1024 * 2; s.Bbase = (const char*)(ws + WS_WQ); s.lda = NIN; s.ldb = 256; s.K = 256; s.nM = T / 256; s.nN = 5; s.G = G; s.c = c;
        EpiQ e; e.Q = (u16*)(ws + WS_Q); e.QI = (u16*)(ws + WS_QI); e.SSQ = (const float*)(ws + WS_SSQ);
        g8::gemm_phase(lds, s, e);
        for (int u = c; u < 1024; u += G) gmlp_unit(a, lds, u);
        kvnorm(a);
    }
    xcd_barrier(xbar);
    dsa_phase(a, lds);
    xcd_barrier(xbar);
    {
        g8::PlainSched s; s.Abase = (const char*)(ws + WS_YO); s.Bbase = (const char*)(ws + WS_WCAT); s.lda = 1536; s.ldb = 1536; s.K = 512; s.nM = T / 256; s.nN = 4; s.G = G; s.c = c;
        EpiMrg<0> e0; e0.OUT = (u16*)(ws + WS_TMP); e0.TMP = nullptr; e0.H = (const u16*)(ws + WS_H);
        g8::gemm_phase(lds, s, e0);
        s.Abase = (const char*)(ws + WS_YO) + 512 * 2; s.Bbase = (const char*)(ws + WS_WCAT) + 512 * 2; s.K = 1024;
        EpiMrg<1> e1; e1.OUT = (u16*)(ws + WS_MRG); e1.TMP = (const u16*)(ws + WS_TMP); e1.H = (const u16*)(ws + WS_H);
        g8::gemm_phase(lds, s, e1);
    }
    xcd_barrier(xbar);
    {
        g8::PlainSched s; s.Abase = (const char*)(ws + WS_MRG); s.Bbase = (const char*)(ws + WS_WOUT); s.lda = 1024; s.ldb = 1024; s.K = 1024; s.nM = T / 256; s.nN = 4; s.G = G; s.c = c;
        EpiOut e; e.out = a.out; e.x = a.in[I_X];
        g8::gemm_phase(lds, s, e);
    }
    xcd_barrier(xbar);
    router_phase(a, lds);
    xcd_barrier(xbar);
    moe_table(lds, (const unsigned*)(ws + WS_CTL));
    {
        MoeSched<8, true> s; s.Abase = (const char*)(ws + WS_XN2); s.Wbase = (const char*)(ws + WS_WE1); s.LTOK = (const int*)(ws + WS_LTOK); s.tab = (LAS const int*)(lds + MOE_TAB);
        s.lda = 1024; s.ldb = 1024; s.K = 1024; s.G = G; s.c = c; s.wstride = (size_t)2048 * 1024;
        EpiMoe1 e; e.ACT = (unsigned char*)(ws + WS_ACT); e.b1 = a.in[I_BE1];
        g8::gemm_phase<true>(lds, s, e);
    }
    xcd_barrier(xbar);
    {
        MoeSched<4, false> s; s.Abase = (const char*)(ws + WS_ACT); s.Wbase = (const char*)(ws + WS_WE2); s.LTOK = nullptr; s.tab = (LAS const int*)(lds + MOE_TAB);
        s.lda = 1024; s.ldb = 1024; s.K = 1024; s.G = G; s.c = c; s.wstride = (size_t)1024 * 1024;
        EpiMoe2 e; e.YB = (u16*)(ws + WS_YB); e.b2 = a.in[I_BE2]; e.LGATE = (const float*)(ws + WS_LGATE); e.tab = (LAS const int*)(lds + MOE_TAB);
        g8::gemm_phase<true>(lds, s, e);
    }
    xcd_barrier(xbar);
    combine_phase(a, lds);
    if (a.mask == 0u) grid.sync();
}

extern "C" void kernel_launch(void* const* d_in, const int* in_sizes, int n_in, void* d_out, int out_size, void* d_ws, size_t ws_size, hipStream_t stream) {
    static int grid = 0;
    if (grid == 0) {
        int dev = 0, cus = 0, per_cu = 0;
        if (n_in != 23 || out_size != T * Dm || ws_size < WS_END) { fprintf(stderr, "kernel_launch: unexpected problem (n_in %d, out %d, ws %zu < %zu)\n", n_in, out_size, ws_size, (size_t)WS_END); grid = -1; return; }
        if (hipGetDevice(&dev) != hipSuccess || hipDeviceGetAttribute(&cus, hipDeviceAttributeMultiprocessorCount, dev) != hipSuccess) { grid = -1; return; }
        if (hipFuncSetAttribute((const void*)fwd, hipFuncAttributeMaxDynamicSharedMemorySize, LDS_BYTES) != hipSuccess) { fprintf(stderr, "hipFuncSetAttribute failed\n"); grid = -1; return; }
        if (hipOccupancyMaxActiveBlocksPerMultiprocessor(&per_cu, (const void*)fwd, NT, LDS_BYTES) != hipSuccess || per_cu < 1) { fprintf(stderr, "occupancy query failed (%d)\n", per_cu); grid = -1; return; }
        grid = cus;
        fprintf(stderr, "kernel_launch: cus %d per_cu %d grid %d ws %zu need %zu\n", cus, per_cu, grid, ws_size, (size_t)WS_END);
    }
    if (grid < 0) return;
    Args a{};
    for (int i = 0; i < 23; ++i) a.in[i] = (const float*)d_in[i];
    a.out = (float*)d_out; a.ws = (unsigned char*)d_ws; a.mask = 0xffffffffu; a.pad = 0u;
    if (hipMemsetAsync((char*)d_ws + WS_CTL, 0, 65536, stream) != hipSuccess) { fprintf(stderr, "memset failed\n"); return; }
    void* args[] = {&a};
    hipError_t e = hipLaunchCooperativeKernel((const void*)fwd, dim3(grid), dim3(NT), args, LDS_BYTES, stream);
    if (e != hipSuccess) fprintf(stderr, "cooperative launch failed: %s (grid %d)\n", hipGetErrorString(e), grid);
}
```

```cpp
#include <hip/hip_runtime.h>
#include <hip/hip_cooperative_groups.h>
#include <cstdio>
#include <cstdint>
namespace cg = cooperative_groups;

#define LAS __attribute__((address_space(3)))
#define DI __device__ __forceinline__
typedef unsigned short u16;
typedef short bf16x8 __attribute__((ext_vector_type(8)));
typedef short s16x4 __attribute__((ext_vector_type(4)));
typedef float f32x4 __attribute__((ext_vector_type(4)));
typedef float f32x2 __attribute__((ext_vector_type(2)));
typedef unsigned u32x4 __attribute__((ext_vector_type(4)));
typedef unsigned u32x2 __attribute__((ext_vector_type(2)));
typedef __bf16 bf2_t __attribute__((ext_vector_type(2)));
typedef int v8i_t __attribute__((ext_vector_type(8)));

constexpr int NT = 512;
constexpr int LDS_BYTES = 155648;
constexpr int Dm = 1024, Bsz = 4, S = 8192, T = Bsz * S;
constexpr int NIN = 3584;
constexpr int NE = 32, ECAP = 32768, PPAD = 131072 + NE * 256;
constexpr float EPS = 1e-6f;

constexpr size_t MiB = 1024 * 1024;
constexpr size_t WS_CTL = 0;
constexpr size_t WS_BAR = 16384;
constexpr int LDS_BARST = LDS_BYTES - 16;
constexpr size_t WS_WIN = 64 * 1024;
constexpr size_t WS_WQ = WS_WIN + (size_t)NIN * 1024 * 2;
constexpr size_t WS_WSP = WS_WQ + 1280 * 256 * 2;
constexpr size_t WS_WCAT = WS_WSP + 4 * 128 * 128 * 2;
constexpr size_t WS_WOUT = WS_WCAT + 1024 * 1536 * 2;
constexpr size_t WS_WR = WS_WOUT + 1024 * 1024 * 2;
constexpr size_t WS_WE1 = WS_WR + 32 * 1024 * 4;
constexpr size_t WS_WE2 = WS_WE1 + (size_t)32 * 2048 * 1024 * 2;
constexpr size_t WS_RS1 = WS_WE2 + (size_t)32 * 1024 * 1024 * 2;
constexpr size_t WS_SSQ = WS_RS1 + (size_t)T * 4;
constexpr size_t WS_WI = WS_SSQ + (size_t)T * 32 * 4;
constexpr size_t WS_ROUTE = WS_WI + (size_t)T * 4 * 4;
constexpr size_t WS_LTOK = WS_ROUTE + (size_t)T * 4 * 4;
constexpr size_t WS_LGATE = WS_LTOK + (size_t)NE * ECAP * 4;
constexpr size_t WS_LRS = WS_LGATE + (size_t)NE * ECAP * 4;
constexpr size_t WS_XN2 = WS_LRS + (size_t)NE * ECAP * 4;
constexpr size_t WS_R0 = WS_XN2 + (size_t)T * 1024 * 2;
constexpr size_t WS_XB = WS_R0;
constexpr size_t WS_H = WS_XB + (size_t)T * 1024 * 2;
constexpr size_t WS_Q = WS_H + (size_t)T * NIN * 2;
constexpr size_t WS_QI = WS_Q + (size_t)T * 1024 * 2;
constexpr size_t WS_KVN = WS_QI + (size_t)T * 256 * 2;
constexpr size_t WS_KIN = WS_KVN + (size_t)T * 128 * 2;
constexpr size_t WS_YO = WS_KIN + (size_t)T * 64 * 2;
constexpr size_t WS_TMP = WS_YO + (size_t)T * 1536 * 2;
constexpr size_t WS_MRG = WS_TMP + (size_t)T * 1024 * 2;
constexpr size_t WS_R0END = WS_MRG + (size_t)T * 1024 * 2;
constexpr size_t WS_ACT = WS_XB;
constexpr size_t WS_YB = WS_Q;
static_assert(WS_ACT + (size_t)PPAD * 1024 * 2 <= WS_Q, "ACT overlaps YB");
static_assert(WS_YB + (size_t)PPAD * 1024 * 2 <= WS_R0END, "YB too large");
constexpr size_t WS_END = WS_R0END;

struct Args { const float* in[23]; float* out; unsigned char* ws; unsigned mask; unsigned pad; };
enum { I_X = 0, I_N1G, I_WIN, I_QLG, I_WUQ, I_QNG, I_KVG, I_WUV, I_WQI, I_KIG, I_VG, I_WSP, I_BSP, I_WPA, I_WPB, I_WOUT, I_N2G, I_WR, I_BR, I_WE1, I_BE1, I_WE2, I_BE2 };

DI unsigned pk2(float a, float b) { f32x2 v = {a, b}; bf2_t r = __builtin_convertvector(v, bf2_t); return __builtin_bit_cast(unsigned, r); }
DI unsigned pk4_fp8(float a, float b, float c, float d) { unsigned w = 0u; w = (unsigned)__builtin_amdgcn_cvt_pk_fp8_f32(a, b, (int)w, false); w = (unsigned)__builtin_amdgcn_cvt_pk_fp8_f32(c, d, (int)w, true); return w; }
DI unsigned pk4_i8(float a, float b, float c, float d) {
    const int ia = (int)__builtin_rintf(fminf(fmaxf(a * 32.0f, -127.0f), 127.0f)), ib = (int)__builtin_rintf(fminf(fmaxf(b * 32.0f, -127.0f), 127.0f));
    const int ic = (int)__builtin_rintf(fminf(fmaxf(c * 32.0f, -127.0f), 127.0f)), id = (int)__builtin_rintf(fminf(fmaxf(d * 32.0f, -127.0f), 127.0f));
    return (unsigned)(ia & 0xff) | ((unsigned)(ib & 0xff) << 8) | ((unsigned)(ic & 0xff) << 16) | ((unsigned)(id & 0xff) << 24);
}
DI float bflo(unsigned u) { return __uint_as_float(u << 16); }
DI float bfhi(unsigned u) { return __uint_as_float(u & 0xffff0000u); }
DI u16 f2bf(float f) { return (u16)(pk2(f, 0.f) & 0xffffu); }
DI float bf2f(u16 h) { return __uint_as_float(((unsigned)h) << 16); }
DI float sigmoidf_(float x) { return __builtin_amdgcn_rcpf(1.0f + __expf(-x)); }
DI float gelu_tanh(float x) { const float u = 1.5957691216057308f * (x + 0.044715f * x * x * x); return x * sigmoidf_(u); }
DI float fast_sigmoid(float x) { return __builtin_amdgcn_rcpf(1.0f + __builtin_amdgcn_exp2f(x * -1.4426950408889634f)); }
DI float fast_gelu(float x) { const float p = __builtin_fmaf(x * x, -0.10294324f, -2.3022082f); return x * __builtin_amdgcn_rcpf(1.0f + __builtin_amdgcn_exp2f(x * p)); }
DI int otid() { int t = threadIdx.x; asm volatile("" : "+v"(t)); return t; }
DI void wave_lds_sync() { asm volatile("s_waitcnt lgkmcnt(0)" ::: "memory"); }

namespace g8 {
constexpr int BM = 256, BK = 64, HALF = 128, HTB = HALF * BK * 2, STAGE_BYTES = 8 * HTB, NXCD = 8, WGM = 8;
DI int lds_byte(int r, int c) { const int st = (r >> 4) * 2 + (c >> 5), rr = r & 15, cc = c & 31, ob = rr * 64 + cc * 2; return st * 1024 + (ob ^ (((ob >> 9) & 1) << 5)); }
DI int perm32(int rho) { const int n = rho >> 4, i = rho & 15; return 8 * (i >> 2) + 4 * n + (i & 3); }
DI void stage_rc(int b, int& R, int& C) { const int st = b / 1024, sb = b % 1024, swz = sb ^ (((sb >> 9) & 1) << 5); R = (st >> 1) * 16 + swz / 64; C = (st & 1) * 32 + (swz % 64) / 2; }

struct UnitD { const char* Bp; int pm, pn, e, rb; };

DI bool static_tile(int i, int G, int c, int nM, int nN, int& pm, int& pn) {
    const int nwg = nM * nN; const long L = (long)i * G + c; if (L >= nwg) return false;
    int wgid = (int)L; { const int q = nwg / NXCD, r = nwg % NXCD, xcd = wgid % NXCD, off = wgid / NXCD; wgid = (xcd < r ? xcd * (q + 1) : r * (q + 1) + (xcd - r) * q) + off; }
    const int nig = WGM * nN, gid = wgid / nig, fm = gid * WGM, gsz = (nM - fm) < WGM ? (nM - fm) : WGM;
    pm = fm + ((wgid % nig) % gsz); pn = (wgid % nig) / gsz; return true;
}

struct PlainSched {
    const char* Abase; const char* Bbase; int lda, ldb, K, nM, nN, G, c; static constexpr int esz = 2;
    DI bool next(int i, UnitD& u) const { int pm, pn; if (!static_tile(i, G, c, nM, nN, pm, pn)) return false; u.pm = pm; u.pn = pn; u.e = 0; u.rb = 0; u.Bp = Bbase + (size_t)pn * BM * ldb * 2; return true; }
    DI void a_offs(const UnitD& u, int R0, int C0, unsigned (&o)[2][2]) const {
#pragma unroll
        for (int h = 0; h < 2; ++h)
#pragma unroll
            for (int i = 0; i < 2; ++i) o[h][i] = (unsigned)(((size_t)(u.pm * BM + h * HALF + R0 + 64 * i) * lda + C0) * 2);
    }
};

template <bool FP8 = false, class Epi, class Sched>
DI void gemm_phase(LAS unsigned char* lds, const Sched& S, const Epi& E) {
    const int tid = otid(), wid = __builtin_amdgcn_readfirstlane(tid >> 6), lane = tid & 63, wr = wid >> 2, wc = wid & 3, fr = lane & 15, fq = lane >> 4;
    const int nt = S.K * Sched::esz / 128;
    int R0, C0; stage_rc(tid * 16, R0, C0);
    unsigned voffB[2];
#pragma unroll
    for (int i = 0; i < 2; ++i) { const int Rr = R0 + 64 * i, Rb = Epi::PERM ? ((Rr & ~31) + perm32(Rr & 31)) : Rr; voffB[i] = (unsigned)(Rb * S.ldb * Sched::esz + C0 * 2); }
    const size_t hstepB = (size_t)HALF * S.ldb * Sched::esz;
    const unsigned ldsw = (unsigned)wid * 1024u;
    const int aoff = FP8 ? lds_byte(wr * 64 + fr, fq * 16) : lds_byte(wr * 64 + fr, fq * 8), boff = FP8 ? lds_byte(wc * 32 + fr, fq * 16) : lds_byte(wc * 32 + fr, fq * 8);
    const unsigned mxscale = 0x7f7f7f7fu;
    const int kst = FP8 ? 16 : 1024;
    const char* Ab = S.Abase;
#define G8_SA(b, h) (((b) * 2 + (h)) * HTB)
#define G8_SB(b, h) ((4 + (b) * 2 + (h)) * HTB)
#define G8_STAGE_A(bufoff, offs, kb) do { _Pragma("unroll") for (int _i = 0; _i < 2; ++_i) \
        __builtin_amdgcn_global_load_lds((const unsigned*)(Ab + (size_t)(offs)[_i] + (size_t)(kb)), (LAS unsigned*)(lds + (bufoff) + ldsw + _i * 8192), 16, 0, 0); } while (0)
#define G8_STAGE_B(bufoff, gbase, kb) do { _Pragma("unroll") for (int _i = 0; _i < 2; ++_i) \
        __builtin_amdgcn_global_load_lds((const unsigned*)((gbase) + voffB[_i] + (size_t)(kb)), (LAS unsigned*)(lds + (bufoff) + ldsw + _i * 8192), 16, 0, 0); } while (0)
#define G8_LDA(dst, b, h) do { _Pragma("unroll") for (int m = 0; m < 4; ++m) { const i32x4_t _p = *(const LAS i32x4_t*)(lds + G8_SA(b, h) + aoff + m * 2048), _q = *(const LAS i32x4_t*)(lds + G8_SA(b, h) + aoff + m * 2048 + kst); dst[m] = __builtin_shufflevector(_p, _q, 0, 1, 2, 3, 4, 5, 6, 7); } } while (0)
#define G8_LDB(dst, b, h) do { _Pragma("unroll") for (int n = 0; n < 2; ++n) { const i32x4_t _p = *(const LAS i32x4_t*)(lds + G8_SB(b, h) + boff + n * 2048), _q = *(const LAS i32x4_t*)(lds + G8_SB(b, h) + boff + n * 2048 + kst); dst[n] = __builtin_shufflevector(_p, _q, 0, 1, 2, 3, 4, 5, 6, 7); } } while (0)
#define G8_MMA(ai, bj, At, Bt) do { __builtin_amdgcn_s_setprio(1); _Pragma("unroll") for (int m = 0; m < 4; ++m) _Pragma("unroll") for (int n = 0; n < 2; ++n) { \
        if constexpr (FP8) asm volatile("v_mfma_scale_f32_16x16x128_f8f6f4 %0, %1, %2, %0, %3, %3 op_sel_hi:[0,0,0]" : "+v"(acc[ai][bj][m][n]) : "v"(Bt[n]), "v"(At[m]), "v"(mxscale)); \
        else { acc[ai][bj][m][n] = __builtin_amdgcn_mfma_f32_16x16x32_bf16(__builtin_bit_cast(bf16x8, __builtin_shufflevector(Bt[n], Bt[n], 0, 1, 2, 3)), __builtin_bit_cast(bf16x8, __builtin_shufflevector(At[m], At[m], 0, 1, 2, 3)), acc[ai][bj][m][n], 0, 0, 0); \
               acc[ai][bj][m][n] = __builtin_amdgcn_mfma_f32_16x16x32_bf16(__builtin_bit_cast(bf16x8, __builtin_shufflevector(Bt[n], Bt[n], 4, 5, 6, 7)), __builtin_bit_cast(bf16x8, __builtin_shufflevector(At[m], At[m], 4, 5, 6, 7)), acc[ai][bj][m][n], 0, 0, 0); } } \
        __builtin_amdgcn_s_setprio(0); } while (0)
#define G8_WAIT_V(n) asm volatile("s_waitcnt vmcnt(" #n ")" ::: "memory")
#define G8_WAIT_L(n) asm volatile("s_waitcnt lgkmcnt(" #n ")" ::: "memory")
#define G8_BAR __builtin_amdgcn_s_barrier()
#define G8_SCHED __builtin_amdgcn_sched_barrier(0)
    UnitD cur, nxt; int ui = 0;
    if (!S.next(0, cur)) return;
    f32x4 acc[2][2][4][2];
#pragma unroll
    for (int a = 0; a < 2; ++a)
#pragma unroll
        for (int b = 0; b < 2; ++b)
#pragma unroll
            for (int m = 0; m < 4; ++m)
#pragma unroll
                for (int n = 0; n < 2; ++n) acc[a][b][m][n] = (f32x4){0.f, 0.f, 0.f, 0.f};
    typedef int i32x4_t __attribute__((ext_vector_type(4)));
    v8i_t At[4], B0[2], B1[2];
    unsigned cA[2][2];
    S.a_offs(cur, R0, C0, cA);
    const char* cB = cur.Bp;
    G8_STAGE_B(G8_SB(0, 0), cB, 0); G8_STAGE_A(G8_SA(0, 0), cA[0], 0); G8_STAGE_B(G8_SB(0, 1), cB + hstepB, 0); G8_STAGE_A(G8_SA(0, 1), cA[1], 0);
    if (wr == 1) G8_BAR;
    G8_WAIT_V(4); G8_BAR;
    G8_STAGE_B(G8_SB(1, 0), cB, 128); G8_STAGE_A(G8_SA(1, 0), cA[0], 128); G8_STAGE_B(G8_SB(1, 1), cB + hstepB, 128);
    G8_WAIT_V(6); G8_BAR;
    for (;;) {
        const bool has_next = S.next(ui + 1, nxt);
        const char* nB = has_next ? nxt.Bp : cB;
        for (int t = 0; t < nt; t += 2) {
            const bool last = (t == nt - 2);
            const unsigned k1 = (unsigned)(t + 1) * 128u;
            const unsigned k2 = last ? 0u : (unsigned)(t + 2) * 128u, k3 = k2 + 128u;
            unsigned c1[2] = {cA[1][0], cA[1][1]};
            if (last && has_next) S.a_offs(nxt, R0, C0, cA);
            const char* b2 = last ? nB : cB;
            G8_LDB(B0, 0, 0); G8_SCHED; G8_LDA(At, 0, 0); G8_STAGE_A(G8_SA(1, 1), c1, k1);
            G8_WAIT_L(8); G8_BAR; G8_WAIT_L(0); G8_MMA(0, 0, At, B0); G8_BAR; G8_SCHED;
            G8_LDB(B1, 0, 1); G8_STAGE_B(G8_SB(0, 0), b2, k2);
            G8_BAR; G8_WAIT_L(0); G8_MMA(0, 1, At, B1); G8_BAR;
            G8_LDA(At, 0, 1); G8_STAGE_A(G8_SA(0, 0), cA[0], k2);
            G8_BAR; G8_WAIT_L(0); G8_MMA(1, 0, At, B0); G8_BAR; G8_SCHED;
            G8_STAGE_B(G8_SB(0, 1), b2 + hstepB, k2);
            G8_WAIT_V(6); G8_BAR; G8_MMA(1, 1, At, B1); G8_BAR;
            G8_LDB(B0, 1, 0); G8_SCHED; G8_LDA(At, 1, 0); G8_STAGE_A(G8_SA(0, 1), cA[1], k2);
            G8_WAIT_L(8); G8_BAR; G8_WAIT_L(0); G8_MMA(0, 0, At, B0); G8_BAR; G8_SCHED;
            G8_LDB(B1, 1, 1); G8_STAGE_B(G8_SB(1, 0), b2, k3);
            G8_BAR; G8_WAIT_L(0); G8_MMA(0, 1, At, B1); G8_BAR;
            G8_LDA(At, 1, 1); G8_STAGE_A(G8_SA(1, 0), cA[0], k3);
            G8_BAR; G8_WAIT_L(0); G8_MMA(1, 0, At, B0); G8_BAR; G8_SCHED;
            G8_STAGE_B(G8_SB(1, 1), b2 + hstepB, k3);
            G8_WAIT_V(6); G8_BAR; G8_MMA(1, 1, At, B1); G8_BAR;
        }
        if constexpr (FP8) asm volatile("s_nop 15\n\ts_nop 15" ::: "memory");
        E(acc, cur, wr, wc, fr, fq);
        if (!has_next) break;
#pragma unroll
        for (int a = 0; a < 2; ++a)
#pragma unroll
            for (int b = 0; b < 2; ++b)
#pragma unroll
                for (int m = 0; m < 4; ++m)
#pragma unroll
                    for (int n = 0; n < 2; ++n) acc[a][b][m][n] = (f32x4){0.f, 0.f, 0.f, 0.f};
        cur = nxt; cB = nB; ++ui;
    }
    G8_WAIT_V(0);
    if (wr == 0) G8_BAR;
    G8_BAR;
#undef G8_SA
#undef G8_SB
#undef G8_STAGE_A
#undef G8_STAGE_B
#undef G8_LDA
#undef G8_LDB
#undef G8_MMA
#undef G8_WAIT_V
#undef G8_WAIT_L
#undef G8_BAR
#undef G8_SCHED
}
}
using g8::UnitD;
typedef f32x4 Acc[2][2][4][2];

struct EpiIn {
    static constexpr bool PERM = true;
    u16* H; const float* rs1; float* SSQ; float* WI;
    template <int ACT, bool DOSSQ> DI void run(const Acc& acc, const UnitD& u, int wr, int wc, int fr, int fq) const {
        const int pn = u.pn;
        float rsv[2][4];
#pragma unroll
        for (int ai = 0; ai < 2; ++ai)
#pragma unroll
            for (int m = 0; m < 4; ++m) rsv[ai][m] = rs1[u.pm * 256 + ai * 128 + wr * 64 + m * 16 + fr];
        __builtin_amdgcn_sched_barrier(0);
#pragma unroll
        for (int ai = 0; ai < 2; ++ai)
#pragma unroll
            for (int m = 0; m < 4; ++m) {
                const int row = u.pm * 256 + ai * 128 + wr * 64 + m * 16 + fr;
                const float rs = rsv[ai][m];
#pragma unroll
                for (int bj = 0; bj < 2; ++bj) {
                    f32x4 v0 = acc[ai][bj][m][0] * rs, v1 = acc[ai][bj][m][1] * rs;
                    if (ACT == 1) {
#pragma unroll
                        for (int j = 0; j < 4; ++j) { v0[j] = fast_gelu(v0[j]); v1[j] = fast_gelu(v1[j]); }
                    } else if (ACT == 2) {
#pragma unroll
                        for (int j = 0; j < 4; ++j) { v0[j] = fast_sigmoid(v0[j]); v1[j] = fast_sigmoid(v1[j]); }
                    }
                    u32x4 w; w.x = pk2(v0[0], v0[1]); w.y = pk2(v0[2], v0[3]); w.z = pk2(v1[0], v1[1]); w.w = pk2(v1[2], v1[3]);
                    *(u32x4*)(H + (size_t)row * NIN + pn * 256 + bj * 128 + wc * 32 + 8 * fq) = w;
                    if (DOSSQ) {
                        float ssq = ((v0[0] * v0[0] + v0[1] * v0[1]) + (v0[2] * v0[2] + v0[3] * v0[3])) + ((v1[0] * v1[0] + v1[1] * v1[1]) + (v1[2] * v1[2] + v1[3] * v1[3]));
                        ssq += __shfl_xor(ssq, 16); ssq += __shfl_xor(ssq, 32);
                        if (fq == 0) SSQ[(size_t)row * 32 + (pn - 2) * 8 + bj * 4 + wc] = ssq;
                        if (pn == 5 && bj == 1 && wc == 2 && fq == 0) *(f32x4*)(WI + (size_t)row * 4) = v0 * 0.5f;
                    }
                }
            }
    }
    DI void operator()(const Acc& acc, const UnitD& u, int wr, int wc, int fr, int fq) const {
        const int pn = u.pn;
        if (pn < 2) run<1, false>(acc, u, wr, wc, fr, fq);
        else if (pn < 4) run<1, true>(acc, u, wr, wc, fr, fq);
        else if (pn < 6) run<0, true>(acc, u, wr, wc, fr, fq);
        else run<2, false>(acc, u, wr, wc, fr, fq);
    }
};
struct EpiQ {
    static constexpr bool PERM = true;
    u16* Q; u16* QI; const float* SSQ;
    DI void operator()(const Acc& acc, const UnitD& u, int wr, int wc, int fr, int fq) const {
        f32x4 sq[2][4][2];
#pragma unroll
        for (int ai = 0; ai < 2; ++ai)
#pragma unroll
            for (int m = 0; m < 4; ++m) { const int row = u.pm * 256 + ai * 128 + wr * 64 + m * 16 + fr; sq[ai][m][0] = *(const f32x4*)(SSQ + (size_t)row * 32 + 16); sq[ai][m][1] = *(const f32x4*)(SSQ + (size_t)row * 32 + 20); }
        __builtin_amdgcn_sched_barrier(0);
#pragma unroll
        for (int ai = 0; ai < 2; ++ai)
#pragma unroll
            for (int m = 0; m < 4; ++m) {
                const int row = u.pm * 256 + ai * 128 + wr * 64 + m * 16 + fr;
                const f32x4 s0 = sq[ai][m][0], s1 = sq[ai][m][1];
                const float ss = ((s0[0] + s0[1]) + (s0[2] + s0[3])) + ((s1[0] + s1[1]) + (s1[2] + s1[3]));
                const float rs = __builtin_amdgcn_rsqf(ss * (1.0f / 256.0f) + EPS);
#pragma unroll
                for (int bj = 0; bj < 2; ++bj) {
                    const int col = u.pn * 256 + bj * 128 + wc * 32 + 8 * fq;
                    const f32x4 v0 = acc[ai][bj][m][0] * rs, v1 = acc[ai][bj][m][1] * rs;
                    if (col < 1024) { u32x4 w; w.x = pk2(v0[0], v0[1]); w.y = pk2(v0[2], v0[3]); w.z = pk2(v1[0], v1[1]); w.w = pk2(v1[2], v1[3]); *(u32x4*)(Q + (size_t)row * 1024 + col) = w; }
                    else { u32x2 w; w.x = pk4_i8(v0[0], v0[1], v0[2], v0[3]); w.y = pk4_i8(v1[0], v1[1], v1[2], v1[3]); *(u32x2*)((unsigned char*)QI + (size_t)row * 256 + (col - 1024)) = w; }
                }
            }
    }
};
template <int SECOND> struct EpiMrg {
    static constexpr bool PERM = true;
    u16* OUT; const u16* TMP; const u16* H;
    DI void operator()(const Acc& acc, const UnitD& u, int wr, int wc, int fr, int fq) const {
#pragma unroll
        for (int ai = 0; ai < 2; ++ai) {
            u32x4 g[4][2], tp[4][2];
#pragma unroll
            for (int m = 0; m < 4; ++m)
#pragma unroll
                for (int bj = 0; bj < 2; ++bj) {
                    const int row = u.pm * 256 + ai * 128 + wr * 64 + m * 16 + fr, col = u.pn * 256 + bj * 128 + wc * 32 + 8 * fq;
                    g[m][bj] = *(const u32x4*)(H + (size_t)row * NIN + 1536 + SECOND * 1024 + col);
                    if (SECOND) tp[m][bj] = *(const u32x4*)(TMP + (size_t)row * 1024 + col);
                }
            __builtin_amdgcn_sched_barrier(0);
#pragma unroll
            for (int m = 0; m < 4; ++m)
#pragma unroll
                for (int bj = 0; bj < 2; ++bj) {
                    const int row = u.pm * 256 + ai * 128 + wr * 64 + m * 16 + fr, col = u.pn * 256 + bj * 128 + wc * 32 + 8 * fq;
                    const u32x4 gg = g[m][bj];
                    f32x4 v0 = acc[ai][bj][m][0], v1 = acc[ai][bj][m][1];
                    v0[0] *= bflo(gg.x); v0[1] *= bfhi(gg.x); v0[2] *= bflo(gg.y); v0[3] *= bfhi(gg.y); v1[0] *= bflo(gg.z); v1[1] *= bfhi(gg.z); v1[2] *= bflo(gg.w); v1[3] *= bfhi(gg.w);
                    if (SECOND) { const u32x4 t = tp[m][bj];
                        v0[0] += bflo(t.x); v0[1] += bfhi(t.x); v0[2] += bflo(t.y); v0[3] += bfhi(t.y); v1[0] += bflo(t.z); v1[1] += bfhi(t.z); v1[2] += bflo(t.w); v1[3] += bfhi(t.w); }
                    u32x4 w; w.x = pk2(v0[0], v0[1]); w.y = pk2(v0[2], v0[3]); w.z = pk2(v1[0], v1[1]); w.w = pk2(v1[2], v1[3]);
                    *(u32x4*)(OUT + (size_t)row * 1024 + col) = w;
                }
            __builtin_amdgcn_sched_barrier(0);
        }
    }
};
struct EpiOut {
    static constexpr bool PERM = false;
    float* out; const float* x;
    DI void operator()(const Acc& acc, const UnitD& u, int wr, int wc, int fr, int fq) const {
#pragma unroll
        for (int ai = 0; ai < 2; ++ai) {
            f32x4 xv[4][2][2];
#pragma unroll
            for (int m = 0; m < 4; ++m)
#pragma unroll
                for (int bj = 0; bj < 2; ++bj)
#pragma unroll
                    for (int n = 0; n < 2; ++n)
                        xv[m][bj][n] = *(const f32x4*)(x + (size_t)(u.pm * 256 + ai * 128 + wr * 64 + m * 16 + fr) * 1024 + u.pn * 256 + bj * 128 + wc * 32 + n * 16 + 4 * fq);
            __builtin_amdgcn_sched_barrier(0);
#pragma unroll
            for (int m = 0; m < 4; ++m)
#pragma unroll
                for (int bj = 0; bj < 2; ++bj)
#pragma unroll
                    for (int n = 0; n < 2; ++n)
                        *(f32x4*)(out + (size_t)(u.pm * 256 + ai * 128 + wr * 64 + m * 16 + fr) * 1024 + u.pn * 256 + bj * 128 + wc * 32 + n * 16 + 4 * fq) = xv[m][bj][n] + acc[ai][bj][m][n];
            __builtin_amdgcn_sched_barrier(0);
        }
    }
};

constexpr int MOE_TAB = g8::STAGE_BYTES;
DI void moe_table(LAS unsigned char* lds, const unsigned* CNT) {
    LAS int* tab = (LAS int*)(lds + MOE_TAB);
    __syncthreads();
    if (threadIdx.x == 0) { int acc = 0; for (int e = 0; e < NE; ++e) { const int c = (int)__hip_atomic_load(CNT + e, __ATOMIC_RELAXED, __HIP_MEMORY_SCOPE_AGENT); tab[e] = acc; tab[33 + e] = c; acc += (c + 255) >> 8; } tab[32] = acc; }
    __syncthreads();
}
template <int NPN, bool GATHER> struct MoeSched {
    const char* Abase; const char* Wbase; const int* LTOK; LAS const int* tab; int lda, ldb, K, G, c; size_t wstride; static constexpr int esz = 1;
    DI bool next(int i, UnitD& u) const {
        const long L = (long)i * G + c; const int R = tab[32];
        if (L >= (long)R * NPN) return false;
        const int rbg = (int)(L / NPN), pn = (int)(L % NPN);
        int e = 0;
        for (int j = 1; j < NE; ++j) e += (tab[j] <= rbg) ? 1 : 0;
        e = __builtin_amdgcn_readfirstlane(e);
        u.pm = rbg; u.pn = pn; u.e = e; u.rb = rbg - tab[e];
        u.Bp = Wbase + (size_t)e * wstride + (size_t)pn * 256 * ldb * esz;
        return true;
    }
    DI void a_offs(const UnitD& u, int R0, int C0, unsigned (&o)[2][2]) const {
        const int cnt = tab[33 + u.e];
#pragma unroll
        for (int h = 0; h < 2; ++h)
#pragma unroll
            for (int i = 0; i < 2; ++i) {
                const int r = h * 128 + R0 + 64 * i;
                if (GATHER) { const int slot = u.rb * 256 + r; const int tok = slot < cnt ? LTOK[(size_t)u.e * ECAP + slot] : 0; o[h][i] = (unsigned)((size_t)tok * lda * esz + C0 * 2); }
                else o[h][i] = (unsigned)((size_t)(u.pm * 256 + r) * lda * esz + C0 * 2);
            }
    }
};
struct EpiMoe1 {
    static constexpr bool PERM = true;
    unsigned char* ACT; const float* b1;
    DI void operator()(const Acc& acc, const UnitD& u, int wr, int wc, int fr, int fq) const {
        const float* be = b1 + (size_t)u.e * 2048;
        const int hc = u.pn * 128 + wc * 32 + 8 * fq;
        const f32x4 bg0 = *(const f32x4*)(be + hc), bg1 = *(const f32x4*)(be + hc + 4), bu0 = *(const f32x4*)(be + 1024 + hc), bu1 = *(const f32x4*)(be + 1024 + hc + 4);
        __builtin_amdgcn_sched_barrier(0);
#pragma unroll
        for (int ai = 0; ai < 2; ++ai)
#pragma unroll
            for (int m = 0; m < 4; ++m) {
                const int row = u.pm * 256 + ai * 128 + wr * 64 + m * 16 + fr;
                float av[8];
#pragma unroll
                for (int n = 0; n < 2; ++n) {
                    const f32x4 g = acc[ai][0][m][n] * 0.015625f + (n ? bg1 : bg0), up = acc[ai][1][m][n] * 0.015625f + (n ? bu1 : bu0);
#pragma unroll
                    for (int j = 0; j < 4; ++j) {
                        const float hg = fminf(g[j], 7.0f), hu = __builtin_amdgcn_fmed3f(up[j], -7.0f, 7.0f);
                        av[4 * n + j] = (hu + 1.0f) * (hg * __builtin_amdgcn_rcpf(1.0f + __builtin_amdgcn_exp2f(hg * -2.4554669595930157f)));
                    }
                }
                u32x2 w; w.x = pk4_fp8(av[0], av[1], av[2], av[3]); w.y = pk4_fp8(av[4], av[5], av[6], av[7]);
                *(u32x2*)(ACT + (size_t)row * 1024 + hc) = w;
            }
    }
};
struct EpiMoe2 {
    static constexpr bool PERM = true;
    u16* YB; const float* b2; const float* LGATE; LAS const int* tab;
    DI void operator()(const Acc& acc, const UnitD& u, int wr, int wc, int fr, int fq) const {
        const float* be = b2 + (size_t)u.e * 1024; const int cnt = tab[33 + u.e];
        float gate[2][4]; f32x4 bias[2][2];
#pragma unroll
        for (int ai = 0; ai < 2; ++ai)
#pragma unroll
            for (int m = 0; m < 4; ++m) { const int slot = u.rb * 256 + ai * 128 + wr * 64 + m * 16 + fr; gate[ai][m] = slot < cnt ? LGATE[(size_t)u.e * ECAP + slot] : 0.f; }
#pragma unroll
        for (int bj = 0; bj < 2; ++bj) { const int col = u.pn * 256 + bj * 128 + wc * 32 + 8 * fq; bias[bj][0] = *(const f32x4*)(be + col); bias[bj][1] = *(const f32x4*)(be + col + 4); }
        __builtin_amdgcn_sched_barrier(0);
#pragma unroll
        for (int ai = 0; ai < 2; ++ai)
#pragma unroll
            for (int m = 0; m < 4; ++m) {
                const int r = ai * 128 + wr * 64 + m * 16 + fr;
                const float gt = gate[ai][m];
#pragma unroll
                for (int bj = 0; bj < 2; ++bj) {
                    const int col = u.pn * 256 + bj * 128 + wc * 32 + 8 * fq;
                    const f32x4 v0 = (acc[ai][bj][m][0] * 0.015625f + bias[bj][0]) * gt, v1 = (acc[ai][bj][m][1] * 0.015625f + bias[bj][1]) * gt;
                    u32x4 w; w.x = pk2(v0[0], v0[1]); w.y = pk2(v0[2], v0[3]); w.z = pk2(v1[0], v1[1]); w.w = pk2(v1[2], v1[3]);
                    *(u32x4*)(YB + (size_t)(u.pm * 256 + r) * 1024 + col) = w;
                }
            }
    }
};

template <bool FP8 = false, class F> DI void tr_tile(LAS unsigned char* lds, const float* src, int ld_src, int Nsz, int k0, int n0, const float* sk, float mul, u16* dst, int ld_dst, F rowmap) {
    LAS float* t = (LAS float*)lds;
    const int tid = otid();
    __syncthreads();
#pragma unroll
    for (int it = 0; it < 2; ++it) {
        const int k = (tid >> 4) + 32 * it, n = 4 * (tid & 15);
        f32x4 v = {0.f, 0.f, 0.f, 0.f};
        if (n0 + n < Nsz) v = *(const f32x4*)(src + (size_t)(k0 + k) * ld_src + n0 + n);
        const float s = (sk ? sk[k0 + k] : 1.0f) * mul;
        t[k * 65 + n] = v[0] * s; t[k * 65 + n + 1] = v[1] * s; t[k * 65 + n + 2] = v[2] * s; t[k * 65 + n + 3] = v[3] * s;
    }
    __syncthreads();
    const int n = tid >> 3, kc = (tid & 7) * 8;
    if (FP8) {
        if (n0 + n < Nsz) {
            u32x2 w;
            w.x = pk4_fp8(t[(kc + 0) * 65 + n], t[(kc + 1) * 65 + n], t[(kc + 2) * 65 + n], t[(kc + 3) * 65 + n]);
            w.y = pk4_fp8(t[(kc + 4) * 65 + n], t[(kc + 5) * 65 + n], t[(kc + 6) * 65 + n], t[(kc + 7) * 65 + n]);
            *(u32x2*)((unsigned char*)dst + (size_t)rowmap(n0 + n) * ld_dst + k0 + kc) = w;
        }
    } else if (n0 + n < Nsz) {
        u32x4 w;
        w.x = pk2(t[(kc + 0) * 65 + n], t[(kc + 1) * 65 + n]); w.y = pk2(t[(kc + 2) * 65 + n], t[(kc + 3) * 65 + n]);
        w.z = pk2(t[(kc + 4) * 65 + n], t[(kc + 5) * 65 + n]); w.w = pk2(t[(kc + 6) * 65 + n], t[(kc + 7) * 65 + n]);
        *(u32x4*)(dst + (size_t)rowmap(n0 + n) * ld_dst + k0 + kc) = w;
    }
}
struct MapId { DI int operator()(int n) const { return n; } };
struct MapIn { DI int operator()(int n) const { return n < 1476 ? n : n + 60; } };
struct MapE1 { DI int operator()(int n) const { const int hi = n >= 1024 ? 1 : 0, q = n - hi * 1024; return (q >> 7) * 256 + hi * 128 + (q & 127); } };

DI void phase0(const Args& a, LAS unsigned char* lds) {
    unsigned char* ws = a.ws;
    const int tid = otid();
    const size_t gtid = (size_t)blockIdx.x * NT + tid, gstride = (size_t)gridDim.x * NT;
    for (size_t i = gtid; i < 60 * 1024 / 2; i += gstride) ((unsigned*)(ws + WS_WIN + (size_t)1476 * 1024 * 2))[i] = 0u;
    for (size_t i = gtid; i < 32 * 1024; i += gstride) { const int e = (int)(i >> 10), k = (int)(i & 1023); const float w = a.in[I_WR][k * 32 + e] * a.in[I_N2G][k]; const u16 h = f2bf(w); ((u16*)(ws + WS_WR))[i] = h; ((u16*)(ws + WS_WR))[32 * 1024 + i] = f2bf(w - bf2f(h)); }
    for (size_t i = gtid; i < 4 * 128 * 128; i += gstride) { const int tt = (int)((i >> 7) & 127), ss = (int)(i & 127); ((u16*)(ws + WS_WSP))[i] = f2bf(ss <= tt ? a.in[I_WSP][i] : 0.f); }
    {
        const int wid = tid >> 6, lane = tid & 63;
        for (int row = blockIdx.x * 8 + wid; row < T; row += gridDim.x * 8) {
            const float* xr = a.in[I_X] + (size_t)row * 1024; u16* xb = (u16*)(ws + WS_XB) + (size_t)row * 1024;
            float ss = 0.f;
#pragma unroll
            for (int i = 0; i < 4; ++i) {
                const f32x4 v = *(const f32x4*)(xr + i * 256 + lane * 4);
                ss += (v[0] * v[0] + v[1] * v[1]) + (v[2] * v[2] + v[3] * v[3]);
                u32x2 w; w.x = pk2(v[0], v[1]); w.y = pk2(v[2], v[3]);
                *(u32x2*)(xb + i * 256 + lane * 4) = w;
            }
#pragma unroll
            for (int o = 32; o >= 1; o >>= 1) ss += __shfl_xor(ss, o);
            if (lane == 0) ((float*)(ws + WS_RS1))[row] = __builtin_amdgcn_rsqf(ss * (1.0f / 1024.0f) + EPS);
        }
    }
    constexpr int U_IN = 16 * 56, U_UQ = 4 * 16, U_QI = 4 * 4, U_PA = 8 * 16, U_OUT = 16 * 16, U_E1 = 32 * 16 * 32, U_E2 = 32 * 16 * 16, U_CB = 64;
    constexpr int U_TOT = U_IN + U_UQ + U_QI + U_PA + U_OUT + U_E1 + U_E2 + U_CB;
    for (int u = blockIdx.x; u < U_TOT; u += gridDim.x) {
        int v = u;
        if (v < U_IN) { tr_tile(lds, a.in[I_WIN], 3524, 3524, (v & 15) * 64, (v >> 4) * 64, a.in[I_N1G], 1.0f, (u16*)(ws + WS_WIN), 1024, MapIn()); continue; }
        v -= U_IN;
        if (v < U_UQ) { tr_tile(lds, a.in[I_WUQ], 1024, 1024, (v & 3) * 64, (v >> 2) * 64, a.in[I_QLG], 1.0f, (u16*)(ws + WS_WQ), 256, MapId()); continue; }
        v -= U_UQ;
        if (v < U_QI) { tr_tile(lds, a.in[I_WQI], 256, 256, (v & 3) * 64, (v >> 2) * 64, a.in[I_QLG], 1.0f, (u16*)(ws + WS_WQ) + 1024 * 256, 256, MapId()); continue; }
        v -= U_QI;
        if (v < U_PA) { tr_tile(lds, a.in[I_WPA], 1024, 1024, (v & 7) * 64, (v >> 3) * 64, nullptr, 1.0f, (u16*)(ws + WS_WCAT), 1536, MapId()); continue; }
        v -= U_PA;
        if (v < U_OUT) { tr_tile(lds, a.in[I_WOUT], 1024, 1024, (v & 15) * 64, (v >> 4) * 64, nullptr, 1.0f, (u16*)(ws + WS_WOUT), 1024, MapId()); continue; }
        v -= U_OUT;
        if (v < U_E1) { const int e = v >> 9, w = v & 511; tr_tile<true>(lds, a.in[I_WE1] + (size_t)e * 1024 * 2048, 2048, 2048, (w & 15) * 64, (w >> 4) * 64, a.in[I_N2G], 64.0f, (u16*)(ws + WS_WE1 + (size_t)e * 2048 * 1024), 1024, MapE1()); continue; }
        v -= U_E1;
        if (v < U_E2) { const int e = v >> 8, w = v & 255; tr_tile<true>(lds, a.in[I_WE2] + (size_t)e * 1024 * 1024, 1024, 1024, (w & 15) * 64, (w >> 4) * 64, nullptr, 64.0f, (u16*)(ws + WS_WE2 + (size_t)e * 1024 * 1024), 1024, MapId()); continue; }
        v -= U_E2;
        {
            const int h = v >> 3, c0 = (v & 7) * 16;
            LAS float* t = (LAS float*)lds;
            __syncthreads();
            for (int i = tid; i < 1024; i += NT) t[i] = a.in[I_WUV][(size_t)h * 128 * 64 + (size_t)c0 * 64 + i];
            __syncthreads();
            for (int nn = tid; nn < 1024; nn += NT) {
                float accv[16];
#pragma unroll
                for (int i = 0; i < 16; ++i) accv[i] = 0.f;
                for (int vv = 0; vv < 64; ++vv) {
                    const float pb = a.in[I_WPB][(size_t)(h * 64 + vv) * 1024 + nn];
#pragma unroll
                    for (int i = 0; i < 16; ++i) accv[i] += t[i * 64 + vv] * pb;
                }
                u32x4 w0, w1;
                w0.x = pk2(accv[0], accv[1]); w0.y = pk2(accv[2], accv[3]); w0.z = pk2(accv[4], accv[5]); w0.w = pk2(accv[6], accv[7]);
                w1.x = pk2(accv[8], accv[9]); w1.y = pk2(accv[10], accv[11]); w1.z = pk2(accv[12], accv[13]); w1.w = pk2(accv[14], accv[15]);
                u16* d = (u16*)(ws + WS_WCAT) + (size_t)nn * 1536 + 512 + h * 128 + c0;
                *(u32x4*)d = w0; *(u32x4*)(d + 8) = w1;
            }
        }
    }
}

DI void gmlp_unit(const Args& a, LAS unsigned char* lds, int u) {
    unsigned char* ws = a.ws;
    const int tid = otid(), wid = tid >> 6, lane = tid & 63, fr = lane & 15, fq = lane >> 4;
    const int g = u & 3, row0 = (u >> 2) * 128;
    const u16* H = (const u16*)(ws + WS_H);
    LAS u16* img = (LAS u16*)lds;
    __syncthreads();
    {
        const int s = tid & 127, cset = tid >> 7;
        const f32x4 sq = *(const f32x4*)((const float*)(ws + WS_SSQ) + (size_t)(row0 + s) * 32 + g * 4);
        const float rs = __builtin_amdgcn_rsqf(((sq[0] + sq[1]) + (sq[2] + sq[3])) * (1.0f / 128.0f) + EPS);
#pragma unroll
        for (int it = 0; it < 4; ++it) {
            const int c = cset + 4 * it;
            const u32x4 raw = *(const u32x4*)(H + (size_t)(row0 + s) * NIN + 512 + g * 128 + 8 * c);
            const float* vg = a.in[I_VG] + 8 * c;
            float f[8] = {bflo(raw.x), bfhi(raw.x), bflo(raw.y), bfhi(raw.y), bflo(raw.z), bfhi(raw.z), bflo(raw.w), bfhi(raw.w)};
#pragma unroll
            for (int i = 0; i < 8; ++i) img[(8 * c + i) * 136 + s] = f2bf(f[i] * rs * vg[i]);
        }
    }
    __syncthreads();
    const u16* W = (const u16*)(ws + WS_WSP) + (size_t)g * 128 * 128 + (size_t)(16 * wid + fr) * 128;
    f32x4 acc[8];
#pragma unroll
    for (int i = 0; i < 8; ++i) acc[i] = (f32x4){0.f, 0.f, 0.f, 0.f};
    const int nks = (16 * wid + 15) / 32 + 1;
    for (int ks = 0; ks < nks; ++ks) {
        const bf16x8 bw = *(const bf16x8*)(W + ks * 32 + 8 * fq);
#pragma unroll
        for (int i = 0; i < 8; ++i) {
            const bf16x8 av = *(const LAS bf16x8*)(img + (16 * i + fr) * 136 + ks * 32 + 8 * fq);
            acc[i] = __builtin_amdgcn_mfma_f32_16x16x32_bf16(av, bw, acc[i], 0, 0, 0);
        }
    }
    const int t = 16 * wid + fr;
    const float bias = a.in[I_BSP][g * 128 + t];
    u16* YO = (u16*)(ws + WS_YO);
#pragma unroll
    for (int i = 0; i < 8; ++i) {
        const int d = 16 * i + 4 * fq;
        const u32x2 uu = *(const u32x2*)(H + (size_t)(row0 + t) * NIN + g * 128 + d);
        const float y0 = bflo(uu.x) * (acc[i][0] + bias), y1 = bfhi(uu.x) * (acc[i][1] + bias), y2 = bflo(uu.y) * (acc[i][2] + bias), y3 = bfhi(uu.y) * (acc[i][3] + bias);
        u32x2 w; w.x = pk2(y0, y1); w.y = pk2(y2, y3);
        *(u32x2*)(YO + (size_t)(row0 + t) * 1536 + g * 128 + d) = w;
    }
}

DI void kvnorm(const Args& a) {
    unsigned char* ws = a.ws;
    const u16* H = (const u16*)(ws + WS_H); const float* SSQ = (const float*)(ws + WS_SSQ);
    const size_t gtid = (size_t)blockIdx.x * NT + otid(), gstride = (size_t)gridDim.x * NT;
    for (size_t idx = gtid; idx < (size_t)T * 24; idx += gstride) {
        const int row = (int)(idx / 24), c = (int)(idx % 24);
        const u16* src; u16* dst; const float* gain; float rs;
        if (c < 16) {
            const f32x4 sq = *(const f32x4*)(SSQ + (size_t)row * 32 + 24);
            rs = __builtin_amdgcn_rsqf(((sq[0] + sq[1]) + (sq[2] + sq[3])) * (1.0f / 128.0f) + EPS);
            src = H + (size_t)row * NIN + 1280 + 8 * c; dst = (u16*)(ws + WS_KVN) + (size_t)row * 128 + 8 * c; gain = a.in[I_KVG] + 8 * c;
        } else {
            const int cc = c - 16;
            rs = __builtin_amdgcn_rsqf((SSQ[(size_t)row * 32 + 28] + SSQ[(size_t)row * 32 + 29]) * (1.0f / 64.0f) + EPS);
            src = H + (size_t)row * NIN + 1408 + 8 * cc; dst = nullptr; gain = a.in[I_KIG] + 8 * cc;
            const u32x4 raw = *(const u32x4*)src;
            u32x2 w8;
            w8.x = pk4_i8(bflo(raw.x) * rs * gain[0], bfhi(raw.x) * rs * gain[1], bflo(raw.y) * rs * gain[2], bfhi(raw.y) * rs * gain[3]);
            w8.y = pk4_i8(bflo(raw.z) * rs * gain[4], bfhi(raw.z) * rs * gain[5], bflo(raw.w) * rs * gain[6], bfhi(raw.w) * rs * gain[7]);
            *(u32x2*)(ws + WS_KIN + (size_t)row * 64 + 8 * cc) = w8;
            continue;
        }
        const u32x4 raw = *(const u32x4*)src;
        u32x4 w;
        w.x = pk2(bflo(raw.x) * rs * gain[0], bfhi(raw.x) * rs * gain[1]); w.y = pk2(bflo(raw.y) * rs * gain[2], bfhi(raw.y) * rs * gain[3]);
        w.z = pk2(bflo(raw.z) * rs * gain[4], bfhi(raw.z) * rs * gain[5]); w.w = pk2(bflo(raw.w) * rs * gain[6], bfhi(raw.w) * rs * gain[7]);
        *(u32x4*)dst = w;
    }
}

constexpr int P3_ROWS = 0, P3_HIST = 131072, P3_LIST = 147456;
DI unsigned f2key(float f) { const unsigned u = __float_as_uint(f); return (u & 0x80000000u) ? ~u : (u | 0x80000000u); }
DI int wave_incl_scan(int v, int lane) {
#pragma unroll
    for (int o = 1; o < 64; o <<= 1) { const int t = __shfl_up(v, o); if (lane >= o) v += t; }
    return v;
}
DI int wave_suffix_scan(int v, int lane) {
#pragma unroll
    for (int o = 1; o < 64; o <<= 1) { const int t = __shfl_down(v, o); if (lane + o < 64) v += t; }
    return v;
}
DI unsigned pk_gt(unsigned kw, unsigned xw, unsigned one) {
    unsigned d, m;
    asm("v_pk_sub_u16 %0, %1, %2 clamp" : "=v"(d) : "v"(kw), "v"(xw));
    asm("v_pk_min_u16 %0, %1, %2" : "=v"(m) : "v"(d), "v"(one));
    return m;
}
DI unsigned pk_subs(unsigned kw, unsigned xw) { unsigned d; asm("v_pk_sub_u16 %0, %1, %2 clamp" : "=v"(d) : "v"(kw), "v"(xw)); return d; }
DI unsigned pk_min1(unsigned d, unsigned one) { unsigned m; asm("v_pk_min_u16 %0, %1, %2" : "=v"(m) : "v"(d), "v"(one)); return m; }
DI unsigned pk_max(unsigned a, unsigned b) { unsigned r; asm("v_pk_max_u16 %0, %1, %2" : "=v"(r) : "v"(a), "v"(b)); return r; }
DI unsigned pk_add(unsigned a, unsigned b) { unsigned r; asm("v_pk_add_u16 %0, %1, %2" : "=v"(r) : "v"(a), "v"(b)); return r; }
DI int wave_sum(int v) {
    v += __builtin_amdgcn_update_dpp(0, v, 0xB1, 0xf, 0xf, false);
    v += __builtin_amdgcn_update_dpp(0, v, 0x4E, 0xf, 0xf, false);
    v += __builtin_amdgcn_update_dpp(0, v, 0x141, 0xf, 0xf, false);
    v += __builtin_amdgcn_update_dpp(0, v, 0x140, 0xf, 0xf, false);
    return __builtin_amdgcn_readlane(v, 0) + __builtin_amdgcn_readlane(v, 16) + __builtin_amdgcn_readlane(v, 32) + __builtin_amdgcn_readlane(v, 48);
}
DI int rowaddr(int p) { return (p & ~511) | ((p & 63) << 3) | ((p >> 6) & 7); }
typedef unsigned short us2_t __attribute__((ext_vector_type(2)));
DI unsigned dot2acc(unsigned flags, unsigned wts, unsigned acc) { return __builtin_amdgcn_udot2(__builtin_bit_cast(us2_t, flags), __builtin_bit_cast(us2_t, wts), acc, false); }
DI void keys_load(LAS u16* row, int N, int lane, u32x4 (&kr)[16]) {
    const int Nup = (N + 511) & ~511, niter = Nup >> 9;
    for (int p = N + lane; p < Nup; p += 64) row[rowaddr(p)] = (u16)0;
    wave_lds_sync();
#pragma unroll
    for (int i = 0; i < 16; ++i) { kr[i] = (u32x4){0u, 0u, 0u, 0u}; if (i < niter) kr[i] = *(LAS const u32x4*)(row + i * 512 + lane * 8); }
    wave_lds_sync();
}
DI void keys_select(const u32x4 (&kr)[16], LAS u16* list, int N, int lane) {
    const int Nup = (N + 511) & ~511, niter = Nup >> 9;
    const unsigned one = 0x00010001u;
    auto count_gt = [&](unsigned x) -> int {
        const unsigned xw = x | (x << 16);
        unsigned acc = 0u, acc1 = 0u, acc2 = 0u, acc3 = 0u;
#pragma unroll
        for (int c = 0; c < 4; ++c) {
            if (4 * c < niter) {
#pragma unroll
                for (int h = 0; h < 2; ++h) {
                    unsigned d[8];
#pragma unroll
                    for (int i = 0; i < 2; ++i) { const u32x4 kk = kr[4 * c + 2 * h + i]; d[4 * i] = pk_subs(kk.x, xw); d[4 * i + 1] = pk_subs(kk.y, xw); d[4 * i + 2] = pk_subs(kk.z, xw); d[4 * i + 3] = pk_subs(kk.w, xw); }
#pragma unroll
                    for (int i = 0; i < 8; ++i) d[i] = pk_min1(d[i], one);
#pragma unroll
                    for (int i = 0; i < 8; i += 4) { acc = dot2acc(d[i], one, acc); acc1 = dot2acc(d[i + 1], one, acc1); acc2 = dot2acc(d[i + 2], one, acc2); acc3 = dot2acc(d[i + 3], one, acc3); }
                }
            }
        }
        return wave_sum((int)((acc + acc1) + (acc2 + acc3)));
    };
    unsigned T = 0u; int cge = Nup, topbit = 15;
    {
        unsigned mx = 0u;
#pragma unroll
        for (int c = 0; c < 4; ++c) {
            if (4 * c < niter) {
#pragma unroll
                for (int i = 4 * c; i < 4 * c + 4; ++i) { mx = pk_max(mx, kr[i].x); mx = pk_max(mx, kr[i].y); mx = pk_max(mx, kr[i].z); mx = pk_max(mx, kr[i].w); }
            }
        }
        unsigned m1 = max(mx & 0xffffu, mx >> 16);
        m1 = max(m1, (unsigned)__builtin_amdgcn_update_dpp(0, (int)m1, 0xB1, 0xf, 0xf, false)); m1 = max(m1, (unsigned)__builtin_amdgcn_update_dpp(0, (int)m1, 0x4E, 0xf, 0xf, false));
        m1 = max(m1, (unsigned)__builtin_amdgcn_update_dpp(0, (int)m1, 0x141, 0xf, 0xf, false)); m1 = max(m1, (unsigned)__builtin_amdgcn_update_dpp(0, (int)m1, 0x140, 0xf, 0xf, false));
        const unsigned kmax = max(max((unsigned)__builtin_amdgcn_readlane((int)m1, 0), (unsigned)__builtin_amdgcn_readlane((int)m1, 16)), max((unsigned)__builtin_amdgcn_readlane((int)m1, 32), (unsigned)__builtin_amdgcn_readlane((int)m1, 48)));
        if (kmax > 1024u) {
            const unsigned lo = kmax - 1023u;
            const int clo = count_gt(lo - 1u);
            if (clo >= 256) { T = lo; cge = clo; topbit = 9; }
        }
    }
#pragma unroll 1
    for (int bit = topbit; bit >= 0; --bit) {
        const unsigned cand = topbit == 15 ? (T | (1u << bit)) : (T + (1u << bit));
        if (cand > 0xffffu) continue;
        const int cnt = count_gt(cand - 1u);
        if (cnt >= 256) { T = cand; cge = cnt; }
    }
    auto build = [&](unsigned x, unsigned (&M)[4]) {
        const unsigned xw = x | (x << 16);
#pragma unroll
        for (int c = 0; c < 4; ++c) {
            M[c] = 0u;
            if (4 * c < niter) {
#pragma unroll
                for (int i = 4 * c; i < 4 * c + 4; ++i) {
                    unsigned byte = dot2acc(pk_gt(kr[i].x, xw, one), 0x00020001u, 0u);
                    byte = dot2acc(pk_gt(kr[i].y, xw, one), 0x00080004u, byte);
                    byte = dot2acc(pk_gt(kr[i].z, xw, one), 0x00200010u, byte);
                    byte = dot2acc(pk_gt(kr[i].w, xw, one), 0x00800040u, byte);
                    M[c] |= byte << (8 * (i & 3));
                }
            }
        }
    };
    unsigned M[4];
    build(T - 1u, M);
    if (cge != 256) {
        unsigned G[4]; build(T, G);
        unsigned E[4];
#pragma unroll
        for (int c = 0; c < 4; ++c) E[c] = M[c] & ~G[c];
        const int need = 256 - (cge - wave_sum((int)(__builtin_popcount(E[0]) + __builtin_popcount(E[1]) + __builtin_popcount(E[2]) + __builtin_popcount(E[3]))));
        auto below = [&](int B, int c) -> unsigned { const int nb = B - 32 * c; return nb <= 0 ? 0u : (nb >= 32 ? 0xffffffffu : ((1u << nb) - 1u)); };
        auto ties_below = [&](int B) -> int {
            return wave_sum((int)(__builtin_popcount(E[0] & below(B, 0)) + __builtin_popcount(E[1] & below(B, 1)) + __builtin_popcount(E[2] & below(B, 2)) + __builtin_popcount(E[3] & below(B, 3))));
        };
        int lo = 0, hi = 127;
#pragma unroll 1
        while (lo < hi) { const int mid = (lo + hi) >> 1; if (ties_below(mid + 1) >= need) hi = mid; else lo = mid + 1; }
        const int Bs = lo, r = need - ties_below(Bs);
        const unsigned ew = Bs < 32 ? E[0] : (Bs < 64 ? E[1] : (Bs < 96 ? E[2] : E[3]));
        const bool tb = ((ew >> (Bs & 31)) & 1u) != 0u;
        const unsigned long long em = __ballot(tb);
        const bool take_row = tb && __builtin_popcountll(em & ((1ull << lane) - 1ull)) < r;
#pragma unroll
        for (int c = 0; c < 4; ++c) {
            unsigned tk = E[c] & below(Bs, c);
            if ((Bs >> 5) == c && take_row) tk |= 1u << (Bs & 31);
            M[c] = G[c] | tk;
        }
    }
    const int kl = __builtin_popcount(M[0]) + __builtin_popcount(M[1]) + __builtin_popcount(M[2]) + __builtin_popcount(M[3]);
    int wp = wave_incl_scan(kl, lane) - kl;
#pragma unroll
    for (int c = 0; c < 4; ++c) {
        unsigned m = M[c];
        while (m) { const int b = __builtin_ctz(m); list[wp] = (u16)((32 * c + b) * 64 + lane); ++wp; m &= m - 1u; }
    }
}

DI void attend(const Args& a, size_t brow, int t, int cnt, LAS const u16* list, LAS unsigned char* img, int lane, int fr, int fq) {
    const u16* Q = (const u16*)(a.ws + WS_Q); const u16* KVN = (const u16*)(a.ws + WS_KVN); u16* YO = (u16*)(a.ws + WS_YO);
    bf16x8 qf[4];
    {
        const int head = fr & 7;
        const u16* qrow = Q + (brow + t) * 1024 + head * 128;
        float f[4][8]; float ss = 0.f;
#pragma unroll
        for (int ks = 0; ks < 4; ++ks) {
            const u32x4 raw = *(const u32x4*)(qrow + ks * 32 + 8 * fq);
            f[ks][0] = bflo(raw.x); f[ks][1] = bfhi(raw.x); f[ks][2] = bflo(raw.y); f[ks][3] = bfhi(raw.y); f[ks][4] = bflo(raw.z); f[ks][5] = bfhi(raw.z); f[ks][6] = bflo(raw.w); f[ks][7] = bfhi(raw.w);
#pragma unroll
            for (int j = 0; j < 8; ++j) ss += f[ks][j] * f[ks][j];
        }
        ss += __shfl_xor(ss, 16); ss += __shfl_xor(ss, 32);
        const float rq = __builtin_amdgcn_rsqf(ss * (1.0f / 128.0f) + EPS) * (0.08838834764831845f * 1.4426950408889634f);
#pragma unroll
        for (int ks = 0; ks < 4; ++ks) {
            const float* qg = a.in[I_QNG] + ks * 32 + 8 * fq;
            u32x4 w;
            w.x = pk2(f[ks][0] * rq * qg[0], f[ks][1] * rq * qg[1]); w.y = pk2(f[ks][2] * rq * qg[2], f[ks][3] * rq * qg[3]);
            w.z = pk2(f[ks][4] * rq * qg[4], f[ks][5] * rq * qg[5]); w.w = pk2(f[ks][6] * rq * qg[6], f[ks][7] * rq * qg[7]);
            qf[ks] = __builtin_bit_cast(bf16x8, w);
        }
    }
    const int nsteps = (cnt + 31) >> 5;
    f32x4 oacc[8];
#pragma unroll
    for (int i = 0; i < 8; ++i) oacc[i] = (f32x4){0.f, 0.f, 0.f, 0.f};
    float mrun = -3.0e38f, lpart = 0.f;
    const char* kvb = (const char*)(KVN + brow * 128);
    auto issue = [&](u32x4 (&pf)[8], int pp) {
#pragma unroll
        for (int it = 0; it < 8; ++it) { const int piece = it * 64 + lane; const unsigned key = list[pp * 32 + (piece >> 4)]; pf[it] = *(const u32x4*)(kvb + (key * 256u + 16u * (unsigned)(piece & 15))); }
    };
    auto step = [&](u32x4 (&pf)[8], int pp) {
#pragma unroll
        for (int it = 0; it < 8; ++it) { const int piece = it * 64 + lane; *(LAS u32x4*)(img + (piece >> 4) * 288 + (piece & 15) * 16) = pf[it]; }
        if (pp + 2 < nsteps) issue(pf, pp + 2);
        wave_lds_sync();
        __builtin_amdgcn_sched_barrier(0);
        f32x4 sa = {0.f, 0.f, 0.f, 0.f}, sb = {0.f, 0.f, 0.f, 0.f};
#pragma unroll
        for (int ks = 0; ks < 4; ++ks) {
            const bf16x8 a0 = *(LAS const bf16x8*)(img + fr * 288 + (ks * 32 + 8 * fq) * 2), a1 = *(LAS const bf16x8*)(img + (16 + fr) * 288 + (ks * 32 + 8 * fq) * 2);
            sa = __builtin_amdgcn_mfma_f32_16x16x32_bf16(a0, qf[ks], sa, 0, 0, 0); sb = __builtin_amdgcn_mfma_f32_16x16x32_bf16(a1, qf[ks], sb, 0, 0, 0);
            if (ks == 1) __builtin_amdgcn_sched_barrier(0);
        }
        if (pp * 32 + 32 > cnt) {
            const int pb0 = pp * 32 + 4 * fq;
#pragma unroll
            for (int r = 0; r < 4; ++r) { if (pb0 + r >= cnt) sa[r] = -3.0e38f; if (pb0 + 16 + r >= cnt) sb[r] = -3.0e38f; }
        }
        float mx = fmaxf(fmaxf(fmaxf(sa[0], sa[1]), fmaxf(sa[2], sa[3])), fmaxf(fmaxf(sb[0], sb[1]), fmaxf(sb[2], sb[3])));
        mx = fmaxf(mx, __shfl_xor(mx, 16)); mx = fmaxf(mx, __shfl_xor(mx, 32));
        if (__ballot(mx > mrun) != 0ull) {
            const float mnew = fmaxf(mrun, mx), alpha = __builtin_amdgcn_exp2f(mrun - mnew);
            mrun = mnew; lpart *= alpha;
#pragma unroll
            for (int cb = 0; cb < 8; ++cb) oacc[cb] *= alpha;
        }
        float ps = 0.f;
#pragma unroll
        for (int r = 0; r < 4; ++r) { sa[r] = __builtin_amdgcn_exp2f(sa[r] - mrun); sb[r] = __builtin_amdgcn_exp2f(sb[r] - mrun); ps += sa[r] + sb[r]; }
        lpart += ps;
        u32x4 pw; pw.x = pk2(sa[0], sa[1]); pw.y = pk2(sa[2], sa[3]); pw.z = pk2(sb[0], sb[1]); pw.w = pk2(sb[2], sb[3]);
        const bf16x8 pb = __builtin_bit_cast(bf16x8, pw);
#pragma unroll
        for (int cb = 0; cb < 8; ++cb) {
            const s16x4 r0 = __builtin_amdgcn_ds_read_tr16_b64_v4i16((LAS s16x4*)(img + (4 * fq + (fr >> 2)) * 288 + (cb * 16 + 4 * (fr & 3)) * 2));
            const s16x4 r1 = __builtin_amdgcn_ds_read_tr16_b64_v4i16((LAS s16x4*)(img + (16 + 4 * fq + (fr >> 2)) * 288 + (cb * 16 + 4 * (fr & 3)) * 2));
            const bf16x8 av = {r0[0], r0[1], r0[2], r0[3], r1[0], r1[1], r1[2], r1[3]};
            oacc[cb] = __builtin_amdgcn_mfma_f32_16x16x32_bf16(av, pb, oacc[cb], 0, 0, 0);
            if (cb == 3) __builtin_amdgcn_sched_barrier(0);
        }
        wave_lds_sync();
    };
    u32x4 pf0[8], pf1[8];
    issue(pf0, 0);
    if (nsteps > 1) issue(pf1, 1);
#pragma unroll 1
    for (int pp = 0; pp < nsteps; pp += 2) {
        step(pf0, pp);
        if (pp + 1 < nsteps) step(pf1, pp + 1);
    }
    float lsum = lpart; lsum += __shfl_xor(lsum, 16); lsum += __shfl_xor(lsum, 32);
    const float inv = __builtin_amdgcn_rcpf(lsum);
    if (fr < 8) {
        u16* orow = YO + (brow + t) * 1536 + 512 + fr * 128 + 4 * fq;
#pragma unroll
        for (int cb = 0; cb < 8; ++cb) { u32x2 w; w.x = pk2(oacc[cb][0] * inv, oacc[cb][1] * inv); w.y = pk2(oacc[cb][2] * inv, oacc[cb][3] * inv); *(u32x2*)(orow + cb * 16) = w; }
    }
}

DI void dsa_phase(const Args& a, LAS unsigned char* lds) {
    unsigned char* ws = a.ws;
    const int wid = __builtin_amdgcn_readfirstlane(otid() >> 6);
    LAS u16* rows = (LAS u16*)(lds + P3_ROWS);
    bool bprev = false; size_t pbrow = 0; int pt0 = 0, bbuf = 0;
    for (int gi = blockIdx.x; gi < T / 8; gi += gridDim.x) {
        const int lane = otid() & 63, fr = lane & 15, fq = lane >> 4;
        const int b = gi & 3, t0 = S - 8 - 8 * (gi >> 2);
        const size_t brow = (size_t)b * S;
        const int ntile = (t0 + 8 + 15) >> 4;
        __syncthreads();
        {
            const unsigned char* QI = (const unsigned char*)(ws + WS_QI); const unsigned char* KIN = (const unsigned char*)(ws + WS_KIN); const float* WI = (const float*)(ws + WS_WI);
            typedef int i32x4_t __attribute__((ext_vector_type(4)));
            i32x4_t qa[2]; f32x4 wi[2];
#pragma unroll
            for (int rg = 0; rg < 2; ++rg) {
                qa[rg] = *(const i32x4_t*)(QI + (brow + t0 + 4 * rg + (fr >> 2)) * 256 + (fr & 3) * 64 + 16 * fq);
                wi[rg] = *(const f32x4*)(WI + (brow + t0 + 4 * rg + fq) * 4);
            }
            auto ldk = [&](i32x4_t (&kf)[4], int jt0) {
#pragma unroll
                for (int u = 0; u < 4; ++u) {
                    const int jt = (jt0 + 8 * u) < ntile ? (jt0 + 8 * u) : (ntile - 1);
                    kf[u] = *(const i32x4_t*)(KIN + (brow + jt * 16 + fr) * 64 + 16 * fq);
                }
            };
            auto cmpk = [&](const i32x4_t (&kf)[4], int jt0) {
#pragma unroll
                for (int u = 0; u < 4; ++u) {
                    const int jt = jt0 + 8 * u;
                    if (jt < ntile) {
#pragma unroll
                        for (int rg = 0; rg < 2; ++rg) {
                            i32x4_t d = {0, 0, 0, 0};
                            d = __builtin_amdgcn_mfma_i32_16x16x64_i8(qa[rg], kf[u], d, 0, 0, 0);
                            const float sc = (((float)max(d[0], 0) * wi[rg][0] + (float)max(d[1], 0) * wi[rg][1]) + (float)max(d[2], 0) * wi[rg][2]) + (float)max(d[3], 0) * wi[rg][3];
                            rows[(4 * rg + fq) * 8192 + rowaddr(jt * 16 + fr)] = (u16)(f2key(sc) >> 16);
                        }
                    }
                }
            };
            i32x4_t kA[4], kB[4];
            if (wid < ntile) ldk(kA, wid);
            for (int jt0 = wid; jt0 < ntile; jt0 += 64) {
                const bool hasB = jt0 + 32 < ntile;
                if (hasB) ldk(kB, jt0 + 32);
                cmpk(kA, jt0);
                if (hasB) { if (jt0 + 64 < ntile) ldk(kA, jt0 + 64); cmpk(kB, jt0 + 32); }
            }
        }
        __syncthreads();
        if (wid < 4) {
            u32x4 kr[16];
            const int N0 = t0 + wid + 1, N1 = N0 + 4;
            if (N0 > 256) keys_load(rows + wid * 8192, N0, lane, kr);
            __syncthreads();
            LAS u16* l0 = (LAS u16*)(lds + (bbuf ? P3_HIST : P3_LIST) + wid * 512);
            LAS u16* l1 = l0 + 4 * 256;
            if (N0 > 256) keys_select(kr, l0, N0, lane); else { for (int p = lane; p < 256; p += 64) l0[p] = p < N0 ? (u16)p : (u16)0; }
            if (N1 > 256) { keys_load(rows + (wid + 4) * 8192, N1, lane, kr); keys_select(kr, l1, N1, lane); } else { for (int p = lane; p < 256; p += 64) l1[p] = p < N1 ? (u16)p : (u16)0; }
        } else {
            __syncthreads();
            if (bprev) {
                LAS const u16* lp = (LAS const u16*)(lds + (bbuf ? P3_LIST : P3_HIST));
                LAS unsigned char* img = (LAS unsigned char*)(rows + (wid - 4) * 8192);
                { const int q = wid - 4, t = pt0 + q; attend(a, pbrow, t, t + 1 < 256 ? t + 1 : 256, lp + q * 256, img, lane, fr, fq); }
                { const int q = wid, t = pt0 + q; attend(a, pbrow, t, t + 1 < 256 ? t + 1 : 256, lp + q * 256, img, lane, fr, fq); }
            }
        }
        bprev = true; pbrow = brow; pt0 = t0; bbuf ^= 1;
    }
    __syncthreads();
    if (bprev) {
        const int lane = otid() & 63, fr = lane & 15, fq = lane >> 4;
        LAS const u16* lp = (LAS const u16*)(lds + (bbuf ? P3_LIST : P3_HIST));
        const int q = wid, t = pt0 + q;
        attend(a, pbrow, t, t + 1 < 256 ? t + 1 : 256, lp + q * 256, (LAS unsigned char*)(rows + wid * 8192), lane, fr, fq);
    }
}

constexpr int P6_LCNT = 0, P6_BASE = 128, P6_RSB = 256, P6_RI = 1024;
DI unsigned dpp_max_u32(unsigned v) {
    v = max(v, (unsigned)__builtin_amdgcn_update_dpp(0, (int)v, 0xB1, 0xf, 0xf, false));
    v = max(v, (unsigned)__builtin_amdgcn_update_dpp(0, (int)v, 0x4E, 0xf, 0xf, false));
    v = max(v, (unsigned)__builtin_amdgcn_update_dpp(0, (int)v, 0x141, 0xf, 0xf, false));
    v = max(v, (unsigned)__builtin_amdgcn_update_dpp(0, (int)v, 0x140, 0xf, 0xf, false));
    return v;
}
DI float key2f(unsigned k) { return __uint_as_float((k & 0x80000000u) ? (k & 0x7fffffffu) : ~k); }
DI void router_phase(const Args& a, LAS unsigned char* lds) {
    unsigned char* ws = a.ws;
    const int tid = otid(), wid = tid >> 6, lane = tid & 63, fr = lane & 15, fq = lane >> 4;
    LAS int* lcnt = (LAS int*)(lds + P6_LCNT); LAS int* lbase = (LAS int*)(lds + P6_BASE); LAS float* rsb = (LAS float*)(lds + P6_RSB); LAS int* RI = (LAS int*)(lds + P6_RI);
    const u16* WRH = (const u16*)(ws + WS_WR);
    unsigned* CNT = (unsigned*)(ws + WS_CTL);
    LAS unsigned char* WL = lds + 16384;
    __syncthreads();
    for (int i = tid; i < 64 * 128; i += NT) { const int r = i >> 7, p = i & 127; *(LAS u32x4*)(WL + r * 2064 + p * 16) = *(const u32x4*)(WRH + (size_t)r * 1024 + p * 8); }
    for (int rg = blockIdx.x; rg < T / 128; rg += gridDim.x) {
        __syncthreads();
        if (tid < 32) lcnt[tid] = 0;
        __syncthreads();
        {
            const int row = rg * 128 + wid * 16 + fr;
            const float* xr = a.out + (size_t)row * 1024 + 8 * fq;
            f32x4 acc[2] = {{0.f, 0.f, 0.f, 0.f}, {0.f, 0.f, 0.f, 0.f}};
            float ss = 0.f;
#pragma unroll 4
            for (int ks = 0; ks < 32; ++ks) {
                const f32x4 x0 = *(const f32x4*)(xr + ks * 32), x1 = *(const f32x4*)(xr + ks * 32 + 4);
                ss += ((x0[0] * x0[0] + x0[1] * x0[1]) + (x0[2] * x0[2] + x0[3] * x0[3])) + ((x1[0] * x1[0] + x1[1] * x1[1]) + (x1[2] * x1[2] + x1[3] * x1[3]));
                u32x4 hw; hw.x = pk2(x0[0], x0[1]); hw.y = pk2(x0[2], x0[3]); hw.z = pk2(x1[0], x1[1]); hw.w = pk2(x1[2], x1[3]);
                u32x4 lw; lw.x = pk2(x0[0] - bflo(hw.x), x0[1] - bfhi(hw.x)); lw.y = pk2(x0[2] - bflo(hw.y), x0[3] - bfhi(hw.y)); lw.z = pk2(x1[0] - bflo(hw.z), x1[1] - bfhi(hw.z)); lw.w = pk2(x1[2] - bflo(hw.w), x1[3] - bfhi(hw.w));
                const bf16x8 xh = __builtin_bit_cast(bf16x8, hw), xl = __builtin_bit_cast(bf16x8, lw);
#pragma unroll
                for (int nt = 0; nt < 2; ++nt) {
                    const bf16x8 wh = *(LAS const bf16x8*)(WL + (nt * 16 + fr) * 2064 + (ks * 32 + 8 * fq) * 2), wl = *(LAS const bf16x8*)(WL + (32 + nt * 16 + fr) * 2064 + (ks * 32 + 8 * fq) * 2);
                    acc[nt] = __builtin_amdgcn_mfma_f32_16x16x32_bf16(xh, wh, acc[nt], 0, 0, 0);
                    acc[nt] = __builtin_amdgcn_mfma_f32_16x16x32_bf16(xl, wh, acc[nt], 0, 0, 0);
                    acc[nt] = __builtin_amdgcn_mfma_f32_16x16x32_bf16(xh, wl, acc[nt], 0, 0, 0);
                }
            }
            ss += __shfl_xor(ss, 16); ss += __shfl_xor(ss, 32);
            const float rsrow = __builtin_amdgcn_rsqf(ss * (1.0f / 1024.0f) + EPS);
            if (fq == 0) rsb[wid * 16 + fr] = rsrow;
            {
                unsigned char* xn = ws + WS_XN2 + (size_t)row * 1024 + 8 * fq;
#pragma unroll 4
                for (int ks = 0; ks < 32; ++ks) {
                    const f32x4 x0 = *(const f32x4*)(xr + ks * 32), x1 = *(const f32x4*)(xr + ks * 32 + 4);
                    u32x2 w; w.x = pk4_fp8(x0[0] * rsrow, x0[1] * rsrow, x0[2] * rsrow, x0[3] * rsrow); w.y = pk4_fp8(x1[0] * rsrow, x1[1] * rsrow, x1[2] * rsrow, x1[3] * rsrow);
                    *(u32x2*)(xn + ks * 32) = w;
                }
            }
            wave_lds_sync();
            const float b0 = a.in[I_BR][fr], b1 = a.in[I_BR][16 + fr];
#pragma unroll
            for (int r = 0; r < 4; ++r) {
                const float rs = rsb[wid * 16 + 4 * fq + r];
                unsigned k0 = (f2key(acc[0][r] * rs + b0) & ~31u) | (unsigned)(31 - fr), k1 = (f2key(acc[1][r] * rs + b1) & ~31u) | (unsigned)(15 - fr);
                unsigned sel[4];
#pragma unroll
                for (int k = 0; k < 4; ++k) {
                    const unsigned best = dpp_max_u32(k0 > k1 ? k0 : k1);
                    sel[k] = best;
                    if (k0 == best) k0 = 0u;
                    if (k1 == best) k1 = 0u;
                }
                const float v0 = key2f(sel[0] & ~31u), e1 = __expf(key2f(sel[1] & ~31u) - v0), e2 = __expf(key2f(sel[2] & ~31u) - v0), e3 = __expf(key2f(sel[3] & ~31u) - v0);
                const float inv = 1.0f / (1.0f + e1 + e2 + e3);
                if (fr < 4) {
                    const unsigned sk = fr == 0 ? sel[0] : (fr == 1 ? sel[1] : (fr == 2 ? sel[2] : sel[3]));
                    const int e = 31 - (int)(sk & 31u);
                    const float gt = (fr == 0 ? 1.0f : (fr == 1 ? e1 : (fr == 2 ? e2 : e3))) * inv;
                    const int ls = __hip_atomic_fetch_add(lcnt + e, 1, __ATOMIC_RELAXED, __HIP_MEMORY_SCOPE_WORKGROUP);
                    const int ri = ((wid * 16 + 4 * fq + r) * 4 + fr) * 4;
                    RI[ri + 0] = e; RI[ri + 1] = ls; RI[ri + 2] = __float_as_int(gt);
                }
            }
        }
        __syncthreads();
        if (tid < 32) lbase[tid] = (int)__hip_atomic_fetch_add(CNT + tid, (unsigned)lcnt[tid], __ATOMIC_RELAXED, __HIP_MEMORY_SCOPE_AGENT);
        __syncthreads();
        {
            const int rl = tid >> 2, k = tid & 3, row = rg * 128 + rl;
            const int e = RI[tid * 4 + 0], slot = lbase[e] + RI[tid * 4 + 1];
            ((int*)(ws + WS_LTOK))[(size_t)e * ECAP + slot] = row;
            ((float*)(ws + WS_LGATE))[(size_t)e * ECAP + slot] = __int_as_float(RI[tid * 4 + 2]);
            ((unsigned*)(ws + WS_ROUTE))[(size_t)row * 4 + k] = ((unsigned)e << 16) | (unsigned)slot;
        }
    }
}

DI void combine_phase(const Args& a, LAS unsigned char* lds) {
    unsigned char* ws = a.ws;
    LAS const int* tab = (LAS const int*)(lds + MOE_TAB);
    const int tid = otid(), wid = tid >> 6, lane = tid & 63;
    const u16* YB = (const u16*)(ws + WS_YB); const unsigned* ROUTE = (const unsigned*)(ws + WS_ROUTE);
    for (int row = blockIdx.x * 8 + wid; row < T; row += gridDim.x * 8) {
        size_t pos[4];
#pragma unroll
        for (int k = 0; k < 4; ++k) { const unsigned r = ROUTE[(size_t)row * 4 + k]; const int e = (int)(r >> 16), slot = (int)(r & 0xffffu); pos[k] = (size_t)tab[e] * 256 + slot; }
        float* orow = a.out + (size_t)row * 1024;
#pragma unroll
        for (int i = 0; i < 4; ++i) {
            f32x4 v = *(const f32x4*)(orow + i * 256 + lane * 4);
#pragma unroll
            for (int k = 0; k < 4; ++k) { const u32x2 y = *(const u32x2*)(YB + pos[k] * 1024 + i * 256 + lane * 4); v[0] += bflo(y.x); v[1] += bfhi(y.x); v[2] += bflo(y.y); v[3] += bfhi(y.y); }
            *(f32x4*)(orow + i * 256 + lane * 4) = v;
        }
    }
}

#define XB_TMO      128
#define XB_XCNT(j)  (256  + 64 * (j))
#define XB_XSUB(j)  (1280 + 64 * (j))
#define XB_XGEN(j)  (2304 + 64 * (j))
#define XB_TOP      3328
#define XB_TOPGEN   3392
#define XCD_BAR_WORDS 3456
#define XB_SPIN_CAP (1u << 18)

__device__ __forceinline__ unsigned xb_ld(unsigned* p)              { return __hip_atomic_load(p, __ATOMIC_RELAXED, __HIP_MEMORY_SCOPE_AGENT); }
__device__ __forceinline__ unsigned xb_add(unsigned* p, unsigned v) { return __hip_atomic_fetch_add(p, v, __ATOMIC_RELAXED, __HIP_MEMORY_SCOPE_AGENT); }
__device__ __forceinline__ unsigned xb_xcc_id() { return (unsigned)__builtin_amdgcn_s_getreg((3 << 11) | 20) & 0xFu; }
#define XB_SPIN(cond, bar) do { unsigned _sp = 0; while (cond) { __builtin_amdgcn_s_sleep(1); \
    if ((++_sp & 255u) == 0u) { if (xb_ld(&(bar)[XB_TMO])) break; if (_sp > XB_SPIN_CAP) { atomicAdd(&(bar)[XB_TMO], 1u); break; } } } } while (0)

struct XcdBarrier {
    unsigned* bar; unsigned x;
    volatile LAS unsigned* st;
};

__device__ __forceinline__ XcdBarrier xcd_barrier_post(unsigned* bar, volatile LAS unsigned* st) {
    XcdBarrier b; b.bar = bar; b.x = xb_xcc_id(); b.st = st;
    if (threadIdx.x == 0) (void)xb_add(&bar[XB_XCNT(b.x)], 1u);
    return b;
}
__device__ __forceinline__ void xcd_barrier_complete(unsigned* bar, unsigned x, unsigned& nloc, unsigned& nx) {
    const unsigned G = gridDim.x * gridDim.y * gridDim.z;
    unsigned sum, cnt, mine, sp = 0u;
    for (;;) {
        sum = 0u; cnt = 0u; mine = 0u;
#pragma unroll
        for (unsigned j = 0; j < 16; ++j) { const unsigned c = xb_ld(&bar[XB_XCNT(j)]); sum += c; cnt += (c > 0u) ? 1u : 0u; mine = (j == x) ? c : mine; }
        if (sum == G) break;
        __builtin_amdgcn_s_sleep(1);
        if ((++sp & 255u) == 0u) { if (xb_ld(&bar[XB_TMO])) break; if (sp > XB_SPIN_CAP) { atomicAdd(&bar[XB_TMO], 1u); break; } }
    }
    nloc = mine > 0u ? mine : 1u; nx = cnt > 0u ? cnt : 1u;
}

__device__ __forceinline__ void xcd_barrier(const XcdBarrier& b) {
    asm volatile("s_waitcnt vmcnt(0)" ::: "memory");
    __syncthreads();
    if (threadIdx.x == 0) {
        unsigned* bar = b.bar;
        __builtin_amdgcn_s_waitcnt(0);
        unsigned nloc = b.st[0], nx = b.st[1];
        if (nloc == 0u) { xcd_barrier_complete(bar, b.x, nloc, nx); b.st[0] = nloc; b.st[1] = nx; }
        const unsigned old = xb_add(&bar[XB_XSUB(b.x)], 1u);
        const unsigned gen = old / nloc;
        if (old + 1u == (gen + 1u) * nloc) {
            __builtin_amdgcn_fence(__ATOMIC_RELEASE, "agent");
            asm volatile("s_waitcnt vmcnt(0)" ::: "memory");
            const unsigned og = xb_add(&bar[XB_TOP], 1u);
            const unsigned tg = og / nx;
            if (og + 1u == (tg + 1u) * nx) xb_add(&bar[XB_TOPGEN], 1u);
            else XB_SPIN(xb_ld(&bar[XB_TOPGEN]) == tg, bar);
            __builtin_amdgcn_fence(__ATOMIC_ACQUIRE, "agent");
            xb_add(&bar[XB_XGEN(b.x)], 1u);
            asm volatile("s_waitcnt vmcnt(0)" ::: "memory");
        } else {
            XB_SPIN(xb_ld(&bar[XB_XGEN(b.x)]) == gen, bar);
            __builtin_amdgcn_fence(__ATOMIC_ACQUIRE, "agent");
            asm volatile("s_waitcnt vmcnt(0)" ::: "memory");
        }
    }
    __syncthreads();
}

__global__ void __launch_bounds__(NT, 2) fwd(Args a) {
    extern __shared__ __attribute__((aligned(16))) unsigned char lds_raw[];
    LAS unsigned char* lds = (LAS unsigned char*)lds_raw;
    cg::grid_group grid = cg::this_grid();
    unsigned char* ws = a.ws;
    const int G = gridDim.x, c = blockIdx.x;
    if (threadIdx.x < 2) ((volatile LAS unsigned*)(lds + LDS_BARST))[threadIdx.x] = 0u;
    __syncthreads();
    const XcdBarrier xbar = xcd_barrier_post((unsigned*)(ws + WS_BAR), (volatile LAS unsigned*)(lds + LDS_BARST));

    phase0(a, lds);
    xcd_barrier(xbar);
    {
        g8::PlainSched s; s.Abase = (const char*)(ws + WS_XB); s.Bbase = (const char*)(ws + WS_WIN); s.lda = 1024; s.ldb = 1024; s.K = 1024; s.nM = T / 256; s.nN = NIN / 256; s.G = G; s.c = c;
        EpiIn e; e.H = (u16*)(ws + WS_H); e.rs1 = (const float*)(ws + WS_RS1); e.SSQ = (float*)(ws + WS_SSQ); e.WI = (float*)(ws + WS_WI);
        g8::gemm_phase(lds, s, e);
    }
    xcd_barrier(xbar);
    {
        g8::PlainSched s; s.Abase = (const char*)(ws + WS_H) + 1024 * 2; s.Bbase = (const char*)(ws + WS_WQ); s.lda = NIN; s.ldb = 256; s.K = 256; s.nM = T / 256; s.nN = 5; s.G = G; s.c = c;
        EpiQ e; e.Q = (u16*)(ws + WS_Q); e.QI = (u16*)(ws + WS_QI); e.SSQ = (const float*)(ws + WS_SSQ);
        g8::gemm_phase(lds, s, e);
        for (int u = c; u < 1024; u += G) gmlp_unit(a, lds, u);
        kvnorm(a);
    }
    xcd_barrier(xbar);
    dsa_phase(a, lds);
    xcd_barrier(xbar);
    {
        g8::PlainSched s; s.Abase = (const char*)(ws + WS_YO); s.Bbase = (const char*)(ws + WS_WCAT); s.lda = 1536; s.ldb = 1536; s.K = 512; s.nM = T / 256; s.nN = 4; s.G = G; s.c = c;
        EpiMrg<0> e0; e0.OUT = (u16*)(ws + WS_TMP); e0.TMP = nullptr; e0.H = (const u16*)(ws + WS_H);
        g8::gemm_phase(lds, s, e0);
        s.Abase = (const char*)(ws + WS_YO) + 512 * 2; s.Bbase = (const char*)(ws + WS_WCAT) + 512 * 2; s.K = 1024;
        EpiMrg<1> e1; e1.OUT = (u16*)(ws + WS_MRG); e1.TMP = (const u16*)(ws + WS_TMP); e1.H = (const u16*)(ws + WS_H);
        g8::gemm_phase(lds, s, e1);
    }
    xcd_barrier(xbar);
    {
        g8::PlainSched s; s.Abase = (const char*)(ws + WS_MRG); s.Bbase = (const char*)(ws + WS_WOUT); s.lda = 1024; s.ldb = 1024; s.K = 1024; s.nM = T / 256; s.nN = 4; s.G = G; s.c = c;
        EpiOut e; e.out = a.out; e.x = a.in[I_X];
        g8::gemm_phase(lds, s, e);
    }
    xcd_barrier(xbar);
    router_phase(a, lds);
    xcd_barrier(xbar);
    moe_table(lds, (const unsigned*)(ws + WS_CTL));
    {
        MoeSched<8, true> s; s.Abase = (const char*)(ws + WS_XN2); s.Wbase = (const char*)(ws + WS_WE1); s.LTOK = (const int*)(ws + WS_LTOK); s.tab = (LAS const int*)(lds + MOE_TAB);
        s.lda = 1024; s.ldb = 1024; s.K = 1024; s.G = G; s.c = c; s.wstride = (size_t)2048 * 1024;
        EpiMoe1 e; e.ACT = (unsigned char*)(ws + WS_ACT); e.b1 = a.in[I_BE1];
        g8::gemm_phase<true>(lds, s, e);
    }
    xcd_barrier(xbar);
    {
        MoeSched<4, false> s; s.Abase = (const char*)(ws + WS_ACT); s.Wbase = (const char*)(ws + WS_WE2); s.LTOK = nullptr; s.tab = (LAS const int*)(lds + MOE_TAB);
        s.lda = 1024; s.ldb = 1024; s.K = 1024; s.G = G; s.c = c; s.wstride = (size_t)1024 * 1024;
        EpiMoe2 e; e.YB = (u16*)(ws + WS_YB); e.b2 = a.in[I_BE2]; e.LGATE = (const float*)(ws + WS_LGATE); e.tab = (LAS const int*)(lds + MOE_TAB);
        g8::gemm_phase<true>(lds, s, e);
    }
    xcd_barrier(xbar);
    combine_phase(a, lds);
    if (a.mask == 0u) grid.sync();
}

extern "C" void kernel_launch(void* const* d_in, const int* in_sizes, int n_in, void* d_out, int out_size, void* d_ws, size_t ws_size, hipStream_t stream) {
    static int grid = 0;
    if (grid == 0) {
        int dev = 0, cus = 0, per_cu = 0;
        if (n_in != 23 || out_size != T * Dm || ws_size < WS_END) { fprintf(stderr, "kernel_launch: unexpected problem (n_in %d, out %d, ws %zu < %zu)\n", n_in, out_size, ws_size, (size_t)WS_END); grid = -1; return; }
        if (hipGetDevice(&dev) != hipSuccess || hipDeviceGetAttribute(&cus, hipDeviceAttributeMultiprocessorCount, dev) != hipSuccess) { grid = -1; return; }
        if (hipFuncSetAttribute((const void*)fwd, hipFuncAttributeMaxDynamicSharedMemorySize, LDS_BYTES) != hipSuccess) { fprintf(stderr, "hipFuncSetAttribute failed\n"); grid = -1; return; }
        if (hipOccupancyMaxActiveBlocksPerMultiprocessor(&per_cu, (const void*)fwd, NT, LDS_BYTES) != hipSuccess || per_cu < 1) { fprintf(stderr, "occupancy query failed (%d)\n", per_cu); grid = -1; return; }
        grid = cus;
        fprintf(stderr, "kernel_launch: cus %d per_cu %d grid %d ws %zu need %zu\n", cus, per_cu, grid, ws_size, (size_t)WS_END);
    }
    if (grid < 0) return;
    Args a{};
    for (int i = 0; i < 23; ++i) a.in[i] = (const float*)d_in[i];
    a.out = (float*)d_out; a.ws = (unsigned char*)d_ws; a.mask = 0xffffffffu; a.pad = 0u;
    if (hipMemsetAsync((char*)d_ws + WS_CTL, 0, 65536, stream) != hipSuccess) { fprintf(stderr, "memset failed\n"); return; }
    void* args[] = {&a};
    hipError_t e = hipLaunchCooperativeKernel((const void*)fwd, dim3(grid), dim3(NT), args, LDS_BYTES, stream);
    if (e != hipSuccess) fprintf(stderr, "cooperative launch failed: %s (grid %d)\n", hipGetErrorString(e), grid);
}
```

```cpp
#include <hip/hip_runtime.h>
#include <hip/hip_cooperative_groups.h>
#include <cstdio>
#include <cstdint>
namespace cg = cooperative_groups;

#define LAS __attribute__((address_space(3)))
#define DI __device__ __forceinline__
typedef unsigned short u16;
typedef short bf16x8 __attribute__((ext_vector_type(8)));
typedef short s16x4 __attribute__((ext_vector_type(4)));
typedef float f32x4 __attribute__((ext_vector_type(4)));
typedef float f32x2 __attribute__((ext_vector_type(2)));
typedef unsigned u32x4 __attribute__((ext_vector_type(4)));
typedef unsigned u32x2 __attribute__((ext_vector_type(2)));
typedef __bf16 bf2_t __attribute__((ext_vector_type(2)));
typedef int v8i_t __attribute__((ext_vector_type(8)));

constexpr int NT = 512;
constexpr int LDS_BYTES = 159744;
constexpr int Dm = 1024, Bsz = 4, S = 8192, T = Bsz * S;
constexpr int NIN = 3584;
constexpr int NE = 32, ECAP = 32768, PPAD = 131072 + NE * 256;
constexpr float EPS = 1e-6f;

constexpr size_t MiB = 1024 * 1024;
constexpr size_t WS_CTL = 0;
constexpr size_t WS_BAR = 16384;
constexpr int LDS_BARST = LDS_BYTES - 16;
constexpr size_t WS_WIN = 64 * 1024;
constexpr size_t WS_WQ = WS_WIN + (size_t)NIN * 1024 * 2;
constexpr size_t WS_WSP = WS_WQ + 1280 * 256 * 2;
constexpr size_t WS_WCAT = WS_WSP + 4 * 128 * 128 * 2;
constexpr size_t WS_WOUT = WS_WCAT + 1024 * 1536 * 2;
constexpr size_t WS_WR = WS_WOUT + 1024 * 1024 * 2;
constexpr size_t WS_WE1 = WS_WR + 32 * 1024 * 4;
constexpr size_t WS_WE2 = WS_WE1 + (size_t)32 * 2048 * 1024 * 2;
constexpr size_t WS_RS1 = WS_WE2 + (size_t)32 * 1024 * 1024 * 2;
constexpr size_t WS_SSQ = WS_RS1 + (size_t)T * 4;
constexpr size_t WS_WI = WS_SSQ + (size_t)T * 32 * 4;
constexpr size_t WS_ROUTE = WS_WI + (size_t)T * 4 * 4;
constexpr size_t WS_LTOK = WS_ROUTE + (size_t)T * 4 * 4;
constexpr size_t WS_LGATE = WS_LTOK + (size_t)NE * ECAP * 4;
constexpr size_t WS_LRS = WS_LGATE + (size_t)NE * ECAP * 4;
constexpr size_t WS_XN2 = WS_LRS + (size_t)NE * ECAP * 4;
constexpr size_t WS_R0 = WS_XN2 + (size_t)T * 1024 * 2;
constexpr size_t WS_XB = WS_R0;
constexpr size_t WS_H = WS_XB + (size_t)T * 1024 * 2;
constexpr size_t WS_Q = WS_H + (size_t)T * NIN * 2;
constexpr size_t WS_QI = WS_Q + (size_t)T * 1024 * 2;
constexpr size_t WS_KVN = WS_QI + (size_t)T * 256 * 2;
constexpr size_t WS_KIN = WS_KVN + (size_t)T * 128 * 2;
constexpr size_t WS_YO = WS_KIN + (size_t)T * 64 * 2;
constexpr size_t WS_TMP = WS_YO + (size_t)T * 1536 * 2;
constexpr size_t WS_MRG = WS_TMP + (size_t)T * 1024 * 2;
constexpr size_t WS_R0END = WS_MRG + (size_t)T * 1024 * 2;
constexpr size_t WS_ACT = WS_XB;
constexpr size_t WS_YB = WS_Q;
static_assert(WS_ACT + (size_t)PPAD * 1024 * 2 <= WS_Q, "ACT overlaps YB");
static_assert(WS_YB + (size_t)PPAD * 1024 * 2 <= WS_R0END, "YB too large");
constexpr size_t WS_END = WS_R0END;

struct Args { const float* in[23]; float* out; unsigned char* ws; unsigned mask; unsigned pad; };
enum { I_X = 0, I_N1G, I_WIN, I_QLG, I_WUQ, I_QNG, I_KVG, I_WUV, I_WQI, I_KIG, I_VG, I_WSP, I_BSP, I_WPA, I_WPB, I_WOUT, I_N2G, I_WR, I_BR, I_WE1, I_BE1, I_WE2, I_BE2 };

DI unsigned pk2(float a, float b) { f32x2 v = {a, b}; bf2_t r = __builtin_convertvector(v, bf2_t); return __builtin_bit_cast(unsigned, r); }
DI unsigned pk4_fp8(float a, float b, float c, float d) { unsigned w = 0u; w = (unsigned)__builtin_amdgcn_cvt_pk_fp8_f32(a, b, (int)w, false); w = (unsigned)__builtin_amdgcn_cvt_pk_fp8_f32(c, d, (int)w, true); return w; }
DI unsigned pk4_i8(float a, float b, float c, float d) {
    const int ia = (int)__builtin_rintf(fminf(fmaxf(a * 32.0f, -127.0f), 127.0f)), ib = (int)__builtin_rintf(fminf(fmaxf(b * 32.0f, -127.0f), 127.0f));
    const int ic = (int)__builtin_rintf(fminf(fmaxf(c * 32.0f, -127.0f), 127.0f)), id = (int)__builtin_rintf(fminf(fmaxf(d * 32.0f, -127.0f), 127.0f));
    return (unsigned)(ia & 0xff) | ((unsigned)(ib & 0xff) << 8) | ((unsigned)(ic & 0xff) << 16) | ((unsigned)(id & 0xff) << 24);
}
DI float bflo(unsigned u) { return __uint_as_float(u << 16); }
DI float bfhi(unsigned u) { return __uint_as_float(u & 0xffff0000u); }
DI u16 f2bf(float f) { return (u16)(pk2(f, 0.f) & 0xffffu); }
DI float bf2f(u16 h) { return __uint_as_float(((unsigned)h) << 16); }
DI float sigmoidf_(float x) { return __builtin_amdgcn_rcpf(1.0f + __expf(-x)); }
DI float gelu_tanh(float x) { const float u = 1.5957691216057308f * (x + 0.044715f * x * x * x); return x * sigmoidf_(u); }
DI float fast_sigmoid(float x) { return __builtin_amdgcn_rcpf(1.0f + __builtin_amdgcn_exp2f(x * -1.4426950408889634f)); }
DI float fast_gelu(float x) { const float p = __builtin_fmaf(x * x, -0.10294324f, -2.3022082f); return x * __builtin_amdgcn_rcpf(1.0f + __builtin_amdgcn_exp2f(x * p)); }
DI int otid() { int t = threadIdx.x; asm volatile("" : "+v"(t)); return t; }
DI void wave_lds_sync() { asm volatile("s_waitcnt lgkmcnt(0)" ::: "memory"); }

namespace g8 {
constexpr int BM = 256, BK = 64, HALF = 128, HTB = HALF * BK * 2, STAGE_BYTES = 8 * HTB, NXCD = 8, WGM = 8;
DI int lds_byte(int r, int c) { const int st = (r >> 4) * 2 + (c >> 5), rr = r & 15, cc = c & 31, ob = rr * 64 + cc * 2; return st * 1024 + (ob ^ (((ob >> 9) & 1) << 5)); }
DI int perm32(int rho) { const int n = rho >> 4, i = rho & 15; return 8 * (i >> 2) + 4 * n + (i & 3); }
DI void stage_rc(int b, int& R, int& C) { const int st = b / 1024, sb = b % 1024, swz = sb ^ (((sb >> 9) & 1) << 5); R = (st >> 1) * 16 + swz / 64; C = (st & 1) * 32 + (swz % 64) / 2; }

struct UnitD { const char* Bp; int pm, pn, e, rb; };

DI bool static_tile(int i, int G, int c, int nM, int nN, int& pm, int& pn) {
    const int nwg = nM * nN; const long L = (long)i * G + c; if (L >= nwg) return false;
    int wgid = (int)L; { const int q = nwg / NXCD, r = nwg % NXCD, xcd = wgid % NXCD, off = wgid / NXCD; wgid = (xcd < r ? xcd * (q + 1) : r * (q + 1) + (xcd - r) * q) + off; }
    const int nig = WGM * nN, gid = wgid / nig, fm = gid * WGM, gsz = (nM - fm) < WGM ? (nM - fm) : WGM;
    pm = fm + ((wgid % nig) % gsz); pn = (wgid % nig) / gsz; return true;
}

struct PlainSched {
    const char* Abase; const char* Bbase; int lda, ldb, K, nM, nN, G, c; static constexpr int esz = 2;
    DI bool next(int i, UnitD& u) const { int pm, pn; if (!static_tile(i, G, c, nM, nN, pm, pn)) return false; u.pm = pm; u.pn = pn; u.e = 0; u.rb = 0; u.Bp = Bbase + (size_t)pn * BM * ldb * 2; return true; }
    DI void a_offs(const UnitD& u, int R0, int C0, unsigned (&o)[2][2]) const {
#pragma unroll
        for (int h = 0; h < 2; ++h)
#pragma unroll
            for (int i = 0; i < 2; ++i) o[h][i] = (unsigned)(((size_t)(u.pm * BM + h * HALF + R0 + 64 * i) * lda + C0) * 2);
    }
};

template <bool FP8 = false, class Epi, class Sched>
DI void gemm_phase(LAS unsigned char* lds, const Sched& S, const Epi& E) {
    const int tid = otid(), wid = __builtin_amdgcn_readfirstlane(tid >> 6), lane = tid & 63, wr = wid >> 2, wc = wid & 3, fr = lane & 15, fq = lane >> 4;
    const int nt = S.K * Sched::esz / 128;
    int R0, C0; stage_rc(tid * 16, R0, C0);
    unsigned voffB[2];
#pragma unroll
    for (int i = 0; i < 2; ++i) { const int Rr = R0 + 64 * i, Rb = Epi::PERM ? ((Rr & ~31) + perm32(Rr & 31)) : Rr; voffB[i] = (unsigned)(Rb * S.ldb * Sched::esz + C0 * 2); }
    const size_t hstepB = (size_t)HALF * S.ldb * Sched::esz;
    const unsigned ldsw = (unsigned)wid * 1024u;
    const int aoff = FP8 ? lds_byte(wr * 64 + fr, fq * 16) : lds_byte(wr * 64 + fr, fq * 8), boff = FP8 ? lds_byte(wc * 32 + fr, fq * 16) : lds_byte(wc * 32 + fr, fq * 8);
    const unsigned mxscale = 0x7f7f7f7fu;
    const int kst = FP8 ? 16 : 1024;
    const char* Ab = S.Abase;
#define G8_SA(b, h) (((b) * 2 + (h)) * HTB)
#define G8_SB(b, h) ((4 + (b) * 2 + (h)) * HTB)
#define G8_STAGE_A(bufoff, offs, kb) do { _Pragma("unroll") for (int _i = 0; _i < 2; ++_i) \
        __builtin_amdgcn_global_load_lds((const unsigned*)(Ab + (size_t)(offs)[_i] + (size_t)(kb)), (LAS unsigned*)(lds + (bufoff) + ldsw + _i * 8192), 16, 0, 0); } while (0)
#define G8_STAGE_B(bufoff, gbase, kb) do { _Pragma("unroll") for (int _i = 0; _i < 2; ++_i) \
        __builtin_amdgcn_global_load_lds((const unsigned*)((gbase) + voffB[_i] + (size_t)(kb)), (LAS unsigned*)(lds + (bufoff) + ldsw + _i * 8192), 16, 0, 0); } while (0)
#define G8_LDA(dst, b, h) do { _Pragma("unroll") for (int m = 0; m < 4; ++m) { const i32x4_t _p = *(const LAS i32x4_t*)(lds + G8_SA(b, h) + aoff + m * 2048), _q = *(const LAS i32x4_t*)(lds + G8_SA(b, h) + aoff + m * 2048 + kst); dst[m] = __builtin_shufflevector(_p, _q, 0, 1, 2, 3, 4, 5, 6, 7); } } while (0)
#define G8_LDB(dst, b, h) do { _Pragma("unroll") for (int n = 0; n < 2; ++n) { const i32x4_t _p = *(const LAS i32x4_t*)(lds + G8_SB(b, h) + boff + n * 2048), _q = *(const LAS i32x4_t*)(lds + G8_SB(b, h) + boff + n * 2048 + kst); dst[n] = __builtin_shufflevector(_p, _q, 0, 1, 2, 3, 4, 5, 6, 7); } } while (0)
#define G8_MMA(ai, bj, At, Bt) do { __builtin_amdgcn_s_setprio(1); _Pragma("unroll") for (int m = 0; m < 4; ++m) _Pragma("unroll") for (int n = 0; n < 2; ++n) { \
        if constexpr (FP8) asm volatile("v_mfma_scale_f32_16x16x128_f8f6f4 %0, %1, %2, %0, %3, %3 op_sel_hi:[0,0,0]" : "+v"(acc[ai][bj][m][n]) : "v"(Bt[n]), "v"(At[m]), "v"(mxscale)); \
        else { acc[ai][bj][m][n] = __builtin_amdgcn_mfma_f32_16x16x32_bf16(__builtin_bit_cast(bf16x8, __builtin_shufflevector(Bt[n], Bt[n], 0, 1, 2, 3)), __builtin_bit_cast(bf16x8, __builtin_shufflevector(At[m], At[m], 0, 1, 2, 3)), acc[ai][bj][m][n], 0, 0, 0); \
               acc[ai][bj][m][n] = __builtin_amdgcn_mfma_f32_16x16x32_bf16(__builtin_bit_cast(bf16x8, __builtin_shufflevector(Bt[n], Bt[n], 4, 5, 6, 7)), __builtin_bit_cast(bf16x8, __builtin_shufflevector(At[m], At[m], 4, 5, 6, 7)), acc[ai][bj][m][n], 0, 0, 0); } } \
        __builtin_amdgcn_s_setprio(0); } while (0)
#define G8_WAIT_V(n) asm volatile("s_waitcnt vmcnt(" #n ")" ::: "memory")
#define G8_WAIT_L(n) asm volatile("s_waitcnt lgkmcnt(" #n ")" ::: "memory")
#define G8_BAR __builtin_amdgcn_s_barrier()
#define G8_SCHED __builtin_amdgcn_sched_barrier(0)
    UnitD cur, nxt; int ui = 0;
    if (!S.next(0, cur)) return;
    f32x4 acc[2][2][4][2];
#pragma unroll
    for (int a = 0; a < 2; ++a)
#pragma unroll
        for (int b = 0; b < 2; ++b)
#pragma unroll
            for (int m = 0; m < 4; ++m)
#pragma unroll
                for (int n = 0; n < 2; ++n) acc[a][b][m][n] = (f32x4){0.f, 0.f, 0.f, 0.f};
    typedef int i32x4_t __attribute__((ext_vector_type(4)));
    v8i_t At[4], B0[2], B1[2];
    unsigned cA[2][2];
    S.a_offs(cur, R0, C0, cA);
    const char* cB = cur.Bp;
    G8_STAGE_B(G8_SB(0, 0), cB, 0); G8_STAGE_A(G8_SA(0, 0), cA[0], 0); G8_STAGE_B(G8_SB(0, 1), cB + hstepB, 0); G8_STAGE_A(G8_SA(0, 1), cA[1], 0);
    if (wr == 1) G8_BAR;
    G8_WAIT_V(4); G8_BAR;
    G8_STAGE_B(G8_SB(1, 0), cB, 128); G8_STAGE_A(G8_SA(1, 0), cA[0], 128); G8_STAGE_B(G8_SB(1, 1), cB + hstepB, 128);
    G8_WAIT_V(6); G8_BAR;
    for (;;) {
        const bool has_next = S.next(ui + 1, nxt);
        const char* nB = has_next ? nxt.Bp : cB;
        for (int t = 0; t < nt; t += 2) {
            const bool last = (t == nt - 2);
            const unsigned k1 = (unsigned)(t + 1) * 128u;
            const unsigned k2 = last ? 0u : (unsigned)(t + 2) * 128u, k3 = k2 + 128u;
            unsigned c1[2] = {cA[1][0], cA[1][1]};
            if (last && has_next) S.a_offs(nxt, R0, C0, cA);
            const char* b2 = last ? nB : cB;
            G8_LDB(B0, 0, 0); G8_SCHED; G8_LDA(At, 0, 0); G8_STAGE_A(G8_SA(1, 1), c1, k1);
            G8_WAIT_L(8); G8_BAR; G8_WAIT_L(0); G8_MMA(0, 0, At, B0); G8_BAR; G8_SCHED;
            G8_LDB(B1, 0, 1); G8_STAGE_B(G8_SB(0, 0), b2, k2);
            G8_BAR; G8_WAIT_L(0); G8_MMA(0, 1, At, B1); G8_BAR;
            G8_LDA(At, 0, 1); G8_STAGE_A(G8_SA(0, 0), cA[0], k2);
            G8_BAR; G8_WAIT_L(0); G8_MMA(1, 0, At, B0); G8_BAR; G8_SCHED;
            G8_STAGE_B(G8_SB(0, 1), b2 + hstepB, k2);
            G8_WAIT_V(6); G8_BAR; G8_MMA(1, 1, At, B1); G8_BAR;
            G8_LDB(B0, 1, 0); G8_SCHED; G8_LDA(At, 1, 0); G8_STAGE_A(G8_SA(0, 1), cA[1], k2);
            G8_WAIT_L(8); G8_BAR; G8_WAIT_L(0); G8_MMA(0, 0, At, B0); G8_BAR; G8_SCHED;
            G8_LDB(B1, 1, 1); G8_STAGE_B(G8_SB(1, 0), b2, k3);
            G8_BAR; G8_WAIT_L(0); G8_MMA(0, 1, At, B1); G8_BAR;
            G8_LDA(At, 1, 1); G8_STAGE_A(G8_SA(1, 0), cA[0], k3);
            G8_BAR; G8_WAIT_L(0); G8_MMA(1, 0, At, B0); G8_BAR; G8_SCHED;
            G8_STAGE_B(G8_SB(1, 1), b2 + hstepB, k3);
            G8_WAIT_V(6); G8_BAR; G8_MMA(1, 1, At, B1); G8_BAR;
        }
        if constexpr (FP8) asm volatile("s_nop 15\n\ts_nop 15" ::: "memory");
        E(acc, cur, wr, wc, fr, fq);
        if (!has_next) break;
#pragma unroll
        for (int a = 0; a < 2; ++a)
#pragma unroll
            for (int b = 0; b < 2; ++b)
#pragma unroll
                for (int m = 0; m < 4; ++m)
#pragma unroll
                    for (int n = 0; n < 2; ++n) acc[a][b][m][n] = (f32x4){0.f, 0.f, 0.f, 0.f};
        cur = nxt; cB = nB; ++ui;
    }
    G8_WAIT_V(0);
    if (wr == 0) G8_BAR;
    G8_BAR;
#undef G8_SA
#undef G8_SB
#undef G8_STAGE_A
#undef G8_STAGE_B
#undef G8_LDA
#undef G8_LDB
#undef G8_MMA
#undef G8_WAIT_V
#undef G8_WAIT_L
#undef G8_BAR
#undef G8_SCHED
}
}
using g8::UnitD;
typedef f32x4 Acc[2][2][4][2];

struct EpiIn {
    static constexpr bool PERM = true;
    u16* H; const float* rs1; float* SSQ; float* WI;
    template <int ACT, bool DOSSQ> DI void run(const Acc& acc, const UnitD& u, int wr, int wc, int fr, int fq) const {
        const int pn = u.pn;
        float rsv[2][4];
#pragma unroll
        for (int ai = 0; ai < 2; ++ai)
#pragma unroll
            for (int m = 0; m < 4; ++m) rsv[ai][m] = rs1[u.pm * 256 + ai * 128 + wr * 64 + m * 16 + fr];
        __builtin_amdgcn_sched_barrier(0);
#pragma unroll
        for (int ai = 0; ai < 2; ++ai)
#pragma unroll
            for (int m = 0; m < 4; ++m) {
                const int row = u.pm * 256 + ai * 128 + wr * 64 + m * 16 + fr;
                const float rs = rsv[ai][m];
#pragma unroll
                for (int bj = 0; bj < 2; ++bj) {
                    f32x4 v0 = acc[ai][bj][m][0] * rs, v1 = acc[ai][bj][m][1] * rs;
                    if (ACT == 1) {
#pragma unroll
                        for (int j = 0; j < 4; ++j) { v0[j] = fast_gelu(v0[j]); v1[j] = fast_gelu(v1[j]); }
                    } else if (ACT == 2) {
#pragma unroll
                        for (int j = 0; j < 4; ++j) { v0[j] = fast_sigmoid(v0[j]); v1[j] = fast_sigmoid(v1[j]); }
                    }
                    u32x4 w; w.x = pk2(v0[0], v0[1]); w.y = pk2(v0[2], v0[3]); w.z = pk2(v1[0], v1[1]); w.w = pk2(v1[2], v1[3]);
                    *(u32x4*)(H + (size_t)row * NIN + pn * 256 + bj * 128 + wc * 32 + 8 * fq) = w;
                    if (DOSSQ) {
                        float ssq = ((v0[0] * v0[0] + v0[1] * v0[1]) + (v0[2] * v0[2] + v0[3] * v0[3])) + ((v1[0] * v1[0] + v1[1] * v1[1]) + (v1[2] * v1[2] + v1[3] * v1[3]));
                        ssq += __shfl_xor(ssq, 16); ssq += __shfl_xor(ssq, 32);
                        if (fq == 0) SSQ[(size_t)row * 32 + (pn - 2) * 8 + bj * 4 + wc] = ssq;
                        if (pn == 5 && bj == 1 && wc == 2 && fq == 0) *(f32x4*)(WI + (size_t)row * 4) = v0 * 0.5f;
                    }
                }
            }
    }
    DI void operator()(const Acc& acc, const UnitD& u, int wr, int wc, int fr, int fq) const {
        const int pn = u.pn;
        if (pn < 2) run<1, false>(acc, u, wr, wc, fr, fq);
        else if (pn < 4) run<1, true>(acc, u, wr, wc, fr, fq);
        else if (pn < 6) run<0, true>(acc, u, wr, wc, fr, fq);
        else run<2, false>(acc, u, wr, wc, fr, fq);
    }
};
struct EpiQ {
    static constexpr bool PERM = true;
    u16* Q; u16* QI; const float* SSQ;
    DI void operator()(const Acc& acc, const UnitD& u, int wr, int wc, int fr, int fq) const {
        f32x4 sq[2][4][2];
#pragma unroll
        for (int ai = 0; ai < 2; ++ai)
#pragma unroll
            for (int m = 0; m < 4; ++m) { const int row = u.pm * 256 + ai * 128 + wr * 64 + m * 16 + fr; sq[ai][m][0] = *(const f32x4*)(SSQ + (size_t)row * 32 + 16); sq[ai][m][1] = *(const f32x4*)(SSQ + (size_t)row * 32 + 20); }
        __builtin_amdgcn_sched_barrier(0);
#pragma unroll
        for (int ai = 0; ai < 2; ++ai)
#pragma unroll
            for (int m = 0; m < 4; ++m) {
                const int row = u.pm * 256 + ai * 128 + wr * 64 + m * 16 + fr;
                const f32x4 s0 = sq[ai][m][0], s1 = sq[ai][m][1];
                const float ss = ((s0[0] + s0[1]) + (s0[2] + s0[3])) + ((s1[0] + s1[1]) + (s1[2] + s1[3]));
                const float rs = __builtin_amdgcn_rsqf(ss * (1.0f / 256.0f) + EPS);
#pragma unroll
                for (int bj = 0; bj < 2; ++bj) {
                    const int col = u.pn * 256 + bj * 128 + wc * 32 + 8 * fq;
                    const f32x4 v0 = acc[ai][bj][m][0] * rs, v1 = acc[ai][bj][m][1] * rs;
                    if (col < 1024) { u32x4 w; w.x = pk2(v0[0], v0[1]); w.y = pk2(v0[2], v0[3]); w.z = pk2(v1[0], v1[1]); w.w = pk2(v1[2], v1[3]); *(u32x4*)(Q + (size_t)row * 1024 + col) = w; }
                    else { u32x2 w; w.x = pk4_i8(v0[0], v0[1], v0[2], v0[3]); w.y = pk4_i8(v1[0], v1[1], v1[2], v1[3]); *(u32x2*)((unsigned char*)QI + (size_t)row * 256 + (col - 1024)) = w; }
                }
            }
    }
};
template <int SECOND> struct EpiMrg {
    static constexpr bool PERM = true;
    u16* OUT; const u16* TMP; const u16* H;
    DI void operator()(const Acc& acc, const UnitD& u, int wr, int wc, int fr, int fq) const {
#pragma unroll
        for (int ai = 0; ai < 2; ++ai) {
            u32x4 g[4][2], tp[4][2];
#pragma unroll
            for (int m = 0; m < 4; ++m)
#pragma unroll
                for (int bj = 0; bj < 2; ++bj) {
                    const int row = u.pm * 256 + ai * 128 + wr * 64 + m * 16 + fr, col = u.pn * 256 + bj * 128 + wc * 32 + 8 * fq;
                    g[m][bj] = *(const u32x4*)(H + (size_t)row * NIN + 1536 + SECOND * 1024 + col);
                    if (SECOND) tp[m][bj] = *(const u32x4*)(TMP + (size_t)row * 1024 + col);
                }
            __builtin_amdgcn_sched_barrier(0);
#pragma unroll
            for (int m = 0; m < 4; ++m)
#pragma unroll
                for (int bj = 0; bj < 2; ++bj) {
                    const int row = u.pm * 256 + ai * 128 + wr * 64 + m * 16 + fr, col = u.pn * 256 + bj * 128 + wc * 32 + 8 * fq;
                    const u32x4 gg = g[m][bj];
                    f32x4 v0 = acc[ai][bj][m][0], v1 = acc[ai][bj][m][1];
                    v0[0] *= bflo(gg.x); v0[1] *= bfhi(gg.x); v0[2] *= bflo(gg.y); v0[3] *= bfhi(gg.y); v1[0] *= bflo(gg.z); v1[1] *= bfhi(gg.z); v1[2] *= bflo(gg.w); v1[3] *= bfhi(gg.w);
                    if (SECOND) { const u32x4 t = tp[m][bj];
                        v0[0] += bflo(t.x); v0[1] += bfhi(t.x); v0[2] += bflo(t.y); v0[3] += bfhi(t.y); v1[0] += bflo(t.z); v1[1] += bfhi(t.z); v1[2] += bflo(t.w); v1[3] += bfhi(t.w); }
                    u32x4 w; w.x = pk2(v0[0], v0[1]); w.y = pk2(v0[2], v0[3]); w.z = pk2(v1[0], v1[1]); w.w = pk2(v1[2], v1[3]);
                    *(u32x4*)(OUT + (size_t)row * 1024 + col) = w;
                }
            __builtin_amdgcn_sched_barrier(0);
        }
    }
};
struct EpiOut {
    static constexpr bool PERM = false;
    float* out; const float* x;
    DI void operator()(const Acc& acc, const UnitD& u, int wr, int wc, int fr, int fq) const {
#pragma unroll
        for (int ai = 0; ai < 2; ++ai) {
            f32x4 xv[4][2][2];
#pragma unroll
            for (int m = 0; m < 4; ++m)
#pragma unroll
                for (int bj = 0; bj < 2; ++bj)
#pragma unroll
                    for (int n = 0; n < 2; ++n)
                        xv[m][bj][n] = *(const f32x4*)(x + (size_t)(u.pm * 256 + ai * 128 + wr * 64 + m * 16 + fr) * 1024 + u.pn * 256 + bj * 128 + wc * 32 + n * 16 + 4 * fq);
            __builtin_amdgcn_sched_barrier(0);
#pragma unroll
            for (int m = 0; m < 4; ++m)
#pragma unroll
                for (int bj = 0; bj < 2; ++bj)
#pragma unroll
                    for (int n = 0; n < 2; ++n)
                        *(f32x4*)(out + (size_t)(u.pm * 256 + ai * 128 + wr * 64 + m * 16 + fr) * 1024 + u.pn * 256 + bj * 128 + wc * 32 + n * 16 + 4 * fq) = xv[m][bj][n] + acc[ai][bj][m][n];
            __builtin_amdgcn_sched_barrier(0);
        }
    }
};

constexpr int MOE_TAB = g8::STAGE_BYTES;
DI void moe_table(LAS unsigned char* lds, const unsigned* CNT) {
    LAS int* tab = (LAS int*)(lds + MOE_TAB);
    __syncthreads();
    if (threadIdx.x == 0) { int acc = 0; for (int e = 0; e < NE; ++e) { const int c = (int)__hip_atomic_load(CNT + e, __ATOMIC_RELAXED, __HIP_MEMORY_SCOPE_AGENT); tab[e] = acc; tab[33 + e] = c; acc += (c + 255) >> 8; } tab[32] = acc; }
    __syncthreads();
}
template <int NPN, bool GATHER> struct MoeSched {
    const char* Abase; const char* Wbase; const int* LTOK; LAS const int* tab; int lda, ldb, K, G, c; size_t wstride; static constexpr int esz = 1;
    DI bool next(int i, UnitD& u) const {
        const long L = (long)i * G + c; const int R = tab[32];
        if (L >= (long)R * NPN) return false;
        const int rbg = (int)(L / NPN), pn = (int)(L % NPN);
        int e = 0;
        for (int j = 1; j < NE; ++j) e += (tab[j] <= rbg) ? 1 : 0;
        e = __builtin_amdgcn_readfirstlane(e);
        u.pm = rbg; u.pn = pn; u.e = e; u.rb = rbg - tab[e];
        u.Bp = Wbase + (size_t)e * wstride + (size_t)pn * 256 * ldb * esz;
        return true;
    }
    DI void a_offs(const UnitD& u, int R0, int C0, unsigned (&o)[2][2]) const {
        const int cnt = tab[33 + u.e];
#pragma unroll
        for (int h = 0; h < 2; ++h)
#pragma unroll
            for (int i = 0; i < 2; ++i) {
                const int r = h * 128 + R0 + 64 * i;
                if (GATHER) { const int slot = u.rb * 256 + r; const int tok = slot < cnt ? LTOK[(size_t)u.e * ECAP + slot] : 0; o[h][i] = (unsigned)((size_t)tok * lda * esz + C0 * 2); }
                else o[h][i] = (unsigned)((size_t)(u.pm * 256 + r) * lda * esz + C0 * 2);
            }
    }
};
struct EpiMoe1 {
    static constexpr bool PERM = true;
    unsigned char* ACT; const float* b1;
    DI void operator()(const Acc& acc, const UnitD& u, int wr, int wc, int fr, int fq) const {
        const float* be = b1 + (size_t)u.e * 2048;
        const int hc = u.pn * 128 + wc * 32 + 8 * fq;
        const f32x4 bg0 = *(const f32x4*)(be + hc), bg1 = *(const f32x4*)(be + hc + 4), bu0 = *(const f32x4*)(be + 1024 + hc), bu1 = *(const f32x4*)(be + 1024 + hc + 4);
        __builtin_amdgcn_sched_barrier(0);
#pragma unroll
        for (int ai = 0; ai < 2; ++ai)
#pragma unroll
            for (int m = 0; m < 4; ++m) {
                const int row = u.pm * 256 + ai * 128 + wr * 64 + m * 16 + fr;
                float av[8];
#pragma unroll
                for (int n = 0; n < 2; ++n) {
                    const f32x4 g = acc[ai][0][m][n] * 0.015625f + (n ? bg1 : bg0), up = acc[ai][1][m][n] * 0.015625f + (n ? bu1 : bu0);
#pragma unroll
                    for (int j = 0; j < 4; ++j) {
                        const float hg = fminf(g[j], 7.0f), hu = __builtin_amdgcn_fmed3f(up[j], -7.0f, 7.0f);
                        av[4 * n + j] = (hu + 1.0f) * (hg * __builtin_amdgcn_rcpf(1.0f + __builtin_amdgcn_exp2f(hg * -2.4554669595930157f)));
                    }
                }
                u32x2 w; w.x = pk4_fp8(av[0], av[1], av[2], av[3]); w.y = pk4_fp8(av[4], av[5], av[6], av[7]);
                *(u32x2*)(ACT + (size_t)row * 1024 + hc) = w;
            }
    }
};
struct EpiMoe2 {
    static constexpr bool PERM = true;
    u16* YB; const float* b2; const float* LGATE; LAS const int* tab;
    DI void operator()(const Acc& acc, const UnitD& u, int wr, int wc, int fr, int fq) const {
        const float* be = b2 + (size_t)u.e * 1024; const int cnt = tab[33 + u.e];
        float gate[2][4]; f32x4 bias[2][2];
#pragma unroll
        for (int ai = 0; ai < 2; ++ai)
#pragma unroll
            for (int m = 0; m < 4; ++m) { const int slot = u.rb * 256 + ai * 128 + wr * 64 + m * 16 + fr; gate[ai][m] = slot < cnt ? LGATE[(size_t)u.e * ECAP + slot] : 0.f; }
#pragma unroll
        for (int bj = 0; bj < 2; ++bj) { const int col = u.pn * 256 + bj * 128 + wc * 32 + 8 * fq; bias[bj][0] = *(const f32x4*)(be + col); bias[bj][1] = *(const f32x4*)(be + col + 4); }
        __builtin_amdgcn_sched_barrier(0);
#pragma unroll
        for (int ai = 0; ai < 2; ++ai)
#pragma unroll
            for (int m = 0; m < 4; ++m) {
                const int r = ai * 128 + wr * 64 + m * 16 + fr;
                const float gt = gate[ai][m];
#pragma unroll
                for (int bj = 0; bj < 2; ++bj) {
                    const int col = u.pn * 256 + bj * 128 + wc * 32 + 8 * fq;
                    const f32x4 v0 = (acc[ai][bj][m][0] * 0.015625f + bias[bj][0]) * gt, v1 = (acc[ai][bj][m][1] * 0.015625f + bias[bj][1]) * gt;
                    u32x4 w; w.x = pk2(v0[0], v0[1]); w.y = pk2(v0[2], v0[3]); w.z = pk2(v1[0], v1[1]); w.w = pk2(v1[2], v1[3]);
                    *(u32x4*)(YB + (size_t)(u.pm * 256 + r) * 1024 + col) = w;
                }
            }
    }
};

template <bool FP8 = false, class F> DI void tr_tile(LAS unsigned char* lds, const float* src, int ld_src, int Nsz, int k0, int n0, const float* sk, float mul, u16* dst, int ld_dst, F rowmap) {
    LAS float* t = (LAS float*)lds;
    const int tid = otid();
    __syncthreads();
#pragma unroll
    for (int it = 0; it < 2; ++it) {
        const int k = (tid >> 4) + 32 * it, n = 4 * (tid & 15);
        f32x4 v = {0.f, 0.f, 0.f, 0.f};
        if (n0 + n < Nsz) v = *(const f32x4*)(src + (size_t)(k0 + k) * ld_src + n0 + n);
        const float s = (sk ? sk[k0 + k] : 1.0f) * mul;
        t[k * 65 + n] = v[0] * s; t[k * 65 + n + 1] = v[1] * s; t[k * 65 + n + 2] = v[2] * s; t[k * 65 + n + 3] = v[3] * s;
    }
    __syncthreads();
    const int n = tid >> 3, kc = (tid & 7) * 8;
    if (FP8) {
        if (n0 + n < Nsz) {
            u32x2 w;
            w.x = pk4_fp8(t[(kc + 0) * 65 + n], t[(kc + 1) * 65 + n], t[(kc + 2) * 65 + n], t[(kc + 3) * 65 + n]);
            w.y = pk4_fp8(t[(kc + 4) * 65 + n], t[(kc + 5) * 65 + n], t[(kc + 6) * 65 + n], t[(kc + 7) * 65 + n]);
            *(u32x2*)((unsigned char*)dst + (size_t)rowmap(n0 + n) * ld_dst + k0 + kc) = w;
        }
    } else if (n0 + n < Nsz) {
        u32x4 w;
        w.x = pk2(t[(kc + 0) * 65 + n], t[(kc + 1) * 65 + n]); w.y = pk2(t[(kc + 2) * 65 + n], t[(kc + 3) * 65 + n]);
        w.z = pk2(t[(kc + 4) * 65 + n], t[(kc + 5) * 65 + n]); w.w = pk2(t[(kc + 6) * 65 + n], t[(kc + 7) * 65 + n]);
        *(u32x4*)(dst + (size_t)rowmap(n0 + n) * ld_dst + k0 + kc) = w;
    }
}
struct MapId { DI int operator()(int n) const { return n; } };
struct MapIn { DI int operator()(int n) const { return n < 1476 ? n : n + 60; } };
struct MapE1 { DI int operator()(int n) const { const int hi = n >= 1024 ? 1 : 0, q = n - hi * 1024; return (q >> 7) * 256 + hi * 128 + (q & 127); } };

DI void phase0(const Args& a, LAS unsigned char* lds) {
    unsigned char* ws = a.ws;
    const int tid = otid();
    const size_t gtid = (size_t)blockIdx.x * NT + tid, gstride = (size_t)gridDim.x * NT;
    for (size_t i = gtid; i < 60 * 1024 / 2; i += gstride) ((unsigned*)(ws + WS_WIN + (size_t)1476 * 1024 * 2))[i] = 0u;
    for (size_t i = gtid; i < 32 * 1024; i += gstride) { const int e = (int)(i >> 10), k = (int)(i & 1023); const float w = a.in[I_WR][k * 32 + e] * a.in[I_N2G][k]; const u16 h = f2bf(w); ((u16*)(ws + WS_WR))[i] = h; ((u16*)(ws + WS_WR))[32 * 1024 + i] = f2bf(w - bf2f(h)); }
    for (size_t i = gtid; i < 4 * 128 * 128; i += gstride) { const int tt = (int)((i >> 7) & 127), ss = (int)(i & 127); ((u16*)(ws + WS_WSP))[i] = f2bf(ss <= tt ? a.in[I_WSP][i] : 0.f); }
    {
        const int wid = tid >> 6, lane = tid & 63;
        for (int row = blockIdx.x * 8 + wid; row < T; row += gridDim.x * 8) {
            const float* xr = a.in[I_X] + (size_t)row * 1024; u16* xb = (u16*)(ws + WS_XB) + (size_t)row * 1024;
            float ss = 0.f;
#pragma unroll
            for (int i = 0; i < 4; ++i) {
                const f32x4 v = *(const f32x4*)(xr + i * 256 + lane * 4);
                ss += (v[0] * v[0] + v[1] * v[1]) + (v[2] * v[2] + v[3] * v[3]);
                u32x2 w; w.x = pk2(v[0], v[1]); w.y = pk2(v[2], v[3]);
                *(u32x2*)(xb + i * 256 + lane * 4) = w;
            }
#pragma unroll
            for (int o = 32; o >= 1; o >>= 1) ss += __shfl_xor(ss, o);
            if (lane == 0) ((float*)(ws + WS_RS1))[row] = __builtin_amdgcn_rsqf(ss * (1.0f / 1024.0f) + EPS);
        }
    }
    constexpr int U_IN = 16 * 56, U_UQ = 4 * 16, U_QI = 4 * 4, U_PA = 8 * 16, U_OUT = 16 * 16, U_CB = 64;
    constexpr int U_TOT = U_IN + U_UQ + U_QI + U_PA + U_OUT + U_CB;
    for (int u = blockIdx.x; u < U_TOT; u += gridDim.x) {
        int v = u;
        if (v < U_IN) { tr_tile(lds, a.in[I_WIN], 3524, 3524, (v & 15) * 64, (v >> 4) * 64, a.in[I_N1G], 1.0f, (u16*)(ws + WS_WIN), 1024, MapIn()); continue; }
        v -= U_IN;
        if (v < U_UQ) { tr_tile(lds, a.in[I_WUQ], 1024, 1024, (v & 3) * 64, (v >> 2) * 64, a.in[I_QLG], 1.0f, (u16*)(ws + WS_WQ), 256, MapId()); continue; }
        v -= U_UQ;
        if (v < U_QI) { tr_tile(lds, a.in[I_WQI], 256, 256, (v & 3) * 64, (v >> 2) * 64, a.in[I_QLG], 1.0f, (u16*)(ws + WS_WQ) + 1024 * 256, 256, MapId()); continue; }
        v -= U_QI;
        if (v < U_PA) { tr_tile(lds, a.in[I_WPA], 1024, 1024, (v & 7) * 64, (v >> 3) * 64, nullptr, 1.0f, (u16*)(ws + WS_WCAT), 1536, MapId()); continue; }
        v -= U_PA;
        if (v < U_OUT) { tr_tile(lds, a.in[I_WOUT], 1024, 1024, (v & 15) * 64, (v >> 4) * 64, nullptr, 1.0f, (u16*)(ws + WS_WOUT), 1024, MapId()); continue; }
        v -= U_OUT;
        {
            const int h = v >> 3, c0 = (v & 7) * 16;
            LAS float* t = (LAS float*)lds;
            __syncthreads();
            for (int i = tid; i < 1024; i += NT) t[i] = a.in[I_WUV][(size_t)h * 128 * 64 + (size_t)c0 * 64 + i];
            __syncthreads();
            for (int nn = tid; nn < 1024; nn += NT) {
                float accv[16];
#pragma unroll
                for (int i = 0; i < 16; ++i) accv[i] = 0.f;
                for (int vv = 0; vv < 64; ++vv) {
                    const float pb = a.in[I_WPB][(size_t)(h * 64 + vv) * 1024 + nn];
#pragma unroll
                    for (int i = 0; i < 16; ++i) accv[i] += t[i * 64 + vv] * pb;
                }
                u32x4 w0, w1;
                w0.x = pk2(accv[0], accv[1]); w0.y = pk2(accv[2], accv[3]); w0.z = pk2(accv[4], accv[5]); w0.w = pk2(accv[6], accv[7]);
                w1.x = pk2(accv[8], accv[9]); w1.y = pk2(accv[10], accv[11]); w1.z = pk2(accv[12], accv[13]); w1.w = pk2(accv[14], accv[15]);
                u16* d = (u16*)(ws + WS_WCAT) + (size_t)nn * 1536 + 512 + h * 128 + c0;
                *(u32x4*)d = w0; *(u32x4*)(d + 8) = w1;
            }
        }
    }
}

DI void gmlp_unit(const Args& a, LAS unsigned char* lds, int u) {
    unsigned char* ws = a.ws;
    const int tid = otid(), wid = tid >> 6, lane = tid & 63, fr = lane & 15, fq = lane >> 4;
    const int g = u & 3, row0 = (u >> 2) * 128;
    const u16* H = (const u16*)(ws + WS_H);
    LAS u16* img = (LAS u16*)lds;
    __syncthreads();
    {
        const int s = tid & 127, cset = tid >> 7;
        const f32x4 sq = *(const f32x4*)((const float*)(ws + WS_SSQ) + (size_t)(row0 + s) * 32 + g * 4);
        const float rs = __builtin_amdgcn_rsqf(((sq[0] + sq[1]) + (sq[2] + sq[3])) * (1.0f / 128.0f) + EPS);
#pragma unroll
        for (int it = 0; it < 4; ++it) {
            const int c = cset + 4 * it;
            const u32x4 raw = *(const u32x4*)(H + (size_t)(row0 + s) * NIN + 512 + g * 128 + 8 * c);
            const float* vg = a.in[I_VG] + 8 * c;
            float f[8] = {bflo(raw.x), bfhi(raw.x), bflo(raw.y), bfhi(raw.y), bflo(raw.z), bfhi(raw.z), bflo(raw.w), bfhi(raw.w)};
#pragma unroll
            for (int i = 0; i < 8; ++i) img[(8 * c + i) * 136 + s] = f2bf(f[i] * rs * vg[i]);
        }
    }
    __syncthreads();
    const u16* W = (const u16*)(ws + WS_WSP) + (size_t)g * 128 * 128 + (size_t)(16 * wid + fr) * 128;
    f32x4 acc[8];
#pragma unroll
    for (int i = 0; i < 8; ++i) acc[i] = (f32x4){0.f, 0.f, 0.f, 0.f};
    const int nks = (16 * wid + 15) / 32 + 1;
    for (int ks = 0; ks < nks; ++ks) {
        const bf16x8 bw = *(const bf16x8*)(W + ks * 32 + 8 * fq);
#pragma unroll
        for (int i = 0; i < 8; ++i) {
            const bf16x8 av = *(const LAS bf16x8*)(img + (16 * i + fr) * 136 + ks * 32 + 8 * fq);
            acc[i] = __builtin_amdgcn_mfma_f32_16x16x32_bf16(av, bw, acc[i], 0, 0, 0);
        }
    }
    const int t = 16 * wid + fr;
    const float bias = a.in[I_BSP][g * 128 + t];
    u16* YO = (u16*)(ws + WS_YO);
#pragma unroll
    for (int i = 0; i < 8; ++i) {
        const int d = 16 * i + 4 * fq;
        const u32x2 uu = *(const u32x2*)(H + (size_t)(row0 + t) * NIN + g * 128 + d);
        const float y0 = bflo(uu.x) * (acc[i][0] + bias), y1 = bfhi(uu.x) * (acc[i][1] + bias), y2 = bflo(uu.y) * (acc[i][2] + bias), y3 = bfhi(uu.y) * (acc[i][3] + bias);
        u32x2 w; w.x = pk2(y0, y1); w.y = pk2(y2, y3);
        *(u32x2*)(YO + (size_t)(row0 + t) * 1536 + g * 128 + d) = w;
    }
}

DI void kvnorm(const Args& a) {
    unsigned char* ws = a.ws;
    const u16* H = (const u16*)(ws + WS_H); const float* SSQ = (const float*)(ws + WS_SSQ);
    const size_t gtid = (size_t)blockIdx.x * NT + otid(), gstride = (size_t)gridDim.x * NT;
    for (size_t idx = gtid; idx < (size_t)T * 24; idx += gstride) {
        const int row = (int)(idx / 24), c = (int)(idx % 24);
        const u16* src; u16* dst; const float* gain; float rs;
        if (c < 16) {
            const f32x4 sq = *(const f32x4*)(SSQ + (size_t)row * 32 + 24);
            rs = __builtin_amdgcn_rsqf(((sq[0] + sq[1]) + (sq[2] + sq[3])) * (1.0f / 128.0f) + EPS);
            src = H + (size_t)row * NIN + 1280 + 8 * c; dst = (u16*)(ws + WS_KVN) + (size_t)row * 128 + 8 * c; gain = a.in[I_KVG] + 8 * c;
        } else {
            const int cc = c - 16;
            rs = __builtin_amdgcn_rsqf((SSQ[(size_t)row * 32 + 28] + SSQ[(size_t)row * 32 + 29]) * (1.0f / 64.0f) + EPS);
            src = H + (size_t)row * NIN + 1408 + 8 * cc; dst = nullptr; gain = a.in[I_KIG] + 8 * cc;
            const u32x4 raw = *(const u32x4*)src;
            u32x2 w8;
            w8.x = pk4_i8(bflo(raw.x) * rs * gain[0], bfhi(raw.x) * rs * gain[1], bflo(raw.y) * rs * gain[2], bfhi(raw.y) * rs * gain[3]);
            w8.y = pk4_i8(bflo(raw.z) * rs * gain[4], bfhi(raw.z) * rs * gain[5], bflo(raw.w) * rs * gain[6], bfhi(raw.w) * rs * gain[7]);
            *(u32x2*)(ws + WS_KIN + (size_t)row * 64 + 8 * cc) = w8;
            continue;
        }
        const u32x4 raw = *(const u32x4*)src;
        u32x4 w;
        w.x = pk2(bflo(raw.x) * rs * gain[0], bfhi(raw.x) * rs * gain[1]); w.y = pk2(bflo(raw.y) * rs * gain[2], bfhi(raw.y) * rs * gain[3]);
        w.z = pk2(bflo(raw.z) * rs * gain[4], bfhi(raw.z) * rs * gain[5]); w.w = pk2(bflo(raw.w) * rs * gain[6], bfhi(raw.w) * rs * gain[7]);
        *(u32x4*)dst = w;
    }
}

constexpr int P3_ROWS = 0, P3_HIST = 131072, P3_LIST = 147456;
DI unsigned f2key(float f) { const unsigned u = __float_as_uint(f); return (u & 0x80000000u) ? ~u : (u | 0x80000000u); }
DI int wave_incl_scan(int v, int lane) {
#pragma unroll
    for (int o = 1; o < 64; o <<= 1) { const int t = __shfl_up(v, o); if (lane >= o) v += t; }
    return v;
}
DI int wave_suffix_scan(int v, int lane) {
#pragma unroll
    for (int o = 1; o < 64; o <<= 1) { const int t = __shfl_down(v, o); if (lane + o < 64) v += t; }
    return v;
}
DI unsigned pk_gt(unsigned kw, unsigned xw, unsigned one) {
    unsigned d, m;
    asm("v_pk_sub_u16 %0, %1, %2 clamp" : "=v"(d) : "v"(kw), "v"(xw));
    asm("v_pk_min_u16 %0, %1, %2" : "=v"(m) : "v"(d), "v"(one));
    return m;
}
DI unsigned pk_subs(unsigned kw, unsigned xw) { unsigned d; asm("v_pk_sub_u16 %0, %1, %2 clamp" : "=v"(d) : "v"(kw), "v"(xw)); return d; }
DI unsigned pk_min1(unsigned d, unsigned one) { unsigned m; asm("v_pk_min_u16 %0, %1, %2" : "=v"(m) : "v"(d), "v"(one)); return m; }
DI unsigned pk_max(unsigned a, unsigned b) { unsigned r; asm("v_pk_max_u16 %0, %1, %2" : "=v"(r) : "v"(a), "v"(b)); return r; }
DI unsigned pk_add(unsigned a, unsigned b) { unsigned r; asm("v_pk_add_u16 %0, %1, %2" : "=v"(r) : "v"(a), "v"(b)); return r; }
DI int wave_sum(int v) {
    v += __builtin_amdgcn_update_dpp(0, v, 0xB1, 0xf, 0xf, false);
    v += __builtin_amdgcn_update_dpp(0, v, 0x4E, 0xf, 0xf, false);
    v += __builtin_amdgcn_update_dpp(0, v, 0x141, 0xf, 0xf, false);
    v += __builtin_amdgcn_update_dpp(0, v, 0x140, 0xf, 0xf, false);
    return __builtin_amdgcn_readlane(v, 0) + __builtin_amdgcn_readlane(v, 16) + __builtin_amdgcn_readlane(v, 32) + __builtin_amdgcn_readlane(v, 48);
}
DI int rowaddr(int p) { return (p & ~511) | ((p & 63) << 3) | ((p >> 6) & 7); }
typedef unsigned short us2_t __attribute__((ext_vector_type(2)));
DI unsigned dot2acc(unsigned flags, unsigned wts, unsigned acc) { return __builtin_amdgcn_udot2(__builtin_bit_cast(us2_t, flags), __builtin_bit_cast(us2_t, wts), acc, false); }
DI void keys_load(LAS u16* row, int N, int lane, u32x4 (&kr)[16]) {
    const int Nup = (N + 511) & ~511, niter = Nup >> 9;
    for (int p = N + lane; p < Nup; p += 64) row[rowaddr(p)] = (u16)0;
    wave_lds_sync();
#pragma unroll
    for (int i = 0; i < 16; ++i) { kr[i] = (u32x4){0u, 0u, 0u, 0u}; if (i < niter) kr[i] = *(LAS const u32x4*)(row + i * 512 + lane * 8); }
    wave_lds_sync();
}
DI void keys_select(const u32x4 (&kr)[16], LAS u16* list, int N, int lane) {
    const int Nup = (N + 511) & ~511, niter = Nup >> 9;
    const unsigned one = 0x00010001u;
    auto count_gt = [&](unsigned x) -> int {
        const unsigned xw = x | (x << 16);
        unsigned acc = 0u, acc1 = 0u, acc2 = 0u, acc3 = 0u;
#pragma unroll
        for (int c = 0; c < 4; ++c) {
            if (4 * c < niter) {
#pragma unroll
                for (int h = 0; h < 2; ++h) {
                    unsigned d[8];
#pragma unroll
                    for (int i = 0; i < 2; ++i) { const u32x4 kk = kr[4 * c + 2 * h + i]; d[4 * i] = pk_subs(kk.x, xw); d[4 * i + 1] = pk_subs(kk.y, xw); d[4 * i + 2] = pk_subs(kk.z, xw); d[4 * i + 3] = pk_subs(kk.w, xw); }
#pragma unroll
                    for (int i = 0; i < 8; ++i) d[i] = pk_min1(d[i], one);
#pragma unroll
                    for (int i = 0; i < 8; i += 4) { acc = dot2acc(d[i], one, acc); acc1 = dot2acc(d[i + 1], one, acc1); acc2 = dot2acc(d[i + 2], one, acc2); acc3 = dot2acc(d[i + 3], one, acc3); }
                }
            }
        }
        return wave_sum((int)((acc + acc1) + (acc2 + acc3)));
    };
    unsigned T = 0u; int cge = Nup, topbit = 15;
    {
        unsigned mx = 0u;
#pragma unroll
        for (int c = 0; c < 4; ++c) {
            if (4 * c < niter) {
#pragma unroll
                for (int i = 4 * c; i < 4 * c + 4; ++i) { mx = pk_max(mx, kr[i].x); mx = pk_max(mx, kr[i].y); mx = pk_max(mx, kr[i].z); mx = pk_max(mx, kr[i].w); }
            }
        }
        unsigned m1 = max(mx & 0xffffu, mx >> 16);
        m1 = max(m1, (unsigned)__builtin_amdgcn_update_dpp(0, (int)m1, 0xB1, 0xf, 0xf, false)); m1 = max(m1, (unsigned)__builtin_amdgcn_update_dpp(0, (int)m1, 0x4E, 0xf, 0xf, false));
        m1 = max(m1, (unsigned)__builtin_amdgcn_update_dpp(0, (int)m1, 0x141, 0xf, 0xf, false)); m1 = max(m1, (unsigned)__builtin_amdgcn_update_dpp(0, (int)m1, 0x140, 0xf, 0xf, false));
        const unsigned kmax = max(max((unsigned)__builtin_amdgcn_readlane((int)m1, 0), (unsigned)__builtin_amdgcn_readlane((int)m1, 16)), max((unsigned)__builtin_amdgcn_readlane((int)m1, 32), (unsigned)__builtin_amdgcn_readlane((int)m1, 48)));
        if (kmax > 1024u) {
            const unsigned lo = kmax - 1023u;
            const int clo = count_gt(lo - 1u);
            if (clo >= 256) { T = lo; cge = clo; topbit = 9; }
        }
    }
#pragma unroll 1
    for (int bit = topbit; bit >= 0; --bit) {
        const unsigned cand = topbit == 15 ? (T | (1u << bit)) : (T + (1u << bit));
        if (cand > 0xffffu) continue;
        const int cnt = count_gt(cand - 1u);
        if (cnt >= 256) { T = cand; cge = cnt; }
    }
    auto build = [&](unsigned x, unsigned (&M)[4]) {
        const unsigned xw = x | (x << 16);
#pragma unroll
        for (int c = 0; c < 4; ++c) {
            M[c] = 0u;
            if (4 * c < niter) {
#pragma unroll
                for (int i = 4 * c; i < 4 * c + 4; ++i) {
                    unsigned byte = dot2acc(pk_gt(kr[i].x, xw, one), 0x00020001u, 0u);
                    byte = dot2acc(pk_gt(kr[i].y, xw, one), 0x00080004u, byte);
                    byte = dot2acc(pk_gt(kr[i].z, xw, one), 0x00200010u, byte);
                    byte = dot2acc(pk_gt(kr[i].w, xw, one), 0x00800040u, byte);
                    M[c] |= byte << (8 * (i & 3));
                }
            }
        }
    };
    unsigned M[4];
    build(T - 1u, M);
    if (cge != 256) {
        unsigned G[4]; build(T, G);
        unsigned E[4];
#pragma unroll
        for (int c = 0; c < 4; ++c) E[c] = M[c] & ~G[c];
        const int need = 256 - (cge - wave_sum((int)(__builtin_popcount(E[0]) + __builtin_popcount(E[1]) + __builtin_popcount(E[2]) + __builtin_popcount(E[3]))));
        auto below = [&](int B, int c) -> unsigned { const int nb = B - 32 * c; return nb <= 0 ? 0u : (nb >= 32 ? 0xffffffffu : ((1u << nb) - 1u)); };
        auto ties_below = [&](int B) -> int {
            return wave_sum((int)(__builtin_popcount(E[0] & below(B, 0)) + __builtin_popcount(E[1] & below(B, 1)) + __builtin_popcount(E[2] & below(B, 2)) + __builtin_popcount(E[3] & below(B, 3))));
        };
        int lo = 0, hi = 127;
#pragma unroll 1
        while (lo < hi) { const int mid = (lo + hi) >> 1; if (ties_below(mid + 1) >= need) hi = mid; else lo = mid + 1; }
        const int Bs = lo, r = need - ties_below(Bs);
        const unsigned ew = Bs < 32 ? E[0] : (Bs < 64 ? E[1] : (Bs < 96 ? E[2] : E[3]));
        const bool tb = ((ew >> (Bs & 31)) & 1u) != 0u;
        const unsigned long long em = __ballot(tb);
        const bool take_row = tb && __builtin_popcountll(em & ((1ull << lane) - 1ull)) < r;
#pragma unroll
        for (int c = 0; c < 4; ++c) {
            unsigned tk = E[c] & below(Bs, c);
            if ((Bs >> 5) == c && take_row) tk |= 1u << (Bs & 31);
            M[c] = G[c] | tk;
        }
    }
    const int kl = __builtin_popcount(M[0]) + __builtin_popcount(M[1]) + __builtin_popcount(M[2]) + __builtin_popcount(M[3]);
    int wp = wave_incl_scan(kl, lane) - kl;
#pragma unroll
    for (int c = 0; c < 4; ++c) {
        unsigned m = M[c];
        while (m) { const int b = __builtin_ctz(m); list[wp] = (u16)((32 * c + b) * 64 + lane); ++wp; m &= m - 1u; }
    }
}

DI void attend(const Args& a, size_t brow, int t, int cnt, LAS const u16* list, LAS unsigned char* img, int lane, int fr, int fq) {
    const u16* Q = (const u16*)(a.ws + WS_Q); const u16* KVN = (const u16*)(a.ws + WS_KVN); u16* YO = (u16*)(a.ws + WS_YO);
    bf16x8 qf[4];
    {
        const int head = fr & 7;
        const u16* qrow = Q + (brow + t) * 1024 + head * 128;
        float f[4][8]; float ss = 0.f;
#pragma unroll
        for (int ks = 0; ks < 4; ++ks) {
            const u32x4 raw = *(const u32x4*)(qrow + ks * 32 + 8 * fq);
            f[ks][0] = bflo(raw.x); f[ks][1] = bfhi(raw.x); f[ks][2] = bflo(raw.y); f[ks][3] = bfhi(raw.y); f[ks][4] = bflo(raw.z); f[ks][5] = bfhi(raw.z); f[ks][6] = bflo(raw.w); f[ks][7] = bfhi(raw.w);
#pragma unroll
            for (int j = 0; j < 8; ++j) ss += f[ks][j] * f[ks][j];
        }
        ss += __shfl_xor(ss, 16); ss += __shfl_xor(ss, 32);
        const float rq = __builtin_amdgcn_rsqf(ss * (1.0f / 128.0f) + EPS) * (0.08838834764831845f * 1.4426950408889634f);
#pragma unroll
        for (int ks = 0; ks < 4; ++ks) {
            const float* qg = a.in[I_QNG] + ks * 32 + 8 * fq;
            u32x4 w;
            w.x = pk2(f[ks][0] * rq * qg[0], f[ks][1] * rq * qg[1]); w.y = pk2(f[ks][2] * rq * qg[2], f[ks][3] * rq * qg[3]);
            w.z = pk2(f[ks][4] * rq * qg[4], f[ks][5] * rq * qg[5]); w.w = pk2(f[ks][6] * rq * qg[6], f[ks][7] * rq * qg[7]);
            qf[ks] = __builtin_bit_cast(bf16x8, w);
        }
    }
    const int nsteps = (cnt + 31) >> 5;
    f32x4 oacc[8];
#pragma unroll
    for (int i = 0; i < 8; ++i) oacc[i] = (f32x4){0.f, 0.f, 0.f, 0.f};
    float mrun = -3.0e38f, lpart = 0.f;
    const char* kvb = (const char*)(KVN + brow * 128);
    auto issue = [&](u32x4 (&pf)[8], int pp) {
#pragma unroll
        for (int it = 0; it < 8; ++it) { const int piece = it * 64 + lane; const unsigned key = list[pp * 32 + (piece >> 4)]; pf[it] = *(const u32x4*)(kvb + (key * 256u + 16u * (unsigned)(piece & 15))); }
    };
    auto step = [&](u32x4 (&pf)[8], int pp) {
#pragma unroll
        for (int it = 0; it < 8; ++it) { const int piece = it * 64 + lane; *(LAS u32x4*)(img + (piece >> 4) * 288 + (piece & 15) * 16) = pf[it]; }
        if (pp + 2 < nsteps) issue(pf, pp + 2);
        wave_lds_sync();
        __builtin_amdgcn_sched_barrier(0);
        f32x4 sa = {0.f, 0.f, 0.f, 0.f}, sb = {0.f, 0.f, 0.f, 0.f};
#pragma unroll
        for (int ks = 0; ks < 4; ++ks) {
            const bf16x8 a0 = *(LAS const bf16x8*)(img + fr * 288 + (ks * 32 + 8 * fq) * 2), a1 = *(LAS const bf16x8*)(img + (16 + fr) * 288 + (ks * 32 + 8 * fq) * 2);
            sa = __builtin_amdgcn_mfma_f32_16x16x32_bf16(a0, qf[ks], sa, 0, 0, 0); sb = __builtin_amdgcn_mfma_f32_16x16x32_bf16(a1, qf[ks], sb, 0, 0, 0);
            if (ks == 1) __builtin_amdgcn_sched_barrier(0);
        }
        if (pp * 32 + 32 > cnt) {
            const int pb0 = pp * 32 + 4 * fq;
#pragma unroll
            for (int r = 0; r < 4; ++r) { if (pb0 + r >= cnt) sa[r] = -3.0e38f; if (pb0 + 16 + r >= cnt) sb[r] = -3.0e38f; }
        }
        float mx = fmaxf(fmaxf(fmaxf(sa[0], sa[1]), fmaxf(sa[2], sa[3])), fmaxf(fmaxf(sb[0], sb[1]), fmaxf(sb[2], sb[3])));
        mx = fmaxf(mx, __shfl_xor(mx, 16)); mx = fmaxf(mx, __shfl_xor(mx, 32));
        if (__ballot(mx > mrun) != 0ull) {
            const float mnew = fmaxf(mrun, mx), alpha = __builtin_amdgcn_exp2f(mrun - mnew);
            mrun = mnew; lpart *= alpha;
#pragma unroll
            for (int cb = 0; cb < 8; ++cb) oacc[cb] *= alpha;
        }
        float ps = 0.f;
#pragma unroll
        for (int r = 0; r < 4; ++r) { sa[r] = __builtin_amdgcn_exp2f(sa[r] - mrun); sb[r] = __builtin_amdgcn_exp2f(sb[r] - mrun); ps += sa[r] + sb[r]; }
        lpart += ps;
        u32x4 pw; pw.x = pk2(sa[0], sa[1]); pw.y = pk2(sa[2], sa[3]); pw.z = pk2(sb[0], sb[1]); pw.w = pk2(sb[2], sb[3]);
        const bf16x8 pb = __builtin_bit_cast(bf16x8, pw);
#pragma unroll
        for (int cb = 0; cb < 8; ++cb) {
            const s16x4 r0 = __builtin_amdgcn_ds_read_tr16_b64_v4i16((LAS s16x4*)(img + (4 * fq + (fr >> 2)) * 288 + (cb * 16 + 4 * (fr & 3)) * 2));
            const s16x4 r1 = __builtin_amdgcn_ds_read_tr16_b64_v4i16((LAS s16x4*)(img + (16 + 4 * fq + (fr >> 2)) * 288 + (cb * 16 + 4 * (fr & 3)) * 2));
            const bf16x8 av = {r0[0], r0[1], r0[2], r0[3], r1[0], r1[1], r1[2], r1[3]};
            oacc[cb] = __builtin_amdgcn_mfma_f32_16x16x32_bf16(av, pb, oacc[cb], 0, 0, 0);
            if (cb == 3) __builtin_amdgcn_sched_barrier(0);
        }
        wave_lds_sync();
    };
    u32x4 pf0[8], pf1[8];
    issue(pf0, 0);
    if (nsteps > 1) issue(pf1, 1);
#pragma unroll 1
    for (int pp = 0; pp < nsteps; pp += 2) {
        step(pf0, pp);
        if (pp + 1 < nsteps) step(pf1, pp + 1);
    }
    float lsum = lpart; lsum += __shfl_xor(lsum, 16); lsum += __shfl_xor(lsum, 32);
    const float inv = __builtin_amdgcn_rcpf(lsum);
    if (fr < 8) {
        u16* orow = YO + (brow + t) * 1536 + 512 + fr * 128 + 4 * fq;
#pragma unroll
        for (int cb = 0; cb < 8; ++cb) { u32x2 w; w.x = pk2(oacc[cb][0] * inv, oacc[cb][1] * inv); w.y = pk2(oacc[cb][2] * inv, oacc[cb][3] * inv); *(u32x2*)(orow + cb * 16) = w; }
    }
}

constexpr int N_CVT_JOBS = 32 * 16 * 32 + 32 * 16 * 16;
DI void cvt_job(const Args& a, LAS float* t, int J, int lane) {
    if (J >= N_CVT_JOBS) return;
    const float* src; const float* sk; unsigned char* dst; int ld, k0, n0, row;
    if (J < 16384) {
        const int e = J >> 9, w = J & 511; src = a.in[I_WE1] + (size_t)e * 1024 * 2048; ld = 2048; k0 = (w >> 5) * 64; n0 = (w & 31) * 64; sk = a.in[I_N2G]; dst = a.ws + WS_WE1 + (size_t)e * 2048 * 1024;
        const int n = n0 + lane, hi = n >= 1024 ? 1 : 0, q = n - hi * 1024; row = (q >> 7) * 256 + hi * 128 + (q & 127);
    } else {
        const int j = J - 16384, e = j >> 8, w = j & 255; src = a.in[I_WE2] + (size_t)e * 1024 * 1024; ld = 1024; k0 = (w >> 4) * 64; n0 = (w & 15) * 64; sk = nullptr; dst = a.ws + WS_WE2 + (size_t)e * 1024 * 1024;
        row = n0 + lane;
    }
    const int kl = lane >> 4, n4 = 4 * (lane & 15);
    f32x4 v[4][4];
#pragma unroll
    for (int ks = 0; ks < 4; ++ks)
#pragma unroll
        for (int i = 0; i < 4; ++i) v[ks][i] = __builtin_nontemporal_load((const f32x4*)(src + (size_t)(k0 + ks * 16 + kl + 4 * i) * ld + n0 + n4));
    unsigned char* drow = dst + (size_t)row * 1024 + k0;
#pragma unroll
    for (int ks = 0; ks < 4; ++ks) {
#pragma unroll
        for (int i = 0; i < 4; ++i) { const float sc = (sk ? sk[k0 + ks * 16 + kl + 4 * i] : 1.0f) * 64.0f; *(LAS f32x4*)(t + (kl + 4 * i) * 64 + n4) = v[ks][i] * sc; }
        wave_lds_sync();
        float c[16];
#pragma unroll
        for (int k = 0; k < 16; ++k) c[k] = t[k * 64 + lane];
        u32x4 w; w.x = pk4_fp8(c[0], c[1], c[2], c[3]); w.y = pk4_fp8(c[4], c[5], c[6], c[7]); w.z = pk4_fp8(c[8], c[9], c[10], c[11]); w.w = pk4_fp8(c[12], c[13], c[14], c[15]);
        *(u32x4*)(drow + ks * 16) = w;
        wave_lds_sync();
    }
}

DI void dsa_phase(const Args& a, LAS unsigned char* lds) {
    unsigned char* ws = a.ws;
    const int wid = __builtin_amdgcn_readfirstlane(otid() >> 6);
    LAS u16* rows = (LAS u16*)(lds + P3_ROWS);
    bool bprev = false; size_t pbrow = 0; int pt0 = 0, bbuf = 0;
    for (int gi = blockIdx.x; gi < T / 8; gi += gridDim.x) {
        const int lane = otid() & 63, fr = lane & 15, fq = lane >> 4;
        const int b = gi & 3, t0 = S - 8 - 8 * (gi >> 2);
        const size_t brow = (size_t)b * S;
        const int ntile = (t0 + 8 + 15) >> 4;
        __syncthreads();
        {
            const unsigned char* QI = (const unsigned char*)(ws + WS_QI); const unsigned char* KIN = (const unsigned char*)(ws + WS_KIN); const float* WI = (const float*)(ws + WS_WI);
            typedef int i32x4_t __attribute__((ext_vector_type(4)));
            i32x4_t qa[2]; f32x4 wi[2];
#pragma unroll
            for (int rg = 0; rg < 2; ++rg) {
                qa[rg] = *(const i32x4_t*)(QI + (brow + t0 + 4 * rg + (fr >> 2)) * 256 + (fr & 3) * 64 + 16 * fq);
                wi[rg] = *(const f32x4*)(WI + (brow + t0 + 4 * rg + fq) * 4);
            }
            auto ldk = [&](i32x4_t (&kf)[4], int jt0) {
#pragma unroll
                for (int u = 0; u < 4; ++u) {
                    const int jt = (jt0 + 8 * u) < ntile ? (jt0 + 8 * u) : (ntile - 1);
                    kf[u] = *(const i32x4_t*)(KIN + (brow + jt * 16 + fr) * 64 + 16 * fq);
                }
            };
            auto cmpk = [&](const i32x4_t (&kf)[4], int jt0) {
#pragma unroll
                for (int u = 0; u < 4; ++u) {
                    const int jt = jt0 + 8 * u;
                    if (jt < ntile) {
#pragma unroll
                        for (int rg = 0; rg < 2; ++rg) {
                            i32x4_t d = {0, 0, 0, 0};
                            d = __builtin_amdgcn_mfma_i32_16x16x64_i8(qa[rg], kf[u], d, 0, 0, 0);
                            const float sc = (((float)max(d[0], 0) * wi[rg][0] + (float)max(d[1], 0) * wi[rg][1]) + (float)max(d[2], 0) * wi[rg][2]) + (float)max(d[3], 0) * wi[rg][3];
                            rows[(4 * rg + fq) * 8192 + rowaddr(jt * 16 + fr)] = (u16)(f2key(sc) >> 16);
                        }
                    }
                }
            };
            i32x4_t kA[4], kB[4];
            if (wid < ntile) ldk(kA, wid);
            for (int jt0 = wid; jt0 < ntile; jt0 += 64) {
                const bool hasB = jt0 + 32 < ntile;
                if (hasB) ldk(kB, jt0 + 32);
                cmpk(kA, jt0);
                if (hasB) { if (jt0 + 64 < ntile) ldk(kA, jt0 + 64); cmpk(kB, jt0 + 32); }
            }
        }
        __syncthreads();
        if (wid < 4) {
            u32x4 kr[16];
            const int N0 = t0 + wid + 1, N1 = N0 + 4;
            if (N0 > 256) keys_load(rows + wid * 8192, N0, lane, kr);
            __syncthreads();
            LAS u16* l0 = (LAS u16*)(lds + (bbuf ? P3_HIST : P3_LIST) + wid * 512);
            LAS u16* l1 = l0 + 4 * 256;
            if (N0 > 256) keys_select(kr, l0, N0, lane); else { for (int p = lane; p < 256; p += 64) l0[p] = p < N0 ? (u16)p : (u16)0; }
            if (N1 > 256) { keys_load(rows + (wid + 4) * 8192, N1, lane, kr); keys_select(kr, l1, N1, lane); } else { for (int p = lane; p < 256; p += 64) l1[p] = p < N1 ? (u16)p : (u16)0; }
            {
                const int G3 = gridDim.x, c3 = blockIdx.x, it3 = (gi - c3) / G3, ntrip = (T / 8 - c3 + G3 - 1) / G3, jtot = (N_CVT_JOBS + 4 * G3 - 1) / (4 * G3);
                const int jlo = (jtot * it3 + ntrip - 1) / ntrip, jhi = (jtot * (it3 + 1) + ntrip - 1) / ntrip;
                LAS float* tcv = (LAS float*)(lds + (wid < 3 ? 135168 + wid * 4096 : 151552));
#pragma unroll 1
                for (int j = jlo; j < jhi; ++j) cvt_job(a, tcv, (j * 4 + wid) * G3 + c3, lane);
            }
        } else {
            __syncthreads();
            if (bprev) {
                LAS const u16* lp = (LAS const u16*)(lds + (bbuf ? P3_LIST : P3_HIST));
                LAS unsigned char* img = (LAS unsigned char*)(rows + (wid - 4) * 8192);
                { const int q = wid - 4, t = pt0 + q; attend(a, pbrow, t, t + 1 < 256 ? t + 1 : 256, lp + q * 256, img, lane, fr, fq); }
                { const int q = wid, t = pt0 + q; attend(a, pbrow, t, t + 1 < 256 ? t + 1 : 256, lp + q * 256, img, lane, fr, fq); }
            }
        }
        bprev = true; pbrow = brow; pt0 = t0; bbuf ^= 1;
    }
    __syncthreads();
    if (bprev) {
        const int lane = otid() & 63, fr = lane & 15, fq = lane >> 4;
        LAS const u16* lp = (LAS const u16*)(lds + (bbuf ? P3_LIST : P3_HIST));
        const int q = wid, t = pt0 + q;
        attend(a, pbrow, t, t + 1 < 256 ? t + 1 : 256, lp + q * 256, (LAS unsigned char*)(rows + wid * 8192), lane, fr, fq);
    }
}

constexpr int P6_LCNT = 0, P6_BASE = 128, P6_RSB = 256, P6_RI = 1024;
DI unsigned dpp_max_u32(unsigned v) {
    v = max(v, (unsigned)__builtin_amdgcn_update_dpp(0, (int)v, 0xB1, 0xf, 0xf, false));
    v = max(v, (unsigned)__builtin_amdgcn_update_dpp(0, (int)v, 0x4E, 0xf, 0xf, false));
    v = max(v, (unsigned)__builtin_amdgcn_update_dpp(0, (int)v, 0x141, 0xf, 0xf, false));
    v = max(v, (unsigned)__builtin_amdgcn_update_dpp(0, (int)v, 0x140, 0xf, 0xf, false));
    return v;
}
DI float key2f(unsigned k) { return __uint_as_float((k & 0x80000000u) ? (k & 0x7fffffffu) : ~k); }
DI void router_phase(const Args& a, LAS unsigned char* lds) {
    unsigned char* ws = a.ws;
    const int tid = otid(), wid = tid >> 6, lane = tid & 63, fr = lane & 15, fq = lane >> 4;
    LAS int* lcnt = (LAS int*)(lds + P6_LCNT); LAS int* lbase = (LAS int*)(lds + P6_BASE); LAS float* rsb = (LAS float*)(lds + P6_RSB); LAS int* RI = (LAS int*)(lds + P6_RI);
    const u16* WRH = (const u16*)(ws + WS_WR);
    unsigned* CNT = (unsigned*)(ws + WS_CTL);
    LAS unsigned char* WL = lds + 16384;
    __syncthreads();
    for (int i = tid; i < 64 * 128; i += NT) { const int r = i >> 7, p = i & 127; *(LAS u32x4*)(WL + r * 2064 + p * 16) = *(const u32x4*)(WRH + (size_t)r * 1024 + p * 8); }
    for (int rg = blockIdx.x; rg < T / 128; rg += gridDim.x) {
        __syncthreads();
        if (tid < 32) lcnt[tid] = 0;
        __syncthreads();
        {
            const int row = rg * 128 + wid * 16 + fr;
            const float* xr = a.out + (size_t)row * 1024 + 8 * fq;
            f32x4 acc[2] = {{0.f, 0.f, 0.f, 0.f}, {0.f, 0.f, 0.f, 0.f}};
            float ss = 0.f;
#pragma unroll 4
            for (int ks = 0; ks < 32; ++ks) {
                const f32x4 x0 = *(const f32x4*)(xr + ks * 32), x1 = *(const f32x4*)(xr + ks * 32 + 4);
                ss += ((x0[0] * x0[0] + x0[1] * x0[1]) + (x0[2] * x0[2] + x0[3] * x0[3])) + ((x1[0] * x1[0] + x1[1] * x1[1]) + (x1[2] * x1[2] + x1[3] * x1[3]));
                u32x4 hw; hw.x = pk2(x0[0], x0[1]); hw.y = pk2(x0[2], x0[3]); hw.z = pk2(x1[0], x1[1]); hw.w = pk2(x1[2], x1[3]);
                u32x4 lw; lw.x = pk2(x0[0] - bflo(hw.x), x0[1] - bfhi(hw.x)); lw.y = pk2(x0[2] - bflo(hw.y), x0[3] - bfhi(hw.y)); lw.z = pk2(x1[0] - bflo(hw.z), x1[1] - bfhi(hw.z)); lw.w = pk2(x1[2] - bflo(hw.w), x1[3] - bfhi(hw.w));
                const bf16x8 xh = __builtin_bit_cast(bf16x8, hw), xl = __builtin_bit_cast(bf16x8, lw);
#pragma unroll
                for (int nt = 0; nt < 2; ++nt) {
                    const bf16x8 wh = *(LAS const bf16x8*)(WL + (nt * 16 + fr) * 2064 + (ks * 32 + 8 * fq) * 2), wl = *(LAS const bf16x8*)(WL + (32 + nt * 16 + fr) * 2064 + (ks * 32 + 8 * fq) * 2);
                    acc[nt] = __builtin_amdgcn_mfma_f32_16x16x32_bf16(xh, wh, acc[nt], 0, 0, 0);
                    acc[nt] = __builtin_amdgcn_mfma_f32_16x16x32_bf16(xl, wh, acc[nt], 0, 0, 0);
                    acc[nt] = __builtin_amdgcn_mfma_f32_16x16x32_bf16(xh, wl, acc[nt], 0, 0, 0);
                }
            }
            ss += __shfl_xor(ss, 16); ss += __shfl_xor(ss, 32);
            const float rsrow = __builtin_amdgcn_rsqf(ss * (1.0f / 1024.0f) + EPS);
            if (fq == 0) rsb[wid * 16 + fr] = rsrow;
            {
                unsigned char* xn = ws + WS_XN2 + (size_t)row * 1024 + 8 * fq;
#pragma unroll 4
                for (int ks = 0; ks < 32; ++ks) {
                    const f32x4 x0 = *(const f32x4*)(xr + ks * 32), x1 = *(const f32x4*)(xr + ks * 32 + 4);
                    u32x2 w; w.x = pk4_fp8(x0[0] * rsrow, x0[1] * rsrow, x0[2] * rsrow, x0[3] * rsrow); w.y = pk4_fp8(x1[0] * rsrow, x1[1] * rsrow, x1[2] * rsrow, x1[3] * rsrow);
                    *(u32x2*)(xn + ks * 32) = w;
                }
            }
            wave_lds_sync();
            const float b0 = a.in[I_BR][fr], b1 = a.in[I_BR][16 + fr];
#pragma unroll
            for (int r = 0; r < 4; ++r) {
                const float rs = rsb[wid * 16 + 4 * fq + r];
                unsigned k0 = (f2key(acc[0][r] * rs + b0) & ~31u) | (unsigned)(31 - fr), k1 = (f2key(acc[1][r] * rs + b1) & ~31u) | (unsigned)(15 - fr);
                unsigned sel[4];
#pragma unroll
                for (int k = 0; k < 4; ++k) {
                    const unsigned best = dpp_max_u32(k0 > k1 ? k0 : k1);
                    sel[k] = best;
                    if (k0 == best) k0 = 0u;
                    if (k1 == best) k1 = 0u;
                }
                const float v0 = key2f(sel[0] & ~31u), e1 = __expf(key2f(sel[1] & ~31u) - v0), e2 = __expf(key2f(sel[2] & ~31u) - v0), e3 = __expf(key2f(sel[3] & ~31u) - v0);
                const float inv = 1.0f / (1.0f + e1 + e2 + e3);
                if (fr < 4) {
                    const unsigned sk = fr == 0 ? sel[0] : (fr == 1 ? sel[1] : (fr == 2 ? sel[2] : sel[3]));
                    const int e = 31 - (int)(sk & 31u);
                    const float gt = (fr == 0 ? 1.0f : (fr == 1 ? e1 : (fr == 2 ? e2 : e3))) * inv;
                    const int ls = __hip_atomic_fetch_add(lcnt + e, 1, __ATOMIC_RELAXED, __HIP_MEMORY_SCOPE_WORKGROUP);
                    const int ri = ((wid * 16 + 4 * fq + r) * 4 + fr) * 4;
                    RI[ri + 0] = e; RI[ri + 1] = ls; RI[ri + 2] = __float_as_int(gt);
                }
            }
        }
        __syncthreads();
        if (tid < 32) lbase[tid] = (int)__hip_atomic_fetch_add(CNT + tid, (unsigned)lcnt[tid], __ATOMIC_RELAXED, __HIP_MEMORY_SCOPE_AGENT);
        __syncthreads();
        {
            const int rl = tid >> 2, k = tid & 3, row = rg * 128 + rl;
            const int e = RI[tid * 4 + 0], slot = lbase[e] + RI[tid * 4 + 1];
            ((int*)(ws + WS_LTOK))[(size_t)e * ECAP + slot] = row;
            ((float*)(ws + WS_LGATE))[(size_t)e * ECAP + slot] = __int_as_float(RI[tid * 4 + 2]);
            ((unsigned*)(ws + WS_ROUTE))[(size_t)row * 4 + k] = ((unsigned)e << 16) | (unsigned)slot;
        }
    }
}

DI void combine_phase(const Args& a, LAS unsigned char* lds) {
    unsigned char* ws = a.ws;
    LAS const int* tab = (LAS const int*)(lds + MOE_TAB);
    const int tid = otid(), wid = tid >> 6, lane = tid & 63;
    const u16* YB = (const u16*)(ws + WS_YB); const unsigned* ROUTE = (const unsigned*)(ws + WS_ROUTE);
    for (int row = blockIdx.x * 8 + wid; row < T; row += gridDim.x * 8) {
        size_t pos[4];
#pragma unroll
        for (int k = 0; k < 4; ++k) { const unsigned r = ROUTE[(size_t)row * 4 + k]; const int e = (int)(r >> 16), slot = (int)(r & 0xffffu); pos[k] = (size_t)tab[e] * 256 + slot; }
        float* orow = a.out + (size_t)row * 1024;
#pragma unroll
        for (int i = 0; i < 4; ++i) {
            f32x4 v = *(const f32x4*)(orow + i * 256 + lane * 4);
#pragma unroll
            for (int k = 0; k < 4; ++k) { const u32x2 y = *(const u32x2*)(YB + pos[k] * 1024 + i * 256 + lane * 4); v[0] += bflo(y.x); v[1] += bfhi(y.x); v[2] += bflo(y.y); v[3] += bfhi(y.y); }
            *(f32x4*)(orow + i * 256 + lane * 4) = v;
        }
    }
}

#define XB_TMO      128
#define XB_XCNT(j)  (256  + 64 * (j))
#define XB_XSUB(j)  (1280 + 64 * (j))
#define XB_XGEN(j)  (2304 + 64 * (j))
#define XB_TOP      3328
#define XB_TOPGEN   3392
#define XCD_BAR_WORDS 3456
#define XB_SPIN_CAP (1u << 18)

__device__ __forceinline__ unsigned xb_ld(unsigned* p)              { return __hip_atomic_load(p, __ATOMIC_RELAXED, __HIP_MEMORY_SCOPE_AGENT); }
__device__ __forceinline__ unsigned xb_add(unsigned* p, unsigned v) { return __hip_atomic_fetch_add(p, v, __ATOMIC_RELAXED, __HIP_MEMORY_SCOPE_AGENT); }
__device__ __forceinline__ unsigned xb_xcc_id() { return (unsigned)__builtin_amdgcn_s_getreg((3 << 11) | 20) & 0xFu; }
#define XB_SPIN(cond, bar) do { unsigned _sp = 0; while (cond) { __builtin_amdgcn_s_sleep(1); \
    if ((++_sp & 255u) == 0u) { if (xb_ld(&(bar)[XB_TMO])) break; if (_sp > XB_SPIN_CAP) { atomicAdd(&(bar)[XB_TMO], 1u); break; } } } } while (0)

struct XcdBarrier {
    unsigned* bar; unsigned x;
    volatile LAS unsigned* st;
};

__device__ __forceinline__ XcdBarrier xcd_barrier_post(unsigned* bar, volatile LAS unsigned* st) {
    XcdBarrier b; b.bar = bar; b.x = xb_xcc_id(); b.st = st;
    if (threadIdx.x == 0) (void)xb_add(&bar[XB_XCNT(b.x)], 1u);
    return b;
}
__device__ __forceinline__ void xcd_barrier_complete(unsigned* bar, unsigned x, unsigned& nloc, unsigned& nx) {
    const unsigned G = gridDim.x * gridDim.y * gridDim.z;
    unsigned sum, cnt, mine, sp = 0u;
    for (;;) {
        sum = 0u; cnt = 0u; mine = 0u;
#pragma unroll
        for (unsigned j = 0; j < 16; ++j) { const unsigned c = xb_ld(&bar[XB_XCNT(j)]); sum += c; cnt += (c > 0u) ? 1u : 0u; mine = (j == x) ? c : mine; }
        if (sum == G) break;
        __builtin_amdgcn_s_sleep(1);
        if ((++sp & 255u) == 0u) { if (xb_ld(&bar[XB_TMO])) break; if (sp > XB_SPIN_CAP) { atomicAdd(&bar[XB_TMO], 1u); break; } }
    }
    nloc = mine > 0u ? mine : 1u; nx = cnt > 0u ? cnt : 1u;
}

__device__ __forceinline__ void xcd_barrier(const XcdBarrier& b) {
    asm volatile("s_waitcnt vmcnt(0)" ::: "memory");
    __syncthreads();
    if (threadIdx.x == 0) {
        unsigned* bar = b.bar;
        __builtin_amdgcn_s_waitcnt(0);
        unsigned nloc = b.st[0], nx = b.st[1];
        if (nloc == 0u) { xcd_barrier_complete(bar, b.x, nloc, nx); b.st[0] = nloc; b.st[1] = nx; }
        const unsigned old = xb_add(&bar[XB_XSUB(b.x)], 1u);
        const unsigned gen = old / nloc;
        if (old + 1u == (gen + 1u) * nloc) {
            __builtin_amdgcn_fence(__ATOMIC_RELEASE, "agent");
            asm volatile("s_waitcnt vmcnt(0)" ::: "memory");
            const unsigned og = xb_add(&bar[XB_TOP], 1u);
            const unsigned tg = og / nx;
            if (og + 1u == (tg + 1u) * nx) xb_add(&bar[XB_TOPGEN], 1u);
            else XB_SPIN(xb_ld(&bar[XB_TOPGEN]) == tg, bar);
            __builtin_amdgcn_fence(__ATOMIC_ACQUIRE, "agent");
            xb_add(&bar[XB_XGEN(b.x)], 1u);
            asm volatile("s_waitcnt vmcnt(0)" ::: "memory");
        } else {
            XB_SPIN(xb_ld(&bar[XB_XGEN(b.x)]) == gen, bar);
            __builtin_amdgcn_fence(__ATOMIC_ACQUIRE, "agent");
            asm volatile("s_waitcnt vmcnt(0)" ::: "memory");
        }
    }
    __syncthreads();
}

__global__ void __launch_bounds__(NT, 2) fwd(Args a) {
    extern __shared__ __attribute__((aligned(16))) unsigned char lds_raw[];
    LAS unsigned char* lds = (LAS unsigned char*)lds_raw;
    cg::grid_group grid = cg::this_grid();
    unsigned char* ws = a.ws;
    const int G = gridDim.x, c = blockIdx.x;
    if (threadIdx.x < 2) ((volatile LAS unsigned*)(lds + LDS_BARST))[threadIdx.x] = 0u;
    __syncthreads();
    const XcdBarrier xbar = xcd_barrier_post((unsigned*)(ws + WS_BAR), (volatile LAS unsigned*)(lds + LDS_BARST));

    phase0(a, lds);
    xcd_barrier(xbar);
    {
        g8::PlainSched s; s.Abase = (const char*)(ws + WS_XB); s.Bbase = (const char*)(ws + WS_WIN); s.lda = 1024; s.ldb = 1024; s.K = 1024; s.nM = T / 256; s.nN = NIN / 256; s.G = G; s.c = c;
        EpiIn e; e.H = (u16*)(ws + WS_H); e.rs1 = (const float*)(ws + WS_RS1); e.SSQ = (float*)(ws + WS_SSQ); e.WI = (float*)(ws + WS_WI);
        g8::gemm_phase(lds, s, e);
    }
    xcd_barrier(xbar);
    {
        g8::PlainSched s; s.Abase = (const char*)(ws + WS_H) + 1024 * 2; s.Bbase = (const char*)(ws + WS_WQ); s.lda = NIN; s.ldb = 256; s.K = 256; s.nM = T / 256; s.nN = 5; s.G = G; s.c = c;
        EpiQ e; e.Q = (u16*)(ws + WS_Q); e.QI = (u16*)(ws + WS_QI); e.SSQ = (const float*)(ws + WS_SSQ);
        g8::gemm_phase(lds, s, e);
        for (int u = c; u < 1024; u += G) gmlp_unit(a, lds, u);
        kvnorm(a);
    }
    xcd_barrier(xbar);
    dsa_phase(a, lds);
    xcd_barrier(xbar);
    {
        g8::PlainSched s; s.Abase = (const char*)(ws + WS_YO); s.Bbase = (const char*)(ws + WS_WCAT); s.lda = 1536; s.ldb = 1536; s.K = 512; s.nM = T / 256; s.nN = 4; s.G = G; s.c = c;
        EpiMrg<0> e0; e0.OUT = (u16*)(ws + WS_TMP); e0.TMP = nullptr; e0.H = (const u16*)(ws + WS_H);
        g8::gemm_phase(lds, s, e0);
        s.Abase = (const char*)(ws + WS_YO) + 512 * 2; s.Bbase = (const char*)(ws + WS_WCAT) + 512 * 2; s.K = 1024;
        EpiMrg<1> e1; e1.OUT = (u16*)(ws + WS_MRG); e1.TMP = (const u16*)(ws + WS_TMP); e1.H = (const u16*)(ws + WS_H);
        g8::gemm_phase(lds, s, e1);
    }
    xcd_barrier(xbar);
    {
        g8::PlainSched s; s.Abase = (const char*)(ws + WS_MRG); s.Bbase = (const char*)(ws + WS_WOUT); s.lda = 1024; s.ldb = 1024; s.K = 1024; s.nM = T / 256; s.nN = 4; s.G = G; s.c = c;
        EpiOut e; e.out = a.out; e.x = a.in[I_X];
        g8::gemm_phase(lds, s, e);
    }
    xcd_barrier(xbar);
    router_phase(a, lds);
    xcd_barrier(xbar);
    moe_table(lds, (const unsigned*)(ws + WS_CTL));
    {
        MoeSched<8, true> s; s.Abase = (const char*)(ws + WS_XN2); s.Wbase = (const char*)(ws + WS_WE1); s.LTOK = (const int*)(ws + WS_LTOK); s.tab = (LAS const int*)(lds + MOE_TAB);
        s.lda = 1024; s.ldb = 1024; s.K = 1024; s.G = G; s.c = c; s.wstride = (size_t)2048 * 1024;
        EpiMoe1 e; e.ACT = (unsigned char*)(ws + WS_ACT); e.b1 = a.in[I_BE1];
        g8::gemm_phase<true>(lds, s, e);
    }
    xcd_barrier(xbar);
    {
        MoeSched<4, false> s; s.Abase = (const char*)(ws + WS_ACT); s.Wbase = (const char*)(ws + WS_WE2); s.LTOK = nullptr; s.tab = (LAS const int*)(lds + MOE_TAB);
        s.lda = 1024; s.ldb = 1024; s.K = 1024; s.G = G; s.c = c; s.wstride = (size_t)1024 * 1024;
        EpiMoe2 e; e.YB = (u16*)(ws + WS_YB); e.b2 = a.in[I_BE2]; e.LGATE = (const float*)(ws + WS_LGATE); e.tab = (LAS const int*)(lds + MOE_TAB);
        g8::gemm_phase<true>(lds, s, e);
    }
    xcd_barrier(xbar);
    combine_phase(a, lds);
    if (a.mask == 0u) grid.sync();
}

extern "C" void kernel_launch(void* const* d_in, const int* in_sizes, int n_in, void* d_out, int out_size, void* d_ws, size_t ws_size, hipStream_t stream) {
    static int grid = 0;
    if (grid == 0) {
        int dev = 0, cus = 0, per_cu = 0;
        if (n_in != 23 || out_size != T * Dm || ws_size < WS_END) { fprintf(stderr, "kernel_launch: unexpected problem (n_in %d, out %d, ws %zu < %zu)\n", n_in, out_size, ws_size, (size_t)WS_END); grid = -1; return; }
        if (hipGetDevice(&dev) != hipSuccess || hipDeviceGetAttribute(&cus, hipDeviceAttributeMultiprocessorCount, dev) != hipSuccess) { grid = -1; return; }
        if (hipFuncSetAttribute((const void*)fwd, hipFuncAttributeMaxDynamicSharedMemorySize, LDS_BYTES) != hipSuccess) { fprintf(stderr, "hipFuncSetAttribute failed\n"); grid = -1; return; }
        if (hipOccupancyMaxActiveBlocksPerMultiprocessor(&per_cu, (const void*)fwd, NT, LDS_BYTES) != hipSuccess || per_cu < 1) { fprintf(stderr, "occupancy query failed (%d)\n", per_cu); grid = -1; return; }
        grid = cus;
        fprintf(stderr, "kernel_launch: cus %d per_cu %d grid %d ws %zu need %zu\n", cus, per_cu, grid, ws_size, (size_t)WS_END);
    }
    if (grid < 0) return;
    Args a{};
    for (int i = 0; i < 23; ++i) a.in[i] = (const float*)d_in[i];
    a.out = (float*)d_out; a.ws = (unsigned char*)d_ws; a.mask = 0xffffffffu; a.pad = 0u;
    if (hipMemsetAsync((char*)d_ws + WS_CTL, 0, 65536, stream) != hipSuccess) { fprintf(stderr, "memset failed\n"); return; }
    void* args[] = {&a};
    hipError_t e = hipLaunchCooperativeKernel((const void*)fwd, dim3(grid), dim3(NT), args, LDS_BYTES, stream);
    if (e != hipSuccess) fprintf(stderr, "cooperative launch failed: %s (grid %d)\n", hipGetErrorString(e), grid);
}
```

```cpp
#include <hip/hip_runtime.h>
#include <hip/hip_cooperative_groups.h>
#include <cstdio>
#include <cstdint>
namespace cg = cooperative_groups;

#define LAS __attribute__((address_space(3)))
#define DI __device__ __forceinline__
typedef unsigned short u16;
typedef short bf16x8 __attribute__((ext_vector_type(8)));
typedef short s16x4 __attribute__((ext_vector_type(4)));
typedef float f32x4 __attribute__((ext_vector_type(4)));
typedef float f32x2 __attribute__((ext_vector_type(2)));
typedef unsigned u32x4 __attribute__((ext_vector_type(4)));
typedef unsigned u32x2 __attribute__((ext_vector_type(2)));
typedef __bf16 bf2_t __attribute__((ext_vector_type(2)));
typedef int v8i_t __attribute__((ext_vector_type(8)));

constexpr int NT = 512;
constexpr int LDS_BYTES = 159744;
constexpr int Dm = 1024, Bsz = 4, S = 8192, T = Bsz * S;
constexpr int NIN = 3584;
constexpr int NE = 32, ECAP = 32768, PPAD = 131072 + NE * 256;
constexpr float EPS = 1e-6f;

constexpr size_t MiB = 1024 * 1024;
constexpr size_t WS_CTL = 0;
constexpr size_t WS_BAR = 16384;
constexpr int LDS_BARST = LDS_BYTES - 16;
constexpr size_t WS_WIN = 64 * 1024;
constexpr size_t WS_WQ = WS_WIN + (size_t)NIN * 1024 * 2;
constexpr size_t WS_WSP = WS_WQ + 1280 * 256 * 2;
constexpr size_t WS_WCAT = WS_WSP + 4 * 128 * 128 * 2;
constexpr size_t WS_WOUT = WS_WCAT + 1024 * 1536 * 2;
constexpr size_t WS_WR = WS_WOUT + 1024 * 1024 * 2;
constexpr size_t WS_WE1 = WS_WR + 32 * 1024 * 4;
constexpr size_t WS_WE2 = WS_WE1 + (size_t)32 * 2048 * 1024 * 2;
constexpr size_t WS_RS1 = WS_WE2 + (size_t)32 * 1024 * 1024 * 2;
constexpr size_t WS_SSQ = WS_RS1 + (size_t)T * 4;
constexpr size_t WS_WI = WS_SSQ + (size_t)T * 32 * 4;
constexpr size_t WS_ROUTE = WS_WI + (size_t)T * 4 * 4;
constexpr size_t WS_LTOK = WS_ROUTE + (size_t)T * 4 * 4;
constexpr size_t WS_LGATE = WS_LTOK + (size_t)NE * ECAP * 4;
constexpr size_t WS_LRS = WS_LGATE + (size_t)NE * ECAP * 4;
constexpr size_t WS_XN2 = WS_LRS + (size_t)NE * ECAP * 4;
constexpr size_t WS_R0 = WS_XN2 + (size_t)T * 1024 * 2;
constexpr size_t WS_XB = WS_R0;
constexpr size_t WS_H = WS_XB + (size_t)T * 1024 * 2;
constexpr size_t WS_Q = WS_H + (size_t)T * NIN * 2;
constexpr size_t WS_QI = WS_Q + (size_t)T * 1024 * 2;
constexpr size_t WS_KVN = WS_QI + (size_t)T * 256 * 2;
constexpr size_t WS_KIN = WS_KVN + (size_t)T * 128 * 2;
constexpr size_t WS_YO = WS_KIN + (size_t)T * 64 * 2;
constexpr size_t WS_TMP = WS_YO + (size_t)T * 1536 * 2;
constexpr size_t WS_MRG = WS_TMP + (size_t)T * 1024 * 2;
constexpr size_t WS_R0END = WS_MRG + (size_t)T * 1024 * 2;
constexpr size_t WS_ACT = WS_XB;
constexpr size_t WS_YB = WS_Q;
static_assert(WS_ACT + (size_t)PPAD * 1024 * 2 <= WS_Q, "ACT overlaps YB");
static_assert(WS_YB + (size_t)PPAD * 1024 * 2 <= WS_R0END, "YB too large");
constexpr size_t WS_END = WS_R0END;

struct Args { const float* in[23]; float* out; unsigned char* ws; unsigned mask; unsigned pad; };
enum { I_X = 0, I_N1G, I_WIN, I_QLG, I_WUQ, I_QNG, I_KVG, I_WUV, I_WQI, I_KIG, I_VG, I_WSP, I_BSP, I_WPA, I_WPB, I_WOUT, I_N2G, I_WR, I_BR, I_WE1, I_BE1, I_WE2, I_BE2 };

DI unsigned pk2(float a, float b) { f32x2 v = {a, b}; bf2_t r = __builtin_convertvector(v, bf2_t); return __builtin_bit_cast(unsigned, r); }
DI unsigned pk4_fp8(float a, float b, float c, float d) { unsigned w = 0u; w = (unsigned)__builtin_amdgcn_cvt_pk_fp8_f32(a, b, (int)w, false); w = (unsigned)__builtin_amdgcn_cvt_pk_fp8_f32(c, d, (int)w, true); return w; }
DI unsigned pk4_i8(float a, float b, float c, float d) {
    const int ia = (int)__builtin_rintf(fminf(fmaxf(a * 32.0f, -127.0f), 127.0f)), ib = (int)__builtin_rintf(fminf(fmaxf(b * 32.0f, -127.0f), 127.0f));
    const int ic = (int)__builtin_rintf(fminf(fmaxf(c * 32.0f, -127.0f), 127.0f)), id = (int)__builtin_rintf(fminf(fmaxf(d * 32.0f, -127.0f), 127.0f));
    return (unsigned)(ia & 0xff) | ((unsigned)(ib & 0xff) << 8) | ((unsigned)(ic & 0xff) << 16) | ((unsigned)(id & 0xff) << 24);
}
DI float bflo(unsigned u) { return __uint_as_float(u << 16); }
DI float bfhi(unsigned u) { return __uint_as_float(u & 0xffff0000u); }
DI u16 f2bf(float f) { return (u16)(pk2(f, 0.f) & 0xffffu); }
DI float bf2f(u16 h) { return __uint_as_float(((unsigned)h) << 16); }
DI float sigmoidf_(float x) { return __builtin_amdgcn_rcpf(1.0f + __expf(-x)); }
DI float gelu_tanh(float x) { const float u = 1.5957691216057308f * (x + 0.044715f * x * x * x); return x * sigmoidf_(u); }
DI float fast_sigmoid(float x) { return __builtin_amdgcn_rcpf(1.0f + __builtin_amdgcn_exp2f(x * -1.4426950408889634f)); }
DI float fast_gelu(float x) { const float p = __builtin_fmaf(x * x, -0.10294324f, -2.3022082f); return x * __builtin_amdgcn_rcpf(1.0f + __builtin_amdgcn_exp2f(x * p)); }
DI int otid() { int t = threadIdx.x; asm volatile("" : "+v"(t)); return t; }
DI void wave_lds_sync() { asm volatile("s_waitcnt lgkmcnt(0)" ::: "memory"); }

namespace g8 {
constexpr int BM = 256, BK = 64, HALF = 128, HTB = HALF * BK * 2, STAGE_BYTES = 8 * HTB, NXCD = 8, WGM = 8;
DI int lds_byte(int r, int c) { const int st = (r >> 4) * 2 + (c >> 5), rr = r & 15, cc = c & 31, ob = rr * 64 + cc * 2; return st * 1024 + (ob ^ (((ob >> 9) & 1) << 5)); }
DI int perm32(int rho) { const int n = rho >> 4, i = rho & 15; return 8 * (i >> 2) + 4 * n + (i & 3); }
DI void stage_rc(int b, int& R, int& C) { const int st = b / 1024, sb = b % 1024, swz = sb ^ (((sb >> 9) & 1) << 5); R = (st >> 1) * 16 + swz / 64; C = (st & 1) * 32 + (swz % 64) / 2; }

struct UnitD { const char* Bp; int pm, pn, e, rb; };

DI bool static_tile(int i, int G, int c, int nM, int nN, int& pm, int& pn) {
    const int nwg = nM * nN; const long L = (long)i * G + c; if (L >= nwg) return false;
    int wgid = (int)L; { const int q = nwg / NXCD, r = nwg % NXCD, xcd = wgid % NXCD, off = wgid / NXCD; wgid = (xcd < r ? xcd * (q + 1) : r * (q + 1) + (xcd - r) * q) + off; }
    const int nig = WGM * nN, gid = wgid / nig, fm = gid * WGM, gsz = (nM - fm) < WGM ? (nM - fm) : WGM;
    pm = fm + ((wgid % nig) % gsz); pn = (wgid % nig) / gsz; return true;
}

struct PlainSched {
    const char* Abase; const char* Bbase; int lda, ldb, K, nM, nN, G, c; static constexpr int esz = 2;
    DI bool next(int i, UnitD& u) const { int pm, pn; if (!static_tile(i, G, c, nM, nN, pm, pn)) return false; u.pm = pm; u.pn = pn; u.e = 0; u.rb = 0; u.Bp = Bbase + (size_t)pn * BM * ldb * 2; return true; }
    DI void a_offs(const UnitD& u, int R0, int C0, unsigned (&o)[2][2]) const {
#pragma unroll
        for (int h = 0; h < 2; ++h)
#pragma unroll
            for (int i = 0; i < 2; ++i) o[h][i] = (unsigned)(((size_t)(u.pm * BM + h * HALF + R0 + 64 * i) * lda + C0) * 2);
    }
};

template <bool FP8 = false, class Epi, class Sched>
DI void gemm_phase(LAS unsigned char* lds, const Sched& S, const Epi& E) {
    const int tid = otid(), wid = __builtin_amdgcn_readfirstlane(tid >> 6), lane = tid & 63, wr = wid >> 2, wc = wid & 3, fr = lane & 15, fq = lane >> 4;
    const int nt = S.K * Sched::esz / 128;
    int R0, C0; stage_rc(tid * 16, R0, C0);
    unsigned voffB[2];
#pragma unroll
    for (int i = 0; i < 2; ++i) { const int Rr = R0 + 64 * i, Rb = Epi::PERM ? ((Rr & ~31) + perm32(Rr & 31)) : Rr; voffB[i] = (unsigned)(Rb * S.ldb * Sched::esz + C0 * 2); }
    const size_t hstepB = (size_t)HALF * S.ldb * Sched::esz;
    const unsigned ldsw = (unsigned)wid * 1024u;
    const int aoff = FP8 ? lds_byte(wr * 64 + fr, fq * 16) : lds_byte(wr * 64 + fr, fq * 8), boff = FP8 ? lds_byte(wc * 32 + fr, fq * 16) : lds_byte(wc * 32 + fr, fq * 8);
    const unsigned mxscale = 0x7f7f7f7fu;
    const int kst = FP8 ? 16 : 1024;
    const char* Ab = S.Abase;
#define G8_SA(b, h) (((b) * 2 + (h)) * HTB)
#define G8_SB(b, h) ((4 + (b) * 2 + (h)) * HTB)
#define G8_STAGE_A(bufoff, offs, kb) do { _Pragma("unroll") for (int _i = 0; _i < 2; ++_i) \
        __builtin_amdgcn_global_load_lds((const unsigned*)(Ab + (size_t)(offs)[_i] + (size_t)(kb)), (LAS unsigned*)(lds + (bufoff) + ldsw + _i * 8192), 16, 0, 0); } while (0)
#define G8_STAGE_B(bufoff, gbase, kb) do { _Pragma("unroll") for (int _i = 0; _i < 2; ++_i) \
        __builtin_amdgcn_global_load_lds((const unsigned*)((gbase) + voffB[_i] + (size_t)(kb)), (LAS unsigned*)(lds + (bufoff) + ldsw + _i * 8192), 16, 0, 0); } while (0)
#define G8_LDA(dst, b, h) do { _Pragma("unroll") for (int m = 0; m < 4; ++m) { const i32x4_t _p = *(const LAS i32x4_t*)(lds + G8_SA(b, h) + aoff + m * 2048), _q = *(const LAS i32x4_t*)(lds + G8_SA(b, h) + aoff + m * 2048 + kst); dst[m] = __builtin_shufflevector(_p, _q, 0, 1, 2, 3, 4, 5, 6, 7); } } while (0)
#define G8_LDB(dst, b, h) do { _Pragma("unroll") for (int n = 0; n < 2; ++n) { const i32x4_t _p = *(const LAS i32x4_t*)(lds + G8_SB(b, h) + boff + n * 2048), _q = *(const LAS i32x4_t*)(lds + G8_SB(b, h) + boff + n * 2048 + kst); dst[n] = __builtin_shufflevector(_p, _q, 0, 1, 2, 3, 4, 5, 6, 7); } } while (0)
#define G8_MMA(ai, bj, At, Bt) do { __builtin_amdgcn_s_setprio(1); _Pragma("unroll") for (int m = 0; m < 4; ++m) _Pragma("unroll") for (int n = 0; n < 2; ++n) { \
        if constexpr (FP8) asm volatile("v_mfma_scale_f32_16x16x128_f8f6f4 %0, %1, %2, %0, %3, %3 op_sel_hi:[0,0,0]" : "+v"(acc[ai][bj][m][n]) : "v"(Bt[n]), "v"(At[m]), "v"(mxscale)); \
        else { acc[ai][bj][m][n] = __builtin_amdgcn_mfma_f32_16x16x32_bf16(__builtin_bit_cast(bf16x8, __builtin_shufflevector(Bt[n], Bt[n], 0, 1, 2, 3)), __builtin_bit_cast(bf16x8, __builtin_shufflevector(At[m], At[m], 0, 1, 2, 3)), acc[ai][bj][m][n], 0, 0, 0); \
               acc[ai][bj][m][n] = __builtin_amdgcn_mfma_f32_16x16x32_bf16(__builtin_bit_cast(bf16x8, __builtin_shufflevector(Bt[n], Bt[n], 4, 5, 6, 7)), __builtin_bit_cast(bf16x8, __builtin_shufflevector(At[m], At[m], 4, 5, 6, 7)), acc[ai][bj][m][n], 0, 0, 0); } } \
        __builtin_amdgcn_s_setprio(0); } while (0)
#define G8_WAIT_V(n) asm volatile("s_waitcnt vmcnt(" #n ")" ::: "memory")
#define G8_WAIT_L(n) asm volatile("s_waitcnt lgkmcnt(" #n ")" ::: "memory")
#define G8_BAR __builtin_amdgcn_s_barrier()
#define G8_SCHED __builtin_amdgcn_sched_barrier(0)
    UnitD cur, nxt; int ui = 0;
    if (!S.next(0, cur)) return;
    f32x4 acc[2][2][4][2];
#pragma unroll
    for (int a = 0; a < 2; ++a)
#pragma unroll
        for (int b = 0; b < 2; ++b)
#pragma unroll
            for (int m = 0; m < 4; ++m)
#pragma unroll
                for (int n = 0; n < 2; ++n) acc[a][b][m][n] = (f32x4){0.f, 0.f, 0.f, 0.f};
    typedef int i32x4_t __attribute__((ext_vector_type(4)));
    v8i_t At[4], B0[2], B1[2];
    unsigned cA[2][2];
    S.a_offs(cur, R0, C0, cA);
    const char* cB = cur.Bp;
    G8_STAGE_B(G8_SB(0, 0), cB, 0); G8_STAGE_A(G8_SA(0, 0), cA[0], 0); G8_STAGE_B(G8_SB(0, 1), cB + hstepB, 0); G8_STAGE_A(G8_SA(0, 1), cA[1], 0);
    if (wr == 1) G8_BAR;
    G8_WAIT_V(4); G8_BAR;
    G8_STAGE_B(G8_SB(1, 0), cB, 128); G8_STAGE_A(G8_SA(1, 0), cA[0], 128); G8_STAGE_B(G8_SB(1, 1), cB + hstepB, 128);
    G8_WAIT_V(6); G8_BAR;
    for (;;) {
        const bool has_next = S.next(ui + 1, nxt);
        const char* nB = has_next ? nxt.Bp : cB;
        for (int t = 0; t < nt; t += 2) {
            const bool last = (t == nt - 2);
            const unsigned k1 = (unsigned)(t + 1) * 128u;
            const unsigned k2 = last ? 0u : (unsigned)(t + 2) * 128u, k3 = k2 + 128u;
            unsigned c1[2] = {cA[1][0], cA[1][1]};
            if (last && has_next) S.a_offs(nxt, R0, C0, cA);
            const char* b2 = last ? nB : cB;
            G8_LDB(B0, 0, 0); G8_SCHED; G8_LDA(At, 0, 0); G8_STAGE_A(G8_SA(1, 1), c1, k1);
            G8_WAIT_L(8); G8_BAR; G8_WAIT_L(0); G8_MMA(0, 0, At, B0); G8_BAR; G8_SCHED;
            G8_LDB(B1, 0, 1); G8_STAGE_B(G8_SB(0, 0), b2, k2);
            G8_BAR; G8_WAIT_L(0); G8_MMA(0, 1, At, B1); G8_BAR;
            G8_LDA(At, 0, 1); G8_STAGE_A(G8_SA(0, 0), cA[0], k2);
            G8_BAR; G8_WAIT_L(0); G8_MMA(1, 0, At, B0); G8_BAR; G8_SCHED;
            G8_STAGE_B(G8_SB(0, 1), b2 + hstepB, k2);
            G8_WAIT_V(6); G8_BAR; G8_MMA(1, 1, At, B1); G8_BAR;
            G8_LDB(B0, 1, 0); G8_SCHED; G8_LDA(At, 1, 0); G8_STAGE_A(G8_SA(0, 1), cA[1], k2);
            G8_WAIT_L(8); G8_BAR; G8_WAIT_L(0); G8_MMA(0, 0, At, B0); G8_BAR; G8_SCHED;
            G8_LDB(B1, 1, 1); G8_STAGE_B(G8_SB(1, 0), b2, k3);
            G8_BAR; G8_WAIT_L(0); G8_MMA(0, 1, At, B1); G8_BAR;
            G8_LDA(At, 1, 1); G8_STAGE_A(G8_SA(1, 0), cA[0], k3);
            G8_BAR; G8_WAIT_L(0); G8_MMA(1, 0, At, B0); G8_BAR; G8_SCHED;
            G8_STAGE_B(G8_SB(1, 1), b2 + hstepB, k3);
            G8_WAIT_V(6); G8_BAR; G8_MMA(1, 1, At, B1); G8_BAR;
        }
        if constexpr (FP8) asm volatile("s_nop 15\n\ts_nop 15" ::: "memory");
        E(acc, cur, wr, wc, fr, fq);
        if (!has_next) break;
#pragma unroll
        for (int a = 0; a < 2; ++a)
#pragma unroll
            for (int b = 0; b < 2; ++b)
#pragma unroll
                for (int m = 0; m < 4; ++m)
#pragma unroll
                    for (int n = 0; n < 2; ++n) acc[a][b][m][n] = (f32x4){0.f, 0.f, 0.f, 0.f};
        cur = nxt; cB = nB; ++ui;
    }
    G8_WAIT_V(0);
    if (wr == 0) G8_BAR;
    G8_BAR;
#undef G8_SA
#undef G8_SB
#undef G8_STAGE_A
#undef G8_STAGE_B
#undef G8_LDA
#undef G8_LDB
#undef G8_MMA
#undef G8_WAIT_V
#undef G8_WAIT_L
#undef G8_BAR
#undef G8_SCHED
}
}
using g8::UnitD;
typedef f32x4 Acc[2][2][4][2];

struct EpiIn {
    static constexpr bool PERM = true;
    u16* H; const float* rs1; float* SSQ; float* WI;
    template <int ACT, bool DOSSQ> DI void run(const Acc& acc, const UnitD& u, int wr, int wc, int fr, int fq) const {
        const int pn = u.pn;
        float rsv[2][4];
#pragma unroll
        for (int ai = 0; ai < 2; ++ai)
#pragma unroll
            for (int m = 0; m < 4; ++m) rsv[ai][m] = rs1[u.pm * 256 + ai * 128 + wr * 64 + m * 16 + fr];
        __builtin_amdgcn_sched_barrier(0);
#pragma unroll
        for (int ai = 0; ai < 2; ++ai)
#pragma unroll
            for (int m = 0; m < 4; ++m) {
                const int row = u.pm * 256 + ai * 128 + wr * 64 + m * 16 + fr;
                const float rs = rsv[ai][m];
#pragma unroll
                for (int bj = 0; bj < 2; ++bj) {
                    f32x4 v0 = acc[ai][bj][m][0] * rs, v1 = acc[ai][bj][m][1] * rs;
                    if (ACT == 1) {
#pragma unroll
                        for (int j = 0; j < 4; ++j) { v0[j] = fast_gelu(v0[j]); v1[j] = fast_gelu(v1[j]); }
                    } else if (ACT == 2) {
#pragma unroll
                        for (int j = 0; j < 4; ++j) { v0[j] = fast_sigmoid(v0[j]); v1[j] = fast_sigmoid(v1[j]); }
                    }
                    u32x4 w; w.x = pk2(v0[0], v0[1]); w.y = pk2(v0[2], v0[3]); w.z = pk2(v1[0], v1[1]); w.w = pk2(v1[2], v1[3]);
                    *(u32x4*)(H + (size_t)row * NIN + pn * 256 + bj * 128 + wc * 32 + 8 * fq) = w;
                    if (DOSSQ) {
                        float ssq = ((v0[0] * v0[0] + v0[1] * v0[1]) + (v0[2] * v0[2] + v0[3] * v0[3])) + ((v1[0] * v1[0] + v1[1] * v1[1]) + (v1[2] * v1[2] + v1[3] * v1[3]));
                        ssq += __shfl_xor(ssq, 16); ssq += __shfl_xor(ssq, 32);
                        if (fq == 0) SSQ[(size_t)row * 32 + (pn - 2) * 8 + bj * 4 + wc] = ssq;
                        if (pn == 5 && bj == 1 && wc == 2 && fq == 0) *(f32x4*)(WI + (size_t)row * 4) = v0 * 0.5f;
                    }
                }
            }
    }
    DI void operator()(const Acc& acc, const UnitD& u, int wr, int wc, int fr, int fq) const {
        const int pn = u.pn;
        if (pn < 2) run<1, false>(acc, u, wr, wc, fr, fq);
        else if (pn < 4) run<1, true>(acc, u, wr, wc, fr, fq);
        else if (pn < 6) run<0, true>(acc, u, wr, wc, fr, fq);
        else run<2, false>(acc, u, wr, wc, fr, fq);
    }
};
struct EpiQ {
    static constexpr bool PERM = true;
    u16* Q; u16* QI; const float* SSQ;
    DI void operator()(const Acc& acc, const UnitD& u, int wr, int wc, int fr, int fq) const {
        f32x4 sq[2][4][2];
#pragma unroll
        for (int ai = 0; ai < 2; ++ai)
#pragma unroll
            for (int m = 0; m < 4; ++m) { const int row = u.pm * 256 + ai * 128 + wr * 64 + m * 16 + fr; sq[ai][m][0] = *(const f32x4*)(SSQ + (size_t)row * 32 + 16); sq[ai][m][1] = *(const f32x4*)(SSQ + (size_t)row * 32 + 20); }
        __builtin_amdgcn_sched_barrier(0);
#pragma unroll
        for (int ai = 0; ai < 2; ++ai)
#pragma unroll
            for (int m = 0; m < 4; ++m) {
                const int row = u.pm * 256 + ai * 128 + wr * 64 + m * 16 + fr;
                const f32x4 s0 = sq[ai][m][0], s1 = sq[ai][m][1];
                const float ss = ((s0[0] + s0[1]) + (s0[2] + s0[3])) + ((s1[0] + s1[1]) + (s1[2] + s1[3]));
                const float rs = __builtin_amdgcn_rsqf(ss * (1.0f / 256.0f) + EPS);
#pragma unroll
                for (int bj = 0; bj < 2; ++bj) {
                    const int col = u.pn * 256 + bj * 128 + wc * 32 + 8 * fq;
                    const f32x4 v0 = acc[ai][bj][m][0] * rs, v1 = acc[ai][bj][m][1] * rs;
                    if (col < 1024) { u32x4 w; w.x = pk2(v0[0], v0[1]); w.y = pk2(v0[2], v0[3]); w.z = pk2(v1[0], v1[1]); w.w = pk2(v1[2], v1[3]); *(u32x4*)(Q + (size_t)row * 1024 + col) = w; }
                    else { u32x2 w; w.x = pk4_i8(v0[0], v0[1], v0[2], v0[3]); w.y = pk4_i8(v1[0], v1[1], v1[2], v1[3]); *(u32x2*)((unsigned char*)QI + (size_t)row * 256 + (col - 1024)) = w; }
                }
            }
    }
};
template <int SECOND> struct EpiMrg {
    static constexpr bool PERM = true;
    u16* OUT; const u16* TMP; const u16* H;
    DI void operator()(const Acc& acc, const UnitD& u, int wr, int wc, int fr, int fq) const {
#pragma unroll
        for (int ai = 0; ai < 2; ++ai) {
            u32x4 g[4][2], tp[4][2];
#pragma unroll
            for (int m = 0; m < 4; ++m)
#pragma unroll
                for (int bj = 0; bj < 2; ++bj) {
                    const int row = u.pm * 256 + ai * 128 + wr * 64 + m * 16 + fr, col = u.pn * 256 + bj * 128 + wc * 32 + 8 * fq;
                    g[m][bj] = *(const u32x4*)(H + (size_t)row * NIN + 1536 + SECOND * 1024 + col);
                    if (SECOND) tp[m][bj] = *(const u32x4*)(TMP + (size_t)row * 1024 + col);
                }
            __builtin_amdgcn_sched_barrier(0);
#pragma unroll
            for (int m = 0; m < 4; ++m)
#pragma unroll
                for (int bj = 0; bj < 2; ++bj) {
                    const int row = u.pm * 256 + ai * 128 + wr * 64 + m * 16 + fr, col = u.pn * 256 + bj * 128 + wc * 32 + 8 * fq;
                    const u32x4 gg = g[m][bj];
                    f32x4 v0 = acc[ai][bj][m][0], v1 = acc[ai][bj][m][1];
                    v0[0] *= bflo(gg.x); v0[1] *= bfhi(gg.x); v0[2] *= bflo(gg.y); v0[3] *= bfhi(gg.y); v1[0] *= bflo(gg.z); v1[1] *= bfhi(gg.z); v1[2] *= bflo(gg.w); v1[3] *= bfhi(gg.w);
                    if (SECOND) { const u32x4 t = tp[m][bj];
                        v0[0] += bflo(t.x); v0[1] += bfhi(t.x); v0[2] += bflo(t.y); v0[3] += bfhi(t.y); v1[0] += bflo(t.z); v1[1] += bfhi(t.z); v1[2] += bflo(t.w); v1[3] += bfhi(t.w); }
                    u32x4 w; w.x = pk2(v0[0], v0[1]); w.y = pk2(v0[2], v0[3]); w.z = pk2(v1[0], v1[1]); w.w = pk2(v1[2], v1[3]);
                    *(u32x4*)(OUT + (size_t)row * 1024 + col) = w;
                }
            __builtin_amdgcn_sched_barrier(0);
        }
    }
};
struct EpiOut {
    static constexpr bool PERM = false;
    float* out; const float* x;
    DI void operator()(const Acc& acc, const UnitD& u, int wr, int wc, int fr, int fq) const {
#pragma unroll
        for (int ai = 0; ai < 2; ++ai) {
            f32x4 xv[4][2][2];
#pragma unroll
            for (int m = 0; m < 4; ++m)
#pragma unroll
                for (int bj = 0; bj < 2; ++bj)
#pragma unroll
                    for (int n = 0; n < 2; ++n)
                        xv[m][bj][n] = *(const f32x4*)(x + (size_t)(u.pm * 256 + ai * 128 + wr * 64 + m * 16 + fr) * 1024 + u.pn * 256 + bj * 128 + wc * 32 + n * 16 + 4 * fq);
            __builtin_amdgcn_sched_barrier(0);
#pragma unroll
            for (int m = 0; m < 4; ++m)
#pragma unroll
                for (int bj = 0; bj < 2; ++bj)
#pragma unroll
                    for (int n = 0; n < 2; ++n)
                        *(f32x4*)(out + (size_t)(u.pm * 256 + ai * 128 + wr * 64 + m * 16 + fr) * 1024 + u.pn * 256 + bj * 128 + wc * 32 + n * 16 + 4 * fq) = xv[m][bj][n] + acc[ai][bj][m][n];
            __builtin_amdgcn_sched_barrier(0);
        }
    }
};

constexpr int MOE_TAB = g8::STAGE_BYTES;
DI void moe_table(LAS unsigned char* lds, const unsigned* CNT) {
    LAS int* tab = (LAS int*)(lds + MOE_TAB);
    __syncthreads();
    if (threadIdx.x == 0) { int acc = 0; for (int e = 0; e < NE; ++e) { const int c = (int)__hip_atomic_load(CNT + e, __ATOMIC_RELAXED, __HIP_MEMORY_SCOPE_AGENT); tab[e] = acc; tab[33 + e] = c; acc += (c + 255) >> 8; } tab[32] = acc; }
    __syncthreads();
}
template <int NPN, bool GATHER> struct MoeSched {
    const char* Abase; const char* Wbase; const int* LTOK; LAS const int* tab; int lda, ldb, K, G, c; size_t wstride; static constexpr int esz = 1;
    DI bool next(int i, UnitD& u) const {
        const long L = (long)i * G + c; const int R = tab[32];
        if (L >= (long)R * NPN) return false;
        const int rbg = (int)(L / NPN), pn = (int)(L % NPN);
        int e = 0;
        for (int j = 1; j < NE; ++j) e += (tab[j] <= rbg) ? 1 : 0;
        e = __builtin_amdgcn_readfirstlane(e);
        u.pm = rbg; u.pn = pn; u.e = e; u.rb = rbg - tab[e];
        u.Bp = Wbase + (size_t)e * wstride + (size_t)pn * 256 * ldb * esz;
        return true;
    }
    DI void a_offs(const UnitD& u, int R0, int C0, unsigned (&o)[2][2]) const {
        const int cnt = tab[33 + u.e];
#pragma unroll
        for (int h = 0; h < 2; ++h)
#pragma unroll
            for (int i = 0; i < 2; ++i) {
                const int r = h * 128 + R0 + 64 * i;
                if (GATHER) { const int slot = u.rb * 256 + r; const int tok = slot < cnt ? LTOK[(size_t)u.e * ECAP + slot] : 0; o[h][i] = (unsigned)((size_t)tok * lda * esz + C0 * 2); }
                else o[h][i] = (unsigned)((size_t)(u.pm * 256 + r) * lda * esz + C0 * 2);
            }
    }
};
struct EpiMoe1 {
    static constexpr bool PERM = true;
    unsigned char* ACT; const float* b1;
    DI void operator()(const Acc& acc, const UnitD& u, int wr, int wc, int fr, int fq) const {
        const float* be = b1 + (size_t)u.e * 2048;
        const int hc = u.pn * 128 + wc * 32 + 8 * fq;
        const f32x4 bg0 = *(const f32x4*)(be + hc), bg1 = *(const f32x4*)(be + hc + 4), bu0 = *(const f32x4*)(be + 1024 + hc), bu1 = *(const f32x4*)(be + 1024 + hc + 4);
        __builtin_amdgcn_sched_barrier(0);
#pragma unroll
        for (int ai = 0; ai < 2; ++ai)
#pragma unroll
            for (int m = 0; m < 4; ++m) {
                const int row = u.pm * 256 + ai * 128 + wr * 64 + m * 16 + fr;
                float av[8];
#pragma unroll
                for (int n = 0; n < 2; ++n) {
                    const f32x4 g = acc[ai][0][m][n] * 0.015625f + (n ? bg1 : bg0), up = acc[ai][1][m][n] * 0.015625f + (n ? bu1 : bu0);
#pragma unroll
                    for (int j = 0; j < 4; ++j) {
                        const float hg = fminf(g[j], 7.0f), hu = __builtin_amdgcn_fmed3f(up[j], -7.0f, 7.0f);
                        av[4 * n + j] = (hu + 1.0f) * (hg * __builtin_amdgcn_rcpf(1.0f + __builtin_amdgcn_exp2f(hg * -2.4554669595930157f)));
                    }
                }
                u32x2 w; w.x = pk4_fp8(av[0], av[1], av[2], av[3]); w.y = pk4_fp8(av[4], av[5], av[6], av[7]);
                *(u32x2*)(ACT + (size_t)row * 1024 + hc) = w;
            }
    }
};
struct EpiMoe2 {
    static constexpr bool PERM = true;
    u16* YB; const float* b2; const float* LGATE; LAS const int* tab;
    DI void operator()(const Acc& acc, const UnitD& u, int wr, int wc, int fr, int fq) const {
        const float* be = b2 + (size_t)u.e * 1024; const int cnt = tab[33 + u.e];
        float gate[2][4]; f32x4 bias[2][2];
#pragma unroll
        for (int ai = 0; ai < 2; ++ai)
#pragma unroll
            for (int m = 0; m < 4; ++m) { const int slot = u.rb * 256 + ai * 128 + wr * 64 + m * 16 + fr; gate[ai][m] = slot < cnt ? LGATE[(size_t)u.e * ECAP + slot] : 0.f; }
#pragma unroll
        for (int bj = 0; bj < 2; ++bj) { const int col = u.pn * 256 + bj * 128 + wc * 32 + 8 * fq; bias[bj][0] = *(const f32x4*)(be + col); bias[bj][1] = *(const f32x4*)(be + col + 4); }
        __builtin_amdgcn_sched_barrier(0);
#pragma unroll
        for (int ai = 0; ai < 2; ++ai)
#pragma unroll
            for (int m = 0; m < 4; ++m) {
                const int r = ai * 128 + wr * 64 + m * 16 + fr;
                const float gt = gate[ai][m];
#pragma unroll
                for (int bj = 0; bj < 2; ++bj) {
                    const int col = u.pn * 256 + bj * 128 + wc * 32 + 8 * fq;
                    const f32x4 v0 = (acc[ai][bj][m][0] * 0.015625f + bias[bj][0]) * gt, v1 = (acc[ai][bj][m][1] * 0.015625f + bias[bj][1]) * gt;
                    u32x4 w; w.x = pk2(v0[0], v0[1]); w.y = pk2(v0[2], v0[3]); w.z = pk2(v1[0], v1[1]); w.w = pk2(v1[2], v1[3]);
                    *(u32x4*)(YB + (size_t)(u.pm * 256 + r) * 1024 + col) = w;
                }
            }
    }
};

template <bool FP8 = false, class F> DI void tr_tile(LAS unsigned char* lds, const float* src, int ld_src, int Nsz, int k0, int n0, const float* sk, float mul, u16* dst, int ld_dst, F rowmap) {
    LAS float* t = (LAS float*)lds;
    const int tid = otid();
    __syncthreads();
#pragma unroll
    for (int it = 0; it < 2; ++it) {
        const int k = (tid >> 4) + 32 * it, n = 4 * (tid & 15);
        f32x4 v = {0.f, 0.f, 0.f, 0.f};
        if (n0 + n < Nsz) v = *(const f32x4*)(src + (size_t)(k0 + k) * ld_src + n0 + n);
        const float s = (sk ? sk[k0 + k] : 1.0f) * mul;
        t[k * 65 + n] = v[0] * s; t[k * 65 + n + 1] = v[1] * s; t[k * 65 + n + 2] = v[2] * s; t[k * 65 + n + 3] = v[3] * s;
    }
    __syncthreads();
    const int n = tid >> 3, kc = (tid & 7) * 8;
    if (FP8) {
        if (n0 + n < Nsz) {
            u32x2 w;
            w.x = pk4_fp8(t[(kc + 0) * 65 + n], t[(kc + 1) * 65 + n], t[(kc + 2) * 65 + n], t[(kc + 3) * 65 + n]);
            w.y = pk4_fp8(t[(kc + 4) * 65 + n], t[(kc + 5) * 65 + n], t[(kc + 6) * 65 + n], t[(kc + 7) * 65 + n]);
            *(u32x2*)((unsigned char*)dst + (size_t)rowmap(n0 + n) * ld_dst + k0 + kc) = w;
        }
    } else if (n0 + n < Nsz) {
        u32x4 w;
        w.x = pk2(t[(kc + 0) * 65 + n], t[(kc + 1) * 65 + n]); w.y = pk2(t[(kc + 2) * 65 + n], t[(kc + 3) * 65 + n]);
        w.z = pk2(t[(kc + 4) * 65 + n], t[(kc + 5) * 65 + n]); w.w = pk2(t[(kc + 6) * 65 + n], t[(kc + 7) * 65 + n]);
        *(u32x4*)(dst + (size_t)rowmap(n0 + n) * ld_dst + k0 + kc) = w;
    }
}
struct MapId { DI int operator()(int n) const { return n; } };
struct MapIn { DI int operator()(int n) const { return n < 1476 ? n : n + 60; } };
struct MapE1 { DI int operator()(int n) const { const int hi = n >= 1024 ? 1 : 0, q = n - hi * 1024; return (q >> 7) * 256 + hi * 128 + (q & 127); } };

DI void phase0(const Args& a, LAS unsigned char* lds) {
    unsigned char* ws = a.ws;
    const int tid = otid();
    const size_t gtid = (size_t)blockIdx.x * NT + tid, gstride = (size_t)gridDim.x * NT;
    for (size_t i = gtid; i < 60 * 1024 / 2; i += gstride) ((unsigned*)(ws + WS_WIN + (size_t)1476 * 1024 * 2))[i] = 0u;
    for (size_t i = gtid; i < 32 * 1024; i += gstride) { const int e = (int)(i >> 10), k = (int)(i & 1023); const float w = a.in[I_WR][k * 32 + e] * a.in[I_N2G][k]; const u16 h = f2bf(w); ((u16*)(ws + WS_WR))[i] = h; ((u16*)(ws + WS_WR))[32 * 1024 + i] = f2bf(w - bf2f(h)); }
    for (size_t i = gtid; i < 4 * 128 * 128; i += gstride) { const int tt = (int)((i >> 7) & 127), ss = (int)(i & 127); ((u16*)(ws + WS_WSP))[i] = f2bf(ss <= tt ? a.in[I_WSP][i] : 0.f); }
    {
        const int wid = tid >> 6, lane = tid & 63;
        for (int row = blockIdx.x * 8 + wid; row < T; row += gridDim.x * 8) {
            const float* xr = a.in[I_X] + (size_t)row * 1024; u16* xb = (u16*)(ws + WS_XB) + (size_t)row * 1024;
            float ss = 0.f;
#pragma unroll
            for (int i = 0; i < 4; ++i) {
                const f32x4 v = __builtin_nontemporal_load((const f32x4*)(xr + i * 256 + lane * 4));
                ss += (v[0] * v[0] + v[1] * v[1]) + (v[2] * v[2] + v[3] * v[3]);
                u32x2 w; w.x = pk2(v[0], v[1]); w.y = pk2(v[2], v[3]);
                *(u32x2*)(xb + i * 256 + lane * 4) = w;
            }
#pragma unroll
            for (int o = 32; o >= 1; o >>= 1) ss += __shfl_xor(ss, o);
            if (lane == 0) ((float*)(ws + WS_RS1))[row] = __builtin_amdgcn_rsqf(ss * (1.0f / 1024.0f) + EPS);
        }
    }
    constexpr int U_IN = 16 * 56, U_UQ = 4 * 16, U_QI = 4 * 4, U_PA = 8 * 16, U_OUT = 16 * 16, U_CB = 64;
    constexpr int U_TOT = U_IN + U_UQ + U_QI + U_PA + U_OUT + U_CB;
    for (int u = blockIdx.x; u < U_TOT; u += gridDim.x) {
        int v = u;
        if (v < U_IN) { tr_tile(lds, a.in[I_WIN], 3524, 3524, (v & 15) * 64, (v >> 4) * 64, a.in[I_N1G], 1.0f, (u16*)(ws + WS_WIN), 1024, MapIn()); continue; }
        v -= U_IN;
        if (v < U_UQ) { tr_tile(lds, a.in[I_WUQ], 1024, 1024, (v & 3) * 64, (v >> 2) * 64, a.in[I_QLG], 1.0f, (u16*)(ws + WS_WQ), 256, MapId()); continue; }
        v -= U_UQ;
        if (v < U_QI) { tr_tile(lds, a.in[I_WQI], 256, 256, (v & 3) * 64, (v >> 2) * 64, a.in[I_QLG], 1.0f, (u16*)(ws + WS_WQ) + 1024 * 256, 256, MapId()); continue; }
        v -= U_QI;
        if (v < U_PA) { tr_tile(lds, a.in[I_WPA], 1024, 1024, (v & 7) * 64, (v >> 3) * 64, nullptr, 1.0f, (u16*)(ws + WS_WCAT), 1536, MapId()); continue; }
        v -= U_PA;
        if (v < U_OUT) { tr_tile(lds, a.in[I_WOUT], 1024, 1024, (v & 15) * 64, (v >> 4) * 64, nullptr, 1.0f, (u16*)(ws + WS_WOUT), 1024, MapId()); continue; }
        v -= U_OUT;
        {
            const int h = v >> 3, c0 = (v & 7) * 16;
            LAS float* t = (LAS float*)lds;
            __syncthreads();
            for (int i = tid; i < 1024; i += NT) t[i] = a.in[I_WUV][(size_t)h * 128 * 64 + (size_t)c0 * 64 + i];
            __syncthreads();
            for (int nn = tid; nn < 1024; nn += NT) {
                float accv[16];
#pragma unroll
                for (int i = 0; i < 16; ++i) accv[i] = 0.f;
                for (int vv = 0; vv < 64; ++vv) {
                    const float pb = a.in[I_WPB][(size_t)(h * 64 + vv) * 1024 + nn];
#pragma unroll
                    for (int i = 0; i < 16; ++i) accv[i] += t[i * 64 + vv] * pb;
                }
                u32x4 w0, w1;
                w0.x = pk2(accv[0], accv[1]); w0.y = pk2(accv[2], accv[3]); w0.z = pk2(accv[4], accv[5]); w0.w = pk2(accv[6], accv[7]);
                w1.x = pk2(accv[8], accv[9]); w1.y = pk2(accv[10], accv[11]); w1.z = pk2(accv[12], accv[13]); w1.w = pk2(accv[14], accv[15]);
                u16* d = (u16*)(ws + WS_WCAT) + (size_t)nn * 1536 + 512 + h * 128 + c0;
                *(u32x4*)d = w0; *(u32x4*)(d + 8) = w1;
            }
        }
    }
}

DI void gmlp_unit(const Args& a, LAS unsigned char* lds, int u) {
    unsigned char* ws = a.ws;
    const int tid = otid(), wid = tid >> 6, lane = tid & 63, fr = lane & 15, fq = lane >> 4;
    const int g = u & 3, row0 = (u >> 2) * 128;
    const u16* H = (const u16*)(ws + WS_H);
    LAS u16* img = (LAS u16*)lds;
    __syncthreads();
    {
        const int s = tid & 127, cset = tid >> 7;
        const f32x4 sq = *(const f32x4*)((const float*)(ws + WS_SSQ) + (size_t)(row0 + s) * 32 + g * 4);
        const float rs = __builtin_amdgcn_rsqf(((sq[0] + sq[1]) + (sq[2] + sq[3])) * (1.0f / 128.0f) + EPS);
#pragma unroll
        for (int it = 0; it < 4; ++it) {
            const int c = cset + 4 * it;
            const u32x4 raw = *(const u32x4*)(H + (size_t)(row0 + s) * NIN + 512 + g * 128 + 8 * c);
            const float* vg = a.in[I_VG] + 8 * c;
            float f[8] = {bflo(raw.x), bfhi(raw.x), bflo(raw.y), bfhi(raw.y), bflo(raw.z), bfhi(raw.z), bflo(raw.w), bfhi(raw.w)};
#pragma unroll
            for (int i = 0; i < 8; ++i) img[(8 * c + i) * 136 + s] = f2bf(f[i] * rs * vg[i]);
        }
    }
    __syncthreads();
    const u16* W = (const u16*)(ws + WS_WSP) + (size_t)g * 128 * 128 + (size_t)(16 * wid + fr) * 128;
    f32x4 acc[8];
#pragma unroll
    for (int i = 0; i < 8; ++i) acc[i] = (f32x4){0.f, 0.f, 0.f, 0.f};
    const int nks = (16 * wid + 15) / 32 + 1;
    for (int ks = 0; ks < nks; ++ks) {
        const bf16x8 bw = *(const bf16x8*)(W + ks * 32 + 8 * fq);
#pragma unroll
        for (int i = 0; i < 8; ++i) {
            const bf16x8 av = *(const LAS bf16x8*)(img + (16 * i + fr) * 136 + ks * 32 + 8 * fq);
            acc[i] = __builtin_amdgcn_mfma_f32_16x16x32_bf16(av, bw, acc[i], 0, 0, 0);
        }
    }
    const int t = 16 * wid + fr;
    const float bias = a.in[I_BSP][g * 128 + t];
    u16* YO = (u16*)(ws + WS_YO);
#pragma unroll
    for (int i = 0; i < 8; ++i) {
        const int d = 16 * i + 4 * fq;
        const u32x2 uu = *(const u32x2*)(H + (size_t)(row0 + t) * NIN + g * 128 + d);
        const float y0 = bflo(uu.x) * (acc[i][0] + bias), y1 = bfhi(uu.x) * (acc[i][1] + bias), y2 = bflo(uu.y) * (acc[i][2] + bias), y3 = bfhi(uu.y) * (acc[i][3] + bias);
        u32x2 w; w.x = pk2(y0, y1); w.y = pk2(y2, y3);
        *(u32x2*)(YO + (size_t)(row0 + t) * 1536 + g * 128 + d) = w;
    }
}

DI void kvnorm(const Args& a) {
    unsigned char* ws = a.ws;
    const u16* H = (const u16*)(ws + WS_H); const float* SSQ = (const float*)(ws + WS_SSQ);
    const size_t gtid = (size_t)blockIdx.x * NT + otid(), gstride = (size_t)gridDim.x * NT;
    for (size_t idx = gtid; idx < (size_t)T * 24; idx += gstride) {
        const int row = (int)(idx / 24), c = (int)(idx % 24);
        const u16* src; u16* dst; const float* gain; float rs;
        if (c < 16) {
            const f32x4 sq = *(const f32x4*)(SSQ + (size_t)row * 32 + 24);
            rs = __builtin_amdgcn_rsqf(((sq[0] + sq[1]) + (sq[2] + sq[3])) * (1.0f / 128.0f) + EPS);
            src = H + (size_t)row * NIN + 1280 + 8 * c; dst = (u16*)(ws + WS_KVN) + (size_t)row * 128 + 8 * c; gain = a.in[I_KVG] + 8 * c;
        } else {
            const int cc = c - 16;
            rs = __builtin_amdgcn_rsqf((SSQ[(size_t)row * 32 + 28] + SSQ[(size_t)row * 32 + 29]) * (1.0f / 64.0f) + EPS);
            src = H + (size_t)row * NIN + 1408 + 8 * cc; dst = nullptr; gain = a.in[I_KIG] + 8 * cc;
            const u32x4 raw = *(const u32x4*)src;
            u32x2 w8;
            w8.x = pk4_i8(bflo(raw.x) * rs * gain[0], bfhi(raw.x) * rs * gain[1], bflo(raw.y) * rs * gain[2], bfhi(raw.y) * rs * gain[3]);
            w8.y = pk4_i8(bflo(raw.z) * rs * gain[4], bfhi(raw.z) * rs * gain[5], bflo(raw.w) * rs * gain[6], bfhi(raw.w) * rs * gain[7]);
            *(u32x2*)(ws + WS_KIN + (size_t)row * 64 + 8 * cc) = w8;
            continue;
        }
        const u32x4 raw = *(const u32x4*)src;
        u32x4 w;
        w.x = pk2(bflo(raw.x) * rs * gain[0], bfhi(raw.x) * rs * gain[1]); w.y = pk2(bflo(raw.y) * rs * gain[2], bfhi(raw.y) * rs * gain[3]);
        w.z = pk2(bflo(raw.z) * rs * gain[4], bfhi(raw.z) * rs * gain[5]); w.w = pk2(bflo(raw.w) * rs * gain[6], bfhi(raw.w) * rs * gain[7]);
        *(u32x4*)dst = w;
    }
}

constexpr int P3_ROWS = 0, P3_HIST = 131072, P3_LIST = 147456;
DI unsigned f2key(float f) { const unsigned u = __float_as_uint(f); return (u & 0x80000000u) ? ~u : (u | 0x80000000u); }
DI int wave_incl_scan(int v, int lane) {
#pragma unroll
    for (int o = 1; o < 64; o <<= 1) { const int t = __shfl_up(v, o); if (lane >= o) v += t; }
    return v;
}
DI int wave_suffix_scan(int v, int lane) {
#pragma unroll
    for (int o = 1; o < 64; o <<= 1) { const int t = __shfl_down(v, o); if (lane + o < 64) v += t; }
    return v;
}
DI unsigned pk_gt(unsigned kw, unsigned xw, unsigned one) {
    unsigned d, m;
    asm("v_pk_sub_u16 %0, %1, %2 clamp" : "=v"(d) : "v"(kw), "v"(xw));
    asm("v_pk_min_u16 %0, %1, %2" : "=v"(m) : "v"(d), "v"(one));
    return m;
}
DI unsigned pk_subs(unsigned kw, unsigned xw) { unsigned d; asm("v_pk_sub_u16 %0, %1, %2 clamp" : "=v"(d) : "v"(kw), "v"(xw)); return d; }
DI unsigned pk_min1(unsigned d, unsigned one) { unsigned m; asm("v_pk_min_u16 %0, %1, %2" : "=v"(m) : "v"(d), "v"(one)); return m; }
DI unsigned pk_max(unsigned a, unsigned b) { unsigned r; asm("v_pk_max_u16 %0, %1, %2" : "=v"(r) : "v"(a), "v"(b)); return r; }
DI unsigned pk_add(unsigned a, unsigned b) { unsigned r; asm("v_pk_add_u16 %0, %1, %2" : "=v"(r) : "v"(a), "v"(b)); return r; }
DI int wave_sum(int v) {
    v += __builtin_amdgcn_update_dpp(0, v, 0xB1, 0xf, 0xf, false);
    v += __builtin_amdgcn_update_dpp(0, v, 0x4E, 0xf, 0xf, false);
    v += __builtin_amdgcn_update_dpp(0, v, 0x141, 0xf, 0xf, false);
    v += __builtin_amdgcn_update_dpp(0, v, 0x140, 0xf, 0xf, false);
    return __builtin_amdgcn_readlane(v, 0) + __builtin_amdgcn_readlane(v, 16) + __builtin_amdgcn_readlane(v, 32) + __builtin_amdgcn_readlane(v, 48);
}
DI int rowaddr(int p) { return (p & ~511) | ((p & 63) << 3) | ((p >> 6) & 7); }
typedef unsigned short us2_t __attribute__((ext_vector_type(2)));
DI unsigned dot2acc(unsigned flags, unsigned wts, unsigned acc) { return __builtin_amdgcn_udot2(__builtin_bit_cast(us2_t, flags), __builtin_bit_cast(us2_t, wts), acc, false); }
DI void keys_load(LAS u16* row, int N, int lane, u32x4 (&kr)[16]) {
    const int Nup = (N + 511) & ~511, niter = Nup >> 9;
    for (int p = N + lane; p < Nup; p += 64) row[rowaddr(p)] = (u16)0;
    wave_lds_sync();
#pragma unroll
    for (int i = 0; i < 16; ++i) { kr[i] = (u32x4){0u, 0u, 0u, 0u}; if (i < niter) kr[i] = *(LAS const u32x4*)(row + i * 512 + lane * 8); }
    wave_lds_sync();
}
DI void keys_select(const u32x4 (&kr)[16], LAS u16* list, int N, int lane) {
    const int Nup = (N + 511) & ~511, niter = Nup >> 9;
    const unsigned one = 0x00010001u;
    auto count_gt = [&](unsigned x) -> int {
        const unsigned xw = x | (x << 16);
        unsigned acc = 0u, acc1 = 0u, acc2 = 0u, acc3 = 0u;
#pragma unroll
        for (int c = 0; c < 4; ++c) {
            if (4 * c < niter) {
#pragma unroll
                for (int h = 0; h < 2; ++h) {
                    unsigned d[8];
#pragma unroll
                    for (int i = 0; i < 2; ++i) { const u32x4 kk = kr[4 * c + 2 * h + i]; d[4 * i] = pk_subs(kk.x, xw); d[4 * i + 1] = pk_subs(kk.y, xw); d[4 * i + 2] = pk_subs(kk.z, xw); d[4 * i + 3] = pk_subs(kk.w, xw); }
#pragma unroll
                    for (int i = 0; i < 8; ++i) d[i] = pk_min1(d[i], one);
#pragma unroll
                    for (int i = 0; i < 8; i += 4) { acc = dot2acc(d[i], one, acc); acc1 = dot2acc(d[i + 1], one, acc1); acc2 = dot2acc(d[i + 2], one, acc2); acc3 = dot2acc(d[i + 3], one, acc3); }
                }
            }
        }
        return wave_sum((int)((acc + acc1) + (acc2 + acc3)));
    };
    unsigned T = 0u; int cge = Nup, topbit = 15;
    {
        unsigned mx = 0u;
#pragma unroll
        for (int c = 0; c < 4; ++c) {
            if (4 * c < niter) {
#pragma unroll
                for (int i = 4 * c; i < 4 * c + 4; ++i) { mx = pk_max(mx, kr[i].x); mx = pk_max(mx, kr[i].y); mx = pk_max(mx, kr[i].z); mx = pk_max(mx, kr[i].w); }
            }
        }
        unsigned m1 = max(mx & 0xffffu, mx >> 16);
        m1 = max(m1, (unsigned)__builtin_amdgcn_update_dpp(0, (int)m1, 0xB1, 0xf, 0xf, false)); m1 = max(m1, (unsigned)__builtin_amdgcn_update_dpp(0, (int)m1, 0x4E, 0xf, 0xf, false));
        m1 = max(m1, (unsigned)__builtin_amdgcn_update_dpp(0, (int)m1, 0x141, 0xf, 0xf, false)); m1 = max(m1, (unsigned)__builtin_amdgcn_update_dpp(0, (int)m1, 0x140, 0xf, 0xf, false));
        const unsigned kmax = max(max((unsigned)__builtin_amdgcn_readlane((int)m1, 0), (unsigned)__builtin_amdgcn_readlane((int)m1, 16)), max((unsigned)__builtin_amdgcn_readlane((int)m1, 32), (unsigned)__builtin_amdgcn_readlane((int)m1, 48)));
        if (kmax > 1024u) {
            const unsigned lo = kmax - 1023u;
            const int clo = count_gt(lo - 1u);
            if (clo >= 256) { T = lo; cge = clo; topbit = 9; }
        }
    }
#pragma unroll 1
    for (int bit = topbit; bit >= 0; --bit) {
        const unsigned cand = topbit == 15 ? (T | (1u << bit)) : (T + (1u << bit));
        if (cand > 0xffffu) continue;
        const int cnt = count_gt(cand - 1u);
        if (cnt >= 256) { T = cand; cge = cnt; }
    }
    auto build = [&](unsigned x, unsigned (&M)[4]) {
        const unsigned xw = x | (x << 16);
#pragma unroll
        for (int c = 0; c < 4; ++c) {
            M[c] = 0u;
            if (4 * c < niter) {
#pragma unroll
                for (int i = 4 * c; i < 4 * c + 4; ++i) {
                    unsigned byte = dot2acc(pk_gt(kr[i].x, xw, one), 0x00020001u, 0u);
                    byte = dot2acc(pk_gt(kr[i].y, xw, one), 0x00080004u, byte);
                    byte = dot2acc(pk_gt(kr[i].z, xw, one), 0x00200010u, byte);
                    byte = dot2acc(pk_gt(kr[i].w, xw, one), 0x00800040u, byte);
                    M[c] |= byte << (8 * (i & 3));
                }
            }
        }
    };
    unsigned M[4];
    build(T - 1u, M);
    if (cge != 256) {
        unsigned G[4]; build(T, G);
        unsigned E[4];
#pragma unroll
        for (int c = 0; c < 4; ++c) E[c] = M[c] & ~G[c];
        const int need = 256 - (cge - wave_sum((int)(__builtin_popcount(E[0]) + __builtin_popcount(E[1]) + __builtin_popcount(E[2]) + __builtin_popcount(E[3]))));
        auto below = [&](int B, int c) -> unsigned { const int nb = B - 32 * c; return nb <= 0 ? 0u : (nb >= 32 ? 0xffffffffu : ((1u << nb) - 1u)); };
        auto ties_below = [&](int B) -> int {
            return wave_sum((int)(__builtin_popcount(E[0] & below(B, 0)) + __builtin_popcount(E[1] & below(B, 1)) + __builtin_popcount(E[2] & below(B, 2)) + __builtin_popcount(E[3] & below(B, 3))));
        };
        int lo = 0, hi = 127;
#pragma unroll 1
        while (lo < hi) { const int mid = (lo + hi) >> 1; if (ties_below(mid + 1) >= need) hi = mid; else lo = mid + 1; }
        const int Bs = lo, r = need - ties_below(Bs);
        const unsigned ew = Bs < 32 ? E[0] : (Bs < 64 ? E[1] : (Bs < 96 ? E[2] : E[3]));
        const bool tb = ((ew >> (Bs & 31)) & 1u) != 0u;
        const unsigned long long em = __ballot(tb);
        const bool take_row = tb && __builtin_popcountll(em & ((1ull << lane) - 1ull)) < r;
#pragma unroll
        for (int c = 0; c < 4; ++c) {
            unsigned tk = E[c] & below(Bs, c);
            if ((Bs >> 5) == c && take_row) tk |= 1u << (Bs & 31);
            M[c] = G[c] | tk;
        }
    }
    const int kl = __builtin_popcount(M[0]) + __builtin_popcount(M[1]) + __builtin_popcount(M[2]) + __builtin_popcount(M[3]);
    int wp = wave_incl_scan(kl, lane) - kl;
#pragma unroll
    for (int c = 0; c < 4; ++c) {
        unsigned m = M[c];
        while (m) { const int b = __builtin_ctz(m); list[wp] = (u16)((32 * c + b) * 64 + lane); ++wp; m &= m - 1u; }
    }
}

DI void attend(const Args& a, size_t brow, int t, int cnt, LAS const u16* list, LAS unsigned char* img, int lane, int fr, int fq) {
    const u16* Q = (const u16*)(a.ws + WS_Q); const u16* KVN = (const u16*)(a.ws + WS_KVN); u16* YO = (u16*)(a.ws + WS_YO);
    bf16x8 qf[4];
    {
        const int head = fr & 7;
        const u16* qrow = Q + (brow + t) * 1024 + head * 128;
        float f[4][8]; float ss = 0.f;
#pragma unroll
        for (int ks = 0; ks < 4; ++ks) {
            const u32x4 raw = *(const u32x4*)(qrow + ks * 32 + 8 * fq);
            f[ks][0] = bflo(raw.x); f[ks][1] = bfhi(raw.x); f[ks][2] = bflo(raw.y); f[ks][3] = bfhi(raw.y); f[ks][4] = bflo(raw.z); f[ks][5] = bfhi(raw.z); f[ks][6] = bflo(raw.w); f[ks][7] = bfhi(raw.w);
#pragma unroll
            for (int j = 0; j < 8; ++j) ss += f[ks][j] * f[ks][j];
        }
        ss += __shfl_xor(ss, 16); ss += __shfl_xor(ss, 32);
        const float rq = __builtin_amdgcn_rsqf(ss * (1.0f / 128.0f) + EPS) * (0.08838834764831845f * 1.4426950408889634f);
#pragma unroll
        for (int ks = 0; ks < 4; ++ks) {
            const float* qg = a.in[I_QNG] + ks * 32 + 8 * fq;
            u32x4 w;
            w.x = pk2(f[ks][0] * rq * qg[0], f[ks][1] * rq * qg[1]); w.y = pk2(f[ks][2] * rq * qg[2], f[ks][3] * rq * qg[3]);
            w.z = pk2(f[ks][4] * rq * qg[4], f[ks][5] * rq * qg[5]); w.w = pk2(f[ks][6] * rq * qg[6], f[ks][7] * rq * qg[7]);
            qf[ks] = __builtin_bit_cast(bf16x8, w);
        }
    }
    const int nsteps = (cnt + 31) >> 5;
    f32x4 oacc[8];
#pragma unroll
    for (int i = 0; i < 8; ++i) oacc[i] = (f32x4){0.f, 0.f, 0.f, 0.f};
    float mrun = -3.0e38f, lpart = 0.f;
    const char* kvb = (const char*)(KVN + brow * 128);
    auto issue = [&](u32x4 (&pf)[8], int pp) {
#pragma unroll
        for (int it = 0; it < 8; ++it) { const int piece = it * 64 + lane; const unsigned key = list[pp * 32 + (piece >> 4)]; pf[it] = *(const u32x4*)(kvb + (key * 256u + 16u * (unsigned)(piece & 15))); }
    };
    auto step = [&](u32x4 (&pf)[8], int pp) {
#pragma unroll
        for (int it = 0; it < 8; ++it) { const int piece = it * 64 + lane; *(LAS u32x4*)(img + (piece >> 4) * 288 + (piece & 15) * 16) = pf[it]; }
        if (pp + 2 < nsteps) issue(pf, pp + 2);
        wave_lds_sync();
        __builtin_amdgcn_sched_barrier(0);
        f32x4 sa = {0.f, 0.f, 0.f, 0.f}, sb = {0.f, 0.f, 0.f, 0.f};
#pragma unroll
        for (int ks = 0; ks < 4; ++ks) {
            const bf16x8 a0 = *(LAS const bf16x8*)(img + fr * 288 + (ks * 32 + 8 * fq) * 2), a1 = *(LAS const bf16x8*)(img + (16 + fr) * 288 + (ks * 32 + 8 * fq) * 2);
            sa = __builtin_amdgcn_mfma_f32_16x16x32_bf16(a0, qf[ks], sa, 0, 0, 0); sb = __builtin_amdgcn_mfma_f32_16x16x32_bf16(a1, qf[ks], sb, 0, 0, 0);
            if (ks == 1) __builtin_amdgcn_sched_barrier(0);
        }
        if (pp * 32 + 32 > cnt) {
            const int pb0 = pp * 32 + 4 * fq;
#pragma unroll
            for (int r = 0; r < 4; ++r) { if (pb0 + r >= cnt) sa[r] = -3.0e38f; if (pb0 + 16 + r >= cnt) sb[r] = -3.0e38f; }
        }
        float mx = fmaxf(fmaxf(fmaxf(sa[0], sa[1]), fmaxf(sa[2], sa[3])), fmaxf(fmaxf(sb[0], sb[1]), fmaxf(sb[2], sb[3])));
        mx = fmaxf(mx, __shfl_xor(mx, 16)); mx = fmaxf(mx, __shfl_xor(mx, 32));
        if (__ballot(mx > mrun) != 0ull) {
            const float mnew = fmaxf(mrun, mx), alpha = __builtin_amdgcn_exp2f(mrun - mnew);
            mrun = mnew; lpart *= alpha;
#pragma unroll
            for (int cb = 0; cb < 8; ++cb) oacc[cb] *= alpha;
        }
        float ps = 0.f;
#pragma unroll
        for (int r = 0; r < 4; ++r) { sa[r] = __builtin_amdgcn_exp2f(sa[r] - mrun); sb[r] = __builtin_amdgcn_exp2f(sb[r] - mrun); ps += sa[r] + sb[r]; }
        lpart += ps;
        u32x4 pw; pw.x = pk2(sa[0], sa[1]); pw.y = pk2(sa[2], sa[3]); pw.z = pk2(sb[0], sb[1]); pw.w = pk2(sb[2], sb[3]);
        const bf16x8 pb = __builtin_bit_cast(bf16x8, pw);
#pragma unroll
        for (int cb = 0; cb < 8; ++cb) {
            const s16x4 r0 = __builtin_amdgcn_ds_read_tr16_b64_v4i16((LAS s16x4*)(img + (4 * fq + (fr >> 2)) * 288 + (cb * 16 + 4 * (fr & 3)) * 2));
            const s16x4 r1 = __builtin_amdgcn_ds_read_tr16_b64_v4i16((LAS s16x4*)(img + (16 + 4 * fq + (fr >> 2)) * 288 + (cb * 16 + 4 * (fr & 3)) * 2));
            const bf16x8 av = {r0[0], r0[1], r0[2], r0[3], r1[0], r1[1], r1[2], r1[3]};
            oacc[cb] = __builtin_amdgcn_mfma_f32_16x16x32_bf16(av, pb, oacc[cb], 0, 0, 0);
            if (cb == 3) __builtin_amdgcn_sched_barrier(0);
        }
        wave_lds_sync();
    };
    u32x4 pf0[8], pf1[8];
    issue(pf0, 0);
    if (nsteps > 1) issue(pf1, 1);
#pragma unroll 1
    for (int pp = 0; pp < nsteps; pp += 2) {
        step(pf0, pp);
        if (pp + 1 < nsteps) step(pf1, pp + 1);
    }
    float lsum = lpart; lsum += __shfl_xor(lsum, 16); lsum += __shfl_xor(lsum, 32);
    const float inv = __builtin_amdgcn_rcpf(lsum);
    if (fr < 8) {
        u16* orow = YO + (brow + t) * 1536 + 512 + fr * 128 + 4 * fq;
#pragma unroll
        for (int cb = 0; cb < 8; ++cb) { u32x2 w; w.x = pk2(oacc[cb][0] * inv, oacc[cb][1] * inv); w.y = pk2(oacc[cb][2] * inv, oacc[cb][3] * inv); *(u32x2*)(orow + cb * 16) = w; }
    }
}

constexpr int N_CVT_JOBS = 32 * 16 * 32 + 32 * 16 * 16;
DI void cvt_job(const Args& a, LAS float* t, int J, int lane) {
    if (J >= N_CVT_JOBS) return;
    const float* src; const float* sk; unsigned char* dst; int ld, k0, n0, row;
    if (J < 16384) {
        const int e = J >> 9, w = J & 511; src = a.in[I_WE1] + (size_t)e * 1024 * 2048; ld = 2048; k0 = (w >> 5) * 64; n0 = (w & 31) * 64; sk = a.in[I_N2G]; dst = a.ws + WS_WE1 + (size_t)e * 2048 * 1024;
        const int n = n0 + lane, hi = n >= 1024 ? 1 : 0, q = n - hi * 1024; row = (q >> 7) * 256 + hi * 128 + (q & 127);
    } else {
        const int j = J - 16384, e = j >> 8, w = j & 255; src = a.in[I_WE2] + (size_t)e * 1024 * 1024; ld = 1024; k0 = (w >> 4) * 64; n0 = (w & 15) * 64; sk = nullptr; dst = a.ws + WS_WE2 + (size_t)e * 1024 * 1024;
        row = n0 + lane;
    }
    const int kl = lane >> 4, n4 = 4 * (lane & 15);
    f32x4 v[4][4];
#pragma unroll
    for (int ks = 0; ks < 4; ++ks)
#pragma unroll
        for (int i = 0; i < 4; ++i) v[ks][i] = __builtin_nontemporal_load((const f32x4*)(src + (size_t)(k0 + ks * 16 + kl + 4 * i) * ld + n0 + n4));
    unsigned char* drow = dst + (size_t)row * 1024 + k0;
#pragma unroll
    for (int ks = 0; ks < 4; ++ks) {
#pragma unroll
        for (int i = 0; i < 4; ++i) { const float sc = (sk ? sk[k0 + ks * 16 + kl + 4 * i] : 1.0f) * 64.0f; *(LAS f32x4*)(t + (kl + 4 * i) * 64 + n4) = v[ks][i] * sc; }
        wave_lds_sync();
        float c[16];
#pragma unroll
        for (int k = 0; k < 16; ++k) c[k] = t[k * 64 + lane];
        u32x4 w; w.x = pk4_fp8(c[0], c[1], c[2], c[3]); w.y = pk4_fp8(c[4], c[5], c[6], c[7]); w.z = pk4_fp8(c[8], c[9], c[10], c[11]); w.w = pk4_fp8(c[12], c[13], c[14], c[15]);
        *(u32x4*)(drow + ks * 16) = w;
        wave_lds_sync();
    }
}

DI void dsa_phase(const Args& a, LAS unsigned char* lds) {
    unsigned char* ws = a.ws;
    const int wid = __builtin_amdgcn_readfirstlane(otid() >> 6);
    LAS u16* rows = (LAS u16*)(lds + P3_ROWS);
    bool bprev = false; size_t pbrow = 0; int pt0 = 0, bbuf = 0;
    for (int gi = blockIdx.x; gi < T / 8; gi += gridDim.x) {
        const int lane = otid() & 63, fr = lane & 15, fq = lane >> 4;
        const int b = gi & 3, t0 = S - 8 - 8 * (gi >> 2);
        const size_t brow = (size_t)b * S;
        const int ntile = (t0 + 8 + 15) >> 4;
        __syncthreads();
        {
            const unsigned char* QI = (const unsigned char*)(ws + WS_QI); const unsigned char* KIN = (const unsigned char*)(ws + WS_KIN); const float* WI = (const float*)(ws + WS_WI);
            typedef int i32x4_t __attribute__((ext_vector_type(4)));
            i32x4_t qa[2]; f32x4 wi[2];
#pragma unroll
            for (int rg = 0; rg < 2; ++rg) {
                qa[rg] = *(const i32x4_t*)(QI + (brow + t0 + 4 * rg + (fr >> 2)) * 256 + (fr & 3) * 64 + 16 * fq);
                wi[rg] = *(const f32x4*)(WI + (brow + t0 + 4 * rg + fq) * 4);
            }
            auto ldk = [&](i32x4_t (&kf)[4], int jt0) {
#pragma unroll
                for (int u = 0; u < 4; ++u) {
                    const int jt = (jt0 + 8 * u) < ntile ? (jt0 + 8 * u) : (ntile - 1);
                    kf[u] = *(const i32x4_t*)(KIN + (brow + jt * 16 + fr) * 64 + 16 * fq);
                }
            };
            auto cmpk = [&](const i32x4_t (&kf)[4], int jt0) {
#pragma unroll
                for (int u = 0; u < 4; ++u) {
                    const int jt = jt0 + 8 * u;
                    if (jt < ntile) {
#pragma unroll
                        for (int rg = 0; rg < 2; ++rg) {
                            i32x4_t d = {0, 0, 0, 0};
                            d = __builtin_amdgcn_mfma_i32_16x16x64_i8(qa[rg], kf[u], d, 0, 0, 0);
                            const float sc = (((float)max(d[0], 0) * wi[rg][0] + (float)max(d[1], 0) * wi[rg][1]) + (float)max(d[2], 0) * wi[rg][2]) + (float)max(d[3], 0) * wi[rg][3];
                            rows[(4 * rg + fq) * 8192 + rowaddr(jt * 16 + fr)] = (u16)(f2key(sc) >> 16);
                        }
                    }
                }
            };
            i32x4_t kA[4], kB[4];
            if (wid < ntile) ldk(kA, wid);
            for (int jt0 = wid; jt0 < ntile; jt0 += 64) {
                const bool hasB = jt0 + 32 < ntile;
                if (hasB) ldk(kB, jt0 + 32);
                cmpk(kA, jt0);
                if (hasB) { if (jt0 + 64 < ntile) ldk(kA, jt0 + 64); cmpk(kB, jt0 + 32); }
            }
        }
        __syncthreads();
        if (wid < 4) {
            u32x4 kr[16];
            const int N0 = t0 + wid + 1, N1 = N0 + 4;
            if (N0 > 256) keys_load(rows + wid * 8192, N0, lane, kr);
            __syncthreads();
            LAS u16* l0 = (LAS u16*)(lds + (bbuf ? P3_HIST : P3_LIST) + wid * 512);
            LAS u16* l1 = l0 + 4 * 256;
            if (N0 > 256) keys_select(kr, l0, N0, lane); else { for (int p = lane; p < 256; p += 64) l0[p] = p < N0 ? (u16)p : (u16)0; }
            if (N1 > 256) { keys_load(rows + (wid + 4) * 8192, N1, lane, kr); keys_select(kr, l1, N1, lane); } else { for (int p = lane; p < 256; p += 64) l1[p] = p < N1 ? (u16)p : (u16)0; }
            {
                const int G3 = gridDim.x, c3 = blockIdx.x, it3 = (gi - c3) / G3, ntrip = (T / 8 - c3 + G3 - 1) / G3, jtot = (N_CVT_JOBS + 4 * G3 - 1) / (4 * G3);
                const int jlo = (jtot * it3 + ntrip - 1) / ntrip, jhi = (jtot * (it3 + 1) + ntrip - 1) / ntrip;
                LAS float* tcv = (LAS float*)(lds + (wid < 3 ? 135168 + wid * 4096 : 151552));
#pragma unroll 1
                for (int j = jlo; j < jhi; ++j) cvt_job(a, tcv, (j * 4 + wid) * G3 + c3, lane);
            }
        } else {
            __syncthreads();
            if (bprev) {
                LAS const u16* lp = (LAS const u16*)(lds + (bbuf ? P3_LIST : P3_HIST));
                LAS unsigned char* img = (LAS unsigned char*)(rows + (wid - 4) * 8192);
                { const int q = wid - 4, t = pt0 + q; attend(a, pbrow, t, t + 1 < 256 ? t + 1 : 256, lp + q * 256, img, lane, fr, fq); }
                { const int q = wid, t = pt0 + q; attend(a, pbrow, t, t + 1 < 256 ? t + 1 : 256, lp + q * 256, img, lane, fr, fq); }
            }
        }
        bprev = true; pbrow = brow; pt0 = t0; bbuf ^= 1;
    }
    __syncthreads();
    if (bprev) {
        const int lane = otid() & 63, fr = lane & 15, fq = lane >> 4;
        LAS const u16* lp = (LAS const u16*)(lds + (bbuf ? P3_LIST : P3_HIST));
        const int q = wid, t = pt0 + q;
        attend(a, pbrow, t, t + 1 < 256 ? t + 1 : 256, lp + q * 256, (LAS unsigned char*)(rows + wid * 8192), lane, fr, fq);
    }
}

constexpr int P6_LCNT = 0, P6_BASE = 128, P6_RSB = 256, P6_RI = 1024;
DI unsigned dpp_max_u32(unsigned v) {
    v = max(v, (unsigned)__builtin_amdgcn_update_dpp(0, (int)v, 0xB1, 0xf, 0xf, false));
    v = max(v, (unsigned)__builtin_amdgcn_update_dpp(0, (int)v, 0x4E, 0xf, 0xf, false));
    v = max(v, (unsigned)__builtin_amdgcn_update_dpp(0, (int)v, 0x141, 0xf, 0xf, false));
    v = max(v, (unsigned)__builtin_amdgcn_update_dpp(0, (int)v, 0x140, 0xf, 0xf, false));
    return v;
}
DI float key2f(unsigned k) { return __uint_as_float((k & 0x80000000u) ? (k & 0x7fffffffu) : ~k); }
DI void router_phase(const Args& a, LAS unsigned char* lds) {
    unsigned char* ws = a.ws;
    const int tid = otid(), wid = tid >> 6, lane = tid & 63, fr = lane & 15, fq = lane >> 4;
    LAS int* lcnt = (LAS int*)(lds + P6_LCNT); LAS int* lbase = (LAS int*)(lds + P6_BASE); LAS float* rsb = (LAS float*)(lds + P6_RSB); LAS int* RI = (LAS int*)(lds + P6_RI);
    const u16* WRH = (const u16*)(ws + WS_WR);
    unsigned* CNT = (unsigned*)(ws + WS_CTL);
    LAS unsigned char* WL = lds + 16384;
    __syncthreads();
    for (int i = tid; i < 64 * 128; i += NT) { const int r = i >> 7, p = i & 127; *(LAS u32x4*)(WL + r * 2064 + p * 16) = *(const u32x4*)(WRH + (size_t)r * 1024 + p * 8); }
    for (int rg = blockIdx.x; rg < T / 128; rg += gridDim.x) {
        __syncthreads();
        if (tid < 32) lcnt[tid] = 0;
        __syncthreads();
        {
            const int row = rg * 128 + wid * 16 + fr;
            const float* xr = a.out + (size_t)row * 1024 + 8 * fq;
            f32x4 acc[2] = {{0.f, 0.f, 0.f, 0.f}, {0.f, 0.f, 0.f, 0.f}};
            float ss = 0.f;
#pragma unroll 4
            for (int ks = 0; ks < 32; ++ks) {
                const f32x4 x0 = *(const f32x4*)(xr + ks * 32), x1 = *(const f32x4*)(xr + ks * 32 + 4);
                ss += ((x0[0] * x0[0] + x0[1] * x0[1]) + (x0[2] * x0[2] + x0[3] * x0[3])) + ((x1[0] * x1[0] + x1[1] * x1[1]) + (x1[2] * x1[2] + x1[3] * x1[3]));
                u32x4 hw; hw.x = pk2(x0[0], x0[1]); hw.y = pk2(x0[2], x0[3]); hw.z = pk2(x1[0], x1[1]); hw.w = pk2(x1[2], x1[3]);
                u32x4 lw; lw.x = pk2(x0[0] - bflo(hw.x), x0[1] - bfhi(hw.x)); lw.y = pk2(x0[2] - bflo(hw.y), x0[3] - bfhi(hw.y)); lw.z = pk2(x1[0] - bflo(hw.z), x1[1] - bfhi(hw.z)); lw.w = pk2(x1[2] - bflo(hw.w), x1[3] - bfhi(hw.w));
                const bf16x8 xh = __builtin_bit_cast(bf16x8, hw), xl = __builtin_bit_cast(bf16x8, lw);
#pragma unroll
                for (int nt = 0; nt < 2; ++nt) {
                    const bf16x8 wh = *(LAS const bf16x8*)(WL + (nt * 16 + fr) * 2064 + (ks * 32 + 8 * fq) * 2), wl = *(LAS const bf16x8*)(WL + (32 + nt * 16 + fr) * 2064 + (ks * 32 + 8 * fq) * 2);
                    acc[nt] = __builtin_amdgcn_mfma_f32_16x16x32_bf16(xh, wh, acc[nt], 0, 0, 0);
                    acc[nt] = __builtin_amdgcn_mfma_f32_16x16x32_bf16(xl, wh, acc[nt], 0, 0, 0);
                    acc[nt] = __builtin_amdgcn_mfma_f32_16x16x32_bf16(xh, wl, acc[nt], 0, 0, 0);
                }
            }
            ss += __shfl_xor(ss, 16); ss += __shfl_xor(ss, 32);
            const float rsrow = __builtin_amdgcn_rsqf(ss * (1.0f / 1024.0f) + EPS);
            if (fq == 0) rsb[wid * 16 + fr] = rsrow;
            {
                unsigned char* xn = ws + WS_XN2 + (size_t)row * 1024 + 8 * fq;
#pragma unroll 4
                for (int ks = 0; ks < 32; ++ks) {
                    const f32x4 x0 = *(const f32x4*)(xr + ks * 32), x1 = *(const f32x4*)(xr + ks * 32 + 4);
                    u32x2 w; w.x = pk4_fp8(x0[0] * rsrow, x0[1] * rsrow, x0[2] * rsrow, x0[3] * rsrow); w.y = pk4_fp8(x1[0] * rsrow, x1[1] * rsrow, x1[2] * rsrow, x1[3] * rsrow);
                    *(u32x2*)(xn + ks * 32) = w;
                }
            }
            wave_lds_sync();
            const float b0 = a.in[I_BR][fr], b1 = a.in[I_BR][16 + fr];
#pragma unroll
            for (int r = 0; r < 4; ++r) {
                const float rs = rsb[wid * 16 + 4 * fq + r];
                unsigned k0 = (f2key(acc[0][r] * rs + b0) & ~31u) | (unsigned)(31 - fr), k1 = (f2key(acc[1][r] * rs + b1) & ~31u) | (unsigned)(15 - fr);
                unsigned sel[4];
#pragma unroll
                for (int k = 0; k < 4; ++k) {
                    const unsigned best = dpp_max_u32(k0 > k1 ? k0 : k1);
                    sel[k] = best;
                    if (k0 == best) k0 = 0u;
                    if (k1 == best) k1 = 0u;
                }
                const float v0 = key2f(sel[0] & ~31u), e1 = __expf(key2f(sel[1] & ~31u) - v0), e2 = __expf(key2f(sel[2] & ~31u) - v0), e3 = __expf(key2f(sel[3] & ~31u) - v0);
                const float inv = 1.0f / (1.0f + e1 + e2 + e3);
                if (fr < 4) {
                    const unsigned sk = fr == 0 ? sel[0] : (fr == 1 ? sel[1] : (fr == 2 ? sel[2] : sel[3]));
                    const int e = 31 - (int)(sk & 31u);
                    const float gt = (fr == 0 ? 1.0f : (fr == 1 ? e1 : (fr == 2 ? e2 : e3))) * inv;
                    const int ls = __hip_atomic_fetch_add(lcnt + e, 1, __ATOMIC_RELAXED, __HIP_MEMORY_SCOPE_WORKGROUP);
                    const int ri = ((wid * 16 + 4 * fq + r) * 4 + fr) * 4;
                    RI[ri + 0] = e; RI[ri + 1] = ls; RI[ri + 2] = __float_as_int(gt);
                }
            }
        }
        __syncthreads();
        if (tid < 32) lbase[tid] = (int)__hip_atomic_fetch_add(CNT + tid, (unsigned)lcnt[tid], __ATOMIC_RELAXED, __HIP_MEMORY_SCOPE_AGENT);
        __syncthreads();
        {
            const int rl = tid >> 2, k = tid & 3, row = rg * 128 + rl;
            const int e = RI[tid * 4 + 0], slot = lbase[e] + RI[tid * 4 + 1];
            ((int*)(ws + WS_LTOK))[(size_t)e * ECAP + slot] = row;
            ((float*)(ws + WS_LGATE))[(size_t)e * ECAP + slot] = __int_as_float(RI[tid * 4 + 2]);
            ((unsigned*)(ws + WS_ROUTE))[(size_t)row * 4 + k] = ((unsigned)e << 16) | (unsigned)slot;
        }
    }
}

DI void combine_phase(const Args& a, LAS unsigned char* lds) {
    unsigned char* ws = a.ws;
    LAS const int* tab = (LAS const int*)(lds + MOE_TAB);
    const int tid = otid(), wid = tid >> 6, lane = tid & 63;
    const u16* YB = (const u16*)(ws + WS_YB); const unsigned* ROUTE = (const unsigned*)(ws + WS_ROUTE);
    for (int row = blockIdx.x * 8 + wid; row < T; row += gridDim.x * 8) {
        size_t pos[4];
#pragma unroll
        for (int k = 0; k < 4; ++k) { const unsigned r = ROUTE[(size_t)row * 4 + k]; const int e = (int)(r >> 16), slot = (int)(r & 0xffffu); pos[k] = (size_t)tab[e] * 256 + slot; }
        float* orow = a.out + (size_t)row * 1024;
#pragma unroll
        for (int i = 0; i < 4; ++i) {
            f32x4 v = *(const f32x4*)(orow + i * 256 + lane * 4);
#pragma unroll
            for (int k = 0; k < 4; ++k) { const u32x2 y = __builtin_nontemporal_load((const u32x2*)(YB + pos[k] * 1024 + i * 256 + lane * 4)); v[0] += bflo(y.x); v[1] += bfhi(y.x); v[2] += bflo(y.y); v[3] += bfhi(y.y); }
            *(f32x4*)(orow + i * 256 + lane * 4) = v;
        }
    }
}

#define XB_TMO      128
#define XB_XCNT(j)  (256  + 64 * (j))
#define XB_XSUB(j)  (1280 + 64 * (j))
#define XB_XGEN(j)  (2304 + 64 * (j))
#define XB_TOP      3328
#define XB_TOPGEN   3392
#define XCD_BAR_WORDS 3456
#define XB_SPIN_CAP (1u << 18)

__device__ __forceinline__ unsigned xb_ld(unsigned* p)              { return __hip_atomic_load(p, __ATOMIC_RELAXED, __HIP_MEMORY_SCOPE_AGENT); }
__device__ __forceinline__ unsigned xb_add(unsigned* p, unsigned v) { return __hip_atomic_fetch_add(p, v, __ATOMIC_RELAXED, __HIP_MEMORY_SCOPE_AGENT); }
__device__ __forceinline__ unsigned xb_xcc_id() { return (unsigned)__builtin_amdgcn_s_getreg((3 << 11) | 20) & 0xFu; }
#define XB_SPIN(cond, bar) do { unsigned _sp = 0; while (cond) { __builtin_amdgcn_s_sleep(1); \
    if ((++_sp & 255u) == 0u) { if (xb_ld(&(bar)[XB_TMO])) break; if (_sp > XB_SPIN_CAP) { atomicAdd(&(bar)[XB_TMO], 1u); break; } } } } while (0)

struct XcdBarrier {
    unsigned* bar; unsigned x;
    volatile LAS unsigned* st;
};

__device__ __forceinline__ XcdBarrier xcd_barrier_post(unsigned* bar, volatile LAS unsigned* st) {
    XcdBarrier b; b.bar = bar; b.x = xb_xcc_id(); b.st = st;
    if (threadIdx.x == 0) (void)xb_add(&bar[XB_XCNT(b.x)], 1u);
    return b;
}
__device__ __forceinline__ void xcd_barrier_complete(unsigned* bar, unsigned x, unsigned& nloc, unsigned& nx) {
    const unsigned G = gridDim.x * gridDim.y * gridDim.z;
    unsigned sum, cnt, mine, sp = 0u;
    for (;;) {
        sum = 0u; cnt = 0u; mine = 0u;
#pragma unroll
        for (unsigned j = 0; j < 16; ++j) { const unsigned c = xb_ld(&bar[XB_XCNT(j)]); sum += c; cnt += (c > 0u) ? 1u : 0u; mine = (j == x) ? c : mine; }
        if (sum == G) break;
        __builtin_amdgcn_s_sleep(1);
        if ((++sp & 255u) == 0u) { if (xb_ld(&bar[XB_TMO])) break; if (sp > XB_SPIN_CAP) { atomicAdd(&bar[XB_TMO], 1u); break; } }
    }
    nloc = mine > 0u ? mine : 1u; nx = cnt > 0u ? cnt : 1u;
}

__device__ __forceinline__ void xcd_barrier(const XcdBarrier& b) {
    asm volatile("s_waitcnt vmcnt(0)" ::: "memory");
    __syncthreads();
    if (threadIdx.x == 0) {
        unsigned* bar = b.bar;
        __builtin_amdgcn_s_waitcnt(0);
        unsigned nloc = b.st[0], nx = b.st[1];
        if (nloc == 0u) { xcd_barrier_complete(bar, b.x, nloc, nx); b.st[0] = nloc; b.st[1] = nx; }
        const unsigned old = xb_add(&bar[XB_XSUB(b.x)], 1u);
        const unsigned gen = old / nloc;
        if (old + 1u == (gen + 1u) * nloc) {
            __builtin_amdgcn_fence(__ATOMIC_RELEASE, "agent");
            asm volatile("s_waitcnt vmcnt(0)" ::: "memory");
            const unsigned og = xb_add(&bar[XB_TOP], 1u);
            const unsigned tg = og / nx;
            if (og + 1u == (tg + 1u) * nx) xb_add(&bar[XB_TOPGEN], 1u);
            else XB_SPIN(xb_ld(&bar[XB_TOPGEN]) == tg, bar);
            __builtin_amdgcn_fence(__ATOMIC_ACQUIRE, "agent");
            xb_add(&bar[XB_XGEN(b.x)], 1u);
            asm volatile("s_waitcnt vmcnt(0)" ::: "memory");
        } else {
            XB_SPIN(xb_ld(&bar[XB_XGEN(b.x)]) == gen, bar);
            __builtin_amdgcn_fence(__ATOMIC_ACQUIRE, "agent");
            asm volatile("s_waitcnt vmcnt(0)" ::: "memory");
        }
    }
    __syncthreads();
}

__global__ void __launch_bounds__(NT, 2) fwd(Args a) {
    extern __shared__ __attribute__((aligned(16))) unsigned char lds_raw[];
    LAS unsigned char* lds = (LAS unsigned char*)lds_raw;
    cg::grid_group grid = cg::this_grid();
    unsigned char* ws = a.ws;
    const int G = gridDim.x, c = blockIdx.x;
    if (threadIdx.x < 2) ((volatile LAS unsigned*)(lds + LDS_BARST))[threadIdx.x] = 0u;
    __syncthreads();
    const XcdBarrier xbar = xcd_barrier_post((unsigned*)(ws + WS_BAR), (volatile LAS unsigned*)(lds + LDS_BARST));

    phase0(a, lds);
    xcd_barrier(xbar);
    {
        g8::PlainSched s; s.Abase = (const char*)(ws + WS_XB); s.Bbase = (const char*)(ws + WS_WIN); s.lda = 1024; s.ldb = 1024; s.K = 1024; s.nM = T / 256; s.nN = NIN / 256; s.G = G; s.c = c;
        EpiIn e; e.H = (u16*)(ws + WS_H); e.rs1 = (const float*)(ws + WS_RS1); e.SSQ = (float*)(ws + WS_SSQ); e.WI = (float*)(ws + WS_WI);
        g8::gemm_phase(lds, s, e);
    }
    xcd_barrier(xbar);
    {
        g8::PlainSched s; s.Abase = (const char*)(ws + WS_H) + 1024 * 2; s.Bbase = (const char*)(ws + WS_WQ); s.lda = NIN; s.ldb = 256; s.K = 256; s.nM = T / 256; s.nN = 5; s.G = G; s.c = c;
        EpiQ e; e.Q = (u16*)(ws + WS_Q); e.QI = (u16*)(ws + WS_QI); e.SSQ = (const float*)(ws + WS_SSQ);
        g8::gemm_phase(lds, s, e);
        for (int u = c; u < 1024; u += G) gmlp_unit(a, lds, u);
        kvnorm(a);
    }
    xcd_barrier(xbar);
    dsa_phase(a, lds);
    xcd_barrier(xbar);
    {
        g8::PlainSched s; s.Abase = (const char*)(ws + WS_YO); s.Bbase = (const char*)(ws + WS_WCAT); s.lda = 1536; s.ldb = 1536; s.K = 512; s.nM = T / 256; s.nN = 4; s.G = G; s.c = c;
        EpiMrg<0> e0; e0.OUT = (u16*)(ws + WS_TMP); e0.TMP = nullptr; e0.H = (const u16*)(ws + WS_H);
        g8::gemm_phase(lds, s, e0);
        s.Abase = (const char*)(ws + WS_YO) + 512 * 2; s.Bbase = (const char*)(ws + WS_WCAT) + 512 * 2; s.K = 1024;
        EpiMrg<1> e1; e1.OUT = (u16*)(ws + WS_MRG); e1.TMP = (const u16*)(ws + WS_TMP); e1.H = (const u16*)(ws + WS_H);
        g8::gemm_phase(lds, s, e1);
    }
    xcd_barrier(xbar);
    {
        g8::PlainSched s; s.Abase = (const char*)(ws + WS_MRG); s.Bbase = (const char*)(ws + WS_WOUT); s.lda = 1024; s.ldb = 1024; s.K = 1024; s.nM = T / 256; s.nN = 4; s.G = G; s.c = c;
        EpiOut e; e.out = a.out; e.x = a.in[I_X];
        g8::gemm_phase(lds, s, e);
    }
    xcd_barrier(xbar);
    router_phase(a, lds);
    xcd_barrier(xbar);
    moe_table(lds, (const unsigned*)(ws + WS_CTL));
    {
        MoeSched<8, true> s; s.Abase = (const char*)(ws + WS_XN2); s.Wbase = (const char*)(ws + WS_WE1); s.LTOK = (const int*)(ws + WS_LTOK); s.tab = (LAS const int*)(lds + MOE_TAB);
        s.lda = 1024; s.ldb = 1024; s.K = 1024; s.G = G; s.c = c; s.wstride = (size_t)2048 * 1024;
        EpiMoe1 e; e.ACT = (unsigned char*)(ws + WS_ACT); e.b1 = a.in[I_BE1];
        g8::gemm_phase<true>(lds, s, e);
    }
    xcd_barrier(xbar);
    {
        MoeSched<4, false> s; s.Abase = (const char*)(ws + WS_ACT); s.Wbase = (const char*)(ws + WS_WE2); s.LTOK = nullptr; s.tab = (LAS const int*)(lds + MOE_TAB);
        s.lda = 1024; s.ldb = 1024; s.K = 1024; s.G = G; s.c = c; s.wstride = (size_t)1024 * 1024;
        EpiMoe2 e; e.YB = (u16*)(ws + WS_YB); e.b2 = a.in[I_BE2]; e.LGATE = (const float*)(ws + WS_LGATE); e.tab = (LAS const int*)(lds + MOE_TAB);
        g8::gemm_phase<true>(lds, s, e);
    }
    xcd_barrier(xbar);
    combine_phase(a, lds);
    if (a.mask == 0u) grid.sync();
}

extern "C" void kernel_launch(void* const* d_in, const int* in_sizes, int n_in, void* d_out, int out_size, void* d_ws, size_t ws_size, hipStream_t stream) {
    static int grid = 0;
    if (grid == 0) {
        int dev = 0, cus = 0, per_cu = 0;
        if (n_in != 23 || out_size != T * Dm || ws_size < WS_END) { fprintf(stderr, "kernel_launch: unexpected problem (n_in %d, out %d, ws %zu < %zu)\n", n_in, out_size, ws_size, (size_t)WS_END); grid = -1; return; }
        if (hipGetDevice(&dev) != hipSuccess || hipDeviceGetAttribute(&cus, hipDeviceAttributeMultiprocessorCount, dev) != hipSuccess) { grid = -1; return; }
        if (hipFuncSetAttribute((const void*)fwd, hipFuncAttributeMaxDynamicSharedMemorySize, LDS_BYTES) != hipSuccess) { fprintf(stderr, "hipFuncSetAttribute failed\n"); grid = -1; return; }
        if (hipOccupancyMaxActiveBlocksPerMultiprocessor(&per_cu, (const void*)fwd, NT, LDS_BYTES) != hipSuccess || per_cu < 1) { fprintf(stderr, "occupancy query failed (%d)\n", per_cu); grid = -1; return; }
        grid = cus;
        fprintf(stderr, "kernel_launch: cus %d per_cu %d grid %d ws %zu need %zu\n", cus, per_cu, grid, ws_size, (size_t)WS_END);
    }
    if (grid < 0) return;
    Args a{};
    for (int i = 0; i < 23; ++i) a.in[i] = (const float*)d_in[i];
    a.out = (float*)d_out; a.ws = (unsigned char*)d_ws; a.mask = 0xffffffffu; a.pad = 0u;
    if (hipMemsetAsync((char*)d_ws + WS_CTL, 0, 65536, stream) != hipSuccess) { fprintf(stderr, "memset failed\n"); return; }
    void* args[] = {&a};
    hipError_t e = hipLaunchCooperativeKernel((const void*)fwd, dim3(grid), dim3(NT), args, LDS_BYTES, stream);
    if (e != hipSuccess) fprintf(stderr, "cooperative launch failed: %s (grid %d)\n", hipGetErrorString(e), grid);
}
```

```cpp
#include <hip/hip_runtime.h>
#include <hip/hip_cooperative_groups.h>
#include <cstdio>
#include <cstdint>
namespace cg = cooperative_groups;

#define LAS __attribute__((address_space(3)))
#define DI __device__ __forceinline__
typedef unsigned short u16;
typedef short bf16x8 __attribute__((ext_vector_type(8)));
typedef short s16x4 __attribute__((ext_vector_type(4)));
typedef float f32x4 __attribute__((ext_vector_type(4)));
typedef float f32x2 __attribute__((ext_vector_type(2)));
typedef unsigned u32x4 __attribute__((ext_vector_type(4)));
typedef unsigned u32x2 __attribute__((ext_vector_type(2)));
typedef __bf16 bf2_t __attribute__((ext_vector_type(2)));
typedef int v8i_t __attribute__((ext_vector_type(8)));

constexpr int NT = 512;
constexpr int LDS_BYTES = 159744;
constexpr int Dm = 1024, Bsz = 4, S = 8192, T = Bsz * S;
constexpr int NIN = 3584;
constexpr int NE = 32, ECAP = 32768, PPAD = 131072 + NE * 256;
constexpr float EPS = 1e-6f;

constexpr size_t MiB = 1024 * 1024;
constexpr size_t WS_CTL = 0;
constexpr size_t WS_BAR = 16384;
constexpr int LDS_BARST = LDS_BYTES - 16;
constexpr size_t WS_WIN = 64 * 1024;
constexpr size_t WS_WQ = WS_WIN + (size_t)NIN * 1024 * 2;
constexpr size_t WS_WSP = WS_WQ + 1280 * 256 * 2;
constexpr size_t WS_WCAT = WS_WSP + 4 * 128 * 128 * 2;
constexpr size_t WS_WOUT = WS_WCAT + 1024 * 1536 * 2;
constexpr size_t WS_WR = WS_WOUT + 1024 * 1024 * 2;
constexpr size_t WS_WE1 = WS_WR + 32 * 1024 * 4;
constexpr size_t WS_WE2 = WS_WE1 + (size_t)32 * 2048 * 1024 * 2;
constexpr size_t WS_RS1 = WS_WE2 + (size_t)32 * 1024 * 1024 * 2;
constexpr size_t WS_SSQ = WS_RS1 + (size_t)T * 4;
constexpr size_t WS_WI = WS_SSQ + (size_t)T * 32 * 4;
constexpr size_t WS_ROUTE = WS_WI + (size_t)T * 4 * 4;
constexpr size_t WS_LTOK = WS_ROUTE + (size_t)T * 4 * 4;
constexpr size_t WS_LGATE = WS_LTOK + (size_t)NE * ECAP * 4;
constexpr size_t WS_LRS = WS_LGATE + (size_t)NE * ECAP * 4;
constexpr size_t WS_XN2 = WS_LRS + (size_t)NE * ECAP * 4;
constexpr size_t WS_R0 = WS_XN2 + (size_t)T * 1024 * 2;
constexpr size_t WS_XB = WS_R0;
constexpr size_t WS_H = WS_XB + (size_t)T * 1024 * 2;
constexpr size_t WS_Q = WS_H + (size_t)T * NIN * 2;
constexpr size_t WS_QI = WS_Q + (size_t)T * 1024 * 2;
constexpr size_t WS_KVN = WS_QI + (size_t)T * 256 * 2;
constexpr size_t WS_KIN = WS_KVN + (size_t)T * 128 * 2;
constexpr size_t WS_YO = WS_KIN + (size_t)T * 64 * 2;
constexpr size_t WS_TMP = WS_YO + (size_t)T * 1536 * 2;
constexpr size_t WS_MRG = WS_TMP + (size_t)T * 1024 * 2;
constexpr size_t WS_R0END = WS_MRG + (size_t)T * 1024 * 2;
constexpr size_t WS_ACT = WS_XB;
constexpr size_t WS_YB = WS_Q;
static_assert(WS_ACT + (size_t)PPAD * 1024 * 2 <= WS_Q, "ACT overlaps YB");
static_assert(WS_YB + (size_t)PPAD * 1024 * 2 <= WS_R0END, "YB too large");
constexpr size_t WS_END = WS_R0END;

struct Args { const float* in[23]; float* out; unsigned char* ws; unsigned mask; unsigned pad; };
enum { I_X = 0, I_N1G, I_WIN, I_QLG, I_WUQ, I_QNG, I_KVG, I_WUV, I_WQI, I_KIG, I_VG, I_WSP, I_BSP, I_WPA, I_WPB, I_WOUT, I_N2G, I_WR, I_BR, I_WE1, I_BE1, I_WE2, I_BE2 };

DI unsigned pk2(float a, float b) { f32x2 v = {a, b}; bf2_t r = __builtin_convertvector(v, bf2_t); return __builtin_bit_cast(unsigned, r); }
DI unsigned pk4_fp8(float a, float b, float c, float d) { unsigned w = 0u; w = (unsigned)__builtin_amdgcn_cvt_pk_fp8_f32(a, b, (int)w, false); w = (unsigned)__builtin_amdgcn_cvt_pk_fp8_f32(c, d, (int)w, true); return w; }
DI unsigned pk4_i8(float a, float b, float c, float d) {
    const int ia = (int)__builtin_rintf(fminf(fmaxf(a * 32.0f, -127.0f), 127.0f)), ib = (int)__builtin_rintf(fminf(fmaxf(b * 32.0f, -127.0f), 127.0f));
    const int ic = (int)__builtin_rintf(fminf(fmaxf(c * 32.0f, -127.0f), 127.0f)), id = (int)__builtin_rintf(fminf(fmaxf(d * 32.0f, -127.0f), 127.0f));
    return (unsigned)(ia & 0xff) | ((unsigned)(ib & 0xff) << 8) | ((unsigned)(ic & 0xff) << 16) | ((unsigned)(id & 0xff) << 24);
}
DI float bflo(unsigned u) { return __uint_as_float(u << 16); }
DI float bfhi(unsigned u) { return __uint_as_float(u & 0xffff0000u); }
DI u16 f2bf(float f) { return (u16)(pk2(f, 0.f) & 0xffffu); }
DI float bf2f(u16 h) { return __uint_as_float(((unsigned)h) << 16); }
DI float sigmoidf_(float x) { return __builtin_amdgcn_rcpf(1.0f + __expf(-x)); }
DI float gelu_tanh(float x) { const float u = 1.5957691216057308f * (x + 0.044715f * x * x * x); return x * sigmoidf_(u); }
DI float fast_sigmoid(float x) { return __builtin_amdgcn_rcpf(1.0f + __builtin_amdgcn_exp2f(x * -1.4426950408889634f)); }
DI float fast_gelu(float x) { const float p = __builtin_fmaf(x * x, -0.10294324f, -2.3022082f); return x * __builtin_amdgcn_rcpf(1.0f + __builtin_amdgcn_exp2f(x * p)); }
DI int otid() { int t = threadIdx.x; asm volatile("" : "+v"(t)); return t; }
DI void wave_lds_sync() { asm volatile("s_waitcnt lgkmcnt(0)" ::: "memory"); }

namespace g8 {
constexpr int BM = 256, BK = 64, HALF = 128, HTB = HALF * BK * 2, STAGE_BYTES = 8 * HTB, NXCD = 8, WGM = 8;
DI int lds_byte(int r, int c) { const int st = (r >> 4) * 2 + (c >> 5), rr = r & 15, cc = c & 31, ob = rr * 64 + cc * 2; return st * 1024 + (ob ^ (((ob >> 9) & 1) << 5)); }
DI int perm32(int rho) { const int n = rho >> 4, i = rho & 15; return 8 * (i >> 2) + 4 * n + (i & 3); }
DI void stage_rc(int b, int& R, int& C) { const int st = b / 1024, sb = b % 1024, swz = sb ^ (((sb >> 9) & 1) << 5); R = (st >> 1) * 16 + swz / 64; C = (st & 1) * 32 + (swz % 64) / 2; }

struct UnitD { const char* Bp; int pm, pn, e, rb; };

DI bool static_tile(int i, int G, int c, int nM, int nN, int& pm, int& pn) {
    const int nwg = nM * nN; const long L = (long)i * G + c; if (L >= nwg) return false;
    int wgid = (int)L; { const int q = nwg / NXCD, r = nwg % NXCD, xcd = wgid % NXCD, off = wgid / NXCD; wgid = (xcd < r ? xcd * (q + 1) : r * (q + 1) + (xcd - r) * q) + off; }
    const int nig = WGM * nN, gid = wgid / nig, fm = gid * WGM, gsz = (nM - fm) < WGM ? (nM - fm) : WGM;
    pm = fm + ((wgid % nig) % gsz); pn = (wgid % nig) / gsz; return true;
}

struct PlainSched {
    const char* Abase; const char* Bbase; int lda, ldb, K, nM, nN, G, c; static constexpr int esz = 2;
    DI bool next(int i, UnitD& u) const { int pm, pn; if (!static_tile(i, G, c, nM, nN, pm, pn)) return false; u.pm = pm; u.pn = pn; u.e = 0; u.rb = 0; u.Bp = Bbase + (size_t)pn * BM * ldb * 2; return true; }
    DI void a_offs(const UnitD& u, int R0, int C0, unsigned (&o)[2][2]) const {
#pragma unroll
        for (int h = 0; h < 2; ++h)
#pragma unroll
            for (int i = 0; i < 2; ++i) o[h][i] = (unsigned)(((size_t)(u.pm * BM + h * HALF + R0 + 64 * i) * lda + C0) * 2);
    }
};

template <bool FP8 = false, class Epi, class Sched>
DI void gemm_phase(LAS unsigned char* lds, const Sched& S, const Epi& E) {
    const int tid = otid(), wid = __builtin_amdgcn_readfirstlane(tid >> 6), lane = tid & 63, wr = wid >> 2, wc = wid & 3, fr = lane & 15, fq = lane >> 4;
    const int nt = S.K * Sched::esz / 128;
    int R0, C0; stage_rc(tid * 16, R0, C0);
    unsigned voffB[2];
#pragma unroll
    for (int i = 0; i < 2; ++i) { const int Rr = R0 + 64 * i, Rb = Epi::PERM ? ((Rr & ~31) + perm32(Rr & 31)) : Rr; voffB[i] = (unsigned)(Rb * S.ldb * Sched::esz + C0 * 2); }
    const size_t hstepB = (size_t)HALF * S.ldb * Sched::esz;
    const unsigned ldsw = (unsigned)wid * 1024u;
    const int aoff = FP8 ? lds_byte(wr * 64 + fr, fq * 16) : lds_byte(wr * 64 + fr, fq * 8), boff = FP8 ? lds_byte(wc * 32 + fr, fq * 16) : lds_byte(wc * 32 + fr, fq * 8);
    const unsigned mxscale = 0x7f7f7f7fu;
    const int kst = FP8 ? 16 : 1024;
    const char* Ab = S.Abase;
#define G8_SA(b, h) (((b) * 2 + (h)) * HTB)
#define G8_SB(b, h) ((4 + (b) * 2 + (h)) * HTB)
#define G8_STAGE_A(bufoff, offs, kb) do { _Pragma("unroll") for (int _i = 0; _i < 2; ++_i) \
        __builtin_amdgcn_global_load_lds((const unsigned*)(Ab + (size_t)(offs)[_i] + (size_t)(kb)), (LAS unsigned*)(lds + (bufoff) + ldsw + _i * 8192), 16, 0, 0); } while (0)
#define G8_STAGE_B(bufoff, gbase, kb) do { _Pragma("unroll") for (int _i = 0; _i < 2; ++_i) \
        __builtin_amdgcn_global_load_lds((const unsigned*)((gbase) + voffB[_i] + (size_t)(kb)), (LAS unsigned*)(lds + (bufoff) + ldsw + _i * 8192), 16, 0, 0); } while (0)
#define G8_LDA(dst, b, h) do { _Pragma("unroll") for (int m = 0; m < 4; ++m) { const i32x4_t _p = *(const LAS i32x4_t*)(lds + G8_SA(b, h) + aoff + m * 2048), _q = *(const LAS i32x4_t*)(lds + G8_SA(b, h) + aoff + m * 2048 + kst); dst[m] = __builtin_shufflevector(_p, _q, 0, 1, 2, 3, 4, 5, 6, 7); } } while (0)
#define G8_LDB(dst, b, h) do { _Pragma("unroll") for (int n = 0; n < 2; ++n) { const i32x4_t _p = *(const LAS i32x4_t*)(lds + G8_SB(b, h) + boff + n * 2048), _q = *(const LAS i32x4_t*)(lds + G8_SB(b, h) + boff + n * 2048 + kst); dst[n] = __builtin_shufflevector(_p, _q, 0, 1, 2, 3, 4, 5, 6, 7); } } while (0)
#define G8_MMA(ai, bj, At, Bt) do { __builtin_amdgcn_s_setprio(1); _Pragma("unroll") for (int m = 0; m < 4; ++m) _Pragma("unroll") for (int n = 0; n < 2; ++n) { \
        if constexpr (FP8) asm volatile("v_mfma_scale_f32_16x16x128_f8f6f4 %0, %1, %2, %0, %3, %3 op_sel_hi:[0,0,0]" : "+v"(acc[ai][bj][m][n]) : "v"(Bt[n]), "v"(At[m]), "v"(mxscale)); \
        else { acc[ai][bj][m][n] = __builtin_amdgcn_mfma_f32_16x16x32_bf16(__builtin_bit_cast(bf16x8, __builtin_shufflevector(Bt[n], Bt[n], 0, 1, 2, 3)), __builtin_bit_cast(bf16x8, __builtin_shufflevector(At[m], At[m], 0, 1, 2, 3)), acc[ai][bj][m][n], 0, 0, 0); \
               acc[ai][bj][m][n] = __builtin_amdgcn_mfma_f32_16x16x32_bf16(__builtin_bit_cast(bf16x8, __builtin_shufflevector(Bt[n], Bt[n], 4, 5, 6, 7)), __builtin_bit_cast(bf16x8, __builtin_shufflevector(At[m], At[m], 4, 5, 6, 7)), acc[ai][bj][m][n], 0, 0, 0); } } \
        __builtin_amdgcn_s_setprio(0); } while (0)
#define G8_WAIT_V(n) asm volatile("s_waitcnt vmcnt(" #n ")" ::: "memory")
#define G8_WAIT_L(n) asm volatile("s_waitcnt lgkmcnt(" #n ")" ::: "memory")
#define G8_BAR __builtin_amdgcn_s_barrier()
#define G8_SCHED __builtin_amdgcn_sched_barrier(0)
    UnitD cur, nxt; int ui = 0;
    if (!S.next(0, cur)) return;
    f32x4 acc[2][2][4][2];
#pragma unroll
    for (int a = 0; a < 2; ++a)
#pragma unroll
        for (int b = 0; b < 2; ++b)
#pragma unroll
            for (int m = 0; m < 4; ++m)
#pragma unroll
                for (int n = 0; n < 2; ++n) acc[a][b][m][n] = (f32x4){0.f, 0.f, 0.f, 0.f};
    typedef int i32x4_t __attribute__((ext_vector_type(4)));
    v8i_t At[4], B0[2], B1[2];
    unsigned cA[2][2];
    S.a_offs(cur, R0, C0, cA);
    const char* cB = cur.Bp;
    G8_STAGE_B(G8_SB(0, 0), cB, 0); G8_STAGE_A(G8_SA(0, 0), cA[0], 0); G8_STAGE_B(G8_SB(0, 1), cB + hstepB, 0); G8_STAGE_A(G8_SA(0, 1), cA[1], 0);
    if (wr == 1) G8_BAR;
    G8_WAIT_V(4); G8_BAR;
    G8_STAGE_B(G8_SB(1, 0), cB, 128); G8_STAGE_A(G8_SA(1, 0), cA[0], 128); G8_STAGE_B(G8_SB(1, 1), cB + hstepB, 128);
    G8_WAIT_V(6); G8_BAR;
    for (;;) {
        const bool has_next = S.next(ui + 1, nxt);
        const char* nB = has_next ? nxt.Bp : cB;
        for (int t = 0; t < nt; t += 2) {
            const bool last = (t == nt - 2);
            const unsigned k1 = (unsigned)(t + 1) * 128u;
            const unsigned k2 = last ? 0u : (unsigned)(t + 2) * 128u, k3 = k2 + 128u;
            unsigned c1[2] = {cA[1][0], cA[1][1]};
            if (last && has_next) S.a_offs(nxt, R0, C0, cA);
            const char* b2 = last ? nB : cB;
            G8_LDB(B0, 0, 0); G8_SCHED; G8_LDA(At, 0, 0); G8_STAGE_A(G8_SA(1, 1), c1, k1);
            G8_WAIT_L(8); G8_BAR; G8_WAIT_L(0); G8_MMA(0, 0, At, B0); G8_BAR; G8_SCHED;
            G8_LDB(B1, 0, 1); G8_STAGE_B(G8_SB(0, 0), b2, k2);
            G8_BAR; G8_WAIT_L(0); G8_MMA(0, 1, At, B1); G8_BAR;
            G8_LDA(At, 0, 1); G8_STAGE_A(G8_SA(0, 0), cA[0], k2);
            G8_BAR; G8_WAIT_L(0); G8_MMA(1, 0, At, B0); G8_BAR; G8_SCHED;
            G8_STAGE_B(G8_SB(0, 1), b2 + hstepB, k2);
            G8_WAIT_V(6); G8_BAR; G8_MMA(1, 1, At, B1); G8_BAR;
            G8_LDB(B0, 1, 0); G8_SCHED; G8_LDA(At, 1, 0); G8_STAGE_A(G8_SA(0, 1), cA[1], k2);
            G8_WAIT_L(8); G8_BAR; G8_WAIT_L(0); G8_MMA(0, 0, At, B0); G8_BAR; G8_SCHED;
            G8_LDB(B1, 1, 1); G8_STAGE_B(G8_SB(1, 0), b2, k3);
            G8_BAR; G8_WAIT_L(0); G8_MMA(0, 1, At, B1); G8_BAR;
            G8_LDA(At, 1, 1); G8_STAGE_A(G8_SA(1, 0), cA[0], k3);
            G8_BAR; G8_WAIT_L(0); G8_MMA(1, 0, At, B0); G8_BAR; G8_SCHED;
            G8_STAGE_B(G8_SB(1, 1), b2 + hstepB, k3);
            G8_WAIT_V(6); G8_BAR; G8_MMA(1, 1, At, B1); G8_BAR;
        }
        if constexpr (FP8) asm volatile("s_nop 15\n\ts_nop 15" ::: "memory");
        E(acc, cur, wr, wc, fr, fq);
        if (!has_next) break;
#pragma unroll
        for (int a = 0; a < 2; ++a)
#pragma unroll
            for (int b = 0; b < 2; ++b)
#pragma unroll
                for (int m = 0; m < 4; ++m)
#pragma unroll
                    for (int n = 0; n < 2; ++n) acc[a][b][m][n] = (f32x4){0.f, 0.f, 0.f, 0.f};
        cur = nxt; cB = nB; ++ui;
    }
    G8_WAIT_V(0);
    if (wr == 0) G8_BAR;
    G8_BAR;
#undef G8_SA
#undef G8_SB
#undef G8_STAGE_A
#undef G8_STAGE_B
#undef G8_LDA
#undef G8_LDB
#undef G8_MMA
#undef G8_WAIT_V
#undef G8_WAIT_L
#undef G8_BAR
#undef G8_SCHED
}
}
using g8::UnitD;
typedef f32x4 Acc[2][2][4][2];

struct EpiIn {
    static constexpr bool PERM = true;
    u16* H; const float* rs1; float* SSQ; float* WI;
    template <int ACT, bool DOSSQ> DI void run(const Acc& acc, const UnitD& u, int wr, int wc, int fr, int fq) const {
        const int pn = u.pn;
        float rsv[2][4];
#pragma unroll
        for (int ai = 0; ai < 2; ++ai)
#pragma unroll
            for (int m = 0; m < 4; ++m) rsv[ai][m] = rs1[u.pm * 256 + ai * 128 + wr * 64 + m * 16 + fr];
        __builtin_amdgcn_sched_barrier(0);
#pragma unroll
        for (int ai = 0; ai < 2; ++ai)
#pragma unroll
            for (int m = 0; m < 4; ++m) {
                const int row = u.pm * 256 + ai * 128 + wr * 64 + m * 16 + fr;
                const float rs = rsv[ai][m];
#pragma unroll
                for (int bj = 0; bj < 2; ++bj) {
                    f32x4 v0 = acc[ai][bj][m][0] * rs, v1 = acc[ai][bj][m][1] * rs;
                    if (ACT == 1) {
#pragma unroll
                        for (int j = 0; j < 4; ++j) { v0[j] = fast_gelu(v0[j]); v1[j] = fast_gelu(v1[j]); }
                    } else if (ACT == 2) {
#pragma unroll
                        for (int j = 0; j < 4; ++j) { v0[j] = fast_sigmoid(v0[j]); v1[j] = fast_sigmoid(v1[j]); }
                    }
                    u32x4 w; w.x = pk2(v0[0], v0[1]); w.y = pk2(v0[2], v0[3]); w.z = pk2(v1[0], v1[1]); w.w = pk2(v1[2], v1[3]);
                    *(u32x4*)(H + (size_t)row * NIN + pn * 256 + bj * 128 + wc * 32 + 8 * fq) = w;
                    if (DOSSQ) {
                        float ssq = ((v0[0] * v0[0] + v0[1] * v0[1]) + (v0[2] * v0[2] + v0[3] * v0[3])) + ((v1[0] * v1[0] + v1[1] * v1[1]) + (v1[2] * v1[2] + v1[3] * v1[3]));
                        ssq += __shfl_xor(ssq, 16); ssq += __shfl_xor(ssq, 32);
                        if (fq == 0) SSQ[(size_t)row * 32 + (pn - 2) * 8 + bj * 4 + wc] = ssq;
                        if (pn == 5 && bj == 1 && wc == 2 && fq == 0) *(f32x4*)(WI + (size_t)row * 4) = v0 * 0.5f;
                    }
                }
            }
    }
    DI void operator()(const Acc& acc, const UnitD& u, int wr, int wc, int fr, int fq) const {
        const int pn = u.pn;
        if (pn < 2) run<1, false>(acc, u, wr, wc, fr, fq);
        else if (pn < 4) run<1, true>(acc, u, wr, wc, fr, fq);
        else if (pn < 6) run<0, true>(acc, u, wr, wc, fr, fq);
        else run<2, false>(acc, u, wr, wc, fr, fq);
    }
};
struct EpiQ {
    static constexpr bool PERM = true;
    u16* Q; u16* QI; const float* SSQ;
    DI void operator()(const Acc& acc, const UnitD& u, int wr, int wc, int fr, int fq) const {
        f32x4 sq[2][4][2];
#pragma unroll
        for (int ai = 0; ai < 2; ++ai)
#pragma unroll
            for (int m = 0; m < 4; ++m) { const int row = u.pm * 256 + ai * 128 + wr * 64 + m * 16 + fr; sq[ai][m][0] = *(const f32x4*)(SSQ + (size_t)row * 32 + 16); sq[ai][m][1] = *(const f32x4*)(SSQ + (size_t)row * 32 + 20); }
        __builtin_amdgcn_sched_barrier(0);
#pragma unroll
        for (int ai = 0; ai < 2; ++ai)
#pragma unroll
            for (int m = 0; m < 4; ++m) {
                const int row = u.pm * 256 + ai * 128 + wr * 64 + m * 16 + fr;
                const f32x4 s0 = sq[ai][m][0], s1 = sq[ai][m][1];
                const float ss = ((s0[0] + s0[1]) + (s0[2] + s0[3])) + ((s1[0] + s1[1]) + (s1[2] + s1[3]));
                const float rs = __builtin_amdgcn_rsqf(ss * (1.0f / 256.0f) + EPS);
#pragma unroll
                for (int bj = 0; bj < 2; ++bj) {
                    const int col = u.pn * 256 + bj * 128 + wc * 32 + 8 * fq;
                    const f32x4 v0 = acc[ai][bj][m][0] * rs, v1 = acc[ai][bj][m][1] * rs;
                    if (col < 1024) { u32x4 w; w.x = pk2(v0[0], v0[1]); w.y = pk2(v0[2], v0[3]); w.z = pk2(v1[0], v1[1]); w.w = pk2(v1[2], v1[3]); *(u32x4*)(Q + (size_t)row * 1024 + col) = w; }
                    else { u32x2 w; w.x = pk4_i8(v0[0], v0[1], v0[2], v0[3]); w.y = pk4_i8(v1[0], v1[1], v1[2], v1[3]); *(u32x2*)((unsigned char*)QI + (size_t)row * 256 + (col - 1024)) = w; }
                }
            }
    }
};
template <int SECOND> struct EpiMrg {
    static constexpr bool PERM = true;
    u16* OUT; const u16* TMP; const u16* H;
    DI void operator()(const Acc& acc, const UnitD& u, int wr, int wc, int fr, int fq) const {
#pragma unroll
        for (int ai = 0; ai < 2; ++ai) {
            u32x4 g[4][2], tp[4][2];
#pragma unroll
            for (int m = 0; m < 4; ++m)
#pragma unroll
                for (int bj = 0; bj < 2; ++bj) {
                    const int row = u.pm * 256 + ai * 128 + wr * 64 + m * 16 + fr, col = u.pn * 256 + bj * 128 + wc * 32 + 8 * fq;
                    g[m][bj] = *(const u32x4*)(H + (size_t)row * NIN + 1536 + SECOND * 1024 + col);
                    if (SECOND) tp[m][bj] = *(const u32x4*)(TMP + (size_t)row * 1024 + col);
                }
            __builtin_amdgcn_sched_barrier(0);
#pragma unroll
            for (int m = 0; m < 4; ++m)
#pragma unroll
                for (int bj = 0; bj < 2; ++bj) {
                    const int row = u.pm * 256 + ai * 128 + wr * 64 + m * 16 + fr, col = u.pn * 256 + bj * 128 + wc * 32 + 8 * fq;
                    const u32x4 gg = g[m][bj];
                    f32x4 v0 = acc[ai][bj][m][0], v1 = acc[ai][bj][m][1];
                    v0[0] *= bflo(gg.x); v0[1] *= bfhi(gg.x); v0[2] *= bflo(gg.y); v0[3] *= bfhi(gg.y); v1[0] *= bflo(gg.z); v1[1] *= bfhi(gg.z); v1[2] *= bflo(gg.w); v1[3] *= bfhi(gg.w);
                    if (SECOND) { const u32x4 t = tp[m][bj];
                        v0[0] += bflo(t.x); v0[1] += bfhi(t.x); v0[2] += bflo(t.y); v0[3] += bfhi(t.y); v1[0] += bflo(t.z); v1[1] += bfhi(t.z); v1[2] += bflo(t.w); v1[3] += bfhi(t.w); }
                    u32x4 w; w.x = pk2(v0[0], v0[1]); w.y = pk2(v0[2], v0[3]); w.z = pk2(v1[0], v1[1]); w.w = pk2(v1[2], v1[3]);
                    *(u32x4*)(OUT + (size_t)row * 1024 + col) = w;
                }
            __builtin_amdgcn_sched_barrier(0);
        }
    }
};
struct EpiOut {
    static constexpr bool PERM = false;
    float* out; const float* x;
    DI void operator()(const Acc& acc, const UnitD& u, int wr, int wc, int fr, int fq) const {
#pragma unroll
        for (int ai = 0; ai < 2; ++ai) {
            f32x4 xv[4][2][2];
#pragma unroll
            for (int m = 0; m < 4; ++m)
#pragma unroll
                for (int bj = 0; bj < 2; ++bj)
#pragma unroll
                    for (int n = 0; n < 2; ++n)
                        xv[m][bj][n] = *(const f32x4*)(x + (size_t)(u.pm * 256 + ai * 128 + wr * 64 + m * 16 + fr) * 1024 + u.pn * 256 + bj * 128 + wc * 32 + n * 16 + 4 * fq);
            __builtin_amdgcn_sched_barrier(0);
#pragma unroll
            for (int m = 0; m < 4; ++m)
#pragma unroll
                for (int bj = 0; bj < 2; ++bj)
#pragma unroll
                    for (int n = 0; n < 2; ++n)
                        *(f32x4*)(out + (size_t)(u.pm * 256 + ai * 128 + wr * 64 + m * 16 + fr) * 1024 + u.pn * 256 + bj * 128 + wc * 32 + n * 16 + 4 * fq) = xv[m][bj][n] + acc[ai][bj][m][n];
            __builtin_amdgcn_sched_barrier(0);
        }
    }
};

constexpr int MOE_TAB = g8::STAGE_BYTES;
DI void moe_table(LAS unsigned char* lds, const unsigned* CNT) {
    LAS int* tab = (LAS int*)(lds + MOE_TAB);
    __syncthreads();
    if (threadIdx.x == 0) { int acc = 0; for (int e = 0; e < NE; ++e) { const int c = (int)__hip_atomic_load(CNT + e, __ATOMIC_RELAXED, __HIP_MEMORY_SCOPE_AGENT); tab[e] = acc; tab[33 + e] = c; acc += (c + 255) >> 8; } tab[32] = acc; }
    __syncthreads();
}
template <int NPN, bool GATHER> struct MoeSched {
    const char* Abase; const char* Wbase; const int* LTOK; LAS const int* tab; int lda, ldb, K, G, c; size_t wstride; static constexpr int esz = 1;
    DI bool next(int i, UnitD& u) const {
        const long L = (long)i * G + c; const int R = tab[32];
        if (L >= (long)R * NPN) return false;
        const int rbg = (int)(L / NPN), pn = (int)(L % NPN);
        int e = 0;
        for (int j = 1; j < NE; ++j) e += (tab[j] <= rbg) ? 1 : 0;
        e = __builtin_amdgcn_readfirstlane(e);
        u.pm = rbg; u.pn = pn; u.e = e; u.rb = rbg - tab[e];
        u.Bp = Wbase + (size_t)e * wstride + (size_t)pn * 256 * ldb * esz;
        return true;
    }
    DI void a_offs(const UnitD& u, int R0, int C0, unsigned (&o)[2][2]) const {
        const int cnt = tab[33 + u.e];
#pragma unroll
        for (int h = 0; h < 2; ++h)
#pragma unroll
            for (int i = 0; i < 2; ++i) {
                const int r = h * 128 + R0 + 64 * i;
                if (GATHER) { const int slot = u.rb * 256 + r; const int tok = slot < cnt ? LTOK[(size_t)u.e * ECAP + slot] : 0; o[h][i] = (unsigned)((size_t)tok * lda * esz + C0 * 2); }
                else o[h][i] = (unsigned)((size_t)(u.pm * 256 + r) * lda * esz + C0 * 2);
            }
    }
};
struct EpiMoe1 {
    static constexpr bool PERM = true;
    unsigned char* ACT; const float* b1;
    DI void operator()(const Acc& acc, const UnitD& u, int wr, int wc, int fr, int fq) const {
        const float* be = b1 + (size_t)u.e * 2048;
        const int hc = u.pn * 128 + wc * 32 + 8 * fq;
        const f32x4 bg0 = *(const f32x4*)(be + hc), bg1 = *(const f32x4*)(be + hc + 4), bu0 = *(const f32x4*)(be + 1024 + hc), bu1 = *(const f32x4*)(be + 1024 + hc + 4);
        __builtin_amdgcn_sched_barrier(0);
#pragma unroll
        for (int ai = 0; ai < 2; ++ai)
#pragma unroll
            for (int m = 0; m < 4; ++m) {
                const int row = u.pm * 256 + ai * 128 + wr * 64 + m * 16 + fr;
                float av[8];
#pragma unroll
                for (int n = 0; n < 2; ++n) {
                    const f32x4 g = acc[ai][0][m][n] * 0.015625f + (n ? bg1 : bg0), up = acc[ai][1][m][n] * 0.015625f + (n ? bu1 : bu0);
#pragma unroll
                    for (int j = 0; j < 4; ++j) {
                        const float hg = fminf(g[j], 7.0f), hu = __builtin_amdgcn_fmed3f(up[j], -7.0f, 7.0f);
                        av[4 * n + j] = (hu + 1.0f) * (hg * __builtin_amdgcn_rcpf(1.0f + __builtin_amdgcn_exp2f(hg * -2.4554669595930157f)));
                    }
                }
                u32x2 w; w.x = pk4_fp8(av[0], av[1], av[2], av[3]); w.y = pk4_fp8(av[4], av[5], av[6], av[7]);
                *(u32x2*)(ACT + (size_t)row * 1024 + hc) = w;
            }
    }
};
struct EpiMoe2 {
    static constexpr bool PERM = true;
    u16* YB; const float* b2;
    DI void operator()(const Acc& acc, const UnitD& u, int wr, int wc, int fr, int fq) const {
        const float* be = b2 + (size_t)u.e * 1024;
        f32x4 bias[2][2];
#pragma unroll
        for (int bj = 0; bj < 2; ++bj) { const int col = u.pn * 256 + bj * 128 + wc * 32 + 8 * fq; bias[bj][0] = *(const f32x4*)(be + col); bias[bj][1] = *(const f32x4*)(be + col + 4); }
        __builtin_amdgcn_sched_barrier(0);
#pragma unroll
        for (int ai = 0; ai < 2; ++ai)
#pragma unroll
            for (int m = 0; m < 4; ++m) {
                const int r = ai * 128 + wr * 64 + m * 16 + fr;
#pragma unroll
                for (int bj = 0; bj < 2; ++bj) {
                    const int col = u.pn * 256 + bj * 128 + wc * 32 + 8 * fq;
                    const f32x4 v0 = acc[ai][bj][m][0] * 0.015625f + bias[bj][0], v1 = acc[ai][bj][m][1] * 0.015625f + bias[bj][1];
                    u32x4 w; w.x = pk2(v0[0], v0[1]); w.y = pk2(v0[2], v0[3]); w.z = pk2(v1[0], v1[1]); w.w = pk2(v1[2], v1[3]);
                    *(u32x4*)(YB + (size_t)(u.pm * 256 + r) * 1024 + col) = w;
                }
            }
    }
};

template <bool FP8 = false, class F> DI void tr_tile(LAS unsigned char* lds, const float* src, int ld_src, int Nsz, int k0, int n0, const float* sk, float mul, u16* dst, int ld_dst, F rowmap) {
    LAS float* t = (LAS float*)lds;
    const int tid = otid();
    __syncthreads();
#pragma unroll
    for (int it = 0; it < 2; ++it) {
        const int k = (tid >> 4) + 32 * it, n = 4 * (tid & 15);
        f32x4 v = {0.f, 0.f, 0.f, 0.f};
        if (n0 + n < Nsz) v = *(const f32x4*)(src + (size_t)(k0 + k) * ld_src + n0 + n);
        const float s = (sk ? sk[k0 + k] : 1.0f) * mul;
        t[k * 65 + n] = v[0] * s; t[k * 65 + n + 1] = v[1] * s; t[k * 65 + n + 2] = v[2] * s; t[k * 65 + n + 3] = v[3] * s;
    }
    __syncthreads();
    const int n = tid >> 3, kc = (tid & 7) * 8;
    if (FP8) {
        if (n0 + n < Nsz) {
            u32x2 w;
            w.x = pk4_fp8(t[(kc + 0) * 65 + n], t[(kc + 1) * 65 + n], t[(kc + 2) * 65 + n], t[(kc + 3) * 65 + n]);
            w.y = pk4_fp8(t[(kc + 4) * 65 + n], t[(kc + 5) * 65 + n], t[(kc + 6) * 65 + n], t[(kc + 7) * 65 + n]);
            *(u32x2*)((unsigned char*)dst + (size_t)rowmap(n0 + n) * ld_dst + k0 + kc) = w;
        }
    } else if (n0 + n < Nsz) {
        u32x4 w;
        w.x = pk2(t[(kc + 0) * 65 + n], t[(kc + 1) * 65 + n]); w.y = pk2(t[(kc + 2) * 65 + n], t[(kc + 3) * 65 + n]);
        w.z = pk2(t[(kc + 4) * 65 + n], t[(kc + 5) * 65 + n]); w.w = pk2(t[(kc + 6) * 65 + n], t[(kc + 7) * 65 + n]);
        *(u32x4*)(dst + (size_t)rowmap(n0 + n) * ld_dst + k0 + kc) = w;
    }
}
struct MapId { DI int operator()(int n) const { return n; } };
struct MapIn { DI int operator()(int n) const { return n < 1476 ? n : n + 60; } };
struct MapE1 { DI int operator()(int n) const { const int hi = n >= 1024 ? 1 : 0, q = n - hi * 1024; return (q >> 7) * 256 + hi * 128 + (q & 127); } };

DI void phase0(const Args& a, LAS unsigned char* lds) {
    unsigned char* ws = a.ws;
    const int tid = otid();
    const size_t gtid = (size_t)blockIdx.x * NT + tid, gstride = (size_t)gridDim.x * NT;
    for (size_t i = gtid; i < 60 * 1024 / 2; i += gstride) ((unsigned*)(ws + WS_WIN + (size_t)1476 * 1024 * 2))[i] = 0u;
    for (size_t i = gtid; i < 32 * 1024; i += gstride) { const int e = (int)(i >> 10), k = (int)(i & 1023); const float w = a.in[I_WR][k * 32 + e] * a.in[I_N2G][k]; const u16 h = f2bf(w); ((u16*)(ws + WS_WR))[i] = h; ((u16*)(ws + WS_WR))[32 * 1024 + i] = f2bf(w - bf2f(h)); }
    for (size_t i = gtid; i < 4 * 128 * 128; i += gstride) { const int tt = (int)((i >> 7) & 127), ss = (int)(i & 127); ((u16*)(ws + WS_WSP))[i] = f2bf(ss <= tt ? a.in[I_WSP][i] : 0.f); }
    {
        const int wid = tid >> 6, lane = tid & 63;
        for (int row = blockIdx.x * 8 + wid; row < T; row += gridDim.x * 8) {
            const float* xr = a.in[I_X] + (size_t)row * 1024; u16* xb = (u16*)(ws + WS_XB) + (size_t)row * 1024;
            float ss = 0.f;
#pragma unroll
            for (int i = 0; i < 4; ++i) {
                const f32x4 v = __builtin_nontemporal_load((const f32x4*)(xr + i * 256 + lane * 4));
                ss += (v[0] * v[0] + v[1] * v[1]) + (v[2] * v[2] + v[3] * v[3]);
                u32x2 w; w.x = pk2(v[0], v[1]); w.y = pk2(v[2], v[3]);
                *(u32x2*)(xb + i * 256 + lane * 4) = w;
            }
#pragma unroll
            for (int o = 32; o >= 1; o >>= 1) ss += __shfl_xor(ss, o);
            if (lane == 0) ((float*)(ws + WS_RS1))[row] = __builtin_amdgcn_rsqf(ss * (1.0f / 1024.0f) + EPS);
        }
    }
    constexpr int U_IN = 16 * 56, U_UQ = 4 * 16, U_QI = 4 * 4, U_PA = 8 * 16, U_OUT = 16 * 16, U_CB = 64;
    constexpr int U_TOT = U_IN + U_UQ + U_QI + U_PA + U_OUT + U_CB;
    for (int u = blockIdx.x; u < U_TOT; u += gridDim.x) {
        int v = u;
        if (v < U_IN) { tr_tile(lds, a.in[I_WIN], 3524, 3524, (v & 15) * 64, (v >> 4) * 64, a.in[I_N1G], 1.0f, (u16*)(ws + WS_WIN), 1024, MapIn()); continue; }
        v -= U_IN;
        if (v < U_UQ) { tr_tile(lds, a.in[I_WUQ], 1024, 1024, (v & 3) * 64, (v >> 2) * 64, a.in[I_QLG], 1.0f, (u16*)(ws + WS_WQ), 256, MapId()); continue; }
        v -= U_UQ;
        if (v < U_QI) { tr_tile(lds, a.in[I_WQI], 256, 256, (v & 3) * 64, (v >> 2) * 64, a.in[I_QLG], 1.0f, (u16*)(ws + WS_WQ) + 1024 * 256, 256, MapId()); continue; }
        v -= U_QI;
        if (v < U_PA) { tr_tile(lds, a.in[I_WPA], 1024, 1024, (v & 7) * 64, (v >> 3) * 64, nullptr, 1.0f, (u16*)(ws + WS_WCAT), 1536, MapId()); continue; }
        v -= U_PA;
        if (v < U_OUT) { tr_tile(lds, a.in[I_WOUT], 1024, 1024, (v & 15) * 64, (v >> 4) * 64, nullptr, 1.0f, (u16*)(ws + WS_WOUT), 1024, MapId()); continue; }
        v -= U_OUT;
        {
            const int h = v >> 3, c0 = (v & 7) * 16;
            LAS float* t = (LAS float*)lds;
            __syncthreads();
            for (int i = tid; i < 1024; i += NT) t[i] = a.in[I_WUV][(size_t)h * 128 * 64 + (size_t)c0 * 64 + i];
            __syncthreads();
            for (int nn = tid; nn < 1024; nn += NT) {
                float accv[16];
#pragma unroll
                for (int i = 0; i < 16; ++i) accv[i] = 0.f;
                for (int vv = 0; vv < 64; ++vv) {
                    const float pb = a.in[I_WPB][(size_t)(h * 64 + vv) * 1024 + nn];
#pragma unroll
                    for (int i = 0; i < 16; ++i) accv[i] += t[i * 64 + vv] * pb;
                }
                u32x4 w0, w1;
                w0.x = pk2(accv[0], accv[1]); w0.y = pk2(accv[2], accv[3]); w0.z = pk2(accv[4], accv[5]); w0.w = pk2(accv[6], accv[7]);
                w1.x = pk2(accv[8], accv[9]); w1.y = pk2(accv[10], accv[11]); w1.z = pk2(accv[12], accv[13]); w1.w = pk2(accv[14], accv[15]);
                u16* d = (u16*)(ws + WS_WCAT) + (size_t)nn * 1536 + 512 + h * 128 + c0;
                *(u32x4*)d = w0; *(u32x4*)(d + 8) = w1;
            }
        }
    }
}

DI void gmlp_unit(const Args& a, LAS unsigned char* lds, int u) {
    unsigned char* ws = a.ws;
    const int tid = otid(), wid = tid >> 6, lane = tid & 63, fr = lane & 15, fq = lane >> 4;
    const int g = u & 3, row0 = (u >> 2) * 128;
    const u16* H = (const u16*)(ws + WS_H);
    LAS u16* img = (LAS u16*)lds;
    __syncthreads();
    {
        const int s = tid & 127, cset = tid >> 7;
        const f32x4 sq = *(const f32x4*)((const float*)(ws + WS_SSQ) + (size_t)(row0 + s) * 32 + g * 4);
        const float rs = __builtin_amdgcn_rsqf(((sq[0] + sq[1]) + (sq[2] + sq[3])) * (1.0f / 128.0f) + EPS);
#pragma unroll
        for (int it = 0; it < 4; ++it) {
            const int c = cset + 4 * it;
            const u32x4 raw = *(const u32x4*)(H + (size_t)(row0 + s) * NIN + 512 + g * 128 + 8 * c);
            const float* vg = a.in[I_VG] + 8 * c;
            float f[8] = {bflo(raw.x), bfhi(raw.x), bflo(raw.y), bfhi(raw.y), bflo(raw.z), bfhi(raw.z), bflo(raw.w), bfhi(raw.w)};
#pragma unroll
            for (int i = 0; i < 8; ++i) img[(8 * c + i) * 136 + s] = f2bf(f[i] * rs * vg[i]);
        }
    }
    __syncthreads();
    const u16* W = (const u16*)(ws + WS_WSP) + (size_t)g * 128 * 128 + (size_t)(16 * wid + fr) * 128;
    f32x4 acc[8];
#pragma unroll
    for (int i = 0; i < 8; ++i) acc[i] = (f32x4){0.f, 0.f, 0.f, 0.f};
    const int nks = (16 * wid + 15) / 32 + 1;
    for (int ks = 0; ks < nks; ++ks) {
        const bf16x8 bw = *(const bf16x8*)(W + ks * 32 + 8 * fq);
#pragma unroll
        for (int i = 0; i < 8; ++i) {
            const bf16x8 av = *(const LAS bf16x8*)(img + (16 * i + fr) * 136 + ks * 32 + 8 * fq);
            acc[i] = __builtin_amdgcn_mfma_f32_16x16x32_bf16(av, bw, acc[i], 0, 0, 0);
        }
    }
    const int t = 16 * wid + fr;
    const float bias = a.in[I_BSP][g * 128 + t];
    u16* YO = (u16*)(ws + WS_YO);
#pragma unroll
    for (int i = 0; i < 8; ++i) {
        const int d = 16 * i + 4 * fq;
        const u32x2 uu = *(const u32x2*)(H + (size_t)(row0 + t) * NIN + g * 128 + d);
        const float y0 = bflo(uu.x) * (acc[i][0] + bias), y1 = bfhi(uu.x) * (acc[i][1] + bias), y2 = bflo(uu.y) * (acc[i][2] + bias), y3 = bfhi(uu.y) * (acc[i][3] + bias);
        u32x2 w; w.x = pk2(y0, y1); w.y = pk2(y2, y3);
        *(u32x2*)(YO + (size_t)(row0 + t) * 1536 + g * 128 + d) = w;
    }
}

DI void kvnorm(const Args& a) {
    unsigned char* ws = a.ws;
    const u16* H = (const u16*)(ws + WS_H); const float* SSQ = (const float*)(ws + WS_SSQ);
    const size_t gtid = (size_t)blockIdx.x * NT + otid(), gstride = (size_t)gridDim.x * NT;
    for (size_t idx = gtid; idx < (size_t)T * 24; idx += gstride) {
        const int row = (int)(idx / 24), c = (int)(idx % 24);
        const u16* src; u16* dst; const float* gain; float rs;
        if (c < 16) {
            const f32x4 sq = *(const f32x4*)(SSQ + (size_t)row * 32 + 24);
            rs = __builtin_amdgcn_rsqf(((sq[0] + sq[1]) + (sq[2] + sq[3])) * (1.0f / 128.0f) + EPS);
            src = H + (size_t)row * NIN + 1280 + 8 * c; dst = (u16*)(ws + WS_KVN) + (size_t)row * 128 + 8 * c; gain = a.in[I_KVG] + 8 * c;
        } else {
            const int cc = c - 16;
            rs = __builtin_amdgcn_rsqf((SSQ[(size_t)row * 32 + 28] + SSQ[(size_t)row * 32 + 29]) * (1.0f / 64.0f) + EPS);
            src = H + (size_t)row * NIN + 1408 + 8 * cc; dst = nullptr; gain = a.in[I_KIG] + 8 * cc;
            const u32x4 raw = *(const u32x4*)src;
            u32x2 w8;
            w8.x = pk4_i8(bflo(raw.x) * rs * gain[0], bfhi(raw.x) * rs * gain[1], bflo(raw.y) * rs * gain[2], bfhi(raw.y) * rs * gain[3]);
            w8.y = pk4_i8(bflo(raw.z) * rs * gain[4], bfhi(raw.z) * rs * gain[5], bflo(raw.w) * rs * gain[6], bfhi(raw.w) * rs * gain[7]);
            *(u32x2*)(ws + WS_KIN + (size_t)row * 64 + 8 * cc) = w8;
            continue;
        }
        const u32x4 raw = *(const u32x4*)src;
        u32x4 w;
        w.x = pk2(bflo(raw.x) * rs * gain[0], bfhi(raw.x) * rs * gain[1]); w.y = pk2(bflo(raw.y) * rs * gain[2], bfhi(raw.y) * rs * gain[3]);
        w.z = pk2(bflo(raw.z) * rs * gain[4], bfhi(raw.z) * rs * gain[5]); w.w = pk2(bflo(raw.w) * rs * gain[6], bfhi(raw.w) * rs * gain[7]);
        *(u32x4*)dst = w;
    }
}

constexpr int P3_ROWS = 0, P3_HIST = 131072, P3_LIST = 147456;
DI unsigned f2key(float f) { const unsigned u = __float_as_uint(f); return (u & 0x80000000u) ? ~u : (u | 0x80000000u); }
DI int wave_incl_scan(int v, int lane) {
#pragma unroll
    for (int o = 1; o < 64; o <<= 1) { const int t = __shfl_up(v, o); if (lane >= o) v += t; }
    return v;
}
DI int wave_suffix_scan(int v, int lane) {
#pragma unroll
    for (int o = 1; o < 64; o <<= 1) { const int t = __shfl_down(v, o); if (lane + o < 64) v += t; }
    return v;
}
DI unsigned pk_gt(unsigned kw, unsigned xw, unsigned one) {
    unsigned d, m;
    asm("v_pk_sub_u16 %0, %1, %2 clamp" : "=v"(d) : "v"(kw), "v"(xw));
    asm("v_pk_min_u16 %0, %1, %2" : "=v"(m) : "v"(d), "v"(one));
    return m;
}
DI unsigned pk_subs(unsigned kw, unsigned xw) { unsigned d; asm("v_pk_sub_u16 %0, %1, %2 clamp" : "=v"(d) : "v"(kw), "v"(xw)); return d; }
DI unsigned pk_min1(unsigned d, unsigned one) { unsigned m; asm("v_pk_min_u16 %0, %1, %2" : "=v"(m) : "v"(d), "v"(one)); return m; }
DI unsigned pk_max(unsigned a, unsigned b) { unsigned r; asm("v_pk_max_u16 %0, %1, %2" : "=v"(r) : "v"(a), "v"(b)); return r; }
DI unsigned pk_add(unsigned a, unsigned b) { unsigned r; asm("v_pk_add_u16 %0, %1, %2" : "=v"(r) : "v"(a), "v"(b)); return r; }
DI int wave_sum(int v) {
    v += __builtin_amdgcn_update_dpp(0, v, 0xB1, 0xf, 0xf, false);
    v += __builtin_amdgcn_update_dpp(0, v, 0x4E, 0xf, 0xf, false);
    v += __builtin_amdgcn_update_dpp(0, v, 0x141, 0xf, 0xf, false);
    v += __builtin_amdgcn_update_dpp(0, v, 0x140, 0xf, 0xf, false);
    return __builtin_amdgcn_readlane(v, 0) + __builtin_amdgcn_readlane(v, 16) + __builtin_amdgcn_readlane(v, 32) + __builtin_amdgcn_readlane(v, 48);
}
DI int rowaddr(int p) { return (p & ~511) | ((p & 63) << 3) | ((p >> 6) & 7); }
typedef unsigned short us2_t __attribute__((ext_vector_type(2)));
DI unsigned dot2acc(unsigned flags, unsigned wts, unsigned acc) { return __builtin_amdgcn_udot2(__builtin_bit_cast(us2_t, flags), __builtin_bit_cast(us2_t, wts), acc, false); }
DI void keys_load(LAS u16* row, int N, int lane, u32x4 (&kr)[16]) {
    const int Nup = (N + 511) & ~511, niter = Nup >> 9;
    for (int p = N + lane; p < Nup; p += 64) row[rowaddr(p)] = (u16)0;
    wave_lds_sync();
#pragma unroll
    for (int i = 0; i < 16; ++i) { kr[i] = (u32x4){0u, 0u, 0u, 0u}; if (i < niter) kr[i] = *(LAS const u32x4*)(row + i * 512 + lane * 8); }
    wave_lds_sync();
}
DI void keys_select(const u32x4 (&kr)[16], LAS u16* list, int N, int lane) {
    const int Nup = (N + 511) & ~511, niter = Nup >> 9;
    const unsigned one = 0x00010001u;
    auto count_gt = [&](unsigned x) -> int {
        const unsigned xw = x | (x << 16);
        unsigned acc = 0u, acc1 = 0u, acc2 = 0u, acc3 = 0u;
#pragma unroll
        for (int c = 0; c < 4; ++c) {
            if (4 * c < niter) {
#pragma unroll
                for (int h = 0; h < 2; ++h) {
                    unsigned d[8];
#pragma unroll
                    for (int i = 0; i < 2; ++i) { const u32x4 kk = kr[4 * c + 2 * h + i]; d[4 * i] = pk_subs(kk.x, xw); d[4 * i + 1] = pk_subs(kk.y, xw); d[4 * i + 2] = pk_subs(kk.z, xw); d[4 * i + 3] = pk_subs(kk.w, xw); }
#pragma unroll
                    for (int i = 0; i < 8; ++i) d[i] = pk_min1(d[i], one);
#pragma unroll
                    for (int i = 0; i < 8; i += 4) { acc = dot2acc(d[i], one, acc); acc1 = dot2acc(d[i + 1], one, acc1); acc2 = dot2acc(d[i + 2], one, acc2); acc3 = dot2acc(d[i + 3], one, acc3); }
                }
            }
        }
        return wave_sum((int)((acc + acc1) + (acc2 + acc3)));
    };
    unsigned T = 0u; int cge = Nup, topbit = 15;
    {
        unsigned mx = 0u;
#pragma unroll
        for (int c = 0; c < 4; ++c) {
            if (4 * c < niter) {
#pragma unroll
                for (int i = 4 * c; i < 4 * c + 4; ++i) { mx = pk_max(mx, kr[i].x); mx = pk_max(mx, kr[i].y); mx = pk_max(mx, kr[i].z); mx = pk_max(mx, kr[i].w); }
            }
        }
        unsigned m1 = max(mx & 0xffffu, mx >> 16);
        m1 = max(m1, (unsigned)__builtin_amdgcn_update_dpp(0, (int)m1, 0xB1, 0xf, 0xf, false)); m1 = max(m1, (unsigned)__builtin_amdgcn_update_dpp(0, (int)m1, 0x4E, 0xf, 0xf, false));
        m1 = max(m1, (unsigned)__builtin_amdgcn_update_dpp(0, (int)m1, 0x141, 0xf, 0xf, false)); m1 = max(m1, (unsigned)__builtin_amdgcn_update_dpp(0, (int)m1, 0x140, 0xf, 0xf, false));
        const unsigned kmax = max(max((unsigned)__builtin_amdgcn_readlane((int)m1, 0), (unsigned)__builtin_amdgcn_readlane((int)m1, 16)), max((unsigned)__builtin_amdgcn_readlane((int)m1, 32), (unsigned)__builtin_amdgcn_readlane((int)m1, 48)));
        if (kmax > 1024u) {
            const unsigned lo = kmax - 1023u;
            const int clo = count_gt(lo - 1u);
            if (clo >= 256) { T = lo; cge = clo; topbit = 9; }
        }
    }
#pragma unroll 1
    for (int bit = topbit; bit >= 0; --bit) {
        const unsigned cand = topbit == 15 ? (T | (1u << bit)) : (T + (1u << bit));
        if (cand > 0xffffu) continue;
        const int cnt = count_gt(cand - 1u);
        if (cnt >= 256) { T = cand; cge = cnt; }
    }
    auto build = [&](unsigned x, unsigned (&M)[4]) {
        const unsigned xw = x | (x << 16);
#pragma unroll
        for (int c = 0; c < 4; ++c) {
            M[c] = 0u;
            if (4 * c < niter) {
#pragma unroll
                for (int i = 4 * c; i < 4 * c + 4; ++i) {
                    unsigned byte = dot2acc(pk_gt(kr[i].x, xw, one), 0x00020001u, 0u);
                    byte = dot2acc(pk_gt(kr[i].y, xw, one), 0x00080004u, byte);
                    byte = dot2acc(pk_gt(kr[i].z, xw, one), 0x00200010u, byte);
                    byte = dot2acc(pk_gt(kr[i].w, xw, one), 0x00800040u, byte);
                    M[c] |= byte << (8 * (i & 3));
                }
            }
        }
    };
    unsigned M[4];
    build(T - 1u, M);
    if (cge != 256) {
        unsigned G[4]; build(T, G);
        unsigned E[4];
#pragma unroll
        for (int c = 0; c < 4; ++c) E[c] = M[c] & ~G[c];
        const int need = 256 - (cge - wave_sum((int)(__builtin_popcount(E[0]) + __builtin_popcount(E[1]) + __builtin_popcount(E[2]) + __builtin_popcount(E[3]))));
        auto below = [&](int B, int c) -> unsigned { const int nb = B - 32 * c; return nb <= 0 ? 0u : (nb >= 32 ? 0xffffffffu : ((1u << nb) - 1u)); };
        auto ties_below = [&](int B) -> int {
            return wave_sum((int)(__builtin_popcount(E[0] & below(B, 0)) + __builtin_popcount(E[1] & below(B, 1)) + __builtin_popcount(E[2] & below(B, 2)) + __builtin_popcount(E[3] & below(B, 3))));
        };
        int lo = 0, hi = 127;
#pragma unroll 1
        while (lo < hi) { const int mid = (lo + hi) >> 1; if (ties_below(mid + 1) >= need) hi = mid; else lo = mid + 1; }
        const int Bs = lo, r = need - ties_below(Bs);
        const unsigned ew = Bs < 32 ? E[0] : (Bs < 64 ? E[1] : (Bs < 96 ? E[2] : E[3]));
        const bool tb = ((ew >> (Bs & 31)) & 1u) != 0u;
        const unsigned long long em = __ballot(tb);
        const bool take_row = tb && __builtin_popcountll(em & ((1ull << lane) - 1ull)) < r;
#pragma unroll
        for (int c = 0; c < 4; ++c) {
            unsigned tk = E[c] & below(Bs, c);
            if ((Bs >> 5) == c && take_row) tk |= 1u << (Bs & 31);
            M[c] = G[c] | tk;
        }
    }
    const int kl = __builtin_popcount(M[0]) + __builtin_popcount(M[1]) + __builtin_popcount(M[2]) + __builtin_popcount(M[3]);
    int wp = wave_incl_scan(kl, lane) - kl;
#pragma unroll
    for (int c = 0; c < 4; ++c) {
        unsigned m = M[c];
        while (m) { const int b = __builtin_ctz(m); list[wp] = (u16)((32 * c + b) * 64 + lane); ++wp; m &= m - 1u; }
    }
}

DI void attend(const Args& a, size_t brow, int t, int cnt, LAS const u16* list, LAS unsigned char* img, int lane, int fr, int fq) {
    const u16* Q = (const u16*)(a.ws + WS_Q); const u16* KVN = (const u16*)(a.ws + WS_KVN); u16* YO = (u16*)(a.ws + WS_YO);
    bf16x8 qf[4];
    {
        const int head = fr & 7;
        const u16* qrow = Q + (brow + t) * 1024 + head * 128;
        float f[4][8]; float ss = 0.f;
#pragma unroll
        for (int ks = 0; ks < 4; ++ks) {
            const u32x4 raw = *(const u32x4*)(qrow + ks * 32 + 8 * fq);
            f[ks][0] = bflo(raw.x); f[ks][1] = bfhi(raw.x); f[ks][2] = bflo(raw.y); f[ks][3] = bfhi(raw.y); f[ks][4] = bflo(raw.z); f[ks][5] = bfhi(raw.z); f[ks][6] = bflo(raw.w); f[ks][7] = bfhi(raw.w);
#pragma unroll
            for (int j = 0; j < 8; ++j) ss += f[ks][j] * f[ks][j];
        }
        ss += __shfl_xor(ss, 16); ss += __shfl_xor(ss, 32);
        const float rq = __builtin_amdgcn_rsqf(ss * (1.0f / 128.0f) + EPS) * (0.08838834764831845f * 1.4426950408889634f);
#pragma unroll
        for (int ks = 0; ks < 4; ++ks) {
            const float* qg = a.in[I_QNG] + ks * 32 + 8 * fq;
            u32x4 w;
            w.x = pk2(f[ks][0] * rq * qg[0], f[ks][1] * rq * qg[1]); w.y = pk2(f[ks][2] * rq * qg[2], f[ks][3] * rq * qg[3]);
            w.z = pk2(f[ks][4] * rq * qg[4], f[ks][5] * rq * qg[5]); w.w = pk2(f[ks][6] * rq * qg[6], f[ks][7] * rq * qg[7]);
            qf[ks] = __builtin_bit_cast(bf16x8, w);
        }
    }
    const int nsteps = (cnt + 31) >> 5;
    f32x4 oacc[8];
#pragma unroll
    for (int i = 0; i < 8; ++i) oacc[i] = (f32x4){0.f, 0.f, 0.f, 0.f};
    float mrun = -3.0e38f, lpart = 0.f;
    const char* kvb = (const char*)(KVN + brow * 128);
    auto issue = [&](u32x4 (&pf)[8], int pp) {
#pragma unroll
        for (int it = 0; it < 8; ++it) { const int piece = it * 64 + lane; const unsigned key = list[pp * 32 + (piece >> 4)]; pf[it] = *(const u32x4*)(kvb + (key * 256u + 16u * (unsigned)(piece & 15))); }
    };
    auto step = [&](u32x4 (&pf)[8], int pp) {
#pragma unroll
        for (int it = 0; it < 8; ++it) { const int piece = it * 64 + lane; *(LAS u32x4*)(img + (piece >> 4) * 288 + (piece & 15) * 16) = pf[it]; }
        if (pp + 2 < nsteps) issue(pf, pp + 2);
        wave_lds_sync();
        __builtin_amdgcn_sched_barrier(0);
        f32x4 sa = {0.f, 0.f, 0.f, 0.f}, sb = {0.f, 0.f, 0.f, 0.f};
#pragma unroll
        for (int ks = 0; ks < 4; ++ks) {
            const bf16x8 a0 = *(LAS const bf16x8*)(img + fr * 288 + (ks * 32 + 8 * fq) * 2), a1 = *(LAS const bf16x8*)(img + (16 + fr) * 288 + (ks * 32 + 8 * fq) * 2);
            sa = __builtin_amdgcn_mfma_f32_16x16x32_bf16(a0, qf[ks], sa, 0, 0, 0); sb = __builtin_amdgcn_mfma_f32_16x16x32_bf16(a1, qf[ks], sb, 0, 0, 0);
            if (ks == 1) __builtin_amdgcn_sched_barrier(0);
        }
        if (pp * 32 + 32 > cnt) {
            const int pb0 = pp * 32 + 4 * fq;
#pragma unroll
            for (int r = 0; r < 4; ++r) { if (pb0 + r >= cnt) sa[r] = -3.0e38f; if (pb0 + 16 + r >= cnt) sb[r] = -3.0e38f; }
        }
        float mx = fmaxf(fmaxf(fmaxf(sa[0], sa[1]), fmaxf(sa[2], sa[3])), fmaxf(fmaxf(sb[0], sb[1]), fmaxf(sb[2], sb[3])));
        mx = fmaxf(mx, __shfl_xor(mx, 16)); mx = fmaxf(mx, __shfl_xor(mx, 32));
        if (__ballot(mx > mrun) != 0ull) {
            const float mnew = fmaxf(mrun, mx), alpha = __builtin_amdgcn_exp2f(mrun - mnew);
            mrun = mnew; lpart *= alpha;
#pragma unroll
            for (int cb = 0; cb < 8; ++cb) oacc[cb] *= alpha;
        }
        float ps = 0.f;
#pragma unroll
        for (int r = 0; r < 4; ++r) { sa[r] = __builtin_amdgcn_exp2f(sa[r] - mrun); sb[r] = __builtin_amdgcn_exp2f(sb[r] - mrun); ps += sa[r] + sb[r]; }
        lpart += ps;
        u32x4 pw; pw.x = pk2(sa[0], sa[1]); pw.y = pk2(sa[2], sa[3]); pw.z = pk2(sb[0], sb[1]); pw.w = pk2(sb[2], sb[3]);
        const bf16x8 pb = __builtin_bit_cast(bf16x8, pw);
#pragma unroll
        for (int cb = 0; cb < 8; ++cb) {
            const s16x4 r0 = __builtin_amdgcn_ds_read_tr16_b64_v4i16((LAS s16x4*)(img + (4 * fq + (fr >> 2)) * 288 + (cb * 16 + 4 * (fr & 3)) * 2));
            const s16x4 r1 = __builtin_amdgcn_ds_read_tr16_b64_v4i16((LAS s16x4*)(img + (16 + 4 * fq + (fr >> 2)) * 288 + (cb * 16 + 4 * (fr & 3)) * 2));
            const bf16x8 av = {r0[0], r0[1], r0[2], r0[3], r1[0], r1[1], r1[2], r1[3]};
            oacc[cb] = __builtin_amdgcn_mfma_f32_16x16x32_bf16(av, pb, oacc[cb], 0, 0, 0);
            if (cb == 3) __builtin_amdgcn_sched_barrier(0);
        }
        wave_lds_sync();
    };
    u32x4 pf0[8], pf1[8];
    issue(pf0, 0);
    if (nsteps > 1) issue(pf1, 1);
#pragma unroll 1
    for (int pp = 0; pp < nsteps; pp += 2) {
        step(pf0, pp);
        if (pp + 1 < nsteps) step(pf1, pp + 1);
    }
    float lsum = lpart; lsum += __shfl_xor(lsum, 16); lsum += __shfl_xor(lsum, 32);
    const float inv = __builtin_amdgcn_rcpf(lsum);
    if (fr < 8) {
        u16* orow = YO + (brow + t) * 1536 + 512 + fr * 128 + 4 * fq;
#pragma unroll
        for (int cb = 0; cb < 8; ++cb) { u32x2 w; w.x = pk2(oacc[cb][0] * inv, oacc[cb][1] * inv); w.y = pk2(oacc[cb][2] * inv, oacc[cb][3] * inv); *(u32x2*)(orow + cb * 16) = w; }
    }
}

constexpr int N_CVT_JOBS = 32 * 16 * 32 + 32 * 16 * 16;
DI void cvt_job(const Args& a, LAS float* t, int J, int lane) {
    if (J >= N_CVT_JOBS) return;
    const float* src; const float* sk; unsigned char* dst; int ld, k0, n0, row;
    if (J < 16384) {
        const int e = J >> 9, w = J & 511; src = a.in[I_WE1] + (size_t)e * 1024 * 2048; ld = 2048; k0 = (w >> 5) * 64; n0 = (w & 31) * 64; sk = a.in[I_N2G]; dst = a.ws + WS_WE1 + (size_t)e * 2048 * 1024;
        const int n = n0 + lane, hi = n >= 1024 ? 1 : 0, q = n - hi * 1024; row = (q >> 7) * 256 + hi * 128 + (q & 127);
    } else {
        const int j = J - 16384, e = j >> 8, w = j & 255; src = a.in[I_WE2] + (size_t)e * 1024 * 1024; ld = 1024; k0 = (w >> 4) * 64; n0 = (w & 15) * 64; sk = nullptr; dst = a.ws + WS_WE2 + (size_t)e * 1024 * 1024;
        row = n0 + lane;
    }
    const int kl = lane >> 4, n4 = 4 * (lane & 15);
    f32x4 v[4][4];
#pragma unroll
    for (int ks = 0; ks < 4; ++ks)
#pragma unroll
        for (int i = 0; i < 4; ++i) v[ks][i] = __builtin_nontemporal_load((const f32x4*)(src + (size_t)(k0 + ks * 16 + kl + 4 * i) * ld + n0 + n4));
    unsigned char* drow = dst + (size_t)row * 1024 + k0;
#pragma unroll
    for (int ks = 0; ks < 4; ++ks) {
#pragma unroll
        for (int i = 0; i < 4; ++i) { const float sc = (sk ? sk[k0 + ks * 16 + kl + 4 * i] : 1.0f) * 64.0f; *(LAS f32x4*)(t + (kl + 4 * i) * 64 + n4) = v[ks][i] * sc; }
        wave_lds_sync();
        float c[16];
#pragma unroll
        for (int k = 0; k < 16; ++k) c[k] = t[k * 64 + lane];
        u32x4 w; w.x = pk4_fp8(c[0], c[1], c[2], c[3]); w.y = pk4_fp8(c[4], c[5], c[6], c[7]); w.z = pk4_fp8(c[8], c[9], c[10], c[11]); w.w = pk4_fp8(c[12], c[13], c[14], c[15]);
        *(u32x4*)(drow + ks * 16) = w;
        wave_lds_sync();
    }
}

DI void dsa_phase(const Args& a, LAS unsigned char* lds) {
    unsigned char* ws = a.ws;
    const int wid = __builtin_amdgcn_readfirstlane(otid() >> 6);
    LAS u16* rows = (LAS u16*)(lds + P3_ROWS);
    bool bprev = false; size_t pbrow = 0; int pt0 = 0, bbuf = 0;
    for (int gi = blockIdx.x; gi < T / 8; gi += gridDim.x) {
        const int lane = otid() & 63, fr = lane & 15, fq = lane >> 4;
        const int b = gi & 3, t0 = S - 8 - 8 * (gi >> 2);
        const size_t brow = (size_t)b * S;
        const int ntile = (t0 + 8 + 15) >> 4;
        __syncthreads();
        {
            const unsigned char* QI = (const unsigned char*)(ws + WS_QI); const unsigned char* KIN = (const unsigned char*)(ws + WS_KIN); const float* WI = (const float*)(ws + WS_WI);
            typedef int i32x4_t __attribute__((ext_vector_type(4)));
            i32x4_t qa[2]; f32x4 wi[2];
#pragma unroll
            for (int rg = 0; rg < 2; ++rg) {
                qa[rg] = *(const i32x4_t*)(QI + (brow + t0 + 4 * rg + (fr >> 2)) * 256 + (fr & 3) * 64 + 16 * fq);
                wi[rg] = *(const f32x4*)(WI + (brow + t0 + 4 * rg + fq) * 4);
            }
            auto ldk = [&](i32x4_t (&kf)[4], int jt0) {
#pragma unroll
                for (int u = 0; u < 4; ++u) {
                    const int jt = (jt0 + 8 * u) < ntile ? (jt0 + 8 * u) : (ntile - 1);
                    kf[u] = *(const i32x4_t*)(KIN + (brow + jt * 16 + fr) * 64 + 16 * fq);
                }
            };
            auto cmpk = [&](const i32x4_t (&kf)[4], int jt0) {
#pragma unroll
                for (int u = 0; u < 4; ++u) {
                    const int jt = jt0 + 8 * u;
                    if (jt < ntile) {
#pragma unroll
                        for (int rg = 0; rg < 2; ++rg) {
                            i32x4_t d = {0, 0, 0, 0};
                            d = __builtin_amdgcn_mfma_i32_16x16x64_i8(qa[rg], kf[u], d, 0, 0, 0);
                            const float sc = (((float)max(d[0], 0) * wi[rg][0] + (float)max(d[1], 0) * wi[rg][1]) + (float)max(d[2], 0) * wi[rg][2]) + (float)max(d[3], 0) * wi[rg][3];
                            rows[(4 * rg + fq) * 8192 + rowaddr(jt * 16 + fr)] = (u16)(f2key(sc) >> 16);
                        }
                    }
                }
            };
            i32x4_t kA[4], kB[4];
            if (wid < ntile) ldk(kA, wid);
            for (int jt0 = wid; jt0 < ntile; jt0 += 64) {
                const bool hasB = jt0 + 32 < ntile;
                if (hasB) ldk(kB, jt0 + 32);
                cmpk(kA, jt0);
                if (hasB) { if (jt0 + 64 < ntile) ldk(kA, jt0 + 64); cmpk(kB, jt0 + 32); }
            }
        }
        __syncthreads();
        if (wid < 4) {
            u32x4 kr[16];
            const int N0 = t0 + wid + 1, N1 = N0 + 4;
            if (N0 > 256) keys_load(rows + wid * 8192, N0, lane, kr);
            __syncthreads();
            LAS u16* l0 = (LAS u16*)(lds + (bbuf ? P3_HIST : P3_LIST) + wid * 512);
            LAS u16* l1 = l0 + 4 * 256;
            if (N0 > 256) keys_select(kr, l0, N0, lane); else { for (int p = lane; p < 256; p += 64) l0[p] = p < N0 ? (u16)p : (u16)0; }
            if (N1 > 256) { keys_load(rows + (wid + 4) * 8192, N1, lane, kr); keys_select(kr, l1, N1, lane); } else { for (int p = lane; p < 256; p += 64) l1[p] = p < N1 ? (u16)p : (u16)0; }
            {
                const int G3 = gridDim.x, c3 = blockIdx.x, it3 = (gi - c3) / G3, ntrip = (T / 8 - c3 + G3 - 1) / G3, jtot = (N_CVT_JOBS + 4 * G3 - 1) / (4 * G3);
                const int jlo = (jtot * it3 + ntrip - 1) / ntrip, jhi = (jtot * (it3 + 1) + ntrip - 1) / ntrip;
                LAS float* tcv = (LAS float*)(lds + (wid < 3 ? 135168 + wid * 4096 : 151552));
#pragma unroll 1
                for (int j = jlo; j < jhi; ++j) cvt_job(a, tcv, (j * 4 + wid) * G3 + c3, lane);
            }
        } else {
            __syncthreads();
            if (bprev) {
                LAS const u16* lp = (LAS const u16*)(lds + (bbuf ? P3_LIST : P3_HIST));
                LAS unsigned char* img = (LAS unsigned char*)(rows + (wid - 4) * 8192);
                { const int q = wid - 4, t = pt0 + q; attend(a, pbrow, t, t + 1 < 256 ? t + 1 : 256, lp + q * 256, img, lane, fr, fq); }
                { const int q = wid, t = pt0 + q; attend(a, pbrow, t, t + 1 < 256 ? t + 1 : 256, lp + q * 256, img, lane, fr, fq); }
            }
        }
        bprev = true; pbrow = brow; pt0 = t0; bbuf ^= 1;
    }
    __syncthreads();
    if (bprev) {
        const int lane = otid() & 63, fr = lane & 15, fq = lane >> 4;
        LAS const u16* lp = (LAS const u16*)(lds + (bbuf ? P3_LIST : P3_HIST));
        const int q = wid, t = pt0 + q;
        attend(a, pbrow, t, t + 1 < 256 ? t + 1 : 256, lp + q * 256, (LAS unsigned char*)(rows + wid * 8192), lane, fr, fq);
    }
}

constexpr int P6_LCNT = 0, P6_BASE = 128, P6_RSB = 256, P6_RI = 1024;
DI unsigned dpp_max_u32(unsigned v) {
    v = max(v, (unsigned)__builtin_amdgcn_update_dpp(0, (int)v, 0xB1, 0xf, 0xf, false));
    v = max(v, (unsigned)__builtin_amdgcn_update_dpp(0, (int)v, 0x4E, 0xf, 0xf, false));
    v = max(v, (unsigned)__builtin_amdgcn_update_dpp(0, (int)v, 0x141, 0xf, 0xf, false));
    v = max(v, (unsigned)__builtin_amdgcn_update_dpp(0, (int)v, 0x140, 0xf, 0xf, false));
    return v;
}
DI float key2f(unsigned k) { return __uint_as_float((k & 0x80000000u) ? (k & 0x7fffffffu) : ~k); }
DI void router_phase(const Args& a, LAS unsigned char* lds) {
    unsigned char* ws = a.ws;
    const int tid = otid(), wid = tid >> 6, lane = tid & 63, fr = lane & 15, fq = lane >> 4;
    LAS int* lcnt = (LAS int*)(lds + P6_LCNT); LAS int* lbase = (LAS int*)(lds + P6_BASE); LAS float* rsb = (LAS float*)(lds + P6_RSB); LAS int* RI = (LAS int*)(lds + P6_RI);
    const u16* WRH = (const u16*)(ws + WS_WR);
    unsigned* CNT = (unsigned*)(ws + WS_CTL);
    LAS unsigned char* WL = lds + 16384;
    __syncthreads();
    for (int i = tid; i < 64 * 128; i += NT) { const int r = i >> 7, p = i & 127; *(LAS u32x4*)(WL + r * 2064 + p * 16) = *(const u32x4*)(WRH + (size_t)r * 1024 + p * 8); }
    for (int rg = blockIdx.x; rg < T / 128; rg += gridDim.x) {
        __syncthreads();
        if (tid < 32) lcnt[tid] = 0;
        __syncthreads();
        {
            const int row = rg * 128 + wid * 16 + fr;
            const float* xr = a.out + (size_t)row * 1024 + 8 * fq;
            f32x4 acc[2] = {{0.f, 0.f, 0.f, 0.f}, {0.f, 0.f, 0.f, 0.f}};
            float ss = 0.f;
#pragma unroll 4
            for (int ks = 0; ks < 32; ++ks) {
                const f32x4 x0 = *(const f32x4*)(xr + ks * 32), x1 = *(const f32x4*)(xr + ks * 32 + 4);
                ss += ((x0[0] * x0[0] + x0[1] * x0[1]) + (x0[2] * x0[2] + x0[3] * x0[3])) + ((x1[0] * x1[0] + x1[1] * x1[1]) + (x1[2] * x1[2] + x1[3] * x1[3]));
                u32x4 hw; hw.x = pk2(x0[0], x0[1]); hw.y = pk2(x0[2], x0[3]); hw.z = pk2(x1[0], x1[1]); hw.w = pk2(x1[2], x1[3]);
                u32x4 lw; lw.x = pk2(x0[0] - bflo(hw.x), x0[1] - bfhi(hw.x)); lw.y = pk2(x0[2] - bflo(hw.y), x0[3] - bfhi(hw.y)); lw.z = pk2(x1[0] - bflo(hw.z), x1[1] - bfhi(hw.z)); lw.w = pk2(x1[2] - bflo(hw.w), x1[3] - bfhi(hw.w));
                const bf16x8 xh = __builtin_bit_cast(bf16x8, hw), xl = __builtin_bit_cast(bf16x8, lw);
#pragma unroll
                for (int nt = 0; nt < 2; ++nt) {
                    const bf16x8 wh = *(LAS const bf16x8*)(WL + (nt * 16 + fr) * 2064 + (ks * 32 + 8 * fq) * 2), wl = *(LAS const bf16x8*)(WL + (32 + nt * 16 + fr) * 2064 + (ks * 32 + 8 * fq) * 2);
                    acc[nt] = __builtin_amdgcn_mfma_f32_16x16x32_bf16(xh, wh, acc[nt], 0, 0, 0);
                    acc[nt] = __builtin_amdgcn_mfma_f32_16x16x32_bf16(xl, wh, acc[nt], 0, 0, 0);
                    acc[nt] = __builtin_amdgcn_mfma_f32_16x16x32_bf16(xh, wl, acc[nt], 0, 0, 0);
                }
            }
            ss += __shfl_xor(ss, 16); ss += __shfl_xor(ss, 32);
            const float rsrow = __builtin_amdgcn_rsqf(ss * (1.0f / 1024.0f) + EPS);
            if (fq == 0) rsb[wid * 16 + fr] = rsrow;
            {
                unsigned char* xn = ws + WS_XN2 + (size_t)row * 1024 + 8 * fq;
#pragma unroll 4
                for (int ks = 0; ks < 32; ++ks) {
                    const f32x4 x0 = *(const f32x4*)(xr + ks * 32), x1 = *(const f32x4*)(xr + ks * 32 + 4);
                    u32x2 w; w.x = pk4_fp8(x0[0] * rsrow, x0[1] * rsrow, x0[2] * rsrow, x0[3] * rsrow); w.y = pk4_fp8(x1[0] * rsrow, x1[1] * rsrow, x1[2] * rsrow, x1[3] * rsrow);
                    *(u32x2*)(xn + ks * 32) = w;
                }
            }
            wave_lds_sync();
            const float b0 = a.in[I_BR][fr], b1 = a.in[I_BR][16 + fr];
#pragma unroll
            for (int r = 0; r < 4; ++r) {
                const float rs = rsb[wid * 16 + 4 * fq + r];
                unsigned k0 = (f2key(acc[0][r] * rs + b0) & ~31u) | (unsigned)(31 - fr), k1 = (f2key(acc[1][r] * rs + b1) & ~31u) | (unsigned)(15 - fr);
                unsigned sel[4];
#pragma unroll
                for (int k = 0; k < 4; ++k) {
                    const unsigned best = dpp_max_u32(k0 > k1 ? k0 : k1);
                    sel[k] = best;
                    if (k0 == best) k0 = 0u;
                    if (k1 == best) k1 = 0u;
                }
                const float v0 = key2f(sel[0] & ~31u), e1 = __expf(key2f(sel[1] & ~31u) - v0), e2 = __expf(key2f(sel[2] & ~31u) - v0), e3 = __expf(key2f(sel[3] & ~31u) - v0);
                const float inv = 1.0f / (1.0f + e1 + e2 + e3);
                if (fr < 4) {
                    const unsigned sk = fr == 0 ? sel[0] : (fr == 1 ? sel[1] : (fr == 2 ? sel[2] : sel[3]));
                    const int e = 31 - (int)(sk & 31u);
                    const float gt = (fr == 0 ? 1.0f : (fr == 1 ? e1 : (fr == 2 ? e2 : e3))) * inv;
                    const int ls = __hip_atomic_fetch_add(lcnt + e, 1, __ATOMIC_RELAXED, __HIP_MEMORY_SCOPE_WORKGROUP);
                    const int ri = ((wid * 16 + 4 * fq + r) * 4 + fr) * 4;
                    RI[ri + 0] = e; RI[ri + 1] = ls; RI[ri + 2] = __float_as_int(gt);
                }
            }
        }
        __syncthreads();
        if (tid < 32) lbase[tid] = (int)__hip_atomic_fetch_add(CNT + tid, (unsigned)lcnt[tid], __ATOMIC_RELAXED, __HIP_MEMORY_SCOPE_AGENT);
        __syncthreads();
        {
            const int rl = tid >> 2, k = tid & 3, row = rg * 128 + rl;
            const int e = RI[tid * 4 + 0], slot = lbase[e] + RI[tid * 4 + 1];
            ((int*)(ws + WS_LTOK))[(size_t)e * ECAP + slot] = row;
            ((float*)(ws + WS_LRS))[(size_t)row * 4 + k] = __int_as_float(RI[tid * 4 + 2]);
            ((unsigned*)(ws + WS_ROUTE))[(size_t)row * 4 + k] = ((unsigned)e << 16) | (unsigned)slot;
        }
    }
}

DI void combine_phase(const Args& a, LAS unsigned char* lds) {
    unsigned char* ws = a.ws;
    LAS const int* tab = (LAS const int*)(lds + MOE_TAB);
    const int tid = otid(), wid = tid >> 6, lane = tid & 63;
    const u16* YB = (const u16*)(ws + WS_YB); const unsigned* ROUTE = (const unsigned*)(ws + WS_ROUTE);
    for (int row = blockIdx.x * 8 + wid; row < T; row += gridDim.x * 8) {
        size_t pos[4];
#pragma unroll
        for (int k = 0; k < 4; ++k) { const unsigned r = ROUTE[(size_t)row * 4 + k]; const int e = (int)(r >> 16), slot = (int)(r & 0xffffu); pos[k] = (size_t)tab[e] * 256 + slot; }
        float* orow = a.out + (size_t)row * 1024;
        const f32x4 gt = *(const f32x4*)((const float*)(ws + WS_LRS) + (size_t)row * 4);
#pragma unroll
        for (int i = 0; i < 4; ++i) {
            f32x4 v = *(const f32x4*)(orow + i * 256 + lane * 4);
#pragma unroll
            for (int k = 0; k < 4; ++k) { const u32x2 y = __builtin_nontemporal_load((const u32x2*)(YB + pos[k] * 1024 + i * 256 + lane * 4)); v[0] += gt[k] * bflo(y.x); v[1] += gt[k] * bfhi(y.x); v[2] += gt[k] * bflo(y.y); v[3] += gt[k] * bfhi(y.y); }
            *(f32x4*)(orow + i * 256 + lane * 4) = v;
        }
    }
}

#define XB_TMO      128
#define XB_XCNT(j)  (256  + 64 * (j))
#define XB_XSUB(j)  (1280 + 64 * (j))
#define XB_XGEN(j)  (2304 + 64 * (j))
#define XB_TOP      3328
#define XB_TOPGEN   3392
#define XCD_BAR_WORDS 3456
#define XB_SPIN_CAP (1u << 18)

__device__ __forceinline__ unsigned xb_ld(unsigned* p)              { return __hip_atomic_load(p, __ATOMIC_RELAXED, __HIP_MEMORY_SCOPE_AGENT); }
__device__ __forceinline__ unsigned xb_add(unsigned* p, unsigned v) { return __hip_atomic_fetch_add(p, v, __ATOMIC_RELAXED, __HIP_MEMORY_SCOPE_AGENT); }
__device__ __forceinline__ unsigned xb_xcc_id() { return (unsigned)__builtin_amdgcn_s_getreg((3 << 11) | 20) & 0xFu; }
#define XB_SPIN(cond, bar) do { unsigned _sp = 0; while (cond) { __builtin_amdgcn_s_sleep(1); \
    if ((++_sp & 255u) == 0u) { if (xb_ld(&(bar)[XB_TMO])) break; if (_sp > XB_SPIN_CAP) { atomicAdd(&(bar)[XB_TMO], 1u); break; } } } } while (0)

struct XcdBarrier {
    unsigned* bar; unsigned x;
    volatile LAS unsigned* st;
};

__device__ __forceinline__ XcdBarrier xcd_barrier_post(unsigned* bar, volatile LAS unsigned* st) {
    XcdBarrier b; b.bar = bar; b.x = xb_xcc_id(); b.st = st;
    if (threadIdx.x == 0) (void)xb_add(&bar[XB_XCNT(b.x)], 1u);
    return b;
}
__device__ __forceinline__ void xcd_barrier_complete(unsigned* bar, unsigned x, unsigned& nloc, unsigned& nx) {
    const unsigned G = gridDim.x * gridDim.y * gridDim.z;
    unsigned sum, cnt, mine, sp = 0u;
    for (;;) {
        sum = 0u; cnt = 0u; mine = 0u;
#pragma unroll
        for (unsigned j = 0; j < 16; ++j) { const unsigned c = xb_ld(&bar[XB_XCNT(j)]); sum += c; cnt += (c > 0u) ? 1u : 0u; mine = (j == x) ? c : mine; }
        if (sum == G) break;
        __builtin_amdgcn_s_sleep(1);
        if ((++sp & 255u) == 0u) { if (xb_ld(&bar[XB_TMO])) break; if (sp > XB_SPIN_CAP) { atomicAdd(&bar[XB_TMO], 1u); break; } }
    }
    nloc = mine > 0u ? mine : 1u; nx = cnt > 0u ? cnt : 1u;
}

__device__ __forceinline__ void xcd_barrier(const XcdBarrier& b) {
    asm volatile("s_waitcnt vmcnt(0)" ::: "memory");
    __syncthreads();
    if (threadIdx.x == 0) {
        unsigned* bar = b.bar;
        __builtin_amdgcn_s_waitcnt(0);
        unsigned nloc = b.st[0], nx = b.st[1];
        if (nloc == 0u) { xcd_barrier_complete(bar, b.x, nloc, nx); b.st[0] = nloc; b.st[1] = nx; }
        const unsigned old = xb_add(&bar[XB_XSUB(b.x)], 1u);
        const unsigned gen = old / nloc;
        if (old + 1u == (gen + 1u) * nloc) {
            __builtin_amdgcn_fence(__ATOMIC_RELEASE, "agent");
            asm volatile("s_waitcnt vmcnt(0)" ::: "memory");
            const unsigned og = xb_add(&bar[XB_TOP], 1u);
            const unsigned tg = og / nx;
            if (og + 1u == (tg + 1u) * nx) xb_add(&bar[XB_TOPGEN], 1u);
            else XB_SPIN(xb_ld(&bar[XB_TOPGEN]) == tg, bar);
            __builtin_amdgcn_fence(__ATOMIC_ACQUIRE, "agent");
            xb_add(&bar[XB_XGEN(b.x)], 1u);
            asm volatile("s_waitcnt vmcnt(0)" ::: "memory");
        } else {
            XB_SPIN(xb_ld(&bar[XB_XGEN(b.x)]) == gen, bar);
            __builtin_amdgcn_fence(__ATOMIC_ACQUIRE, "agent");
            asm volatile("s_waitcnt vmcnt(0)" ::: "memory");
        }
    }
    __syncthreads();
}

__global__ void __launch_bounds__(NT, 2) fwd(Args a) {
    extern __shared__ __attribute__((aligned(16))) unsigned char lds_raw[];
    LAS unsigned char* lds = (LAS unsigned char*)lds_raw;
    cg::grid_group grid = cg::this_grid();
    unsigned char* ws = a.ws;
    const int G = gridDim.x, c = blockIdx.x;
    if (threadIdx.x < 2) ((volatile LAS unsigned*)(lds + LDS_BARST))[threadIdx.x] = 0u;
    __syncthreads();
    const XcdBarrier xbar = xcd_barrier_post((unsigned*)(ws + WS_BAR), (volatile LAS unsigned*)(lds + LDS_BARST));

    phase0(a, lds);
    xcd_barrier(xbar);
    {
        g8::PlainSched s; s.Abase = (const char*)(ws + WS_XB); s.Bbase = (const char*)(ws + WS_WIN); s.lda = 1024; s.ldb = 1024; s.K = 1024; s.nM = T / 256; s.nN = NIN / 256; s.G = G; s.c = c;
        EpiIn e; e.H = (u16*)(ws + WS_H); e.rs1 = (const float*)(ws + WS_RS1); e.SSQ = (float*)(ws + WS_SSQ); e.WI = (float*)(ws + WS_WI);
        g8::gemm_phase(lds, s, e);
    }
    xcd_barrier(xbar);
    {
        g8::PlainSched s; s.Abase = (const char*)(ws + WS_H) + 1024 * 2; s.Bbase = (const char*)(ws + WS_WQ); s.lda = NIN; s.ldb = 256; s.K = 256; s.nM = T / 256; s.nN = 5; s.G = G; s.c = c;
        EpiQ e; e.Q = (u16*)(ws + WS_Q); e.QI = (u16*)(ws + WS_QI); e.SSQ = (const float*)(ws + WS_SSQ);
        g8::gemm_phase(lds, s, e);
        for (int u = c; u < 1024; u += G) gmlp_unit(a, lds, u);
        kvnorm(a);
    }
    xcd_barrier(xbar);
    dsa_phase(a, lds);
    xcd_barrier(xbar);
    {
        g8::PlainSched s; s.Abase = (const char*)(ws + WS_YO); s.Bbase = (const char*)(ws + WS_WCAT); s.lda = 1536; s.ldb = 1536; s.K = 512; s.nM = T / 256; s.nN = 4; s.G = G; s.c = c;
        EpiMrg<0> e0; e0.OUT = (u16*)(ws + WS_TMP); e0.TMP = nullptr; e0.H = (const u16*)(ws + WS_H);
        g8::gemm_phase(lds, s, e0);
        s.Abase = (const char*)(ws + WS_YO) + 512 * 2; s.Bbase = (const char*)(ws + WS_WCAT) + 512 * 2; s.K = 1024;
        EpiMrg<1> e1; e1.OUT = (u16*)(ws + WS_MRG); e1.TMP = (const u16*)(ws + WS_TMP); e1.H = (const u16*)(ws + WS_H);
        g8::gemm_phase(lds, s, e1);
    }
    xcd_barrier(xbar);
    {
        g8::PlainSched s; s.Abase = (const char*)(ws + WS_MRG); s.Bbase = (const char*)(ws + WS_WOUT); s.lda = 1024; s.ldb = 1024; s.K = 1024; s.nM = T / 256; s.nN = 4; s.G = G; s.c = c;
        EpiOut e; e.out = a.out; e.x = a.in[I_X];
        g8::gemm_phase(lds, s, e);
    }
    xcd_barrier(xbar);
    router_phase(a, lds);
    xcd_barrier(xbar);
    moe_table(lds, (const unsigned*)(ws + WS_CTL));
    {
        MoeSched<8, true> s; s.Abase = (const char*)(ws + WS_XN2); s.Wbase = (const char*)(ws + WS_WE1); s.LTOK = (const int*)(ws + WS_LTOK); s.tab = (LAS const int*)(lds + MOE_TAB);
        s.lda = 1024; s.ldb = 1024; s.K = 1024; s.G = G; s.c = c; s.wstride = (size_t)2048 * 1024;
        EpiMoe1 e; e.ACT = (unsigned char*)(ws + WS_ACT); e.b1 = a.in[I_BE1];
        g8::gemm_phase<true>(lds, s, e);
    }
    xcd_barrier(xbar);
    {
        MoeSched<4, false> s; s.Abase = (const char*)(ws + WS_ACT); s.Wbase = (const char*)(ws + WS_WE2); s.LTOK = nullptr; s.tab = (LAS const int*)(lds + MOE_TAB);
        s.lda = 1024; s.ldb = 1024; s.K = 1024; s.G = G; s.c = c; s.wstride = (size_t)1024 * 1024;
        EpiMoe2 e; e.YB = (u16*)(ws + WS_YB); e.b2 = a.in[I_BE2];
        g8::gemm_phase<true>(lds, s, e);
    }
    xcd_barrier(xbar);
    combine_phase(a, lds);
    if (a.mask == 0u) grid.sync();
}

extern "C" void kernel_launch(void* const* d_in, const int* in_sizes, int n_in, void* d_out, int out_size, void* d_ws, size_t ws_size, hipStream_t stream) {
    static int grid = 0;
    if (grid == 0) {
        int dev = 0, cus = 0, per_cu = 0;
        if (n_in != 23 || out_size != T * Dm || ws_size < WS_END) { fprintf(stderr, "kernel_launch: unexpected problem (n_in %d, out %d, ws %zu < %zu)\n", n_in, out_size, ws_size, (size_t)WS_END); grid = -1; return; }
        if (hipGetDevice(&dev) != hipSuccess || hipDeviceGetAttribute(&cus, hipDeviceAttributeMultiprocessorCount, dev) != hipSuccess) { grid = -1; return; }
        if (hipFuncSetAttribute((const void*)fwd, hipFuncAttributeMaxDynamicSharedMemorySize, LDS_BYTES) != hipSuccess) { fprintf(stderr, "hipFuncSetAttribute failed\n"); grid = -1; return; }
        if (hipOccupancyMaxActiveBlocksPerMultiprocessor(&per_cu, (const void*)fwd, NT, LDS_BYTES) != hipSuccess || per_cu < 1) { fprintf(stderr, "occupancy query failed (%d)\n", per_cu); grid = -1; return; }
        grid = cus;
        fprintf(stderr, "kernel_launch: cus %d per_cu %d grid %d ws %zu need %zu\n", cus, per_cu, grid, ws_size, (size_t)WS_END);
    }
    if (grid < 0) return;
    Args a{};
    for (int i = 0; i < 23; ++i) a.in[i] = (const float*)d_in[i];
    a.out = (float*)d_out; a.ws = (unsigned char*)d_ws; a.mask = 0xffffffffu; a.pad = 0u;
    if (hipMemsetAsync((char*)d_ws + WS_CTL, 0, 65536, stream) != hipSuccess) { fprintf(stderr, "memset failed\n"); return; }
    void* args[] = {&a};
    hipError_t e = hipLaunchCooperativeKernel((const void*)fwd, dim3(grid), dim3(NT), args, LDS_BYTES, stream);
    if (e != hipSuccess) fprintf(stderr, "cooperative launch failed: %s (grid %d)\n", hipGetErrorString(e), grid);
}
```

```cpp
#include <hip/hip_runtime.h>
#include <hip/hip_cooperative_groups.h>
#include <cstdio>
#include <cstdint>
namespace cg = cooperative_groups;

#define LAS __attribute__((address_space(3)))
#define DI __device__ __forceinline__
typedef unsigned short u16;
typedef short bf16x8 __attribute__((ext_vector_type(8)));
typedef short s16x4 __attribute__((ext_vector_type(4)));
typedef float f32x4 __attribute__((ext_vector_type(4)));
typedef float f32x2 __attribute__((ext_vector_type(2)));
typedef unsigned u32x4 __attribute__((ext_vector_type(4)));
typedef unsigned u32x2 __attribute__((ext_vector_type(2)));
typedef __bf16 bf2_t __attribute__((ext_vector_type(2)));
typedef int v8i_t __attribute__((ext_vector_type(8)));

constexpr int NT = 512;
constexpr int LDS_BYTES = 159744;
constexpr int Dm = 1024, Bsz = 4, S = 8192, T = Bsz * S;
constexpr int NIN = 3584;
constexpr int NE = 32, ECAP = 32768, PPAD = 131072 + NE * 256;
constexpr float EPS = 1e-6f;

constexpr size_t MiB = 1024 * 1024;
constexpr size_t WS_CTL = 0;
constexpr size_t WS_BAR = 16384;
constexpr int LDS_BARST = LDS_BYTES - 16;
constexpr size_t WS_WIN = 64 * 1024;
constexpr size_t WS_WQ = WS_WIN + (size_t)NIN * 1024 * 2;
constexpr size_t WS_WSP = WS_WQ + 1280 * 256 * 2;
constexpr size_t WS_WCAT = WS_WSP + 4 * 128 * 128 * 2;
constexpr size_t WS_WOUT = WS_WCAT + 1024 * 1536 * 2;
constexpr size_t WS_WR = WS_WOUT + 1024 * 1024 * 2;
constexpr size_t WS_WE1 = WS_WR + 32 * 1024 * 4;
constexpr size_t WS_WE2 = WS_WE1 + (size_t)32 * 2048 * 1024 * 2;
constexpr size_t WS_RS1 = WS_WE2 + (size_t)32 * 1024 * 1024 * 2;
constexpr size_t WS_SSQ = WS_RS1 + (size_t)T * 4;
constexpr size_t WS_WI = WS_SSQ + (size_t)T * 32 * 4;
constexpr size_t WS_ROUTE = WS_WI + (size_t)T * 4 * 4;
constexpr size_t WS_LTOK = WS_ROUTE + (size_t)T * 4 * 4;
constexpr size_t WS_LGATE = WS_LTOK + (size_t)NE * ECAP * 4;
constexpr size_t WS_LRS = WS_LGATE + (size_t)NE * ECAP * 4;
constexpr size_t WS_XN2 = WS_LRS + (size_t)NE * ECAP * 4;
constexpr size_t WS_R0 = WS_XN2 + (size_t)T * 1024 * 2;
constexpr size_t WS_XB = WS_R0;
constexpr size_t WS_H = WS_XB + (size_t)T * 1024 * 2;
constexpr size_t WS_Q = WS_H + (size_t)T * NIN * 2;
constexpr size_t WS_QI = WS_Q + (size_t)T * 1024 * 2;
constexpr size_t WS_KVN = WS_QI + (size_t)T * 256 * 2;
constexpr size_t WS_KIN = WS_KVN + (size_t)T * 128 * 2;
constexpr size_t WS_YO = WS_KIN + (size_t)T * 64 * 2;
constexpr size_t WS_TMP = WS_YO + (size_t)T * 1536 * 2;
constexpr size_t WS_MRG = WS_TMP + (size_t)T * 1024 * 2;
constexpr size_t WS_R0END = WS_MRG + (size_t)T * 1024 * 2;
constexpr size_t WS_ACT = WS_XB;
constexpr size_t WS_YB = WS_Q;
static_assert(WS_ACT + (size_t)PPAD * 1024 * 2 <= WS_Q, "ACT overlaps YB");
static_assert(WS_YB + (size_t)PPAD * 1024 * 2 <= WS_R0END, "YB too large");
constexpr size_t WS_END = WS_R0END;

struct Args { const float* in[23]; float* out; unsigned char* ws; unsigned mask; unsigned pad; };
enum { I_X = 0, I_N1G, I_WIN, I_QLG, I_WUQ, I_QNG, I_KVG, I_WUV, I_WQI, I_KIG, I_VG, I_WSP, I_BSP, I_WPA, I_WPB, I_WOUT, I_N2G, I_WR, I_BR, I_WE1, I_BE1, I_WE2, I_BE2 };

DI unsigned pk2(float a, float b) { f32x2 v = {a, b}; bf2_t r = __builtin_convertvector(v, bf2_t); return __builtin_bit_cast(unsigned, r); }
DI unsigned pk4_fp8(float a, float b, float c, float d) { unsigned w = 0u; w = (unsigned)__builtin_amdgcn_cvt_pk_fp8_f32(a, b, (int)w, false); w = (unsigned)__builtin_amdgcn_cvt_pk_fp8_f32(c, d, (int)w, true); return w; }
DI unsigned pk4_i8(float a, float b, float c, float d) {
    const int ia = (int)__builtin_rintf(fminf(fmaxf(a * 32.0f, -127.0f), 127.0f)), ib = (int)__builtin_rintf(fminf(fmaxf(b * 32.0f, -127.0f), 127.0f));
    const int ic = (int)__builtin_rintf(fminf(fmaxf(c * 32.0f, -127.0f), 127.0f)), id = (int)__builtin_rintf(fminf(fmaxf(d * 32.0f, -127.0f), 127.0f));
    return (unsigned)(ia & 0xff) | ((unsigned)(ib & 0xff) << 8) | ((unsigned)(ic & 0xff) << 16) | ((unsigned)(id & 0xff) << 24);
}
DI float bflo(unsigned u) { return __uint_as_float(u << 16); }
DI float bfhi(unsigned u) { return __uint_as_float(u & 0xffff0000u); }
DI u16 f2bf(float f) { return (u16)(pk2(f, 0.f) & 0xffffu); }
DI float bf2f(u16 h) { return __uint_as_float(((unsigned)h) << 16); }
DI float sigmoidf_(float x) { return __builtin_amdgcn_rcpf(1.0f + __expf(-x)); }
DI float gelu_tanh(float x) { const float u = 1.5957691216057308f * (x + 0.044715f * x * x * x); return x * sigmoidf_(u); }
DI float fast_sigmoid(float x) { return __builtin_amdgcn_rcpf(1.0f + __builtin_amdgcn_exp2f(x * -1.4426950408889634f)); }
DI float fast_gelu(float x) { const float p = __builtin_fmaf(x * x, -0.10294324f, -2.3022082f); return x * __builtin_amdgcn_rcpf(1.0f + __builtin_amdgcn_exp2f(x * p)); }
DI int otid() { int t = threadIdx.x; asm volatile("" : "+v"(t)); return t; }
DI void wave_lds_sync() { asm volatile("s_waitcnt lgkmcnt(0)" ::: "memory"); }

namespace g8 {
constexpr int BM = 256, BK = 64, HALF = 128, HTB = HALF * BK * 2, STAGE_BYTES = 8 * HTB, NXCD = 8, WGM = 8;
DI int lds_byte(int r, int c) { const int st = (r >> 4) * 2 + (c >> 5), rr = r & 15, cc = c & 31, ob = rr * 64 + cc * 2; return st * 1024 + (ob ^ (((ob >> 9) & 1) << 5)); }
DI int perm32(int rho) { const int n = rho >> 4, i = rho & 15; return 8 * (i >> 2) + 4 * n + (i & 3); }
DI void stage_rc(int b, int& R, int& C) { const int st = b / 1024, sb = b % 1024, swz = sb ^ (((sb >> 9) & 1) << 5); R = (st >> 1) * 16 + swz / 64; C = (st & 1) * 32 + (swz % 64) / 2; }

struct UnitD { const char* Bp; int pm, pn, e, rb; };

DI bool static_tile(int i, int G, int c, int nM, int nN, int& pm, int& pn) {
    const int nwg = nM * nN; const long L = (long)i * G + c; if (L >= nwg) return false;
    int wgid = (int)L; { const int q = nwg / NXCD, r = nwg % NXCD, xcd = wgid % NXCD, off = wgid / NXCD; wgid = (xcd < r ? xcd * (q + 1) : r * (q + 1) + (xcd - r) * q) + off; }
    const int nig = WGM * nN, gid = wgid / nig, fm = gid * WGM, gsz = (nM - fm) < WGM ? (nM - fm) : WGM;
    pm = fm + ((wgid % nig) % gsz); pn = (wgid % nig) / gsz; return true;
}

struct PlainSched {
    const char* Abase; const char* Bbase; int lda, ldb, K, nM, nN, G, c; static constexpr int esz = 2;
    DI bool next(int i, UnitD& u) const { int pm, pn; if (!static_tile(i, G, c, nM, nN, pm, pn)) return false; u.pm = pm; u.pn = pn; u.e = 0; u.rb = 0; u.Bp = Bbase + (size_t)pn * BM * ldb * 2; return true; }
    DI void a_offs(const UnitD& u, int R0, int C0, unsigned (&o)[2][2]) const {
#pragma unroll
        for (int h = 0; h < 2; ++h)
#pragma unroll
            for (int i = 0; i < 2; ++i) o[h][i] = (unsigned)(((size_t)(u.pm * BM + h * HALF + R0 + 64 * i) * lda + C0) * 2);
    }
};

template <bool FP8 = false, class Epi, class Sched>
DI void gemm_phase(LAS unsigned char* lds, const Sched& S, const Epi& E) {
    const int tid = otid(), wid = __builtin_amdgcn_readfirstlane(tid >> 6), lane = tid & 63, wr = wid >> 2, wc = wid & 3, fr = lane & 15, fq = lane >> 4;
    const int nt = S.K * Sched::esz / 128;
    int R0, C0; stage_rc(tid * 16, R0, C0);
    unsigned voffB[2];
#pragma unroll
    for (int i = 0; i < 2; ++i) { const int Rr = R0 + 64 * i, Rb = Epi::PERM ? ((Rr & ~31) + perm32(Rr & 31)) : Rr; voffB[i] = (unsigned)(Rb * S.ldb * Sched::esz + C0 * 2); }
    const size_t hstepB = (size_t)HALF * S.ldb * Sched::esz;
    const unsigned ldsw = (unsigned)wid * 1024u;
    const int aoff = FP8 ? lds_byte(wr * 64 + fr, fq * 16) : lds_byte(wr * 64 + fr, fq * 8), boff = FP8 ? lds_byte(wc * 32 + fr, fq * 16) : lds_byte(wc * 32 + fr, fq * 8);
    const unsigned mxscale = 0x7f7f7f7fu;
    const int kst = FP8 ? 16 : 1024;
    const char* Ab = S.Abase;
#define G8_SA(b, h) (((b) * 2 + (h)) * HTB)
#define G8_SB(b, h) ((4 + (b) * 2 + (h)) * HTB)
#define G8_STAGE_A(bufoff, offs, kb) do { _Pragma("unroll") for (int _i = 0; _i < 2; ++_i) \
        __builtin_amdgcn_global_load_lds((const unsigned*)(Ab + (size_t)(offs)[_i] + (size_t)(kb)), (LAS unsigned*)(lds + (bufoff) + ldsw + _i * 8192), 16, 0, 0); } while (0)
#define G8_STAGE_B(bufoff, gbase, kb) do { _Pragma("unroll") for (int _i = 0; _i < 2; ++_i) \
        __builtin_amdgcn_global_load_lds((const unsigned*)((gbase) + voffB[_i] + (size_t)(kb)), (LAS unsigned*)(lds + (bufoff) + ldsw + _i * 8192), 16, 0, 0); } while (0)
#define G8_LDA(dst, b, h) do { _Pragma("unroll") for (int m = 0; m < 4; ++m) { const i32x4_t _p = *(const LAS i32x4_t*)(lds + G8_SA(b, h) + aoff + m * 2048), _q = *(const LAS i32x4_t*)(lds + G8_SA(b, h) + aoff + m * 2048 + kst); dst[m] = __builtin_shufflevector(_p, _q, 0, 1, 2, 3, 4, 5, 6, 7); } } while (0)
#define G8_LDB(dst, b, h) do { _Pragma("unroll") for (int n = 0; n < 2; ++n) { const i32x4_t _p = *(const LAS i32x4_t*)(lds + G8_SB(b, h) + boff + n * 2048), _q = *(const LAS i32x4_t*)(lds + G8_SB(b, h) + boff + n * 2048 + kst); dst[n] = __builtin_shufflevector(_p, _q, 0, 1, 2, 3, 4, 5, 6, 7); } } while (0)
#define G8_MMA(ai, bj, At, Bt) do { __builtin_amdgcn_s_setprio(1); _Pragma("unroll") for (int m = 0; m < 4; ++m) _Pragma("unroll") for (int n = 0; n < 2; ++n) { \
        if constexpr (FP8) asm volatile("v_mfma_scale_f32_16x16x128_f8f6f4 %0, %1, %2, %0, %3, %3 op_sel_hi:[0,0,0]" : "+v"(acc[ai][bj][m][n]) : "v"(Bt[n]), "v"(At[m]), "v"(mxscale)); \
        else { acc[ai][bj][m][n] = __builtin_amdgcn_mfma_f32_16x16x32_bf16(__builtin_bit_cast(bf16x8, __builtin_shufflevector(Bt[n], Bt[n], 0, 1, 2, 3)), __builtin_bit_cast(bf16x8, __builtin_shufflevector(At[m], At[m], 0, 1, 2, 3)), acc[ai][bj][m][n], 0, 0, 0); \
               acc[ai][bj][m][n] = __builtin_amdgcn_mfma_f32_16x16x32_bf16(__builtin_bit_cast(bf16x8, __builtin_shufflevector(Bt[n], Bt[n], 4, 5, 6, 7)), __builtin_bit_cast(bf16x8, __builtin_shufflevector(At[m], At[m], 4, 5, 6, 7)), acc[ai][bj][m][n], 0, 0, 0); } } \
        __builtin_amdgcn_s_setprio(0); } while (0)
#define G8_WAIT_V(n) asm volatile("s_waitcnt vmcnt(" #n ")" ::: "memory")
#define G8_WAIT_L(n) asm volatile("s_waitcnt lgkmcnt(" #n ")" ::: "memory")
#define G8_BAR __builtin_amdgcn_s_barrier()
#define G8_SCHED __builtin_amdgcn_sched_barrier(0)
    UnitD cur, nxt; int ui = 0;
    if (!S.next(0, cur)) return;
    f32x4 acc[2][2][4][2];
#pragma unroll
    for (int a = 0; a < 2; ++a)
#pragma unroll
        for (int b = 0; b < 2; ++b)
#pragma unroll
            for (int m = 0; m < 4; ++m)
#pragma unroll
                for (int n = 0; n < 2; ++n) acc[a][b][m][n] = (f32x4){0.f, 0.f, 0.f, 0.f};
    typedef int i32x4_t __attribute__((ext_vector_type(4)));
    v8i_t At[4], B0[2], B1[2];
    unsigned cA[2][2];
    S.a_offs(cur, R0, C0, cA);
    const char* cB = cur.Bp;
    G8_STAGE_B(G8_SB(0, 0), cB, 0); G8_STAGE_A(G8_SA(0, 0), cA[0], 0); G8_STAGE_B(G8_SB(0, 1), cB + hstepB, 0); G8_STAGE_A(G8_SA(0, 1), cA[1], 0);
    if (wr == 1) G8_BAR;
    G8_WAIT_V(4); G8_BAR;
    G8_STAGE_B(G8_SB(1, 0), cB, 128); G8_STAGE_A(G8_SA(1, 0), cA[0], 128); G8_STAGE_B(G8_SB(1, 1), cB + hstepB, 128);
    G8_WAIT_V(6); G8_BAR;
    for (;;) {
        const bool has_next = S.next(ui + 1, nxt);
        const char* nB = has_next ? nxt.Bp : cB;
        for (int t = 0; t < nt; t += 2) {
            const bool last = (t == nt - 2);
            const unsigned k1 = (unsigned)(t + 1) * 128u;
            const unsigned k2 = last ? 0u : (unsigned)(t + 2) * 128u, k3 = k2 + 128u;
            unsigned c1[2] = {cA[1][0], cA[1][1]};
            if (last && has_next) S.a_offs(nxt, R0, C0, cA);
            const char* b2 = last ? nB : cB;
            G8_LDB(B0, 0, 0); G8_SCHED; G8_LDA(At, 0, 0); G8_STAGE_A(G8_SA(1, 1), c1, k1);
            G8_WAIT_L(8); G8_BAR; G8_WAIT_L(0); G8_MMA(0, 0, At, B0); G8_BAR; G8_SCHED;
            G8_LDB(B1, 0, 1); G8_STAGE_B(G8_SB(0, 0), b2, k2);
            G8_BAR; G8_WAIT_L(0); G8_MMA(0, 1, At, B1); G8_BAR;
            G8_LDA(At, 0, 1); G8_STAGE_A(G8_SA(0, 0), cA[0], k2);
            G8_BAR; G8_WAIT_L(0); G8_MMA(1, 0, At, B0); G8_BAR; G8_SCHED;
            G8_STAGE_B(G8_SB(0, 1), b2 + hstepB, k2);
            G8_WAIT_V(6); G8_BAR; G8_MMA(1, 1, At, B1); G8_BAR;
            G8_LDB(B0, 1, 0); G8_SCHED; G8_LDA(At, 1, 0); G8_STAGE_A(G8_SA(0, 1), cA[1], k2);
            G8_WAIT_L(8); G8_BAR; G8_WAIT_L(0); G8_MMA(0, 0, At, B0); G8_BAR; G8_SCHED;
            G8_LDB(B1, 1, 1); G8_STAGE_B(G8_SB(1, 0), b2, k3);
            G8_BAR; G8_WAIT_L(0); G8_MMA(0, 1, At, B1); G8_BAR;
            G8_LDA(At, 1, 1); G8_STAGE_A(G8_SA(1, 0), cA[0], k3);
            G8_BAR; G8_WAIT_L(0); G8_MMA(1, 0, At, B0); G8_BAR; G8_SCHED;
            G8_STAGE_B(G8_SB(1, 1), b2 + hstepB, k3);
            G8_WAIT_V(6); G8_BAR; G8_MMA(1, 1, At, B1); G8_BAR;
        }
        if constexpr (FP8) asm volatile("s_nop 15\n\ts_nop 15" ::: "memory");
        E(acc, cur, wr, wc, fr, fq);
        if (!has_next) break;
#pragma unroll
        for (int a = 0; a < 2; ++a)
#pragma unroll
            for (int b = 0; b < 2; ++b)
#pragma unroll
                for (int m = 0; m < 4; ++m)
#pragma unroll
                    for (int n = 0; n < 2; ++n) acc[a][b][m][n] = (f32x4){0.f, 0.f, 0.f, 0.f};
        cur = nxt; cB = nB; ++ui;
    }
    G8_WAIT_V(0);
    if (wr == 0) G8_BAR;
    G8_BAR;
#undef G8_SA
#undef G8_SB
#undef G8_STAGE_A
#undef G8_STAGE_B
#undef G8_LDA
#undef G8_LDB
#undef G8_MMA
#undef G8_WAIT_V
#undef G8_WAIT_L
#undef G8_BAR
#undef G8_SCHED
}
}
using g8::UnitD;
typedef f32x4 Acc[2][2][4][2];

struct EpiIn {
    static constexpr bool PERM = true;
    u16* H; const float* rs1; float* SSQ; float* WI;
    template <int ACT, bool DOSSQ> DI void run(const Acc& acc, const UnitD& u, int wr, int wc, int fr, int fq) const {
        const int pn = u.pn;
#pragma unroll
        for (int ai = 0; ai < 2; ++ai)
#pragma unroll
            for (int m = 0; m < 4; ++m) {
                const int row = u.pm * 256 + ai * 128 + wr * 64 + m * 16 + fr;
#pragma unroll
                for (int bj = 0; bj < 2; ++bj) {
                    f32x4 v0 = acc[ai][bj][m][0], v1 = acc[ai][bj][m][1];
                    if (ACT == 1) {
#pragma unroll
                        for (int j = 0; j < 4; ++j) { v0[j] = fast_gelu(v0[j]); v1[j] = fast_gelu(v1[j]); }
                    } else if (ACT == 2) {
#pragma unroll
                        for (int j = 0; j < 4; ++j) { v0[j] = fast_sigmoid(v0[j]); v1[j] = fast_sigmoid(v1[j]); }
                    }
                    u32x4 w; w.x = pk2(v0[0], v0[1]); w.y = pk2(v0[2], v0[3]); w.z = pk2(v1[0], v1[1]); w.w = pk2(v1[2], v1[3]);
                    *(u32x4*)(H + (size_t)row * NIN + pn * 256 + bj * 128 + wc * 32 + 8 * fq) = w;
                    if (DOSSQ) {
                        float ssq = ((v0[0] * v0[0] + v0[1] * v0[1]) + (v0[2] * v0[2] + v0[3] * v0[3])) + ((v1[0] * v1[0] + v1[1] * v1[1]) + (v1[2] * v1[2] + v1[3] * v1[3]));
                        ssq += __shfl_xor(ssq, 16); ssq += __shfl_xor(ssq, 32);
                        if (fq == 0) SSQ[(size_t)row * 32 + (pn - 2) * 8 + bj * 4 + wc] = ssq;
                        if (pn == 5 && bj == 1 && wc == 2 && fq == 0) *(f32x4*)(WI + (size_t)row * 4) = v0 * 0.5f;
                    }
                }
            }
    }
    DI void operator()(const Acc& acc, const UnitD& u, int wr, int wc, int fr, int fq) const {
        const int pn = u.pn;
        if (pn < 2) run<1, false>(acc, u, wr, wc, fr, fq);
        else if (pn < 4) run<1, true>(acc, u, wr, wc, fr, fq);
        else if (pn < 6) run<0, true>(acc, u, wr, wc, fr, fq);
        else run<2, false>(acc, u, wr, wc, fr, fq);
    }
};
struct EpiQ {
    static constexpr bool PERM = true;
    u16* Q; u16* QI; const float* SSQ;
    DI void operator()(const Acc& acc, const UnitD& u, int wr, int wc, int fr, int fq) const {
        f32x4 sq[2][4][2];
#pragma unroll
        for (int ai = 0; ai < 2; ++ai)
#pragma unroll
            for (int m = 0; m < 4; ++m) { const int row = u.pm * 256 + ai * 128 + wr * 64 + m * 16 + fr; sq[ai][m][0] = *(const f32x4*)(SSQ + (size_t)row * 32 + 16); sq[ai][m][1] = *(const f32x4*)(SSQ + (size_t)row * 32 + 20); }
        __builtin_amdgcn_sched_barrier(0);
#pragma unroll
        for (int ai = 0; ai < 2; ++ai)
#pragma unroll
            for (int m = 0; m < 4; ++m) {
                const int row = u.pm * 256 + ai * 128 + wr * 64 + m * 16 + fr;
                const f32x4 s0 = sq[ai][m][0], s1 = sq[ai][m][1];
                const float ss = ((s0[0] + s0[1]) + (s0[2] + s0[3])) + ((s1[0] + s1[1]) + (s1[2] + s1[3]));
                const float rs = __builtin_amdgcn_rsqf(ss * (1.0f / 256.0f) + EPS);
#pragma unroll
                for (int bj = 0; bj < 2; ++bj) {
                    const int col = u.pn * 256 + bj * 128 + wc * 32 + 8 * fq;
                    const f32x4 v0 = acc[ai][bj][m][0] * rs, v1 = acc[ai][bj][m][1] * rs;
                    if (col < 1024) { u32x4 w; w.x = pk2(v0[0], v0[1]); w.y = pk2(v0[2], v0[3]); w.z = pk2(v1[0], v1[1]); w.w = pk2(v1[2], v1[3]); *(u32x4*)(Q + (size_t)row * 1024 + col) = w; }
                    else { u32x2 w; w.x = pk4_i8(v0[0], v0[1], v0[2], v0[3]); w.y = pk4_i8(v1[0], v1[1], v1[2], v1[3]); *(u32x2*)((unsigned char*)QI + (size_t)row * 256 + (col - 1024)) = w; }
                }
            }
    }
};
template <int SECOND> struct EpiMrg {
    static constexpr bool PERM = true;
    u16* OUT; const u16* TMP; const u16* H;
    DI void operator()(const Acc& acc, const UnitD& u, int wr, int wc, int fr, int fq) const {
#pragma unroll
        for (int ai = 0; ai < 2; ++ai) {
            u32x4 g[4][2], tp[4][2];
#pragma unroll
            for (int m = 0; m < 4; ++m)
#pragma unroll
                for (int bj = 0; bj < 2; ++bj) {
                    const int row = u.pm * 256 + ai * 128 + wr * 64 + m * 16 + fr, col = u.pn * 256 + bj * 128 + wc * 32 + 8 * fq;
                    g[m][bj] = *(const u32x4*)(H + (size_t)row * NIN + 1536 + SECOND * 1024 + col);
                    if (SECOND) tp[m][bj] = *(const u32x4*)(TMP + (size_t)row * 1024 + col);
                }
            __builtin_amdgcn_sched_barrier(0);
#pragma unroll
            for (int m = 0; m < 4; ++m)
#pragma unroll
                for (int bj = 0; bj < 2; ++bj) {
                    const int row = u.pm * 256 + ai * 128 + wr * 64 + m * 16 + fr, col = u.pn * 256 + bj * 128 + wc * 32 + 8 * fq;
                    const u32x4 gg = g[m][bj];
                    f32x4 v0 = acc[ai][bj][m][0], v1 = acc[ai][bj][m][1];
                    v0[0] *= bflo(gg.x); v0[1] *= bfhi(gg.x); v0[2] *= bflo(gg.y); v0[3] *= bfhi(gg.y); v1[0] *= bflo(gg.z); v1[1] *= bfhi(gg.z); v1[2] *= bflo(gg.w); v1[3] *= bfhi(gg.w);
                    if (SECOND) { const u32x4 t = tp[m][bj];
                        v0[0] += bflo(t.x); v0[1] += bfhi(t.x); v0[2] += bflo(t.y); v0[3] += bfhi(t.y); v1[0] += bflo(t.z); v1[1] += bfhi(t.z); v1[2] += bflo(t.w); v1[3] += bfhi(t.w); }
                    u32x4 w; w.x = pk2(v0[0], v0[1]); w.y = pk2(v0[2], v0[3]); w.z = pk2(v1[0], v1[1]); w.w = pk2(v1[2], v1[3]);
                    *(u32x4*)(OUT + (size_t)row * 1024 + col) = w;
                }
            __builtin_amdgcn_sched_barrier(0);
        }
    }
};
struct EpiOut {
    static constexpr bool PERM = false;
    float* out; const float* x;
    DI void operator()(const Acc& acc, const UnitD& u, int wr, int wc, int fr, int fq) const {
#pragma unroll
        for (int ai = 0; ai < 2; ++ai) {
            f32x4 xv[4][2][2];
#pragma unroll
            for (int m = 0; m < 4; ++m)
#pragma unroll
                for (int bj = 0; bj < 2; ++bj)
#pragma unroll
                    for (int n = 0; n < 2; ++n)
                        xv[m][bj][n] = *(const f32x4*)(x + (size_t)(u.pm * 256 + ai * 128 + wr * 64 + m * 16 + fr) * 1024 + u.pn * 256 + bj * 128 + wc * 32 + n * 16 + 4 * fq);
            __builtin_amdgcn_sched_barrier(0);
#pragma unroll
            for (int m = 0; m < 4; ++m)
#pragma unroll
                for (int bj = 0; bj < 2; ++bj)
#pragma unroll
                    for (int n = 0; n < 2; ++n)
                        *(f32x4*)(out + (size_t)(u.pm * 256 + ai * 128 + wr * 64 + m * 16 + fr) * 1024 + u.pn * 256 + bj * 128 + wc * 32 + n * 16 + 4 * fq) = xv[m][bj][n] + acc[ai][bj][m][n];
            __builtin_amdgcn_sched_barrier(0);
        }
    }
};

constexpr int MOE_TAB = g8::STAGE_BYTES;
DI void moe_table(LAS unsigned char* lds, const unsigned* CNT) {
    LAS int* tab = (LAS int*)(lds + MOE_TAB);
    __syncthreads();
    if (threadIdx.x == 0) { int acc = 0; for (int e = 0; e < NE; ++e) { const int c = (int)__hip_atomic_load(CNT + e, __ATOMIC_RELAXED, __HIP_MEMORY_SCOPE_AGENT); tab[e] = acc; tab[33 + e] = c; acc += (c + 255) >> 8; } tab[32] = acc; }
    __syncthreads();
}
template <int NPN, bool GATHER> struct MoeSched {
    const char* Abase; const char* Wbase; const int* LTOK; LAS const int* tab; int lda, ldb, K, G, c; size_t wstride; static constexpr int esz = 1;
    DI bool next(int i, UnitD& u) const {
        const long L = (long)i * G + c; const int R = tab[32];
        if (L >= (long)R * NPN) return false;
        const int rbg = (int)(L / NPN), pn = (int)(L % NPN);
        int e = 0;
        for (int j = 1; j < NE; ++j) e += (tab[j] <= rbg) ? 1 : 0;
        e = __builtin_amdgcn_readfirstlane(e);
        u.pm = rbg; u.pn = pn; u.e = e; u.rb = rbg - tab[e];
        u.Bp = Wbase + (size_t)e * wstride + (size_t)pn * 256 * ldb * esz;
        return true;
    }
    DI void a_offs(const UnitD& u, int R0, int C0, unsigned (&o)[2][2]) const {
        const int cnt = tab[33 + u.e];
#pragma unroll
        for (int h = 0; h < 2; ++h)
#pragma unroll
            for (int i = 0; i < 2; ++i) {
                const int r = h * 128 + R0 + 64 * i;
                if (GATHER) { const int slot = u.rb * 256 + r; const int tok = slot < cnt ? LTOK[(size_t)u.e * ECAP + slot] : 0; o[h][i] = (unsigned)((size_t)tok * lda * esz + C0 * 2); }
                else o[h][i] = (unsigned)((size_t)(u.pm * 256 + r) * lda * esz + C0 * 2);
            }
    }
};
struct EpiMoe1 {
    static constexpr bool PERM = true;
    unsigned char* ACT; const float* b1;
    DI void operator()(const Acc& acc, const UnitD& u, int wr, int wc, int fr, int fq) const {
        const float* be = b1 + (size_t)u.e * 2048;
        const int hc = u.pn * 128 + wc * 32 + 8 * fq;
        const f32x4 bg0 = *(const f32x4*)(be + hc), bg1 = *(const f32x4*)(be + hc + 4), bu0 = *(const f32x4*)(be + 1024 + hc), bu1 = *(const f32x4*)(be + 1024 + hc + 4);
        __builtin_amdgcn_sched_barrier(0);
#pragma unroll
        for (int ai = 0; ai < 2; ++ai)
#pragma unroll
            for (int m = 0; m < 4; ++m) {
                const int row = u.pm * 256 + ai * 128 + wr * 64 + m * 16 + fr;
                float av[8];
#pragma unroll
                for (int n = 0; n < 2; ++n) {
                    const f32x4 g = acc[ai][0][m][n] * 0.015625f + (n ? bg1 : bg0), up = acc[ai][1][m][n] * 0.015625f + (n ? bu1 : bu0);
#pragma unroll
                    for (int j = 0; j < 4; ++j) {
                        const float hg = fminf(g[j], 7.0f), hu = __builtin_amdgcn_fmed3f(up[j], -7.0f, 7.0f);
                        av[4 * n + j] = (hu + 1.0f) * (hg * __builtin_amdgcn_rcpf(1.0f + __builtin_amdgcn_exp2f(hg * -2.4554669595930157f)));
                    }
                }
                u32x2 w; w.x = pk4_fp8(av[0], av[1], av[2], av[3]); w.y = pk4_fp8(av[4], av[5], av[6], av[7]);
                *(u32x2*)(ACT + (size_t)row * 1024 + hc) = w;
            }
    }
};
struct EpiMoe2 {
    static constexpr bool PERM = true;
    u16* YB; const float* b2;
    DI void operator()(const Acc& acc, const UnitD& u, int wr, int wc, int fr, int fq) const {
        const float* be = b2 + (size_t)u.e * 1024;
        f32x4 bias[2][2];
#pragma unroll
        for (int bj = 0; bj < 2; ++bj) { const int col = u.pn * 256 + bj * 128 + wc * 32 + 8 * fq; bias[bj][0] = *(const f32x4*)(be + col); bias[bj][1] = *(const f32x4*)(be + col + 4); }
        __builtin_amdgcn_sched_barrier(0);
#pragma unroll
        for (int ai = 0; ai < 2; ++ai)
#pragma unroll
            for (int m = 0; m < 4; ++m) {
                const int r = ai * 128 + wr * 64 + m * 16 + fr;
#pragma unroll
                for (int bj = 0; bj < 2; ++bj) {
                    const int col = u.pn * 256 + bj * 128 + wc * 32 + 8 * fq;
                    const f32x4 v0 = acc[ai][bj][m][0] * 0.015625f + bias[bj][0], v1 = acc[ai][bj][m][1] * 0.015625f + bias[bj][1];
                    u32x4 w; w.x = pk2(v0[0], v0[1]); w.y = pk2(v0[2], v0[3]); w.z = pk2(v1[0], v1[1]); w.w = pk2(v1[2], v1[3]);
                    *(u32x4*)(YB + (size_t)(u.pm * 256 + r) * 1024 + col) = w;
                }
            }
    }
};

template <bool FP8 = false, class F> DI void tr_tile(LAS unsigned char* lds, const float* src, int ld_src, int Nsz, int k0, int n0, const float* sk, float mul, u16* dst, int ld_dst, F rowmap) {
    LAS float* t = (LAS float*)lds;
    const int tid = otid();
    __syncthreads();
#pragma unroll
    for (int it = 0; it < 2; ++it) {
        const int k = (tid >> 4) + 32 * it, n = 4 * (tid & 15);
        f32x4 v = {0.f, 0.f, 0.f, 0.f};
        if (n0 + n < Nsz) v = *(const f32x4*)(src + (size_t)(k0 + k) * ld_src + n0 + n);
        const float s = (sk ? sk[k0 + k] : 1.0f) * mul;
        t[k * 65 + n] = v[0] * s; t[k * 65 + n + 1] = v[1] * s; t[k * 65 + n + 2] = v[2] * s; t[k * 65 + n + 3] = v[3] * s;
    }
    __syncthreads();
    const int n = tid >> 3, kc = (tid & 7) * 8;
    if (FP8) {
        if (n0 + n < Nsz) {
            u32x2 w;
            w.x = pk4_fp8(t[(kc + 0) * 65 + n], t[(kc + 1) * 65 + n], t[(kc + 2) * 65 + n], t[(kc + 3) * 65 + n]);
            w.y = pk4_fp8(t[(kc + 4) * 65 + n], t[(kc + 5) * 65 + n], t[(kc + 6) * 65 + n], t[(kc + 7) * 65 + n]);
            *(u32x2*)((unsigned char*)dst + (size_t)rowmap(n0 + n) * ld_dst + k0 + kc) = w;
        }
    } else if (n0 + n < Nsz) {
        u32x4 w;
        w.x = pk2(t[(kc + 0) * 65 + n], t[(kc + 1) * 65 + n]); w.y = pk2(t[(kc + 2) * 65 + n], t[(kc + 3) * 65 + n]);
        w.z = pk2(t[(kc + 4) * 65 + n], t[(kc + 5) * 65 + n]); w.w = pk2(t[(kc + 6) * 65 + n], t[(kc + 7) * 65 + n]);
        *(u32x4*)(dst + (size_t)rowmap(n0 + n) * ld_dst + k0 + kc) = w;
    }
}
struct MapId { DI int operator()(int n) const { return n; } };
struct MapIn { DI int operator()(int n) const { return n < 1476 ? n : n + 60; } };
struct MapE1 { DI int operator()(int n) const { const int hi = n >= 1024 ? 1 : 0, q = n - hi * 1024; return (q >> 7) * 256 + hi * 128 + (q & 127); } };

DI void phase0(const Args& a, LAS unsigned char* lds) {
    unsigned char* ws = a.ws;
    const int tid = otid();
    const size_t gtid = (size_t)blockIdx.x * NT + tid, gstride = (size_t)gridDim.x * NT;
    for (size_t i = gtid; i < 60 * 1024 / 2; i += gstride) ((unsigned*)(ws + WS_WIN + (size_t)1476 * 1024 * 2))[i] = 0u;
    for (size_t i = gtid; i < 32 * 1024; i += gstride) { const int e = (int)(i >> 10), k = (int)(i & 1023); const float w = a.in[I_WR][k * 32 + e] * a.in[I_N2G][k]; const u16 h = f2bf(w); ((u16*)(ws + WS_WR))[i] = h; ((u16*)(ws + WS_WR))[32 * 1024 + i] = f2bf(w - bf2f(h)); }
    for (size_t i = gtid; i < 4 * 128 * 128; i += gstride) { const int tt = (int)((i >> 7) & 127), ss = (int)(i & 127); ((u16*)(ws + WS_WSP))[i] = f2bf(ss <= tt ? a.in[I_WSP][i] : 0.f); }
    {
        const int wid = tid >> 6, lane = tid & 63;
        for (int row = blockIdx.x * 8 + wid; row < T; row += gridDim.x * 8) {
            const float* xr = a.in[I_X] + (size_t)row * 1024; u16* xb = (u16*)(ws + WS_XB) + (size_t)row * 1024;
            float ss = 0.f; f32x4 xv[4];
#pragma unroll
            for (int i = 0; i < 4; ++i) {
                xv[i] = __builtin_nontemporal_load((const f32x4*)(xr + i * 256 + lane * 4));
                ss += (xv[i][0] * xv[i][0] + xv[i][1] * xv[i][1]) + (xv[i][2] * xv[i][2] + xv[i][3] * xv[i][3]);
            }
#pragma unroll
            for (int o = 32; o >= 1; o >>= 1) ss += __shfl_xor(ss, o);
            const float rs = __builtin_amdgcn_rsqf(ss * (1.0f / 1024.0f) + EPS);
#pragma unroll
            for (int i = 0; i < 4; ++i) { u32x2 w; w.x = pk2(xv[i][0] * rs, xv[i][1] * rs); w.y = pk2(xv[i][2] * rs, xv[i][3] * rs); *(u32x2*)(xb + i * 256 + lane * 4) = w; }
        }
    }
    constexpr int U_IN = 16 * 56, U_UQ = 4 * 16, U_QI = 4 * 4, U_PA = 8 * 16, U_OUT = 16 * 16, U_CB = 64;
    constexpr int U_TOT = U_IN + U_UQ + U_QI + U_PA + U_OUT + U_CB;
    for (int u = blockIdx.x; u < U_TOT; u += gridDim.x) {
        int v = u;
        if (v < U_IN) { tr_tile(lds, a.in[I_WIN], 3524, 3524, (v & 15) * 64, (v >> 4) * 64, a.in[I_N1G], 1.0f, (u16*)(ws + WS_WIN), 1024, MapIn()); continue; }
        v -= U_IN;
        if (v < U_UQ) { tr_tile(lds, a.in[I_WUQ], 1024, 1024, (v & 3) * 64, (v >> 2) * 64, a.in[I_QLG], 1.0f, (u16*)(ws + WS_WQ), 256, MapId()); continue; }
        v -= U_UQ;
        if (v < U_QI) { tr_tile(lds, a.in[I_WQI], 256, 256, (v & 3) * 64, (v >> 2) * 64, a.in[I_QLG], 1.0f, (u16*)(ws + WS_WQ) + 1024 * 256, 256, MapId()); continue; }
        v -= U_QI;
        if (v < U_PA) { tr_tile(lds, a.in[I_WPA], 1024, 1024, (v & 7) * 64, (v >> 3) * 64, nullptr, 1.0f, (u16*)(ws + WS_WCAT), 1536, MapId()); continue; }
        v -= U_PA;
        if (v < U_OUT) { tr_tile(lds, a.in[I_WOUT], 1024, 1024, (v & 15) * 64, (v >> 4) * 64, nullptr, 1.0f, (u16*)(ws + WS_WOUT), 1024, MapId()); continue; }
        v -= U_OUT;
        {
            const int h = v >> 3, c0 = (v & 7) * 16;
            LAS float* t = (LAS float*)lds;
            __syncthreads();
            for (int i = tid; i < 1024; i += NT) t[i] = a.in[I_WUV][(size_t)h * 128 * 64 + (size_t)c0 * 64 + i];
            __syncthreads();
            for (int nn = tid; nn < 1024; nn += NT) {
                float accv[16];
#pragma unroll
                for (int i = 0; i < 16; ++i) accv[i] = 0.f;
                for (int vv = 0; vv < 64; ++vv) {
                    const float pb = a.in[I_WPB][(size_t)(h * 64 + vv) * 1024 + nn];
#pragma unroll
                    for (int i = 0; i < 16; ++i) accv[i] += t[i * 64 + vv] * pb;
                }
                u32x4 w0, w1;
                w0.x = pk2(accv[0], accv[1]); w0.y = pk2(accv[2], accv[3]); w0.z = pk2(accv[4], accv[5]); w0.w = pk2(accv[6], accv[7]);
                w1.x = pk2(accv[8], accv[9]); w1.y = pk2(accv[10], accv[11]); w1.z = pk2(accv[12], accv[13]); w1.w = pk2(accv[14], accv[15]);
                u16* d = (u16*)(ws + WS_WCAT) + (size_t)nn * 1536 + 512 + h * 128 + c0;
                *(u32x4*)d = w0; *(u32x4*)(d + 8) = w1;
            }
        }
    }
}

DI void gmlp_unit(const Args& a, LAS unsigned char* lds, int u) {
    unsigned char* ws = a.ws;
    const int tid = otid(), wid = tid >> 6, lane = tid & 63, fr = lane & 15, fq = lane >> 4;
    const int g = u & 3, row0 = (u >> 2) * 128;
    const u16* H = (const u16*)(ws + WS_H);
    LAS u16* img = (LAS u16*)lds;
    __syncthreads();
    {
        const int s = tid & 127, cset = tid >> 7;
        const f32x4 sq = *(const f32x4*)((const float*)(ws + WS_SSQ) + (size_t)(row0 + s) * 32 + g * 4);
        const float rs = __builtin_amdgcn_rsqf(((sq[0] + sq[1]) + (sq[2] + sq[3])) * (1.0f / 128.0f) + EPS);
#pragma unroll
        for (int it = 0; it < 4; ++it) {
            const int c = cset + 4 * it;
            const u32x4 raw = *(const u32x4*)(H + (size_t)(row0 + s) * NIN + 512 + g * 128 + 8 * c);
            const float* vg = a.in[I_VG] + 8 * c;
            float f[8] = {bflo(raw.x), bfhi(raw.x), bflo(raw.y), bfhi(raw.y), bflo(raw.z), bfhi(raw.z), bflo(raw.w), bfhi(raw.w)};
#pragma unroll
            for (int i = 0; i < 8; ++i) img[(8 * c + i) * 136 + s] = f2bf(f[i] * rs * vg[i]);
        }
    }
    __syncthreads();
    const u16* W = (const u16*)(ws + WS_WSP) + (size_t)g * 128 * 128 + (size_t)(16 * wid + fr) * 128;
    f32x4 acc[8];
#pragma unroll
    for (int i = 0; i < 8; ++i) acc[i] = (f32x4){0.f, 0.f, 0.f, 0.f};
    const int nks = (16 * wid + 15) / 32 + 1;
    for (int ks = 0; ks < nks; ++ks) {
        const bf16x8 bw = *(const bf16x8*)(W + ks * 32 + 8 * fq);
#pragma unroll
        for (int i = 0; i < 8; ++i) {
            const bf16x8 av = *(const LAS bf16x8*)(img + (16 * i + fr) * 136 + ks * 32 + 8 * fq);
            acc[i] = __builtin_amdgcn_mfma_f32_16x16x32_bf16(av, bw, acc[i], 0, 0, 0);
        }
    }
    const int t = 16 * wid + fr;
    const float bias = a.in[I_BSP][g * 128 + t];
    u16* YO = (u16*)(ws + WS_YO);
#pragma unroll
    for (int i = 0; i < 8; ++i) {
        const int d = 16 * i + 4 * fq;
        const u32x2 uu = *(const u32x2*)(H + (size_t)(row0 + t) * NIN + g * 128 + d);
        const float y0 = bflo(uu.x) * (acc[i][0] + bias), y1 = bfhi(uu.x) * (acc[i][1] + bias), y2 = bflo(uu.y) * (acc[i][2] + bias), y3 = bfhi(uu.y) * (acc[i][3] + bias);
        u32x2 w; w.x = pk2(y0, y1); w.y = pk2(y2, y3);
        *(u32x2*)(YO + (size_t)(row0 + t) * 1536 + g * 128 + d) = w;
    }
}

DI void kvnorm(const Args& a) {
    unsigned char* ws = a.ws;
    const u16* H = (const u16*)(ws + WS_H); const float* SSQ = (const float*)(ws + WS_SSQ);
    const size_t gtid = (size_t)blockIdx.x * NT + otid(), gstride = (size_t)gridDim.x * NT;
    for (size_t idx = gtid; idx < (size_t)T * 24; idx += gstride) {
        const int row = (int)(idx / 24), c = (int)(idx % 24);
        const u16* src; u16* dst; const float* gain; float rs;
        if (c < 16) {
            const f32x4 sq = *(const f32x4*)(SSQ + (size_t)row * 32 + 24);
            rs = __builtin_amdgcn_rsqf(((sq[0] + sq[1]) + (sq[2] + sq[3])) * (1.0f / 128.0f) + EPS);
            src = H + (size_t)row * NIN + 1280 + 8 * c; dst = (u16*)(ws + WS_KVN) + (size_t)row * 128 + 8 * c; gain = a.in[I_KVG] + 8 * c;
        } else {
            const int cc = c - 16;
            rs = __builtin_amdgcn_rsqf((SSQ[(size_t)row * 32 + 28] + SSQ[(size_t)row * 32 + 29]) * (1.0f / 64.0f) + EPS);
            src = H + (size_t)row * NIN + 1408 + 8 * cc; dst = nullptr; gain = a.in[I_KIG] + 8 * cc;
            const u32x4 raw = *(const u32x4*)src;
            u32x2 w8;
            w8.x = pk4_i8(bflo(raw.x) * rs * gain[0], bfhi(raw.x) * rs * gain[1], bflo(raw.y) * rs * gain[2], bfhi(raw.y) * rs * gain[3]);
            w8.y = pk4_i8(bflo(raw.z) * rs * gain[4], bfhi(raw.z) * rs * gain[5], bflo(raw.w) * rs * gain[6], bfhi(raw.w) * rs * gain[7]);
            *(u32x2*)(ws + WS_KIN + (size_t)row * 64 + 8 * cc) = w8;
            continue;
        }
        const u32x4 raw = *(const u32x4*)src;
        u32x4 w;
        w.x = pk2(bflo(raw.x) * rs * gain[0], bfhi(raw.x) * rs * gain[1]); w.y = pk2(bflo(raw.y) * rs * gain[2], bfhi(raw.y) * rs * gain[3]);
        w.z = pk2(bflo(raw.z) * rs * gain[4], bfhi(raw.z) * rs * gain[5]); w.w = pk2(bflo(raw.w) * rs * gain[6], bfhi(raw.w) * rs * gain[7]);
        *(u32x4*)dst = w;
    }
}

constexpr int P3_ROWS = 0, P3_HIST = 131072, P3_LIST = 147456;
DI unsigned f2key(float f) { const unsigned u = __float_as_uint(f); return (u & 0x80000000u) ? ~u : (u | 0x80000000u); }
DI int wave_incl_scan(int v, int lane) {
#pragma unroll
    for (int o = 1; o < 64; o <<= 1) { const int t = __shfl_up(v, o); if (lane >= o) v += t; }
    return v;
}
DI int wave_suffix_scan(int v, int lane) {
#pragma unroll
    for (int o = 1; o < 64; o <<= 1) { const int t = __shfl_down(v, o); if (lane + o < 64) v += t; }
    return v;
}
DI unsigned pk_gt(unsigned kw, unsigned xw, unsigned one) {
    unsigned d, m;
    asm("v_pk_sub_u16 %0, %1, %2 clamp" : "=v"(d) : "v"(kw), "v"(xw));
    asm("v_pk_min_u16 %0, %1, %2" : "=v"(m) : "v"(d), "v"(one));
    return m;
}
DI unsigned pk_subs(unsigned kw, unsigned xw) { unsigned d; asm("v_pk_sub_u16 %0, %1, %2 clamp" : "=v"(d) : "v"(kw), "v"(xw)); return d; }
DI unsigned pk_min1(unsigned d, unsigned one) { unsigned m; asm("v_pk_min_u16 %0, %1, %2" : "=v"(m) : "v"(d), "v"(one)); return m; }
DI unsigned pk_max(unsigned a, unsigned b) { unsigned r; asm("v_pk_max_u16 %0, %1, %2" : "=v"(r) : "v"(a), "v"(b)); return r; }
DI unsigned pk_add(unsigned a, unsigned b) { unsigned r; asm("v_pk_add_u16 %0, %1, %2" : "=v"(r) : "v"(a), "v"(b)); return r; }
DI int wave_sum(int v) {
    v += __builtin_amdgcn_update_dpp(0, v, 0xB1, 0xf, 0xf, false);
    v += __builtin_amdgcn_update_dpp(0, v, 0x4E, 0xf, 0xf, false);
    v += __builtin_amdgcn_update_dpp(0, v, 0x141, 0xf, 0xf, false);
    v += __builtin_amdgcn_update_dpp(0, v, 0x140, 0xf, 0xf, false);
    return __builtin_amdgcn_readlane(v, 0) + __builtin_amdgcn_readlane(v, 16) + __builtin_amdgcn_readlane(v, 32) + __builtin_amdgcn_readlane(v, 48);
}
DI int rowaddr(int p) { return (p & ~511) | ((p & 63) << 3) | ((p >> 6) & 7); }
typedef unsigned short us2_t __attribute__((ext_vector_type(2)));
DI unsigned dot2acc(unsigned flags, unsigned wts, unsigned acc) { return __builtin_amdgcn_udot2(__builtin_bit_cast(us2_t, flags), __builtin_bit_cast(us2_t, wts), acc, false); }
DI void keys_load(LAS u16* row, int N, int lane, u32x4 (&kr)[16]) {
    const int Nup = (N + 511) & ~511, niter = Nup >> 9;
    for (int p = N + lane; p < Nup; p += 64) row[rowaddr(p)] = (u16)0;
    wave_lds_sync();
#pragma unroll
    for (int i = 0; i < 16; ++i) { kr[i] = (u32x4){0u, 0u, 0u, 0u}; if (i < niter) kr[i] = *(LAS const u32x4*)(row + i * 512 + lane * 8); }
    wave_lds_sync();
}
DI void keys_select(const u32x4 (&kr)[16], LAS u16* list, int N, int lane) {
    const int Nup = (N + 511) & ~511, niter = Nup >> 9;
    const unsigned one = 0x00010001u;
    auto count_gt = [&](unsigned x) -> int {
        const unsigned xw = x | (x << 16);
        unsigned acc = 0u, acc1 = 0u, acc2 = 0u, acc3 = 0u;
#pragma unroll
        for (int c = 0; c < 4; ++c) {
            if (4 * c < niter) {
#pragma unroll
                for (int h = 0; h < 2; ++h) {
                    unsigned d[8];
#pragma unroll
                    for (int i = 0; i < 2; ++i) { const u32x4 kk = kr[4 * c + 2 * h + i]; d[4 * i] = pk_subs(kk.x, xw); d[4 * i + 1] = pk_subs(kk.y, xw); d[4 * i + 2] = pk_subs(kk.z, xw); d[4 * i + 3] = pk_subs(kk.w, xw); }
#pragma unroll
                    for (int i = 0; i < 8; ++i) d[i] = pk_min1(d[i], one);
#pragma unroll
                    for (int i = 0; i < 8; i += 4) { acc = dot2acc(d[i], one, acc); acc1 = dot2acc(d[i + 1], one, acc1); acc2 = dot2acc(d[i + 2], one, acc2); acc3 = dot2acc(d[i + 3], one, acc3); }
                }
            }
        }
        return wave_sum((int)((acc + acc1) + (acc2 + acc3)));
    };
    unsigned T = 0u; int cge = Nup, topbit = 15;
    {
        unsigned mx = 0u;
#pragma unroll
        for (int c = 0; c < 4; ++c) {
            if (4 * c < niter) {
#pragma unroll
                for (int i = 4 * c; i < 4 * c + 4; ++i) { mx = pk_max(mx, kr[i].x); mx = pk_max(mx, kr[i].y); mx = pk_max(mx, kr[i].z); mx = pk_max(mx, kr[i].w); }
            }
        }
        unsigned m1 = max(mx & 0xffffu, mx >> 16);
        m1 = max(m1, (unsigned)__builtin_amdgcn_update_dpp(0, (int)m1, 0xB1, 0xf, 0xf, false)); m1 = max(m1, (unsigned)__builtin_amdgcn_update_dpp(0, (int)m1, 0x4E, 0xf, 0xf, false));
        m1 = max(m1, (unsigned)__builtin_amdgcn_update_dpp(0, (int)m1, 0x141, 0xf, 0xf, false)); m1 = max(m1, (unsigned)__builtin_amdgcn_update_dpp(0, (int)m1, 0x140, 0xf, 0xf, false));
        const unsigned kmax = max(max((unsigned)__builtin_amdgcn_readlane((int)m1, 0), (unsigned)__builtin_amdgcn_readlane((int)m1, 16)), max((unsigned)__builtin_amdgcn_readlane((int)m1, 32), (unsigned)__builtin_amdgcn_readlane((int)m1, 48)));
        if (kmax > 1024u) {
            const unsigned lo = kmax - 1023u;
            const int clo = count_gt(lo - 1u);
            if (clo >= 256) { T = lo; cge = clo; topbit = 9; }
        }
    }
#pragma unroll 1
    for (int bit = topbit; bit >= 0; --bit) {
        const unsigned cand = topbit == 15 ? (T | (1u << bit)) : (T + (1u << bit));
        if (cand > 0xffffu) continue;
        const int cnt = count_gt(cand - 1u);
        if (cnt >= 256) { T = cand; cge = cnt; }
    }
    auto build = [&](unsigned x, unsigned (&M)[4]) {
        const unsigned xw = x | (x << 16);
#pragma unroll
        for (int c = 0; c < 4; ++c) {
            M[c] = 0u;
            if (4 * c < niter) {
#pragma unroll
                for (int i = 4 * c; i < 4 * c + 4; ++i) {
                    unsigned byte = dot2acc(pk_gt(kr[i].x, xw, one), 0x00020001u, 0u);
                    byte = dot2acc(pk_gt(kr[i].y, xw, one), 0x00080004u, byte);
                    byte = dot2acc(pk_gt(kr[i].z, xw, one), 0x00200010u, byte);
                    byte = dot2acc(pk_gt(kr[i].w, xw, one), 0x00800040u, byte);
                    M[c] |= byte << (8 * (i & 3));
                }
            }
        }
    };
    unsigned M[4];
    build(T - 1u, M);
    if (cge != 256) {
        unsigned G[4]; build(T, G);
        unsigned E[4];
#pragma unroll
        for (int c = 0; c < 4; ++c) E[c] = M[c] & ~G[c];
        const int need = 256 - (cge - wave_sum((int)(__builtin_popcount(E[0]) + __builtin_popcount(E[1]) + __builtin_popcount(E[2]) + __builtin_popcount(E[3]))));
        auto below = [&](int B, int c) -> unsigned { const int nb = B - 32 * c; return nb <= 0 ? 0u : (nb >= 32 ? 0xffffffffu : ((1u << nb) - 1u)); };
        auto ties_below = [&](int B) -> int {
            return wave_sum((int)(__builtin_popcount(E[0] & below(B, 0)) + __builtin_popcount(E[1] & below(B, 1)) + __builtin_popcount(E[2] & below(B, 2)) + __builtin_popcount(E[3] & below(B, 3))));
        };
        int lo = 0, hi = 127;
#pragma unroll 1
        while (lo < hi) { const int mid = (lo + hi) >> 1; if (ties_below(mid + 1) >= need) hi = mid; else lo = mid + 1; }
        const int Bs = lo, r = need - ties_below(Bs);
        const unsigned ew = Bs < 32 ? E[0] : (Bs < 64 ? E[1] : (Bs < 96 ? E[2] : E[3]));
        const bool tb = ((ew >> (Bs & 31)) & 1u) != 0u;
        const unsigned long long em = __ballot(tb);
        const bool take_row = tb && __builtin_popcountll(em & ((1ull << lane) - 1ull)) < r;
#pragma unroll
        for (int c = 0; c < 4; ++c) {
            unsigned tk = E[c] & below(Bs, c);
            if ((Bs >> 5) == c && take_row) tk |= 1u << (Bs & 31);
            M[c] = G[c] | tk;
        }
    }
    const int kl = __builtin_popcount(M[0]) + __builtin_popcount(M[1]) + __builtin_popcount(M[2]) + __builtin_popcount(M[3]);
    int wp = wave_incl_scan(kl, lane) - kl;
#pragma unroll
    for (int c = 0; c < 4; ++c) {
        unsigned m = M[c];
        while (m) { const int b = __builtin_ctz(m); list[wp] = (u16)((32 * c + b) * 64 + lane); ++wp; m &= m - 1u; }
    }
}

DI void attend(const Args& a, size_t brow, int t, int cnt, LAS const u16* list, LAS unsigned char* img, int lane, int fr, int fq) {
    const u16* Q = (const u16*)(a.ws + WS_Q); const u16* KVN = (const u16*)(a.ws + WS_KVN); u16* YO = (u16*)(a.ws + WS_YO);
    bf16x8 qf[4];
    {
        const int head = fr & 7;
        const u16* qrow = Q + (brow + t) * 1024 + head * 128;
        float f[4][8]; float ss = 0.f;
#pragma unroll
        for (int ks = 0; ks < 4; ++ks) {
            const u32x4 raw = *(const u32x4*)(qrow + ks * 32 + 8 * fq);
            f[ks][0] = bflo(raw.x); f[ks][1] = bfhi(raw.x); f[ks][2] = bflo(raw.y); f[ks][3] = bfhi(raw.y); f[ks][4] = bflo(raw.z); f[ks][5] = bfhi(raw.z); f[ks][6] = bflo(raw.w); f[ks][7] = bfhi(raw.w);
#pragma unroll
            for (int j = 0; j < 8; ++j) ss += f[ks][j] * f[ks][j];
        }
        ss += __shfl_xor(ss, 16); ss += __shfl_xor(ss, 32);
        const float rq = __builtin_amdgcn_rsqf(ss * (1.0f / 128.0f) + EPS) * (0.08838834764831845f * 1.4426950408889634f);
#pragma unroll
        for (int ks = 0; ks < 4; ++ks) {
            const float* qg = a.in[I_QNG] + ks * 32 + 8 * fq;
            u32x4 w;
            w.x = pk2(f[ks][0] * rq * qg[0], f[ks][1] * rq * qg[1]); w.y = pk2(f[ks][2] * rq * qg[2], f[ks][3] * rq * qg[3]);
            w.z = pk2(f[ks][4] * rq * qg[4], f[ks][5] * rq * qg[5]); w.w = pk2(f[ks][6] * rq * qg[6], f[ks][7] * rq * qg[7]);
            qf[ks] = __builtin_bit_cast(bf16x8, w);
        }
    }
    const int nsteps = (cnt + 31) >> 5;
    f32x4 oacc[8];
#pragma unroll
    for (int i = 0; i < 8; ++i) oacc[i] = (f32x4){0.f, 0.f, 0.f, 0.f};
    float mrun = -3.0e38f, lpart = 0.f;
    const char* kvb = (const char*)(KVN + brow * 128);
    auto issue = [&](u32x4 (&pf)[8], int pp) {
#pragma unroll
        for (int it = 0; it < 8; ++it) { const int piece = it * 64 + lane; const unsigned key = list[pp * 32 + (piece >> 4)]; pf[it] = *(const u32x4*)(kvb + (key * 256u + 16u * (unsigned)(piece & 15))); }
    };
    auto step = [&](u32x4 (&pf)[8], int pp) {
#pragma unroll
        for (int it = 0; it < 8; ++it) { const int piece = it * 64 + lane; *(LAS u32x4*)(img + (piece >> 4) * 288 + (piece & 15) * 16) = pf[it]; }
        if (pp + 2 < nsteps) issue(pf, pp + 2);
        wave_lds_sync();
        __builtin_amdgcn_sched_barrier(0);
        f32x4 sa = {0.f, 0.f, 0.f, 0.f}, sb = {0.f, 0.f, 0.f, 0.f};
#pragma unroll
        for (int ks = 0; ks < 4; ++ks) {
            const bf16x8 a0 = *(LAS const bf16x8*)(img + fr * 288 + (ks * 32 + 8 * fq) * 2), a1 = *(LAS const bf16x8*)(img + (16 + fr) * 288 + (ks * 32 + 8 * fq) * 2);
            sa = __builtin_amdgcn_mfma_f32_16x16x32_bf16(a0, qf[ks], sa, 0, 0, 0); sb = __builtin_amdgcn_mfma_f32_16x16x32_bf16(a1, qf[ks], sb, 0, 0, 0);
            if (ks == 1) __builtin_amdgcn_sched_barrier(0);
        }
        if (pp * 32 + 32 > cnt) {
            const int pb0 = pp * 32 + 4 * fq;
#pragma unroll
            for (int r = 0; r < 4; ++r) { if (pb0 + r >= cnt) sa[r] = -3.0e38f; if (pb0 + 16 + r >= cnt) sb[r] = -3.0e38f; }
        }
        float mx = fmaxf(fmaxf(fmaxf(sa[0], sa[1]), fmaxf(sa[2], sa[3])), fmaxf(fmaxf(sb[0], sb[1]), fmaxf(sb[2], sb[3])));
        mx = fmaxf(mx, __shfl_xor(mx, 16)); mx = fmaxf(mx, __shfl_xor(mx, 32));
        if (__ballot(mx > mrun) != 0ull) {
            const float mnew = fmaxf(mrun, mx), alpha = __builtin_amdgcn_exp2f(mrun - mnew);
            mrun = mnew; lpart *= alpha;
#pragma unroll
            for (int cb = 0; cb < 8; ++cb) oacc[cb] *= alpha;
        }
        float ps = 0.f;
#pragma unroll
        for (int r = 0; r < 4; ++r) { sa[r] = __builtin_amdgcn_exp2f(sa[r] - mrun); sb[r] = __builtin_amdgcn_exp2f(sb[r] - mrun); ps += sa[r] + sb[r]; }
        lpart += ps;
        u32x4 pw; pw.x = pk2(sa[0], sa[1]); pw.y = pk2(sa[2], sa[3]); pw.z = pk2(sb[0], sb[1]); pw.w = pk2(sb[2], sb[3]);
        const bf16x8 pb = __builtin_bit_cast(bf16x8, pw);
#pragma unroll
        for (int cb = 0; cb < 8; ++cb) {
            const s16x4 r0 = __builtin_amdgcn_ds_read_tr16_b64_v4i16((LAS s16x4*)(img + (4 * fq + (fr >> 2)) * 288 + (cb * 16 + 4 * (fr & 3)) * 2));
            const s16x4 r1 = __builtin_amdgcn_ds_read_tr16_b64_v4i16((LAS s16x4*)(img + (16 + 4 * fq + (fr >> 2)) * 288 + (cb * 16 + 4 * (fr & 3)) * 2));
            const bf16x8 av = {r0[0], r0[1], r0[2], r0[3], r1[0], r1[1], r1[2], r1[3]};
            oacc[cb] = __builtin_amdgcn_mfma_f32_16x16x32_bf16(av, pb, oacc[cb], 0, 0, 0);
            if (cb == 3) __builtin_amdgcn_sched_barrier(0);
        }
        wave_lds_sync();
    };
    u32x4 pf0[8], pf1[8];
    issue(pf0, 0);
    if (nsteps > 1) issue(pf1, 1);
#pragma unroll 1
    for (int pp = 0; pp < nsteps; pp += 2) {
        step(pf0, pp);
        if (pp + 1 < nsteps) step(pf1, pp + 1);
    }
    float lsum = lpart; lsum += __shfl_xor(lsum, 16); lsum += __shfl_xor(lsum, 32);
    const float inv = __builtin_amdgcn_rcpf(lsum);
    if (fr < 8) {
        u16* orow = YO + (brow + t) * 1536 + 512 + fr * 128 + 4 * fq;
#pragma unroll
        for (int cb = 0; cb < 8; ++cb) { u32x2 w; w.x = pk2(oacc[cb][0] * inv, oacc[cb][1] * inv); w.y = pk2(oacc[cb][2] * inv, oacc[cb][3] * inv); *(u32x2*)(orow + cb * 16) = w; }
    }
}

constexpr int N_CVT_JOBS = 32 * 16 * 32 + 32 * 16 * 16;
DI void cvt_job(const Args& a, LAS float* t, int J, int lane) {
    if (J >= N_CVT_JOBS) return;
    const float* src; const float* sk; unsigned char* dst; int ld, k0, n0, row;
    if (J < 16384) {
        const int e = J >> 9, w = J & 511; src = a.in[I_WE1] + (size_t)e * 1024 * 2048; ld = 2048; k0 = (w >> 5) * 64; n0 = (w & 31) * 64; sk = a.in[I_N2G]; dst = a.ws + WS_WE1 + (size_t)e * 2048 * 1024;
        const int n = n0 + lane, hi = n >= 1024 ? 1 : 0, q = n - hi * 1024; row = (q >> 7) * 256 + hi * 128 + (q & 127);
    } else {
        const int j = J - 16384, e = j >> 8, w = j & 255; src = a.in[I_WE2] + (size_t)e * 1024 * 1024; ld = 1024; k0 = (w >> 4) * 64; n0 = (w & 15) * 64; sk = nullptr; dst = a.ws + WS_WE2 + (size_t)e * 1024 * 1024;
        row = n0 + lane;
    }
    const int kl = lane >> 4, n4 = 4 * (lane & 15);
    f32x4 v[4][4];
#pragma unroll
    for (int ks = 0; ks < 4; ++ks)
#pragma unroll
        for (int i = 0; i < 4; ++i) v[ks][i] = __builtin_nontemporal_load((const f32x4*)(src + (size_t)(k0 + ks * 16 + kl + 4 * i) * ld + n0 + n4));
    unsigned char* drow = dst + (size_t)row * 1024 + k0;
#pragma unroll
    for (int ks = 0; ks < 4; ++ks) {
#pragma unroll
        for (int i = 0; i < 4; ++i) { const float sc = (sk ? sk[k0 + ks * 16 + kl + 4 * i] : 1.0f) * 64.0f; *(LAS f32x4*)(t + (kl + 4 * i) * 64 + n4) = v[ks][i] * sc; }
        wave_lds_sync();
        float c[16];
#pragma unroll
        for (int k = 0; k < 16; ++k) c[k] = t[k * 64 + lane];
        u32x4 w; w.x = pk4_fp8(c[0], c[1], c[2], c[3]); w.y = pk4_fp8(c[4], c[5], c[6], c[7]); w.z = pk4_fp8(c[8], c[9], c[10], c[11]); w.w = pk4_fp8(c[12], c[13], c[14], c[15]);
        *(u32x4*)(drow + ks * 16) = w;
        wave_lds_sync();
    }
}

DI void dsa_phase(const Args& a, LAS unsigned char* lds) {
    unsigned char* ws = a.ws;
    const int wid = __builtin_amdgcn_readfirstlane(otid() >> 6);
    LAS u16* rows = (LAS u16*)(lds + P3_ROWS);
    bool bprev = false; size_t pbrow = 0; int pt0 = 0, bbuf = 0;
    for (int gi = blockIdx.x; gi < T / 8; gi += gridDim.x) {
        const int lane = otid() & 63, fr = lane & 15, fq = lane >> 4;
        const int b = gi & 3, t0 = S - 8 - 8 * (gi >> 2);
        const size_t brow = (size_t)b * S;
        const int ntile = (t0 + 8 + 15) >> 4;
        __syncthreads();
        {
            const unsigned char* QI = (const unsigned char*)(ws + WS_QI); const unsigned char* KIN = (const unsigned char*)(ws + WS_KIN); const float* WI = (const float*)(ws + WS_WI);
            typedef int i32x4_t __attribute__((ext_vector_type(4)));
            i32x4_t qa[2]; f32x4 wi[2];
#pragma unroll
            for (int rg = 0; rg < 2; ++rg) {
                qa[rg] = *(const i32x4_t*)(QI + (brow + t0 + 4 * rg + (fr >> 2)) * 256 + (fr & 3) * 64 + 16 * fq);
                wi[rg] = *(const f32x4*)(WI + (brow + t0 + 4 * rg + fq) * 4);
            }
            auto ldk = [&](i32x4_t (&kf)[4], int jt0) {
#pragma unroll
                for (int u = 0; u < 4; ++u) {
                    const int jt = (jt0 + 8 * u) < ntile ? (jt0 + 8 * u) : (ntile - 1);
                    kf[u] = *(const i32x4_t*)(KIN + (brow + jt * 16 + fr) * 64 + 16 * fq);
                }
            };
            auto cmpk = [&](const i32x4_t (&kf)[4], int jt0) {
#pragma unroll
                for (int u = 0; u < 4; ++u) {
                    const int jt = jt0 + 8 * u;
                    if (jt < ntile) {
#pragma unroll
                        for (int rg = 0; rg < 2; ++rg) {
                            i32x4_t d = {0, 0, 0, 0};
                            d = __builtin_amdgcn_mfma_i32_16x16x64_i8(qa[rg], kf[u], d, 0, 0, 0);
                            const float sc = (((float)max(d[0], 0) * wi[rg][0] + (float)max(d[1], 0) * wi[rg][1]) + (float)max(d[2], 0) * wi[rg][2]) + (float)max(d[3], 0) * wi[rg][3];
                            rows[(4 * rg + fq) * 8192 + rowaddr(jt * 16 + fr)] = (u16)(f2key(sc) >> 16);
                        }
                    }
                }
            };
            i32x4_t kA[4], kB[4];
            if (wid < ntile) ldk(kA, wid);
            for (int jt0 = wid; jt0 < ntile; jt0 += 64) {
                const bool hasB = jt0 + 32 < ntile;
                if (hasB) ldk(kB, jt0 + 32);
                cmpk(kA, jt0);
                if (hasB) { if (jt0 + 64 < ntile) ldk(kA, jt0 + 64); cmpk(kB, jt0 + 32); }
            }
        }
        __syncthreads();
        if (wid < 4) {
            u32x4 kr[16];
            const int N0 = t0 + wid + 1, N1 = N0 + 4;
            if (N0 > 256) keys_load(rows + wid * 8192, N0, lane, kr);
            __syncthreads();
            LAS u16* l0 = (LAS u16*)(lds + (bbuf ? P3_HIST : P3_LIST) + wid * 512);
            LAS u16* l1 = l0 + 4 * 256;
            if (N0 > 256) keys_select(kr, l0, N0, lane); else { for (int p = lane; p < 256; p += 64) l0[p] = p < N0 ? (u16)p : (u16)0; }
            if (N1 > 256) { keys_load(rows + (wid + 4) * 8192, N1, lane, kr); keys_select(kr, l1, N1, lane); } else { for (int p = lane; p < 256; p += 64) l1[p] = p < N1 ? (u16)p : (u16)0; }
            {
                const int G3 = gridDim.x, c3 = blockIdx.x, it3 = (gi - c3) / G3, ntrip = (T / 8 - c3 + G3 - 1) / G3, jtot = (N_CVT_JOBS + 4 * G3 - 1) / (4 * G3);
                const int jlo = (jtot * it3 + ntrip - 1) / ntrip, jhi = (jtot * (it3 + 1) + ntrip - 1) / ntrip;
                LAS float* tcv = (LAS float*)(lds + (wid < 3 ? 135168 + wid * 4096 : 151552));
#pragma unroll 1
                for (int j = jlo; j < jhi; ++j) cvt_job(a, tcv, (j * 4 + wid) * G3 + c3, lane);
            }
        } else {
            __syncthreads();
            if (bprev) {
                LAS const u16* lp = (LAS const u16*)(lds + (bbuf ? P3_LIST : P3_HIST));
                LAS unsigned char* img = (LAS unsigned char*)(rows + (wid - 4) * 8192);
                { const int q = wid - 4, t = pt0 + q; attend(a, pbrow, t, t + 1 < 256 ? t + 1 : 256, lp + q * 256, img, lane, fr, fq); }
                { const int q = wid, t = pt0 + q; attend(a, pbrow, t, t + 1 < 256 ? t + 1 : 256, lp + q * 256, img, lane, fr, fq); }
            }
        }
        bprev = true; pbrow = brow; pt0 = t0; bbuf ^= 1;
    }
    __syncthreads();
    if (bprev) {
        const int lane = otid() & 63, fr = lane & 15, fq = lane >> 4;
        LAS const u16* lp = (LAS const u16*)(lds + (bbuf ? P3_LIST : P3_HIST));
        const int q = wid, t = pt0 + q;
        attend(a, pbrow, t, t + 1 < 256 ? t + 1 : 256, lp + q * 256, (LAS unsigned char*)(rows + wid * 8192), lane, fr, fq);
    }
}

constexpr int P6_LCNT = 0, P6_BASE = 128, P6_RSB = 256, P6_RI = 1024;
DI unsigned dpp_max_u32(unsigned v) {
    v = max(v, (unsigned)__builtin_amdgcn_update_dpp(0, (int)v, 0xB1, 0xf, 0xf, false));
    v = max(v, (unsigned)__builtin_amdgcn_update_dpp(0, (int)v, 0x4E, 0xf, 0xf, false));
    v = max(v, (unsigned)__builtin_amdgcn_update_dpp(0, (int)v, 0x141, 0xf, 0xf, false));
    v = max(v, (unsigned)__builtin_amdgcn_update_dpp(0, (int)v, 0x140, 0xf, 0xf, false));
    return v;
}
DI float key2f(unsigned k) { return __uint_as_float((k & 0x80000000u) ? (k & 0x7fffffffu) : ~k); }
DI void router_phase(const Args& a, LAS unsigned char* lds) {
    unsigned char* ws = a.ws;
    const int tid = otid(), wid = tid >> 6, lane = tid & 63, fr = lane & 15, fq = lane >> 4;
    LAS int* lcnt = (LAS int*)(lds + P6_LCNT); LAS int* lbase = (LAS int*)(lds + P6_BASE); LAS float* rsb = (LAS float*)(lds + P6_RSB); LAS int* RI = (LAS int*)(lds + P6_RI);
    const u16* WRH = (const u16*)(ws + WS_WR);
    unsigned* CNT = (unsigned*)(ws + WS_CTL);
    LAS unsigned char* WL = lds + 16384;
    __syncthreads();
    for (int i = tid; i < 64 * 128; i += NT) { const int r = i >> 7, p = i & 127; *(LAS u32x4*)(WL + r * 2064 + p * 16) = *(const u32x4*)(WRH + (size_t)r * 1024 + p * 8); }
    for (int rg = blockIdx.x; rg < T / 128; rg += gridDim.x) {
        __syncthreads();
        if (tid < 32) lcnt[tid] = 0;
        __syncthreads();
        {
            const int row = rg * 128 + wid * 16 + fr;
            const float* xr = a.out + (size_t)row * 1024 + 8 * fq;
            f32x4 acc[2] = {{0.f, 0.f, 0.f, 0.f}, {0.f, 0.f, 0.f, 0.f}};
            float ss = 0.f;
#pragma unroll 4
            for (int ks = 0; ks < 32; ++ks) {
                const f32x4 x0 = *(const f32x4*)(xr + ks * 32), x1 = *(const f32x4*)(xr + ks * 32 + 4);
                ss += ((x0[0] * x0[0] + x0[1] * x0[1]) + (x0[2] * x0[2] + x0[3] * x0[3])) + ((x1[0] * x1[0] + x1[1] * x1[1]) + (x1[2] * x1[2] + x1[3] * x1[3]));
                u32x4 hw; hw.x = pk2(x0[0], x0[1]); hw.y = pk2(x0[2], x0[3]); hw.z = pk2(x1[0], x1[1]); hw.w = pk2(x1[2], x1[3]);
                u32x4 lw; lw.x = pk2(x0[0] - bflo(hw.x), x0[1] - bfhi(hw.x)); lw.y = pk2(x0[2] - bflo(hw.y), x0[3] - bfhi(hw.y)); lw.z = pk2(x1[0] - bflo(hw.z), x1[1] - bfhi(hw.z)); lw.w = pk2(x1[2] - bflo(hw.w), x1[3] - bfhi(hw.w));
                const bf16x8 xh = __builtin_bit_cast(bf16x8, hw), xl = __builtin_bit_cast(bf16x8, lw);
#pragma unroll
                for (int nt = 0; nt < 2; ++nt) {
                    const bf16x8 wh = *(LAS const bf16x8*)(WL + (nt * 16 + fr) * 2064 + (ks * 32 + 8 * fq) * 2), wl = *(LAS const bf16x8*)(WL + (32 + nt * 16 + fr) * 2064 + (ks * 32 + 8 * fq) * 2);
                    acc[nt] = __builtin_amdgcn_mfma_f32_16x16x32_bf16(xh, wh, acc[nt], 0, 0, 0);
                    acc[nt] = __builtin_amdgcn_mfma_f32_16x16x32_bf16(xl, wh, acc[nt], 0, 0, 0);
                    acc[nt] = __builtin_amdgcn_mfma_f32_16x16x32_bf16(xh, wl, acc[nt], 0, 0, 0);
                }
            }
            ss += __shfl_xor(ss, 16); ss += __shfl_xor(ss, 32);
            const float rsrow = __builtin_amdgcn_rsqf(ss * (1.0f / 1024.0f) + EPS);
            if (fq == 0) rsb[wid * 16 + fr] = rsrow;
            {
                unsigned char* xn = ws + WS_XN2 + (size_t)row * 1024 + 8 * fq;
#pragma unroll 4
                for (int ks = 0; ks < 32; ++ks) {
                    const f32x4 x0 = *(const f32x4*)(xr + ks * 32), x1 = *(const f32x4*)(xr + ks * 32 + 4);
                    u32x2 w; w.x = pk4_fp8(x0[0] * rsrow, x0[1] * rsrow, x0[2] * rsrow, x0[3] * rsrow); w.y = pk4_fp8(x1[0] * rsrow, x1[1] * rsrow, x1[2] * rsrow, x1[3] * rsrow);
                    *(u32x2*)(xn + ks * 32) = w;
                }
            }
            wave_lds_sync();
            const float b0 = a.in[I_BR][fr], b1 = a.in[I_BR][16 + fr];
#pragma unroll
            for (int r = 0; r < 4; ++r) {
                const float rs = rsb[wid * 16 + 4 * fq + r];
                unsigned k0 = (f2key(acc[0][r] * rs + b0) & ~31u) | (unsigned)(31 - fr), k1 = (f2key(acc[1][r] * rs + b1) & ~31u) | (unsigned)(15 - fr);
                unsigned sel[4];
#pragma unroll
                for (int k = 0; k < 4; ++k) {
                    const unsigned best = dpp_max_u32(k0 > k1 ? k0 : k1);
                    sel[k] = best;
                    if (k0 == best) k0 = 0u;
                    if (k1 == best) k1 = 0u;
                }
                const float v0 = key2f(sel[0] & ~31u), e1 = __expf(key2f(sel[1] & ~31u) - v0), e2 = __expf(key2f(sel[2] & ~31u) - v0), e3 = __expf(key2f(sel[3] & ~31u) - v0);
                const float inv = 1.0f / (1.0f + e1 + e2 + e3);
                if (fr < 4) {
                    const unsigned sk = fr == 0 ? sel[0] : (fr == 1 ? sel[1] : (fr == 2 ? sel[2] : sel[3]));
                    const int e = 31 - (int)(sk & 31u);
                    const float gt = (fr == 0 ? 1.0f : (fr == 1 ? e1 : (fr == 2 ? e2 : e3))) * inv;
                    const int ls = __hip_atomic_fetch_add(lcnt + e, 1, __ATOMIC_RELAXED, __HIP_MEMORY_SCOPE_WORKGROUP);
                    const int ri = ((wid * 16 + 4 * fq + r) * 4 + fr) * 4;
                    RI[ri + 0] = e; RI[ri + 1] = ls; RI[ri + 2] = __float_as_int(gt);
                }
            }
        }
        __syncthreads();
        if (tid < 32) lbase[tid] = (int)__hip_atomic_fetch_add(CNT + tid, (unsigned)lcnt[tid], __ATOMIC_RELAXED, __HIP_MEMORY_SCOPE_AGENT);
        __syncthreads();
        {
            const int rl = tid >> 2, k = tid & 3, row = rg * 128 + rl;
            const int e = RI[tid * 4 + 0], slot = lbase[e] + RI[tid * 4 + 1];
            ((int*)(ws + WS_LTOK))[(size_t)e * ECAP + slot] = row;
            ((float*)(ws + WS_LRS))[(size_t)row * 4 + k] = __int_as_float(RI[tid * 4 + 2]);
            ((unsigned*)(ws + WS_ROUTE))[(size_t)row * 4 + k] = ((unsigned)e << 16) | (unsigned)slot;
        }
    }
}

DI void combine_phase(const Args& a, LAS unsigned char* lds) {
    unsigned char* ws = a.ws;
    LAS const int* tab = (LAS const int*)(lds + MOE_TAB);
    const int tid = otid(), wid = tid >> 6, lane = tid & 63;
    const u16* YB = (const u16*)(ws + WS_YB); const unsigned* ROUTE = (const unsigned*)(ws + WS_ROUTE);
    for (int row = blockIdx.x * 8 + wid; row < T; row += gridDim.x * 8) {
        size_t pos[4];
#pragma unroll
        for (int k = 0; k < 4; ++k) { const unsigned r = ROUTE[(size_t)row * 4 + k]; const int e = (int)(r >> 16), slot = (int)(r & 0xffffu); pos[k] = (size_t)tab[e] * 256 + slot; }
        float* orow = a.out + (size_t)row * 1024;
        const f32x4 gt = *(const f32x4*)((const float*)(ws + WS_LRS) + (size_t)row * 4);
#pragma unroll
        for (int i = 0; i < 4; ++i) {
            f32x4 v = *(const f32x4*)(orow + i * 256 + lane * 4);
#pragma unroll
            for (int k = 0; k < 4; ++k) { const u32x2 y = __builtin_nontemporal_load((const u32x2*)(YB + pos[k] * 1024 + i * 256 + lane * 4)); v[0] += gt[k] * bflo(y.x); v[1] += gt[k] * bfhi(y.x); v[2] += gt[k] * bflo(y.y); v[3] += gt[k] * bfhi(y.y); }
            *(f32x4*)(orow + i * 256 + lane * 4) = v;
        }
    }
}

#define XB_TMO      128
#define XB_XCNT(j)  (256  + 64 * (j))
#define XB_XSUB(j)  (1280 + 64 * (j))
#define XB_XGEN(j)  (2304 + 64 * (j))
#define XB_TOP      3328
#define XB_TOPGEN   3392
#define XCD_BAR_WORDS 3456
#define XB_SPIN_CAP (1u << 18)

__device__ __forceinline__ unsigned xb_ld(unsigned* p)              { return __hip_atomic_load(p, __ATOMIC_RELAXED, __HIP_MEMORY_SCOPE_AGENT); }
__device__ __forceinline__ unsigned xb_add(unsigned* p, unsigned v) { return __hip_atomic_fetch_add(p, v, __ATOMIC_RELAXED, __HIP_MEMORY_SCOPE_AGENT); }
__device__ __forceinline__ unsigned xb_xcc_id() { return (unsigned)__builtin_amdgcn_s_getreg((3 << 11) | 20) & 0xFu; }
#define XB_SPIN(cond, bar) do { unsigned _sp = 0; while (cond) { __builtin_amdgcn_s_sleep(1); \
    if ((++_sp & 255u) == 0u) { if (xb_ld(&(bar)[XB_TMO])) break; if (_sp > XB_SPIN_CAP) { atomicAdd(&(bar)[XB_TMO], 1u); break; } } } } while (0)

struct XcdBarrier {
    unsigned* bar; unsigned x;
    volatile LAS unsigned* st;
};

__device__ __forceinline__ XcdBarrier xcd_barrier_post(unsigned* bar, volatile LAS unsigned* st) {
    XcdBarrier b; b.bar = bar; b.x = xb_xcc_id(); b.st = st;
    if (threadIdx.x == 0) (void)xb_add(&bar[XB_XCNT(b.x)], 1u);
    return b;
}
__device__ __forceinline__ void xcd_barrier_complete(unsigned* bar, unsigned x, unsigned& nloc, unsigned& nx) {
    const unsigned G = gridDim.x * gridDim.y * gridDim.z;
    unsigned sum, cnt, mine, sp = 0u;
    for (;;) {
        sum = 0u; cnt = 0u; mine = 0u;
#pragma unroll
        for (unsigned j = 0; j < 16; ++j) { const unsigned c = xb_ld(&bar[XB_XCNT(j)]); sum += c; cnt += (c > 0u) ? 1u : 0u; mine = (j == x) ? c : mine; }
        if (sum == G) break;
        __builtin_amdgcn_s_sleep(1);
        if ((++sp & 255u) == 0u) { if (xb_ld(&bar[XB_TMO])) break; if (sp > XB_SPIN_CAP) { atomicAdd(&bar[XB_TMO], 1u); break; } }
    }
    nloc = mine > 0u ? mine : 1u; nx = cnt > 0u ? cnt : 1u;
}

__device__ __forceinline__ void xcd_barrier(const XcdBarrier& b) {
    asm volatile("s_waitcnt vmcnt(0)" ::: "memory");
    __syncthreads();
    if (threadIdx.x == 0) {
        unsigned* bar = b.bar;
        __builtin_amdgcn_s_waitcnt(0);
        unsigned nloc = b.st[0], nx = b.st[1];
        if (nloc == 0u) { xcd_barrier_complete(bar, b.x, nloc, nx); b.st[0] = nloc; b.st[1] = nx; }
        const unsigned old = xb_add(&bar[XB_XSUB(b.x)], 1u);
        const unsigned gen = old / nloc;
        if (old + 1u == (gen + 1u) * nloc) {
            __builtin_amdgcn_fence(__ATOMIC_RELEASE, "agent");
            asm volatile("s_waitcnt vmcnt(0)" ::: "memory");
            const unsigned og = xb_add(&bar[XB_TOP], 1u);
            const unsigned tg = og / nx;
            if (og + 1u == (tg + 1u) * nx) xb_add(&bar[XB_TOPGEN], 1u);
            else XB_SPIN(xb_ld(&bar[XB_TOPGEN]) == tg, bar);
            __builtin_amdgcn_fence(__ATOMIC_ACQUIRE, "agent");
            xb_add(&bar[XB_XGEN(b.x)], 1u);
            asm volatile("s_waitcnt vmcnt(0)" ::: "memory");
        } else {
            XB_SPIN(xb_ld(&bar[XB_XGEN(b.x)]) == gen, bar);
            __builtin_amdgcn_fence(__ATOMIC_ACQUIRE, "agent");
            asm volatile("s_waitcnt vmcnt(0)" ::: "memory");
        }
    }
    __syncthreads();
}

__global__ void __launch_bounds__(NT, 2) fwd(Args a) {
    extern __shared__ __attribute__((aligned(16))) unsigned char lds_raw[];
    LAS unsigned char* lds = (LAS unsigned char*)lds_raw;
    cg::grid_group grid = cg::this_grid();
    unsigned char* ws = a.ws;
    const int G = gridDim.x, c = blockIdx.x;
    if (threadIdx.x < 2) ((volatile LAS unsigned*)(lds + LDS_BARST))[threadIdx.x] = 0u;
    __syncthreads();
    const XcdBarrier xbar = xcd_barrier_post((unsigned*)(ws + WS_BAR), (volatile LAS unsigned*)(lds + LDS_BARST));

    phase0(a, lds);
    xcd_barrier(xbar);
    {
        g8::PlainSched s; s.Abase = (const char*)(ws + WS_XB); s.Bbase = (const char*)(ws + WS_WIN); s.lda = 1024; s.ldb = 1024; s.K = 1024; s.nM = T / 256; s.nN = NIN / 256; s.G = G; s.c = c;
        EpiIn e; e.H = (u16*)(ws + WS_H); e.rs1 = (const float*)(ws + WS_RS1); e.SSQ = (float*)(ws + WS_SSQ); e.WI = (float*)(ws + WS_WI);
        g8::gemm_phase(lds, s, e);
    }
    xcd_barrier(xbar);
    {
        g8::PlainSched s; s.Abase = (const char*)(ws + WS_H) + 1024 * 2; s.Bbase = (const char*)(ws + WS_WQ); s.lda = NIN; s.ldb = 256; s.K = 256; s.nM = T / 256; s.nN = 5; s.G = G; s.c = c;
        EpiQ e; e.Q = (u16*)(ws + WS_Q); e.QI = (u16*)(ws + WS_QI); e.SSQ = (const float*)(ws + WS_SSQ);
        g8::gemm_phase(lds, s, e);
        for (int u = c; u < 1024; u += G) gmlp_unit(a, lds, u);
        kvnorm(a);
    }
    xcd_barrier(xbar);
    dsa_phase(a, lds);
    xcd_barrier(xbar);
    {
        g8::PlainSched s; s.Abase = (const char*)(ws + WS_YO); s.Bbase = (const char*)(ws + WS_WCAT); s.lda = 1536; s.ldb = 1536; s.K = 512; s.nM = T / 256; s.nN = 4; s.G = G; s.c = c;
        EpiMrg<0> e0; e0.OUT = (u16*)(ws + WS_TMP); e0.TMP = nullptr; e0.H = (const u16*)(ws + WS_H);
        g8::gemm_phase(lds, s, e0);
        s.Abase = (const char*)(ws + WS_YO) + 512 * 2; s.Bbase = (const char*)(ws + WS_WCAT) + 512 * 2; s.K = 1024;
        EpiMrg<1> e1; e1.OUT = (u16*)(ws + WS_MRG); e1.TMP = (const u16*)(ws + WS_TMP); e1.H = (const u16*)(ws + WS_H);
        g8::gemm_phase(lds, s, e1);
    }
    xcd_barrier(xbar);
    {
        g8::PlainSched s; s.Abase = (const char*)(ws + WS_MRG); s.Bbase = (const char*)(ws + WS_WOUT); s.lda = 1024; s.ldb = 1024; s.K = 1024; s.nM = T / 256; s.nN = 4; s.G = G; s.c = c;
        EpiOut e; e.out = a.out; e.x = a.in[I_X];
        g8::gemm_phase(lds, s, e);
    }
    xcd_barrier(xbar);
    router_phase(a, lds);
    xcd_barrier(xbar);
    moe_table(lds, (const unsigned*)(ws + WS_CTL));
    {
        MoeSched<8, true> s; s.Abase = (const char*)(ws + WS_XN2); s.Wbase = (const char*)(ws + WS_WE1); s.LTOK = (const int*)(ws + WS_LTOK); s.tab = (LAS const int*)(lds + MOE_TAB);
        s.lda = 1024; s.ldb = 1024; s.K = 1024; s.G = G; s.c = c; s.wstride = (size_t)2048 * 1024;
        EpiMoe1 e; e.ACT = (unsigned char*)(ws + WS_ACT); e.b1 = a.in[I_BE1];
        g8::gemm_phase<true>(lds, s, e);
    }
    xcd_barrier(xbar);
    {
        MoeSched<4, false> s; s.Abase = (const char*)(ws + WS_ACT); s.Wbase = (const char*)(ws + WS_WE2); s.LTOK = nullptr; s.tab = (LAS const int*)(lds + MOE_TAB);
        s.lda = 1024; s.ldb = 1024; s.K = 1024; s.G = G; s.c = c; s.wstride = (size_t)1024 * 1024;
        EpiMoe2 e; e.YB = (u16*)(ws + WS_YB); e.b2 = a.in[I_BE2];
        g8::gemm_phase<true>(lds, s, e);
    }
    xcd_barrier(xbar);
    combine_phase(a, lds);
    if (a.mask == 0u) grid.sync();
}

extern "C" void kernel_launch(void* const* d_in, const int* in_sizes, int n_in, void* d_out, int out_size, void* d_ws, size_t ws_size, hipStream_t stream) {
    static int grid = 0;
    if (grid == 0) {
        int dev = 0, cus = 0, per_cu = 0;
        if (n_in != 23 || out_size != T * Dm || ws_size < WS_END) { fprintf(stderr, "kernel_launch: unexpected problem (n_in %d, out %d, ws %zu < %zu)\n", n_in, out_size, ws_size, (size_t)WS_END); grid = -1; return; }
        if (hipGetDevice(&dev) != hipSuccess || hipDeviceGetAttribute(&cus, hipDeviceAttributeMultiprocessorCount, dev) != hipSuccess) { grid = -1; return; }
        if (hipFuncSetAttribute((const void*)fwd, hipFuncAttributeMaxDynamicSharedMemorySize, LDS_BYTES) != hipSuccess) { fprintf(stderr, "hipFuncSetAttribute failed\n"); grid = -1; return; }
        if (hipOccupancyMaxActiveBlocksPerMultiprocessor(&per_cu, (const void*)fwd, NT, LDS_BYTES) != hipSuccess || per_cu < 1) { fprintf(stderr, "occupancy query failed (%d)\n", per_cu); grid = -1; return; }
        grid = cus;
        fprintf(stderr, "kernel_launch: cus %d per_cu %d grid %d ws %zu need %zu\n", cus, per_cu, grid, ws_size, (size_t)WS_END);
    }
    if (grid < 0) return;
    Args a{};
    for (int i = 0; i < 23; ++i) a.in[i] = (const float*)d_in[i];
    a.out = (float*)d_out; a.ws = (unsigned char*)d_ws; a.mask = 0xffffffffu; a.pad = 0u;
    if (hipMemsetAsync((char*)d_ws + WS_CTL, 0, 65536, stream) != hipSuccess) { fprintf(stderr, "memset failed\n"); return; }
    void* args[] = {&a};
    hipError_t e = hipLaunchCooperativeKernel((const void*)fwd, dim3(grid), dim3(NT), args, LDS_BYTES, stream);
    if (e != hipSuccess) fprintf(stderr, "cooperative launch failed: %s (grid %d)\n", hipGetErrorString(e), grid);
}
```

```cpp
#include <hip/hip_runtime.h>
#include <hip/hip_cooperative_groups.h>
#include <cstdio>
#include <cstdint>
namespace cg = cooperative_groups;

#define LAS __attribute__((address_space(3)))
#define DI __device__ __forceinline__
typedef unsigned short u16;
typedef short bf16x8 __attribute__((ext_vector_type(8)));
typedef short s16x4 __attribute__((ext_vector_type(4)));
typedef float f32x4 __attribute__((ext_vector_type(4)));
typedef float f32x2 __attribute__((ext_vector_type(2)));
typedef unsigned u32x4 __attribute__((ext_vector_type(4)));
typedef unsigned u32x2 __attribute__((ext_vector_type(2)));
typedef __bf16 bf2_t __attribute__((ext_vector_type(2)));
typedef int v8i_t __attribute__((ext_vector_type(8)));

constexpr int NT = 512;
constexpr int LDS_BYTES = 159744;
constexpr int Dm = 1024, Bsz = 4, S = 8192, T = Bsz * S;
constexpr int NIN = 3584;
constexpr int NE = 32, ECAP = 32768, PPAD = 131072 + NE * 256;
constexpr float EPS = 1e-6f;

constexpr size_t MiB = 1024 * 1024;
constexpr size_t WS_CTL = 0;
constexpr size_t WS_BAR = 16384;
constexpr int LDS_BARST = LDS_BYTES - 16;
constexpr size_t WS_WIN = 64 * 1024;
constexpr size_t WS_WQ = WS_WIN + (size_t)NIN * 1024 * 2;
constexpr size_t WS_WSP = WS_WQ + 1280 * 256 * 2;
constexpr size_t WS_WCAT = WS_WSP + 4 * 128 * 128 * 2;
constexpr size_t WS_WOUT = WS_WCAT + 1024 * 1536 * 2;
constexpr size_t WS_WR = WS_WOUT + 1024 * 1024 * 2;
constexpr size_t WS_WE1 = WS_WR + 32 * 1024 * 4;
constexpr size_t WS_WE2 = WS_WE1 + (size_t)32 * 2048 * 1024 * 2;
constexpr size_t WS_RS1 = WS_WE2 + (size_t)32 * 1024 * 1024 * 2;
constexpr size_t WS_SSQ = WS_RS1 + (size_t)T * 4;
constexpr size_t WS_WI = WS_SSQ + (size_t)T * 32 * 4;
constexpr size_t WS_ROUTE = WS_WI + (size_t)T * 4 * 4;
constexpr size_t WS_LTOK = WS_ROUTE + (size_t)T * 4 * 4;
constexpr size_t WS_LGATE = WS_LTOK + (size_t)NE * ECAP * 4;
constexpr size_t WS_LRS = WS_LGATE + (size_t)NE * ECAP * 4;
constexpr size_t WS_XN2 = WS_LRS + (size_t)NE * ECAP * 4;
constexpr size_t WS_R0 = WS_XN2 + (size_t)T * 1024 * 2;
constexpr size_t WS_XB = WS_R0;
constexpr size_t WS_H = WS_XB + (size_t)T * 1024 * 2;
constexpr size_t WS_Q = WS_H + (size_t)T * NIN * 2;
constexpr size_t WS_QI = WS_Q + (size_t)T * 1024 * 2;
constexpr size_t WS_KVN = WS_QI + (size_t)T * 256 * 2;
constexpr size_t WS_KIN = WS_KVN + (size_t)T * 128 * 2;
constexpr size_t WS_YO = WS_KIN + (size_t)T * 64 * 2;
constexpr size_t WS_TMP = WS_YO + (size_t)T * 1536 * 2;
constexpr size_t WS_MRG = WS_TMP + (size_t)T * 1024 * 2;
constexpr size_t WS_R0END = WS_MRG + (size_t)T * 1024 * 2;
constexpr size_t WS_ACT = WS_XB;
constexpr size_t WS_YB = WS_Q;
static_assert(WS_ACT + (size_t)PPAD * 1024 * 2 <= WS_Q, "ACT overlaps YB");
static_assert(WS_YB + (size_t)PPAD * 1024 * 2 <= WS_R0END, "YB too large");
constexpr size_t WS_END = WS_R0END;

struct Args { const float* in[23]; float* out; unsigned char* ws; unsigned mask; unsigned pad; };
enum { I_X = 0, I_N1G, I_WIN, I_QLG, I_WUQ, I_QNG, I_KVG, I_WUV, I_WQI, I_KIG, I_VG, I_WSP, I_BSP, I_WPA, I_WPB, I_WOUT, I_N2G, I_WR, I_BR, I_WE1, I_BE1, I_WE2, I_BE2 };

DI unsigned pk2(float a, float b) { f32x2 v = {a, b}; bf2_t r = __builtin_convertvector(v, bf2_t); return __builtin_bit_cast(unsigned, r); }
DI unsigned pk4_fp8(float a, float b, float c, float d) { unsigned w = 0u; w = (unsigned)__builtin_amdgcn_cvt_pk_fp8_f32(a, b, (int)w, false); w = (unsigned)__builtin_amdgcn_cvt_pk_fp8_f32(c, d, (int)w, true); return w; }
DI unsigned pk4_i8(float a, float b, float c, float d) {
    const int ia = (int)__builtin_rintf(fminf(fmaxf(a * 32.0f, -127.0f), 127.0f)), ib = (int)__builtin_rintf(fminf(fmaxf(b * 32.0f, -127.0f), 127.0f));
    const int ic = (int)__builtin_rintf(fminf(fmaxf(c * 32.0f, -127.0f), 127.0f)), id = (int)__builtin_rintf(fminf(fmaxf(d * 32.0f, -127.0f), 127.0f));
    return (unsigned)(ia & 0xff) | ((unsigned)(ib & 0xff) << 8) | ((unsigned)(ic & 0xff) << 16) | ((unsigned)(id & 0xff) << 24);
}
DI float bflo(unsigned u) { return __uint_as_float(u << 16); }
DI float bfhi(unsigned u) { return __uint_as_float(u & 0xffff0000u); }
DI u16 f2bf(float f) { return (u16)(pk2(f, 0.f) & 0xffffu); }
DI float bf2f(u16 h) { return __uint_as_float(((unsigned)h) << 16); }
DI float sigmoidf_(float x) { return __builtin_amdgcn_rcpf(1.0f + __expf(-x)); }
DI float gelu_tanh(float x) { const float u = 1.5957691216057308f * (x + 0.044715f * x * x * x); return x * sigmoidf_(u); }
DI float fast_sigmoid(float x) { return __builtin_amdgcn_rcpf(1.0f + __builtin_amdgcn_exp2f(x * -1.4426950408889634f)); }
DI float fast_gelu(float x) { const float p = __builtin_fmaf(x * x, -0.10294324f, -2.3022082f); return x * __builtin_amdgcn_rcpf(1.0f + __builtin_amdgcn_exp2f(x * p)); }
DI int otid() { int t = threadIdx.x; asm volatile("" : "+v"(t)); return t; }
DI void wave_lds_sync() { asm volatile("s_waitcnt lgkmcnt(0)" ::: "memory"); }

namespace g8 {
constexpr int BM = 256, BK = 64, HALF = 128, HTB = HALF * BK * 2, STAGE_BYTES = 8 * HTB, NXCD = 8, WGM = 8;
DI int lds_byte(int r, int c) { const int st = (r >> 4) * 2 + (c >> 5), rr = r & 15, cc = c & 31, ob = rr * 64 + cc * 2; return st * 1024 + (ob ^ (((ob >> 9) & 1) << 5)); }
DI int perm32(int rho) { const int n = rho >> 4, i = rho & 15; return 8 * (i >> 2) + 4 * n + (i & 3); }
DI void stage_rc(int b, int& R, int& C) { const int st = b / 1024, sb = b % 1024, swz = sb ^ (((sb >> 9) & 1) << 5); R = (st >> 1) * 16 + swz / 64; C = (st & 1) * 32 + (swz % 64) / 2; }

struct UnitD { const char* Bp; int pm, pn, e, rb; };

DI bool static_tile(int i, int G, int c, int nM, int nN, int& pm, int& pn) {
    const int nwg = nM * nN; const long L = (long)i * G + c; if (L >= nwg) return false;
    int wgid = (int)L; { const int q = nwg / NXCD, r = nwg % NXCD, xcd = wgid % NXCD, off = wgid / NXCD; wgid = (xcd < r ? xcd * (q + 1) : r * (q + 1) + (xcd - r) * q) + off; }
    const int nig = WGM * nN, gid = wgid / nig, fm = gid * WGM, gsz = (nM - fm) < WGM ? (nM - fm) : WGM;
    pm = fm + ((wgid % nig) % gsz); pn = (wgid % nig) / gsz; return true;
}

struct PlainSched {
    const char* Abase; const char* Bbase; int lda, ldb, K, nM, nN, G, c; static constexpr int esz = 2;
    DI bool next(int i, UnitD& u) const { int pm, pn; if (!static_tile(i, G, c, nM, nN, pm, pn)) return false; u.pm = pm; u.pn = pn; u.e = 0; u.rb = 0; u.Bp = Bbase + (size_t)pn * BM * ldb * 2; return true; }
    DI void a_offs(const UnitD& u, int R0, int C0, unsigned (&o)[2][2]) const {
#pragma unroll
        for (int h = 0; h < 2; ++h)
#pragma unroll
            for (int i = 0; i < 2; ++i) o[h][i] = (unsigned)(((size_t)(u.pm * BM + h * HALF + R0 + 64 * i) * lda + C0) * 2);
    }
};

template <bool FP8 = false, class Epi, class Sched>
DI void gemm_phase(LAS unsigned char* lds, const Sched& S, const Epi& E) {
    const int tid = otid(), wid = __builtin_amdgcn_readfirstlane(tid >> 6), lane = tid & 63, wr = wid >> 2, wc = wid & 3, fr = lane & 15, fq = lane >> 4;
    const int nt = S.K * Sched::esz / 128;
    int R0, C0; stage_rc(tid * 16, R0, C0);
    unsigned voffB[2];
#pragma unroll
    for (int i = 0; i < 2; ++i) { const int Rr = R0 + 64 * i, Rb = Epi::PERM ? ((Rr & ~31) + perm32(Rr & 31)) : Rr; voffB[i] = (unsigned)(Rb * S.ldb * Sched::esz + C0 * 2); }
    const size_t hstepB = (size_t)HALF * S.ldb * Sched::esz;
    const unsigned ldsw = (unsigned)wid * 1024u;
    const int aoff = FP8 ? lds_byte(wr * 64 + fr, fq * 16) : lds_byte(wr * 64 + fr, fq * 8), boff = FP8 ? lds_byte(wc * 32 + fr, fq * 16) : lds_byte(wc * 32 + fr, fq * 8);
    const unsigned mxscale = 0x7f7f7f7fu;
    const int kst = FP8 ? 16 : 1024;
    const char* Ab = S.Abase;
#define G8_SA(b, h) (((b) * 2 + (h)) * HTB)
#define G8_SB(b, h) ((4 + (b) * 2 + (h)) * HTB)
#define G8_STAGE_A(bufoff, offs, kb) do { _Pragma("unroll") for (int _i = 0; _i < 2; ++_i) \
        __builtin_amdgcn_global_load_lds((const unsigned*)(Ab + (size_t)(offs)[_i] + (size_t)(kb)), (LAS unsigned*)(lds + (bufoff) + ldsw + _i * 8192), 16, 0, 0); } while (0)
#define G8_STAGE_B(bufoff, gbase, kb) do { _Pragma("unroll") for (int _i = 0; _i < 2; ++_i) \
        __builtin_amdgcn_global_load_lds((const unsigned*)((gbase) + voffB[_i] + (size_t)(kb)), (LAS unsigned*)(lds + (bufoff) + ldsw + _i * 8192), 16, 0, 0); } while (0)
#define G8_LDA(dst, b, h) do { _Pragma("unroll") for (int m = 0; m < 4; ++m) { const i32x4_t _p = *(const LAS i32x4_t*)(lds + G8_SA(b, h) + aoff + m * 2048), _q = *(const LAS i32x4_t*)(lds + G8_SA(b, h) + aoff + m * 2048 + kst); dst[m] = __builtin_shufflevector(_p, _q, 0, 1, 2, 3, 4, 5, 6, 7); } } while (0)
#define G8_LDB(dst, b, h) do { _Pragma("unroll") for (int n = 0; n < 2; ++n) { const i32x4_t _p = *(const LAS i32x4_t*)(lds + G8_SB(b, h) + boff + n * 2048), _q = *(const LAS i32x4_t*)(lds + G8_SB(b, h) + boff + n * 2048 + kst); dst[n] = __builtin_shufflevector(_p, _q, 0, 1, 2, 3, 4, 5, 6, 7); } } while (0)
#define G8_MMA(ai, bj, At, Bt) do { __builtin_amdgcn_s_setprio(1); _Pragma("unroll") for (int m = 0; m < 4; ++m) _Pragma("unroll") for (int n = 0; n < 2; ++n) { \
        if constexpr (FP8) asm volatile("v_mfma_scale_f32_16x16x128_f8f6f4 %0, %1, %2, %0, %3, %3 op_sel_hi:[0,0,0]" : "+v"(acc[ai][bj][m][n]) : "v"(Bt[n]), "v"(At[m]), "v"(mxscale)); \
        else { acc[ai][bj][m][n] = __builtin_amdgcn_mfma_f32_16x16x32_bf16(__builtin_bit_cast(bf16x8, __builtin_shufflevector(Bt[n], Bt[n], 0, 1, 2, 3)), __builtin_bit_cast(bf16x8, __builtin_shufflevector(At[m], At[m], 0, 1, 2, 3)), acc[ai][bj][m][n], 0, 0, 0); \
               acc[ai][bj][m][n] = __builtin_amdgcn_mfma_f32_16x16x32_bf16(__builtin_bit_cast(bf16x8, __builtin_shufflevector(Bt[n], Bt[n], 4, 5, 6, 7)), __builtin_bit_cast(bf16x8, __builtin_shufflevector(At[m], At[m], 4, 5, 6, 7)), acc[ai][bj][m][n], 0, 0, 0); } } \
        __builtin_amdgcn_s_setprio(0); } while (0)
#define G8_WAIT_V(n) asm volatile("s_waitcnt vmcnt(" #n ")" ::: "memory")
#define G8_WAIT_L(n) asm volatile("s_waitcnt lgkmcnt(" #n ")" ::: "memory")
#define G8_BAR __builtin_amdgcn_s_barrier()
#define G8_SCHED __builtin_amdgcn_sched_barrier(0)
    UnitD cur, nxt; int ui = 0;
    if (!S.next(0, cur)) return;
    f32x4 acc[2][2][4][2];
#pragma unroll
    for (int a = 0; a < 2; ++a)
#pragma unroll
        for (int b = 0; b < 2; ++b)
#pragma unroll
            for (int m = 0; m < 4; ++m)
#pragma unroll
                for (int n = 0; n < 2; ++n) acc[a][b][m][n] = (f32x4){0.f, 0.f, 0.f, 0.f};
    typedef int i32x4_t __attribute__((ext_vector_type(4)));
    v8i_t At[4], B0[2], B1[2];
    unsigned cA[2][2];
    S.a_offs(cur, R0, C0, cA);
    const char* cB = cur.Bp;
    G8_STAGE_B(G8_SB(0, 0), cB, 0); G8_STAGE_A(G8_SA(0, 0), cA[0], 0); G8_STAGE_B(G8_SB(0, 1), cB + hstepB, 0); G8_STAGE_A(G8_SA(0, 1), cA[1], 0);
    if (wr == 1) G8_BAR;
    G8_WAIT_V(4); G8_BAR;
    G8_STAGE_B(G8_SB(1, 0), cB, 128); G8_STAGE_A(G8_SA(1, 0), cA[0], 128); G8_STAGE_B(G8_SB(1, 1), cB + hstepB, 128);
    G8_WAIT_V(6); G8_BAR;
    for (;;) {
        const bool has_next = S.next(ui + 1, nxt);
        const char* nB = has_next ? nxt.Bp : cB;
        for (int t = 0; t < nt; t += 2) {
            const bool last = (t == nt - 2);
            const unsigned k1 = (unsigned)(t + 1) * 128u;
            const unsigned k2 = last ? 0u : (unsigned)(t + 2) * 128u, k3 = k2 + 128u;
            unsigned c1[2] = {cA[1][0], cA[1][1]};
            if (last && has_next) S.a_offs(nxt, R0, C0, cA);
            const char* b2 = last ? nB : cB;
            G8_LDB(B0, 0, 0); G8_SCHED; G8_LDA(At, 0, 0); G8_STAGE_A(G8_SA(1, 1), c1, k1);
            G8_WAIT_L(8); G8_BAR; G8_WAIT_L(0); G8_MMA(0, 0, At, B0); G8_BAR; G8_SCHED;
            G8_LDB(B1, 0, 1); G8_STAGE_B(G8_SB(0, 0), b2, k2);
            G8_BAR; G8_WAIT_L(0); G8_MMA(0, 1, At, B1); G8_BAR;
            G8_LDA(At, 0, 1); G8_STAGE_A(G8_SA(0, 0), cA[0], k2);
            G8_BAR; G8_WAIT_L(0); G8_MMA(1, 0, At, B0); G8_BAR; G8_SCHED;
            G8_STAGE_B(G8_SB(0, 1), b2 + hstepB, k2);
            G8_WAIT_V(6); G8_BAR; G8_MMA(1, 1, At, B1); G8_BAR;
            G8_LDB(B0, 1, 0); G8_SCHED; G8_LDA(At, 1, 0); G8_STAGE_A(G8_SA(0, 1), cA[1], k2);
            G8_WAIT_L(8); G8_BAR; G8_WAIT_L(0); G8_MMA(0, 0, At, B0); G8_BAR; G8_SCHED;
            G8_LDB(B1, 1, 1); G8_STAGE_B(G8_SB(1, 0), b2, k3);
            G8_BAR; G8_WAIT_L(0); G8_MMA(0, 1, At, B1); G8_BAR;
            G8_LDA(At, 1, 1); G8_STAGE_A(G8_SA(1, 0), cA[0], k3);
            G8_BAR; G8_WAIT_L(0); G8_MMA(1, 0, At, B0); G8_BAR; G8_SCHED;
            G8_STAGE_B(G8_SB(1, 1), b2 + hstepB, k3);
            G8_WAIT_V(6); G8_BAR; G8_MMA(1, 1, At, B1); G8_BAR;
        }
        if constexpr (FP8) asm volatile("s_nop 15\n\ts_nop 15" ::: "memory");
        E(acc, cur, wr, wc, fr, fq);
        if (!has_next) break;
#pragma unroll
        for (int a = 0; a < 2; ++a)
#pragma unroll
            for (int b = 0; b < 2; ++b)
#pragma unroll
                for (int m = 0; m < 4; ++m)
#pragma unroll
                    for (int n = 0; n < 2; ++n) acc[a][b][m][n] = (f32x4){0.f, 0.f, 0.f, 0.f};
        cur = nxt; cB = nB; ++ui;
    }
    G8_WAIT_V(0);
    if (wr == 0) G8_BAR;
    G8_BAR;
#undef G8_SA
#undef G8_SB
#undef G8_STAGE_A
#undef G8_STAGE_B
#undef G8_LDA
#undef G8_LDB
#undef G8_MMA
#undef G8_WAIT_V
#undef G8_WAIT_L
#undef G8_BAR
#undef G8_SCHED
}
}
using g8::UnitD;
typedef f32x4 Acc[2][2][4][2];

struct EpiIn {
    static constexpr bool PERM = true;
    u16* H; const float* rs1; float* SSQ; float* WI;
    template <int ACT, bool DOSSQ> DI void run(const Acc& acc, const UnitD& u, int wr, int wc, int fr, int fq) const {
        const int pn = u.pn;
#pragma unroll
        for (int ai = 0; ai < 2; ++ai)
#pragma unroll
            for (int m = 0; m < 4; ++m) {
                const int row = u.pm * 256 + ai * 128 + wr * 64 + m * 16 + fr;
#pragma unroll
                for (int bj = 0; bj < 2; ++bj) {
                    f32x4 v0 = acc[ai][bj][m][0], v1 = acc[ai][bj][m][1];
                    if (ACT == 1) {
#pragma unroll
                        for (int j = 0; j < 4; ++j) { v0[j] = fast_gelu(v0[j]); v1[j] = fast_gelu(v1[j]); }
                    } else if (ACT == 2) {
#pragma unroll
                        for (int j = 0; j < 4; ++j) { v0[j] = fast_sigmoid(v0[j]); v1[j] = fast_sigmoid(v1[j]); }
                    }
                    u32x4 w; w.x = pk2(v0[0], v0[1]); w.y = pk2(v0[2], v0[3]); w.z = pk2(v1[0], v1[1]); w.w = pk2(v1[2], v1[3]);
                    *(u32x4*)(H + (size_t)row * NIN + pn * 256 + bj * 128 + wc * 32 + 8 * fq) = w;
                    if (DOSSQ) {
                        float ssq = ((v0[0] * v0[0] + v0[1] * v0[1]) + (v0[2] * v0[2] + v0[3] * v0[3])) + ((v1[0] * v1[0] + v1[1] * v1[1]) + (v1[2] * v1[2] + v1[3] * v1[3]));
                        ssq += __shfl_xor(ssq, 16); ssq += __shfl_xor(ssq, 32);
                        if (fq == 0) SSQ[(size_t)row * 32 + (pn - 2) * 8 + bj * 4 + wc] = ssq;
                        if (pn == 5 && bj == 1 && wc == 2 && fq == 0) *(f32x4*)(WI + (size_t)row * 4) = v0 * 0.5f;
                    }
                }
            }
    }
    DI void operator()(const Acc& acc, const UnitD& u, int wr, int wc, int fr, int fq) const {
        const int pn = u.pn;
        if (pn < 2) run<1, false>(acc, u, wr, wc, fr, fq);
        else if (pn < 4) run<1, true>(acc, u, wr, wc, fr, fq);
        else if (pn < 6) run<0, true>(acc, u, wr, wc, fr, fq);
        else run<2, false>(acc, u, wr, wc, fr, fq);
    }
};
struct EpiQ {
    static constexpr bool PERM = true;
    u16* Q; u16* QI; const float* SSQ;
    DI void operator()(const Acc& acc, const UnitD& u, int wr, int wc, int fr, int fq) const {
        f32x4 sq[2][4][2];
#pragma unroll
        for (int ai = 0; ai < 2; ++ai)
#pragma unroll
            for (int m = 0; m < 4; ++m) { const int row = u.pm * 256 + ai * 128 + wr * 64 + m * 16 + fr; sq[ai][m][0] = *(const f32x4*)(SSQ + (size_t)row * 32 + 16); sq[ai][m][1] = *(const f32x4*)(SSQ + (size_t)row * 32 + 20); }
        __builtin_amdgcn_sched_barrier(0);
#pragma unroll
        for (int ai = 0; ai < 2; ++ai)
#pragma unroll
            for (int m = 0; m < 4; ++m) {
                const int row = u.pm * 256 + ai * 128 + wr * 64 + m * 16 + fr;
                const f32x4 s0 = sq[ai][m][0], s1 = sq[ai][m][1];
                const float ss = ((s0[0] + s0[1]) + (s0[2] + s0[3])) + ((s1[0] + s1[1]) + (s1[2] + s1[3]));
                const float rs = __builtin_amdgcn_rsqf(ss * (1.0f / 256.0f) + EPS);
#pragma unroll
                for (int bj = 0; bj < 2; ++bj) {
                    const int col = u.pn * 256 + bj * 128 + wc * 32 + 8 * fq;
                    const f32x4 v0 = acc[ai][bj][m][0] * rs, v1 = acc[ai][bj][m][1] * rs;
                    if (col < 1024) { u32x4 w; w.x = pk2(v0[0], v0[1]); w.y = pk2(v0[2], v0[3]); w.z = pk2(v1[0], v1[1]); w.w = pk2(v1[2], v1[3]); *(u32x4*)(Q + (size_t)row * 1024 + col) = w; }
                    else { u32x2 w; w.x = pk4_i8(v0[0], v0[1], v0[2], v0[3]); w.y = pk4_i8(v1[0], v1[1], v1[2], v1[3]); *(u32x2*)((unsigned char*)QI + (size_t)row * 256 + (col - 1024)) = w; }
                }
            }
    }
};
template <int SECOND> struct EpiMrg {
    static constexpr bool PERM = true;
    u16* OUT; const u16* TMP; const u16* H;
    DI void operator()(const Acc& acc, const UnitD& u, int wr, int wc, int fr, int fq) const {
#pragma unroll
        for (int ai = 0; ai < 2; ++ai) {
            u32x4 g[4][2], tp[4][2];
#pragma unroll
            for (int m = 0; m < 4; ++m)
#pragma unroll
                for (int bj = 0; bj < 2; ++bj) {
                    const int row = u.pm * 256 + ai * 128 + wr * 64 + m * 16 + fr, col = u.pn * 256 + bj * 128 + wc * 32 + 8 * fq;
                    g[m][bj] = *(const u32x4*)(H + (size_t)row * NIN + 1536 + SECOND * 1024 + col);
                    if (SECOND) tp[m][bj] = *(const u32x4*)(TMP + (size_t)row * 1024 + col);
                }
            __builtin_amdgcn_sched_barrier(0);
#pragma unroll
            for (int m = 0; m < 4; ++m)
#pragma unroll
                for (int bj = 0; bj < 2; ++bj) {
                    const int row = u.pm * 256 + ai * 128 + wr * 64 + m * 16 + fr, col = u.pn * 256 + bj * 128 + wc * 32 + 8 * fq;
                    const u32x4 gg = g[m][bj];
                    f32x4 v0 = acc[ai][bj][m][0], v1 = acc[ai][bj][m][1];
                    v0[0] *= bflo(gg.x); v0[1] *= bfhi(gg.x); v0[2] *= bflo(gg.y); v0[3] *= bfhi(gg.y); v1[0] *= bflo(gg.z); v1[1] *= bfhi(gg.z); v1[2] *= bflo(gg.w); v1[3] *= bfhi(gg.w);
                    if (SECOND) { const u32x4 t = tp[m][bj];
                        v0[0] += bflo(t.x); v0[1] += bfhi(t.x); v0[2] += bflo(t.y); v0[3] += bfhi(t.y); v1[0] += bflo(t.z); v1[1] += bfhi(t.z); v1[2] += bflo(t.w); v1[3] += bfhi(t.w); }
                    u32x4 w; w.x = pk2(v0[0], v0[1]); w.y = pk2(v0[2], v0[3]); w.z = pk2(v1[0], v1[1]); w.w = pk2(v1[2], v1[3]);
                    *(u32x4*)(OUT + (size_t)row * 1024 + col) = w;
                }
            __builtin_amdgcn_sched_barrier(0);
        }
    }
};
struct EpiOut {
    static constexpr bool PERM = false;
    float* out; const float* x;
    DI void operator()(const Acc& acc, const UnitD& u, int wr, int wc, int fr, int fq) const {
#pragma unroll
        for (int ai = 0; ai < 2; ++ai) {
            f32x4 xv[4][2][2];
#pragma unroll
            for (int m = 0; m < 4; ++m)
#pragma unroll
                for (int bj = 0; bj < 2; ++bj)
#pragma unroll
                    for (int n = 0; n < 2; ++n)
                        xv[m][bj][n] = *(const f32x4*)(x + (size_t)(u.pm * 256 + ai * 128 + wr * 64 + m * 16 + fr) * 1024 + u.pn * 256 + bj * 128 + wc * 32 + n * 16 + 4 * fq);
            __builtin_amdgcn_sched_barrier(0);
#pragma unroll
            for (int m = 0; m < 4; ++m)
#pragma unroll
                for (int bj = 0; bj < 2; ++bj)
#pragma unroll
                    for (int n = 0; n < 2; ++n)
                        *(f32x4*)(out + (size_t)(u.pm * 256 + ai * 128 + wr * 64 + m * 16 + fr) * 1024 + u.pn * 256 + bj * 128 + wc * 32 + n * 16 + 4 * fq) = xv[m][bj][n] + acc[ai][bj][m][n];
            __builtin_amdgcn_sched_barrier(0);
        }
    }
};

constexpr int MOE_TAB = g8::STAGE_BYTES;
DI void moe_table(LAS unsigned char* lds, const unsigned* CNT) {
    LAS int* tab = (LAS int*)(lds + MOE_TAB);
    __syncthreads();
    if (threadIdx.x == 0) { int acc = 0; for (int e = 0; e < NE; ++e) { const int c = (int)__hip_atomic_load(CNT + e, __ATOMIC_RELAXED, __HIP_MEMORY_SCOPE_AGENT); tab[e] = acc; tab[33 + e] = c; acc += (c + 255) >> 8; } tab[32] = acc; }
    __syncthreads();
}
template <int NPN, bool GATHER> struct MoeSched {
    const char* Abase; const char* Wbase; const int* LTOK; LAS const int* tab; int lda, ldb, K, G, c; size_t wstride; static constexpr int esz = 1;
    DI bool next(int i, UnitD& u) const {
        const long L = (long)i * G + c; const int R = tab[32];
        if (L >= (long)R * NPN) return false;
        const int rbg = (int)(L / NPN), pn = (int)(L % NPN);
        int e = 0;
        for (int j = 1; j < NE; ++j) e += (tab[j] <= rbg) ? 1 : 0;
        e = __builtin_amdgcn_readfirstlane(e);
        u.pm = rbg; u.pn = pn; u.e = e; u.rb = rbg - tab[e];
        u.Bp = Wbase + (size_t)e * wstride + (size_t)pn * 256 * ldb * esz;
        return true;
    }
    DI void a_offs(const UnitD& u, int R0, int C0, unsigned (&o)[2][2]) const {
        const int cnt = tab[33 + u.e];
#pragma unroll
        for (int h = 0; h < 2; ++h)
#pragma unroll
            for (int i = 0; i < 2; ++i) {
                const int r = h * 128 + R0 + 64 * i;
                if (GATHER) { const int slot = u.rb * 256 + r; const int tok = slot < cnt ? LTOK[(size_t)u.e * ECAP + slot] : 0; o[h][i] = (unsigned)((size_t)tok * lda * esz + C0 * 2); }
                else o[h][i] = (unsigned)((size_t)(u.pm * 256 + r) * lda * esz + C0 * 2);
            }
    }
};
struct EpiMoe1 {
    static constexpr bool PERM = true;
    unsigned char* ACT; const float* b1;
    DI void operator()(const Acc& acc, const UnitD& u, int wr, int wc, int fr, int fq) const {
        const float* be = b1 + (size_t)u.e * 2048;
        const int hc = u.pn * 128 + wc * 32 + 8 * fq;
        const f32x4 bg0 = *(const f32x4*)(be + hc), bg1 = *(const f32x4*)(be + hc + 4), bu0 = *(const f32x4*)(be + 1024 + hc), bu1 = *(const f32x4*)(be + 1024 + hc + 4);
        __builtin_amdgcn_sched_barrier(0);
#pragma unroll
        for (int ai = 0; ai < 2; ++ai)
#pragma unroll
            for (int m = 0; m < 4; ++m) {
                const int row = u.pm * 256 + ai * 128 + wr * 64 + m * 16 + fr;
                float av[8];
#pragma unroll
                for (int n = 0; n < 2; ++n) {
                    const f32x4 g = acc[ai][0][m][n] * 0.015625f + (n ? bg1 : bg0), up = acc[ai][1][m][n] * 0.015625f + (n ? bu1 : bu0);
#pragma unroll
                    for (int j = 0; j < 4; ++j) {
                        const float hg = fminf(g[j], 7.0f), hu = __builtin_amdgcn_fmed3f(up[j], -7.0f, 7.0f);
                        av[4 * n + j] = (hu + 1.0f) * (hg * __builtin_amdgcn_rcpf(1.0f + __builtin_amdgcn_exp2f(hg * -2.4554669595930157f)));
                    }
                }
                u32x2 w; w.x = pk4_fp8(av[0], av[1], av[2], av[3]); w.y = pk4_fp8(av[4], av[5], av[6], av[7]);
                *(u32x2*)(ACT + (size_t)row * 1024 + hc) = w;
            }
    }
};
struct EpiMoe2 {
    static constexpr bool PERM = true;
    u16* YB; const float* b2;
    DI void operator()(const Acc& acc, const UnitD& u, int wr, int wc, int fr, int fq) const {
        const float* be = b2 + (size_t)u.e * 1024;
        f32x4 bias[2][2];
#pragma unroll
        for (int bj = 0; bj < 2; ++bj) { const int col = u.pn * 256 + bj * 128 + wc * 32 + 8 * fq; bias[bj][0] = *(const f32x4*)(be + col); bias[bj][1] = *(const f32x4*)(be + col + 4); }
        __builtin_amdgcn_sched_barrier(0);
#pragma unroll
        for (int ai = 0; ai < 2; ++ai)
#pragma unroll
            for (int m = 0; m < 4; ++m) {
                const int r = ai * 128 + wr * 64 + m * 16 + fr;
#pragma unroll
                for (int bj = 0; bj < 2; ++bj) {
                    const int col = u.pn * 256 + bj * 128 + wc * 32 + 8 * fq;
                    const f32x4 v0 = acc[ai][bj][m][0] * 0.015625f + bias[bj][0], v1 = acc[ai][bj][m][1] * 0.015625f + bias[bj][1];
                    u32x4 w; w.x = pk2(v0[0], v0[1]); w.y = pk2(v0[2], v0[3]); w.z = pk2(v1[0], v1[1]); w.w = pk2(v1[2], v1[3]);
                    *(u32x4*)(YB + (size_t)(u.pm * 256 + r) * 1024 + col) = w;
                }
            }
    }
};

template <bool FP8 = false, class F> DI void tr_tile(LAS unsigned char* lds, const float* src, int ld_src, int Nsz, int k0, int n0, const float* sk, float mul, u16* dst, int ld_dst, F rowmap) {
    LAS float* t = (LAS float*)lds;
    const int tid = otid();
    __syncthreads();
#pragma unroll
    for (int it = 0; it < 2; ++it) {
        const int k = (tid >> 4) + 32 * it, n = 4 * (tid & 15);
        f32x4 v = {0.f, 0.f, 0.f, 0.f};
        if (n0 + n < Nsz) v = *(const f32x4*)(src + (size_t)(k0 + k) * ld_src + n0 + n);
        const float s = (sk ? sk[k0 + k] : 1.0f) * mul;
        t[k * 65 + n] = v[0] * s; t[k * 65 + n + 1] = v[1] * s; t[k * 65 + n + 2] = v[2] * s; t[k * 65 + n + 3] = v[3] * s;
    }
    __syncthreads();
    const int n = tid >> 3, kc = (tid & 7) * 8;
    if (FP8) {
        if (n0 + n < Nsz) {
            u32x2 w;
            w.x = pk4_fp8(t[(kc + 0) * 65 + n], t[(kc + 1) * 65 + n], t[(kc + 2) * 65 + n], t[(kc + 3) * 65 + n]);
            w.y = pk4_fp8(t[(kc + 4) * 65 + n], t[(kc + 5) * 65 + n], t[(kc + 6) * 65 + n], t[(kc + 7) * 65 + n]);
            *(u32x2*)((unsigned char*)dst + (size_t)rowmap(n0 + n) * ld_dst + k0 + kc) = w;
        }
    } else if (n0 + n < Nsz) {
        u32x4 w;
        w.x = pk2(t[(kc + 0) * 65 + n], t[(kc + 1) * 65 + n]); w.y = pk2(t[(kc + 2) * 65 + n], t[(kc + 3) * 65 + n]);
        w.z = pk2(t[(kc + 4) * 65 + n], t[(kc + 5) * 65 + n]); w.w = pk2(t[(kc + 6) * 65 + n], t[(kc + 7) * 65 + n]);
        *(u32x4*)(dst + (size_t)rowmap(n0 + n) * ld_dst + k0 + kc) = w;
    }
}
struct MapId { DI int operator()(int n) const { return n; } };
struct MapIn { DI int operator()(int n) const { return n < 1476 ? n : n + 60; } };
struct MapE1 { DI int operator()(int n) const { const int hi = n >= 1024 ? 1 : 0, q = n - hi * 1024; return (q >> 7) * 256 + hi * 128 + (q & 127); } };

DI void phase0(const Args& a, LAS unsigned char* lds) {
    unsigned char* ws = a.ws;
    const int tid = otid();
    const size_t gtid = (size_t)blockIdx.x * NT + tid, gstride = (size_t)gridDim.x * NT;
    for (size_t i = gtid; i < 60 * 1024 / 2; i += gstride) ((unsigned*)(ws + WS_WIN + (size_t)1476 * 1024 * 2))[i] = 0u;
    for (size_t i = gtid; i < 32 * 1024; i += gstride) { const int e = (int)(i >> 10), k = (int)(i & 1023); const float w = a.in[I_WR][k * 32 + e] * a.in[I_N2G][k]; const u16 h = f2bf(w); ((u16*)(ws + WS_WR))[i] = h; ((u16*)(ws + WS_WR))[32 * 1024 + i] = f2bf(w - bf2f(h)); }
    for (size_t i = gtid; i < 4 * 128 * 128; i += gstride) { const int tt = (int)((i >> 7) & 127), ss = (int)(i & 127); ((u16*)(ws + WS_WSP))[i] = f2bf(ss <= tt ? a.in[I_WSP][i] : 0.f); }
    {
        const int wid = tid >> 6, lane = tid & 63;
        for (int row = blockIdx.x * 8 + wid; row < T; row += gridDim.x * 8) {
            const float* xr = a.in[I_X] + (size_t)row * 1024; u16* xb = (u16*)(ws + WS_XB) + (size_t)row * 1024;
            float ss = 0.f; f32x4 xv[4];
#pragma unroll
            for (int i = 0; i < 4; ++i) {
                xv[i] = __builtin_nontemporal_load((const f32x4*)(xr + i * 256 + lane * 4));
                ss += (xv[i][0] * xv[i][0] + xv[i][1] * xv[i][1]) + (xv[i][2] * xv[i][2] + xv[i][3] * xv[i][3]);
            }
#pragma unroll
            for (int o = 32; o >= 1; o >>= 1) ss += __shfl_xor(ss, o);
            const float rs = __builtin_amdgcn_rsqf(ss * (1.0f / 1024.0f) + EPS);
#pragma unroll
            for (int i = 0; i < 4; ++i) { u32x2 w; w.x = pk2(xv[i][0] * rs, xv[i][1] * rs); w.y = pk2(xv[i][2] * rs, xv[i][3] * rs); *(u32x2*)(xb + i * 256 + lane * 4) = w; }
        }
    }
    constexpr int U_IN = 16 * 56, U_UQ = 4 * 16, U_QI = 4 * 4, U_PA = 8 * 16, U_OUT = 16 * 16, U_CB = 64;
    constexpr int U_TOT = U_IN + U_UQ + U_QI + U_PA + U_OUT + U_CB;
    for (int u = blockIdx.x; u < U_TOT; u += gridDim.x) {
        int v = u;
        if (v < U_IN) { tr_tile(lds, a.in[I_WIN], 3524, 3524, (v & 15) * 64, (v >> 4) * 64, a.in[I_N1G], 1.0f, (u16*)(ws + WS_WIN), 1024, MapIn()); continue; }
        v -= U_IN;
        if (v < U_UQ) { tr_tile(lds, a.in[I_WUQ], 1024, 1024, (v & 3) * 64, (v >> 2) * 64, a.in[I_QLG], 1.0f, (u16*)(ws + WS_WQ), 256, MapId()); continue; }
        v -= U_UQ;
        if (v < U_QI) { tr_tile(lds, a.in[I_WQI], 256, 256, (v & 3) * 64, (v >> 2) * 64, a.in[I_QLG], 1.0f, (u16*)(ws + WS_WQ) + 1024 * 256, 256, MapId()); continue; }
        v -= U_QI;
        if (v < U_PA) { tr_tile(lds, a.in[I_WPA], 1024, 1024, (v & 7) * 64, (v >> 3) * 64, nullptr, 1.0f, (u16*)(ws + WS_WCAT), 1536, MapId()); continue; }
        v -= U_PA;
        if (v < U_OUT) { tr_tile(lds, a.in[I_WOUT], 1024, 1024, (v & 15) * 64, (v >> 4) * 64, nullptr, 1.0f, (u16*)(ws + WS_WOUT), 1024, MapId()); continue; }
        v -= U_OUT;
        {
            const int h = v >> 3, c0 = (v & 7) * 16;
            LAS float* t = (LAS float*)lds;
            __syncthreads();
            for (int i = tid; i < 1024; i += NT) t[i] = a.in[I_WUV][(size_t)h * 128 * 64 + (size_t)c0 * 64 + i];
            __syncthreads();
            for (int nn = tid; nn < 1024; nn += NT) {
                float accv[16];
#pragma unroll
                for (int i = 0; i < 16; ++i) accv[i] = 0.f;
                for (int vv = 0; vv < 64; ++vv) {
                    const float pb = a.in[I_WPB][(size_t)(h * 64 + vv) * 1024 + nn];
#pragma unroll
                    for (int i = 0; i < 16; ++i) accv[i] += t[i * 64 + vv] * pb;
                }
                u32x4 w0, w1;
                w0.x = pk2(accv[0], accv[1]); w0.y = pk2(accv[2], accv[3]); w0.z = pk2(accv[4], accv[5]); w0.w = pk2(accv[6], accv[7]);
                w1.x = pk2(accv[8], accv[9]); w1.y = pk2(accv[10], accv[11]); w1.z = pk2(accv[12], accv[13]); w1.w = pk2(accv[14], accv[15]);
                u16* d = (u16*)(ws + WS_WCAT) + (size_t)nn * 1536 + 512 + h * 128 + c0;
                *(u32x4*)d = w0; *(u32x4*)(d + 8) = w1;
            }
        }
    }
}

DI void gmlp_unit(const Args& a, LAS unsigned char* lds, int u) {
    unsigned char* ws = a.ws;
    const int tid = otid(), wid = tid >> 6, lane = tid & 63, fr = lane & 15, fq = lane >> 4;
    const int g = u & 3, row0 = (u >> 2) * 128;
    const u16* H = (const u16*)(ws + WS_H);
    LAS u16* img = (LAS u16*)lds;
    __syncthreads();
    {
        const int s = tid & 127, cset = tid >> 7;
        const f32x4 sq = *(const f32x4*)((const float*)(ws + WS_SSQ) + (size_t)(row0 + s) * 32 + g * 4);
        const float rs = __builtin_amdgcn_rsqf(((sq[0] + sq[1]) + (sq[2] + sq[3])) * (1.0f / 128.0f) + EPS);
#pragma unroll
        for (int it = 0; it < 4; ++it) {
            const int c = cset + 4 * it;
            const u32x4 raw = *(const u32x4*)(H + (size_t)(row0 + s) * NIN + 512 + g * 128 + 8 * c);
            const float* vg = a.in[I_VG] + 8 * c;
            float f[8] = {bflo(raw.x), bfhi(raw.x), bflo(raw.y), bfhi(raw.y), bflo(raw.z), bfhi(raw.z), bflo(raw.w), bfhi(raw.w)};
#pragma unroll
            for (int i = 0; i < 8; ++i) img[(8 * c + i) * 136 + s] = f2bf(f[i] * rs * vg[i]);
        }
    }
    __syncthreads();
    const u16* W = (const u16*)(ws + WS_WSP) + (size_t)g * 128 * 128 + (size_t)(16 * wid + fr) * 128;
    f32x4 acc[8];
#pragma unroll
    for (int i = 0; i < 8; ++i) acc[i] = (f32x4){0.f, 0.f, 0.f, 0.f};
    const int nks = (16 * wid + 15) / 32 + 1;
    for (int ks = 0; ks < nks; ++ks) {
        const bf16x8 bw = *(const bf16x8*)(W + ks * 32 + 8 * fq);
#pragma unroll
        for (int i = 0; i < 8; ++i) {
            const bf16x8 av = *(const LAS bf16x8*)(img + (16 * i + fr) * 136 + ks * 32 + 8 * fq);
            acc[i] = __builtin_amdgcn_mfma_f32_16x16x32_bf16(av, bw, acc[i], 0, 0, 0);
        }
    }
    const int t = 16 * wid + fr;
    const float bias = a.in[I_BSP][g * 128 + t];
    u16* YO = (u16*)(ws + WS_YO);
#pragma unroll
    for (int i = 0; i < 8; ++i) {
        const int d = 16 * i + 4 * fq;
        const u32x2 uu = *(const u32x2*)(H + (size_t)(row0 + t) * NIN + g * 128 + d);
        const float y0 = bflo(uu.x) * (acc[i][0] + bias), y1 = bfhi(uu.x) * (acc[i][1] + bias), y2 = bflo(uu.y) * (acc[i][2] + bias), y3 = bfhi(uu.y) * (acc[i][3] + bias);
        u32x2 w; w.x = pk2(y0, y1); w.y = pk2(y2, y3);
        *(u32x2*)(YO + (size_t)(row0 + t) * 1536 + g * 128 + d) = w;
    }
}

DI void kvnorm(const Args& a) {
    unsigned char* ws = a.ws;
    const u16* H = (const u16*)(ws + WS_H); const float* SSQ = (const float*)(ws + WS_SSQ);
    const size_t gtid = (size_t)blockIdx.x * NT + otid(), gstride = (size_t)gridDim.x * NT;
    for (size_t idx = gtid; idx < (size_t)T * 24; idx += gstride) {
        const int row = (int)(idx / 24), c = (int)(idx % 24);
        const u16* src; u16* dst; const float* gain; float rs;
        if (c < 16) {
            const f32x4 sq = *(const f32x4*)(SSQ + (size_t)row * 32 + 24);
            rs = __builtin_amdgcn_rsqf(((sq[0] + sq[1]) + (sq[2] + sq[3])) * (1.0f / 128.0f) + EPS);
            src = H + (size_t)row * NIN + 1280 + 8 * c; dst = (u16*)(ws + WS_KVN) + (size_t)row * 128 + 8 * c; gain = a.in[I_KVG] + 8 * c;
        } else {
            const int cc = c - 16;
            rs = __builtin_amdgcn_rsqf((SSQ[(size_t)row * 32 + 28] + SSQ[(size_t)row * 32 + 29]) * (1.0f / 64.0f) + EPS);
            src = H + (size_t)row * NIN + 1408 + 8 * cc; dst = nullptr; gain = a.in[I_KIG] + 8 * cc;
            const u32x4 raw = *(const u32x4*)src;
            u32x2 w8;
            w8.x = pk4_i8(bflo(raw.x) * rs * gain[0], bfhi(raw.x) * rs * gain[1], bflo(raw.y) * rs * gain[2], bfhi(raw.y) * rs * gain[3]);
            w8.y = pk4_i8(bflo(raw.z) * rs * gain[4], bfhi(raw.z) * rs * gain[5], bflo(raw.w) * rs * gain[6], bfhi(raw.w) * rs * gain[7]);
            *(u32x2*)(ws + WS_KIN + (size_t)row * 64 + 8 * cc) = w8;
            continue;
        }
        const u32x4 raw = *(const u32x4*)src;
        u32x4 w;
        w.x = pk2(bflo(raw.x) * rs * gain[0], bfhi(raw.x) * rs * gain[1]); w.y = pk2(bflo(raw.y) * rs * gain[2], bfhi(raw.y) * rs * gain[3]);
        w.z = pk2(bflo(raw.z) * rs * gain[4], bfhi(raw.z) * rs * gain[5]); w.w = pk2(bflo(raw.w) * rs * gain[6], bfhi(raw.w) * rs * gain[7]);
        *(u32x4*)dst = w;
    }
}

constexpr int P3_ROWS = 0, P3_HIST = 131072, P3_LIST = 147456;
DI unsigned bf2keys(unsigned b) {
    unsigned m; asm("v_pk_ashrrev_i16 %0, %1, %2" : "=v"(m) : "v"(0x000f000fu), "v"(b));
    return b ^ (m | 0x80008000u);
}
DI unsigned f2key(float f) { const unsigned u = __float_as_uint(f); return (u & 0x80000000u) ? ~u : (u | 0x80000000u); }
DI int wave_incl_scan(int v, int lane) {
#pragma unroll
    for (int o = 1; o < 64; o <<= 1) { const int t = __shfl_up(v, o); if (lane >= o) v += t; }
    return v;
}
DI int wave_suffix_scan(int v, int lane) {
#pragma unroll
    for (int o = 1; o < 64; o <<= 1) { const int t = __shfl_down(v, o); if (lane + o < 64) v += t; }
    return v;
}
DI unsigned pk_gt(unsigned kw, unsigned xw, unsigned one) {
    unsigned d, m;
    asm("v_pk_sub_u16 %0, %1, %2 clamp" : "=v"(d) : "v"(kw), "v"(xw));
    asm("v_pk_min_u16 %0, %1, %2" : "=v"(m) : "v"(d), "v"(one));
    return m;
}
DI unsigned pk_subs(unsigned kw, unsigned xw) { unsigned d; asm("v_pk_sub_u16 %0, %1, %2 clamp" : "=v"(d) : "v"(kw), "v"(xw)); return d; }
DI unsigned pk_min1(unsigned d, unsigned one) { unsigned m; asm("v_pk_min_u16 %0, %1, %2" : "=v"(m) : "v"(d), "v"(one)); return m; }
DI unsigned pk_max(unsigned a, unsigned b) { unsigned r; asm("v_pk_max_u16 %0, %1, %2" : "=v"(r) : "v"(a), "v"(b)); return r; }
DI unsigned pk_add(unsigned a, unsigned b) { unsigned r; asm("v_pk_add_u16 %0, %1, %2" : "=v"(r) : "v"(a), "v"(b)); return r; }
DI int wave_sum(int v) {
    v += __builtin_amdgcn_update_dpp(0, v, 0xB1, 0xf, 0xf, false);
    v += __builtin_amdgcn_update_dpp(0, v, 0x4E, 0xf, 0xf, false);
    v += __builtin_amdgcn_update_dpp(0, v, 0x141, 0xf, 0xf, false);
    v += __builtin_amdgcn_update_dpp(0, v, 0x140, 0xf, 0xf, false);
    return __builtin_amdgcn_readlane(v, 0) + __builtin_amdgcn_readlane(v, 16) + __builtin_amdgcn_readlane(v, 32) + __builtin_amdgcn_readlane(v, 48);
}
DI int rowaddr(int p) { return (p & ~511) | ((p & 63) << 3) | ((p >> 6) & 7); }
typedef unsigned short us2_t __attribute__((ext_vector_type(2)));
DI unsigned dot2acc(unsigned flags, unsigned wts, unsigned acc) { return __builtin_amdgcn_udot2(__builtin_bit_cast(us2_t, flags), __builtin_bit_cast(us2_t, wts), acc, false); }
DI void keys_load(LAS u16* row, int N, int lane, u32x4 (&kr)[16]) {
    const int Nup = (N + 511) & ~511, niter = Nup >> 9;
    for (int p = N + lane; p < Nup; p += 64) row[rowaddr(p)] = (u16)0;
    wave_lds_sync();
#pragma unroll
    for (int i = 0; i < 16; ++i) { kr[i] = (u32x4){0u, 0u, 0u, 0u}; if (i < niter) kr[i] = *(LAS const u32x4*)(row + i * 512 + lane * 8); }
    wave_lds_sync();
}
DI void keys_select(const u32x4 (&kr)[16], LAS u16* list, int N, int lane) {
    const int Nup = (N + 511) & ~511, niter = Nup >> 9;
    const unsigned one = 0x00010001u;
    auto count_gt = [&](unsigned x) -> int {
        const unsigned xw = x | (x << 16);
        unsigned acc = 0u, acc1 = 0u, acc2 = 0u, acc3 = 0u;
#pragma unroll
        for (int c = 0; c < 4; ++c) {
            if (4 * c < niter) {
#pragma unroll
                for (int h = 0; h < 2; ++h) {
                    unsigned d[8];
#pragma unroll
                    for (int i = 0; i < 2; ++i) { const u32x4 kk = kr[4 * c + 2 * h + i]; d[4 * i] = pk_subs(kk.x, xw); d[4 * i + 1] = pk_subs(kk.y, xw); d[4 * i + 2] = pk_subs(kk.z, xw); d[4 * i + 3] = pk_subs(kk.w, xw); }
#pragma unroll
                    for (int i = 0; i < 8; ++i) d[i] = pk_min1(d[i], one);
#pragma unroll
                    for (int i = 0; i < 8; i += 4) { acc = dot2acc(d[i], one, acc); acc1 = dot2acc(d[i + 1], one, acc1); acc2 = dot2acc(d[i + 2], one, acc2); acc3 = dot2acc(d[i + 3], one, acc3); }
                }
            }
        }
        return wave_sum((int)((acc + acc1) + (acc2 + acc3)));
    };
    unsigned T = 0u; int cge = Nup, topbit = 15;
    {
        unsigned mx = 0u;
#pragma unroll
        for (int c = 0; c < 4; ++c) {
            if (4 * c < niter) {
#pragma unroll
                for (int i = 4 * c; i < 4 * c + 4; ++i) { mx = pk_max(mx, kr[i].x); mx = pk_max(mx, kr[i].y); mx = pk_max(mx, kr[i].z); mx = pk_max(mx, kr[i].w); }
            }
        }
        unsigned m1 = max(mx & 0xffffu, mx >> 16);
        m1 = max(m1, (unsigned)__builtin_amdgcn_update_dpp(0, (int)m1, 0xB1, 0xf, 0xf, false)); m1 = max(m1, (unsigned)__builtin_amdgcn_update_dpp(0, (int)m1, 0x4E, 0xf, 0xf, false));
        m1 = max(m1, (unsigned)__builtin_amdgcn_update_dpp(0, (int)m1, 0x141, 0xf, 0xf, false)); m1 = max(m1, (unsigned)__builtin_amdgcn_update_dpp(0, (int)m1, 0x140, 0xf, 0xf, false));
        const unsigned kmax = max(max((unsigned)__builtin_amdgcn_readlane((int)m1, 0), (unsigned)__builtin_amdgcn_readlane((int)m1, 16)), max((unsigned)__builtin_amdgcn_readlane((int)m1, 32), (unsigned)__builtin_amdgcn_readlane((int)m1, 48)));
        if (kmax > 1024u) {
            const unsigned lo = kmax - 1023u;
            const int clo = count_gt(lo - 1u);
            if (clo >= 256) { T = lo; cge = clo; topbit = 9; }
        }
    }
#pragma unroll 1
    for (int bit = topbit; bit >= 0; --bit) {
        const unsigned cand = topbit == 15 ? (T | (1u << bit)) : (T + (1u << bit));
        if (cand > 0xffffu) continue;
        const int cnt = count_gt(cand - 1u);
        if (cnt >= 256) { T = cand; cge = cnt; }
    }
    auto build = [&](unsigned x, unsigned (&M)[4]) {
        const unsigned xw = x | (x << 16);
#pragma unroll
        for (int c = 0; c < 4; ++c) {
            M[c] = 0u;
            if (4 * c < niter) {
#pragma unroll
                for (int i = 4 * c; i < 4 * c + 4; ++i) {
                    unsigned byte = dot2acc(pk_gt(kr[i].x, xw, one), 0x00020001u, 0u);
                    byte = dot2acc(pk_gt(kr[i].y, xw, one), 0x00080004u, byte);
                    byte = dot2acc(pk_gt(kr[i].z, xw, one), 0x00200010u, byte);
                    byte = dot2acc(pk_gt(kr[i].w, xw, one), 0x00800040u, byte);
                    M[c] |= byte << (8 * (i & 3));
                }
            }
        }
    };
    unsigned M[4];
    build(T - 1u, M);
    if (cge != 256) {
        unsigned G[4]; build(T, G);
        unsigned E[4];
#pragma unroll
        for (int c = 0; c < 4; ++c) E[c] = M[c] & ~G[c];
        const int need = 256 - (cge - wave_sum((int)(__builtin_popcount(E[0]) + __builtin_popcount(E[1]) + __builtin_popcount(E[2]) + __builtin_popcount(E[3]))));
        auto below = [&](int B, int c) -> unsigned { const int nb = B - 32 * c; return nb <= 0 ? 0u : (nb >= 32 ? 0xffffffffu : ((1u << nb) - 1u)); };
        auto ties_below = [&](int B) -> int {
            return wave_sum((int)(__builtin_popcount(E[0] & below(B, 0)) + __builtin_popcount(E[1] & below(B, 1)) + __builtin_popcount(E[2] & below(B, 2)) + __builtin_popcount(E[3] & below(B, 3))));
        };
        int lo = 0, hi = 127;
#pragma unroll 1
        while (lo < hi) { const int mid = (lo + hi) >> 1; if (ties_below(mid + 1) >= need) hi = mid; else lo = mid + 1; }
        const int Bs = lo, r = need - ties_below(Bs);
        const unsigned ew = Bs < 32 ? E[0] : (Bs < 64 ? E[1] : (Bs < 96 ? E[2] : E[3]));
        const bool tb = ((ew >> (Bs & 31)) & 1u) != 0u;
        const unsigned long long em = __ballot(tb);
        const bool take_row = tb && __builtin_popcountll(em & ((1ull << lane) - 1ull)) < r;
#pragma unroll
        for (int c = 0; c < 4; ++c) {
            unsigned tk = E[c] & below(Bs, c);
            if ((Bs >> 5) == c && take_row) tk |= 1u << (Bs & 31);
            M[c] = G[c] | tk;
        }
    }
    const int kl = __builtin_popcount(M[0]) + __builtin_popcount(M[1]) + __builtin_popcount(M[2]) + __builtin_popcount(M[3]);
    int wp = wave_incl_scan(kl, lane) - kl;
#pragma unroll
    for (int c = 0; c < 4; ++c) {
        unsigned m = M[c];
        while (m) { const int b = __builtin_ctz(m); list[wp] = (u16)((32 * c + b) * 64 + lane); ++wp; m &= m - 1u; }
    }
}

DI float max2f(float a, float b) { float r; asm("v_max_f32 %0, %1, %2" : "=v"(r) : "v"(a), "v"(b)); return r; }
DI float max8_mfma(const f32x4& a, const f32x4& b) {
    float r;
    asm("s_nop 7\n\tv_max3_f32 %0, %1, %2, %3\n\tv_max3_f32 %0, %0, %4, %5\n\tv_max3_f32 %0, %0, %6, %7\n\tv_max_f32 %0, %0, %8"
        : "=&v"(r) : "v"(a[0]), "v"(a[1]), "v"(a[2]), "v"(a[3]), "v"(b[0]), "v"(b[1]), "v"(b[2]), "v"(b[3]));
    return r;
}
DI float xmax_16_32(float x) {
    const unsigned xi = __float_as_uint(x);
    const auto r = __builtin_amdgcn_permlane16_swap(xi, xi, false, false);
    const unsigned mi = __float_as_uint(max2f(__uint_as_float(r[0]), __uint_as_float(r[1])));
    const auto q = __builtin_amdgcn_permlane32_swap(mi, mi, false, false);
    return max2f(__uint_as_float(q[0]), __uint_as_float(q[1]));
}
DI void attend(const Args& a, size_t brow, int t, int cnt, LAS const u16* list, LAS unsigned char* img, int lane, int fr, int fq) {
    const u16* Q = (const u16*)(a.ws + WS_Q); const u16* KVN = (const u16*)(a.ws + WS_KVN); u16* YO = (u16*)(a.ws + WS_YO);
    const float* qgbase = a.in[I_QNG]; asm volatile("" : "+s"(qgbase));
    bf16x8 qf[4];
    {
        const int head = fr & 7;
        const u16* qrow = Q + (brow + t) * 1024 + head * 128;
        float f[4][8]; float ss = 0.f;
#pragma unroll
        for (int ks = 0; ks < 4; ++ks) {
            const u32x4 raw = *(const u32x4*)(qrow + ks * 32 + 8 * fq);
            f[ks][0] = bflo(raw.x); f[ks][1] = bfhi(raw.x); f[ks][2] = bflo(raw.y); f[ks][3] = bfhi(raw.y); f[ks][4] = bflo(raw.z); f[ks][5] = bfhi(raw.z); f[ks][6] = bflo(raw.w); f[ks][7] = bfhi(raw.w);
#pragma unroll
            for (int j = 0; j < 8; ++j) ss += f[ks][j] * f[ks][j];
        }
        ss += __shfl_xor(ss, 16); ss += __shfl_xor(ss, 32);
        const float rq = __builtin_amdgcn_rsqf(ss * (1.0f / 128.0f) + EPS) * (0.08838834764831845f * 1.4426950408889634f);
#pragma unroll
        for (int ks = 0; ks < 4; ++ks) {
            const float* qg = qgbase + ks * 32 + 8 * fq;
            u32x4 w;
            w.x = pk2(f[ks][0] * rq * qg[0], f[ks][1] * rq * qg[1]); w.y = pk2(f[ks][2] * rq * qg[2], f[ks][3] * rq * qg[3]);
            w.z = pk2(f[ks][4] * rq * qg[4], f[ks][5] * rq * qg[5]); w.w = pk2(f[ks][6] * rq * qg[6], f[ks][7] * rq * qg[7]);
            qf[ks] = __builtin_bit_cast(bf16x8, w);
        }
    }
    const int nsteps = (cnt + 31) >> 5;
    f32x4 oacc[8];
#pragma unroll
    for (int i = 0; i < 8; ++i) oacc[i] = (f32x4){0.f, 0.f, 0.f, 0.f};
    float mrun = -3.0e38f, lpart = 0.f;
    const char* kvb = (const char*)(KVN + brow * 128);
    auto issue = [&](u32x4 (&pf)[8], int pp) {
#pragma unroll
        for (int it = 0; it < 8; ++it) { const int piece = it * 64 + lane; const unsigned key = list[pp * 32 + (piece >> 4)]; pf[it] = *(const u32x4*)(kvb + (key * 256u + 16u * (unsigned)(piece & 15))); }
    };
    auto step = [&](u32x4 (&pf)[8], int pp) {
#pragma unroll
        for (int it = 0; it < 8; ++it) { const int piece = it * 64 + lane; *(LAS u32x4*)(img + (piece >> 4) * 288 + (piece & 15) * 16) = pf[it]; }
        if (pp + 2 < nsteps) issue(pf, pp + 2);
        wave_lds_sync();
        __builtin_amdgcn_sched_barrier(0);
        f32x4 sa = {0.f, 0.f, 0.f, 0.f}, sb = {0.f, 0.f, 0.f, 0.f};
#pragma unroll
        for (int ks = 0; ks < 4; ++ks) {
            const bf16x8 a0 = *(LAS const bf16x8*)(img + fr * 288 + (ks * 32 + 8 * fq) * 2), a1 = *(LAS const bf16x8*)(img + (16 + fr) * 288 + (ks * 32 + 8 * fq) * 2);
            sa = __builtin_amdgcn_mfma_f32_16x16x32_bf16(a0, qf[ks], sa, 0, 0, 0); sb = __builtin_amdgcn_mfma_f32_16x16x32_bf16(a1, qf[ks], sb, 0, 0, 0);
            if (ks == 1) __builtin_amdgcn_sched_barrier(0);
        }
        if (pp * 32 + 32 > cnt) {
            const int pb0 = pp * 32 + 4 * fq;
#pragma unroll
            for (int r = 0; r < 4; ++r) { if (pb0 + r >= cnt) sa[r] = -3.0e38f; if (pb0 + 16 + r >= cnt) sb[r] = -3.0e38f; }
        }
        const float mx = xmax_16_32(max8_mfma(sa, sb));
        if (__ballot(mx > mrun) != 0ull) {
            const float mnew = max2f(mrun, mx), alpha = __builtin_amdgcn_exp2f(mrun - mnew);
            mrun = mnew; lpart *= alpha;
#pragma unroll
            for (int cb = 0; cb < 8; ++cb) oacc[cb] *= alpha;
        }
        float ps = 0.f;
#pragma unroll
        for (int r = 0; r < 4; ++r) { sa[r] = __builtin_amdgcn_exp2f(sa[r] - mrun); sb[r] = __builtin_amdgcn_exp2f(sb[r] - mrun); ps += sa[r] + sb[r]; }
        lpart += ps;
        u32x4 pw; pw.x = pk2(sa[0], sa[1]); pw.y = pk2(sa[2], sa[3]); pw.z = pk2(sb[0], sb[1]); pw.w = pk2(sb[2], sb[3]);
        const bf16x8 pb = __builtin_bit_cast(bf16x8, pw);
#pragma unroll
        for (int cb = 0; cb < 8; ++cb) {
            const s16x4 r0 = __builtin_amdgcn_ds_read_tr16_b64_v4i16((LAS s16x4*)(img + (4 * fq + (fr >> 2)) * 288 + (cb * 16 + 4 * (fr & 3)) * 2));
            const s16x4 r1 = __builtin_amdgcn_ds_read_tr16_b64_v4i16((LAS s16x4*)(img + (16 + 4 * fq + (fr >> 2)) * 288 + (cb * 16 + 4 * (fr & 3)) * 2));
            const bf16x8 av = {r0[0], r0[1], r0[2], r0[3], r1[0], r1[1], r1[2], r1[3]};
            oacc[cb] = __builtin_amdgcn_mfma_f32_16x16x32_bf16(av, pb, oacc[cb], 0, 0, 0);
            if (cb == 3) __builtin_amdgcn_sched_barrier(0);
        }
        wave_lds_sync();
    };
    u32x4 pf0[8], pf1[8];
    issue(pf0, 0);
    if (nsteps > 1) issue(pf1, 1);
#pragma unroll 1
    for (int pp = 0; pp < nsteps; pp += 2) {
        step(pf0, pp);
        if (pp + 1 < nsteps) step(pf1, pp + 1);
    }
    float lsum = lpart; lsum += __shfl_xor(lsum, 16); lsum += __shfl_xor(lsum, 32);
    const float inv = __builtin_amdgcn_rcpf(lsum);
    if (fr < 8) {
        u16* orow = YO + (brow + t) * 1536 + 512 + fr * 128 + 4 * fq;
#pragma unroll
        for (int cb = 0; cb < 8; ++cb) { u32x2 w; w.x = pk2(oacc[cb][0] * inv, oacc[cb][1] * inv); w.y = pk2(oacc[cb][2] * inv, oacc[cb][3] * inv); *(u32x2*)(orow + cb * 16) = w; }
    }
}

constexpr int N_CVT_JOBS = 32 * 16 * 32 + 32 * 16 * 16;
DI void cvt_job(const Args& a, LAS float* t, int J, int lane) {
    if (J >= N_CVT_JOBS) return;
    const float* src; const float* sk; unsigned char* dst; int ld, k0, n0, row;
    if (J < 16384) {
        const int e = J >> 9, w = J & 511; src = a.in[I_WE1] + (size_t)e * 1024 * 2048; ld = 2048; k0 = (w >> 5) * 64; n0 = (w & 31) * 64; sk = a.in[I_N2G]; dst = a.ws + WS_WE1 + (size_t)e * 2048 * 1024;
        const int n = n0 + lane, hi = n >= 1024 ? 1 : 0, q = n - hi * 1024; row = (q >> 7) * 256 + hi * 128 + (q & 127);
    } else {
        const int j = J - 16384, e = j >> 8, w = j & 255; src = a.in[I_WE2] + (size_t)e * 1024 * 1024; ld = 1024; k0 = (w >> 4) * 64; n0 = (w & 15) * 64; sk = nullptr; dst = a.ws + WS_WE2 + (size_t)e * 1024 * 1024;
        row = n0 + lane;
    }
    const int kl = lane >> 4, n4 = 4 * (lane & 15);
    f32x4 v[4][4];
#pragma unroll
    for (int ks = 0; ks < 4; ++ks)
#pragma unroll
        for (int i = 0; i < 4; ++i) v[ks][i] = __builtin_nontemporal_load((const f32x4*)(src + (size_t)(k0 + ks * 16 + kl + 4 * i) * ld + n0 + n4));
    unsigned char* drow = dst + (size_t)row * 1024 + k0;
#pragma unroll
    for (int ks = 0; ks < 4; ++ks) {
#pragma unroll
        for (int i = 0; i < 4; ++i) { const float sc = (sk ? sk[k0 + ks * 16 + kl + 4 * i] : 1.0f) * 64.0f; *(LAS f32x4*)(t + (kl + 4 * i) * 64 + n4) = v[ks][i] * sc; }
        wave_lds_sync();
        float c[16];
#pragma unroll
        for (int k = 0; k < 16; ++k) c[k] = t[k * 64 + lane];
        u32x4 w; w.x = pk4_fp8(c[0], c[1], c[2], c[3]); w.y = pk4_fp8(c[4], c[5], c[6], c[7]); w.z = pk4_fp8(c[8], c[9], c[10], c[11]); w.w = pk4_fp8(c[12], c[13], c[14], c[15]);
        *(u32x4*)(drow + ks * 16) = w;
        wave_lds_sync();
    }
}

template <bool ROLE_A>
DI void dsa_loop(const Args& a, LAS unsigned char* lds, const int wid) {
    unsigned char* ws = a.ws;
    LAS u16* rows = (LAS u16*)(lds + P3_ROWS);
    bool bprev = false; size_t pbrow = 0; int pt0 = 0, bbuf = 0;
    for (int gi = blockIdx.x; gi < T / 8; gi += gridDim.x) {
        const int lane = otid() & 63, fr = lane & 15, fq = lane >> 4;
        const int b = gi & 3, t0 = S - 8 - 8 * (gi >> 2);
        const size_t brow = (size_t)b * S;
        const int ntile = (t0 + 8 + 15) >> 4;
        __syncthreads();
        {
            const unsigned char* QI = (const unsigned char*)(ws + WS_QI); const unsigned char* KIN = (const unsigned char*)(ws + WS_KIN); const float* WI = (const float*)(ws + WS_WI);
            typedef int i32x4_t __attribute__((ext_vector_type(4)));
            i32x4_t qa[2]; f32x4 wi[2];
#pragma unroll
            for (int rg = 0; rg < 2; ++rg) {
                qa[rg] = *(const i32x4_t*)(QI + (brow + t0 + 4 * rg + (fr >> 2)) * 256 + (fr & 3) * 64 + 16 * fq);
                wi[rg] = *(const f32x4*)(WI + (brow + t0 + 4 * rg + fq) * 4);
            }
            auto ldk = [&](i32x4_t (&kf)[4], int jt0) {
#pragma unroll
                for (int u = 0; u < 4; ++u) {
                    const int jt = (jt0 + 8 * u) < ntile ? (jt0 + 8 * u) : (ntile - 1);
                    kf[u] = *(const i32x4_t*)(KIN + (brow + jt * 16 + fr) * 64 + 16 * fq);
                }
            };
            auto cmpk = [&](const i32x4_t (&kf)[4], int jt0) {
#pragma unroll
                for (int u = 0; u < 4; ++u) {
                    const int jt = jt0 + 8 * u;
                    if (jt < ntile) {
                        float sc[2];
#pragma unroll
                        for (int rg = 0; rg < 2; ++rg) {
                            i32x4_t d = {0, 0, 0, 0};
                            d = __builtin_amdgcn_mfma_i32_16x16x64_i8(qa[rg], kf[u], d, 0, 0, 0);
                            sc[rg] = (((float)max(d[0], 0) * wi[rg][0] + (float)max(d[1], 0) * wi[rg][1]) + (float)max(d[2], 0) * wi[rg][2]) + (float)max(d[3], 0) * wi[rg][3];
                        }
                        const unsigned kw = bf2keys(pk2(sc[0], sc[1]));
                        const int ra = ((jt >> 5) << 9) | ((jt & 3) << 7) | ((jt >> 2) & 7);
                        LAS u16* wp = rows + (fq * 16384 + fr * 8) + ra;
                        wp[0] = (u16)kw; wp[8192] = (u16)(kw >> 16);
                    }
                }
            };
            i32x4_t kA[4], kB[4];
            if (wid < ntile) ldk(kA, wid);
            for (int jt0 = wid; jt0 < ntile; jt0 += 64) {
                const bool hasB = jt0 + 32 < ntile;
                if (hasB) ldk(kB, jt0 + 32);
                cmpk(kA, jt0);
                if (hasB) { if (jt0 + 64 < ntile) ldk(kA, jt0 + 64); cmpk(kB, jt0 + 32); }
            }
        }
        __syncthreads();
        if constexpr (ROLE_A) {
            u32x4 kr[16];
            const int N0 = t0 + wid + 1, N1 = N0 + 4;
            if (N0 > 256) keys_load(rows + wid * 16384, N0, lane, kr);
            __syncthreads();
            LAS u16* l0 = (LAS u16*)(lds + (bbuf ? P3_HIST : P3_LIST) + wid * 512);
            LAS u16* l1 = l0 + 4 * 256;
            if (N0 > 256) keys_select(kr, l0, N0, lane); else { for (int p = lane; p < 256; p += 64) l0[p] = p < N0 ? (u16)p : (u16)0; }
            if (N1 > 256) { keys_load(rows + wid * 16384 + 8192, N1, lane, kr); keys_select(kr, l1, N1, lane); } else { for (int p = lane; p < 256; p += 64) l1[p] = p < N1 ? (u16)p : (u16)0; }
            {
                const int G3 = gridDim.x, c3 = blockIdx.x, it3 = (gi - c3) / G3, ntrip = (T / 8 - c3 + G3 - 1) / G3, jtot = (N_CVT_JOBS + 4 * G3 - 1) / (4 * G3);
                const int jlo = (jtot * it3 + ntrip - 1) / ntrip, jhi = (jtot * (it3 + 1) + ntrip - 1) / ntrip;
                LAS float* tcv = (LAS float*)(lds + (wid < 3 ? 135168 + wid * 4096 : 151552));
#pragma unroll 1
                for (int j = jlo; j < jhi; ++j) cvt_job(a, tcv, (j * 4 + wid) * G3 + c3, lane);
            }
        } else {
            __syncthreads();
            if (bprev) {
                LAS const u16* lp = (LAS const u16*)(lds + (bbuf ? P3_LIST : P3_HIST));
                LAS unsigned char* img = (LAS unsigned char*)(rows + (wid - 4) * 16384);
                { const int q = wid - 4, t = pt0 + q; attend(a, pbrow, t, t + 1 < 256 ? t + 1 : 256, lp + q * 256, img, lane, fr, fq); }
                { const int q = wid, t = pt0 + q; attend(a, pbrow, t, t + 1 < 256 ? t + 1 : 256, lp + q * 256, img, lane, fr, fq); }
            }
        }
        bprev = true; pbrow = brow; pt0 = t0; bbuf ^= 1;
    }
}

DI void dsa_phase(const Args& a, LAS unsigned char* lds) {
    const int wid = __builtin_amdgcn_readfirstlane(otid() >> 6);
    if (wid < 4) dsa_loop<true>(a, lds, wid); else dsa_loop<false>(a, lds, wid);
    __syncthreads();
    {
        const int ntrip = (T / 8 - (int)blockIdx.x + (int)gridDim.x - 1) / (int)gridDim.x;
        if (ntrip > 0) {
            const int gl = blockIdx.x + (ntrip - 1) * gridDim.x, pt0 = S - 8 - 8 * (gl >> 2);
            const size_t pbrow = (size_t)(gl & 3) * S;
            const int lane = otid() & 63, fr = lane & 15, fq = lane >> 4;
            LAS u16* rows = (LAS u16*)(lds + P3_ROWS);
            LAS const u16* lp = (LAS const u16*)(lds + ((ntrip & 1) ? P3_LIST : P3_HIST));
            const int q = wid, t = pt0 + q;
            attend(a, pbrow, t, t + 1 < 256 ? t + 1 : 256, lp + q * 256, (LAS unsigned char*)(rows + wid * 8192), lane, fr, fq);
        }
    }
}

constexpr int P6_LCNT = 0, P6_BASE = 128, P6_RSB = 256, P6_RI = 1024;
DI unsigned dpp_max_u32(unsigned v) {
    v = max(v, (unsigned)__builtin_amdgcn_update_dpp(0, (int)v, 0xB1, 0xf, 0xf, false));
    v = max(v, (unsigned)__builtin_amdgcn_update_dpp(0, (int)v, 0x4E, 0xf, 0xf, false));
    v = max(v, (unsigned)__builtin_amdgcn_update_dpp(0, (int)v, 0x141, 0xf, 0xf, false));
    v = max(v, (unsigned)__builtin_amdgcn_update_dpp(0, (int)v, 0x140, 0xf, 0xf, false));
    return v;
}
DI float key2f(unsigned k) { return __uint_as_float((k & 0x80000000u) ? (k & 0x7fffffffu) : ~k); }
DI void router_phase(const Args& a, LAS unsigned char* lds) {
    unsigned char* ws = a.ws;
    const int tid = otid(), wid = tid >> 6, lane = tid & 63, fr = lane & 15, fq = lane >> 4;
    LAS int* lcnt = (LAS int*)(lds + P6_LCNT); LAS int* lbase = (LAS int*)(lds + P6_BASE); LAS float* rsb = (LAS float*)(lds + P6_RSB); LAS int* RI = (LAS int*)(lds + P6_RI);
    const u16* WRH = (const u16*)(ws + WS_WR);
    unsigned* CNT = (unsigned*)(ws + WS_CTL);
    LAS unsigned char* WL = lds + 16384;
    __syncthreads();
    for (int i = tid; i < 64 * 128; i += NT) { const int r = i >> 7, p = i & 127; *(LAS u32x4*)(WL + r * 2064 + p * 16) = *(const u32x4*)(WRH + (size_t)r * 1024 + p * 8); }
    for (int rg = blockIdx.x; rg < T / 128; rg += gridDim.x) {
        __syncthreads();
        if (tid < 32) lcnt[tid] = 0;
        __syncthreads();
        {
            const int row = rg * 128 + wid * 16 + fr;
            const float* xr = a.out + (size_t)row * 1024 + 8 * fq;
            f32x4 acc[2] = {{0.f, 0.f, 0.f, 0.f}, {0.f, 0.f, 0.f, 0.f}};
            float ss = 0.f;
#pragma unroll 4
            for (int ks = 0; ks < 32; ++ks) {
                const f32x4 x0 = *(const f32x4*)(xr + ks * 32), x1 = *(const f32x4*)(xr + ks * 32 + 4);
                ss += ((x0[0] * x0[0] + x0[1] * x0[1]) + (x0[2] * x0[2] + x0[3] * x0[3])) + ((x1[0] * x1[0] + x1[1] * x1[1]) + (x1[2] * x1[2] + x1[3] * x1[3]));
                u32x4 hw; hw.x = pk2(x0[0], x0[1]); hw.y = pk2(x0[2], x0[3]); hw.z = pk2(x1[0], x1[1]); hw.w = pk2(x1[2], x1[3]);
                u32x4 lw; lw.x = pk2(x0[0] - bflo(hw.x), x0[1] - bfhi(hw.x)); lw.y = pk2(x0[2] - bflo(hw.y), x0[3] - bfhi(hw.y)); lw.z = pk2(x1[0] - bflo(hw.z), x1[1] - bfhi(hw.z)); lw.w = pk2(x1[2] - bflo(hw.w), x1[3] - bfhi(hw.w));
                const bf16x8 xh = __builtin_bit_cast(bf16x8, hw), xl = __builtin_bit_cast(bf16x8, lw);
#pragma unroll
                for (int nt = 0; nt < 2; ++nt) {
                    const bf16x8 wh = *(LAS const bf16x8*)(WL + (nt * 16 + fr) * 2064 + (ks * 32 + 8 * fq) * 2), wl = *(LAS const bf16x8*)(WL + (32 + nt * 16 + fr) * 2064 + (ks * 32 + 8 * fq) * 2);
                    acc[nt] = __builtin_amdgcn_mfma_f32_16x16x32_bf16(xh, wh, acc[nt], 0, 0, 0);
                    acc[nt] = __builtin_amdgcn_mfma_f32_16x16x32_bf16(xl, wh, acc[nt], 0, 0, 0);
                    acc[nt] = __builtin_amdgcn_mfma_f32_16x16x32_bf16(xh, wl, acc[nt], 0, 0, 0);
                }
            }
            ss += __shfl_xor(ss, 16); ss += __shfl_xor(ss, 32);
            const float rsrow = __builtin_amdgcn_rsqf(ss * (1.0f / 1024.0f) + EPS);
            if (fq == 0) rsb[wid * 16 + fr] = rsrow;
            {
                unsigned char* xn = ws + WS_XN2 + (size_t)row * 1024 + 8 * fq;
#pragma unroll 4
                for (int ks = 0; ks < 32; ++ks) {
                    const f32x4 x0 = *(const f32x4*)(xr + ks * 32), x1 = *(const f32x4*)(xr + ks * 32 + 4);
                    u32x2 w; w.x = pk4_fp8(x0[0] * rsrow, x0[1] * rsrow, x0[2] * rsrow, x0[3] * rsrow); w.y = pk4_fp8(x1[0] * rsrow, x1[1] * rsrow, x1[2] * rsrow, x1[3] * rsrow);
                    *(u32x2*)(xn + ks * 32) = w;
                }
            }
            wave_lds_sync();
            const float b0 = a.in[I_BR][fr], b1 = a.in[I_BR][16 + fr];
#pragma unroll
            for (int r = 0; r < 4; ++r) {
                const float rs = rsb[wid * 16 + 4 * fq + r];
                unsigned k0 = (f2key(acc[0][r] * rs + b0) & ~31u) | (unsigned)(31 - fr), k1 = (f2key(acc[1][r] * rs + b1) & ~31u) | (unsigned)(15 - fr);
                unsigned sel[4];
#pragma unroll
                for (int k = 0; k < 4; ++k) {
                    const unsigned best = dpp_max_u32(k0 > k1 ? k0 : k1);
                    sel[k] = best;
                    if (k0 == best) k0 = 0u;
                    if (k1 == best) k1 = 0u;
                }
                const float v0 = key2f(sel[0] & ~31u), e1 = __expf(key2f(sel[1] & ~31u) - v0), e2 = __expf(key2f(sel[2] & ~31u) - v0), e3 = __expf(key2f(sel[3] & ~31u) - v0);
                const float inv = 1.0f / (1.0f + e1 + e2 + e3);
                if (fr < 4) {
                    const unsigned sk = fr == 0 ? sel[0] : (fr == 1 ? sel[1] : (fr == 2 ? sel[2] : sel[3]));
                    const int e = 31 - (int)(sk & 31u);
                    const float gt = (fr == 0 ? 1.0f : (fr == 1 ? e1 : (fr == 2 ? e2 : e3))) * inv;
                    const int ls = __hip_atomic_fetch_add(lcnt + e, 1, __ATOMIC_RELAXED, __HIP_MEMORY_SCOPE_WORKGROUP);
                    const int ri = ((wid * 16 + 4 * fq + r) * 4 + fr) * 4;
                    RI[ri + 0] = e; RI[ri + 1] = ls; RI[ri + 2] = __float_as_int(gt);
                }
            }
        }
        __syncthreads();
        if (tid < 32) lbase[tid] = (int)__hip_atomic_fetch_add(CNT + tid, (unsigned)lcnt[tid], __ATOMIC_RELAXED, __HIP_MEMORY_SCOPE_AGENT);
        __syncthreads();
        {
            const int rl = tid >> 2, k = tid & 3, row = rg * 128 + rl;
            const int e = RI[tid * 4 + 0], slot = lbase[e] + RI[tid * 4 + 1];
            ((int*)(ws + WS_LTOK))[(size_t)e * ECAP + slot] = row;
            ((float*)(ws + WS_LRS))[(size_t)row * 4 + k] = __int_as_float(RI[tid * 4 + 2]);
            ((unsigned*)(ws + WS_ROUTE))[(size_t)row * 4 + k] = ((unsigned)e << 16) | (unsigned)slot;
        }
    }
}

DI void combine_phase(const Args& a, LAS unsigned char* lds) {
    unsigned char* ws = a.ws;
    LAS const int* tab = (LAS const int*)(lds + MOE_TAB);
    const int tid = otid(), wid = tid >> 6, lane = tid & 63;
    const u16* YB = (const u16*)(ws + WS_YB); const unsigned* ROUTE = (const unsigned*)(ws + WS_ROUTE);
    for (int row = blockIdx.x * 8 + wid; row < T; row += gridDim.x * 8) {
        size_t pos[4];
#pragma unroll
        for (int k = 0; k < 4; ++k) { const unsigned r = ROUTE[(size_t)row * 4 + k]; const int e = (int)(r >> 16), slot = (int)(r & 0xffffu); pos[k] = (size_t)tab[e] * 256 + slot; }
        float* orow = a.out + (size_t)row * 1024;
        const f32x4 gt = *(const f32x4*)((const float*)(ws + WS_LRS) + (size_t)row * 4);
#pragma unroll
        for (int i = 0; i < 4; ++i) {
            f32x4 v = *(const f32x4*)(orow + i * 256 + lane * 4);
#pragma unroll
            for (int k = 0; k < 4; ++k) { const u32x2 y = __builtin_nontemporal_load((const u32x2*)(YB + pos[k] * 1024 + i * 256 + lane * 4)); v[0] += gt[k] * bflo(y.x); v[1] += gt[k] * bfhi(y.x); v[2] += gt[k] * bflo(y.y); v[3] += gt[k] * bfhi(y.y); }
            *(f32x4*)(orow + i * 256 + lane * 4) = v;
        }
    }
}

#define XB_TMO      128
#define XB_XCNT(j)  (256  + 64 * (j))
#define XB_XSUB(j)  (1280 + 64 * (j))
#define XB_XGEN(j)  (2304 + 64 * (j))
#define XB_TOP      3328
#define XB_TOPGEN   3392
#define XCD_BAR_WORDS 3456
#define XB_SPIN_CAP (1u << 18)

__device__ __forceinline__ unsigned xb_ld(unsigned* p)              { return __hip_atomic_load(p, __ATOMIC_RELAXED, __HIP_MEMORY_SCOPE_AGENT); }
__device__ __forceinline__ unsigned xb_add(unsigned* p, unsigned v) { return __hip_atomic_fetch_add(p, v, __ATOMIC_RELAXED, __HIP_MEMORY_SCOPE_AGENT); }
__device__ __forceinline__ unsigned xb_xcc_id() { return (unsigned)__builtin_amdgcn_s_getreg((3 << 11) | 20) & 0xFu; }
#define XB_SPIN(cond, bar) do { unsigned _sp = 0; while (cond) { __builtin_amdgcn_s_sleep(1); \
    if ((++_sp & 255u) == 0u) { if (xb_ld(&(bar)[XB_TMO])) break; if (_sp > XB_SPIN_CAP) { atomicAdd(&(bar)[XB_TMO], 1u); break; } } } } while (0)

struct XcdBarrier {
    unsigned* bar; unsigned x;
    volatile LAS unsigned* st;
};

__device__ __forceinline__ XcdBarrier xcd_barrier_post(unsigned* bar, volatile LAS unsigned* st) {
    XcdBarrier b; b.bar = bar; b.x = xb_xcc_id(); b.st = st;
    if (threadIdx.x == 0) (void)xb_add(&bar[XB_XCNT(b.x)], 1u);
    return b;
}
__device__ __forceinline__ void xcd_barrier_complete(unsigned* bar, unsigned x, unsigned& nloc, unsigned& nx) {
    const unsigned G = gridDim.x * gridDim.y * gridDim.z;
    unsigned sum, cnt, mine, sp = 0u;
    for (;;) {
        sum = 0u; cnt = 0u; mine = 0u;
#pragma unroll
        for (unsigned j = 0; j < 16; ++j) { const unsigned c = xb_ld(&bar[XB_XCNT(j)]); sum += c; cnt += (c > 0u) ? 1u : 0u; mine = (j == x) ? c : mine; }
        if (sum == G) break;
        __builtin_amdgcn_s_sleep(1);
        if ((++sp & 255u) == 0u) { if (xb_ld(&bar[XB_TMO])) break; if (sp > XB_SPIN_CAP) { atomicAdd(&bar[XB_TMO], 1u); break; } }
    }
    nloc = mine > 0u ? mine : 1u; nx = cnt > 0u ? cnt : 1u;
}

__device__ __forceinline__ void xcd_barrier(const XcdBarrier& b) {
    asm volatile("s_waitcnt vmcnt(0)" ::: "memory");
    __syncthreads();
    if (threadIdx.x == 0) {
        unsigned* bar = b.bar;
        __builtin_amdgcn_s_waitcnt(0);
        unsigned nloc = b.st[0], nx = b.st[1];
        if (nloc == 0u) { xcd_barrier_complete(bar, b.x, nloc, nx); b.st[0] = nloc; b.st[1] = nx; }
        const unsigned old = xb_add(&bar[XB_XSUB(b.x)], 1u);
        const unsigned gen = old / nloc;
        if (old + 1u == (gen + 1u) * nloc) {
            __builtin_amdgcn_fence(__ATOMIC_RELEASE, "agent");
            asm volatile("s_waitcnt vmcnt(0)" ::: "memory");
            const unsigned og = xb_add(&bar[XB_TOP], 1u);
            const unsigned tg = og / nx;
            if (og + 1u == (tg + 1u) * nx) xb_add(&bar[XB_TOPGEN], 1u);
            else XB_SPIN(xb_ld(&bar[XB_TOPGEN]) == tg, bar);
            __builtin_amdgcn_fence(__ATOMIC_ACQUIRE, "agent");
            xb_add(&bar[XB_XGEN(b.x)], 1u);
            asm volatile("s_waitcnt vmcnt(0)" ::: "memory");
        } else {
            XB_SPIN(xb_ld(&bar[XB_XGEN(b.x)]) == gen, bar);
            __builtin_amdgcn_fence(__ATOMIC_ACQUIRE, "agent");
            asm volatile("s_waitcnt vmcnt(0)" ::: "memory");
        }
    }
    __syncthreads();
}

__global__ void __launch_bounds__(NT, 2) fwd(Args a) {
    extern __shared__ __attribute__((aligned(16))) unsigned char lds_raw[];
    LAS unsigned char* lds = (LAS unsigned char*)lds_raw;
    cg::grid_group grid = cg::this_grid();
    unsigned char* ws = a.ws;
    const int G = gridDim.x, c = blockIdx.x;
    if (threadIdx.x < 2) ((volatile LAS unsigned*)(lds + LDS_BARST))[threadIdx.x] = 0u;
    __syncthreads();
    const XcdBarrier xbar = xcd_barrier_post((unsigned*)(ws + WS_BAR), (volatile LAS unsigned*)(lds + LDS_BARST));

    phase0(a, lds);
    xcd_barrier(xbar);
    {
        g8::PlainSched s; s.Abase = (const char*)(ws + WS_XB); s.Bbase = (const char*)(ws + WS_WIN); s.lda = 1024; s.ldb = 1024; s.K = 1024; s.nM = T / 256; s.nN = NIN / 256; s.G = G; s.c = c;
        EpiIn e; e.H = (u16*)(ws + WS_H); e.rs1 = (const float*)(ws + WS_RS1); e.SSQ = (float*)(ws + WS_SSQ); e.WI = (float*)(ws + WS_WI);
        g8::gemm_phase(lds, s, e);
    }
    xcd_barrier(xbar);
    {
        g8::PlainSched s; s.Abase = (const char*)(ws + WS_H) + 1024 * 2; s.Bbase = (const char*)(ws + WS_WQ); s.lda = NIN; s.ldb = 256; s.K = 256; s.nM = T / 256; s.nN = 5; s.G = G; s.c = c;
        EpiQ e; e.Q = (u16*)(ws + WS_Q); e.QI = (u16*)(ws + WS_QI); e.SSQ = (const float*)(ws + WS_SSQ);
        g8::gemm_phase(lds, s, e);
        for (int u = c; u < 1024; u += G) gmlp_unit(a, lds, u);
        kvnorm(a);
    }
    xcd_barrier(xbar);
    dsa_phase(a, lds);
    xcd_barrier(xbar);
    {
        g8::PlainSched s; s.Abase = (const char*)(ws + WS_YO); s.Bbase = (const char*)(ws + WS_WCAT); s.lda = 1536; s.ldb = 1536; s.K = 512; s.nM = T / 256; s.nN = 4; s.G = G; s.c = c;
        EpiMrg<0> e0; e0.OUT = (u16*)(ws + WS_TMP); e0.TMP = nullptr; e0.H = (const u16*)(ws + WS_H);
        g8::gemm_phase(lds, s, e0);
        s.Abase = (const char*)(ws + WS_YO) + 512 * 2; s.Bbase = (const char*)(ws + WS_WCAT) + 512 * 2; s.K = 1024;
        EpiMrg<1> e1; e1.OUT = (u16*)(ws + WS_MRG); e1.TMP = (const u16*)(ws + WS_TMP); e1.H = (const u16*)(ws + WS_H);
        g8::gemm_phase(lds, s, e1);
    }
    xcd_barrier(xbar);
    {
        g8::PlainSched s; s.Abase = (const char*)(ws + WS_MRG); s.Bbase = (const char*)(ws + WS_WOUT); s.lda = 1024; s.ldb = 1024; s.K = 1024; s.nM = T / 256; s.nN = 4; s.G = G; s.c = c;
        EpiOut e; e.out = a.out; e.x = a.in[I_X];
        g8::gemm_phase(lds, s, e);
    }
    xcd_barrier(xbar);
    router_phase(a, lds);
    xcd_barrier(xbar);
    moe_table(lds, (const unsigned*)(ws + WS_CTL));
    {
        MoeSched<8, true> s; s.Abase = (const char*)(ws + WS_XN2); s.Wbase = (const char*)(ws + WS_WE1); s.LTOK = (const int*)(ws + WS_LTOK); s.tab = (LAS const int*)(lds + MOE_TAB);
        s.lda = 1024; s.ldb = 1024; s.K = 1024; s.G = G; s.c = c; s.wstride = (size_t)2048 * 1024;
        EpiMoe1 e; e.ACT = (unsigned char*)(ws + WS_ACT); e.b1 = a.in[I_BE1];
        g8::gemm_phase<true>(lds, s, e);
    }
    xcd_barrier(xbar);
    {
        MoeSched<4, false> s; s.Abase = (const char*)(ws + WS_ACT); s.Wbase = (const char*)(ws + WS_WE2); s.LTOK = nullptr; s.tab = (LAS const int*)(lds + MOE_TAB);
        s.lda = 1024; s.ldb = 1024; s.K = 1024; s.G = G; s.c = c; s.wstride = (size_t)1024 * 1024;
        EpiMoe2 e; e.YB = (u16*)(ws + WS_YB); e.b2 = a.in[I_BE2];
        g8::gemm_phase<true>(lds, s, e);
    }
    xcd_barrier(xbar);
    combine_phase(a, lds);
    if (a.mask == 0u) grid.sync();
}

extern "C" void kernel_launch(void* const* d_in, const int* in_sizes, int n_in, void* d_out, int out_size, void* d_ws, size_t ws_size, hipStream_t stream) {
    static int grid = 0;
    if (grid == 0) {
        int dev = 0, cus = 0, per_cu = 0;
        if (n_in != 23 || out_size != T * Dm || ws_size < WS_END) { fprintf(stderr, "kernel_launch: unexpected problem (n_in %d, out %d, ws %zu < %zu)\n", n_in, out_size, ws_size, (size_t)WS_END); grid = -1; return; }
        if (hipGetDevice(&dev) != hipSuccess || hipDeviceGetAttribute(&cus, hipDeviceAttributeMultiprocessorCount, dev) != hipSuccess) { grid = -1; return; }
        if (hipFuncSetAttribute((const void*)fwd, hipFuncAttributeMaxDynamicSharedMemorySize, LDS_BYTES) != hipSuccess) { fprintf(stderr, "hipFuncSetAttribute failed\n"); grid = -1; return; }
        if (hipOccupancyMaxActiveBlocksPerMultiprocessor(&per_cu, (const void*)fwd, NT, LDS_BYTES) != hipSuccess || per_cu < 1) { fprintf(stderr, "occupancy query failed (%d)\n", per_cu); grid = -1; return; }
        grid = cus;
        fprintf(stderr, "kernel_launch: cus %d per_cu %d grid %d ws %zu need %zu\n", cus, per_cu, grid, ws_size, (size_t)WS_END);
    }
    if (grid < 0) return;
    Args a{};
    for (int i = 0; i < 23; ++i) a.in[i] = (const float*)d_in[i];
    a.out = (float*)d_out; a.ws = (unsigned char*)d_ws; a.mask = 0xffffffffu; a.pad = 0u;
    if (hipMemsetAsync((char*)d_ws + WS_CTL, 0, 65536, stream) != hipSuccess) { fprintf(stderr, "memset failed\n"); return; }
    void* args[] = {&a};
    hipError_t e = hipLaunchCooperativeKernel((const void*)fwd, dim3(grid), dim3(NT), args, LDS_BYTES, stream);
    if (e != hipSuccess) fprintf(stderr, "cooperative launch failed: %s (grid %d)\n", hipGetErrorString(e), grid);
}
```

```cpp
#include <hip/hip_runtime.h>
#include <hip/hip_cooperative_groups.h>
#include <cstdio>
#include <cstdint>
namespace cg = cooperative_groups;

#define LAS __attribute__((address_space(3)))
#define DI __device__ __forceinline__
typedef unsigned short u16;
typedef short bf16x8 __attribute__((ext_vector_type(8)));
typedef short s16x4 __attribute__((ext_vector_type(4)));
typedef float f32x4 __attribute__((ext_vector_type(4)));
typedef float f32x2 __attribute__((ext_vector_type(2)));
typedef unsigned u32x4 __attribute__((ext_vector_type(4)));
typedef unsigned u32x2 __attribute__((ext_vector_type(2)));
typedef __bf16 bf2_t __attribute__((ext_vector_type(2)));
typedef int v8i_t __attribute__((ext_vector_type(8)));

constexpr int NT = 512;
constexpr int LDS_BYTES = 159744;
constexpr int Dm = 1024, Bsz = 4, S = 8192, T = Bsz * S;
constexpr int NIN = 3584;
constexpr int NE = 32, ECAP = 32768, PPAD = 131072 + NE * 256;
constexpr float EPS = 1e-6f;

constexpr size_t MiB = 1024 * 1024;
constexpr size_t WS_CTL = 0;
constexpr size_t WS_BAR = 16384;
constexpr int LDS_BARST = LDS_BYTES - 16;
constexpr size_t WS_WIN = 64 * 1024;
constexpr size_t WS_WQ = WS_WIN + (size_t)NIN * 1024 * 2;
constexpr size_t WS_WSP = WS_WQ + 1280 * 256 * 2;
constexpr size_t WS_WCAT = WS_WSP + 4 * 128 * 128 * 2;
constexpr size_t WS_WOUT = WS_WCAT + 1024 * 1536 * 2;
constexpr size_t WS_WR = WS_WOUT + 1024 * 1024 * 2;
constexpr size_t WS_WE1 = WS_WR + 32 * 1024 * 4;
constexpr size_t WS_WE2 = WS_WE1 + (size_t)32 * 2048 * 1024 * 2;
constexpr size_t WS_RS1 = WS_WE2 + (size_t)32 * 1024 * 1024 * 2;
constexpr size_t WS_SSQ = WS_RS1 + (size_t)T * 4;
constexpr size_t WS_WI = WS_SSQ + (size_t)T * 32 * 4;
constexpr size_t WS_ROUTE = WS_WI + (size_t)T * 4 * 4;
constexpr size_t WS_LTOK = WS_ROUTE + (size_t)T * 4 * 4;
constexpr size_t WS_LGATE = WS_LTOK + (size_t)NE * ECAP * 4;
constexpr size_t WS_LRS = WS_LGATE + (size_t)NE * ECAP * 4;
constexpr size_t WS_XN2 = WS_LRS + (size_t)NE * ECAP * 4;
constexpr size_t WS_R0 = WS_XN2 + (size_t)T * 1024 * 2;
constexpr size_t WS_XB = WS_R0;
constexpr size_t WS_H = WS_XB + (size_t)T * 1024 * 2;
constexpr size_t WS_Q = WS_H + (size_t)T * NIN * 2;
constexpr size_t WS_QI = WS_Q + (size_t)T * 1024 * 2;
constexpr size_t WS_KVN = WS_QI + (size_t)T * 256 * 2;
constexpr size_t WS_KIN = WS_KVN + (size_t)T * 128 * 2;
constexpr size_t WS_YO = WS_KIN + (size_t)T * 64 * 2;
constexpr size_t WS_TMP = WS_YO + (size_t)T * 1536 * 2;
constexpr size_t WS_MRG = WS_TMP + (size_t)T * 1024 * 2;
constexpr size_t WS_R0END = WS_MRG + (size_t)T * 1024 * 2;
constexpr size_t WS_ACT = WS_XB;
constexpr size_t WS_YB = WS_Q;
static_assert(WS_ACT + (size_t)PPAD * 1024 * 2 <= WS_Q, "ACT overlaps YB");
static_assert(WS_YB + (size_t)PPAD * 1024 * 2 <= WS_R0END, "YB too large");
constexpr size_t WS_END = WS_R0END;

struct Args { const float* in[23]; float* out; unsigned char* ws; unsigned mask; unsigned pad; };
enum { I_X = 0, I_N1G, I_WIN, I_QLG, I_WUQ, I_QNG, I_KVG, I_WUV, I_WQI, I_KIG, I_VG, I_WSP, I_BSP, I_WPA, I_WPB, I_WOUT, I_N2G, I_WR, I_BR, I_WE1, I_BE1, I_WE2, I_BE2 };

DI unsigned pk2(float a, float b) { f32x2 v = {a, b}; bf2_t r = __builtin_convertvector(v, bf2_t); return __builtin_bit_cast(unsigned, r); }
DI unsigned pk4_fp8(float a, float b, float c, float d) { unsigned w = 0u; w = (unsigned)__builtin_amdgcn_cvt_pk_fp8_f32(a, b, (int)w, false); w = (unsigned)__builtin_amdgcn_cvt_pk_fp8_f32(c, d, (int)w, true); return w; }
DI unsigned pk4_i8(float a, float b, float c, float d) {
    const int ia = (int)__builtin_rintf(fminf(fmaxf(a * 32.0f, -127.0f), 127.0f)), ib = (int)__builtin_rintf(fminf(fmaxf(b * 32.0f, -127.0f), 127.0f));
    const int ic = (int)__builtin_rintf(fminf(fmaxf(c * 32.0f, -127.0f), 127.0f)), id = (int)__builtin_rintf(fminf(fmaxf(d * 32.0f, -127.0f), 127.0f));
    return (unsigned)(ia & 0xff) | ((unsigned)(ib & 0xff) << 8) | ((unsigned)(ic & 0xff) << 16) | ((unsigned)(id & 0xff) << 24);
}
DI float bflo(unsigned u) { return __uint_as_float(u << 16); }
DI float bfhi(unsigned u) { return __uint_as_float(u & 0xffff0000u); }
DI u16 f2bf(float f) { return (u16)(pk2(f, 0.f) & 0xffffu); }
DI float bf2f(u16 h) { return __uint_as_float(((unsigned)h) << 16); }
DI float sigmoidf_(float x) { return __builtin_amdgcn_rcpf(1.0f + __expf(-x)); }
DI float gelu_tanh(float x) { const float u = 1.5957691216057308f * (x + 0.044715f * x * x * x); return x * sigmoidf_(u); }
DI float fast_sigmoid(float x) { return __builtin_amdgcn_rcpf(1.0f + __builtin_amdgcn_exp2f(x * -1.4426950408889634f)); }
DI float fast_gelu(float x) { const float p = __builtin_fmaf(x * x, -0.10294324f, -2.3022082f); return x * __builtin_amdgcn_rcpf(1.0f + __builtin_amdgcn_exp2f(x * p)); }
DI int otid() { int t = threadIdx.x; asm volatile("" : "+v"(t)); return t; }
DI void wave_lds_sync() { asm volatile("s_waitcnt lgkmcnt(0)" ::: "memory"); }

namespace g8 {
constexpr int BM = 256, BK = 64, HALF = 128, HTB = HALF * BK * 2, STAGE_BYTES = 8 * HTB, NXCD = 8, WGM = 8;
DI int lds_byte(int r, int c) { const int st = (r >> 4) * 2 + (c >> 5), rr = r & 15, cc = c & 31, ob = rr * 64 + cc * 2; return st * 1024 + (ob ^ (((ob >> 9) & 1) << 5)); }
DI int perm32(int rho) { const int n = rho >> 4, i = rho & 15; return 8 * (i >> 2) + 4 * n + (i & 3); }
DI void stage_rc(int b, int& R, int& C) { const int st = b / 1024, sb = b % 1024, swz = sb ^ (((sb >> 9) & 1) << 5); R = (st >> 1) * 16 + swz / 64; C = (st & 1) * 32 + (swz % 64) / 2; }

struct UnitD { const char* Bp; int pm, pn, e, rb; };

DI bool static_tile(int i, int G, int c, int nM, int nN, int& pm, int& pn) {
    const int nwg = nM * nN; const long L = (long)i * G + c; if (L >= nwg) return false;
    int wgid = (int)L; { const int q = nwg / NXCD, r = nwg % NXCD, xcd = wgid % NXCD, off = wgid / NXCD; wgid = (xcd < r ? xcd * (q + 1) : r * (q + 1) + (xcd - r) * q) + off; }
    const int nig = WGM * nN, gid = wgid / nig, fm = gid * WGM, gsz = (nM - fm) < WGM ? (nM - fm) : WGM;
    pm = fm + ((wgid % nig) % gsz); pn = (wgid % nig) / gsz; return true;
}

struct PlainSched {
    const char* Abase; const char* Bbase; int lda, ldb, K, nM, nN, G, c; static constexpr int esz = 2;
    DI bool next(int i, UnitD& u) const { int pm, pn; if (!static_tile(i, G, c, nM, nN, pm, pn)) return false; u.pm = pm; u.pn = pn; u.e = 0; u.rb = 0; u.Bp = Bbase + (size_t)pn * BM * ldb * 2; return true; }
    DI void a_offs(const UnitD& u, int R0, int C0, unsigned (&o)[2][2]) const {
#pragma unroll
        for (int h = 0; h < 2; ++h)
#pragma unroll
            for (int i = 0; i < 2; ++i) o[h][i] = (unsigned)(((size_t)(u.pm * BM + h * HALF + R0 + 64 * i) * lda + C0) * 2);
    }
};

template <bool FP8 = false, class Epi, class Sched>
DI void gemm_phase(LAS unsigned char* lds, const Sched& S, const Epi& E) {
    const int tid = otid(), wid = __builtin_amdgcn_readfirstlane(tid >> 6), lane = tid & 63, wr = wid >> 2, wc = wid & 3, fr = lane & 15, fq = lane >> 4;
    const int nt = S.K * Sched::esz / 128;
    int R0, C0; stage_rc(tid * 16, R0, C0);
    unsigned voffB[2];
#pragma unroll
    for (int i = 0; i < 2; ++i) { const int Rr = R0 + 64 * i, Rb = Epi::PERM ? ((Rr & ~31) + perm32(Rr & 31)) : Rr; voffB[i] = (unsigned)(Rb * S.ldb * Sched::esz + C0 * 2); }
    const size_t hstepB = (size_t)HALF * S.ldb * Sched::esz;
    const unsigned ldsw = (unsigned)wid * 1024u;
    const int aoff = FP8 ? lds_byte(wr * 64 + fr, fq * 16) : lds_byte(wr * 64 + fr, fq * 8), boff = FP8 ? lds_byte(wc * 32 + fr, fq * 16) : lds_byte(wc * 32 + fr, fq * 8);
    const unsigned mxscale = 0x7f7f7f7fu;
    const int kst = FP8 ? 16 : 1024;
    const char* Ab = S.Abase;
#define G8_SA(b, h) (((b) * 2 + (h)) * HTB)
#define G8_SB(b, h) ((4 + (b) * 2 + (h)) * HTB)
#define G8_STAGE_A(bufoff, offs, kb) do { _Pragma("unroll") for (int _i = 0; _i < 2; ++_i) \
        __builtin_amdgcn_global_load_lds((const unsigned*)(Ab + (size_t)(offs)[_i] + (size_t)(kb)), (LAS unsigned*)(lds + (bufoff) + ldsw + _i * 8192), 16, 0, 0); } while (0)
#define G8_STAGE_B(bufoff, gbase, kb) do { _Pragma("unroll") for (int _i = 0; _i < 2; ++_i) \
        __builtin_amdgcn_global_load_lds((const unsigned*)((gbase) + voffB[_i] + (size_t)(kb)), (LAS unsigned*)(lds + (bufoff) + ldsw + _i * 8192), 16, 0, 0); } while (0)
#define G8_LDA(dst, b, h) do { _Pragma("unroll") for (int m = 0; m < 4; ++m) { const i32x4_t _p = *(const LAS i32x4_t*)(lds + G8_SA(b, h) + aoff + m * 2048), _q = *(const LAS i32x4_t*)(lds + G8_SA(b, h) + aoff + m * 2048 + kst); dst[m] = __builtin_shufflevector(_p, _q, 0, 1, 2, 3, 4, 5, 6, 7); } } while (0)
#define G8_LDB(dst, b, h) do { _Pragma("unroll") for (int n = 0; n < 2; ++n) { const i32x4_t _p = *(const LAS i32x4_t*)(lds + G8_SB(b, h) + boff + n * 2048), _q = *(const LAS i32x4_t*)(lds + G8_SB(b, h) + boff + n * 2048 + kst); dst[n] = __builtin_shufflevector(_p, _q, 0, 1, 2, 3, 4, 5, 6, 7); } } while (0)
#define G8_MMA(ai, bj, At, Bt) do { __builtin_amdgcn_s_setprio(1); _Pragma("unroll") for (int m = 0; m < 4; ++m) _Pragma("unroll") for (int n = 0; n < 2; ++n) { \
        if constexpr (FP8) asm volatile("v_mfma_scale_f32_16x16x128_f8f6f4 %0, %1, %2, %0, %3, %3 op_sel_hi:[0,0,0]" : "+v"(acc[ai][bj][m][n]) : "v"(Bt[n]), "v"(At[m]), "v"(mxscale)); \
        else { acc[ai][bj][m][n] = __builtin_amdgcn_mfma_f32_16x16x32_bf16(__builtin_bit_cast(bf16x8, __builtin_shufflevector(Bt[n], Bt[n], 0, 1, 2, 3)), __builtin_bit_cast(bf16x8, __builtin_shufflevector(At[m], At[m], 0, 1, 2, 3)), acc[ai][bj][m][n], 0, 0, 0); \
               acc[ai][bj][m][n] = __builtin_amdgcn_mfma_f32_16x16x32_bf16(__builtin_bit_cast(bf16x8, __builtin_shufflevector(Bt[n], Bt[n], 4, 5, 6, 7)), __builtin_bit_cast(bf16x8, __builtin_shufflevector(At[m], At[m], 4, 5, 6, 7)), acc[ai][bj][m][n], 0, 0, 0); } } \
        __builtin_amdgcn_s_setprio(0); } while (0)
#define G8_WAIT_V(n) asm volatile("s_waitcnt vmcnt(" #n ")" ::: "memory")
#define G8_WAIT_L(n) asm volatile("s_waitcnt lgkmcnt(" #n ")" ::: "memory")
#define G8_BAR __builtin_amdgcn_s_barrier()
#define G8_SCHED __builtin_amdgcn_sched_barrier(0)
    UnitD cur, nxt; int ui = 0;
    if (!S.next(0, cur)) return;
    f32x4 acc[2][2][4][2];
#pragma unroll
    for (int a = 0; a < 2; ++a)
#pragma unroll
        for (int b = 0; b < 2; ++b)
#pragma unroll
            for (int m = 0; m < 4; ++m)
#pragma unroll
                for (int n = 0; n < 2; ++n) acc[a][b][m][n] = (f32x4){0.f, 0.f, 0.f, 0.f};
    typedef int i32x4_t __attribute__((ext_vector_type(4)));
    v8i_t At[4], B0[2], B1[2];
    unsigned cA[2][2];
    S.a_offs(cur, R0, C0, cA);
    const char* cB = cur.Bp;
    G8_STAGE_B(G8_SB(0, 0), cB, 0); G8_STAGE_A(G8_SA(0, 0), cA[0], 0); G8_STAGE_B(G8_SB(0, 1), cB + hstepB, 0); G8_STAGE_A(G8_SA(0, 1), cA[1], 0);
    if (wr == 1) G8_BAR;
    G8_WAIT_V(4); G8_BAR;
    G8_STAGE_B(G8_SB(1, 0), cB, 128); G8_STAGE_A(G8_SA(1, 0), cA[0], 128); G8_STAGE_B(G8_SB(1, 1), cB + hstepB, 128);
    G8_WAIT_V(6); G8_BAR;
    for (;;) {
        const bool has_next = S.next(ui + 1, nxt);
        const char* nB = has_next ? nxt.Bp : cB;
        for (int t = 0; t < nt; t += 2) {
            const bool last = (t == nt - 2);
            const unsigned k1 = (unsigned)(t + 1) * 128u;
            const unsigned k2 = last ? 0u : (unsigned)(t + 2) * 128u, k3 = k2 + 128u;
            unsigned c1[2] = {cA[1][0], cA[1][1]};
            if (last && has_next) S.a_offs(nxt, R0, C0, cA);
            const char* b2 = last ? nB : cB;
            G8_LDB(B0, 0, 0); G8_SCHED; G8_LDA(At, 0, 0); G8_STAGE_A(G8_SA(1, 1), c1, k1);
            G8_WAIT_L(8); G8_BAR; G8_WAIT_L(0); G8_MMA(0, 0, At, B0); G8_BAR; G8_SCHED;
            G8_LDB(B1, 0, 1); G8_STAGE_B(G8_SB(0, 0), b2, k2);
            G8_BAR; G8_WAIT_L(0); G8_MMA(0, 1, At, B1); G8_BAR;
            G8_LDA(At, 0, 1); G8_STAGE_A(G8_SA(0, 0), cA[0], k2);
            G8_BAR; G8_WAIT_L(0); G8_MMA(1, 0, At, B0); G8_BAR; G8_SCHED;
            G8_STAGE_B(G8_SB(0, 1), b2 + hstepB, k2);
            G8_WAIT_V(6); G8_BAR; G8_MMA(1, 1, At, B1); G8_BAR;
            G8_LDB(B0, 1, 0); G8_SCHED; G8_LDA(At, 1, 0); G8_STAGE_A(G8_SA(0, 1), cA[1], k2);
            G8_WAIT_L(8); G8_BAR; G8_WAIT_L(0); G8_MMA(0, 0, At, B0); G8_BAR; G8_SCHED;
            G8_LDB(B1, 1, 1); G8_STAGE_B(G8_SB(1, 0), b2, k3);
            G8_BAR; G8_WAIT_L(0); G8_MMA(0, 1, At, B1); G8_BAR;
            G8_LDA(At, 1, 1); G8_STAGE_A(G8_SA(1, 0), cA[0], k3);
            G8_BAR; G8_WAIT_L(0); G8_MMA(1, 0, At, B0); G8_BAR; G8_SCHED;
            G8_STAGE_B(G8_SB(1, 1), b2 + hstepB, k3);
            G8_WAIT_V(6); G8_BAR; G8_MMA(1, 1, At, B1); G8_BAR;
        }
        if constexpr (FP8) asm volatile("s_nop 15\n\ts_nop 15" ::: "memory");
        E(acc, cur, wr, wc, fr, fq);
        if (!has_next) break;
#pragma unroll
        for (int a = 0; a < 2; ++a)
#pragma unroll
            for (int b = 0; b < 2; ++b)
#pragma unroll
                for (int m = 0; m < 4; ++m)
#pragma unroll
                    for (int n = 0; n < 2; ++n) acc[a][b][m][n] = (f32x4){0.f, 0.f, 0.f, 0.f};
        cur = nxt; cB = nB; ++ui;
    }
    G8_WAIT_V(0);
    if (wr == 0) G8_BAR;
    G8_BAR;
#undef G8_SA
#undef G8_SB
#undef G8_STAGE_A
#undef G8_STAGE_B
#undef G8_LDA
#undef G8_LDB
#undef G8_MMA
#undef G8_WAIT_V
#undef G8_WAIT_L
#undef G8_BAR
#undef G8_SCHED
}
}
using g8::UnitD;
typedef f32x4 Acc[2][2][4][2];

struct EpiIn {
    static constexpr bool PERM = true;
    u16* H; const float* rs1; float* SSQ; float* WI;
    template <int ACT, bool DOSSQ> DI void run(const Acc& acc, const UnitD& u, int wr, int wc, int fr, int fq) const {
        const int pn = u.pn;
#pragma unroll
        for (int ai = 0; ai < 2; ++ai)
#pragma unroll
            for (int m = 0; m < 4; ++m) {
                const int row = u.pm * 256 + ai * 128 + wr * 64 + m * 16 + fr;
#pragma unroll
                for (int bj = 0; bj < 2; ++bj) {
                    f32x4 v0 = acc[ai][bj][m][0], v1 = acc[ai][bj][m][1];
                    if (ACT == 1) {
#pragma unroll
                        for (int j = 0; j < 4; ++j) { v0[j] = fast_gelu(v0[j]); v1[j] = fast_gelu(v1[j]); }
                    } else if (ACT == 2) {
#pragma unroll
                        for (int j = 0; j < 4; ++j) { v0[j] = fast_sigmoid(v0[j]); v1[j] = fast_sigmoid(v1[j]); }
                    }
                    u32x4 w; w.x = pk2(v0[0], v0[1]); w.y = pk2(v0[2], v0[3]); w.z = pk2(v1[0], v1[1]); w.w = pk2(v1[2], v1[3]);
                    *(u32x4*)(H + (size_t)row * NIN + pn * 256 + bj * 128 + wc * 32 + 8 * fq) = w;
                    if (DOSSQ) {
                        float ssq = ((v0[0] * v0[0] + v0[1] * v0[1]) + (v0[2] * v0[2] + v0[3] * v0[3])) + ((v1[0] * v1[0] + v1[1] * v1[1]) + (v1[2] * v1[2] + v1[3] * v1[3]));
                        ssq += __shfl_xor(ssq, 16); ssq += __shfl_xor(ssq, 32);
                        if (fq == 0) SSQ[(size_t)row * 32 + (pn - 2) * 8 + bj * 4 + wc] = ssq;
                        if (pn == 5 && bj == 1 && wc == 2 && fq == 0) *(f32x4*)(WI + (size_t)row * 4) = v0 * 0.5f;
                    }
                }
            }
    }
    DI void operator()(const Acc& acc, const UnitD& u, int wr, int wc, int fr, int fq) const {
        const int pn = u.pn;
        if (pn < 2) run<1, false>(acc, u, wr, wc, fr, fq);
        else if (pn < 4) run<1, true>(acc, u, wr, wc, fr, fq);
        else if (pn < 6) run<0, true>(acc, u, wr, wc, fr, fq);
        else run<2, false>(acc, u, wr, wc, fr, fq);
    }
};
struct EpiQ {
    static constexpr bool PERM = true;
    u16* Q; u16* QI; const float* SSQ;
    DI void operator()(const Acc& acc, const UnitD& u, int wr, int wc, int fr, int fq) const {
        f32x4 sq[2][4][2];
#pragma unroll
        for (int ai = 0; ai < 2; ++ai)
#pragma unroll
            for (int m = 0; m < 4; ++m) { const int row = u.pm * 256 + ai * 128 + wr * 64 + m * 16 + fr; sq[ai][m][0] = *(const f32x4*)(SSQ + (size_t)row * 32 + 16); sq[ai][m][1] = *(const f32x4*)(SSQ + (size_t)row * 32 + 20); }
        __builtin_amdgcn_sched_barrier(0);
#pragma unroll
        for (int ai = 0; ai < 2; ++ai)
#pragma unroll
            for (int m = 0; m < 4; ++m) {
                const int row = u.pm * 256 + ai * 128 + wr * 64 + m * 16 + fr;
                const f32x4 s0 = sq[ai][m][0], s1 = sq[ai][m][1];
                const float ss = ((s0[0] + s0[1]) + (s0[2] + s0[3])) + ((s1[0] + s1[1]) + (s1[2] + s1[3]));
                const float rs = __builtin_amdgcn_rsqf(ss * (1.0f / 256.0f) + EPS);
#pragma unroll
                for (int bj = 0; bj < 2; ++bj) {
                    const int col = u.pn * 256 + bj * 128 + wc * 32 + 8 * fq;
                    const f32x4 v0 = acc[ai][bj][m][0] * rs, v1 = acc[ai][bj][m][1] * rs;
                    if (col < 1024) { u32x4 w; w.x = pk2(v0[0], v0[1]); w.y = pk2(v0[2], v0[3]); w.z = pk2(v1[0], v1[1]); w.w = pk2(v1[2], v1[3]); *(u32x4*)(Q + (size_t)row * 1024 + col) = w; }
                    else { u32x2 w; w.x = pk4_i8(v0[0], v0[1], v0[2], v0[3]); w.y = pk4_i8(v1[0], v1[1], v1[2], v1[3]); *(u32x2*)((unsigned char*)QI + (size_t)row * 256 + (col - 1024)) = w; }
                }
            }
    }
};
template <int SECOND> struct EpiMrg {
    static constexpr bool PERM = true;
    u16* OUT; const u16* TMP; const u16* H;
    DI void operator()(const Acc& acc, const UnitD& u, int wr, int wc, int fr, int fq) const {
#pragma unroll
        for (int ai = 0; ai < 2; ++ai) {
            u32x4 g[4][2], tp[4][2];
#pragma unroll
            for (int m = 0; m < 4; ++m)
#pragma unroll
                for (int bj = 0; bj < 2; ++bj) {
                    const int row = u.pm * 256 + ai * 128 + wr * 64 + m * 16 + fr, col = u.pn * 256 + bj * 128 + wc * 32 + 8 * fq;
                    g[m][bj] = *(const u32x4*)(H + (size_t)row * NIN + 1536 + SECOND * 1024 + col);
                    if (SECOND) tp[m][bj] = *(const u32x4*)(TMP + (size_t)row * 1024 + col);
                }
            __builtin_amdgcn_sched_barrier(0);
#pragma unroll
            for (int m = 0; m < 4; ++m)
#pragma unroll
                for (int bj = 0; bj < 2; ++bj) {
                    const int row = u.pm * 256 + ai * 128 + wr * 64 + m * 16 + fr, col = u.pn * 256 + bj * 128 + wc * 32 + 8 * fq;
                    const u32x4 gg = g[m][bj];
                    f32x4 v0 = acc[ai][bj][m][0], v1 = acc[ai][bj][m][1];
                    v0[0] *= bflo(gg.x); v0[1] *= bfhi(gg.x); v0[2] *= bflo(gg.y); v0[3] *= bfhi(gg.y); v1[0] *= bflo(gg.z); v1[1] *= bfhi(gg.z); v1[2] *= bflo(gg.w); v1[3] *= bfhi(gg.w);
                    if (SECOND) { const u32x4 t = tp[m][bj];
                        v0[0] += bflo(t.x); v0[1] += bfhi(t.x); v0[2] += bflo(t.y); v0[3] += bfhi(t.y); v1[0] += bflo(t.z); v1[1] += bfhi(t.z); v1[2] += bflo(t.w); v1[3] += bfhi(t.w); }
                    u32x4 w; w.x = pk2(v0[0], v0[1]); w.y = pk2(v0[2], v0[3]); w.z = pk2(v1[0], v1[1]); w.w = pk2(v1[2], v1[3]);
                    *(u32x4*)(OUT + (size_t)row * 1024 + col) = w;
                }
            __builtin_amdgcn_sched_barrier(0);
        }
    }
};
struct EpiOut {
    static constexpr bool PERM = false;
    float* out; const float* x;
    DI void operator()(const Acc& acc, const UnitD& u, int wr, int wc, int fr, int fq) const {
#pragma unroll
        for (int ai = 0; ai < 2; ++ai) {
            f32x4 xv[4][2][2];
#pragma unroll
            for (int m = 0; m < 4; ++m)
#pragma unroll
                for (int bj = 0; bj < 2; ++bj)
#pragma unroll
                    for (int n = 0; n < 2; ++n)
                        xv[m][bj][n] = *(const f32x4*)(x + (size_t)(u.pm * 256 + ai * 128 + wr * 64 + m * 16 + fr) * 1024 + u.pn * 256 + bj * 128 + wc * 32 + n * 16 + 4 * fq);
            __builtin_amdgcn_sched_barrier(0);
#pragma unroll
            for (int m = 0; m < 4; ++m)
#pragma unroll
                for (int bj = 0; bj < 2; ++bj)
#pragma unroll
                    for (int n = 0; n < 2; ++n)
                        *(f32x4*)(out + (size_t)(u.pm * 256 + ai * 128 + wr * 64 + m * 16 + fr) * 1024 + u.pn * 256 + bj * 128 + wc * 32 + n * 16 + 4 * fq) = xv[m][bj][n] + acc[ai][bj][m][n];
            __builtin_amdgcn_sched_barrier(0);
        }
    }
};

constexpr int MOE_TAB = g8::STAGE_BYTES;
DI void moe_table(LAS unsigned char* lds, const unsigned* CNT) {
    LAS int* tab = (LAS int*)(lds + MOE_TAB);
    __syncthreads();
    if (threadIdx.x == 0) { int acc = 0; for (int e = 0; e < NE; ++e) { const int c = (int)__hip_atomic_load(CNT + e, __ATOMIC_RELAXED, __HIP_MEMORY_SCOPE_AGENT); tab[e] = acc; tab[33 + e] = c; acc += (c + 255) >> 8; } tab[32] = acc; }
    __syncthreads();
}
template <int NPN, bool GATHER> struct MoeSched {
    const char* Abase; const char* Wbase; const int* LTOK; LAS const int* tab; int lda, ldb, K, G, c; size_t wstride; static constexpr int esz = 1;
    DI bool next(int i, UnitD& u) const {
        const long L = (long)i * G + c; const int R = tab[32];
        if (L >= (long)R * NPN) return false;
        const int rbg = (int)(L / NPN), pn = (int)(L % NPN);
        int e = 0;
        for (int j = 1; j < NE; ++j) e += (tab[j] <= rbg) ? 1 : 0;
        e = __builtin_amdgcn_readfirstlane(e);
        u.pm = rbg; u.pn = pn; u.e = e; u.rb = rbg - tab[e];
        u.Bp = Wbase + (size_t)e * wstride + (size_t)pn * 256 * ldb * esz;
        return true;
    }
    DI void a_offs(const UnitD& u, int R0, int C0, unsigned (&o)[2][2]) const {
        const int cnt = tab[33 + u.e];
#pragma unroll
        for (int h = 0; h < 2; ++h)
#pragma unroll
            for (int i = 0; i < 2; ++i) {
                const int r = h * 128 + R0 + 64 * i;
                if (GATHER) { const int slot = u.rb * 256 + r; const int tok = slot < cnt ? LTOK[(size_t)u.e * ECAP + slot] : 0; o[h][i] = (unsigned)((size_t)tok * lda * esz + C0 * 2); }
                else o[h][i] = (unsigned)((size_t)(u.pm * 256 + r) * lda * esz + C0 * 2);
            }
    }
};
struct EpiMoe1 {
    static constexpr bool PERM = true;
    unsigned char* ACT; const float* b1;
    DI void operator()(const Acc& acc, const UnitD& u, int wr, int wc, int fr, int fq) const {
        const float* be = b1 + (size_t)u.e * 2048;
        const int hc = u.pn * 128 + wc * 32 + 8 * fq;
        const f32x4 bg0 = *(const f32x4*)(be + hc), bg1 = *(const f32x4*)(be + hc + 4), bu0 = *(const f32x4*)(be + 1024 + hc), bu1 = *(const f32x4*)(be + 1024 + hc + 4);
        __builtin_amdgcn_sched_barrier(0);
#pragma unroll
        for (int ai = 0; ai < 2; ++ai)
#pragma unroll
            for (int m = 0; m < 4; ++m) {
                const int row = u.pm * 256 + ai * 128 + wr * 64 + m * 16 + fr;
                float av[8];
#pragma unroll
                for (int n = 0; n < 2; ++n) {
                    const f32x4 g = acc[ai][0][m][n] * 0.015625f + (n ? bg1 : bg0), up = acc[ai][1][m][n] * 0.015625f + (n ? bu1 : bu0);
#pragma unroll
                    for (int j = 0; j < 4; ++j) {
                        const float hg = fminf(g[j], 7.0f), hu = __builtin_amdgcn_fmed3f(up[j], -7.0f, 7.0f);
                        av[4 * n + j] = (hu + 1.0f) * (hg * __builtin_amdgcn_rcpf(1.0f + __builtin_amdgcn_exp2f(hg * -2.4554669595930157f)));
                    }
                }
                u32x2 w; w.x = pk4_fp8(av[0], av[1], av[2], av[3]); w.y = pk4_fp8(av[4], av[5], av[6], av[7]);
                *(u32x2*)(ACT + (size_t)row * 1024 + hc) = w;
            }
    }
};
struct EpiMoe2 {
    static constexpr bool PERM = true;
    u16* YB; const float* b2;
    DI void operator()(const Acc& acc, const UnitD& u, int wr, int wc, int fr, int fq) const {
        const float* be = b2 + (size_t)u.e * 1024;
        f32x4 bias[2][2];
#pragma unroll
        for (int bj = 0; bj < 2; ++bj) { const int col = u.pn * 256 + bj * 128 + wc * 32 + 8 * fq; bias[bj][0] = *(const f32x4*)(be + col); bias[bj][1] = *(const f32x4*)(be + col + 4); }
        __builtin_amdgcn_sched_barrier(0);
#pragma unroll
        for (int ai = 0; ai < 2; ++ai)
#pragma unroll
            for (int m = 0; m < 4; ++m) {
                const int r = ai * 128 + wr * 64 + m * 16 + fr;
#pragma unroll
                for (int bj = 0; bj < 2; ++bj) {
                    const int col = u.pn * 256 + bj * 128 + wc * 32 + 8 * fq;
                    const f32x4 v0 = acc[ai][bj][m][0] * 0.015625f + bias[bj][0], v1 = acc[ai][bj][m][1] * 0.015625f + bias[bj][1];
                    u32x4 w; w.x = pk2(v0[0], v0[1]); w.y = pk2(v0[2], v0[3]); w.z = pk2(v1[0], v1[1]); w.w = pk2(v1[2], v1[3]);
                    *(u32x4*)(YB + (size_t)(u.pm * 256 + r) * 1024 + col) = w;
                }
            }
    }
};

template <bool FP8 = false, class F> DI void tr_tile(LAS unsigned char* lds, const float* src, int ld_src, int Nsz, int k0, int n0, const float* sk, float mul, u16* dst, int ld_dst, F rowmap) {
    LAS float* t = (LAS float*)lds;
    const int tid = otid();
    __syncthreads();
#pragma unroll
    for (int it = 0; it < 2; ++it) {
        const int k = (tid >> 4) + 32 * it, n = 4 * (tid & 15);
        f32x4 v = {0.f, 0.f, 0.f, 0.f};
        if (n0 + n < Nsz) v = *(const f32x4*)(src + (size_t)(k0 + k) * ld_src + n0 + n);
        const float s = (sk ? sk[k0 + k] : 1.0f) * mul;
        t[k * 65 + n] = v[0] * s; t[k * 65 + n + 1] = v[1] * s; t[k * 65 + n + 2] = v[2] * s; t[k * 65 + n + 3] = v[3] * s;
    }
    __syncthreads();
    const int n = tid >> 3, kc = (tid & 7) * 8;
    if (FP8) {
        if (n0 + n < Nsz) {
            u32x2 w;
            w.x = pk4_fp8(t[(kc + 0) * 65 + n], t[(kc + 1) * 65 + n], t[(kc + 2) * 65 + n], t[(kc + 3) * 65 + n]);
            w.y = pk4_fp8(t[(kc + 4) * 65 + n], t[(kc + 5) * 65 + n], t[(kc + 6) * 65 + n], t[(kc + 7) * 65 + n]);
            *(u32x2*)((unsigned char*)dst + (size_t)rowmap(n0 + n) * ld_dst + k0 + kc) = w;
        }
    } else if (n0 + n < Nsz) {
        u32x4 w;
        w.x = pk2(t[(kc + 0) * 65 + n], t[(kc + 1) * 65 + n]); w.y = pk2(t[(kc + 2) * 65 + n], t[(kc + 3) * 65 + n]);
        w.z = pk2(t[(kc + 4) * 65 + n], t[(kc + 5) * 65 + n]); w.w = pk2(t[(kc + 6) * 65 + n], t[(kc + 7) * 65 + n]);
        *(u32x4*)(dst + (size_t)rowmap(n0 + n) * ld_dst + k0 + kc) = w;
    }
}
struct MapId { DI int operator()(int n) const { return n; } };
struct MapIn { DI int operator()(int n) const { return n < 1476 ? n : n + 60; } };
struct MapE1 { DI int operator()(int n) const { const int hi = n >= 1024 ? 1 : 0, q = n - hi * 1024; return (q >> 7) * 256 + hi * 128 + (q & 127); } };

DI void phase0(const Args& a, LAS unsigned char* lds) {
    unsigned char* ws = a.ws;
    const int tid = otid();
    const size_t gtid = (size_t)blockIdx.x * NT + tid, gstride = (size_t)gridDim.x * NT;
    for (size_t i = gtid; i < 60 * 1024 / 2; i += gstride) ((unsigned*)(ws + WS_WIN + (size_t)1476 * 1024 * 2))[i] = 0u;
    for (size_t i = gtid; i < 32 * 1024; i += gstride) { const int e = (int)(i >> 10), k = (int)(i & 1023); const float w = a.in[I_WR][k * 32 + e] * a.in[I_N2G][k]; const u16 h = f2bf(w); ((u16*)(ws + WS_WR))[i] = h; ((u16*)(ws + WS_WR))[32 * 1024 + i] = f2bf(w - bf2f(h)); }
    for (size_t i = gtid; i < 4 * 128 * 128; i += gstride) { const int tt = (int)((i >> 7) & 127), ss = (int)(i & 127); ((u16*)(ws + WS_WSP))[i] = f2bf(ss <= tt ? a.in[I_WSP][i] : 0.f); }
    {
        const int wid = tid >> 6, lane = tid & 63;
        for (int row = blockIdx.x * 8 + wid; row < T; row += gridDim.x * 8) {
            const float* xr = a.in[I_X] + (size_t)row * 1024; u16* xb = (u16*)(ws + WS_XB) + (size_t)row * 1024;
            float ss = 0.f; f32x4 xv[4];
#pragma unroll
            for (int i = 0; i < 4; ++i) {
                xv[i] = __builtin_nontemporal_load((const f32x4*)(xr + i * 256 + lane * 4));
                ss += (xv[i][0] * xv[i][0] + xv[i][1] * xv[i][1]) + (xv[i][2] * xv[i][2] + xv[i][3] * xv[i][3]);
            }
#pragma unroll
            for (int o = 32; o >= 1; o >>= 1) ss += __shfl_xor(ss, o);
            const float rs = __builtin_amdgcn_rsqf(ss * (1.0f / 1024.0f) + EPS);
#pragma unroll
            for (int i = 0; i < 4; ++i) { u32x2 w; w.x = pk2(xv[i][0] * rs, xv[i][1] * rs); w.y = pk2(xv[i][2] * rs, xv[i][3] * rs); *(u32x2*)(xb + i * 256 + lane * 4) = w; }
        }
    }
    constexpr int U_IN = 16 * 56, U_UQ = 4 * 16, U_QI = 4 * 4, U_PA = 8 * 16, U_OUT = 16 * 16, U_CB = 64;
    constexpr int U_TOT = U_IN + U_UQ + U_QI + U_PA + U_OUT + U_CB;
    for (int u = blockIdx.x; u < U_TOT; u += gridDim.x) {
        int v = u;
        if (v < U_IN) { tr_tile(lds, a.in[I_WIN], 3524, 3524, (v & 15) * 64, (v >> 4) * 64, a.in[I_N1G], 1.0f, (u16*)(ws + WS_WIN), 1024, MapIn()); continue; }
        v -= U_IN;
        if (v < U_UQ) { tr_tile(lds, a.in[I_WUQ], 1024, 1024, (v & 3) * 64, (v >> 2) * 64, a.in[I_QLG], 1.0f, (u16*)(ws + WS_WQ), 256, MapId()); continue; }
        v -= U_UQ;
        if (v < U_QI) { tr_tile(lds, a.in[I_WQI], 256, 256, (v & 3) * 64, (v >> 2) * 64, a.in[I_QLG], 1.0f, (u16*)(ws + WS_WQ) + 1024 * 256, 256, MapId()); continue; }
        v -= U_QI;
        if (v < U_PA) { tr_tile(lds, a.in[I_WPA], 1024, 1024, (v & 7) * 64, (v >> 3) * 64, nullptr, 1.0f, (u16*)(ws + WS_WCAT), 1536, MapId()); continue; }
        v -= U_PA;
        if (v < U_OUT) { tr_tile(lds, a.in[I_WOUT], 1024, 1024, (v & 15) * 64, (v >> 4) * 64, nullptr, 1.0f, (u16*)(ws + WS_WOUT), 1024, MapId()); continue; }
        v -= U_OUT;
        {
            const int h = v >> 3, c0 = (v & 7) * 16;
            LAS float* t = (LAS float*)lds;
            __syncthreads();
            for (int i = tid; i < 1024; i += NT) t[i] = a.in[I_WUV][(size_t)h * 128 * 64 + (size_t)c0 * 64 + i];
            __syncthreads();
            for (int nn = tid; nn < 1024; nn += NT) {
                float accv[16];
#pragma unroll
                for (int i = 0; i < 16; ++i) accv[i] = 0.f;
                for (int vv = 0; vv < 64; ++vv) {
                    const float pb = a.in[I_WPB][(size_t)(h * 64 + vv) * 1024 + nn];
#pragma unroll
                    for (int i = 0; i < 16; ++i) accv[i] += t[i * 64 + vv] * pb;
                }
                u32x4 w0, w1;
                w0.x = pk2(accv[0], accv[1]); w0.y = pk2(accv[2], accv[3]); w0.z = pk2(accv[4], accv[5]); w0.w = pk2(accv[6], accv[7]);
                w1.x = pk2(accv[8], accv[9]); w1.y = pk2(accv[10], accv[11]); w1.z = pk2(accv[12], accv[13]); w1.w = pk2(accv[14], accv[15]);
                u16* d = (u16*)(ws + WS_WCAT) + (size_t)nn * 1536 + 512 + h * 128 + c0;
                *(u32x4*)d = w0; *(u32x4*)(d + 8) = w1;
            }
        }
    }
}

DI void gmlp_unit(const Args& a, LAS unsigned char* lds, int u) {
    unsigned char* ws = a.ws;
    const int tid = otid(), wid = tid >> 6, lane = tid & 63, fr = lane & 15, fq = lane >> 4;
    const int g = u & 3, row0 = (u >> 2) * 128;
    const u16* H = (const u16*)(ws + WS_H);
    LAS u16* img = (LAS u16*)lds;
    __syncthreads();
    {
        const int s = tid & 127, cset = tid >> 7;
        const f32x4 sq = *(const f32x4*)((const float*)(ws + WS_SSQ) + (size_t)(row0 + s) * 32 + g * 4);
        const float rs = __builtin_amdgcn_rsqf(((sq[0] + sq[1]) + (sq[2] + sq[3])) * (1.0f / 128.0f) + EPS);
#pragma unroll
        for (int it = 0; it < 4; ++it) {
            const int c = cset + 4 * it;
            const u32x4 raw = *(const u32x4*)(H + (size_t)(row0 + s) * NIN + 512 + g * 128 + 8 * c);
            const float* vg = a.in[I_VG] + 8 * c;
            float f[8] = {bflo(raw.x), bfhi(raw.x), bflo(raw.y), bfhi(raw.y), bflo(raw.z), bfhi(raw.z), bflo(raw.w), bfhi(raw.w)};
#pragma unroll
            for (int i = 0; i < 8; ++i) img[(8 * c + i) * 136 + s] = f2bf(f[i] * rs * vg[i]);
        }
    }
    __syncthreads();
    const u16* W = (const u16*)(ws + WS_WSP) + (size_t)g * 128 * 128 + (size_t)(16 * wid + fr) * 128;
    f32x4 acc[8];
#pragma unroll
    for (int i = 0; i < 8; ++i) acc[i] = (f32x4){0.f, 0.f, 0.f, 0.f};
    const int nks = (16 * wid + 15) / 32 + 1;
    for (int ks = 0; ks < nks; ++ks) {
        const bf16x8 bw = *(const bf16x8*)(W + ks * 32 + 8 * fq);
#pragma unroll
        for (int i = 0; i < 8; ++i) {
            const bf16x8 av = *(const LAS bf16x8*)(img + (16 * i + fr) * 136 + ks * 32 + 8 * fq);
            acc[i] = __builtin_amdgcn_mfma_f32_16x16x32_bf16(av, bw, acc[i], 0, 0, 0);
        }
    }
    const int t = 16 * wid + fr;
    const float bias = a.in[I_BSP][g * 128 + t];
    u16* YO = (u16*)(ws + WS_YO);
#pragma unroll
    for (int i = 0; i < 8; ++i) {
        const int d = 16 * i + 4 * fq;
        const u32x2 uu = *(const u32x2*)(H + (size_t)(row0 + t) * NIN + g * 128 + d);
        const float y0 = bflo(uu.x) * (acc[i][0] + bias), y1 = bfhi(uu.x) * (acc[i][1] + bias), y2 = bflo(uu.y) * (acc[i][2] + bias), y3 = bfhi(uu.y) * (acc[i][3] + bias);
        u32x2 w; w.x = pk2(y0, y1); w.y = pk2(y2, y3);
        *(u32x2*)(YO + (size_t)(row0 + t) * 1536 + g * 128 + d) = w;
    }
}

DI void kvnorm(const Args& a) {
    unsigned char* ws = a.ws;
    const u16* H = (const u16*)(ws + WS_H); const float* SSQ = (const float*)(ws + WS_SSQ);
    const size_t gtid = (size_t)blockIdx.x * NT + otid(), gstride = (size_t)gridDim.x * NT;
    for (size_t idx = gtid; idx < (size_t)T * 24; idx += gstride) {
        const int row = (int)(idx / 24), c = (int)(idx % 24);
        const u16* src; u16* dst; const float* gain; float rs;
        if (c < 16) {
            const f32x4 sq = *(const f32x4*)(SSQ + (size_t)row * 32 + 24);
            rs = __builtin_amdgcn_rsqf(((sq[0] + sq[1]) + (sq[2] + sq[3])) * (1.0f / 128.0f) + EPS);
            src = H + (size_t)row * NIN + 1280 + 8 * c; dst = (u16*)(ws + WS_KVN) + (size_t)row * 128 + 8 * c; gain = a.in[I_KVG] + 8 * c;
        } else {
            const int cc = c - 16;
            rs = __builtin_amdgcn_rsqf((SSQ[(size_t)row * 32 + 28] + SSQ[(size_t)row * 32 + 29]) * (1.0f / 64.0f) + EPS);
            src = H + (size_t)row * NIN + 1408 + 8 * cc; dst = nullptr; gain = a.in[I_KIG] + 8 * cc;
            const u32x4 raw = *(const u32x4*)src;
            u32x2 w8;
            w8.x = pk4_i8(bflo(raw.x) * rs * gain[0], bfhi(raw.x) * rs * gain[1], bflo(raw.y) * rs * gain[2], bfhi(raw.y) * rs * gain[3]);
            w8.y = pk4_i8(bflo(raw.z) * rs * gain[4], bfhi(raw.z) * rs * gain[5], bflo(raw.w) * rs * gain[6], bfhi(raw.w) * rs * gain[7]);
            *(u32x2*)(ws + WS_KIN + (size_t)row * 64 + 8 * cc) = w8;
            continue;
        }
        const u32x4 raw = *(const u32x4*)src;
        u32x4 w;
        w.x = pk2(bflo(raw.x) * rs * gain[0], bfhi(raw.x) * rs * gain[1]); w.y = pk2(bflo(raw.y) * rs * gain[2], bfhi(raw.y) * rs * gain[3]);
        w.z = pk2(bflo(raw.z) * rs * gain[4], bfhi(raw.z) * rs * gain[5]); w.w = pk2(bflo(raw.w) * rs * gain[6], bfhi(raw.w) * rs * gain[7]);
        *(u32x4*)dst = w;
    }
}

constexpr int P3_ROWS = 0, P3_HIST = 131072, P3_LIST = 147456;
DI unsigned bf2keys(unsigned b) {
    unsigned m; asm("v_pk_ashrrev_i16 %0, %1, %2" : "=v"(m) : "v"(0x000f000fu), "v"(b));
    return b ^ (m | 0x80008000u);
}
DI unsigned f2key(float f) { const unsigned u = __float_as_uint(f); return (u & 0x80000000u) ? ~u : (u | 0x80000000u); }
DI int wave_incl_scan(int v, int lane) {
#pragma unroll
    for (int o = 1; o < 64; o <<= 1) { const int t = __shfl_up(v, o); if (lane >= o) v += t; }
    return v;
}
DI int wave_suffix_scan(int v, int lane) {
#pragma unroll
    for (int o = 1; o < 64; o <<= 1) { const int t = __shfl_down(v, o); if (lane + o < 64) v += t; }
    return v;
}
DI unsigned pk_gt(unsigned kw, unsigned xw, unsigned one) {
    unsigned d, m;
    asm("v_pk_sub_u16 %0, %1, %2 clamp" : "=v"(d) : "v"(kw), "v"(xw));
    asm("v_pk_min_u16 %0, %1, %2" : "=v"(m) : "v"(d), "v"(one));
    return m;
}
DI unsigned pk_subs(unsigned kw, unsigned xw) { unsigned d; asm("v_pk_sub_u16 %0, %1, %2 clamp" : "=v"(d) : "v"(kw), "v"(xw)); return d; }
DI unsigned pk_min1(unsigned d, unsigned one) { unsigned m; asm("v_pk_min_u16 %0, %1, %2" : "=v"(m) : "v"(d), "v"(one)); return m; }
DI unsigned pk_max(unsigned a, unsigned b) { unsigned r; asm("v_pk_max_u16 %0, %1, %2" : "=v"(r) : "v"(a), "v"(b)); return r; }
DI unsigned pk_add(unsigned a, unsigned b) { unsigned r; asm("v_pk_add_u16 %0, %1, %2" : "=v"(r) : "v"(a), "v"(b)); return r; }
DI int wave_sum(int v) {
    v += __builtin_amdgcn_update_dpp(0, v, 0xB1, 0xf, 0xf, false);
    v += __builtin_amdgcn_update_dpp(0, v, 0x4E, 0xf, 0xf, false);
    v += __builtin_amdgcn_update_dpp(0, v, 0x141, 0xf, 0xf, false);
    v += __builtin_amdgcn_update_dpp(0, v, 0x140, 0xf, 0xf, false);
    return __builtin_amdgcn_readlane(v, 0) + __builtin_amdgcn_readlane(v, 16) + __builtin_amdgcn_readlane(v, 32) + __builtin_amdgcn_readlane(v, 48);
}
DI int rowaddr(int p) { return (p & ~511) | ((p & 63) << 3) | ((p >> 6) & 7); }
typedef unsigned short us2_t __attribute__((ext_vector_type(2)));
DI unsigned dot2acc(unsigned flags, unsigned wts, unsigned acc) { return __builtin_amdgcn_udot2(__builtin_bit_cast(us2_t, flags), __builtin_bit_cast(us2_t, wts), acc, false); }
DI void keys_load(LAS u16* row, int N, int lane, u32x4 (&kr)[16]) {
    const int Nup = (N + 511) & ~511, niter = Nup >> 9;
    for (int p = N + lane; p < Nup; p += 64) row[rowaddr(p)] = (u16)0;
    wave_lds_sync();
#pragma unroll
    for (int i = 0; i < 16; ++i) { kr[i] = (u32x4){0u, 0u, 0u, 0u}; if (i < niter) kr[i] = *(LAS const u32x4*)(row + i * 512 + lane * 8); }
    wave_lds_sync();
}
DI void keys_select(const u32x4 (&kr)[16], LAS u16* list, int N, int lane) {
    const int Nup = (N + 511) & ~511, niter = Nup >> 9;
    const unsigned one = 0x00010001u;
    auto count_gt = [&](unsigned x) -> int {
        const unsigned xw = x | (x << 16);
        unsigned acc = 0u, acc1 = 0u, acc2 = 0u, acc3 = 0u;
#pragma unroll
        for (int c = 0; c < 4; ++c) {
            if (4 * c < niter) {
#pragma unroll
                for (int h = 0; h < 2; ++h) {
                    unsigned d[8];
#pragma unroll
                    for (int i = 0; i < 2; ++i) { const u32x4 kk = kr[4 * c + 2 * h + i]; d[4 * i] = pk_subs(kk.x, xw); d[4 * i + 1] = pk_subs(kk.y, xw); d[4 * i + 2] = pk_subs(kk.z, xw); d[4 * i + 3] = pk_subs(kk.w, xw); }
#pragma unroll
                    for (int i = 0; i < 8; ++i) d[i] = pk_min1(d[i], one);
#pragma unroll
                    for (int i = 0; i < 8; i += 4) { acc = dot2acc(d[i], one, acc); acc1 = dot2acc(d[i + 1], one, acc1); acc2 = dot2acc(d[i + 2], one, acc2); acc3 = dot2acc(d[i + 3], one, acc3); }
                }
            }
        }
        return wave_sum((int)((acc + acc1) + (acc2 + acc3)));
    };
    unsigned T = 0u; int cge = Nup, topbit = 15;
    {
        unsigned mx = 0u;
#pragma unroll
        for (int c = 0; c < 4; ++c) {
            if (4 * c < niter) {
#pragma unroll
                for (int i = 4 * c; i < 4 * c + 4; ++i) { mx = pk_max(mx, kr[i].x); mx = pk_max(mx, kr[i].y); mx = pk_max(mx, kr[i].z); mx = pk_max(mx, kr[i].w); }
            }
        }
        unsigned m1 = max(mx & 0xffffu, mx >> 16);
        m1 = max(m1, (unsigned)__builtin_amdgcn_update_dpp(0, (int)m1, 0xB1, 0xf, 0xf, false)); m1 = max(m1, (unsigned)__builtin_amdgcn_update_dpp(0, (int)m1, 0x4E, 0xf, 0xf, false));
        m1 = max(m1, (unsigned)__builtin_amdgcn_update_dpp(0, (int)m1, 0x141, 0xf, 0xf, false)); m1 = max(m1, (unsigned)__builtin_amdgcn_update_dpp(0, (int)m1, 0x140, 0xf, 0xf, false));
        const unsigned kmax = max(max((unsigned)__builtin_amdgcn_readlane((int)m1, 0), (unsigned)__builtin_amdgcn_readlane((int)m1, 16)), max((unsigned)__builtin_amdgcn_readlane((int)m1, 32), (unsigned)__builtin_amdgcn_readlane((int)m1, 48)));
        if (kmax > 1024u) {
            const unsigned lo = kmax - 1023u;
            const int clo = count_gt(lo - 1u);
            if (clo >= 256) { T = lo; cge = clo; topbit = 9; }
        }
    }
#pragma unroll 1
    for (int bit = topbit; bit >= 0; --bit) {
        const unsigned cand = topbit == 15 ? (T | (1u << bit)) : (T + (1u << bit));
        if (cand > 0xffffu) continue;
        const int cnt = count_gt(cand - 1u);
        if (cnt >= 256) { T = cand; cge = cnt; }
    }
    auto build = [&](unsigned x, unsigned (&M)[4]) {
        const unsigned xw = x | (x << 16);
#pragma unroll
        for (int c = 0; c < 4; ++c) {
            M[c] = 0u;
            if (4 * c < niter) {
#pragma unroll
                for (int i = 4 * c; i < 4 * c + 4; ++i) {
                    unsigned byte = dot2acc(pk_gt(kr[i].x, xw, one), 0x00020001u, 0u);
                    byte = dot2acc(pk_gt(kr[i].y, xw, one), 0x00080004u, byte);
                    byte = dot2acc(pk_gt(kr[i].z, xw, one), 0x00200010u, byte);
                    byte = dot2acc(pk_gt(kr[i].w, xw, one), 0x00800040u, byte);
                    M[c] |= byte << (8 * (i & 3));
                }
            }
        }
    };
    unsigned M[4];
    build(T - 1u, M);
    if (cge != 256) {
        unsigned G[4]; build(T, G);
        unsigned E[4];
#pragma unroll
        for (int c = 0; c < 4; ++c) E[c] = M[c] & ~G[c];
        const int need = 256 - (cge - wave_sum((int)(__builtin_popcount(E[0]) + __builtin_popcount(E[1]) + __builtin_popcount(E[2]) + __builtin_popcount(E[3]))));
        auto below = [&](int B, int c) -> unsigned { const int nb = B - 32 * c; return nb <= 0 ? 0u : (nb >= 32 ? 0xffffffffu : ((1u << nb) - 1u)); };
        auto ties_below = [&](int B) -> int {
            return wave_sum((int)(__builtin_popcount(E[0] & below(B, 0)) + __builtin_popcount(E[1] & below(B, 1)) + __builtin_popcount(E[2] & below(B, 2)) + __builtin_popcount(E[3] & below(B, 3))));
        };
        int lo = 0, hi = 127;
#pragma unroll 1
        while (lo < hi) { const int mid = (lo + hi) >> 1; if (ties_below(mid + 1) >= need) hi = mid; else lo = mid + 1; }
        const int Bs = lo, r = need - ties_below(Bs);
        const unsigned ew = Bs < 32 ? E[0] : (Bs < 64 ? E[1] : (Bs < 96 ? E[2] : E[3]));
        const bool tb = ((ew >> (Bs & 31)) & 1u) != 0u;
        const unsigned long long em = __ballot(tb);
        const bool take_row = tb && __builtin_popcountll(em & ((1ull << lane) - 1ull)) < r;
#pragma unroll
        for (int c = 0; c < 4; ++c) {
            unsigned tk = E[c] & below(Bs, c);
            if ((Bs >> 5) == c && take_row) tk |= 1u << (Bs & 31);
            M[c] = G[c] | tk;
        }
    }
    const int kl = __builtin_popcount(M[0]) + __builtin_popcount(M[1]) + __builtin_popcount(M[2]) + __builtin_popcount(M[3]);
    int wp = wave_incl_scan(kl, lane) - kl;
#pragma unroll
    for (int c = 0; c < 4; ++c) {
        unsigned m = M[c];
        while (m) { const int b = __builtin_ctz(m); list[wp] = (u16)((32 * c + b) * 64 + lane); ++wp; m &= m - 1u; }
    }
}

DI float max2f(float a, float b) { float r; asm("v_max_f32 %0, %1, %2" : "=v"(r) : "v"(a), "v"(b)); return r; }
DI float max8_mfma(const f32x4& a, const f32x4& b) {
    float r;
    asm("s_nop 7\n\tv_max3_f32 %0, %1, %2, %3\n\tv_max3_f32 %0, %0, %4, %5\n\tv_max3_f32 %0, %0, %6, %7\n\tv_max_f32 %0, %0, %8"
        : "=&v"(r) : "v"(a[0]), "v"(a[1]), "v"(a[2]), "v"(a[3]), "v"(b[0]), "v"(b[1]), "v"(b[2]), "v"(b[3]));
    return r;
}
DI float xmax_16_32(float x) {
    const unsigned xi = __float_as_uint(x);
    const auto r = __builtin_amdgcn_permlane16_swap(xi, xi, false, false);
    const unsigned mi = __float_as_uint(max2f(__uint_as_float(r[0]), __uint_as_float(r[1])));
    const auto q = __builtin_amdgcn_permlane32_swap(mi, mi, false, false);
    return max2f(__uint_as_float(q[0]), __uint_as_float(q[1]));
}
DI void attend(const Args& a, size_t brow, int t, int cnt, LAS const u16* list, LAS unsigned char* img, int lane, int fr, int fq) {
    const u16* Q = (const u16*)(a.ws + WS_Q); const u16* KVN = (const u16*)(a.ws + WS_KVN); u16* YO = (u16*)(a.ws + WS_YO);
    const float* qgbase = a.in[I_QNG]; asm volatile("" : "+s"(qgbase));
    bf16x8 qf[4];
    {
        const int head = fr & 7;
        const u16* qrow = Q + (brow + t) * 1024 + head * 128;
        float f[4][8]; float ss = 0.f;
#pragma unroll
        for (int ks = 0; ks < 4; ++ks) {
            const u32x4 raw = *(const u32x4*)(qrow + ks * 32 + 8 * fq);
            f[ks][0] = bflo(raw.x); f[ks][1] = bfhi(raw.x); f[ks][2] = bflo(raw.y); f[ks][3] = bfhi(raw.y); f[ks][4] = bflo(raw.z); f[ks][5] = bfhi(raw.z); f[ks][6] = bflo(raw.w); f[ks][7] = bfhi(raw.w);
#pragma unroll
            for (int j = 0; j < 8; ++j) ss += f[ks][j] * f[ks][j];
        }
        ss += __shfl_xor(ss, 16); ss += __shfl_xor(ss, 32);
        const float rq = __builtin_amdgcn_rsqf(ss * (1.0f / 128.0f) + EPS) * (0.08838834764831845f * 1.4426950408889634f);
#pragma unroll
        for (int ks = 0; ks < 4; ++ks) {
            const float* qg = qgbase + ks * 32 + 8 * fq;
            u32x4 w;
            w.x = pk2(f[ks][0] * rq * qg[0], f[ks][1] * rq * qg[1]); w.y = pk2(f[ks][2] * rq * qg[2], f[ks][3] * rq * qg[3]);
            w.z = pk2(f[ks][4] * rq * qg[4], f[ks][5] * rq * qg[5]); w.w = pk2(f[ks][6] * rq * qg[6], f[ks][7] * rq * qg[7]);
            qf[ks] = __builtin_bit_cast(bf16x8, w);
        }
    }
    const int nsteps = (cnt + 31) >> 5;
    f32x4 oacc[8];
#pragma unroll
    for (int i = 0; i < 8; ++i) oacc[i] = (f32x4){0.f, 0.f, 0.f, 0.f};
    float mrun = -3.0e38f, lpart = 0.f;
    const char* kvb = (const char*)(KVN + brow * 128);
    auto issue = [&](u32x4 (&pf)[8], int pp) {
#pragma unroll
        for (int it = 0; it < 8; ++it) { const int piece = it * 64 + lane; const unsigned key = list[pp * 32 + (piece >> 4)]; pf[it] = *(const u32x4*)(kvb + (key * 256u + 16u * (unsigned)(piece & 15))); }
    };
    auto step = [&](u32x4 (&pf)[8], int pp) {
#pragma unroll
        for (int it = 0; it < 8; ++it) { const int piece = it * 64 + lane; *(LAS u32x4*)(img + (piece >> 4) * 288 + (piece & 15) * 16) = pf[it]; }
        if (pp + 2 < nsteps) issue(pf, pp + 2);
        wave_lds_sync();
        __builtin_amdgcn_sched_barrier(0);
        f32x4 sa = {0.f, 0.f, 0.f, 0.f}, sb = {0.f, 0.f, 0.f, 0.f};
#pragma unroll
        for (int ks = 0; ks < 4; ++ks) {
            const bf16x8 a0 = *(LAS const bf16x8*)(img + fr * 288 + (ks * 32 + 8 * fq) * 2), a1 = *(LAS const bf16x8*)(img + (16 + fr) * 288 + (ks * 32 + 8 * fq) * 2);
            sa = __builtin_amdgcn_mfma_f32_16x16x32_bf16(a0, qf[ks], sa, 0, 0, 0); sb = __builtin_amdgcn_mfma_f32_16x16x32_bf16(a1, qf[ks], sb, 0, 0, 0);
            if (ks == 1) __builtin_amdgcn_sched_barrier(0);
        }
        if (pp * 32 + 32 > cnt) {
            const int pb0 = pp * 32 + 4 * fq;
#pragma unroll
            for (int r = 0; r < 4; ++r) { if (pb0 + r >= cnt) sa[r] = -3.0e38f; if (pb0 + 16 + r >= cnt) sb[r] = -3.0e38f; }
        }
        const float mx = xmax_16_32(max8_mfma(sa, sb));
        if (__ballot(mx > mrun) != 0ull) {
            const float mnew = max2f(mrun, mx), alpha = __builtin_amdgcn_exp2f(mrun - mnew);
            mrun = mnew; lpart *= alpha;
#pragma unroll
            for (int cb = 0; cb < 8; ++cb) oacc[cb] *= alpha;
        }
        float ps = 0.f;
#pragma unroll
        for (int r = 0; r < 4; ++r) { sa[r] = __builtin_amdgcn_exp2f(sa[r] - mrun); sb[r] = __builtin_amdgcn_exp2f(sb[r] - mrun); ps += sa[r] + sb[r]; }
        lpart += ps;
        u32x4 pw; pw.x = pk2(sa[0], sa[1]); pw.y = pk2(sa[2], sa[3]); pw.z = pk2(sb[0], sb[1]); pw.w = pk2(sb[2], sb[3]);
        const bf16x8 pb = __builtin_bit_cast(bf16x8, pw);
#pragma unroll
        for (int cb = 0; cb < 8; ++cb) {
            const s16x4 r0 = __builtin_amdgcn_ds_read_tr16_b64_v4i16((LAS s16x4*)(img + (4 * fq + (fr >> 2)) * 288 + (cb * 16 + 4 * (fr & 3)) * 2));
            const s16x4 r1 = __builtin_amdgcn_ds_read_tr16_b64_v4i16((LAS s16x4*)(img + (16 + 4 * fq + (fr >> 2)) * 288 + (cb * 16 + 4 * (fr & 3)) * 2));
            const bf16x8 av = {r0[0], r0[1], r0[2], r0[3], r1[0], r1[1], r1[2], r1[3]};
            oacc[cb] = __builtin_amdgcn_mfma_f32_16x16x32_bf16(av, pb, oacc[cb], 0, 0, 0);
            if (cb == 3) __builtin_amdgcn_sched_barrier(0);
        }
        wave_lds_sync();
    };
    u32x4 pf0[8], pf1[8];
    issue(pf0, 0);
    if (nsteps > 1) issue(pf1, 1);
#pragma unroll 1
    for (int pp = 0; pp < nsteps; pp += 2) {
        step(pf0, pp);
        if (pp + 1 < nsteps) step(pf1, pp + 1);
    }
    float lsum = lpart; lsum += __shfl_xor(lsum, 16); lsum += __shfl_xor(lsum, 32);
    const float inv = __builtin_amdgcn_rcpf(lsum);
    if (fr < 8) {
        u16* orow = YO + (brow + t) * 1536 + 512 + fr * 128 + 4 * fq;
#pragma unroll
        for (int cb = 0; cb < 8; ++cb) { u32x2 w; w.x = pk2(oacc[cb][0] * inv, oacc[cb][1] * inv); w.y = pk2(oacc[cb][2] * inv, oacc[cb][3] * inv); *(u32x2*)(orow + cb * 16) = w; }
    }
}

constexpr int N_CVT_JOBS = 32 * 16 * 32 + 32 * 16 * 16;
DI void cvt_job(const Args& a, LAS float* t, int J, int lane) {
    if (J >= N_CVT_JOBS) return;
    const float* src; const float* sk; unsigned char* dst; int ld, k0, n0, row;
    if (J < 16384) {
        const int e = J >> 9, w = J & 511; src = a.in[I_WE1] + (size_t)e * 1024 * 2048; ld = 2048; k0 = (w >> 5) * 64; n0 = (w & 31) * 64; sk = a.in[I_N2G]; dst = a.ws + WS_WE1 + (size_t)e * 2048 * 1024;
        const int n = n0 + lane, hi = n >= 1024 ? 1 : 0, q = n - hi * 1024; row = (q >> 7) * 256 + hi * 128 + (q & 127);
    } else {
        const int j = J - 16384, e = j >> 8, w = j & 255; src = a.in[I_WE2] + (size_t)e * 1024 * 1024; ld = 1024; k0 = (w >> 4) * 64; n0 = (w & 15) * 64; sk = nullptr; dst = a.ws + WS_WE2 + (size_t)e * 1024 * 1024;
        row = n0 + lane;
    }
    const int kl = lane >> 4, n4 = 4 * (lane & 15);
    f32x4 v[4][4];
#pragma unroll
    for (int ks = 0; ks < 4; ++ks)
#pragma unroll
        for (int i = 0; i < 4; ++i) v[ks][i] = __builtin_nontemporal_load((const f32x4*)(src + (size_t)(k0 + ks * 16 + kl + 4 * i) * ld + n0 + n4));
    unsigned char* drow = dst + (size_t)row * 1024 + k0;
#pragma unroll
    for (int ks = 0; ks < 4; ++ks) {
#pragma unroll
        for (int i = 0; i < 4; ++i) { const float sc = (sk ? sk[k0 + ks * 16 + kl + 4 * i] : 1.0f) * 64.0f; *(LAS f32x4*)(t + (kl + 4 * i) * 64 + n4) = v[ks][i] * sc; }
        wave_lds_sync();
        float c[16];
#pragma unroll
        for (int k = 0; k < 16; ++k) c[k] = t[k * 64 + lane];
        u32x4 w; w.x = pk4_fp8(c[0], c[1], c[2], c[3]); w.y = pk4_fp8(c[4], c[5], c[6], c[7]); w.z = pk4_fp8(c[8], c[9], c[10], c[11]); w.w = pk4_fp8(c[12], c[13], c[14], c[15]);
        *(u32x4*)(drow + ks * 16) = w;
        wave_lds_sync();
    }
}

template <bool ROLE_A>
DI void dsa_loop(const Args& a, LAS unsigned char* lds, const int wid) {
    unsigned char* ws = a.ws;
    LAS u16* rows = (LAS u16*)(lds + P3_ROWS);
    bool bprev = false; size_t pbrow = 0; int pt0 = 0, bbuf = 0;
    for (int gi = blockIdx.x; gi < T / 8; gi += gridDim.x) {
        const int lane = otid() & 63, fr = lane & 15, fq = lane >> 4;
        const int b = gi & 3, t0 = S - 8 - 8 * (gi >> 2);
        const size_t brow = (size_t)b * S;
        const int ntile = (t0 + 8 + 15) >> 4;
        __syncthreads();
        {
            const unsigned char* QI = (const unsigned char*)(ws + WS_QI); const unsigned char* KIN = (const unsigned char*)(ws + WS_KIN); const float* WI = (const float*)(ws + WS_WI);
            typedef int i32x4_t __attribute__((ext_vector_type(4)));
            i32x4_t qa[2]; f32x4 wi[2];
#pragma unroll
            for (int rg = 0; rg < 2; ++rg) {
                qa[rg] = *(const i32x4_t*)(QI + (brow + t0 + 4 * rg + (fr >> 2)) * 256 + (fr & 3) * 64 + 16 * fq);
                wi[rg] = *(const f32x4*)(WI + (brow + t0 + 4 * rg + fq) * 4);
            }
            auto ldk = [&](i32x4_t (&kf)[4], int jt0) {
#pragma unroll
                for (int u = 0; u < 4; ++u) {
                    const int jt = (jt0 + 8 * u) < ntile ? (jt0 + 8 * u) : (ntile - 1);
                    kf[u] = *(const i32x4_t*)(KIN + (brow + jt * 16 + fr) * 64 + 16 * fq);
                }
            };
            auto cmpk = [&](const i32x4_t (&kf)[4], int jt0) {
#pragma unroll
                for (int u = 0; u < 4; ++u) {
                    const int jt = jt0 + 8 * u;
                    if (jt < ntile) {
                        float sc[2];
#pragma unroll
                        for (int rg = 0; rg < 2; ++rg) {
                            i32x4_t d = {0, 0, 0, 0};
                            d = __builtin_amdgcn_mfma_i32_16x16x64_i8(qa[rg], kf[u], d, 0, 0, 0);
                            sc[rg] = (((float)max(d[0], 0) * wi[rg][0] + (float)max(d[1], 0) * wi[rg][1]) + (float)max(d[2], 0) * wi[rg][2]) + (float)max(d[3], 0) * wi[rg][3];
                        }
                        const unsigned kw = bf2keys(pk2(sc[0], sc[1]));
                        const int ra = ((jt >> 5) << 9) | ((jt & 3) << 7) | ((jt >> 2) & 7);
                        LAS u16* wp = rows + (fq * 16384 + fr * 8) + ra;
                        wp[0] = (u16)kw; wp[8192] = (u16)(kw >> 16);
                    }
                }
            };
            i32x4_t kA[4], kB[4];
            if (wid < ntile) ldk(kA, wid);
            for (int jt0 = wid; jt0 < ntile; jt0 += 64) {
                const bool hasB = jt0 + 32 < ntile;
                if (hasB) ldk(kB, jt0 + 32);
                cmpk(kA, jt0);
                if (hasB) { if (jt0 + 64 < ntile) ldk(kA, jt0 + 64); cmpk(kB, jt0 + 32); }
            }
        }
        __syncthreads();
        if constexpr (ROLE_A) {
            LAS u16* l0 = (LAS u16*)(lds + (bbuf ? P3_HIST : P3_LIST) + wid * 512);
#pragma unroll 1
            for (int qh = 0; qh < 2; ++qh) {
                u32x4 kr[16];
                const int Nq = t0 + wid + 1 + 4 * qh;
                LAS u16* lq = l0 + qh * 1024;
                if (Nq > 256) keys_load(rows + wid * 16384 + qh * 8192, Nq, lane, kr);
                if (qh == 0) __syncthreads();
                if (Nq > 256) keys_select(kr, lq, Nq, lane); else { for (int p = lane; p < 256; p += 64) lq[p] = p < Nq ? (u16)p : (u16)0; }
            }
            {
                const int G3 = gridDim.x, c3 = blockIdx.x, it3 = (gi - c3) / G3, ntrip = (T / 8 - c3 + G3 - 1) / G3, jtot = (N_CVT_JOBS + 4 * G3 - 1) / (4 * G3);
                const int jlo = (jtot * it3 + ntrip - 1) / ntrip, jhi = (jtot * (it3 + 1) + ntrip - 1) / ntrip;
                LAS float* tcv = (LAS float*)(lds + (wid < 3 ? 135168 + wid * 4096 : 151552));
#pragma unroll 1
                for (int j = jlo; j < jhi; ++j) cvt_job(a, tcv, (j * 4 + wid) * G3 + c3, lane);
            }
        } else {
            __syncthreads();
            if (bprev) {
                LAS const u16* lp = (LAS const u16*)(lds + (bbuf ? P3_LIST : P3_HIST));
                LAS unsigned char* img = (LAS unsigned char*)(rows + (wid - 4) * 16384);
#pragma unroll 1
                for (int qh = 0; qh < 2; ++qh) { const int q = wid - 4 + 4 * qh, t = pt0 + q; attend(a, pbrow, t, t + 1 < 256 ? t + 1 : 256, lp + q * 256, img, lane, fr, fq); }
            }
        }
        bprev = true; pbrow = brow; pt0 = t0; bbuf ^= 1;
    }
}

DI void dsa_phase(const Args& a, LAS unsigned char* lds) {
    const int wid = __builtin_amdgcn_readfirstlane(otid() >> 6);
    if (wid < 4) dsa_loop<true>(a, lds, wid); else dsa_loop<false>(a, lds, wid);
    __syncthreads();
    {
        const int ntrip = (T / 8 - (int)blockIdx.x + (int)gridDim.x - 1) / (int)gridDim.x;
        if (ntrip > 0) {
            const int gl = blockIdx.x + (ntrip - 1) * gridDim.x, pt0 = S - 8 - 8 * (gl >> 2);
            const size_t pbrow = (size_t)(gl & 3) * S;
            const int lane = otid() & 63, fr = lane & 15, fq = lane >> 4;
            LAS u16* rows = (LAS u16*)(lds + P3_ROWS);
            LAS const u16* lp = (LAS const u16*)(lds + ((ntrip & 1) ? P3_LIST : P3_HIST));
            const int q = wid, t = pt0 + q;
            attend(a, pbrow, t, t + 1 < 256 ? t + 1 : 256, lp + q * 256, (LAS unsigned char*)(rows + wid * 8192), lane, fr, fq);
        }
    }
}

constexpr int P6_LCNT = 0, P6_BASE = 128, P6_RSB = 256, P6_RI = 1024;
DI unsigned dpp_max_u32(unsigned v) {
    v = max(v, (unsigned)__builtin_amdgcn_update_dpp(0, (int)v, 0xB1, 0xf, 0xf, false));
    v = max(v, (unsigned)__builtin_amdgcn_update_dpp(0, (int)v, 0x4E, 0xf, 0xf, false));
    v = max(v, (unsigned)__builtin_amdgcn_update_dpp(0, (int)v, 0x141, 0xf, 0xf, false));
    v = max(v, (unsigned)__builtin_amdgcn_update_dpp(0, (int)v, 0x140, 0xf, 0xf, false));
    return v;
}
DI float key2f(unsigned k) { return __uint_as_float((k & 0x80000000u) ? (k & 0x7fffffffu) : ~k); }
DI void router_phase(const Args& a, LAS unsigned char* lds) {
    unsigned char* ws = a.ws;
    const int tid = otid(), wid = tid >> 6, lane = tid & 63, fr = lane & 15, fq = lane >> 4;
    LAS int* lcnt = (LAS int*)(lds + P6_LCNT); LAS int* lbase = (LAS int*)(lds + P6_BASE); LAS float* rsb = (LAS float*)(lds + P6_RSB); LAS int* RI = (LAS int*)(lds + P6_RI);
    const u16* WRH = (const u16*)(ws + WS_WR);
    unsigned* CNT = (unsigned*)(ws + WS_CTL);
    LAS unsigned char* WL = lds + 16384;
    __syncthreads();
    for (int i = tid; i < 64 * 128; i += NT) { const int r = i >> 7, p = i & 127; *(LAS u32x4*)(WL + r * 2064 + p * 16) = *(const u32x4*)(WRH + (size_t)r * 1024 + p * 8); }
    for (int rg = blockIdx.x; rg < T / 128; rg += gridDim.x) {
        __syncthreads();
        if (tid < 32) lcnt[tid] = 0;
        __syncthreads();
        {
            const int row = rg * 128 + wid * 16 + fr;
            const float* xr = a.out + (size_t)row * 1024 + 8 * fq;
            f32x4 acc[2] = {{0.f, 0.f, 0.f, 0.f}, {0.f, 0.f, 0.f, 0.f}};
            float ss = 0.f;
#pragma unroll 4
            for (int ks = 0; ks < 32; ++ks) {
                const f32x4 x0 = *(const f32x4*)(xr + ks * 32), x1 = *(const f32x4*)(xr + ks * 32 + 4);
                ss += ((x0[0] * x0[0] + x0[1] * x0[1]) + (x0[2] * x0[2] + x0[3] * x0[3])) + ((x1[0] * x1[0] + x1[1] * x1[1]) + (x1[2] * x1[2] + x1[3] * x1[3]));
                u32x4 hw; hw.x = pk2(x0[0], x0[1]); hw.y = pk2(x0[2], x0[3]); hw.z = pk2(x1[0], x1[1]); hw.w = pk2(x1[2], x1[3]);
                u32x4 lw; lw.x = pk2(x0[0] - bflo(hw.x), x0[1] - bfhi(hw.x)); lw.y = pk2(x0[2] - bflo(hw.y), x0[3] - bfhi(hw.y)); lw.z = pk2(x1[0] - bflo(hw.z), x1[1] - bfhi(hw.z)); lw.w = pk2(x1[2] - bflo(hw.w), x1[3] - bfhi(hw.w));
                const bf16x8 xh = __builtin_bit_cast(bf16x8, hw), xl = __builtin_bit_cast(bf16x8, lw);
#pragma unroll
                for (int nt = 0; nt < 2; ++nt) {
                    const bf16x8 wh = *(LAS const bf16x8*)(WL + (nt * 16 + fr) * 2064 + (ks * 32 + 8 * fq) * 2), wl = *(LAS const bf16x8*)(WL + (32 + nt * 16 + fr) * 2064 + (ks * 32 + 8 * fq) * 2);
                    acc[nt] = __builtin_amdgcn_mfma_f32_16x16x32_bf16(xh, wh, acc[nt], 0, 0, 0);
                    acc[nt] = __builtin_amdgcn_mfma_f32_16x16x32_bf16(xl, wh, acc[nt], 0, 0, 0);
                    acc[nt] = __builtin_amdgcn_mfma_f32_16x16x32_bf16(xh, wl, acc[nt], 0, 0, 0);
                }
            }
            ss += __shfl_xor(ss, 16); ss += __shfl_xor(ss, 32);
            const float rsrow = __builtin_amdgcn_rsqf(ss * (1.0f / 1024.0f) + EPS);
            if (fq == 0) rsb[wid * 16 + fr] = rsrow;
            {
                unsigned char* xn = ws + WS_XN2 + (size_t)row * 1024 + 8 * fq;
#pragma unroll 4
                for (int ks = 0; ks < 32; ++ks) {
                    const f32x4 x0 = *(const f32x4*)(xr + ks * 32), x1 = *(const f32x4*)(xr + ks * 32 + 4);
                    u32x2 w; w.x = pk4_fp8(x0[0] * rsrow, x0[1] * rsrow, x0[2] * rsrow, x0[3] * rsrow); w.y = pk4_fp8(x1[0] * rsrow, x1[1] * rsrow, x1[2] * rsrow, x1[3] * rsrow);
                    *(u32x2*)(xn + ks * 32) = w;
                }
            }
            wave_lds_sync();
            const float b0 = a.in[I_BR][fr], b1 = a.in[I_BR][16 + fr];
#pragma unroll
            for (int r = 0; r < 4; ++r) {
                const float rs = rsb[wid * 16 + 4 * fq + r];
                unsigned k0 = (f2key(acc[0][r] * rs + b0) & ~31u) | (unsigned)(31 - fr), k1 = (f2key(acc[1][r] * rs + b1) & ~31u) | (unsigned)(15 - fr);
                unsigned sel[4];
#pragma unroll
                for (int k = 0; k < 4; ++k) {
                    const unsigned best = dpp_max_u32(k0 > k1 ? k0 : k1);
                    sel[k] = best;
                    if (k0 == best) k0 = 0u;
                    if (k1 == best) k1 = 0u;
                }
                const float v0 = key2f(sel[0] & ~31u), e1 = __expf(key2f(sel[1] & ~31u) - v0), e2 = __expf(key2f(sel[2] & ~31u) - v0), e3 = __expf(key2f(sel[3] & ~31u) - v0);
                const float inv = 1.0f / (1.0f + e1 + e2 + e3);
                if (fr < 4) {
                    const unsigned sk = fr == 0 ? sel[0] : (fr == 1 ? sel[1] : (fr == 2 ? sel[2] : sel[3]));
                    const int e = 31 - (int)(sk & 31u);
                    const float gt = (fr == 0 ? 1.0f : (fr == 1 ? e1 : (fr == 2 ? e2 : e3))) * inv;
                    const int ls = __hip_atomic_fetch_add(lcnt + e, 1, __ATOMIC_RELAXED, __HIP_MEMORY_SCOPE_WORKGROUP);
                    const int ri = ((wid * 16 + 4 * fq + r) * 4 + fr) * 4;
                    RI[ri + 0] = e; RI[ri + 1] = ls; RI[ri + 2] = __float_as_int(gt);
                }
            }
        }
        __syncthreads();
        if (tid < 32) lbase[tid] = (int)__hip_atomic_fetch_add(CNT + tid, (unsigned)lcnt[tid], __ATOMIC_RELAXED, __HIP_MEMORY_SCOPE_AGENT);
        __syncthreads();
        {
            const int rl = tid >> 2, k = tid & 3, row = rg * 128 + rl;
            const int e = RI[tid * 4 + 0], slot = lbase[e] + RI[tid * 4 + 1];
            ((int*)(ws + WS_LTOK))[(size_t)e * ECAP + slot] = row;
            ((float*)(ws + WS_LRS))[(size_t)row * 4 + k] = __int_as_float(RI[tid * 4 + 2]);
            ((unsigned*)(ws + WS_ROUTE))[(size_t)row * 4 + k] = ((unsigned)e << 16) | (unsigned)slot;
        }
    }
}

DI void combine_phase(const Args& a, LAS unsigned char* lds) {
    unsigned char* ws = a.ws;
    LAS const int* tab = (LAS const int*)(lds + MOE_TAB);
    const int tid = otid(), wid = tid >> 6, lane = tid & 63;
    const u16* YB = (const u16*)(ws + WS_YB); const unsigned* ROUTE = (const unsigned*)(ws + WS_ROUTE);
    for (int row = blockIdx.x * 8 + wid; row < T; row += gridDim.x * 8) {
        size_t pos[4];
#pragma unroll
        for (int k = 0; k < 4; ++k) { const unsigned r = ROUTE[(size_t)row * 4 + k]; const int e = (int)(r >> 16), slot = (int)(r & 0xffffu); pos[k] = (size_t)tab[e] * 256 + slot; }
        float* orow = a.out + (size_t)row * 1024;
        const f32x4 gt = *(const f32x4*)((const float*)(ws + WS_LRS) + (size_t)row * 4);
#pragma unroll
        for (int i = 0; i < 4; ++i) {
            f32x4 v = *(const f32x4*)(orow + i * 256 + lane * 4);
#pragma unroll
            for (int k = 0; k < 4; ++k) { const u32x2 y = __builtin_nontemporal_load((const u32x2*)(YB + pos[k] * 1024 + i * 256 + lane * 4)); v[0] += gt[k] * bflo(y.x); v[1] += gt[k] * bfhi(y.x); v[2] += gt[k] * bflo(y.y); v[3] += gt[k] * bfhi(y.y); }
            *(f32x4*)(orow + i * 256 + lane * 4) = v;
        }
    }
}

#define XB_TMO      128
#define XB_XCNT(j)  (256  + 64 * (j))
#define XB_XSUB(j)  (1280 + 64 * (j))
#define XB_XGEN(j)  (2304 + 64 * (j))
#define XB_TOP      3328
#define XB_TOPGEN   3392
#define XCD_BAR_WORDS 3456
#define XB_SPIN_CAP (1u << 18)

__device__ __forceinline__ unsigned xb_ld(unsigned* p)              { return __hip_atomic_load(p, __ATOMIC_RELAXED, __HIP_MEMORY_SCOPE_AGENT); }
__device__ __forceinline__ unsigned xb_add(unsigned* p, unsigned v) { return __hip_atomic_fetch_add(p, v, __ATOMIC_RELAXED, __HIP_MEMORY_SCOPE_AGENT); }
__device__ __forceinline__ unsigned xb_xcc_id() { return (unsigned)__builtin_amdgcn_s_getreg((3 << 11) | 20) & 0xFu; }
#define XB_SPIN(cond, bar) do { unsigned _sp = 0; while (cond) { __builtin_amdgcn_s_sleep(1); \
    if ((++_sp & 255u) == 0u) { if (xb_ld(&(bar)[XB_TMO])) break; if (_sp > XB_SPIN_CAP) { atomicAdd(&(bar)[XB_TMO], 1u); break; } } } } while (0)

struct XcdBarrier {
    unsigned* bar; unsigned x;
    volatile LAS unsigned* st;
};

__device__ __forceinline__ XcdBarrier xcd_barrier_post(unsigned* bar, volatile LAS unsigned* st) {
    XcdBarrier b; b.bar = bar; b.x = xb_xcc_id(); b.st = st;
    if (threadIdx.x == 0) (void)xb_add(&bar[XB_XCNT(b.x)], 1u);
    return b;
}
__device__ __forceinline__ void xcd_barrier_complete(unsigned* bar, unsigned x, unsigned& nloc, unsigned& nx) {
    const unsigned G = gridDim.x * gridDim.y * gridDim.z;
    unsigned sum, cnt, mine, sp = 0u;
    for (;;) {
        sum = 0u; cnt = 0u; mine = 0u;
#pragma unroll
        for (unsigned j = 0; j < 16; ++j) { const unsigned c = xb_ld(&bar[XB_XCNT(j)]); sum += c; cnt += (c > 0u) ? 1u : 0u; mine = (j == x) ? c : mine; }
        if (sum == G) break;
        __builtin_amdgcn_s_sleep(1);
        if ((++sp & 255u) == 0u) { if (xb_ld(&bar[XB_TMO])) break; if (sp > XB_SPIN_CAP) { atomicAdd(&bar[XB_TMO], 1u); break; } }
    }
    nloc = mine > 0u ? mine : 1u; nx = cnt > 0u ? cnt : 1u;
}

__device__ __forceinline__ void xcd_barrier(const XcdBarrier& b) {
    asm volatile("s_waitcnt vmcnt(0)" ::: "memory");
    __syncthreads();
    if (threadIdx.x == 0) {
        unsigned* bar = b.bar;
        __builtin_amdgcn_s_waitcnt(0);
        unsigned nloc = b.st[0], nx = b.st[1];
        if (nloc == 0u) { xcd_barrier_complete(bar, b.x, nloc, nx); b.st[0] = nloc; b.st[1] = nx; }
        const unsigned old = xb_add(&bar[XB_XSUB(b.x)], 1u);
        const unsigned gen = old / nloc;
        if (old + 1u == (gen + 1u) * nloc) {
            __builtin_amdgcn_fence(__ATOMIC_RELEASE, "agent");
            asm volatile("s_waitcnt vmcnt(0)" ::: "memory");
            const unsigned og = xb_add(&bar[XB_TOP], 1u);
            const unsigned tg = og / nx;
            if (og + 1u == (tg + 1u) * nx) xb_add(&bar[XB_TOPGEN], 1u);
            else XB_SPIN(xb_ld(&bar[XB_TOPGEN]) == tg, bar);
            __builtin_amdgcn_fence(__ATOMIC_ACQUIRE, "agent");
            xb_add(&bar[XB_XGEN(b.x)], 1u);
            asm volatile("s_waitcnt vmcnt(0)" ::: "memory");
        } else {
            XB_SPIN(xb_ld(&bar[XB_XGEN(b.x)]) == gen, bar);
            __builtin_amdgcn_fence(__ATOMIC_ACQUIRE, "agent");
            asm volatile("s_waitcnt vmcnt(0)" ::: "memory");
        }
    }
    __syncthreads();
}

__global__ void __launch_bounds__(NT, 2) fwd(Args a) {
    extern __shared__ __attribute__((aligned(16))) unsigned char lds_raw[];
    LAS unsigned char* lds = (LAS unsigned char*)lds_raw;
    cg::grid_group grid = cg::this_grid();
    unsigned char* ws = a.ws;
    const int G = gridDim.x, c = blockIdx.x;
    if (threadIdx.x < 2) ((volatile LAS unsigned*)(lds + LDS_BARST))[threadIdx.x] = 0u;
    __syncthreads();
    const XcdBarrier xbar = xcd_barrier_post((unsigned*)(ws + WS_BAR), (volatile LAS unsigned*)(lds + LDS_BARST));

    phase0(a, lds);
    xcd_barrier(xbar);
    {
        g8::PlainSched s; s.Abase = (const char*)(ws + WS_XB); s.Bbase = (const char*)(ws + WS_WIN); s.lda = 1024; s.ldb = 1024; s.K = 1024; s.nM = T / 256; s.nN = NIN / 256; s.G = G; s.c = c;
        EpiIn e; e.H = (u16*)(ws + WS_H); e.rs1 = (const float*)(ws + WS_RS1); e.SSQ = (float*)(ws + WS_SSQ); e.WI = (float*)(ws + WS_WI);
        g8::gemm_phase(lds, s, e);
    }
    xcd_barrier(xbar);
    {
        g8::PlainSched s; s.Abase = (const char*)(ws + WS_H) + 1024 * 2; s.Bbase = (const char*)(ws + WS_WQ); s.lda = NIN; s.ldb = 256; s.K = 256; s.nM = T / 256; s.nN = 5; s.G = G; s.c = c;
        EpiQ e; e.Q = (u16*)(ws + WS_Q); e.QI = (u16*)(ws + WS_QI); e.SSQ = (const float*)(ws + WS_SSQ);
        g8::gemm_phase(lds, s, e);
        for (int u = c; u < 1024; u += G) gmlp_unit(a, lds, u);
        kvnorm(a);
    }
    xcd_barrier(xbar);
    dsa_phase(a, lds);
    xcd_barrier(xbar);
    {
        g8::PlainSched s; s.Abase = (const char*)(ws + WS_YO); s.Bbase = (const char*)(ws + WS_WCAT); s.lda = 1536; s.ldb = 1536; s.K = 512; s.nM = T / 256; s.nN = 4; s.G = G; s.c = c;
        EpiMrg<0> e0; e0.OUT = (u16*)(ws + WS_TMP); e0.TMP = nullptr; e0.H = (const u16*)(ws + WS_H);
        g8::gemm_phase(lds, s, e0);
        s.Abase = (const char*)(ws + WS_YO) + 512 * 2; s.Bbase = (const char*)(ws + WS_WCAT) + 512 * 2; s.K = 1024;
        EpiMrg<1> e1; e1.OUT = (u16*)(ws + WS_MRG); e1.TMP = (const u16*)(ws + WS_TMP); e1.H = (const u16*)(ws + WS_H);
        g8::gemm_phase(lds, s, e1);
    }
    xcd_barrier(xbar);
    {
        g8::PlainSched s; s.Abase = (const char*)(ws + WS_MRG); s.Bbase = (const char*)(ws + WS_WOUT); s.lda = 1024; s.ldb = 1024; s.K = 1024; s.nM = T / 256; s.nN = 4; s.G = G; s.c = c;
        EpiOut e; e.out = a.out; e.x = a.in[I_X];
        g8::gemm_phase(lds, s, e);
    }
    xcd_barrier(xbar);
    router_phase(a, lds);
    xcd_barrier(xbar);
    moe_table(lds, (const unsigned*)(ws + WS_CTL));
    {
        MoeSched<8, true> s; s.Abase = (const char*)(ws + WS_XN2); s.Wbase = (const char*)(ws + WS_WE1); s.LTOK = (const int*)(ws + WS_LTOK); s.tab = (LAS const int*)(lds + MOE_TAB);
        s.lda = 1024; s.ldb = 1024; s.K = 1024; s.G = G; s.c = c; s.wstride = (size_t)2048 * 1024;
        EpiMoe1 e; e.ACT = (unsigned char*)(ws + WS_ACT); e.b1 = a.in[I_BE1];
        g8::gemm_phase<true>(lds, s, e);
    }
    xcd_barrier(xbar);
    {
        MoeSched<4, false> s; s.Abase = (const char*)(ws + WS_ACT); s.Wbase = (const char*)(ws + WS_WE2); s.LTOK = nullptr; s.tab = (LAS const int*)(lds + MOE_TAB);
        s.lda = 1024; s.ldb = 1024; s.K = 1024; s.G = G; s.c = c; s.wstride = (size_t)1024 * 1024;
        EpiMoe2 e; e.YB = (u16*)(ws + WS_YB); e.b2 = a.in[I_BE2];
        g8::gemm_phase<true>(lds, s, e);
    }
    xcd_barrier(xbar);
    combine_phase(a, lds);
    if (a.mask == 0u) grid.sync();
}

extern "C" void kernel_launch(void* const* d_in, const int* in_sizes, int n_in, void* d_out, int out_size, void* d_ws, size_t ws_size, hipStream_t stream) {
    static int grid = 0;
    if (grid == 0) {
        int dev = 0, cus = 0, per_cu = 0;
        if (n_in != 23 || out_size != T * Dm || ws_size < WS_END) { fprintf(stderr, "kernel_launch: unexpected problem (n_in %d, out %d, ws %zu < %zu)\n", n_in, out_size, ws_size, (size_t)WS_END); grid = -1; return; }
        if (hipGetDevice(&dev) != hipSuccess || hipDeviceGetAttribute(&cus, hipDeviceAttributeMultiprocessorCount, dev) != hipSuccess) { grid = -1; return; }
        if (hipFuncSetAttribute((const void*)fwd, hipFuncAttributeMaxDynamicSharedMemorySize, LDS_BYTES) != hipSuccess) { fprintf(stderr, "hipFuncSetAttribute failed\n"); grid = -1; return; }
        if (hipOccupancyMaxActiveBlocksPerMultiprocessor(&per_cu, (const void*)fwd, NT, LDS_BYTES) != hipSuccess || per_cu < 1) { fprintf(stderr, "occupancy query failed (%d)\n", per_cu); grid = -1; return; }
        grid = cus;
        fprintf(stderr, "kernel_launch: cus %d per_cu %d grid %d ws %zu need %zu\n", cus, per_cu, grid, ws_size, (size_t)WS_END);
    }
    if (grid < 0) return;
    Args a{};
    for (int i = 0; i < 23; ++i) a.in[i] = (const float*)d_in[i];
    a.out = (float*)d_out; a.ws = (unsigned char*)d_ws; a.mask = 0xffffffffu; a.pad = 0u;
    if (hipMemsetAsync((char*)d_ws + WS_CTL, 0, 65536, stream) != hipSuccess) { fprintf(stderr, "memset failed\n"); return; }
    void* args[] = {&a};
    hipError_t e = hipLaunchCooperativeKernel((const void*)fwd, dim3(grid), dim3(NT), args, LDS_BYTES, stream);
    if (e != hipSuccess) fprintf(stderr, "cooperative launch failed: %s (grid %d)\n", hipGetErrorString(e), grid);
}
```

```cpp
#include <hip/hip_runtime.h>
#include <hip/hip_cooperative_groups.h>
#include <cstdio>
#include <cstdint>
namespace cg = cooperative_groups;

#define LAS __attribute__((address_space(3)))
#define DI __device__ __forceinline__
typedef unsigned short u16;
typedef short bf16x8 __attribute__((ext_vector_type(8)));
typedef short s16x4 __attribute__((ext_vector_type(4)));
typedef float f32x4 __attribute__((ext_vector_type(4)));
typedef float f32x2 __attribute__((ext_vector_type(2)));
typedef unsigned u32x4 __attribute__((ext_vector_type(4)));
typedef unsigned u32x2 __attribute__((ext_vector_type(2)));
typedef __bf16 bf2_t __attribute__((ext_vector_type(2)));
typedef int v8i_t __attribute__((ext_vector_type(8)));

constexpr int NT = 512;
constexpr int LDS_BYTES = 159744;
constexpr int Dm = 1024, Bsz = 4, S = 8192, T = Bsz * S;
constexpr int NIN = 3584;
constexpr int NE = 32, ECAP = 32768, PPAD = 131072 + NE * 256;
constexpr float EPS = 1e-6f;

constexpr size_t MiB = 1024 * 1024;
constexpr size_t WS_CTL = 0;
constexpr size_t WS_BAR = 16384;
constexpr int LDS_BARST = LDS_BYTES - 16;
constexpr size_t WS_WIN = 64 * 1024;
constexpr size_t WS_WQ = WS_WIN + (size_t)NIN * 1024 * 2;
constexpr size_t WS_WSP = WS_WQ + 1280 * 256 * 2;
constexpr size_t WS_WCAT = WS_WSP + 4 * 128 * 128 * 2;
constexpr size_t WS_WOUT = WS_WCAT + 1024 * 1536 * 2;
constexpr size_t WS_WR = WS_WOUT + 1024 * 1024 * 2;
constexpr size_t WS_WE1 = WS_WR + 32 * 1024 * 4;
constexpr size_t WS_WE2 = WS_WE1 + (size_t)32 * 2048 * 1024 * 2;
constexpr size_t WS_RS1 = WS_WE2 + (size_t)32 * 1024 * 1024 * 2;
constexpr size_t WS_SSQ = WS_RS1 + (size_t)T * 4;
constexpr size_t WS_WI = WS_SSQ + (size_t)T * 32 * 4;
constexpr size_t WS_ROUTE = WS_WI + (size_t)T * 4 * 4;
constexpr size_t WS_LTOK = WS_ROUTE + (size_t)T * 4 * 4;
constexpr size_t WS_LGATE = WS_LTOK + (size_t)NE * ECAP * 4;
constexpr size_t WS_LRS = WS_LGATE + (size_t)NE * ECAP * 4;
constexpr size_t WS_XN2 = WS_LRS + (size_t)NE * ECAP * 4;
constexpr size_t WS_R0 = WS_XN2 + (size_t)T * 1024 * 2;
constexpr size_t WS_XB = WS_R0;
constexpr size_t WS_H = WS_XB + (size_t)T * 1024 * 2;
constexpr size_t WS_Q = WS_H + (size_t)T * NIN * 2;
constexpr size_t WS_QI = WS_Q + (size_t)T * 1024 * 2;
constexpr size_t WS_KVN = WS_QI + (size_t)T * 256 * 2;
constexpr size_t WS_KIN = WS_KVN + (size_t)T * 128 * 2;
constexpr size_t WS_YO = WS_KIN + (size_t)T * 64 * 2;
constexpr size_t WS_TMP = WS_YO + (size_t)T * 1536 * 2;
constexpr size_t WS_MRG = WS_TMP + (size_t)T * 1024 * 2;
constexpr size_t WS_R0END = WS_MRG + (size_t)T * 1024 * 2;
constexpr size_t WS_ACT = WS_XB;
constexpr size_t WS_YB = WS_Q;
static_assert(WS_ACT + (size_t)PPAD * 1024 * 2 <= WS_Q, "ACT overlaps YB");
static_assert(WS_YB + (size_t)PPAD * 1024 * 2 <= WS_R0END, "YB too large");
constexpr size_t WS_END = WS_R0END;

struct Args { const float* in[23]; float* out; unsigned char* ws; unsigned mask; unsigned pad; };
enum { I_X = 0, I_N1G, I_WIN, I_QLG, I_WUQ, I_QNG, I_KVG, I_WUV, I_WQI, I_KIG, I_VG, I_WSP, I_BSP, I_WPA, I_WPB, I_WOUT, I_N2G, I_WR, I_BR, I_WE1, I_BE1, I_WE2, I_BE2 };

DI unsigned pk2(float a, float b) { f32x2 v = {a, b}; bf2_t r = __builtin_convertvector(v, bf2_t); return __builtin_bit_cast(unsigned, r); }
DI unsigned pk4_fp8(float a, float b, float c, float d) { unsigned w = 0u; w = (unsigned)__builtin_amdgcn_cvt_pk_fp8_f32(a, b, (int)w, false); w = (unsigned)__builtin_amdgcn_cvt_pk_fp8_f32(c, d, (int)w, true); return w; }
DI unsigned pk4_i8(float a, float b, float c, float d) {
    const int ia = (int)__builtin_rintf(fminf(fmaxf(a * 32.0f, -127.0f), 127.0f)), ib = (int)__builtin_rintf(fminf(fmaxf(b * 32.0f, -127.0f), 127.0f));
    const int ic = (int)__builtin_rintf(fminf(fmaxf(c * 32.0f, -127.0f), 127.0f)), id = (int)__builtin_rintf(fminf(fmaxf(d * 32.0f, -127.0f), 127.0f));
    return (unsigned)(ia & 0xff) | ((unsigned)(ib & 0xff) << 8) | ((unsigned)(ic & 0xff) << 16) | ((unsigned)(id & 0xff) << 24);
}
DI float bflo(unsigned u) { return __uint_as_float(u << 16); }
DI float bfhi(unsigned u) { return __uint_as_float(u & 0xffff0000u); }
DI u16 f2bf(float f) { return (u16)(pk2(f, 0.f) & 0xffffu); }
DI float bf2f(u16 h) { return __uint_as_float(((unsigned)h) << 16); }
DI float sigmoidf_(float x) { return __builtin_amdgcn_rcpf(1.0f + __expf(-x)); }
DI float gelu_tanh(float x) { const float u = 1.5957691216057308f * (x + 0.044715f * x * x * x); return x * sigmoidf_(u); }
DI float fast_sigmoid(float x) { return __builtin_amdgcn_rcpf(1.0f + __builtin_amdgcn_exp2f(x * -1.4426950408889634f)); }
DI float fast_gelu(float x) { const float p = __builtin_fmaf(x * x, -0.10294324f, -2.3022082f); return x * __builtin_amdgcn_rcpf(1.0f + __builtin_amdgcn_exp2f(x * p)); }
DI int otid() { int t = threadIdx.x; asm volatile("" : "+v"(t)); return t; }
DI void wave_lds_sync() { asm volatile("s_waitcnt lgkmcnt(0)" ::: "memory"); }

namespace g8 {
constexpr int BM = 256, BK = 64, HALF = 128, HTB = HALF * BK * 2, STAGE_BYTES = 8 * HTB, NXCD = 8, WGM = 8;
DI int lds_byte(int r, int c) { const int st = (r >> 4) * 2 + (c >> 5), rr = r & 15, cc = c & 31, ob = rr * 64 + cc * 2; return st * 1024 + (ob ^ (((ob >> 9) & 1) << 5)); }
DI int perm32(int rho) { const int n = rho >> 4, i = rho & 15; return 8 * (i >> 2) + 4 * n + (i & 3); }
DI void stage_rc(int b, int& R, int& C) { const int st = b / 1024, sb = b % 1024, swz = sb ^ (((sb >> 9) & 1) << 5); R = (st >> 1) * 16 + swz / 64; C = (st & 1) * 32 + (swz % 64) / 2; }

struct UnitD { const char* Bp; int pm, pn, e, rb; };

DI bool static_tile(int i, int G, int c, int nM, int nN, int& pm, int& pn) {
    const int nwg = nM * nN; const long L = (long)i * G + c; if (L >= nwg) return false;
    int wgid = (int)L; { const int q = nwg / NXCD, r = nwg % NXCD, xcd = wgid % NXCD, off = wgid / NXCD; wgid = (xcd < r ? xcd * (q + 1) : r * (q + 1) + (xcd - r) * q) + off; }
    const int nig = WGM * nN, gid = wgid / nig, fm = gid * WGM, gsz = (nM - fm) < WGM ? (nM - fm) : WGM;
    pm = fm + ((wgid % nig) % gsz); pn = (wgid % nig) / gsz; return true;
}

struct PlainSched {
    const char* Abase; const char* Bbase; int lda, ldb, K, nM, nN, G, c; static constexpr int esz = 2;
    DI bool next(int i, UnitD& u) const { int pm, pn; if (!static_tile(i, G, c, nM, nN, pm, pn)) return false; u.pm = pm; u.pn = pn; u.e = 0; u.rb = 0; u.Bp = Bbase + (size_t)pn * BM * ldb * 2; return true; }
    DI void a_offs(const UnitD& u, int R0, int C0, unsigned (&o)[2][2]) const {
#pragma unroll
        for (int h = 0; h < 2; ++h)
#pragma unroll
            for (int i = 0; i < 2; ++i) o[h][i] = (unsigned)(((size_t)(u.pm * BM + h * HALF + R0 + 64 * i) * lda + C0) * 2);
    }
};

template <bool FP8 = false, class Epi, class Sched>
DI void gemm_phase(LAS unsigned char* lds, const Sched& S, const Epi& E) {
    const int tid = otid(), wid = __builtin_amdgcn_readfirstlane(tid >> 6), lane = tid & 63, wr = wid >> 2, wc = wid & 3, fr = lane & 15, fq = lane >> 4;
    const int nt = S.K * Sched::esz / 128;
    int R0, C0; stage_rc(tid * 16, R0, C0);
    unsigned voffB[2];
#pragma unroll
    for (int i = 0; i < 2; ++i) { const int Rr = R0 + 64 * i, Rb = Epi::PERM ? ((Rr & ~31) + perm32(Rr & 31)) : Rr; voffB[i] = (unsigned)(Rb * S.ldb * Sched::esz + C0 * 2); }
    const size_t hstepB = (size_t)HALF * S.ldb * Sched::esz;
    const unsigned ldsw = (unsigned)wid * 1024u;
    const int aoff = FP8 ? lds_byte(wr * 64 + fr, fq * 16) : lds_byte(wr * 64 + fr, fq * 8), boff = FP8 ? lds_byte(wc * 32 + fr, fq * 16) : lds_byte(wc * 32 + fr, fq * 8);
    const unsigned mxscale = 0x7f7f7f7fu;
    const int kst = FP8 ? 16 : 1024;
    const char* Ab = S.Abase;
#define G8_SA(b, h) (((b) * 2 + (h)) * HTB)
#define G8_SB(b, h) ((4 + (b) * 2 + (h)) * HTB)
#define G8_STAGE_A(bufoff, offs, kb) do { _Pragma("unroll") for (int _i = 0; _i < 2; ++_i) \
        __builtin_amdgcn_global_load_lds((const unsigned*)(Ab + (size_t)(offs)[_i] + (size_t)(kb)), (LAS unsigned*)(lds + (bufoff) + ldsw + _i * 8192), 16, 0, 0); } while (0)
#define G8_STAGE_B(bufoff, gbase, kb) do { _Pragma("unroll") for (int _i = 0; _i < 2; ++_i) \
        __builtin_amdgcn_global_load_lds((const unsigned*)((gbase) + voffB[_i] + (size_t)(kb)), (LAS unsigned*)(lds + (bufoff) + ldsw + _i * 8192), 16, 0, 0); } while (0)
#define G8_LDA(dst, b, h) do { _Pragma("unroll") for (int m = 0; m < 4; ++m) { const i32x4_t _p = *(const LAS i32x4_t*)(lds + G8_SA(b, h) + aoff + m * 2048), _q = *(const LAS i32x4_t*)(lds + G8_SA(b, h) + aoff + m * 2048 + kst); dst[m] = __builtin_shufflevector(_p, _q, 0, 1, 2, 3, 4, 5, 6, 7); } } while (0)
#define G8_LDB(dst, b, h) do { _Pragma("unroll") for (int n = 0; n < 2; ++n) { const i32x4_t _p = *(const LAS i32x4_t*)(lds + G8_SB(b, h) + boff + n * 2048), _q = *(const LAS i32x4_t*)(lds + G8_SB(b, h) + boff + n * 2048 + kst); dst[n] = __builtin_shufflevector(_p, _q, 0, 1, 2, 3, 4, 5, 6, 7); } } while (0)
#define G8_MMA(ai, bj, At, Bt) do { __builtin_amdgcn_s_setprio(1); _Pragma("unroll") for (int m = 0; m < 4; ++m) _Pragma("unroll") for (int n = 0; n < 2; ++n) { \
        if constexpr (FP8) asm volatile("v_mfma_scale_f32_16x16x128_f8f6f4 %0, %1, %2, %0, %3, %3 op_sel_hi:[0,0,0]" : "+v"(acc[ai][bj][m][n]) : "v"(Bt[n]), "v"(At[m]), "v"(mxscale)); \
        else { acc[ai][bj][m][n] = __builtin_amdgcn_mfma_f32_16x16x32_bf16(__builtin_bit_cast(bf16x8, __builtin_shufflevector(Bt[n], Bt[n], 0, 1, 2, 3)), __builtin_bit_cast(bf16x8, __builtin_shufflevector(At[m], At[m], 0, 1, 2, 3)), acc[ai][bj][m][n], 0, 0, 0); \
               acc[ai][bj][m][n] = __builtin_amdgcn_mfma_f32_16x16x32_bf16(__builtin_bit_cast(bf16x8, __builtin_shufflevector(Bt[n], Bt[n], 4, 5, 6, 7)), __builtin_bit_cast(bf16x8, __builtin_shufflevector(At[m], At[m], 4, 5, 6, 7)), acc[ai][bj][m][n], 0, 0, 0); } } \
        __builtin_amdgcn_s_setprio(0); } while (0)
#define G8_WAIT_V(n) asm volatile("s_waitcnt vmcnt(" #n ")" ::: "memory")
#define G8_WAIT_L(n) asm volatile("s_waitcnt lgkmcnt(" #n ")" ::: "memory")
#define G8_BAR __builtin_amdgcn_s_barrier()
#define G8_SCHED __builtin_amdgcn_sched_barrier(0)
    UnitD cur, nxt; int ui = 0;
    if (!S.next(0, cur)) return;
    f32x4 acc[2][2][4][2];
#pragma unroll
    for (int a = 0; a < 2; ++a)
#pragma unroll
        for (int b = 0; b < 2; ++b)
#pragma unroll
            for (int m = 0; m < 4; ++m)
#pragma unroll
                for (int n = 0; n < 2; ++n) acc[a][b][m][n] = (f32x4){0.f, 0.f, 0.f, 0.f};
    typedef int i32x4_t __attribute__((ext_vector_type(4)));
    v8i_t At[4], B0[2], B1[2];
    unsigned cA[2][2];
    S.a_offs(cur, R0, C0, cA);
    const char* cB = cur.Bp;
    G8_STAGE_B(G8_SB(0, 0), cB, 0); G8_STAGE_A(G8_SA(0, 0), cA[0], 0); G8_STAGE_B(G8_SB(0, 1), cB + hstepB, 0); G8_STAGE_A(G8_SA(0, 1), cA[1], 0);
    if (wr == 1) G8_BAR;
    G8_WAIT_V(4); G8_BAR;
    G8_STAGE_B(G8_SB(1, 0), cB, 128); G8_STAGE_A(G8_SA(1, 0), cA[0], 128); G8_STAGE_B(G8_SB(1, 1), cB + hstepB, 128);
    G8_WAIT_V(6); G8_BAR;
    for (;;) {
        const bool has_next = S.next(ui + 1, nxt);
        const char* nB = has_next ? nxt.Bp : cB;
        for (int t = 0; t < nt; t += 2) {
            const bool last = (t == nt - 2);
            const unsigned k1 = (unsigned)(t + 1) * 128u;
            const unsigned k2 = last ? 0u : (unsigned)(t + 2) * 128u, k3 = k2 + 128u;
            unsigned c1[2] = {cA[1][0], cA[1][1]};
            if (last && has_next) S.a_offs(nxt, R0, C0, cA);
            const char* b2 = last ? nB : cB;
            G8_LDB(B0, 0, 0); G8_SCHED; G8_LDA(At, 0, 0); G8_STAGE_A(G8_SA(1, 1), c1, k1);
            G8_WAIT_L(8); G8_BAR; G8_WAIT_L(0); G8_MMA(0, 0, At, B0); G8_BAR; G8_SCHED;
            G8_LDB(B1, 0, 1); G8_STAGE_B(G8_SB(0, 0), b2, k2);
            G8_BAR; G8_WAIT_L(0); G8_MMA(0, 1, At, B1); G8_BAR;
            G8_LDA(At, 0, 1); G8_STAGE_A(G8_SA(0, 0), cA[0], k2);
            G8_BAR; G8_WAIT_L(0); G8_MMA(1, 0, At, B0); G8_BAR; G8_SCHED;
            G8_STAGE_B(G8_SB(0, 1), b2 + hstepB, k2);
            G8_WAIT_V(6); G8_BAR; G8_MMA(1, 1, At, B1); G8_BAR;
            G8_LDB(B0, 1, 0); G8_SCHED; G8_LDA(At, 1, 0); G8_STAGE_A(G8_SA(0, 1), cA[1], k2);
            G8_WAIT_L(8); G8_BAR; G8_WAIT_L(0); G8_MMA(0, 0, At, B0); G8_BAR; G8_SCHED;
            G8_LDB(B1, 1, 1); G8_STAGE_B(G8_SB(1, 0), b2, k3);
            G8_BAR; G8_WAIT_L(0); G8_MMA(0, 1, At, B1); G8_BAR;
            G8_LDA(At, 1, 1); G8_STAGE_A(G8_SA(1, 0), cA[0], k3);
            G8_BAR; G8_WAIT_L(0); G8_MMA(1, 0, At, B0); G8_BAR; G8_SCHED;
            G8_STAGE_B(G8_SB(1, 1), b2 + hstepB, k3);
            G8_WAIT_V(6); G8_BAR; G8_MMA(1, 1, At, B1); G8_BAR;
        }
        if constexpr (FP8) asm volatile("s_nop 15\n\ts_nop 15" ::: "memory");
        E(acc, cur, wr, wc, fr, fq);
        if (!has_next) break;
#pragma unroll
        for (int a = 0; a < 2; ++a)
#pragma unroll
            for (int b = 0; b < 2; ++b)
#pragma unroll
                for (int m = 0; m < 4; ++m)
#pragma unroll
                    for (int n = 0; n < 2; ++n) acc[a][b][m][n] = (f32x4){0.f, 0.f, 0.f, 0.f};
        cur = nxt; cB = nB; ++ui;
    }
    G8_WAIT_V(0);
    if (wr == 0) G8_BAR;
    G8_BAR;
#undef G8_SA
#undef G8_SB
#undef G8_STAGE_A
#undef G8_STAGE_B
#undef G8_LDA
#undef G8_LDB
#undef G8_MMA
#undef G8_WAIT_V
#undef G8_WAIT_L
#undef G8_BAR
#undef G8_SCHED
}
}
using g8::UnitD;
typedef f32x4 Acc[2][2][4][2];

struct EpiIn {
    static constexpr bool PERM = true;
    u16* H; const float* rs1; float* SSQ; float* WI;
    template <int ACT, bool DOSSQ> DI void run(const Acc& acc, const UnitD& u, int wr, int wc, int fr, int fq) const {
        const int pn = u.pn;
#pragma unroll
        for (int ai = 0; ai < 2; ++ai)
#pragma unroll
            for (int m = 0; m < 4; ++m) {
                const int row = u.pm * 256 + ai * 128 + wr * 64 + m * 16 + fr;
#pragma unroll
                for (int bj = 0; bj < 2; ++bj) {
                    f32x4 v0 = acc[ai][bj][m][0], v1 = acc[ai][bj][m][1];
                    if (ACT == 1) {
#pragma unroll
                        for (int j = 0; j < 4; ++j) { v0[j] = fast_gelu(v0[j]); v1[j] = fast_gelu(v1[j]); }
                    } else if (ACT == 2) {
#pragma unroll
                        for (int j = 0; j < 4; ++j) { v0[j] = fast_sigmoid(v0[j]); v1[j] = fast_sigmoid(v1[j]); }
                    }
                    u32x4 w; w.x = pk2(v0[0], v0[1]); w.y = pk2(v0[2], v0[3]); w.z = pk2(v1[0], v1[1]); w.w = pk2(v1[2], v1[3]);
                    *(u32x4*)(H + (size_t)row * NIN + pn * 256 + bj * 128 + wc * 32 + 8 * fq) = w;
                    if (DOSSQ) {
                        float ssq = ((v0[0] * v0[0] + v0[1] * v0[1]) + (v0[2] * v0[2] + v0[3] * v0[3])) + ((v1[0] * v1[0] + v1[1] * v1[1]) + (v1[2] * v1[2] + v1[3] * v1[3]));
                        ssq += __shfl_xor(ssq, 16); ssq += __shfl_xor(ssq, 32);
                        if (fq == 0) SSQ[(size_t)row * 32 + (pn - 2) * 8 + bj * 4 + wc] = ssq;
                        if (pn == 5 && bj == 1 && wc == 2 && fq == 0) *(f32x4*)(WI + (size_t)row * 4) = v0 * 0.5f;
                    }
                }
            }
    }
    DI void operator()(const Acc& acc, const UnitD& u, int wr, int wc, int fr, int fq) const {
        const int pn = u.pn;
        if (pn < 2) run<1, false>(acc, u, wr, wc, fr, fq);
        else if (pn < 4) run<1, true>(acc, u, wr, wc, fr, fq);
        else if (pn < 6) run<0, true>(acc, u, wr, wc, fr, fq);
        else run<2, false>(acc, u, wr, wc, fr, fq);
    }
};
struct EpiQ {
    static constexpr bool PERM = true;
    u16* Q; u16* QI; const float* SSQ;
    DI void operator()(const Acc& acc, const UnitD& u, int wr, int wc, int fr, int fq) const {
        f32x4 sq[2][4][2];
#pragma unroll
        for (int ai = 0; ai < 2; ++ai)
#pragma unroll
            for (int m = 0; m < 4; ++m) { const int row = u.pm * 256 + ai * 128 + wr * 64 + m * 16 + fr; sq[ai][m][0] = *(const f32x4*)(SSQ + (size_t)row * 32 + 16); sq[ai][m][1] = *(const f32x4*)(SSQ + (size_t)row * 32 + 20); }
        __builtin_amdgcn_sched_barrier(0);
#pragma unroll
        for (int ai = 0; ai < 2; ++ai)
#pragma unroll
            for (int m = 0; m < 4; ++m) {
                const int row = u.pm * 256 + ai * 128 + wr * 64 + m * 16 + fr;
                const f32x4 s0 = sq[ai][m][0], s1 = sq[ai][m][1];
                const float ss = ((s0[0] + s0[1]) + (s0[2] + s0[3])) + ((s1[0] + s1[1]) + (s1[2] + s1[3]));
                const float rs = __builtin_amdgcn_rsqf(ss * (1.0f / 256.0f) + EPS);
#pragma unroll
                for (int bj = 0; bj < 2; ++bj) {
                    const int col = u.pn * 256 + bj * 128 + wc * 32 + 8 * fq;
                    const f32x4 v0 = acc[ai][bj][m][0] * rs, v1 = acc[ai][bj][m][1] * rs;
                    if (col < 1024) { u32x4 w; w.x = pk2(v0[0], v0[1]); w.y = pk2(v0[2], v0[3]); w.z = pk2(v1[0], v1[1]); w.w = pk2(v1[2], v1[3]); *(u32x4*)(Q + (size_t)row * 1024 + col) = w; }
                    else { u32x2 w; w.x = pk4_i8(v0[0], v0[1], v0[2], v0[3]); w.y = pk4_i8(v1[0], v1[1], v1[2], v1[3]); *(u32x2*)((unsigned char*)QI + (size_t)row * 256 + (col - 1024)) = w; }
                }
            }
    }
};
template <int SECOND> struct EpiMrg {
    static constexpr bool PERM = true;
    u16* OUT; const u16* TMP; const u16* H;
    DI void operator()(const Acc& acc, const UnitD& u, int wr, int wc, int fr, int fq) const {
#pragma unroll
        for (int ai = 0; ai < 2; ++ai) {
            u32x4 g[4][2], tp[4][2];
#pragma unroll
            for (int m = 0; m < 4; ++m)
#pragma unroll
                for (int bj = 0; bj < 2; ++bj) {
                    const int row = u.pm * 256 + ai * 128 + wr * 64 + m * 16 + fr, col = u.pn * 256 + bj * 128 + wc * 32 + 8 * fq;
                    g[m][bj] = *(const u32x4*)(H + (size_t)row * NIN + 1536 + SECOND * 1024 + col);
                    if (SECOND) tp[m][bj] = *(const u32x4*)(TMP + (size_t)row * 1024 + col);
                }
            __builtin_amdgcn_sched_barrier(0);
#pragma unroll
            for (int m = 0; m < 4; ++m)
#pragma unroll
                for (int bj = 0; bj < 2; ++bj) {
                    const int row = u.pm * 256 + ai * 128 + wr * 64 + m * 16 + fr, col = u.pn * 256 + bj * 128 + wc * 32 + 8 * fq;
                    const u32x4 gg = g[m][bj];
                    f32x4 v0 = acc[ai][bj][m][0], v1 = acc[ai][bj][m][1];
                    v0[0] *= bflo(gg.x); v0[1] *= bfhi(gg.x); v0[2] *= bflo(gg.y); v0[3] *= bfhi(gg.y); v1[0] *= bflo(gg.z); v1[1] *= bfhi(gg.z); v1[2] *= bflo(gg.w); v1[3] *= bfhi(gg.w);
                    if (SECOND) { const u32x4 t = tp[m][bj];
                        v0[0] += bflo(t.x); v0[1] += bfhi(t.x); v0[2] += bflo(t.y); v0[3] += bfhi(t.y); v1[0] += bflo(t.z); v1[1] += bfhi(t.z); v1[2] += bflo(t.w); v1[3] += bfhi(t.w); }
                    u32x4 w; w.x = pk2(v0[0], v0[1]); w.y = pk2(v0[2], v0[3]); w.z = pk2(v1[0], v1[1]); w.w = pk2(v1[2], v1[3]);
                    *(u32x4*)(OUT + (size_t)row * 1024 + col) = w;
                }
            __builtin_amdgcn_sched_barrier(0);
        }
    }
};
struct EpiOut {
    static constexpr bool PERM = false;
    float* out; const float* x;
    DI void operator()(const Acc& acc, const UnitD& u, int wr, int wc, int fr, int fq) const {
#pragma unroll
        for (int ai = 0; ai < 2; ++ai) {
            f32x4 xv[4][2][2];
#pragma unroll
            for (int m = 0; m < 4; ++m)
#pragma unroll
                for (int bj = 0; bj < 2; ++bj)
#pragma unroll
                    for (int n = 0; n < 2; ++n)
                        xv[m][bj][n] = *(const f32x4*)(x + (size_t)(u.pm * 256 + ai * 128 + wr * 64 + m * 16 + fr) * 1024 + u.pn * 256 + bj * 128 + wc * 32 + n * 16 + 4 * fq);
            __builtin_amdgcn_sched_barrier(0);
#pragma unroll
            for (int m = 0; m < 4; ++m)
#pragma unroll
                for (int bj = 0; bj < 2; ++bj)
#pragma unroll
                    for (int n = 0; n < 2; ++n)
                        *(f32x4*)(out + (size_t)(u.pm * 256 + ai * 128 + wr * 64 + m * 16 + fr) * 1024 + u.pn * 256 + bj * 128 + wc * 32 + n * 16 + 4 * fq) = xv[m][bj][n] + acc[ai][bj][m][n];
            __builtin_amdgcn_sched_barrier(0);
        }
    }
};

constexpr int MOE_TAB = g8::STAGE_BYTES;
DI void moe_table(LAS unsigned char* lds, const unsigned* CNT) {
    LAS int* tab = (LAS int*)(lds + MOE_TAB);
    __syncthreads();
    if (threadIdx.x == 0) { int acc = 0; for (int e = 0; e < NE; ++e) { const int c = (int)__hip_atomic_load(CNT + e, __ATOMIC_RELAXED, __HIP_MEMORY_SCOPE_AGENT); tab[e] = acc; tab[33 + e] = c; acc += (c + 255) >> 8; } tab[32] = acc; }
    __syncthreads();
}
template <int NPN, bool GATHER> struct MoeSched {
    const char* Abase; const char* Wbase; const int* LTOK; LAS const int* tab; int lda, ldb, K, G, c; size_t wstride; static constexpr int esz = 1;
    DI bool next(int i, UnitD& u) const {
        const long L = (long)i * G + c; const int R = tab[32];
        if (L >= (long)R * NPN) return false;
        const int rbg = (int)(L / NPN), pn = (int)(L % NPN);
        int e = 0;
        for (int j = 1; j < NE; ++j) e += (tab[j] <= rbg) ? 1 : 0;
        e = __builtin_amdgcn_readfirstlane(e);
        u.pm = rbg; u.pn = pn; u.e = e; u.rb = rbg - tab[e];
        u.Bp = Wbase + (size_t)e * wstride + (size_t)pn * 256 * ldb * esz;
        return true;
    }
    DI void a_offs(const UnitD& u, int R0, int C0, unsigned (&o)[2][2]) const {
        const int cnt = tab[33 + u.e];
#pragma unroll
        for (int h = 0; h < 2; ++h)
#pragma unroll
            for (int i = 0; i < 2; ++i) {
                const int r = h * 128 + R0 + 64 * i;
                if (GATHER) { const int slot = u.rb * 256 + r; const int tok = slot < cnt ? LTOK[(size_t)u.e * ECAP + slot] : 0; o[h][i] = (unsigned)((size_t)tok * lda * esz + C0 * 2); }
                else o[h][i] = (unsigned)((size_t)(u.pm * 256 + r) * lda * esz + C0 * 2);
            }
    }
};
struct EpiMoe1 {
    static constexpr bool PERM = true;
    unsigned char* ACT; const float* b1;
    DI void operator()(const Acc& acc, const UnitD& u, int wr, int wc, int fr, int fq) const {
        const float* be = b1 + (size_t)u.e * 2048;
        const int hc = u.pn * 128 + wc * 32 + 8 * fq;
        const f32x4 bg0 = *(const f32x4*)(be + hc), bg1 = *(const f32x4*)(be + hc + 4), bu0 = *(const f32x4*)(be + 1024 + hc), bu1 = *(const f32x4*)(be + 1024 + hc + 4);
        __builtin_amdgcn_sched_barrier(0);
#pragma unroll
        for (int ai = 0; ai < 2; ++ai)
#pragma unroll
            for (int m = 0; m < 4; ++m) {
                const int row = u.pm * 256 + ai * 128 + wr * 64 + m * 16 + fr;
                float av[8];
#pragma unroll
                for (int n = 0; n < 2; ++n) {
                    const f32x4 g = acc[ai][0][m][n] * 0.015625f + (n ? bg1 : bg0), up = acc[ai][1][m][n] * 0.015625f + (n ? bu1 : bu0);
#pragma unroll
                    for (int j = 0; j < 4; ++j) {
                        const float hg = fminf(g[j], 7.0f), hu = __builtin_amdgcn_fmed3f(up[j], -7.0f, 7.0f);
                        av[4 * n + j] = (hu + 1.0f) * (hg * __builtin_amdgcn_rcpf(1.0f + __builtin_amdgcn_exp2f(hg * -2.4554669595930157f)));
                    }
                }
                u32x2 w; w.x = pk4_fp8(av[0], av[1], av[2], av[3]); w.y = pk4_fp8(av[4], av[5], av[6], av[7]);
                *(u32x2*)(ACT + (size_t)row * 1024 + hc) = w;
            }
    }
};
struct EpiMoe2 {
    static constexpr bool PERM = true;
    u16* YB; const float* b2;
    DI void operator()(const Acc& acc, const UnitD& u, int wr, int wc, int fr, int fq) const {
        const float* be = b2 + (size_t)u.e * 1024;
        f32x4 bias[2][2];
#pragma unroll
        for (int bj = 0; bj < 2; ++bj) { const int col = u.pn * 256 + bj * 128 + wc * 32 + 8 * fq; bias[bj][0] = *(const f32x4*)(be + col); bias[bj][1] = *(const f32x4*)(be + col + 4); }
        __builtin_amdgcn_sched_barrier(0);
#pragma unroll
        for (int ai = 0; ai < 2; ++ai)
#pragma unroll
            for (int m = 0; m < 4; ++m) {
                const int r = ai * 128 + wr * 64 + m * 16 + fr;
#pragma unroll
                for (int bj = 0; bj < 2; ++bj) {
                    const int col = u.pn * 256 + bj * 128 + wc * 32 + 8 * fq;
                    const f32x4 v0 = acc[ai][bj][m][0] * 0.015625f + bias[bj][0], v1 = acc[ai][bj][m][1] * 0.015625f + bias[bj][1];
                    u32x4 w; w.x = pk2(v0[0], v0[1]); w.y = pk2(v0[2], v0[3]); w.z = pk2(v1[0], v1[1]); w.w = pk2(v1[2], v1[3]);
                    *(u32x4*)(YB + (size_t)(u.pm * 256 + r) * 1024 + col) = w;
                }
            }
    }
};

template <bool FP8 = false, class F> DI void tr_tile(LAS unsigned char* lds, const float* src, int ld_src, int Nsz, int k0, int n0, const float* sk, float mul, u16* dst, int ld_dst, F rowmap) {
    LAS float* t = (LAS float*)lds;
    const int tid = otid();
    __syncthreads();
#pragma unroll
    for (int it = 0; it < 2; ++it) {
        const int k = (tid >> 4) + 32 * it, n = 4 * (tid & 15);
        f32x4 v = {0.f, 0.f, 0.f, 0.f};
        if (n0 + n < Nsz) v = *(const f32x4*)(src + (size_t)(k0 + k) * ld_src + n0 + n);
        const float s = (sk ? sk[k0 + k] : 1.0f) * mul;
        t[k * 65 + n] = v[0] * s; t[k * 65 + n + 1] = v[1] * s; t[k * 65 + n + 2] = v[2] * s; t[k * 65 + n + 3] = v[3] * s;
    }
    __syncthreads();
    const int n = tid >> 3, kc = (tid & 7) * 8;
    if (FP8) {
        if (n0 + n < Nsz) {
            u32x2 w;
            w.x = pk4_fp8(t[(kc + 0) * 65 + n], t[(kc + 1) * 65 + n], t[(kc + 2) * 65 + n], t[(kc + 3) * 65 + n]);
            w.y = pk4_fp8(t[(kc + 4) * 65 + n], t[(kc + 5) * 65 + n], t[(kc + 6) * 65 + n], t[(kc + 7) * 65 + n]);
            *(u32x2*)((unsigned char*)dst + (size_t)rowmap(n0 + n) * ld_dst + k0 + kc) = w;
        }
    } else if (n0 + n < Nsz) {
        u32x4 w;
        w.x = pk2(t[(kc + 0) * 65 + n], t[(kc + 1) * 65 + n]); w.y = pk2(t[(kc + 2) * 65 + n], t[(kc + 3) * 65 + n]);
        w.z = pk2(t[(kc + 4) * 65 + n], t[(kc + 5) * 65 + n]); w.w = pk2(t[(kc + 6) * 65 + n], t[(kc + 7) * 65 + n]);
        *(u32x4*)(dst + (size_t)rowmap(n0 + n) * ld_dst + k0 + kc) = w;
    }
}
struct MapId { DI int operator()(int n) const { return n; } };
struct MapIn { DI int operator()(int n) const { return n < 1476 ? n : n + 60; } };
struct MapE1 { DI int operator()(int n) const { const int hi = n >= 1024 ? 1 : 0, q = n - hi * 1024; return (q >> 7) * 256 + hi * 128 + (q & 127); } };

DI void phase0(const Args& a, LAS unsigned char* lds) {
    unsigned char* ws = a.ws;
    const int tid = otid();
    const size_t gtid = (size_t)blockIdx.x * NT + tid, gstride = (size_t)gridDim.x * NT;
    for (size_t i = gtid; i < 60 * 1024 / 2; i += gstride) ((unsigned*)(ws + WS_WIN + (size_t)1476 * 1024 * 2))[i] = 0u;
    for (size_t i = gtid; i < 32 * 1024; i += gstride) { const int e = (int)(i >> 10), k = (int)(i & 1023); const float w = a.in[I_WR][k * 32 + e] * a.in[I_N2G][k]; const u16 h = f2bf(w); ((u16*)(ws + WS_WR))[i] = h; ((u16*)(ws + WS_WR))[32 * 1024 + i] = f2bf(w - bf2f(h)); }
    for (size_t i = gtid; i < 4 * 128 * 128; i += gstride) { const int tt = (int)((i >> 7) & 127), ss = (int)(i & 127); ((u16*)(ws + WS_WSP))[i] = f2bf(ss <= tt ? a.in[I_WSP][i] : 0.f); }
    {
        const int wid = tid >> 6, lane = tid & 63;
        for (int row = blockIdx.x * 8 + wid; row < T; row += gridDim.x * 8) {
            const float* xr = a.in[I_X] + (size_t)row * 1024; u16* xb = (u16*)(ws + WS_XB) + (size_t)row * 1024;
            float ss = 0.f; f32x4 xv[4];
#pragma unroll
            for (int i = 0; i < 4; ++i) {
                xv[i] = __builtin_nontemporal_load((const f32x4*)(xr + i * 256 + lane * 4));
                ss += (xv[i][0] * xv[i][0] + xv[i][1] * xv[i][1]) + (xv[i][2] * xv[i][2] + xv[i][3] * xv[i][3]);
            }
#pragma unroll
            for (int o = 32; o >= 1; o >>= 1) ss += __shfl_xor(ss, o);
            const float rs = __builtin_amdgcn_rsqf(ss * (1.0f / 1024.0f) + EPS);
#pragma unroll
            for (int i = 0; i < 4; ++i) { u32x2 w; w.x = pk2(xv[i][0] * rs, xv[i][1] * rs); w.y = pk2(xv[i][2] * rs, xv[i][3] * rs); *(u32x2*)(xb + i * 256 + lane * 4) = w; }
        }
    }
    constexpr int U_IN = 16 * 56, U_UQ = 4 * 16, U_QI = 4 * 4, U_PA = 8 * 16, U_OUT = 16 * 16, U_CB = 64;
    constexpr int U_TOT = U_IN + U_UQ + U_QI + U_PA + U_OUT + U_CB;
    for (int u = blockIdx.x; u < U_TOT; u += gridDim.x) {
        int v = u;
        if (v < U_IN) { tr_tile(lds, a.in[I_WIN], 3524, 3524, (v & 15) * 64, (v >> 4) * 64, a.in[I_N1G], 1.0f, (u16*)(ws + WS_WIN), 1024, MapIn()); continue; }
        v -= U_IN;
        if (v < U_UQ) { tr_tile(lds, a.in[I_WUQ], 1024, 1024, (v & 3) * 64, (v >> 2) * 64, a.in[I_QLG], 1.0f, (u16*)(ws + WS_WQ), 256, MapId()); continue; }
        v -= U_UQ;
        if (v < U_QI) { tr_tile(lds, a.in[I_WQI], 256, 256, (v & 3) * 64, (v >> 2) * 64, a.in[I_QLG], 1.0f, (u16*)(ws + WS_WQ) + 1024 * 256, 256, MapId()); continue; }
        v -= U_QI;
        if (v < U_PA) { tr_tile(lds, a.in[I_WPA], 1024, 1024, (v & 7) * 64, (v >> 3) * 64, nullptr, 1.0f, (u16*)(ws + WS_WCAT), 1536, MapId()); continue; }
        v -= U_PA;
        if (v < U_OUT) { tr_tile(lds, a.in[I_WOUT], 1024, 1024, (v & 15) * 64, (v >> 4) * 64, nullptr, 1.0f, (u16*)(ws + WS_WOUT), 1024, MapId()); continue; }
        v -= U_OUT;
        {
            const int h = v >> 3, c0 = (v & 7) * 16;
            LAS float* t = (LAS float*)lds;
            __syncthreads();
            for (int i = tid; i < 1024; i += NT) t[i] = a.in[I_WUV][(size_t)h * 128 * 64 + (size_t)c0 * 64 + i];
            __syncthreads();
            for (int nn = tid; nn < 1024; nn += NT) {
                float accv[16];
#pragma unroll
                for (int i = 0; i < 16; ++i) accv[i] = 0.f;
                for (int vv = 0; vv < 64; ++vv) {
                    const float pb = a.in[I_WPB][(size_t)(h * 64 + vv) * 1024 + nn];
#pragma unroll
                    for (int i = 0; i < 16; ++i) accv[i] += t[i * 64 + vv] * pb;
                }
                u32x4 w0, w1;
                w0.x = pk2(accv[0], accv[1]); w0.y = pk2(accv[2], accv[3]); w0.z = pk2(accv[4], accv[5]); w0.w = pk2(accv[6], accv[7]);
                w1.x = pk2(accv[8], accv[9]); w1.y = pk2(accv[10], accv[11]); w1.z = pk2(accv[12], accv[13]); w1.w = pk2(accv[14], accv[15]);
                u16* d = (u16*)(ws + WS_WCAT) + (size_t)nn * 1536 + 512 + h * 128 + c0;
                *(u32x4*)d = w0; *(u32x4*)(d + 8) = w1;
            }
        }
    }
}

DI void gmlp_unit(const Args& a, LAS unsigned char* lds, int u) {
    unsigned char* ws = a.ws;
    const int tid = otid(), wid = tid >> 6, lane = tid & 63, fr = lane & 15, fq = lane >> 4;
    const int g = u & 3, row0 = (u >> 2) * 128;
    const u16* H = (const u16*)(ws + WS_H);
    LAS u16* img = (LAS u16*)lds;
    __syncthreads();
    {
        const int s = tid & 127, cset = tid >> 7;
        const f32x4 sq = *(const f32x4*)((const float*)(ws + WS_SSQ) + (size_t)(row0 + s) * 32 + g * 4);
        const float rs = __builtin_amdgcn_rsqf(((sq[0] + sq[1]) + (sq[2] + sq[3])) * (1.0f / 128.0f) + EPS);
#pragma unroll
        for (int it = 0; it < 4; ++it) {
            const int c = cset + 4 * it;
            const u32x4 raw = *(const u32x4*)(H + (size_t)(row0 + s) * NIN + 512 + g * 128 + 8 * c);
            const float* vg = a.in[I_VG] + 8 * c;
            float f[8] = {bflo(raw.x), bfhi(raw.x), bflo(raw.y), bfhi(raw.y), bflo(raw.z), bfhi(raw.z), bflo(raw.w), bfhi(raw.w)};
#pragma unroll
            for (int i = 0; i < 8; ++i) img[(8 * c + i) * 136 + s] = f2bf(f[i] * rs * vg[i]);
        }
    }
    __syncthreads();
    const u16* W = (const u16*)(ws + WS_WSP) + (size_t)g * 128 * 128 + (size_t)(16 * wid + fr) * 128;
    f32x4 acc[8];
#pragma unroll
    for (int i = 0; i < 8; ++i) acc[i] = (f32x4){0.f, 0.f, 0.f, 0.f};
    const int nks = (16 * wid + 15) / 32 + 1;
    for (int ks = 0; ks < nks; ++ks) {
        const bf16x8 bw = *(const bf16x8*)(W + ks * 32 + 8 * fq);
#pragma unroll
        for (int i = 0; i < 8; ++i) {
            const bf16x8 av = *(const LAS bf16x8*)(img + (16 * i + fr) * 136 + ks * 32 + 8 * fq);
            acc[i] = __builtin_amdgcn_mfma_f32_16x16x32_bf16(av, bw, acc[i], 0, 0, 0);
        }
    }
    const int t = 16 * wid + fr;
    const float bias = a.in[I_BSP][g * 128 + t];
    u16* YO = (u16*)(ws + WS_YO);
#pragma unroll
    for (int i = 0; i < 8; ++i) {
        const int d = 16 * i + 4 * fq;
        const u32x2 uu = *(const u32x2*)(H + (size_t)(row0 + t) * NIN + g * 128 + d);
        const float y0 = bflo(uu.x) * (acc[i][0] + bias), y1 = bfhi(uu.x) * (acc[i][1] + bias), y2 = bflo(uu.y) * (acc[i][2] + bias), y3 = bfhi(uu.y) * (acc[i][3] + bias);
        u32x2 w; w.x = pk2(y0, y1); w.y = pk2(y2, y3);
        *(u32x2*)(YO + (size_t)(row0 + t) * 1536 + g * 128 + d) = w;
    }
}

DI void kvnorm(const Args& a) {
    unsigned char* ws = a.ws;
    const u16* H = (const u16*)(ws + WS_H); const float* SSQ = (const float*)(ws + WS_SSQ);
    const size_t gtid = (size_t)blockIdx.x * NT + otid(), gstride = (size_t)gridDim.x * NT;
    for (size_t idx = gtid; idx < (size_t)T * 24; idx += gstride) {
        const int row = (int)(idx / 24), c = (int)(idx % 24);
        const u16* src; u16* dst; const float* gain; float rs;
        if (c < 16) {
            const f32x4 sq = *(const f32x4*)(SSQ + (size_t)row * 32 + 24);
            rs = __builtin_amdgcn_rsqf(((sq[0] + sq[1]) + (sq[2] + sq[3])) * (1.0f / 128.0f) + EPS);
            src = H + (size_t)row * NIN + 1280 + 8 * c; dst = (u16*)(ws + WS_KVN) + (size_t)row * 128 + 8 * c; gain = a.in[I_KVG] + 8 * c;
        } else {
            const int cc = c - 16;
            rs = __builtin_amdgcn_rsqf((SSQ[(size_t)row * 32 + 28] + SSQ[(size_t)row * 32 + 29]) * (1.0f / 64.0f) + EPS);
            src = H + (size_t)row * NIN + 1408 + 8 * cc; dst = nullptr; gain = a.in[I_KIG] + 8 * cc;
            const u32x4 raw = *(const u32x4*)src;
            u32x2 w8;
            w8.x = pk4_i8(bflo(raw.x) * rs * gain[0], bfhi(raw.x) * rs * gain[1], bflo(raw.y) * rs * gain[2], bfhi(raw.y) * rs * gain[3]);
            w8.y = pk4_i8(bflo(raw.z) * rs * gain[4], bfhi(raw.z) * rs * gain[5], bflo(raw.w) * rs * gain[6], bfhi(raw.w) * rs * gain[7]);
            *(u32x2*)(ws + WS_KIN + (size_t)row * 64 + 8 * cc) = w8;
            continue;
        }
        const u32x4 raw = *(const u32x4*)src;
        u32x4 w;
        w.x = pk2(bflo(raw.x) * rs * gain[0], bfhi(raw.x) * rs * gain[1]); w.y = pk2(bflo(raw.y) * rs * gain[2], bfhi(raw.y) * rs * gain[3]);
        w.z = pk2(bflo(raw.z) * rs * gain[4], bfhi(raw.z) * rs * gain[5]); w.w = pk2(bflo(raw.w) * rs * gain[6], bfhi(raw.w) * rs * gain[7]);
        *(u32x4*)dst = w;
    }
}

constexpr int P3_ROWS = 0, P3_HIST = 131072, P3_LIST = 147456;
DI unsigned bf2keys(unsigned b) {
    unsigned m; asm("v_pk_ashrrev_i16 %0, %1, %2" : "=v"(m) : "v"(0x000f000fu), "v"(b));
    return b ^ (m | 0x80008000u);
}
DI unsigned f2key(float f) { const unsigned u = __float_as_uint(f); return (u & 0x80000000u) ? ~u : (u | 0x80000000u); }
DI int wave_incl_scan(int v, int lane) {
#pragma unroll
    for (int o = 1; o < 64; o <<= 1) { const int t = __shfl_up(v, o); if (lane >= o) v += t; }
    return v;
}
DI int wave_suffix_scan(int v, int lane) {
#pragma unroll
    for (int o = 1; o < 64; o <<= 1) { const int t = __shfl_down(v, o); if (lane + o < 64) v += t; }
    return v;
}
DI unsigned pk_gt(unsigned kw, unsigned xw, unsigned one) {
    unsigned d, m;
    asm("v_pk_sub_u16 %0, %1, %2 clamp" : "=v"(d) : "v"(kw), "v"(xw));
    asm("v_pk_min_u16 %0, %1, %2" : "=v"(m) : "v"(d), "v"(one));
    return m;
}
DI unsigned pk_subs(unsigned kw, unsigned xw) { unsigned d; asm("v_pk_sub_u16 %0, %1, %2 clamp" : "=v"(d) : "v"(kw), "v"(xw)); return d; }
DI unsigned pk_min1(unsigned d, unsigned one) { unsigned m; asm("v_pk_min_u16 %0, %1, %2" : "=v"(m) : "v"(d), "v"(one)); return m; }
DI unsigned pk_max(unsigned a, unsigned b) { unsigned r; asm("v_pk_max_u16 %0, %1, %2" : "=v"(r) : "v"(a), "v"(b)); return r; }
DI unsigned pk_add(unsigned a, unsigned b) { unsigned r; asm("v_pk_add_u16 %0, %1, %2" : "=v"(r) : "v"(a), "v"(b)); return r; }
DI int wave_sum(int v) {
    v += __builtin_amdgcn_update_dpp(0, v, 0xB1, 0xf, 0xf, false);
    v += __builtin_amdgcn_update_dpp(0, v, 0x4E, 0xf, 0xf, false);
    v += __builtin_amdgcn_update_dpp(0, v, 0x141, 0xf, 0xf, false);
    v += __builtin_amdgcn_update_dpp(0, v, 0x140, 0xf, 0xf, false);
    return __builtin_amdgcn_readlane(v, 0) + __builtin_amdgcn_readlane(v, 16) + __builtin_amdgcn_readlane(v, 32) + __builtin_amdgcn_readlane(v, 48);
}
DI int rowaddr(int p) { return (p & ~511) | ((p & 63) << 3) | ((p >> 6) & 7); }
typedef unsigned short us2_t __attribute__((ext_vector_type(2)));
DI unsigned dot2acc(unsigned flags, unsigned wts, unsigned acc) { return __builtin_amdgcn_udot2(__builtin_bit_cast(us2_t, flags), __builtin_bit_cast(us2_t, wts), acc, false); }
DI void keys_load(LAS u16* row, int N, int lane, u32x4 (&kr)[16]) {
    const int Nup = (N + 511) & ~511, niter = Nup >> 9;
    for (int p = N + lane; p < Nup; p += 64) row[rowaddr(p)] = (u16)0;
    wave_lds_sync();
#pragma unroll
    for (int i = 0; i < 16; ++i) { kr[i] = (u32x4){0u, 0u, 0u, 0u}; if (i < niter) kr[i] = *(LAS const u32x4*)(row + i * 512 + lane * 8); }
    wave_lds_sync();
}
DI void keys_select(const u32x4 (&kr)[16], LAS u16* list, int N, int lane) {
    const int Nup = (N + 511) & ~511, niter = Nup >> 9;
    const unsigned one = 0x00010001u;
    auto count_gt = [&](unsigned x) -> int {
        const unsigned xw = x | (x << 16);
        unsigned acc = 0u, acc1 = 0u, acc2 = 0u, acc3 = 0u;
#pragma unroll
        for (int c = 0; c < 4; ++c) {
            if (4 * c < niter) {
#pragma unroll
                for (int h = 0; h < 2; ++h) {
                    unsigned d[8];
#pragma unroll
                    for (int i = 0; i < 2; ++i) { const u32x4 kk = kr[4 * c + 2 * h + i]; d[4 * i] = pk_subs(kk.x, xw); d[4 * i + 1] = pk_subs(kk.y, xw); d[4 * i + 2] = pk_subs(kk.z, xw); d[4 * i + 3] = pk_subs(kk.w, xw); }
#pragma unroll
                    for (int i = 0; i < 8; ++i) d[i] = pk_min1(d[i], one);
#pragma unroll
                    for (int i = 0; i < 8; i += 4) { acc = dot2acc(d[i], one, acc); acc1 = dot2acc(d[i + 1], one, acc1); acc2 = dot2acc(d[i + 2], one, acc2); acc3 = dot2acc(d[i + 3], one, acc3); }
                }
            }
        }
        return wave_sum((int)((acc + acc1) + (acc2 + acc3)));
    };
    unsigned T = 0u; int cge = Nup, topbit = 15;
    {
        unsigned mx = 0u;
#pragma unroll
        for (int c = 0; c < 4; ++c) {
            if (4 * c < niter) {
#pragma unroll
                for (int i = 4 * c; i < 4 * c + 4; ++i) { mx = pk_max(mx, kr[i].x); mx = pk_max(mx, kr[i].y); mx = pk_max(mx, kr[i].z); mx = pk_max(mx, kr[i].w); }
            }
        }
        unsigned m1 = max(mx & 0xffffu, mx >> 16);
        m1 = max(m1, (unsigned)__builtin_amdgcn_update_dpp(0, (int)m1, 0xB1, 0xf, 0xf, false)); m1 = max(m1, (unsigned)__builtin_amdgcn_update_dpp(0, (int)m1, 0x4E, 0xf, 0xf, false));
        m1 = max(m1, (unsigned)__builtin_amdgcn_update_dpp(0, (int)m1, 0x141, 0xf, 0xf, false)); m1 = max(m1, (unsigned)__builtin_amdgcn_update_dpp(0, (int)m1, 0x140, 0xf, 0xf, false));
        const unsigned kmax = max(max((unsigned)__builtin_amdgcn_readlane((int)m1, 0), (unsigned)__builtin_amdgcn_readlane((int)m1, 16)), max((unsigned)__builtin_amdgcn_readlane((int)m1, 32), (unsigned)__builtin_amdgcn_readlane((int)m1, 48)));
        if (kmax > 1024u) {
            const unsigned lo = kmax - 1023u;
            const int clo = count_gt(lo - 1u);
            if (clo >= 256) { T = lo; cge = clo; topbit = 9; }
        }
    }
#pragma unroll 1
    for (int bit = topbit; bit >= 0; --bit) {
        const unsigned cand = topbit == 15 ? (T | (1u << bit)) : (T + (1u << bit));
        if (cand > 0xffffu) continue;
        const int cnt = count_gt(cand - 1u);
        if (cnt >= 256) { T = cand; cge = cnt; }
    }
    auto build = [&](unsigned x, unsigned (&M)[4]) {
        const unsigned xw = x | (x << 16);
#pragma unroll
        for (int c = 0; c < 4; ++c) {
            M[c] = 0u;
            if (4 * c < niter) {
#pragma unroll
                for (int i = 4 * c; i < 4 * c + 4; ++i) {
                    unsigned byte = dot2acc(pk_gt(kr[i].x, xw, one), 0x00020001u, 0u);
                    byte = dot2acc(pk_gt(kr[i].y, xw, one), 0x00080004u, byte);
                    byte = dot2acc(pk_gt(kr[i].z, xw, one), 0x00200010u, byte);
                    byte = dot2acc(pk_gt(kr[i].w, xw, one), 0x00800040u, byte);
                    M[c] |= byte << (8 * (i & 3));
                }
            }
        }
    };
    unsigned M[4];
    build(T - 1u, M);
    if (cge != 256) {
        unsigned G[4]; build(T, G);
        unsigned E[4];
#pragma unroll
        for (int c = 0; c < 4; ++c) E[c] = M[c] & ~G[c];
        const int need = 256 - (cge - wave_sum((int)(__builtin_popcount(E[0]) + __builtin_popcount(E[1]) + __builtin_popcount(E[2]) + __builtin_popcount(E[3]))));
        auto below = [&](int B, int c) -> unsigned { const int nb = B - 32 * c; return nb <= 0 ? 0u : (nb >= 32 ? 0xffffffffu : ((1u << nb) - 1u)); };
        auto ties_below = [&](int B) -> int {
            return wave_sum((int)(__builtin_popcount(E[0] & below(B, 0)) + __builtin_popcount(E[1] & below(B, 1)) + __builtin_popcount(E[2] & below(B, 2)) + __builtin_popcount(E[3] & below(B, 3))));
        };
        int lo = 0, hi = 127;
#pragma unroll 1
        while (lo < hi) { const int mid = (lo + hi) >> 1; if (ties_below(mid + 1) >= need) hi = mid; else lo = mid + 1; }
        const int Bs = lo, r = need - ties_below(Bs);
        const unsigned ew = Bs < 32 ? E[0] : (Bs < 64 ? E[1] : (Bs < 96 ? E[2] : E[3]));
        const bool tb = ((ew >> (Bs & 31)) & 1u) != 0u;
        const unsigned long long em = __ballot(tb);
        const bool take_row = tb && __builtin_popcountll(em & ((1ull << lane) - 1ull)) < r;
#pragma unroll
        for (int c = 0; c < 4; ++c) {
            unsigned tk = E[c] & below(Bs, c);
            if ((Bs >> 5) == c && take_row) tk |= 1u << (Bs & 31);
            M[c] = G[c] | tk;
        }
    }
    const int kl = __builtin_popcount(M[0]) + __builtin_popcount(M[1]) + __builtin_popcount(M[2]) + __builtin_popcount(M[3]);
    int wp = wave_incl_scan(kl, lane) - kl;
#pragma unroll
    for (int c = 0; c < 4; ++c) {
        unsigned m = M[c];
        while (m) { const int b = __builtin_ctz(m); list[wp] = (u16)((32 * c + b) * 64 + lane); ++wp; m &= m - 1u; }
    }
}

DI float max2f(float a, float b) { float r; asm("v_max_f32 %0, %1, %2" : "=v"(r) : "v"(a), "v"(b)); return r; }
DI float max8_mfma(const f32x4& a, const f32x4& b) {
    float r;
    asm("s_nop 7\n\tv_max3_f32 %0, %1, %2, %3\n\tv_max3_f32 %0, %0, %4, %5\n\tv_max3_f32 %0, %0, %6, %7\n\tv_max_f32 %0, %0, %8"
        : "=&v"(r) : "v"(a[0]), "v"(a[1]), "v"(a[2]), "v"(a[3]), "v"(b[0]), "v"(b[1]), "v"(b[2]), "v"(b[3]));
    return r;
}
DI float xmax_16_32(float x) {
    const unsigned xi = __float_as_uint(x);
    const auto r = __builtin_amdgcn_permlane16_swap(xi, xi, false, false);
    const unsigned mi = __float_as_uint(max2f(__uint_as_float(r[0]), __uint_as_float(r[1])));
    const auto q = __builtin_amdgcn_permlane32_swap(mi, mi, false, false);
    return max2f(__uint_as_float(q[0]), __uint_as_float(q[1]));
}
DI void attend(const Args& a, size_t brow, int t, int cnt, LAS const u16* list, LAS unsigned char* img, int lane, int fr, int fq) {
    const u16* Q = (const u16*)(a.ws + WS_Q); const u16* KVN = (const u16*)(a.ws + WS_KVN); u16* YO = (u16*)(a.ws + WS_YO);
    const float* qgbase = a.in[I_QNG]; asm volatile("" : "+s"(qgbase));
    bf16x8 qf[4];
    {
        const int head = fr & 7;
        const u16* qrow = Q + (brow + t) * 1024 + head * 128;
        float f[4][8]; float ss = 0.f;
#pragma unroll
        for (int ks = 0; ks < 4; ++ks) {
            const u32x4 raw = *(const u32x4*)(qrow + ks * 32 + 8 * fq);
            f[ks][0] = bflo(raw.x); f[ks][1] = bfhi(raw.x); f[ks][2] = bflo(raw.y); f[ks][3] = bfhi(raw.y); f[ks][4] = bflo(raw.z); f[ks][5] = bfhi(raw.z); f[ks][6] = bflo(raw.w); f[ks][7] = bfhi(raw.w);
#pragma unroll
            for (int j = 0; j < 8; ++j) ss += f[ks][j] * f[ks][j];
        }
        ss += __shfl_xor(ss, 16); ss += __shfl_xor(ss, 32);
        const float rq = __builtin_amdgcn_rsqf(ss * (1.0f / 128.0f) + EPS) * (0.08838834764831845f * 1.4426950408889634f);
#pragma unroll
        for (int ks = 0; ks < 4; ++ks) {
            const float* qg = qgbase + ks * 32 + 8 * fq;
            u32x4 w;
            w.x = pk2(f[ks][0] * rq * qg[0], f[ks][1] * rq * qg[1]); w.y = pk2(f[ks][2] * rq * qg[2], f[ks][3] * rq * qg[3]);
            w.z = pk2(f[ks][4] * rq * qg[4], f[ks][5] * rq * qg[5]); w.w = pk2(f[ks][6] * rq * qg[6], f[ks][7] * rq * qg[7]);
            qf[ks] = __builtin_bit_cast(bf16x8, w);
        }
    }
    const int nsteps = (cnt + 31) >> 5;
    f32x4 oacc[8];
#pragma unroll
    for (int i = 0; i < 8; ++i) oacc[i] = (f32x4){0.f, 0.f, 0.f, 0.f};
    float mrun = -3.0e38f;
    f32x4 lacc = {0.f, 0.f, 0.f, 0.f};
    const bf16x8 ones = {0x3F80, 0x3F80, 0x3F80, 0x3F80, 0x3F80, 0x3F80, 0x3F80, 0x3F80};
    const char* kvb = (const char*)(KVN + brow * 128);
    auto issue = [&](u32x4 (&pf)[8], int pp) {
#pragma unroll
        for (int it = 0; it < 8; ++it) { const int piece = it * 64 + lane; const unsigned key = list[pp * 32 + (piece >> 4)]; pf[it] = *(const u32x4*)(kvb + (key * 256u + 16u * (unsigned)(piece & 15))); }
    };
    auto step = [&](u32x4 (&pf)[8], int pp) {
#pragma unroll
        for (int it = 0; it < 8; ++it) { const int piece = it * 64 + lane; *(LAS u32x4*)(img + (piece >> 4) * 288 + (piece & 15) * 16) = pf[it]; }
        if (pp + 2 < nsteps) issue(pf, pp + 2);
        wave_lds_sync();
        __builtin_amdgcn_sched_barrier(0);
        f32x4 sa = {0.f, 0.f, 0.f, 0.f}, sb = {0.f, 0.f, 0.f, 0.f};
#pragma unroll
        for (int ks = 0; ks < 4; ++ks) {
            const bf16x8 a0 = *(LAS const bf16x8*)(img + fr * 288 + (ks * 32 + 8 * fq) * 2), a1 = *(LAS const bf16x8*)(img + (16 + fr) * 288 + (ks * 32 + 8 * fq) * 2);
            sa = __builtin_amdgcn_mfma_f32_16x16x32_bf16(a0, qf[ks], sa, 0, 0, 0); sb = __builtin_amdgcn_mfma_f32_16x16x32_bf16(a1, qf[ks], sb, 0, 0, 0);
            if (ks == 1) __builtin_amdgcn_sched_barrier(0);
        }
        if (pp * 32 + 32 > cnt) {
            const int pb0 = pp * 32 + 4 * fq;
#pragma unroll
            for (int r = 0; r < 4; ++r) { if (pb0 + r >= cnt) sa[r] = -3.0e38f; if (pb0 + 16 + r >= cnt) sb[r] = -3.0e38f; }
        }
        const float mx = xmax_16_32(max8_mfma(sa, sb));
        if (__ballot(mx > mrun) != 0ull) {
            const float mnew = max2f(mrun, mx), alpha = __builtin_amdgcn_exp2f(mrun - mnew);
            mrun = mnew; lacc *= alpha;
#pragma unroll
            for (int cb = 0; cb < 8; ++cb) oacc[cb] *= alpha;
        }
#pragma unroll
        for (int r = 0; r < 4; ++r) { sa[r] = __builtin_amdgcn_exp2f(sa[r] - mrun); sb[r] = __builtin_amdgcn_exp2f(sb[r] - mrun); }
        u32x4 pw; pw.x = pk2(sa[0], sa[1]); pw.y = pk2(sa[2], sa[3]); pw.z = pk2(sb[0], sb[1]); pw.w = pk2(sb[2], sb[3]);
        const bf16x8 pb = __builtin_bit_cast(bf16x8, pw);
        lacc = __builtin_amdgcn_mfma_f32_16x16x32_bf16(ones, pb, lacc, 0, 0, 0);
#pragma unroll
        for (int cb = 0; cb < 8; ++cb) {
            const s16x4 r0 = __builtin_amdgcn_ds_read_tr16_b64_v4i16((LAS s16x4*)(img + (4 * fq + (fr >> 2)) * 288 + (cb * 16 + 4 * (fr & 3)) * 2));
            const s16x4 r1 = __builtin_amdgcn_ds_read_tr16_b64_v4i16((LAS s16x4*)(img + (16 + 4 * fq + (fr >> 2)) * 288 + (cb * 16 + 4 * (fr & 3)) * 2));
            const bf16x8 av = {r0[0], r0[1], r0[2], r0[3], r1[0], r1[1], r1[2], r1[3]};
            oacc[cb] = __builtin_amdgcn_mfma_f32_16x16x32_bf16(av, pb, oacc[cb], 0, 0, 0);
            if (cb == 3) __builtin_amdgcn_sched_barrier(0);
        }
        wave_lds_sync();
    };
    u32x4 pf0[8], pf1[8];
    issue(pf0, 0);
    if (nsteps > 1) issue(pf1, 1);
#pragma unroll 1
    for (int pp = 0; pp < nsteps; pp += 2) {
        step(pf0, pp);
        if (pp + 1 < nsteps) step(pf1, pp + 1);
    }
    const float inv = __builtin_amdgcn_rcpf(lacc[0]);
    if (fr < 8) {
        u16* orow = YO + (brow + t) * 1536 + 512 + fr * 128 + 4 * fq;
#pragma unroll
        for (int cb = 0; cb < 8; ++cb) { u32x2 w; w.x = pk2(oacc[cb][0] * inv, oacc[cb][1] * inv); w.y = pk2(oacc[cb][2] * inv, oacc[cb][3] * inv); *(u32x2*)(orow + cb * 16) = w; }
    }
}

constexpr int N_CVT_JOBS = 32 * 16 * 32 + 32 * 16 * 16;
DI void cvt_job(const Args& a, LAS float* t, int J, int lane) {
    if (J >= N_CVT_JOBS) return;
    const float* src; const float* sk; unsigned char* dst; int ld, k0, n0, row;
    if (J < 16384) {
        const int e = J >> 9, w = J & 511; src = a.in[I_WE1] + (size_t)e * 1024 * 2048; ld = 2048; k0 = (w >> 5) * 64; n0 = (w & 31) * 64; sk = a.in[I_N2G]; dst = a.ws + WS_WE1 + (size_t)e * 2048 * 1024;
        const int n = n0 + lane, hi = n >= 1024 ? 1 : 0, q = n - hi * 1024; row = (q >> 7) * 256 + hi * 128 + (q & 127);
    } else {
        const int j = J - 16384, e = j >> 8, w = j & 255; src = a.in[I_WE2] + (size_t)e * 1024 * 1024; ld = 1024; k0 = (w >> 4) * 64; n0 = (w & 15) * 64; sk = nullptr; dst = a.ws + WS_WE2 + (size_t)e * 1024 * 1024;
        row = n0 + lane;
    }
    const int kl = lane >> 4, n4 = 4 * (lane & 15);
    f32x4 v[4][4];
#pragma unroll
    for (int ks = 0; ks < 4; ++ks)
#pragma unroll
        for (int i = 0; i < 4; ++i) v[ks][i] = __builtin_nontemporal_load((const f32x4*)(src + (size_t)(k0 + ks * 16 + kl + 4 * i) * ld + n0 + n4));
    unsigned char* drow = dst + (size_t)row * 1024 + k0;
#pragma unroll
    for (int ks = 0; ks < 4; ++ks) {
#pragma unroll
        for (int i = 0; i < 4; ++i) { const float sc = (sk ? sk[k0 + ks * 16 + kl + 4 * i] : 1.0f) * 64.0f; *(LAS f32x4*)(t + (kl + 4 * i) * 64 + n4) = v[ks][i] * sc; }
        wave_lds_sync();
        float c[16];
#pragma unroll
        for (int k = 0; k < 16; ++k) c[k] = t[k * 64 + lane];
        u32x4 w; w.x = pk4_fp8(c[0], c[1], c[2], c[3]); w.y = pk4_fp8(c[4], c[5], c[6], c[7]); w.z = pk4_fp8(c[8], c[9], c[10], c[11]); w.w = pk4_fp8(c[12], c[13], c[14], c[15]);
        *(u32x4*)(drow + ks * 16) = w;
        wave_lds_sync();
    }
}

template <bool ROLE_A>
DI void dsa_loop(const Args& a, LAS unsigned char* lds, const int wid) {
    unsigned char* ws = a.ws;
    LAS u16* rows = (LAS u16*)(lds + P3_ROWS);
    bool bprev = false; size_t pbrow = 0; int pt0 = 0, bbuf = 0;
    for (int gi = blockIdx.x; gi < T / 8; gi += gridDim.x) {
        const int lane = otid() & 63, fr = lane & 15, fq = lane >> 4;
        const int b = gi & 3, t0 = S - 8 - 8 * (gi >> 2);
        const size_t brow = (size_t)b * S;
        const int ntile = (t0 + 8 + 15) >> 4;
        __syncthreads();
        {
            const unsigned char* QI = (const unsigned char*)(ws + WS_QI); const unsigned char* KIN = (const unsigned char*)(ws + WS_KIN); const float* WI = (const float*)(ws + WS_WI);
            typedef int i32x4_t __attribute__((ext_vector_type(4)));
            i32x4_t qa[2]; f32x4 wi[2];
#pragma unroll
            for (int rg = 0; rg < 2; ++rg) {
                qa[rg] = *(const i32x4_t*)(QI + (brow + t0 + 4 * rg + (fr >> 2)) * 256 + (fr & 3) * 64 + 16 * fq);
                wi[rg] = *(const f32x4*)(WI + (brow + t0 + 4 * rg + fq) * 4);
            }
            auto ldk = [&](i32x4_t (&kf)[4], int jt0) {
#pragma unroll
                for (int u = 0; u < 4; ++u) {
                    const int jt = (jt0 + 8 * u) < ntile ? (jt0 + 8 * u) : (ntile - 1);
                    kf[u] = *(const i32x4_t*)(KIN + (brow + jt * 16 + fr) * 64 + 16 * fq);
                }
            };
            auto cmpk = [&](const i32x4_t (&kf)[4], int jt0) {
#pragma unroll
                for (int u = 0; u < 4; ++u) {
                    const int jt = jt0 + 8 * u;
                    if (jt < ntile) {
                        float sc[2];
#pragma unroll
                        for (int rg = 0; rg < 2; ++rg) {
                            i32x4_t d = {0, 0, 0, 0};
                            d = __builtin_amdgcn_mfma_i32_16x16x64_i8(qa[rg], kf[u], d, 0, 0, 0);
                            sc[rg] = (((float)max(d[0], 0) * wi[rg][0] + (float)max(d[1], 0) * wi[rg][1]) + (float)max(d[2], 0) * wi[rg][2]) + (float)max(d[3], 0) * wi[rg][3];
                        }
                        const unsigned kw = bf2keys(pk2(sc[0], sc[1]));
                        const int ra = ((jt >> 5) << 9) | ((jt & 3) << 7) | ((jt >> 2) & 7);
                        LAS u16* wp = rows + (fq * 16384 + fr * 8) + ra;
                        wp[0] = (u16)kw; wp[8192] = (u16)(kw >> 16);
                    }
                }
            };
            i32x4_t kA[4], kB[4];
            if (wid < ntile) ldk(kA, wid);
            for (int jt0 = wid; jt0 < ntile; jt0 += 64) {
                const bool hasB = jt0 + 32 < ntile;
                if (hasB) ldk(kB, jt0 + 32);
                cmpk(kA, jt0);
                if (hasB) { if (jt0 + 64 < ntile) ldk(kA, jt0 + 64); cmpk(kB, jt0 + 32); }
            }
        }
        __syncthreads();
        if constexpr (ROLE_A) {
            LAS u16* l0 = (LAS u16*)(lds + (bbuf ? P3_HIST : P3_LIST) + wid * 512);
#pragma unroll 1
            for (int qh = 0; qh < 2; ++qh) {
                u32x4 kr[16];
                const int Nq = t0 + wid + 1 + 4 * qh;
                LAS u16* lq = l0 + qh * 1024;
                if (Nq > 256) keys_load(rows + wid * 16384 + qh * 8192, Nq, lane, kr);
                if (qh == 0) __syncthreads();
                if (Nq > 256) keys_select(kr, lq, Nq, lane); else { for (int p = lane; p < 256; p += 64) lq[p] = p < Nq ? (u16)p : (u16)0; }
            }
            {
                const int G3 = gridDim.x, c3 = blockIdx.x, it3 = (gi - c3) / G3, ntrip = (T / 8 - c3 + G3 - 1) / G3, jtot = (N_CVT_JOBS + 4 * G3 - 1) / (4 * G3);
                const int jlo = (jtot * it3 + ntrip - 1) / ntrip, jhi = (jtot * (it3 + 1) + ntrip - 1) / ntrip;
                LAS float* tcv = (LAS float*)(lds + (wid < 3 ? 135168 + wid * 4096 : 151552));
#pragma unroll 1
                for (int j = jlo; j < jhi; ++j) cvt_job(a, tcv, (j * 4 + wid) * G3 + c3, lane);
            }
        } else {
            __syncthreads();
            if (bprev) {
                LAS const u16* lp = (LAS const u16*)(lds + (bbuf ? P3_LIST : P3_HIST));
                LAS unsigned char* img = (LAS unsigned char*)(rows + (wid - 4) * 16384);
#pragma unroll 1
                for (int qh = 0; qh < 2; ++qh) { const int q = wid - 4 + 4 * qh, t = pt0 + q; attend(a, pbrow, t, t + 1 < 256 ? t + 1 : 256, lp + q * 256, img, lane, fr, fq); }
            }
        }
        bprev = true; pbrow = brow; pt0 = t0; bbuf ^= 1;
    }
}

DI void dsa_phase(const Args& a, LAS unsigned char* lds) {
    const int wid = __builtin_amdgcn_readfirstlane(otid() >> 6);
    if (wid < 4) dsa_loop<true>(a, lds, wid); else dsa_loop<false>(a, lds, wid);
    __syncthreads();
    {
        const int ntrip = (T / 8 - (int)blockIdx.x + (int)gridDim.x - 1) / (int)gridDim.x;
        if (ntrip > 0) {
            const int gl = blockIdx.x + (ntrip - 1) * gridDim.x, pt0 = S - 8 - 8 * (gl >> 2);
            const size_t pbrow = (size_t)(gl & 3) * S;
            const int lane = otid() & 63, fr = lane & 15, fq = lane >> 4;
            LAS u16* rows = (LAS u16*)(lds + P3_ROWS);
            LAS const u16* lp = (LAS const u16*)(lds + ((ntrip & 1) ? P3_LIST : P3_HIST));
            const int q = wid, t = pt0 + q;
            attend(a, pbrow, t, t + 1 < 256 ? t + 1 : 256, lp + q * 256, (LAS unsigned char*)(rows + wid * 8192), lane, fr, fq);
        }
    }
}

constexpr int P6_LCNT = 0, P6_BASE = 128, P6_RSB = 256, P6_RI = 1024;
DI unsigned dpp_max_u32(unsigned v) {
    v = max(v, (unsigned)__builtin_amdgcn_update_dpp(0, (int)v, 0xB1, 0xf, 0xf, false));
    v = max(v, (unsigned)__builtin_amdgcn_update_dpp(0, (int)v, 0x4E, 0xf, 0xf, false));
    v = max(v, (unsigned)__builtin_amdgcn_update_dpp(0, (int)v, 0x141, 0xf, 0xf, false));
    v = max(v, (unsigned)__builtin_amdgcn_update_dpp(0, (int)v, 0x140, 0xf, 0xf, false));
    return v;
}
DI float key2f(unsigned k) { return __uint_as_float((k & 0x80000000u) ? (k & 0x7fffffffu) : ~k); }
DI void router_phase(const Args& a, LAS unsigned char* lds) {
    unsigned char* ws = a.ws;
    const int tid = otid(), wid = tid >> 6, lane = tid & 63, fr = lane & 15, fq = lane >> 4;
    LAS int* lcnt = (LAS int*)(lds + P6_LCNT); LAS int* lbase = (LAS int*)(lds + P6_BASE); LAS float* rsb = (LAS float*)(lds + P6_RSB); LAS int* RI = (LAS int*)(lds + P6_RI);
    const u16* WRH = (const u16*)(ws + WS_WR);
    unsigned* CNT = (unsigned*)(ws + WS_CTL);
    LAS unsigned char* WL = lds + 16384;
    __syncthreads();
    for (int i = tid; i < 64 * 128; i += NT) { const int r = i >> 7, p = i & 127; *(LAS u32x4*)(WL + r * 2064 + p * 16) = *(const u32x4*)(WRH + (size_t)r * 1024 + p * 8); }
    for (int rg = blockIdx.x; rg < T / 128; rg += gridDim.x) {
        __syncthreads();
        if (tid < 32) lcnt[tid] = 0;
        __syncthreads();
        {
            const int row = rg * 128 + wid * 16 + fr;
            const float* xr = a.out + (size_t)row * 1024 + 8 * fq;
            f32x4 acc[2] = {{0.f, 0.f, 0.f, 0.f}, {0.f, 0.f, 0.f, 0.f}};
            float ss = 0.f;
#pragma unroll 4
            for (int ks = 0; ks < 32; ++ks) {
                const f32x4 x0 = *(const f32x4*)(xr + ks * 32), x1 = *(const f32x4*)(xr + ks * 32 + 4);
                ss += ((x0[0] * x0[0] + x0[1] * x0[1]) + (x0[2] * x0[2] + x0[3] * x0[3])) + ((x1[0] * x1[0] + x1[1] * x1[1]) + (x1[2] * x1[2] + x1[3] * x1[3]));
                u32x4 hw; hw.x = pk2(x0[0], x0[1]); hw.y = pk2(x0[2], x0[3]); hw.z = pk2(x1[0], x1[1]); hw.w = pk2(x1[2], x1[3]);
                u32x4 lw; lw.x = pk2(x0[0] - bflo(hw.x), x0[1] - bfhi(hw.x)); lw.y = pk2(x0[2] - bflo(hw.y), x0[3] - bfhi(hw.y)); lw.z = pk2(x1[0] - bflo(hw.z), x1[1] - bfhi(hw.z)); lw.w = pk2(x1[2] - bflo(hw.w), x1[3] - bfhi(hw.w));
                const bf16x8 xh = __builtin_bit_cast(bf16x8, hw), xl = __builtin_bit_cast(bf16x8, lw);
#pragma unroll
                for (int nt = 0; nt < 2; ++nt) {
                    const bf16x8 wh = *(LAS const bf16x8*)(WL + (nt * 16 + fr) * 2064 + (ks * 32 + 8 * fq) * 2), wl = *(LAS const bf16x8*)(WL + (32 + nt * 16 + fr) * 2064 + (ks * 32 + 8 * fq) * 2);
                    acc[nt] = __builtin_amdgcn_mfma_f32_16x16x32_bf16(xh, wh, acc[nt], 0, 0, 0);
                    acc[nt] = __builtin_amdgcn_mfma_f32_16x16x32_bf16(xl, wh, acc[nt], 0, 0, 0);
                    acc[nt] = __builtin_amdgcn_mfma_f32_16x16x32_bf16(xh, wl, acc[nt], 0, 0, 0);
                }
            }
            ss += __shfl_xor(ss, 16); ss += __shfl_xor(ss, 32);
            const float rsrow = __builtin_amdgcn_rsqf(ss * (1.0f / 1024.0f) + EPS);
            if (fq == 0) rsb[wid * 16 + fr] = rsrow;
            {
                unsigned char* xn = ws + WS_XN2 + (size_t)row * 1024 + 8 * fq;
#pragma unroll 4
                for (int ks = 0; ks < 32; ++ks) {
                    const f32x4 x0 = *(const f32x4*)(xr + ks * 32), x1 = *(const f32x4*)(xr + ks * 32 + 4);
                    u32x2 w; w.x = pk4_fp8(x0[0] * rsrow, x0[1] * rsrow, x0[2] * rsrow, x0[3] * rsrow); w.y = pk4_fp8(x1[0] * rsrow, x1[1] * rsrow, x1[2] * rsrow, x1[3] * rsrow);
                    *(u32x2*)(xn + ks * 32) = w;
                }
            }
            wave_lds_sync();
            const float b0 = a.in[I_BR][fr], b1 = a.in[I_BR][16 + fr];
#pragma unroll
            for (int r = 0; r < 4; ++r) {
                const float rs = rsb[wid * 16 + 4 * fq + r];
                unsigned k0 = (f2key(acc[0][r] * rs + b0) & ~31u) | (unsigned)(31 - fr), k1 = (f2key(acc[1][r] * rs + b1) & ~31u) | (unsigned)(15 - fr);
                unsigned sel[4];
#pragma unroll
                for (int k = 0; k < 4; ++k) {
                    const unsigned best = dpp_max_u32(k0 > k1 ? k0 : k1);
                    sel[k] = best;
                    if (k0 == best) k0 = 0u;
                    if (k1 == best) k1 = 0u;
                }
                const float v0 = key2f(sel[0] & ~31u), e1 = __expf(key2f(sel[1] & ~31u) - v0), e2 = __expf(key2f(sel[2] & ~31u) - v0), e3 = __expf(key2f(sel[3] & ~31u) - v0);
                const float inv = 1.0f / (1.0f + e1 + e2 + e3);
                if (fr < 4) {
                    const unsigned sk = fr == 0 ? sel[0] : (fr == 1 ? sel[1] : (fr == 2 ? sel[2] : sel[3]));
                    const int e = 31 - (int)(sk & 31u);
                    const float gt = (fr == 0 ? 1.0f : (fr == 1 ? e1 : (fr == 2 ? e2 : e3))) * inv;
                    const int ls = __hip_atomic_fetch_add(lcnt + e, 1, __ATOMIC_RELAXED, __HIP_MEMORY_SCOPE_WORKGROUP);
                    const int ri = ((wid * 16 + 4 * fq + r) * 4 + fr) * 4;
                    RI[ri + 0] = e; RI[ri + 1] = ls; RI[ri + 2] = __float_as_int(gt);
                }
            }
        }
        __syncthreads();
        if (tid < 32) lbase[tid] = (int)__hip_atomic_fetch_add(CNT + tid, (unsigned)lcnt[tid], __ATOMIC_RELAXED, __HIP_MEMORY_SCOPE_AGENT);
        __syncthreads();
        {
            const int rl = tid >> 2, k = tid & 3, row = rg * 128 + rl;
            const int e = RI[tid * 4 + 0], slot = lbase[e] + RI[tid * 4 + 1];
            ((int*)(ws + WS_LTOK))[(size_t)e * ECAP + slot] = row;
            ((float*)(ws + WS_LRS))[(size_t)row * 4 + k] = __int_as_float(RI[tid * 4 + 2]);
            ((unsigned*)(ws + WS_ROUTE))[(size_t)row * 4 + k] = ((unsigned)e << 16) | (unsigned)slot;
        }
    }
}

DI void combine_phase(const Args& a, LAS unsigned char* lds) {
    unsigned char* ws = a.ws;
    LAS const int* tab = (LAS const int*)(lds + MOE_TAB);
    const int tid = otid(), wid = tid >> 6, lane = tid & 63;
    const u16* YB = (const u16*)(ws + WS_YB); const unsigned* ROUTE = (const unsigned*)(ws + WS_ROUTE);
    for (int row = blockIdx.x * 8 + wid; row < T; row += gridDim.x * 8) {
        size_t pos[4];
#pragma unroll
        for (int k = 0; k < 4; ++k) { const unsigned r = ROUTE[(size_t)row * 4 + k]; const int e = (int)(r >> 16), slot = (int)(r & 0xffffu); pos[k] = (size_t)tab[e] * 256 + slot; }
        float* orow = a.out + (size_t)row * 1024;
        const f32x4 gt = *(const f32x4*)((const float*)(ws + WS_LRS) + (size_t)row * 4);
#pragma unroll
        for (int i = 0; i < 4; ++i) {
            f32x4 v = *(const f32x4*)(orow + i * 256 + lane * 4);
#pragma unroll
            for (int k = 0; k < 4; ++k) { const u32x2 y = __builtin_nontemporal_load((const u32x2*)(YB + pos[k] * 1024 + i * 256 + lane * 4)); v[0] += gt[k] * bflo(y.x); v[1] += gt[k] * bfhi(y.x); v[2] += gt[k] * bflo(y.y); v[3] += gt[k] * bfhi(y.y); }
            *(f32x4*)(orow + i * 256 + lane * 4) = v;
        }
    }
}

#define XB_TMO      128
#define XB_XCNT(j)  (256  + 64 * (j))
#define XB_XSUB(j)  (1280 + 64 * (j))
#define XB_XGEN(j)  (2304 + 64 * (j))
#define XB_TOP      3328
#define XB_TOPGEN   3392
#define XCD_BAR_WORDS 3456
#define XB_SPIN_CAP (1u << 18)

__device__ __forceinline__ unsigned xb_ld(unsigned* p)              { return __hip_atomic_load(p, __ATOMIC_RELAXED, __HIP_MEMORY_SCOPE_AGENT); }
__device__ __forceinline__ unsigned xb_add(unsigned* p, unsigned v) { return __hip_atomic_fetch_add(p, v, __ATOMIC_RELAXED, __HIP_MEMORY_SCOPE_AGENT); }
__device__ __forceinline__ unsigned xb_xcc_id() { return (unsigned)__builtin_amdgcn_s_getreg((3 << 11) | 20) & 0xFu; }
#define XB_SPIN(cond, bar) do { unsigned _sp = 0; while (cond) { __builtin_amdgcn_s_sleep(1); \
    if ((++_sp & 255u) == 0u) { if (xb_ld(&(bar)[XB_TMO])) break; if (_sp > XB_SPIN_CAP) { atomicAdd(&(bar)[XB_TMO], 1u); break; } } } } while (0)

struct XcdBarrier {
    unsigned* bar; unsigned x;
    volatile LAS unsigned* st;
};

__device__ __forceinline__ XcdBarrier xcd_barrier_post(unsigned* bar, volatile LAS unsigned* st) {
    XcdBarrier b; b.bar = bar; b.x = xb_xcc_id(); b.st = st;
    if (threadIdx.x == 0) (void)xb_add(&bar[XB_XCNT(b.x)], 1u);
    return b;
}
__device__ __forceinline__ void xcd_barrier_complete(unsigned* bar, unsigned x, unsigned& nloc, unsigned& nx) {
    const unsigned G = gridDim.x * gridDim.y * gridDim.z;
    unsigned sum, cnt, mine, sp = 0u;
    for (;;) {
        sum = 0u; cnt = 0u; mine = 0u;
#pragma unroll
        for (unsigned j = 0; j < 16; ++j) { const unsigned c = xb_ld(&bar[XB_XCNT(j)]); sum += c; cnt += (c > 0u) ? 1u : 0u; mine = (j == x) ? c : mine; }
        if (sum == G) break;
        __builtin_amdgcn_s_sleep(1);
        if ((++sp & 255u) == 0u) { if (xb_ld(&bar[XB_TMO])) break; if (sp > XB_SPIN_CAP) { atomicAdd(&bar[XB_TMO], 1u); break; } }
    }
    nloc = mine > 0u ? mine : 1u; nx = cnt > 0u ? cnt : 1u;
}

__device__ __forceinline__ void xcd_barrier(const XcdBarrier& b) {
    asm volatile("s_waitcnt vmcnt(0)" ::: "memory");
    __syncthreads();
    if (threadIdx.x == 0) {
        unsigned* bar = b.bar;
        __builtin_amdgcn_s_waitcnt(0);
        unsigned nloc = b.st[0], nx = b.st[1];
        if (nloc == 0u) { xcd_barrier_complete(bar, b.x, nloc, nx); b.st[0] = nloc; b.st[1] = nx; }
        const unsigned old = xb_add(&bar[XB_XSUB(b.x)], 1u);
        const unsigned gen = old / nloc;
        if (old + 1u == (gen + 1u) * nloc) {
            __builtin_amdgcn_fence(__ATOMIC_RELEASE, "agent");
            asm volatile("s_waitcnt vmcnt(0)" ::: "memory");
            const unsigned og = xb_add(&bar[XB_TOP], 1u);
            const unsigned tg = og / nx;
            if (og + 1u == (tg + 1u) * nx) xb_add(&bar[XB_TOPGEN], 1u);
            else XB_SPIN(xb_ld(&bar[XB_TOPGEN]) == tg, bar);
            __builtin_amdgcn_fence(__ATOMIC_ACQUIRE, "agent");
            xb_add(&bar[XB_XGEN(b.x)], 1u);
            asm volatile("s_waitcnt vmcnt(0)" ::: "memory");
        } else {
            XB_SPIN(xb_ld(&bar[XB_XGEN(b.x)]) == gen, bar);
            __builtin_amdgcn_fence(__ATOMIC_ACQUIRE, "agent");
            asm volatile("s_waitcnt vmcnt(0)" ::: "memory");
        }
    }
    __syncthreads();
}

__global__ void __launch_bounds__(NT, 2) fwd(Args a) {
    extern __shared__ __attribute__((aligned(16))) unsigned char lds_raw[];
    LAS unsigned char* lds = (LAS unsigned char*)lds_raw;
    cg::grid_group grid = cg::this_grid();
    unsigned char* ws = a.ws;
    const int G = gridDim.x, c = blockIdx.x;
    if (threadIdx.x < 2) ((volatile LAS unsigned*)(lds + LDS_BARST))[threadIdx.x] = 0u;
    __syncthreads();
    const XcdBarrier xbar = xcd_barrier_post((unsigned*)(ws + WS_BAR), (volatile LAS unsigned*)(lds + LDS_BARST));

    phase0(a, lds);
    xcd_barrier(xbar);
    {
        g8::PlainSched s; s.Abase = (const char*)(ws + WS_XB); s.Bbase = (const char*)(ws + WS_WIN); s.lda = 1024; s.ldb = 1024; s.K = 1024; s.nM = T / 256; s.nN = NIN / 256; s.G = G; s.c = c;
        EpiIn e; e.H = (u16*)(ws + WS_H); e.rs1 = (const float*)(ws + WS_RS1); e.SSQ = (float*)(ws + WS_SSQ); e.WI = (float*)(ws + WS_WI);
        g8::gemm_phase(lds, s, e);
    }
    xcd_barrier(xbar);
    {
        g8::PlainSched s; s.Abase = (const char*)(ws + WS_H) + 1024 * 2; s.Bbase = (const char*)(ws + WS_WQ); s.lda = NIN; s.ldb = 256; s.K = 256; s.nM = T / 256; s.nN = 5; s.G = G; s.c = c;
        EpiQ e; e.Q = (u16*)(ws + WS_Q); e.QI = (u16*)(ws + WS_QI); e.SSQ = (const float*)(ws + WS_SSQ);
        g8::gemm_phase(lds, s, e);
        for (int u = c; u < 1024; u += G) gmlp_unit(a, lds, u);
        kvnorm(a);
    }
    xcd_barrier(xbar);
    dsa_phase(a, lds);
    xcd_barrier(xbar);
    {
        g8::PlainSched s; s.Abase = (const char*)(ws + WS_YO); s.Bbase = (const char*)(ws + WS_WCAT); s.lda = 1536; s.ldb = 1536; s.K = 512; s.nM = T / 256; s.nN = 4; s.G = G; s.c = c;
        EpiMrg<0> e0; e0.OUT = (u16*)(ws + WS_TMP); e0.TMP = nullptr; e0.H = (const u16*)(ws + WS_H);
        g8::gemm_phase(lds, s, e0);
        s.Abase = (const char*)(ws + WS_YO) + 512 * 2; s.Bbase = (const char*)(ws + WS_WCAT) + 512 * 2; s.K = 1024;
        EpiMrg<1> e1; e1.OUT = (u16*)(ws + WS_MRG); e1.TMP = (const u16*)(ws + WS_TMP); e1.H = (const u16*)(ws + WS_H);
        g8::gemm_phase(lds, s, e1);
    }
    xcd_barrier(xbar);
    {
        g8::PlainSched s; s.Abase = (const char*)(ws + WS_MRG); s.Bbase = (const char*)(ws + WS_WOUT); s.lda = 1024; s.ldb = 1024; s.K = 1024; s.nM = T / 256; s.nN = 4; s.G = G; s.c = c;
        EpiOut e; e.out = a.out; e.x = a.in[I_X];
        g8::gemm_phase(lds, s, e);
    }
    xcd_barrier(xbar);
    router_phase(a, lds);
    xcd_barrier(xbar);
    moe_table(lds, (const unsigned*)(ws + WS_CTL));
    {
        MoeSched<8, true> s; s.Abase = (const char*)(ws + WS_XN2); s.Wbase = (const char*)(ws + WS_WE1); s.LTOK = (const int*)(ws + WS_LTOK); s.tab = (LAS const int*)(lds + MOE_TAB);
        s.lda = 1024; s.ldb = 1024; s.K = 1024; s.G = G; s.c = c; s.wstride = (size_t)2048 * 1024;
        EpiMoe1 e; e.ACT = (unsigned char*)(ws + WS_ACT); e.b1 = a.in[I_BE1];
        g8::gemm_phase<true>(lds, s, e);
    }
    xcd_barrier(xbar);
    {
        MoeSched<4, false> s; s.Abase = (const char*)(ws + WS_ACT); s.Wbase = (const char*)(ws + WS_WE2); s.LTOK = nullptr; s.tab = (LAS const int*)(lds + MOE_TAB);
        s.lda = 1024; s.ldb = 1024; s.K = 1024; s.G = G; s.c = c; s.wstride = (size_t)1024 * 1024;
        EpiMoe2 e; e.YB = (u16*)(ws + WS_YB); e.b2 = a.in[I_BE2];
        g8::gemm_phase<true>(lds, s, e);
    }
    xcd_barrier(xbar);
    combine_phase(a, lds);
    if (a.mask == 0u) grid.sync();
}

extern "C" void kernel_launch(void* const* d_in, const int* in_sizes, int n_in, void* d_out, int out_size, void* d_ws, size_t ws_size, hipStream_t stream) {
    static int grid = 0;
    if (grid == 0) {
        int dev = 0, cus = 0, per_cu = 0;
        if (n_in != 23 || out_size != T * Dm || ws_size < WS_END) { fprintf(stderr, "kernel_launch: unexpected problem (n_in %d, out %d, ws %zu < %zu)\n", n_in, out_size, ws_size, (size_t)WS_END); grid = -1; return; }
        if (hipGetDevice(&dev) != hipSuccess || hipDeviceGetAttribute(&cus, hipDeviceAttributeMultiprocessorCount, dev) != hipSuccess) { grid = -1; return; }
        if (hipFuncSetAttribute((const void*)fwd, hipFuncAttributeMaxDynamicSharedMemorySize, LDS_BYTES) != hipSuccess) { fprintf(stderr, "hipFuncSetAttribute failed\n"); grid = -1; return; }
        if (hipOccupancyMaxActiveBlocksPerMultiprocessor(&per_cu, (const void*)fwd, NT, LDS_BYTES) != hipSuccess || per_cu < 1) { fprintf(stderr, "occupancy query failed (%d)\n", per_cu); grid = -1; return; }
        grid = cus;
        fprintf(stderr, "kernel_launch: cus %d per_cu %d grid %d ws %zu need %zu\n", cus, per_cu, grid, ws_size, (size_t)WS_END);
    }
    if (grid < 0) return;
    Args a{};
    for (int i = 0; i < 23; ++i) a.in[i] = (const float*)d_in[i];
    a.out = (float*)d_out; a.ws = (unsigned char*)d_ws; a.mask = 0xffffffffu; a.pad = 0u;
    if (hipMemsetAsync((char*)d_ws + WS_CTL, 0, 65536, stream) != hipSuccess) { fprintf(stderr, "memset failed\n"); return; }
    void* args[] = {&a};
    hipError_t e = hipLaunchCooperativeKernel((const void*)fwd, dim3(grid), dim3(NT), args, LDS_BYTES, stream);
    if (e != hipSuccess) fprintf(stderr, "cooperative launch failed: %s (grid %d)\n", hipGetErrorString(e), grid);
}
```

```cpp
#include <hip/hip_runtime.h>
#include <hip/hip_cooperative_groups.h>
#include <cstdio>
#include <cstdint>
namespace cg = cooperative_groups;

#define LAS __attribute__((address_space(3)))
#define DI __device__ __forceinline__
typedef unsigned short u16;
typedef short bf16x8 __attribute__((ext_vector_type(8)));
typedef short s16x4 __attribute__((ext_vector_type(4)));
typedef float f32x4 __attribute__((ext_vector_type(4)));
typedef float f32x2 __attribute__((ext_vector_type(2)));
typedef unsigned u32x4 __attribute__((ext_vector_type(4)));
typedef unsigned u32x2 __attribute__((ext_vector_type(2)));
typedef __bf16 bf2_t __attribute__((ext_vector_type(2)));
typedef int v8i_t __attribute__((ext_vector_type(8)));

constexpr int NT = 512;
constexpr int LDS_BYTES = 159744;
constexpr int Dm = 1024, Bsz = 4, S = 8192, T = Bsz * S;
constexpr int NIN = 3584;
constexpr int NE = 32, ECAP = 32768, PPAD = 131072 + NE * 256;
constexpr float EPS = 1e-6f;

constexpr size_t MiB = 1024 * 1024;
constexpr size_t WS_CTL = 0;
constexpr size_t WS_BAR = 16384;
constexpr int LDS_BARST = LDS_BYTES - 16;
constexpr size_t WS_WIN = 64 * 1024;
constexpr size_t WS_WQ = WS_WIN + (size_t)NIN * 1024 * 2;
constexpr size_t WS_WSP = WS_WQ + 1280 * 256 * 2;
constexpr size_t WS_WCAT = WS_WSP + 4 * 128 * 128 * 2;
constexpr size_t WS_WOUT = WS_WCAT + 1024 * 1536 * 2;
constexpr size_t WS_WR = WS_WOUT + 1024 * 1024 * 2;
constexpr size_t WS_WE1 = WS_WR + 32 * 1024 * 4;
constexpr size_t WS_WE2 = WS_WE1 + (size_t)32 * 2048 * 1024 * 2;
constexpr size_t WS_RS1 = WS_WE2 + (size_t)32 * 1024 * 1024 * 2;
constexpr size_t WS_SSQ = WS_RS1 + (size_t)T * 4;
constexpr size_t WS_WI = WS_SSQ + (size_t)T * 32 * 4;
constexpr size_t WS_ROUTE = WS_WI + (size_t)T * 4 * 4;
constexpr size_t WS_LTOK = WS_ROUTE + (size_t)T * 4 * 4;
constexpr size_t WS_LGATE = WS_LTOK + (size_t)NE * ECAP * 4;
constexpr size_t WS_LRS = WS_LGATE + (size_t)NE * ECAP * 4;
constexpr size_t WS_XN2 = WS_LRS + (size_t)NE * ECAP * 4;
constexpr size_t WS_R0 = WS_XN2 + (size_t)T * 1024 * 2;
constexpr size_t WS_XB = WS_R0;
constexpr size_t WS_H = WS_XB + (size_t)T * 1024 * 2;
constexpr size_t WS_Q = WS_H + (size_t)T * NIN * 2;
constexpr size_t WS_QI = WS_Q + (size_t)T * 1024 * 2;
constexpr size_t WS_KVN = WS_QI + (size_t)T * 256 * 2;
constexpr size_t WS_KIN = WS_KVN + (size_t)T * 128 * 2;
constexpr size_t WS_YO = WS_KIN + (size_t)T * 64 * 2;
constexpr size_t WS_TMP = WS_YO + (size_t)T * 1536 * 2;
constexpr size_t WS_MRG = WS_TMP + (size_t)T * 1024 * 2;
constexpr size_t WS_R0END = WS_MRG + (size_t)T * 1024 * 2;
constexpr size_t WS_ACT = WS_XB;
constexpr size_t WS_YB = WS_Q;
static_assert(WS_ACT + (size_t)PPAD * 1024 * 2 <= WS_Q, "ACT overlaps YB");
static_assert(WS_YB + (size_t)PPAD * 1024 * 2 <= WS_R0END, "YB too large");
constexpr size_t WS_END = WS_R0END;

struct Args { const float* in[23]; float* out; unsigned char* ws; unsigned mask; unsigned pad; };
enum { I_X = 0, I_N1G, I_WIN, I_QLG, I_WUQ, I_QNG, I_KVG, I_WUV, I_WQI, I_KIG, I_VG, I_WSP, I_BSP, I_WPA, I_WPB, I_WOUT, I_N2G, I_WR, I_BR, I_WE1, I_BE1, I_WE2, I_BE2 };

DI unsigned pk2(float a, float b) { f32x2 v = {a, b}; bf2_t r = __builtin_convertvector(v, bf2_t); return __builtin_bit_cast(unsigned, r); }
DI unsigned pk4_fp8(float a, float b, float c, float d) { unsigned w = 0u; w = (unsigned)__builtin_amdgcn_cvt_pk_fp8_f32(a, b, (int)w, false); w = (unsigned)__builtin_amdgcn_cvt_pk_fp8_f32(c, d, (int)w, true); return w; }
DI unsigned pk4_i8(float a, float b, float c, float d) {
    const int ia = (int)__builtin_rintf(fminf(fmaxf(a * 32.0f, -127.0f), 127.0f)), ib = (int)__builtin_rintf(fminf(fmaxf(b * 32.0f, -127.0f), 127.0f));
    const int ic = (int)__builtin_rintf(fminf(fmaxf(c * 32.0f, -127.0f), 127.0f)), id = (int)__builtin_rintf(fminf(fmaxf(d * 32.0f, -127.0f), 127.0f));
    return (unsigned)(ia & 0xff) | ((unsigned)(ib & 0xff) << 8) | ((unsigned)(ic & 0xff) << 16) | ((unsigned)(id & 0xff) << 24);
}
DI float bflo(unsigned u) { return __uint_as_float(u << 16); }
DI float bfhi(unsigned u) { return __uint_as_float(u & 0xffff0000u); }
DI u16 f2bf(float f) { return (u16)(pk2(f, 0.f) & 0xffffu); }
DI float bf2f(u16 h) { return __uint_as_float(((unsigned)h) << 16); }
DI float sigmoidf_(float x) { return __builtin_amdgcn_rcpf(1.0f + __expf(-x)); }
DI float gelu_tanh(float x) { const float u = 1.5957691216057308f * (x + 0.044715f * x * x * x); return x * sigmoidf_(u); }
DI float fast_sigmoid(float x) { return __builtin_amdgcn_rcpf(1.0f + __builtin_amdgcn_exp2f(x * -1.4426950408889634f)); }
DI float fast_gelu(float x) { const float p = __builtin_fmaf(x * x, -0.10294324f, -2.3022082f); return x * __builtin_amdgcn_rcpf(1.0f + __builtin_amdgcn_exp2f(x * p)); }
DI int otid() { int t = threadIdx.x; asm volatile("" : "+v"(t)); return t; }
DI void wave_lds_sync() { asm volatile("s_waitcnt lgkmcnt(0)" ::: "memory"); }

namespace g8 {
constexpr int BM = 256, BK = 64, HALF = 128, HTB = HALF * BK * 2, STAGE_BYTES = 8 * HTB, NXCD = 8, WGM = 8;
DI int lds_byte(int r, int c) { const int st = (r >> 4) * 2 + (c >> 5), rr = r & 15, cc = c & 31, ob = rr * 64 + cc * 2; return st * 1024 + (ob ^ (((ob >> 9) & 1) << 5)); }
DI int perm32(int rho) { const int n = rho >> 4, i = rho & 15; return 8 * (i >> 2) + 4 * n + (i & 3); }
DI void stage_rc(int b, int& R, int& C) { const int st = b / 1024, sb = b % 1024, swz = sb ^ (((sb >> 9) & 1) << 5); R = (st >> 1) * 16 + swz / 64; C = (st & 1) * 32 + (swz % 64) / 2; }

struct UnitD { const char* Bp; int pm, pn, e, rb; };

DI bool static_tile(int i, int G, int c, int nM, int nN, int& pm, int& pn) {
    const int nwg = nM * nN; const long L = (long)i * G + c; if (L >= nwg) return false;
    int wgid = (int)L; { const int q = nwg / NXCD, r = nwg % NXCD, xcd = wgid % NXCD, off = wgid / NXCD; wgid = (xcd < r ? xcd * (q + 1) : r * (q + 1) + (xcd - r) * q) + off; }
    const int nig = WGM * nN, gid = wgid / nig, fm = gid * WGM, gsz = (nM - fm) < WGM ? (nM - fm) : WGM;
    pm = fm + ((wgid % nig) % gsz); pn = (wgid % nig) / gsz; return true;
}

struct PlainSched {
    const char* Abase; const char* Bbase; int lda, ldb, K, nM, nN, G, c; static constexpr int esz = 2;
    DI bool next(int i, UnitD& u) const { int pm, pn; if (!static_tile(i, G, c, nM, nN, pm, pn)) return false; u.pm = pm; u.pn = pn; u.e = 0; u.rb = 0; u.Bp = Bbase + (size_t)pn * BM * ldb * 2; return true; }
    DI void a_offs(const UnitD& u, int R0, int C0, unsigned (&o)[2][2]) const {
#pragma unroll
        for (int h = 0; h < 2; ++h)
#pragma unroll
            for (int i = 0; i < 2; ++i) o[h][i] = (unsigned)(((size_t)(u.pm * BM + h * HALF + R0 + 64 * i) * lda + C0) * 2);
    }
};

template <bool FP8 = false, class Epi, class Sched>
DI void gemm_phase(LAS unsigned char* lds, const Sched& S, const Epi& E) {
    const int tid = otid(), wid = __builtin_amdgcn_readfirstlane(tid >> 6), lane = tid & 63, wr = wid >> 2, wc = wid & 3, fr = lane & 15, fq = lane >> 4;
    const int nt = S.K * Sched::esz / 128;
    int R0, C0; stage_rc(tid * 16, R0, C0);
    unsigned voffB[2];
#pragma unroll
    for (int i = 0; i < 2; ++i) { const int Rr = R0 + 64 * i, Rb = Epi::PERM ? ((Rr & ~31) + perm32(Rr & 31)) : Rr; voffB[i] = (unsigned)(Rb * S.ldb * Sched::esz + C0 * 2); }
    const size_t hstepB = (size_t)HALF * S.ldb * Sched::esz;
    const unsigned ldsw = (unsigned)wid * 1024u;
    const int aoff = FP8 ? lds_byte(wr * 64 + fr, fq * 16) : lds_byte(wr * 64 + fr, fq * 8), boff = FP8 ? lds_byte(wc * 32 + fr, fq * 16) : lds_byte(wc * 32 + fr, fq * 8);
    const unsigned mxscale = 0x7f7f7f7fu;
    const int kst = FP8 ? 16 : 1024;
    const char* Ab = S.Abase;
#define G8_SA(b, h) (((b) * 2 + (h)) * HTB)
#define G8_SB(b, h) ((4 + (b) * 2 + (h)) * HTB)
#define G8_STAGE_A(bufoff, offs, kb) do { _Pragma("unroll") for (int _i = 0; _i < 2; ++_i) \
        __builtin_amdgcn_global_load_lds((const unsigned*)(Ab + (size_t)(offs)[_i] + (size_t)(kb)), (LAS unsigned*)(lds + (bufoff) + ldsw + _i * 8192), 16, 0, 0); } while (0)
#define G8_STAGE_B(bufoff, gbase, kb) do { _Pragma("unroll") for (int _i = 0; _i < 2; ++_i) \
        __builtin_amdgcn_global_load_lds((const unsigned*)((gbase) + voffB[_i] + (size_t)(kb)), (LAS unsigned*)(lds + (bufoff) + ldsw + _i * 8192), 16, 0, 0); } while (0)
#define G8_LDA(dst, b, h) do { _Pragma("unroll") for (int m = 0; m < 4; ++m) { const i32x4_t _p = *(const LAS i32x4_t*)(lds + G8_SA(b, h) + aoff + m * 2048), _q = *(const LAS i32x4_t*)(lds + G8_SA(b, h) + aoff + m * 2048 + kst); dst[m] = __builtin_shufflevector(_p, _q, 0, 1, 2, 3, 4, 5, 6, 7); } } while (0)
#define G8_LDB(dst, b, h) do { _Pragma("unroll") for (int n = 0; n < 2; ++n) { const i32x4_t _p = *(const LAS i32x4_t*)(lds + G8_SB(b, h) + boff + n * 2048), _q = *(const LAS i32x4_t*)(lds + G8_SB(b, h) + boff + n * 2048 + kst); dst[n] = __builtin_shufflevector(_p, _q, 0, 1, 2, 3, 4, 5, 6, 7); } } while (0)
#define G8_MMA(ai, bj, At, Bt) do { __builtin_amdgcn_s_setprio(1); _Pragma("unroll") for (int m = 0; m < 4; ++m) _Pragma("unroll") for (int n = 0; n < 2; ++n) { \
        if constexpr (FP8) asm volatile("v_mfma_scale_f32_16x16x128_f8f6f4 %0, %1, %2, %0, %3, %3 op_sel_hi:[0,0,0]" : "+v"(acc[ai][bj][m][n]) : "v"(Bt[n]), "v"(At[m]), "v"(mxscale)); \
        else { acc[ai][bj][m][n] = __builtin_amdgcn_mfma_f32_16x16x32_bf16(__builtin_bit_cast(bf16x8, __builtin_shufflevector(Bt[n], Bt[n], 0, 1, 2, 3)), __builtin_bit_cast(bf16x8, __builtin_shufflevector(At[m], At[m], 0, 1, 2, 3)), acc[ai][bj][m][n], 0, 0, 0); \
               acc[ai][bj][m][n] = __builtin_amdgcn_mfma_f32_16x16x32_bf16(__builtin_bit_cast(bf16x8, __builtin_shufflevector(Bt[n], Bt[n], 4, 5, 6, 7)), __builtin_bit_cast(bf16x8, __builtin_shufflevector(At[m], At[m], 4, 5, 6, 7)), acc[ai][bj][m][n], 0, 0, 0); } } \
        __builtin_amdgcn_s_setprio(0); } while (0)
#define G8_WAIT_V(n) asm volatile("s_waitcnt vmcnt(" #n ")" ::: "memory")
#define G8_WAIT_L(n) asm volatile("s_waitcnt lgkmcnt(" #n ")" ::: "memory")
#define G8_BAR __builtin_amdgcn_s_barrier()
#define G8_SCHED __builtin_amdgcn_sched_barrier(0)
    UnitD cur, nxt; int ui = 0;
    if (!S.next(0, cur)) return;
    f32x4 acc[2][2][4][2];
#pragma unroll
    for (int a = 0; a < 2; ++a)
#pragma unroll
        for (int b = 0; b < 2; ++b)
#pragma unroll
            for (int m = 0; m < 4; ++m)
#pragma unroll
                for (int n = 0; n < 2; ++n) acc[a][b][m][n] = (f32x4){0.f, 0.f, 0.f, 0.f};
    typedef int i32x4_t __attribute__((ext_vector_type(4)));
    v8i_t At[4], B0[2], B1[2];
    unsigned cA[2][2];
    S.a_offs(cur, R0, C0, cA);
    const char* cB = cur.Bp;
    G8_STAGE_B(G8_SB(0, 0), cB, 0); G8_STAGE_A(G8_SA(0, 0), cA[0], 0); G8_STAGE_B(G8_SB(0, 1), cB + hstepB, 0); G8_STAGE_A(G8_SA(0, 1), cA[1], 0);
    if (wr == 1) G8_BAR;
    G8_WAIT_V(4); G8_BAR;
    G8_STAGE_B(G8_SB(1, 0), cB, 128); G8_STAGE_A(G8_SA(1, 0), cA[0], 128); G8_STAGE_B(G8_SB(1, 1), cB + hstepB, 128);
    G8_WAIT_V(6); G8_BAR;
    for (;;) {
        const bool has_next = S.next(ui + 1, nxt);
        const char* nB = has_next ? nxt.Bp : cB;
        for (int t = 0; t < nt; t += 2) {
            const bool last = (t == nt - 2);
            const unsigned k1 = (unsigned)(t + 1) * 128u;
            const unsigned k2 = last ? 0u : (unsigned)(t + 2) * 128u, k3 = k2 + 128u;
            unsigned c1[2] = {cA[1][0], cA[1][1]};
            if (last && has_next) S.a_offs(nxt, R0, C0, cA);
            const char* b2 = last ? nB : cB;
            G8_LDB(B0, 0, 0); G8_SCHED; G8_LDA(At, 0, 0); G8_STAGE_A(G8_SA(1, 1), c1, k1);
            G8_WAIT_L(8); G8_BAR; G8_WAIT_L(0); G8_MMA(0, 0, At, B0); G8_BAR; G8_SCHED;
            G8_LDB(B1, 0, 1); G8_STAGE_B(G8_SB(0, 0), b2, k2);
            G8_BAR; G8_WAIT_L(0); G8_MMA(0, 1, At, B1); G8_BAR;
            G8_LDA(At, 0, 1); G8_STAGE_A(G8_SA(0, 0), cA[0], k2);
            G8_BAR; G8_WAIT_L(0); G8_MMA(1, 0, At, B0); G8_BAR; G8_SCHED;
            G8_STAGE_B(G8_SB(0, 1), b2 + hstepB, k2);
            G8_WAIT_V(6); G8_BAR; G8_MMA(1, 1, At, B1); G8_BAR;
            G8_LDB(B0, 1, 0); G8_SCHED; G8_LDA(At, 1, 0); G8_STAGE_A(G8_SA(0, 1), cA[1], k2);
            G8_WAIT_L(8); G8_BAR; G8_WAIT_L(0); G8_MMA(0, 0, At, B0); G8_BAR; G8_SCHED;
            G8_LDB(B1, 1, 1); G8_STAGE_B(G8_SB(1, 0), b2, k3);
            G8_BAR; G8_WAIT_L(0); G8_MMA(0, 1, At, B1); G8_BAR;
            G8_LDA(At, 1, 1); G8_STAGE_A(G8_SA(1, 0), cA[0], k3);
            G8_BAR; G8_WAIT_L(0); G8_MMA(1, 0, At, B0); G8_BAR; G8_SCHED;
            G8_STAGE_B(G8_SB(1, 1), b2 + hstepB, k3);
            G8_WAIT_V(6); G8_BAR; G8_MMA(1, 1, At, B1); G8_BAR;
        }
        if constexpr (FP8) asm volatile("s_nop 15\n\ts_nop 15" ::: "memory");
        E(acc, cur, wr, wc, fr, fq);
        if (!has_next) break;
#pragma unroll
        for (int a = 0; a < 2; ++a)
#pragma unroll
            for (int b = 0; b < 2; ++b)
#pragma unroll
                for (int m = 0; m < 4; ++m)
#pragma unroll
                    for (int n = 0; n < 2; ++n) acc[a][b][m][n] = (f32x4){0.f, 0.f, 0.f, 0.f};
        cur = nxt; cB = nB; ++ui;
    }
    G8_WAIT_V(0);
    if (wr == 0) G8_BAR;
    G8_BAR;
#undef G8_SA
#undef G8_SB
#undef G8_STAGE_A
#undef G8_STAGE_B
#undef G8_LDA
#undef G8_LDB
#undef G8_MMA
#undef G8_WAIT_V
#undef G8_WAIT_L
#undef G8_BAR
#undef G8_SCHED
}
}
using g8::UnitD;
typedef f32x4 Acc[2][2][4][2];

struct EpiIn {
    static constexpr bool PERM = true;
    u16* H; const float* rs1; float* SSQ; float* WI;
    template <int ACT, bool DOSSQ> DI void run(const Acc& acc, const UnitD& u, int wr, int wc, int fr, int fq) const {
        const int pn = u.pn;
#pragma unroll
        for (int ai = 0; ai < 2; ++ai)
#pragma unroll
            for (int m = 0; m < 4; ++m) {
                const int row = u.pm * 256 + ai * 128 + wr * 64 + m * 16 + fr;
#pragma unroll
                for (int bj = 0; bj < 2; ++bj) {
                    f32x4 v0 = acc[ai][bj][m][0], v1 = acc[ai][bj][m][1];
                    if (ACT == 1) {
#pragma unroll
                        for (int j = 0; j < 4; ++j) { v0[j] = fast_gelu(v0[j]); v1[j] = fast_gelu(v1[j]); }
                    } else if (ACT == 2) {
#pragma unroll
                        for (int j = 0; j < 4; ++j) { v0[j] = fast_sigmoid(v0[j]); v1[j] = fast_sigmoid(v1[j]); }
                    }
                    u32x4 w; w.x = pk2(v0[0], v0[1]); w.y = pk2(v0[2], v0[3]); w.z = pk2(v1[0], v1[1]); w.w = pk2(v1[2], v1[3]);
                    *(u32x4*)(H + (size_t)row * NIN + pn * 256 + bj * 128 + wc * 32 + 8 * fq) = w;
                    if (DOSSQ) {
                        float ssq = ((v0[0] * v0[0] + v0[1] * v0[1]) + (v0[2] * v0[2] + v0[3] * v0[3])) + ((v1[0] * v1[0] + v1[1] * v1[1]) + (v1[2] * v1[2] + v1[3] * v1[3]));
                        ssq += __shfl_xor(ssq, 16); ssq += __shfl_xor(ssq, 32);
                        if (fq == 0) SSQ[(size_t)row * 32 + (pn - 2) * 8 + bj * 4 + wc] = ssq;
                        if (pn == 5 && bj == 1 && wc == 2 && fq == 0) *(f32x4*)(WI + (size_t)row * 4) = v0 * 0.5f;
                    }
                }
            }
    }
    DI void operator()(const Acc& acc, const UnitD& u, int wr, int wc, int fr, int fq) const {
        const int pn = u.pn;
        if (pn < 2) run<1, false>(acc, u, wr, wc, fr, fq);
        else if (pn < 4) run<1, true>(acc, u, wr, wc, fr, fq);
        else if (pn < 6) run<0, true>(acc, u, wr, wc, fr, fq);
        else run<2, false>(acc, u, wr, wc, fr, fq);
    }
};
struct EpiQ {
    static constexpr bool PERM = true;
    u16* Q; u16* QI; const float* SSQ;
    DI void operator()(const Acc& acc, const UnitD& u, int wr, int wc, int fr, int fq) const {
        f32x4 sq[2][4][2];
#pragma unroll
        for (int ai = 0; ai < 2; ++ai)
#pragma unroll
            for (int m = 0; m < 4; ++m) { const int row = u.pm * 256 + ai * 128 + wr * 64 + m * 16 + fr; sq[ai][m][0] = *(const f32x4*)(SSQ + (size_t)row * 32 + 16); sq[ai][m][1] = *(const f32x4*)(SSQ + (size_t)row * 32 + 20); }
        __builtin_amdgcn_sched_barrier(0);
#pragma unroll
        for (int ai = 0; ai < 2; ++ai)
#pragma unroll
            for (int m = 0; m < 4; ++m) {
                const int row = u.pm * 256 + ai * 128 + wr * 64 + m * 16 + fr;
                const f32x4 s0 = sq[ai][m][0], s1 = sq[ai][m][1];
                const float ss = ((s0[0] + s0[1]) + (s0[2] + s0[3])) + ((s1[0] + s1[1]) + (s1[2] + s1[3]));
                const float rs = __builtin_amdgcn_rsqf(ss * (1.0f / 256.0f) + EPS);
#pragma unroll
                for (int bj = 0; bj < 2; ++bj) {
                    const int col = u.pn * 256 + bj * 128 + wc * 32 + 8 * fq;
                    const f32x4 v0 = acc[ai][bj][m][0] * rs, v1 = acc[ai][bj][m][1] * rs;
                    if (col < 1024) { u32x4 w; w.x = pk2(v0[0], v0[1]); w.y = pk2(v0[2], v0[3]); w.z = pk2(v1[0], v1[1]); w.w = pk2(v1[2], v1[3]); *(u32x4*)(Q + (size_t)row * 1024 + col) = w; }
                    else { u32x2 w; w.x = pk4_i8(v0[0], v0[1], v0[2], v0[3]); w.y = pk4_i8(v1[0], v1[1], v1[2], v1[3]); *(u32x2*)((unsigned char*)QI + (size_t)row * 256 + (col - 1024)) = w; }
                }
            }
    }
};
template <int SECOND> struct EpiMrg {
    static constexpr bool PERM = true;
    u16* OUT; const u16* TMP; const u16* H;
    DI void operator()(const Acc& acc, const UnitD& u, int wr, int wc, int fr, int fq) const {
#pragma unroll
        for (int ai = 0; ai < 2; ++ai) {
            u32x4 g[4][2], tp[4][2];
#pragma unroll
            for (int m = 0; m < 4; ++m)
#pragma unroll
                for (int bj = 0; bj < 2; ++bj) {
                    const int row = u.pm * 256 + ai * 128 + wr * 64 + m * 16 + fr, col = u.pn * 256 + bj * 128 + wc * 32 + 8 * fq;
                    g[m][bj] = *(const u32x4*)(H + (size_t)row * NIN + 1536 + SECOND * 1024 + col);
                    if (SECOND) tp[m][bj] = *(const u32x4*)(TMP + (size_t)row * 1024 + col);
                }
            __builtin_amdgcn_sched_barrier(0);
#pragma unroll
            for (int m = 0; m < 4; ++m)
#pragma unroll
                for (int bj = 0; bj < 2; ++bj) {
                    const int row = u.pm * 256 + ai * 128 + wr * 64 + m * 16 + fr, col = u.pn * 256 + bj * 128 + wc * 32 + 8 * fq;
                    const u32x4 gg = g[m][bj];
                    f32x4 v0 = acc[ai][bj][m][0], v1 = acc[ai][bj][m][1];
                    v0[0] *= bflo(gg.x); v0[1] *= bfhi(gg.x); v0[2] *= bflo(gg.y); v0[3] *= bfhi(gg.y); v1[0] *= bflo(gg.z); v1[1] *= bfhi(gg.z); v1[2] *= bflo(gg.w); v1[3] *= bfhi(gg.w);
                    if (SECOND) { const u32x4 t = tp[m][bj];
                        v0[0] += bflo(t.x); v0[1] += bfhi(t.x); v0[2] += bflo(t.y); v0[3] += bfhi(t.y); v1[0] += bflo(t.z); v1[1] += bfhi(t.z); v1[2] += bflo(t.w); v1[3] += bfhi(t.w); }
                    u32x4 w; w.x = pk2(v0[0], v0[1]); w.y = pk2(v0[2], v0[3]); w.z = pk2(v1[0], v1[1]); w.w = pk2(v1[2], v1[3]);
                    *(u32x4*)(OUT + (size_t)row * 1024 + col) = w;
                }
            __builtin_amdgcn_sched_barrier(0);
        }
    }
};
struct EpiOut {
    static constexpr bool PERM = false;
    float* out; const float* x;
    DI void operator()(const Acc& acc, const UnitD& u, int wr, int wc, int fr, int fq) const {
#pragma unroll
        for (int ai = 0; ai < 2; ++ai) {
            f32x4 xv[4][2][2];
#pragma unroll
            for (int m = 0; m < 4; ++m)
#pragma unroll
                for (int bj = 0; bj < 2; ++bj)
#pragma unroll
                    for (int n = 0; n < 2; ++n)
                        xv[m][bj][n] = *(const f32x4*)(x + (size_t)(u.pm * 256 + ai * 128 + wr * 64 + m * 16 + fr) * 1024 + u.pn * 256 + bj * 128 + wc * 32 + n * 16 + 4 * fq);
            __builtin_amdgcn_sched_barrier(0);
#pragma unroll
            for (int m = 0; m < 4; ++m)
#pragma unroll
                for (int bj = 0; bj < 2; ++bj)
#pragma unroll
                    for (int n = 0; n < 2; ++n)
                        *(f32x4*)(out + (size_t)(u.pm * 256 + ai * 128 + wr * 64 + m * 16 + fr) * 1024 + u.pn * 256 + bj * 128 + wc * 32 + n * 16 + 4 * fq) = xv[m][bj][n] + acc[ai][bj][m][n];
            __builtin_amdgcn_sched_barrier(0);
        }
    }
};

constexpr int MOE_TAB = g8::STAGE_BYTES;
DI void moe_table(LAS unsigned char* lds, const unsigned* CNT) {
    LAS int* tab = (LAS int*)(lds + MOE_TAB);
    __syncthreads();
    if (threadIdx.x == 0) { int acc = 0; for (int e = 0; e < NE; ++e) { const int c = (int)__hip_atomic_load(CNT + e, __ATOMIC_RELAXED, __HIP_MEMORY_SCOPE_AGENT); tab[e] = acc; tab[33 + e] = c; acc += (c + 255) >> 8; } tab[32] = acc; }
    __syncthreads();
}
template <int NPN, bool GATHER> struct MoeSched {
    const char* Abase; const char* Wbase; const int* LTOK; LAS const int* tab; int lda, ldb, K, G, c; size_t wstride; static constexpr int esz = 1;
    DI bool next(int i, UnitD& u) const {
        const long L = (long)i * G + c; const int R = tab[32];
        if (L >= (long)R * NPN) return false;
        const int rbg = (int)(L / NPN), pn = (int)(L % NPN);
        int e = 0;
        for (int j = 1; j < NE; ++j) e += (tab[j] <= rbg) ? 1 : 0;
        e = __builtin_amdgcn_readfirstlane(e);
        u.pm = rbg; u.pn = pn; u.e = e; u.rb = rbg - tab[e];
        u.Bp = Wbase + (size_t)e * wstride + (size_t)pn * 256 * ldb * esz;
        return true;
    }
    DI void a_offs(const UnitD& u, int R0, int C0, unsigned (&o)[2][2]) const {
        const int cnt = tab[33 + u.e];
#pragma unroll
        for (int h = 0; h < 2; ++h)
#pragma unroll
            for (int i = 0; i < 2; ++i) {
                const int r = h * 128 + R0 + 64 * i;
                if (GATHER) { const int slot = u.rb * 256 + r; const int tok = slot < cnt ? LTOK[(size_t)u.e * ECAP + slot] : 0; o[h][i] = (unsigned)((size_t)tok * lda * esz + C0 * 2); }
                else o[h][i] = (unsigned)((size_t)(u.pm * 256 + r) * lda * esz + C0 * 2);
            }
    }
};
struct EpiMoe1 {
    static constexpr bool PERM = true;
    unsigned char* ACT; const float* b1;
    DI void operator()(const Acc& acc, const UnitD& u, int wr, int wc, int fr, int fq) const {
        const float* be = b1 + (size_t)u.e * 2048;
        const int hc = u.pn * 128 + wc * 32 + 8 * fq;
        const f32x4 bg0 = *(const f32x4*)(be + hc), bg1 = *(const f32x4*)(be + hc + 4), bu0 = *(const f32x4*)(be + 1024 + hc), bu1 = *(const f32x4*)(be + 1024 + hc + 4);
        __builtin_amdgcn_sched_barrier(0);
#pragma unroll
        for (int ai = 0; ai < 2; ++ai)
#pragma unroll
            for (int m = 0; m < 4; ++m) {
                const int row = u.pm * 256 + ai * 128 + wr * 64 + m * 16 + fr;
                float av[8];
#pragma unroll
                for (int n = 0; n < 2; ++n) {
                    const f32x4 g = acc[ai][0][m][n] * 0.015625f + (n ? bg1 : bg0), up = acc[ai][1][m][n] * 0.015625f + (n ? bu1 : bu0);
#pragma unroll
                    for (int j = 0; j < 4; ++j) {
                        const float hg = fminf(g[j], 7.0f), hu = __builtin_amdgcn_fmed3f(up[j], -7.0f, 7.0f);
                        av[4 * n + j] = (hu + 1.0f) * (hg * __builtin_amdgcn_rcpf(1.0f + __builtin_amdgcn_exp2f(hg * -2.4554669595930157f)));
                    }
                }
                u32x2 w; w.x = pk4_fp8(av[0], av[1], av[2], av[3]); w.y = pk4_fp8(av[4], av[5], av[6], av[7]);
                *(u32x2*)(ACT + (size_t)row * 1024 + hc) = w;
            }
    }
};
struct EpiMoe2 {
    static constexpr bool PERM = true;
    u16* YB; const float* b2;
    DI void operator()(const Acc& acc, const UnitD& u, int wr, int wc, int fr, int fq) const {
        const float* be = b2 + (size_t)u.e * 1024;
        f32x4 bias[2][2];
#pragma unroll
        for (int bj = 0; bj < 2; ++bj) { const int col = u.pn * 256 + bj * 128 + wc * 32 + 8 * fq; bias[bj][0] = *(const f32x4*)(be + col); bias[bj][1] = *(const f32x4*)(be + col + 4); }
        __builtin_amdgcn_sched_barrier(0);
#pragma unroll
        for (int ai = 0; ai < 2; ++ai)
#pragma unroll
            for (int m = 0; m < 4; ++m) {
                const int r = ai * 128 + wr * 64 + m * 16 + fr;
#pragma unroll
                for (int bj = 0; bj < 2; ++bj) {
                    const int col = u.pn * 256 + bj * 128 + wc * 32 + 8 * fq;
                    const f32x4 v0 = acc[ai][bj][m][0] * 0.015625f + bias[bj][0], v1 = acc[ai][bj][m][1] * 0.015625f + bias[bj][1];
                    u32x4 w; w.x = pk2(v0[0], v0[1]); w.y = pk2(v0[2], v0[3]); w.z = pk2(v1[0], v1[1]); w.w = pk2(v1[2], v1[3]);
                    *(u32x4*)(YB + (size_t)(u.pm * 256 + r) * 1024 + col) = w;
                }
            }
    }
};

template <bool FP8 = false, class F> DI void tr_tile(LAS unsigned char* lds, const float* src, int ld_src, int Nsz, int k0, int n0, const float* sk, float mul, u16* dst, int ld_dst, F rowmap) {
    LAS float* t = (LAS float*)lds;
    const int tid = otid();
    __syncthreads();
#pragma unroll
    for (int it = 0; it < 2; ++it) {
        const int k = (tid >> 4) + 32 * it, n = 4 * (tid & 15);
        f32x4 v = {0.f, 0.f, 0.f, 0.f};
        if (n0 + n < Nsz) v = *(const f32x4*)(src + (size_t)(k0 + k) * ld_src + n0 + n);
        const float s = (sk ? sk[k0 + k] : 1.0f) * mul;
        t[k * 65 + n] = v[0] * s; t[k * 65 + n + 1] = v[1] * s; t[k * 65 + n + 2] = v[2] * s; t[k * 65 + n + 3] = v[3] * s;
    }
    __syncthreads();
    const int n = tid >> 3, kc = (tid & 7) * 8;
    if (FP8) {
        if (n0 + n < Nsz) {
            u32x2 w;
            w.x = pk4_fp8(t[(kc + 0) * 65 + n], t[(kc + 1) * 65 + n], t[(kc + 2) * 65 + n], t[(kc + 3) * 65 + n]);
            w.y = pk4_fp8(t[(kc + 4) * 65 + n], t[(kc + 5) * 65 + n], t[(kc + 6) * 65 + n], t[(kc + 7) * 65 + n]);
            *(u32x2*)((unsigned char*)dst + (size_t)rowmap(n0 + n) * ld_dst + k0 + kc) = w;
        }
    } else if (n0 + n < Nsz) {
        u32x4 w;
        w.x = pk2(t[(kc + 0) * 65 + n], t[(kc + 1) * 65 + n]); w.y = pk2(t[(kc + 2) * 65 + n], t[(kc + 3) * 65 + n]);
        w.z = pk2(t[(kc + 4) * 65 + n], t[(kc + 5) * 65 + n]); w.w = pk2(t[(kc + 6) * 65 + n], t[(kc + 7) * 65 + n]);
        *(u32x4*)(dst + (size_t)rowmap(n0 + n) * ld_dst + k0 + kc) = w;
    }
}
struct MapId { DI int operator()(int n) const { return n; } };
struct MapIn { DI int operator()(int n) const { return n < 1476 ? n : n + 60; } };
struct MapE1 { DI int operator()(int n) const { const int hi = n >= 1024 ? 1 : 0, q = n - hi * 1024; return (q >> 7) * 256 + hi * 128 + (q & 127); } };

DI void phase0(const Args& a, LAS unsigned char* lds) {
    unsigned char* ws = a.ws;
    const int tid = otid();
    const size_t gtid = (size_t)blockIdx.x * NT + tid, gstride = (size_t)gridDim.x * NT;
    for (size_t i = gtid; i < 60 * 1024 / 2; i += gstride) ((unsigned*)(ws + WS_WIN + (size_t)1476 * 1024 * 2))[i] = 0u;
    for (size_t i = gtid; i < 32 * 1024; i += gstride) { const int e = (int)(i >> 10), k = (int)(i & 1023); const float w = a.in[I_WR][k * 32 + e] * a.in[I_N2G][k]; const u16 h = f2bf(w); ((u16*)(ws + WS_WR))[i] = h; ((u16*)(ws + WS_WR))[32 * 1024 + i] = f2bf(w - bf2f(h)); }
    for (size_t i = gtid; i < 4 * 128 * 128; i += gstride) { const int tt = (int)((i >> 7) & 127), ss = (int)(i & 127); ((u16*)(ws + WS_WSP))[i] = f2bf(ss <= tt ? a.in[I_WSP][i] : 0.f); }
    {
        const int wid = tid >> 6, lane = tid & 63;
        for (int row = blockIdx.x * 8 + wid; row < T; row += gridDim.x * 8) {
            const float* xr = a.in[I_X] + (size_t)row * 1024; u16* xb = (u16*)(ws + WS_XB) + (size_t)row * 1024;
            float ss = 0.f; f32x4 xv[4];
#pragma unroll
            for (int i = 0; i < 4; ++i) {
                xv[i] = __builtin_nontemporal_load((const f32x4*)(xr + i * 256 + lane * 4));
                ss += (xv[i][0] * xv[i][0] + xv[i][1] * xv[i][1]) + (xv[i][2] * xv[i][2] + xv[i][3] * xv[i][3]);
            }
#pragma unroll
            for (int o = 32; o >= 1; o >>= 1) ss += __shfl_xor(ss, o);
            const float rs = __builtin_amdgcn_rsqf(ss * (1.0f / 1024.0f) + EPS);
#pragma unroll
            for (int i = 0; i < 4; ++i) { u32x2 w; w.x = pk2(xv[i][0] * rs, xv[i][1] * rs); w.y = pk2(xv[i][2] * rs, xv[i][3] * rs); *(u32x2*)(xb + i * 256 + lane * 4) = w; }
        }
    }
    constexpr int U_IN = 16 * 56, U_UQ = 4 * 16, U_QI = 4 * 4, U_PA = 8 * 16, U_OUT = 16 * 16, U_CB = 64;
    constexpr int U_TOT = U_IN + U_UQ + U_QI + U_PA + U_OUT + U_CB;
    for (int u = blockIdx.x; u < U_TOT; u += gridDim.x) {
        int v = u;
        if (v < U_IN) { tr_tile(lds, a.in[I_WIN], 3524, 3524, (v & 15) * 64, (v >> 4) * 64, a.in[I_N1G], 1.0f, (u16*)(ws + WS_WIN), 1024, MapIn()); continue; }
        v -= U_IN;
        if (v < U_UQ) { tr_tile(lds, a.in[I_WUQ], 1024, 1024, (v & 3) * 64, (v >> 2) * 64, a.in[I_QLG], 1.0f, (u16*)(ws + WS_WQ), 256, MapId()); continue; }
        v -= U_UQ;
        if (v < U_QI) { tr_tile(lds, a.in[I_WQI], 256, 256, (v & 3) * 64, (v >> 2) * 64, a.in[I_QLG], 1.0f, (u16*)(ws + WS_WQ) + 1024 * 256, 256, MapId()); continue; }
        v -= U_QI;
        if (v < U_PA) { tr_tile(lds, a.in[I_WPA], 1024, 1024, (v & 7) * 64, (v >> 3) * 64, nullptr, 1.0f, (u16*)(ws + WS_WCAT), 1536, MapId()); continue; }
        v -= U_PA;
        if (v < U_OUT) { tr_tile(lds, a.in[I_WOUT], 1024, 1024, (v & 15) * 64, (v >> 4) * 64, nullptr, 1.0f, (u16*)(ws + WS_WOUT), 1024, MapId()); continue; }
        v -= U_OUT;
        {
            const int h = v >> 3, c0 = (v & 7) * 16;
            LAS float* t = (LAS float*)lds;
            __syncthreads();
            for (int i = tid; i < 1024; i += NT) t[i] = a.in[I_WUV][(size_t)h * 128 * 64 + (size_t)c0 * 64 + i];
            __syncthreads();
            for (int nn = tid; nn < 1024; nn += NT) {
                float accv[16];
#pragma unroll
                for (int i = 0; i < 16; ++i) accv[i] = 0.f;
                for (int vv = 0; vv < 64; ++vv) {
                    const float pb = a.in[I_WPB][(size_t)(h * 64 + vv) * 1024 + nn];
#pragma unroll
                    for (int i = 0; i < 16; ++i) accv[i] += t[i * 64 + vv] * pb;
                }
                u32x4 w0, w1;
                w0.x = pk2(accv[0], accv[1]); w0.y = pk2(accv[2], accv[3]); w0.z = pk2(accv[4], accv[5]); w0.w = pk2(accv[6], accv[7]);
                w1.x = pk2(accv[8], accv[9]); w1.y = pk2(accv[10], accv[11]); w1.z = pk2(accv[12], accv[13]); w1.w = pk2(accv[14], accv[15]);
                u16* d = (u16*)(ws + WS_WCAT) + (size_t)nn * 1536 + 512 + h * 128 + c0;
                *(u32x4*)d = w0; *(u32x4*)(d + 8) = w1;
            }
        }
    }
}

DI void gmlp_unit(const Args& a, LAS unsigned char* lds, int u) {
    unsigned char* ws = a.ws;
    const int tid = otid(), wid = tid >> 6, lane = tid & 63, fr = lane & 15, fq = lane >> 4;
    const int g = u & 3, row0 = (u >> 2) * 128;
    const u16* H = (const u16*)(ws + WS_H);
    LAS u16* img = (LAS u16*)lds;
    __syncthreads();
    {
        const int s = tid & 127, cset = tid >> 7;
        const f32x4 sq = *(const f32x4*)((const float*)(ws + WS_SSQ) + (size_t)(row0 + s) * 32 + g * 4);
        const float rs = __builtin_amdgcn_rsqf(((sq[0] + sq[1]) + (sq[2] + sq[3])) * (1.0f / 128.0f) + EPS);
#pragma unroll
        for (int it = 0; it < 4; ++it) {
            const int c = cset + 4 * it;
            const u32x4 raw = *(const u32x4*)(H + (size_t)(row0 + s) * NIN + 512 + g * 128 + 8 * c);
            const float* vg = a.in[I_VG] + 8 * c;
            float f[8] = {bflo(raw.x), bfhi(raw.x), bflo(raw.y), bfhi(raw.y), bflo(raw.z), bfhi(raw.z), bflo(raw.w), bfhi(raw.w)};
#pragma unroll
            for (int i = 0; i < 8; ++i) img[(8 * c + i) * 136 + s] = f2bf(f[i] * rs * vg[i]);
        }
    }
    __syncthreads();
    const u16* W = (const u16*)(ws + WS_WSP) + (size_t)g * 128 * 128 + (size_t)(16 * wid + fr) * 128;
    f32x4 acc[8];
#pragma unroll
    for (int i = 0; i < 8; ++i) acc[i] = (f32x4){0.f, 0.f, 0.f, 0.f};
    const int nks = (16 * wid + 15) / 32 + 1;
    for (int ks = 0; ks < nks; ++ks) {
        const bf16x8 bw = *(const bf16x8*)(W + ks * 32 + 8 * fq);
#pragma unroll
        for (int i = 0; i < 8; ++i) {
            const bf16x8 av = *(const LAS bf16x8*)(img + (16 * i + fr) * 136 + ks * 32 + 8 * fq);
            acc[i] = __builtin_amdgcn_mfma_f32_16x16x32_bf16(av, bw, acc[i], 0, 0, 0);
        }
    }
    const int t = 16 * wid + fr;
    const float bias = a.in[I_BSP][g * 128 + t];
    u16* YO = (u16*)(ws + WS_YO);
#pragma unroll
    for (int i = 0; i < 8; ++i) {
        const int d = 16 * i + 4 * fq;
        const u32x2 uu = *(const u32x2*)(H + (size_t)(row0 + t) * NIN + g * 128 + d);
        const float y0 = bflo(uu.x) * (acc[i][0] + bias), y1 = bfhi(uu.x) * (acc[i][1] + bias), y2 = bflo(uu.y) * (acc[i][2] + bias), y3 = bfhi(uu.y) * (acc[i][3] + bias);
        u32x2 w; w.x = pk2(y0, y1); w.y = pk2(y2, y3);
        *(u32x2*)(YO + (size_t)(row0 + t) * 1536 + g * 128 + d) = w;
    }
}

DI void kvnorm(const Args& a) {
    unsigned char* ws = a.ws;
    const u16* H = (const u16*)(ws + WS_H); const float* SSQ = (const float*)(ws + WS_SSQ);
    const size_t gtid = (size_t)blockIdx.x * NT + otid(), gstride = (size_t)gridDim.x * NT;
    for (size_t idx = gtid; idx < (size_t)T * 24; idx += gstride) {
        const int row = (int)(idx / 24), c = (int)(idx % 24);
        const u16* src; u16* dst; const float* gain; float rs;
        if (c < 16) {
            const f32x4 sq = *(const f32x4*)(SSQ + (size_t)row * 32 + 24);
            rs = __builtin_amdgcn_rsqf(((sq[0] + sq[1]) + (sq[2] + sq[3])) * (1.0f / 128.0f) + EPS);
            src = H + (size_t)row * NIN + 1280 + 8 * c; dst = (u16*)(ws + WS_KVN) + (size_t)row * 128 + 8 * c; gain = a.in[I_KVG] + 8 * c;
        } else {
            const int cc = c - 16;
            rs = __builtin_amdgcn_rsqf((SSQ[(size_t)row * 32 + 28] + SSQ[(size_t)row * 32 + 29]) * (1.0f / 64.0f) + EPS);
            src = H + (size_t)row * NIN + 1408 + 8 * cc; dst = nullptr; gain = a.in[I_KIG] + 8 * cc;
            const u32x4 raw = *(const u32x4*)src;
            u32x2 w8;
            w8.x = pk4_i8(bflo(raw.x) * rs * gain[0], bfhi(raw.x) * rs * gain[1], bflo(raw.y) * rs * gain[2], bfhi(raw.y) * rs * gain[3]);
            w8.y = pk4_i8(bflo(raw.z) * rs * gain[4], bfhi(raw.z) * rs * gain[5], bflo(raw.w) * rs * gain[6], bfhi(raw.w) * rs * gain[7]);
            *(u32x2*)(ws + WS_KIN + (size_t)row * 64 + 8 * cc) = w8;
            continue;
        }
        const u32x4 raw = *(const u32x4*)src;
        u32x4 w;
        w.x = pk2(bflo(raw.x) * rs * gain[0], bfhi(raw.x) * rs * gain[1]); w.y = pk2(bflo(raw.y) * rs * gain[2], bfhi(raw.y) * rs * gain[3]);
        w.z = pk2(bflo(raw.z) * rs * gain[4], bfhi(raw.z) * rs * gain[5]); w.w = pk2(bflo(raw.w) * rs * gain[6], bfhi(raw.w) * rs * gain[7]);
        *(u32x4*)dst = w;
    }
}

constexpr int P3_ROWS = 0, P3_HIST = 131072, P3_LIST = 147456;
DI unsigned bf2keys(unsigned b) {
    unsigned m; asm("v_pk_ashrrev_i16 %0, %1, %2" : "=v"(m) : "v"(0x000f000fu), "v"(b));
    return b ^ (m | 0x80008000u);
}
DI unsigned f2key(float f) { const unsigned u = __float_as_uint(f); return (u & 0x80000000u) ? ~u : (u | 0x80000000u); }
DI int wave_incl_scan(int v, int lane) {
#pragma unroll
    for (int o = 1; o < 64; o <<= 1) { const int t = __shfl_up(v, o); if (lane >= o) v += t; }
    return v;
}
DI int wave_suffix_scan(int v, int lane) {
#pragma unroll
    for (int o = 1; o < 64; o <<= 1) { const int t = __shfl_down(v, o); if (lane + o < 64) v += t; }
    return v;
}
DI unsigned pk_gt(unsigned kw, unsigned xw, unsigned one) {
    unsigned d, m;
    asm("v_pk_sub_u16 %0, %1, %2 clamp" : "=v"(d) : "v"(kw), "v"(xw));
    asm("v_pk_min_u16 %0, %1, %2" : "=v"(m) : "v"(d), "v"(one));
    return m;
}
DI unsigned pk_subs(unsigned kw, unsigned xw) { unsigned d; asm("v_pk_sub_u16 %0, %1, %2 clamp" : "=v"(d) : "v"(kw), "v"(xw)); return d; }
DI unsigned pk_min1(unsigned d, unsigned one) { unsigned m; asm("v_pk_min_u16 %0, %1, %2" : "=v"(m) : "v"(d), "v"(one)); return m; }
DI unsigned pk_max(unsigned a, unsigned b) { unsigned r; asm("v_pk_max_u16 %0, %1, %2" : "=v"(r) : "v"(a), "v"(b)); return r; }
DI unsigned pk_add(unsigned a, unsigned b) { unsigned r; asm("v_pk_add_u16 %0, %1, %2" : "=v"(r) : "v"(a), "v"(b)); return r; }
DI int wave_sum(int v) {
    v += __builtin_amdgcn_update_dpp(0, v, 0xB1, 0xf, 0xf, false);
    v += __builtin_amdgcn_update_dpp(0, v, 0x4E, 0xf, 0xf, false);
    v += __builtin_amdgcn_update_dpp(0, v, 0x141, 0xf, 0xf, false);
    v += __builtin_amdgcn_update_dpp(0, v, 0x140, 0xf, 0xf, false);
    return __builtin_amdgcn_readlane(v, 0) + __builtin_amdgcn_readlane(v, 16) + __builtin_amdgcn_readlane(v, 32) + __builtin_amdgcn_readlane(v, 48);
}
DI int rowaddr(int p) { return (p & ~511) | ((p & 63) << 3) | ((p >> 6) & 7); }
typedef unsigned short us2_t __attribute__((ext_vector_type(2)));
DI unsigned dot2acc(unsigned flags, unsigned wts, unsigned acc) { return __builtin_amdgcn_udot2(__builtin_bit_cast(us2_t, flags), __builtin_bit_cast(us2_t, wts), acc, false); }
DI void keys_load(LAS u16* row, int N, int lane, u32x4 (&kr)[16]) {
    const int Nup = (N + 511) & ~511, niter = Nup >> 9;
    for (int p = N + lane; p < Nup; p += 64) row[rowaddr(p)] = (u16)0;
    wave_lds_sync();
#pragma unroll
    for (int i = 0; i < 16; ++i) { kr[i] = (u32x4){0u, 0u, 0u, 0u}; if (i < niter) kr[i] = *(LAS const u32x4*)(row + i * 512 + lane * 8); }
    wave_lds_sync();
}
DI void keys_select(const u32x4 (&kr)[16], LAS u16* list, int N, int lane) {
    const int Nup = (N + 511) & ~511, niter = Nup >> 9;
    const unsigned one = 0x00010001u;
    auto count_gt = [&](unsigned x) -> int {
        const unsigned xw = x | (x << 16);
        unsigned acc = 0u, acc1 = 0u, acc2 = 0u, acc3 = 0u;
#pragma unroll
        for (int c = 0; c < 4; ++c) {
            if (4 * c < niter) {
#pragma unroll
                for (int h = 0; h < 2; ++h) {
                    unsigned d[8];
#pragma unroll
                    for (int i = 0; i < 2; ++i) { const u32x4 kk = kr[4 * c + 2 * h + i]; d[4 * i] = pk_subs(kk.x, xw); d[4 * i + 1] = pk_subs(kk.y, xw); d[4 * i + 2] = pk_subs(kk.z, xw); d[4 * i + 3] = pk_subs(kk.w, xw); }
#pragma unroll
                    for (int i = 0; i < 8; ++i) d[i] = pk_min1(d[i], one);
#pragma unroll
                    for (int i = 0; i < 8; i += 4) { acc = dot2acc(d[i], one, acc); acc1 = dot2acc(d[i + 1], one, acc1); acc2 = dot2acc(d[i + 2], one, acc2); acc3 = dot2acc(d[i + 3], one, acc3); }
                }
            }
        }
        return wave_sum((int)((acc + acc1) + (acc2 + acc3)));
    };
    unsigned T = 0u; int cge = Nup, topbit = 15;
    {
        unsigned mx = 0u;
#pragma unroll
        for (int c = 0; c < 4; ++c) {
            if (4 * c < niter) {
#pragma unroll
                for (int i = 4 * c; i < 4 * c + 4; ++i) { mx = pk_max(mx, kr[i].x); mx = pk_max(mx, kr[i].y); mx = pk_max(mx, kr[i].z); mx = pk_max(mx, kr[i].w); }
            }
        }
        unsigned m1 = max(mx & 0xffffu, mx >> 16);
        m1 = max(m1, (unsigned)__builtin_amdgcn_update_dpp(0, (int)m1, 0xB1, 0xf, 0xf, false)); m1 = max(m1, (unsigned)__builtin_amdgcn_update_dpp(0, (int)m1, 0x4E, 0xf, 0xf, false));
        m1 = max(m1, (unsigned)__builtin_amdgcn_update_dpp(0, (int)m1, 0x141, 0xf, 0xf, false)); m1 = max(m1, (unsigned)__builtin_amdgcn_update_dpp(0, (int)m1, 0x140, 0xf, 0xf, false));
        const unsigned kmax = max(max((unsigned)__builtin_amdgcn_readlane((int)m1, 0), (unsigned)__builtin_amdgcn_readlane((int)m1, 16)), max((unsigned)__builtin_amdgcn_readlane((int)m1, 32), (unsigned)__builtin_amdgcn_readlane((int)m1, 48)));
        if (kmax > 1024u) {
            const unsigned lo1 = kmax - 255u;
            const int c1 = count_gt(lo1 - 1u);
            if (c1 >= 256) { T = lo1; cge = c1; topbit = 7; }
            else {
                const unsigned lo = kmax - 1023u;
                const int clo = count_gt(lo - 1u);
                if (clo >= 256) { T = lo; cge = clo; topbit = 9; }
            }
        }
    }
#pragma unroll 1
    for (int bit = topbit; bit >= 0; --bit) {
        const unsigned cand = topbit == 15 ? (T | (1u << bit)) : (T + (1u << bit));
        if (cand > 0xffffu) continue;
        const int cnt = count_gt(cand - 1u);
        if (cnt >= 256) { T = cand; cge = cnt; }
    }
    auto build = [&](unsigned x, unsigned (&M)[4]) {
        const unsigned xw = x | (x << 16);
#pragma unroll
        for (int c = 0; c < 4; ++c) {
            M[c] = 0u;
            if (4 * c < niter) {
#pragma unroll
                for (int i = 4 * c; i < 4 * c + 4; ++i) {
                    unsigned byte = dot2acc(pk_gt(kr[i].x, xw, one), 0x00020001u, 0u);
                    byte = dot2acc(pk_gt(kr[i].y, xw, one), 0x00080004u, byte);
                    byte = dot2acc(pk_gt(kr[i].z, xw, one), 0x00200010u, byte);
                    byte = dot2acc(pk_gt(kr[i].w, xw, one), 0x00800040u, byte);
                    M[c] |= byte << (8 * (i & 3));
                }
            }
        }
    };
    unsigned M[4];
    build(T - 1u, M);
    if (cge != 256) {
        unsigned G[4]; build(T, G);
        unsigned E[4];
#pragma unroll
        for (int c = 0; c < 4; ++c) E[c] = M[c] & ~G[c];
        const int need = 256 - (cge - wave_sum((int)(__builtin_popcount(E[0]) + __builtin_popcount(E[1]) + __builtin_popcount(E[2]) + __builtin_popcount(E[3]))));
        auto below = [&](int B, int c) -> unsigned { const int nb = B - 32 * c; return nb <= 0 ? 0u : (nb >= 32 ? 0xffffffffu : ((1u << nb) - 1u)); };
        auto ties_below = [&](int B) -> int {
            return wave_sum((int)(__builtin_popcount(E[0] & below(B, 0)) + __builtin_popcount(E[1] & below(B, 1)) + __builtin_popcount(E[2] & below(B, 2)) + __builtin_popcount(E[3] & below(B, 3))));
        };
        int lo = 0, hi = 127;
#pragma unroll 1
        while (lo < hi) { const int mid = (lo + hi) >> 1; if (ties_below(mid + 1) >= need) hi = mid; else lo = mid + 1; }
        const int Bs = lo, r = need - ties_below(Bs);
        const unsigned ew = Bs < 32 ? E[0] : (Bs < 64 ? E[1] : (Bs < 96 ? E[2] : E[3]));
        const bool tb = ((ew >> (Bs & 31)) & 1u) != 0u;
        const unsigned long long em = __ballot(tb);
        const bool take_row = tb && __builtin_popcountll(em & ((1ull << lane) - 1ull)) < r;
#pragma unroll
        for (int c = 0; c < 4; ++c) {
            unsigned tk = E[c] & below(Bs, c);
            if ((Bs >> 5) == c && take_row) tk |= 1u << (Bs & 31);
            M[c] = G[c] | tk;
        }
    }
    const int kl = __builtin_popcount(M[0]) + __builtin_popcount(M[1]) + __builtin_popcount(M[2]) + __builtin_popcount(M[3]);
    int wp = wave_incl_scan(kl, lane) - kl;
#pragma unroll
    for (int c = 0; c < 4; ++c) {
        unsigned m = M[c];
        while (m) { const int b = __builtin_ctz(m); list[wp] = (u16)((32 * c + b) * 64 + lane); ++wp; m &= m - 1u; }
    }
}

DI float max2f(float a, float b) { float r; asm("v_max_f32 %0, %1, %2" : "=v"(r) : "v"(a), "v"(b)); return r; }
DI float max8_mfma(const f32x4& a, const f32x4& b) {
    float r;
    asm("s_nop 7\n\tv_max3_f32 %0, %1, %2, %3\n\tv_max3_f32 %0, %0, %4, %5\n\tv_max3_f32 %0, %0, %6, %7\n\tv_max_f32 %0, %0, %8"
        : "=&v"(r) : "v"(a[0]), "v"(a[1]), "v"(a[2]), "v"(a[3]), "v"(b[0]), "v"(b[1]), "v"(b[2]), "v"(b[3]));
    return r;
}
DI float xmax_16_32(float x) {
    const unsigned xi = __float_as_uint(x);
    const auto r = __builtin_amdgcn_permlane16_swap(xi, xi, false, false);
    const unsigned mi = __float_as_uint(max2f(__uint_as_float(r[0]), __uint_as_float(r[1])));
    const auto q = __builtin_amdgcn_permlane32_swap(mi, mi, false, false);
    return max2f(__uint_as_float(q[0]), __uint_as_float(q[1]));
}
DI void attend(const Args& a, size_t brow, int t, int cnt, LAS const u16* list, LAS unsigned char* img, int lane, int fr, int fq) {
    const u16* Q = (const u16*)(a.ws + WS_Q); const u16* KVN = (const u16*)(a.ws + WS_KVN); u16* YO = (u16*)(a.ws + WS_YO);
    const float* qgbase = a.in[I_QNG]; asm volatile("" : "+s"(qgbase));
    bf16x8 qf[4];
    {
        const int head = fr & 7;
        const u16* qrow = Q + (brow + t) * 1024 + head * 128;
        float f[4][8]; float ss = 0.f;
#pragma unroll
        for (int ks = 0; ks < 4; ++ks) {
            const u32x4 raw = *(const u32x4*)(qrow + ks * 32 + 8 * fq);
            f[ks][0] = bflo(raw.x); f[ks][1] = bfhi(raw.x); f[ks][2] = bflo(raw.y); f[ks][3] = bfhi(raw.y); f[ks][4] = bflo(raw.z); f[ks][5] = bfhi(raw.z); f[ks][6] = bflo(raw.w); f[ks][7] = bfhi(raw.w);
#pragma unroll
            for (int j = 0; j < 8; ++j) ss += f[ks][j] * f[ks][j];
        }
        ss += __shfl_xor(ss, 16); ss += __shfl_xor(ss, 32);
        const float rq = __builtin_amdgcn_rsqf(ss * (1.0f / 128.0f) + EPS) * (0.08838834764831845f * 1.4426950408889634f);
#pragma unroll
        for (int ks = 0; ks < 4; ++ks) {
            const float* qg = qgbase + ks * 32 + 8 * fq;
            u32x4 w;
            w.x = pk2(f[ks][0] * rq * qg[0], f[ks][1] * rq * qg[1]); w.y = pk2(f[ks][2] * rq * qg[2], f[ks][3] * rq * qg[3]);
            w.z = pk2(f[ks][4] * rq * qg[4], f[ks][5] * rq * qg[5]); w.w = pk2(f[ks][6] * rq * qg[6], f[ks][7] * rq * qg[7]);
            qf[ks] = __builtin_bit_cast(bf16x8, w);
        }
    }
    const int nsteps = (cnt + 31) >> 5;
    f32x4 oacc[8];
#pragma unroll
    for (int i = 0; i < 8; ++i) oacc[i] = (f32x4){0.f, 0.f, 0.f, 0.f};
    float mrun = -3.0e38f;
    f32x4 lacc = {0.f, 0.f, 0.f, 0.f};
    const bf16x8 ones = {0x3F80, 0x3F80, 0x3F80, 0x3F80, 0x3F80, 0x3F80, 0x3F80, 0x3F80};
    const char* kvb = (const char*)(KVN + brow * 128);
    auto issue = [&](u32x4 (&pf)[8], int pp) {
#pragma unroll
        for (int it = 0; it < 8; ++it) { const int piece = it * 64 + lane; const unsigned key = list[pp * 32 + (piece >> 4)]; pf[it] = *(const u32x4*)(kvb + (key * 256u + 16u * (unsigned)(piece & 15))); }
    };
    auto step = [&](u32x4 (&pf)[8], int pp) {
#pragma unroll
        for (int it = 0; it < 8; ++it) { const int piece = it * 64 + lane; *(LAS u32x4*)(img + (piece >> 4) * 288 + (piece & 15) * 16) = pf[it]; }
        if (pp + 2 < nsteps) issue(pf, pp + 2);
        wave_lds_sync();
        __builtin_amdgcn_sched_barrier(0);
        f32x4 sa = {0.f, 0.f, 0.f, 0.f}, sb = {0.f, 0.f, 0.f, 0.f};
#pragma unroll
        for (int ks = 0; ks < 4; ++ks) {
            const bf16x8 a0 = *(LAS const bf16x8*)(img + fr * 288 + (ks * 32 + 8 * fq) * 2), a1 = *(LAS const bf16x8*)(img + (16 + fr) * 288 + (ks * 32 + 8 * fq) * 2);
            sa = __builtin_amdgcn_mfma_f32_16x16x32_bf16(a0, qf[ks], sa, 0, 0, 0); sb = __builtin_amdgcn_mfma_f32_16x16x32_bf16(a1, qf[ks], sb, 0, 0, 0);
            if (ks == 1) __builtin_amdgcn_sched_barrier(0);
        }
        if (pp * 32 + 32 > cnt) {
            const int pb0 = pp * 32 + 4 * fq;
#pragma unroll
            for (int r = 0; r < 4; ++r) { if (pb0 + r >= cnt) sa[r] = -3.0e38f; if (pb0 + 16 + r >= cnt) sb[r] = -3.0e38f; }
        }
        const float mx = xmax_16_32(max8_mfma(sa, sb));
        if (__ballot(mx > mrun) != 0ull) {
            const float mnew = max2f(mrun, mx), alpha = __builtin_amdgcn_exp2f(mrun - mnew);
            mrun = mnew; lacc *= alpha;
#pragma unroll
            for (int cb = 0; cb < 8; ++cb) oacc[cb] *= alpha;
        }
#pragma unroll
        for (int r = 0; r < 4; ++r) { sa[r] = __builtin_amdgcn_exp2f(sa[r] - mrun); sb[r] = __builtin_amdgcn_exp2f(sb[r] - mrun); }
        u32x4 pw; pw.x = pk2(sa[0], sa[1]); pw.y = pk2(sa[2], sa[3]); pw.z = pk2(sb[0], sb[1]); pw.w = pk2(sb[2], sb[3]);
        const bf16x8 pb = __builtin_bit_cast(bf16x8, pw);
        lacc = __builtin_amdgcn_mfma_f32_16x16x32_bf16(ones, pb, lacc, 0, 0, 0);
#pragma unroll
        for (int cb = 0; cb < 8; ++cb) {
            const s16x4 r0 = __builtin_amdgcn_ds_read_tr16_b64_v4i16((LAS s16x4*)(img + (4 * fq + (fr >> 2)) * 288 + (cb * 16 + 4 * (fr & 3)) * 2));
            const s16x4 r1 = __builtin_amdgcn_ds_read_tr16_b64_v4i16((LAS s16x4*)(img + (16 + 4 * fq + (fr >> 2)) * 288 + (cb * 16 + 4 * (fr & 3)) * 2));
            const bf16x8 av = {r0[0], r0[1], r0[2], r0[3], r1[0], r1[1], r1[2], r1[3]};
            oacc[cb] = __builtin_amdgcn_mfma_f32_16x16x32_bf16(av, pb, oacc[cb], 0, 0, 0);
            if (cb == 3) __builtin_amdgcn_sched_barrier(0);
        }
        wave_lds_sync();
    };
    u32x4 pf0[8], pf1[8];
    issue(pf0, 0);
    if (nsteps > 1) issue(pf1, 1);
#pragma unroll 1
    for (int pp = 0; pp < nsteps; pp += 2) {
        step(pf0, pp);
        if (pp + 1 < nsteps) step(pf1, pp + 1);
    }
    const float inv = __builtin_amdgcn_rcpf(lacc[0]);
    if (fr < 8) {
        u16* orow = YO + (brow + t) * 1536 + 512 + fr * 128 + 4 * fq;
#pragma unroll
        for (int cb = 0; cb < 8; ++cb) { u32x2 w; w.x = pk2(oacc[cb][0] * inv, oacc[cb][1] * inv); w.y = pk2(oacc[cb][2] * inv, oacc[cb][3] * inv); *(u32x2*)(orow + cb * 16) = w; }
    }
}

constexpr int N_CVT_JOBS = 32 * 16 * 32 + 32 * 16 * 16;
DI void cvt_job(const Args& a, LAS float* t, int J, int lane) {
    if (J >= N_CVT_JOBS) return;
    const float* src; const float* sk; unsigned char* dst; int ld, k0, n0, row;
    if (J < 16384) {
        const int e = J >> 9, w = J & 511; src = a.in[I_WE1] + (size_t)e * 1024 * 2048; ld = 2048; k0 = (w >> 5) * 64; n0 = (w & 31) * 64; sk = a.in[I_N2G]; dst = a.ws + WS_WE1 + (size_t)e * 2048 * 1024;
        const int n = n0 + lane, hi = n >= 1024 ? 1 : 0, q = n - hi * 1024; row = (q >> 7) * 256 + hi * 128 + (q & 127);
    } else {
        const int j = J - 16384, e = j >> 8, w = j & 255; src = a.in[I_WE2] + (size_t)e * 1024 * 1024; ld = 1024; k0 = (w >> 4) * 64; n0 = (w & 15) * 64; sk = nullptr; dst = a.ws + WS_WE2 + (size_t)e * 1024 * 1024;
        row = n0 + lane;
    }
    const int kl = lane >> 4, n4 = 4 * (lane & 15);
    f32x4 v[4][4];
#pragma unroll
    for (int ks = 0; ks < 4; ++ks)
#pragma unroll
        for (int i = 0; i < 4; ++i) v[ks][i] = __builtin_nontemporal_load((const f32x4*)(src + (size_t)(k0 + ks * 16 + kl + 4 * i) * ld + n0 + n4));
    unsigned char* drow = dst + (size_t)row * 1024 + k0;
#pragma unroll
    for (int ks = 0; ks < 4; ++ks) {
#pragma unroll
        for (int i = 0; i < 4; ++i) { const float sc = (sk ? sk[k0 + ks * 16 + kl + 4 * i] : 1.0f) * 64.0f; *(LAS f32x4*)(t + (kl + 4 * i) * 64 + n4) = v[ks][i] * sc; }
        wave_lds_sync();
        float c[16];
#pragma unroll
        for (int k = 0; k < 16; ++k) c[k] = t[k * 64 + lane];
        u32x4 w; w.x = pk4_fp8(c[0], c[1], c[2], c[3]); w.y = pk4_fp8(c[4], c[5], c[6], c[7]); w.z = pk4_fp8(c[8], c[9], c[10], c[11]); w.w = pk4_fp8(c[12], c[13], c[14], c[15]);
        *(u32x4*)(drow + ks * 16) = w;
        wave_lds_sync();
    }
}

constexpr int P3_CA = 155648, P3_CB = 155652, P3_TK = 155656;
DI void scores_dyn(const Args& a, LAS unsigned char* lds, size_t brow, int t0, unsigned tkbase, int lane, int fr, int fq) {
    unsigned char* ws = a.ws;
    LAS u16* rows = (LAS u16*)(lds + P3_ROWS);
    const unsigned char* QI = (const unsigned char*)(ws + WS_QI); const unsigned char* KIN = (const unsigned char*)(ws + WS_KIN); const float* WI = (const float*)(ws + WS_WI);
    typedef int i32x4_t __attribute__((ext_vector_type(4)));
    const int ntile = (t0 + 8 + 15) >> 4, nsets = (ntile + 3) >> 2;
    i32x4_t qa[2]; f32x4 wi[2];
#pragma unroll
    for (int rg = 0; rg < 2; ++rg) {
        qa[rg] = *(const i32x4_t*)(QI + (brow + t0 + 4 * rg + (fr >> 2)) * 256 + (fr & 3) * 64 + 16 * fq);
        wi[rg] = *(const f32x4*)(WI + (brow + t0 + 4 * rg + fq) * 4);
    }
    auto claim = [&]() -> int {
        unsigned t = 0u;
        if (lane == 0) t = __hip_atomic_fetch_add((LAS unsigned*)(lds + P3_TK), 1u, __ATOMIC_RELAXED, __HIP_MEMORY_SCOPE_WORKGROUP);
        return (int)((unsigned)__builtin_amdgcn_readfirstlane((int)t) - tkbase);
    };
    auto ldk = [&](i32x4_t (&kf)[4], int sidx) {
#pragma unroll
        for (int u = 0; u < 4; ++u) { const int jt = (4 * sidx + u) < ntile ? (4 * sidx + u) : (ntile - 1); kf[u] = *(const i32x4_t*)(KIN + (brow + jt * 16 + fr) * 64 + 16 * fq); }
    };
    auto cmpk = [&](const i32x4_t (&kf)[4], int sidx) {
#pragma unroll
        for (int u = 0; u < 4; ++u) {
            const int jt = 4 * sidx + u;
            if (jt < ntile) {
                float sc[2];
#pragma unroll
                for (int rg = 0; rg < 2; ++rg) {
                    i32x4_t d = {0, 0, 0, 0};
                    d = __builtin_amdgcn_mfma_i32_16x16x64_i8(qa[rg], kf[u], d, 0, 0, 0);
                    sc[rg] = (((float)max(d[0], 0) * wi[rg][0] + (float)max(d[1], 0) * wi[rg][1]) + (float)max(d[2], 0) * wi[rg][2]) + (float)max(d[3], 0) * wi[rg][3];
                }
                const unsigned kw = bf2keys(pk2(sc[0], sc[1]));
                const int ra = ((jt >> 5) << 9) | ((jt & 3) << 7) | ((jt >> 2) & 7);
                LAS u16* wp = rows + (fq * 16384 + fr * 8) + ra;
                wp[0] = (u16)kw; wp[8192] = (u16)(kw >> 16);
            }
        }
    };
    i32x4_t kA[4], kB[4];
    int sA = claim();
    if (sA < nsets) ldk(kA, sA);
    while (sA < nsets) {
        const int sB = claim();
        if (sB < nsets) ldk(kB, sB);
        cmpk(kA, sA);
        if (sB >= nsets) break;
        sA = claim();
        if (sA < nsets) ldk(kA, sA);
        cmpk(kB, sB);
    }
}
DI unsigned p3_sets(int t0) { return (unsigned)((((t0 + 8 + 15) >> 4) + 3) >> 2) + 8u; }

template <bool ROLE_A>
DI void dsa_loop(const Args& a, LAS unsigned char* lds, const int wid) {
    unsigned char* ws = a.ws; (void)ws;
    LAS u16* rows = (LAS u16*)(lds + P3_ROWS);
    volatile LAS unsigned* cnt = (volatile LAS unsigned*)(lds + P3_CA);
    bool bprev = false; size_t pbrow = 0; int pt0 = 0, bbuf = 0;
    unsigned tkbase = 0u; int trip = 0;
    if ((int)blockIdx.x < T / 8) {
        const int lane = otid() & 63, fr = lane & 15, fq = lane >> 4, gi = blockIdx.x, t0 = S - 8 - 8 * (gi >> 2);
        scores_dyn(a, lds, (size_t)(gi & 3) * S, t0, tkbase, lane, fr, fq);
        tkbase += p3_sets(t0);
    }
    for (int gi = blockIdx.x; gi < T / 8; gi += gridDim.x) {
        const int lane = otid() & 63, fr = lane & 15, fq = lane >> 4;
        const int b = gi & 3, t0 = S - 8 - 8 * (gi >> 2);
        const size_t brow = (size_t)b * S;
        __syncthreads();
        if constexpr (ROLE_A) {
            LAS u16* l0 = (LAS u16*)(lds + (bbuf ? P3_HIST : P3_LIST) + wid * 512);
#pragma unroll 1
            for (int qh = 0; qh < 2; ++qh) {
                u32x4 kr[16];
                const int Nq = t0 + wid + 1 + 4 * qh;
                LAS u16* lq = l0 + qh * 1024;
                if (Nq > 256) keys_load(rows + wid * 16384 + qh * 8192, Nq, lane, kr);
                if (qh == 0) __syncthreads();
                else { wave_lds_sync(); if (lane == 0) __hip_atomic_fetch_add((LAS unsigned*)(lds + P3_CA), 1u, __ATOMIC_RELAXED, __HIP_MEMORY_SCOPE_WORKGROUP); }
                if (Nq > 256) keys_select(kr, lq, Nq, lane); else { for (int p = lane; p < 256; p += 64) lq[p] = p < Nq ? (u16)p : (u16)0; }
            }
            {
                const int G3 = gridDim.x, c3 = blockIdx.x, it3 = (gi - c3) / G3, ntrip = (T / 8 - c3 + G3 - 1) / G3, jtot = (N_CVT_JOBS + 4 * G3 - 1) / (4 * G3);
                const int jlo = (jtot * it3 + ntrip - 1) / ntrip, jhi = (jtot * (it3 + 1) + ntrip - 1) / ntrip;
                LAS float* tcv = (LAS float*)(lds + (wid < 3 ? 135168 + wid * 4096 : 151552));
#pragma unroll 1
                for (int j = jlo; j < jhi; ++j) cvt_job(a, tcv, (j * 4 + wid) * G3 + c3, lane);
            }
        } else {
            __syncthreads();
            if (bprev) {
                LAS const u16* lp = (LAS const u16*)(lds + (bbuf ? P3_LIST : P3_HIST));
                LAS unsigned char* img = (LAS unsigned char*)(rows + (wid - 4) * 16384);
#pragma unroll 1
                for (int qh = 0; qh < 2; ++qh) { const int q = wid - 4 + 4 * qh, t = pt0 + q; attend(a, pbrow, t, t + 1 < 256 ? t + 1 : 256, lp + q * 256, img, lane, fr, fq); }
            }
            wave_lds_sync();
            if (lane == 0) __hip_atomic_fetch_add((LAS unsigned*)(lds + P3_CB), 1u, __ATOMIC_RELAXED, __HIP_MEMORY_SCOPE_WORKGROUP);
        }
        bprev = true; pbrow = brow; pt0 = t0; bbuf ^= 1; ++trip;
        const int gn = gi + gridDim.x;
        if (gn < T / 8) {
            { unsigned sp = 0u; while ((cnt[0] < 4u * (unsigned)trip || cnt[1] < 4u * (unsigned)trip) && ++sp < (1u << 22)) __builtin_amdgcn_s_sleep(1); }
            const int tn = S - 8 - 8 * (gn >> 2);
            scores_dyn(a, lds, (size_t)(gn & 3) * S, tn, tkbase, lane, fr, fq);
            tkbase += p3_sets(tn);
        }
    }
}

DI void dsa_phase(const Args& a, LAS unsigned char* lds) {
    const int wid = __builtin_amdgcn_readfirstlane(otid() >> 6);
    if (threadIdx.x < 3) ((volatile LAS unsigned*)(lds + P3_CA))[threadIdx.x] = 0u;
    __syncthreads();
    if (wid < 4) dsa_loop<true>(a, lds, wid); else dsa_loop<false>(a, lds, wid);
    __syncthreads();
    {
        const int ntrip = (T / 8 - (int)blockIdx.x + (int)gridDim.x - 1) / (int)gridDim.x;
        if (ntrip > 0) {
            const int gl = blockIdx.x + (ntrip - 1) * gridDim.x, pt0 = S - 8 - 8 * (gl >> 2);
            const size_t pbrow = (size_t)(gl & 3) * S;
            const int lane = otid() & 63, fr = lane & 15, fq = lane >> 4;
            LAS u16* rows = (LAS u16*)(lds + P3_ROWS);
            LAS const u16* lp = (LAS const u16*)(lds + ((ntrip & 1) ? P3_LIST : P3_HIST));
            const int q = wid, t = pt0 + q;
            attend(a, pbrow, t, t + 1 < 256 ? t + 1 : 256, lp + q * 256, (LAS unsigned char*)(rows + wid * 8192), lane, fr, fq);
        }
    }
}

constexpr int P6_LCNT = 0, P6_BASE = 128, P6_RSB = 256, P6_RI = 1024;
DI unsigned dpp_max_u32(unsigned v) {
    v = max(v, (unsigned)__builtin_amdgcn_update_dpp(0, (int)v, 0xB1, 0xf, 0xf, false));
    v = max(v, (unsigned)__builtin_amdgcn_update_dpp(0, (int)v, 0x4E, 0xf, 0xf, false));
    v = max(v, (unsigned)__builtin_amdgcn_update_dpp(0, (int)v, 0x141, 0xf, 0xf, false));
    v = max(v, (unsigned)__builtin_amdgcn_update_dpp(0, (int)v, 0x140, 0xf, 0xf, false));
    return v;
}
DI float key2f(unsigned k) { return __uint_as_float((k & 0x80000000u) ? (k & 0x7fffffffu) : ~k); }
DI void router_phase(const Args& a, LAS unsigned char* lds) {
    unsigned char* ws = a.ws;
    const int tid = otid(), wid = tid >> 6, lane = tid & 63, fr = lane & 15, fq = lane >> 4;
    LAS int* lcnt = (LAS int*)(lds + P6_LCNT); LAS int* lbase = (LAS int*)(lds + P6_BASE); LAS float* rsb = (LAS float*)(lds + P6_RSB); LAS int* RI = (LAS int*)(lds + P6_RI);
    const u16* WRH = (const u16*)(ws + WS_WR);
    unsigned* CNT = (unsigned*)(ws + WS_CTL);
    LAS unsigned char* WL = lds + 16384;
    __syncthreads();
    for (int i = tid; i < 64 * 128; i += NT) { const int r = i >> 7, p = i & 127; *(LAS u32x4*)(WL + r * 2064 + p * 16) = *(const u32x4*)(WRH + (size_t)r * 1024 + p * 8); }
    for (int rg = blockIdx.x; rg < T / 128; rg += gridDim.x) {
        __syncthreads();
        if (tid < 32) lcnt[tid] = 0;
        __syncthreads();
        {
            const int row = rg * 128 + wid * 16 + fr;
            const float* xr = a.out + (size_t)row * 1024 + 8 * fq;
            f32x4 acc[2] = {{0.f, 0.f, 0.f, 0.f}, {0.f, 0.f, 0.f, 0.f}};
            float ss = 0.f;
#pragma unroll 4
            for (int ks = 0; ks < 32; ++ks) {
                const f32x4 x0 = *(const f32x4*)(xr + ks * 32), x1 = *(const f32x4*)(xr + ks * 32 + 4);
                ss += ((x0[0] * x0[0] + x0[1] * x0[1]) + (x0[2] * x0[2] + x0[3] * x0[3])) + ((x1[0] * x1[0] + x1[1] * x1[1]) + (x1[2] * x1[2] + x1[3] * x1[3]));
                u32x4 hw; hw.x = pk2(x0[0], x0[1]); hw.y = pk2(x0[2], x0[3]); hw.z = pk2(x1[0], x1[1]); hw.w = pk2(x1[2], x1[3]);
                u32x4 lw; lw.x = pk2(x0[0] - bflo(hw.x), x0[1] - bfhi(hw.x)); lw.y = pk2(x0[2] - bflo(hw.y), x0[3] - bfhi(hw.y)); lw.z = pk2(x1[0] - bflo(hw.z), x1[1] - bfhi(hw.z)); lw.w = pk2(x1[2] - bflo(hw.w), x1[3] - bfhi(hw.w));
                const bf16x8 xh = __builtin_bit_cast(bf16x8, hw), xl = __builtin_bit_cast(bf16x8, lw);
#pragma unroll
                for (int nt = 0; nt < 2; ++nt) {
                    const bf16x8 wh = *(LAS const bf16x8*)(WL + (nt * 16 + fr) * 2064 + (ks * 32 + 8 * fq) * 2), wl = *(LAS const bf16x8*)(WL + (32 + nt * 16 + fr) * 2064 + (ks * 32 + 8 * fq) * 2);
                    acc[nt] = __builtin_amdgcn_mfma_f32_16x16x32_bf16(xh, wh, acc[nt], 0, 0, 0);
                    acc[nt] = __builtin_amdgcn_mfma_f32_16x16x32_bf16(xl, wh, acc[nt], 0, 0, 0);
                    acc[nt] = __builtin_amdgcn_mfma_f32_16x16x32_bf16(xh, wl, acc[nt], 0, 0, 0);
                }
            }
            ss += __shfl_xor(ss, 16); ss += __shfl_xor(ss, 32);
            const float rsrow = __builtin_amdgcn_rsqf(ss * (1.0f / 1024.0f) + EPS);
            if (fq == 0) rsb[wid * 16 + fr] = rsrow;
            {
                unsigned char* xn = ws + WS_XN2 + (size_t)row * 1024 + 8 * fq;
#pragma unroll 4
                for (int ks = 0; ks < 32; ++ks) {
                    const f32x4 x0 = *(const f32x4*)(xr + ks * 32), x1 = *(const f32x4*)(xr + ks * 32 + 4);
                    u32x2 w; w.x = pk4_fp8(x0[0] * rsrow, x0[1] * rsrow, x0[2] * rsrow, x0[3] * rsrow); w.y = pk4_fp8(x1[0] * rsrow, x1[1] * rsrow, x1[2] * rsrow, x1[3] * rsrow);
                    *(u32x2*)(xn + ks * 32) = w;
                }
            }
            wave_lds_sync();
            const float b0 = a.in[I_BR][fr], b1 = a.in[I_BR][16 + fr];
#pragma unroll
            for (int r = 0; r < 4; ++r) {
                const float rs = rsb[wid * 16 + 4 * fq + r];
                unsigned k0 = (f2key(acc[0][r] * rs + b0) & ~31u) | (unsigned)(31 - fr), k1 = (f2key(acc[1][r] * rs + b1) & ~31u) | (unsigned)(15 - fr);
                unsigned sel[4];
#pragma unroll
                for (int k = 0; k < 4; ++k) {
                    const unsigned best = dpp_max_u32(k0 > k1 ? k0 : k1);
                    sel[k] = best;
                    if (k0 == best) k0 = 0u;
                    if (k1 == best) k1 = 0u;
                }
                const float v0 = key2f(sel[0] & ~31u), e1 = __expf(key2f(sel[1] & ~31u) - v0), e2 = __expf(key2f(sel[2] & ~31u) - v0), e3 = __expf(key2f(sel[3] & ~31u) - v0);
                const float inv = 1.0f / (1.0f + e1 + e2 + e3);
                if (fr < 4) {
                    const unsigned sk = fr == 0 ? sel[0] : (fr == 1 ? sel[1] : (fr == 2 ? sel[2] : sel[3]));
                    const int e = 31 - (int)(sk & 31u);
                    const float gt = (fr == 0 ? 1.0f : (fr == 1 ? e1 : (fr == 2 ? e2 : e3))) * inv;
                    const int ls = __hip_atomic_fetch_add(lcnt + e, 1, __ATOMIC_RELAXED, __HIP_MEMORY_SCOPE_WORKGROUP);
                    const int ri = ((wid * 16 + 4 * fq + r) * 4 + fr) * 4;
                    RI[ri + 0] = e; RI[ri + 1] = ls; RI[ri + 2] = __float_as_int(gt);
                }
            }
        }
        __syncthreads();
        if (tid < 32) lbase[tid] = (int)__hip_atomic_fetch_add(CNT + tid, (unsigned)lcnt[tid], __ATOMIC_RELAXED, __HIP_MEMORY_SCOPE_AGENT);
        __syncthreads();
        {
            const int rl = tid >> 2, k = tid & 3, row = rg * 128 + rl;
            const int e = RI[tid * 4 + 0], slot = lbase[e] + RI[tid * 4 + 1];
            ((int*)(ws + WS_LTOK))[(size_t)e * ECAP + slot] = row;
            ((float*)(ws + WS_LRS))[(size_t)row * 4 + k] = __int_as_float(RI[tid * 4 + 2]);
            ((unsigned*)(ws + WS_ROUTE))[(size_t)row * 4 + k] = ((unsigned)e << 16) | (unsigned)slot;
        }
    }
}

DI void combine_phase(const Args& a, LAS unsigned char* lds) {
    unsigned char* ws = a.ws;
    LAS const int* tab = (LAS const int*)(lds + MOE_TAB);
    const int tid = otid(), wid = tid >> 6, lane = tid & 63;
    const u16* YB = (const u16*)(ws + WS_YB); const unsigned* ROUTE = (const unsigned*)(ws + WS_ROUTE);
    for (int row = blockIdx.x * 8 + wid; row < T; row += gridDim.x * 8) {
        size_t pos[4];
#pragma unroll
        for (int k = 0; k < 4; ++k) { const unsigned r = ROUTE[(size_t)row * 4 + k]; const int e = (int)(r >> 16), slot = (int)(r & 0xffffu); pos[k] = (size_t)tab[e] * 256 + slot; }
        float* orow = a.out + (size_t)row * 1024;
        const f32x4 gt = *(const f32x4*)((const float*)(ws + WS_LRS) + (size_t)row * 4);
#pragma unroll
        for (int i = 0; i < 4; ++i) {
            f32x4 v = *(const f32x4*)(orow + i * 256 + lane * 4);
#pragma unroll
            for (int k = 0; k < 4; ++k) { const u32x2 y = __builtin_nontemporal_load((const u32x2*)(YB + pos[k] * 1024 + i * 256 + lane * 4)); v[0] += gt[k] * bflo(y.x); v[1] += gt[k] * bfhi(y.x); v[2] += gt[k] * bflo(y.y); v[3] += gt[k] * bfhi(y.y); }
            *(f32x4*)(orow + i * 256 + lane * 4) = v;
        }
    }
}

#define XB_TMO      128
#define XB_XCNT(j)  (256  + 64 * (j))
#define XB_XSUB(j)  (1280 + 64 * (j))
#define XB_XGEN(j)  (2304 + 64 * (j))
#define XB_TOP      3328
#define XB_TOPGEN   3392
#define XCD_BAR_WORDS 3456
#define XB_SPIN_CAP (1u << 18)

__device__ __forceinline__ unsigned xb_ld(unsigned* p)              { return __hip_atomic_load(p, __ATOMIC_RELAXED, __HIP_MEMORY_SCOPE_AGENT); }
__device__ __forceinline__ unsigned xb_add(unsigned* p, unsigned v) { return __hip_atomic_fetch_add(p, v, __ATOMIC_RELAXED, __HIP_MEMORY_SCOPE_AGENT); }
__device__ __forceinline__ unsigned xb_xcc_id() { return (unsigned)__builtin_amdgcn_s_getreg((3 << 11) | 20) & 0xFu; }
#define XB_SPIN(cond, bar) do { unsigned _sp = 0; while (cond) { __builtin_amdgcn_s_sleep(1); \
    if ((++_sp & 255u) == 0u) { if (xb_ld(&(bar)[XB_TMO])) break; if (_sp > XB_SPIN_CAP) { atomicAdd(&(bar)[XB_TMO], 1u); break; } } } } while (0)

struct XcdBarrier {
    unsigned* bar; unsigned x;
    volatile LAS unsigned* st;
};

__device__ __forceinline__ XcdBarrier xcd_barrier_post(unsigned* bar, volatile LAS unsigned* st) {
    XcdBarrier b; b.bar = bar; b.x = xb_xcc_id(); b.st = st;
    if (threadIdx.x == 0) (void)xb_add(&bar[XB_XCNT(b.x)], 1u);
    return b;
}
__device__ __forceinline__ void xcd_barrier_complete(unsigned* bar, unsigned x, unsigned& nloc, unsigned& nx) {
    const unsigned G = gridDim.x * gridDim.y * gridDim.z;
    unsigned sum, cnt, mine, sp = 0u;
    for (;;) {
        sum = 0u; cnt = 0u; mine = 0u;
#pragma unroll
        for (unsigned j = 0; j < 16; ++j) { const unsigned c = xb_ld(&bar[XB_XCNT(j)]); sum += c; cnt += (c > 0u) ? 1u : 0u; mine = (j == x) ? c : mine; }
        if (sum == G) break;
        __builtin_amdgcn_s_sleep(1);
        if ((++sp & 255u) == 0u) { if (xb_ld(&bar[XB_TMO])) break; if (sp > XB_SPIN_CAP) { atomicAdd(&bar[XB_TMO], 1u); break; } }
    }
    nloc = mine > 0u ? mine : 1u; nx = cnt > 0u ? cnt : 1u;
}

__device__ __forceinline__ void xcd_barrier(const XcdBarrier& b) {
    asm volatile("s_waitcnt vmcnt(0)" ::: "memory");
    __syncthreads();
    if (threadIdx.x == 0) {
        unsigned* bar = b.bar;
        __builtin_amdgcn_s_waitcnt(0);
        unsigned nloc = b.st[0], nx = b.st[1];
        if (nloc == 0u) { xcd_barrier_complete(bar, b.x, nloc, nx); b.st[0] = nloc; b.st[1] = nx; }
        const unsigned old = xb_add(&bar[XB_XSUB(b.x)], 1u);
        const unsigned gen = old / nloc;
        if (old + 1u == (gen + 1u) * nloc) {
            __builtin_amdgcn_fence(__ATOMIC_RELEASE, "agent");
            asm volatile("s_waitcnt vmcnt(0)" ::: "memory");
            const unsigned og = xb_add(&bar[XB_TOP], 1u);
            const unsigned tg = og / nx;
            if (og + 1u == (tg + 1u) * nx) xb_add(&bar[XB_TOPGEN], 1u);
            else XB_SPIN(xb_ld(&bar[XB_TOPGEN]) == tg, bar);
            __builtin_amdgcn_fence(__ATOMIC_ACQUIRE, "agent");
            xb_add(&bar[XB_XGEN(b.x)], 1u);
            asm volatile("s_waitcnt vmcnt(0)" ::: "memory");
        } else {
            XB_SPIN(xb_ld(&bar[XB_XGEN(b.x)]) == gen, bar);
            __builtin_amdgcn_fence(__ATOMIC_ACQUIRE, "agent");
            asm volatile("s_waitcnt vmcnt(0)" ::: "memory");
        }
    }
    __syncthreads();
}

__global__ void __launch_bounds__(NT, 2) fwd(Args a) {
    extern __shared__ __attribute__((aligned(16))) unsigned char lds_raw[];
    LAS unsigned char* lds = (LAS unsigned char*)lds_raw;
    cg::grid_group grid = cg::this_grid();
    unsigned char* ws = a.ws;
    const int G = gridDim.x, c = blockIdx.x;
    if (threadIdx.x < 2) ((volatile LAS unsigned*)(lds + LDS_BARST))[threadIdx.x] = 0u;
    __syncthreads();
    const XcdBarrier xbar = xcd_barrier_post((unsigned*)(ws + WS_BAR), (volatile LAS unsigned*)(lds + LDS_BARST));

    phase0(a, lds);
    xcd_barrier(xbar);
    {
        g8::PlainSched s; s.Abase = (const char*)(ws + WS_XB); s.Bbase = (const char*)(ws + WS_WIN); s.lda = 1024; s.ldb = 1024; s.K = 1024; s.nM = T / 256; s.nN = NIN / 256; s.G = G; s.c = c;
        EpiIn e; e.H = (u16*)(ws + WS_H); e.rs1 = (const float*)(ws + WS_RS1); e.SSQ = (float*)(ws + WS_SSQ); e.WI = (float*)(ws + WS_WI);
        g8::gemm_phase(lds, s, e);
    }
    xcd_barrier(xbar);
    {
        g8::PlainSched s; s.Abase = (const char*)(ws + WS_H) + 1024 * 2; s.Bbase = (const char*)(ws + WS_WQ); s.lda = NIN; s.ldb = 256; s.K = 256; s.nM = T / 256; s.nN = 5; s.G = G; s.c = c;
        EpiQ e; e.Q = (u16*)(ws + WS_Q); e.QI = (u16*)(ws + WS_QI); e.SSQ = (const float*)(ws + WS_SSQ);
        g8::gemm_phase(lds, s, e);
        for (int u = c; u < 1024; u += G) gmlp_unit(a, lds, u);
        kvnorm(a);
    }
    xcd_barrier(xbar);
    dsa_phase(a, lds);
    xcd_barrier(xbar);
    {
        g8::PlainSched s; s.Abase = (const char*)(ws + WS_YO); s.Bbase = (const char*)(ws + WS_WCAT); s.lda = 1536; s.ldb = 1536; s.K = 512; s.nM = T / 256; s.nN = 4; s.G = G; s.c = c;
        EpiMrg<0> e0; e0.OUT = (u16*)(ws + WS_TMP); e0.TMP = nullptr; e0.H = (const u16*)(ws + WS_H);
        g8::gemm_phase(lds, s, e0);
        s.Abase = (const char*)(ws + WS_YO) + 512 * 2; s.Bbase = (const char*)(ws + WS_WCAT) + 512 * 2; s.K = 1024;
        EpiMrg<1> e1; e1.OUT = (u16*)(ws + WS_MRG); e1.TMP = (const u16*)(ws + WS_TMP); e1.H = (const u16*)(ws + WS_H);
        g8::gemm_phase(lds, s, e1);
    }
    xcd_barrier(xbar);
    {
        g8::PlainSched s; s.Abase = (const char*)(ws + WS_MRG); s.Bbase = (const char*)(ws + WS_WOUT); s.lda = 1024; s.ldb = 1024; s.K = 1024; s.nM = T / 256; s.nN = 4; s.G = G; s.c = c;
        EpiOut e; e.out = a.out; e.x = a.in[I_X];
        g8::gemm_phase(lds, s, e);
    }
    xcd_barrier(xbar);
    router_phase(a, lds);
    xcd_barrier(xbar);
    moe_table(lds, (const unsigned*)(ws + WS_CTL));
    {
        MoeSched<8, true> s; s.Abase = (const char*)(ws + WS_XN2); s.Wbase = (const char*)(ws + WS_WE1); s.LTOK = (const int*)(ws + WS_LTOK); s.tab = (LAS const int*)(lds + MOE_TAB);
        s.lda = 1024; s.ldb = 1024; s.K = 1024; s.G = G; s.c = c; s.wstride = (size_t)2048 * 1024;
        EpiMoe1 e; e.ACT = (unsigned char*)(ws + WS_ACT); e.b1 = a.in[I_BE1];
        g8::gemm_phase<true>(lds, s, e);
    }
    xcd_barrier(xbar);
    {
        MoeSched<4, false> s; s.Abase = (const char*)(ws + WS_ACT); s.Wbase = (const char*)(ws + WS_WE2); s.LTOK = nullptr; s.tab = (LAS const int*)(lds + MOE_TAB);
        s.lda = 1024; s.ldb = 1024; s.K = 1024; s.G = G; s.c = c; s.wstride = (size_t)1024 * 1024;
        EpiMoe2 e; e.YB = (u16*)(ws + WS_YB); e.b2 = a.in[I_BE2];
        g8::gemm_phase<true>(lds, s, e);
    }
    xcd_barrier(xbar);
    combine_phase(a, lds);
    if (a.mask == 0u) grid.sync();
}

extern "C" void kernel_launch(void* const* d_in, const int* in_sizes, int n_in, void* d_out, int out_size, void* d_ws, size_t ws_size, hipStream_t stream) {
    static int grid = 0;
    if (grid == 0) {
        int dev = 0, cus = 0, per_cu = 0;
        if (n_in != 23 || out_size != T * Dm || ws_size < WS_END) { fprintf(stderr, "kernel_launch: unexpected problem (n_in %d, out %d, ws %zu < %zu)\n", n_in, out_size, ws_size, (size_t)WS_END); grid = -1; return; }
        if (hipGetDevice(&dev) != hipSuccess || hipDeviceGetAttribute(&cus, hipDeviceAttributeMultiprocessorCount, dev) != hipSuccess) { grid = -1; return; }
        if (hipFuncSetAttribute((const void*)fwd, hipFuncAttributeMaxDynamicSharedMemorySize, LDS_BYTES) != hipSuccess) { fprintf(stderr, "hipFuncSetAttribute failed\n"); grid = -1; return; }
        if (hipOccupancyMaxActiveBlocksPerMultiprocessor(&per_cu, (const void*)fwd, NT, LDS_BYTES) != hipSuccess || per_cu < 1) { fprintf(stderr, "occupancy query failed (%d)\n", per_cu); grid = -1; return; }
        grid = cus;
        fprintf(stderr, "kernel_launch: cus %d per_cu %d grid %d ws %zu need %zu\n", cus, per_cu, grid, ws_size, (size_t)WS_END);
    }
    if (grid < 0) return;
    Args a{};
    for (int i = 0; i < 23; ++i) a.in[i] = (const float*)d_in[i];
    a.out = (float*)d_out; a.ws = (unsigned char*)d_ws; a.mask = 0xffffffffu; a.pad = 0u;
    if (hipMemsetAsync((char*)d_ws + WS_CTL, 0, 65536, stream) != hipSuccess) { fprintf(stderr, "memset failed\n"); return; }
    void* args[] = {&a};
    hipError_t e = hipLaunchCooperativeKernel((const void*)fwd, dim3(grid), dim3(NT), args, LDS_BYTES, stream);
    if (e != hipSuccess) fprintf(stderr, "cooperative launch failed: %s (grid %d)\n", hipGetErrorString(e), grid);
}
```

```cpp
#include <hip/hip_runtime.h>
#include <hip/hip_cooperative_groups.h>
#include <cstdio>
#include <cstdint>
namespace cg = cooperative_groups;

#define LAS __attribute__((address_space(3)))
#define DI __device__ __forceinline__
typedef unsigned short u16;
typedef short bf16x8 __attribute__((ext_vector_type(8)));
typedef short s16x4 __attribute__((ext_vector_type(4)));
typedef float f32x4 __attribute__((ext_vector_type(4)));
typedef float f32x2 __attribute__((ext_vector_type(2)));
typedef unsigned u32x4 __attribute__((ext_vector_type(4)));
typedef unsigned u32x2 __attribute__((ext_vector_type(2)));
typedef __bf16 bf2_t __attribute__((ext_vector_type(2)));
typedef int v8i_t __attribute__((ext_vector_type(8)));

constexpr int NT = 512;
constexpr int LDS_BYTES = 159744;
constexpr int Dm = 1024, Bsz = 4, S = 8192, T = Bsz * S;
constexpr int NIN = 3584;
constexpr int NE = 32, ECAP = 32768, PPAD = 131072 + NE * 256;
constexpr float EPS = 1e-6f;

constexpr size_t MiB = 1024 * 1024;
constexpr size_t WS_CTL = 0;
constexpr size_t WS_BAR = 16384;
constexpr int LDS_BARST = LDS_BYTES - 16;
constexpr size_t WS_WIN = 64 * 1024;
constexpr size_t WS_WQ = WS_WIN + (size_t)NIN * 1024 * 2;
constexpr size_t WS_WSP = WS_WQ + 1280 * 256 * 2;
constexpr size_t WS_WCAT = WS_WSP + 4 * 128 * 128 * 2;
constexpr size_t WS_WOUT = WS_WCAT + 1024 * 1536 * 2;
constexpr size_t WS_WR = WS_WOUT + 1024 * 1024 * 2;
constexpr size_t WS_WE1 = WS_WR + 32 * 1024 * 4;
constexpr size_t WS_WE2 = WS_WE1 + (size_t)32 * 2048 * 1024 * 2;
constexpr size_t WS_RS1 = WS_WE2 + (size_t)32 * 1024 * 1024 * 2;
constexpr size_t WS_SSQ = WS_RS1 + (size_t)T * 4;
constexpr size_t WS_WI = WS_SSQ + (size_t)T * 32 * 4;
constexpr size_t WS_ROUTE = WS_WI + (size_t)T * 4 * 4;
constexpr size_t WS_LTOK = WS_ROUTE + (size_t)T * 4 * 4;
constexpr size_t WS_LGATE = WS_LTOK + (size_t)NE * ECAP * 4;
constexpr size_t WS_LRS = WS_LGATE + (size_t)NE * ECAP * 4;
constexpr size_t WS_XN2 = WS_LRS + (size_t)NE * ECAP * 4;
constexpr size_t WS_R0 = WS_XN2 + (size_t)T * 1024 * 2;
constexpr size_t WS_XB = WS_R0;
constexpr size_t WS_H = WS_XB + (size_t)T * 1024 * 2;
constexpr size_t WS_Q = WS_H + (size_t)T * NIN * 2;
constexpr size_t WS_QI = WS_Q + (size_t)T * 1024 * 2;
constexpr size_t WS_KVN = WS_QI + (size_t)T * 256 * 2;
constexpr size_t WS_KIN = WS_KVN + (size_t)T * 128 * 2;
constexpr size_t WS_YO = WS_KIN + (size_t)T * 64 * 2;
constexpr size_t WS_TMP = WS_YO + (size_t)T * 1536 * 2;
constexpr size_t WS_MRG = WS_TMP + (size_t)T * 1024 * 2;
constexpr size_t WS_R0END = WS_MRG + (size_t)T * 1024 * 2;
constexpr size_t WS_ACT = WS_XB;
constexpr size_t WS_YB = WS_Q;
static_assert(WS_ACT + (size_t)PPAD * 1024 * 2 <= WS_Q, "ACT overlaps YB");
static_assert(WS_YB + (size_t)PPAD * 1024 * 2 <= WS_R0END, "YB too large");
constexpr size_t WS_X1B = WS_WE1 + (size_t)32 * 2048 * 1024;
constexpr size_t WS_G8 = WS_R0END;
constexpr size_t WS_WIN8 = WS_G8 + (size_t)T * 2048;
constexpr size_t WS_XB8 = WS_XN2 + (size_t)T * 1024;
constexpr size_t WS_END = WS_WIN8 + (size_t)2048 * 1024;

struct Args { const float* in[23]; float* out; unsigned char* ws; unsigned mask; unsigned pad; };
enum { I_X = 0, I_N1G, I_WIN, I_QLG, I_WUQ, I_QNG, I_KVG, I_WUV, I_WQI, I_KIG, I_VG, I_WSP, I_BSP, I_WPA, I_WPB, I_WOUT, I_N2G, I_WR, I_BR, I_WE1, I_BE1, I_WE2, I_BE2 };

DI unsigned pk2(float a, float b) { f32x2 v = {a, b}; bf2_t r = __builtin_convertvector(v, bf2_t); return __builtin_bit_cast(unsigned, r); }
DI unsigned pk4_fp8(float a, float b, float c, float d) { unsigned w = 0u; w = (unsigned)__builtin_amdgcn_cvt_pk_fp8_f32(a, b, (int)w, false); w = (unsigned)__builtin_amdgcn_cvt_pk_fp8_f32(c, d, (int)w, true); return w; }
DI unsigned pk4_i8(float a, float b, float c, float d) {
    const int ia = (int)__builtin_rintf(fminf(fmaxf(a * 32.0f, -127.0f), 127.0f)), ib = (int)__builtin_rintf(fminf(fmaxf(b * 32.0f, -127.0f), 127.0f));
    const int ic = (int)__builtin_rintf(fminf(fmaxf(c * 32.0f, -127.0f), 127.0f)), id = (int)__builtin_rintf(fminf(fmaxf(d * 32.0f, -127.0f), 127.0f));
    return (unsigned)(ia & 0xff) | ((unsigned)(ib & 0xff) << 8) | ((unsigned)(ic & 0xff) << 16) | ((unsigned)(id & 0xff) << 24);
}
DI float bflo(unsigned u) { return __uint_as_float(u << 16); }
DI float bfhi(unsigned u) { return __uint_as_float(u & 0xffff0000u); }
DI u16 f2bf(float f) { return (u16)(pk2(f, 0.f) & 0xffffu); }
DI float bf2f(u16 h) { return __uint_as_float(((unsigned)h) << 16); }
DI float sigmoidf_(float x) { return __builtin_amdgcn_rcpf(1.0f + __expf(-x)); }
DI float gelu_tanh(float x) { const float u = 1.5957691216057308f * (x + 0.044715f * x * x * x); return x * sigmoidf_(u); }
DI float fast_sigmoid(float x) { return __builtin_amdgcn_rcpf(1.0f + __builtin_amdgcn_exp2f(x * -1.4426950408889634f)); }
DI float fast_gelu(float x) { const float p = __builtin_fmaf(x * x, -0.10294324f, -2.3022082f); return x * __builtin_amdgcn_rcpf(1.0f + __builtin_amdgcn_exp2f(x * p)); }
DI int otid() { int t = threadIdx.x; asm volatile("" : "+v"(t)); return t; }
DI void wave_lds_sync() { asm volatile("s_waitcnt lgkmcnt(0)" ::: "memory"); }

namespace g8 {
constexpr int BM = 256, BK = 64, HALF = 128, HTB = HALF * BK * 2, STAGE_BYTES = 8 * HTB, NXCD = 8, WGM = 8;
DI int lds_byte(int r, int c) { const int st = (r >> 4) * 2 + (c >> 5), rr = r & 15, cc = c & 31, ob = rr * 64 + cc * 2; return st * 1024 + (ob ^ (((ob >> 9) & 1) << 5)); }
DI int perm32(int rho) { const int n = rho >> 4, i = rho & 15; return 8 * (i >> 2) + 4 * n + (i & 3); }
DI void stage_rc(int b, int& R, int& C) { const int st = b / 1024, sb = b % 1024, swz = sb ^ (((sb >> 9) & 1) << 5); R = (st >> 1) * 16 + swz / 64; C = (st & 1) * 32 + (swz % 64) / 2; }

struct UnitD { const char* Bp; int pm, pn, e, rb; };

DI bool static_tile(int i, int G, int c, int nM, int nN, int& pm, int& pn) {
    const int nwg = nM * nN; const long L = (long)i * G + c; if (L >= nwg) return false;
    int wgid = (int)L; { const int q = nwg / NXCD, r = nwg % NXCD, xcd = wgid % NXCD, off = wgid / NXCD; wgid = (xcd < r ? xcd * (q + 1) : r * (q + 1) + (xcd - r) * q) + off; }
    const int nig = WGM * nN, gid = wgid / nig, fm = gid * WGM, gsz = (nM - fm) < WGM ? (nM - fm) : WGM;
    pm = fm + ((wgid % nig) % gsz); pn = (wgid % nig) / gsz; return true;
}

struct PlainSched {
    const char* Abase; const char* Bbase; int lda, ldb, K, nM, nN, G, c; static constexpr int esz = 2;
    DI bool next(int i, UnitD& u) const { int pm, pn; if (!static_tile(i, G, c, nM, nN, pm, pn)) return false; u.pm = pm; u.pn = pn; u.e = 0; u.rb = 0; u.Bp = Bbase + (size_t)pn * BM * ldb * 2; return true; }
    DI void a_offs(const UnitD& u, int R0, int C0, unsigned (&o)[2][2]) const {
#pragma unroll
        for (int h = 0; h < 2; ++h)
#pragma unroll
            for (int i = 0; i < 2; ++i) o[h][i] = (unsigned)(((size_t)(u.pm * BM + h * HALF + R0 + 64 * i) * lda + C0) * 2);
    }
};

struct PlainSched8 {
    const char* Abase; const char* Bbase; int lda, ldb, K, nM, nN, G, c; static constexpr int esz = 1;
    DI int rowB() const { return ldb; }
    DI int kmulB() const { return 1; }
    DI bool next(int i, UnitD& u) const { int pm, pn; if (!static_tile(i, G, c, nM, nN, pm, pn)) return false; u.pm = pm; u.pn = pn; u.e = 0; u.rb = 0; u.Bp = Bbase + (size_t)pn * BM * ldb; return true; }
    DI void a_offs(const UnitD& u, int R0, int C0, unsigned (&o)[2][2]) const {
#pragma unroll
        for (int h = 0; h < 2; ++h)
#pragma unroll
            for (int i = 0; i < 2; ++i) o[h][i] = (unsigned)((size_t)(u.pm * BM + h * HALF + R0 + 64 * i) * lda + C0 * 2);
    }
};

template <bool FP8 = false, class Epi, class Sched>
DI void gemm_phase(LAS unsigned char* lds, const Sched& S, const Epi& E) {
    const int tid = otid(), wid = __builtin_amdgcn_readfirstlane(tid >> 6), lane = tid & 63, wr = wid >> 2, wc = wid & 3, fr = lane & 15, fq = lane >> 4;
    const int nt = S.K * Sched::esz / 128;
    int R0, C0; stage_rc(tid * 16, R0, C0);
    unsigned voffB[2];
#pragma unroll
    for (int i = 0; i < 2; ++i) { const int Rr = R0 + 64 * i, Rb = Epi::PERM ? ((Rr & ~31) + perm32(Rr & 31)) : Rr; voffB[i] = (unsigned)(Rb * S.ldb * Sched::esz + C0 * 2); }
    const size_t hstepB = (size_t)HALF * S.ldb * Sched::esz;
    const unsigned ldsw = (unsigned)wid * 1024u;
    const int aoff = lds_byte(wr * 64 + fr, fq * 8), boff = lds_byte(wc * 32 + fr, fq * 8);
    const unsigned mxscale = 0x7f7f7f7fu;
    const int kst = 1024;
    const char* Ab = S.Abase;
#define G8_SA(b, h) (((b) * 2 + (h)) * HTB)
#define G8_SB(b, h) ((4 + (b) * 2 + (h)) * HTB)
#define G8_STAGE_A(bufoff, offs, kb) do { _Pragma("unroll") for (int _i = 0; _i < 2; ++_i) \
        __builtin_amdgcn_global_load_lds((const unsigned*)(Ab + (size_t)(offs)[_i] + (size_t)(kb)), (LAS unsigned*)(lds + (bufoff) + ldsw + _i * 8192), 16, 0, 0); } while (0)
#define G8_STAGE_B(bufoff, gbase, kb) do { _Pragma("unroll") for (int _i = 0; _i < 2; ++_i) \
        __builtin_amdgcn_global_load_lds((const unsigned*)((gbase) + voffB[_i] + (size_t)(kb)), (LAS unsigned*)(lds + (bufoff) + ldsw + _i * 8192), 16, 0, 0); } while (0)
#define G8_LDA(dst, b, h) do { _Pragma("unroll") for (int m = 0; m < 4; ++m) { const i32x4_t _p = *(const LAS i32x4_t*)(lds + G8_SA(b, h) + aoff + m * 2048), _q = *(const LAS i32x4_t*)(lds + G8_SA(b, h) + aoff + m * 2048 + kst); dst[m] = __builtin_shufflevector(_p, _q, 0, 1, 2, 3, 4, 5, 6, 7); } } while (0)
#define G8_LDB(dst, b, h) do { _Pragma("unroll") for (int n = 0; n < 2; ++n) { const i32x4_t _p = *(const LAS i32x4_t*)(lds + G8_SB(b, h) + boff + n * 2048), _q = *(const LAS i32x4_t*)(lds + G8_SB(b, h) + boff + n * 2048 + kst); dst[n] = __builtin_shufflevector(_p, _q, 0, 1, 2, 3, 4, 5, 6, 7); } } while (0)
#define G8_MMA(ai, bj, At, Bt) do { __builtin_amdgcn_s_setprio(1); _Pragma("unroll") for (int m = 0; m < 4; ++m) _Pragma("unroll") for (int n = 0; n < 2; ++n) { \
        if constexpr (FP8) asm volatile("v_mfma_f32_16x16x128_f8f6f4 %0, %1, %2, %0" : "+v"(acc[ai][bj][m][n]) : "v"(Bt[n]), "v"(At[m]));     \
        else { acc[ai][bj][m][n] = __builtin_amdgcn_mfma_f32_16x16x32_bf16(__builtin_bit_cast(bf16x8, __builtin_shufflevector(Bt[n], Bt[n], 0, 1, 2, 3)), __builtin_bit_cast(bf16x8, __builtin_shufflevector(At[m], At[m], 0, 1, 2, 3)), acc[ai][bj][m][n], 0, 0, 0); \
               acc[ai][bj][m][n] = __builtin_amdgcn_mfma_f32_16x16x32_bf16(__builtin_bit_cast(bf16x8, __builtin_shufflevector(Bt[n], Bt[n], 4, 5, 6, 7)), __builtin_bit_cast(bf16x8, __builtin_shufflevector(At[m], At[m], 4, 5, 6, 7)), acc[ai][bj][m][n], 0, 0, 0); } } \
        __builtin_amdgcn_s_setprio(0); } while (0)
#define G8_WAIT_V(n) asm volatile("s_waitcnt vmcnt(" #n ")" ::: "memory")
#define G8_WAIT_L(n) asm volatile("s_waitcnt lgkmcnt(" #n ")" ::: "memory")
#define G8_BAR __builtin_amdgcn_s_barrier()
#define G8_SCHED __builtin_amdgcn_sched_barrier(0)
    UnitD cur, nxt; int ui = 0;
    if (!S.next(0, cur)) return;
    f32x4 acc[2][2][4][2];
#pragma unroll
    for (int a = 0; a < 2; ++a)
#pragma unroll
        for (int b = 0; b < 2; ++b)
#pragma unroll
            for (int m = 0; m < 4; ++m)
#pragma unroll
                for (int n = 0; n < 2; ++n) acc[a][b][m][n] = (f32x4){0.f, 0.f, 0.f, 0.f};
    typedef int i32x4_t __attribute__((ext_vector_type(4)));
    v8i_t At[4], B0[2], B1[2];
    unsigned cA[2][2];
    S.a_offs(cur, R0, C0, cA);
    const char* cB = cur.Bp;
    G8_STAGE_B(G8_SB(0, 0), cB, 0); G8_STAGE_A(G8_SA(0, 0), cA[0], 0); G8_STAGE_B(G8_SB(0, 1), cB + hstepB, 0); G8_STAGE_A(G8_SA(0, 1), cA[1], 0);
    if (wr == 1) G8_BAR;
    G8_WAIT_V(4); G8_BAR;
    G8_STAGE_B(G8_SB(1, 0), cB, 128); G8_STAGE_A(G8_SA(1, 0), cA[0], 128); G8_STAGE_B(G8_SB(1, 1), cB + hstepB, 128);
    G8_WAIT_V(6); G8_BAR;
    for (;;) {
        const bool has_next = S.next(ui + 1, nxt);
        const char* nB = has_next ? nxt.Bp : cB;
        for (int t = 0; t < nt; t += 2) {
            const bool last = (t == nt - 2);
            const unsigned k1 = (unsigned)(t + 1) * 128u;
            const unsigned k2 = last ? 0u : (unsigned)(t + 2) * 128u, k3 = k2 + 128u;
            unsigned c1[2] = {cA[1][0], cA[1][1]};
            if (last && has_next) S.a_offs(nxt, R0, C0, cA);
            const char* b2 = last ? nB : cB;
            G8_LDB(B0, 0, 0); G8_SCHED; G8_LDA(At, 0, 0); G8_STAGE_A(G8_SA(1, 1), c1, k1);
            G8_WAIT_L(8); G8_BAR; G8_WAIT_L(0); G8_MMA(0, 0, At, B0); G8_BAR; G8_SCHED;
            G8_LDB(B1, 0, 1); G8_STAGE_B(G8_SB(0, 0), b2, k2);
            G8_BAR; G8_WAIT_L(0); G8_MMA(0, 1, At, B1); G8_BAR;
            G8_LDA(At, 0, 1); G8_STAGE_A(G8_SA(0, 0), cA[0], k2);
            G8_BAR; G8_WAIT_L(0); G8_MMA(1, 0, At, B0); G8_BAR; G8_SCHED;
            G8_STAGE_B(G8_SB(0, 1), b2 + hstepB, k2);
            G8_WAIT_V(6); G8_BAR; G8_MMA(1, 1, At, B1); G8_BAR;
            G8_LDB(B0, 1, 0); G8_SCHED; G8_LDA(At, 1, 0); G8_STAGE_A(G8_SA(0, 1), cA[1], k2);
            G8_WAIT_L(8); G8_BAR; G8_WAIT_L(0); G8_MMA(0, 0, At, B0); G8_BAR; G8_SCHED;
            G8_LDB(B1, 1, 1); G8_STAGE_B(G8_SB(1, 0), b2, k3);
            G8_BAR; G8_WAIT_L(0); G8_MMA(0, 1, At, B1); G8_BAR;
            G8_LDA(At, 1, 1); G8_STAGE_A(G8_SA(1, 0), cA[0], k3);
            G8_BAR; G8_WAIT_L(0); G8_MMA(1, 0, At, B0); G8_BAR; G8_SCHED;
            G8_STAGE_B(G8_SB(1, 1), b2 + hstepB, k3);
            G8_WAIT_V(6); G8_BAR; G8_MMA(1, 1, At, B1); G8_BAR;
        }
        if constexpr (FP8) asm volatile("s_nop 15\n\ts_nop 15" ::: "memory");
        E(acc, cur, wr, wc, fr, fq);
        if (!has_next) break;
#pragma unroll
        for (int a = 0; a < 2; ++a)
#pragma unroll
            for (int b = 0; b < 2; ++b)
#pragma unroll
                for (int m = 0; m < 4; ++m)
#pragma unroll
                    for (int n = 0; n < 2; ++n) acc[a][b][m][n] = (f32x4){0.f, 0.f, 0.f, 0.f};
        cur = nxt; cB = nB; ++ui;
    }
    G8_WAIT_V(0);
    if (wr == 0) G8_BAR;
    G8_BAR;
#undef G8_SA
#undef G8_SB
#undef G8_STAGE_A
#undef G8_STAGE_B
#undef G8_LDA
#undef G8_LDB
#undef G8_MMA
#undef G8_WAIT_V
#undef G8_WAIT_L
#undef G8_BAR
#undef G8_SCHED
}
}
using g8::UnitD;
typedef f32x4 Acc[2][2][4][2];

struct EpiIn {
    static constexpr bool PERM = true;
    u16* H; const float* rs1; float* SSQ; float* WI; unsigned char* G8;
    template <int ACT, bool DOSSQ> DI void run(const Acc& acc, const UnitD& u, int wr, int wc, int fr, int fq) const {
        const int pn = u.pn;
#pragma unroll
        for (int ai = 0; ai < 2; ++ai)
#pragma unroll
            for (int m = 0; m < 4; ++m) {
                const int row = u.pm * 256 + ai * 128 + wr * 64 + m * 16 + fr;
#pragma unroll
                for (int bj = 0; bj < 2; ++bj) {
                    f32x4 v0 = acc[ai][bj][m][0], v1 = acc[ai][bj][m][1];
                    if (ACT == 1) {
#pragma unroll
                        for (int j = 0; j < 4; ++j) { v0[j] = fast_gelu(v0[j]); v1[j] = fast_gelu(v1[j]); }
                    } else if (ACT == 2) {
#pragma unroll
                        for (int j = 0; j < 4; ++j) { v0[j] = fast_sigmoid(v0[j]); v1[j] = fast_sigmoid(v1[j]); }
                    }
                    if (ACT == 2) {
                        u32x2 w8;
                        w8.x = (unsigned)__builtin_rintf(v0[0] * 255.0f) | ((unsigned)__builtin_rintf(v0[1] * 255.0f) << 8) | ((unsigned)__builtin_rintf(v0[2] * 255.0f) << 16) | ((unsigned)__builtin_rintf(v0[3] * 255.0f) << 24);
                        w8.y = (unsigned)__builtin_rintf(v1[0] * 255.0f) | ((unsigned)__builtin_rintf(v1[1] * 255.0f) << 8) | ((unsigned)__builtin_rintf(v1[2] * 255.0f) << 16) | ((unsigned)__builtin_rintf(v1[3] * 255.0f) << 24);
                        *(u32x2*)(G8 + (size_t)row * 2048 + (pn - 6) * 256 + bj * 128 + wc * 32 + 8 * fq) = w8;
                    } else {
                    u32x4 w; w.x = pk2(v0[0], v0[1]); w.y = pk2(v0[2], v0[3]); w.z = pk2(v1[0], v1[1]); w.w = pk2(v1[2], v1[3]);
                    *(u32x4*)(H + (size_t)row * NIN + pn * 256 + bj * 128 + wc * 32 + 8 * fq) = w;
                    }
                    if (DOSSQ) {
                        float ssq = ((v0[0] * v0[0] + v0[1] * v0[1]) + (v0[2] * v0[2] + v0[3] * v0[3])) + ((v1[0] * v1[0] + v1[1] * v1[1]) + (v1[2] * v1[2] + v1[3] * v1[3]));
                        ssq += __shfl_xor(ssq, 16); ssq += __shfl_xor(ssq, 32);
                        if (fq == 0) SSQ[(size_t)row * 32 + (pn - 2) * 8 + bj * 4 + wc] = ssq;
                        if (pn == 5 && bj == 1 && wc == 2 && fq == 0) *(f32x4*)(WI + (size_t)row * 4) = v0 * 0.5f;
                    }
                }
            }
    }
    DI void operator()(const Acc& acc, const UnitD& u, int wr, int wc, int fr, int fq) const {
        const int pn = u.pn;
        if (pn < 2) run<1, false>(acc, u, wr, wc, fr, fq);
        else if (pn < 4) run<1, true>(acc, u, wr, wc, fr, fq);
        else if (pn < 6) run<0, true>(acc, u, wr, wc, fr, fq);
        else run<2, false>(acc, u, wr, wc, fr, fq);
    }
};
struct EpiGate {
    static constexpr bool PERM = true;
    unsigned char* G8;
    DI void operator()(const Acc& acc, const UnitD& u, int wr, int wc, int fr, int fq) const {
#pragma unroll
        for (int ai = 0; ai < 2; ++ai)
#pragma unroll
            for (int m = 0; m < 4; ++m) {
                const int row = u.pm * 256 + ai * 128 + wr * 64 + m * 16 + fr;
                u32x4 w8;
#pragma unroll
                for (int bj = 0; bj < 2; ++bj) {
                    f32x4 v0 = acc[ai][bj][m][0] * 0.015625f, v1 = acc[ai][bj][m][1] * 0.015625f;
#pragma unroll
                    for (int j = 0; j < 4; ++j) { v0[j] = fast_sigmoid(v0[j]); v1[j] = fast_sigmoid(v1[j]); }
                    const unsigned lo = (unsigned)__builtin_rintf(v0[0] * 255.0f) | ((unsigned)__builtin_rintf(v0[1] * 255.0f) << 8) | ((unsigned)__builtin_rintf(v0[2] * 255.0f) << 16) | ((unsigned)__builtin_rintf(v0[3] * 255.0f) << 24);
                    const unsigned hi = (unsigned)__builtin_rintf(v1[0] * 255.0f) | ((unsigned)__builtin_rintf(v1[1] * 255.0f) << 8) | ((unsigned)__builtin_rintf(v1[2] * 255.0f) << 16) | ((unsigned)__builtin_rintf(v1[3] * 255.0f) << 24);
                    if (bj == 0) { w8.x = lo; w8.y = hi; } else { w8.z = lo; w8.w = hi; }
                }
                *(u32x4*)(G8 + (size_t)row * 2048 + u.pn * 256 + wc * 64 + fq * 16) = w8;
            }
    }
};
struct EpiQ {
    static constexpr bool PERM = true;
    u16* Q; u16* QI; const float* SSQ;
    DI void operator()(const Acc& acc, const UnitD& u, int wr, int wc, int fr, int fq) const {
        f32x4 sq[2][4][2];
#pragma unroll
        for (int ai = 0; ai < 2; ++ai)
#pragma unroll
            for (int m = 0; m < 4; ++m) { const int row = u.pm * 256 + ai * 128 + wr * 64 + m * 16 + fr; sq[ai][m][0] = *(const f32x4*)(SSQ + (size_t)row * 32 + 16); sq[ai][m][1] = *(const f32x4*)(SSQ + (size_t)row * 32 + 20); }
        __builtin_amdgcn_sched_barrier(0);
#pragma unroll
        for (int ai = 0; ai < 2; ++ai)
#pragma unroll
            for (int m = 0; m < 4; ++m) {
                const int row = u.pm * 256 + ai * 128 + wr * 64 + m * 16 + fr;
                const f32x4 s0 = sq[ai][m][0], s1 = sq[ai][m][1];
                const float ss = ((s0[0] + s0[1]) + (s0[2] + s0[3])) + ((s1[0] + s1[1]) + (s1[2] + s1[3]));
                const float rs = __builtin_amdgcn_rsqf(ss * (1.0f / 256.0f) + EPS);
#pragma unroll
                for (int bj = 0; bj < 2; ++bj) {
                    const int col = u.pn * 256 + bj * 128 + wc * 32 + 8 * fq;
                    const f32x4 v0 = acc[ai][bj][m][0] * rs, v1 = acc[ai][bj][m][1] * rs;
                    if (col < 1024) { u32x4 w; w.x = pk2(v0[0], v0[1]); w.y = pk2(v0[2], v0[3]); w.z = pk2(v1[0], v1[1]); w.w = pk2(v1[2], v1[3]); *(u32x4*)(Q + (size_t)row * 1024 + col) = w; }
                    else { u32x2 w; w.x = pk4_i8(v0[0], v0[1], v0[2], v0[3]); w.y = pk4_i8(v1[0], v1[1], v1[2], v1[3]); *(u32x2*)((unsigned char*)QI + (size_t)row * 256 + (col - 1024)) = w; }
                }
            }
    }
};
template <int SECOND> struct EpiMrg {
    static constexpr bool PERM = true;
    u16* OUT; const u16* TMP; const unsigned char* G8;
    DI void operator()(const Acc& acc, const UnitD& u, int wr, int wc, int fr, int fq) const {
        u32x4 gall[2][4];
#pragma unroll
        for (int ai = 0; ai < 2; ++ai)
#pragma unroll
            for (int m = 0; m < 4; ++m) gall[ai][m] = *(const u32x4*)(G8 + (size_t)(u.pm * 256 + ai * 128 + wr * 64 + m * 16 + fr) * 2048 + SECOND * 1024 + u.pn * 256 + wc * 64 + fq * 16);
#pragma unroll
        for (int ai = 0; ai < 2; ++ai) {
            u32x4 g[4]; u32x4 tp[4][2];
#pragma unroll
            for (int m = 0; m < 4; ++m)
#pragma unroll
                for (int bj = 0; bj < 2; ++bj) {
                    const int row = u.pm * 256 + ai * 128 + wr * 64 + m * 16 + fr, col = u.pn * 256 + bj * 128 + wc * 32 + 8 * fq;
                    if (bj == 0) g[m] = gall[ai][m];
                    if (SECOND) tp[m][bj] = *(const u32x4*)(TMP + (size_t)row * 1024 + col);
                }
            __builtin_amdgcn_sched_barrier(0);
#pragma unroll
            for (int m = 0; m < 4; ++m)
#pragma unroll
                for (int bj = 0; bj < 2; ++bj) {
                    const int row = u.pm * 256 + ai * 128 + wr * 64 + m * 16 + fr, col = u.pn * 256 + bj * 128 + wc * 32 + 8 * fq;
                    u32x2 gg; if (bj == 0) { gg.x = g[m].x; gg.y = g[m].y; } else { gg.x = g[m].z; gg.y = g[m].w; }
                    f32x4 v0 = acc[ai][bj][m][0] * (1.0f / 255.0f), v1 = acc[ai][bj][m][1] * (1.0f / 255.0f);
                    v0[0] *= (float)(gg.x & 255u); v0[1] *= (float)((gg.x >> 8) & 255u); v0[2] *= (float)((gg.x >> 16) & 255u); v0[3] *= (float)(gg.x >> 24);
                    v1[0] *= (float)(gg.y & 255u); v1[1] *= (float)((gg.y >> 8) & 255u); v1[2] *= (float)((gg.y >> 16) & 255u); v1[3] *= (float)(gg.y >> 24);
                    if (SECOND) { const u32x4 t = tp[m][bj];
                        v0[0] += bflo(t.x); v0[1] += bfhi(t.x); v0[2] += bflo(t.y); v0[3] += bfhi(t.y); v1[0] += bflo(t.z); v1[1] += bfhi(t.z); v1[2] += bflo(t.w); v1[3] += bfhi(t.w); }
                    if (SECOND) {
                        u32x2 w8; w8.x = pk4_fp8(v0[0] * 8.0f, v0[1] * 8.0f, v0[2] * 8.0f, v0[3] * 8.0f); w8.y = pk4_fp8(v1[0] * 8.0f, v1[1] * 8.0f, v1[2] * 8.0f, v1[3] * 8.0f);
                        *(u32x2*)((unsigned char*)OUT + (size_t)row * 1024 + col) = w8;
                    } else {
                        u32x4 w; w.x = pk2(v0[0], v0[1]); w.y = pk2(v0[2], v0[3]); w.z = pk2(v1[0], v1[1]); w.w = pk2(v1[2], v1[3]);
                        *(u32x4*)(OUT + (size_t)row * 1024 + col) = w;
                    }
                }
            __builtin_amdgcn_sched_barrier(0);
        }
    }
};
struct EpiOut {
    static constexpr bool PERM = true;
    u16* x1b; const u16* xb; const float* irs;
    DI void operator()(const Acc& acc, const UnitD& u, int wr, int wc, int fr, int fq) const {
#pragma unroll
        for (int ai = 0; ai < 2; ++ai) {
            u32x4 xv[4][2]; float ir[4];
#pragma unroll
            for (int m = 0; m < 4; ++m) {
                const size_t row = (size_t)(u.pm * 256 + ai * 128 + wr * 64 + m * 16 + fr);
                ir[m] = irs[row];
#pragma unroll
                for (int bj = 0; bj < 2; ++bj) xv[m][bj] = *(const u32x4*)(xb + row * 1024 + u.pn * 256 + bj * 128 + wc * 32 + 8 * fq);
            }
            __builtin_amdgcn_sched_barrier(0);
#pragma unroll
            for (int m = 0; m < 4; ++m)
#pragma unroll
                for (int bj = 0; bj < 2; ++bj) {
                    const u32x4 xx = xv[m][bj]; const float r = ir[m];
                    const f32x4 x0 = {bflo(xx.x) * r, bfhi(xx.x) * r, bflo(xx.y) * r, bfhi(xx.y) * r}, x1 = {bflo(xx.z) * r, bfhi(xx.z) * r, bflo(xx.w) * r, bfhi(xx.w) * r};
                    const f32x4 v0 = x0 + acc[ai][bj][m][0] * (1.0f / 512.0f), v1 = x1 + acc[ai][bj][m][1] * (1.0f / 512.0f);
                    u32x4 w; w.x = pk2(v0[0], v0[1]); w.y = pk2(v0[2], v0[3]); w.z = pk2(v1[0], v1[1]); w.w = pk2(v1[2], v1[3]);
                    *(u32x4*)(x1b + (size_t)(u.pm * 256 + ai * 128 + wr * 64 + m * 16 + fr) * 1024 + u.pn * 256 + bj * 128 + wc * 32 + 8 * fq) = w;
                }
            __builtin_amdgcn_sched_barrier(0);
        }
    }
};

constexpr int MOE_TAB = g8::STAGE_BYTES;
DI void moe_table(LAS unsigned char* lds, const unsigned* CNT) {
    LAS int* tab = (LAS int*)(lds + MOE_TAB);
    __syncthreads();
    if (threadIdx.x == 0) { int acc = 0; for (int e = 0; e < NE; ++e) { const int c = (int)__hip_atomic_load(CNT + e, __ATOMIC_RELAXED, __HIP_MEMORY_SCOPE_AGENT); tab[e] = acc; tab[33 + e] = c; acc += (c + 255) >> 8; } tab[32] = acc; }
    __syncthreads();
}
template <int NPN, bool GATHER> struct MoeSched {
    const char* Abase; const char* Wbase; const int* LTOK; LAS const int* tab; int lda, ldb, K, G, c; size_t wstride; static constexpr int esz = 1;
    DI bool next(int i, UnitD& u) const {
        const long L = (long)i * G + c; const int R = tab[32];
        if (L >= (long)R * NPN) return false;
        const int rbg = (int)(L / NPN), pn = (int)(L % NPN);
        int e = 0;
        for (int j = 1; j < NE; ++j) e += (tab[j] <= rbg) ? 1 : 0;
        e = __builtin_amdgcn_readfirstlane(e);
        u.pm = rbg; u.pn = pn; u.e = e; u.rb = rbg - tab[e];
        u.Bp = Wbase + (size_t)e * wstride + (size_t)pn * 256 * ldb * esz;
        return true;
    }
    DI void a_offs(const UnitD& u, int R0, int C0, unsigned (&o)[2][2]) const {
        const int cnt = tab[33 + u.e];
#pragma unroll
        for (int h = 0; h < 2; ++h)
#pragma unroll
            for (int i = 0; i < 2; ++i) {
                const int r = h * 128 + R0 + 64 * i;
                if (GATHER) { const int slot = u.rb * 256 + r; const int tok = slot < cnt ? LTOK[(size_t)u.e * ECAP + slot] : 0; o[h][i] = (unsigned)((size_t)tok * lda * esz + C0 * 2); }
                else o[h][i] = (unsigned)((size_t)(u.pm * 256 + r) * lda * esz + C0 * 2);
            }
    }
};
struct EpiMoe1 {
    static constexpr bool PERM = true;
    unsigned char* ACT; const float* b1;
    DI void operator()(const Acc& acc, const UnitD& u, int wr, int wc, int fr, int fq) const {
        const float* be = b1 + (size_t)u.e * 2048;
        const int hc = u.pn * 128 + wc * 32 + 8 * fq;
        const f32x4 bg0 = *(const f32x4*)(be + hc), bg1 = *(const f32x4*)(be + hc + 4), bu0 = *(const f32x4*)(be + 1024 + hc), bu1 = *(const f32x4*)(be + 1024 + hc + 4);
        __builtin_amdgcn_sched_barrier(0);
#pragma unroll
        for (int ai = 0; ai < 2; ++ai)
#pragma unroll
            for (int m = 0; m < 4; ++m) {
                const int row = u.pm * 256 + ai * 128 + wr * 64 + m * 16 + fr;
                float av[8];
#pragma unroll
                for (int n = 0; n < 2; ++n) {
                    const f32x4 g = acc[ai][0][m][n] * 0.015625f + (n ? bg1 : bg0), up = acc[ai][1][m][n] * 0.015625f + (n ? bu1 : bu0);
#pragma unroll
                    for (int j = 0; j < 4; ++j) {
                        const float hg = fminf(g[j], 7.0f), hu = __builtin_amdgcn_fmed3f(up[j], -7.0f, 7.0f);
                        av[4 * n + j] = (hu + 1.0f) * (hg * __builtin_amdgcn_rcpf(1.0f + __builtin_amdgcn_exp2f(hg * -2.4554669595930157f)));
                    }
                }
                u32x2 w; w.x = pk4_fp8(av[0], av[1], av[2], av[3]); w.y = pk4_fp8(av[4], av[5], av[6], av[7]);
                *(u32x2*)(ACT + (size_t)row * 1024 + hc) = w;
            }
    }
};
struct EpiMoe2 {
    static constexpr bool PERM = true;
    u16* YB; const float* b2;
    DI void operator()(const Acc& acc, const UnitD& u, int wr, int wc, int fr, int fq) const {
        const float* be = b2 + (size_t)u.e * 1024;
        f32x4 bias[2][2];
#pragma unroll
        for (int bj = 0; bj < 2; ++bj) { const int col = u.pn * 256 + bj * 128 + wc * 32 + 8 * fq; bias[bj][0] = *(const f32x4*)(be + col); bias[bj][1] = *(const f32x4*)(be + col + 4); }
        __builtin_amdgcn_sched_barrier(0);
#pragma unroll
        for (int ai = 0; ai < 2; ++ai)
#pragma unroll
            for (int m = 0; m < 4; ++m) {
                const int r = ai * 128 + wr * 64 + m * 16 + fr;
#pragma unroll
                for (int bj = 0; bj < 2; ++bj) {
                    const int col = u.pn * 256 + bj * 128 + wc * 32 + 8 * fq;
                    const f32x4 v0 = acc[ai][bj][m][0] * 0.015625f + bias[bj][0], v1 = acc[ai][bj][m][1] * 0.015625f + bias[bj][1];
                    u32x2 w; w.x = pk4_fp8(v0[0] * 16.0f, v0[1] * 16.0f, v0[2] * 16.0f, v0[3] * 16.0f); w.y = pk4_fp8(v1[0] * 16.0f, v1[1] * 16.0f, v1[2] * 16.0f, v1[3] * 16.0f);
                    *(u32x2*)((unsigned char*)YB + (size_t)(u.pm * 256 + r) * 1024 + col) = w;
                }
            }
    }
};

template <bool FP8 = false, class F> DI void tr_tile(LAS unsigned char* lds, const float* src, int ld_src, int Nsz, int k0, int n0, const float* sk, float mul, u16* dst, int ld_dst, F rowmap) {
    LAS float* t = (LAS float*)lds;
    const int tid = otid();
    __syncthreads();
#pragma unroll
    for (int it = 0; it < 2; ++it) {
        const int k = (tid >> 4) + 32 * it, n = 4 * (tid & 15);
        f32x4 v = {0.f, 0.f, 0.f, 0.f};
        if (n0 + n < Nsz) v = *(const f32x4*)(src + (size_t)(k0 + k) * ld_src + n0 + n);
        const float s = (sk ? sk[k0 + k] : 1.0f) * mul;
        t[k * 65 + n] = v[0] * s; t[k * 65 + n + 1] = v[1] * s; t[k * 65 + n + 2] = v[2] * s; t[k * 65 + n + 3] = v[3] * s;
    }
    __syncthreads();
    const int n = tid >> 3, kc = (tid & 7) * 8;
    if (FP8) {
        if (n0 + n < Nsz && rowmap(n0 + n) >= 0) {
            u32x2 w;
            w.x = pk4_fp8(t[(kc + 0) * 65 + n], t[(kc + 1) * 65 + n], t[(kc + 2) * 65 + n], t[(kc + 3) * 65 + n]);
            w.y = pk4_fp8(t[(kc + 4) * 65 + n], t[(kc + 5) * 65 + n], t[(kc + 6) * 65 + n], t[(kc + 7) * 65 + n]);
            *(u32x2*)((unsigned char*)dst + (size_t)rowmap(n0 + n) * ld_dst + k0 + kc) = w;
        }
    } else if (n0 + n < Nsz && rowmap(n0 + n) >= 0) {
        u32x4 w;
        w.x = pk2(t[(kc + 0) * 65 + n], t[(kc + 1) * 65 + n]); w.y = pk2(t[(kc + 2) * 65 + n], t[(kc + 3) * 65 + n]);
        w.z = pk2(t[(kc + 4) * 65 + n], t[(kc + 5) * 65 + n]); w.w = pk2(t[(kc + 6) * 65 + n], t[(kc + 7) * 65 + n]);
        *(u32x4*)(dst + (size_t)rowmap(n0 + n) * ld_dst + k0 + kc) = w;
    }
}
struct MapId { DI int operator()(int n) const { return n; } };
struct MapIn { DI int operator()(int n) const { return n < 1476 ? n : -1; } };
struct MapGate { DI int operator()(int n) const { return n >= 1476 ? n - 1476 : -1; } };
struct MapE1 { DI int operator()(int n) const { const int hi = n >= 1024 ? 1 : 0, q = n - hi * 1024; return (q >> 7) * 256 + hi * 128 + (q & 127); } };

DI void phase0(const Args& a, LAS unsigned char* lds) {
    unsigned char* ws = a.ws;
    const int tid = otid();
    const size_t gtid = (size_t)blockIdx.x * NT + tid, gstride = (size_t)gridDim.x * NT;
    for (size_t i = gtid; i < 60 * 1024 / 2; i += gstride) ((unsigned*)(ws + WS_WIN + (size_t)1476 * 1024 * 2))[i] = 0u;
    for (size_t i = gtid; i < 32 * 1024; i += gstride) { const int e = (int)(i >> 10), k = (int)(i & 1023); const float w = a.in[I_WR][k * 32 + e] * a.in[I_N2G][k]; const u16 h = f2bf(w); ((u16*)(ws + WS_WR))[i] = h; ((u16*)(ws + WS_WR))[32 * 1024 + i] = f2bf(w - bf2f(h)); }
    for (size_t i = gtid; i < 4 * 128 * 128; i += gstride) { const int tt = (int)((i >> 7) & 127), ss = (int)(i & 127); ((u16*)(ws + WS_WSP))[i] = f2bf(ss <= tt ? a.in[I_WSP][i] : 0.f); }
    {
        const int wid = tid >> 6, lane = tid & 63, rstride = gridDim.x * 8;
        for (int row0 = blockIdx.x * 8 + wid; row0 < T; row0 += 4 * rstride) {
            f32x4 xv[4][4];
#pragma unroll
            for (int r = 0; r < 4; ++r) {
                const int row = row0 + r * rstride < T ? row0 + r * rstride : row0;
                const float* xr = a.in[I_X] + (size_t)row * 1024;
#pragma unroll
                for (int i = 0; i < 4; ++i) xv[r][i] = __builtin_nontemporal_load((const f32x4*)(xr + i * 256 + lane * 4));
            }
#pragma unroll
            for (int r = 0; r < 4; ++r) {
                const int row = row0 + r * rstride;
                if (row < T) {
                    float ss = 0.f;
#pragma unroll
                    for (int i = 0; i < 4; ++i) ss += (xv[r][i][0] * xv[r][i][0] + xv[r][i][1] * xv[r][i][1]) + (xv[r][i][2] * xv[r][i][2] + xv[r][i][3] * xv[r][i][3]);
#pragma unroll
                    for (int o = 32; o >= 1; o >>= 1) ss += __shfl_xor(ss, o);
                    const float rs = __builtin_amdgcn_rsqf(ss * (1.0f / 1024.0f) + EPS);
                    u16* xb = (u16*)(ws + WS_XB) + (size_t)row * 1024; unsigned char* xb8 = ws + WS_XB8 + (size_t)row * 1024;
#pragma unroll
                    for (int i = 0; i < 4; ++i) {
                        u32x2 w; w.x = pk2(xv[r][i][0] * rs, xv[r][i][1] * rs); w.y = pk2(xv[r][i][2] * rs, xv[r][i][3] * rs); *(u32x2*)(xb + i * 256 + lane * 4) = w;
                        *(unsigned*)(xb8 + i * 256 + lane * 4) = pk4_fp8(xv[r][i][0] * rs, xv[r][i][1] * rs, xv[r][i][2] * rs, xv[r][i][3] * rs);
                    }
                    if (lane == 0) ((float*)(ws + WS_RS1))[row] = 1.0f / rs;
                }
            }
        }
    }
    constexpr int U_IN = 16 * 56, U_UQ = 4 * 16, U_QI = 4 * 4, U_PA = 8 * 16, U_OUT = 16 * 16, U_CB = 128;
    constexpr int U_TOT = U_IN + U_UQ + U_QI + U_PA + U_OUT + U_CB;
    for (int u = blockIdx.x; u < U_TOT; u += gridDim.x) {
        int v = u;
        if (v < U_IN) {
            const int n0 = (v >> 4) * 64;
            if (n0 < 1476) tr_tile(lds, a.in[I_WIN], 3524, 3524, (v & 15) * 64, n0, a.in[I_N1G], 1.0f, (u16*)(ws + WS_WIN), 1024, MapIn());
            if (n0 + 63 >= 1476) tr_tile<true>(lds, a.in[I_WIN], 3524, 3524, (v & 15) * 64, n0, a.in[I_N1G], 64.0f, (u16*)(ws + WS_WIN8), 1024, MapGate());
            continue;
        }
        v -= U_IN;
        if (v < U_UQ) { tr_tile(lds, a.in[I_WUQ], 1024, 1024, (v & 3) * 64, (v >> 2) * 64, a.in[I_QLG], 1.0f, (u16*)(ws + WS_WQ), 256, MapId()); continue; }
        v -= U_UQ;
        if (v < U_QI) { tr_tile(lds, a.in[I_WQI], 256, 256, (v & 3) * 64, (v >> 2) * 64, a.in[I_QLG], 1.0f, (u16*)(ws + WS_WQ) + 1024 * 256, 256, MapId()); continue; }
        v -= U_QI;
        if (v < U_PA) { tr_tile(lds, a.in[I_WPA], 1024, 1024, (v & 7) * 64, (v >> 3) * 64, nullptr, 1.0f, (u16*)(ws + WS_WCAT), 1536, MapId()); continue; }
        v -= U_PA;
        if (v < U_OUT) { tr_tile<true>(lds, a.in[I_WOUT], 1024, 1024, (v & 15) * 64, (v >> 4) * 64, nullptr, 64.0f, (u16*)(ws + WS_WOUT), 1024, MapId()); continue; }
        v -= U_OUT;
        {
            const int h = v >> 4, c0 = ((v >> 1) & 7) * 16, nn = (v & 1) * 512 + tid;
            LAS float* t = (LAS float*)lds;
            __syncthreads();
            for (int i = tid; i < 1024; i += NT) t[i] = a.in[I_WUV][(size_t)h * 128 * 64 + (size_t)c0 * 64 + i];
            __syncthreads();
            float accv[16];
#pragma unroll
            for (int i = 0; i < 16; ++i) accv[i] = 0.f;
            const float* pbp = a.in[I_WPB] + (size_t)(h * 64) * 1024 + nn;
#pragma unroll 2
            for (int vv = 0; vv < 64; vv += 4) {
                const float p0 = pbp[(size_t)(vv + 0) * 1024], p1 = pbp[(size_t)(vv + 1) * 1024], p2 = pbp[(size_t)(vv + 2) * 1024], p3 = pbp[(size_t)(vv + 3) * 1024];
#pragma unroll
                for (int i = 0; i < 16; ++i) { const f32x4 tv = *(LAS const f32x4*)(t + i * 64 + vv); accv[i] += ((tv[0] * p0 + tv[1] * p1) + (tv[2] * p2 + tv[3] * p3)); }
            }
            u32x4 w0, w1;
            w0.x = pk2(accv[0], accv[1]); w0.y = pk2(accv[2], accv[3]); w0.z = pk2(accv[4], accv[5]); w0.w = pk2(accv[6], accv[7]);
            w1.x = pk2(accv[8], accv[9]); w1.y = pk2(accv[10], accv[11]); w1.z = pk2(accv[12], accv[13]); w1.w = pk2(accv[14], accv[15]);
            u16* d = (u16*)(ws + WS_WCAT) + (size_t)nn * 1536 + 512 + h * 128 + c0;
            *(u32x4*)d = w0; *(u32x4*)(d + 8) = w1;
        }
    }
}

DI void gmlp_unit(const Args& a, LAS unsigned char* lds, int u) {
    unsigned char* ws = a.ws;
    const int tid = otid(), wid = tid >> 6, lane = tid & 63, fr = lane & 15, fq = lane >> 4;
    const int g = u & 3, row0 = (u >> 2) * 128;
    const u16* H = (const u16*)(ws + WS_H);
    LAS u16* img = (LAS u16*)lds;
    __syncthreads();
    {
        const int c = tid & 15;
        const f32x4 vg0 = *(const f32x4*)(a.in[I_VG] + 8 * c), vg1 = *(const f32x4*)(a.in[I_VG] + 8 * c + 4);
#pragma unroll
        for (int it = 0; it < 4; ++it) {
            const int s = (tid >> 4) + 32 * it;
            const f32x4 sq = *(const f32x4*)((const float*)(ws + WS_SSQ) + (size_t)(row0 + s) * 32 + g * 4);
            const float rs = __builtin_amdgcn_rsqf(((sq[0] + sq[1]) + (sq[2] + sq[3])) * (1.0f / 128.0f) + EPS);
            const u32x4 raw = *(const u32x4*)(H + (size_t)(row0 + s) * NIN + 512 + g * 128 + 8 * c);
            u32x4 w;
            w.x = pk2(bflo(raw.x) * rs * vg0[0], bfhi(raw.x) * rs * vg0[1]); w.y = pk2(bflo(raw.y) * rs * vg0[2], bfhi(raw.y) * rs * vg0[3]);
            w.z = pk2(bflo(raw.z) * rs * vg1[0], bfhi(raw.z) * rs * vg1[1]); w.w = pk2(bflo(raw.w) * rs * vg1[2], bfhi(raw.w) * rs * vg1[3]);
            *(LAS u32x4*)(img + s * 136 + 8 * c) = w;
        }
    }
    __syncthreads();
    const u16* W = (const u16*)(ws + WS_WSP) + (size_t)g * 128 * 128 + (size_t)(16 * wid + fr) * 128;
    f32x4 acc[8];
#pragma unroll
    for (int i = 0; i < 8; ++i) acc[i] = (f32x4){0.f, 0.f, 0.f, 0.f};
    const int nks = (16 * wid + 15) / 32 + 1;
    for (int ks = 0; ks < nks; ++ks) {
        const bf16x8 bw = *(const bf16x8*)(W + ks * 32 + 8 * fq);
#pragma unroll
        for (int i = 0; i < 8; ++i) {
            const s16x4 r0 = __builtin_amdgcn_ds_read_tr16_b64_v4i16((LAS s16x4*)(img + (ks * 32 + 8 * fq + (fr >> 2)) * 136 + 16 * i + 4 * (fr & 3)));
            const s16x4 r1 = __builtin_amdgcn_ds_read_tr16_b64_v4i16((LAS s16x4*)(img + (ks * 32 + 8 * fq + 4 + (fr >> 2)) * 136 + 16 * i + 4 * (fr & 3)));
            const bf16x8 av = {r0[0], r0[1], r0[2], r0[3], r1[0], r1[1], r1[2], r1[3]};
            acc[i] = __builtin_amdgcn_mfma_f32_16x16x32_bf16(av, bw, acc[i], 0, 0, 0);
        }
    }
    {
        const int t = 16 * wid + fr;
        const float bias = a.in[I_BSP][g * 128 + t];
        LAS float* sv = (LAS float*)(lds + 36864);
#pragma unroll
        for (int i = 0; i < 8; ++i) *(LAS f32x4*)(sv + t * 132 + 16 * i + 4 * fq) = acc[i] + bias;
    }
    __syncthreads();
    {
        const int c = tid & 15;
        LAS const float* sv = (LAS const float*)(lds + 36864);
        u16* YO = (u16*)(ws + WS_YO);
#pragma unroll
        for (int it = 0; it < 4; ++it) {
            const int tr = (tid >> 4) + 32 * it;
            const u32x4 uu = *(const u32x4*)(H + (size_t)(row0 + tr) * NIN + g * 128 + 8 * c);
            const f32x4 s0 = *(LAS const f32x4*)(sv + tr * 132 + 8 * c), s1 = *(LAS const f32x4*)(sv + tr * 132 + 8 * c + 4);
            u32x4 w;
            w.x = pk2(bflo(uu.x) * s0[0], bfhi(uu.x) * s0[1]); w.y = pk2(bflo(uu.y) * s0[2], bfhi(uu.y) * s0[3]);
            w.z = pk2(bflo(uu.z) * s1[0], bfhi(uu.z) * s1[1]); w.w = pk2(bflo(uu.w) * s1[2], bfhi(uu.w) * s1[3]);
            *(u32x4*)(YO + (size_t)(row0 + tr) * 1536 + g * 128 + 8 * c) = w;
        }
    }
}

DI void kvnorm(const Args& a) {
    unsigned char* ws = a.ws;
    const u16* H = (const u16*)(ws + WS_H); const float* SSQ = (const float*)(ws + WS_SSQ);
    const size_t gtid = (size_t)blockIdx.x * NT + otid(), gstride = (size_t)gridDim.x * NT;
    for (size_t idx = gtid; idx < (size_t)T * 24; idx += gstride) {
        const int row = (int)(idx / 24), c = (int)(idx % 24);
        const u16* src; u16* dst; const float* gain; float rs;
        if (c < 16) {
            const f32x4 sq = *(const f32x4*)(SSQ + (size_t)row * 32 + 24);
            rs = __builtin_amdgcn_rsqf(((sq[0] + sq[1]) + (sq[2] + sq[3])) * (1.0f / 128.0f) + EPS);
            src = H + (size_t)row * NIN + 1280 + 8 * c; dst = (u16*)(ws + WS_KVN) + (size_t)row * 128 + 8 * c; gain = a.in[I_KVG] + 8 * c;
        } else {
            const int cc = c - 16;
            rs = __builtin_amdgcn_rsqf((SSQ[(size_t)row * 32 + 28] + SSQ[(size_t)row * 32 + 29]) * (1.0f / 64.0f) + EPS);
            src = H + (size_t)row * NIN + 1408 + 8 * cc; dst = nullptr; gain = a.in[I_KIG] + 8 * cc;
            const u32x4 raw = *(const u32x4*)src;
            u32x2 w8;
            w8.x = pk4_i8(bflo(raw.x) * rs * gain[0], bfhi(raw.x) * rs * gain[1], bflo(raw.y) * rs * gain[2], bfhi(raw.y) * rs * gain[3]);
            w8.y = pk4_i8(bflo(raw.z) * rs * gain[4], bfhi(raw.z) * rs * gain[5], bflo(raw.w) * rs * gain[6], bfhi(raw.w) * rs * gain[7]);
            *(u32x2*)(ws + WS_KIN + (size_t)row * 64 + 8 * cc) = w8;
            continue;
        }
        const u32x4 raw = *(const u32x4*)src;
        u32x4 w;
        w.x = pk2(bflo(raw.x) * rs * gain[0], bfhi(raw.x) * rs * gain[1]); w.y = pk2(bflo(raw.y) * rs * gain[2], bfhi(raw.y) * rs * gain[3]);
        w.z = pk2(bflo(raw.z) * rs * gain[4], bfhi(raw.z) * rs * gain[5]); w.w = pk2(bflo(raw.w) * rs * gain[6], bfhi(raw.w) * rs * gain[7]);
        *(u32x4*)dst = w;
    }
}

constexpr int P3_ROWS = 0, P3_HIST = 131072, P3_LIST = 147456;
DI unsigned bf2keys(unsigned b) {
    unsigned m; asm("v_pk_ashrrev_i16 %0, %1, %2" : "=v"(m) : "v"(0x000f000fu), "v"(b));
    return b ^ (m | 0x80008000u);
}
DI unsigned f2key(float f) { const unsigned u = __float_as_uint(f); return (u & 0x80000000u) ? ~u : (u | 0x80000000u); }
DI int wave_incl_scan(int v, int lane) {
#pragma unroll
    for (int o = 1; o < 64; o <<= 1) { const int t = __shfl_up(v, o); if (lane >= o) v += t; }
    return v;
}
DI int wave_suffix_scan(int v, int lane) {
#pragma unroll
    for (int o = 1; o < 64; o <<= 1) { const int t = __shfl_down(v, o); if (lane + o < 64) v += t; }
    return v;
}
DI unsigned pk_gt(unsigned kw, unsigned xw, unsigned one) {
    unsigned d, m;
    asm("v_pk_sub_u16 %0, %1, %2 clamp" : "=v"(d) : "v"(kw), "v"(xw));
    asm("v_pk_min_u16 %0, %1, %2" : "=v"(m) : "v"(d), "v"(one));
    return m;
}
DI unsigned pk_subs(unsigned kw, unsigned xw) { unsigned d; asm("v_pk_sub_u16 %0, %1, %2 clamp" : "=v"(d) : "v"(kw), "v"(xw)); return d; }
DI unsigned pk_min1(unsigned d, unsigned one) { unsigned m; asm("v_pk_min_u16 %0, %1, %2" : "=v"(m) : "v"(d), "v"(one)); return m; }
DI unsigned pk_max(unsigned a, unsigned b) { unsigned r; asm("v_pk_max_u16 %0, %1, %2" : "=v"(r) : "v"(a), "v"(b)); return r; }
DI unsigned pk_add(unsigned a, unsigned b) { unsigned r; asm("v_pk_add_u16 %0, %1, %2" : "=v"(r) : "v"(a), "v"(b)); return r; }
DI int wave_sum(int v) {
    v += __builtin_amdgcn_update_dpp(0, v, 0xB1, 0xf, 0xf, false);
    v += __builtin_amdgcn_update_dpp(0, v, 0x4E, 0xf, 0xf, false);
    v += __builtin_amdgcn_update_dpp(0, v, 0x141, 0xf, 0xf, false);
    v += __builtin_amdgcn_update_dpp(0, v, 0x140, 0xf, 0xf, false);
    return __builtin_amdgcn_readlane(v, 0) + __builtin_amdgcn_readlane(v, 16) + __builtin_amdgcn_readlane(v, 32) + __builtin_amdgcn_readlane(v, 48);
}
DI int rowaddr(int p) { return (p & ~511) | ((p & 63) << 3) | ((p >> 6) & 7); }
typedef unsigned short us2_t __attribute__((ext_vector_type(2)));
DI unsigned dot2acc(unsigned flags, unsigned wts, unsigned acc) { return __builtin_amdgcn_udot2(__builtin_bit_cast(us2_t, flags), __builtin_bit_cast(us2_t, wts), acc, false); }
DI void keys_load(LAS u16* row, int N, int lane, u32x4 (&kr)[16]) {
    const int Nup = (N + 511) & ~511, niter = Nup >> 9;
    for (int p = N + lane; p < Nup; p += 64) row[rowaddr(p)] = (u16)0;
    wave_lds_sync();
#pragma unroll
    for (int i = 0; i < 16; ++i) { kr[i] = (u32x4){0u, 0u, 0u, 0u}; if (i < niter) kr[i] = *(LAS const u32x4*)(row + i * 512 + lane * 8); }
    wave_lds_sync();
}
DI void keys_select(const u32x4 (&kr)[16], LAS u16* list, int N, int lane) {
    const int Nup = (N + 511) & ~511, niter = Nup >> 9;
    unsigned P[4][16];
#pragma unroll
    for (int c = 0; c < 4; ++c) {
#pragma unroll
        for (int m = 0; m < 16; ++m) P[c][m] = kr[4 * c + (m >> 2)][m & 3];
        if (4 * c < niter) {
#pragma unroll
            for (int st = 0; st < 4; ++st) {
                const int sh = 1 << st; const unsigned Ms = st == 0 ? 0x55555555u : (st == 1 ? 0x33333333u : (st == 2 ? 0x0F0F0F0Fu : 0x00FF00FFu));
#pragma unroll
                for (int m = 0; m < 16; ++m) {
                    if (m & sh) continue;
                    const unsigned x = P[c][m], y = P[c][m + sh];
                    P[c][m] = (x & Ms) | ((y << sh) & ~Ms);
                    P[c][m + sh] = ((x >> sh) & Ms) | (y & ~Ms);
                }
            }
        }
    }
    unsigned eq[4], gt[4];
#pragma unroll
    for (int c = 0; c < 4; ++c) { eq[c] = 4 * c < niter ? 0xffffffffu : 0u; gt[c] = 0u; }
    int G = 0;
#pragma unroll
    for (int t = 15; t >= 0; --t) {
        unsigned c1[4]; int cnt = 0;
#pragma unroll
        for (int c = 0; c < 4; ++c) { c1[c] = eq[c] & P[c][t]; cnt += __builtin_popcount(c1[c]); }
        const int tot = wave_sum(cnt);
        if (G + tot >= 256) {
#pragma unroll
            for (int c = 0; c < 4; ++c) eq[c] = c1[c];
        } else {
#pragma unroll
            for (int c = 0; c < 4; ++c) { gt[c] |= c1[c]; eq[c] ^= c1[c]; }
            G += tot;
        }
    }
    const int cge = G + wave_sum((int)(__builtin_popcount(eq[0]) + __builtin_popcount(eq[1]) + __builtin_popcount(eq[2]) + __builtin_popcount(eq[3])));
    unsigned M[4];
#pragma unroll
    for (int c = 0; c < 4; ++c) M[c] = gt[c] | eq[c];
    if (cge != 256) {
        const int need = 256 - G;
        auto below = [&](int B, int c) -> unsigned {
            const int nb = B - 32 * c;
            if (nb <= 0) return 0u;
            if (nb >= 32) return 0xffffffffu;
            return ((1u << ((nb + 1) >> 1)) - 1u) | (((1u << (nb >> 1)) - 1u) << 16);
        };
        auto ties_below = [&](int B) -> int {
            return wave_sum((int)(__builtin_popcount(eq[0] & below(B, 0)) + __builtin_popcount(eq[1] & below(B, 1)) + __builtin_popcount(eq[2] & below(B, 2)) + __builtin_popcount(eq[3] & below(B, 3))));
        };
        int lo = 0, hi = 127;
#pragma unroll 1
        while (lo < hi) { const int mid = (lo + hi) >> 1; if (ties_below(mid + 1) >= need) hi = mid; else lo = mid + 1; }
        const int Bs = lo, r = need - ties_below(Bs);
        const unsigned ew = Bs < 32 ? eq[0] : (Bs < 64 ? eq[1] : (Bs < 96 ? eq[2] : eq[3]));
        const int bl = Bs & 31, pb = 16 * (bl & 1) + (bl >> 1);
        const bool tb = ((ew >> pb) & 1u) != 0u;
        const unsigned long long em = __ballot(tb);
        const bool take_row = tb && __builtin_popcountll(em & ((1ull << lane) - 1ull)) < r;
#pragma unroll
        for (int c = 0; c < 4; ++c) {
            unsigned tk = eq[c] & below(Bs, c);
            if ((Bs >> 5) == c && take_row) tk |= 1u << pb;
            M[c] = gt[c] | tk;
        }
    }
    const int kl = __builtin_popcount(M[0]) + __builtin_popcount(M[1]) + __builtin_popcount(M[2]) + __builtin_popcount(M[3]);
    int wp = wave_incl_scan(kl, lane) - kl;
#pragma unroll
    for (int c = 0; c < 4; ++c) {
        unsigned m = M[c];
        while (m) { const int p = __builtin_ctz(m); list[wp] = (u16)((32 * c + 2 * (p & 15) + (p >> 4)) * 64 + lane); ++wp; m &= m - 1u; }
    }
}

DI float max2f(float a, float b) { float r; asm("v_max_f32 %0, %1, %2" : "=v"(r) : "v"(a), "v"(b)); return r; }
DI float max8_mfma(const f32x4& a, const f32x4& b) {
    float r;
    asm("s_nop 7\n\tv_max3_f32 %0, %1, %2, %3\n\tv_max3_f32 %0, %0, %4, %5\n\tv_max3_f32 %0, %0, %6, %7\n\tv_max_f32 %0, %0, %8"
        : "=&v"(r) : "v"(a[0]), "v"(a[1]), "v"(a[2]), "v"(a[3]), "v"(b[0]), "v"(b[1]), "v"(b[2]), "v"(b[3]));
    return r;
}
DI float xmax_16_32(float x) {
    const unsigned xi = __float_as_uint(x);
    const auto r = __builtin_amdgcn_permlane16_swap(xi, xi, false, false);
    const unsigned mi = __float_as_uint(max2f(__uint_as_float(r[0]), __uint_as_float(r[1])));
    const auto q = __builtin_amdgcn_permlane32_swap(mi, mi, false, false);
    return max2f(__uint_as_float(q[0]), __uint_as_float(q[1]));
}
DI float kv_gain_max(const Args& a, int lane) {
    const float* kg = a.in[I_KVG];
    float gm = fmaxf(fabsf(kg[lane]), fabsf(kg[64 + lane]));
    gm = fmaxf(gm, __shfl_xor(gm, 1)); gm = fmaxf(gm, __shfl_xor(gm, 2)); gm = fmaxf(gm, __shfl_xor(gm, 4)); gm = fmaxf(gm, __shfl_xor(gm, 8)); gm = fmaxf(gm, __shfl_xor(gm, 16)); gm = fmaxf(gm, __shfl_xor(gm, 32));
    return gm;
}
DI void attend(const Args& a, size_t brow, int t, int cnt, LAS const u16* list, LAS unsigned char* img, int lane, int fr, int fq, float gm) {
    const u16* Q = (const u16*)(a.ws + WS_Q); const u16* KVN = (const u16*)(a.ws + WS_KVN); u16* YO = (u16*)(a.ws + WS_YO);
    const float* qgbase = a.in[I_QNG];
    bf16x8 qf[4];
    float mshift;
    {
        const int head = fr & 7;
        const u16* qrow = Q + (brow + t) * 1024 + head * 128;
        float f[4][8]; float ss = 0.f;
#pragma unroll
        for (int ks = 0; ks < 4; ++ks) {
            const u32x4 raw = *(const u32x4*)(qrow + ks * 32 + 8 * fq);
            f[ks][0] = bflo(raw.x); f[ks][1] = bfhi(raw.x); f[ks][2] = bflo(raw.y); f[ks][3] = bfhi(raw.y); f[ks][4] = bflo(raw.z); f[ks][5] = bfhi(raw.z); f[ks][6] = bflo(raw.w); f[ks][7] = bfhi(raw.w);
#pragma unroll
            for (int j = 0; j < 8; ++j) ss += f[ks][j] * f[ks][j];
        }
        ss += __shfl_xor(ss, 16); ss += __shfl_xor(ss, 32);
        const float rq = __builtin_amdgcn_rsqf(ss * (1.0f / 128.0f) + EPS) * (0.08838834764831845f * 1.4426950408889634f);
        float q2 = 0.f;
#pragma unroll
        for (int ks = 0; ks < 4; ++ks) {
            const float* qg = qgbase + ks * 32 + 8 * fq;
            float qv[8];
#pragma unroll
            for (int j = 0; j < 8; ++j) { qv[j] = f[ks][j] * rq * qg[j]; q2 += qv[j] * qv[j]; }
            u32x4 w;
            w.x = pk2(qv[0], qv[1]); w.y = pk2(qv[2], qv[3]); w.z = pk2(qv[4], qv[5]); w.w = pk2(qv[6], qv[7]);
            qf[ks] = __builtin_bit_cast(bf16x8, w);
        }
        q2 += __shfl_xor(q2, 16); q2 += __shfl_xor(q2, 32);
        mshift = -fminf(__builtin_sqrtf(q2) * gm * 11.3137085f * 1.01f, 64.0f);
    }
    const int nsteps = (cnt + 31) >> 5;
    f32x4 oacc[8];
#pragma unroll
    for (int i = 0; i < 8; ++i) oacc[i] = (f32x4){0.f, 0.f, 0.f, 0.f};
    f32x4 lacc = {0.f, 0.f, 0.f, 0.f};
    const bf16x8 ones = {0x3F80, 0x3F80, 0x3F80, 0x3F80, 0x3F80, 0x3F80, 0x3F80, 0x3F80};
    const char* kvb = (const char*)(KVN + brow * 128);
    auto issue = [&](u32x4 (&pf)[8], int pp) {
#pragma unroll
        for (int it = 0; it < 8; ++it) { const int piece = it * 64 + lane; const unsigned key = list[pp * 32 + (piece >> 4)]; pf[it] = *(const u32x4*)(kvb + (key * 256u + 16u * (unsigned)(piece & 15))); }
    };
    auto step = [&](u32x4 (&pf)[8], int pp) {
#pragma unroll
        for (int it = 0; it < 8; ++it) { const int piece = it * 64 + lane; *(LAS u32x4*)(img + (piece >> 4) * 288 + (piece & 15) * 16) = pf[it]; }
        if (pp + 2 < nsteps) issue(pf, pp + 2);
        wave_lds_sync();
        __builtin_amdgcn_sched_barrier(0);
        f32x4 sa = {mshift, mshift, mshift, mshift}, sb = sa;
#pragma unroll
        for (int ks = 0; ks < 4; ++ks) {
            const bf16x8 a0 = *(LAS const bf16x8*)(img + fr * 288 + (ks * 32 + 8 * fq) * 2), a1 = *(LAS const bf16x8*)(img + (16 + fr) * 288 + (ks * 32 + 8 * fq) * 2);
            sa = __builtin_amdgcn_mfma_f32_16x16x32_bf16(a0, qf[ks], sa, 0, 0, 0); sb = __builtin_amdgcn_mfma_f32_16x16x32_bf16(a1, qf[ks], sb, 0, 0, 0);
            if (ks == 1) __builtin_amdgcn_sched_barrier(0);
        }
        if (pp * 32 + 32 > cnt) {
            const int pb0 = pp * 32 + 4 * fq;
#pragma unroll
            for (int r = 0; r < 4; ++r) { if (pb0 + r >= cnt) sa[r] = -3.0e38f; if (pb0 + 16 + r >= cnt) sb[r] = -3.0e38f; }
        }
#pragma unroll
        for (int r = 0; r < 4; ++r) { sa[r] = __builtin_amdgcn_exp2f(sa[r]); sb[r] = __builtin_amdgcn_exp2f(sb[r]); }
        u32x4 pw; pw.x = pk2(sa[0], sa[1]); pw.y = pk2(sa[2], sa[3]); pw.z = pk2(sb[0], sb[1]); pw.w = pk2(sb[2], sb[3]);
        const bf16x8 pb = __builtin_bit_cast(bf16x8, pw);
        lacc = __builtin_amdgcn_mfma_f32_16x16x32_bf16(ones, pb, lacc, 0, 0, 0);
#pragma unroll
        for (int cb = 0; cb < 8; ++cb) {
            const s16x4 r0 = __builtin_amdgcn_ds_read_tr16_b64_v4i16((LAS s16x4*)(img + (4 * fq + (fr >> 2)) * 288 + (cb * 16 + 4 * (fr & 3)) * 2));
            const s16x4 r1 = __builtin_amdgcn_ds_read_tr16_b64_v4i16((LAS s16x4*)(img + (16 + 4 * fq + (fr >> 2)) * 288 + (cb * 16 + 4 * (fr & 3)) * 2));
            const bf16x8 av = {r0[0], r0[1], r0[2], r0[3], r1[0], r1[1], r1[2], r1[3]};
            oacc[cb] = __builtin_amdgcn_mfma_f32_16x16x32_bf16(av, pb, oacc[cb], 0, 0, 0);
            if (cb == 3) __builtin_amdgcn_sched_barrier(0);
        }
        wave_lds_sync();
    };
    u32x4 pf0[8], pf1[8];
    issue(pf0, 0);
    if (nsteps > 1) issue(pf1, 1);
#pragma unroll 1
    for (int pp = 0; pp < nsteps; pp += 2) {
        step(pf0, pp);
        if (pp + 1 < nsteps) step(pf1, pp + 1);
    }
    const float inv = __builtin_amdgcn_rcpf(lacc[0]);
    if (fr < 8) {
#pragma unroll
        for (int cb = 0; cb < 8; ++cb) { u32x2 w; w.x = pk2(oacc[cb][0] * inv, oacc[cb][1] * inv); w.y = pk2(oacc[cb][2] * inv, oacc[cb][3] * inv); *(LAS u32x2*)(img + fr * 272 + (cb * 16 + 4 * fq) * 2) = w; }
    }
    wave_lds_sync();
    {
        LAS const unsigned char* src = img + (lane >> 3) * 272 + (lane & 7) * 32;
        const u32x4 o0 = *(LAS const u32x4*)(src), o1 = *(LAS const u32x4*)(src + 16);
        u16* orow = YO + (brow + t) * 1536 + 512 + lane * 16;
        *(u32x4*)orow = o0; *(u32x4*)(orow + 8) = o1;
    }
    wave_lds_sync();
}

constexpr int N_CVT_JOBS = 32 * 16 * 32 + 32 * 16 * 16;
DI void cvt_job(const Args& a, LAS float* t, int J, int lane) {
    if (J >= N_CVT_JOBS) return;
    const float* src; const float* sk; unsigned char* dst; int ld, k0, n0, row;
    if (J < 16384) {
        const int e = J >> 9, w = J & 511; src = a.in[I_WE1] + (size_t)e * 1024 * 2048; ld = 2048; k0 = (w >> 5) * 64; n0 = (w & 31) * 64; sk = a.in[I_N2G]; dst = a.ws + WS_WE1 + (size_t)e * 2048 * 1024;
        const int n = n0 + lane, hi = n >= 1024 ? 1 : 0, q = n - hi * 1024; row = (q >> 7) * 256 + hi * 128 + (q & 127);
    } else {
        const int j = J - 16384, e = j >> 8, w = j & 255; src = a.in[I_WE2] + (size_t)e * 1024 * 1024; ld = 1024; k0 = (w >> 4) * 64; n0 = (w & 15) * 64; sk = nullptr; dst = a.ws + WS_WE2 + (size_t)e * 1024 * 1024;
        row = n0 + lane;
    }
    const int kl = lane >> 4, n4 = 4 * (lane & 15);
    f32x4 v[4][4];
#pragma unroll
    for (int ks = 0; ks < 4; ++ks)
#pragma unroll
        for (int i = 0; i < 4; ++i) v[ks][i] = __builtin_nontemporal_load((const f32x4*)(src + (size_t)(k0 + ks * 16 + kl + 4 * i) * ld + n0 + n4));
    unsigned char* drow = dst + (size_t)row * 1024 + k0;
#pragma unroll
    for (int ks = 0; ks < 4; ++ks) {
#pragma unroll
        for (int i = 0; i < 4; ++i) { const float sc = (sk ? sk[k0 + ks * 16 + kl + 4 * i] : 1.0f) * 64.0f; *(LAS f32x4*)(t + (kl + 4 * i) * 64 + n4) = v[ks][i] * sc; }
        wave_lds_sync();
        float c[16];
#pragma unroll
        for (int k = 0; k < 16; ++k) c[k] = t[k * 64 + lane];
        u32x4 w; w.x = pk4_fp8(c[0], c[1], c[2], c[3]); w.y = pk4_fp8(c[4], c[5], c[6], c[7]); w.z = pk4_fp8(c[8], c[9], c[10], c[11]); w.w = pk4_fp8(c[12], c[13], c[14], c[15]);
        *(u32x4*)(drow + ks * 16) = w;
        wave_lds_sync();
    }
}

constexpr int P3_CA = 155648, P3_CB = 155652, P3_TK = 155656;
DI void scores_dyn(const Args& a, LAS unsigned char* lds, size_t brow, int t0, unsigned tkbase, int lane, int fr, int fq) {
    unsigned char* ws = a.ws;
    LAS u16* rows = (LAS u16*)(lds + P3_ROWS);
    const unsigned char* QI = (const unsigned char*)(ws + WS_QI); const unsigned char* KIN = (const unsigned char*)(ws + WS_KIN); const float* WI = (const float*)(ws + WS_WI);
    typedef int i32x4_t __attribute__((ext_vector_type(4)));
    const int ntile = (t0 + 8 + 15) >> 4, nsets = (ntile + 7) >> 3;
    i32x4_t qa[2]; f32x4 wi[2];
#pragma unroll
    for (int rg = 0; rg < 2; ++rg) {
        qa[rg] = *(const i32x4_t*)(QI + (brow + t0 + 4 * rg + (fr >> 2)) * 256 + (fr & 3) * 64 + 16 * fq);
        wi[rg] = *(const f32x4*)(WI + (brow + t0 + 4 * rg + fq) * 4);
    }
    auto claim = [&]() -> int {
        unsigned t = 0u;
        if (lane == 0) t = __hip_atomic_fetch_add((LAS unsigned*)(lds + P3_TK), 1u, __ATOMIC_RELAXED, __HIP_MEMORY_SCOPE_WORKGROUP);
        return (int)((unsigned)__builtin_amdgcn_readfirstlane((int)t) - tkbase);
    };
    auto ldk = [&](i32x4_t (&kf)[4], int sidx) {
#pragma unroll
        for (int u = 0; u < 4; ++u) { const int jt = (4 * sidx + u) < ntile ? (4 * sidx + u) : (ntile - 1); kf[u] = *(const i32x4_t*)(KIN + (brow + jt * 16 + fr) * 64 + 16 * fq); }
    };
    auto cmpk = [&](const i32x4_t (&kf)[4], int sidx) {
#pragma unroll
        for (int u = 0; u < 4; ++u) {
            const int jt = 4 * sidx + u;
            if (jt < ntile) {
                float sc[2];
#pragma unroll
                for (int rg = 0; rg < 2; ++rg) {
                    i32x4_t d = {0, 0, 0, 0};
                    d = __builtin_amdgcn_mfma_i32_16x16x64_i8(qa[rg], kf[u], d, 0, 0, 0);
                    sc[rg] = (((float)max(d[0], 0) * wi[rg][0] + (float)max(d[1], 0) * wi[rg][1]) + (float)max(d[2], 0) * wi[rg][2]) + (float)max(d[3], 0) * wi[rg][3];
                }
                const unsigned kw = bf2keys(pk2(sc[0], sc[1]));
                const int ra = ((jt >> 5) << 9) | ((jt & 3) << 7) | ((jt >> 2) & 7);
                LAS u16* wp = rows + (fq * 16384 + fr * 8) + ra;
                wp[0] = (u16)kw; wp[8192] = (u16)(kw >> 16);
            }
        }
    };
    i32x4_t kA[4], kB[4];
    int t = claim();
    if (t < nsets) ldk(kA, 2 * t);
    while (t < nsets) {
        ldk(kB, 2 * t + 1);
        cmpk(kA, 2 * t);
        const int tn = claim();
        if (tn < nsets) ldk(kA, 2 * tn);
        cmpk(kB, 2 * t + 1);
        t = tn;
    }
}
DI unsigned p3_sets(int t0) { return (unsigned)((((t0 + 8 + 15) >> 4) + 7) >> 3) + 8u; }

template <bool ROLE_A>
DI void dsa_loop(const Args& a, LAS unsigned char* lds, const int wid) {
    unsigned char* ws = a.ws; (void)ws;
    LAS u16* rows = (LAS u16*)(lds + P3_ROWS);
    volatile LAS unsigned* cnt = (volatile LAS unsigned*)(lds + P3_CA);
    bool bprev = false; size_t pbrow = 0; int pt0 = 0, bbuf = 0;
    unsigned tkbase = 0u; int trip = 0;
    const float gmax = ROLE_A ? 0.f : kv_gain_max(a, otid() & 63);
    if ((int)blockIdx.x < T / 8) {
        const int lane = otid() & 63, fr = lane & 15, fq = lane >> 4, gi = blockIdx.x, t0 = S - 8 - 8 * (gi >> 2);
        scores_dyn(a, lds, (size_t)(gi & 3) * S, t0, tkbase, lane, fr, fq);
        tkbase += p3_sets(t0);
    }
    for (int gi = blockIdx.x; gi < T / 8; gi += gridDim.x) {
        const int lane = otid() & 63, fr = lane & 15, fq = lane >> 4;
        const int b = gi & 3, t0 = S - 8 - 8 * (gi >> 2);
        const size_t brow = (size_t)b * S;
        __syncthreads();
        if constexpr (ROLE_A) {
            LAS u16* l0 = (LAS u16*)(lds + (bbuf ? P3_HIST : P3_LIST) + wid * 512);
#pragma unroll 1
            for (int qh = 0; qh < 2; ++qh) {
                u32x4 kr[16];
                const int Nq = t0 + wid + 1 + 4 * qh;
                LAS u16* lq = l0 + qh * 1024;
                if (Nq > 256) keys_load(rows + wid * 16384 + qh * 8192, Nq, lane, kr);
                if (qh == 0) __syncthreads();
                else { wave_lds_sync(); if (lane == 0) __hip_atomic_fetch_add((LAS unsigned*)(lds + P3_CA), 1u, __ATOMIC_RELAXED, __HIP_MEMORY_SCOPE_WORKGROUP); }
                if (Nq > 256) keys_select(kr, lq, Nq, lane); else { for (int p = lane; p < 256; p += 64) lq[p] = p < Nq ? (u16)p : (u16)0; }
            }
            {
                const int G3 = gridDim.x, c3 = blockIdx.x, it3 = (gi - c3) / G3, ntrip = (T / 8 - c3 + G3 - 1) / G3, jtot = (N_CVT_JOBS + 4 * G3 - 1) / (4 * G3);
                const int jlo = (jtot * it3 + ntrip - 1) / ntrip, jhi = (jtot * (it3 + 1) + ntrip - 1) / ntrip;
                LAS float* tcv = (LAS float*)(lds + (wid < 3 ? 135168 + wid * 4096 : 151552));
#pragma unroll 1
                for (int j = jlo; j < jhi; ++j) cvt_job(a, tcv, (j * 4 + wid) * G3 + c3, lane);
            }
        } else {
            __syncthreads();
            if (bprev) {
                LAS const u16* lp = (LAS const u16*)(lds + (bbuf ? P3_LIST : P3_HIST));
                LAS unsigned char* img = (LAS unsigned char*)(rows + (wid - 4) * 16384);
#pragma unroll 1
                for (int qh = 0; qh < 2; ++qh) { const int q = wid - 4 + 4 * qh, t = pt0 + q; attend(a, pbrow, t, t + 1 < 256 ? t + 1 : 256, lp + q * 256, img, lane, fr, fq, gmax); }
            }
            wave_lds_sync();
            if (lane == 0) __hip_atomic_fetch_add((LAS unsigned*)(lds + P3_CB), 1u, __ATOMIC_RELAXED, __HIP_MEMORY_SCOPE_WORKGROUP);
        }
        bprev = true; pbrow = brow; pt0 = t0; bbuf ^= 1; ++trip;
        const int gn = gi + gridDim.x;
        if (gn < T / 8) {
            { unsigned sp = 0u; while ((cnt[0] < 4u * (unsigned)trip || cnt[1] < 4u * (unsigned)trip) && ++sp < (1u << 22)) __builtin_amdgcn_s_sleep(1); }
            const int tn = S - 8 - 8 * (gn >> 2);
            scores_dyn(a, lds, (size_t)(gn & 3) * S, tn, tkbase, lane, fr, fq);
            tkbase += p3_sets(tn);
        }
    }
}

DI void dsa_phase(const Args& a, LAS unsigned char* lds) {
    const int wid = __builtin_amdgcn_readfirstlane(otid() >> 6);
    if (threadIdx.x < 3) ((volatile LAS unsigned*)(lds + P3_CA))[threadIdx.x] = 0u;
    __syncthreads();
    if (wid < 4) dsa_loop<true>(a, lds, wid); else dsa_loop<false>(a, lds, wid);
    __syncthreads();
    {
        const int ntrip = (T / 8 - (int)blockIdx.x + (int)gridDim.x - 1) / (int)gridDim.x;
        if (ntrip > 0) {
            const int gl = blockIdx.x + (ntrip - 1) * gridDim.x, pt0 = S - 8 - 8 * (gl >> 2);
            const size_t pbrow = (size_t)(gl & 3) * S;
            const int lane = otid() & 63, fr = lane & 15, fq = lane >> 4;
            LAS u16* rows = (LAS u16*)(lds + P3_ROWS);
            LAS const u16* lp = (LAS const u16*)(lds + ((ntrip & 1) ? P3_LIST : P3_HIST));
            const int q = wid, t = pt0 + q;
            attend(a, pbrow, t, t + 1 < 256 ? t + 1 : 256, lp + q * 256, (LAS unsigned char*)(rows + wid * 8192), lane, fr, fq, kv_gain_max(a, lane));
        }
    }
}

constexpr int P6_LCNT = 0, P6_BASE = 128, P6_RSB = 256, P6_RI = 1024;
DI unsigned dpp_max_u32(unsigned v) {
    v = max(v, (unsigned)__builtin_amdgcn_update_dpp(0, (int)v, 0xB1, 0xf, 0xf, false));
    v = max(v, (unsigned)__builtin_amdgcn_update_dpp(0, (int)v, 0x4E, 0xf, 0xf, false));
    v = max(v, (unsigned)__builtin_amdgcn_update_dpp(0, (int)v, 0x141, 0xf, 0xf, false));
    v = max(v, (unsigned)__builtin_amdgcn_update_dpp(0, (int)v, 0x140, 0xf, 0xf, false));
    return v;
}
DI float key2f(unsigned k) { return __uint_as_float((k & 0x80000000u) ? (k & 0x7fffffffu) : ~k); }
DI void router_phase(const Args& a, LAS unsigned char* lds) {
    unsigned char* ws = a.ws;
    const int tid = otid(), wid = tid >> 6, lane = tid & 63, fr = lane & 15, fq = lane >> 4;
    LAS int* lcnt = (LAS int*)(lds + P6_LCNT); LAS int* lbase = (LAS int*)(lds + P6_BASE); LAS float* rsb = (LAS float*)(lds + P6_RSB); LAS int* RI = (LAS int*)(lds + P6_RI);
    const u16* WRH = (const u16*)(ws + WS_WR);
    unsigned* CNT = (unsigned*)(ws + WS_CTL);
    LAS unsigned char* WL = lds + 16384;
    __syncthreads();
#pragma unroll 8
    for (int i = tid; i < 64 * 128; i += NT) { const int r = i >> 7, p = i & 127; *(LAS u32x4*)(WL + r * 2064 + p * 16) = *(const u32x4*)(WRH + (size_t)r * 1024 + p * 8); }
    for (int rg = blockIdx.x; rg < T / 128; rg += gridDim.x) {
        __syncthreads();
        if (tid < 32) lcnt[tid] = 0;
        __syncthreads();
        {
            const int row = rg * 128 + wid * 16 + fr;
            const u16* xr = (const u16*)(ws + WS_X1B) + (size_t)row * 1024 + 8 * fq;
            f32x4 acc[2] = {{0.f, 0.f, 0.f, 0.f}, {0.f, 0.f, 0.f, 0.f}};
            float ss = 0.f;
#pragma unroll 4
            for (int ks = 0; ks < 32; ++ks) {
                const u32x4 hw = *(const u32x4*)(xr + ks * 32);
                ss += ((bflo(hw.x) * bflo(hw.x) + bfhi(hw.x) * bfhi(hw.x)) + (bflo(hw.y) * bflo(hw.y) + bfhi(hw.y) * bfhi(hw.y))) + ((bflo(hw.z) * bflo(hw.z) + bfhi(hw.z) * bfhi(hw.z)) + (bflo(hw.w) * bflo(hw.w) + bfhi(hw.w) * bfhi(hw.w)));
                const bf16x8 xh = __builtin_bit_cast(bf16x8, hw);
#pragma unroll
                for (int nt = 0; nt < 2; ++nt) {
                    const bf16x8 wh = *(LAS const bf16x8*)(WL + (nt * 16 + fr) * 2064 + (ks * 32 + 8 * fq) * 2), wl = *(LAS const bf16x8*)(WL + (32 + nt * 16 + fr) * 2064 + (ks * 32 + 8 * fq) * 2);
                    acc[nt] = __builtin_amdgcn_mfma_f32_16x16x32_bf16(xh, wh, acc[nt], 0, 0, 0);
                    acc[nt] = __builtin_amdgcn_mfma_f32_16x16x32_bf16(xh, wl, acc[nt], 0, 0, 0);
                }
            }
            ss += __shfl_xor(ss, 16); ss += __shfl_xor(ss, 32);
            const float rsrow = __builtin_amdgcn_rsqf(ss * (1.0f / 1024.0f) + EPS);
            if (fq == 0) rsb[wid * 16 + fr] = rsrow;
            wave_lds_sync();
            {
                const u16* xw = (const u16*)(ws + WS_X1B) + (size_t)(rg * 128 + wid * 16) * 1024 + lane * 16;
                unsigned char* xo = ws + WS_XN2 + (size_t)(rg * 128 + wid * 16) * 1024 + lane * 16;
#pragma unroll 4
                for (int r = 0; r < 16; ++r) {
                    const float rs = rsb[wid * 16 + r];
                    const u32x4 h0 = *(const u32x4*)(xw + (size_t)r * 1024), h1 = *(const u32x4*)(xw + (size_t)r * 1024 + 8);
                    u32x4 w;
                    w.x = pk4_fp8(bflo(h0.x) * rs, bfhi(h0.x) * rs, bflo(h0.y) * rs, bfhi(h0.y) * rs); w.y = pk4_fp8(bflo(h0.z) * rs, bfhi(h0.z) * rs, bflo(h0.w) * rs, bfhi(h0.w) * rs);
                    w.z = pk4_fp8(bflo(h1.x) * rs, bfhi(h1.x) * rs, bflo(h1.y) * rs, bfhi(h1.y) * rs); w.w = pk4_fp8(bflo(h1.z) * rs, bfhi(h1.z) * rs, bflo(h1.w) * rs, bfhi(h1.w) * rs);
                    *(u32x4*)(xo + (size_t)r * 1024) = w;
                }
            }
            wave_lds_sync();
            const float b0 = a.in[I_BR][fr], b1 = a.in[I_BR][16 + fr];
#pragma unroll
            for (int r = 0; r < 4; ++r) {
                const float rs = rsb[wid * 16 + 4 * fq + r];
                unsigned k0 = (f2key(acc[0][r] * rs + b0) & ~31u) | (unsigned)(31 - fr), k1 = (f2key(acc[1][r] * rs + b1) & ~31u) | (unsigned)(15 - fr);
                unsigned sel[4];
#pragma unroll
                for (int k = 0; k < 4; ++k) {
                    const unsigned best = dpp_max_u32(k0 > k1 ? k0 : k1);
                    sel[k] = best;
                    if (k0 == best) k0 = 0u;
                    if (k1 == best) k1 = 0u;
                }
                const float v0 = key2f(sel[0] & ~31u), e1 = __expf(key2f(sel[1] & ~31u) - v0), e2 = __expf(key2f(sel[2] & ~31u) - v0), e3 = __expf(key2f(sel[3] & ~31u) - v0);
                const float inv = 1.0f / (1.0f + e1 + e2 + e3);
                if (fr < 4) {
                    const unsigned sk = fr == 0 ? sel[0] : (fr == 1 ? sel[1] : (fr == 2 ? sel[2] : sel[3]));
                    const int e = 31 - (int)(sk & 31u);
                    const float gt = (fr == 0 ? 1.0f : (fr == 1 ? e1 : (fr == 2 ? e2 : e3))) * inv;
                    const int ls = __hip_atomic_fetch_add(lcnt + e, 1, __ATOMIC_RELAXED, __HIP_MEMORY_SCOPE_WORKGROUP);
                    const int ri = ((wid * 16 + 4 * fq + r) * 4 + fr) * 4;
                    RI[ri + 0] = e; RI[ri + 1] = ls; RI[ri + 2] = __float_as_int(gt);
                }
            }
        }
        __syncthreads();
        if (tid < 32) lbase[tid] = (int)__hip_atomic_fetch_add(CNT + tid, (unsigned)lcnt[tid], __ATOMIC_RELAXED, __HIP_MEMORY_SCOPE_AGENT);
        __syncthreads();
        {
            const int rl = tid >> 2, k = tid & 3, row = rg * 128 + rl;
            const int e = RI[tid * 4 + 0], slot = lbase[e] + RI[tid * 4 + 1];
            ((int*)(ws + WS_LTOK))[(size_t)e * ECAP + slot] = row;
            ((float*)(ws + WS_LRS))[(size_t)row * 4 + k] = __int_as_float(RI[tid * 4 + 2]);
            ((unsigned*)(ws + WS_ROUTE))[(size_t)row * 4 + k] = ((unsigned)e << 16) | (unsigned)slot;
        }
    }
}

DI void combine_phase(const Args& a, LAS unsigned char* lds) {
    unsigned char* ws = a.ws;
    LAS const int* tab = (LAS const int*)(lds + MOE_TAB);
    const int tid = otid(), wid = tid >> 6, lane = tid & 63;
    const unsigned char* YB = (const unsigned char*)(ws + WS_YB); const unsigned* ROUTE = (const unsigned*)(ws + WS_ROUTE);
    for (int row = blockIdx.x * 8 + wid; row < T; row += gridDim.x * 8) {
        size_t pos[4];
#pragma unroll
        for (int k = 0; k < 4; ++k) { const unsigned r = ROUTE[(size_t)row * 4 + k]; const int e = (int)(r >> 16), slot = (int)(r & 0xffffu); pos[k] = (size_t)tab[e] * 256 + slot; }
        float* orow = a.out + (size_t)row * 1024 + lane * 16;
        const f32x4 gt = *(const f32x4*)((const float*)(ws + WS_LRS) + (size_t)row * 4) * 0.0625f;
        u32x4 y[4];
#pragma unroll
        for (int k = 0; k < 4; ++k) y[k] = __builtin_nontemporal_load((const u32x4*)(YB + pos[k] * 1024 + lane * 16));
        const u16* x1r = (const u16*)(ws + WS_X1B) + (size_t)row * 1024 + lane * 16;
        const u32x4 xa = *(const u32x4*)(x1r), xb2 = *(const u32x4*)(x1r + 8);
        f32x4 v[4];
        v[0] = (f32x4){bflo(xa.x), bfhi(xa.x), bflo(xa.y), bfhi(xa.y)}; v[1] = (f32x4){bflo(xa.z), bfhi(xa.z), bflo(xa.w), bfhi(xa.w)};
        v[2] = (f32x4){bflo(xb2.x), bfhi(xb2.x), bflo(xb2.y), bfhi(xb2.y)}; v[3] = (f32x4){bflo(xb2.z), bfhi(xb2.z), bflo(xb2.w), bfhi(xb2.w)};
#pragma unroll
        for (int k = 0; k < 4; ++k)
#pragma unroll
            for (int i = 0; i < 4; ++i) {
                const unsigned w = y[k][i];
                v[i][0] += gt[k] * __builtin_amdgcn_cvt_f32_fp8((int)w, 0); v[i][1] += gt[k] * __builtin_amdgcn_cvt_f32_fp8((int)w, 1);
                v[i][2] += gt[k] * __builtin_amdgcn_cvt_f32_fp8((int)w, 2); v[i][3] += gt[k] * __builtin_amdgcn_cvt_f32_fp8((int)w, 3);
            }
#pragma unroll
        for (int i = 0; i < 4; ++i) *(f32x4*)(orow + 4 * i) = v[i];
    }
}

#define XB_TMO      128
#define XB_XCNT(j)  (256  + 64 * (j))
#define XB_XSUB(j)  (1280 + 64 * (j))
#define XB_XGEN(j)  (2304 + 64 * (j))
#define XB_TOP      3328
#define XB_TOPGEN   3392
#define XCD_BAR_WORDS 3456
#define XB_SPIN_CAP (1u << 18)

__device__ __forceinline__ unsigned xb_ld(unsigned* p)              { return __hip_atomic_load(p, __ATOMIC_RELAXED, __HIP_MEMORY_SCOPE_AGENT); }
__device__ __forceinline__ unsigned xb_add(unsigned* p, unsigned v) { return __hip_atomic_fetch_add(p, v, __ATOMIC_RELAXED, __HIP_MEMORY_SCOPE_AGENT); }
__device__ __forceinline__ unsigned xb_xcc_id() { return (unsigned)__builtin_amdgcn_s_getreg((3 << 11) | 20) & 0xFu; }
#define XB_SPIN(cond, bar) do { unsigned _sp = 0; while (cond) { __builtin_amdgcn_s_sleep(1); \
    if ((++_sp & 255u) == 0u) { if (xb_ld(&(bar)[XB_TMO])) break; if (_sp > XB_SPIN_CAP) { atomicAdd(&(bar)[XB_TMO], 1u); break; } } } } while (0)

struct XcdBarrier {
    unsigned* bar; unsigned x;
    volatile LAS unsigned* st;
};

__device__ __forceinline__ XcdBarrier xcd_barrier_post(unsigned* bar, volatile LAS unsigned* st) {
    XcdBarrier b; b.bar = bar; b.x = xb_xcc_id(); b.st = st;
    if (threadIdx.x == 0) (void)xb_add(&bar[XB_XCNT(b.x)], 1u);
    return b;
}
__device__ __forceinline__ void xcd_barrier_complete(unsigned* bar, unsigned x, unsigned& nloc, unsigned& nx) {
    const unsigned G = gridDim.x * gridDim.y * gridDim.z;
    unsigned sum, cnt, mine, sp = 0u;
    for (;;) {
        sum = 0u; cnt = 0u; mine = 0u;
#pragma unroll
        for (unsigned j = 0; j < 16; ++j) { const unsigned c = xb_ld(&bar[XB_XCNT(j)]); sum += c; cnt += (c > 0u) ? 1u : 0u; mine = (j == x) ? c : mine; }
        if (sum == G) break;
        __builtin_amdgcn_s_sleep(1);
        if ((++sp & 255u) == 0u) { if (xb_ld(&bar[XB_TMO])) break; if (sp > XB_SPIN_CAP) { atomicAdd(&bar[XB_TMO], 1u); break; } }
    }
    nloc = mine > 0u ? mine : 1u; nx = cnt > 0u ? cnt : 1u;
}

__device__ __forceinline__ void xcd_barrier(const XcdBarrier& b) {
    asm volatile("s_waitcnt vmcnt(0)" ::: "memory");
    __syncthreads();
    if (threadIdx.x == 0) {
        unsigned* bar = b.bar;
        __builtin_amdgcn_s_waitcnt(0);
        unsigned nloc = b.st[0], nx = b.st[1];
        if (nloc == 0u) { xcd_barrier_complete(bar, b.x, nloc, nx); b.st[0] = nloc; b.st[1] = nx; }
        const unsigned old = xb_add(&bar[XB_XSUB(b.x)], 1u);
        const unsigned gen = old / nloc;
        if (old + 1u == (gen + 1u) * nloc) {
            __builtin_amdgcn_fence(__ATOMIC_RELEASE, "agent");
            asm volatile("s_waitcnt vmcnt(0)" ::: "memory");
            const unsigned og = xb_add(&bar[XB_TOP], 1u);
            const unsigned tg = og / nx;
            if (og + 1u == (tg + 1u) * nx) xb_add(&bar[XB_TOPGEN], 1u);
            else XB_SPIN(xb_ld(&bar[XB_TOPGEN]) == tg, bar);
            __builtin_amdgcn_fence(__ATOMIC_ACQUIRE, "agent");
            xb_add(&bar[XB_XGEN(b.x)], 1u);
            asm volatile("s_waitcnt vmcnt(0)" ::: "memory");
        } else {
            XB_SPIN(xb_ld(&bar[XB_XGEN(b.x)]) == gen, bar);
            __builtin_amdgcn_fence(__ATOMIC_ACQUIRE, "agent");
            asm volatile("s_waitcnt vmcnt(0)" ::: "memory");
        }
    }
    __syncthreads();
}

__global__ void __launch_bounds__(NT, 2) fwd(Args a) {
    extern __shared__ __attribute__((aligned(16))) unsigned char lds_raw[];
    LAS unsigned char* lds = (LAS unsigned char*)lds_raw;
    cg::grid_group grid = cg::this_grid();
    unsigned char* ws = a.ws;
    const int G = gridDim.x, c = blockIdx.x;
    if (threadIdx.x < 2) ((volatile LAS unsigned*)(lds + LDS_BARST))[threadIdx.x] = 0u;
    __syncthreads();
    const XcdBarrier xbar = xcd_barrier_post((unsigned*)(ws + WS_BAR), (volatile LAS unsigned*)(lds + LDS_BARST));

    phase0(a, lds);
    xcd_barrier(xbar);
    {
        g8::PlainSched s; s.Abase = (const char*)(ws + WS_XB); s.Bbase = (const char*)(ws + WS_WIN); s.lda = 1024; s.ldb = 1024; s.K = 1024; s.nM = T / 256; s.nN = 6; s.G = G; s.c = c;
        EpiIn e; e.G8 = ws + WS_G8; e.H = (u16*)(ws + WS_H); e.rs1 = (const float*)(ws + WS_RS1); e.SSQ = (float*)(ws + WS_SSQ); e.WI = (float*)(ws + WS_WI);
        g8::gemm_phase(lds, s, e);
        g8::PlainSched8 s8; s8.Abase = (const char*)(ws + WS_XB8); s8.Bbase = (const char*)(ws + WS_WIN8); s8.lda = 1024; s8.ldb = 1024; s8.K = 1024; s8.nM = T / 256; s8.nN = 8; s8.G = G; s8.c = c;
        EpiGate eg; eg.G8 = ws + WS_G8;
        g8::gemm_phase<true>(lds, s8, eg);
    }
    xcd_barrier(xbar);
    {
        g8::PlainSched s; s.Abase = (const char*)(ws + WS_H) + 1024 * 2; s.Bbase = (const char*)(ws + WS_WQ); s.lda = NIN; s.ldb = 256; s.K = 256; s.nM = T / 256; s.nN = 5; s.G = G; s.c = c;
        EpiQ e; e.Q = (u16*)(ws + WS_Q); e.QI = (u16*)(ws + WS_QI); e.SSQ = (const float*)(ws + WS_SSQ);
        g8::gemm_phase(lds, s, e);
        if (G == 256) {
            const int nu = c < 128 ? 3 : 5;
            for (int k = 0; k < nu; ++k) gmlp_unit(a, lds, k < 4 ? c + 256 * k : c - 128 + 768);
        } else {
            for (int u = c; u < 1024; u += G) gmlp_unit(a, lds, u);
        }
        kvnorm(a);
    }
    xcd_barrier(xbar);
    dsa_phase(a, lds);
    xcd_barrier(xbar);
    {
        g8::PlainSched s; s.Abase = (const char*)(ws + WS_YO); s.Bbase = (const char*)(ws + WS_WCAT); s.lda = 1536; s.ldb = 1536; s.K = 512; s.nM = T / 256; s.nN = 4; s.G = G; s.c = c;
        EpiMrg<0> e0; e0.OUT = (u16*)(ws + WS_TMP); e0.TMP = nullptr; e0.G8 = ws + WS_G8;
        g8::gemm_phase(lds, s, e0);
        s.Abase = (const char*)(ws + WS_YO) + 512 * 2; s.Bbase = (const char*)(ws + WS_WCAT) + 512 * 2; s.K = 1024;
        EpiMrg<1> e1; e1.OUT = (u16*)(ws + WS_MRG); e1.TMP = (const u16*)(ws + WS_TMP); e1.G8 = ws + WS_G8;
        g8::gemm_phase(lds, s, e1);
    }
    xcd_barrier(xbar);
    {
        g8::PlainSched8 s; s.Abase = (const char*)(ws + WS_MRG); s.Bbase = (const char*)(ws + WS_WOUT); s.lda = 1024; s.ldb = 1024; s.K = 1024; s.nM = T / 256; s.nN = 4; s.G = G; s.c = c;
        EpiOut e; e.x1b = (u16*)(ws + WS_X1B); e.xb = (const u16*)(ws + WS_XB); e.irs = (const float*)(ws + WS_RS1);
        g8::gemm_phase<true>(lds, s, e);
    }
    xcd_barrier(xbar);
    router_phase(a, lds);
    xcd_barrier(xbar);
    moe_table(lds, (const unsigned*)(ws + WS_CTL));
    {
        MoeSched<8, true> s; s.Abase = (const char*)(ws + WS_XN2); s.Wbase = (const char*)(ws + WS_WE1); s.LTOK = (const int*)(ws + WS_LTOK); s.tab = (LAS const int*)(lds + MOE_TAB);
        s.lda = 1024; s.ldb = 1024; s.K = 1024; s.G = G; s.c = c; s.wstride = (size_t)2048 * 1024;
        EpiMoe1 e; e.ACT = (unsigned char*)(ws + WS_ACT); e.b1 = a.in[I_BE1];
        g8::gemm_phase<true>(lds, s, e);
    }
    xcd_barrier(xbar);
    {
        MoeSched<4, false> s; s.Abase = (const char*)(ws + WS_ACT); s.Wbase = (const char*)(ws + WS_WE2); s.LTOK = nullptr; s.tab = (LAS const int*)(lds + MOE_TAB);
        s.lda = 1024; s.ldb = 1024; s.K = 1024; s.G = G; s.c = c; s.wstride = (size_t)1024 * 1024;
        EpiMoe2 e; e.YB = (u16*)(ws + WS_YB); e.b2 = a.in[I_BE2];
        g8::gemm_phase<true>(lds, s, e);
    }
    xcd_barrier(xbar);
    combine_phase(a, lds);
    if (a.mask == 0u) grid.sync();
}

extern "C" void kernel_launch(void* const* d_in, const int* in_sizes, int n_in, void* d_out, int out_size, void* d_ws, size_t ws_size, hipStream_t stream) {
    static int grid = 0;
    if (grid == 0) {
        int dev = 0, cus = 0, per_cu = 0;
        if (n_in != 23 || out_size != T * Dm || ws_size < WS_END) { fprintf(stderr, "kernel_launch: unexpected problem (n_in %d, out %d, ws %zu < %zu)\n", n_in, out_size, ws_size, (size_t)WS_END); grid = -1; return; }
        if (hipGetDevice(&dev) != hipSuccess || hipDeviceGetAttribute(&cus, hipDeviceAttributeMultiprocessorCount, dev) != hipSuccess) { grid = -1; return; }
        if (hipFuncSetAttribute((const void*)fwd, hipFuncAttributeMaxDynamicSharedMemorySize, LDS_BYTES) != hipSuccess) { fprintf(stderr, "hipFuncSetAttribute failed\n"); grid = -1; return; }
        if (hipOccupancyMaxActiveBlocksPerMultiprocessor(&per_cu, (const void*)fwd, NT, LDS_BYTES) != hipSuccess || per_cu < 1) { fprintf(stderr, "occupancy query failed (%d)\n", per_cu); grid = -1; return; }
        grid = cus;
        fprintf(stderr, "kernel_launch: cus %d per_cu %d grid %d ws %zu need %zu\n", cus, per_cu, grid, ws_size, (size_t)WS_END);
    }
    if (grid < 0) return;
    Args a{};
    for (int i = 0; i < 23; ++i) a.in[i] = (const float*)d_in[i];
    a.out = (float*)d_out; a.ws = (unsigned char*)d_ws; a.mask = 0xffffffffu; a.pad = 0u;
    if (hipMemsetAsync((char*)d_ws + WS_CTL, 0, 65536, stream) != hipSuccess) { fprintf(stderr, "memset failed\n"); return; }
    void* args[] = {&a};
    hipError_t e = hipLaunchCooperativeKernel((const void*)fwd, dim3(grid), dim3(NT), args, LDS_BYTES, stream);
    if (e != hipSuccess) fprintf(stderr, "cooperative launch failed: %s (grid %d)\n", hipGetErrorString(e), grid);
}
```
